# Optimizing an MI355X kernel written in HIP

```python
import jax, jax.numpy as jnp
from jax import lax
import numpy as np

D_MODEL = 1024
BATCH = 4
SEQ = 8192
DEPTH = 1

NSA_HEADS = 8
NSA_HEAD_DIM = 64
NSA_WIDTH = NSA_HEADS * NSA_HEAD_DIM
NSA_KV_HEADS = 2
NSA_HEADS_PER_KV = NSA_HEADS // NSA_KV_HEADS
NSA_KV_WIDTH = NSA_KV_HEADS * NSA_HEAD_DIM
CMP_BLOCK = 32
CMP_STRIDE = 16
CMP_HIDDEN = 256
SEL_BLOCK = 64
N_SELECT = 16
WINDOW = 512
Q_BLOCK = 128
HGRN_HEADS = 4
HGRN_KEY_DIM = 128
HGRN_VAL_DIM = 128
HGRN_WIDTH = HGRN_HEADS * HGRN_VAL_DIM
HGRN_CHUNK = 64
MIX_WIDTH = NSA_WIDTH + HGRN_WIDTH
N_EXPERTS = 256
TOP_K = 8
N_GROUPS = 8
TOPK_GROUPS = 4
EXPERT_FF = 256
SHARED_FF = 256
ROUTED_SCALE = 2.5
EXPERT_ROWS = 128
RMS_EPS = 1e-6
BIG = 1e9
IN_SPLITS = (NSA_WIDTH,) + (NSA_KV_WIDTH,) * 6 + (NSA_HEADS * 3,) + (HGRN_HEADS * HGRN_KEY_DIM, HGRN_HEADS * HGRN_KEY_DIM, HGRN_WIDTH, HGRN_WIDTH)
IN_COLS = sum(IN_SPLITS)

kernel_name = 'hymba_nsa_hgrn2_moe_adaln_block'


def rms_norm(x, w):
    xf = x.astype(jnp.float32)
    y = xf * lax.rsqrt(jnp.mean(xf * xf, axis=-1, keepdims=True) + RMS_EPS)
    return (y * w.astype(jnp.float32)).astype(x.dtype)


def masked_softmax(s, valid):
    s = jnp.where(valid, s, -jnp.inf)
    m = jnp.max(s, axis=-1, keepdims=True)
    m = jnp.where(jnp.isfinite(m), m, 0.0)
    e = jnp.exp(s - m)
    return e / jnp.maximum(jnp.sum(e, axis=-1, keepdims=True), 1e-30)


def alibi_slopes(n):
    return jnp.asarray(np.array([2.0 ** (-8.0 * (i + 1) / n) for i in range(n)], dtype=np.float32))


def compress_blocks(t, pos, w1, b1, w2):
    b, s, g, d = t.shape
    ch = t.reshape(b, s // CMP_STRIDE, CMP_STRIDE, g, d)
    blk = jnp.concatenate([ch[:, :-1], ch[:, 1:]], axis=2) + pos[None, None, :, None, :]
    flat = blk.transpose(0, 1, 3, 2, 4).reshape(b, s // CMP_STRIDE - 1, g, CMP_BLOCK * d)
    return jax.nn.gelu(flat @ w1 + b1) @ w2


def nsa_mixer(q, kc_raw, vc_raw, ks, vs, kw, vw, gate_logits, q_norm_w, k_norm_w,
              cmp_pos, cmp_w1, cmp_b1, cmp_w2, out_norm_w):
    b, s, _ = q.shape
    g_, hg, hd = NSA_KV_HEADS, NSA_HEADS_PER_KV, NSA_HEAD_DIM
    n_cmp = s // CMP_STRIDE - 1
    n_slc = s // SEL_BLOCK
    n_top = min(N_SELECT, n_slc)
    n_sel_tok = n_top * SEL_BLOCK
    scale = hd ** -0.5
    q = rms_norm(q.reshape(b, s, NSA_HEADS, hd), q_norm_w)
    kc = rms_norm(compress_blocks(kc_raw.reshape(b, s, g_, hd), cmp_pos[0], cmp_w1[0], cmp_b1[0], cmp_w2[0]), k_norm_w[0])
    vc = compress_blocks(vc_raw.reshape(b, s, g_, hd), cmp_pos[1], cmp_w1[1], cmp_b1[1], cmp_w2[1])
    ks_blk = rms_norm(ks.reshape(b, s, g_, hd), k_norm_w[1]).reshape(b, n_slc, SEL_BLOCK, g_, hd).transpose(0, 3, 1, 2, 4)
    vs_blk = vs.reshape(b, n_slc, SEL_BLOCK, g_, hd).transpose(0, 3, 1, 2, 4)
    pad = jnp.zeros((b, WINDOW, g_, hd), kw.dtype)
    kw_pad = jnp.concatenate([pad, rms_norm(kw.reshape(b, s, g_, hd), k_norm_w[2])], axis=1)
    vw_pad = jnp.concatenate([pad, vw.reshape(b, s, g_, hd)], axis=1)
    gates = jax.nn.sigmoid(gate_logits.astype(jnp.float32)).reshape(b, s, g_, hg, 3)
    slopes = alibi_slopes(NSA_HEADS).reshape(g_, hg)[None, :, :, None, None]
    cmp_end = jnp.arange(n_cmp) * CMP_STRIDE + CMP_BLOCK - 1
    blk_ids = jnp.arange(n_slc)
    ci = jnp.arange(n_cmp)[:, None] * CMP_STRIDE
    overlap = ((ci < (blk_ids[None, :] + 1) * SEL_BLOCK) & (ci + CMP_BLOCK > blk_ids[None, :] * SEL_BLOCK)).astype(jnp.float32)
    bi = jnp.arange(b)[:, None, None, None]
    gi = jnp.arange(g_)[None, :, None, None]
    tok_in_blk = jnp.arange(SEL_BLOCK)

    def query_block(qb_idx):
        q0 = qb_idx * Q_BLOCK
        t = q0 + jnp.arange(Q_BLOCK)
        qb = lax.dynamic_slice_in_dim(q, q0, Q_BLOCK, axis=1).reshape(b, Q_BLOCK, g_, hg, hd)
        gb = lax.dynamic_slice_in_dim(gates, q0, Q_BLOCK, axis=1)
        dist_c = t[:, None] - cmp_end[None, :]
        s_c = jnp.einsum('bqghd,bngd->bghqn', qb, kc).astype(jnp.float32) * scale - slopes * dist_c
        p_c = masked_softmax(s_c, dist_c >= 0)
        o_c = jnp.einsum('bghqn,bngd->bqghd', p_c.astype(vc.dtype), vc)
        imp = jnp.einsum('bghqn,nj->bgqj', p_c, overlap)
        cur = (t // SEL_BLOCK)[:, None]
        forced = (blk_ids[None, :] == 0) | (blk_ids[None, :] == cur) | (blk_ids[None, :] == cur - 1)
        causal_blk = blk_ids[None, :] * SEL_BLOCK <= t[:, None]
        rank = jnp.where(forced, BIG, jnp.where(causal_blk, imp, -BIG))
        _, idx = lax.top_k(rank, n_top)
        k_sel = ks_blk[bi, gi, idx].reshape(b, g_, Q_BLOCK, n_sel_tok, hd)
        v_sel = vs_blk[bi, gi, idx].reshape(b, g_, Q_BLOCK, n_sel_tok, hd)
        pos = (idx[..., None] * SEL_BLOCK + tok_in_blk).reshape(b, g_, Q_BLOCK, n_sel_tok)
        dist_s = (t[None, None, :, None] - pos)[:, :, None]
        s_s = jnp.einsum('bqghd,bgqkd->bghqk', qb, k_sel).astype(jnp.float32) * scale - slopes * dist_s
        p_s = masked_softmax(s_s, dist_s >= 0)
        o_s = jnp.einsum('bghqk,bgqkd->bqghd', p_s.astype(v_sel.dtype), v_sel)
        kwb = lax.dynamic_slice_in_dim(kw_pad, q0, Q_BLOCK + WINDOW, axis=1)
        vwb = lax.dynamic_slice_in_dim(vw_pad, q0, Q_BLOCK + WINDOW, axis=1)
        src = q0 - WINDOW + jnp.arange(Q_BLOCK + WINDOW)
        dist_w = t[:, None] - src[None, :]
        valid_w = (dist_w >= 0) & (dist_w < WINDOW) & (src >= 0)[None, :]
        s_w = jnp.einsum('bqghd,bkgd->bghqk', qb, kwb).astype(jnp.float32) * scale - slopes * dist_w
        p_w = masked_softmax(s_w, valid_w)
        o_w = jnp.einsum('bghqk,bkgd->bqghd', p_w.astype(vwb.dtype), vwb)
        out = gb[..., 0:1] * o_c + gb[..., 1:2] * o_s + gb[..., 2:3] * o_w
        return out.astype(q.dtype)

    o = lax.map(query_block, jnp.arange(s // Q_BLOCK))
    o = o.transpose(1, 0, 2, 3, 4, 5).reshape(b, s, NSA_HEADS, hd)
    return rms_norm(o, out_norm_w.reshape(NSA_HEADS, hd)).reshape(b, s, NSA_WIDTH)


def hgrn2_mixer(q_r, f_r, i_r, g_r, lb, out_norm_w):
    b, s, _ = q_r.shape
    n_chunk = s // HGRN_CHUNK
    q = jax.nn.silu(q_r.astype(jnp.float32)) * HGRN_KEY_DIM ** -0.5
    f = lb + (1.0 - lb) * jax.nn.sigmoid(f_r.astype(jnp.float32))
    k = 1.0 - f
    logf = jnp.log(f)
    v = i_r.astype(jnp.float32)

    def to_chunks(a, d):
        return a.reshape(b, n_chunk, HGRN_CHUNK, HGRN_HEADS, d).transpose(1, 0, 3, 2, 4)

    causal = jnp.tril(jnp.ones((HGRN_CHUNK, HGRN_CHUNK), bool))

    def step(state, inp):
        qc, kc, vc, gc = inp
        cum = jnp.cumsum(gc, axis=2)
        o_inter = jnp.einsum('bhtk,bhkv->bhtv', qc * jnp.exp(cum), state)
        diff = cum[:, :, :, None, :] - cum[:, :, None, :, :]
        decay = jnp.exp(jnp.where(causal[:, :, None], diff, -jnp.inf))
        scores = jnp.einsum('bhtsk,bhsk->bhts', qc[:, :, :, None, :] * decay, kc)
        o_intra = jnp.einsum('bhts,bhsv->bhtv', scores, vc)
        last = cum[:, :, -1:, :]
        state = jnp.exp(last[:, :, 0, :])[..., None] * state + jnp.einsum('bhsk,bhsv->bhkv', kc * jnp.exp(last - cum), vc)
        return state, o_inter + o_intra

    state0 = jnp.zeros((b, HGRN_HEADS, HGRN_KEY_DIM, HGRN_VAL_DIM), jnp.float32)
    _, o = lax.scan(step, state0, (to_chunks(q, HGRN_KEY_DIM), to_chunks(k, HGRN_KEY_DIM),
                                   to_chunks(v, HGRN_VAL_DIM), to_chunks(logf, HGRN_KEY_DIM)))
    o = o.transpose(1, 0, 3, 2, 4).reshape(b, s, HGRN_HEADS, HGRN_VAL_DIM)
    o = o * jax.nn.sigmoid(g_r.astype(jnp.float32)).reshape(b, s, HGRN_HEADS, HGRN_VAL_DIM)
    o = rms_norm(o, out_norm_w.reshape(HGRN_HEADS, HGRN_VAL_DIM))
    return o.reshape(b, s, HGRN_WIDTH).astype(q_r.dtype)


def swiglu(x, wg, wu, wd):
    return (jax.nn.silu(x @ wg) * (x @ wu)) @ wd


def route(h, router_w, router_bias):
    t = h.shape[0]
    scores = jax.nn.sigmoid((h @ router_w).astype(jnp.float32))
    biased = scores + router_bias.astype(jnp.float32)
    grp_score = lax.top_k(biased.reshape(t, N_GROUPS, N_EXPERTS // N_GROUPS), 2)[0].sum(-1)
    _, top_grp = lax.top_k(grp_score, TOPK_GROUPS)
    grp_mask = jax.nn.one_hot(top_grp, N_GROUPS, dtype=jnp.float32).sum(1) > 0
    exp_mask = jnp.repeat(grp_mask, N_EXPERTS // N_GROUPS, axis=1)
    _, idx = lax.top_k(jnp.where(exp_mask, biased, -jnp.inf), TOP_K)
    w = jnp.take_along_axis(scores, idx, axis=1)
    w = w / jnp.sum(w, axis=-1, keepdims=True) * ROUTED_SCALE
    return idx, w


def routed_experts(h, idx, w, w_gate, w_up, w_down):
    t, d = h.shape
    n = t * TOP_K
    n_blk = (n + EXPERT_ROWS - 1) // EXPERT_ROWS + N_EXPERTS
    flat_e = idx.reshape(-1).astype(jnp.int32)
    flat_tok = jnp.repeat(jnp.arange(t, dtype=jnp.int32), TOP_K)
    flat_w = w.reshape(-1)
    counts = jnp.bincount(flat_e, length=N_EXPERTS)
    padded = (counts + EXPERT_ROWS - 1) // EXPERT_ROWS * EXPERT_ROWS
    start = jnp.cumsum(counts) - counts
    pad_end = jnp.cumsum(padded)
    pad_start = pad_end - padded
    order = jnp.argsort(flat_e)
    e_sorted = flat_e[order]
    dest = pad_start[e_sorted] + jnp.arange(n, dtype=jnp.int32) - start[e_sorted]
    rows = jnp.zeros(n_blk * EXPERT_ROWS, jnp.int32).at[dest].set(flat_tok[order])
    wts = jnp.zeros(n_blk * EXPERT_ROWS, jnp.float32).at[dest].set(flat_w[order])
    blk_e = jnp.minimum(jnp.searchsorted(pad_end, jnp.arange(n_blk, dtype=jnp.int32) * EXPERT_ROWS, side='right'), N_EXPERTS - 1)

    def step(acc, xs):
        r, wt, e = xs
        y = swiglu(h[r], w_gate[e], w_up[e], w_down[e])
        return acc.at[r].add(y * wt[:, None].astype(y.dtype)), None

    acc, _ = lax.scan(step, jnp.zeros((t, d), h.dtype),
                      (rows.reshape(n_blk, EXPERT_ROWS), wts.reshape(n_blk, EXPERT_ROWS), blk_e))
    return acc


def setup_inputs(seed: int = 0) -> dict:
    key = jax.random.key(seed)
    ks = jax.random.split(key, 26)
    f32 = jnp.float32

    def nrm(k, shape, scale):
        return jax.random.normal(k, shape, f32) * scale

    def gain(k, shape):
        return 1.0 + nrm(k, shape, 0.02)

    return {
        'x': nrm(ks[0], (BATCH, SEQ, D_MODEL), 1.0),
        'c': nrm(ks[1], (BATCH, D_MODEL), 1.0),
        'ada_w': nrm(ks[2], (DEPTH, D_MODEL, 6 * D_MODEL), 0.5 * D_MODEL ** -0.5),
        'ada_b': nrm(ks[3], (DEPTH, 6 * D_MODEL), 0.02),
        'norm1_w': gain(ks[4], (DEPTH, D_MODEL)),
        'norm2_w': gain(ks[5], (DEPTH, D_MODEL)),
        'w_in': nrm(ks[6], (DEPTH, D_MODEL, IN_COLS), D_MODEL ** -0.5),
        'q_norm_w': gain(ks[7], (DEPTH, NSA_HEAD_DIM)),
        'k_norm_w': gain(ks[8], (DEPTH, 3, NSA_HEAD_DIM)),
        'cmp_pos': nrm(ks[9], (DEPTH, 2, CMP_BLOCK, NSA_HEAD_DIM), 0.2),
        'cmp_w1': nrm(ks[10], (DEPTH, 2, CMP_BLOCK * NSA_HEAD_DIM, CMP_HIDDEN), (CMP_BLOCK * NSA_HEAD_DIM) ** -0.5),
        'cmp_b1': nrm(ks[11], (DEPTH, 2, CMP_HIDDEN), 0.02),
        'cmp_w2': nrm(ks[12], (DEPTH, 2, CMP_HIDDEN, NSA_HEAD_DIM), CMP_HIDDEN ** -0.5),
        'attn_out_norm_w': gain(ks[13], (DEPTH, NSA_WIDTH)),
        'hgrn_lb_param': nrm(ks[14], (DEPTH + 1, HGRN_HEADS * HGRN_KEY_DIM), 0.5),
        'rec_out_norm_w': gain(ks[15], (DEPTH, HGRN_WIDTH)),
        'w_out': nrm(ks[16], (DEPTH, MIX_WIDTH, D_MODEL), MIX_WIDTH ** -0.5),
        'router_w': nrm(ks[17], (DEPTH, D_MODEL, N_EXPERTS), D_MODEL ** -0.5),
        'router_bias': nrm(ks[18], (DEPTH, N_EXPERTS), 0.01),
        'exp_w_gate': nrm(ks[19], (DEPTH, N_EXPERTS, D_MODEL, EXPERT_FF), D_MODEL ** -0.5),
        'exp_w_up': nrm(ks[20], (DEPTH, N_EXPERTS, D_MODEL, EXPERT_FF), D_MODEL ** -0.5),
        'exp_w_down': nrm(ks[21], (DEPTH, N_EXPERTS, EXPERT_FF, D_MODEL), EXPERT_FF ** -0.5),
        'shared_w_gate': nrm(ks[22], (DEPTH, D_MODEL, SHARED_FF), D_MODEL ** -0.5),
        'shared_w_up': nrm(ks[23], (DEPTH, D_MODEL, SHARED_FF), D_MODEL ** -0.5),
        'shared_w_down': nrm(ks[24], (DEPTH, SHARED_FF, D_MODEL), SHARED_FF ** -0.5),
    }


def reference(x, c, ada_w, ada_b, norm1_w, norm2_w, w_in, q_norm_w, k_norm_w, cmp_pos, cmp_w1,
              cmp_b1, cmp_w2, attn_out_norm_w, hgrn_lb_param, rec_out_norm_w, w_out, router_w,
              router_bias, exp_w_gate, exp_w_up, exp_w_down, shared_w_gate, shared_w_up, shared_w_down):
    b, s, d = x.shape
    lower_bounds = jnp.cumsum(jax.nn.softmax(hgrn_lb_param.astype(jnp.float32), axis=0), axis=0)
    split_at = [int(v) for v in np.cumsum(IN_SPLITS)[:-1]]
    cond = jax.nn.silu(c)
    for l in range(DEPTH):
        mod = cond @ ada_w[l] + ada_b[l]
        sh1, sc1, gt1, sh2, sc2, gt2 = [m[:, None, :] for m in jnp.split(mod, 6, axis=-1)]
        h = rms_norm(x, norm1_w[l]) * (1 + sc1) + sh1
        proj = h @ w_in[l]
        (q, kc, vc, ksl, vsl, kwn, vwn, gl, hq, hf, hi, hg) = jnp.split(proj, split_at, axis=-1)
        attn = nsa_mixer(q, kc, vc, ksl, vsl, kwn, vwn, gl, q_norm_w[l], k_norm_w[l], cmp_pos[l],
                         cmp_w1[l], cmp_b1[l], cmp_w2[l], attn_out_norm_w[l])
        rec = hgrn2_mixer(hq, hf, hi, hg, lower_bounds[l], rec_out_norm_w[l])
        mixed = jnp.concatenate([attn, rec], axis=-1) @ w_out[l]
        x = x + gt1 * mixed
        h2 = (rms_norm(x, norm2_w[l]) * (1 + sc2) + sh2).reshape(b * s, d)
        idx, wts = route(h2, router_w[l], router_bias[l])
        ffn = swiglu(h2, shared_w_gate[l], shared_w_up[l], shared_w_down[l]) + routed_experts(
            h2, idx, wts, exp_w_gate[l], exp_w_up[l], exp_w_down[l])
        x = x + gt2 * ffn.reshape(b, s, d)
    return x
```

```cpp
#include <hip/hip_runtime.h>
#include <hip/hip_cooperative_groups.h>
#include <cstdio>
#include <cstdint>
namespace cg = cooperative_groups;

#define LAS __attribute__((address_space(3)))
typedef unsigned short bf16_t;
typedef short bf16x8 __attribute__((ext_vector_type(8)));
typedef short s16x4 __attribute__((ext_vector_type(4)));
typedef float f32x4 __attribute__((ext_vector_type(4)));
typedef float f32x16 __attribute__((ext_vector_type(16)));
typedef unsigned u32x4 __attribute__((ext_vector_type(4)));
typedef unsigned u32x2 __attribute__((ext_vector_type(2)));

constexpr int D = 1024, BATCH = 4, SEQ = 8192, T = BATCH * SEQ;
constexpr int IN_COLS = 3352;
constexpr int NTHREADS = 512;
constexpr float RMS_EPS = 1e-6f;
constexpr float LOG2E = 1.4426950408889634f;

constexpr size_t MB = 1024ull * 1024ull;
constexpr size_t WS_CTL    = 0;
constexpr size_t WS_MOD    = 64 * 1024;
constexpr size_t WS_LB     = WS_MOD + 4 * 6144 * 4;
constexpr size_t WS_CB     = WS_LB + 2048;
constexpr size_t WS_H      = 1 * MB;
constexpr size_t WS_SCORES = WS_H + 64 * MB;
constexpr size_t WS_HIDS   = WS_SCORES + 32 * MB;
constexpr size_t WS_RIDX   = WS_HIDS + 16 * MB;
constexpr size_t WS_RW     = WS_RIDX + 1 * MB;
constexpr size_t WS_BUCKET = WS_RW + 1 * MB;
constexpr size_t WS_HIDR   = WS_BUCKET + 32 * MB;
constexpr size_t WS_Y      = WS_HIDR + 16 * MB;
constexpr size_t WS_Q      = WS_Y;
constexpr size_t WS_KV     = WS_Q + 32 * MB;
constexpr size_t WS_GATES  = WS_KV + 48 * MB;
constexpr size_t WS_HQ     = WS_GATES + 4 * MB;
constexpr size_t WS_LOGF   = WS_HQ + 32 * MB;
constexpr size_t WS_HV     = WS_LOGF + 64 * MB;
constexpr size_t WS_HG     = WS_HV + 32 * MB;
constexpr size_t WS_CMPH   = WS_HG + 32 * MB;
constexpr size_t WS_KC     = WS_CMPH + 4 * MB;
constexpr size_t WS_VC     = WS_KC + 1 * MB;
constexpr size_t WS_HL     = WS_VC + 1 * MB;
constexpr size_t WS_HD     = WS_HL + 32 * MB;
constexpr size_t WS_MIX    = WS_HD + 1 * MB;
constexpr size_t WS_END    = WS_Y + 512 * MB;

struct Params {
    const float *x, *c, *ada_w, *ada_b, *norm1_w, *norm2_w, *w_in, *q_norm_w, *k_norm_w, *cmp_pos, *cmp_w1, *cmp_b1, *cmp_w2,
        *attn_out_norm_w, *hgrn_lb, *rec_out_norm_w, *w_out, *router_w, *router_bias, *exp_wg, *exp_wu, *exp_wd, *sh_wg, *sh_wu, *sh_wd;
    float* out;
    unsigned char* ws;
};

__device__ __forceinline__ unsigned cvtpk(float lo, float hi) { unsigned r; asm("v_cvt_pk_bf16_f32 %0, %1, %2" : "=v"(r) : "v"(lo), "v"(hi)); return r; }
__device__ __forceinline__ int opaque_tid() { int t = threadIdx.x; asm volatile("" : "+v"(t)); return t; }
__device__ __forceinline__ float bf2f(bf16_t v) { return __uint_as_float(((unsigned)v) << 16); }
__device__ __forceinline__ float sigmoidf_(float v) { return 1.0f / (1.0f + __expf(-v)); }
__device__ __forceinline__ float siluf_(float v) { return v / (1.0f + __expf(-v)); }
__device__ __forceinline__ float wave_sum(float v) {
#pragma unroll
    for (int o = 1; o < 64; o <<= 1) v += __shfl_xor(v, o);
    return v;
}
__device__ __forceinline__ s16x4 lds_tr(const LAS unsigned char* p) {
    return __builtin_bit_cast(s16x4, __builtin_amdgcn_ds_read_tr16_b64_v4i16((LAS s16x4*)p));
}

template <int WM, int WN> struct GemmT {
    static constexpr int BM = 64 * WM, BN = 64 * WN;
    static constexpr int A_BYTES = BM * 128, B_BYTES = 64 * BN * 2, STAGE = A_BYTES + B_BYTES, LDS_BYTES = 2 * STAGE;
    static constexpr int NB4 = BN / 32;
    static constexpr int B_ROW4 = BN / 4;

    static __device__ __forceinline__ void run(f32x4 (&acc)[4][4], const bf16_t* const (&arow)[WM], int a_kstride, const float* Bp, int ldb, int KT, LAS unsigned char* lds) {
        const int tid = opaque_tid(), lane = tid & 63, wid = tid >> 6, wm = wid / WN, wn = wid % WN, fr = lane & 15, fq = lane >> 4;
#pragma unroll
        for (int mi = 0; mi < 4; ++mi)
#pragma unroll
            for (int ni = 0; ni < 4; ++ni) acc[mi][ni] = (f32x4){0.f, 0.f, 0.f, 0.f};
        const int achunk = tid & 7;
        u32x4 areg[WM]; f32x4 breg[NB4];
        int a_wr[WM];
#pragma unroll
        for (int p = 0; p < WM; ++p) { const int row = p * 64 + (tid >> 3); a_wr[p] = row * 128 + ((achunk ^ ((row >> 1) & 7)) << 4); }
        int b_wr[NB4]; int b_goff[NB4];
#pragma unroll
        for (int p = 0; p < NB4; ++p) { const int i = tid + NTHREADS * p, k = i / B_ROW4, n = (i % B_ROW4) * 4;
            const int f = (k & 3) | (((k >> 3) & 1) << 2);
            b_wr[p] = A_BYTES + k * (BN * 2) + (((n >> 4) ^ f) << 5) + ((n & 15) << 1); b_goff[p] = k * ldb + n; }
        int a_rd[4][2];
#pragma unroll
        for (int mi = 0; mi < 4; ++mi)
#pragma unroll
            for (int ks = 0; ks < 2; ++ks) { const int row = wm * 64 + mi * 16 + fr, ch = ks * 4 + fq; a_rd[mi][ks] = row * 128 + ((ch ^ ((row >> 1) & 7)) << 4); }
        int b_rd[2][2];
        int b_f[2][2];
#pragma unroll
        for (int ks = 0; ks < 2; ++ks)
#pragma unroll
            for (int t = 0; t < 2; ++t) { const int k = ks * 32 + 8 * fq + 4 * t + (fr >> 2); b_f[ks][t] = (k & 3) | (((k >> 3) & 1) << 2);
                b_rd[ks][t] = A_BYTES + k * (BN * 2) + ((fr & 3) << 3); }

        auto gload = [&](int kt) {
#pragma unroll
            for (int p = 0; p < WM; ++p) areg[p] = *(const u32x4*)(arow[p] + (size_t)kt * a_kstride + achunk * 8);
            const float* bk = Bp + (size_t)kt * 64 * ldb;
#pragma unroll
            for (int p = 0; p < NB4; ++p) breg[p] = *(const f32x4*)(bk + b_goff[p]);
        };
        auto lstore = [&](int buf) {
            LAS unsigned char* base = lds + buf * STAGE;
#pragma unroll
            for (int p = 0; p < WM; ++p) *(LAS u32x4*)(base + a_wr[p]) = areg[p];
#pragma unroll
            for (int p = 0; p < NB4; ++p) { u32x2 w; w.x = cvtpk(breg[p].x, breg[p].y); w.y = cvtpk(breg[p].z, breg[p].w); *(LAS u32x2*)(base + b_wr[p]) = w; }
        };
        gload(0); lstore(0); __syncthreads();
        for (int kt = 0; kt < KT; ++kt) {
            if (kt + 1 < KT) gload(kt + 1);
            const LAS unsigned char* base = lds + (kt & 1) * STAGE;
#pragma unroll
            for (int ks = 0; ks < 2; ++ks) {
                bf16x8 af[4], bfr[4];
#pragma unroll
                for (int mi = 0; mi < 4; ++mi) af[mi] = *(const LAS bf16x8*)(base + a_rd[mi][ks]);
#pragma unroll
                for (int ni = 0; ni < 4; ++ni) {
                    const int u0 = wn * 4 + ni;
                    const s16x4 lo = lds_tr(base + b_rd[ks][0] + ((u0 ^ b_f[ks][0]) << 5));
                    const s16x4 hi = lds_tr(base + b_rd[ks][1] + ((u0 ^ b_f[ks][1]) << 5));
                    bfr[ni] = (bf16x8){lo[0], lo[1], lo[2], lo[3], hi[0], hi[1], hi[2], hi[3]};
                }
#pragma unroll
                for (int mi = 0; mi < 4; ++mi)
#pragma unroll
                    for (int ni = 0; ni < 4; ++ni) acc[mi][ni] = __builtin_amdgcn_mfma_f32_16x16x32_bf16(bfr[ni], af[mi], acc[mi][ni], 0, 0, 0);
            }
            if (kt + 1 < KT) lstore((kt + 1) & 1);
            __syncthreads();
        }
    }
};

__device__ __forceinline__ void phase_mod(const Params& P, LAS unsigned char* lds) {
    const int tid = threadIdx.x;
    float* mod = (float*)(P.ws + WS_MOD);
    LAS float* sc = (LAS float*)lds;
    LAS float* red = (LAS float*)(lds + 16384);
    for (int i = tid; i < 4096; i += NTHREADS) sc[i] = siluf_(P.c[i]);
    __syncthreads();
    const int kq = tid >> 5, cl = tid & 31;
    for (int u = blockIdx.x; u < 192; u += gridDim.x) {
        const int j = u * 32 + cl;
        float a0 = 0.f, a1 = 0.f, a2 = 0.f, a3 = 0.f;
#pragma unroll 8
        for (int k = kq; k < 1024; k += 16) { const float w = P.ada_w[(size_t)k * 6144 + j];
            a0 += sc[k] * w; a1 += sc[1024 + k] * w; a2 += sc[2048 + k] * w; a3 += sc[3072 + k] * w; }
        red[(kq * 4 + 0) * 32 + cl] = a0; red[(kq * 4 + 1) * 32 + cl] = a1; red[(kq * 4 + 2) * 32 + cl] = a2; red[(kq * 4 + 3) * 32 + cl] = a3;
        __syncthreads();
        if (tid < 128) { const int b = tid >> 5; float s = 0.f;
#pragma unroll
            for (int q = 0; q < 16; ++q) s += red[(q * 4 + b) * 32 + cl];
            mod[b * 6144 + j] = s + P.ada_b[j]; }
        __syncthreads();
    }
    for (int u = blockIdx.x; u < 16; u += gridDim.x) {
        const int sel = u >> 3, j = (u & 7) * 32 + cl;
        const float* w1 = P.cmp_w1 + (size_t)sel * 2048 * 256; const float* pos = P.cmp_pos + sel * 2048;
        float a0 = 0.f;
#pragma unroll 8
        for (int k = kq; k < 2048; k += 16) a0 += pos[k] * w1[(size_t)k * 256 + j];
        red[kq * 32 + cl] = a0;
        __syncthreads();
        if (tid < 32) { float s = 0.f;
#pragma unroll
            for (int q = 0; q < 16; ++q) s += red[q * 32 + cl];
            ((float*)(P.ws + WS_CB))[sel * 256 + j] = s + P.cmp_b1[sel * 256 + j]; }
        __syncthreads();
    }
    if (blockIdx.x == gridDim.x - 2) {
        for (int i = tid; i < 2 * 8 * 64; i += NTHREADS) { const int t2 = i >> 9, bg = (i >> 6) & 7, d = i & 63;
            ((bf16_t*)(P.ws + (t2 ? WS_VC : WS_KC)))[((size_t)bg * 512 + 511) * 64 + d] = 0; }
    }
    if (blockIdx.x == gridDim.x - 1) {
        float* lb = (float*)(P.ws + WS_LB);
        for (int i = tid; i < 512; i += NTHREADS) { const float p0 = P.hgrn_lb[i], p1 = P.hgrn_lb[512 + i]; lb[i] = 1.0f / (1.0f + __expf(p1 - p0)); }
    }
}

__device__ __forceinline__ void norm_mod_rows(const float* x, const float* w, const float* mod_sh, const float* mod_sc, bf16_t* h) {
    const int lane = threadIdx.x & 63, gw = blockIdx.x * (NTHREADS / 64) + (threadIdx.x >> 6), NGW = gridDim.x * (NTHREADS / 64);
    for (int m = gw; m < T; m += NGW) {
        const int b = m / SEQ;
        const f32x4* xr = (const f32x4*)(x + (size_t)m * D) + lane;
        f32x4 v[4]; float s = 0.f;
#pragma unroll
        for (int j = 0; j < 4; ++j) { v[j] = xr[64 * j]; s += (v[j].x * v[j].x + v[j].y * v[j].y) + (v[j].z * v[j].z + v[j].w * v[j].w); }
        const float rstd = rsqrtf(wave_sum(s) * (1.f / D) + RMS_EPS);
        u32x2* o = (u32x2*)(h + (size_t)m * D) + lane;
#pragma unroll
        for (int j = 0; j < 4; ++j) {
            const int col = (lane + 64 * j) * 4;
            const f32x4 wv = *(const f32x4*)(w + col), scv = *(const f32x4*)(mod_sc + b * 6144 + col), shv = *(const f32x4*)(mod_sh + b * 6144 + col);
            f32x4 r;
            r.x = v[j].x * rstd * wv.x * (1.f + scv.x) + shv.x; r.y = v[j].y * rstd * wv.y * (1.f + scv.y) + shv.y;
            r.z = v[j].z * rstd * wv.z * (1.f + scv.z) + shv.z; r.w = v[j].w * rstd * wv.w * (1.f + scv.w) + shv.w;
            u32x2 pk; pk.x = cvtpk(r.x, r.y); pk.y = cvtpk(r.z, r.w); o[64 * j] = pk;
        }
    }
}

__device__ __forceinline__ void phase_inproj(const Params& P, LAS unsigned char* lds) {
    typedef GemmT<4, 2> G;
    const int tid = opaque_tid(), lane = tid & 63, wid = tid >> 6, wm = wid >> 1, wn = wid & 1, fr = lane & 15, fq = lane >> 4;
    const bf16_t* h1 = (const bf16_t*)(P.ws + WS_H);
    bf16_t* qo = (bf16_t*)(P.ws + WS_Q); bf16_t* kvo = (bf16_t*)(P.ws + WS_KV); float* gates = (float*)(P.ws + WS_GATES);
    bf16_t* hq = (bf16_t*)(P.ws + WS_HQ); float* logf = (float*)(P.ws + WS_LOGF); bf16_t* hv = (bf16_t*)(P.ws + WS_HV); bf16_t* hg = (bf16_t*)(P.ws + WS_HG);
    const float* lb = (const float*)(P.ws + WS_LB);
    constexpr int NRT = T / 256, NCT = 27;
    for (int u = blockIdx.x; u < NRT * NCT; u += gridDim.x) {
        const int ct = u / NRT, rt = u % NRT;
        const int col0 = ct < 10 ? ct * 128 : (ct == 10 ? 1280 : 1304 + (ct - 11) * 128);
        const bf16_t* arow[4];
#pragma unroll
        for (int p = 0; p < 4; ++p) arow[p] = h1 + (size_t)(rt * 256 + p * 64 + (tid >> 3)) * D;
        f32x4 acc[4][4];
        G::run(acc, arow, 64, P.w_in + col0, IN_COLS, D / 64, lds);
        const int row0 = rt * 256 + wm * 64 + fr;
        const int cw = wn * 64 + 4 * fq;
        if (ct < 10) {
            const bool is_q = ct < 4; const int seg = ct - 4;
            const bool do_norm = is_q || seg == 2 || seg == 4;
            const float* nw = is_q ? P.q_norm_w : (P.k_norm_w + (seg == 2 ? 64 : 128));
            const float osc = is_q ? 0.125f : 1.0f;
            f32x4 wv[4];
#pragma unroll
            for (int ni = 0; ni < 4; ++ni) wv[ni] = do_norm ? *(const f32x4*)(nw + ni * 16 + 4 * fq) : (f32x4){1.f, 1.f, 1.f, 1.f};
#pragma unroll
            for (int mi = 0; mi < 4; ++mi) {
                float rstd = 1.f;
                if (do_norm) { float s = 0.f;
#pragma unroll
                    for (int ni = 0; ni < 4; ++ni) { const f32x4 a = acc[mi][ni]; s += (a.x * a.x + a.y * a.y) + (a.z * a.z + a.w * a.w); }
                    s += __shfl_xor(s, 16); s += __shfl_xor(s, 32);
                    rstd = rsqrtf(s * (1.f / 64.f) + RMS_EPS) * osc; }
                const size_t m = (size_t)(row0 + mi * 16);
                bf16_t* dst = is_q ? (qo + m * 512 + ct * 128 + cw) : (kvo + m * 768 + seg * 128 + cw);
#pragma unroll
                for (int ni = 0; ni < 4; ++ni) { const f32x4 a = acc[mi][ni]; u32x2 pk;
                    pk.x = cvtpk(a.x * rstd * wv[ni].x, a.y * rstd * wv[ni].y); pk.y = cvtpk(a.z * rstd * wv[ni].z, a.w * rstd * wv[ni].w);
                    *(u32x2*)(dst + ni * 16) = pk; }
            }
        } else if (ct == 10) {
            if (wn == 0) {
#pragma unroll
                for (int mi = 0; mi < 4; ++mi) { const size_t m = (size_t)(row0 + mi * 16);
#pragma unroll
                    for (int ni = 0; ni < 2; ++ni) { const int c = ni * 16 + 4 * fq; if (c < 24) { const f32x4 a = acc[mi][ni];
                            *(f32x4*)(gates + m * 24 + c) = (f32x4){sigmoidf_(a.x), sigmoidf_(a.y), sigmoidf_(a.z), sigmoidf_(a.w)}; } } }
            }
        } else {
            const int hs = (ct - 11) >> 2, cc = ((ct - 11) & 3) * 128 + cw;
#pragma unroll
            for (int mi = 0; mi < 4; ++mi) { const size_t m = (size_t)(row0 + mi * 16);
#pragma unroll
                for (int ni = 0; ni < 4; ++ni) { const f32x4 a = acc[mi][ni]; const int c = cc + ni * 16;
                    if (hs == 0) { const float s = 0.08838834764831845f; u32x2 pk; pk.x = cvtpk(siluf_(a.x) * s, siluf_(a.y) * s); pk.y = cvtpk(siluf_(a.z) * s, siluf_(a.w) * s); *(u32x2*)(hq + m * 512 + c) = pk; }
                    else if (hs == 1) { const f32x4 l = *(const f32x4*)(lb + c); f32x4 o;
                        o.x = __logf(l.x + (1.f - l.x) * sigmoidf_(a.x)); o.y = __logf(l.y + (1.f - l.y) * sigmoidf_(a.y));
                        o.z = __logf(l.z + (1.f - l.z) * sigmoidf_(a.z)); o.w = __logf(l.w + (1.f - l.w) * sigmoidf_(a.w)); *(f32x4*)(logf + m * 512 + c) = o; }
                    else if (hs == 2) { u32x2 pk; pk.x = cvtpk(a.x, a.y); pk.y = cvtpk(a.z, a.w); *(u32x2*)(hv + m * 512 + c) = pk; }
                    else { u32x2 pk; pk.x = cvtpk(sigmoidf_(a.x), sigmoidf_(a.y)); pk.y = cvtpk(sigmoidf_(a.z), sigmoidf_(a.w)); *(u32x2*)(hg + m * 512 + c) = pk; }
                } }
        }
    }
}


__device__ __forceinline__ float gelu_tanh(float x) {
    const float u = 0.7978845608028654f * (x + 0.044715f * x * x * x);
    const float th = 1.0f - 2.0f / (1.0f + __expf(2.0f * u));
    return 0.5f * x * (1.0f + th);
}
__device__ __forceinline__ void compress_unit(const Params& P, LAS unsigned char* lds, int u) {
    typedef GemmT<2, 4> G;
    const int tid = opaque_tid(), lane = tid & 63, wid = tid >> 6, wm = wid >> 2, wn = wid & 3, fr = lane & 15, fq = lane >> 4;
    const int sel = u >> 5, rt = u & 31;
    const bf16_t* kv = (const bf16_t*)(P.ws + WS_KV);
    bf16_t* cmph = (bf16_t*)(P.ws + WS_CMPH) + (size_t)sel * 4096 * 256;
    const float* cb = (const float*)(P.ws + WS_CB) + sel * 256;
    const bf16_t* arow[2];
#pragma unroll
    for (int p = 0; p < 2; ++p) { int r = rt * 128 + p * 64 + (tid >> 3); r = r < 4088 ? r : 4087;
        const int b = r / 1022, rem = r % 1022, i = rem >> 1, g = rem & 1;
        arow[p] = kv + (size_t)(b * SEQ + 16 * i) * 768 + sel * 128 + g * 64; }
    f32x4 acc[4][4];
    G::run(acc, arow, 768, P.cmp_w1 + (size_t)sel * 2048 * 256, 256, 32, lds);
#pragma unroll
    for (int mi = 0; mi < 4; ++mi) { const size_t row = (size_t)(rt * 128 + wm * 64 + mi * 16 + fr);
#pragma unroll
        for (int ni = 0; ni < 4; ++ni) { const int col = wn * 64 + ni * 16 + 4 * fq; const f32x4 a = acc[mi][ni]; const f32x4 bb = *(const f32x4*)(cb + col);
            u32x2 pk; pk.x = cvtpk(gelu_tanh(a.x + bb.x), gelu_tanh(a.y + bb.y)); pk.y = cvtpk(gelu_tanh(a.z + bb.z), gelu_tanh(a.w + bb.w));
            *(u32x2*)(cmph + row * 256 + col) = pk; } }
    __syncthreads();
    {
        const int row = tid >> 2, cq = tid & 3;
        const bf16_t* hr = cmph + (size_t)(rt * 128 + row) * 256;
        const float* w2 = P.cmp_w2 + (size_t)sel * 256 * 64 + cq * 16;
        float o[16];
#pragma unroll
        for (int j = 0; j < 16; ++j) o[j] = 0.f;
        for (int k8 = 0; k8 < 256; k8 += 8) {
            const u32x4 hv = *(const u32x4*)(hr + k8);
#pragma unroll
            for (int kk = 0; kk < 8; ++kk) {
                const unsigned wd = hv[kk >> 1]; const float a = (kk & 1) ? __uint_as_float(wd & 0xffff0000u) : __uint_as_float(wd << 16);
                const float* wr = w2 + (size_t)(k8 + kk) * 64;
#pragma unroll
                for (int j4 = 0; j4 < 4; ++j4) { const f32x4 w = *(const f32x4*)(wr + j4 * 4);
                    o[j4 * 4 + 0] += a * w.x; o[j4 * 4 + 1] += a * w.y; o[j4 * 4 + 2] += a * w.z; o[j4 * 4 + 3] += a * w.w; }
            }
        }
        if (sel == 0) { float s = 0.f;
#pragma unroll
            for (int j = 0; j < 16; ++j) s += o[j] * o[j];
            s += __shfl_xor(s, 1); s += __shfl_xor(s, 2);
            const float rstd = rsqrtf(s * (1.f / 64.f) + RMS_EPS);
#pragma unroll
            for (int j = 0; j < 16; ++j) o[j] *= rstd * P.k_norm_w[cq * 16 + j]; }
        const int r = rt * 128 + row;
        if (r < 4088) { const int b = r / 1022, rem = r % 1022, i = rem >> 1, g = rem & 1;
            bf16_t* dst = (bf16_t*)(P.ws + (sel ? WS_VC : WS_KC)) + ((size_t)(b * 2 + g) * 512 + i) * 64 + cq * 16;
            u32x4 w0, w1;
            w0.x = cvtpk(o[0], o[1]); w0.y = cvtpk(o[2], o[3]); w0.z = cvtpk(o[4], o[5]); w0.w = cvtpk(o[6], o[7]);
            w1.x = cvtpk(o[8], o[9]); w1.y = cvtpk(o[10], o[11]); w1.z = cvtpk(o[12], o[13]); w1.w = cvtpk(o[14], o[15]);
            *(u32x4*)dst = w0; *(u32x4*)(dst + 8) = w1; }
    }
    __syncthreads();
}

__device__ __forceinline__ int off_row128(int row, int ch) { return row * 128 + ((ch ^ ((row >> 1) & 7)) << 4); }
__device__ __forceinline__ int off_row256(int row, int ch) { return row * 256 + ((ch ^ (row & 15)) << 4); }
__device__ __forceinline__ int fk_(int r) { return (r & 3) | (((r >> 3) & 1) << 2); }
__device__ __forceinline__ int off_tr256(int row, int col) { return row * 256 + ((((col >> 4) ^ fk_(row)) << 5) + ((col & 15) << 1)); }
constexpr int HL_QT = 0, HL_KT = 16384, HL_KH = 32768, HL_V = 49152, HL_SB = 65536, HL_P = 98304  , HL_TOT = 106496  , HL_RED = 110592  , HL_END = 111104;

template <int MODE> __device__ __forceinline__ void hgrn_unit(const Params& P, LAS unsigned char* lds, int u) {
    const int tid = opaque_tid(), lane = tid & 63, wid = tid >> 6, fr = lane & 15, fq = lane >> 4;
    const int b = u >> 7, h = (u >> 5) & 3, sc = u & 31;
    const bf16_t* hq = (const bf16_t*)(P.ws + WS_HQ); const float* logf = (const float*)(P.ws + WS_LOGF);
    const bf16_t* hv = (const bf16_t*)(P.ws + WS_HV); const bf16_t* hg = (const bf16_t*)(P.ws + WS_HG);
    float* HLs = (float*)(P.ws + WS_HL); float* HDs = (float*)(P.ws + WS_HD);
    bf16_t* mix = (bf16_t*)(P.ws + WS_MIX);
    LAS float* tot = (LAS float*)(lds + HL_TOT); LAS float* red = (LAS float*)(lds + HL_RED);
    f32x4 st[8];
#pragma unroll
    for (int vt = 0; vt < 8; ++vt) st[vt] = (f32x4){0.f, 0.f, 0.f, 0.f};
    if (MODE == 1) {
        const int kk = 16 * wid + fr;
        for (int j = 0; j < sc; ++j) {
            const float* Lj = HLs + (size_t)(u - sc + j) * 16384 + kk * 128 + 4 * fq; const float dj = HDs[(size_t)(u - sc + j) * 128 + kk];
#pragma unroll
            for (int vt = 0; vt < 8; ++vt) { const f32x4 l = *(const f32x4*)(Lj + vt * 16); st[vt] = st[vt] * dj + l; }
        }
    }
    float dsum = 0.f;
    const int kp = tid & 63, te = tid >> 6;
    for (int c = 0; c < 4; ++c) {
        const size_t tok0 = (size_t)b * SEQ + sc * 256 + c * 64;
        float lf0[8], lf1[8], cs0[8], cs1[8];
        { float a0 = 0.f, a1 = 0.f;
#pragma unroll
          for (int i = 0; i < 8; ++i) { const float2 v = *(const float2*)(logf + (tok0 + te * 8 + i) * 512 + h * 128 + 2 * kp); lf0[i] = v.x; lf1[i] = v.y; a0 += v.x; a1 += v.y; cs0[i] = a0; cs1[i] = a1; }
          tot[te * 128 + 2 * kp] = a0; tot[te * 128 + 2 * kp + 1] = a1; }
#pragma unroll
        for (int i = 0; i < 2; ++i) { const int pc = tid + NTHREADS * i, row = pc >> 4, c8 = (pc & 15) * 8;
            const u32x4 v = *(const u32x4*)(hv + (tok0 + row) * 512 + h * 128 + c8);
            *(LAS u32x4*)(lds + HL_V + off_tr256(row, c8)) = v; }
        if (MODE == 1 ) {
#pragma unroll
            for (int vt = 0; vt < 8; ++vt) { u32x2 pk; pk.x = cvtpk(st[vt].x, st[vt].y); pk.y = cvtpk(st[vt].z, st[vt].w);
                *(LAS u32x2*)(lds + HL_SB + off_tr256(16 * wid + fr, 16 * vt + 4 * fq)) = pk; }
        }
        __syncthreads();
        float pre0 = 0.f, pre1 = 0.f, last0 = 0.f, last1 = 0.f;
#pragma unroll
        for (int e = 0; e < 8; ++e) { const float t0 = tot[e * 128 + 2 * kp], t1 = tot[e * 128 + 2 * kp + 1]; if (e < te) { pre0 += t0; pre1 += t1; } last0 += t0; last1 += t1; }
#pragma unroll
        for (int i = 0; i < 8; ++i) {
            const int t = te * 8 + i;
            const float c0 = cs0[i] + pre0, c1 = cs1[i] + pre1;
            const float k0 = 1.f - __expf(lf0[i]), k1 = 1.f - __expf(lf1[i]);
            const unsigned khat = cvtpk(k0 * __expf(last0 - c0), k1 * __expf(last1 - c1));
            *(LAS unsigned*)(lds + HL_KH + off_tr256(t, 2 * kp)) = khat;
            if (MODE == 1) {
                const unsigned qraw = *(const unsigned*)(hq + (tok0 + t) * 512 + h * 128 + 2 * kp);
                const float q0 = __uint_as_float(qraw << 16), q1 = __uint_as_float(qraw & 0xffff0000u);
                const unsigned qt = cvtpk(q0 * __expf(c0), q1 * __expf(c1));
                const unsigned kt = cvtpk(k0 * __expf(fminf(-c0, 80.f)), k1 * __expf(fminf(-c1, 80.f)));
                const int o = off_row256(t, kp >> 2) + ((kp & 3) << 2);
                *(LAS unsigned*)(lds + HL_QT + o) = qt; *(LAS unsigned*)(lds + HL_KT + o) = kt;
            }
        }
        const float dec = __expf(tot[0 * 128 + 16 * wid + fr] + tot[1 * 128 + 16 * wid + fr] + tot[2 * 128 + 16 * wid + fr] + tot[3 * 128 + 16 * wid + fr]
                                 + tot[4 * 128 + 16 * wid + fr] + tot[5 * 128 + 16 * wid + fr] + tot[6 * 128 + 16 * wid + fr] + tot[7 * 128 + 16 * wid + fr]);
        if (MODE == 0 && tid < 128) { float s = 0.f;
#pragma unroll
            for (int e = 0; e < 8; ++e) s += tot[e * 128 + tid];
            dsum += s; }
        __syncthreads();
        f32x4 oacc[4];
        if (MODE == 1) {
            { const int tt = wid & 3;
#pragma unroll
              for (int si = 0; si < 2; ++si) { const int stl = 2 * (wid >> 2) + si;
                  f32x4 sacc = (f32x4){0.f, 0.f, 0.f, 0.f};
                  if (stl <= tt) {
#pragma unroll
                      for (int ks = 0; ks < 4; ++ks) {
                          const bf16x8 a = *(const LAS bf16x8*)(lds + HL_KT + off_row256(stl * 16 + fr, ks * 4 + fq));
                          const bf16x8 bq = *(const LAS bf16x8*)(lds + HL_QT + off_row256(tt * 16 + fr, ks * 4 + fq));
                          sacc = __builtin_amdgcn_mfma_f32_16x16x32_bf16(a, bq, sacc, 0, 0, 0);
                      }
                  }
                  const int t = tt * 16 + fr, s0 = stl * 16 + 4 * fq;
                  u32x2 pk; pk.x = cvtpk(s0 + 0 <= t ? sacc.x : 0.f, s0 + 1 <= t ? sacc.y : 0.f); pk.y = cvtpk(s0 + 2 <= t ? sacc.z : 0.f, s0 + 3 <= t ? sacc.w : 0.f);
                  *(LAS u32x2*)(lds + HL_P + off_row128(t, s0 >> 3) + ((s0 & 7) << 1)) = pk; }
            }
            __syncthreads();
            { const int tt = wid >> 1;
#pragma unroll
              for (int i = 0; i < 4; ++i) { const int vt = 4 * (wid & 1) + i;
                  f32x4 a = (f32x4){0.f, 0.f, 0.f, 0.f};
#pragma unroll
                  for (int ks = 0; ks < 2; ++ks) {
                      const int kr = ks * 32 + 8 * fq + (fr >> 2);
                      const s16x4 lo = lds_tr(lds + HL_V + off_tr256(kr, vt * 16 + 4 * (fr & 3))), hi = lds_tr(lds + HL_V + off_tr256(kr + 4, vt * 16 + 4 * (fr & 3)));
                      const bf16x8 va = (bf16x8){lo[0], lo[1], lo[2], lo[3], hi[0], hi[1], hi[2], hi[3]};
                      const bf16x8 pb = *(const LAS bf16x8*)(lds + HL_P + off_row128(tt * 16 + fr, ks * 4 + fq));
                      a = __builtin_amdgcn_mfma_f32_16x16x32_bf16(va, pb, a, 0, 0, 0);
                  }
#pragma unroll
                  for (int ks = 0; ks < 4; ++ks) {
                      const int kr = ks * 32 + 8 * fq + (fr >> 2);
                      const s16x4 lo = lds_tr(lds + HL_SB + off_tr256(kr, vt * 16 + 4 * (fr & 3))), hi = lds_tr(lds + HL_SB + off_tr256(kr + 4, vt * 16 + 4 * (fr & 3)));
                      const bf16x8 sa = (bf16x8){lo[0], lo[1], lo[2], lo[3], hi[0], hi[1], hi[2], hi[3]};
                      const bf16x8 qb = *(const LAS bf16x8*)(lds + HL_QT + off_row256(tt * 16 + fr, ks * 4 + fq));
                      a = __builtin_amdgcn_mfma_f32_16x16x32_bf16(sa, qb, a, 0, 0, 0);
                  }
                  const u32x2 gr = *(const u32x2*)(hg + (tok0 + tt * 16 + fr) * 512 + h * 128 + vt * 16 + 4 * fq);
                  a.x *= __uint_as_float(gr.x << 16); a.y *= __uint_as_float(gr.x & 0xffff0000u); a.z *= __uint_as_float(gr.y << 16); a.w *= __uint_as_float(gr.y & 0xffff0000u);
                  oacc[i] = a; }
              float ss = 0.f;
#pragma unroll
              for (int i = 0; i < 4; ++i) ss += (oacc[i].x * oacc[i].x + oacc[i].y * oacc[i].y) + (oacc[i].z * oacc[i].z + oacc[i].w * oacc[i].w);
              ss += __shfl_xor(ss, 16); ss += __shfl_xor(ss, 32);
              if (fq == 0) red[(tt * 2 + (wid & 1)) * 16 + fr] = ss; }
        }
#pragma unroll
        for (int vt = 0; vt < 8; ++vt) {
            f32x4 a = st[vt] * dec;
#pragma unroll
            for (int ks = 0; ks < 2; ++ks) {
                const int kr = ks * 32 + 8 * fq + (fr >> 2);
                const s16x4 lo = lds_tr(lds + HL_V + off_tr256(kr, vt * 16 + 4 * (fr & 3))), hi = lds_tr(lds + HL_V + off_tr256(kr + 4, vt * 16 + 4 * (fr & 3)));
                const bf16x8 va = (bf16x8){lo[0], lo[1], lo[2], lo[3], hi[0], hi[1], hi[2], hi[3]};
                const s16x4 lo2 = lds_tr(lds + HL_KH + off_tr256(kr, wid * 16 + 4 * (fr & 3))), hi2 = lds_tr(lds + HL_KH + off_tr256(kr + 4, wid * 16 + 4 * (fr & 3)));
                const bf16x8 kb = (bf16x8){lo2[0], lo2[1], lo2[2], lo2[3], hi2[0], hi2[1], hi2[2], hi2[3]};
                a = __builtin_amdgcn_mfma_f32_16x16x32_bf16(va, kb, a, 0, 0, 0);
            }
            st[vt] = a;
        }
        __syncthreads();
        if (MODE == 1) {
            const int tt = wid >> 1; const float ssum = red[(tt * 2) * 16 + fr] + red[(tt * 2 + 1) * 16 + fr];
            const float rstd = rsqrtf(ssum * (1.f / 128.f) + RMS_EPS);
#pragma unroll
            for (int i = 0; i < 4; ++i) { const int v = (4 * (wid & 1) + i) * 16 + 4 * fq; const f32x4 w = *(const f32x4*)(P.rec_out_norm_w + h * 128 + v);
                u32x2 pk; pk.x = cvtpk(oacc[i].x * rstd * w.x, oacc[i].y * rstd * w.y); pk.y = cvtpk(oacc[i].z * rstd * w.z, oacc[i].w * rstd * w.w);
                *(u32x2*)(mix + (tok0 + tt * 16 + fr) * 1024 + 512 + h * 128 + v) = pk; }
        }
    }
    if (MODE == 0) {
#pragma unroll
        for (int vt = 0; vt < 8; ++vt) *(f32x4*)(HLs + (size_t)u * 16384 + (16 * wid + fr) * 128 + vt * 16 + 4 * fq) = st[vt];
        if (tid < 128) HDs[(size_t)u * 128 + tid] = __expf(dsum);
    }
    __syncthreads();
}

__device__ __forceinline__ void phase_cmp_h1(const Params& P, LAS unsigned char* lds) {
    for (int u = blockIdx.x; u < 64 + 512; u += gridDim.x) {
        if (u < 64) compress_unit(P, lds, u); else hgrn_unit<0>(P, lds, u - 64);
    }
}


constexpr int NL_K = 0, NL_V = 16384, NL_IMP = 32768, NL_IMP_STRIDE = 132, NL_SELM = NL_IMP + 8 * 8 * NL_IMP_STRIDE * 4, NL_END = NL_SELM + 1024;
__device__ __forceinline__ int off_v128(int row, int ch) { return row * 128 + ((ch ^ ((row & 3) << 1)) << 4); }
#define MFMA32(a, b, c) __builtin_amdgcn_mfma_f32_32x32x16_bf16(a, b, c, 0, 0, 0)

struct NsaLane { int t; float sl2; int qi; unsigned long long mlo, mhi; };

template <int MODE> __device__ __forceinline__ void nsa_pass(LAS unsigned char* lds, const bf16_t* Kg, const bf16_t* Vg, int rs, unsigned long long ulo, unsigned long long uhi,
                                                            const bf16x8 (&qf)[4], const NsaLane& L, float inv, float& lsum, f32x16 (&O)[2], LAS float* impw) {
    const int tid = opaque_tid(), lane = tid & 63, hi = lane >> 5, c = lane & 31;
    const int ld_row = tid >> 3, ld_ch = tid & 7;
    const int kw_off = off_row128(ld_row, ld_ch), vw_off = off_v128(ld_row, ld_ch);
    u32x4 kreg, vreg;
    int j = -1;
    auto next = [&](int jj) -> int { ++jj; if (jj < 64) { const unsigned long long m = ulo >> jj; if (m) return jj + __builtin_ctzll(m); jj = 64; }
                                     if (jj < 128) { const unsigned long long m = uhi >> (jj - 64); if (m) return jj + __builtin_ctzll(m); } return 128; };
    auto gld = [&](int jj) { kreg = *(const u32x4*)(Kg + (size_t)(jj * 64 + ld_row) * rs + ld_ch * 8); if (MODE != 0) vreg = *(const u32x4*)(Vg + (size_t)(jj * 64 + ld_row) * rs + ld_ch * 8); };
    j = next(j);
    if (j < 128) gld(j);
    int it = 0;
    while (j < 128) {
        LAS unsigned char* kb = lds + NL_K + (it & 1) * 8192; LAS unsigned char* vb = lds + NL_V + (it & 1) * 8192;
        *(LAS u32x4*)(kb + kw_off) = kreg; if (MODE != 0) *(LAS u32x4*)(vb + vw_off) = vreg;
        const int jn = next(j);
        if (jn < 128) gld(jn);
        __syncthreads();
        bool need = true; bool selbit = true;
        if (MODE == 2) { selbit = (j < 64 ? (L.mlo >> j) : (L.mhi >> (j - 64))) & 1ull; need = __any(selbit); }
        if (need) {
            f32x16 p0 = {}, p1 = {};
#pragma unroll
            for (int ks = 0; ks < 4; ++ks) {
                const bf16x8 a0 = *(const LAS bf16x8*)(kb + off_row128(c, 2 * ks + hi)), a1 = *(const LAS bf16x8*)(kb + off_row128(32 + c, 2 * ks + hi));
                p0 = MFMA32(a0, qf[ks], p0); p1 = MFMA32(a1, qf[ks], p1);
            }
            const int stride = (MODE <= 1) ? 16 : 1;
            const int dl = (MODE <= 1) ? (L.t - 31 - 16 * (j * 64 + 4 * hi)) : (L.t - (j * 64 + 4 * hi));
            const float nb = -L.sl2 * (float)dl, sls = L.sl2 * (float)stride;
            float rs_ = 0.f;
#pragma unroll
            for (int r = 0; r < 16; ++r) {
                const int ro0 = (r & 3) + 8 * (r >> 2), ro1 = ro0 + 32;
                const int d0 = dl - stride * ro0, d1 = dl - stride * ro1;
                bool v0 = d0 >= 0, v1 = d1 >= 0;
                if (MODE == 3) { v0 = v0 && d0 < 512; v1 = v1 && d1 < 512; }
                if (MODE == 2) { v0 = v0 && selbit; v1 = v1 && selbit; }
                float e0 = __builtin_amdgcn_exp2f(__builtin_fmaf(p0[r], LOG2E, __builtin_fmaf(sls, (float)ro0, nb)));
                float e1 = __builtin_amdgcn_exp2f(__builtin_fmaf(p1[r], LOG2E, __builtin_fmaf(sls, (float)ro1, nb)));
                e0 = v0 ? e0 : 0.f; e1 = v1 ? e1 : 0.f;
                if (MODE == 1) { e0 *= inv; e1 *= inv; }
                p0[r] = e0; p1[r] = e1; rs_ += e0 + e1;
            }
            lsum += rs_;
            if (MODE == 1) {
#pragma unroll
                for (int kt = 0; kt < 2; ++kt)
#pragma unroll
                    for (int i = 0; i < 4; ++i) {
                        float g = kt ? (p1[4 * i] + p1[4 * i + 1]) + (p1[4 * i + 2] + p1[4 * i + 3]) : (p0[4 * i] + p0[4 * i + 1]) + (p0[4 * i + 2] + p0[4 * i + 3]);
                        float l3 = kt ? p1[4 * i + 3] : p0[4 * i + 3];
                        g += __shfl_xor(g, 1); g += __shfl_xor(g, 2); l3 += __shfl_xor(l3, 1); l3 += __shfl_xor(l3, 2);
                        if ((c & 3) == 0) { const int jj = j * 16 + kt * 8 + 2 * i + hi; __hip_atomic_fetch_add(impw + L.qi * NL_IMP_STRIDE + jj, g, __ATOMIC_RELAXED, __HIP_MEMORY_SCOPE_WORKGROUP); __hip_atomic_fetch_add(impw + L.qi * NL_IMP_STRIDE + jj + 1, l3, __ATOMIC_RELAXED, __HIP_MEMORY_SCOPE_WORKGROUP); }
                    }
            }
            if (MODE != 0) {
                bf16x8 pf[4];
#pragma unroll
                for (int s4 = 0; s4 < 4; ++s4) { u32x4 w;
#pragma unroll
                    for (int e = 0; e < 4; ++e) { const int r = 8 * (s4 & 1) + 2 * e; w[e] = (s4 >> 1) ? cvtpk(p1[r], p1[r + 1]) : cvtpk(p0[r], p0[r + 1]); }
                    pf[s4] = __builtin_bit_cast(bf16x8, w); }
                const int g4 = lane >> 4, sub = g4 & 1, i16 = lane & 15, qq = i16 >> 2, pp = i16 & 3;
#pragma unroll
                for (int dt = 0; dt < 2; ++dt)
#pragma unroll
                    for (int s4 = 0; s4 < 4; ++s4) {
                        const int row = 16 * s4 + 4 * hi + qq, ch = 4 * dt + 2 * sub + (pp >> 1);
                        const s16x4 lo = lds_tr(vb + off_v128(row, ch) + 8 * (pp & 1)), hh = lds_tr(vb + off_v128(row + 8, ch) + 8 * (pp & 1));
                        const bf16x8 vf = (bf16x8){lo[0], lo[1], lo[2], lo[3], hh[0], hh[1], hh[2], hh[3]};
                        O[dt] = MFMA32(vf, pf[s4], O[dt]);
                    }
            }
        }
        j = jn; ++it;
    }
    __syncthreads();
}

__device__ __forceinline__ void nsa_unit(const Params& P, LAS unsigned char* lds, int u) {
    const int tid = opaque_tid(), lane = tid & 63, wid = tid >> 6, hi = lane >> 5, c = lane & 31;
    const int b = u >> 8, g = (u >> 7) & 1, qb = u & 127;
    const bf16_t* qg = (const bf16_t*)(P.ws + WS_Q); const bf16_t* kv = (const bf16_t*)(P.ws + WS_KV);
    const bf16_t* kcn = (const bf16_t*)(P.ws + WS_KC) + (size_t)(b * 2 + g) * 512 * 64; const bf16_t* vcc = (const bf16_t*)(P.ws + WS_VC) + (size_t)(b * 2 + g) * 512 * 64;
    const float* gates = (const float*)(P.ws + WS_GATES); bf16_t* mix = (bf16_t*)(P.ws + WS_MIX);
    LAS float* impw = (LAS float*)(lds + NL_IMP) + wid * 8 * NL_IMP_STRIDE;
    LAS unsigned long long* selm = (LAS unsigned long long*)(lds + NL_SELM);
    NsaLane L; L.qi = c >> 2; const int hh = c & 3, head = g * 4 + hh;
    L.t = qb * 64 + wid * 8 + L.qi; L.sl2 = exp2f(-(float)(head + 1)) * LOG2E; L.mlo = 0; L.mhi = 0;
    const size_t tok = (size_t)b * SEQ + L.t;
    bf16x8 qf[4];
#pragma unroll
    for (int ks = 0; ks < 4; ++ks) qf[ks] = *(const bf16x8*)(qg + tok * 512 + head * 64 + 16 * ks + 8 * hi);
    for (int i = lane; i < 8 * NL_IMP_STRIDE; i += 64) impw[i] = 0.f;
    const int ncmp = qb * 4 + 3 < 511 ? qb * 4 + 3 : 511;
    const int nblk = (ncmp + 63) >> 6;
    const unsigned long long cm = nblk >= 64 ? ~0ull : ((1ull << nblk) - 1ull);
    f32x16 O[2], Ot[2]; float lsum = 0.f;
    O[0] = f32x16{}; O[1] = f32x16{};
    nsa_pass<0>(lds, kcn, vcc, 64, cm, 0ull, qf, L, 1.f, lsum, O, impw);
    lsum += __shfl_xor(lsum, 32);
    const float invc = 1.0f / fmaxf(lsum, 1e-30f);
    float dummy = 0.f;
    nsa_pass<1>(lds, kcn, vcc, 64, cm, 0ull, qf, L, invc, dummy, O, impw);
    const float* gt = gates + tok * 24 + g * 12 + hh * 3;
    const float g0 = gt[0], g1 = gt[1], g2 = gt[2];
#pragma unroll
    for (int dt = 0; dt < 2; ++dt) Ot[dt] = O[dt] * g0;
    {
        const int ncausal = qb + 1;
        for (int qi = 0; qi < 8; ++qi) {
            unsigned long long lo, hi64;
            if (ncausal <= 16) { lo = (1ull << ncausal) - 1ull; hi64 = 0ull; }
            else {
                const int j0 = lane, j1 = lane + 64;
                const bool f0 = (j0 == 0) || (j0 == qb) || (j0 == qb - 1), f1 = (j1 == qb) || (j1 == qb - 1);
                const unsigned k0 = (j0 <= qb && !f0) ? (0x80000000u | (__float_as_uint(impw[qi * NL_IMP_STRIDE + j0]) & 0x7fffff80u) | (unsigned)j0) : 0u;
                const unsigned k1 = (j1 <= qb && !f1) ? (0x80000000u | (__float_as_uint(impw[qi * NL_IMP_STRIDE + j1]) & 0x7fffff80u) | (unsigned)j1) : 0u;
                const int needn = 13;
                unsigned th = 0u;
                for (int bit = 31; bit >= 0; --bit) { const unsigned cand = th | (1u << bit);
                    const int cnt = __popcll(__ballot(k0 >= cand)) + __popcll(__ballot(k1 >= cand));
                    if (cnt >= needn) th = cand; }
                lo = __ballot(f0 || (k0 >= th && k0 != 0u)); hi64 = __ballot(f1 || (k1 >= th && k1 != 0u));
            }
            if (lane == 0) { selm[(wid * 8 + qi) * 2] = lo; selm[(wid * 8 + qi) * 2 + 1] = hi64; }
        }
    }
    __syncthreads();
    unsigned long long ulo = selm[lane * 2], uhi = selm[lane * 2 + 1];
#pragma unroll
    for (int o = 1; o < 64; o <<= 1) { ulo |= __shfl_xor(ulo, o); uhi |= __shfl_xor(uhi, o); }
    L.mlo = selm[(wid * 8 + L.qi) * 2]; L.mhi = selm[(wid * 8 + L.qi) * 2 + 1];
    const bf16_t* kvb = kv + (size_t)b * SEQ * 768 + g * 64;
    O[0] = f32x16{}; O[1] = f32x16{}; lsum = 0.f;
    nsa_pass<2>(lds, kvb + 256, kvb + 384, 768, ulo, uhi, qf, L, 1.f, lsum, O, impw);
    lsum += __shfl_xor(lsum, 32);
    { const float sc = g1 / fmaxf(lsum, 1e-30f);
#pragma unroll
      for (int dt = 0; dt < 2; ++dt) Ot[dt] += O[dt] * sc; }
    {
        const int jlo = qb >= 8 ? qb - 8 : 0;
        unsigned long long wlo = 0ull, whi = 0ull;
        for (int jj = jlo; jj <= qb; ++jj) { if (jj < 64) wlo |= 1ull << jj; else whi |= 1ull << (jj - 64); }
        O[0] = f32x16{}; O[1] = f32x16{}; lsum = 0.f;
        nsa_pass<3>(lds, kvb + 512, kvb + 640, 768, wlo, whi, qf, L, 1.f, lsum, O, impw);
        lsum += __shfl_xor(lsum, 32);
        const float sc = g2 / fmaxf(lsum, 1e-30f);
#pragma unroll
        for (int dt = 0; dt < 2; ++dt) Ot[dt] += O[dt] * sc;
    }
    float ss = 0.f;
#pragma unroll
    for (int dt = 0; dt < 2; ++dt)
#pragma unroll
        for (int r = 0; r < 16; ++r) ss += Ot[dt][r] * Ot[dt][r];
    ss += __shfl_xor(ss, 32);
    const float rstd = rsqrtf(ss * (1.f / 64.f) + RMS_EPS);
#pragma unroll
    for (int dt = 0; dt < 2; ++dt)
#pragma unroll
        for (int r4 = 0; r4 < 4; ++r4) { const int d = 32 * dt + 8 * r4 + 4 * hi; const f32x4 w = *(const f32x4*)(P.attn_out_norm_w + head * 64 + d);
            u32x2 pk; pk.x = cvtpk(Ot[dt][4 * r4] * rstd * w.x, Ot[dt][4 * r4 + 1] * rstd * w.y); pk.y = cvtpk(Ot[dt][4 * r4 + 2] * rstd * w.z, Ot[dt][4 * r4 + 3] * rstd * w.w);
            *(u32x2*)(mix + tok * 1024 + head * 64 + d) = pk; }
    __syncthreads();
}


constexpr int P4_ROWSS = 96 * 1024;
constexpr int CTL_CNT = 1024;

__device__ __forceinline__ void route_token(const Params& P, int t, int lane) {
    const float* scores = (const float*)(P.ws + WS_SCORES) + (size_t)t * 256;
    const f32x4 s4 = *(const f32x4*)(scores + 4 * lane); const f32x4 b4 = *(const f32x4*)(P.router_bias + 4 * lane);
    float sc[4] = {s4.x, s4.y, s4.z, s4.w};
    float bs[4] = {s4.x + b4.x, s4.y + b4.y, s4.z + b4.z, s4.w + b4.w};
    float m1 = fmaxf(bs[0], bs[1]), m2 = fminf(bs[0], bs[1]);
    { const float v = bs[2]; const float n1 = fmaxf(m1, v); m2 = fmaxf(fminf(m1, v), m2); m1 = n1; }
    { const float v = bs[3]; const float n1 = fmaxf(m1, v); m2 = fmaxf(fminf(m1, v), m2); m1 = n1; }
#pragma unroll
    for (int o = 1; o < 8; o <<= 1) { const float o1 = __shfl_xor(m1, o), o2 = __shfl_xor(m2, o); const float n1 = fmaxf(m1, o1); m2 = fmaxf(fminf(m1, o1), fmaxf(m2, o2)); m1 = n1; }
    const float gs = m1 + m2;
    const int grp = lane >> 3;
    int rank = 0;
#pragma unroll
    for (int g2 = 0; g2 < 8; ++g2) { const float og = __shfl(gs, g2 * 8); rank += (og > gs || (og == gs && g2 < grp)) ? 1 : 0; }
    const bool gsel = rank < 4;
    float mv[4];
#pragma unroll
    for (int i = 0; i < 4; ++i) mv[i] = gsel ? bs[i] : -INFINITY;
    int myidx = -1; float myw = 0.f; float wsum = 0.f;
#pragma unroll 1
    for (int k = 0; k < 8; ++k) {
        float bv = mv[0]; int bi = 4 * lane;
#pragma unroll
        for (int i = 1; i < 4; ++i) if (mv[i] > bv) { bv = mv[i]; bi = 4 * lane + i; }
#pragma unroll
        for (int o = 1; o < 64; o <<= 1) { const float ov = __shfl_xor(bv, o); const int oi = __shfl_xor(bi, o); if (ov > bv || (ov == bv && oi < bi)) { bv = ov; bi = oi; } }
        const int wl = bi >> 2, wc = bi & 3;
        const float mine = wc == 0 ? sc[0] : (wc == 1 ? sc[1] : (wc == 2 ? sc[2] : sc[3]));
        const float wv = __shfl(mine, wl);
        wsum += wv;
        if (lane == k) { myidx = bi; myw = wv; }
        if (lane == wl) {
#pragma unroll
            for (int i = 0; i < 4; ++i) if (i == wc) mv[i] = -INFINITY; }
    }
    if (lane < 8) {
        int* cnt = (int*)(P.ws + WS_CTL + CTL_CNT);
        const int pos = atomicAdd(cnt + myidx, 1);
        ((int*)(P.ws + WS_BUCKET))[(size_t)myidx * 32768 + pos] = t * 8 + lane;
        ((float*)(P.ws + WS_RW))[(size_t)t * 8 + lane] = myw / wsum * 2.5f;
    }
}

__device__ __forceinline__ void p4_unit(const Params& P, LAS unsigned char* lds, int u) {
    typedef GemmT<2, 4> G;
    const int tid = opaque_tid(), lane = tid & 63, wid = tid >> 6, wm = wid >> 2, wn = wid & 3, fr = lane & 15, fq = lane >> 4;
    const int r0 = u * 128, b = r0 / SEQ;
    const float* mod = (const float*)(P.ws + WS_MOD) + b * 6144;
    const bf16_t* mix = (const bf16_t*)(P.ws + WS_MIX); bf16_t* h2 = (bf16_t*)(P.ws + WS_H);
    float* scores = (float*)(P.ws + WS_SCORES); bf16_t* hidS = (bf16_t*)(P.ws + WS_HIDS);
    LAS float* rowss = (LAS float*)(lds + P4_ROWSS);
    if (tid < 128) rowss[tid] = 0.f;
    __syncthreads();
    const bf16_t* arow[2];
    f32x4 acc[4][4];
#pragma unroll
    for (int p = 0; p < 2; ++p) arow[p] = mix + (size_t)(r0 + p * 64 + (tid >> 3)) * 1024;
    for (int ct = 0; ct < 4; ++ct) {
        G::run(acc, arow, 64, P.w_out + ct * 256, 1024, 16, lds);
#pragma unroll
        for (int mi = 0; mi < 4; ++mi) { const int rl = wm * 64 + mi * 16 + fr; const size_t m = (size_t)(r0 + rl); float ss = 0.f;
#pragma unroll
            for (int ni = 0; ni < 4; ++ni) { const int col = ct * 256 + wn * 64 + ni * 16 + 4 * fq;
                const f32x4 xv = *(const f32x4*)(P.x + m * 1024 + col), gv = *(const f32x4*)(mod + 2048 + col); const f32x4 a = acc[mi][ni];
                f32x4 o; o.x = xv.x + gv.x * a.x; o.y = xv.y + gv.y * a.y; o.z = xv.z + gv.z * a.z; o.w = xv.w + gv.w * a.w;
                *(f32x4*)(P.out + m * 1024 + col) = o; ss += (o.x * o.x + o.y * o.y) + (o.z * o.z + o.w * o.w); }
            ss += __shfl_xor(ss, 16); ss += __shfl_xor(ss, 32);
            if (fq == 0) __hip_atomic_fetch_add(rowss + rl, ss, __ATOMIC_RELAXED, __HIP_MEMORY_SCOPE_WORKGROUP); }
    }
    __syncthreads();
    for (int rr = 0; rr < 16; ++rr) {
        const int rl = wid * 16 + rr; const size_t m = (size_t)(r0 + rl);
        const float rstd = rsqrtf(rowss[rl] * (1.f / 1024.f) + RMS_EPS);
#pragma unroll
        for (int j = 0; j < 4; ++j) { const int col = (lane + 64 * j) * 4;
            const f32x4 v = *(const f32x4*)(P.out + m * 1024 + col), wv = *(const f32x4*)(P.norm2_w + col), scv = *(const f32x4*)(mod + 4096 + col), shv = *(const f32x4*)(mod + 3072 + col);
            u32x2 pk; pk.x = cvtpk(v.x * rstd * wv.x * (1.f + scv.x) + shv.x, v.y * rstd * wv.y * (1.f + scv.y) + shv.y);
            pk.y = cvtpk(v.z * rstd * wv.z * (1.f + scv.z) + shv.z, v.w * rstd * wv.w * (1.f + scv.w) + shv.w);
            *(u32x2*)(h2 + m * 1024 + col) = pk; }
    }
    __syncthreads();
#pragma unroll
    for (int p = 0; p < 2; ++p) arow[p] = h2 + (size_t)(r0 + p * 64 + (tid >> 3)) * 1024;
    G::run(acc, arow, 64, P.router_w, 256, 16, lds);
#pragma unroll
    for (int mi = 0; mi < 4; ++mi) { const size_t m = (size_t)(r0 + wm * 64 + mi * 16 + fr);
#pragma unroll
        for (int ni = 0; ni < 4; ++ni) { const int col = wn * 64 + ni * 16 + 4 * fq; const f32x4 a = acc[mi][ni];
            *(f32x4*)(scores + m * 256 + col) = (f32x4){sigmoidf_(a.x), sigmoidf_(a.y), sigmoidf_(a.z), sigmoidf_(a.w)}; } }
    __syncthreads();
    for (int rr = 0; rr < 16; ++rr) route_token(P, r0 + wid * 16 + rr, lane);
    G::run(acc, arow, 64, P.sh_wg, 256, 16, lds);
#pragma unroll
    for (int mi = 0; mi < 4; ++mi) { const size_t m = (size_t)(r0 + wm * 64 + mi * 16 + fr);
#pragma unroll
        for (int ni = 0; ni < 4; ++ni) { const int col = wn * 64 + ni * 16 + 4 * fq; const f32x4 a = acc[mi][ni];
            u32x2 pk; pk.x = cvtpk(siluf_(a.x), siluf_(a.y)); pk.y = cvtpk(siluf_(a.z), siluf_(a.w)); *(u32x2*)(hidS + m * 256 + col) = pk; } }
    G::run(acc, arow, 64, P.sh_wu, 256, 16, lds);
#pragma unroll
    for (int mi = 0; mi < 4; ++mi) { const size_t m = (size_t)(r0 + wm * 64 + mi * 16 + fr);
#pragma unroll
        for (int ni = 0; ni < 4; ++ni) { const int col = wn * 64 + ni * 16 + 4 * fq; const f32x4 a = acc[mi][ni];
            const u32x2 gv = *(const u32x2*)(hidS + m * 256 + col);
            u32x2 pk; pk.x = cvtpk(a.x * __uint_as_float(gv.x << 16), a.y * __uint_as_float(gv.x & 0xffff0000u)); pk.y = cvtpk(a.z * __uint_as_float(gv.y << 16), a.w * __uint_as_float(gv.y & 0xffff0000u));
            *(u32x2*)(hidS + m * 256 + col) = pk; } }
    __syncthreads();
#pragma unroll
    for (int p = 0; p < 2; ++p) arow[p] = hidS + (size_t)(r0 + p * 64 + (tid >> 3)) * 256;
    for (int ct = 0; ct < 4; ++ct) {
        G::run(acc, arow, 64, P.sh_wd + ct * 256, 1024, 4, lds);
#pragma unroll
        for (int mi = 0; mi < 4; ++mi) { const size_t m = (size_t)(r0 + wm * 64 + mi * 16 + fr);
#pragma unroll
            for (int ni = 0; ni < 4; ++ni) { const int col = ct * 256 + wn * 64 + ni * 16 + 4 * fq;
                const f32x4 xv = *(const f32x4*)(P.out + m * 1024 + col), gv = *(const f32x4*)(mod + 5120 + col); const f32x4 a = acc[mi][ni];
                f32x4 o; o.x = xv.x + gv.x * a.x; o.y = xv.y + gv.y * a.y; o.z = xv.z + gv.z * a.z; o.w = xv.w + gv.w * a.w;
                *(f32x4*)(P.out + m * 1024 + col) = o; } }
    }
    __syncthreads();
}

constexpr int P6_TILES = 96 * 1024, P6_PRE = P6_TILES + 1024, P6_PAIR = P6_PRE + 1028, P6_W = P6_PAIR + 512;
__device__ __forceinline__ void phase_experts(const Params& P, LAS unsigned char* lds) {
    typedef GemmT<2, 4> G;
    const int tid = opaque_tid(), lane = tid & 63, wid = tid >> 6, wm = wid >> 2, wn = wid & 3, fr = lane & 15, fq = lane >> 4;
    const int* cnt = (const int*)(P.ws + WS_CTL + CTL_CNT); const int* bucket = (const int*)(P.ws + WS_BUCKET); const float* rw = (const float*)(P.ws + WS_RW);
    const bf16_t* h2 = (const bf16_t*)(P.ws + WS_H); bf16_t* hidR = (bf16_t*)(P.ws + WS_HIDR) + (size_t)blockIdx.x * 128 * 256; bf16_t* y = (bf16_t*)(P.ws + WS_Y);
    LAS int* tiles = (LAS int*)(lds + P6_TILES); LAS int* pre = (LAS int*)(lds + P6_PRE); LAS int* pairs = (LAS int*)(lds + P6_PAIR); LAS float* wts = (LAS float*)(lds + P6_W);
    if (tid < 256) tiles[tid] = (cnt[tid] + 127) >> 7;
    __syncthreads();
    if (tid < 256) { int s = 0; for (int i = 0; i < tid; ++i) s += tiles[i]; pre[tid] = s; if (tid == 255) pre[256] = s + tiles[255]; }
    __syncthreads();
    const int total = pre[256];
    for (int u = blockIdx.x; u < total; u += gridDim.x) {
        int lo = 0, hi = 255;
        while (lo < hi) { const int mid = (lo + hi + 1) >> 1; if (pre[mid] <= u) lo = mid; else hi = mid - 1; }
        const int e = lo, tile = u - pre[e], n = cnt[e], rows = (n - tile * 128) < 128 ? (n - tile * 128) : 128;
        if (tid < 128) { const int r = tid < rows ? tid : 0; const int pr = bucket[(size_t)e * 32768 + tile * 128 + r]; pairs[tid] = pr; wts[tid] = tid < rows ? rw[pr] : 0.f; }
        __syncthreads();
        const bf16_t* arow[2];
#pragma unroll
        for (int p = 0; p < 2; ++p) arow[p] = h2 + (size_t)(pairs[p * 64 + (tid >> 3)] >> 3) * 1024;
        f32x4 acc[4][4];
        G::run(acc, arow, 64, P.exp_wg + (size_t)e * 1024 * 256, 256, 16, lds);
#pragma unroll
        for (int mi = 0; mi < 4; ++mi) { const int rl = wm * 64 + mi * 16 + fr;
#pragma unroll
            for (int ni = 0; ni < 4; ++ni) { const int col = wn * 64 + ni * 16 + 4 * fq; const f32x4 a = acc[mi][ni];
                u32x2 pk; pk.x = cvtpk(siluf_(a.x), siluf_(a.y)); pk.y = cvtpk(siluf_(a.z), siluf_(a.w)); *(u32x2*)(hidR + rl * 256 + col) = pk; } }
        G::run(acc, arow, 64, P.exp_wu + (size_t)e * 1024 * 256, 256, 16, lds);
#pragma unroll
        for (int mi = 0; mi < 4; ++mi) { const int rl = wm * 64 + mi * 16 + fr;
#pragma unroll
            for (int ni = 0; ni < 4; ++ni) { const int col = wn * 64 + ni * 16 + 4 * fq; const f32x4 a = acc[mi][ni];
                const u32x2 gv = *(const u32x2*)(hidR + rl * 256 + col);
                u32x2 pk; pk.x = cvtpk(a.x * __uint_as_float(gv.x << 16), a.y * __uint_as_float(gv.x & 0xffff0000u)); pk.y = cvtpk(a.z * __uint_as_float(gv.y << 16), a.w * __uint_as_float(gv.y & 0xffff0000u));
                *(u32x2*)(hidR + rl * 256 + col) = pk; } }
        __syncthreads();
#pragma unroll
        for (int p = 0; p < 2; ++p) arow[p] = hidR + (size_t)(p * 64 + (tid >> 3)) * 256;
        for (int ct = 0; ct < 4; ++ct) {
            G::run(acc, arow, 64, P.exp_wd + (size_t)e * 256 * 1024 + ct * 256, 1024, 4, lds);
#pragma unroll
            for (int mi = 0; mi < 4; ++mi) { const int rl = wm * 64 + mi * 16 + fr; const float wgt = wts[rl]; const size_t pr = (size_t)pairs[rl];
                if (rl < rows) {
#pragma unroll
                    for (int ni = 0; ni < 4; ++ni) { const int col = ct * 256 + wn * 64 + ni * 16 + 4 * fq; const f32x4 a = acc[mi][ni] * wgt;
                        u32x2 pk; pk.x = cvtpk(a.x, a.y); pk.y = cvtpk(a.z, a.w); *(u32x2*)(y + pr * 1024 + col) = pk; } } }
        }
        __syncthreads();
    }
}

__device__ __forceinline__ void phase_combine(const Params& P) {
    const int lane = threadIdx.x & 63, gw = blockIdx.x * (NTHREADS / 64) + (threadIdx.x >> 6), NGW = gridDim.x * (NTHREADS / 64);
    const bf16_t* y = (const bf16_t*)(P.ws + WS_Y);
    for (int m = gw; m < T; m += NGW) {
        const float* mod = (const float*)(P.ws + WS_MOD) + (m / SEQ) * 6144 + 5120;
#pragma unroll
        for (int j = 0; j < 4; ++j) { const int col = (lane + 64 * j) * 4;
            f32x4 s = (f32x4){0.f, 0.f, 0.f, 0.f};
#pragma unroll
            for (int sl = 0; sl < 8; ++sl) { const u32x2 v = *(const u32x2*)(y + ((size_t)m * 8 + sl) * 1024 + col);
                s.x += __uint_as_float(v.x << 16); s.y += __uint_as_float(v.x & 0xffff0000u); s.z += __uint_as_float(v.y << 16); s.w += __uint_as_float(v.y & 0xffff0000u); }
            const f32x4 g = *(const f32x4*)(mod + col); f32x4 o = *(const f32x4*)(P.out + (size_t)m * 1024 + col);
            o.x += g.x * s.x; o.y += g.y * s.y; o.z += g.z * s.z; o.w += g.w * s.w;
            *(f32x4*)(P.out + (size_t)m * 1024 + col) = o; }
    }
}

constexpr int LDS_BYTES = 144 * 1024;
__global__ void __launch_bounds__(NTHREADS) mega(Params P) {
    extern __shared__ __attribute__((aligned(16))) unsigned char smem[];
    LAS unsigned char* lds = (LAS unsigned char*)smem;
    cg::grid_group grid = cg::this_grid();
    phase_mod(P, lds);
    grid.sync();
    { const float* mod = (const float*)(P.ws + WS_MOD); norm_mod_rows(P.x, P.norm1_w, mod, mod + 1024, (bf16_t*)(P.ws + WS_H)); }
    grid.sync();
    phase_inproj(P, lds);
    grid.sync();
    phase_cmp_h1(P, lds);
    grid.sync();
    for (int u = blockIdx.x; u < 512; u += gridDim.x) hgrn_unit<1>(P, lds, u);
    for (int u = blockIdx.x; u < 1024; u += gridDim.x) nsa_unit(P, lds, u);
    grid.sync();
    for (int u = blockIdx.x; u < 256; u += gridDim.x) p4_unit(P, lds, u);
    grid.sync();
    phase_experts(P, lds);
    grid.sync();
    phase_combine(P);
}

extern "C" void kernel_launch(void* const* d_in, const int* in_sizes, int n_in, void* d_out, int out_size, void* d_ws, size_t ws_size, hipStream_t stream) {
    static int grid = 0;
    if (grid == 0) {
        if (n_in != 25 || ws_size < WS_END) { fprintf(stderr, "kernel_launch: unexpected n_in %d or ws_size %zu (need %zu)\n", n_in, ws_size, (size_t)WS_END); grid = -1; return; }
        int dev = 0, cus = 0, per_cu = 0;
        (void)hipGetDevice(&dev); (void)hipDeviceGetAttribute(&cus, hipDeviceAttributeMultiprocessorCount, dev);
        (void)hipFuncSetAttribute((const void*)mega, hipFuncAttributeMaxDynamicSharedMemorySize, LDS_BYTES);
        (void)hipOccupancyMaxActiveBlocksPerMultiprocessor(&per_cu, (const void*)mega, NTHREADS, LDS_BYTES);
        if (per_cu < 1) { fprintf(stderr, "kernel_launch: occupancy query says %d blocks per CU\n", per_cu); grid = -1; return; }
        grid = cus;
    }
    if (grid < 0) return;
    (void)hipMemsetAsync((char*)d_ws + WS_CTL, 0, 64 * 1024, stream);
    Params p{};
    const float** pf = (const float**)&p;
    for (int i = 0; i < 25; ++i) pf[i] = (const float*)d_in[i];
    p.out = (float*)d_out; p.ws = (unsigned char*)d_ws;
    void* args[] = {&p};
    hipError_t e = hipLaunchCooperativeKernel((const void*)mega, dim3(grid), dim3(NTHREADS), args, LDS_BYTES, stream);
    if (e != hipSuccess) fprintf(stderr, "cooperative launch failed: %s (grid %d)\n", hipGetErrorString(e), grid);
}

#ifdef PHASE_TEST
__global__ void __launch_bounds__(NTHREADS) t_p4(Params P) { extern __shared__ __attribute__((aligned(16))) unsigned char smem[]; p4_unit(P, (LAS unsigned char*)smem, blockIdx.x); }
__global__ void __launch_bounds__(NTHREADS) t_p6(Params P) { extern __shared__ __attribute__((aligned(16))) unsigned char smem[]; phase_experts(P, (LAS unsigned char*)smem); }
__global__ void __launch_bounds__(NTHREADS) t_nsa(Params P) { extern __shared__ __attribute__((aligned(16))) unsigned char smem[]; nsa_unit(P, (LAS unsigned char*)smem, blockIdx.x); }
__global__ void __launch_bounds__(NTHREADS) t_mod(Params P) { extern __shared__ __attribute__((aligned(16))) unsigned char smem[]; phase_mod(P, (LAS unsigned char*)smem); }
__global__ void __launch_bounds__(NTHREADS) t_inproj(Params P) { extern __shared__ __attribute__((aligned(16))) unsigned char smem[]; phase_inproj(P, (LAS unsigned char*)smem); }
__global__ void __launch_bounds__(NTHREADS) t_cmp(Params P) { extern __shared__ __attribute__((aligned(16))) unsigned char smem[]; compress_unit(P, (LAS unsigned char*)smem, blockIdx.x); }
__global__ void __launch_bounds__(NTHREADS) t_h0(Params P) { extern __shared__ __attribute__((aligned(16))) unsigned char smem[]; hgrn_unit<0>(P, (LAS unsigned char*)smem, blockIdx.x); }
__global__ void __launch_bounds__(NTHREADS) t_h1(Params P) { extern __shared__ __attribute__((aligned(16))) unsigned char smem[]; hgrn_unit<1>(P, (LAS unsigned char*)smem, blockIdx.x); }
#endif
```

```cpp
#include <hip/hip_runtime.h>
#include <hip/hip_cooperative_groups.h>
#include <cstdio>
#include <cstdint>
#include <type_traits>
namespace cg = cooperative_groups;

#define LAS __attribute__((address_space(3)))
typedef unsigned short bf16_t;
typedef short bf16x8 __attribute__((ext_vector_type(8)));
typedef short s16x4 __attribute__((ext_vector_type(4)));
typedef float f32x4 __attribute__((ext_vector_type(4)));
typedef float f32x16 __attribute__((ext_vector_type(16)));
typedef unsigned u32x4 __attribute__((ext_vector_type(4)));
typedef unsigned u32x2 __attribute__((ext_vector_type(2)));

constexpr int D = 1024, BATCH = 4, SEQ = 8192, T = BATCH * SEQ;
constexpr int IN_COLS = 3352;
constexpr int NTHREADS = 512;
constexpr int H1S = 1088;
constexpr float RMS_EPS = 1e-6f;
constexpr float LOG2E = 1.4426950408889634f;

constexpr size_t MB = 1024ull * 1024ull;
constexpr size_t WS_CTL    = 0;
constexpr size_t WS_MOD    = 64 * 1024;
constexpr size_t WS_LB     = WS_MOD + 4 * 6144 * 4;
constexpr size_t WS_CB     = WS_LB + 2048;
constexpr size_t WS_H      = 1 * MB;
constexpr size_t WS_SS     = WS_H + 72 * MB;
constexpr size_t WS_RW     = WS_SS + 1 * MB;
constexpr size_t WS_BUCKET = WS_RW + 1 * MB;
constexpr size_t WS_HIDR   = WS_BUCKET + 16 * MB;
constexpr size_t WS_WSM    = WS_HIDR + 32 * MB;
constexpr size_t WS_WOUT   = WS_WSM, WS_WRS = WS_WSM + 2 * MB, WS_WSD = WS_WSM + 4 * MB;
constexpr size_t WS_WBE    = WS_WSM + 5 * MB;
constexpr size_t WS_WBGU   = WS_WBE, WS_WBD = WS_WBE + 256 * MB;
constexpr size_t WS_SCORES = WS_WBE;
constexpr size_t WS_HIDS   = WS_SCORES + 32 * MB;
constexpr size_t WS_WIN    = WS_HIDS + 16 * MB;
constexpr size_t WS_Y      = WS_WBE + 384 * MB;
constexpr size_t WS_Q      = WS_Y;
constexpr size_t WS_KV     = WS_Q + 32 * MB;
constexpr size_t WS_GATES  = WS_KV + 48 * MB;
constexpr size_t WS_HQ     = WS_GATES + 4 * MB;
constexpr size_t WS_LOGF   = WS_HQ + 32 * MB;
constexpr size_t WS_HV     = WS_LOGF + 64 * MB;
constexpr size_t WS_HG     = WS_HV + 32 * MB;
constexpr size_t WS_CMPH   = WS_HG + 32 * MB;
constexpr size_t WS_KC     = WS_CMPH + 4 * MB;
constexpr size_t WS_VC     = WS_KC + 1 * MB;
constexpr size_t WS_HL     = WS_VC + 1 * MB;
constexpr size_t WS_HD     = WS_HL + 32 * MB;
constexpr size_t WS_MIX    = WS_HD + 1 * MB;
constexpr size_t WS_END    = WS_Y + 512 * MB;
constexpr int BCAP = 16384;
constexpr int CTL_CNT = 1024;
constexpr int CTL_BAR = 16384;

struct Params {
    const float *x, *c, *ada_w, *ada_b, *norm1_w, *norm2_w, *w_in, *q_norm_w, *k_norm_w, *cmp_pos, *cmp_w1, *cmp_b1, *cmp_w2,
        *attn_out_norm_w, *hgrn_lb, *rec_out_norm_w, *w_out, *router_w, *router_bias, *exp_wg, *exp_wu, *exp_wd, *sh_wg, *sh_wu, *sh_wd;
    float* out;
    unsigned char* ws;
};

__device__ __forceinline__ unsigned cvtpk(float lo, float hi) { unsigned r; asm("v_cvt_pk_bf16_f32 %0, %1, %2" : "=v"(r) : "v"(lo), "v"(hi)); return r; }
__device__ __forceinline__ int opaque_tid() { int t = threadIdx.x; asm volatile("" : "+v"(t)); return t; }
__device__ __forceinline__ float bf2f(bf16_t v) { return __uint_as_float(((unsigned)v) << 16); }
__device__ __forceinline__ float sigmoidf_(float v) { return __builtin_amdgcn_rcpf(1.0f + __expf(-v)); }
__device__ __forceinline__ float siluf_(float v) { return v * __builtin_amdgcn_rcpf(1.0f + __expf(-v)); }
__device__ __forceinline__ float wave_sum(float v) {
#pragma unroll
    for (int o = 1; o < 64; o <<= 1) v += __shfl_xor(v, o);
    return v;
}
__device__ __forceinline__ s16x4 lds_tr(const LAS unsigned char* p) {
    return __builtin_bit_cast(s16x4, __builtin_amdgcn_ds_read_tr16_b64_v4i16((LAS s16x4*)p));
}

#define XB_TMO      128
#define XB_XCNT(j)  (256  + 64 * (j))
#define XB_XSUB(j)  (1280 + 64 * (j))
#define XB_XGEN(j)  (2304 + 64 * (j))
#define XB_TOP      3328
#define XB_TOPGEN   3392
#define XCD_BAR_WORDS 3456
#define XB_SPIN_CAP (1u << 22)
__device__ __forceinline__ unsigned xb_ld(unsigned* p)              { return __hip_atomic_load(p, __ATOMIC_RELAXED, __HIP_MEMORY_SCOPE_AGENT); }
__device__ __forceinline__ unsigned xb_add(unsigned* p, unsigned v) { return __hip_atomic_fetch_add(p, v, __ATOMIC_RELAXED, __HIP_MEMORY_SCOPE_AGENT); }
__device__ __forceinline__ unsigned xb_xcc_id() { return (unsigned)__builtin_amdgcn_s_getreg((3 << 11) | 20) & 0xFu; }
#define XB_SPIN(cond, bar) do { unsigned _sp = 0; while (cond) { __builtin_amdgcn_s_sleep(1); \
    if ((++_sp & 255u) == 0u) { if (xb_ld(&(bar)[XB_TMO])) break; if (_sp > XB_SPIN_CAP) { atomicAdd(&(bar)[XB_TMO], 1u); break; } } } } while (0)
struct XcdBarrier { unsigned* bar; unsigned x; volatile LAS unsigned* st; };
__device__ __forceinline__ XcdBarrier xcd_barrier_post(unsigned* bar, volatile LAS unsigned* st) {
    XcdBarrier b; b.bar = bar; b.x = xb_xcc_id(); b.st = st;
    if (threadIdx.x == 0) (void)xb_add(&bar[XB_XCNT(b.x)], 1u);
    return b;
}
__device__ __forceinline__ void xcd_barrier_complete(unsigned* bar, unsigned x, unsigned& nloc, unsigned& nx) {
    const unsigned G = gridDim.x * gridDim.y * gridDim.z;
    unsigned sum, cnt, mine, sp = 0u;
    for (;;) {
        sum = 0u; cnt = 0u; mine = 0u;
#pragma unroll
        for (unsigned j = 0; j < 16; ++j) { const unsigned c = xb_ld(&bar[XB_XCNT(j)]); sum += c; cnt += (c > 0u) ? 1u : 0u; mine = (j == x) ? c : mine; }
        if (sum == G) break;
        __builtin_amdgcn_s_sleep(1);
        if ((++sp & 255u) == 0u) { if (xb_ld(&bar[XB_TMO])) break; if (sp > XB_SPIN_CAP) { atomicAdd(&bar[XB_TMO], 1u); break; } }
    }
    nloc = mine > 0u ? mine : 1u; nx = cnt > 0u ? cnt : 1u;
}
__device__ __forceinline__ void xcd_barrier(const XcdBarrier& b) {
    asm volatile("s_waitcnt vmcnt(0)" ::: "memory");
    __syncthreads();
    if (threadIdx.x == 0) {
        unsigned* bar = b.bar;
        __builtin_amdgcn_s_waitcnt(0);
        unsigned nloc = b.st[0], nx = b.st[1];
        if (nloc == 0u) { xcd_barrier_complete(bar, b.x, nloc, nx); b.st[0] = nloc; b.st[1] = nx; }
        const unsigned old = xb_add(&bar[XB_XSUB(b.x)], 1u);
        const unsigned gen = old / nloc;
        if (old + 1u == (gen + 1u) * nloc) {
            __builtin_amdgcn_fence(__ATOMIC_RELEASE, "agent");
            asm volatile("s_waitcnt vmcnt(0)" ::: "memory");
            const unsigned og = xb_add(&bar[XB_TOP], 1u);
            const unsigned tg = og / nx;
            if (og + 1u == (tg + 1u) * nx) xb_add(&bar[XB_TOPGEN], 1u);
            else XB_SPIN(xb_ld(&bar[XB_TOPGEN]) == tg, bar);
            __builtin_amdgcn_fence(__ATOMIC_ACQUIRE, "agent");
            xb_add(&bar[XB_XGEN(b.x)], 1u);
            asm volatile("s_waitcnt vmcnt(0)" ::: "memory");
        } else {
            XB_SPIN(xb_ld(&bar[XB_XGEN(b.x)]) == gen, bar);
            __builtin_amdgcn_fence(__ATOMIC_ACQUIRE, "agent");
            asm volatile("s_waitcnt vmcnt(0)" ::: "memory");
        }
    }
    __syncthreads();
}

template <int WM, int WN> struct GemmT {
    static constexpr int BM = 64 * WM, BN = 64 * WN;
    static constexpr int A_BYTES = BM * 128, B_BYTES = 64 * BN * 2, STAGE = A_BYTES + B_BYTES, LDS_BYTES = 2 * STAGE;
    static constexpr int NB4 = BN / 32;
    static constexpr int B_ROW4 = BN / 4;

    static __device__ __forceinline__ void run(f32x4 (&acc)[4][4], const bf16_t* const (&arow)[WM], int a_kstride, const float* Bp, int ldb, int KT, LAS unsigned char* lds) {
        const int tid = opaque_tid(), lane = tid & 63, wid = tid >> 6, wm = wid / WN, wn = wid % WN, fr = lane & 15, fq = lane >> 4;
#pragma unroll
        for (int mi = 0; mi < 4; ++mi)
#pragma unroll
            for (int ni = 0; ni < 4; ++ni) acc[mi][ni] = (f32x4){0.f, 0.f, 0.f, 0.f};
        const int achunk = tid & 7;
        u32x4 areg[WM]; f32x4 breg[NB4];
        int a_wr[WM];
#pragma unroll
        for (int p = 0; p < WM; ++p) { const int row = p * 64 + (tid >> 3); a_wr[p] = row * 128 + ((achunk ^ ((row >> 1) & 7)) << 4); }
        int b_wr[NB4]; int b_goff[NB4];
#pragma unroll
        for (int p = 0; p < NB4; ++p) { const int i = tid + NTHREADS * p, k = i / B_ROW4, n = (i % B_ROW4) * 4;
            const int f = (k & 3) | (((k >> 3) & 1) << 2);
            b_wr[p] = A_BYTES + k * (BN * 2) + (((n >> 4) ^ f) << 5) + ((n & 15) << 1); b_goff[p] = k * ldb + n; }
        int a_rd[4][2];
#pragma unroll
        for (int mi = 0; mi < 4; ++mi)
#pragma unroll
            for (int ks = 0; ks < 2; ++ks) { const int row = wm * 64 + mi * 16 + fr, ch = ks * 4 + fq; a_rd[mi][ks] = row * 128 + ((ch ^ ((row >> 1) & 7)) << 4); }
        int b_rd[2][2];
        int b_f[2][2];
#pragma unroll
        for (int ks = 0; ks < 2; ++ks)
#pragma unroll
            for (int t = 0; t < 2; ++t) { const int k = ks * 32 + 8 * fq + 4 * t + (fr >> 2); b_f[ks][t] = (k & 3) | (((k >> 3) & 1) << 2);
                b_rd[ks][t] = A_BYTES + k * (BN * 2) + ((fr & 3) << 3); }

        auto gload = [&](int kt) {
#pragma unroll
            for (int p = 0; p < WM; ++p) areg[p] = *(const u32x4*)(arow[p] + (size_t)kt * a_kstride + achunk * 8);
            const float* bk = Bp + (size_t)kt * 64 * ldb;
#pragma unroll
            for (int p = 0; p < NB4; ++p) breg[p] = *(const f32x4*)(bk + b_goff[p]);
        };
        auto lstore = [&](int buf) {
            LAS unsigned char* base = lds + buf * STAGE;
#pragma unroll
            for (int p = 0; p < WM; ++p) *(LAS u32x4*)(base + a_wr[p]) = areg[p];
#pragma unroll
            for (int p = 0; p < NB4; ++p) { u32x2 w; w.x = cvtpk(breg[p].x, breg[p].y); w.y = cvtpk(breg[p].z, breg[p].w); *(LAS u32x2*)(base + b_wr[p]) = w; }
        };
        gload(0); lstore(0); __syncthreads();
        for (int kt = 0; kt < KT; ++kt) {
            if (kt + 1 < KT) gload(kt + 1);
            __builtin_amdgcn_sched_barrier(0);
            const LAS unsigned char* base = lds + (kt & 1) * STAGE;
#pragma unroll
            for (int ks = 0; ks < 2; ++ks) {
                bf16x8 af[4], bfr[4];
#pragma unroll
                for (int mi = 0; mi < 4; ++mi) af[mi] = *(const LAS bf16x8*)(base + a_rd[mi][ks]);
#pragma unroll
                for (int ni = 0; ni < 4; ++ni) {
                    const int u0 = wn * 4 + ni;
                    const s16x4 lo = lds_tr(base + b_rd[ks][0] + ((u0 ^ b_f[ks][0]) << 5));
                    const s16x4 hi = lds_tr(base + b_rd[ks][1] + ((u0 ^ b_f[ks][1]) << 5));
                    bfr[ni] = (bf16x8){lo[0], lo[1], lo[2], lo[3], hi[0], hi[1], hi[2], hi[3]};
                }
#pragma unroll
                for (int mi = 0; mi < 4; ++mi)
#pragma unroll
                    for (int ni = 0; ni < 4; ++ni) acc[mi][ni] = __builtin_amdgcn_mfma_f32_16x16x32_bf16(bfr[ni], af[mi], acc[mi][ni], 0, 0, 0);
            }
            if (kt + 1 < KT) lstore((kt + 1) & 1);
            __syncthreads();
        }
    }
};

struct Gemm2 {
    static constexpr int A_BYTES = 32768, STAGE = 65536, LDS_BYTES = 2 * STAGE;
    static __device__ __forceinline__ int a_row(int i, int w, int lane) { return (i * 8 + w) * 8 + (lane >> 3); }
    static __device__ __forceinline__ int a_chunk(int row, int lane) { return (lane & 7) ^ ((row >> 1) & 7); }
    static __device__ __forceinline__ int b_k(int i, int w, int lane) { return (i * 8 + w) * 2 + (lane >> 5); }
    static __device__ __forceinline__ int b_n(int k, int lane) { return ((((lane & 31) >> 1) ^ fk2(k)) << 4) + ((lane & 1) << 3); }
    static __device__ __forceinline__ int fk2(int r) { return (r & 3) | (((r >> 3) & 1) << 2); }

    static __device__ __forceinline__ void run(f32x4 (&acc)[4][8], const bf16_t* const (&aptr)[4], int a_kstride, const bf16_t* const (&bptr)[4], size_t b_kstride, int KT, LAS unsigned char* lds) {
        const int tid = opaque_tid(), lane = tid & 63, wid = tid >> 6, wm = wid >> 1, wn = wid & 1, fr = lane & 15, fq = lane >> 4;
        const int wu = __builtin_amdgcn_readfirstlane(wid);
#pragma unroll
        for (int mi = 0; mi < 4; ++mi)
#pragma unroll
            for (int ni = 0; ni < 8; ++ni) acc[mi][ni] = (f32x4){0.f, 0.f, 0.f, 0.f};
        int a_rd[4][2];
#pragma unroll
        for (int mi = 0; mi < 4; ++mi)
#pragma unroll
            for (int ks = 0; ks < 2; ++ks) { const int row = wm * 64 + mi * 16 + fr, ch = ks * 4 + fq; a_rd[mi][ks] = row * 128 + ((ch ^ ((row >> 1) & 7)) << 4); }
        int b_rd[2][2], b_f[2][2];
#pragma unroll
        for (int ks = 0; ks < 2; ++ks)
#pragma unroll
            for (int t = 0; t < 2; ++t) { const int k = ks * 32 + 8 * fq + 4 * t + (fr >> 2); b_f[ks][t] = fk2(k); b_rd[ks][t] = A_BYTES + k * 512 + ((fr & 3) << 3); }
        auto issue = [&](int kt, int buf) {
            LAS unsigned char* base = lds + buf * STAGE + wu * 1024;
#pragma unroll
            for (int i = 0; i < 4; ++i) __builtin_amdgcn_global_load_lds((const unsigned*)(aptr[i] + (size_t)kt * a_kstride), (LAS unsigned*)(base + i * 8192), 16, 0, 0);
#pragma unroll
            for (int i = 0; i < 4; ++i) __builtin_amdgcn_global_load_lds((const unsigned*)(bptr[i] + (size_t)kt * b_kstride), (LAS unsigned*)(base + A_BYTES + i * 8192), 16, 0, 0);
        };
        issue(0, 0);
        for (int kt = 0; kt < KT; ++kt) {
            asm volatile("s_waitcnt vmcnt(0)" ::: "memory");
            __syncthreads();
            if (kt + 1 < KT) issue(kt + 1, (kt + 1) & 1);
            const LAS unsigned char* base = lds + (kt & 1) * STAGE;
#pragma unroll
            for (int ks = 0; ks < 2; ++ks) {
                bf16x8 af[4];
#pragma unroll
                for (int mi = 0; mi < 4; ++mi) af[mi] = *(const LAS bf16x8*)(base + a_rd[mi][ks]);
#pragma unroll
                for (int ni = 0; ni < 8; ++ni) {
                    const int u0 = wn * 8 + ni;
                    const s16x4 lo = lds_tr(base + b_rd[ks][0] + ((u0 ^ b_f[ks][0]) << 5));
                    const s16x4 hi = lds_tr(base + b_rd[ks][1] + ((u0 ^ b_f[ks][1]) << 5));
                    const bf16x8 bfr = (bf16x8){lo[0], lo[1], lo[2], lo[3], hi[0], hi[1], hi[2], hi[3]};
#pragma unroll
                    for (int mi = 0; mi < 4; ++mi) acc[mi][ni] = __builtin_amdgcn_mfma_f32_16x16x32_bf16(bfr, af[mi], acc[mi][ni], 0, 0, 0);
                }
            }
        }
        __syncthreads();
    }
};

struct Gemm3 {
    static constexpr int A_BYTES = 16384, STAGE = 32768, LDS_BYTES = 4 * STAGE;
    static __device__ __forceinline__ int a_row(int i, int w, int lane) { return (i * 8 + w) * 16 + (lane >> 2); }
    static __device__ __forceinline__ int a_chunk(int row, int lane) { return (lane & 3) ^ ((row >> 1) & 3); }
    static __device__ __forceinline__ int b_k(int i, int w, int lane) { return (i * 8 + w) * 2 + (lane >> 5); }
    static __device__ __forceinline__ int fk2(int r) { return (r & 3) | (((r >> 3) & 1) << 2); }
    static __device__ __forceinline__ int b_n(int k, int lane) { return ((((lane & 31) >> 1) ^ fk2(k)) << 4) + ((lane & 1) << 3); }
    static __device__ __forceinline__ void run(f32x4 (&acc)[4][8], const bf16_t* const (&aptr)[2], int a_kstride, const bf16_t* const (&bptr)[2], size_t b_kstride, int KT, LAS unsigned char* lds) {
        const int tid = opaque_tid(), lane = tid & 63, wid = tid >> 6, wm = wid >> 1, wn = wid & 1, fr = lane & 15, fq = lane >> 4;
        const int wu = __builtin_amdgcn_readfirstlane(wid);
#pragma unroll
        for (int mi = 0; mi < 4; ++mi)
#pragma unroll
            for (int ni = 0; ni < 8; ++ni) acc[mi][ni] = (f32x4){0.f, 0.f, 0.f, 0.f};
        int a_rd[4];
#pragma unroll
        for (int mi = 0; mi < 4; ++mi) { const int row = wm * 64 + mi * 16 + fr; a_rd[mi] = row * 64 + ((fq ^ ((row >> 1) & 3)) << 4); }
        int b_rd[2], b_f[2];
#pragma unroll
        for (int t = 0; t < 2; ++t) { const int k = 8 * fq + 4 * t + (fr >> 2); b_f[t] = fk2(k); b_rd[t] = A_BYTES + k * 512 + ((fr & 3) << 3); }
        auto issue = [&](int kt) {
            LAS unsigned char* base = lds + (kt & 3) * STAGE + wu * 1024;
#pragma unroll
            for (int i = 0; i < 2; ++i) __builtin_amdgcn_global_load_lds((const unsigned*)(aptr[i] + (size_t)kt * a_kstride), (LAS unsigned*)(base + i * 8192), 16, 0, 0);
#pragma unroll
            for (int i = 0; i < 2; ++i) __builtin_amdgcn_global_load_lds((const unsigned*)(bptr[i] + (size_t)kt * b_kstride), (LAS unsigned*)(base + A_BYTES + i * 8192), 16, 0, 0);
        };
        asm volatile("s_waitcnt vmcnt(0)" ::: "memory");
        issue(0); if (KT > 1) issue(1); if (KT > 2) issue(2);
        for (int kt = 0; kt < KT; ++kt) {
            const int rem = KT - 1 - kt;
            if (rem >= 2) asm volatile("s_waitcnt vmcnt(8)" ::: "memory"); else if (rem == 1) asm volatile("s_waitcnt vmcnt(4)" ::: "memory"); else asm volatile("s_waitcnt vmcnt(0)" ::: "memory");
            __builtin_amdgcn_s_barrier();
            asm volatile("" ::: "memory");
            if (kt + 3 < KT) issue(kt + 3);
            const LAS unsigned char* base = lds + (kt & 3) * STAGE;
            bf16x8 af[4];
#pragma unroll
            for (int mi = 0; mi < 4; ++mi) af[mi] = *(const LAS bf16x8*)(base + a_rd[mi]);
#pragma unroll
            for (int ni = 0; ni < 8; ++ni) {
                const int u0 = wn * 8 + ni;
                const s16x4 lo = lds_tr(base + b_rd[0] + ((u0 ^ b_f[0]) << 5));
                const s16x4 hi = lds_tr(base + b_rd[1] + ((u0 ^ b_f[1]) << 5));
                const bf16x8 bfr = (bf16x8){lo[0], lo[1], lo[2], lo[3], hi[0], hi[1], hi[2], hi[3]};
#pragma unroll
                for (int mi = 0; mi < 4; ++mi) acc[mi][ni] = __builtin_amdgcn_mfma_f32_16x16x32_bf16(bfr, af[mi], acc[mi][ni], 0, 0, 0);
            }
        }
        asm volatile("s_waitcnt lgkmcnt(0)" ::: "memory");
        __builtin_amdgcn_s_barrier();
        asm volatile("" ::: "memory");
    }
};

struct Gemm4 {
    static constexpr int A_BYTES = 16384, STAGE = 32768, LDS_BYTES = 2 * STAGE;
    static __device__ __forceinline__ int fk2(int r) { return (r & 3) | (((r >> 3) & 1) << 2); }
    static __device__ __forceinline__ int a_row(int i, int tid) { return (tid >> 2) + 128 * i; }
    static __device__ __forceinline__ int b_k(int i, int tid) { return (tid >> 5) + 16 * i; }
    static __device__ __forceinline__ void run(f32x4 (&acc)[4][8], const bf16_t* const (&aptr)[2], int a_kstride, const bf16_t* const (&bptr)[2], size_t b_kstride, int KT, LAS unsigned char* lds) {
        const int tid = opaque_tid(), lane = tid & 63, wid = tid >> 6, wm = wid >> 1, wn = wid & 1, fr = lane & 15, fq = lane >> 4;
#pragma unroll
        for (int mi = 0; mi < 4; ++mi)
#pragma unroll
            for (int ni = 0; ni < 8; ++ni) acc[mi][ni] = (f32x4){0.f, 0.f, 0.f, 0.f};
        int a_wr[2], b_wr[2];
#pragma unroll
        for (int i = 0; i < 2; ++i) { const int row = a_row(i, tid); a_wr[i] = row * 64 + (((tid & 3) ^ ((row >> 1) & 3)) << 4);
            const int k = b_k(i, tid), n = (tid & 31) * 8; b_wr[i] = A_BYTES + k * 512 + (((n >> 4) ^ fk2(k)) << 5) + ((n & 15) << 1); }
        int a_rd[4];
#pragma unroll
        for (int mi = 0; mi < 4; ++mi) { const int row = wm * 64 + mi * 16 + fr; a_rd[mi] = row * 64 + ((fq ^ ((row >> 1) & 3)) << 4); }
        int b_rd[2], b_f[2];
#pragma unroll
        for (int t = 0; t < 2; ++t) { const int k = 8 * fq + 4 * t + (fr >> 2); b_f[t] = fk2(k); b_rd[t] = A_BYTES + k * 512 + ((fr & 3) << 3); }
        u32x4 ra0[2], rb0[2], ra1[2], rb1[2];
        auto gload = [&](int kt, u32x4 (&ra)[2], u32x4 (&rb)[2]) {
#pragma unroll
            for (int i = 0; i < 2; ++i) { ra[i] = *(const u32x4*)(aptr[i] + (size_t)kt * a_kstride); rb[i] = *(const u32x4*)(bptr[i] + (size_t)kt * b_kstride); }
        };
        auto lstore = [&](int buf, const u32x4 (&ra)[2], const u32x4 (&rb)[2]) {
            LAS unsigned char* base = lds + buf * STAGE;
#pragma unroll
            for (int i = 0; i < 2; ++i) { *(LAS u32x4*)(base + a_wr[i]) = ra[i]; *(LAS u32x4*)(base + b_wr[i]) = rb[i]; }
        };
        auto compute = [&](int buf) {
            const LAS unsigned char* base = lds + buf * STAGE;
            bf16x8 af[4];
#pragma unroll
            for (int mi = 0; mi < 4; ++mi) af[mi] = *(const LAS bf16x8*)(base + a_rd[mi]);
#pragma unroll
            for (int ni = 0; ni < 8; ++ni) {
                const int u0 = wn * 8 + ni;
                const s16x4 lo = lds_tr(base + b_rd[0] + ((u0 ^ b_f[0]) << 5));
                const s16x4 hi = lds_tr(base + b_rd[1] + ((u0 ^ b_f[1]) << 5));
                const bf16x8 bfr = (bf16x8){lo[0], lo[1], lo[2], lo[3], hi[0], hi[1], hi[2], hi[3]};
#pragma unroll
                for (int mi = 0; mi < 4; ++mi) acc[mi][ni] = __builtin_amdgcn_mfma_f32_16x16x32_bf16(bfr, af[mi], acc[mi][ni], 0, 0, 0);
            }
        };
        gload(0, ra0, rb0); gload(1, ra1, rb1);
        lstore(0, ra0, rb0); __syncthreads();
        for (int kt = 0; kt < KT; kt += 2) {
            gload(kt + 2 < KT ? kt + 2 : KT - 1, ra0, rb0);
            __builtin_amdgcn_sched_barrier(0);
            compute(0);
            lstore(1, ra1, rb1);
            __syncthreads();
            gload(kt + 3 < KT ? kt + 3 : KT - 1, ra1, rb1);
            __builtin_amdgcn_sched_barrier(0);
            compute(1);
            lstore(0, ra0, rb0);
            __syncthreads();
        }
    }

    template <class F> static __device__ __forceinline__ void run_stream(F& f, int NSEG, int KT, int a_kstride, size_t b_kstride, LAS unsigned char* lds) {
        const int tid = opaque_tid(), lane = tid & 63, wid = tid >> 6, wm = wid >> 1, wn = wid & 1, fr = lane & 15, fq = lane >> 4;
        f32x4 acc[4][8];
#pragma unroll
        for (int mi = 0; mi < 4; ++mi)
#pragma unroll
            for (int ni = 0; ni < 8; ++ni) acc[mi][ni] = (f32x4){0.f, 0.f, 0.f, 0.f};
        int a_wr[2], b_wr[2];
#pragma unroll
        for (int i = 0; i < 2; ++i) { const int row = a_row(i, tid); a_wr[i] = row * 64 + (((tid & 3) ^ ((row >> 1) & 3)) << 4);
            const int k = b_k(i, tid), n = (tid & 31) * 8; b_wr[i] = A_BYTES + k * 512 + (((n >> 4) ^ fk2(k)) << 5) + ((n & 15) << 1); }
        int a_rd[4];
#pragma unroll
        for (int mi = 0; mi < 4; ++mi) { const int row = wm * 64 + mi * 16 + fr; a_rd[mi] = row * 64 + ((fq ^ ((row >> 1) & 3)) << 4); }
        int b_rd[2], b_f[2];
#pragma unroll
        for (int t = 0; t < 2; ++t) { const int k = 8 * fq + 4 * t + (fr >> 2); b_f[t] = fk2(k); b_rd[t] = A_BYTES + k * 512 + ((fr & 3) << 3); }
        const bf16_t* aptr[2]; const bf16_t* bptr[2];
        u32x4 ra0[2], rb0[2], ra1[2], rb1[2];
        int lseg = 0, lkt = 0;
        auto gload = [&](u32x4 (&ra)[2], u32x4 (&rb)[2]) {
#pragma unroll
            for (int i = 0; i < 2; ++i) { ra[i] = *(const u32x4*)(aptr[i] + (size_t)lkt * a_kstride); rb[i] = *(const u32x4*)(bptr[i] + (size_t)lkt * b_kstride); }
            if (lkt + 1 < KT) ++lkt; else if (lseg + 1 < NSEG) { lkt = 0; ++lseg; f.ptrs(lseg, aptr, bptr); }
        };
        auto lstore = [&](int buf, const u32x4 (&ra)[2], const u32x4 (&rb)[2]) {
            LAS unsigned char* base = lds + buf * STAGE;
#pragma unroll
            for (int i = 0; i < 2; ++i) { *(LAS u32x4*)(base + a_wr[i]) = ra[i]; *(LAS u32x4*)(base + b_wr[i]) = rb[i]; }
        };
        auto compute = [&](int buf) {
            const LAS unsigned char* base = lds + buf * STAGE;
            bf16x8 af[4];
#pragma unroll
            for (int mi = 0; mi < 4; ++mi) af[mi] = *(const LAS bf16x8*)(base + a_rd[mi]);
#pragma unroll
            for (int ni = 0; ni < 8; ++ni) {
                const int u0 = wn * 8 + ni;
                const s16x4 lo = lds_tr(base + b_rd[0] + ((u0 ^ b_f[0]) << 5));
                const s16x4 hi = lds_tr(base + b_rd[1] + ((u0 ^ b_f[1]) << 5));
                const bf16x8 bfr = (bf16x8){lo[0], lo[1], lo[2], lo[3], hi[0], hi[1], hi[2], hi[3]};
#pragma unroll
                for (int mi = 0; mi < 4; ++mi) acc[mi][ni] = __builtin_amdgcn_mfma_f32_16x16x32_bf16(bfr, af[mi], acc[mi][ni], 0, 0, 0);
            }
        };
        f.ptrs(0, aptr, bptr);
        gload(ra0, rb0); gload(ra1, rb1);
        lstore(0, ra0, rb0); __syncthreads();
        int cseg = 0, ckt = 0;
        const int total = NSEG * KT;
#pragma unroll 1
        for (int g = 0; g < total; g += 2) {
            gload(ra0, rb0);
            __builtin_amdgcn_sched_barrier(0);
            compute(0);
            lstore(1, ra1, rb1);
            __syncthreads();
            gload(ra1, rb1);
            __builtin_amdgcn_sched_barrier(0);
            compute(1);
            lstore(0, ra0, rb0);
            __syncthreads();
            ckt += 2;
            if (ckt == KT) {
                f.epi(cseg, acc);
#pragma unroll
                for (int mi = 0; mi < 4; ++mi)
#pragma unroll
                    for (int ni = 0; ni < 8; ++ni) acc[mi][ni] = (f32x4){0.f, 0.f, 0.f, 0.f};
                ckt = 0; ++cseg;
            }
        }
    }
};

template <bool BF32> struct Gemm5 {
    static constexpr int A_BYTES = 16384, STAGE = 32768, LDS_BYTES = 2 * STAGE;
    static __device__ __forceinline__ int fk2(int r) { return (r & 3) | (((r >> 3) & 1) << 2); }
    static __device__ __forceinline__ int a_row(int i, int tid) { return (tid >> 2) + 128 * i; }
    static __device__ __forceinline__ int b_k(int i, int tid) { return (tid >> 5) + 16 * i; }
    typedef typename std::conditional<BF32, float, bf16_t>::type b_t;
    static __device__ __forceinline__ void run(f32x4 (&acc)[4][8], const bf16_t* const (&aptr)[2], int a_kstride, const b_t* const (&bptr)[2], size_t b_kstride, int KT, LAS unsigned char* lds) {
        const int tid = opaque_tid(), lane = tid & 63, wid = tid >> 6, wm = wid >> 1, wn = wid & 1, fr = lane & 15, fq = lane >> 4;
#pragma unroll
        for (int mi = 0; mi < 4; ++mi)
#pragma unroll
            for (int ni = 0; ni < 8; ++ni) acc[mi][ni] = (f32x4){0.f, 0.f, 0.f, 0.f};
        int a_wr[2], b_wr[2];
#pragma unroll
        for (int i = 0; i < 2; ++i) { const int row = a_row(i, tid); a_wr[i] = row * 64 + (((tid & 3) ^ ((row >> 1) & 3)) << 4);
            const int k = b_k(i, tid), n = (tid & 31) * 8; b_wr[i] = A_BYTES + k * 512 + (((n >> 4) ^ fk2(k)) << 5) + ((n & 15) << 1); }
        int a_rd[4];
#pragma unroll
        for (int mi = 0; mi < 4; ++mi) { const int row = wm * 64 + mi * 16 + fr; a_rd[mi] = row * 64 + ((fq ^ ((row >> 1) & 3)) << 4); }
        int b_rd[2], b_f[2];
#pragma unroll
        for (int t = 0; t < 2; ++t) { const int k = 8 * fq + 4 * t + (fr >> 2); b_f[t] = fk2(k); b_rd[t] = A_BYTES + k * 512 + ((fr & 3) << 3); }
        u32x4 ra[2]; u32x4 rb[2]; f32x4 rbf[2][2];
        auto gload = [&](int kt) {
#pragma unroll
            for (int i = 0; i < 2; ++i) { ra[i] = *(const u32x4*)(aptr[i] + (size_t)kt * a_kstride);
                if (BF32) { const float* p = (const float*)bptr[i] + (size_t)kt * b_kstride; rbf[i][0] = *(const f32x4*)p; rbf[i][1] = *(const f32x4*)(p + 4); }
                else rb[i] = *(const u32x4*)((const bf16_t*)bptr[i] + (size_t)kt * b_kstride); }
        };
        auto lstore = [&](int buf) {
            LAS unsigned char* base = lds + buf * STAGE;
#pragma unroll
            for (int i = 0; i < 2; ++i) { *(LAS u32x4*)(base + a_wr[i]) = ra[i];
                if (BF32) { u32x4 w; w.x = cvtpk(rbf[i][0].x, rbf[i][0].y); w.y = cvtpk(rbf[i][0].z, rbf[i][0].w); w.z = cvtpk(rbf[i][1].x, rbf[i][1].y); w.w = cvtpk(rbf[i][1].z, rbf[i][1].w); *(LAS u32x4*)(base + b_wr[i]) = w; }
                else *(LAS u32x4*)(base + b_wr[i]) = rb[i]; }
        };
        auto compute = [&](int buf) {
            const LAS unsigned char* base = lds + buf * STAGE;
            bf16x8 af[4];
#pragma unroll
            for (int mi = 0; mi < 4; ++mi) af[mi] = *(const LAS bf16x8*)(base + a_rd[mi]);
#pragma unroll
            for (int ni = 0; ni < 8; ++ni) {
                const int u0 = wn * 8 + ni;
                const s16x4 lo = lds_tr(base + b_rd[0] + ((u0 ^ b_f[0]) << 5));
                const s16x4 hi = lds_tr(base + b_rd[1] + ((u0 ^ b_f[1]) << 5));
                const bf16x8 bfr = (bf16x8){lo[0], lo[1], lo[2], lo[3], hi[0], hi[1], hi[2], hi[3]};
#pragma unroll
                for (int mi = 0; mi < 4; ++mi) acc[mi][ni] = __builtin_amdgcn_mfma_f32_16x16x32_bf16(bfr, af[mi], acc[mi][ni], 0, 0, 0);
            }
        };
        gload(0); lstore(0); __syncthreads();
#pragma unroll 1
        for (int kt = 0; kt < KT; ++kt) {
            gload(kt + 1 < KT ? kt + 1 : KT - 1);
            __builtin_amdgcn_sched_barrier(0);
            compute(kt & 1);
            lstore((kt + 1) & 1);
            __syncthreads();
        }
    }

    template <class F> static __device__ __forceinline__ void run_stream(F& f, int NSEG, int KT, int a_kstride, size_t b_kstride, LAS unsigned char* lds) {
        const int tid = opaque_tid(), lane = tid & 63, wid = tid >> 6, wm = wid >> 1, wn = wid & 1, fr = lane & 15, fq = lane >> 4;
        f32x4 acc[4][8];
#pragma unroll
        for (int mi = 0; mi < 4; ++mi)
#pragma unroll
            for (int ni = 0; ni < 8; ++ni) acc[mi][ni] = (f32x4){0.f, 0.f, 0.f, 0.f};
        int a_wr[2], b_wr[2];
#pragma unroll
        for (int i = 0; i < 2; ++i) { const int row = a_row(i, tid); a_wr[i] = row * 64 + (((tid & 3) ^ ((row >> 1) & 3)) << 4);
            const int k = b_k(i, tid), n = (tid & 31) * 8; b_wr[i] = A_BYTES + k * 512 + (((n >> 4) ^ fk2(k)) << 5) + ((n & 15) << 1); }
        int a_rd[4];
#pragma unroll
        for (int mi = 0; mi < 4; ++mi) { const int row = wm * 64 + mi * 16 + fr; a_rd[mi] = row * 64 + ((fq ^ ((row >> 1) & 3)) << 4); }
        int b_rd[2], b_f[2];
#pragma unroll
        for (int t = 0; t < 2; ++t) { const int k = 8 * fq + 4 * t + (fr >> 2); b_f[t] = fk2(k); b_rd[t] = A_BYTES + k * 512 + ((fr & 3) << 3); }
        const bf16_t* aptr[2]; const b_t* bptr[2];
        u32x4 ra[2]; u32x4 rb[2]; f32x4 rbf[2][2];
        auto gload = [&](int kt) {
#pragma unroll
            for (int i = 0; i < 2; ++i) { ra[i] = *(const u32x4*)(aptr[i] + (size_t)kt * a_kstride);
                if (BF32) { const float* p = (const float*)bptr[i] + (size_t)kt * b_kstride; rbf[i][0] = *(const f32x4*)p; rbf[i][1] = *(const f32x4*)(p + 4); }
                else rb[i] = *(const u32x4*)((const bf16_t*)bptr[i] + (size_t)kt * b_kstride); }
        };
        auto lstore = [&](int buf) {
            LAS unsigned char* base = lds + buf * STAGE;
#pragma unroll
            for (int i = 0; i < 2; ++i) { *(LAS u32x4*)(base + a_wr[i]) = ra[i];
                if (BF32) { u32x4 w; w.x = cvtpk(rbf[i][0].x, rbf[i][0].y); w.y = cvtpk(rbf[i][0].z, rbf[i][0].w); w.z = cvtpk(rbf[i][1].x, rbf[i][1].y); w.w = cvtpk(rbf[i][1].z, rbf[i][1].w); *(LAS u32x4*)(base + b_wr[i]) = w; }
                else *(LAS u32x4*)(base + b_wr[i]) = rb[i]; }
        };
        auto compute = [&](int buf) {
            const LAS unsigned char* base = lds + buf * STAGE;
            bf16x8 af[4];
#pragma unroll
            for (int mi = 0; mi < 4; ++mi) af[mi] = *(const LAS bf16x8*)(base + a_rd[mi]);
#pragma unroll
            for (int ni = 0; ni < 8; ++ni) {
                const int u0 = wn * 8 + ni;
                const s16x4 lo = lds_tr(base + b_rd[0] + ((u0 ^ b_f[0]) << 5));
                const s16x4 hi = lds_tr(base + b_rd[1] + ((u0 ^ b_f[1]) << 5));
                const bf16x8 bfr = (bf16x8){lo[0], lo[1], lo[2], lo[3], hi[0], hi[1], hi[2], hi[3]};
#pragma unroll
                for (int mi = 0; mi < 4; ++mi) acc[mi][ni] = __builtin_amdgcn_mfma_f32_16x16x32_bf16(bfr, af[mi], acc[mi][ni], 0, 0, 0);
            }
        };
        f.ptrs(0, aptr, bptr);
        gload(0); lstore(0); __syncthreads();
        int seg = 0, kt = 0;
        const int total = NSEG * KT;
#pragma unroll 1
        for (int g = 0; g < total; ++g) {
            int nkt = kt + 1, nsg = seg; if (nkt == KT) { nkt = 0; nsg = seg + 1; }
            if (nkt == 0 && nsg < NSEG) f.ptrs(nsg, aptr, bptr);
            gload(nsg < NSEG ? nkt : KT - 1);
            __builtin_amdgcn_sched_barrier(0);
            compute(g & 1);
            lstore((g + 1) & 1);
            __syncthreads();
            if (nkt == 0) {
                f.epi(seg, acc);
#pragma unroll
                for (int mi = 0; mi < 4; ++mi)
#pragma unroll
                    for (int ni = 0; ni < 8; ++ni) acc[mi][ni] = (f32x4){0.f, 0.f, 0.f, 0.f};
            }
            seg = nsg; kt = nkt;
        }
    }
};

__device__ __forceinline__ void phase_mod(const Params& P, LAS unsigned char* lds) {
    const int tid = threadIdx.x;
    float* mod = (float*)(P.ws + WS_MOD);
    LAS float* sc = (LAS float*)lds;
    LAS float* red = (LAS float*)(lds + 16384);
    for (int i = tid; i < 4096; i += NTHREADS) sc[i] = siluf_(P.c[i]);
    __syncthreads();
    const int kq = tid >> 5, cl = tid & 31;
    for (int u = blockIdx.x; u < 192; u += gridDim.x) {
        const int j = u * 32 + cl;
        float a0 = 0.f, a1 = 0.f, a2 = 0.f, a3 = 0.f;
#pragma unroll 8
        for (int k = kq; k < 1024; k += 16) { const float w = P.ada_w[(size_t)k * 6144 + j];
            a0 += sc[k] * w; a1 += sc[1024 + k] * w; a2 += sc[2048 + k] * w; a3 += sc[3072 + k] * w; }
        red[(kq * 4 + 0) * 32 + cl] = a0; red[(kq * 4 + 1) * 32 + cl] = a1; red[(kq * 4 + 2) * 32 + cl] = a2; red[(kq * 4 + 3) * 32 + cl] = a3;
        __syncthreads();
        if (tid < 128) { const int b = tid >> 5; float s = 0.f;
#pragma unroll
            for (int q = 0; q < 16; ++q) s += red[(q * 4 + b) * 32 + cl];
            mod[b * 6144 + j] = s + P.ada_b[j]; }
        __syncthreads();
    }
    for (int u = blockIdx.x; u < 16; u += gridDim.x) {
        const int sel = u >> 3, j = (u & 7) * 32 + cl;
        const float* w1 = P.cmp_w1 + (size_t)sel * 2048 * 256; const float* pos = P.cmp_pos + sel * 2048;
        float a0 = 0.f;
#pragma unroll 8
        for (int k = kq; k < 2048; k += 16) a0 += pos[k] * w1[(size_t)k * 256 + j];
        red[kq * 32 + cl] = a0;
        __syncthreads();
        if (tid < 32) { float s = 0.f;
#pragma unroll
            for (int q = 0; q < 16; ++q) s += red[q * 32 + cl];
            ((float*)(P.ws + WS_CB))[sel * 256 + j] = s + P.cmp_b1[sel * 256 + j]; }
        __syncthreads();
    }
    {
        bf16_t* wb = (bf16_t*)(P.ws + WS_WIN);
        const int gt = blockIdx.x * NTHREADS + tid, NG = gridDim.x * NTHREADS;
        for (int i = gt; i < 1024 * (3584 / 8); i += NG) { const int k = i / 448, c8 = (i % 448) * 8;
            const int sc_ = c8 < 1280 ? c8 : (c8 < 3328 ? c8 + 24 : c8 - 2048);
            u32x4 o = (u32x4){0u, 0u, 0u, 0u};
            if (c8 < 3352) { const f32x4 a = *(const f32x4*)(P.w_in + (size_t)k * IN_COLS + sc_), b2 = *(const f32x4*)(P.w_in + (size_t)k * IN_COLS + sc_ + 4);
                o.x = cvtpk(a.x, a.y); o.y = cvtpk(a.z, a.w); o.z = cvtpk(b2.x, b2.y); o.w = cvtpk(b2.z, b2.w); }
            *(u32x4*)(wb + (size_t)k * 3584 + c8) = o; }
    }
    if (blockIdx.x == gridDim.x - 2) {
        for (int i = tid; i < 2 * 8 * 64; i += NTHREADS) { const int t2 = i >> 9, bg = (i >> 6) & 7, d = i & 63;
            ((bf16_t*)(P.ws + (t2 ? WS_VC : WS_KC)))[((size_t)bg * 512 + 511) * 64 + d] = 0; }
    }
    if (blockIdx.x == gridDim.x - 1) {
        float* lb = (float*)(P.ws + WS_LB);
        for (int i = tid; i < 512; i += NTHREADS) { const float p0 = P.hgrn_lb[i], p1 = P.hgrn_lb[512 + i]; lb[i] = 1.0f / (1.0f + __expf(p1 - p0)); }
    }
}

__device__ __forceinline__ void norm_mod_rows(const float* x, const float* w, const float* mod_sh, const float* mod_sc, bf16_t* h, int hs) {
    const int lane = threadIdx.x & 63, gw = blockIdx.x * (NTHREADS / 64) + (threadIdx.x >> 6), NGW = gridDim.x * (NTHREADS / 64);
    for (int m = gw; m < T; m += NGW) {
        const int b = m / SEQ;
        const f32x4* xr = (const f32x4*)(x + (size_t)m * D) + lane;
        f32x4 v[4]; float s = 0.f;
#pragma unroll
        for (int j = 0; j < 4; ++j) { v[j] = xr[64 * j]; s += (v[j].x * v[j].x + v[j].y * v[j].y) + (v[j].z * v[j].z + v[j].w * v[j].w); }
        const float rstd = rsqrtf(wave_sum(s) * (1.f / D) + RMS_EPS);
        u32x2* o = (u32x2*)(h + (size_t)m * hs) + lane;
#pragma unroll
        for (int j = 0; j < 4; ++j) {
            const int col = (lane + 64 * j) * 4;
            const f32x4 wv = *(const f32x4*)(w + col), scv = *(const f32x4*)(mod_sc + b * 6144 + col), shv = *(const f32x4*)(mod_sh + b * 6144 + col);
            f32x4 r;
            r.x = v[j].x * rstd * wv.x * (1.f + scv.x) + shv.x; r.y = v[j].y * rstd * wv.y * (1.f + scv.y) + shv.y;
            r.z = v[j].z * rstd * wv.z * (1.f + scv.z) + shv.z; r.w = v[j].w * rstd * wv.w * (1.f + scv.w) + shv.w;
            u32x2 pk; pk.x = cvtpk(r.x, r.y); pk.y = cvtpk(r.z, r.w); o[64 * j] = pk;
        }
    }
}

__device__ __forceinline__ void phase_inproj(const Params& P, LAS unsigned char* lds) {
    const int tid = opaque_tid(), lane = tid & 63, wid = tid >> 6, wm = wid >> 1, wn = wid & 1, fr = lane & 15, fq = lane >> 4;
    const bf16_t* h1 = (const bf16_t*)(P.ws + WS_H); const bf16_t* wb = (const bf16_t*)(P.ws + WS_WIN);
    bf16_t* qo = (bf16_t*)(P.ws + WS_Q); bf16_t* kvo = (bf16_t*)(P.ws + WS_KV); float* gates = (float*)(P.ws + WS_GATES);
    bf16_t* hq = (bf16_t*)(P.ws + WS_HQ); float* logf = (float*)(P.ws + WS_LOGF); bf16_t* hv = (bf16_t*)(P.ws + WS_HV); bf16_t* hg = (bf16_t*)(P.ws + WS_HG);
    const float* lb = (const float*)(P.ws + WS_LB);
    constexpr int NRT = T / 256, NCT = 14;
    const int nx = (gridDim.x % 8 == 0) ? 8 : 1, xl = blockIdx.x % nx, li = blockIdx.x / nx, nloc = gridDim.x / nx;
    for (int v = li; v < (NRT / nx) * NCT; v += nloc) {
        const int rg = v / (NCT * 4), rem = v % (NCT * 4), ct = rem >> 2, rt = xl + nx * (rg * 4 + (rem & 3));
        const bf16_t* aptr[2]; const bf16_t* bptr[2];
#pragma unroll
        for (int i = 0; i < 2; ++i) { aptr[i] = h1 + (size_t)(rt * 256 + Gemm4::a_row(i, tid)) * H1S + 8 * (tid & 3);
            bptr[i] = wb + (size_t)Gemm4::b_k(i, tid) * 3584 + ct * 256 + 8 * (tid & 31); }
        f32x4 acc[4][8];
        Gemm4::run(acc, aptr, 32, bptr, (size_t)32 * 3584, D / 32, lds);
        const int row0 = rt * 256 + wm * 64 + fr;
        const int cw = wn * 128 + 4 * fq;
        if (ct < 5) {
            const bool is_q = ct < 2; const int seg = (ct - 2) * 2 + wn;
            const bool do_norm = is_q || seg == 2 || seg == 4;
            const float* nw = is_q ? P.q_norm_w : (P.k_norm_w + (seg == 2 ? 64 : 128));
            const float osc = is_q ? 0.125f : 1.0f;
#pragma unroll
            for (int hh = 0; hh < 2; ++hh) {
                f32x4 wv[4];
#pragma unroll
                for (int n4 = 0; n4 < 4; ++n4) wv[n4] = do_norm ? *(const f32x4*)(nw + n4 * 16 + 4 * fq) : (f32x4){1.f, 1.f, 1.f, 1.f};
#pragma unroll
                for (int mi = 0; mi < 4; ++mi) {
                    float rstd = 1.f;
                    if (do_norm) { float s = 0.f;
#pragma unroll
                        for (int n4 = 0; n4 < 4; ++n4) { const f32x4 a = acc[mi][hh * 4 + n4]; s += (a.x * a.x + a.y * a.y) + (a.z * a.z + a.w * a.w); }
                        s += __shfl_xor(s, 16); s += __shfl_xor(s, 32);
                        rstd = rsqrtf(s * (1.f / 64.f) + RMS_EPS) * osc; }
                    const size_t m = (size_t)(row0 + mi * 16);
                    bf16_t* dst = is_q ? (qo + m * 512 + ct * 256 + cw + hh * 64) : (kvo + m * 768 + (ct - 2) * 256 + cw + hh * 64);
#pragma unroll
                    for (int n4 = 0; n4 < 4; ++n4) { const f32x4 a = acc[mi][hh * 4 + n4]; u32x2 pk;
                        pk.x = cvtpk(a.x * rstd * wv[n4].x, a.y * rstd * wv[n4].y); pk.y = cvtpk(a.z * rstd * wv[n4].z, a.w * rstd * wv[n4].w);
                        *(u32x2*)(dst + n4 * 16) = pk; }
                }
            }
        } else if (ct == 13) {
            if (wn == 0) {
#pragma unroll
                for (int mi = 0; mi < 4; ++mi) { const size_t m = (size_t)(row0 + mi * 16);
#pragma unroll
                    for (int ni = 0; ni < 2; ++ni) { const int c = ni * 16 + 4 * fq; if (c < 24) { const f32x4 a = acc[mi][ni];
                            *(f32x4*)(gates + m * 24 + c) = (f32x4){sigmoidf_(a.x), sigmoidf_(a.y), sigmoidf_(a.z), sigmoidf_(a.w)}; } } }
            }
        } else {
            const int hs = (ct - 5) >> 1, cc = ((ct - 5) & 1) * 256 + cw;
#pragma unroll
            for (int mi = 0; mi < 4; ++mi) { const size_t m = (size_t)(row0 + mi * 16);
#pragma unroll
                for (int ni = 0; ni < 8; ++ni) { const f32x4 a = acc[mi][ni]; const int c = cc + ni * 16;
                    if (hs == 0) { const float s = 0.08838834764831845f; u32x2 pk; pk.x = cvtpk(siluf_(a.x) * s, siluf_(a.y) * s); pk.y = cvtpk(siluf_(a.z) * s, siluf_(a.w) * s); *(u32x2*)(hq + m * 512 + c) = pk; }
                    else if (hs == 1) { const f32x4 l = *(const f32x4*)(lb + c); f32x4 o;
                        o.x = __logf(l.x + (1.f - l.x) * sigmoidf_(a.x)); o.y = __logf(l.y + (1.f - l.y) * sigmoidf_(a.y));
                        o.z = __logf(l.z + (1.f - l.z) * sigmoidf_(a.z)); o.w = __logf(l.w + (1.f - l.w) * sigmoidf_(a.w)); *(f32x4*)(logf + m * 512 + c) = o; }
                    else if (hs == 2) { u32x2 pk; pk.x = cvtpk(a.x, a.y); pk.y = cvtpk(a.z, a.w); *(u32x2*)(hv + m * 512 + c) = pk; }
                    else { u32x2 pk; pk.x = cvtpk(sigmoidf_(a.x), sigmoidf_(a.y)); pk.y = cvtpk(sigmoidf_(a.z), sigmoidf_(a.w)); *(u32x2*)(hg + m * 512 + c) = pk; }
                } }
        }
    }
}

__device__ __forceinline__ float gelu_tanh(float x) {
    const float u = 0.7978845608028654f * (x + 0.044715f * x * x * x);
    const float th = 1.0f - 2.0f / (1.0f + __expf(2.0f * u));
    return 0.5f * x * (1.0f + th);
}
__device__ __forceinline__ void compress_unit(const Params& P, LAS unsigned char* lds, int u) {
    typedef GemmT<2, 4> G;
    const int tid = opaque_tid(), lane = tid & 63, wid = tid >> 6, wm = wid >> 2, wn = wid & 3, fr = lane & 15, fq = lane >> 4;
    const int sel = u >> 5, rt = u & 31;
    const bf16_t* kv = (const bf16_t*)(P.ws + WS_KV);
    bf16_t* cmph = (bf16_t*)(P.ws + WS_CMPH) + (size_t)sel * 4096 * 256;
    const float* cb = (const float*)(P.ws + WS_CB) + sel * 256;
    const bf16_t* arow[2];
#pragma unroll
    for (int p = 0; p < 2; ++p) { int r = rt * 128 + p * 64 + (tid >> 3); r = r < 4088 ? r : 4087;
        const int b = r / 1022, rem = r % 1022, i = rem >> 1, g = rem & 1;
        arow[p] = kv + (size_t)(b * SEQ + 16 * i) * 768 + sel * 128 + g * 64; }
    f32x4 acc[4][4];
    G::run(acc, arow, 768, P.cmp_w1 + (size_t)sel * 2048 * 256, 256, 32, lds);
#pragma unroll
    for (int mi = 0; mi < 4; ++mi) { const size_t row = (size_t)(rt * 128 + wm * 64 + mi * 16 + fr);
#pragma unroll
        for (int ni = 0; ni < 4; ++ni) { const int col = wn * 64 + ni * 16 + 4 * fq; const f32x4 a = acc[mi][ni]; const f32x4 bb = *(const f32x4*)(cb + col);
            u32x2 pk; pk.x = cvtpk(gelu_tanh(a.x + bb.x), gelu_tanh(a.y + bb.y)); pk.y = cvtpk(gelu_tanh(a.z + bb.z), gelu_tanh(a.w + bb.w));
            *(u32x2*)(cmph + row * 256 + col) = pk; } }
    __syncthreads();
    {
        const int row = tid >> 2, cq = tid & 3;
        const bf16_t* hr = cmph + (size_t)(rt * 128 + row) * 256;
        const float* w2 = P.cmp_w2 + (size_t)sel * 256 * 64 + cq * 16;
        float o[16];
#pragma unroll
        for (int j = 0; j < 16; ++j) o[j] = 0.f;
        for (int k8 = 0; k8 < 256; k8 += 8) {
            const u32x4 hv = *(const u32x4*)(hr + k8);
#pragma unroll
            for (int kk = 0; kk < 8; ++kk) {
                const unsigned wd = hv[kk >> 1]; const float a = (kk & 1) ? __uint_as_float(wd & 0xffff0000u) : __uint_as_float(wd << 16);
                const float* wr = w2 + (size_t)(k8 + kk) * 64;
#pragma unroll
                for (int j4 = 0; j4 < 4; ++j4) { const f32x4 w = *(const f32x4*)(wr + j4 * 4);
                    o[j4 * 4 + 0] += a * w.x; o[j4 * 4 + 1] += a * w.y; o[j4 * 4 + 2] += a * w.z; o[j4 * 4 + 3] += a * w.w; }
            }
        }
        if (sel == 0) { float s = 0.f;
#pragma unroll
            for (int j = 0; j < 16; ++j) s += o[j] * o[j];
            s += __shfl_xor(s, 1); s += __shfl_xor(s, 2);
            const float rstd = rsqrtf(s * (1.f / 64.f) + RMS_EPS);
#pragma unroll
            for (int j = 0; j < 16; ++j) o[j] *= rstd * P.k_norm_w[cq * 16 + j]; }
        const int r = rt * 128 + row;
        if (r < 4088) { const int b = r / 1022, rem = r % 1022, i = rem >> 1, g = rem & 1;
            bf16_t* dst = (bf16_t*)(P.ws + (sel ? WS_VC : WS_KC)) + ((size_t)(b * 2 + g) * 512 + i) * 64 + cq * 16;
            u32x4 w0, w1;
            w0.x = cvtpk(o[0], o[1]); w0.y = cvtpk(o[2], o[3]); w0.z = cvtpk(o[4], o[5]); w0.w = cvtpk(o[6], o[7]);
            w1.x = cvtpk(o[8], o[9]); w1.y = cvtpk(o[10], o[11]); w1.z = cvtpk(o[12], o[13]); w1.w = cvtpk(o[14], o[15]);
            *(u32x4*)dst = w0; *(u32x4*)(dst + 8) = w1; }
    }
    __syncthreads();
}

__device__ __forceinline__ int off_row128(int row, int ch) { return row * 128 + ((ch ^ ((row >> 1) & 7)) << 4); }
__device__ __forceinline__ int off_row256(int row, int ch) { return row * 256 + ((ch ^ (row & 15)) << 4); }
__device__ __forceinline__ int fk_(int r) { return (r & 3) | (((r >> 3) & 1) << 2); }
__device__ __forceinline__ int off_tr256(int row, int col) { return row * 256 + ((((col >> 4) ^ fk_(row)) << 5) + ((col & 15) << 1)); }
constexpr int HL_QT = 0, HL_KT = 16384, HL_KH = 32768, HL_V = 49152, HL_SB = 65536, HL_P = 98304  , HL_TOT = 106496  , HL_RED = 110592  , HL_END = 111104;

template <int MODE> __device__ __forceinline__ void hgrn_unit(const Params& P, LAS unsigned char* lds, int u) {
    const int tid = opaque_tid(), lane = tid & 63, wid = tid >> 6, fr = lane & 15, fq = lane >> 4;
    const int b = u >> 7, h = (u >> 5) & 3, sc = u & 31;
    const bf16_t* hq = (const bf16_t*)(P.ws + WS_HQ); const float* logf = (const float*)(P.ws + WS_LOGF);
    const bf16_t* hv = (const bf16_t*)(P.ws + WS_HV); const bf16_t* hg = (const bf16_t*)(P.ws + WS_HG);
    float* HLs = (float*)(P.ws + WS_HL); float* HDs = (float*)(P.ws + WS_HD);
    bf16_t* mix = (bf16_t*)(P.ws + WS_MIX);
    LAS float* tot = (LAS float*)(lds + HL_TOT); LAS float* red = (LAS float*)(lds + HL_RED);
    f32x4 st[8];
#pragma unroll
    for (int vt = 0; vt < 8; ++vt) st[vt] = (f32x4){0.f, 0.f, 0.f, 0.f};
    if (MODE == 1) {
        const int kk = 16 * wid + fr;
        for (int j = 0; j < sc; ++j) {
            const float* Lj = HLs + (size_t)(u - sc + j) * 16384 + kk * 128 + 4 * fq; const float dj = HDs[(size_t)(u - sc + j) * 128 + kk];
#pragma unroll
            for (int vt = 0; vt < 8; ++vt) { const f32x4 l = *(const f32x4*)(Lj + vt * 16); st[vt] = st[vt] * dj + l; }
        }
    }
    float dsum = 0.f;
    const int kp = tid & 63, te = tid >> 6;
    for (int c = 0; c < 4; ++c) {
        const size_t tok0 = (size_t)b * SEQ + sc * 256 + c * 64;
        float lf0[8], lf1[8], cs0[8], cs1[8];
        { float a0 = 0.f, a1 = 0.f;
#pragma unroll
          for (int i = 0; i < 8; ++i) { const float2 v = *(const float2*)(logf + (tok0 + te * 8 + i) * 512 + h * 128 + 2 * kp); lf0[i] = v.x; lf1[i] = v.y; a0 += v.x; a1 += v.y; cs0[i] = a0; cs1[i] = a1; }
          tot[te * 128 + 2 * kp] = a0; tot[te * 128 + 2 * kp + 1] = a1; }
#pragma unroll
        for (int i = 0; i < 2; ++i) { const int pc = tid + NTHREADS * i, row = pc >> 4, c8 = (pc & 15) * 8;
            const u32x4 v = *(const u32x4*)(hv + (tok0 + row) * 512 + h * 128 + c8);
            *(LAS u32x4*)(lds + HL_V + off_tr256(row, c8)) = v; }
        if (MODE == 1 ) {
#pragma unroll
            for (int vt = 0; vt < 8; ++vt) { u32x2 pk; pk.x = cvtpk(st[vt].x, st[vt].y); pk.y = cvtpk(st[vt].z, st[vt].w);
                *(LAS u32x2*)(lds + HL_SB + off_tr256(16 * wid + fr, 16 * vt + 4 * fq)) = pk; }
        }
        __syncthreads();
        float pre0 = 0.f, pre1 = 0.f, last0 = 0.f, last1 = 0.f;
#pragma unroll
        for (int e = 0; e < 8; ++e) { const float t0 = tot[e * 128 + 2 * kp], t1 = tot[e * 128 + 2 * kp + 1]; if (e < te) { pre0 += t0; pre1 += t1; } last0 += t0; last1 += t1; }
#pragma unroll
        for (int i = 0; i < 8; ++i) {
            const int t = te * 8 + i;
            const float c0 = cs0[i] + pre0, c1 = cs1[i] + pre1;
            const float k0 = 1.f - __expf(lf0[i]), k1 = 1.f - __expf(lf1[i]);
            const unsigned khat = cvtpk(k0 * __expf(last0 - c0), k1 * __expf(last1 - c1));
            *(LAS unsigned*)(lds + HL_KH + off_tr256(t, 2 * kp)) = khat;
            if (MODE == 1) {
                const unsigned qraw = *(const unsigned*)(hq + (tok0 + t) * 512 + h * 128 + 2 * kp);
                const float q0 = __uint_as_float(qraw << 16), q1 = __uint_as_float(qraw & 0xffff0000u);
                const unsigned qt = cvtpk(q0 * __expf(c0), q1 * __expf(c1));
                const unsigned kt = cvtpk(k0 * __expf(fminf(-c0, 80.f)), k1 * __expf(fminf(-c1, 80.f)));
                const int o = off_row256(t, kp >> 2) + ((kp & 3) << 2);
                *(LAS unsigned*)(lds + HL_QT + o) = qt; *(LAS unsigned*)(lds + HL_KT + o) = kt;
            }
        }
        const float dec = __expf(tot[0 * 128 + 16 * wid + fr] + tot[1 * 128 + 16 * wid + fr] + tot[2 * 128 + 16 * wid + fr] + tot[3 * 128 + 16 * wid + fr]
                                 + tot[4 * 128 + 16 * wid + fr] + tot[5 * 128 + 16 * wid + fr] + tot[6 * 128 + 16 * wid + fr] + tot[7 * 128 + 16 * wid + fr]);
        if (MODE == 0 && tid < 128) { float s = 0.f;
#pragma unroll
            for (int e = 0; e < 8; ++e) s += tot[e * 128 + tid];
            dsum += s; }
        __syncthreads();
        f32x4 oacc[4];
        if (MODE == 1) {
            { const int tt = wid & 3;
#pragma unroll
              for (int si = 0; si < 2; ++si) { const int stl = 2 * (wid >> 2) + si;
                  f32x4 sacc = (f32x4){0.f, 0.f, 0.f, 0.f};
                  if (stl <= tt) {
#pragma unroll
                      for (int ks = 0; ks < 4; ++ks) {
                          const bf16x8 a = *(const LAS bf16x8*)(lds + HL_KT + off_row256(stl * 16 + fr, ks * 4 + fq));
                          const bf16x8 bq = *(const LAS bf16x8*)(lds + HL_QT + off_row256(tt * 16 + fr, ks * 4 + fq));
                          sacc = __builtin_amdgcn_mfma_f32_16x16x32_bf16(a, bq, sacc, 0, 0, 0);
                      }
                  }
                  const int t = tt * 16 + fr, s0 = stl * 16 + 4 * fq;
                  u32x2 pk; pk.x = cvtpk(s0 + 0 <= t ? sacc.x : 0.f, s0 + 1 <= t ? sacc.y : 0.f); pk.y = cvtpk(s0 + 2 <= t ? sacc.z : 0.f, s0 + 3 <= t ? sacc.w : 0.f);
                  *(LAS u32x2*)(lds + HL_P + off_row128(t, s0 >> 3) + ((s0 & 7) << 1)) = pk; }
            }
            __syncthreads();
            { const int tt = wid >> 1;
#pragma unroll
              for (int i = 0; i < 4; ++i) { const int vt = 4 * (wid & 1) + i;
                  f32x4 a = (f32x4){0.f, 0.f, 0.f, 0.f};
#pragma unroll
                  for (int ks = 0; ks < 2; ++ks) {
                      const int kr = ks * 32 + 8 * fq + (fr >> 2);
                      const s16x4 lo = lds_tr(lds + HL_V + off_tr256(kr, vt * 16 + 4 * (fr & 3))), hi = lds_tr(lds + HL_V + off_tr256(kr + 4, vt * 16 + 4 * (fr & 3)));
                      const bf16x8 va = (bf16x8){lo[0], lo[1], lo[2], lo[3], hi[0], hi[1], hi[2], hi[3]};
                      const bf16x8 pb = *(const LAS bf16x8*)(lds + HL_P + off_row128(tt * 16 + fr, ks * 4 + fq));
                      a = __builtin_amdgcn_mfma_f32_16x16x32_bf16(va, pb, a, 0, 0, 0);
                  }
#pragma unroll
                  for (int ks = 0; ks < 4; ++ks) {
                      const int kr = ks * 32 + 8 * fq + (fr >> 2);
                      const s16x4 lo = lds_tr(lds + HL_SB + off_tr256(kr, vt * 16 + 4 * (fr & 3))), hi = lds_tr(lds + HL_SB + off_tr256(kr + 4, vt * 16 + 4 * (fr & 3)));
                      const bf16x8 sa = (bf16x8){lo[0], lo[1], lo[2], lo[3], hi[0], hi[1], hi[2], hi[3]};
                      const bf16x8 qb = *(const LAS bf16x8*)(lds + HL_QT + off_row256(tt * 16 + fr, ks * 4 + fq));
                      a = __builtin_amdgcn_mfma_f32_16x16x32_bf16(sa, qb, a, 0, 0, 0);
                  }
                  const u32x2 gr = *(const u32x2*)(hg + (tok0 + tt * 16 + fr) * 512 + h * 128 + vt * 16 + 4 * fq);
                  a.x *= __uint_as_float(gr.x << 16); a.y *= __uint_as_float(gr.x & 0xffff0000u); a.z *= __uint_as_float(gr.y << 16); a.w *= __uint_as_float(gr.y & 0xffff0000u);
                  oacc[i] = a; }
              float ss = 0.f;
#pragma unroll
              for (int i = 0; i < 4; ++i) ss += (oacc[i].x * oacc[i].x + oacc[i].y * oacc[i].y) + (oacc[i].z * oacc[i].z + oacc[i].w * oacc[i].w);
              ss += __shfl_xor(ss, 16); ss += __shfl_xor(ss, 32);
              if (fq == 0) red[(tt * 2 + (wid & 1)) * 16 + fr] = ss; }
        }
#pragma unroll
        for (int vt = 0; vt < 8; ++vt) {
            f32x4 a = st[vt] * dec;
#pragma unroll
            for (int ks = 0; ks < 2; ++ks) {
                const int kr = ks * 32 + 8 * fq + (fr >> 2);
                const s16x4 lo = lds_tr(lds + HL_V + off_tr256(kr, vt * 16 + 4 * (fr & 3))), hi = lds_tr(lds + HL_V + off_tr256(kr + 4, vt * 16 + 4 * (fr & 3)));
                const bf16x8 va = (bf16x8){lo[0], lo[1], lo[2], lo[3], hi[0], hi[1], hi[2], hi[3]};
                const s16x4 lo2 = lds_tr(lds + HL_KH + off_tr256(kr, wid * 16 + 4 * (fr & 3))), hi2 = lds_tr(lds + HL_KH + off_tr256(kr + 4, wid * 16 + 4 * (fr & 3)));
                const bf16x8 kb = (bf16x8){lo2[0], lo2[1], lo2[2], lo2[3], hi2[0], hi2[1], hi2[2], hi2[3]};
                a = __builtin_amdgcn_mfma_f32_16x16x32_bf16(va, kb, a, 0, 0, 0);
            }
            st[vt] = a;
        }
        __syncthreads();
        if (MODE == 1) {
            const int tt = wid >> 1; const float ssum = red[(tt * 2) * 16 + fr] + red[(tt * 2 + 1) * 16 + fr];
            const float rstd = rsqrtf(ssum * (1.f / 128.f) + RMS_EPS);
#pragma unroll
            for (int i = 0; i < 4; ++i) { const int v = (4 * (wid & 1) + i) * 16 + 4 * fq; const f32x4 w = *(const f32x4*)(P.rec_out_norm_w + h * 128 + v);
                u32x2 pk; pk.x = cvtpk(oacc[i].x * rstd * w.x, oacc[i].y * rstd * w.y); pk.y = cvtpk(oacc[i].z * rstd * w.z, oacc[i].w * rstd * w.w);
                *(u32x2*)(mix + (tok0 + tt * 16 + fr) * 1024 + 512 + h * 128 + v) = pk; }
        }
    }
    if (MODE == 0) {
#pragma unroll
        for (int vt = 0; vt < 8; ++vt) *(f32x4*)(HLs + (size_t)u * 16384 + (16 * wid + fr) * 128 + vt * 16 + 4 * fq) = st[vt];
        if (tid < 128) HDs[(size_t)u * 128 + tid] = __expf(dsum);
    }
    __syncthreads();
}

__device__ __forceinline__ void phase_cmp_h1(const Params& P, LAS unsigned char* lds) {
    for (int u = blockIdx.x; u < 64 + 512; u += gridDim.x) {
        if (u < 64) compress_unit(P, lds, u); else hgrn_unit<0>(P, lds, u - 64);
    }
}


constexpr int NL_K = 0, NL_V = 16384, NL_IMP = 32768, NL_IMP_STRIDE = 132, NL_SELM = NL_IMP + 8 * 8 * NL_IMP_STRIDE * 4, NL_END = NL_SELM + 1024;
__device__ __forceinline__ int off_v128(int row, int ch) { return row * 128 + ((ch ^ ((row & 3) << 1)) << 4); }
#define MFMA32(a, b, c) __builtin_amdgcn_mfma_f32_32x32x16_bf16(a, b, c, 0, 0, 0)

struct NsaLane { int t; float sl2; int qi; unsigned long long mlo, mhi; };

template <int MODE> __device__ __forceinline__ void nsa_pass(LAS unsigned char* lds, const bf16_t* Kg, const bf16_t* Vg, int rs, unsigned long long ulo, unsigned long long uhi,
                                                            const bf16x8 (&qf)[4], const NsaLane& L, float inv, float& lsum, f32x16 (&O)[2], LAS float* impw) {
    const int tid = opaque_tid(), lane = tid & 63, hi = lane >> 5, c = lane & 31;
    const int ld_row = tid >> 3, ld_ch = tid & 7;
    const int kw_off = off_row128(ld_row, ld_ch), vw_off = off_v128(ld_row, ld_ch);
    u32x4 k0, v0, k1, v1, k2, v2;
    auto next = [&](int jj) -> int { ++jj; if (jj < 64) { const unsigned long long m = ulo >> jj; if (m) return jj + __builtin_ctzll(m); jj = 64; }
                                     if (jj < 128) { const unsigned long long m = uhi >> (jj - 64); if (m) return jj + __builtin_ctzll(m); } return 128; };
    int jA = next(-1), jB = jA < 128 ? next(jA) : 128, jC = jB < 128 ? next(jB) : 128;
    const int jsafe = jA < 128 ? jA : 0;
    auto ldk = [&](int jj) -> u32x4 { const int q = jj < 128 ? jj : jsafe; return *(const u32x4*)(Kg + (size_t)(q * 64 + ld_row) * rs + ld_ch * 8); };
    auto ldv = [&](int jj) -> u32x4 { const int q = jj < 128 ? jj : jsafe; return *(const u32x4*)(Vg + (size_t)(q * 64 + ld_row) * rs + ld_ch * 8); };
    k0 = ldk(jA); k1 = ldk(jB); k2 = ldk(jC);
    if (MODE != 0) { v0 = ldv(jA); v1 = ldv(jB); v2 = ldv(jC); }
    int it = 0;
    auto step = [&](u32x4& kreg, u32x4& vreg) {
        const int j = jA;
        LAS unsigned char* kb = lds + NL_K + (it & 1) * 8192; LAS unsigned char* vb = lds + NL_V + (it & 1) * 8192;
        *(LAS u32x4*)(kb + kw_off) = kreg; if (MODE != 0) *(LAS u32x4*)(vb + vw_off) = vreg;
        const int jD = jC < 128 ? next(jC) : 128;
        kreg = ldk(jD); if (MODE != 0) vreg = ldv(jD);
        __syncthreads();
        bool need = true; bool selbit = true;
        if (MODE == 2) { selbit = (j < 64 ? (L.mlo >> j) : (L.mhi >> (j - 64))) & 1ull; need = __any(selbit); }
        if (need) {
            f32x16 p0 = {}, p1 = {};
#pragma unroll
            for (int ks = 0; ks < 4; ++ks) {
                const bf16x8 a0 = *(const LAS bf16x8*)(kb + off_row128(c, 2 * ks + hi)), a1 = *(const LAS bf16x8*)(kb + off_row128(32 + c, 2 * ks + hi));
                p0 = MFMA32(a0, qf[ks], p0); p1 = MFMA32(a1, qf[ks], p1);
            }
            const int stride = (MODE <= 1) ? 16 : 1;
            const int dl = (MODE <= 1) ? (L.t - 31 - 16 * (j * 64 + 4 * hi)) : (L.t - (j * 64 + 4 * hi));
            const float nb = -L.sl2 * (float)dl, sls = L.sl2 * (float)stride;
            float rs_ = 0.f;
#pragma unroll
            for (int r = 0; r < 16; ++r) {
                const int ro0 = (r & 3) + 8 * (r >> 2), ro1 = ro0 + 32;
                const int d0 = dl - stride * ro0, d1 = dl - stride * ro1;
                bool v0 = d0 >= 0, v1 = d1 >= 0;
                if (MODE == 3) { v0 = v0 && d0 < 512; v1 = v1 && d1 < 512; }
                if (MODE == 2) { v0 = v0 && selbit; v1 = v1 && selbit; }
                float e0 = __builtin_amdgcn_exp2f(__builtin_fmaf(p0[r], LOG2E, __builtin_fmaf(sls, (float)ro0, nb)));
                float e1 = __builtin_amdgcn_exp2f(__builtin_fmaf(p1[r], LOG2E, __builtin_fmaf(sls, (float)ro1, nb)));
                e0 = v0 ? e0 : 0.f; e1 = v1 ? e1 : 0.f;
                if (MODE == 1) { e0 *= inv; e1 *= inv; }
                p0[r] = e0; p1[r] = e1; rs_ += e0 + e1;
            }
            lsum += rs_;
            if (MODE == 1) {
#pragma unroll
                for (int kt = 0; kt < 2; ++kt)
#pragma unroll
                    for (int i = 0; i < 4; ++i) {
                        float g = kt ? (p1[4 * i] + p1[4 * i + 1]) + (p1[4 * i + 2] + p1[4 * i + 3]) : (p0[4 * i] + p0[4 * i + 1]) + (p0[4 * i + 2] + p0[4 * i + 3]);
                        float l3 = kt ? p1[4 * i + 3] : p0[4 * i + 3];
                        g += __shfl_xor(g, 1); g += __shfl_xor(g, 2); l3 += __shfl_xor(l3, 1); l3 += __shfl_xor(l3, 2);
                        if ((c & 3) == 0) { const int jj = j * 16 + kt * 8 + 2 * i + hi; __hip_atomic_fetch_add(impw + L.qi * NL_IMP_STRIDE + jj, g, __ATOMIC_RELAXED, __HIP_MEMORY_SCOPE_WORKGROUP); __hip_atomic_fetch_add(impw + L.qi * NL_IMP_STRIDE + jj + 1, l3, __ATOMIC_RELAXED, __HIP_MEMORY_SCOPE_WORKGROUP); }
                    }
            }
            if (MODE != 0) {
                bf16x8 pf[4];
#pragma unroll
                for (int s4 = 0; s4 < 4; ++s4) { u32x4 w;
#pragma unroll
                    for (int e = 0; e < 4; ++e) { const int r = 8 * (s4 & 1) + 2 * e; w[e] = (s4 >> 1) ? cvtpk(p1[r], p1[r + 1]) : cvtpk(p0[r], p0[r + 1]); }
                    pf[s4] = __builtin_bit_cast(bf16x8, w); }
                const int g4 = lane >> 4, sub = g4 & 1, i16 = lane & 15, qq = i16 >> 2, pp = i16 & 3;
#pragma unroll
                for (int dt = 0; dt < 2; ++dt)
#pragma unroll
                    for (int s4 = 0; s4 < 4; ++s4) {
                        const int row = 16 * s4 + 4 * hi + qq, ch = 4 * dt + 2 * sub + (pp >> 1);
                        const s16x4 lo = lds_tr(vb + off_v128(row, ch) + 8 * (pp & 1)), hh = lds_tr(vb + off_v128(row + 8, ch) + 8 * (pp & 1));
                        const bf16x8 vf = (bf16x8){lo[0], lo[1], lo[2], lo[3], hh[0], hh[1], hh[2], hh[3]};
                        O[dt] = MFMA32(vf, pf[s4], O[dt]);
                    }
            }
        }
        jA = jB; jB = jC; jC = jD; ++it;
    };
    while (jA < 128) {
        step(k0, v0); if (jA >= 128) break;
        step(k1, v1); if (jA >= 128) break;
        step(k2, v2);
    }
    __syncthreads();
}

__device__ __forceinline__ void nsa_unit(const Params& P, LAS unsigned char* lds, int u) {
    const int tid = opaque_tid(), lane = tid & 63, wid = tid >> 6, hi = lane >> 5, c = lane & 31;
    const int b = u >> 8, g = (u >> 7) & 1, qb = u & 127;
    const bf16_t* qg = (const bf16_t*)(P.ws + WS_Q); const bf16_t* kv = (const bf16_t*)(P.ws + WS_KV);
    const bf16_t* kcn = (const bf16_t*)(P.ws + WS_KC) + (size_t)(b * 2 + g) * 512 * 64; const bf16_t* vcc = (const bf16_t*)(P.ws + WS_VC) + (size_t)(b * 2 + g) * 512 * 64;
    const float* gates = (const float*)(P.ws + WS_GATES); bf16_t* mix = (bf16_t*)(P.ws + WS_MIX);
    LAS float* impw = (LAS float*)(lds + NL_IMP) + wid * 8 * NL_IMP_STRIDE;
    LAS unsigned long long* selm = (LAS unsigned long long*)(lds + NL_SELM);
    NsaLane L; L.qi = c >> 2; const int hh = c & 3, head = g * 4 + hh;
    L.t = qb * 64 + wid * 8 + L.qi; L.sl2 = exp2f(-(float)(head + 1)) * LOG2E; L.mlo = 0; L.mhi = 0;
    const size_t tok = (size_t)b * SEQ + L.t;
    bf16x8 qf[4];
#pragma unroll
    for (int ks = 0; ks < 4; ++ks) qf[ks] = *(const bf16x8*)(qg + tok * 512 + head * 64 + 16 * ks + 8 * hi);
    for (int i = lane; i < 8 * NL_IMP_STRIDE; i += 64) impw[i] = 0.f;
    const int ncmp = qb * 4 + 3 < 511 ? qb * 4 + 3 : 511;
    const int nblk = (ncmp + 63) >> 6;
    const unsigned long long cm = nblk >= 64 ? ~0ull : ((1ull << nblk) - 1ull);
    f32x16 O[2], Ot[2]; float lsum = 0.f;
    O[0] = f32x16{}; O[1] = f32x16{};
    nsa_pass<0>(lds, kcn, vcc, 64, cm, 0ull, qf, L, 1.f, lsum, O, impw);
    lsum += __shfl_xor(lsum, 32);
    const float invc = 1.0f / fmaxf(lsum, 1e-30f);
    float dummy = 0.f;
    nsa_pass<1>(lds, kcn, vcc, 64, cm, 0ull, qf, L, invc, dummy, O, impw);
    const float* gt = gates + tok * 24 + g * 12 + hh * 3;
    const float g0 = gt[0], g1 = gt[1], g2 = gt[2];
#pragma unroll
    for (int dt = 0; dt < 2; ++dt) Ot[dt] = O[dt] * g0;
    {
        const int ncausal = qb + 1;
        for (int qi = 0; qi < 8; ++qi) {
            unsigned long long lo, hi64;
            if (ncausal <= 16) { lo = (1ull << ncausal) - 1ull; hi64 = 0ull; }
            else {
                const int j0 = lane, j1 = lane + 64;
                const bool f0 = (j0 == 0) || (j0 == qb) || (j0 == qb - 1), f1 = (j1 == qb) || (j1 == qb - 1);
                const unsigned k0 = (j0 <= qb && !f0) ? (0x80000000u | (__float_as_uint(impw[qi * NL_IMP_STRIDE + j0]) & 0x7fffff80u) | (unsigned)j0) : 0u;
                const unsigned k1 = (j1 <= qb && !f1) ? (0x80000000u | (__float_as_uint(impw[qi * NL_IMP_STRIDE + j1]) & 0x7fffff80u) | (unsigned)j1) : 0u;
                const int needn = 13;
                unsigned th = 0u;
                for (int bit = 31; bit >= 0; --bit) { const unsigned cand = th | (1u << bit);
                    const int cnt = __popcll(__ballot(k0 >= cand)) + __popcll(__ballot(k1 >= cand));
                    if (cnt >= needn) th = cand; }
                lo = __ballot(f0 || (k0 >= th && k0 != 0u)); hi64 = __ballot(f1 || (k1 >= th && k1 != 0u));
            }
            if (lane == 0) { selm[(wid * 8 + qi) * 2] = lo; selm[(wid * 8 + qi) * 2 + 1] = hi64; }
        }
    }
    __syncthreads();
    unsigned long long ulo = selm[lane * 2], uhi = selm[lane * 2 + 1];
#pragma unroll
    for (int o = 1; o < 64; o <<= 1) { ulo |= __shfl_xor(ulo, o); uhi |= __shfl_xor(uhi, o); }
    L.mlo = selm[(wid * 8 + L.qi) * 2]; L.mhi = selm[(wid * 8 + L.qi) * 2 + 1];
    const bf16_t* kvb = kv + (size_t)b * SEQ * 768 + g * 64;
    O[0] = f32x16{}; O[1] = f32x16{}; lsum = 0.f;
    nsa_pass<2>(lds, kvb + 256, kvb + 384, 768, ulo, uhi, qf, L, 1.f, lsum, O, impw);
    lsum += __shfl_xor(lsum, 32);
    { const float sc = g1 / fmaxf(lsum, 1e-30f);
#pragma unroll
      for (int dt = 0; dt < 2; ++dt) Ot[dt] += O[dt] * sc; }
    {
        const int jlo = qb >= 8 ? qb - 8 : 0;
        unsigned long long wlo = 0ull, whi = 0ull;
        for (int jj = jlo; jj <= qb; ++jj) { if (jj < 64) wlo |= 1ull << jj; else whi |= 1ull << (jj - 64); }
        O[0] = f32x16{}; O[1] = f32x16{}; lsum = 0.f;
        nsa_pass<3>(lds, kvb + 512, kvb + 640, 768, wlo, whi, qf, L, 1.f, lsum, O, impw);
        lsum += __shfl_xor(lsum, 32);
        const float sc = g2 / fmaxf(lsum, 1e-30f);
#pragma unroll
        for (int dt = 0; dt < 2; ++dt) Ot[dt] += O[dt] * sc;
    }
    float ss = 0.f;
#pragma unroll
    for (int dt = 0; dt < 2; ++dt)
#pragma unroll
        for (int r = 0; r < 16; ++r) ss += Ot[dt][r] * Ot[dt][r];
    ss += __shfl_xor(ss, 32);
    const float rstd = rsqrtf(ss * (1.f / 64.f) + RMS_EPS);
#pragma unroll
    for (int dt = 0; dt < 2; ++dt)
#pragma unroll
        for (int r4 = 0; r4 < 4; ++r4) { const int d = 32 * dt + 8 * r4 + 4 * hi; const f32x4 w = *(const f32x4*)(P.attn_out_norm_w + head * 64 + d);
            u32x2 pk; pk.x = cvtpk(Ot[dt][4 * r4] * rstd * w.x, Ot[dt][4 * r4 + 1] * rstd * w.y); pk.y = cvtpk(Ot[dt][4 * r4 + 2] * rstd * w.z, Ot[dt][4 * r4 + 3] * rstd * w.w);
            *(u32x2*)(mix + tok * 1024 + head * 64 + d) = pk; }
    __syncthreads();
}


__device__ __forceinline__ void phase_cvt_small(const Params& P) {
    const int tid = threadIdx.x;
    {
        const int gt = blockIdx.x * NTHREADS + tid, NG = gridDim.x * NTHREADS;
        bf16_t* wo = (bf16_t*)(P.ws + WS_WOUT); bf16_t* wrs = (bf16_t*)(P.ws + WS_WRS); bf16_t* wsd = (bf16_t*)(P.ws + WS_WSD);
        for (int i = gt; i < 1024 * 128; i += NG) { const f32x4 a = *(const f32x4*)(P.w_out + (size_t)i * 8), b2 = *(const f32x4*)(P.w_out + (size_t)i * 8 + 4);
            *(u32x4*)(wo + (size_t)i * 8) = (u32x4){cvtpk(a.x, a.y), cvtpk(a.z, a.w), cvtpk(b2.x, b2.y), cvtpk(b2.z, b2.w)}; }
        for (int i = gt; i < 256 * 128; i += NG) { const f32x4 a = *(const f32x4*)(P.sh_wd + (size_t)i * 8), b2 = *(const f32x4*)(P.sh_wd + (size_t)i * 8 + 4);
            *(u32x4*)(wsd + (size_t)i * 8) = (u32x4){cvtpk(a.x, a.y), cvtpk(a.z, a.w), cvtpk(b2.x, b2.y), cvtpk(b2.z, b2.w)}; }
        for (int i = gt; i < 1024 * 96; i += NG) { const int k = i / 96, c8 = (i % 96) * 8;
            const float* s;
            if (c8 < 256) s = P.router_w + (size_t)k * 256 + c8;
            else { const int cc = c8 - 256, t = cc >> 8, u16 = (cc & 255) >> 4; s = ((u16 & 1) ? P.sh_wu : P.sh_wg) + (size_t)k * 256 + t * 128 + (u16 >> 1) * 16 + (cc & 8); }
            const f32x4 a = *(const f32x4*)s, b2 = *(const f32x4*)(s + 4);
            *(u32x4*)(wrs + (size_t)k * 768 + c8) = (u32x4){cvtpk(a.x, a.y), cvtpk(a.z, a.w), cvtpk(b2.x, b2.y), cvtpk(b2.z, b2.w)}; }
    }
}

__device__ __forceinline__ void route_token(const Params& P, int t, int lane) {
    const float* scores = (const float*)(P.ws + WS_SCORES) + (size_t)t * 256;
    const f32x4 s4 = *(const f32x4*)(scores + 4 * lane); const f32x4 b4 = *(const f32x4*)(P.router_bias + 4 * lane);
    float sc[4] = {s4.x, s4.y, s4.z, s4.w};
    float bs[4] = {s4.x + b4.x, s4.y + b4.y, s4.z + b4.z, s4.w + b4.w};
    float m1 = fmaxf(bs[0], bs[1]), m2 = fminf(bs[0], bs[1]);
    { const float v = bs[2]; const float n1 = fmaxf(m1, v); m2 = fmaxf(fminf(m1, v), m2); m1 = n1; }
    { const float v = bs[3]; const float n1 = fmaxf(m1, v); m2 = fmaxf(fminf(m1, v), m2); m1 = n1; }
#pragma unroll
    for (int o = 1; o < 8; o <<= 1) { const float o1 = __shfl_xor(m1, o), o2 = __shfl_xor(m2, o); const float n1 = fmaxf(m1, o1); m2 = fmaxf(fminf(m1, o1), fmaxf(m2, o2)); m1 = n1; }
    const float gs = m1 + m2;
    const int grp = lane >> 3;
    int rank = 0;
#pragma unroll
    for (int g2 = 0; g2 < 8; ++g2) { const float og = __shfl(gs, g2 * 8); rank += (og > gs || (og == gs && g2 < grp)) ? 1 : 0; }
    const bool gsel = rank < 4;
    float mv[4];
#pragma unroll
    for (int i = 0; i < 4; ++i) mv[i] = gsel ? bs[i] : -INFINITY;
    int myidx = -1; float myw = 0.f; float wsum = 0.f;
#pragma unroll 1
    for (int k = 0; k < 8; ++k) {
        float bv = mv[0]; int bi = 4 * lane;
#pragma unroll
        for (int i = 1; i < 4; ++i) if (mv[i] > bv) { bv = mv[i]; bi = 4 * lane + i; }
#pragma unroll
        for (int o = 1; o < 64; o <<= 1) { const float ov = __shfl_xor(bv, o); const int oi = __shfl_xor(bi, o); if (ov > bv || (ov == bv && oi < bi)) { bv = ov; bi = oi; } }
        const int wl = bi >> 2, wc = bi & 3;
        const float mine = wc == 0 ? sc[0] : (wc == 1 ? sc[1] : (wc == 2 ? sc[2] : sc[3]));
        const float wv = __shfl(mine, wl);
        wsum += wv;
        if (lane == k) { myidx = bi; myw = wv; }
        if (lane == wl) {
#pragma unroll
            for (int i = 0; i < 4; ++i) if (i == wc) mv[i] = -INFINITY; }
    }
    if (lane < 8) {
        int* cnt = (int*)(P.ws + WS_CTL + CTL_CNT);
        const int pos = atomicAdd(cnt + myidx, 1);
        if (pos < BCAP) ((int*)(P.ws + WS_BUCKET))[(size_t)myidx * BCAP + pos] = t * 8 + lane;
        ((float*)(P.ws + WS_RW))[(size_t)t * 8 + lane] = myw / wsum * 2.5f;
    }
}


__device__ __forceinline__ void phase_p4a(const Params& P, LAS unsigned char* lds) {
    typedef Gemm4 G;
    const int tid = opaque_tid(), lane = tid & 63, wid = tid >> 6, wm = wid >> 1, wn = wid & 1, fr = lane & 15, fq = lane >> 4;
    struct F { const Params& P;
        __device__ __forceinline__ void ptrs(int seg, const bf16_t* (&aptr)[2], const bf16_t* (&bptr)[2]) const {
            const int tid = opaque_tid(), lane = tid & 63, wid = tid >> 6, wm = wid >> 1, wn = wid & 1, fr = lane & 15, fq = lane >> 4, c8 = 8 * (tid & 31); (void)wm; (void)wn; (void)fr; (void)fq; (void)c8;
            const int u = blockIdx.x + seg * gridDim.x, rt = u >> 2, ct = u & 3;
            const bf16_t* mix = (const bf16_t*)(P.ws + WS_MIX); const bf16_t* wo = (const bf16_t*)(P.ws + WS_WOUT);
#pragma unroll
            for (int i = 0; i < 2; ++i) { aptr[i] = mix + (size_t)(rt * 256 + G::a_row(i, tid)) * 1024 + 8 * (tid & 3); bptr[i] = wo + (size_t)G::b_k(i, tid) * 1024 + ct * 256 + 8 * (tid & 31); } }
        __device__ __forceinline__ void epi(int seg, f32x4 (&acc)[4][8]) const {
            const int tid = opaque_tid(), lane = tid & 63, wid = tid >> 6, wm = wid >> 1, wn = wid & 1, fr = lane & 15, fq = lane >> 4, c8 = 8 * (tid & 31); (void)wm; (void)wn; (void)fr; (void)fq; (void)c8;
            const int u = blockIdx.x + seg * gridDim.x, rt = u >> 2, ct = u & 3, b = (rt * 256) / SEQ;
            const float* mod = (const float*)(P.ws + WS_MOD) + b * 6144; float* ssp = (float*)(P.ws + WS_SS);
#pragma unroll
            for (int mi = 0; mi < 4; ++mi) { const size_t m = (size_t)(rt * 256 + wm * 64 + mi * 16 + fr); float ss = 0.f;
#pragma unroll
                for (int ni = 0; ni < 8; ++ni) { const int col = ct * 256 + wn * 128 + ni * 16 + 4 * fq;
                    const f32x4 xv = *(const f32x4*)(P.x + m * 1024 + col), gv = *(const f32x4*)(mod + 2048 + col); const f32x4 a = acc[mi][ni];
                    f32x4 o; o.x = xv.x + gv.x * a.x; o.y = xv.y + gv.y * a.y; o.z = xv.z + gv.z * a.z; o.w = xv.w + gv.w * a.w;
                    *(f32x4*)(P.out + m * 1024 + col) = o; ss += (o.x * o.x + o.y * o.y) + (o.z * o.z + o.w * o.w); if (ni & 1) asm volatile("" ::: "memory"); }
                ss += __shfl_xor(ss, 16); ss += __shfl_xor(ss, 32);
                if (fq == 0) ssp[m * 8 + ct * 2 + wn] = ss; } }
    } f{P};
    const int nu = (128 * 4 - (int)blockIdx.x + (int)gridDim.x - 1) / (int)gridDim.x;
    if (nu > 0) G::run_stream(f, nu, 32, 32, (size_t)32 * 1024, lds);
}
__device__ __forceinline__ void phase_p4b(const Params& P) {
    const int lane = threadIdx.x & 63, gw = blockIdx.x * (NTHREADS / 64) + (threadIdx.x >> 6), NGW = gridDim.x * (NTHREADS / 64);
    const float* ssp = (const float*)(P.ws + WS_SS); bf16_t* h2 = (bf16_t*)(P.ws + WS_H);
    for (int m = gw; m < T; m += NGW) {
        const float* mod = (const float*)(P.ws + WS_MOD) + (m / SEQ) * 6144;
        const f32x4 s0 = *(const f32x4*)(ssp + (size_t)m * 8), s1 = *(const f32x4*)(ssp + (size_t)m * 8 + 4);
        const float rstd = rsqrtf(((s0.x + s0.y) + (s0.z + s0.w) + (s1.x + s1.y) + (s1.z + s1.w)) * (1.f / 1024.f) + RMS_EPS);
#pragma unroll
        for (int j = 0; j < 4; ++j) { const int col = (lane + 64 * j) * 4;
            const f32x4 v = *(const f32x4*)(P.out + (size_t)m * 1024 + col), wv = *(const f32x4*)(P.norm2_w + col), scv = *(const f32x4*)(mod + 4096 + col), shv = *(const f32x4*)(mod + 3072 + col);
            u32x2 pk; pk.x = cvtpk(v.x * rstd * wv.x * (1.f + scv.x) + shv.x, v.y * rstd * wv.y * (1.f + scv.y) + shv.y);
            pk.y = cvtpk(v.z * rstd * wv.z * (1.f + scv.z) + shv.z, v.w * rstd * wv.w * (1.f + scv.w) + shv.w);
            *(u32x2*)(h2 + (size_t)m * 1024 + col) = pk; }
    }
}
__device__ __forceinline__ void phase_p4c(const Params& P, LAS unsigned char* lds) {
    typedef Gemm4 G;
    const int tid = opaque_tid(), lane = tid & 63, wid = tid >> 6, wm = wid >> 1, wn = wid & 1, fr = lane & 15, fq = lane >> 4;
    struct F { const Params& P;
        __device__ __forceinline__ void ptrs(int seg, const bf16_t* (&aptr)[2], const bf16_t* (&bptr)[2]) const {
            const int tid = opaque_tid(), lane = tid & 63, wid = tid >> 6, wm = wid >> 1, wn = wid & 1, fr = lane & 15, fq = lane >> 4, c8 = 8 * (tid & 31); (void)wm; (void)wn; (void)fr; (void)fq; (void)c8;
            const int u = blockIdx.x + seg * gridDim.x, rt = u / 3, ct = u % 3;
            const bf16_t* h2 = (const bf16_t*)(P.ws + WS_H); const bf16_t* wrs = (const bf16_t*)(P.ws + WS_WRS);
#pragma unroll
            for (int i = 0; i < 2; ++i) { aptr[i] = h2 + (size_t)(rt * 256 + G::a_row(i, tid)) * 1024 + 8 * (tid & 3); bptr[i] = wrs + (size_t)G::b_k(i, tid) * 768 + ct * 256 + 8 * (tid & 31); } }
        __device__ __forceinline__ void epi(int seg, f32x4 (&acc)[4][8]) const {
            const int tid = opaque_tid(), lane = tid & 63, wid = tid >> 6, wm = wid >> 1, wn = wid & 1, fr = lane & 15, fq = lane >> 4, c8 = 8 * (tid & 31); (void)wm; (void)wn; (void)fr; (void)fq; (void)c8;
            const int u = blockIdx.x + seg * gridDim.x, rt = u / 3, ct = u % 3;
            float* scores = (float*)(P.ws + WS_SCORES); bf16_t* hidS = (bf16_t*)(P.ws + WS_HIDS);
#pragma unroll
            for (int mi = 0; mi < 4; ++mi) { const size_t m = (size_t)(rt * 256 + wm * 64 + mi * 16 + fr);
                if (ct == 0) {
#pragma unroll
                    for (int ni = 0; ni < 8; ++ni) { const f32x4 a = acc[mi][ni];
                        *(f32x4*)(scores + m * 256 + wn * 128 + ni * 16 + 4 * fq) = (f32x4){sigmoidf_(a.x), sigmoidf_(a.y), sigmoidf_(a.z), sigmoidf_(a.w)}; }
                } else {
#pragma unroll
                    for (int j = 0; j < 4; ++j) { const f32x4 g = acc[mi][2 * j], uu = acc[mi][2 * j + 1];
                        u32x2 pk; pk.x = cvtpk(siluf_(g.x) * uu.x, siluf_(g.y) * uu.y); pk.y = cvtpk(siluf_(g.z) * uu.z, siluf_(g.w) * uu.w);
                        *(u32x2*)(hidS + m * 256 + (ct - 1) * 128 + wn * 64 + j * 16 + 4 * fq) = pk; }
                } } }
    } f{P};
    const int nu = (128 * 3 - (int)blockIdx.x + (int)gridDim.x - 1) / (int)gridDim.x;
    if (nu > 0) G::run_stream(f, nu, 32, 32, (size_t)32 * 768, lds);
}
__device__ __forceinline__ void phase_route(const Params& P) {
    const int tid = opaque_tid(), lane = tid & 63, gw = blockIdx.x * (NTHREADS / 64) + (tid >> 6), NGW = gridDim.x * (NTHREADS / 64);
    for (int t = gw; t < T; t += NGW) route_token(P, t, lane);
}
__device__ __forceinline__ void phase_p4d(const Params& P, LAS unsigned char* lds) {
    typedef Gemm4 G;
    const int tid = opaque_tid(), lane = tid & 63, wid = tid >> 6, wm = wid >> 1, wn = wid & 1, fr = lane & 15, fq = lane >> 4;
    struct F { const Params& P;
        __device__ __forceinline__ void ptrs(int seg, const bf16_t* (&aptr)[2], const bf16_t* (&bptr)[2]) const {
            const int tid = opaque_tid(), lane = tid & 63, wid = tid >> 6, wm = wid >> 1, wn = wid & 1, fr = lane & 15, fq = lane >> 4, c8 = 8 * (tid & 31); (void)wm; (void)wn; (void)fr; (void)fq; (void)c8;
            const int u = blockIdx.x + seg * gridDim.x, rt = u >> 2, ct = u & 3;
            const bf16_t* hidS = (const bf16_t*)(P.ws + WS_HIDS); const bf16_t* wsd = (const bf16_t*)(P.ws + WS_WSD);
#pragma unroll
            for (int i = 0; i < 2; ++i) { aptr[i] = hidS + (size_t)(rt * 256 + G::a_row(i, tid)) * 256 + 8 * (tid & 3); bptr[i] = wsd + (size_t)G::b_k(i, tid) * 1024 + ct * 256 + 8 * (tid & 31); } }
        __device__ __forceinline__ void epi(int seg, f32x4 (&acc)[4][8]) const {
            const int tid = opaque_tid(), lane = tid & 63, wid = tid >> 6, wm = wid >> 1, wn = wid & 1, fr = lane & 15, fq = lane >> 4, c8 = 8 * (tid & 31); (void)wm; (void)wn; (void)fr; (void)fq; (void)c8;
            const int u = blockIdx.x + seg * gridDim.x, rt = u >> 2, ct = u & 3, b = (rt * 256) / SEQ;
            const float* mod = (const float*)(P.ws + WS_MOD) + b * 6144;
#pragma unroll
            for (int mi = 0; mi < 4; ++mi) { const size_t m = (size_t)(rt * 256 + wm * 64 + mi * 16 + fr);
#pragma unroll
                for (int ni = 0; ni < 8; ++ni) { const int col = ct * 256 + wn * 128 + ni * 16 + 4 * fq;
                    const f32x4 xv = *(const f32x4*)(P.out + m * 1024 + col), gv = *(const f32x4*)(mod + 5120 + col); const f32x4 a = acc[mi][ni];
                    f32x4 o; o.x = xv.x + gv.x * a.x; o.y = xv.y + gv.y * a.y; o.z = xv.z + gv.z * a.z; o.w = xv.w + gv.w * a.w;
                    *(f32x4*)(P.out + m * 1024 + col) = o; if (ni & 1) asm volatile("" ::: "memory"); } } }
    } f{P};
    const int nu = (128 * 4 - (int)blockIdx.x + (int)gridDim.x - 1) / (int)gridDim.x;
    if (nu > 0) G::run_stream(f, nu, 8, 32, (size_t)32 * 1024, lds);
}

__device__ __forceinline__ void phase_expert_cvt(const Params& P) {
    const size_t gt = (size_t)blockIdx.x * NTHREADS + threadIdx.x, NG = (size_t)gridDim.x * NTHREADS;
    bf16_t* wgu = (bf16_t*)(P.ws + WS_WBGU); bf16_t* wd = (bf16_t*)(P.ws + WS_WBD);
    for (size_t i = gt; i < (size_t)256 * 1024 * 64; i += NG) {
        const size_t ek = i >> 6; const int c8 = (int)(i & 63) * 8, t = c8 >> 8, u16 = (c8 & 255) >> 4;
        const float* s = ((u16 & 1) ? P.exp_wu : P.exp_wg) + ek * 256 + t * 128 + (u16 >> 1) * 16 + (c8 & 8);
        const f32x4 a = __builtin_nontemporal_load((const f32x4*)s), b2 = __builtin_nontemporal_load((const f32x4*)(s + 4));
        *(u32x4*)(wgu + ek * 512 + c8) = (u32x4){cvtpk(a.x, a.y), cvtpk(a.z, a.w), cvtpk(b2.x, b2.y), cvtpk(b2.z, b2.w)}; }
    for (size_t i = gt; i < (size_t)256 * 256 * 128; i += NG) {
        const f32x4 a = __builtin_nontemporal_load((const f32x4*)(P.exp_wd + i * 8)), b2 = __builtin_nontemporal_load((const f32x4*)(P.exp_wd + i * 8 + 4));
        *(u32x4*)(wd + i * 8) = (u32x4){cvtpk(a.x, a.y), cvtpk(a.z, a.w), cvtpk(b2.x, b2.y), cvtpk(b2.z, b2.w)}; }
}

constexpr int P6_TILES = 64 * 1024, P6_PRE = P6_TILES + 1024, P6_PAIR = P6_PRE + 1040, P6_W = P6_PAIR + 1024;
__device__ __forceinline__ void phase_experts(const Params& P, LAS unsigned char* lds) {
    typedef Gemm4 G;
    const int tid = opaque_tid(), lane = tid & 63, wid = tid >> 6, wm = wid >> 1, wn = wid & 1, fr = lane & 15, fq = lane >> 4;
    const int* cnt = (const int*)(P.ws + WS_CTL + CTL_CNT); const int* bucket = (const int*)(P.ws + WS_BUCKET); const float* rw = (const float*)(P.ws + WS_RW);
    const bf16_t* h2 = (const bf16_t*)(P.ws + WS_H); bf16_t* hidR = (bf16_t*)(P.ws + WS_HIDR) + (size_t)blockIdx.x * 256 * 256; bf16_t* y = (bf16_t*)(P.ws + WS_Y);
    LAS int* tiles = (LAS int*)(lds + P6_TILES); LAS int* pre = (LAS int*)(lds + P6_PRE); LAS int* pairs = (LAS int*)(lds + P6_PAIR); LAS float* wts = (LAS float*)(lds + P6_W);
    const int nx = (gridDim.x % 8 == 0) ? 8 : 1, xl = blockIdx.x % nx, li = blockIdx.x / nx, nloc = gridDim.x / nx, nek = 256 / nx;
    if (tid < nek) { const int c_ = cnt[xl + nx * tid]; tiles[tid] = ((c_ < BCAP ? c_ : BCAP) + 255) >> 8; }
    __syncthreads();
    if (tid < nek) { int s = 0; for (int i = 0; i < tid; ++i) s += tiles[i]; pre[tid] = s; if (tid == nek - 1) pre[nek] = s + tiles[nek - 1]; }
    __syncthreads();
    const int total = pre[nek];
    const int c8 = 8 * (tid & 31), u16 = c8 >> 4;
    for (int u = li; u < total; u += nloc) {
        int lo = 0, hi = nek - 1;
        while (lo < hi) { const int mid = (lo + hi + 1) >> 1; if (pre[mid] <= u) lo = mid; else hi = mid - 1; }
        const int e = xl + nx * lo, tile = u - pre[lo], n = cnt[e] < BCAP ? cnt[e] : BCAP, rows = (n - tile * 256) < 256 ? (n - tile * 256) : 256;
        if (tid < 256) { const int r = tid < rows ? tid : 0; const int pr = bucket[(size_t)e * BCAP + tile * 256 + r]; pairs[tid] = pr; wts[tid] = tid < rows ? rw[pr] : 0.f; }
        __syncthreads();
        {
            struct GU { const bf16_t* h2; LAS int* pairs; const bf16_t* wgu; bf16_t* hidR;
                __device__ __forceinline__ void ptrs(int t, const bf16_t* (&aptr)[2], const bf16_t* (&bptr)[2]) const {
                    const int tid = opaque_tid(), lane = tid & 63, wid = tid >> 6, wm = wid >> 1, wn = wid & 1, fr = lane & 15, fq = lane >> 4, c8 = 8 * (tid & 31); (void)wm; (void)wn; (void)fr; (void)fq; (void)c8;
#pragma unroll
                    for (int i = 0; i < 2; ++i) { aptr[i] = h2 + (size_t)(pairs[G::a_row(i, tid)] >> 3) * 1024 + 8 * (tid & 3);
                        bptr[i] = wgu + (size_t)G::b_k(i, tid) * 512 + t * 256 + c8; } }
                __device__ __forceinline__ void epi(int t, f32x4 (&acc)[4][8]) const {
                    const int tid = opaque_tid(), lane = tid & 63, wid = tid >> 6, wm = wid >> 1, wn = wid & 1, fr = lane & 15, fq = lane >> 4, c8 = 8 * (tid & 31); (void)wm; (void)wn; (void)fr; (void)fq; (void)c8;
#pragma unroll
                    for (int mi = 0; mi < 4; ++mi) { const int rl = wm * 64 + mi * 16 + fr;
#pragma unroll
                        for (int j = 0; j < 4; ++j) { const f32x4 g = acc[mi][2 * j], uu = acc[mi][2 * j + 1];
                            u32x2 pk; pk.x = cvtpk(siluf_(g.x) * uu.x, siluf_(g.y) * uu.y); pk.y = cvtpk(siluf_(g.z) * uu.z, siluf_(g.w) * uu.w);
                            *(u32x2*)(hidR + rl * 256 + t * 128 + wn * 64 + j * 16 + 4 * fq) = pk; } } }
            } f{h2, pairs, (const bf16_t*)(P.ws + WS_WBGU) + (size_t)e * 1024 * 512, hidR};
            G::run_stream(f, 2, 32, 32, (size_t)32 * 512, lds);
        }
        __syncthreads();
        {
            struct DN { bf16_t* hidR; const bf16_t* wd; bf16_t* y; LAS int* pairs; LAS float* wts; int rows;
                __device__ __forceinline__ void ptrs(int ct, const bf16_t* (&aptr)[2], const bf16_t* (&bptr)[2]) const {
                    const int tid = opaque_tid(), lane = tid & 63, wid = tid >> 6, wm = wid >> 1, wn = wid & 1, fr = lane & 15, fq = lane >> 4, c8 = 8 * (tid & 31); (void)wm; (void)wn; (void)fr; (void)fq; (void)c8;
#pragma unroll
                    for (int i = 0; i < 2; ++i) { aptr[i] = hidR + (size_t)G::a_row(i, tid) * 256 + 8 * (tid & 3); bptr[i] = wd + (size_t)G::b_k(i, tid) * 1024 + ct * 256 + c8; } }
                __device__ __forceinline__ void epi(int ct, f32x4 (&acc)[4][8]) const {
                    const int tid = opaque_tid(), lane = tid & 63, wid = tid >> 6, wm = wid >> 1, wn = wid & 1, fr = lane & 15, fq = lane >> 4, c8 = 8 * (tid & 31); (void)wm; (void)wn; (void)fr; (void)fq; (void)c8;
#pragma unroll
                    for (int mi = 0; mi < 4; ++mi) { const int rl = wm * 64 + mi * 16 + fr; const float wgt = wts[rl]; const size_t pr = (size_t)pairs[rl];
                        if (rl < rows) {
#pragma unroll
                            for (int ni = 0; ni < 8; ++ni) { const int col = ct * 256 + wn * 128 + ni * 16 + 4 * fq; const f32x4 a = acc[mi][ni] * wgt;
                                u32x2 pk; pk.x = cvtpk(a.x, a.y); pk.y = cvtpk(a.z, a.w); *(u32x2*)(y + pr * 1024 + col) = pk; } } } }
            } f{hidR, (const bf16_t*)(P.ws + WS_WBD) + (size_t)e * 256 * 1024, y, pairs, wts, rows};
            G::run_stream(f, 4, 8, 32, (size_t)32 * 1024, lds);
        }
        __syncthreads();
    }
}

__device__ __forceinline__ void phase_combine(const Params& P) {
    const int lane = threadIdx.x & 63, gw = blockIdx.x * (NTHREADS / 64) + (threadIdx.x >> 6), NGW = gridDim.x * (NTHREADS / 64);
    const bf16_t* y = (const bf16_t*)(P.ws + WS_Y);
    for (int m = gw; m < T; m += NGW) {
        const float* mod = (const float*)(P.ws + WS_MOD) + (m / SEQ) * 6144 + 5120;
#pragma unroll
        for (int j = 0; j < 4; ++j) { const int col = (lane + 64 * j) * 4;
            f32x4 s = (f32x4){0.f, 0.f, 0.f, 0.f};
#pragma unroll
            for (int sl = 0; sl < 8; ++sl) { const u32x2 v = *(const u32x2*)(y + ((size_t)m * 8 + sl) * 1024 + col);
                s.x += __uint_as_float(v.x << 16); s.y += __uint_as_float(v.x & 0xffff0000u); s.z += __uint_as_float(v.y << 16); s.w += __uint_as_float(v.y & 0xffff0000u); }
            const f32x4 g = *(const f32x4*)(mod + col); f32x4 o = *(const f32x4*)(P.out + (size_t)m * 1024 + col);
            o.x += g.x * s.x; o.y += g.y * s.y; o.z += g.z * s.z; o.w += g.w * s.w;
            *(f32x4*)(P.out + (size_t)m * 1024 + col) = o; }
    }
}

constexpr int LDS_BYTES = 144 * 1024;
__global__ void __launch_bounds__(NTHREADS) mega(Params P) {
    extern __shared__ __attribute__((aligned(16))) unsigned char smem[];
    LAS unsigned char* lds = (LAS unsigned char*)smem;
    cg::grid_group grid = cg::this_grid();
    volatile LAS unsigned* xst = (volatile LAS unsigned*)(lds + LDS_BYTES - 16);
    if (threadIdx.x < 4) xst[threadIdx.x] = 0u;
    __syncthreads();
    XcdBarrier xb = xcd_barrier_post((unsigned*)(P.ws + WS_CTL + CTL_BAR), xst);
    grid.sync();
    phase_mod(P, lds);
    xcd_barrier(xb);
    { const float* mod = (const float*)(P.ws + WS_MOD); norm_mod_rows(P.x, P.norm1_w, mod, mod + 1024, (bf16_t*)(P.ws + WS_H), H1S); }
    xcd_barrier(xb);
    phase_inproj(P, lds);
    xcd_barrier(xb);
    phase_cmp_h1(P, lds);
    xcd_barrier(xb);
    for (int u = blockIdx.x; u < 512; u += gridDim.x) hgrn_unit<1>(P, lds, u);
    for (int u = blockIdx.x; u < 1024; u += gridDim.x) nsa_unit(P, lds, u);
    phase_cvt_small(P);
    xcd_barrier(xb);
    phase_p4a(P, lds);
    xcd_barrier(xb);
    phase_p4b(P);
    xcd_barrier(xb);
    phase_p4c(P, lds);
    xcd_barrier(xb);
    phase_route(P);
    phase_p4d(P, lds);
    xcd_barrier(xb);
    phase_expert_cvt(P);
    xcd_barrier(xb);
    phase_experts(P, lds);
    xcd_barrier(xb);
    phase_combine(P);
}

extern "C" void kernel_launch(void* const* d_in, const int* in_sizes, int n_in, void* d_out, int out_size, void* d_ws, size_t ws_size, hipStream_t stream) {
    static int grid = 0;
    if (grid == 0) {
        if (n_in != 25 || ws_size < WS_END) { fprintf(stderr, "kernel_launch: unexpected n_in %d or ws_size %zu (need %zu)\n", n_in, ws_size, (size_t)WS_END); grid = -1; return; }
        int dev = 0, cus = 0, per_cu = 0;
        (void)hipGetDevice(&dev); (void)hipDeviceGetAttribute(&cus, hipDeviceAttributeMultiprocessorCount, dev);
        (void)hipFuncSetAttribute((const void*)mega, hipFuncAttributeMaxDynamicSharedMemorySize, LDS_BYTES);
        (void)hipOccupancyMaxActiveBlocksPerMultiprocessor(&per_cu, (const void*)mega, NTHREADS, LDS_BYTES);
        if (per_cu < 1) { fprintf(stderr, "kernel_launch: occupancy query says %d blocks per CU\n", per_cu); grid = -1; return; }
        grid = cus;
    }
    if (grid < 0) return;
    (void)hipMemsetAsync((char*)d_ws + WS_CTL, 0, 64 * 1024, stream);
    Params p{};
    const float** pf = (const float**)&p;
    for (int i = 0; i < 25; ++i) pf[i] = (const float*)d_in[i];
    p.out = (float*)d_out; p.ws = (unsigned char*)d_ws;
    void* args[] = {&p};
    hipError_t e = hipLaunchCooperativeKernel((const void*)mega, dim3(grid), dim3(NTHREADS), args, LDS_BYTES, stream);
    if (e != hipSuccess) fprintf(stderr, "cooperative launch failed: %s (grid %d)\n", hipGetErrorString(e), grid);
}

#ifdef PHASE_TEST
__global__ void __launch_bounds__(NTHREADS) t_p4a(Params P) { extern __shared__ __attribute__((aligned(16))) unsigned char smem[]; phase_p4a(P, (LAS unsigned char*)smem); }
__global__ void __launch_bounds__(NTHREADS) t_p4d(Params P) { extern __shared__ __attribute__((aligned(16))) unsigned char smem[]; phase_p4d(P, (LAS unsigned char*)smem); }
__global__ void __launch_bounds__(NTHREADS) t_p4(Params P) { extern __shared__ __attribute__((aligned(16))) unsigned char smem[]; phase_p4c(P, (LAS unsigned char*)smem); }
__global__ void __launch_bounds__(NTHREADS) t_p6(Params P) { extern __shared__ __attribute__((aligned(16))) unsigned char smem[]; phase_experts(P, (LAS unsigned char*)smem); }
__global__ void __launch_bounds__(NTHREADS) t_nsa(Params P) { extern __shared__ __attribute__((aligned(16))) unsigned char smem[]; nsa_unit(P, (LAS unsigned char*)smem, blockIdx.x); }
__global__ void __launch_bounds__(NTHREADS) t_mod(Params P) { extern __shared__ __attribute__((aligned(16))) unsigned char smem[]; phase_mod(P, (LAS unsigned char*)smem); }
__global__ void __launch_bounds__(NTHREADS) t_inproj(Params P) { extern __shared__ __attribute__((aligned(16))) unsigned char smem[]; phase_inproj(P, (LAS unsigned char*)smem); }
__global__ void __launch_bounds__(NTHREADS) t_cmp(Params P) { extern __shared__ __attribute__((aligned(16))) unsigned char smem[]; compress_unit(P, (LAS unsigned char*)smem, blockIdx.x); }
__global__ void __launch_bounds__(NTHREADS) t_h0(Params P) { extern __shared__ __attribute__((aligned(16))) unsigned char smem[]; hgrn_unit<0>(P, (LAS unsigned char*)smem, blockIdx.x); }
__global__ void __launch_bounds__(NTHREADS) t_h1(Params P) { extern __shared__ __attribute__((aligned(16))) unsigned char smem[]; hgrn_unit<1>(P, (LAS unsigned char*)smem, blockIdx.x); }
#endif
```

```cpp
#include <hip/hip_runtime.h>
#include <hip/hip_cooperative_groups.h>
#include <cstdio>
#include <cstdint>
#include <type_traits>
namespace cg = cooperative_groups;

#define LAS __attribute__((address_space(3)))
typedef unsigned short bf16_t;
typedef short bf16x8 __attribute__((ext_vector_type(8)));
typedef short s16x4 __attribute__((ext_vector_type(4)));
typedef float f32x4 __attribute__((ext_vector_type(4)));
typedef float f32x16 __attribute__((ext_vector_type(16)));
typedef unsigned u32x4 __attribute__((ext_vector_type(4)));
typedef unsigned u32x2 __attribute__((ext_vector_type(2)));

constexpr int D = 1024, BATCH = 4, SEQ = 8192, T = BATCH * SEQ;
constexpr int IN_COLS = 3352;
constexpr int NTHREADS = 512;
constexpr int H1S = 1088;
constexpr float RMS_EPS = 1e-6f;
constexpr float LOG2E = 1.4426950408889634f;
constexpr float Y_SCALE = 16.0f, Y_INV = 1.0f / 16.0f;

constexpr size_t MB = 1024ull * 1024ull;
constexpr size_t WS_CTL    = 0;
constexpr size_t WS_MOD    = 64 * 1024;
constexpr size_t WS_LB     = WS_MOD + 4 * 6144 * 4;
constexpr size_t WS_CB     = WS_LB + 2048;
constexpr size_t WS_H      = 1 * MB;
constexpr size_t WS_SS     = WS_H + 72 * MB;
constexpr size_t WS_RW     = WS_SS + 1 * MB;
constexpr size_t WS_BUCKET = WS_RW + 1 * MB;
constexpr size_t WS_HIDR   = WS_BUCKET + 16 * MB;
constexpr size_t WS_WSM    = WS_HIDR + 32 * MB;
constexpr size_t WS_WOUT   = WS_WSM, WS_WRS = WS_WSM + 2 * MB, WS_WSD = WS_WSM + 4 * MB;
constexpr size_t WS_WBE    = WS_WSM + 5 * MB;
constexpr size_t WS_WBGU   = WS_WBE, WS_WBD = WS_WBE + 256 * MB;
constexpr size_t WS_SCORES = WS_WBE;
constexpr size_t WS_HIDS   = WS_SCORES + 32 * MB;
constexpr size_t WS_WIN    = WS_HIDS + 16 * MB;
constexpr size_t WS_Y      = WS_WBE + 384 * MB;
constexpr size_t WS_Q      = WS_Y;
constexpr size_t WS_KV     = WS_Q + 32 * MB;
constexpr size_t WS_GATES  = WS_KV + 48 * MB;
constexpr size_t WS_HQ     = WS_GATES + 4 * MB;
constexpr size_t WS_LOGF   = WS_HQ + 32 * MB;
constexpr size_t WS_HV     = WS_LOGF + 64 * MB;
constexpr size_t WS_HG     = WS_HV + 32 * MB;
constexpr size_t WS_CMPH   = WS_HG + 32 * MB;
constexpr size_t WS_KC     = WS_CMPH + 4 * MB;
constexpr size_t WS_VC     = WS_KC + 1 * MB;
constexpr size_t WS_HL     = WS_VC + 1 * MB;
constexpr size_t WS_HD     = WS_HL + 32 * MB;
constexpr size_t WS_MIX    = WS_HD + 1 * MB;
constexpr size_t WS_END    = WS_Y + 512 * MB;
constexpr int BCAP = 16384;
constexpr int CTL_CNT = 1024;
constexpr int CTL_Q2 = 2048, CTL_Q3 = 2112;
constexpr int CTL_BAR = 16384;

struct Params {
    const float *x, *c, *ada_w, *ada_b, *norm1_w, *norm2_w, *w_in, *q_norm_w, *k_norm_w, *cmp_pos, *cmp_w1, *cmp_b1, *cmp_w2,
        *attn_out_norm_w, *hgrn_lb, *rec_out_norm_w, *w_out, *router_w, *router_bias, *exp_wg, *exp_wu, *exp_wd, *sh_wg, *sh_wu, *sh_wd;
    float* out;
    unsigned char* ws;
};

__device__ __forceinline__ unsigned cvtpk(float lo, float hi) { unsigned r; asm("v_cvt_pk_bf16_f32 %0, %1, %2" : "=v"(r) : "v"(lo), "v"(hi)); return r; }
__device__ __forceinline__ int opaque_tid() { int t = threadIdx.x; asm volatile("" : "+v"(t)); return t; }
__device__ __forceinline__ float bf2f(bf16_t v) { return __uint_as_float(((unsigned)v) << 16); }
__device__ __forceinline__ float sigmoidf_(float v) { return __builtin_amdgcn_rcpf(1.0f + __expf(-v)); }
__device__ __forceinline__ float siluf_(float v) { return v * __builtin_amdgcn_rcpf(1.0f + __expf(-v)); }
__device__ __forceinline__ float wave_sum(float v) {
#pragma unroll
    for (int o = 1; o < 64; o <<= 1) v += __shfl_xor(v, o);
    return v;
}
__device__ __forceinline__ s16x4 lds_tr(const LAS unsigned char* p) {
    return __builtin_bit_cast(s16x4, __builtin_amdgcn_ds_read_tr16_b64_v4i16((LAS s16x4*)p));
}

#define XB_TMO      128
#define XB_XCNT(j)  (256  + 64 * (j))
#define XB_XSUB(j)  (1280 + 64 * (j))
#define XB_XGEN(j)  (2304 + 64 * (j))
#define XB_TOP      3328
#define XB_TOPGEN   3392
#define XCD_BAR_WORDS 3456
#define XB_SPIN_CAP (1u << 22)
__device__ __forceinline__ unsigned xb_ld(unsigned* p)              { return __hip_atomic_load(p, __ATOMIC_RELAXED, __HIP_MEMORY_SCOPE_AGENT); }
__device__ __forceinline__ unsigned xb_add(unsigned* p, unsigned v) { return __hip_atomic_fetch_add(p, v, __ATOMIC_RELAXED, __HIP_MEMORY_SCOPE_AGENT); }
__device__ __forceinline__ unsigned xb_xcc_id() { return (unsigned)__builtin_amdgcn_s_getreg((3 << 11) | 20) & 0xFu; }
#define XB_SPIN(cond, bar) do { unsigned _sp = 0; while (cond) { __builtin_amdgcn_s_sleep(1); \
    if ((++_sp & 255u) == 0u) { if (xb_ld(&(bar)[XB_TMO])) break; if (_sp > XB_SPIN_CAP) { atomicAdd(&(bar)[XB_TMO], 1u); break; } } } } while (0)
struct XcdBarrier { unsigned* bar; unsigned x; volatile LAS unsigned* st; };
__device__ __forceinline__ XcdBarrier xcd_barrier_post(unsigned* bar, volatile LAS unsigned* st) {
    XcdBarrier b; b.bar = bar; b.x = xb_xcc_id(); b.st = st;
    if (threadIdx.x == 0) (void)xb_add(&bar[XB_XCNT(b.x)], 1u);
    return b;
}
__device__ __forceinline__ void xcd_barrier_complete(unsigned* bar, unsigned x, unsigned& nloc, unsigned& nx) {
    const unsigned G = gridDim.x * gridDim.y * gridDim.z;
    unsigned sum, cnt, mine, sp = 0u;
    for (;;) {
        sum = 0u; cnt = 0u; mine = 0u;
#pragma unroll
        for (unsigned j = 0; j < 16; ++j) { const unsigned c = xb_ld(&bar[XB_XCNT(j)]); sum += c; cnt += (c > 0u) ? 1u : 0u; mine = (j == x) ? c : mine; }
        if (sum == G) break;
        __builtin_amdgcn_s_sleep(1);
        if ((++sp & 255u) == 0u) { if (xb_ld(&bar[XB_TMO])) break; if (sp > XB_SPIN_CAP) { atomicAdd(&bar[XB_TMO], 1u); break; } }
    }
    nloc = mine > 0u ? mine : 1u; nx = cnt > 0u ? cnt : 1u;
}
__device__ __forceinline__ void xcd_barrier(const XcdBarrier& b) {
    asm volatile("s_waitcnt vmcnt(0)" ::: "memory");
    __syncthreads();
    if (threadIdx.x == 0) {
        unsigned* bar = b.bar;
        __builtin_amdgcn_s_waitcnt(0);
        unsigned nloc = b.st[0], nx = b.st[1];
        if (nloc == 0u) { xcd_barrier_complete(bar, b.x, nloc, nx); b.st[0] = nloc; b.st[1] = nx; }
        const unsigned old = xb_add(&bar[XB_XSUB(b.x)], 1u);
        const unsigned gen = old / nloc;
        if (old + 1u == (gen + 1u) * nloc) {
            __builtin_amdgcn_fence(__ATOMIC_RELEASE, "agent");
            asm volatile("s_waitcnt vmcnt(0)" ::: "memory");
            const unsigned og = xb_add(&bar[XB_TOP], 1u);
            const unsigned tg = og / nx;
            if (og + 1u == (tg + 1u) * nx) xb_add(&bar[XB_TOPGEN], 1u);
            else XB_SPIN(xb_ld(&bar[XB_TOPGEN]) == tg, bar);
            __builtin_amdgcn_fence(__ATOMIC_ACQUIRE, "agent");
            xb_add(&bar[XB_XGEN(b.x)], 1u);
            asm volatile("s_waitcnt vmcnt(0)" ::: "memory");
        } else {
            XB_SPIN(xb_ld(&bar[XB_XGEN(b.x)]) == gen, bar);
            __builtin_amdgcn_fence(__ATOMIC_ACQUIRE, "agent");
            asm volatile("s_waitcnt vmcnt(0)" ::: "memory");
        }
    }
    __syncthreads();
}

template <int WM, int WN> struct GemmT {
    static constexpr int BM = 64 * WM, BN = 64 * WN;
    static constexpr int A_BYTES = BM * 128, B_BYTES = 64 * BN * 2, STAGE = A_BYTES + B_BYTES, LDS_BYTES = 2 * STAGE;
    static constexpr int NB4 = BN / 32;
    static constexpr int B_ROW4 = BN / 4;

    static __device__ __forceinline__ void run(f32x4 (&acc)[4][4], const bf16_t* const (&arow)[WM], int a_kstride, const float* Bp, int ldb, int KT, LAS unsigned char* lds) {
        const int tid = opaque_tid(), lane = tid & 63, wid = tid >> 6, wm = wid / WN, wn = wid % WN, fr = lane & 15, fq = lane >> 4;
#pragma unroll
        for (int mi = 0; mi < 4; ++mi)
#pragma unroll
            for (int ni = 0; ni < 4; ++ni) acc[mi][ni] = (f32x4){0.f, 0.f, 0.f, 0.f};
        const int achunk = tid & 7;
        u32x4 areg[WM]; f32x4 breg[NB4];
        int a_wr[WM];
#pragma unroll
        for (int p = 0; p < WM; ++p) { const int row = p * 64 + (tid >> 3); a_wr[p] = row * 128 + ((achunk ^ ((row >> 1) & 7)) << 4); }
        int b_wr[NB4]; int b_goff[NB4];
#pragma unroll
        for (int p = 0; p < NB4; ++p) { const int i = tid + NTHREADS * p, k = i / B_ROW4, n = (i % B_ROW4) * 4;
            const int f = (k & 3) | (((k >> 3) & 1) << 2);
            b_wr[p] = A_BYTES + k * (BN * 2) + (((n >> 4) ^ f) << 5) + ((n & 15) << 1); b_goff[p] = k * ldb + n; }
        int a_rd[4][2];
#pragma unroll
        for (int mi = 0; mi < 4; ++mi)
#pragma unroll
            for (int ks = 0; ks < 2; ++ks) { const int row = wm * 64 + mi * 16 + fr, ch = ks * 4 + fq; a_rd[mi][ks] = row * 128 + ((ch ^ ((row >> 1) & 7)) << 4); }
        int b_rd[2][2];
        int b_f[2][2];
#pragma unroll
        for (int ks = 0; ks < 2; ++ks)
#pragma unroll
            for (int t = 0; t < 2; ++t) { const int k = ks * 32 + 8 * fq + 4 * t + (fr >> 2); b_f[ks][t] = (k & 3) | (((k >> 3) & 1) << 2);
                b_rd[ks][t] = A_BYTES + k * (BN * 2) + ((fr & 3) << 3); }

        auto gload = [&](int kt) {
#pragma unroll
            for (int p = 0; p < WM; ++p) areg[p] = *(const u32x4*)(arow[p] + (size_t)kt * a_kstride + achunk * 8);
            const float* bk = Bp + (size_t)kt * 64 * ldb;
#pragma unroll
            for (int p = 0; p < NB4; ++p) breg[p] = *(const f32x4*)(bk + b_goff[p]);
        };
        auto lstore = [&](int buf) {
            LAS unsigned char* base = lds + buf * STAGE;
#pragma unroll
            for (int p = 0; p < WM; ++p) *(LAS u32x4*)(base + a_wr[p]) = areg[p];
#pragma unroll
            for (int p = 0; p < NB4; ++p) { u32x2 w; w.x = cvtpk(breg[p].x, breg[p].y); w.y = cvtpk(breg[p].z, breg[p].w); *(LAS u32x2*)(base + b_wr[p]) = w; }
        };
        gload(0); lstore(0); __syncthreads();
        for (int kt = 0; kt < KT; ++kt) {
            if (kt + 1 < KT) gload(kt + 1);
            __builtin_amdgcn_sched_barrier(0);
            const LAS unsigned char* base = lds + (kt & 1) * STAGE;
#pragma unroll
            for (int ks = 0; ks < 2; ++ks) {
                bf16x8 af[4], bfr[4];
#pragma unroll
                for (int mi = 0; mi < 4; ++mi) af[mi] = *(const LAS bf16x8*)(base + a_rd[mi][ks]);
#pragma unroll
                for (int ni = 0; ni < 4; ++ni) {
                    const int u0 = wn * 4 + ni;
                    const s16x4 lo = lds_tr(base + b_rd[ks][0] + ((u0 ^ b_f[ks][0]) << 5));
                    const s16x4 hi = lds_tr(base + b_rd[ks][1] + ((u0 ^ b_f[ks][1]) << 5));
                    bfr[ni] = (bf16x8){lo[0], lo[1], lo[2], lo[3], hi[0], hi[1], hi[2], hi[3]};
                }
#pragma unroll
                for (int mi = 0; mi < 4; ++mi)
#pragma unroll
                    for (int ni = 0; ni < 4; ++ni) acc[mi][ni] = __builtin_amdgcn_mfma_f32_16x16x32_bf16(bfr[ni], af[mi], acc[mi][ni], 0, 0, 0);
            }
            if (kt + 1 < KT) lstore((kt + 1) & 1);
            __syncthreads();
        }
    }
};

struct Gemm2 {
    static constexpr int A_BYTES = 32768, STAGE = 65536, LDS_BYTES = 2 * STAGE;
    static __device__ __forceinline__ int a_row(int i, int w, int lane) { return (i * 8 + w) * 8 + (lane >> 3); }
    static __device__ __forceinline__ int a_chunk(int row, int lane) { return (lane & 7) ^ ((row >> 1) & 7); }
    static __device__ __forceinline__ int b_k(int i, int w, int lane) { return (i * 8 + w) * 2 + (lane >> 5); }
    static __device__ __forceinline__ int b_n(int k, int lane) { return ((((lane & 31) >> 1) ^ fk2(k)) << 4) + ((lane & 1) << 3); }
    static __device__ __forceinline__ int fk2(int r) { return (r & 3) | (((r >> 3) & 1) << 2); }

    static __device__ __forceinline__ void run(f32x4 (&acc)[4][8], const bf16_t* const (&aptr)[4], int a_kstride, const bf16_t* const (&bptr)[4], size_t b_kstride, int KT, LAS unsigned char* lds) {
        const int tid = opaque_tid(), lane = tid & 63, wid = tid >> 6, wm = wid >> 1, wn = wid & 1, fr = lane & 15, fq = lane >> 4;
        const int wu = __builtin_amdgcn_readfirstlane(wid);
#pragma unroll
        for (int mi = 0; mi < 4; ++mi)
#pragma unroll
            for (int ni = 0; ni < 8; ++ni) acc[mi][ni] = (f32x4){0.f, 0.f, 0.f, 0.f};
        int a_rd[4][2];
#pragma unroll
        for (int mi = 0; mi < 4; ++mi)
#pragma unroll
            for (int ks = 0; ks < 2; ++ks) { const int row = wm * 64 + mi * 16 + fr, ch = ks * 4 + fq; a_rd[mi][ks] = row * 128 + ((ch ^ ((row >> 1) & 7)) << 4); }
        int b_rd[2][2], b_f[2][2];
#pragma unroll
        for (int ks = 0; ks < 2; ++ks)
#pragma unroll
            for (int t = 0; t < 2; ++t) { const int k = ks * 32 + 8 * fq + 4 * t + (fr >> 2); b_f[ks][t] = fk2(k); b_rd[ks][t] = A_BYTES + k * 512 + ((fr & 3) << 3); }
        auto issue = [&](int kt, int buf) {
            LAS unsigned char* base = lds + buf * STAGE + wu * 1024;
#pragma unroll
            for (int i = 0; i < 4; ++i) __builtin_amdgcn_global_load_lds((const unsigned*)(aptr[i] + (size_t)kt * a_kstride), (LAS unsigned*)(base + i * 8192), 16, 0, 0);
#pragma unroll
            for (int i = 0; i < 4; ++i) __builtin_amdgcn_global_load_lds((const unsigned*)(bptr[i] + (size_t)kt * b_kstride), (LAS unsigned*)(base + A_BYTES + i * 8192), 16, 0, 0);
        };
        issue(0, 0);
        for (int kt = 0; kt < KT; ++kt) {
            asm volatile("s_waitcnt vmcnt(0)" ::: "memory");
            __syncthreads();
            if (kt + 1 < KT) issue(kt + 1, (kt + 1) & 1);
            const LAS unsigned char* base = lds + (kt & 1) * STAGE;
#pragma unroll
            for (int ks = 0; ks < 2; ++ks) {
                bf16x8 af[4];
#pragma unroll
                for (int mi = 0; mi < 4; ++mi) af[mi] = *(const LAS bf16x8*)(base + a_rd[mi][ks]);
#pragma unroll
                for (int ni = 0; ni < 8; ++ni) {
                    const int u0 = wn * 8 + ni;
                    const s16x4 lo = lds_tr(base + b_rd[ks][0] + ((u0 ^ b_f[ks][0]) << 5));
                    const s16x4 hi = lds_tr(base + b_rd[ks][1] + ((u0 ^ b_f[ks][1]) << 5));
                    const bf16x8 bfr = (bf16x8){lo[0], lo[1], lo[2], lo[3], hi[0], hi[1], hi[2], hi[3]};
#pragma unroll
                    for (int mi = 0; mi < 4; ++mi) acc[mi][ni] = __builtin_amdgcn_mfma_f32_16x16x32_bf16(bfr, af[mi], acc[mi][ni], 0, 0, 0);
                }
            }
        }
        __syncthreads();
    }
};

struct Gemm3 {
    static constexpr int A_BYTES = 16384, STAGE = 32768, LDS_BYTES = 4 * STAGE;
    static __device__ __forceinline__ int a_row(int i, int w, int lane) { return (i * 8 + w) * 16 + (lane >> 2); }
    static __device__ __forceinline__ int a_chunk(int row, int lane) { return (lane & 3) ^ ((row >> 1) & 3); }
    static __device__ __forceinline__ int b_k(int i, int w, int lane) { return (i * 8 + w) * 2 + (lane >> 5); }
    static __device__ __forceinline__ int fk2(int r) { return (r & 3) | (((r >> 3) & 1) << 2); }
    static __device__ __forceinline__ int b_n(int k, int lane) { return ((((lane & 31) >> 1) ^ fk2(k)) << 4) + ((lane & 1) << 3); }
    static __device__ __forceinline__ void run(f32x4 (&acc)[4][8], const bf16_t* const (&aptr)[2], int a_kstride, const bf16_t* const (&bptr)[2], size_t b_kstride, int KT, LAS unsigned char* lds) {
        const int tid = opaque_tid(), lane = tid & 63, wid = tid >> 6, wm = wid >> 1, wn = wid & 1, fr = lane & 15, fq = lane >> 4;
        const int wu = __builtin_amdgcn_readfirstlane(wid);
#pragma unroll
        for (int mi = 0; mi < 4; ++mi)
#pragma unroll
            for (int ni = 0; ni < 8; ++ni) acc[mi][ni] = (f32x4){0.f, 0.f, 0.f, 0.f};
        int a_rd[4];
#pragma unroll
        for (int mi = 0; mi < 4; ++mi) { const int row = wm * 64 + mi * 16 + fr; a_rd[mi] = row * 64 + ((fq ^ ((row >> 1) & 3)) << 4); }
        int b_rd[2], b_f[2];
#pragma unroll
        for (int t = 0; t < 2; ++t) { const int k = 8 * fq + 4 * t + (fr >> 2); b_f[t] = fk2(k); b_rd[t] = A_BYTES + k * 512 + ((fr & 3) << 3); }
        auto issue = [&](int kt) {
            LAS unsigned char* base = lds + (kt & 3) * STAGE + wu * 1024;
#pragma unroll
            for (int i = 0; i < 2; ++i) __builtin_amdgcn_global_load_lds((const unsigned*)(aptr[i] + (size_t)kt * a_kstride), (LAS unsigned*)(base + i * 8192), 16, 0, 0);
#pragma unroll
            for (int i = 0; i < 2; ++i) __builtin_amdgcn_global_load_lds((const unsigned*)(bptr[i] + (size_t)kt * b_kstride), (LAS unsigned*)(base + A_BYTES + i * 8192), 16, 0, 0);
        };
        asm volatile("s_waitcnt vmcnt(0)" ::: "memory");
        issue(0); if (KT > 1) issue(1); if (KT > 2) issue(2);
        for (int kt = 0; kt < KT; ++kt) {
            const int rem = KT - 1 - kt;
            if (rem >= 2) asm volatile("s_waitcnt vmcnt(8)" ::: "memory"); else if (rem == 1) asm volatile("s_waitcnt vmcnt(4)" ::: "memory"); else asm volatile("s_waitcnt vmcnt(0)" ::: "memory");
            __builtin_amdgcn_s_barrier();
            asm volatile("" ::: "memory");
            if (kt + 3 < KT) issue(kt + 3);
            const LAS unsigned char* base = lds + (kt & 3) * STAGE;
            bf16x8 af[4];
#pragma unroll
            for (int mi = 0; mi < 4; ++mi) af[mi] = *(const LAS bf16x8*)(base + a_rd[mi]);
#pragma unroll
            for (int ni = 0; ni < 8; ++ni) {
                const int u0 = wn * 8 + ni;
                const s16x4 lo = lds_tr(base + b_rd[0] + ((u0 ^ b_f[0]) << 5));
                const s16x4 hi = lds_tr(base + b_rd[1] + ((u0 ^ b_f[1]) << 5));
                const bf16x8 bfr = (bf16x8){lo[0], lo[1], lo[2], lo[3], hi[0], hi[1], hi[2], hi[3]};
#pragma unroll
                for (int mi = 0; mi < 4; ++mi) acc[mi][ni] = __builtin_amdgcn_mfma_f32_16x16x32_bf16(bfr, af[mi], acc[mi][ni], 0, 0, 0);
            }
        }
        asm volatile("s_waitcnt lgkmcnt(0)" ::: "memory");
        __builtin_amdgcn_s_barrier();
        asm volatile("" ::: "memory");
    }
};

struct Gemm4 {
    static constexpr int A_BYTES = 16384, STAGE = 32768, LDS_BYTES = 2 * STAGE;
    static __device__ __forceinline__ int fk2(int r) { return (r & 3) | (((r >> 3) & 1) << 2); }
    static __device__ __forceinline__ int a_row(int i, int tid) { return (tid >> 2) + 128 * i; }
    static __device__ __forceinline__ int b_k(int i, int tid) { return (tid >> 5) + 16 * i; }
    static __device__ __forceinline__ void run(f32x4 (&acc)[4][8], const bf16_t* const (&aptr)[2], int a_kstride, const bf16_t* const (&bptr)[2], size_t b_kstride, int KT, LAS unsigned char* lds) {
        const int tid = opaque_tid(), lane = tid & 63, wid = tid >> 6, wm = wid >> 1, wn = wid & 1, fr = lane & 15, fq = lane >> 4;
#pragma unroll
        for (int mi = 0; mi < 4; ++mi)
#pragma unroll
            for (int ni = 0; ni < 8; ++ni) acc[mi][ni] = (f32x4){0.f, 0.f, 0.f, 0.f};
        int a_wr[2], b_wr[2];
#pragma unroll
        for (int i = 0; i < 2; ++i) { const int row = a_row(i, tid); a_wr[i] = row * 64 + (((tid & 3) ^ ((row >> 1) & 3)) << 4);
            const int k = b_k(i, tid), n = (tid & 31) * 8; b_wr[i] = A_BYTES + k * 512 + (((n >> 4) ^ fk2(k)) << 5) + ((n & 15) << 1); }
        int a_rd[4];
#pragma unroll
        for (int mi = 0; mi < 4; ++mi) { const int row = wm * 64 + mi * 16 + fr; a_rd[mi] = row * 64 + ((fq ^ ((row >> 1) & 3)) << 4); }
        int b_rd[2], b_f[2];
#pragma unroll
        for (int t = 0; t < 2; ++t) { const int k = 8 * fq + 4 * t + (fr >> 2); b_f[t] = fk2(k); b_rd[t] = A_BYTES + k * 512 + ((fr & 3) << 3); }
        u32x4 ra0[2], rb0[2], ra1[2], rb1[2];
        auto gload = [&](int kt, u32x4 (&ra)[2], u32x4 (&rb)[2]) {
#pragma unroll
            for (int i = 0; i < 2; ++i) { ra[i] = *(const u32x4*)(aptr[i] + (size_t)kt * a_kstride); rb[i] = *(const u32x4*)(bptr[i] + (size_t)kt * b_kstride); }
        };
        auto lstore = [&](int buf, const u32x4 (&ra)[2], const u32x4 (&rb)[2]) {
            LAS unsigned char* base = lds + buf * STAGE;
#pragma unroll
            for (int i = 0; i < 2; ++i) { *(LAS u32x4*)(base + a_wr[i]) = ra[i]; *(LAS u32x4*)(base + b_wr[i]) = rb[i]; }
        };
        auto compute = [&](int buf) {
            const LAS unsigned char* base = lds + buf * STAGE;
            bf16x8 af[4];
#pragma unroll
            for (int mi = 0; mi < 4; ++mi) af[mi] = *(const LAS bf16x8*)(base + a_rd[mi]);
#pragma unroll
            for (int ni = 0; ni < 8; ++ni) {
                const int u0 = wn * 8 + ni;
                const s16x4 lo = lds_tr(base + b_rd[0] + ((u0 ^ b_f[0]) << 5));
                const s16x4 hi = lds_tr(base + b_rd[1] + ((u0 ^ b_f[1]) << 5));
                const bf16x8 bfr = (bf16x8){lo[0], lo[1], lo[2], lo[3], hi[0], hi[1], hi[2], hi[3]};
#pragma unroll
                for (int mi = 0; mi < 4; ++mi) acc[mi][ni] = __builtin_amdgcn_mfma_f32_16x16x32_bf16(bfr, af[mi], acc[mi][ni], 0, 0, 0);
            }
        };
        gload(0, ra0, rb0); gload(1, ra1, rb1);
        lstore(0, ra0, rb0); __syncthreads();
        for (int kt = 0; kt < KT; kt += 2) {
            gload(kt + 2 < KT ? kt + 2 : KT - 1, ra0, rb0);
            __builtin_amdgcn_sched_barrier(0);
            compute(0);
            lstore(1, ra1, rb1);
            __syncthreads();
            gload(kt + 3 < KT ? kt + 3 : KT - 1, ra1, rb1);
            __builtin_amdgcn_sched_barrier(0);
            compute(1);
            lstore(0, ra0, rb0);
            __syncthreads();
        }
    }

    template <class F> static __device__ __forceinline__ void run_stream(F& f, int NSEG, int KT, int a_kstride, size_t b_kstride, LAS unsigned char* lds) {
        const int tid = opaque_tid(), lane = tid & 63, wid = tid >> 6, wm = wid >> 1, wn = wid & 1, fr = lane & 15, fq = lane >> 4;
        f32x4 acc[4][8];
#pragma unroll
        for (int mi = 0; mi < 4; ++mi)
#pragma unroll
            for (int ni = 0; ni < 8; ++ni) acc[mi][ni] = (f32x4){0.f, 0.f, 0.f, 0.f};
        int a_wr[2], b_wr[2];
#pragma unroll
        for (int i = 0; i < 2; ++i) { const int row = a_row(i, tid); a_wr[i] = row * 64 + (((tid & 3) ^ ((row >> 1) & 3)) << 4);
            const int k = b_k(i, tid), n = (tid & 31) * 8; b_wr[i] = A_BYTES + k * 512 + (((n >> 4) ^ fk2(k)) << 5) + ((n & 15) << 1); }
        int a_rd[4];
#pragma unroll
        for (int mi = 0; mi < 4; ++mi) { const int row = wm * 64 + mi * 16 + fr; a_rd[mi] = row * 64 + ((fq ^ ((row >> 1) & 3)) << 4); }
        int b_rd[2], b_f[2];
#pragma unroll
        for (int t = 0; t < 2; ++t) { const int k = 8 * fq + 4 * t + (fr >> 2); b_f[t] = fk2(k); b_rd[t] = A_BYTES + k * 512 + ((fr & 3) << 3); }
        const bf16_t* aptr[2]; const bf16_t* bptr[2];
        u32x4 ra0[2], rb0[2], ra1[2], rb1[2];
        int lseg = 0, lkt = 0;
        auto gload = [&](u32x4 (&ra)[2], u32x4 (&rb)[2]) {
#pragma unroll
            for (int i = 0; i < 2; ++i) { ra[i] = *(const u32x4*)(aptr[i] + (size_t)lkt * a_kstride); rb[i] = *(const u32x4*)(bptr[i] + (size_t)lkt * b_kstride); }
            if (lkt + 1 < KT) ++lkt; else if (lseg + 1 < NSEG) { lkt = 0; ++lseg; f.ptrs(lseg, aptr, bptr); }
        };
        auto lstore = [&](int buf, const u32x4 (&ra)[2], const u32x4 (&rb)[2]) {
            LAS unsigned char* base = lds + buf * STAGE;
#pragma unroll
            for (int i = 0; i < 2; ++i) { *(LAS u32x4*)(base + a_wr[i]) = ra[i]; *(LAS u32x4*)(base + b_wr[i]) = rb[i]; }
        };
        auto compute = [&](int buf) {
            const LAS unsigned char* base = lds + buf * STAGE;
            bf16x8 af[4];
#pragma unroll
            for (int mi = 0; mi < 4; ++mi) af[mi] = *(const LAS bf16x8*)(base + a_rd[mi]);
#pragma unroll
            for (int ni = 0; ni < 8; ++ni) {
                const int u0 = wn * 8 + ni;
                const s16x4 lo = lds_tr(base + b_rd[0] + ((u0 ^ b_f[0]) << 5));
                const s16x4 hi = lds_tr(base + b_rd[1] + ((u0 ^ b_f[1]) << 5));
                const bf16x8 bfr = (bf16x8){lo[0], lo[1], lo[2], lo[3], hi[0], hi[1], hi[2], hi[3]};
#pragma unroll
                for (int mi = 0; mi < 4; ++mi) acc[mi][ni] = __builtin_amdgcn_mfma_f32_16x16x32_bf16(bfr, af[mi], acc[mi][ni], 0, 0, 0);
            }
        };
        f.ptrs(0, aptr, bptr);
        gload(ra0, rb0); gload(ra1, rb1);
        lstore(0, ra0, rb0); __syncthreads();
        int cseg = 0, ckt = 0;
        const int total = NSEG * KT;
#pragma unroll 1
        for (int g = 0; g < total; g += 2) {
            gload(ra0, rb0);
            __builtin_amdgcn_sched_barrier(0);
            compute(0);
            lstore(1, ra1, rb1);
            __syncthreads();
            gload(ra1, rb1);
            __builtin_amdgcn_sched_barrier(0);
            compute(1);
            lstore(0, ra0, rb0);
            __syncthreads();
            ckt += 2;
            if (ckt == KT) {
                f.epi(cseg, acc);
#pragma unroll
                for (int mi = 0; mi < 4; ++mi)
#pragma unroll
                    for (int ni = 0; ni < 8; ++ni) acc[mi][ni] = (f32x4){0.f, 0.f, 0.f, 0.f};
                ckt = 0; ++cseg;
            }
        }
    }
};

template <bool BF32> struct Gemm5 {
    static constexpr int A_BYTES = 16384, STAGE = 32768, LDS_BYTES = 2 * STAGE;
    static __device__ __forceinline__ int fk2(int r) { return (r & 3) | (((r >> 3) & 1) << 2); }
    static __device__ __forceinline__ int a_row(int i, int tid) { return (tid >> 2) + 128 * i; }
    static __device__ __forceinline__ int b_k(int i, int tid) { return (tid >> 5) + 16 * i; }
    typedef typename std::conditional<BF32, float, bf16_t>::type b_t;
    static __device__ __forceinline__ void run(f32x4 (&acc)[4][8], const bf16_t* const (&aptr)[2], int a_kstride, const b_t* const (&bptr)[2], size_t b_kstride, int KT, LAS unsigned char* lds) {
        const int tid = opaque_tid(), lane = tid & 63, wid = tid >> 6, wm = wid >> 1, wn = wid & 1, fr = lane & 15, fq = lane >> 4;
#pragma unroll
        for (int mi = 0; mi < 4; ++mi)
#pragma unroll
            for (int ni = 0; ni < 8; ++ni) acc[mi][ni] = (f32x4){0.f, 0.f, 0.f, 0.f};
        int a_wr[2], b_wr[2];
#pragma unroll
        for (int i = 0; i < 2; ++i) { const int row = a_row(i, tid); a_wr[i] = row * 64 + (((tid & 3) ^ ((row >> 1) & 3)) << 4);
            const int k = b_k(i, tid), n = (tid & 31) * 8; b_wr[i] = A_BYTES + k * 512 + (((n >> 4) ^ fk2(k)) << 5) + ((n & 15) << 1); }
        int a_rd[4];
#pragma unroll
        for (int mi = 0; mi < 4; ++mi) { const int row = wm * 64 + mi * 16 + fr; a_rd[mi] = row * 64 + ((fq ^ ((row >> 1) & 3)) << 4); }
        int b_rd[2], b_f[2];
#pragma unroll
        for (int t = 0; t < 2; ++t) { const int k = 8 * fq + 4 * t + (fr >> 2); b_f[t] = fk2(k); b_rd[t] = A_BYTES + k * 512 + ((fr & 3) << 3); }
        u32x4 ra[2]; u32x4 rb[2]; f32x4 rbf[2][2];
        auto gload = [&](int kt) {
#pragma unroll
            for (int i = 0; i < 2; ++i) { ra[i] = *(const u32x4*)(aptr[i] + (size_t)kt * a_kstride);
                if (BF32) { const float* p = (const float*)bptr[i] + (size_t)kt * b_kstride; rbf[i][0] = *(const f32x4*)p; rbf[i][1] = *(const f32x4*)(p + 4); }
                else rb[i] = *(const u32x4*)((const bf16_t*)bptr[i] + (size_t)kt * b_kstride); }
        };
        auto lstore = [&](int buf) {
            LAS unsigned char* base = lds + buf * STAGE;
#pragma unroll
            for (int i = 0; i < 2; ++i) { *(LAS u32x4*)(base + a_wr[i]) = ra[i];
                if (BF32) { u32x4 w; w.x = cvtpk(rbf[i][0].x, rbf[i][0].y); w.y = cvtpk(rbf[i][0].z, rbf[i][0].w); w.z = cvtpk(rbf[i][1].x, rbf[i][1].y); w.w = cvtpk(rbf[i][1].z, rbf[i][1].w); *(LAS u32x4*)(base + b_wr[i]) = w; }
                else *(LAS u32x4*)(base + b_wr[i]) = rb[i]; }
        };
        auto compute = [&](int buf) {
            const LAS unsigned char* base = lds + buf * STAGE;
            bf16x8 af[4];
#pragma unroll
            for (int mi = 0; mi < 4; ++mi) af[mi] = *(const LAS bf16x8*)(base + a_rd[mi]);
#pragma unroll
            for (int ni = 0; ni < 8; ++ni) {
                const int u0 = wn * 8 + ni;
                const s16x4 lo = lds_tr(base + b_rd[0] + ((u0 ^ b_f[0]) << 5));
                const s16x4 hi = lds_tr(base + b_rd[1] + ((u0 ^ b_f[1]) << 5));
                const bf16x8 bfr = (bf16x8){lo[0], lo[1], lo[2], lo[3], hi[0], hi[1], hi[2], hi[3]};
#pragma unroll
                for (int mi = 0; mi < 4; ++mi) acc[mi][ni] = __builtin_amdgcn_mfma_f32_16x16x32_bf16(bfr, af[mi], acc[mi][ni], 0, 0, 0);
            }
        };
        gload(0); lstore(0); __syncthreads();
#pragma unroll 1
        for (int kt = 0; kt < KT; ++kt) {
            gload(kt + 1 < KT ? kt + 1 : KT - 1);
            __builtin_amdgcn_sched_barrier(0);
            compute(kt & 1);
            lstore((kt + 1) & 1);
            __syncthreads();
        }
    }

    template <class F> static __device__ __forceinline__ void run_stream(F& f, int NSEG, int KT, int a_kstride, size_t b_kstride, LAS unsigned char* lds) {
        const int tid = opaque_tid(), lane = tid & 63, wid = tid >> 6, wm = wid >> 1, wn = wid & 1, fr = lane & 15, fq = lane >> 4;
        f32x4 acc[4][8];
#pragma unroll
        for (int mi = 0; mi < 4; ++mi)
#pragma unroll
            for (int ni = 0; ni < 8; ++ni) acc[mi][ni] = (f32x4){0.f, 0.f, 0.f, 0.f};
        int a_wr[2], b_wr[2];
#pragma unroll
        for (int i = 0; i < 2; ++i) { const int row = a_row(i, tid); a_wr[i] = row * 64 + (((tid & 3) ^ ((row >> 1) & 3)) << 4);
            const int k = b_k(i, tid), n = (tid & 31) * 8; b_wr[i] = A_BYTES + k * 512 + (((n >> 4) ^ fk2(k)) << 5) + ((n & 15) << 1); }
        int a_rd[4];
#pragma unroll
        for (int mi = 0; mi < 4; ++mi) { const int row = wm * 64 + mi * 16 + fr; a_rd[mi] = row * 64 + ((fq ^ ((row >> 1) & 3)) << 4); }
        int b_rd[2], b_f[2];
#pragma unroll
        for (int t = 0; t < 2; ++t) { const int k = 8 * fq + 4 * t + (fr >> 2); b_f[t] = fk2(k); b_rd[t] = A_BYTES + k * 512 + ((fr & 3) << 3); }
        const bf16_t* aptr[2]; const b_t* bptr[2];
        u32x4 ra[2]; u32x4 rb[2]; f32x4 rbf[2][2];
        auto gload = [&](int kt) {
#pragma unroll
            for (int i = 0; i < 2; ++i) { ra[i] = *(const u32x4*)(aptr[i] + (size_t)kt * a_kstride);
                if (BF32) { const float* p = (const float*)bptr[i] + (size_t)kt * b_kstride; rbf[i][0] = *(const f32x4*)p; rbf[i][1] = *(const f32x4*)(p + 4); }
                else rb[i] = *(const u32x4*)((const bf16_t*)bptr[i] + (size_t)kt * b_kstride); }
        };
        auto lstore = [&](int buf) {
            LAS unsigned char* base = lds + buf * STAGE;
#pragma unroll
            for (int i = 0; i < 2; ++i) { *(LAS u32x4*)(base + a_wr[i]) = ra[i];
                if (BF32) { u32x4 w; w.x = cvtpk(rbf[i][0].x, rbf[i][0].y); w.y = cvtpk(rbf[i][0].z, rbf[i][0].w); w.z = cvtpk(rbf[i][1].x, rbf[i][1].y); w.w = cvtpk(rbf[i][1].z, rbf[i][1].w); *(LAS u32x4*)(base + b_wr[i]) = w; }
                else *(LAS u32x4*)(base + b_wr[i]) = rb[i]; }
        };
        auto compute = [&](int buf) {
            const LAS unsigned char* base = lds + buf * STAGE;
            bf16x8 af[4];
#pragma unroll
            for (int mi = 0; mi < 4; ++mi) af[mi] = *(const LAS bf16x8*)(base + a_rd[mi]);
#pragma unroll
            for (int ni = 0; ni < 8; ++ni) {
                const int u0 = wn * 8 + ni;
                const s16x4 lo = lds_tr(base + b_rd[0] + ((u0 ^ b_f[0]) << 5));
                const s16x4 hi = lds_tr(base + b_rd[1] + ((u0 ^ b_f[1]) << 5));
                const bf16x8 bfr = (bf16x8){lo[0], lo[1], lo[2], lo[3], hi[0], hi[1], hi[2], hi[3]};
#pragma unroll
                for (int mi = 0; mi < 4; ++mi) acc[mi][ni] = __builtin_amdgcn_mfma_f32_16x16x32_bf16(bfr, af[mi], acc[mi][ni], 0, 0, 0);
            }
        };
        f.ptrs(0, aptr, bptr);
        gload(0); lstore(0); __syncthreads();
        int seg = 0, kt = 0;
        const int total = NSEG * KT;
#pragma unroll 1
        for (int g = 0; g < total; ++g) {
            int nkt = kt + 1, nsg = seg; if (nkt == KT) { nkt = 0; nsg = seg + 1; }
            if (nkt == 0 && nsg < NSEG) f.ptrs(nsg, aptr, bptr);
            gload(nsg < NSEG ? nkt : KT - 1);
            __builtin_amdgcn_sched_barrier(0);
            compute(g & 1);
            lstore((g + 1) & 1);
            __syncthreads();
            if (nkt == 0) {
                f.epi(seg, acc);
#pragma unroll
                for (int mi = 0; mi < 4; ++mi)
#pragma unroll
                    for (int ni = 0; ni < 8; ++ni) acc[mi][ni] = (f32x4){0.f, 0.f, 0.f, 0.f};
            }
            seg = nsg; kt = nkt;
        }
    }
};

__device__ __forceinline__ void phase_mod(const Params& P, LAS unsigned char* lds) {
    const int tid = threadIdx.x;
    float* mod = (float*)(P.ws + WS_MOD);
    LAS float* sc = (LAS float*)lds;
    LAS float* red = (LAS float*)(lds + 16384);
    for (int i = tid; i < 4096; i += NTHREADS) sc[i] = siluf_(P.c[i]);
    __syncthreads();
    const int kq = tid >> 5, cl = tid & 31;
    for (int u = blockIdx.x; u < 192; u += gridDim.x) {
        const int j = u * 32 + cl;
        float a0 = 0.f, a1 = 0.f, a2 = 0.f, a3 = 0.f;
#pragma unroll 8
        for (int k = kq; k < 1024; k += 16) { const float w = P.ada_w[(size_t)k * 6144 + j];
            a0 += sc[k] * w; a1 += sc[1024 + k] * w; a2 += sc[2048 + k] * w; a3 += sc[3072 + k] * w; }
        red[(kq * 4 + 0) * 32 + cl] = a0; red[(kq * 4 + 1) * 32 + cl] = a1; red[(kq * 4 + 2) * 32 + cl] = a2; red[(kq * 4 + 3) * 32 + cl] = a3;
        __syncthreads();
        if (tid < 128) { const int b = tid >> 5; float s = 0.f;
#pragma unroll
            for (int q = 0; q < 16; ++q) s += red[(q * 4 + b) * 32 + cl];
            mod[b * 6144 + j] = s + P.ada_b[j]; }
        __syncthreads();
    }
    for (int u = blockIdx.x; u < 16; u += gridDim.x) {
        const int sel = u >> 3, j = (u & 7) * 32 + cl;
        const float* w1 = P.cmp_w1 + (size_t)sel * 2048 * 256; const float* pos = P.cmp_pos + sel * 2048;
        float a0 = 0.f;
#pragma unroll 8
        for (int k = kq; k < 2048; k += 16) a0 += pos[k] * w1[(size_t)k * 256 + j];
        red[kq * 32 + cl] = a0;
        __syncthreads();
        if (tid < 32) { float s = 0.f;
#pragma unroll
            for (int q = 0; q < 16; ++q) s += red[q * 32 + cl];
            ((float*)(P.ws + WS_CB))[sel * 256 + j] = s + P.cmp_b1[sel * 256 + j]; }
        __syncthreads();
    }
    {
        bf16_t* wb = (bf16_t*)(P.ws + WS_WIN);
        const int gt = blockIdx.x * NTHREADS + tid, NG = gridDim.x * NTHREADS;
        for (int i = gt; i < 1024 * (3584 / 8); i += NG) { const int k = i / 448, c8 = (i % 448) * 8;
            const int sc_ = c8 < 1280 ? c8 : (c8 < 3328 ? c8 + 24 : c8 - 2048);
            u32x4 o = (u32x4){0u, 0u, 0u, 0u};
            if (c8 < 3352) { const f32x4 a = *(const f32x4*)(P.w_in + (size_t)k * IN_COLS + sc_), b2 = *(const f32x4*)(P.w_in + (size_t)k * IN_COLS + sc_ + 4);
                o.x = cvtpk(a.x, a.y); o.y = cvtpk(a.z, a.w); o.z = cvtpk(b2.x, b2.y); o.w = cvtpk(b2.z, b2.w); }
            *(u32x4*)(wb + (size_t)k * 3584 + c8) = o; }
    }
    if (blockIdx.x == gridDim.x - 2) {
        for (int i = tid; i < 2 * 8 * 64; i += NTHREADS) { const int t2 = i >> 9, bg = (i >> 6) & 7, d = i & 63;
            ((bf16_t*)(P.ws + (t2 ? WS_VC : WS_KC)))[((size_t)bg * 512 + 511) * 64 + d] = 0; }
    }
    if (blockIdx.x == gridDim.x - 1) {
        float* lb = (float*)(P.ws + WS_LB);
        for (int i = tid; i < 512; i += NTHREADS) { const float p0 = P.hgrn_lb[i], p1 = P.hgrn_lb[512 + i]; lb[i] = 1.0f / (1.0f + __expf(p1 - p0)); }
    }
}

__device__ __forceinline__ void norm_mod_rows(const float* x, const float* w, const float* mod_sh, const float* mod_sc, bf16_t* h, int hs) {
    const int lane = threadIdx.x & 63, gw = blockIdx.x * (NTHREADS / 64) + (threadIdx.x >> 6), NGW = gridDim.x * (NTHREADS / 64);
    for (int m = gw; m < T; m += NGW) {
        const int b = m / SEQ;
        const f32x4* xr = (const f32x4*)(x + (size_t)m * D) + lane;
        f32x4 v[4]; float s = 0.f;
#pragma unroll
        for (int j = 0; j < 4; ++j) { v[j] = xr[64 * j]; s += (v[j].x * v[j].x + v[j].y * v[j].y) + (v[j].z * v[j].z + v[j].w * v[j].w); }
        const float rstd = rsqrtf(wave_sum(s) * (1.f / D) + RMS_EPS);
        u32x2* o = (u32x2*)(h + (size_t)m * hs) + lane;
#pragma unroll
        for (int j = 0; j < 4; ++j) {
            const int col = (lane + 64 * j) * 4;
            const f32x4 wv = *(const f32x4*)(w + col), scv = *(const f32x4*)(mod_sc + b * 6144 + col), shv = *(const f32x4*)(mod_sh + b * 6144 + col);
            f32x4 r;
            r.x = v[j].x * rstd * wv.x * (1.f + scv.x) + shv.x; r.y = v[j].y * rstd * wv.y * (1.f + scv.y) + shv.y;
            r.z = v[j].z * rstd * wv.z * (1.f + scv.z) + shv.z; r.w = v[j].w * rstd * wv.w * (1.f + scv.w) + shv.w;
            u32x2 pk; pk.x = cvtpk(r.x, r.y); pk.y = cvtpk(r.z, r.w); o[64 * j] = pk;
        }
    }
}

__device__ __forceinline__ void phase_inproj(const Params& P, LAS unsigned char* lds) {
    const int tid = opaque_tid(), lane = tid & 63, wid = tid >> 6, wm = wid >> 1, wn = wid & 1, fr = lane & 15, fq = lane >> 4;
    const bf16_t* h1 = (const bf16_t*)(P.ws + WS_H); const bf16_t* wb = (const bf16_t*)(P.ws + WS_WIN);
    bf16_t* qo = (bf16_t*)(P.ws + WS_Q); bf16_t* kvo = (bf16_t*)(P.ws + WS_KV); float* gates = (float*)(P.ws + WS_GATES);
    bf16_t* hq = (bf16_t*)(P.ws + WS_HQ); float* logf = (float*)(P.ws + WS_LOGF); bf16_t* hv = (bf16_t*)(P.ws + WS_HV); bf16_t* hg = (bf16_t*)(P.ws + WS_HG);
    const float* lb = (const float*)(P.ws + WS_LB);
    constexpr int NRT = T / 256, NCT = 14;
    const int nx = (gridDim.x % 8 == 0) ? 8 : 1, xl = blockIdx.x % nx, li = blockIdx.x / nx, nloc = gridDim.x / nx;
    for (int v = li; v < (NRT / nx) * NCT; v += nloc) {
        const int rg = v / (NCT * 4), rem = v % (NCT * 4), ct = rem >> 2, rt = xl + nx * (rg * 4 + (rem & 3));
        const bf16_t* aptr[2]; const bf16_t* bptr[2];
#pragma unroll
        for (int i = 0; i < 2; ++i) { aptr[i] = h1 + (size_t)(rt * 256 + Gemm4::a_row(i, tid)) * H1S + 8 * (tid & 3);
            bptr[i] = wb + (size_t)Gemm4::b_k(i, tid) * 3584 + ct * 256 + 8 * (tid & 31); }
        f32x4 acc[4][8];
        Gemm4::run(acc, aptr, 32, bptr, (size_t)32 * 3584, D / 32, lds);
        const int row0 = rt * 256 + wm * 64 + fr;
        const int cw = wn * 128 + 4 * fq;
        if (ct < 5) {
            const bool is_q = ct < 2; const int seg = (ct - 2) * 2 + wn;
            const bool do_norm = is_q || seg == 2 || seg == 4;
            const float* nw = is_q ? P.q_norm_w : (P.k_norm_w + (seg == 2 ? 64 : 128));
            const float osc = is_q ? 0.125f : 1.0f;
#pragma unroll
            for (int hh = 0; hh < 2; ++hh) {
                f32x4 wv[4];
#pragma unroll
                for (int n4 = 0; n4 < 4; ++n4) wv[n4] = do_norm ? *(const f32x4*)(nw + n4 * 16 + 4 * fq) : (f32x4){1.f, 1.f, 1.f, 1.f};
#pragma unroll
                for (int mi = 0; mi < 4; ++mi) {
                    float rstd = 1.f;
                    if (do_norm) { float s = 0.f;
#pragma unroll
                        for (int n4 = 0; n4 < 4; ++n4) { const f32x4 a = acc[mi][hh * 4 + n4]; s += (a.x * a.x + a.y * a.y) + (a.z * a.z + a.w * a.w); }
                        s += __shfl_xor(s, 16); s += __shfl_xor(s, 32);
                        rstd = rsqrtf(s * (1.f / 64.f) + RMS_EPS) * osc; }
                    const size_t m = (size_t)(row0 + mi * 16);
                    bf16_t* dst = is_q ? (qo + m * 512 + ct * 256 + cw + hh * 64) : (kvo + m * 768 + (ct - 2) * 256 + cw + hh * 64);
#pragma unroll
                    for (int n4 = 0; n4 < 4; ++n4) { const f32x4 a = acc[mi][hh * 4 + n4]; u32x2 pk;
                        pk.x = cvtpk(a.x * rstd * wv[n4].x, a.y * rstd * wv[n4].y); pk.y = cvtpk(a.z * rstd * wv[n4].z, a.w * rstd * wv[n4].w);
                        *(u32x2*)(dst + n4 * 16) = pk; }
                }
            }
        } else if (ct == 13) {
            if (wn == 0) {
#pragma unroll
                for (int mi = 0; mi < 4; ++mi) { const size_t m = (size_t)(row0 + mi * 16);
#pragma unroll
                    for (int ni = 0; ni < 2; ++ni) { const int c = ni * 16 + 4 * fq; if (c < 24) { const f32x4 a = acc[mi][ni];
                            *(f32x4*)(gates + m * 24 + c) = (f32x4){sigmoidf_(a.x), sigmoidf_(a.y), sigmoidf_(a.z), sigmoidf_(a.w)}; } } }
            }
        } else {
            const int hs = (ct - 5) >> 1, cc = ((ct - 5) & 1) * 256 + cw;
#pragma unroll
            for (int mi = 0; mi < 4; ++mi) { const size_t m = (size_t)(row0 + mi * 16);
#pragma unroll
                for (int ni = 0; ni < 8; ++ni) { const f32x4 a = acc[mi][ni]; const int c = cc + ni * 16;
                    if (hs == 0) { const float s = 0.08838834764831845f; u32x2 pk; pk.x = cvtpk(siluf_(a.x) * s, siluf_(a.y) * s); pk.y = cvtpk(siluf_(a.z) * s, siluf_(a.w) * s); *(u32x2*)(hq + m * 512 + c) = pk; }
                    else if (hs == 1) { const f32x4 l = *(const f32x4*)(lb + c); f32x4 o;
                        o.x = __logf(l.x + (1.f - l.x) * sigmoidf_(a.x)); o.y = __logf(l.y + (1.f - l.y) * sigmoidf_(a.y));
                        o.z = __logf(l.z + (1.f - l.z) * sigmoidf_(a.z)); o.w = __logf(l.w + (1.f - l.w) * sigmoidf_(a.w)); *(f32x4*)(logf + m * 512 + c) = o; }
                    else if (hs == 2) { u32x2 pk; pk.x = cvtpk(a.x, a.y); pk.y = cvtpk(a.z, a.w); *(u32x2*)(hv + m * 512 + c) = pk; }
                    else { u32x2 pk; pk.x = cvtpk(sigmoidf_(a.x), sigmoidf_(a.y)); pk.y = cvtpk(sigmoidf_(a.z), sigmoidf_(a.w)); *(u32x2*)(hg + m * 512 + c) = pk; }
                } }
        }
    }
}

__device__ __forceinline__ float gelu_tanh(float x) {
    const float u = 0.7978845608028654f * (x + 0.044715f * x * x * x);
    const float th = 1.0f - 2.0f / (1.0f + __expf(2.0f * u));
    return 0.5f * x * (1.0f + th);
}
__device__ __forceinline__ void compress_unit(const Params& P, LAS unsigned char* lds, int u) {
    typedef GemmT<2, 4> G;
    const int tid = opaque_tid(), lane = tid & 63, wid = tid >> 6, wm = wid >> 2, wn = wid & 3, fr = lane & 15, fq = lane >> 4;
    const int sel = u >> 5, rt = u & 31;
    const bf16_t* kv = (const bf16_t*)(P.ws + WS_KV);
    bf16_t* cmph = (bf16_t*)(P.ws + WS_CMPH) + (size_t)sel * 4096 * 256;
    const float* cb = (const float*)(P.ws + WS_CB) + sel * 256;
    const bf16_t* arow[2];
#pragma unroll
    for (int p = 0; p < 2; ++p) { int r = rt * 128 + p * 64 + (tid >> 3); r = r < 4088 ? r : 4087;
        const int b = r / 1022, rem = r % 1022, i = rem >> 1, g = rem & 1;
        arow[p] = kv + (size_t)(b * SEQ + 16 * i) * 768 + sel * 128 + g * 64; }
    f32x4 acc[4][4];
    G::run(acc, arow, 768, P.cmp_w1 + (size_t)sel * 2048 * 256, 256, 32, lds);
#pragma unroll
    for (int mi = 0; mi < 4; ++mi) { const size_t row = (size_t)(rt * 128 + wm * 64 + mi * 16 + fr);
#pragma unroll
        for (int ni = 0; ni < 4; ++ni) { const int col = wn * 64 + ni * 16 + 4 * fq; const f32x4 a = acc[mi][ni]; const f32x4 bb = *(const f32x4*)(cb + col);
            u32x2 pk; pk.x = cvtpk(gelu_tanh(a.x + bb.x), gelu_tanh(a.y + bb.y)); pk.y = cvtpk(gelu_tanh(a.z + bb.z), gelu_tanh(a.w + bb.w));
            *(u32x2*)(cmph + row * 256 + col) = pk; } }
    __syncthreads();
    {
        const int row = tid >> 2, cq = tid & 3;
        const bf16_t* hr = cmph + (size_t)(rt * 128 + row) * 256;
        const float* w2 = P.cmp_w2 + (size_t)sel * 256 * 64 + cq * 16;
        float o[16];
#pragma unroll
        for (int j = 0; j < 16; ++j) o[j] = 0.f;
        for (int k8 = 0; k8 < 256; k8 += 8) {
            const u32x4 hv = *(const u32x4*)(hr + k8);
#pragma unroll
            for (int kk = 0; kk < 8; ++kk) {
                const unsigned wd = hv[kk >> 1]; const float a = (kk & 1) ? __uint_as_float(wd & 0xffff0000u) : __uint_as_float(wd << 16);
                const float* wr = w2 + (size_t)(k8 + kk) * 64;
#pragma unroll
                for (int j4 = 0; j4 < 4; ++j4) { const f32x4 w = *(const f32x4*)(wr + j4 * 4);
                    o[j4 * 4 + 0] += a * w.x; o[j4 * 4 + 1] += a * w.y; o[j4 * 4 + 2] += a * w.z; o[j4 * 4 + 3] += a * w.w; }
            }
        }
        if (sel == 0) { float s = 0.f;
#pragma unroll
            for (int j = 0; j < 16; ++j) s += o[j] * o[j];
            s += __shfl_xor(s, 1); s += __shfl_xor(s, 2);
            const float rstd = rsqrtf(s * (1.f / 64.f) + RMS_EPS);
#pragma unroll
            for (int j = 0; j < 16; ++j) o[j] *= rstd * P.k_norm_w[cq * 16 + j]; }
        const int r = rt * 128 + row;
        if (r < 4088) { const int b = r / 1022, rem = r % 1022, i = rem >> 1, g = rem & 1;
            bf16_t* dst = (bf16_t*)(P.ws + (sel ? WS_VC : WS_KC)) + ((size_t)(b * 2 + g) * 512 + i) * 64 + cq * 16;
            u32x4 w0, w1;
            w0.x = cvtpk(o[0], o[1]); w0.y = cvtpk(o[2], o[3]); w0.z = cvtpk(o[4], o[5]); w0.w = cvtpk(o[6], o[7]);
            w1.x = cvtpk(o[8], o[9]); w1.y = cvtpk(o[10], o[11]); w1.z = cvtpk(o[12], o[13]); w1.w = cvtpk(o[14], o[15]);
            *(u32x4*)dst = w0; *(u32x4*)(dst + 8) = w1; }
    }
    __syncthreads();
}

__device__ __forceinline__ int off_row128(int row, int ch) { return row * 128 + ((ch ^ ((row >> 1) & 7)) << 4); }
__device__ __forceinline__ int off_row256(int row, int ch) { return row * 256 + ((ch ^ (row & 15)) << 4); }
__device__ __forceinline__ int fk_(int r) { return (r & 3) | (((r >> 3) & 1) << 2); }
__device__ __forceinline__ int off_tr256(int row, int col) { return row * 256 + ((((col >> 4) ^ fk_(row)) << 5) + ((col & 15) << 1)); }
constexpr int HL_QT = 0, HL_KT = 16384, HL_KH = 32768, HL_V = 49152, HL_SB = 65536, HL_P = 98304  , HL_TOT = 106496  , HL_RED = 110592  , HL_END = 111104;

template <int MODE> __device__ __forceinline__ void hgrn_unit(const Params& P, LAS unsigned char* lds, int u) {
    const int tid = opaque_tid(), lane = tid & 63, wid = tid >> 6, fr = lane & 15, fq = lane >> 4;
    const int b = u >> 7, h = (u >> 5) & 3, sc = u & 31;
    const bf16_t* hq = (const bf16_t*)(P.ws + WS_HQ); const float* logf = (const float*)(P.ws + WS_LOGF);
    const bf16_t* hv = (const bf16_t*)(P.ws + WS_HV); const bf16_t* hg = (const bf16_t*)(P.ws + WS_HG);
    float* HLs = (float*)(P.ws + WS_HL); float* HDs = (float*)(P.ws + WS_HD);
    bf16_t* mix = (bf16_t*)(P.ws + WS_MIX);
    LAS float* tot = (LAS float*)(lds + HL_TOT); LAS float* red = (LAS float*)(lds + HL_RED);
    f32x4 st[8];
#pragma unroll
    for (int vt = 0; vt < 8; ++vt) st[vt] = (f32x4){0.f, 0.f, 0.f, 0.f};
    if (MODE == 1) {
        const int kk = 16 * wid + fr;
#pragma unroll 4
        for (int j = 0; j < sc; ++j) {
            const float* Lj = HLs + (size_t)(u - sc + j) * 16384 + kk * 128 + 4 * fq; const float dj = HDs[(size_t)(u - sc + j) * 128 + kk];
#pragma unroll
            for (int vt = 0; vt < 8; ++vt) { const f32x4 l = *(const f32x4*)(Lj + vt * 16); st[vt] = st[vt] * dj + l; }
        }
    }
    float dsum = 0.f;
    const int kp = tid & 63, te = tid >> 6;
    for (int c = 0; c < 4; ++c) {
        const size_t tok0 = (size_t)b * SEQ + sc * 256 + c * 64;
        float lf0[8], lf1[8], cs0[8], cs1[8];
        { float a0 = 0.f, a1 = 0.f;
#pragma unroll
          for (int i = 0; i < 8; ++i) { const float2 v = *(const float2*)(logf + (tok0 + te * 8 + i) * 512 + h * 128 + 2 * kp); lf0[i] = v.x; lf1[i] = v.y; a0 += v.x; a1 += v.y; cs0[i] = a0; cs1[i] = a1; }
          tot[te * 128 + 2 * kp] = a0; tot[te * 128 + 2 * kp + 1] = a1; }
#pragma unroll
        for (int i = 0; i < 2; ++i) { const int pc = tid + NTHREADS * i, row = pc >> 4, c8 = (pc & 15) * 8;
            const u32x4 v = *(const u32x4*)(hv + (tok0 + row) * 512 + h * 128 + c8);
            *(LAS u32x4*)(lds + HL_V + off_tr256(row, c8)) = v; }
        if (MODE == 1 ) {
#pragma unroll
            for (int vt = 0; vt < 8; ++vt) { u32x2 pk; pk.x = cvtpk(st[vt].x, st[vt].y); pk.y = cvtpk(st[vt].z, st[vt].w);
                *(LAS u32x2*)(lds + HL_SB + off_tr256(16 * wid + fr, 16 * vt + 4 * fq)) = pk; }
        }
        __syncthreads();
        float pre0 = 0.f, pre1 = 0.f, last0 = 0.f, last1 = 0.f;
#pragma unroll
        for (int e = 0; e < 8; ++e) { const float t0 = tot[e * 128 + 2 * kp], t1 = tot[e * 128 + 2 * kp + 1]; if (e < te) { pre0 += t0; pre1 += t1; } last0 += t0; last1 += t1; }
#pragma unroll
        for (int i = 0; i < 8; ++i) {
            const int t = te * 8 + i;
            const float c0 = cs0[i] + pre0, c1 = cs1[i] + pre1;
            const float k0 = 1.f - __expf(lf0[i]), k1 = 1.f - __expf(lf1[i]);
            const unsigned khat = cvtpk(k0 * __expf(last0 - c0), k1 * __expf(last1 - c1));
            *(LAS unsigned*)(lds + HL_KH + off_tr256(t, 2 * kp)) = khat;
            if (MODE == 1) {
                const unsigned qraw = *(const unsigned*)(hq + (tok0 + t) * 512 + h * 128 + 2 * kp);
                const float q0 = __uint_as_float(qraw << 16), q1 = __uint_as_float(qraw & 0xffff0000u);
                const unsigned qt = cvtpk(q0 * __expf(c0), q1 * __expf(c1));
                const unsigned kt = cvtpk(k0 * __expf(fminf(-c0, 80.f)), k1 * __expf(fminf(-c1, 80.f)));
                const int o = off_row256(t, kp >> 2) + ((kp & 3) << 2);
                *(LAS unsigned*)(lds + HL_QT + o) = qt; *(LAS unsigned*)(lds + HL_KT + o) = kt;
            }
        }
        const float dec = __expf(tot[0 * 128 + 16 * wid + fr] + tot[1 * 128 + 16 * wid + fr] + tot[2 * 128 + 16 * wid + fr] + tot[3 * 128 + 16 * wid + fr]
                                 + tot[4 * 128 + 16 * wid + fr] + tot[5 * 128 + 16 * wid + fr] + tot[6 * 128 + 16 * wid + fr] + tot[7 * 128 + 16 * wid + fr]);
        if (MODE == 0 && tid < 128) { float s = 0.f;
#pragma unroll
            for (int e = 0; e < 8; ++e) s += tot[e * 128 + tid];
            dsum += s; }
        __syncthreads();
        f32x4 oacc[4];
        if (MODE == 1) {
            { const int tt = wid & 3;
#pragma unroll
              for (int si = 0; si < 2; ++si) { const int stl = 2 * (wid >> 2) + si;
                  f32x4 sacc = (f32x4){0.f, 0.f, 0.f, 0.f};
                  if (stl <= tt) {
#pragma unroll
                      for (int ks = 0; ks < 4; ++ks) {
                          const bf16x8 a = *(const LAS bf16x8*)(lds + HL_KT + off_row256(stl * 16 + fr, ks * 4 + fq));
                          const bf16x8 bq = *(const LAS bf16x8*)(lds + HL_QT + off_row256(tt * 16 + fr, ks * 4 + fq));
                          sacc = __builtin_amdgcn_mfma_f32_16x16x32_bf16(a, bq, sacc, 0, 0, 0);
                      }
                  }
                  const int t = tt * 16 + fr, s0 = stl * 16 + 4 * fq;
                  u32x2 pk; pk.x = cvtpk(s0 + 0 <= t ? sacc.x : 0.f, s0 + 1 <= t ? sacc.y : 0.f); pk.y = cvtpk(s0 + 2 <= t ? sacc.z : 0.f, s0 + 3 <= t ? sacc.w : 0.f);
                  *(LAS u32x2*)(lds + HL_P + off_row128(t, s0 >> 3) + ((s0 & 7) << 1)) = pk; }
            }
            __syncthreads();
            { const int tt = wid >> 1;
#pragma unroll
              for (int i = 0; i < 4; ++i) { const int vt = 4 * (wid & 1) + i;
                  f32x4 a = (f32x4){0.f, 0.f, 0.f, 0.f};
#pragma unroll
                  for (int ks = 0; ks < 2; ++ks) {
                      const int kr = ks * 32 + 8 * fq + (fr >> 2);
                      const s16x4 lo = lds_tr(lds + HL_V + off_tr256(kr, vt * 16 + 4 * (fr & 3))), hi = lds_tr(lds + HL_V + off_tr256(kr + 4, vt * 16 + 4 * (fr & 3)));
                      const bf16x8 va = (bf16x8){lo[0], lo[1], lo[2], lo[3], hi[0], hi[1], hi[2], hi[3]};
                      const bf16x8 pb = *(const LAS bf16x8*)(lds + HL_P + off_row128(tt * 16 + fr, ks * 4 + fq));
                      a = __builtin_amdgcn_mfma_f32_16x16x32_bf16(va, pb, a, 0, 0, 0);
                  }
#pragma unroll
                  for (int ks = 0; ks < 4; ++ks) {
                      const int kr = ks * 32 + 8 * fq + (fr >> 2);
                      const s16x4 lo = lds_tr(lds + HL_SB + off_tr256(kr, vt * 16 + 4 * (fr & 3))), hi = lds_tr(lds + HL_SB + off_tr256(kr + 4, vt * 16 + 4 * (fr & 3)));
                      const bf16x8 sa = (bf16x8){lo[0], lo[1], lo[2], lo[3], hi[0], hi[1], hi[2], hi[3]};
                      const bf16x8 qb = *(const LAS bf16x8*)(lds + HL_QT + off_row256(tt * 16 + fr, ks * 4 + fq));
                      a = __builtin_amdgcn_mfma_f32_16x16x32_bf16(sa, qb, a, 0, 0, 0);
                  }
                  const u32x2 gr = *(const u32x2*)(hg + (tok0 + tt * 16 + fr) * 512 + h * 128 + vt * 16 + 4 * fq);
                  a.x *= __uint_as_float(gr.x << 16); a.y *= __uint_as_float(gr.x & 0xffff0000u); a.z *= __uint_as_float(gr.y << 16); a.w *= __uint_as_float(gr.y & 0xffff0000u);
                  oacc[i] = a; }
              float ss = 0.f;
#pragma unroll
              for (int i = 0; i < 4; ++i) ss += (oacc[i].x * oacc[i].x + oacc[i].y * oacc[i].y) + (oacc[i].z * oacc[i].z + oacc[i].w * oacc[i].w);
              ss += __shfl_xor(ss, 16); ss += __shfl_xor(ss, 32);
              if (fq == 0) red[(tt * 2 + (wid & 1)) * 16 + fr] = ss; }
        }
#pragma unroll
        for (int vt = 0; vt < 8; ++vt) {
            f32x4 a = st[vt] * dec;
#pragma unroll
            for (int ks = 0; ks < 2; ++ks) {
                const int kr = ks * 32 + 8 * fq + (fr >> 2);
                const s16x4 lo = lds_tr(lds + HL_V + off_tr256(kr, vt * 16 + 4 * (fr & 3))), hi = lds_tr(lds + HL_V + off_tr256(kr + 4, vt * 16 + 4 * (fr & 3)));
                const bf16x8 va = (bf16x8){lo[0], lo[1], lo[2], lo[3], hi[0], hi[1], hi[2], hi[3]};
                const s16x4 lo2 = lds_tr(lds + HL_KH + off_tr256(kr, wid * 16 + 4 * (fr & 3))), hi2 = lds_tr(lds + HL_KH + off_tr256(kr + 4, wid * 16 + 4 * (fr & 3)));
                const bf16x8 kb = (bf16x8){lo2[0], lo2[1], lo2[2], lo2[3], hi2[0], hi2[1], hi2[2], hi2[3]};
                a = __builtin_amdgcn_mfma_f32_16x16x32_bf16(va, kb, a, 0, 0, 0);
            }
            st[vt] = a;
        }
        __syncthreads();
        if (MODE == 1) {
            const int tt = wid >> 1; const float ssum = red[(tt * 2) * 16 + fr] + red[(tt * 2 + 1) * 16 + fr];
            const float rstd = rsqrtf(ssum * (1.f / 128.f) + RMS_EPS);
#pragma unroll
            for (int i = 0; i < 4; ++i) { const int v = (4 * (wid & 1) + i) * 16 + 4 * fq; const f32x4 w = *(const f32x4*)(P.rec_out_norm_w + h * 128 + v);
                u32x2 pk; pk.x = cvtpk(oacc[i].x * rstd * w.x, oacc[i].y * rstd * w.y); pk.y = cvtpk(oacc[i].z * rstd * w.z, oacc[i].w * rstd * w.w);
                *(u32x2*)(mix + (tok0 + tt * 16 + fr) * 1024 + 512 + h * 128 + v) = pk; }
        }
    }
    if (MODE == 0) {
#pragma unroll
        for (int vt = 0; vt < 8; ++vt) *(f32x4*)(HLs + (size_t)u * 16384 + (16 * wid + fr) * 128 + vt * 16 + 4 * fq) = st[vt];
        if (tid < 128) HDs[(size_t)u * 128 + tid] = __expf(dsum);
    }
    __syncthreads();
}


constexpr int NL_K = 0, NL_V = 16384, NL_IMP = 32768, NL_IMP_STRIDE = 132, NL_SELM = NL_IMP + 8 * 8 * NL_IMP_STRIDE * 4, NL_END = NL_SELM + 1024;
__device__ __forceinline__ int off_v128(int row, int ch) { return row * 128 + ((ch ^ ((row & 3) << 1)) << 4); }
#define MFMA32(a, b, c) __builtin_amdgcn_mfma_f32_32x32x16_bf16(a, b, c, 0, 0, 0)

struct NsaLane { int t; float sl2; int qi; unsigned long long mlo, mhi; };

template <int MODE> __device__ __forceinline__ void nsa_pass(LAS unsigned char* lds, const bf16_t* Kg, const bf16_t* Vg, int rs, unsigned long long ulo, unsigned long long uhi,
                                                            const bf16x8 (&qf)[4], const NsaLane& L, float inv, float& lsum, f32x16 (&O)[2], LAS float* impw) {
    const int tid = opaque_tid(), lane = tid & 63, hi = lane >> 5, c = lane & 31;
    const int ld_row = tid >> 3, ld_ch = tid & 7;
    const int kw_off = off_row128(ld_row, ld_ch), vw_off = off_v128(ld_row, ld_ch);
    u32x4 k0, v0, k1, v1, k2, v2;
    auto next = [&](int jj) -> int { ++jj; if (jj < 64) { const unsigned long long m = ulo >> jj; if (m) return jj + __builtin_ctzll(m); jj = 64; }
                                     if (jj < 128) { const unsigned long long m = uhi >> (jj - 64); if (m) return jj + __builtin_ctzll(m); } return 128; };
    int jA = next(-1), jB = jA < 128 ? next(jA) : 128, jC = jB < 128 ? next(jB) : 128;
    const int jsafe = jA < 128 ? jA : 0;
    auto ldk = [&](int jj) -> u32x4 { const int q = jj < 128 ? jj : jsafe; return *(const u32x4*)(Kg + (size_t)(q * 64 + ld_row) * rs + ld_ch * 8); };
    auto ldv = [&](int jj) -> u32x4 { const int q = jj < 128 ? jj : jsafe; return *(const u32x4*)(Vg + (size_t)(q * 64 + ld_row) * rs + ld_ch * 8); };
    k0 = ldk(jA); k1 = ldk(jB); k2 = ldk(jC);
    if (MODE != 0) { v0 = ldv(jA); v1 = ldv(jB); v2 = ldv(jC); }
    int it = 0;
    auto step = [&](u32x4& kreg, u32x4& vreg) {
        const int j = jA;
        LAS unsigned char* kb = lds + NL_K + (it & 1) * 8192; LAS unsigned char* vb = lds + NL_V + (it & 1) * 8192;
        *(LAS u32x4*)(kb + kw_off) = kreg; if (MODE != 0) *(LAS u32x4*)(vb + vw_off) = vreg;
        const int jD = jC < 128 ? next(jC) : 128;
        kreg = ldk(jD); if (MODE != 0) vreg = ldv(jD);
        __syncthreads();
        bool need = true; bool selbit = true;
        if (MODE == 2) { selbit = (j < 64 ? (L.mlo >> j) : (L.mhi >> (j - 64))) & 1ull; need = __any(selbit); }
        if (need) {
            f32x16 p0 = {}, p1 = {};
#pragma unroll
            for (int ks = 0; ks < 4; ++ks) {
                const bf16x8 a0 = *(const LAS bf16x8*)(kb + off_row128(c, 2 * ks + hi)), a1 = *(const LAS bf16x8*)(kb + off_row128(32 + c, 2 * ks + hi));
                p0 = MFMA32(a0, qf[ks], p0); p1 = MFMA32(a1, qf[ks], p1);
            }
            const int stride = (MODE <= 1) ? 16 : 1;
            const int dl = (MODE <= 1) ? (L.t - 31 - 16 * (j * 64 + 4 * hi)) : (L.t - (j * 64 + 4 * hi));
            const float nb = -L.sl2 * (float)dl, sls = L.sl2 * (float)stride;
            float rs_ = 0.f;
#pragma unroll
            for (int r = 0; r < 16; ++r) {
                const int ro0 = (r & 3) + 8 * (r >> 2), ro1 = ro0 + 32;
                const int d0 = dl - stride * ro0, d1 = dl - stride * ro1;
                bool v0 = d0 >= 0, v1 = d1 >= 0;
                if (MODE == 3) { v0 = v0 && d0 < 512; v1 = v1 && d1 < 512; }
                if (MODE == 2) { v0 = v0 && selbit; v1 = v1 && selbit; }
                float e0 = __builtin_amdgcn_exp2f(__builtin_fmaf(p0[r], LOG2E, __builtin_fmaf(sls, (float)ro0, nb)));
                float e1 = __builtin_amdgcn_exp2f(__builtin_fmaf(p1[r], LOG2E, __builtin_fmaf(sls, (float)ro1, nb)));
                e0 = v0 ? e0 : 0.f; e1 = v1 ? e1 : 0.f;
                if (MODE == 1) { e0 *= inv; e1 *= inv; }
                p0[r] = e0; p1[r] = e1; rs_ += e0 + e1;
            }
            lsum += rs_;
            if (MODE == 1) {
#pragma unroll
                for (int kt = 0; kt < 2; ++kt)
#pragma unroll
                    for (int i = 0; i < 4; ++i) {
                        float g = kt ? (p1[4 * i] + p1[4 * i + 1]) + (p1[4 * i + 2] + p1[4 * i + 3]) : (p0[4 * i] + p0[4 * i + 1]) + (p0[4 * i + 2] + p0[4 * i + 3]);
                        float l3 = kt ? p1[4 * i + 3] : p0[4 * i + 3];
                        g += __shfl_xor(g, 1); g += __shfl_xor(g, 2); l3 += __shfl_xor(l3, 1); l3 += __shfl_xor(l3, 2);
                        if ((c & 3) == 0) { const int jj = j * 16 + kt * 8 + 2 * i + hi; __hip_atomic_fetch_add(impw + L.qi * NL_IMP_STRIDE + jj, g, __ATOMIC_RELAXED, __HIP_MEMORY_SCOPE_WORKGROUP); __hip_atomic_fetch_add(impw + L.qi * NL_IMP_STRIDE + jj + 1, l3, __ATOMIC_RELAXED, __HIP_MEMORY_SCOPE_WORKGROUP); }
                    }
            }
            if (MODE != 0) {
                bf16x8 pf[4];
#pragma unroll
                for (int s4 = 0; s4 < 4; ++s4) { u32x4 w;
#pragma unroll
                    for (int e = 0; e < 4; ++e) { const int r = 8 * (s4 & 1) + 2 * e; w[e] = (s4 >> 1) ? cvtpk(p1[r], p1[r + 1]) : cvtpk(p0[r], p0[r + 1]); }
                    pf[s4] = __builtin_bit_cast(bf16x8, w); }
                const int g4 = lane >> 4, sub = g4 & 1, i16 = lane & 15, qq = i16 >> 2, pp = i16 & 3;
#pragma unroll
                for (int dt = 0; dt < 2; ++dt)
#pragma unroll
                    for (int s4 = 0; s4 < 4; ++s4) {
                        const int row = 16 * s4 + 4 * hi + qq, ch = 4 * dt + 2 * sub + (pp >> 1);
                        const s16x4 lo = lds_tr(vb + off_v128(row, ch) + 8 * (pp & 1)), hh = lds_tr(vb + off_v128(row + 8, ch) + 8 * (pp & 1));
                        const bf16x8 vf = (bf16x8){lo[0], lo[1], lo[2], lo[3], hh[0], hh[1], hh[2], hh[3]};
                        O[dt] = MFMA32(vf, pf[s4], O[dt]);
                    }
            }
        }
        jA = jB; jB = jC; jC = jD; ++it;
    };
    while (jA < 128) {
        step(k0, v0); if (jA >= 128) break;
        step(k1, v1); if (jA >= 128) break;
        step(k2, v2);
    }
    __syncthreads();
}

__device__ __forceinline__ void nsa_unit(const Params& P, LAS unsigned char* lds, int u) {
    const int tid = opaque_tid(), lane = tid & 63, wid = tid >> 6, hi = lane >> 5, c = lane & 31;
    const int b = u >> 8, g = (u >> 7) & 1, qb = u & 127;
    const bf16_t* qg = (const bf16_t*)(P.ws + WS_Q); const bf16_t* kv = (const bf16_t*)(P.ws + WS_KV);
    const bf16_t* kcn = (const bf16_t*)(P.ws + WS_KC) + (size_t)(b * 2 + g) * 512 * 64; const bf16_t* vcc = (const bf16_t*)(P.ws + WS_VC) + (size_t)(b * 2 + g) * 512 * 64;
    const float* gates = (const float*)(P.ws + WS_GATES); bf16_t* mix = (bf16_t*)(P.ws + WS_MIX);
    LAS float* impw = (LAS float*)(lds + NL_IMP) + wid * 8 * NL_IMP_STRIDE;
    LAS unsigned long long* selm = (LAS unsigned long long*)(lds + NL_SELM);
    NsaLane L; L.qi = c >> 2; const int hh = c & 3, head = g * 4 + hh;
    L.t = qb * 64 + wid * 8 + L.qi; L.sl2 = exp2f(-(float)(head + 1)) * LOG2E; L.mlo = 0; L.mhi = 0;
    const size_t tok = (size_t)b * SEQ + L.t;
    bf16x8 qf[4];
#pragma unroll
    for (int ks = 0; ks < 4; ++ks) qf[ks] = *(const bf16x8*)(qg + tok * 512 + head * 64 + 16 * ks + 8 * hi);
    for (int i = lane; i < 8 * NL_IMP_STRIDE; i += 64) impw[i] = 0.f;
    const int ncmp = qb * 4 + 3 < 511 ? qb * 4 + 3 : 511;
    const int nblk = (ncmp + 63) >> 6;
    const unsigned long long cm = nblk >= 64 ? ~0ull : ((1ull << nblk) - 1ull);
    f32x16 O[2], Ot[2]; float lsum = 0.f;
    O[0] = f32x16{}; O[1] = f32x16{};
    nsa_pass<0>(lds, kcn, vcc, 64, cm, 0ull, qf, L, 1.f, lsum, O, impw);
    lsum += __shfl_xor(lsum, 32);
    const float invc = 1.0f / fmaxf(lsum, 1e-30f);
    float dummy = 0.f;
    nsa_pass<1>(lds, kcn, vcc, 64, cm, 0ull, qf, L, invc, dummy, O, impw);
    const float* gt = gates + tok * 24 + g * 12 + hh * 3;
    const float g0 = gt[0], g1 = gt[1], g2 = gt[2];
#pragma unroll
    for (int dt = 0; dt < 2; ++dt) Ot[dt] = O[dt] * g0;
    {
        const int ncausal = qb + 1;
        for (int qi = 0; qi < 8; ++qi) {
            unsigned long long lo, hi64;
            if (ncausal <= 16) { lo = (1ull << ncausal) - 1ull; hi64 = 0ull; }
            else {
                const int j0 = lane, j1 = lane + 64;
                const bool f0 = (j0 == 0) || (j0 == qb) || (j0 == qb - 1), f1 = (j1 == qb) || (j1 == qb - 1);
                const unsigned k0 = (j0 <= qb && !f0) ? (0x80000000u | (__float_as_uint(impw[qi * NL_IMP_STRIDE + j0]) & 0x7fffff80u) | (unsigned)j0) : 0u;
                const unsigned k1 = (j1 <= qb && !f1) ? (0x80000000u | (__float_as_uint(impw[qi * NL_IMP_STRIDE + j1]) & 0x7fffff80u) | (unsigned)j1) : 0u;
                const int needn = 13;
                unsigned th = 0u;
                for (int bit = 31; bit >= 0; --bit) { const unsigned cand = th | (1u << bit);
                    const int cnt = __popcll(__ballot(k0 >= cand)) + __popcll(__ballot(k1 >= cand));
                    if (cnt >= needn) th = cand; }
                lo = __ballot(f0 || (k0 >= th && k0 != 0u)); hi64 = __ballot(f1 || (k1 >= th && k1 != 0u));
            }
            if (lane == 0) { selm[(wid * 8 + qi) * 2] = lo; selm[(wid * 8 + qi) * 2 + 1] = hi64; }
        }
    }
    __syncthreads();
    unsigned long long ulo = selm[lane * 2], uhi = selm[lane * 2 + 1];
#pragma unroll
    for (int o = 1; o < 64; o <<= 1) { ulo |= __shfl_xor(ulo, o); uhi |= __shfl_xor(uhi, o); }
    L.mlo = selm[(wid * 8 + L.qi) * 2]; L.mhi = selm[(wid * 8 + L.qi) * 2 + 1];
    const bf16_t* kvb = kv + (size_t)b * SEQ * 768 + g * 64;
    O[0] = f32x16{}; O[1] = f32x16{}; lsum = 0.f;
    nsa_pass<2>(lds, kvb + 256, kvb + 384, 768, ulo, uhi, qf, L, 1.f, lsum, O, impw);
    lsum += __shfl_xor(lsum, 32);
    { const float sc = g1 / fmaxf(lsum, 1e-30f);
#pragma unroll
      for (int dt = 0; dt < 2; ++dt) Ot[dt] += O[dt] * sc; }
    {
        const int jlo = qb >= 8 ? qb - 8 : 0;
        unsigned long long wlo = 0ull, whi = 0ull;
        for (int jj = jlo; jj <= qb; ++jj) { if (jj < 64) wlo |= 1ull << jj; else whi |= 1ull << (jj - 64); }
        O[0] = f32x16{}; O[1] = f32x16{}; lsum = 0.f;
        nsa_pass<3>(lds, kvb + 512, kvb + 640, 768, wlo, whi, qf, L, 1.f, lsum, O, impw);
        lsum += __shfl_xor(lsum, 32);
        const float sc = g2 / fmaxf(lsum, 1e-30f);
#pragma unroll
        for (int dt = 0; dt < 2; ++dt) Ot[dt] += O[dt] * sc;
    }
    float ss = 0.f;
#pragma unroll
    for (int dt = 0; dt < 2; ++dt)
#pragma unroll
        for (int r = 0; r < 16; ++r) ss += Ot[dt][r] * Ot[dt][r];
    ss += __shfl_xor(ss, 32);
    const float rstd = rsqrtf(ss * (1.f / 64.f) + RMS_EPS);
#pragma unroll
    for (int dt = 0; dt < 2; ++dt)
#pragma unroll
        for (int r4 = 0; r4 < 4; ++r4) { const int d = 32 * dt + 8 * r4 + 4 * hi; const f32x4 w = *(const f32x4*)(P.attn_out_norm_w + head * 64 + d);
            u32x2 pk; pk.x = cvtpk(Ot[dt][4 * r4] * rstd * w.x, Ot[dt][4 * r4 + 1] * rstd * w.y); pk.y = cvtpk(Ot[dt][4 * r4 + 2] * rstd * w.z, Ot[dt][4 * r4 + 3] * rstd * w.w);
            *(u32x2*)(mix + tok * 1024 + head * 64 + d) = pk; }
    __syncthreads();
}


__device__ __forceinline__ void phase_cvt_small(const Params& P) {
    const int tid = threadIdx.x;
    {
        const int gt = blockIdx.x * NTHREADS + tid, NG = gridDim.x * NTHREADS;
        bf16_t* wo = (bf16_t*)(P.ws + WS_WOUT); bf16_t* wrs = (bf16_t*)(P.ws + WS_WRS); bf16_t* wsd = (bf16_t*)(P.ws + WS_WSD);
        for (int i = gt; i < 1024 * 128; i += NG) { const f32x4 a = *(const f32x4*)(P.w_out + (size_t)i * 8), b2 = *(const f32x4*)(P.w_out + (size_t)i * 8 + 4);
            *(u32x4*)(wo + (size_t)i * 8) = (u32x4){cvtpk(a.x, a.y), cvtpk(a.z, a.w), cvtpk(b2.x, b2.y), cvtpk(b2.z, b2.w)}; }
        for (int i = gt; i < 256 * 128; i += NG) { const f32x4 a = *(const f32x4*)(P.sh_wd + (size_t)i * 8), b2 = *(const f32x4*)(P.sh_wd + (size_t)i * 8 + 4);
            *(u32x4*)(wsd + (size_t)i * 8) = (u32x4){cvtpk(a.x, a.y), cvtpk(a.z, a.w), cvtpk(b2.x, b2.y), cvtpk(b2.z, b2.w)}; }
        for (int i = gt; i < 1024 * 96; i += NG) { const int k = i / 96, c8 = (i % 96) * 8;
            const float* s;
            if (c8 < 256) s = P.router_w + (size_t)k * 256 + c8;
            else { const int cc = c8 - 256, t = cc >> 8, u16 = (cc & 255) >> 4; s = ((u16 & 1) ? P.sh_wu : P.sh_wg) + (size_t)k * 256 + t * 128 + (u16 >> 1) * 16 + (cc & 8); }
            const f32x4 a = *(const f32x4*)s, b2 = *(const f32x4*)(s + 4);
            *(u32x4*)(wrs + (size_t)k * 768 + c8) = (u32x4){cvtpk(a.x, a.y), cvtpk(a.z, a.w), cvtpk(b2.x, b2.y), cvtpk(b2.z, b2.w)}; }
    }
}

__device__ __forceinline__ void route_token(const Params& P, int t, int lane) {
    const float* scores = (const float*)(P.ws + WS_SCORES) + (size_t)t * 256;
    const f32x4 s4 = *(const f32x4*)(scores + 4 * lane); const f32x4 b4 = *(const f32x4*)(P.router_bias + 4 * lane);
    float sc[4] = {s4.x, s4.y, s4.z, s4.w};
    float bs[4] = {s4.x + b4.x, s4.y + b4.y, s4.z + b4.z, s4.w + b4.w};
    float m1 = fmaxf(bs[0], bs[1]), m2 = fminf(bs[0], bs[1]);
    { const float v = bs[2]; const float n1 = fmaxf(m1, v); m2 = fmaxf(fminf(m1, v), m2); m1 = n1; }
    { const float v = bs[3]; const float n1 = fmaxf(m1, v); m2 = fmaxf(fminf(m1, v), m2); m1 = n1; }
#pragma unroll
    for (int o = 1; o < 8; o <<= 1) { const float o1 = __shfl_xor(m1, o), o2 = __shfl_xor(m2, o); const float n1 = fmaxf(m1, o1); m2 = fmaxf(fminf(m1, o1), fmaxf(m2, o2)); m1 = n1; }
    const float gs = m1 + m2;
    const int grp = lane >> 3;
    int rank = 0;
#pragma unroll
    for (int g2 = 0; g2 < 8; ++g2) { const float og = __shfl(gs, g2 * 8); rank += (og > gs || (og == gs && g2 < grp)) ? 1 : 0; }
    const bool gsel = rank < 4;
    float mv[4];
#pragma unroll
    for (int i = 0; i < 4; ++i) mv[i] = gsel ? bs[i] : -INFINITY;
    int myidx = -1; float myw = 0.f; float wsum = 0.f;
#pragma unroll 1
    for (int k = 0; k < 8; ++k) {
        float bv = mv[0]; int bi = 4 * lane;
#pragma unroll
        for (int i = 1; i < 4; ++i) if (mv[i] > bv) { bv = mv[i]; bi = 4 * lane + i; }
#pragma unroll
        for (int o = 1; o < 64; o <<= 1) { const float ov = __shfl_xor(bv, o); const int oi = __shfl_xor(bi, o); if (ov > bv || (ov == bv && oi < bi)) { bv = ov; bi = oi; } }
        const int wl = bi >> 2, wc = bi & 3;
        const float mine = wc == 0 ? sc[0] : (wc == 1 ? sc[1] : (wc == 2 ? sc[2] : sc[3]));
        const float wv = __shfl(mine, wl);
        wsum += wv;
        if (lane == k) { myidx = bi; myw = wv; }
        if (lane == wl) {
#pragma unroll
            for (int i = 0; i < 4; ++i) if (i == wc) mv[i] = -INFINITY; }
    }
    if (lane < 8) {
        int* cnt = (int*)(P.ws + WS_CTL + CTL_CNT);
        const int pos = atomicAdd(cnt + myidx, 1);
        if (pos < BCAP) ((int*)(P.ws + WS_BUCKET))[(size_t)myidx * BCAP + pos] = t * 8 + lane;
        ((float*)(P.ws + WS_RW))[(size_t)t * 8 + lane] = myw / wsum * 2.5f;
    }
}


__device__ __forceinline__ void phase_p4a(const Params& P, LAS unsigned char* lds) {
    typedef Gemm4 G;
    const int tid = opaque_tid(), lane = tid & 63, wid = tid >> 6, wm = wid >> 1, wn = wid & 1, fr = lane & 15, fq = lane >> 4;
    struct F { const Params& P;
        __device__ __forceinline__ void ptrs(int seg, const bf16_t* (&aptr)[2], const bf16_t* (&bptr)[2]) const {
            const int tid = opaque_tid(), lane = tid & 63, wid = tid >> 6, wm = wid >> 1, wn = wid & 1, fr = lane & 15, fq = lane >> 4, c8 = 8 * (tid & 31); (void)wm; (void)wn; (void)fr; (void)fq; (void)c8;
            const int u = blockIdx.x + seg * gridDim.x, rt = u >> 2, ct = u & 3;
            const bf16_t* mix = (const bf16_t*)(P.ws + WS_MIX); const bf16_t* wo = (const bf16_t*)(P.ws + WS_WOUT);
#pragma unroll
            for (int i = 0; i < 2; ++i) { aptr[i] = mix + (size_t)(rt * 256 + G::a_row(i, tid)) * 1024 + 8 * (tid & 3); bptr[i] = wo + (size_t)G::b_k(i, tid) * 1024 + ct * 256 + 8 * (tid & 31); } }
        __device__ __forceinline__ void epi(int seg, f32x4 (&acc)[4][8]) const {
            const int tid = opaque_tid(), lane = tid & 63, wid = tid >> 6, wm = wid >> 1, wn = wid & 1, fr = lane & 15, fq = lane >> 4, c8 = 8 * (tid & 31); (void)wm; (void)wn; (void)fr; (void)fq; (void)c8;
            const int u = blockIdx.x + seg * gridDim.x, rt = u >> 2, ct = u & 3, b = (rt * 256) / SEQ;
            const float* mod = (const float*)(P.ws + WS_MOD) + b * 6144; float* ssp = (float*)(P.ws + WS_SS);
#pragma unroll
            for (int mi = 0; mi < 4; ++mi) { const size_t m = (size_t)(rt * 256 + wm * 64 + mi * 16 + fr); float ss = 0.f;
#pragma unroll
                for (int ni = 0; ni < 8; ++ni) { const int col = ct * 256 + wn * 128 + ni * 16 + 4 * fq;
                    const f32x4 xv = *(const f32x4*)(P.x + m * 1024 + col), gv = *(const f32x4*)(mod + 2048 + col); const f32x4 a = acc[mi][ni];
                    f32x4 o; o.x = xv.x + gv.x * a.x; o.y = xv.y + gv.y * a.y; o.z = xv.z + gv.z * a.z; o.w = xv.w + gv.w * a.w;
                    *(f32x4*)(P.out + m * 1024 + col) = o; ss += (o.x * o.x + o.y * o.y) + (o.z * o.z + o.w * o.w); if (ni & 1) asm volatile("" ::: "memory"); }
                ss += __shfl_xor(ss, 16); ss += __shfl_xor(ss, 32);
                if (fq == 0) ssp[m * 8 + ct * 2 + wn] = ss; } }
    } f{P};
    const int nu = (128 * 4 - (int)blockIdx.x + (int)gridDim.x - 1) / (int)gridDim.x;
    if (nu > 0) G::run_stream(f, nu, 32, 32, (size_t)32 * 1024, lds);
}
__device__ __forceinline__ void phase_p4b(const Params& P) {
    const int lane = threadIdx.x & 63, gw = blockIdx.x * (NTHREADS / 64) + (threadIdx.x >> 6), NGW = gridDim.x * (NTHREADS / 64);
    const float* ssp = (const float*)(P.ws + WS_SS); bf16_t* h2 = (bf16_t*)(P.ws + WS_H);
    for (int m = gw; m < T; m += NGW) {
        const float* mod = (const float*)(P.ws + WS_MOD) + (m / SEQ) * 6144;
        const f32x4 s0 = *(const f32x4*)(ssp + (size_t)m * 8), s1 = *(const f32x4*)(ssp + (size_t)m * 8 + 4);
        const float rstd = rsqrtf(((s0.x + s0.y) + (s0.z + s0.w) + (s1.x + s1.y) + (s1.z + s1.w)) * (1.f / 1024.f) + RMS_EPS);
#pragma unroll
        for (int j = 0; j < 4; ++j) { const int col = (lane + 64 * j) * 4;
            const f32x4 v = *(const f32x4*)(P.out + (size_t)m * 1024 + col), wv = *(const f32x4*)(P.norm2_w + col), scv = *(const f32x4*)(mod + 4096 + col), shv = *(const f32x4*)(mod + 3072 + col);
            u32x2 pk; pk.x = cvtpk(v.x * rstd * wv.x * (1.f + scv.x) + shv.x, v.y * rstd * wv.y * (1.f + scv.y) + shv.y);
            pk.y = cvtpk(v.z * rstd * wv.z * (1.f + scv.z) + shv.z, v.w * rstd * wv.w * (1.f + scv.w) + shv.w);
            *(u32x2*)(h2 + (size_t)m * 1024 + col) = pk; }
    }
}
__device__ __forceinline__ void phase_p4c(const Params& P, LAS unsigned char* lds) {
    typedef Gemm4 G;
    const int tid = opaque_tid(), lane = tid & 63, wid = tid >> 6, wm = wid >> 1, wn = wid & 1, fr = lane & 15, fq = lane >> 4;
    struct F { const Params& P;
        __device__ __forceinline__ void ptrs(int seg, const bf16_t* (&aptr)[2], const bf16_t* (&bptr)[2]) const {
            const int tid = opaque_tid(), lane = tid & 63, wid = tid >> 6, wm = wid >> 1, wn = wid & 1, fr = lane & 15, fq = lane >> 4, c8 = 8 * (tid & 31); (void)wm; (void)wn; (void)fr; (void)fq; (void)c8;
            const int u = blockIdx.x + seg * gridDim.x, rt = u / 3, ct = u % 3;
            const bf16_t* h2 = (const bf16_t*)(P.ws + WS_H); const bf16_t* wrs = (const bf16_t*)(P.ws + WS_WRS);
#pragma unroll
            for (int i = 0; i < 2; ++i) { aptr[i] = h2 + (size_t)(rt * 256 + G::a_row(i, tid)) * 1024 + 8 * (tid & 3); bptr[i] = wrs + (size_t)G::b_k(i, tid) * 768 + ct * 256 + 8 * (tid & 31); } }
        __device__ __forceinline__ void epi(int seg, f32x4 (&acc)[4][8]) const {
            const int tid = opaque_tid(), lane = tid & 63, wid = tid >> 6, wm = wid >> 1, wn = wid & 1, fr = lane & 15, fq = lane >> 4, c8 = 8 * (tid & 31); (void)wm; (void)wn; (void)fr; (void)fq; (void)c8;
            const int u = blockIdx.x + seg * gridDim.x, rt = u / 3, ct = u % 3;
            float* scores = (float*)(P.ws + WS_SCORES); bf16_t* hidS = (bf16_t*)(P.ws + WS_HIDS);
#pragma unroll
            for (int mi = 0; mi < 4; ++mi) { const size_t m = (size_t)(rt * 256 + wm * 64 + mi * 16 + fr);
                if (ct == 0) {
#pragma unroll
                    for (int ni = 0; ni < 8; ++ni) { const f32x4 a = acc[mi][ni];
                        *(f32x4*)(scores + m * 256 + wn * 128 + ni * 16 + 4 * fq) = (f32x4){sigmoidf_(a.x), sigmoidf_(a.y), sigmoidf_(a.z), sigmoidf_(a.w)}; }
                } else {
#pragma unroll
                    for (int j = 0; j < 4; ++j) { const f32x4 g = acc[mi][2 * j], uu = acc[mi][2 * j + 1];
                        u32x2 pk; pk.x = cvtpk(siluf_(g.x) * uu.x, siluf_(g.y) * uu.y); pk.y = cvtpk(siluf_(g.z) * uu.z, siluf_(g.w) * uu.w);
                        *(u32x2*)(hidS + m * 256 + (ct - 1) * 128 + wn * 64 + j * 16 + 4 * fq) = pk; }
                } } }
    } f{P};
    const int nu = (128 * 3 - (int)blockIdx.x + (int)gridDim.x - 1) / (int)gridDim.x;
    if (nu > 0) G::run_stream(f, nu, 32, 32, (size_t)32 * 768, lds);
}
__device__ __forceinline__ void phase_route(const Params& P) {
    const int tid = opaque_tid(), lane = tid & 63, gw = blockIdx.x * (NTHREADS / 64) + (tid >> 6), NGW = gridDim.x * (NTHREADS / 64);
    for (int t = gw; t < T; t += NGW) route_token(P, t, lane);
}
__device__ __forceinline__ void phase_p4d(const Params& P, LAS unsigned char* lds) {
    typedef Gemm4 G;
    const int tid = opaque_tid(), lane = tid & 63, wid = tid >> 6, wm = wid >> 1, wn = wid & 1, fr = lane & 15, fq = lane >> 4;
    struct F { const Params& P;
        __device__ __forceinline__ void ptrs(int seg, const bf16_t* (&aptr)[2], const bf16_t* (&bptr)[2]) const {
            const int tid = opaque_tid(), lane = tid & 63, wid = tid >> 6, wm = wid >> 1, wn = wid & 1, fr = lane & 15, fq = lane >> 4, c8 = 8 * (tid & 31); (void)wm; (void)wn; (void)fr; (void)fq; (void)c8;
            const int u = blockIdx.x + seg * gridDim.x, rt = u >> 2, ct = u & 3;
            const bf16_t* hidS = (const bf16_t*)(P.ws + WS_HIDS); const bf16_t* wsd = (const bf16_t*)(P.ws + WS_WSD);
#pragma unroll
            for (int i = 0; i < 2; ++i) { aptr[i] = hidS + (size_t)(rt * 256 + G::a_row(i, tid)) * 256 + 8 * (tid & 3); bptr[i] = wsd + (size_t)G::b_k(i, tid) * 1024 + ct * 256 + 8 * (tid & 31); } }
        __device__ __forceinline__ void epi(int seg, f32x4 (&acc)[4][8]) const {
            const int tid = opaque_tid(), lane = tid & 63, wid = tid >> 6, wm = wid >> 1, wn = wid & 1, fr = lane & 15, fq = lane >> 4, c8 = 8 * (tid & 31); (void)wm; (void)wn; (void)fr; (void)fq; (void)c8;
            const int u = blockIdx.x + seg * gridDim.x, rt = u >> 2, ct = u & 3, b = (rt * 256) / SEQ;
            const float* mod = (const float*)(P.ws + WS_MOD) + b * 6144;
#pragma unroll
            for (int mi = 0; mi < 4; ++mi) { const size_t m = (size_t)(rt * 256 + wm * 64 + mi * 16 + fr);
#pragma unroll
                for (int ni = 0; ni < 8; ++ni) { const int col = ct * 256 + wn * 128 + ni * 16 + 4 * fq;
                    const f32x4 xv = *(const f32x4*)(P.out + m * 1024 + col), gv = *(const f32x4*)(mod + 5120 + col); const f32x4 a = acc[mi][ni];
                    f32x4 o; o.x = xv.x + gv.x * a.x; o.y = xv.y + gv.y * a.y; o.z = xv.z + gv.z * a.z; o.w = xv.w + gv.w * a.w;
                    *(f32x4*)(P.out + m * 1024 + col) = o; if (ni & 1) asm volatile("" ::: "memory"); } } }
    } f{P};
    const int nu = (128 * 4 - (int)blockIdx.x + (int)gridDim.x - 1) / (int)gridDim.x;
    if (nu > 0) G::run_stream(f, nu, 8, 32, (size_t)32 * 1024, lds);
}

__device__ __forceinline__ void phase_expert_cvt(const Params& P) {
    const size_t gt = (size_t)blockIdx.x * NTHREADS + threadIdx.x, NG = (size_t)gridDim.x * NTHREADS;
    bf16_t* wgu = (bf16_t*)(P.ws + WS_WBGU); bf16_t* wd = (bf16_t*)(P.ws + WS_WBD);
    for (size_t i = gt; i < (size_t)256 * 1024 * 64; i += NG) {
        const size_t ek = i >> 6; const int c8 = (int)(i & 63) * 8, t = c8 >> 8, u16 = (c8 & 255) >> 4;
        const float* s = ((u16 & 1) ? P.exp_wu : P.exp_wg) + ek * 256 + t * 128 + (u16 >> 1) * 16 + (c8 & 8);
        const f32x4 a = __builtin_nontemporal_load((const f32x4*)s), b2 = __builtin_nontemporal_load((const f32x4*)(s + 4));
        *(u32x4*)(wgu + ek * 512 + c8) = (u32x4){cvtpk(a.x, a.y), cvtpk(a.z, a.w), cvtpk(b2.x, b2.y), cvtpk(b2.z, b2.w)}; }
    for (size_t i = gt; i < (size_t)256 * 256 * 128; i += NG) {
        const f32x4 a = __builtin_nontemporal_load((const f32x4*)(P.exp_wd + i * 8)), b2 = __builtin_nontemporal_load((const f32x4*)(P.exp_wd + i * 8 + 4));
        *(u32x4*)(wd + i * 8) = (u32x4){cvtpk(a.x, a.y), cvtpk(a.z, a.w), cvtpk(b2.x, b2.y), cvtpk(b2.z, b2.w)}; }
}

constexpr int P6_TILES = 64 * 1024, P6_PRE = P6_TILES + 1024, P6_PAIR = P6_PRE + 1040, P6_W = P6_PAIR + 1024;
__device__ __forceinline__ void phase_experts(const Params& P, LAS unsigned char* lds) {
    typedef Gemm4 G;
    const int tid = opaque_tid(), lane = tid & 63, wid = tid >> 6, wm = wid >> 1, wn = wid & 1, fr = lane & 15, fq = lane >> 4;
    const int* cnt = (const int*)(P.ws + WS_CTL + CTL_CNT); const int* bucket = (const int*)(P.ws + WS_BUCKET); const float* rw = (const float*)(P.ws + WS_RW);
    const bf16_t* h2 = (const bf16_t*)(P.ws + WS_H); bf16_t* hidR = (bf16_t*)(P.ws + WS_HIDR) + (size_t)blockIdx.x * 256 * 256; unsigned char* y = (unsigned char*)(P.ws + WS_Y);
    LAS int* tiles = (LAS int*)(lds + P6_TILES); LAS int* pre = (LAS int*)(lds + P6_PRE); LAS int* pairs = (LAS int*)(lds + P6_PAIR); LAS float* wts = (LAS float*)(lds + P6_W);
    const int nx = (gridDim.x % 8 == 0) ? 8 : 1, xl = blockIdx.x % nx, li = blockIdx.x / nx, nloc = gridDim.x / nx, nek = 256 / nx;
    if (tid < nek) { const int c_ = cnt[xl + nx * tid]; tiles[tid] = ((c_ < BCAP ? c_ : BCAP) + 255) >> 8; }
    __syncthreads();
    if (tid < nek) { int s = 0; for (int i = 0; i < tid; ++i) s += tiles[i]; pre[tid] = s; if (tid == nek - 1) pre[nek] = s + tiles[nek - 1]; }
    __syncthreads();
    const int total = pre[nek];
    const int c8 = 8 * (tid & 31), u16 = c8 >> 4;
    for (int u = li; u < total; u += nloc) {
        int lo = 0, hi = nek - 1;
        while (lo < hi) { const int mid = (lo + hi + 1) >> 1; if (pre[mid] <= u) lo = mid; else hi = mid - 1; }
        const int e = xl + nx * lo, tile = u - pre[lo], n = cnt[e] < BCAP ? cnt[e] : BCAP, rows = (n - tile * 256) < 256 ? (n - tile * 256) : 256;
        if (tid < 256) { const int r = tid < rows ? tid : 0; const int pr = bucket[(size_t)e * BCAP + tile * 256 + r]; pairs[tid] = pr; wts[tid] = tid < rows ? rw[pr] : 0.f; }
        __syncthreads();
        {
            struct GU { const bf16_t* h2; LAS int* pairs; const bf16_t* wgu; bf16_t* hidR;
                __device__ __forceinline__ void ptrs(int t, const bf16_t* (&aptr)[2], const bf16_t* (&bptr)[2]) const {
                    const int tid = opaque_tid(), lane = tid & 63, wid = tid >> 6, wm = wid >> 1, wn = wid & 1, fr = lane & 15, fq = lane >> 4, c8 = 8 * (tid & 31); (void)wm; (void)wn; (void)fr; (void)fq; (void)c8;
#pragma unroll
                    for (int i = 0; i < 2; ++i) { aptr[i] = h2 + (size_t)(pairs[G::a_row(i, tid)] >> 3) * 1024 + 8 * (tid & 3);
                        bptr[i] = wgu + (size_t)G::b_k(i, tid) * 512 + t * 256 + c8; } }
                __device__ __forceinline__ void epi(int t, f32x4 (&acc)[4][8]) const {
                    const int tid = opaque_tid(), lane = tid & 63, wid = tid >> 6, wm = wid >> 1, wn = wid & 1, fr = lane & 15, fq = lane >> 4, c8 = 8 * (tid & 31); (void)wm; (void)wn; (void)fr; (void)fq; (void)c8;
#pragma unroll
                    for (int mi = 0; mi < 4; ++mi) { const int rl = wm * 64 + mi * 16 + fr;
#pragma unroll
                        for (int j = 0; j < 4; ++j) { const f32x4 g = acc[mi][2 * j], uu = acc[mi][2 * j + 1];
                            u32x2 pk; pk.x = cvtpk(siluf_(g.x) * uu.x, siluf_(g.y) * uu.y); pk.y = cvtpk(siluf_(g.z) * uu.z, siluf_(g.w) * uu.w);
                            *(u32x2*)(hidR + rl * 256 + t * 128 + wn * 64 + j * 16 + 4 * fq) = pk; } } }
            } f{h2, pairs, (const bf16_t*)(P.ws + WS_WBGU) + (size_t)e * 1024 * 512, hidR};
            G::run_stream(f, 2, 32, 32, (size_t)32 * 512, lds);
        }
        __syncthreads();
        {
            struct DN { bf16_t* hidR; const bf16_t* wd; unsigned char* y; LAS int* pairs; LAS float* wts; int rows;
                __device__ __forceinline__ void ptrs(int ct, const bf16_t* (&aptr)[2], const bf16_t* (&bptr)[2]) const {
                    const int tid = opaque_tid(), lane = tid & 63, wid = tid >> 6, wm = wid >> 1, wn = wid & 1, fr = lane & 15, fq = lane >> 4, c8 = 8 * (tid & 31); (void)wm; (void)wn; (void)fr; (void)fq; (void)c8;
#pragma unroll
                    for (int i = 0; i < 2; ++i) { aptr[i] = hidR + (size_t)G::a_row(i, tid) * 256 + 8 * (tid & 3); bptr[i] = wd + (size_t)G::b_k(i, tid) * 1024 + ct * 256 + c8; } }
                __device__ __forceinline__ void epi(int ct, f32x4 (&acc)[4][8]) const {
                    const int tid = opaque_tid(), lane = tid & 63, wid = tid >> 6, wm = wid >> 1, wn = wid & 1, fr = lane & 15, fq = lane >> 4, c8 = 8 * (tid & 31); (void)wm; (void)wn; (void)fr; (void)fq; (void)c8;
#pragma unroll
                    for (int mi = 0; mi < 4; ++mi) { const int rl = wm * 64 + mi * 16 + fr; const float wgt = wts[rl]; const size_t pr = (size_t)pairs[rl];
                        if (rl < rows) {
#pragma unroll
                            for (int ni = 0; ni < 8; ++ni) { const int col = ct * 256 + wn * 128 + ni * 16 + 4 * fq; const f32x4 a = acc[mi][ni] * (wgt * Y_SCALE);
                                int pk = __builtin_amdgcn_cvt_pk_fp8_f32(a.x, a.y, 0, false); pk = __builtin_amdgcn_cvt_pk_fp8_f32(a.z, a.w, pk, true); *(int*)(y + pr * 1024 + col) = pk; } } } }
            } f{hidR, (const bf16_t*)(P.ws + WS_WBD) + (size_t)e * 256 * 1024, y, pairs, wts, rows};
            G::run_stream(f, 4, 8, 32, (size_t)32 * 1024, lds);
        }
        __syncthreads();
    }
}

__device__ __forceinline__ void phase_combine(const Params& P) {
    const int lane = threadIdx.x & 63, gw = blockIdx.x * (NTHREADS / 64) + (threadIdx.x >> 6), NGW = gridDim.x * (NTHREADS / 64);
    const unsigned char* y = (const unsigned char*)(P.ws + WS_Y);
    typedef float f32x2_ __attribute__((ext_vector_type(2)));
    for (int m = gw; m < T; m += NGW) {
        const float* mod = (const float*)(P.ws + WS_MOD) + (m / SEQ) * 6144 + 5120;
#pragma unroll
        for (int j = 0; j < 2; ++j) { const int col = (lane + 64 * j) * 8;
            f32x4 s0 = (f32x4){0.f, 0.f, 0.f, 0.f}, s1 = s0;
#pragma unroll
            for (int sl = 0; sl < 8; ++sl) { const u32x2 v = *(const u32x2*)(y + ((size_t)m * 8 + sl) * 1024 + col);
                const f32x2_ a = __builtin_amdgcn_cvt_pk_f32_fp8((int)v.x, false), b = __builtin_amdgcn_cvt_pk_f32_fp8((int)v.x, true);
                const f32x2_ c = __builtin_amdgcn_cvt_pk_f32_fp8((int)v.y, false), d = __builtin_amdgcn_cvt_pk_f32_fp8((int)v.y, true);
                s0.x += a.x; s0.y += a.y; s0.z += b.x; s0.w += b.y; s1.x += c.x; s1.y += c.y; s1.z += d.x; s1.w += d.y; }
            const f32x4 g0 = *(const f32x4*)(mod + col), g1 = *(const f32x4*)(mod + col + 4);
            f32x4 o0 = *(const f32x4*)(P.out + (size_t)m * 1024 + col), o1 = *(const f32x4*)(P.out + (size_t)m * 1024 + col + 4);
            o0 += g0 * (s0 * Y_INV); o1 += g1 * (s1 * Y_INV);
            *(f32x4*)(P.out + (size_t)m * 1024 + col) = o0; *(f32x4*)(P.out + (size_t)m * 1024 + col + 4) = o1; }
    }
}


__device__ __forceinline__ int queue_pull(unsigned* head, volatile LAS unsigned* slot) {
    if (threadIdx.x == 0) *slot = atomicAdd(head, 1u);
    __syncthreads();
    const int v = (int)*slot;
    __syncthreads();
    return v;
}
__device__ __forceinline__ void phase_cmp_h1(const Params& P, LAS unsigned char* lds, volatile LAS unsigned* slot) {
    unsigned* head = (unsigned*)(P.ws + WS_CTL + CTL_Q2);
    for (;;) {
        const int u = queue_pull(head, slot);
        if (u >= 64 + 512) break;
        if (u < 64) compress_unit(P, lds, u); else hgrn_unit<0>(P, lds, u - 64);
    }
}
__device__ __forceinline__ void phase_h23_nsa(const Params& P, LAS unsigned char* lds, volatile LAS unsigned* slot) {
    unsigned* head = (unsigned*)(P.ws + WS_CTL + CTL_Q3);
    for (;;) {
        const int n = queue_pull(head, slot);
        if (n >= 1536) break;
        if (n < 512) nsa_unit(P, lds, (n & 7) * 128 + (127 - (n >> 3)));
        else if (n < 1024) { const int m = n - 512; hgrn_unit<1>(P, lds, (m & 15) * 32 + (31 - (m >> 4))); }
        else { const int m = n - 1024; nsa_unit(P, lds, (m & 7) * 128 + (63 - (m >> 3))); }
    }
}

constexpr int LDS_BYTES = 144 * 1024;
__global__ void __launch_bounds__(NTHREADS) mega(Params P) {
    extern __shared__ __attribute__((aligned(16))) unsigned char smem[];
    LAS unsigned char* lds = (LAS unsigned char*)smem;
    volatile LAS unsigned* xst = (volatile LAS unsigned*)(lds + LDS_BYTES - 16);
    if (threadIdx.x < 4) xst[threadIdx.x] = 0u;
    __syncthreads();
    XcdBarrier xb = xcd_barrier_post((unsigned*)(P.ws + WS_CTL + CTL_BAR), xst);
    phase_mod(P, lds);
    xcd_barrier(xb);
    { const float* mod = (const float*)(P.ws + WS_MOD); norm_mod_rows(P.x, P.norm1_w, mod, mod + 1024, (bf16_t*)(P.ws + WS_H), H1S); }
    xcd_barrier(xb);
    phase_inproj(P, lds);
    xcd_barrier(xb);
    phase_cmp_h1(P, lds, xst + 2);
    xcd_barrier(xb);
    phase_h23_nsa(P, lds, xst + 2);
    phase_cvt_small(P);
    xcd_barrier(xb);
    phase_p4a(P, lds);
    xcd_barrier(xb);
    phase_p4b(P);
    xcd_barrier(xb);
    phase_p4c(P, lds);
    xcd_barrier(xb);
    phase_route(P);
    phase_p4d(P, lds);
    xcd_barrier(xb);
    phase_expert_cvt(P);
    xcd_barrier(xb);
    phase_experts(P, lds);
    xcd_barrier(xb);
    phase_combine(P);
}

extern "C" void kernel_launch(void* const* d_in, const int* in_sizes, int n_in, void* d_out, int out_size, void* d_ws, size_t ws_size, hipStream_t stream) {
    static int grid = 0;
    if (grid == 0) {
        if (n_in != 25 || ws_size < WS_END) { fprintf(stderr, "kernel_launch: unexpected n_in %d or ws_size %zu (need %zu)\n", n_in, ws_size, (size_t)WS_END); grid = -1; return; }
        int dev = 0, cus = 0, per_cu = 0;
        (void)hipGetDevice(&dev); (void)hipDeviceGetAttribute(&cus, hipDeviceAttributeMultiprocessorCount, dev);
        (void)hipFuncSetAttribute((const void*)mega, hipFuncAttributeMaxDynamicSharedMemorySize, LDS_BYTES);
        (void)hipOccupancyMaxActiveBlocksPerMultiprocessor(&per_cu, (const void*)mega, NTHREADS, LDS_BYTES);
        if (per_cu < 1) { fprintf(stderr, "kernel_launch: occupancy query says %d blocks per CU\n", per_cu); grid = -1; return; }
        grid = cus;
    }
    if (grid < 0) return;
    (void)hipMemsetAsync((char*)d_ws + WS_CTL, 0, 64 * 1024, stream);
    Params p{};
    const float** pf = (const float**)&p;
    for (int i = 0; i < 25; ++i) pf[i] = (const float*)d_in[i];
    p.out = (float*)d_out; p.ws = (unsigned char*)d_ws;
    void* args[] = {&p};
    hipError_t e = hipLaunchCooperativeKernel((const void*)mega, dim3(grid), dim3(NTHREADS), args, LDS_BYTES, stream);
    if (e != hipSuccess) fprintf(stderr, "cooperative launch failed: %s (grid %d)\n", hipGetErrorString(e), grid);
}

#ifdef PHASE_TEST
__global__ void __launch_bounds__(NTHREADS) t_p4a(Params P) { extern __shared__ __attribute__((aligned(16))) unsigned char smem[]; phase_p4a(P, (LAS unsigned char*)smem); }
__global__ void __launch_bounds__(NTHREADS) t_p4d(Params P) { extern __shared__ __attribute__((aligned(16))) unsigned char smem[]; phase_p4d(P, (LAS unsigned char*)smem); }
__global__ void __launch_bounds__(NTHREADS) t_p4(Params P) { extern __shared__ __attribute__((aligned(16))) unsigned char smem[]; phase_p4c(P, (LAS unsigned char*)smem); }
__global__ void __launch_bounds__(NTHREADS) t_p6(Params P) { extern __shared__ __attribute__((aligned(16))) unsigned char smem[]; phase_experts(P, (LAS unsigned char*)smem); }
__global__ void __launch_bounds__(NTHREADS) t_nsa(Params P) { extern __shared__ __attribute__((aligned(16))) unsigned char smem[]; nsa_unit(P, (LAS unsigned char*)smem, blockIdx.x); }
__global__ void __launch_bounds__(NTHREADS) t_mod(Params P) { extern __shared__ __attribute__((aligned(16))) unsigned char smem[]; phase_mod(P, (LAS unsigned char*)smem); }
__global__ void __launch_bounds__(NTHREADS) t_inproj(Params P) { extern __shared__ __attribute__((aligned(16))) unsigned char smem[]; phase_inproj(P, (LAS unsigned char*)smem); }
__global__ void __launch_bounds__(NTHREADS) t_cmp(Params P) { extern __shared__ __attribute__((aligned(16))) unsigned char smem[]; compress_unit(P, (LAS unsigned char*)smem, blockIdx.x); }
__global__ void __launch_bounds__(NTHREADS) t_h0(Params P) { extern __shared__ __attribute__((aligned(16))) unsigned char smem[]; hgrn_unit<0>(P, (LAS unsigned char*)smem, blockIdx.x); }
__global__ void __launch_bounds__(NTHREADS) t_h1(Params P) { extern __shared__ __attribute__((aligned(16))) unsigned char smem[]; hgrn_unit<1>(P, (LAS unsigned char*)smem, blockIdx.x); }
#endif
```

```cpp
#include <hip/hip_runtime.h>
#include <hip/hip_cooperative_groups.h>
#include <cstdio>
#include <cstdint>
#include <type_traits>
namespace cg = cooperative_groups;

#define LAS __attribute__((address_space(3)))
typedef unsigned short bf16_t;
typedef short bf16x8 __attribute__((ext_vector_type(8)));
typedef short s16x4 __attribute__((ext_vector_type(4)));
typedef float f32x4 __attribute__((ext_vector_type(4)));
typedef float f32x16 __attribute__((ext_vector_type(16)));
typedef unsigned u32x4 __attribute__((ext_vector_type(4)));
typedef unsigned u32x2 __attribute__((ext_vector_type(2)));

constexpr int D = 1024, BATCH = 4, SEQ = 8192, T = BATCH * SEQ;
constexpr int IN_COLS = 3352;
constexpr int NTHREADS = 512;
constexpr int H1S = 1088;
constexpr float RMS_EPS = 1e-6f;
constexpr float LOG2E = 1.4426950408889634f;
constexpr float Y_SCALE = 16.0f, Y_INV = 1.0f / 16.0f;

constexpr size_t MB = 1024ull * 1024ull;
constexpr size_t WS_CTL    = 0;
constexpr size_t WS_MOD    = 64 * 1024;
constexpr size_t WS_LB     = WS_MOD + 4 * 6144 * 4;
constexpr size_t WS_CB     = WS_LB + 2048;
constexpr size_t WS_H      = 1 * MB;
constexpr size_t WS_SS     = WS_H + 72 * MB;
constexpr size_t WS_RW     = WS_SS + 1 * MB;
constexpr size_t WS_BUCKET = WS_RW + 1 * MB;
constexpr size_t WS_HIDR   = WS_BUCKET + 16 * MB;
constexpr size_t WS_WSM    = WS_HIDR + 32 * MB;
constexpr size_t WS_WOUT   = WS_WSM, WS_WRS = WS_WSM + 2 * MB, WS_WSD = WS_WSM + 4 * MB;
constexpr size_t WS_WBE    = WS_WSM + 5 * MB;
constexpr size_t WS_WBGU   = WS_WBE, WS_WBD = WS_WBE + 256 * MB;
constexpr size_t WS_SCORES = WS_WBE;
constexpr size_t WS_HIDS   = WS_SCORES + 32 * MB;
constexpr size_t WS_WIN    = WS_HIDS + 16 * MB;
constexpr size_t WS_Y      = WS_WBE + 384 * MB;
constexpr size_t WS_Q      = WS_Y;
constexpr size_t WS_KV     = WS_Q + 32 * MB;
constexpr size_t WS_GATES  = WS_KV + 48 * MB;
constexpr size_t WS_HQ     = WS_GATES + 4 * MB;
constexpr size_t WS_LOGF   = WS_HQ + 32 * MB;
constexpr size_t WS_HV     = WS_LOGF + 64 * MB;
constexpr size_t WS_HG     = WS_HV + 32 * MB;
constexpr size_t WS_CMPH   = WS_HG + 32 * MB;
constexpr size_t WS_KC     = WS_CMPH + 4 * MB;
constexpr size_t WS_VC     = WS_KC + 1 * MB;
constexpr size_t WS_HL     = WS_VC + 1 * MB;
constexpr size_t WS_HD     = WS_HL + 32 * MB;
constexpr size_t WS_MIX    = WS_HD + 1 * MB;
constexpr size_t WS_END    = WS_Y + 384 * MB;
constexpr int BCAP = 16384;
constexpr int CTL_CNT = 1024;
constexpr int CTL_Q2 = 2048, CTL_Q3 = 2112;
constexpr int CTL_BAR = 16384;

struct Params {
    const float *x, *c, *ada_w, *ada_b, *norm1_w, *norm2_w, *w_in, *q_norm_w, *k_norm_w, *cmp_pos, *cmp_w1, *cmp_b1, *cmp_w2,
        *attn_out_norm_w, *hgrn_lb, *rec_out_norm_w, *w_out, *router_w, *router_bias, *exp_wg, *exp_wu, *exp_wd, *sh_wg, *sh_wu, *sh_wd;
    float* out;
    unsigned char* ws;
};

__device__ __forceinline__ unsigned cvtpk(float lo, float hi) { unsigned r; asm("v_cvt_pk_bf16_f32 %0, %1, %2" : "=v"(r) : "v"(lo), "v"(hi)); return r; }
__device__ __forceinline__ int opaque_tid() { int t = threadIdx.x; asm volatile("" : "+v"(t)); return t; }
__device__ __forceinline__ float bf2f(bf16_t v) { return __uint_as_float(((unsigned)v) << 16); }
__device__ __forceinline__ float sigmoidf_(float v) { return __builtin_amdgcn_rcpf(1.0f + __expf(-v)); }
__device__ __forceinline__ float siluf_(float v) { return v * __builtin_amdgcn_rcpf(1.0f + __expf(-v)); }
__device__ __forceinline__ float wave_sum(float v) {
#pragma unroll
    for (int o = 1; o < 64; o <<= 1) v += __shfl_xor(v, o);
    return v;
}
__device__ __forceinline__ s16x4 lds_tr(const LAS unsigned char* p) {
    return __builtin_bit_cast(s16x4, __builtin_amdgcn_ds_read_tr16_b64_v4i16((LAS s16x4*)p));
}

#define XB_TMO      128
#define XB_XCNT(j)  (256  + 64 * (j))
#define XB_XSUB(j)  (1280 + 64 * (j))
#define XB_XGEN(j)  (2304 + 64 * (j))
#define XB_TOP      3328
#define XB_TOPGEN   3392
#define XCD_BAR_WORDS 3456
#define XB_SPIN_CAP (1u << 22)
__device__ __forceinline__ unsigned xb_ld(unsigned* p)              { return __hip_atomic_load(p, __ATOMIC_RELAXED, __HIP_MEMORY_SCOPE_AGENT); }
__device__ __forceinline__ unsigned xb_add(unsigned* p, unsigned v) { return __hip_atomic_fetch_add(p, v, __ATOMIC_RELAXED, __HIP_MEMORY_SCOPE_AGENT); }
__device__ __forceinline__ unsigned xb_xcc_id() { return (unsigned)__builtin_amdgcn_s_getreg((3 << 11) | 20) & 0xFu; }
#define XB_SPIN(cond, bar) do { unsigned _sp = 0; while (cond) { __builtin_amdgcn_s_sleep(1); \
    if ((++_sp & 255u) == 0u) { if (xb_ld(&(bar)[XB_TMO])) break; if (_sp > XB_SPIN_CAP) { atomicAdd(&(bar)[XB_TMO], 1u); break; } } } } while (0)
struct XcdBarrier { unsigned* bar; unsigned x; volatile LAS unsigned* st; };
__device__ __forceinline__ XcdBarrier xcd_barrier_post(unsigned* bar, volatile LAS unsigned* st) {
    XcdBarrier b; b.bar = bar; b.x = xb_xcc_id(); b.st = st;
    if (threadIdx.x == 0) (void)xb_add(&bar[XB_XCNT(b.x)], 1u);
    return b;
}
__device__ __forceinline__ void xcd_barrier_complete(unsigned* bar, unsigned x, unsigned& nloc, unsigned& nx) {
    const unsigned G = gridDim.x * gridDim.y * gridDim.z;
    unsigned sum, cnt, mine, sp = 0u;
    for (;;) {
        sum = 0u; cnt = 0u; mine = 0u;
#pragma unroll
        for (unsigned j = 0; j < 16; ++j) { const unsigned c = xb_ld(&bar[XB_XCNT(j)]); sum += c; cnt += (c > 0u) ? 1u : 0u; mine = (j == x) ? c : mine; }
        if (sum == G) break;
        __builtin_amdgcn_s_sleep(1);
        if ((++sp & 255u) == 0u) { if (xb_ld(&bar[XB_TMO])) break; if (sp > XB_SPIN_CAP) { atomicAdd(&bar[XB_TMO], 1u); break; } }
    }
    nloc = mine > 0u ? mine : 1u; nx = cnt > 0u ? cnt : 1u;
}
__device__ __forceinline__ void xcd_barrier(const XcdBarrier& b) {
    asm volatile("s_waitcnt vmcnt(0)" ::: "memory");
    __syncthreads();
    if (threadIdx.x == 0) {
        unsigned* bar = b.bar;
        __builtin_amdgcn_s_waitcnt(0);
        unsigned nloc = b.st[0], nx = b.st[1];
        if (nloc == 0u) { xcd_barrier_complete(bar, b.x, nloc, nx); b.st[0] = nloc; b.st[1] = nx; }
        const unsigned old = xb_add(&bar[XB_XSUB(b.x)], 1u);
        const unsigned gen = old / nloc;
        if (old + 1u == (gen + 1u) * nloc) {
            __builtin_amdgcn_fence(__ATOMIC_RELEASE, "agent");
            asm volatile("s_waitcnt vmcnt(0)" ::: "memory");
            const unsigned og = xb_add(&bar[XB_TOP], 1u);
            const unsigned tg = og / nx;
            if (og + 1u == (tg + 1u) * nx) xb_add(&bar[XB_TOPGEN], 1u);
            else XB_SPIN(xb_ld(&bar[XB_TOPGEN]) == tg, bar);
            __builtin_amdgcn_fence(__ATOMIC_ACQUIRE, "agent");
            xb_add(&bar[XB_XGEN(b.x)], 1u);
            asm volatile("s_waitcnt vmcnt(0)" ::: "memory");
        } else {
            XB_SPIN(xb_ld(&bar[XB_XGEN(b.x)]) == gen, bar);
            __builtin_amdgcn_fence(__ATOMIC_ACQUIRE, "agent");
            asm volatile("s_waitcnt vmcnt(0)" ::: "memory");
        }
    }
    __syncthreads();
}

template <int WM, int WN> struct GemmT {
    static constexpr int BM = 64 * WM, BN = 64 * WN;
    static constexpr int A_BYTES = BM * 128, B_BYTES = 64 * BN * 2, STAGE = A_BYTES + B_BYTES, LDS_BYTES = 2 * STAGE;
    static constexpr int NB4 = BN / 32;
    static constexpr int B_ROW4 = BN / 4;

    static __device__ __forceinline__ void run(f32x4 (&acc)[4][4], const bf16_t* const (&arow)[WM], int a_kstride, const float* Bp, int ldb, int KT, LAS unsigned char* lds) {
        const int tid = opaque_tid(), lane = tid & 63, wid = tid >> 6, wm = wid / WN, wn = wid % WN, fr = lane & 15, fq = lane >> 4;
#pragma unroll
        for (int mi = 0; mi < 4; ++mi)
#pragma unroll
            for (int ni = 0; ni < 4; ++ni) acc[mi][ni] = (f32x4){0.f, 0.f, 0.f, 0.f};
        const int achunk = tid & 7;
        u32x4 areg[WM]; f32x4 breg[NB4];
        int a_wr[WM];
#pragma unroll
        for (int p = 0; p < WM; ++p) { const int row = p * 64 + (tid >> 3); a_wr[p] = row * 128 + ((achunk ^ ((row >> 1) & 7)) << 4); }
        int b_wr[NB4]; int b_goff[NB4];
#pragma unroll
        for (int p = 0; p < NB4; ++p) { const int i = tid + NTHREADS * p, k = i / B_ROW4, n = (i % B_ROW4) * 4;
            const int f = (k & 3) | (((k >> 3) & 1) << 2);
            b_wr[p] = A_BYTES + k * (BN * 2) + (((n >> 4) ^ f) << 5) + ((n & 15) << 1); b_goff[p] = k * ldb + n; }
        int a_rd[4][2];
#pragma unroll
        for (int mi = 0; mi < 4; ++mi)
#pragma unroll
            for (int ks = 0; ks < 2; ++ks) { const int row = wm * 64 + mi * 16 + fr, ch = ks * 4 + fq; a_rd[mi][ks] = row * 128 + ((ch ^ ((row >> 1) & 7)) << 4); }
        int b_rd[2][2];
        int b_f[2][2];
#pragma unroll
        for (int ks = 0; ks < 2; ++ks)
#pragma unroll
            for (int t = 0; t < 2; ++t) { const int k = ks * 32 + 8 * fq + 4 * t + (fr >> 2); b_f[ks][t] = (k & 3) | (((k >> 3) & 1) << 2);
                b_rd[ks][t] = A_BYTES + k * (BN * 2) + ((fr & 3) << 3); }

        auto gload = [&](int kt) {
#pragma unroll
            for (int p = 0; p < WM; ++p) areg[p] = *(const u32x4*)(arow[p] + (size_t)kt * a_kstride + achunk * 8);
            const float* bk = Bp + (size_t)kt * 64 * ldb;
#pragma unroll
            for (int p = 0; p < NB4; ++p) breg[p] = *(const f32x4*)(bk + b_goff[p]);
        };
        auto lstore = [&](int buf) {
            LAS unsigned char* base = lds + buf * STAGE;
#pragma unroll
            for (int p = 0; p < WM; ++p) *(LAS u32x4*)(base + a_wr[p]) = areg[p];
#pragma unroll
            for (int p = 0; p < NB4; ++p) { u32x2 w; w.x = cvtpk(breg[p].x, breg[p].y); w.y = cvtpk(breg[p].z, breg[p].w); *(LAS u32x2*)(base + b_wr[p]) = w; }
        };
        gload(0); lstore(0); __syncthreads();
        for (int kt = 0; kt < KT; ++kt) {
            if (kt + 1 < KT) gload(kt + 1);
            __builtin_amdgcn_sched_barrier(0);
            const LAS unsigned char* base = lds + (kt & 1) * STAGE;
#pragma unroll
            for (int ks = 0; ks < 2; ++ks) {
                bf16x8 af[4], bfr[4];
#pragma unroll
                for (int mi = 0; mi < 4; ++mi) af[mi] = *(const LAS bf16x8*)(base + a_rd[mi][ks]);
#pragma unroll
                for (int ni = 0; ni < 4; ++ni) {
                    const int u0 = wn * 4 + ni;
                    const s16x4 lo = lds_tr(base + b_rd[ks][0] + ((u0 ^ b_f[ks][0]) << 5));
                    const s16x4 hi = lds_tr(base + b_rd[ks][1] + ((u0 ^ b_f[ks][1]) << 5));
                    bfr[ni] = (bf16x8){lo[0], lo[1], lo[2], lo[3], hi[0], hi[1], hi[2], hi[3]};
                }
#pragma unroll
                for (int mi = 0; mi < 4; ++mi)
#pragma unroll
                    for (int ni = 0; ni < 4; ++ni) acc[mi][ni] = __builtin_amdgcn_mfma_f32_16x16x32_bf16(bfr[ni], af[mi], acc[mi][ni], 0, 0, 0);
            }
            if (kt + 1 < KT) lstore((kt + 1) & 1);
            __syncthreads();
        }
    }
};

struct Gemm2 {
    static constexpr int A_BYTES = 32768, STAGE = 65536, LDS_BYTES = 2 * STAGE;
    static __device__ __forceinline__ int a_row(int i, int w, int lane) { return (i * 8 + w) * 8 + (lane >> 3); }
    static __device__ __forceinline__ int a_chunk(int row, int lane) { return (lane & 7) ^ ((row >> 1) & 7); }
    static __device__ __forceinline__ int b_k(int i, int w, int lane) { return (i * 8 + w) * 2 + (lane >> 5); }
    static __device__ __forceinline__ int b_n(int k, int lane) { return ((((lane & 31) >> 1) ^ fk2(k)) << 4) + ((lane & 1) << 3); }
    static __device__ __forceinline__ int fk2(int r) { return (r & 3) | (((r >> 3) & 1) << 2); }

    static __device__ __forceinline__ void run(f32x4 (&acc)[4][8], const bf16_t* const (&aptr)[4], int a_kstride, const bf16_t* const (&bptr)[4], size_t b_kstride, int KT, LAS unsigned char* lds) {
        const int tid = opaque_tid(), lane = tid & 63, wid = tid >> 6, wm = wid >> 1, wn = wid & 1, fr = lane & 15, fq = lane >> 4;
        const int wu = __builtin_amdgcn_readfirstlane(wid);
#pragma unroll
        for (int mi = 0; mi < 4; ++mi)
#pragma unroll
            for (int ni = 0; ni < 8; ++ni) acc[mi][ni] = (f32x4){0.f, 0.f, 0.f, 0.f};
        int a_rd[4][2];
#pragma unroll
        for (int mi = 0; mi < 4; ++mi)
#pragma unroll
            for (int ks = 0; ks < 2; ++ks) { const int row = wm * 64 + mi * 16 + fr, ch = ks * 4 + fq; a_rd[mi][ks] = row * 128 + ((ch ^ ((row >> 1) & 7)) << 4); }
        int b_rd[2][2], b_f[2][2];
#pragma unroll
        for (int ks = 0; ks < 2; ++ks)
#pragma unroll
            for (int t = 0; t < 2; ++t) { const int k = ks * 32 + 8 * fq + 4 * t + (fr >> 2); b_f[ks][t] = fk2(k); b_rd[ks][t] = A_BYTES + k * 512 + ((fr & 3) << 3); }
        auto issue = [&](int kt, int buf) {
            LAS unsigned char* base = lds + buf * STAGE + wu * 1024;
#pragma unroll
            for (int i = 0; i < 4; ++i) __builtin_amdgcn_global_load_lds((const unsigned*)(aptr[i] + (size_t)kt * a_kstride), (LAS unsigned*)(base + i * 8192), 16, 0, 0);
#pragma unroll
            for (int i = 0; i < 4; ++i) __builtin_amdgcn_global_load_lds((const unsigned*)(bptr[i] + (size_t)kt * b_kstride), (LAS unsigned*)(base + A_BYTES + i * 8192), 16, 0, 0);
        };
        issue(0, 0);
        for (int kt = 0; kt < KT; ++kt) {
            asm volatile("s_waitcnt vmcnt(0)" ::: "memory");
            __syncthreads();
            if (kt + 1 < KT) issue(kt + 1, (kt + 1) & 1);
            const LAS unsigned char* base = lds + (kt & 1) * STAGE;
#pragma unroll
            for (int ks = 0; ks < 2; ++ks) {
                bf16x8 af[4];
#pragma unroll
                for (int mi = 0; mi < 4; ++mi) af[mi] = *(const LAS bf16x8*)(base + a_rd[mi][ks]);
#pragma unroll
                for (int ni = 0; ni < 8; ++ni) {
                    const int u0 = wn * 8 + ni;
                    const s16x4 lo = lds_tr(base + b_rd[ks][0] + ((u0 ^ b_f[ks][0]) << 5));
                    const s16x4 hi = lds_tr(base + b_rd[ks][1] + ((u0 ^ b_f[ks][1]) << 5));
                    const bf16x8 bfr = (bf16x8){lo[0], lo[1], lo[2], lo[3], hi[0], hi[1], hi[2], hi[3]};
#pragma unroll
                    for (int mi = 0; mi < 4; ++mi) acc[mi][ni] = __builtin_amdgcn_mfma_f32_16x16x32_bf16(bfr, af[mi], acc[mi][ni], 0, 0, 0);
                }
            }
        }
        __syncthreads();
    }
};

struct Gemm3 {
    static constexpr int A_BYTES = 16384, STAGE = 32768, LDS_BYTES = 4 * STAGE;
    static __device__ __forceinline__ int a_row(int i, int w, int lane) { return (i * 8 + w) * 16 + (lane >> 2); }
    static __device__ __forceinline__ int a_chunk(int row, int lane) { return (lane & 3) ^ ((row >> 1) & 3); }
    static __device__ __forceinline__ int b_k(int i, int w, int lane) { return (i * 8 + w) * 2 + (lane >> 5); }
    static __device__ __forceinline__ int fk2(int r) { return (r & 3) | (((r >> 3) & 1) << 2); }
    static __device__ __forceinline__ int b_n(int k, int lane) { return ((((lane & 31) >> 1) ^ fk2(k)) << 4) + ((lane & 1) << 3); }
    static __device__ __forceinline__ void run(f32x4 (&acc)[4][8], const bf16_t* const (&aptr)[2], int a_kstride, const bf16_t* const (&bptr)[2], size_t b_kstride, int KT, LAS unsigned char* lds) {
        const int tid = opaque_tid(), lane = tid & 63, wid = tid >> 6, wm = wid >> 1, wn = wid & 1, fr = lane & 15, fq = lane >> 4;
        const int wu = __builtin_amdgcn_readfirstlane(wid);
#pragma unroll
        for (int mi = 0; mi < 4; ++mi)
#pragma unroll
            for (int ni = 0; ni < 8; ++ni) acc[mi][ni] = (f32x4){0.f, 0.f, 0.f, 0.f};
        int a_rd[4];
#pragma unroll
        for (int mi = 0; mi < 4; ++mi) { const int row = wm * 64 + mi * 16 + fr; a_rd[mi] = row * 64 + ((fq ^ ((row >> 1) & 3)) << 4); }
        int b_rd[2], b_f[2];
#pragma unroll
        for (int t = 0; t < 2; ++t) { const int k = 8 * fq + 4 * t + (fr >> 2); b_f[t] = fk2(k); b_rd[t] = A_BYTES + k * 512 + ((fr & 3) << 3); }
        auto issue = [&](int kt) {
            LAS unsigned char* base = lds + (kt & 3) * STAGE + wu * 1024;
#pragma unroll
            for (int i = 0; i < 2; ++i) __builtin_amdgcn_global_load_lds((const unsigned*)(aptr[i] + (size_t)kt * a_kstride), (LAS unsigned*)(base + i * 8192), 16, 0, 0);
#pragma unroll
            for (int i = 0; i < 2; ++i) __builtin_amdgcn_global_load_lds((const unsigned*)(bptr[i] + (size_t)kt * b_kstride), (LAS unsigned*)(base + A_BYTES + i * 8192), 16, 0, 0);
        };
        asm volatile("s_waitcnt vmcnt(0)" ::: "memory");
        issue(0); if (KT > 1) issue(1); if (KT > 2) issue(2);
        for (int kt = 0; kt < KT; ++kt) {
            const int rem = KT - 1 - kt;
            if (rem >= 2) asm volatile("s_waitcnt vmcnt(8)" ::: "memory"); else if (rem == 1) asm volatile("s_waitcnt vmcnt(4)" ::: "memory"); else asm volatile("s_waitcnt vmcnt(0)" ::: "memory");
            __builtin_amdgcn_s_barrier();
            asm volatile("" ::: "memory");
            if (kt + 3 < KT) issue(kt + 3);
            const LAS unsigned char* base = lds + (kt & 3) * STAGE;
            bf16x8 af[4];
#pragma unroll
            for (int mi = 0; mi < 4; ++mi) af[mi] = *(const LAS bf16x8*)(base + a_rd[mi]);
#pragma unroll
            for (int ni = 0; ni < 8; ++ni) {
                const int u0 = wn * 8 + ni;
                const s16x4 lo = lds_tr(base + b_rd[0] + ((u0 ^ b_f[0]) << 5));
                const s16x4 hi = lds_tr(base + b_rd[1] + ((u0 ^ b_f[1]) << 5));
                const bf16x8 bfr = (bf16x8){lo[0], lo[1], lo[2], lo[3], hi[0], hi[1], hi[2], hi[3]};
#pragma unroll
                for (int mi = 0; mi < 4; ++mi) acc[mi][ni] = __builtin_amdgcn_mfma_f32_16x16x32_bf16(bfr, af[mi], acc[mi][ni], 0, 0, 0);
            }
        }
        asm volatile("s_waitcnt lgkmcnt(0)" ::: "memory");
        __builtin_amdgcn_s_barrier();
        asm volatile("" ::: "memory");
    }
};

struct Gemm4 {
    static constexpr int A_BYTES = 16384, STAGE = 32768, LDS_BYTES = 2 * STAGE;
    static __device__ __forceinline__ int fk2(int r) { return (r & 3) | (((r >> 3) & 1) << 2); }
    static __device__ __forceinline__ int a_row(int i, int tid) { return (tid >> 2) + 128 * i; }
    static __device__ __forceinline__ int b_k(int i, int tid) { return (tid >> 5) + 16 * i; }
    static __device__ __forceinline__ void run(f32x4 (&acc)[4][8], const bf16_t* const (&aptr)[2], int a_kstride, const bf16_t* const (&bptr)[2], size_t b_kstride, int KT, LAS unsigned char* lds) {
        const int tid = opaque_tid(), lane = tid & 63, wid = tid >> 6, wm = wid >> 1, wn = wid & 1, fr = lane & 15, fq = lane >> 4;
#pragma unroll
        for (int mi = 0; mi < 4; ++mi)
#pragma unroll
            for (int ni = 0; ni < 8; ++ni) acc[mi][ni] = (f32x4){0.f, 0.f, 0.f, 0.f};
        int a_wr[2], b_wr[2];
#pragma unroll
        for (int i = 0; i < 2; ++i) { const int row = a_row(i, tid); a_wr[i] = row * 64 + (((tid & 3) ^ ((row >> 1) & 3)) << 4);
            const int k = b_k(i, tid), n = (tid & 31) * 8; b_wr[i] = A_BYTES + k * 512 + (((n >> 4) ^ fk2(k)) << 5) + ((n & 15) << 1); }
        int a_rd[4];
#pragma unroll
        for (int mi = 0; mi < 4; ++mi) { const int row = wm * 64 + mi * 16 + fr; a_rd[mi] = row * 64 + ((fq ^ ((row >> 1) & 3)) << 4); }
        int b_rd[2], b_f[2];
#pragma unroll
        for (int t = 0; t < 2; ++t) { const int k = 8 * fq + 4 * t + (fr >> 2); b_f[t] = fk2(k); b_rd[t] = A_BYTES + k * 512 + ((fr & 3) << 3); }
        u32x4 ra0[2], rb0[2], ra1[2], rb1[2];
        auto gload = [&](int kt, u32x4 (&ra)[2], u32x4 (&rb)[2]) {
#pragma unroll
            for (int i = 0; i < 2; ++i) { ra[i] = *(const u32x4*)(aptr[i] + (size_t)kt * a_kstride); rb[i] = *(const u32x4*)(bptr[i] + (size_t)kt * b_kstride); }
        };
        auto lstore = [&](int buf, const u32x4 (&ra)[2], const u32x4 (&rb)[2]) {
            LAS unsigned char* base = lds + buf * STAGE;
#pragma unroll
            for (int i = 0; i < 2; ++i) { *(LAS u32x4*)(base + a_wr[i]) = ra[i]; *(LAS u32x4*)(base + b_wr[i]) = rb[i]; }
        };
        auto compute = [&](int buf) {
            const LAS unsigned char* base = lds + buf * STAGE;
            bf16x8 af[4];
#pragma unroll
            for (int mi = 0; mi < 4; ++mi) af[mi] = *(const LAS bf16x8*)(base + a_rd[mi]);
#pragma unroll
            for (int ni = 0; ni < 8; ++ni) {
                const int u0 = wn * 8 + ni;
                const s16x4 lo = lds_tr(base + b_rd[0] + ((u0 ^ b_f[0]) << 5));
                const s16x4 hi = lds_tr(base + b_rd[1] + ((u0 ^ b_f[1]) << 5));
                const bf16x8 bfr = (bf16x8){lo[0], lo[1], lo[2], lo[3], hi[0], hi[1], hi[2], hi[3]};
#pragma unroll
                for (int mi = 0; mi < 4; ++mi) acc[mi][ni] = __builtin_amdgcn_mfma_f32_16x16x32_bf16(bfr, af[mi], acc[mi][ni], 0, 0, 0);
            }
        };
        gload(0, ra0, rb0); gload(1, ra1, rb1);
        lstore(0, ra0, rb0); __syncthreads();
        for (int kt = 0; kt < KT; kt += 2) {
            gload(kt + 2 < KT ? kt + 2 : KT - 1, ra0, rb0);
            __builtin_amdgcn_sched_barrier(0);
            compute(0);
            lstore(1, ra1, rb1);
            __syncthreads();
            gload(kt + 3 < KT ? kt + 3 : KT - 1, ra1, rb1);
            __builtin_amdgcn_sched_barrier(0);
            compute(1);
            lstore(0, ra0, rb0);
            __syncthreads();
        }
    }

    template <class F> static __device__ __forceinline__ void run_stream(F& f, int NSEG, int KT, int a_kstride, size_t b_kstride, LAS unsigned char* lds) {
        const int tid = opaque_tid(), lane = tid & 63, wid = tid >> 6, wm = wid >> 1, wn = wid & 1, fr = lane & 15, fq = lane >> 4;
        f32x4 acc[4][8];
#pragma unroll
        for (int mi = 0; mi < 4; ++mi)
#pragma unroll
            for (int ni = 0; ni < 8; ++ni) acc[mi][ni] = (f32x4){0.f, 0.f, 0.f, 0.f};
        int a_wr[2], b_wr[2];
#pragma unroll
        for (int i = 0; i < 2; ++i) { const int row = a_row(i, tid); a_wr[i] = row * 64 + (((tid & 3) ^ ((row >> 1) & 3)) << 4);
            const int k = b_k(i, tid), n = (tid & 31) * 8; b_wr[i] = A_BYTES + k * 512 + (((n >> 4) ^ fk2(k)) << 5) + ((n & 15) << 1); }
        int a_rd[4];
#pragma unroll
        for (int mi = 0; mi < 4; ++mi) { const int row = wm * 64 + mi * 16 + fr; a_rd[mi] = row * 64 + ((fq ^ ((row >> 1) & 3)) << 4); }
        int b_rd[2], b_f[2];
#pragma unroll
        for (int t = 0; t < 2; ++t) { const int k = 8 * fq + 4 * t + (fr >> 2); b_f[t] = fk2(k); b_rd[t] = A_BYTES + k * 512 + ((fr & 3) << 3); }
        const bf16_t* aptr[2]; const bf16_t* bptr[2];
        u32x4 ra0[2], rb0[2], ra1[2], rb1[2];
        int lseg = 0, lkt = 0;
        auto gload = [&](u32x4 (&ra)[2], u32x4 (&rb)[2]) {
#pragma unroll
            for (int i = 0; i < 2; ++i) { ra[i] = *(const u32x4*)(aptr[i] + (size_t)lkt * a_kstride); rb[i] = *(const u32x4*)(bptr[i] + (size_t)lkt * b_kstride); }
            if (lkt + 1 < KT) ++lkt; else if (lseg + 1 < NSEG) { lkt = 0; ++lseg; f.ptrs(lseg, aptr, bptr); }
        };
        auto lstore = [&](int buf, const u32x4 (&ra)[2], const u32x4 (&rb)[2]) {
            LAS unsigned char* base = lds + buf * STAGE;
#pragma unroll
            for (int i = 0; i < 2; ++i) { *(LAS u32x4*)(base + a_wr[i]) = ra[i]; *(LAS u32x4*)(base + b_wr[i]) = rb[i]; }
        };
        auto compute = [&](int buf) {
            const LAS unsigned char* base = lds + buf * STAGE;
            bf16x8 af[4];
#pragma unroll
            for (int mi = 0; mi < 4; ++mi) af[mi] = *(const LAS bf16x8*)(base + a_rd[mi]);
#pragma unroll
            for (int ni = 0; ni < 8; ++ni) {
                const int u0 = wn * 8 + ni;
                const s16x4 lo = lds_tr(base + b_rd[0] + ((u0 ^ b_f[0]) << 5));
                const s16x4 hi = lds_tr(base + b_rd[1] + ((u0 ^ b_f[1]) << 5));
                const bf16x8 bfr = (bf16x8){lo[0], lo[1], lo[2], lo[3], hi[0], hi[1], hi[2], hi[3]};
#pragma unroll
                for (int mi = 0; mi < 4; ++mi) acc[mi][ni] = __builtin_amdgcn_mfma_f32_16x16x32_bf16(bfr, af[mi], acc[mi][ni], 0, 0, 0);
            }
        };
        f.ptrs(0, aptr, bptr);
        gload(ra0, rb0); gload(ra1, rb1);
        lstore(0, ra0, rb0); __syncthreads();
        int cseg = 0, ckt = 0;
        const int total = NSEG * KT;
#pragma unroll 1
        for (int g = 0; g < total; g += 2) {
            gload(ra0, rb0);
            __builtin_amdgcn_sched_barrier(0);
            compute(0);
            lstore(1, ra1, rb1);
            __syncthreads();
            gload(ra1, rb1);
            __builtin_amdgcn_sched_barrier(0);
            compute(1);
            lstore(0, ra0, rb0);
            __syncthreads();
            ckt += 2;
            if (ckt == KT) {
                f.epi(cseg, acc);
#pragma unroll
                for (int mi = 0; mi < 4; ++mi)
#pragma unroll
                    for (int ni = 0; ni < 8; ++ni) acc[mi][ni] = (f32x4){0.f, 0.f, 0.f, 0.f};
                ckt = 0; ++cseg;
            }
        }
    }
};

template <bool BF32> struct Gemm5 {
    static constexpr int A_BYTES = 16384, STAGE = 32768, LDS_BYTES = 2 * STAGE;
    static __device__ __forceinline__ int fk2(int r) { return (r & 3) | (((r >> 3) & 1) << 2); }
    static __device__ __forceinline__ int a_row(int i, int tid) { return (tid >> 2) + 128 * i; }
    static __device__ __forceinline__ int b_k(int i, int tid) { return (tid >> 5) + 16 * i; }
    typedef typename std::conditional<BF32, float, bf16_t>::type b_t;
    static __device__ __forceinline__ void run(f32x4 (&acc)[4][8], const bf16_t* const (&aptr)[2], int a_kstride, const b_t* const (&bptr)[2], size_t b_kstride, int KT, LAS unsigned char* lds) {
        const int tid = opaque_tid(), lane = tid & 63, wid = tid >> 6, wm = wid >> 1, wn = wid & 1, fr = lane & 15, fq = lane >> 4;
#pragma unroll
        for (int mi = 0; mi < 4; ++mi)
#pragma unroll
            for (int ni = 0; ni < 8; ++ni) acc[mi][ni] = (f32x4){0.f, 0.f, 0.f, 0.f};
        int a_wr[2], b_wr[2];
#pragma unroll
        for (int i = 0; i < 2; ++i) { const int row = a_row(i, tid); a_wr[i] = row * 64 + (((tid & 3) ^ ((row >> 1) & 3)) << 4);
            const int k = b_k(i, tid), n = (tid & 31) * 8; b_wr[i] = A_BYTES + k * 512 + (((n >> 4) ^ fk2(k)) << 5) + ((n & 15) << 1); }
        int a_rd[4];
#pragma unroll
        for (int mi = 0; mi < 4; ++mi) { const int row = wm * 64 + mi * 16 + fr; a_rd[mi] = row * 64 + ((fq ^ ((row >> 1) & 3)) << 4); }
        int b_rd[2], b_f[2];
#pragma unroll
        for (int t = 0; t < 2; ++t) { const int k = 8 * fq + 4 * t + (fr >> 2); b_f[t] = fk2(k); b_rd[t] = A_BYTES + k * 512 + ((fr & 3) << 3); }
        u32x4 ra[2]; u32x4 rb[2]; f32x4 rbf[2][2];
        auto gload = [&](int kt) {
#pragma unroll
            for (int i = 0; i < 2; ++i) { ra[i] = *(const u32x4*)(aptr[i] + (size_t)kt * a_kstride);
                if (BF32) { const float* p = (const float*)bptr[i] + (size_t)kt * b_kstride; rbf[i][0] = *(const f32x4*)p; rbf[i][1] = *(const f32x4*)(p + 4); }
                else rb[i] = *(const u32x4*)((const bf16_t*)bptr[i] + (size_t)kt * b_kstride); }
        };
        auto lstore = [&](int buf) {
            LAS unsigned char* base = lds + buf * STAGE;
#pragma unroll
            for (int i = 0; i < 2; ++i) { *(LAS u32x4*)(base + a_wr[i]) = ra[i];
                if (BF32) { u32x4 w; w.x = cvtpk(rbf[i][0].x, rbf[i][0].y); w.y = cvtpk(rbf[i][0].z, rbf[i][0].w); w.z = cvtpk(rbf[i][1].x, rbf[i][1].y); w.w = cvtpk(rbf[i][1].z, rbf[i][1].w); *(LAS u32x4*)(base + b_wr[i]) = w; }
                else *(LAS u32x4*)(base + b_wr[i]) = rb[i]; }
        };
        auto compute = [&](int buf) {
            const LAS unsigned char* base = lds + buf * STAGE;
            bf16x8 af[4];
#pragma unroll
            for (int mi = 0; mi < 4; ++mi) af[mi] = *(const LAS bf16x8*)(base + a_rd[mi]);
#pragma unroll
            for (int ni = 0; ni < 8; ++ni) {
                const int u0 = wn * 8 + ni;
                const s16x4 lo = lds_tr(base + b_rd[0] + ((u0 ^ b_f[0]) << 5));
                const s16x4 hi = lds_tr(base + b_rd[1] + ((u0 ^ b_f[1]) << 5));
                const bf16x8 bfr = (bf16x8){lo[0], lo[1], lo[2], lo[3], hi[0], hi[1], hi[2], hi[3]};
#pragma unroll
                for (int mi = 0; mi < 4; ++mi) acc[mi][ni] = __builtin_amdgcn_mfma_f32_16x16x32_bf16(bfr, af[mi], acc[mi][ni], 0, 0, 0);
            }
        };
        gload(0); lstore(0); __syncthreads();
#pragma unroll 1
        for (int kt = 0; kt < KT; ++kt) {
            gload(kt + 1 < KT ? kt + 1 : KT - 1);
            __builtin_amdgcn_sched_barrier(0);
            compute(kt & 1);
            lstore((kt + 1) & 1);
            __syncthreads();
        }
    }

    template <class F> static __device__ __forceinline__ void run_stream(F& f, int NSEG, int KT, int a_kstride, size_t b_kstride, LAS unsigned char* lds) {
        const int tid = opaque_tid(), lane = tid & 63, wid = tid >> 6, wm = wid >> 1, wn = wid & 1, fr = lane & 15, fq = lane >> 4;
        f32x4 acc[4][8];
#pragma unroll
        for (int mi = 0; mi < 4; ++mi)
#pragma unroll
            for (int ni = 0; ni < 8; ++ni) acc[mi][ni] = (f32x4){0.f, 0.f, 0.f, 0.f};
        int a_wr[2], b_wr[2];
#pragma unroll
        for (int i = 0; i < 2; ++i) { const int row = a_row(i, tid); a_wr[i] = row * 64 + (((tid & 3) ^ ((row >> 1) & 3)) << 4);
            const int k = b_k(i, tid), n = (tid & 31) * 8; b_wr[i] = A_BYTES + k * 512 + (((n >> 4) ^ fk2(k)) << 5) + ((n & 15) << 1); }
        int a_rd[4];
#pragma unroll
        for (int mi = 0; mi < 4; ++mi) { const int row = wm * 64 + mi * 16 + fr; a_rd[mi] = row * 64 + ((fq ^ ((row >> 1) & 3)) << 4); }
        int b_rd[2], b_f[2];
#pragma unroll
        for (int t = 0; t < 2; ++t) { const int k = 8 * fq + 4 * t + (fr >> 2); b_f[t] = fk2(k); b_rd[t] = A_BYTES + k * 512 + ((fr & 3) << 3); }
        const bf16_t* aptr[2]; const b_t* bptr[2];
        u32x4 ra[2]; u32x4 rb[2]; f32x4 rbf[2][2];
        auto gload = [&](int kt) {
#pragma unroll
            for (int i = 0; i < 2; ++i) { ra[i] = *(const u32x4*)(aptr[i] + (size_t)kt * a_kstride);
                if (BF32) { const float* p = (const float*)bptr[i] + (size_t)kt * b_kstride; rbf[i][0] = *(const f32x4*)p; rbf[i][1] = *(const f32x4*)(p + 4); }
                else rb[i] = *(const u32x4*)((const bf16_t*)bptr[i] + (size_t)kt * b_kstride); }
        };
        auto lstore = [&](int buf) {
            LAS unsigned char* base = lds + buf * STAGE;
#pragma unroll
            for (int i = 0; i < 2; ++i) { *(LAS u32x4*)(base + a_wr[i]) = ra[i];
                if (BF32) { u32x4 w; w.x = cvtpk(rbf[i][0].x, rbf[i][0].y); w.y = cvtpk(rbf[i][0].z, rbf[i][0].w); w.z = cvtpk(rbf[i][1].x, rbf[i][1].y); w.w = cvtpk(rbf[i][1].z, rbf[i][1].w); *(LAS u32x4*)(base + b_wr[i]) = w; }
                else *(LAS u32x4*)(base + b_wr[i]) = rb[i]; }
        };
        auto compute = [&](int buf) {
            const LAS unsigned char* base = lds + buf * STAGE;
            bf16x8 af[4];
#pragma unroll
            for (int mi = 0; mi < 4; ++mi) af[mi] = *(const LAS bf16x8*)(base + a_rd[mi]);
#pragma unroll
            for (int ni = 0; ni < 8; ++ni) {
                const int u0 = wn * 8 + ni;
                const s16x4 lo = lds_tr(base + b_rd[0] + ((u0 ^ b_f[0]) << 5));
                const s16x4 hi = lds_tr(base + b_rd[1] + ((u0 ^ b_f[1]) << 5));
                const bf16x8 bfr = (bf16x8){lo[0], lo[1], lo[2], lo[3], hi[0], hi[1], hi[2], hi[3]};
#pragma unroll
                for (int mi = 0; mi < 4; ++mi) acc[mi][ni] = __builtin_amdgcn_mfma_f32_16x16x32_bf16(bfr, af[mi], acc[mi][ni], 0, 0, 0);
            }
        };
        f.ptrs(0, aptr, bptr);
        gload(0); lstore(0); __syncthreads();
        int seg = 0, kt = 0;
        const int total = NSEG * KT;
#pragma unroll 1
        for (int g = 0; g < total; ++g) {
            int nkt = kt + 1, nsg = seg; if (nkt == KT) { nkt = 0; nsg = seg + 1; }
            if (nkt == 0 && nsg < NSEG) f.ptrs(nsg, aptr, bptr);
            gload(nsg < NSEG ? nkt : KT - 1);
            __builtin_amdgcn_sched_barrier(0);
            compute(g & 1);
            lstore((g + 1) & 1);
            __syncthreads();
            if (nkt == 0) {
                f.epi(seg, acc);
#pragma unroll
                for (int mi = 0; mi < 4; ++mi)
#pragma unroll
                    for (int ni = 0; ni < 8; ++ni) acc[mi][ni] = (f32x4){0.f, 0.f, 0.f, 0.f};
            }
            seg = nsg; kt = nkt;
        }
    }
};

__device__ __forceinline__ void phase_mod(const Params& P, LAS unsigned char* lds) {
    const int tid = threadIdx.x;
    float* mod = (float*)(P.ws + WS_MOD);
    LAS float* sc = (LAS float*)lds;
    LAS float* red = (LAS float*)(lds + 16384);
    for (int i = tid; i < 4096; i += NTHREADS) sc[i] = siluf_(P.c[i]);
    __syncthreads();
    const int kq = tid >> 5, cl = tid & 31;
    for (int u = blockIdx.x; u < 192; u += gridDim.x) {
        const int j = u * 32 + cl;
        float a0 = 0.f, a1 = 0.f, a2 = 0.f, a3 = 0.f;
#pragma unroll 8
        for (int k = kq; k < 1024; k += 16) { const float w = P.ada_w[(size_t)k * 6144 + j];
            a0 += sc[k] * w; a1 += sc[1024 + k] * w; a2 += sc[2048 + k] * w; a3 += sc[3072 + k] * w; }
        red[(kq * 4 + 0) * 32 + cl] = a0; red[(kq * 4 + 1) * 32 + cl] = a1; red[(kq * 4 + 2) * 32 + cl] = a2; red[(kq * 4 + 3) * 32 + cl] = a3;
        __syncthreads();
        if (tid < 128) { const int b = tid >> 5; float s = 0.f;
#pragma unroll
            for (int q = 0; q < 16; ++q) s += red[(q * 4 + b) * 32 + cl];
            mod[b * 6144 + j] = s + P.ada_b[j]; }
        __syncthreads();
    }
    for (int u = blockIdx.x; u < 16; u += gridDim.x) {
        const int sel = u >> 3, j = (u & 7) * 32 + cl;
        const float* w1 = P.cmp_w1 + (size_t)sel * 2048 * 256; const float* pos = P.cmp_pos + sel * 2048;
        float a0 = 0.f;
#pragma unroll 8
        for (int k = kq; k < 2048; k += 16) a0 += pos[k] * w1[(size_t)k * 256 + j];
        red[kq * 32 + cl] = a0;
        __syncthreads();
        if (tid < 32) { float s = 0.f;
#pragma unroll
            for (int q = 0; q < 16; ++q) s += red[q * 32 + cl];
            ((float*)(P.ws + WS_CB))[sel * 256 + j] = s + P.cmp_b1[sel * 256 + j]; }
        __syncthreads();
    }
    {
        bf16_t* wb = (bf16_t*)(P.ws + WS_WIN);
        const int gt = blockIdx.x * NTHREADS + tid, NG = gridDim.x * NTHREADS;
        for (int i = gt; i < 1024 * (3584 / 8); i += NG) { const int k = i / 448, c8 = (i % 448) * 8;
            const int sc_ = c8 < 1280 ? c8 : (c8 < 3328 ? c8 + 24 : c8 - 2048);
            u32x4 o = (u32x4){0u, 0u, 0u, 0u};
            if (c8 < 3352) { const f32x4 a = *(const f32x4*)(P.w_in + (size_t)k * IN_COLS + sc_), b2 = *(const f32x4*)(P.w_in + (size_t)k * IN_COLS + sc_ + 4);
                o.x = cvtpk(a.x, a.y); o.y = cvtpk(a.z, a.w); o.z = cvtpk(b2.x, b2.y); o.w = cvtpk(b2.z, b2.w); }
            *(u32x4*)(wb + (size_t)k * 3584 + c8) = o; }
    }
    if (blockIdx.x == gridDim.x - 2) {
        for (int i = tid; i < 2 * 8 * 64; i += NTHREADS) { const int t2 = i >> 9, bg = (i >> 6) & 7, d = i & 63;
            ((bf16_t*)(P.ws + (t2 ? WS_VC : WS_KC)))[((size_t)bg * 512 + 511) * 64 + d] = 0; }
    }
    if (blockIdx.x == gridDim.x - 1) {
        float* lb = (float*)(P.ws + WS_LB);
        for (int i = tid; i < 512; i += NTHREADS) { const float p0 = P.hgrn_lb[i], p1 = P.hgrn_lb[512 + i]; lb[i] = 1.0f / (1.0f + __expf(p1 - p0)); }
    }
}

__device__ __forceinline__ void norm_mod_rows(const float* x, const float* w, const float* mod_sh, const float* mod_sc, bf16_t* h, int hs) {
    const int lane = threadIdx.x & 63, gw = blockIdx.x * (NTHREADS / 64) + (threadIdx.x >> 6), NGW = gridDim.x * (NTHREADS / 64);
    for (int m = gw; m < T; m += NGW) {
        const int b = m / SEQ;
        const f32x4* xr = (const f32x4*)(x + (size_t)m * D) + lane;
        f32x4 v[4]; float s = 0.f;
#pragma unroll
        for (int j = 0; j < 4; ++j) { v[j] = xr[64 * j]; s += (v[j].x * v[j].x + v[j].y * v[j].y) + (v[j].z * v[j].z + v[j].w * v[j].w); }
        const float rstd = rsqrtf(wave_sum(s) * (1.f / D) + RMS_EPS);
        u32x2* o = (u32x2*)(h + (size_t)m * hs) + lane;
#pragma unroll
        for (int j = 0; j < 4; ++j) {
            const int col = (lane + 64 * j) * 4;
            const f32x4 wv = *(const f32x4*)(w + col), scv = *(const f32x4*)(mod_sc + b * 6144 + col), shv = *(const f32x4*)(mod_sh + b * 6144 + col);
            f32x4 r;
            r.x = v[j].x * rstd * wv.x * (1.f + scv.x) + shv.x; r.y = v[j].y * rstd * wv.y * (1.f + scv.y) + shv.y;
            r.z = v[j].z * rstd * wv.z * (1.f + scv.z) + shv.z; r.w = v[j].w * rstd * wv.w * (1.f + scv.w) + shv.w;
            u32x2 pk; pk.x = cvtpk(r.x, r.y); pk.y = cvtpk(r.z, r.w); o[64 * j] = pk;
        }
    }
}

__device__ __forceinline__ void phase_inproj(const Params& P, LAS unsigned char* lds) {
    const int tid = opaque_tid(), lane = tid & 63, wid = tid >> 6, wm = wid >> 1, wn = wid & 1, fr = lane & 15, fq = lane >> 4;
    const bf16_t* h1 = (const bf16_t*)(P.ws + WS_H); const bf16_t* wb = (const bf16_t*)(P.ws + WS_WIN);
    bf16_t* qo = (bf16_t*)(P.ws + WS_Q); bf16_t* kvo = (bf16_t*)(P.ws + WS_KV); float* gates = (float*)(P.ws + WS_GATES);
    bf16_t* hq = (bf16_t*)(P.ws + WS_HQ); float* logf = (float*)(P.ws + WS_LOGF); bf16_t* hv = (bf16_t*)(P.ws + WS_HV); bf16_t* hg = (bf16_t*)(P.ws + WS_HG);
    const float* lb = (const float*)(P.ws + WS_LB);
    constexpr int NRT = T / 256, NCT = 14;
    const int nx = (gridDim.x % 8 == 0) ? 8 : 1, xl = blockIdx.x % nx, li = blockIdx.x / nx, nloc = gridDim.x / nx;
    for (int v = li; v < (NRT / nx) * NCT; v += nloc) {
        const int rg = v / (NCT * 4), rem = v % (NCT * 4), ct = rem >> 2, rt = xl + nx * (rg * 4 + (rem & 3));
        const bf16_t* aptr[2]; const bf16_t* bptr[2];
#pragma unroll
        for (int i = 0; i < 2; ++i) { aptr[i] = h1 + (size_t)(rt * 256 + Gemm4::a_row(i, tid)) * H1S + 8 * (tid & 3);
            bptr[i] = wb + (size_t)Gemm4::b_k(i, tid) * 3584 + ct * 256 + 8 * (tid & 31); }
        f32x4 acc[4][8];
        Gemm4::run(acc, aptr, 32, bptr, (size_t)32 * 3584, D / 32, lds);
        const int row0 = rt * 256 + wm * 64 + fr;
        const int cw = wn * 128 + 4 * fq;
        if (ct < 5) {
            const bool is_q = ct < 2; const int seg = (ct - 2) * 2 + wn;
            const bool do_norm = is_q || seg == 2 || seg == 4;
            const float* nw = is_q ? P.q_norm_w : (P.k_norm_w + (seg == 2 ? 64 : 128));
            const float osc = is_q ? 0.125f : 1.0f;
#pragma unroll
            for (int hh = 0; hh < 2; ++hh) {
                f32x4 wv[4];
#pragma unroll
                for (int n4 = 0; n4 < 4; ++n4) wv[n4] = do_norm ? *(const f32x4*)(nw + n4 * 16 + 4 * fq) : (f32x4){1.f, 1.f, 1.f, 1.f};
#pragma unroll
                for (int mi = 0; mi < 4; ++mi) {
                    float rstd = 1.f;
                    if (do_norm) { float s = 0.f;
#pragma unroll
                        for (int n4 = 0; n4 < 4; ++n4) { const f32x4 a = acc[mi][hh * 4 + n4]; s += (a.x * a.x + a.y * a.y) + (a.z * a.z + a.w * a.w); }
                        s += __shfl_xor(s, 16); s += __shfl_xor(s, 32);
                        rstd = rsqrtf(s * (1.f / 64.f) + RMS_EPS) * osc; }
                    const size_t m = (size_t)(row0 + mi * 16);
                    bf16_t* dst = is_q ? (qo + m * 512 + ct * 256 + cw + hh * 64) : (kvo + m * 768 + (ct - 2) * 256 + cw + hh * 64);
#pragma unroll
                    for (int n4 = 0; n4 < 4; ++n4) { const f32x4 a = acc[mi][hh * 4 + n4]; u32x2 pk;
                        pk.x = cvtpk(a.x * rstd * wv[n4].x, a.y * rstd * wv[n4].y); pk.y = cvtpk(a.z * rstd * wv[n4].z, a.w * rstd * wv[n4].w);
                        *(u32x2*)(dst + n4 * 16) = pk; }
                }
            }
        } else if (ct == 13) {
            if (wn == 0) {
#pragma unroll
                for (int mi = 0; mi < 4; ++mi) { const size_t m = (size_t)(row0 + mi * 16);
#pragma unroll
                    for (int ni = 0; ni < 2; ++ni) { const int c = ni * 16 + 4 * fq; if (c < 24) { const f32x4 a = acc[mi][ni];
                            *(f32x4*)(gates + m * 24 + c) = (f32x4){sigmoidf_(a.x), sigmoidf_(a.y), sigmoidf_(a.z), sigmoidf_(a.w)}; } } }
            }
        } else {
            const int hs = (ct - 5) >> 1, cc = ((ct - 5) & 1) * 256 + cw;
#pragma unroll
            for (int mi = 0; mi < 4; ++mi) { const size_t m = (size_t)(row0 + mi * 16);
#pragma unroll
                for (int ni = 0; ni < 8; ++ni) { const f32x4 a = acc[mi][ni]; const int c = cc + ni * 16;
                    if (hs == 0) { const float s = 0.08838834764831845f; u32x2 pk; pk.x = cvtpk(siluf_(a.x) * s, siluf_(a.y) * s); pk.y = cvtpk(siluf_(a.z) * s, siluf_(a.w) * s); *(u32x2*)(hq + m * 512 + c) = pk; }
                    else if (hs == 1) { const f32x4 l = *(const f32x4*)(lb + c); f32x4 o;
                        o.x = __logf(l.x + (1.f - l.x) * sigmoidf_(a.x)); o.y = __logf(l.y + (1.f - l.y) * sigmoidf_(a.y));
                        o.z = __logf(l.z + (1.f - l.z) * sigmoidf_(a.z)); o.w = __logf(l.w + (1.f - l.w) * sigmoidf_(a.w)); *(f32x4*)(logf + m * 512 + c) = o; }
                    else if (hs == 2) { u32x2 pk; pk.x = cvtpk(a.x, a.y); pk.y = cvtpk(a.z, a.w); *(u32x2*)(hv + m * 512 + c) = pk; }
                    else { u32x2 pk; pk.x = cvtpk(sigmoidf_(a.x), sigmoidf_(a.y)); pk.y = cvtpk(sigmoidf_(a.z), sigmoidf_(a.w)); *(u32x2*)(hg + m * 512 + c) = pk; }
                } }
        }
    }
}

__device__ __forceinline__ float gelu_tanh(float x) {
    const float u = 0.7978845608028654f * (x + 0.044715f * x * x * x);
    const float th = 1.0f - 2.0f / (1.0f + __expf(2.0f * u));
    return 0.5f * x * (1.0f + th);
}
__device__ __forceinline__ void compress_unit(const Params& P, LAS unsigned char* lds, int u) {
    typedef GemmT<2, 4> G;
    const int tid = opaque_tid(), lane = tid & 63, wid = tid >> 6, wm = wid >> 2, wn = wid & 3, fr = lane & 15, fq = lane >> 4;
    const int sel = u >> 5, rt = u & 31;
    const bf16_t* kv = (const bf16_t*)(P.ws + WS_KV);
    bf16_t* cmph = (bf16_t*)(P.ws + WS_CMPH) + (size_t)sel * 4096 * 256;
    const float* cb = (const float*)(P.ws + WS_CB) + sel * 256;
    const bf16_t* arow[2];
#pragma unroll
    for (int p = 0; p < 2; ++p) { int r = rt * 128 + p * 64 + (tid >> 3); r = r < 4088 ? r : 4087;
        const int b = r / 1022, rem = r % 1022, i = rem >> 1, g = rem & 1;
        arow[p] = kv + (size_t)(b * SEQ + 16 * i) * 768 + sel * 128 + g * 64; }
    f32x4 acc[4][4];
    G::run(acc, arow, 768, P.cmp_w1 + (size_t)sel * 2048 * 256, 256, 32, lds);
#pragma unroll
    for (int mi = 0; mi < 4; ++mi) { const size_t row = (size_t)(rt * 128 + wm * 64 + mi * 16 + fr);
#pragma unroll
        for (int ni = 0; ni < 4; ++ni) { const int col = wn * 64 + ni * 16 + 4 * fq; const f32x4 a = acc[mi][ni]; const f32x4 bb = *(const f32x4*)(cb + col);
            u32x2 pk; pk.x = cvtpk(gelu_tanh(a.x + bb.x), gelu_tanh(a.y + bb.y)); pk.y = cvtpk(gelu_tanh(a.z + bb.z), gelu_tanh(a.w + bb.w));
            *(u32x2*)(cmph + row * 256 + col) = pk; } }
    __syncthreads();
    {
        const int row = tid >> 2, cq = tid & 3;
        const bf16_t* hr = cmph + (size_t)(rt * 128 + row) * 256;
        const float* w2 = P.cmp_w2 + (size_t)sel * 256 * 64 + cq * 16;
        float o[16];
#pragma unroll
        for (int j = 0; j < 16; ++j) o[j] = 0.f;
        for (int k8 = 0; k8 < 256; k8 += 8) {
            const u32x4 hv = *(const u32x4*)(hr + k8);
#pragma unroll
            for (int kk = 0; kk < 8; ++kk) {
                const unsigned wd = hv[kk >> 1]; const float a = (kk & 1) ? __uint_as_float(wd & 0xffff0000u) : __uint_as_float(wd << 16);
                const float* wr = w2 + (size_t)(k8 + kk) * 64;
#pragma unroll
                for (int j4 = 0; j4 < 4; ++j4) { const f32x4 w = *(const f32x4*)(wr + j4 * 4);
                    o[j4 * 4 + 0] += a * w.x; o[j4 * 4 + 1] += a * w.y; o[j4 * 4 + 2] += a * w.z; o[j4 * 4 + 3] += a * w.w; }
            }
        }
        if (sel == 0) { float s = 0.f;
#pragma unroll
            for (int j = 0; j < 16; ++j) s += o[j] * o[j];
            s += __shfl_xor(s, 1); s += __shfl_xor(s, 2);
            const float rstd = rsqrtf(s * (1.f / 64.f) + RMS_EPS);
#pragma unroll
            for (int j = 0; j < 16; ++j) o[j] *= rstd * P.k_norm_w[cq * 16 + j]; }
        const int r = rt * 128 + row;
        if (r < 4088) { const int b = r / 1022, rem = r % 1022, i = rem >> 1, g = rem & 1;
            bf16_t* dst = (bf16_t*)(P.ws + (sel ? WS_VC : WS_KC)) + ((size_t)(b * 2 + g) * 512 + i) * 64 + cq * 16;
            u32x4 w0, w1;
            w0.x = cvtpk(o[0], o[1]); w0.y = cvtpk(o[2], o[3]); w0.z = cvtpk(o[4], o[5]); w0.w = cvtpk(o[6], o[7]);
            w1.x = cvtpk(o[8], o[9]); w1.y = cvtpk(o[10], o[11]); w1.z = cvtpk(o[12], o[13]); w1.w = cvtpk(o[14], o[15]);
            *(u32x4*)dst = w0; *(u32x4*)(dst + 8) = w1; }
    }
    __syncthreads();
}

__device__ __forceinline__ int off_row128(int row, int ch) { return row * 128 + ((ch ^ ((row >> 1) & 7)) << 4); }
__device__ __forceinline__ int off_row256(int row, int ch) { return row * 256 + ((ch ^ (row & 15)) << 4); }
__device__ __forceinline__ int fk_(int r) { return (r & 3) | (((r >> 3) & 1) << 2); }
__device__ __forceinline__ int off_tr256(int row, int col) { return row * 256 + ((((col >> 4) ^ fk_(row)) << 5) + ((col & 15) << 1)); }
constexpr int HL_QT = 0, HL_KT = 16384, HL_KH = 32768, HL_V = 49152, HL_SB = 65536, HL_P = 98304  , HL_TOT = 106496  , HL_RED = 110592  , HL_END = 111104;

template <int MODE> __device__ __forceinline__ void hgrn_unit(const Params& P, LAS unsigned char* lds, int u) {
    const int tid = opaque_tid(), lane = tid & 63, wid = tid >> 6, fr = lane & 15, fq = lane >> 4;
    const int b = u >> 7, h = (u >> 5) & 3, sc = u & 31;
    const bf16_t* hq = (const bf16_t*)(P.ws + WS_HQ); const float* logf = (const float*)(P.ws + WS_LOGF);
    const bf16_t* hv = (const bf16_t*)(P.ws + WS_HV); const bf16_t* hg = (const bf16_t*)(P.ws + WS_HG);
    float* HLs = (float*)(P.ws + WS_HL); float* HDs = (float*)(P.ws + WS_HD);
    bf16_t* mix = (bf16_t*)(P.ws + WS_MIX);
    LAS float* tot = (LAS float*)(lds + HL_TOT); LAS float* red = (LAS float*)(lds + HL_RED);
    f32x4 st[8];
#pragma unroll
    for (int vt = 0; vt < 8; ++vt) st[vt] = (f32x4){0.f, 0.f, 0.f, 0.f};
    if (MODE == 1) {
        const int kk = 16 * wid + fr;
#pragma unroll 4
        for (int j = 0; j < sc; ++j) {
            const float* Lj = HLs + (size_t)(u - sc + j) * 16384 + kk * 128 + 4 * fq; const float dj = HDs[(size_t)(u - sc + j) * 128 + kk];
#pragma unroll
            for (int vt = 0; vt < 8; ++vt) { const f32x4 l = *(const f32x4*)(Lj + vt * 16); st[vt] = st[vt] * dj + l; }
        }
    }
    float dsum = 0.f;
    const int kp = tid & 63, te = tid >> 6;
    for (int c = 0; c < 4; ++c) {
        const size_t tok0 = (size_t)b * SEQ + sc * 256 + c * 64;
        float lf0[8], lf1[8], cs0[8], cs1[8];
        { float a0 = 0.f, a1 = 0.f;
#pragma unroll
          for (int i = 0; i < 8; ++i) { const float2 v = *(const float2*)(logf + (tok0 + te * 8 + i) * 512 + h * 128 + 2 * kp); lf0[i] = v.x; lf1[i] = v.y; a0 += v.x; a1 += v.y; cs0[i] = a0; cs1[i] = a1; }
          tot[te * 128 + 2 * kp] = a0; tot[te * 128 + 2 * kp + 1] = a1; }
#pragma unroll
        for (int i = 0; i < 2; ++i) { const int pc = tid + NTHREADS * i, row = pc >> 4, c8 = (pc & 15) * 8;
            const u32x4 v = *(const u32x4*)(hv + (tok0 + row) * 512 + h * 128 + c8);
            *(LAS u32x4*)(lds + HL_V + off_tr256(row, c8)) = v; }
        if (MODE == 1 ) {
#pragma unroll
            for (int vt = 0; vt < 8; ++vt) { u32x2 pk; pk.x = cvtpk(st[vt].x, st[vt].y); pk.y = cvtpk(st[vt].z, st[vt].w);
                *(LAS u32x2*)(lds + HL_SB + off_tr256(16 * wid + fr, 16 * vt + 4 * fq)) = pk; }
        }
        __syncthreads();
        float pre0 = 0.f, pre1 = 0.f, last0 = 0.f, last1 = 0.f;
#pragma unroll
        for (int e = 0; e < 8; ++e) { const float t0 = tot[e * 128 + 2 * kp], t1 = tot[e * 128 + 2 * kp + 1]; if (e < te) { pre0 += t0; pre1 += t1; } last0 += t0; last1 += t1; }
#pragma unroll
        for (int i = 0; i < 8; ++i) {
            const int t = te * 8 + i;
            const float c0 = cs0[i] + pre0, c1 = cs1[i] + pre1;
            const float k0 = 1.f - __expf(lf0[i]), k1 = 1.f - __expf(lf1[i]);
            const unsigned khat = cvtpk(k0 * __expf(last0 - c0), k1 * __expf(last1 - c1));
            *(LAS unsigned*)(lds + HL_KH + off_tr256(t, 2 * kp)) = khat;
            if (MODE == 1) {
                const unsigned qraw = *(const unsigned*)(hq + (tok0 + t) * 512 + h * 128 + 2 * kp);
                const float q0 = __uint_as_float(qraw << 16), q1 = __uint_as_float(qraw & 0xffff0000u);
                const unsigned qt = cvtpk(q0 * __expf(c0), q1 * __expf(c1));
                const unsigned kt = cvtpk(k0 * __expf(fminf(-c0, 80.f)), k1 * __expf(fminf(-c1, 80.f)));
                const int o = off_row256(t, kp >> 2) + ((kp & 3) << 2);
                *(LAS unsigned*)(lds + HL_QT + o) = qt; *(LAS unsigned*)(lds + HL_KT + o) = kt;
            }
        }
        const float dec = __expf(tot[0 * 128 + 16 * wid + fr] + tot[1 * 128 + 16 * wid + fr] + tot[2 * 128 + 16 * wid + fr] + tot[3 * 128 + 16 * wid + fr]
                                 + tot[4 * 128 + 16 * wid + fr] + tot[5 * 128 + 16 * wid + fr] + tot[6 * 128 + 16 * wid + fr] + tot[7 * 128 + 16 * wid + fr]);
        if (MODE == 0 && tid < 128) { float s = 0.f;
#pragma unroll
            for (int e = 0; e < 8; ++e) s += tot[e * 128 + tid];
            dsum += s; }
        __syncthreads();
        f32x4 oacc[4];
        if (MODE == 1) {
            { const int tt = wid & 3;
#pragma unroll
              for (int si = 0; si < 2; ++si) { const int stl = 2 * (wid >> 2) + si;
                  f32x4 sacc = (f32x4){0.f, 0.f, 0.f, 0.f};
                  if (stl <= tt) {
#pragma unroll
                      for (int ks = 0; ks < 4; ++ks) {
                          const bf16x8 a = *(const LAS bf16x8*)(lds + HL_KT + off_row256(stl * 16 + fr, ks * 4 + fq));
                          const bf16x8 bq = *(const LAS bf16x8*)(lds + HL_QT + off_row256(tt * 16 + fr, ks * 4 + fq));
                          sacc = __builtin_amdgcn_mfma_f32_16x16x32_bf16(a, bq, sacc, 0, 0, 0);
                      }
                  }
                  const int t = tt * 16 + fr, s0 = stl * 16 + 4 * fq;
                  u32x2 pk; pk.x = cvtpk(s0 + 0 <= t ? sacc.x : 0.f, s0 + 1 <= t ? sacc.y : 0.f); pk.y = cvtpk(s0 + 2 <= t ? sacc.z : 0.f, s0 + 3 <= t ? sacc.w : 0.f);
                  *(LAS u32x2*)(lds + HL_P + off_row128(t, s0 >> 3) + ((s0 & 7) << 1)) = pk; }
            }
            __syncthreads();
            { const int tt = wid >> 1;
#pragma unroll
              for (int i = 0; i < 4; ++i) { const int vt = 4 * (wid & 1) + i;
                  f32x4 a = (f32x4){0.f, 0.f, 0.f, 0.f};
#pragma unroll
                  for (int ks = 0; ks < 2; ++ks) {
                      const int kr = ks * 32 + 8 * fq + (fr >> 2);
                      const s16x4 lo = lds_tr(lds + HL_V + off_tr256(kr, vt * 16 + 4 * (fr & 3))), hi = lds_tr(lds + HL_V + off_tr256(kr + 4, vt * 16 + 4 * (fr & 3)));
                      const bf16x8 va = (bf16x8){lo[0], lo[1], lo[2], lo[3], hi[0], hi[1], hi[2], hi[3]};
                      const bf16x8 pb = *(const LAS bf16x8*)(lds + HL_P + off_row128(tt * 16 + fr, ks * 4 + fq));
                      a = __builtin_amdgcn_mfma_f32_16x16x32_bf16(va, pb, a, 0, 0, 0);
                  }
#pragma unroll
                  for (int ks = 0; ks < 4; ++ks) {
                      const int kr = ks * 32 + 8 * fq + (fr >> 2);
                      const s16x4 lo = lds_tr(lds + HL_SB + off_tr256(kr, vt * 16 + 4 * (fr & 3))), hi = lds_tr(lds + HL_SB + off_tr256(kr + 4, vt * 16 + 4 * (fr & 3)));
                      const bf16x8 sa = (bf16x8){lo[0], lo[1], lo[2], lo[3], hi[0], hi[1], hi[2], hi[3]};
                      const bf16x8 qb = *(const LAS bf16x8*)(lds + HL_QT + off_row256(tt * 16 + fr, ks * 4 + fq));
                      a = __builtin_amdgcn_mfma_f32_16x16x32_bf16(sa, qb, a, 0, 0, 0);
                  }
                  const u32x2 gr = *(const u32x2*)(hg + (tok0 + tt * 16 + fr) * 512 + h * 128 + vt * 16 + 4 * fq);
                  a.x *= __uint_as_float(gr.x << 16); a.y *= __uint_as_float(gr.x & 0xffff0000u); a.z *= __uint_as_float(gr.y << 16); a.w *= __uint_as_float(gr.y & 0xffff0000u);
                  oacc[i] = a; }
              float ss = 0.f;
#pragma unroll
              for (int i = 0; i < 4; ++i) ss += (oacc[i].x * oacc[i].x + oacc[i].y * oacc[i].y) + (oacc[i].z * oacc[i].z + oacc[i].w * oacc[i].w);
              ss += __shfl_xor(ss, 16); ss += __shfl_xor(ss, 32);
              if (fq == 0) red[(tt * 2 + (wid & 1)) * 16 + fr] = ss; }
        }
#pragma unroll
        for (int vt = 0; vt < 8; ++vt) {
            f32x4 a = st[vt] * dec;
#pragma unroll
            for (int ks = 0; ks < 2; ++ks) {
                const int kr = ks * 32 + 8 * fq + (fr >> 2);
                const s16x4 lo = lds_tr(lds + HL_V + off_tr256(kr, vt * 16 + 4 * (fr & 3))), hi = lds_tr(lds + HL_V + off_tr256(kr + 4, vt * 16 + 4 * (fr & 3)));
                const bf16x8 va = (bf16x8){lo[0], lo[1], lo[2], lo[3], hi[0], hi[1], hi[2], hi[3]};
                const s16x4 lo2 = lds_tr(lds + HL_KH + off_tr256(kr, wid * 16 + 4 * (fr & 3))), hi2 = lds_tr(lds + HL_KH + off_tr256(kr + 4, wid * 16 + 4 * (fr & 3)));
                const bf16x8 kb = (bf16x8){lo2[0], lo2[1], lo2[2], lo2[3], hi2[0], hi2[1], hi2[2], hi2[3]};
                a = __builtin_amdgcn_mfma_f32_16x16x32_bf16(va, kb, a, 0, 0, 0);
            }
            st[vt] = a;
        }
        __syncthreads();
        if (MODE == 1) {
            const int tt = wid >> 1; const float ssum = red[(tt * 2) * 16 + fr] + red[(tt * 2 + 1) * 16 + fr];
            const float rstd = rsqrtf(ssum * (1.f / 128.f) + RMS_EPS);
#pragma unroll
            for (int i = 0; i < 4; ++i) { const int v = (4 * (wid & 1) + i) * 16 + 4 * fq; const f32x4 w = *(const f32x4*)(P.rec_out_norm_w + h * 128 + v);
                u32x2 pk; pk.x = cvtpk(oacc[i].x * rstd * w.x, oacc[i].y * rstd * w.y); pk.y = cvtpk(oacc[i].z * rstd * w.z, oacc[i].w * rstd * w.w);
                *(u32x2*)(mix + (tok0 + tt * 16 + fr) * 1024 + 512 + h * 128 + v) = pk; }
        }
    }
    if (MODE == 0) {
#pragma unroll
        for (int vt = 0; vt < 8; ++vt) *(f32x4*)(HLs + (size_t)u * 16384 + (16 * wid + fr) * 128 + vt * 16 + 4 * fq) = st[vt];
        if (tid < 128) HDs[(size_t)u * 128 + tid] = __expf(dsum);
    }
    __syncthreads();
}


constexpr int NL_K = 0, NL_V = 16384, NL_IMP = 32768, NL_IMP_STRIDE = 132, NL_SELM = NL_IMP + 8 * 8 * NL_IMP_STRIDE * 4, NL_END = NL_SELM + 1024;
__device__ __forceinline__ int off_v128(int row, int ch) { return row * 128 + ((ch ^ ((row & 3) << 1)) << 4); }
#define MFMA32(a, b, c) __builtin_amdgcn_mfma_f32_32x32x16_bf16(a, b, c, 0, 0, 0)

struct NsaLane { int t; float sl2; int qi; unsigned long long mlo, mhi; };

template <int MODE> __device__ __forceinline__ void nsa_pass(LAS unsigned char* lds, const bf16_t* Kg, const bf16_t* Vg, int rs, unsigned long long ulo, unsigned long long uhi,
                                                            const bf16x8 (&qf)[4], const NsaLane& L, float inv, float& lsum, f32x16 (&O)[2], LAS float* impw) {
    const int tid = opaque_tid(), lane = tid & 63, hi = lane >> 5, c = lane & 31;
    const int ld_row = tid >> 3, ld_ch = tid & 7;
    const int kw_off = off_row128(ld_row, ld_ch), vw_off = off_v128(ld_row, ld_ch);
    u32x4 k0, v0, k1, v1, k2, v2;
    auto next = [&](int jj) -> int { ++jj; if (jj < 64) { const unsigned long long m = ulo >> jj; if (m) return jj + __builtin_ctzll(m); jj = 64; }
                                     if (jj < 128) { const unsigned long long m = uhi >> (jj - 64); if (m) return jj + __builtin_ctzll(m); } return 128; };
    int jA = next(-1), jB = jA < 128 ? next(jA) : 128, jC = jB < 128 ? next(jB) : 128;
    const int jsafe = jA < 128 ? jA : 0;
    auto ldk = [&](int jj) -> u32x4 { const int q = jj < 128 ? jj : jsafe; return *(const u32x4*)(Kg + (size_t)(q * 64 + ld_row) * rs + ld_ch * 8); };
    auto ldv = [&](int jj) -> u32x4 { const int q = jj < 128 ? jj : jsafe; return *(const u32x4*)(Vg + (size_t)(q * 64 + ld_row) * rs + ld_ch * 8); };
    k0 = ldk(jA); k1 = ldk(jB); k2 = ldk(jC);
    if (MODE != 0) { v0 = ldv(jA); v1 = ldv(jB); v2 = ldv(jC); }
    int it = 0;
    auto step = [&](u32x4& kreg, u32x4& vreg) {
        const int j = jA;
        LAS unsigned char* kb = lds + NL_K + (it & 1) * 8192; LAS unsigned char* vb = lds + NL_V + (it & 1) * 8192;
        *(LAS u32x4*)(kb + kw_off) = kreg; if (MODE != 0) *(LAS u32x4*)(vb + vw_off) = vreg;
        const int jD = jC < 128 ? next(jC) : 128;
        kreg = ldk(jD); if (MODE != 0) vreg = ldv(jD);
        __syncthreads();
        bool need = true; bool selbit = true;
        if (MODE == 2) { selbit = (j < 64 ? (L.mlo >> j) : (L.mhi >> (j - 64))) & 1ull; need = __any(selbit); }
        if (need) {
            f32x16 p0 = {}, p1 = {};
#pragma unroll
            for (int ks = 0; ks < 4; ++ks) {
                const bf16x8 a0 = *(const LAS bf16x8*)(kb + off_row128(c, 2 * ks + hi)), a1 = *(const LAS bf16x8*)(kb + off_row128(32 + c, 2 * ks + hi));
                p0 = MFMA32(a0, qf[ks], p0); p1 = MFMA32(a1, qf[ks], p1);
            }
            const int stride = (MODE <= 1) ? 16 : 1;
            const int dl = (MODE <= 1) ? (L.t - 31 - 16 * (j * 64 + 4 * hi)) : (L.t - (j * 64 + 4 * hi));
            const float nb = -L.sl2 * (float)dl, sls = L.sl2 * (float)stride;
            float rs_ = 0.f;
#pragma unroll
            for (int r = 0; r < 16; ++r) {
                const int ro0 = (r & 3) + 8 * (r >> 2), ro1 = ro0 + 32;
                const int d0 = dl - stride * ro0, d1 = dl - stride * ro1;
                bool v0 = d0 >= 0, v1 = d1 >= 0;
                if (MODE == 3) { v0 = v0 && d0 < 512; v1 = v1 && d1 < 512; }
                if (MODE == 2) { v0 = v0 && selbit; v1 = v1 && selbit; }
                float e0 = __builtin_amdgcn_exp2f(__builtin_fmaf(p0[r], LOG2E, __builtin_fmaf(sls, (float)ro0, nb)));
                float e1 = __builtin_amdgcn_exp2f(__builtin_fmaf(p1[r], LOG2E, __builtin_fmaf(sls, (float)ro1, nb)));
                e0 = v0 ? e0 : 0.f; e1 = v1 ? e1 : 0.f;
                if (MODE == 1) { e0 *= inv; e1 *= inv; }
                p0[r] = e0; p1[r] = e1; rs_ += e0 + e1;
            }
            lsum += rs_;
            if (MODE == 1) {
#pragma unroll
                for (int kt = 0; kt < 2; ++kt)
#pragma unroll
                    for (int i = 0; i < 4; ++i) {
                        float g = kt ? (p1[4 * i] + p1[4 * i + 1]) + (p1[4 * i + 2] + p1[4 * i + 3]) : (p0[4 * i] + p0[4 * i + 1]) + (p0[4 * i + 2] + p0[4 * i + 3]);
                        float l3 = kt ? p1[4 * i + 3] : p0[4 * i + 3];
                        g += __shfl_xor(g, 1); g += __shfl_xor(g, 2); l3 += __shfl_xor(l3, 1); l3 += __shfl_xor(l3, 2);
                        if ((c & 3) == 0) { const int jj = j * 16 + kt * 8 + 2 * i + hi; __hip_atomic_fetch_add(impw + L.qi * NL_IMP_STRIDE + jj, g, __ATOMIC_RELAXED, __HIP_MEMORY_SCOPE_WORKGROUP); __hip_atomic_fetch_add(impw + L.qi * NL_IMP_STRIDE + jj + 1, l3, __ATOMIC_RELAXED, __HIP_MEMORY_SCOPE_WORKGROUP); }
                    }
            }
            if (MODE != 0) {
                bf16x8 pf[4];
#pragma unroll
                for (int s4 = 0; s4 < 4; ++s4) { u32x4 w;
#pragma unroll
                    for (int e = 0; e < 4; ++e) { const int r = 8 * (s4 & 1) + 2 * e; w[e] = (s4 >> 1) ? cvtpk(p1[r], p1[r + 1]) : cvtpk(p0[r], p0[r + 1]); }
                    pf[s4] = __builtin_bit_cast(bf16x8, w); }
                const int g4 = lane >> 4, sub = g4 & 1, i16 = lane & 15, qq = i16 >> 2, pp = i16 & 3;
#pragma unroll
                for (int dt = 0; dt < 2; ++dt)
#pragma unroll
                    for (int s4 = 0; s4 < 4; ++s4) {
                        const int row = 16 * s4 + 4 * hi + qq, ch = 4 * dt + 2 * sub + (pp >> 1);
                        const s16x4 lo = lds_tr(vb + off_v128(row, ch) + 8 * (pp & 1)), hh = lds_tr(vb + off_v128(row + 8, ch) + 8 * (pp & 1));
                        const bf16x8 vf = (bf16x8){lo[0], lo[1], lo[2], lo[3], hh[0], hh[1], hh[2], hh[3]};
                        O[dt] = MFMA32(vf, pf[s4], O[dt]);
                    }
            }
        }
        jA = jB; jB = jC; jC = jD; ++it;
    };
    while (jA < 128) {
        step(k0, v0); if (jA >= 128) break;
        step(k1, v1); if (jA >= 128) break;
        step(k2, v2);
    }
    __syncthreads();
}

__device__ __forceinline__ void nsa_unit(const Params& P, LAS unsigned char* lds, int u) {
    const int tid = opaque_tid(), lane = tid & 63, wid = tid >> 6, hi = lane >> 5, c = lane & 31;
    const int b = u >> 8, g = (u >> 7) & 1, qb = u & 127;
    const bf16_t* qg = (const bf16_t*)(P.ws + WS_Q); const bf16_t* kv = (const bf16_t*)(P.ws + WS_KV);
    const bf16_t* kcn = (const bf16_t*)(P.ws + WS_KC) + (size_t)(b * 2 + g) * 512 * 64; const bf16_t* vcc = (const bf16_t*)(P.ws + WS_VC) + (size_t)(b * 2 + g) * 512 * 64;
    const float* gates = (const float*)(P.ws + WS_GATES); bf16_t* mix = (bf16_t*)(P.ws + WS_MIX);
    LAS float* impw = (LAS float*)(lds + NL_IMP) + wid * 8 * NL_IMP_STRIDE;
    LAS unsigned long long* selm = (LAS unsigned long long*)(lds + NL_SELM);
    NsaLane L; L.qi = c >> 2; const int hh = c & 3, head = g * 4 + hh;
    L.t = qb * 64 + wid * 8 + L.qi; L.sl2 = exp2f(-(float)(head + 1)) * LOG2E; L.mlo = 0; L.mhi = 0;
    const size_t tok = (size_t)b * SEQ + L.t;
    bf16x8 qf[4];
#pragma unroll
    for (int ks = 0; ks < 4; ++ks) qf[ks] = *(const bf16x8*)(qg + tok * 512 + head * 64 + 16 * ks + 8 * hi);
    for (int i = lane; i < 8 * NL_IMP_STRIDE; i += 64) impw[i] = 0.f;
    const int ncmp = qb * 4 + 3 < 511 ? qb * 4 + 3 : 511;
    const int nblk = (ncmp + 63) >> 6;
    const unsigned long long cm = nblk >= 64 ? ~0ull : ((1ull << nblk) - 1ull);
    f32x16 O[2], Ot[2]; float lsum = 0.f;
    O[0] = f32x16{}; O[1] = f32x16{};
    nsa_pass<0>(lds, kcn, vcc, 64, cm, 0ull, qf, L, 1.f, lsum, O, impw);
    lsum += __shfl_xor(lsum, 32);
    const float invc = 1.0f / fmaxf(lsum, 1e-30f);
    float dummy = 0.f;
    nsa_pass<1>(lds, kcn, vcc, 64, cm, 0ull, qf, L, invc, dummy, O, impw);
    const float* gt = gates + tok * 24 + g * 12 + hh * 3;
    const float g0 = gt[0], g1 = gt[1], g2 = gt[2];
#pragma unroll
    for (int dt = 0; dt < 2; ++dt) Ot[dt] = O[dt] * g0;
    {
        const int ncausal = qb + 1;
        for (int qi = 0; qi < 8; ++qi) {
            unsigned long long lo, hi64;
            if (ncausal <= 16) { lo = (1ull << ncausal) - 1ull; hi64 = 0ull; }
            else {
                const int j0 = lane, j1 = lane + 64;
                const bool f0 = (j0 == 0) || (j0 == qb) || (j0 == qb - 1), f1 = (j1 == qb) || (j1 == qb - 1);
                const unsigned k0 = (j0 <= qb && !f0) ? (0x80000000u | (__float_as_uint(impw[qi * NL_IMP_STRIDE + j0]) & 0x7fffff80u) | (unsigned)j0) : 0u;
                const unsigned k1 = (j1 <= qb && !f1) ? (0x80000000u | (__float_as_uint(impw[qi * NL_IMP_STRIDE + j1]) & 0x7fffff80u) | (unsigned)j1) : 0u;
                const int needn = 13;
                unsigned th = 0u;
                for (int bit = 31; bit >= 0; --bit) { const unsigned cand = th | (1u << bit);
                    const int cnt = __popcll(__ballot(k0 >= cand)) + __popcll(__ballot(k1 >= cand));
                    if (cnt >= needn) th = cand; }
                lo = __ballot(f0 || (k0 >= th && k0 != 0u)); hi64 = __ballot(f1 || (k1 >= th && k1 != 0u));
            }
            if (lane == 0) { selm[(wid * 8 + qi) * 2] = lo; selm[(wid * 8 + qi) * 2 + 1] = hi64; }
        }
    }
    __syncthreads();
    unsigned long long ulo = selm[lane * 2], uhi = selm[lane * 2 + 1];
#pragma unroll
    for (int o = 1; o < 64; o <<= 1) { ulo |= __shfl_xor(ulo, o); uhi |= __shfl_xor(uhi, o); }
    L.mlo = selm[(wid * 8 + L.qi) * 2]; L.mhi = selm[(wid * 8 + L.qi) * 2 + 1];
    const bf16_t* kvb = kv + (size_t)b * SEQ * 768 + g * 64;
    O[0] = f32x16{}; O[1] = f32x16{}; lsum = 0.f;
    nsa_pass<2>(lds, kvb + 256, kvb + 384, 768, ulo, uhi, qf, L, 1.f, lsum, O, impw);
    lsum += __shfl_xor(lsum, 32);
    { const float sc = g1 / fmaxf(lsum, 1e-30f);
#pragma unroll
      for (int dt = 0; dt < 2; ++dt) Ot[dt] += O[dt] * sc; }
    {
        const int jlo = qb >= 8 ? qb - 8 : 0;
        unsigned long long wlo = 0ull, whi = 0ull;
        for (int jj = jlo; jj <= qb; ++jj) { if (jj < 64) wlo |= 1ull << jj; else whi |= 1ull << (jj - 64); }
        O[0] = f32x16{}; O[1] = f32x16{}; lsum = 0.f;
        nsa_pass<3>(lds, kvb + 512, kvb + 640, 768, wlo, whi, qf, L, 1.f, lsum, O, impw);
        lsum += __shfl_xor(lsum, 32);
        const float sc = g2 / fmaxf(lsum, 1e-30f);
#pragma unroll
        for (int dt = 0; dt < 2; ++dt) Ot[dt] += O[dt] * sc;
    }
    float ss = 0.f;
#pragma unroll
    for (int dt = 0; dt < 2; ++dt)
#pragma unroll
        for (int r = 0; r < 16; ++r) ss += Ot[dt][r] * Ot[dt][r];
    ss += __shfl_xor(ss, 32);
    const float rstd = rsqrtf(ss * (1.f / 64.f) + RMS_EPS);
#pragma unroll
    for (int dt = 0; dt < 2; ++dt)
#pragma unroll
        for (int r4 = 0; r4 < 4; ++r4) { const int d = 32 * dt + 8 * r4 + 4 * hi; const f32x4 w = *(const f32x4*)(P.attn_out_norm_w + head * 64 + d);
            u32x2 pk; pk.x = cvtpk(Ot[dt][4 * r4] * rstd * w.x, Ot[dt][4 * r4 + 1] * rstd * w.y); pk.y = cvtpk(Ot[dt][4 * r4 + 2] * rstd * w.z, Ot[dt][4 * r4 + 3] * rstd * w.w);
            *(u32x2*)(mix + tok * 1024 + head * 64 + d) = pk; }
    __syncthreads();
}


__device__ __forceinline__ void phase_cvt_small(const Params& P) {
    const int tid = threadIdx.x;
    {
        const int gt = blockIdx.x * NTHREADS + tid, NG = gridDim.x * NTHREADS;
        bf16_t* wo = (bf16_t*)(P.ws + WS_WOUT); bf16_t* wrs = (bf16_t*)(P.ws + WS_WRS); bf16_t* wsd = (bf16_t*)(P.ws + WS_WSD);
        for (int i = gt; i < 1024 * 128; i += NG) { const f32x4 a = *(const f32x4*)(P.w_out + (size_t)i * 8), b2 = *(const f32x4*)(P.w_out + (size_t)i * 8 + 4);
            *(u32x4*)(wo + (size_t)i * 8) = (u32x4){cvtpk(a.x, a.y), cvtpk(a.z, a.w), cvtpk(b2.x, b2.y), cvtpk(b2.z, b2.w)}; }
        for (int i = gt; i < 256 * 128; i += NG) { const f32x4 a = *(const f32x4*)(P.sh_wd + (size_t)i * 8), b2 = *(const f32x4*)(P.sh_wd + (size_t)i * 8 + 4);
            *(u32x4*)(wsd + (size_t)i * 8) = (u32x4){cvtpk(a.x, a.y), cvtpk(a.z, a.w), cvtpk(b2.x, b2.y), cvtpk(b2.z, b2.w)}; }
        for (int i = gt; i < 1024 * 96; i += NG) { const int k = i / 96, c8 = (i % 96) * 8;
            const float* s;
            if (c8 < 256) s = P.router_w + (size_t)k * 256 + c8;
            else { const int cc = c8 - 256, t = cc >> 8, u16 = (cc & 255) >> 4; s = ((u16 & 1) ? P.sh_wu : P.sh_wg) + (size_t)k * 256 + t * 128 + (u16 >> 1) * 16 + (cc & 8); }
            const f32x4 a = *(const f32x4*)s, b2 = *(const f32x4*)(s + 4);
            *(u32x4*)(wrs + (size_t)k * 768 + c8) = (u32x4){cvtpk(a.x, a.y), cvtpk(a.z, a.w), cvtpk(b2.x, b2.y), cvtpk(b2.z, b2.w)}; }
    }
}

__device__ __forceinline__ void route_token(const Params& P, int t, int lane) {
    const float* scores = (const float*)(P.ws + WS_SCORES) + (size_t)t * 256;
    const f32x4 s4 = *(const f32x4*)(scores + 4 * lane); const f32x4 b4 = *(const f32x4*)(P.router_bias + 4 * lane);
    float sc[4] = {s4.x, s4.y, s4.z, s4.w};
    float bs[4] = {s4.x + b4.x, s4.y + b4.y, s4.z + b4.z, s4.w + b4.w};
    float m1 = fmaxf(bs[0], bs[1]), m2 = fminf(bs[0], bs[1]);
    { const float v = bs[2]; const float n1 = fmaxf(m1, v); m2 = fmaxf(fminf(m1, v), m2); m1 = n1; }
    { const float v = bs[3]; const float n1 = fmaxf(m1, v); m2 = fmaxf(fminf(m1, v), m2); m1 = n1; }
#pragma unroll
    for (int o = 1; o < 8; o <<= 1) { const float o1 = __shfl_xor(m1, o), o2 = __shfl_xor(m2, o); const float n1 = fmaxf(m1, o1); m2 = fmaxf(fminf(m1, o1), fmaxf(m2, o2)); m1 = n1; }
    const float gs = m1 + m2;
    const int grp = lane >> 3;
    int rank = 0;
#pragma unroll
    for (int g2 = 0; g2 < 8; ++g2) { const float og = __shfl(gs, g2 * 8); rank += (og > gs || (og == gs && g2 < grp)) ? 1 : 0; }
    const bool gsel = rank < 4;
    float mv[4];
#pragma unroll
    for (int i = 0; i < 4; ++i) mv[i] = gsel ? bs[i] : -INFINITY;
    int myidx = -1; float myw = 0.f; float wsum = 0.f;
#pragma unroll 1
    for (int k = 0; k < 8; ++k) {
        float bv = mv[0]; int bi = 4 * lane;
#pragma unroll
        for (int i = 1; i < 4; ++i) if (mv[i] > bv) { bv = mv[i]; bi = 4 * lane + i; }
#pragma unroll
        for (int o = 1; o < 64; o <<= 1) { const float ov = __shfl_xor(bv, o); const int oi = __shfl_xor(bi, o); if (ov > bv || (ov == bv && oi < bi)) { bv = ov; bi = oi; } }
        const int wl = bi >> 2, wc = bi & 3;
        const float mine = wc == 0 ? sc[0] : (wc == 1 ? sc[1] : (wc == 2 ? sc[2] : sc[3]));
        const float wv = __shfl(mine, wl);
        wsum += wv;
        if (lane == k) { myidx = bi; myw = wv; }
        if (lane == wl) {
#pragma unroll
            for (int i = 0; i < 4; ++i) if (i == wc) mv[i] = -INFINITY; }
    }
    if (lane < 8) {
        int* cnt = (int*)(P.ws + WS_CTL + CTL_CNT);
        const int pos = atomicAdd(cnt + myidx, 1);
        if (pos < BCAP) ((int*)(P.ws + WS_BUCKET))[(size_t)myidx * BCAP + pos] = t * 8 + lane;
        ((float*)(P.ws + WS_RW))[(size_t)t * 8 + lane] = myw / wsum * 2.5f;
    }
}


__device__ __forceinline__ void phase_p4a(const Params& P, LAS unsigned char* lds) {
    typedef Gemm4 G;
    const int tid = opaque_tid(), lane = tid & 63, wid = tid >> 6, wm = wid >> 1, wn = wid & 1, fr = lane & 15, fq = lane >> 4;
    struct F { const Params& P;
        __device__ __forceinline__ void ptrs(int seg, const bf16_t* (&aptr)[2], const bf16_t* (&bptr)[2]) const {
            const int tid = opaque_tid(), lane = tid & 63, wid = tid >> 6, wm = wid >> 1, wn = wid & 1, fr = lane & 15, fq = lane >> 4, c8 = 8 * (tid & 31); (void)wm; (void)wn; (void)fr; (void)fq; (void)c8;
            const int u = blockIdx.x + seg * gridDim.x, rt = u >> 2, ct = u & 3;
            const bf16_t* mix = (const bf16_t*)(P.ws + WS_MIX); const bf16_t* wo = (const bf16_t*)(P.ws + WS_WOUT);
#pragma unroll
            for (int i = 0; i < 2; ++i) { aptr[i] = mix + (size_t)(rt * 256 + G::a_row(i, tid)) * 1024 + 8 * (tid & 3); bptr[i] = wo + (size_t)G::b_k(i, tid) * 1024 + ct * 256 + 8 * (tid & 31); } }
        __device__ __forceinline__ void epi(int seg, f32x4 (&acc)[4][8]) const {
            const int tid = opaque_tid(), lane = tid & 63, wid = tid >> 6, wm = wid >> 1, wn = wid & 1, fr = lane & 15, fq = lane >> 4, c8 = 8 * (tid & 31); (void)wm; (void)wn; (void)fr; (void)fq; (void)c8;
            const int u = blockIdx.x + seg * gridDim.x, rt = u >> 2, ct = u & 3, b = (rt * 256) / SEQ;
            const float* mod = (const float*)(P.ws + WS_MOD) + b * 6144; float* ssp = (float*)(P.ws + WS_SS);
#pragma unroll
            for (int mi = 0; mi < 4; ++mi) { const size_t m = (size_t)(rt * 256 + wm * 64 + mi * 16 + fr); float ss = 0.f;
#pragma unroll
                for (int ni = 0; ni < 8; ++ni) { const int col = ct * 256 + wn * 128 + ni * 16 + 4 * fq;
                    const f32x4 xv = *(const f32x4*)(P.x + m * 1024 + col), gv = *(const f32x4*)(mod + 2048 + col); const f32x4 a = acc[mi][ni];
                    f32x4 o; o.x = xv.x + gv.x * a.x; o.y = xv.y + gv.y * a.y; o.z = xv.z + gv.z * a.z; o.w = xv.w + gv.w * a.w;
                    *(f32x4*)(P.out + m * 1024 + col) = o; ss += (o.x * o.x + o.y * o.y) + (o.z * o.z + o.w * o.w); if (ni & 1) asm volatile("" ::: "memory"); }
                ss += __shfl_xor(ss, 16); ss += __shfl_xor(ss, 32);
                if (fq == 0) ssp[m * 8 + ct * 2 + wn] = ss; } }
    } f{P};
    const int nu = (128 * 4 - (int)blockIdx.x + (int)gridDim.x - 1) / (int)gridDim.x;
    if (nu > 0) G::run_stream(f, nu, 32, 32, (size_t)32 * 1024, lds);
}
__device__ __forceinline__ void phase_p4b(const Params& P) {
    const int lane = threadIdx.x & 63, gw = blockIdx.x * (NTHREADS / 64) + (threadIdx.x >> 6), NGW = gridDim.x * (NTHREADS / 64);
    const float* ssp = (const float*)(P.ws + WS_SS); bf16_t* h2 = (bf16_t*)(P.ws + WS_H);
    for (int m = gw; m < T; m += NGW) {
        const float* mod = (const float*)(P.ws + WS_MOD) + (m / SEQ) * 6144;
        const f32x4 s0 = *(const f32x4*)(ssp + (size_t)m * 8), s1 = *(const f32x4*)(ssp + (size_t)m * 8 + 4);
        const float rstd = rsqrtf(((s0.x + s0.y) + (s0.z + s0.w) + (s1.x + s1.y) + (s1.z + s1.w)) * (1.f / 1024.f) + RMS_EPS);
#pragma unroll
        for (int j = 0; j < 4; ++j) { const int col = (lane + 64 * j) * 4;
            const f32x4 v = *(const f32x4*)(P.out + (size_t)m * 1024 + col), wv = *(const f32x4*)(P.norm2_w + col), scv = *(const f32x4*)(mod + 4096 + col), shv = *(const f32x4*)(mod + 3072 + col);
            u32x2 pk; pk.x = cvtpk(v.x * rstd * wv.x * (1.f + scv.x) + shv.x, v.y * rstd * wv.y * (1.f + scv.y) + shv.y);
            pk.y = cvtpk(v.z * rstd * wv.z * (1.f + scv.z) + shv.z, v.w * rstd * wv.w * (1.f + scv.w) + shv.w);
            *(u32x2*)(h2 + (size_t)m * 1024 + col) = pk; }
    }
}
__device__ __forceinline__ void phase_p4c(const Params& P, LAS unsigned char* lds) {
    typedef Gemm4 G;
    const int tid = opaque_tid(), lane = tid & 63, wid = tid >> 6, wm = wid >> 1, wn = wid & 1, fr = lane & 15, fq = lane >> 4;
    struct F { const Params& P;
        __device__ __forceinline__ void ptrs(int seg, const bf16_t* (&aptr)[2], const bf16_t* (&bptr)[2]) const {
            const int tid = opaque_tid(), lane = tid & 63, wid = tid >> 6, wm = wid >> 1, wn = wid & 1, fr = lane & 15, fq = lane >> 4, c8 = 8 * (tid & 31); (void)wm; (void)wn; (void)fr; (void)fq; (void)c8;
            const int u = blockIdx.x + seg * gridDim.x, rt = u / 3, ct = u % 3;
            const bf16_t* h2 = (const bf16_t*)(P.ws + WS_H); const bf16_t* wrs = (const bf16_t*)(P.ws + WS_WRS);
#pragma unroll
            for (int i = 0; i < 2; ++i) { aptr[i] = h2 + (size_t)(rt * 256 + G::a_row(i, tid)) * 1024 + 8 * (tid & 3); bptr[i] = wrs + (size_t)G::b_k(i, tid) * 768 + ct * 256 + 8 * (tid & 31); } }
        __device__ __forceinline__ void epi(int seg, f32x4 (&acc)[4][8]) const {
            const int tid = opaque_tid(), lane = tid & 63, wid = tid >> 6, wm = wid >> 1, wn = wid & 1, fr = lane & 15, fq = lane >> 4, c8 = 8 * (tid & 31); (void)wm; (void)wn; (void)fr; (void)fq; (void)c8;
            const int u = blockIdx.x + seg * gridDim.x, rt = u / 3, ct = u % 3;
            float* scores = (float*)(P.ws + WS_SCORES); bf16_t* hidS = (bf16_t*)(P.ws + WS_HIDS);
#pragma unroll
            for (int mi = 0; mi < 4; ++mi) { const size_t m = (size_t)(rt * 256 + wm * 64 + mi * 16 + fr);
                if (ct == 0) {
#pragma unroll
                    for (int ni = 0; ni < 8; ++ni) { const f32x4 a = acc[mi][ni];
                        *(f32x4*)(scores + m * 256 + wn * 128 + ni * 16 + 4 * fq) = (f32x4){sigmoidf_(a.x), sigmoidf_(a.y), sigmoidf_(a.z), sigmoidf_(a.w)}; }
                } else {
#pragma unroll
                    for (int j = 0; j < 4; ++j) { const f32x4 g = acc[mi][2 * j], uu = acc[mi][2 * j + 1];
                        u32x2 pk; pk.x = cvtpk(siluf_(g.x) * uu.x, siluf_(g.y) * uu.y); pk.y = cvtpk(siluf_(g.z) * uu.z, siluf_(g.w) * uu.w);
                        *(u32x2*)(hidS + m * 256 + (ct - 1) * 128 + wn * 64 + j * 16 + 4 * fq) = pk; }
                } } }
    } f{P};
    const int nu = (128 * 3 - (int)blockIdx.x + (int)gridDim.x - 1) / (int)gridDim.x;
    if (nu > 0) G::run_stream(f, nu, 32, 32, (size_t)32 * 768, lds);
}
__device__ __forceinline__ void phase_route(const Params& P) {
    const int tid = opaque_tid(), lane = tid & 63, gw = blockIdx.x * (NTHREADS / 64) + (tid >> 6), NGW = gridDim.x * (NTHREADS / 64);
    for (int t = gw; t < T; t += NGW) route_token(P, t, lane);
}
__device__ __forceinline__ void phase_p4d(const Params& P, LAS unsigned char* lds) {
    typedef Gemm4 G;
    const int tid = opaque_tid(), lane = tid & 63, wid = tid >> 6, wm = wid >> 1, wn = wid & 1, fr = lane & 15, fq = lane >> 4;
    struct F { const Params& P;
        __device__ __forceinline__ void ptrs(int seg, const bf16_t* (&aptr)[2], const bf16_t* (&bptr)[2]) const {
            const int tid = opaque_tid(), lane = tid & 63, wid = tid >> 6, wm = wid >> 1, wn = wid & 1, fr = lane & 15, fq = lane >> 4, c8 = 8 * (tid & 31); (void)wm; (void)wn; (void)fr; (void)fq; (void)c8;
            const int u = blockIdx.x + seg * gridDim.x, rt = u >> 2, ct = u & 3;
            const bf16_t* hidS = (const bf16_t*)(P.ws + WS_HIDS); const bf16_t* wsd = (const bf16_t*)(P.ws + WS_WSD);
#pragma unroll
            for (int i = 0; i < 2; ++i) { aptr[i] = hidS + (size_t)(rt * 256 + G::a_row(i, tid)) * 256 + 8 * (tid & 3); bptr[i] = wsd + (size_t)G::b_k(i, tid) * 1024 + ct * 256 + 8 * (tid & 31); } }
        __device__ __forceinline__ void epi(int seg, f32x4 (&acc)[4][8]) const {
            const int tid = opaque_tid(), lane = tid & 63, wid = tid >> 6, wm = wid >> 1, wn = wid & 1, fr = lane & 15, fq = lane >> 4, c8 = 8 * (tid & 31); (void)wm; (void)wn; (void)fr; (void)fq; (void)c8;
            const int u = blockIdx.x + seg * gridDim.x, rt = u >> 2, ct = u & 3, b = (rt * 256) / SEQ;
            const float* mod = (const float*)(P.ws + WS_MOD) + b * 6144;
#pragma unroll
            for (int mi = 0; mi < 4; ++mi) { const size_t m = (size_t)(rt * 256 + wm * 64 + mi * 16 + fr);
#pragma unroll
                for (int ni = 0; ni < 8; ++ni) { const int col = ct * 256 + wn * 128 + ni * 16 + 4 * fq;
                    const f32x4 xv = *(const f32x4*)(P.out + m * 1024 + col), gv = *(const f32x4*)(mod + 5120 + col); const f32x4 a = acc[mi][ni];
                    f32x4 o; o.x = xv.x + gv.x * a.x; o.y = xv.y + gv.y * a.y; o.z = xv.z + gv.z * a.z; o.w = xv.w + gv.w * a.w;
                    *(f32x4*)(P.out + m * 1024 + col) = o; if (ni & 1) asm volatile("" ::: "memory"); } } }
    } f{P};
    const int nu = (128 * 4 - (int)blockIdx.x + (int)gridDim.x - 1) / (int)gridDim.x;
    if (nu > 0) G::run_stream(f, nu, 8, 32, (size_t)32 * 1024, lds);
}

__device__ __forceinline__ void phase_expert_cvt(const Params& P) {
    const size_t gt = (size_t)blockIdx.x * NTHREADS + threadIdx.x, NG = (size_t)gridDim.x * NTHREADS;
    bf16_t* wgu = (bf16_t*)(P.ws + WS_WBGU); bf16_t* wd = (bf16_t*)(P.ws + WS_WBD);
    for (size_t i = gt; i < (size_t)256 * 1024 * 64; i += NG) {
        const size_t ek = i >> 6; const int c8 = (int)(i & 63) * 8, t = c8 >> 8, u16 = (c8 & 255) >> 4;
        const float* s = ((u16 & 1) ? P.exp_wu : P.exp_wg) + ek * 256 + t * 128 + (u16 >> 1) * 16 + (c8 & 8);
        const f32x4 a = __builtin_nontemporal_load((const f32x4*)s), b2 = __builtin_nontemporal_load((const f32x4*)(s + 4));
        *(u32x4*)(wgu + ek * 512 + c8) = (u32x4){cvtpk(a.x, a.y), cvtpk(a.z, a.w), cvtpk(b2.x, b2.y), cvtpk(b2.z, b2.w)}; }
    for (size_t i = gt; i < (size_t)256 * 256 * 128; i += NG) {
        const f32x4 a = __builtin_nontemporal_load((const f32x4*)(P.exp_wd + i * 8)), b2 = __builtin_nontemporal_load((const f32x4*)(P.exp_wd + i * 8 + 4));
        *(u32x4*)(wd + i * 8) = (u32x4){cvtpk(a.x, a.y), cvtpk(a.z, a.w), cvtpk(b2.x, b2.y), cvtpk(b2.z, b2.w)}; }
}

constexpr int P6_TILES = 64 * 1024, P6_PRE = P6_TILES + 1024, P6_PAIR = P6_PRE + 1040, P6_W = P6_PAIR + 1024;
__device__ __forceinline__ void phase_experts(const Params& P, LAS unsigned char* lds) {
    typedef Gemm4 G;
    const int tid = opaque_tid(), lane = tid & 63, wid = tid >> 6, wm = wid >> 1, wn = wid & 1, fr = lane & 15, fq = lane >> 4;
    const int* cnt = (const int*)(P.ws + WS_CTL + CTL_CNT); const int* bucket = (const int*)(P.ws + WS_BUCKET); const float* rw = (const float*)(P.ws + WS_RW);
    const bf16_t* h2 = (const bf16_t*)(P.ws + WS_H); bf16_t* hidR = (bf16_t*)(P.ws + WS_HIDR) + (size_t)blockIdx.x * 256 * 256; unsigned char* y = (unsigned char*)(P.ws + WS_Y);
    LAS int* tiles = (LAS int*)(lds + P6_TILES); LAS int* pre = (LAS int*)(lds + P6_PRE); LAS int* pairs = (LAS int*)(lds + P6_PAIR); LAS float* wts = (LAS float*)(lds + P6_W);
    const int nx = (gridDim.x % 8 == 0) ? 8 : 1, xl = blockIdx.x % nx, li = blockIdx.x / nx, nloc = gridDim.x / nx, nek = 256 / nx;
    if (tid < nek) { const int c_ = cnt[xl + nx * tid]; tiles[tid] = ((c_ < BCAP ? c_ : BCAP) + 255) >> 8; }
    __syncthreads();
    if (tid < nek) { int s = 0; for (int i = 0; i < tid; ++i) s += tiles[i]; pre[tid] = s; if (tid == nek - 1) pre[nek] = s + tiles[nek - 1]; }
    __syncthreads();
    const int total = pre[nek];
    const int c8 = 8 * (tid & 31), u16 = c8 >> 4;
    for (int u = li; u < total; u += nloc) {
        int lo = 0, hi = nek - 1;
        while (lo < hi) { const int mid = (lo + hi + 1) >> 1; if (pre[mid] <= u) lo = mid; else hi = mid - 1; }
        const int e = xl + nx * lo, tile = u - pre[lo], n = cnt[e] < BCAP ? cnt[e] : BCAP, rows = (n - tile * 256) < 256 ? (n - tile * 256) : 256;
        if (tid < 256) { const int r = tid < rows ? tid : 0; const int pr = bucket[(size_t)e * BCAP + tile * 256 + r]; pairs[tid] = pr; wts[tid] = tid < rows ? rw[pr] : 0.f; }
        __syncthreads();
        {
            struct GU { const bf16_t* h2; LAS int* pairs; const bf16_t* wgu; bf16_t* hidR;
                __device__ __forceinline__ void ptrs(int t, const bf16_t* (&aptr)[2], const bf16_t* (&bptr)[2]) const {
                    const int tid = opaque_tid(), lane = tid & 63, wid = tid >> 6, wm = wid >> 1, wn = wid & 1, fr = lane & 15, fq = lane >> 4, c8 = 8 * (tid & 31); (void)wm; (void)wn; (void)fr; (void)fq; (void)c8;
#pragma unroll
                    for (int i = 0; i < 2; ++i) { aptr[i] = h2 + (size_t)(pairs[G::a_row(i, tid)] >> 3) * 1024 + 8 * (tid & 3);
                        bptr[i] = wgu + (size_t)G::b_k(i, tid) * 512 + t * 256 + c8; } }
                __device__ __forceinline__ void epi(int t, f32x4 (&acc)[4][8]) const {
                    const int tid = opaque_tid(), lane = tid & 63, wid = tid >> 6, wm = wid >> 1, wn = wid & 1, fr = lane & 15, fq = lane >> 4, c8 = 8 * (tid & 31); (void)wm; (void)wn; (void)fr; (void)fq; (void)c8;
#pragma unroll
                    for (int mi = 0; mi < 4; ++mi) { const int rl = wm * 64 + mi * 16 + fr;
#pragma unroll
                        for (int j = 0; j < 4; ++j) { const f32x4 g = acc[mi][2 * j], uu = acc[mi][2 * j + 1];
                            u32x2 pk; pk.x = cvtpk(siluf_(g.x) * uu.x, siluf_(g.y) * uu.y); pk.y = cvtpk(siluf_(g.z) * uu.z, siluf_(g.w) * uu.w);
                            *(u32x2*)(hidR + rl * 256 + t * 128 + wn * 64 + j * 16 + 4 * fq) = pk; } } }
            } f{h2, pairs, (const bf16_t*)(P.ws + WS_WBGU) + (size_t)e * 1024 * 512, hidR};
            G::run_stream(f, 2, 32, 32, (size_t)32 * 512, lds);
        }
        __syncthreads();
        {
            struct DN { bf16_t* hidR; const bf16_t* wd; unsigned char* y; LAS int* pairs; LAS float* wts; int rows;
                __device__ __forceinline__ void ptrs(int ct, const bf16_t* (&aptr)[2], const bf16_t* (&bptr)[2]) const {
                    const int tid = opaque_tid(), lane = tid & 63, wid = tid >> 6, wm = wid >> 1, wn = wid & 1, fr = lane & 15, fq = lane >> 4, c8 = 8 * (tid & 31); (void)wm; (void)wn; (void)fr; (void)fq; (void)c8;
#pragma unroll
                    for (int i = 0; i < 2; ++i) { aptr[i] = hidR + (size_t)G::a_row(i, tid) * 256 + 8 * (tid & 3); bptr[i] = wd + (size_t)G::b_k(i, tid) * 1024 + ct * 256 + c8; } }
                __device__ __forceinline__ void epi(int ct, f32x4 (&acc)[4][8]) const {
                    const int tid = opaque_tid(), lane = tid & 63, wid = tid >> 6, wm = wid >> 1, wn = wid & 1, fr = lane & 15, fq = lane >> 4, c8 = 8 * (tid & 31); (void)wm; (void)wn; (void)fr; (void)fq; (void)c8;
#pragma unroll
                    for (int mi = 0; mi < 4; ++mi) { const int rl = wm * 64 + mi * 16 + fr; const float wgt = wts[rl]; const size_t pr = (size_t)pairs[rl];
                        if (rl < rows) {
#pragma unroll
                            for (int ni = 0; ni < 8; ++ni) { const int col = ct * 256 + wn * 128 + ni * 16 + 4 * fq; const f32x4 a = acc[mi][ni] * (wgt * Y_SCALE);
                                int pk = __builtin_amdgcn_cvt_pk_fp8_f32(a.x, a.y, 0, false); pk = __builtin_amdgcn_cvt_pk_fp8_f32(a.z, a.w, pk, true); *(int*)(y + pr * 1024 + col) = pk; } } } }
            } f{hidR, (const bf16_t*)(P.ws + WS_WBD) + (size_t)e * 256 * 1024, y, pairs, wts, rows};
            G::run_stream(f, 4, 8, 32, (size_t)32 * 1024, lds);
        }
        __syncthreads();
    }
}

__device__ __forceinline__ void phase_combine(const Params& P) {
    const int lane = threadIdx.x & 63, gw = blockIdx.x * (NTHREADS / 64) + (threadIdx.x >> 6), NGW = gridDim.x * (NTHREADS / 64);
    const unsigned char* y = (const unsigned char*)(P.ws + WS_Y);
    typedef float f32x2_ __attribute__((ext_vector_type(2)));
    for (int m = gw; m < T; m += NGW) {
        const float* mod = (const float*)(P.ws + WS_MOD) + (m / SEQ) * 6144 + 5120;
#pragma unroll
        for (int j = 0; j < 2; ++j) { const int col = (lane + 64 * j) * 8;
            f32x4 s0 = (f32x4){0.f, 0.f, 0.f, 0.f}, s1 = s0;
#pragma unroll
            for (int sl = 0; sl < 8; ++sl) { const u32x2 v = *(const u32x2*)(y + ((size_t)m * 8 + sl) * 1024 + col);
                const f32x2_ a = __builtin_amdgcn_cvt_pk_f32_fp8((int)v.x, false), b = __builtin_amdgcn_cvt_pk_f32_fp8((int)v.x, true);
                const f32x2_ c = __builtin_amdgcn_cvt_pk_f32_fp8((int)v.y, false), d = __builtin_amdgcn_cvt_pk_f32_fp8((int)v.y, true);
                s0.x += a.x; s0.y += a.y; s0.z += b.x; s0.w += b.y; s1.x += c.x; s1.y += c.y; s1.z += d.x; s1.w += d.y; }
            const f32x4 g0 = *(const f32x4*)(mod + col), g1 = *(const f32x4*)(mod + col + 4);
            f32x4 o0 = *(const f32x4*)(P.out + (size_t)m * 1024 + col), o1 = *(const f32x4*)(P.out + (size_t)m * 1024 + col + 4);
            o0 += g0 * (s0 * Y_INV); o1 += g1 * (s1 * Y_INV);
            *(f32x4*)(P.out + (size_t)m * 1024 + col) = o0; *(f32x4*)(P.out + (size_t)m * 1024 + col + 4) = o1; }
    }
}


__device__ __forceinline__ int queue_pull(unsigned* head, volatile LAS unsigned* slot) {
    if (threadIdx.x == 0) *slot = atomicAdd(head, 1u);
    __syncthreads();
    const int v = (int)*slot;
    __syncthreads();
    return v;
}
__device__ __forceinline__ void phase_cmp_h1(const Params& P, LAS unsigned char* lds, volatile LAS unsigned* slot) {
    unsigned* head = (unsigned*)(P.ws + WS_CTL + CTL_Q2);
    for (;;) {
        const int u = queue_pull(head, slot);
        if (u >= 64 + 512) break;
        if (u < 64) compress_unit(P, lds, u); else hgrn_unit<0>(P, lds, u - 64);
    }
}
__device__ __forceinline__ void phase_h23_nsa(const Params& P, LAS unsigned char* lds, volatile LAS unsigned* slot) {
    unsigned* head = (unsigned*)(P.ws + WS_CTL + CTL_Q3);
    for (;;) {
        const int n = queue_pull(head, slot);
        if (n >= 1536) break;
        if (n < 512) nsa_unit(P, lds, (n & 7) * 128 + (127 - (n >> 3)));
        else if (n < 1024) { const int m = n - 512; hgrn_unit<1>(P, lds, (m & 15) * 32 + (31 - (m >> 4))); }
        else { const int m = n - 1024; nsa_unit(P, lds, (m & 7) * 128 + (63 - (m >> 3))); }
    }
}

constexpr int LDS_BYTES = 144 * 1024;
__global__ void __launch_bounds__(NTHREADS) mega(Params P) {
    extern __shared__ __attribute__((aligned(16))) unsigned char smem[];
    LAS unsigned char* lds = (LAS unsigned char*)smem;
    volatile LAS unsigned* xst = (volatile LAS unsigned*)(lds + LDS_BYTES - 16);
    if (threadIdx.x < 4) xst[threadIdx.x] = 0u;
    __syncthreads();
    XcdBarrier xb = xcd_barrier_post((unsigned*)(P.ws + WS_CTL + CTL_BAR), xst);
    phase_mod(P, lds);
    xcd_barrier(xb);
    { const float* mod = (const float*)(P.ws + WS_MOD); norm_mod_rows(P.x, P.norm1_w, mod, mod + 1024, (bf16_t*)(P.ws + WS_H), H1S); }
    xcd_barrier(xb);
    phase_inproj(P, lds);
    xcd_barrier(xb);
    phase_cmp_h1(P, lds, xst + 2);
    xcd_barrier(xb);
    phase_h23_nsa(P, lds, xst + 2);
    phase_cvt_small(P);
    xcd_barrier(xb);
    phase_p4a(P, lds);
    xcd_barrier(xb);
    phase_p4b(P);
    xcd_barrier(xb);
    phase_p4c(P, lds);
    xcd_barrier(xb);
    phase_route(P);
    phase_p4d(P, lds);
    xcd_barrier(xb);
    phase_expert_cvt(P);
    xcd_barrier(xb);
    phase_experts(P, lds);
    xcd_barrier(xb);
    phase_combine(P);
}

extern "C" void kernel_launch(void* const* d_in, const int* in_sizes, int n_in, void* d_out, int out_size, void* d_ws, size_t ws_size, hipStream_t stream) {
    static int grid = 0;
    if (grid == 0) {
        if (n_in != 25 || ws_size < WS_END) { fprintf(stderr, "kernel_launch: unexpected n_in %d or ws_size %zu (need %zu)\n", n_in, ws_size, (size_t)WS_END); grid = -1; return; }
        int dev = 0, cus = 0, per_cu = 0;
        (void)hipGetDevice(&dev); (void)hipDeviceGetAttribute(&cus, hipDeviceAttributeMultiprocessorCount, dev);
        (void)hipFuncSetAttribute((const void*)mega, hipFuncAttributeMaxDynamicSharedMemorySize, LDS_BYTES);
        (void)hipOccupancyMaxActiveBlocksPerMultiprocessor(&per_cu, (const void*)mega, NTHREADS, LDS_BYTES);
        if (per_cu < 1) { fprintf(stderr, "kernel_launch: occupancy query says %d blocks per CU\n", per_cu); grid = -1; return; }
        grid = cus;
    }
    if (grid < 0) return;
    (void)hipMemsetAsync((char*)d_ws + WS_CTL, 0, 64 * 1024, stream);
    Params p{};
    const float** pf = (const float**)&p;
    for (int i = 0; i < 25; ++i) pf[i] = (const float*)d_in[i];
    p.out = (float*)d_out; p.ws = (unsigned char*)d_ws;
    void* args[] = {&p};
    hipError_t e = hipLaunchCooperativeKernel((const void*)mega, dim3(grid), dim3(NTHREADS), args, LDS_BYTES, stream);
    if (e != hipSuccess) fprintf(stderr, "cooperative launch failed: %s (grid %d)\n", hipGetErrorString(e), grid);
}

#ifdef PHASE_TEST
__global__ void __launch_bounds__(NTHREADS) t_p4a(Params P) { extern __shared__ __attribute__((aligned(16))) unsigned char smem[]; phase_p4a(P, (LAS unsigned char*)smem); }
__global__ void __launch_bounds__(NTHREADS) t_p4d(Params P) { extern __shared__ __attribute__((aligned(16))) unsigned char smem[]; phase_p4d(P, (LAS unsigned char*)smem); }
__global__ void __launch_bounds__(NTHREADS) t_p4(Params P) { extern __shared__ __attribute__((aligned(16))) unsigned char smem[]; phase_p4c(P, (LAS unsigned char*)smem); }
__global__ void __launch_bounds__(NTHREADS) t_p6(Params P) { extern __shared__ __attribute__((aligned(16))) unsigned char smem[]; phase_experts(P, (LAS unsigned char*)smem); }
__global__ void __launch_bounds__(NTHREADS) t_nsa(Params P) { extern __shared__ __attribute__((aligned(16))) unsigned char smem[]; nsa_unit(P, (LAS unsigned char*)smem, blockIdx.x); }
__global__ void __launch_bounds__(NTHREADS) t_mod(Params P) { extern __shared__ __attribute__((aligned(16))) unsigned char smem[]; phase_mod(P, (LAS unsigned char*)smem); }
__global__ void __launch_bounds__(NTHREADS) t_inproj(Params P) { extern __shared__ __attribute__((aligned(16))) unsigned char smem[]; phase_inproj(P, (LAS unsigned char*)smem); }
__global__ void __launch_bounds__(NTHREADS) t_cmp(Params P) { extern __shared__ __attribute__((aligned(16))) unsigned char smem[]; compress_unit(P, (LAS unsigned char*)smem, blockIdx.x); }
__global__ void __launch_bounds__(NTHREADS) t_h0(Params P) { extern __shared__ __attribute__((aligned(16))) unsigned char smem[]; hgrn_unit<0>(P, (LAS unsigned char*)smem, blockIdx.x); }
__global__ void __launch_bounds__(NTHREADS) t_h1(Params P) { extern __shared__ __attribute__((aligned(16))) unsigned char smem[]; hgrn_unit<1>(P, (LAS unsigned char*)smem, blockIdx.x); }
#endif
```

```cpp
#include <hip/hip_runtime.h>
#include <hip/hip_cooperative_groups.h>
#include <cstdio>
#include <cstdint>
#include <type_traits>
namespace cg = cooperative_groups;

#define LAS __attribute__((address_space(3)))
typedef unsigned short bf16_t;
typedef short bf16x8 __attribute__((ext_vector_type(8)));
typedef short s16x4 __attribute__((ext_vector_type(4)));
typedef float f32x4 __attribute__((ext_vector_type(4)));
typedef float f32x16 __attribute__((ext_vector_type(16)));
typedef unsigned u32x4 __attribute__((ext_vector_type(4)));
typedef unsigned u32x2 __attribute__((ext_vector_type(2)));

constexpr int D = 1024, BATCH = 4, SEQ = 8192, T = BATCH * SEQ;
constexpr int IN_COLS = 3352;
constexpr int NTHREADS = 512;
constexpr int H1S = 1088;
constexpr float RMS_EPS = 1e-6f;
constexpr float LOG2E = 1.4426950408889634f;
constexpr float Y_SCALE = 16.0f, Y_INV = 1.0f / 16.0f;

constexpr size_t MB = 1024ull * 1024ull;
constexpr size_t WS_CTL    = 0;
constexpr size_t WS_MOD    = 64 * 1024;
constexpr size_t WS_LB     = WS_MOD + 4 * 6144 * 4;
constexpr size_t WS_CB     = WS_LB + 2048;
constexpr size_t WS_H      = 1 * MB;
constexpr size_t WS_SS     = WS_H + 72 * MB;
constexpr size_t WS_RW     = WS_SS + 1 * MB;
constexpr size_t WS_BUCKET = WS_RW + 1 * MB;
constexpr size_t WS_HIDR   = WS_BUCKET + 16 * MB;
constexpr size_t WS_WSM    = WS_HIDR + 32 * MB;
constexpr size_t WS_WOUT   = WS_WSM, WS_WRS = WS_WSM + 2 * MB, WS_WSD = WS_WSM + 4 * MB;
constexpr size_t WS_WBE    = WS_WSM + 5 * MB;
constexpr size_t WS_WBGU   = WS_WBE, WS_WBD = WS_WBE + 256 * MB;
constexpr size_t WS_SCORES = WS_WBE;
constexpr size_t WS_HIDS   = WS_SCORES + 32 * MB;
constexpr size_t WS_WIN    = WS_HIDS + 16 * MB;
constexpr size_t WS_Y      = WS_WBE + 384 * MB;
constexpr size_t WS_Q      = WS_Y;
constexpr size_t WS_KV     = WS_Q + 32 * MB;
constexpr size_t WS_GATES  = WS_KV + 48 * MB;
constexpr size_t WS_HQ     = WS_GATES + 4 * MB;
constexpr size_t WS_LOGF   = WS_HQ + 32 * MB;
constexpr size_t WS_HV     = WS_LOGF + 64 * MB;
constexpr size_t WS_HG     = WS_HV + 32 * MB;
constexpr size_t WS_CMPH   = WS_HG + 32 * MB;
constexpr size_t WS_KC     = WS_CMPH + 4 * MB;
constexpr size_t WS_VC     = WS_KC + 1 * MB;
constexpr size_t WS_HL     = WS_VC + 1 * MB;
constexpr size_t WS_HD     = WS_HL + 32 * MB;
constexpr size_t WS_MIX    = WS_HD + 1 * MB;
constexpr size_t WS_YSH    = WS_Y + 384 * MB;
constexpr size_t WS_END    = WS_YSH + 64 * MB;
constexpr int BCAP = 16384;
constexpr int CTL_CNT = 1024;
constexpr int CTL_Q2 = 2048, CTL_Q3 = 2112;
constexpr int CTL_BAR = 16384;

struct Params {
    const float *x, *c, *ada_w, *ada_b, *norm1_w, *norm2_w, *w_in, *q_norm_w, *k_norm_w, *cmp_pos, *cmp_w1, *cmp_b1, *cmp_w2,
        *attn_out_norm_w, *hgrn_lb, *rec_out_norm_w, *w_out, *router_w, *router_bias, *exp_wg, *exp_wu, *exp_wd, *sh_wg, *sh_wu, *sh_wd;
    float* out;
    unsigned char* ws;
};

__device__ __forceinline__ unsigned cvtpk(float lo, float hi) { unsigned r; asm("v_cvt_pk_bf16_f32 %0, %1, %2" : "=v"(r) : "v"(lo), "v"(hi)); return r; }
__device__ __forceinline__ int opaque_tid() { int t = threadIdx.x; asm volatile("" : "+v"(t)); return t; }
__device__ __forceinline__ float bf2f(bf16_t v) { return __uint_as_float(((unsigned)v) << 16); }
__device__ __forceinline__ float sigmoidf_(float v) { return __builtin_amdgcn_rcpf(1.0f + __expf(-v)); }
__device__ __forceinline__ float siluf_(float v) { return v * __builtin_amdgcn_rcpf(1.0f + __expf(-v)); }
__device__ __forceinline__ float wave_sum(float v) {
#pragma unroll
    for (int o = 1; o < 64; o <<= 1) v += __shfl_xor(v, o);
    return v;
}
__device__ __forceinline__ s16x4 lds_tr(const LAS unsigned char* p) {
    return __builtin_bit_cast(s16x4, __builtin_amdgcn_ds_read_tr16_b64_v4i16((LAS s16x4*)p));
}

#define XB_TMO      128
#define XB_XCNT(j)  (256  + 64 * (j))
#define XB_XSUB(j)  (1280 + 64 * (j))
#define XB_XGEN(j)  (2304 + 64 * (j))
#define XB_TOP      3328
#define XB_TOPGEN   3392
#define XCD_BAR_WORDS 3456
#define XB_SPIN_CAP (1u << 22)
__device__ __forceinline__ unsigned xb_ld(unsigned* p)              { return __hip_atomic_load(p, __ATOMIC_RELAXED, __HIP_MEMORY_SCOPE_AGENT); }
__device__ __forceinline__ unsigned xb_add(unsigned* p, unsigned v) { return __hip_atomic_fetch_add(p, v, __ATOMIC_RELAXED, __HIP_MEMORY_SCOPE_AGENT); }
__device__ __forceinline__ unsigned xb_xcc_id() { return (unsigned)__builtin_amdgcn_s_getreg((3 << 11) | 20) & 0xFu; }
#define XB_SPIN(cond, bar) do { unsigned _sp = 0; while (cond) { __builtin_amdgcn_s_sleep(1); \
    if ((++_sp & 255u) == 0u) { if (xb_ld(&(bar)[XB_TMO])) break; if (_sp > XB_SPIN_CAP) { atomicAdd(&(bar)[XB_TMO], 1u); break; } } } } while (0)
struct XcdBarrier { unsigned* bar; unsigned x; volatile LAS unsigned* st; };
__device__ __forceinline__ XcdBarrier xcd_barrier_post(unsigned* bar, volatile LAS unsigned* st) {
    XcdBarrier b; b.bar = bar; b.x = xb_xcc_id(); b.st = st;
    if (threadIdx.x == 0) (void)xb_add(&bar[XB_XCNT(b.x)], 1u);
    return b;
}
__device__ __forceinline__ void xcd_barrier_complete(unsigned* bar, unsigned x, unsigned& nloc, unsigned& nx) {
    const unsigned G = gridDim.x * gridDim.y * gridDim.z;
    unsigned sum, cnt, mine, sp = 0u;
    for (;;) {
        sum = 0u; cnt = 0u; mine = 0u;
#pragma unroll
        for (unsigned j = 0; j < 16; ++j) { const unsigned c = xb_ld(&bar[XB_XCNT(j)]); sum += c; cnt += (c > 0u) ? 1u : 0u; mine = (j == x) ? c : mine; }
        if (sum == G) break;
        __builtin_amdgcn_s_sleep(1);
        if ((++sp & 255u) == 0u) { if (xb_ld(&bar[XB_TMO])) break; if (sp > XB_SPIN_CAP) { atomicAdd(&bar[XB_TMO], 1u); break; } }
    }
    nloc = mine > 0u ? mine : 1u; nx = cnt > 0u ? cnt : 1u;
}
__device__ __forceinline__ void xcd_barrier(const XcdBarrier& b) {
    asm volatile("s_waitcnt vmcnt(0)" ::: "memory");
    __syncthreads();
    if (threadIdx.x == 0) {
        unsigned* bar = b.bar;
        __builtin_amdgcn_s_waitcnt(0);
        unsigned nloc = b.st[0], nx = b.st[1];
        if (nloc == 0u) { xcd_barrier_complete(bar, b.x, nloc, nx); b.st[0] = nloc; b.st[1] = nx; }
        const unsigned old = xb_add(&bar[XB_XSUB(b.x)], 1u);
        const unsigned gen = old / nloc;
        if (old + 1u == (gen + 1u) * nloc) {
            __builtin_amdgcn_fence(__ATOMIC_RELEASE, "agent");
            asm volatile("s_waitcnt vmcnt(0)" ::: "memory");
            const unsigned og = xb_add(&bar[XB_TOP], 1u);
            const unsigned tg = og / nx;
            if (og + 1u == (tg + 1u) * nx) xb_add(&bar[XB_TOPGEN], 1u);
            else XB_SPIN(xb_ld(&bar[XB_TOPGEN]) == tg, bar);
            __builtin_amdgcn_fence(__ATOMIC_ACQUIRE, "agent");
            xb_add(&bar[XB_XGEN(b.x)], 1u);
            asm volatile("s_waitcnt vmcnt(0)" ::: "memory");
        } else {
            XB_SPIN(xb_ld(&bar[XB_XGEN(b.x)]) == gen, bar);
            __builtin_amdgcn_fence(__ATOMIC_ACQUIRE, "agent");
            asm volatile("s_waitcnt vmcnt(0)" ::: "memory");
        }
    }
    __syncthreads();
}

template <int WM, int WN> struct GemmT {
    static constexpr int BM = 64 * WM, BN = 64 * WN;
    static constexpr int A_BYTES = BM * 128, B_BYTES = 64 * BN * 2, STAGE = A_BYTES + B_BYTES, LDS_BYTES = 2 * STAGE;
    static constexpr int NB4 = BN / 32;
    static constexpr int B_ROW4 = BN / 4;

    static __device__ __forceinline__ void run(f32x4 (&acc)[4][4], const bf16_t* const (&arow)[WM], int a_kstride, const float* Bp, int ldb, int KT, LAS unsigned char* lds) {
        const int tid = opaque_tid(), lane = tid & 63, wid = tid >> 6, wm = wid / WN, wn = wid % WN, fr = lane & 15, fq = lane >> 4;
#pragma unroll
        for (int mi = 0; mi < 4; ++mi)
#pragma unroll
            for (int ni = 0; ni < 4; ++ni) acc[mi][ni] = (f32x4){0.f, 0.f, 0.f, 0.f};
        const int achunk = tid & 7;
        u32x4 areg[WM]; f32x4 breg[NB4];
        int a_wr[WM];
#pragma unroll
        for (int p = 0; p < WM; ++p) { const int row = p * 64 + (tid >> 3); a_wr[p] = row * 128 + ((achunk ^ ((row >> 1) & 7)) << 4); }
        int b_wr[NB4]; int b_goff[NB4];
#pragma unroll
        for (int p = 0; p < NB4; ++p) { const int i = tid + NTHREADS * p, k = i / B_ROW4, n = (i % B_ROW4) * 4;
            const int f = (k & 3) | (((k >> 3) & 1) << 2);
            b_wr[p] = A_BYTES + k * (BN * 2) + (((n >> 4) ^ f) << 5) + ((n & 15) << 1); b_goff[p] = k * ldb + n; }
        int a_rd[4][2];
#pragma unroll
        for (int mi = 0; mi < 4; ++mi)
#pragma unroll
            for (int ks = 0; ks < 2; ++ks) { const int row = wm * 64 + mi * 16 + fr, ch = ks * 4 + fq; a_rd[mi][ks] = row * 128 + ((ch ^ ((row >> 1) & 7)) << 4); }
        int b_rd[2][2];
        int b_f[2][2];
#pragma unroll
        for (int ks = 0; ks < 2; ++ks)
#pragma unroll
            for (int t = 0; t < 2; ++t) { const int k = ks * 32 + 8 * fq + 4 * t + (fr >> 2); b_f[ks][t] = (k & 3) | (((k >> 3) & 1) << 2);
                b_rd[ks][t] = A_BYTES + k * (BN * 2) + ((fr & 3) << 3); }

        auto gload = [&](int kt) {
#pragma unroll
            for (int p = 0; p < WM; ++p) areg[p] = *(const u32x4*)(arow[p] + (size_t)kt * a_kstride + achunk * 8);
            const float* bk = Bp + (size_t)kt * 64 * ldb;
#pragma unroll
            for (int p = 0; p < NB4; ++p) breg[p] = *(const f32x4*)(bk + b_goff[p]);
        };
        auto lstore = [&](int buf) {
            LAS unsigned char* base = lds + buf * STAGE;
#pragma unroll
            for (int p = 0; p < WM; ++p) *(LAS u32x4*)(base + a_wr[p]) = areg[p];
#pragma unroll
            for (int p = 0; p < NB4; ++p) { u32x2 w; w.x = cvtpk(breg[p].x, breg[p].y); w.y = cvtpk(breg[p].z, breg[p].w); *(LAS u32x2*)(base + b_wr[p]) = w; }
        };
        gload(0); lstore(0); __syncthreads();
        for (int kt = 0; kt < KT; ++kt) {
            if (kt + 1 < KT) gload(kt + 1);
            __builtin_amdgcn_sched_barrier(0);
            const LAS unsigned char* base = lds + (kt & 1) * STAGE;
#pragma unroll
            for (int ks = 0; ks < 2; ++ks) {
                bf16x8 af[4], bfr[4];
#pragma unroll
                for (int mi = 0; mi < 4; ++mi) af[mi] = *(const LAS bf16x8*)(base + a_rd[mi][ks]);
#pragma unroll
                for (int ni = 0; ni < 4; ++ni) {
                    const int u0 = wn * 4 + ni;
                    const s16x4 lo = lds_tr(base + b_rd[ks][0] + ((u0 ^ b_f[ks][0]) << 5));
                    const s16x4 hi = lds_tr(base + b_rd[ks][1] + ((u0 ^ b_f[ks][1]) << 5));
                    bfr[ni] = (bf16x8){lo[0], lo[1], lo[2], lo[3], hi[0], hi[1], hi[2], hi[3]};
                }
#pragma unroll
                for (int mi = 0; mi < 4; ++mi)
#pragma unroll
                    for (int ni = 0; ni < 4; ++ni) acc[mi][ni] = __builtin_amdgcn_mfma_f32_16x16x32_bf16(bfr[ni], af[mi], acc[mi][ni], 0, 0, 0);
            }
            if (kt + 1 < KT) lstore((kt + 1) & 1);
            __syncthreads();
        }
    }
};

struct Gemm2 {
    static constexpr int A_BYTES = 32768, STAGE = 65536, LDS_BYTES = 2 * STAGE;
    static __device__ __forceinline__ int a_row(int i, int w, int lane) { return (i * 8 + w) * 8 + (lane >> 3); }
    static __device__ __forceinline__ int a_chunk(int row, int lane) { return (lane & 7) ^ ((row >> 1) & 7); }
    static __device__ __forceinline__ int b_k(int i, int w, int lane) { return (i * 8 + w) * 2 + (lane >> 5); }
    static __device__ __forceinline__ int b_n(int k, int lane) { return ((((lane & 31) >> 1) ^ fk2(k)) << 4) + ((lane & 1) << 3); }
    static __device__ __forceinline__ int fk2(int r) { return (r & 3) | (((r >> 3) & 1) << 2); }

    static __device__ __forceinline__ void run(f32x4 (&acc)[4][8], const bf16_t* const (&aptr)[4], int a_kstride, const bf16_t* const (&bptr)[4], size_t b_kstride, int KT, LAS unsigned char* lds) {
        const int tid = opaque_tid(), lane = tid & 63, wid = tid >> 6, wm = wid >> 1, wn = wid & 1, fr = lane & 15, fq = lane >> 4;
        const int wu = __builtin_amdgcn_readfirstlane(wid);
#pragma unroll
        for (int mi = 0; mi < 4; ++mi)
#pragma unroll
            for (int ni = 0; ni < 8; ++ni) acc[mi][ni] = (f32x4){0.f, 0.f, 0.f, 0.f};
        int a_rd[4][2];
#pragma unroll
        for (int mi = 0; mi < 4; ++mi)
#pragma unroll
            for (int ks = 0; ks < 2; ++ks) { const int row = wm * 64 + mi * 16 + fr, ch = ks * 4 + fq; a_rd[mi][ks] = row * 128 + ((ch ^ ((row >> 1) & 7)) << 4); }
        int b_rd[2][2], b_f[2][2];
#pragma unroll
        for (int ks = 0; ks < 2; ++ks)
#pragma unroll
            for (int t = 0; t < 2; ++t) { const int k = ks * 32 + 8 * fq + 4 * t + (fr >> 2); b_f[ks][t] = fk2(k); b_rd[ks][t] = A_BYTES + k * 512 + ((fr & 3) << 3); }
        auto issue = [&](int kt, int buf) {
            LAS unsigned char* base = lds + buf * STAGE + wu * 1024;
#pragma unroll
            for (int i = 0; i < 4; ++i) __builtin_amdgcn_global_load_lds((const unsigned*)(aptr[i] + (size_t)kt * a_kstride), (LAS unsigned*)(base + i * 8192), 16, 0, 0);
#pragma unroll
            for (int i = 0; i < 4; ++i) __builtin_amdgcn_global_load_lds((const unsigned*)(bptr[i] + (size_t)kt * b_kstride), (LAS unsigned*)(base + A_BYTES + i * 8192), 16, 0, 0);
        };
        issue(0, 0);
        for (int kt = 0; kt < KT; ++kt) {
            asm volatile("s_waitcnt vmcnt(0)" ::: "memory");
            __syncthreads();
            if (kt + 1 < KT) issue(kt + 1, (kt + 1) & 1);
            const LAS unsigned char* base = lds + (kt & 1) * STAGE;
#pragma unroll
            for (int ks = 0; ks < 2; ++ks) {
                bf16x8 af[4];
#pragma unroll
                for (int mi = 0; mi < 4; ++mi) af[mi] = *(const LAS bf16x8*)(base + a_rd[mi][ks]);
#pragma unroll
                for (int ni = 0; ni < 8; ++ni) {
                    const int u0 = wn * 8 + ni;
                    const s16x4 lo = lds_tr(base + b_rd[ks][0] + ((u0 ^ b_f[ks][0]) << 5));
                    const s16x4 hi = lds_tr(base + b_rd[ks][1] + ((u0 ^ b_f[ks][1]) << 5));
                    const bf16x8 bfr = (bf16x8){lo[0], lo[1], lo[2], lo[3], hi[0], hi[1], hi[2], hi[3]};
#pragma unroll
                    for (int mi = 0; mi < 4; ++mi) acc[mi][ni] = __builtin_amdgcn_mfma_f32_16x16x32_bf16(bfr, af[mi], acc[mi][ni], 0, 0, 0);
                }
            }
        }
        __syncthreads();
    }
};

struct Gemm3 {
    static constexpr int A_BYTES = 16384, STAGE = 32768, LDS_BYTES = 4 * STAGE;
    static __device__ __forceinline__ int a_row(int i, int w, int lane) { return (i * 8 + w) * 16 + (lane >> 2); }
    static __device__ __forceinline__ int a_chunk(int row, int lane) { return (lane & 3) ^ ((row >> 1) & 3); }
    static __device__ __forceinline__ int b_k(int i, int w, int lane) { return (i * 8 + w) * 2 + (lane >> 5); }
    static __device__ __forceinline__ int fk2(int r) { return (r & 3) | (((r >> 3) & 1) << 2); }
    static __device__ __forceinline__ int b_n(int k, int lane) { return ((((lane & 31) >> 1) ^ fk2(k)) << 4) + ((lane & 1) << 3); }
    static __device__ __forceinline__ void run(f32x4 (&acc)[4][8], const bf16_t* const (&aptr)[2], int a_kstride, const bf16_t* const (&bptr)[2], size_t b_kstride, int KT, LAS unsigned char* lds) {
        const int tid = opaque_tid(), lane = tid & 63, wid = tid >> 6, wm = wid >> 1, wn = wid & 1, fr = lane & 15, fq = lane >> 4;
        const int wu = __builtin_amdgcn_readfirstlane(wid);
#pragma unroll
        for (int mi = 0; mi < 4; ++mi)
#pragma unroll
            for (int ni = 0; ni < 8; ++ni) acc[mi][ni] = (f32x4){0.f, 0.f, 0.f, 0.f};
        int a_rd[4];
#pragma unroll
        for (int mi = 0; mi < 4; ++mi) { const int row = wm * 64 + mi * 16 + fr; a_rd[mi] = row * 64 + ((fq ^ ((row >> 1) & 3)) << 4); }
        int b_rd[2], b_f[2];
#pragma unroll
        for (int t = 0; t < 2; ++t) { const int k = 8 * fq + 4 * t + (fr >> 2); b_f[t] = fk2(k); b_rd[t] = A_BYTES + k * 512 + ((fr & 3) << 3); }
        auto issue = [&](int kt) {
            LAS unsigned char* base = lds + (kt & 3) * STAGE + wu * 1024;
#pragma unroll
            for (int i = 0; i < 2; ++i) __builtin_amdgcn_global_load_lds((const unsigned*)(aptr[i] + (size_t)kt * a_kstride), (LAS unsigned*)(base + i * 8192), 16, 0, 0);
#pragma unroll
            for (int i = 0; i < 2; ++i) __builtin_amdgcn_global_load_lds((const unsigned*)(bptr[i] + (size_t)kt * b_kstride), (LAS unsigned*)(base + A_BYTES + i * 8192), 16, 0, 0);
        };
        asm volatile("s_waitcnt vmcnt(0)" ::: "memory");
        issue(0); if (KT > 1) issue(1); if (KT > 2) issue(2);
        for (int kt = 0; kt < KT; ++kt) {
            const int rem = KT - 1 - kt;
            if (rem >= 2) asm volatile("s_waitcnt vmcnt(8)" ::: "memory"); else if (rem == 1) asm volatile("s_waitcnt vmcnt(4)" ::: "memory"); else asm volatile("s_waitcnt vmcnt(0)" ::: "memory");
            __builtin_amdgcn_s_barrier();
            asm volatile("" ::: "memory");
            if (kt + 3 < KT) issue(kt + 3);
            const LAS unsigned char* base = lds + (kt & 3) * STAGE;
            bf16x8 af[4];
#pragma unroll
            for (int mi = 0; mi < 4; ++mi) af[mi] = *(const LAS bf16x8*)(base + a_rd[mi]);
#pragma unroll
            for (int ni = 0; ni < 8; ++ni) {
                const int u0 = wn * 8 + ni;
                const s16x4 lo = lds_tr(base + b_rd[0] + ((u0 ^ b_f[0]) << 5));
                const s16x4 hi = lds_tr(base + b_rd[1] + ((u0 ^ b_f[1]) << 5));
                const bf16x8 bfr = (bf16x8){lo[0], lo[1], lo[2], lo[3], hi[0], hi[1], hi[2], hi[3]};
#pragma unroll
                for (int mi = 0; mi < 4; ++mi) acc[mi][ni] = __builtin_amdgcn_mfma_f32_16x16x32_bf16(bfr, af[mi], acc[mi][ni], 0, 0, 0);
            }
        }
        asm volatile("s_waitcnt lgkmcnt(0)" ::: "memory");
        __builtin_amdgcn_s_barrier();
        asm volatile("" ::: "memory");
    }
};

struct Gemm4 {
    static constexpr int A_BYTES = 16384, STAGE = 32768, LDS_BYTES = 2 * STAGE;
    static __device__ __forceinline__ int fk2(int r) { return (r & 3) | (((r >> 3) & 1) << 2); }
    static __device__ __forceinline__ int a_row(int i, int tid) { return (tid >> 2) + 128 * i; }
    static __device__ __forceinline__ int b_k(int i, int tid) { return (tid >> 5) + 16 * i; }
    static __device__ __forceinline__ void run(f32x4 (&acc)[4][8], const bf16_t* const (&aptr)[2], int a_kstride, const bf16_t* const (&bptr)[2], size_t b_kstride, int KT, LAS unsigned char* lds) {
        const int tid = opaque_tid(), lane = tid & 63, wid = tid >> 6, wm = wid >> 1, wn = wid & 1, fr = lane & 15, fq = lane >> 4;
#pragma unroll
        for (int mi = 0; mi < 4; ++mi)
#pragma unroll
            for (int ni = 0; ni < 8; ++ni) acc[mi][ni] = (f32x4){0.f, 0.f, 0.f, 0.f};
        int a_wr[2], b_wr[2];
#pragma unroll
        for (int i = 0; i < 2; ++i) { const int row = a_row(i, tid); a_wr[i] = row * 64 + (((tid & 3) ^ ((row >> 1) & 3)) << 4);
            const int k = b_k(i, tid), n = (tid & 31) * 8; b_wr[i] = A_BYTES + k * 512 + (((n >> 4) ^ fk2(k)) << 5) + ((n & 15) << 1); }
        int a_rd[4];
#pragma unroll
        for (int mi = 0; mi < 4; ++mi) { const int row = wm * 64 + mi * 16 + fr; a_rd[mi] = row * 64 + ((fq ^ ((row >> 1) & 3)) << 4); }
        int b_rd[2], b_f[2];
#pragma unroll
        for (int t = 0; t < 2; ++t) { const int k = 8 * fq + 4 * t + (fr >> 2); b_f[t] = fk2(k); b_rd[t] = A_BYTES + k * 512 + ((fr & 3) << 3); }
        u32x4 ra0[2], rb0[2], ra1[2], rb1[2];
        auto gload = [&](int kt, u32x4 (&ra)[2], u32x4 (&rb)[2]) {
#pragma unroll
            for (int i = 0; i < 2; ++i) { ra[i] = *(const u32x4*)(aptr[i] + (size_t)kt * a_kstride); rb[i] = *(const u32x4*)(bptr[i] + (size_t)kt * b_kstride); }
        };
        auto lstore = [&](int buf, const u32x4 (&ra)[2], const u32x4 (&rb)[2]) {
            LAS unsigned char* base = lds + buf * STAGE;
#pragma unroll
            for (int i = 0; i < 2; ++i) { *(LAS u32x4*)(base + a_wr[i]) = ra[i]; *(LAS u32x4*)(base + b_wr[i]) = rb[i]; }
        };
        auto compute = [&](int buf) {
            const LAS unsigned char* base = lds + buf * STAGE;
            bf16x8 af[4];
#pragma unroll
            for (int mi = 0; mi < 4; ++mi) af[mi] = *(const LAS bf16x8*)(base + a_rd[mi]);
#pragma unroll
            for (int ni = 0; ni < 8; ++ni) {
                const int u0 = wn * 8 + ni;
                const s16x4 lo = lds_tr(base + b_rd[0] + ((u0 ^ b_f[0]) << 5));
                const s16x4 hi = lds_tr(base + b_rd[1] + ((u0 ^ b_f[1]) << 5));
                const bf16x8 bfr = (bf16x8){lo[0], lo[1], lo[2], lo[3], hi[0], hi[1], hi[2], hi[3]};
#pragma unroll
                for (int mi = 0; mi < 4; ++mi) acc[mi][ni] = __builtin_amdgcn_mfma_f32_16x16x32_bf16(bfr, af[mi], acc[mi][ni], 0, 0, 0);
            }
        };
        gload(0, ra0, rb0); gload(1, ra1, rb1);
        lstore(0, ra0, rb0); __syncthreads();
        for (int kt = 0; kt < KT; kt += 2) {
            gload(kt + 2 < KT ? kt + 2 : KT - 1, ra0, rb0);
            __builtin_amdgcn_sched_barrier(0);
            compute(0);
            lstore(1, ra1, rb1);
            __syncthreads();
            gload(kt + 3 < KT ? kt + 3 : KT - 1, ra1, rb1);
            __builtin_amdgcn_sched_barrier(0);
            compute(1);
            lstore(0, ra0, rb0);
            __syncthreads();
        }
    }

    template <class F> static __device__ __forceinline__ void run_stream(F& f, int NSEG, int KT, int a_kstride, size_t b_kstride, LAS unsigned char* lds) {
        const int tid = opaque_tid(), lane = tid & 63, wid = tid >> 6, wm = wid >> 1, wn = wid & 1, fr = lane & 15, fq = lane >> 4;
        f32x4 acc[4][8];
#pragma unroll
        for (int mi = 0; mi < 4; ++mi)
#pragma unroll
            for (int ni = 0; ni < 8; ++ni) acc[mi][ni] = (f32x4){0.f, 0.f, 0.f, 0.f};
        int a_wr[2], b_wr[2];
#pragma unroll
        for (int i = 0; i < 2; ++i) { const int row = a_row(i, tid); a_wr[i] = row * 64 + (((tid & 3) ^ ((row >> 1) & 3)) << 4);
            const int k = b_k(i, tid), n = (tid & 31) * 8; b_wr[i] = A_BYTES + k * 512 + (((n >> 4) ^ fk2(k)) << 5) + ((n & 15) << 1); }
        int a_rd[4];
#pragma unroll
        for (int mi = 0; mi < 4; ++mi) { const int row = wm * 64 + mi * 16 + fr; a_rd[mi] = row * 64 + ((fq ^ ((row >> 1) & 3)) << 4); }
        int b_rd[2], b_f[2];
#pragma unroll
        for (int t = 0; t < 2; ++t) { const int k = 8 * fq + 4 * t + (fr >> 2); b_f[t] = fk2(k); b_rd[t] = A_BYTES + k * 512 + ((fr & 3) << 3); }
        const bf16_t* aptr[2]; const bf16_t* bptr[2];
        u32x4 ra0[2], rb0[2], ra1[2], rb1[2];
        int lseg = 0, lkt = 0;
        auto gload = [&](u32x4 (&ra)[2], u32x4 (&rb)[2]) {
#pragma unroll
            for (int i = 0; i < 2; ++i) { ra[i] = *(const u32x4*)(aptr[i] + (size_t)lkt * a_kstride); rb[i] = *(const u32x4*)(bptr[i] + (size_t)lkt * b_kstride); }
            if (lkt + 1 < KT) ++lkt; else if (lseg + 1 < NSEG) { lkt = 0; ++lseg; f.ptrs(lseg, aptr, bptr); }
        };
        auto lstore = [&](int buf, const u32x4 (&ra)[2], const u32x4 (&rb)[2]) {
            LAS unsigned char* base = lds + buf * STAGE;
#pragma unroll
            for (int i = 0; i < 2; ++i) { *(LAS u32x4*)(base + a_wr[i]) = ra[i]; *(LAS u32x4*)(base + b_wr[i]) = rb[i]; }
        };
        auto compute = [&](int buf) {
            const LAS unsigned char* base = lds + buf * STAGE;
            bf16x8 af[4];
#pragma unroll
            for (int mi = 0; mi < 4; ++mi) af[mi] = *(const LAS bf16x8*)(base + a_rd[mi]);
#pragma unroll
            for (int ni = 0; ni < 8; ++ni) {
                const int u0 = wn * 8 + ni;
                const s16x4 lo = lds_tr(base + b_rd[0] + ((u0 ^ b_f[0]) << 5));
                const s16x4 hi = lds_tr(base + b_rd[1] + ((u0 ^ b_f[1]) << 5));
                const bf16x8 bfr = (bf16x8){lo[0], lo[1], lo[2], lo[3], hi[0], hi[1], hi[2], hi[3]};
#pragma unroll
                for (int mi = 0; mi < 4; ++mi) acc[mi][ni] = __builtin_amdgcn_mfma_f32_16x16x32_bf16(bfr, af[mi], acc[mi][ni], 0, 0, 0);
            }
        };
        f.ptrs(0, aptr, bptr);
        gload(ra0, rb0); gload(ra1, rb1);
        lstore(0, ra0, rb0); __syncthreads();
        int cseg = 0, ckt = 0;
        const int total = NSEG * KT;
#pragma unroll 1
        for (int g = 0; g < total; g += 2) {
            gload(ra0, rb0);
            __builtin_amdgcn_sched_barrier(0);
            compute(0);
            lstore(1, ra1, rb1);
            __syncthreads();
            gload(ra1, rb1);
            __builtin_amdgcn_sched_barrier(0);
            compute(1);
            lstore(0, ra0, rb0);
            __syncthreads();
            ckt += 2;
            if (ckt == KT) {
                f.epi(cseg, acc);
#pragma unroll
                for (int mi = 0; mi < 4; ++mi)
#pragma unroll
                    for (int ni = 0; ni < 8; ++ni) acc[mi][ni] = (f32x4){0.f, 0.f, 0.f, 0.f};
                ckt = 0; ++cseg;
            }
        }
    }
};

template <bool BF32> struct Gemm5 {
    static constexpr int A_BYTES = 16384, STAGE = 32768, LDS_BYTES = 2 * STAGE;
    static __device__ __forceinline__ int fk2(int r) { return (r & 3) | (((r >> 3) & 1) << 2); }
    static __device__ __forceinline__ int a_row(int i, int tid) { return (tid >> 2) + 128 * i; }
    static __device__ __forceinline__ int b_k(int i, int tid) { return (tid >> 5) + 16 * i; }
    typedef typename std::conditional<BF32, float, bf16_t>::type b_t;
    static __device__ __forceinline__ void run(f32x4 (&acc)[4][8], const bf16_t* const (&aptr)[2], int a_kstride, const b_t* const (&bptr)[2], size_t b_kstride, int KT, LAS unsigned char* lds) {
        const int tid = opaque_tid(), lane = tid & 63, wid = tid >> 6, wm = wid >> 1, wn = wid & 1, fr = lane & 15, fq = lane >> 4;
#pragma unroll
        for (int mi = 0; mi < 4; ++mi)
#pragma unroll
            for (int ni = 0; ni < 8; ++ni) acc[mi][ni] = (f32x4){0.f, 0.f, 0.f, 0.f};
        int a_wr[2], b_wr[2];
#pragma unroll
        for (int i = 0; i < 2; ++i) { const int row = a_row(i, tid); a_wr[i] = row * 64 + (((tid & 3) ^ ((row >> 1) & 3)) << 4);
            const int k = b_k(i, tid), n = (tid & 31) * 8; b_wr[i] = A_BYTES + k * 512 + (((n >> 4) ^ fk2(k)) << 5) + ((n & 15) << 1); }
        int a_rd[4];
#pragma unroll
        for (int mi = 0; mi < 4; ++mi) { const int row = wm * 64 + mi * 16 + fr; a_rd[mi] = row * 64 + ((fq ^ ((row >> 1) & 3)) << 4); }
        int b_rd[2], b_f[2];
#pragma unroll
        for (int t = 0; t < 2; ++t) { const int k = 8 * fq + 4 * t + (fr >> 2); b_f[t] = fk2(k); b_rd[t] = A_BYTES + k * 512 + ((fr & 3) << 3); }
        u32x4 ra[2]; u32x4 rb[2]; f32x4 rbf[2][2];
        auto gload = [&](int kt) {
#pragma unroll
            for (int i = 0; i < 2; ++i) { ra[i] = *(const u32x4*)(aptr[i] + (size_t)kt * a_kstride);
                if (BF32) { const float* p = (const float*)bptr[i] + (size_t)kt * b_kstride; rbf[i][0] = *(const f32x4*)p; rbf[i][1] = *(const f32x4*)(p + 4); }
                else rb[i] = *(const u32x4*)((const bf16_t*)bptr[i] + (size_t)kt * b_kstride); }
        };
        auto lstore = [&](int buf) {
            LAS unsigned char* base = lds + buf * STAGE;
#pragma unroll
            for (int i = 0; i < 2; ++i) { *(LAS u32x4*)(base + a_wr[i]) = ra[i];
                if (BF32) { u32x4 w; w.x = cvtpk(rbf[i][0].x, rbf[i][0].y); w.y = cvtpk(rbf[i][0].z, rbf[i][0].w); w.z = cvtpk(rbf[i][1].x, rbf[i][1].y); w.w = cvtpk(rbf[i][1].z, rbf[i][1].w); *(LAS u32x4*)(base + b_wr[i]) = w; }
                else *(LAS u32x4*)(base + b_wr[i]) = rb[i]; }
        };
        auto compute = [&](int buf) {
            const LAS unsigned char* base = lds + buf * STAGE;
            bf16x8 af[4];
#pragma unroll
            for (int mi = 0; mi < 4; ++mi) af[mi] = *(const LAS bf16x8*)(base + a_rd[mi]);
#pragma unroll
            for (int ni = 0; ni < 8; ++ni) {
                const int u0 = wn * 8 + ni;
                const s16x4 lo = lds_tr(base + b_rd[0] + ((u0 ^ b_f[0]) << 5));
                const s16x4 hi = lds_tr(base + b_rd[1] + ((u0 ^ b_f[1]) << 5));
                const bf16x8 bfr = (bf16x8){lo[0], lo[1], lo[2], lo[3], hi[0], hi[1], hi[2], hi[3]};
#pragma unroll
                for (int mi = 0; mi < 4; ++mi) acc[mi][ni] = __builtin_amdgcn_mfma_f32_16x16x32_bf16(bfr, af[mi], acc[mi][ni], 0, 0, 0);
            }
        };
        gload(0); lstore(0); __syncthreads();
#pragma unroll 1
        for (int kt = 0; kt < KT; ++kt) {
            gload(kt + 1 < KT ? kt + 1 : KT - 1);
            __builtin_amdgcn_sched_barrier(0);
            compute(kt & 1);
            lstore((kt + 1) & 1);
            __syncthreads();
        }
    }

    template <class F> static __device__ __forceinline__ void run_stream(F& f, int NSEG, int KT, int a_kstride, size_t b_kstride, LAS unsigned char* lds) {
        const int tid = opaque_tid(), lane = tid & 63, wid = tid >> 6, wm = wid >> 1, wn = wid & 1, fr = lane & 15, fq = lane >> 4;
        f32x4 acc[4][8];
#pragma unroll
        for (int mi = 0; mi < 4; ++mi)
#pragma unroll
            for (int ni = 0; ni < 8; ++ni) acc[mi][ni] = (f32x4){0.f, 0.f, 0.f, 0.f};
        int a_wr[2], b_wr[2];
#pragma unroll
        for (int i = 0; i < 2; ++i) { const int row = a_row(i, tid); a_wr[i] = row * 64 + (((tid & 3) ^ ((row >> 1) & 3)) << 4);
            const int k = b_k(i, tid), n = (tid & 31) * 8; b_wr[i] = A_BYTES + k * 512 + (((n >> 4) ^ fk2(k)) << 5) + ((n & 15) << 1); }
        int a_rd[4];
#pragma unroll
        for (int mi = 0; mi < 4; ++mi) { const int row = wm * 64 + mi * 16 + fr; a_rd[mi] = row * 64 + ((fq ^ ((row >> 1) & 3)) << 4); }
        int b_rd[2], b_f[2];
#pragma unroll
        for (int t = 0; t < 2; ++t) { const int k = 8 * fq + 4 * t + (fr >> 2); b_f[t] = fk2(k); b_rd[t] = A_BYTES + k * 512 + ((fr & 3) << 3); }
        const bf16_t* aptr[2]; const b_t* bptr[2];
        u32x4 ra[2]; u32x4 rb[2]; f32x4 rbf[2][2];
        auto gload = [&](int kt) {
#pragma unroll
            for (int i = 0; i < 2; ++i) { ra[i] = *(const u32x4*)(aptr[i] + (size_t)kt * a_kstride);
                if (BF32) { const float* p = (const float*)bptr[i] + (size_t)kt * b_kstride; rbf[i][0] = *(const f32x4*)p; rbf[i][1] = *(const f32x4*)(p + 4); }
                else rb[i] = *(const u32x4*)((const bf16_t*)bptr[i] + (size_t)kt * b_kstride); }
        };
        auto lstore = [&](int buf) {
            LAS unsigned char* base = lds + buf * STAGE;
#pragma unroll
            for (int i = 0; i < 2; ++i) { *(LAS u32x4*)(base + a_wr[i]) = ra[i];
                if (BF32) { u32x4 w; w.x = cvtpk(rbf[i][0].x, rbf[i][0].y); w.y = cvtpk(rbf[i][0].z, rbf[i][0].w); w.z = cvtpk(rbf[i][1].x, rbf[i][1].y); w.w = cvtpk(rbf[i][1].z, rbf[i][1].w); *(LAS u32x4*)(base + b_wr[i]) = w; }
                else *(LAS u32x4*)(base + b_wr[i]) = rb[i]; }
        };
        auto compute = [&](int buf) {
            const LAS unsigned char* base = lds + buf * STAGE;
            bf16x8 af[4];
#pragma unroll
            for (int mi = 0; mi < 4; ++mi) af[mi] = *(const LAS bf16x8*)(base + a_rd[mi]);
#pragma unroll
            for (int ni = 0; ni < 8; ++ni) {
                const int u0 = wn * 8 + ni;
                const s16x4 lo = lds_tr(base + b_rd[0] + ((u0 ^ b_f[0]) << 5));
                const s16x4 hi = lds_tr(base + b_rd[1] + ((u0 ^ b_f[1]) << 5));
                const bf16x8 bfr = (bf16x8){lo[0], lo[1], lo[2], lo[3], hi[0], hi[1], hi[2], hi[3]};
#pragma unroll
                for (int mi = 0; mi < 4; ++mi) acc[mi][ni] = __builtin_amdgcn_mfma_f32_16x16x32_bf16(bfr, af[mi], acc[mi][ni], 0, 0, 0);
            }
        };
        f.ptrs(0, aptr, bptr);
        gload(0); lstore(0); __syncthreads();
        int seg = 0, kt = 0;
        const int total = NSEG * KT;
#pragma unroll 1
        for (int g = 0; g < total; ++g) {
            int nkt = kt + 1, nsg = seg; if (nkt == KT) { nkt = 0; nsg = seg + 1; }
            if (nkt == 0 && nsg < NSEG) f.ptrs(nsg, aptr, bptr);
            gload(nsg < NSEG ? nkt : KT - 1);
            __builtin_amdgcn_sched_barrier(0);
            compute(g & 1);
            lstore((g + 1) & 1);
            __syncthreads();
            if (nkt == 0) {
                f.epi(seg, acc);
#pragma unroll
                for (int mi = 0; mi < 4; ++mi)
#pragma unroll
                    for (int ni = 0; ni < 8; ++ni) acc[mi][ni] = (f32x4){0.f, 0.f, 0.f, 0.f};
            }
            seg = nsg; kt = nkt;
        }
    }
};

__device__ __forceinline__ void phase_mod(const Params& P, LAS unsigned char* lds) {
    const int tid = threadIdx.x;
    float* mod = (float*)(P.ws + WS_MOD);
    LAS float* sc = (LAS float*)lds;
    LAS float* red = (LAS float*)(lds + 16384);
    for (int i = tid; i < 4096; i += NTHREADS) sc[i] = siluf_(P.c[i]);
    __syncthreads();
    const int kq = tid >> 5, cl = tid & 31;
    for (int u = blockIdx.x; u < 192; u += gridDim.x) {
        const int j = u * 32 + cl;
        float a0 = 0.f, a1 = 0.f, a2 = 0.f, a3 = 0.f;
#pragma unroll 8
        for (int k = kq; k < 1024; k += 16) { const float w = P.ada_w[(size_t)k * 6144 + j];
            a0 += sc[k] * w; a1 += sc[1024 + k] * w; a2 += sc[2048 + k] * w; a3 += sc[3072 + k] * w; }
        red[(kq * 4 + 0) * 32 + cl] = a0; red[(kq * 4 + 1) * 32 + cl] = a1; red[(kq * 4 + 2) * 32 + cl] = a2; red[(kq * 4 + 3) * 32 + cl] = a3;
        __syncthreads();
        if (tid < 128) { const int b = tid >> 5; float s = 0.f;
#pragma unroll
            for (int q = 0; q < 16; ++q) s += red[(q * 4 + b) * 32 + cl];
            mod[b * 6144 + j] = s + P.ada_b[j]; }
        __syncthreads();
    }
    for (int u = blockIdx.x; u < 16; u += gridDim.x) {
        const int sel = u >> 3, j = (u & 7) * 32 + cl;
        const float* w1 = P.cmp_w1 + (size_t)sel * 2048 * 256; const float* pos = P.cmp_pos + sel * 2048;
        float a0 = 0.f;
#pragma unroll 8
        for (int k = kq; k < 2048; k += 16) a0 += pos[k] * w1[(size_t)k * 256 + j];
        red[kq * 32 + cl] = a0;
        __syncthreads();
        if (tid < 32) { float s = 0.f;
#pragma unroll
            for (int q = 0; q < 16; ++q) s += red[q * 32 + cl];
            ((float*)(P.ws + WS_CB))[sel * 256 + j] = s + P.cmp_b1[sel * 256 + j]; }
        __syncthreads();
    }
    {
        bf16_t* wb = (bf16_t*)(P.ws + WS_WIN);
        const int gt = blockIdx.x * NTHREADS + tid, NG = gridDim.x * NTHREADS;
        for (int i = gt; i < 1024 * (3584 / 8); i += NG) { const int k = i / 448, c8 = (i % 448) * 8;
            const int sc_ = c8 < 1280 ? c8 : (c8 < 3328 ? c8 + 24 : c8 - 2048);
            u32x4 o = (u32x4){0u, 0u, 0u, 0u};
            if (c8 < 3352) { const f32x4 a = *(const f32x4*)(P.w_in + (size_t)k * IN_COLS + sc_), b2 = *(const f32x4*)(P.w_in + (size_t)k * IN_COLS + sc_ + 4);
                o.x = cvtpk(a.x, a.y); o.y = cvtpk(a.z, a.w); o.z = cvtpk(b2.x, b2.y); o.w = cvtpk(b2.z, b2.w); }
            *(u32x4*)(wb + (size_t)k * 3584 + c8) = o; }
    }
    if (blockIdx.x == gridDim.x - 2) {
        for (int i = tid; i < 2 * 8 * 64; i += NTHREADS) { const int t2 = i >> 9, bg = (i >> 6) & 7, d = i & 63;
            ((bf16_t*)(P.ws + (t2 ? WS_VC : WS_KC)))[((size_t)bg * 512 + 511) * 64 + d] = 0; }
    }
    if (blockIdx.x == gridDim.x - 1) {
        float* lb = (float*)(P.ws + WS_LB);
        for (int i = tid; i < 512; i += NTHREADS) { const float p0 = P.hgrn_lb[i], p1 = P.hgrn_lb[512 + i]; lb[i] = 1.0f / (1.0f + __expf(p1 - p0)); }
    }
}

__device__ __forceinline__ void norm_mod_rows(const float* x, const float* w, const float* mod_sh, const float* mod_sc, bf16_t* h, int hs) {
    const int lane = threadIdx.x & 63, gw = blockIdx.x * (NTHREADS / 64) + (threadIdx.x >> 6), NGW = gridDim.x * (NTHREADS / 64);
    for (int m = gw; m < T; m += NGW) {
        const int b = m / SEQ;
        const f32x4* xr = (const f32x4*)(x + (size_t)m * D) + lane;
        f32x4 v[4]; float s = 0.f;
#pragma unroll
        for (int j = 0; j < 4; ++j) { v[j] = xr[64 * j]; s += (v[j].x * v[j].x + v[j].y * v[j].y) + (v[j].z * v[j].z + v[j].w * v[j].w); }
        const float rstd = rsqrtf(wave_sum(s) * (1.f / D) + RMS_EPS);
        u32x2* o = (u32x2*)(h + (size_t)m * hs) + lane;
#pragma unroll
        for (int j = 0; j < 4; ++j) {
            const int col = (lane + 64 * j) * 4;
            const f32x4 wv = *(const f32x4*)(w + col), scv = *(const f32x4*)(mod_sc + b * 6144 + col), shv = *(const f32x4*)(mod_sh + b * 6144 + col);
            f32x4 r;
            r.x = v[j].x * rstd * wv.x * (1.f + scv.x) + shv.x; r.y = v[j].y * rstd * wv.y * (1.f + scv.y) + shv.y;
            r.z = v[j].z * rstd * wv.z * (1.f + scv.z) + shv.z; r.w = v[j].w * rstd * wv.w * (1.f + scv.w) + shv.w;
            u32x2 pk; pk.x = cvtpk(r.x, r.y); pk.y = cvtpk(r.z, r.w); o[64 * j] = pk;
        }
    }
}

__device__ __forceinline__ void phase_inproj(const Params& P, LAS unsigned char* lds) {
    const int tid = opaque_tid(), lane = tid & 63, wid = tid >> 6, wm = wid >> 1, wn = wid & 1, fr = lane & 15, fq = lane >> 4;
    const bf16_t* h1 = (const bf16_t*)(P.ws + WS_H); const bf16_t* wb = (const bf16_t*)(P.ws + WS_WIN);
    bf16_t* qo = (bf16_t*)(P.ws + WS_Q); bf16_t* kvo = (bf16_t*)(P.ws + WS_KV); float* gates = (float*)(P.ws + WS_GATES);
    bf16_t* hq = (bf16_t*)(P.ws + WS_HQ); float* logf = (float*)(P.ws + WS_LOGF); bf16_t* hv = (bf16_t*)(P.ws + WS_HV); bf16_t* hg = (bf16_t*)(P.ws + WS_HG);
    const float* lb = (const float*)(P.ws + WS_LB);
    constexpr int NRT = T / 256, NCT = 14;
    const int nx = (gridDim.x % 8 == 0) ? 8 : 1, xl = blockIdx.x % nx, li = blockIdx.x / nx, nloc = gridDim.x / nx;
    for (int v = li; v < (NRT / nx) * NCT; v += nloc) {
        const int rg = v / (NCT * 4), rem = v % (NCT * 4), ct = rem >> 2, rt = xl + nx * (rg * 4 + (rem & 3));
        const bf16_t* aptr[2]; const bf16_t* bptr[2];
#pragma unroll
        for (int i = 0; i < 2; ++i) { aptr[i] = h1 + (size_t)(rt * 256 + Gemm4::a_row(i, tid)) * H1S + 8 * (tid & 3);
            bptr[i] = wb + (size_t)Gemm4::b_k(i, tid) * 3584 + ct * 256 + 8 * (tid & 31); }
        f32x4 acc[4][8];
        Gemm4::run(acc, aptr, 32, bptr, (size_t)32 * 3584, D / 32, lds);
        const int row0 = rt * 256 + wm * 64 + fr;
        const int cw = wn * 128 + 4 * fq;
        if (ct < 5) {
            const bool is_q = ct < 2; const int seg = (ct - 2) * 2 + wn;
            const bool do_norm = is_q || seg == 2 || seg == 4;
            const float* nw = is_q ? P.q_norm_w : (P.k_norm_w + (seg == 2 ? 64 : 128));
            const float osc = is_q ? 0.125f : 1.0f;
#pragma unroll
            for (int hh = 0; hh < 2; ++hh) {
                f32x4 wv[4];
#pragma unroll
                for (int n4 = 0; n4 < 4; ++n4) wv[n4] = do_norm ? *(const f32x4*)(nw + n4 * 16 + 4 * fq) : (f32x4){1.f, 1.f, 1.f, 1.f};
#pragma unroll
                for (int mi = 0; mi < 4; ++mi) {
                    float rstd = 1.f;
                    if (do_norm) { float s = 0.f;
#pragma unroll
                        for (int n4 = 0; n4 < 4; ++n4) { const f32x4 a = acc[mi][hh * 4 + n4]; s += (a.x * a.x + a.y * a.y) + (a.z * a.z + a.w * a.w); }
                        s += __shfl_xor(s, 16); s += __shfl_xor(s, 32);
                        rstd = rsqrtf(s * (1.f / 64.f) + RMS_EPS) * osc; }
                    const size_t m = (size_t)(row0 + mi * 16);
                    bf16_t* dst = is_q ? (qo + m * 512 + ct * 256 + cw + hh * 64) : (kvo + m * 768 + (ct - 2) * 256 + cw + hh * 64);
#pragma unroll
                    for (int n4 = 0; n4 < 4; ++n4) { const f32x4 a = acc[mi][hh * 4 + n4]; u32x2 pk;
                        pk.x = cvtpk(a.x * rstd * wv[n4].x, a.y * rstd * wv[n4].y); pk.y = cvtpk(a.z * rstd * wv[n4].z, a.w * rstd * wv[n4].w);
                        *(u32x2*)(dst + n4 * 16) = pk; }
                }
            }
        } else if (ct == 13) {
            if (wn == 0) {
#pragma unroll
                for (int mi = 0; mi < 4; ++mi) { const size_t m = (size_t)(row0 + mi * 16);
#pragma unroll
                    for (int ni = 0; ni < 2; ++ni) { const int c = ni * 16 + 4 * fq; if (c < 24) { const f32x4 a = acc[mi][ni];
                            *(f32x4*)(gates + m * 24 + c) = (f32x4){sigmoidf_(a.x), sigmoidf_(a.y), sigmoidf_(a.z), sigmoidf_(a.w)}; } } }
            }
        } else {
            const int hs = (ct - 5) >> 1, cc = ((ct - 5) & 1) * 256 + cw;
#pragma unroll
            for (int mi = 0; mi < 4; ++mi) { const size_t m = (size_t)(row0 + mi * 16);
#pragma unroll
                for (int ni = 0; ni < 8; ++ni) { const f32x4 a = acc[mi][ni]; const int c = cc + ni * 16;
                    if (hs == 0) { const float s = 0.08838834764831845f; u32x2 pk; pk.x = cvtpk(siluf_(a.x) * s, siluf_(a.y) * s); pk.y = cvtpk(siluf_(a.z) * s, siluf_(a.w) * s); *(u32x2*)(hq + m * 512 + c) = pk; }
                    else if (hs == 1) { const f32x4 l = *(const f32x4*)(lb + c); f32x4 o;
                        o.x = __logf(l.x + (1.f - l.x) * sigmoidf_(a.x)); o.y = __logf(l.y + (1.f - l.y) * sigmoidf_(a.y));
                        o.z = __logf(l.z + (1.f - l.z) * sigmoidf_(a.z)); o.w = __logf(l.w + (1.f - l.w) * sigmoidf_(a.w)); *(f32x4*)(logf + m * 512 + c) = o; }
                    else if (hs == 2) { u32x2 pk; pk.x = cvtpk(a.x, a.y); pk.y = cvtpk(a.z, a.w); *(u32x2*)(hv + m * 512 + c) = pk; }
                    else { u32x2 pk; pk.x = cvtpk(sigmoidf_(a.x), sigmoidf_(a.y)); pk.y = cvtpk(sigmoidf_(a.z), sigmoidf_(a.w)); *(u32x2*)(hg + m * 512 + c) = pk; }
                } }
        }
    }
}

__device__ __forceinline__ float gelu_tanh(float x) {
    const float u = 0.7978845608028654f * (x + 0.044715f * x * x * x);
    const float th = 1.0f - 2.0f / (1.0f + __expf(2.0f * u));
    return 0.5f * x * (1.0f + th);
}
__device__ __forceinline__ void compress_unit(const Params& P, LAS unsigned char* lds, int u) {
    typedef GemmT<2, 4> G;
    const int tid = opaque_tid(), lane = tid & 63, wid = tid >> 6, wm = wid >> 2, wn = wid & 3, fr = lane & 15, fq = lane >> 4;
    const int sel = u >> 5, rt = u & 31;
    const bf16_t* kv = (const bf16_t*)(P.ws + WS_KV);
    bf16_t* cmph = (bf16_t*)(P.ws + WS_CMPH) + (size_t)sel * 4096 * 256;
    const float* cb = (const float*)(P.ws + WS_CB) + sel * 256;
    const bf16_t* arow[2];
#pragma unroll
    for (int p = 0; p < 2; ++p) { int r = rt * 128 + p * 64 + (tid >> 3); r = r < 4088 ? r : 4087;
        const int b = r / 1022, rem = r % 1022, i = rem >> 1, g = rem & 1;
        arow[p] = kv + (size_t)(b * SEQ + 16 * i) * 768 + sel * 128 + g * 64; }
    f32x4 acc[4][4];
    G::run(acc, arow, 768, P.cmp_w1 + (size_t)sel * 2048 * 256, 256, 32, lds);
#pragma unroll
    for (int mi = 0; mi < 4; ++mi) { const size_t row = (size_t)(rt * 128 + wm * 64 + mi * 16 + fr);
#pragma unroll
        for (int ni = 0; ni < 4; ++ni) { const int col = wn * 64 + ni * 16 + 4 * fq; const f32x4 a = acc[mi][ni]; const f32x4 bb = *(const f32x4*)(cb + col);
            u32x2 pk; pk.x = cvtpk(gelu_tanh(a.x + bb.x), gelu_tanh(a.y + bb.y)); pk.y = cvtpk(gelu_tanh(a.z + bb.z), gelu_tanh(a.w + bb.w));
            *(u32x2*)(cmph + row * 256 + col) = pk; } }
    __syncthreads();
    {
        const int row = tid >> 2, cq = tid & 3;
        const bf16_t* hr = cmph + (size_t)(rt * 128 + row) * 256;
        const float* w2 = P.cmp_w2 + (size_t)sel * 256 * 64 + cq * 16;
        float o[16];
#pragma unroll
        for (int j = 0; j < 16; ++j) o[j] = 0.f;
        for (int k8 = 0; k8 < 256; k8 += 8) {
            const u32x4 hv = *(const u32x4*)(hr + k8);
#pragma unroll
            for (int kk = 0; kk < 8; ++kk) {
                const unsigned wd = hv[kk >> 1]; const float a = (kk & 1) ? __uint_as_float(wd & 0xffff0000u) : __uint_as_float(wd << 16);
                const float* wr = w2 + (size_t)(k8 + kk) * 64;
#pragma unroll
                for (int j4 = 0; j4 < 4; ++j4) { const f32x4 w = *(const f32x4*)(wr + j4 * 4);
                    o[j4 * 4 + 0] += a * w.x; o[j4 * 4 + 1] += a * w.y; o[j4 * 4 + 2] += a * w.z; o[j4 * 4 + 3] += a * w.w; }
            }
        }
        if (sel == 0) { float s = 0.f;
#pragma unroll
            for (int j = 0; j < 16; ++j) s += o[j] * o[j];
            s += __shfl_xor(s, 1); s += __shfl_xor(s, 2);
            const float rstd = rsqrtf(s * (1.f / 64.f) + RMS_EPS);
#pragma unroll
            for (int j = 0; j < 16; ++j) o[j] *= rstd * P.k_norm_w[cq * 16 + j]; }
        const int r = rt * 128 + row;
        if (r < 4088) { const int b = r / 1022, rem = r % 1022, i = rem >> 1, g = rem & 1;
            bf16_t* dst = (bf16_t*)(P.ws + (sel ? WS_VC : WS_KC)) + ((size_t)(b * 2 + g) * 512 + i) * 64 + cq * 16;
            u32x4 w0, w1;
            w0.x = cvtpk(o[0], o[1]); w0.y = cvtpk(o[2], o[3]); w0.z = cvtpk(o[4], o[5]); w0.w = cvtpk(o[6], o[7]);
            w1.x = cvtpk(o[8], o[9]); w1.y = cvtpk(o[10], o[11]); w1.z = cvtpk(o[12], o[13]); w1.w = cvtpk(o[14], o[15]);
            *(u32x4*)dst = w0; *(u32x4*)(dst + 8) = w1; }
    }
    __syncthreads();
}

__device__ __forceinline__ int off_row128(int row, int ch) { return row * 128 + ((ch ^ ((row >> 1) & 7)) << 4); }
__device__ __forceinline__ int off_row256(int row, int ch) { return row * 256 + ((ch ^ (row & 15)) << 4); }
__device__ __forceinline__ int fk_(int r) { return (r & 3) | (((r >> 3) & 1) << 2); }
__device__ __forceinline__ int off_tr256(int row, int col) { return row * 256 + ((((col >> 4) ^ fk_(row)) << 5) + ((col & 15) << 1)); }
constexpr int HL_QT = 0, HL_KT = 16384, HL_KH = 32768, HL_V = 49152, HL_SB = 65536, HL_P = 98304  , HL_TOT = 106496  , HL_RED = 110592  , HL_END = 111104;

template <int MODE> __device__ __forceinline__ void hgrn_unit(const Params& P, LAS unsigned char* lds, int u) {
    const int tid = opaque_tid(), lane = tid & 63, wid = tid >> 6, fr = lane & 15, fq = lane >> 4;
    const int b = u >> 7, h = (u >> 5) & 3, sc = u & 31;
    const bf16_t* hq = (const bf16_t*)(P.ws + WS_HQ); const float* logf = (const float*)(P.ws + WS_LOGF);
    const bf16_t* hv = (const bf16_t*)(P.ws + WS_HV); const bf16_t* hg = (const bf16_t*)(P.ws + WS_HG);
    float* HLs = (float*)(P.ws + WS_HL); float* HDs = (float*)(P.ws + WS_HD);
    bf16_t* mix = (bf16_t*)(P.ws + WS_MIX);
    LAS float* tot = (LAS float*)(lds + HL_TOT); LAS float* red = (LAS float*)(lds + HL_RED);
    f32x4 st[8];
#pragma unroll
    for (int vt = 0; vt < 8; ++vt) st[vt] = (f32x4){0.f, 0.f, 0.f, 0.f};
    if (MODE == 1) {
        const int kk = 16 * wid + fr;
#pragma unroll 4
        for (int j = 0; j < sc; ++j) {
            const float* Lj = HLs + (size_t)(u - sc + j) * 16384 + kk * 128 + 4 * fq; const float dj = HDs[(size_t)(u - sc + j) * 128 + kk];
#pragma unroll
            for (int vt = 0; vt < 8; ++vt) { const f32x4 l = *(const f32x4*)(Lj + vt * 16); st[vt] = st[vt] * dj + l; }
        }
    }
    float dsum = 0.f;
    const int kp = tid & 63, te = tid >> 6;
    for (int c = 0; c < 4; ++c) {
        const size_t tok0 = (size_t)b * SEQ + sc * 256 + c * 64;
        float lf0[8], lf1[8], cs0[8], cs1[8];
        { float a0 = 0.f, a1 = 0.f;
#pragma unroll
          for (int i = 0; i < 8; ++i) { const float2 v = *(const float2*)(logf + (tok0 + te * 8 + i) * 512 + h * 128 + 2 * kp); lf0[i] = v.x; lf1[i] = v.y; a0 += v.x; a1 += v.y; cs0[i] = a0; cs1[i] = a1; }
          tot[te * 128 + 2 * kp] = a0; tot[te * 128 + 2 * kp + 1] = a1; }
#pragma unroll
        for (int i = 0; i < 2; ++i) { const int pc = tid + NTHREADS * i, row = pc >> 4, c8 = (pc & 15) * 8;
            const u32x4 v = *(const u32x4*)(hv + (tok0 + row) * 512 + h * 128 + c8);
            *(LAS u32x4*)(lds + HL_V + off_tr256(row, c8)) = v; }
        if (MODE == 1 ) {
#pragma unroll
            for (int vt = 0; vt < 8; ++vt) { u32x2 pk; pk.x = cvtpk(st[vt].x, st[vt].y); pk.y = cvtpk(st[vt].z, st[vt].w);
                *(LAS u32x2*)(lds + HL_SB + off_tr256(16 * wid + fr, 16 * vt + 4 * fq)) = pk; }
        }
        __syncthreads();
        float pre0 = 0.f, pre1 = 0.f, last0 = 0.f, last1 = 0.f;
#pragma unroll
        for (int e = 0; e < 8; ++e) { const float t0 = tot[e * 128 + 2 * kp], t1 = tot[e * 128 + 2 * kp + 1]; if (e < te) { pre0 += t0; pre1 += t1; } last0 += t0; last1 += t1; }
#pragma unroll
        for (int i = 0; i < 8; ++i) {
            const int t = te * 8 + i;
            const float c0 = cs0[i] + pre0, c1 = cs1[i] + pre1;
            const float k0 = 1.f - __expf(lf0[i]), k1 = 1.f - __expf(lf1[i]);
            const unsigned khat = cvtpk(k0 * __expf(last0 - c0), k1 * __expf(last1 - c1));
            *(LAS unsigned*)(lds + HL_KH + off_tr256(t, 2 * kp)) = khat;
            if (MODE == 1) {
                const unsigned qraw = *(const unsigned*)(hq + (tok0 + t) * 512 + h * 128 + 2 * kp);
                const float q0 = __uint_as_float(qraw << 16), q1 = __uint_as_float(qraw & 0xffff0000u);
                const unsigned qt = cvtpk(q0 * __expf(c0), q1 * __expf(c1));
                const unsigned kt = cvtpk(k0 * __expf(fminf(-c0, 80.f)), k1 * __expf(fminf(-c1, 80.f)));
                const int o = off_row256(t, kp >> 2) + ((kp & 3) << 2);
                *(LAS unsigned*)(lds + HL_QT + o) = qt; *(LAS unsigned*)(lds + HL_KT + o) = kt;
            }
        }
        const float dec = __expf(tot[0 * 128 + 16 * wid + fr] + tot[1 * 128 + 16 * wid + fr] + tot[2 * 128 + 16 * wid + fr] + tot[3 * 128 + 16 * wid + fr]
                                 + tot[4 * 128 + 16 * wid + fr] + tot[5 * 128 + 16 * wid + fr] + tot[6 * 128 + 16 * wid + fr] + tot[7 * 128 + 16 * wid + fr]);
        if (MODE == 0 && tid < 128) { float s = 0.f;
#pragma unroll
            for (int e = 0; e < 8; ++e) s += tot[e * 128 + tid];
            dsum += s; }
        __syncthreads();
        f32x4 oacc[4];
        if (MODE == 1) {
            { const int tt = wid & 3;
#pragma unroll
              for (int si = 0; si < 2; ++si) { const int stl = 2 * (wid >> 2) + si;
                  f32x4 sacc = (f32x4){0.f, 0.f, 0.f, 0.f};
                  if (stl <= tt) {
#pragma unroll
                      for (int ks = 0; ks < 4; ++ks) {
                          const bf16x8 a = *(const LAS bf16x8*)(lds + HL_KT + off_row256(stl * 16 + fr, ks * 4 + fq));
                          const bf16x8 bq = *(const LAS bf16x8*)(lds + HL_QT + off_row256(tt * 16 + fr, ks * 4 + fq));
                          sacc = __builtin_amdgcn_mfma_f32_16x16x32_bf16(a, bq, sacc, 0, 0, 0);
                      }
                  }
                  const int t = tt * 16 + fr, s0 = stl * 16 + 4 * fq;
                  u32x2 pk; pk.x = cvtpk(s0 + 0 <= t ? sacc.x : 0.f, s0 + 1 <= t ? sacc.y : 0.f); pk.y = cvtpk(s0 + 2 <= t ? sacc.z : 0.f, s0 + 3 <= t ? sacc.w : 0.f);
                  *(LAS u32x2*)(lds + HL_P + off_row128(t, s0 >> 3) + ((s0 & 7) << 1)) = pk; }
            }
            __syncthreads();
            { const int tt = wid >> 1;
#pragma unroll
              for (int i = 0; i < 4; ++i) { const int vt = 4 * (wid & 1) + i;
                  f32x4 a = (f32x4){0.f, 0.f, 0.f, 0.f};
#pragma unroll
                  for (int ks = 0; ks < 2; ++ks) {
                      const int kr = ks * 32 + 8 * fq + (fr >> 2);
                      const s16x4 lo = lds_tr(lds + HL_V + off_tr256(kr, vt * 16 + 4 * (fr & 3))), hi = lds_tr(lds + HL_V + off_tr256(kr + 4, vt * 16 + 4 * (fr & 3)));
                      const bf16x8 va = (bf16x8){lo[0], lo[1], lo[2], lo[3], hi[0], hi[1], hi[2], hi[3]};
                      const bf16x8 pb = *(const LAS bf16x8*)(lds + HL_P + off_row128(tt * 16 + fr, ks * 4 + fq));
                      a = __builtin_amdgcn_mfma_f32_16x16x32_bf16(va, pb, a, 0, 0, 0);
                  }
#pragma unroll
                  for (int ks = 0; ks < 4; ++ks) {
                      const int kr = ks * 32 + 8 * fq + (fr >> 2);
                      const s16x4 lo = lds_tr(lds + HL_SB + off_tr256(kr, vt * 16 + 4 * (fr & 3))), hi = lds_tr(lds + HL_SB + off_tr256(kr + 4, vt * 16 + 4 * (fr & 3)));
                      const bf16x8 sa = (bf16x8){lo[0], lo[1], lo[2], lo[3], hi[0], hi[1], hi[2], hi[3]};
                      const bf16x8 qb = *(const LAS bf16x8*)(lds + HL_QT + off_row256(tt * 16 + fr, ks * 4 + fq));
                      a = __builtin_amdgcn_mfma_f32_16x16x32_bf16(sa, qb, a, 0, 0, 0);
                  }
                  const u32x2 gr = *(const u32x2*)(hg + (tok0 + tt * 16 + fr) * 512 + h * 128 + vt * 16 + 4 * fq);
                  a.x *= __uint_as_float(gr.x << 16); a.y *= __uint_as_float(gr.x & 0xffff0000u); a.z *= __uint_as_float(gr.y << 16); a.w *= __uint_as_float(gr.y & 0xffff0000u);
                  oacc[i] = a; }
              float ss = 0.f;
#pragma unroll
              for (int i = 0; i < 4; ++i) ss += (oacc[i].x * oacc[i].x + oacc[i].y * oacc[i].y) + (oacc[i].z * oacc[i].z + oacc[i].w * oacc[i].w);
              ss += __shfl_xor(ss, 16); ss += __shfl_xor(ss, 32);
              if (fq == 0) red[(tt * 2 + (wid & 1)) * 16 + fr] = ss; }
        }
#pragma unroll
        for (int vt = 0; vt < 8; ++vt) {
            f32x4 a = st[vt] * dec;
#pragma unroll
            for (int ks = 0; ks < 2; ++ks) {
                const int kr = ks * 32 + 8 * fq + (fr >> 2);
                const s16x4 lo = lds_tr(lds + HL_V + off_tr256(kr, vt * 16 + 4 * (fr & 3))), hi = lds_tr(lds + HL_V + off_tr256(kr + 4, vt * 16 + 4 * (fr & 3)));
                const bf16x8 va = (bf16x8){lo[0], lo[1], lo[2], lo[3], hi[0], hi[1], hi[2], hi[3]};
                const s16x4 lo2 = lds_tr(lds + HL_KH + off_tr256(kr, wid * 16 + 4 * (fr & 3))), hi2 = lds_tr(lds + HL_KH + off_tr256(kr + 4, wid * 16 + 4 * (fr & 3)));
                const bf16x8 kb = (bf16x8){lo2[0], lo2[1], lo2[2], lo2[3], hi2[0], hi2[1], hi2[2], hi2[3]};
                a = __builtin_amdgcn_mfma_f32_16x16x32_bf16(va, kb, a, 0, 0, 0);
            }
            st[vt] = a;
        }
        __syncthreads();
        if (MODE == 1) {
            const int tt = wid >> 1; const float ssum = red[(tt * 2) * 16 + fr] + red[(tt * 2 + 1) * 16 + fr];
            const float rstd = rsqrtf(ssum * (1.f / 128.f) + RMS_EPS);
#pragma unroll
            for (int i = 0; i < 4; ++i) { const int v = (4 * (wid & 1) + i) * 16 + 4 * fq; const f32x4 w = *(const f32x4*)(P.rec_out_norm_w + h * 128 + v);
                u32x2 pk; pk.x = cvtpk(oacc[i].x * rstd * w.x, oacc[i].y * rstd * w.y); pk.y = cvtpk(oacc[i].z * rstd * w.z, oacc[i].w * rstd * w.w);
                *(u32x2*)(mix + (tok0 + tt * 16 + fr) * 1024 + 512 + h * 128 + v) = pk; }
        }
    }
    if (MODE == 0) {
#pragma unroll
        for (int vt = 0; vt < 8; ++vt) *(f32x4*)(HLs + (size_t)u * 16384 + (16 * wid + fr) * 128 + vt * 16 + 4 * fq) = st[vt];
        if (tid < 128) HDs[(size_t)u * 128 + tid] = __expf(dsum);
    }
    __syncthreads();
}


constexpr int NL_K = 0, NL_V = 16384, NL_IMP = 32768, NL_IMP_STRIDE = 132, NL_SELM = NL_IMP + 8 * 8 * NL_IMP_STRIDE * 4, NL_END = NL_SELM + 1024;
__device__ __forceinline__ int off_v128(int row, int ch) { return row * 128 + ((ch ^ ((row & 3) << 1)) << 4); }
#define MFMA32(a, b, c) __builtin_amdgcn_mfma_f32_32x32x16_bf16(a, b, c, 0, 0, 0)

struct NsaLane { int t; float sl2; int qi; unsigned long long mlo, mhi; };

template <int MODE> __device__ __forceinline__ void nsa_pass(LAS unsigned char* lds, const bf16_t* Kg, const bf16_t* Vg, int rs, unsigned long long ulo, unsigned long long uhi,
                                                            const bf16x8 (&qf)[4], const NsaLane& L, float inv, float& lsum, f32x16 (&O)[2], LAS float* impw) {
    const int tid = opaque_tid(), lane = tid & 63, hi = lane >> 5, c = lane & 31;
    const int ld_row = tid >> 3, ld_ch = tid & 7;
    const int kw_off = off_row128(ld_row, ld_ch), vw_off = off_v128(ld_row, ld_ch);
    u32x4 k0, v0, k1, v1, k2, v2;
    auto next = [&](int jj) -> int { ++jj; if (jj < 64) { const unsigned long long m = ulo >> jj; if (m) return jj + __builtin_ctzll(m); jj = 64; }
                                     if (jj < 128) { const unsigned long long m = uhi >> (jj - 64); if (m) return jj + __builtin_ctzll(m); } return 128; };
    int jA = next(-1), jB = jA < 128 ? next(jA) : 128, jC = jB < 128 ? next(jB) : 128;
    const int jsafe = jA < 128 ? jA : 0;
    auto ldk = [&](int jj) -> u32x4 { const int q = jj < 128 ? jj : jsafe; return *(const u32x4*)(Kg + (size_t)(q * 64 + ld_row) * rs + ld_ch * 8); };
    auto ldv = [&](int jj) -> u32x4 { const int q = jj < 128 ? jj : jsafe; return *(const u32x4*)(Vg + (size_t)(q * 64 + ld_row) * rs + ld_ch * 8); };
    k0 = ldk(jA); k1 = ldk(jB); k2 = ldk(jC);
    if (MODE != 0) { v0 = ldv(jA); v1 = ldv(jB); v2 = ldv(jC); }
    int it = 0;
    auto step = [&](u32x4& kreg, u32x4& vreg) {
        const int j = jA;
        LAS unsigned char* kb = lds + NL_K + (it & 1) * 8192; LAS unsigned char* vb = lds + NL_V + (it & 1) * 8192;
        *(LAS u32x4*)(kb + kw_off) = kreg; if (MODE != 0) *(LAS u32x4*)(vb + vw_off) = vreg;
        const int jD = jC < 128 ? next(jC) : 128;
        kreg = ldk(jD); if (MODE != 0) vreg = ldv(jD);
        __syncthreads();
        bool need = true; bool selbit = true;
        if (MODE == 2) { selbit = (j < 64 ? (L.mlo >> j) : (L.mhi >> (j - 64))) & 1ull; need = __any(selbit); }
        if (need) {
            f32x16 p0 = {}, p1 = {};
#pragma unroll
            for (int ks = 0; ks < 4; ++ks) {
                const bf16x8 a0 = *(const LAS bf16x8*)(kb + off_row128(c, 2 * ks + hi)), a1 = *(const LAS bf16x8*)(kb + off_row128(32 + c, 2 * ks + hi));
                p0 = MFMA32(a0, qf[ks], p0); p1 = MFMA32(a1, qf[ks], p1);
            }
            const int stride = (MODE <= 1) ? 16 : 1;
            const int dl = (MODE <= 1) ? (L.t - 31 - 16 * (j * 64 + 4 * hi)) : (L.t - (j * 64 + 4 * hi));
            const float nb = -L.sl2 * (float)dl, sls = L.sl2 * (float)stride;
            float rs_ = 0.f;
#pragma unroll
            for (int r = 0; r < 16; ++r) {
                const int ro0 = (r & 3) + 8 * (r >> 2), ro1 = ro0 + 32;
                const int d0 = dl - stride * ro0, d1 = dl - stride * ro1;
                bool v0 = d0 >= 0, v1 = d1 >= 0;
                if (MODE == 3) { v0 = v0 && d0 < 512; v1 = v1 && d1 < 512; }
                if (MODE == 2) { v0 = v0 && selbit; v1 = v1 && selbit; }
                float e0 = __builtin_amdgcn_exp2f(__builtin_fmaf(p0[r], LOG2E, __builtin_fmaf(sls, (float)ro0, nb)));
                float e1 = __builtin_amdgcn_exp2f(__builtin_fmaf(p1[r], LOG2E, __builtin_fmaf(sls, (float)ro1, nb)));
                e0 = v0 ? e0 : 0.f; e1 = v1 ? e1 : 0.f;
                if (MODE == 1) { e0 *= inv; e1 *= inv; }
                p0[r] = e0; p1[r] = e1; rs_ += e0 + e1;
            }
            lsum += rs_;
            if (MODE == 1) {
#pragma unroll
                for (int kt = 0; kt < 2; ++kt)
#pragma unroll
                    for (int i = 0; i < 4; ++i) {
                        float g = kt ? (p1[4 * i] + p1[4 * i + 1]) + (p1[4 * i + 2] + p1[4 * i + 3]) : (p0[4 * i] + p0[4 * i + 1]) + (p0[4 * i + 2] + p0[4 * i + 3]);
                        float l3 = kt ? p1[4 * i + 3] : p0[4 * i + 3];
                        g += __shfl_xor(g, 1); g += __shfl_xor(g, 2); l3 += __shfl_xor(l3, 1); l3 += __shfl_xor(l3, 2);
                        if ((c & 3) == 0) { const int jj = j * 16 + kt * 8 + 2 * i + hi; __hip_atomic_fetch_add(impw + L.qi * NL_IMP_STRIDE + jj, g, __ATOMIC_RELAXED, __HIP_MEMORY_SCOPE_WORKGROUP); __hip_atomic_fetch_add(impw + L.qi * NL_IMP_STRIDE + jj + 1, l3, __ATOMIC_RELAXED, __HIP_MEMORY_SCOPE_WORKGROUP); }
                    }
            }
            if (MODE != 0) {
                bf16x8 pf[4];
#pragma unroll
                for (int s4 = 0; s4 < 4; ++s4) { u32x4 w;
#pragma unroll
                    for (int e = 0; e < 4; ++e) { const int r = 8 * (s4 & 1) + 2 * e; w[e] = (s4 >> 1) ? cvtpk(p1[r], p1[r + 1]) : cvtpk(p0[r], p0[r + 1]); }
                    pf[s4] = __builtin_bit_cast(bf16x8, w); }
                const int g4 = lane >> 4, sub = g4 & 1, i16 = lane & 15, qq = i16 >> 2, pp = i16 & 3;
#pragma unroll
                for (int dt = 0; dt < 2; ++dt)
#pragma unroll
                    for (int s4 = 0; s4 < 4; ++s4) {
                        const int row = 16 * s4 + 4 * hi + qq, ch = 4 * dt + 2 * sub + (pp >> 1);
                        const s16x4 lo = lds_tr(vb + off_v128(row, ch) + 8 * (pp & 1)), hh = lds_tr(vb + off_v128(row + 8, ch) + 8 * (pp & 1));
                        const bf16x8 vf = (bf16x8){lo[0], lo[1], lo[2], lo[3], hh[0], hh[1], hh[2], hh[3]};
                        O[dt] = MFMA32(vf, pf[s4], O[dt]);
                    }
            }
        }
        jA = jB; jB = jC; jC = jD; ++it;
    };
    while (jA < 128) {
        step(k0, v0); if (jA >= 128) break;
        step(k1, v1); if (jA >= 128) break;
        step(k2, v2);
    }
    __syncthreads();
}

__device__ __forceinline__ void nsa_unit(const Params& P, LAS unsigned char* lds, int u) {
    const int tid = opaque_tid(), lane = tid & 63, wid = tid >> 6, hi = lane >> 5, c = lane & 31;
    const int b = u >> 8, g = (u >> 7) & 1, qb = u & 127;
    const bf16_t* qg = (const bf16_t*)(P.ws + WS_Q); const bf16_t* kv = (const bf16_t*)(P.ws + WS_KV);
    const bf16_t* kcn = (const bf16_t*)(P.ws + WS_KC) + (size_t)(b * 2 + g) * 512 * 64; const bf16_t* vcc = (const bf16_t*)(P.ws + WS_VC) + (size_t)(b * 2 + g) * 512 * 64;
    const float* gates = (const float*)(P.ws + WS_GATES); bf16_t* mix = (bf16_t*)(P.ws + WS_MIX);
    LAS float* impw = (LAS float*)(lds + NL_IMP) + wid * 8 * NL_IMP_STRIDE;
    LAS unsigned long long* selm = (LAS unsigned long long*)(lds + NL_SELM);
    NsaLane L; L.qi = c >> 2; const int hh = c & 3, head = g * 4 + hh;
    L.t = qb * 64 + wid * 8 + L.qi; L.sl2 = exp2f(-(float)(head + 1)) * LOG2E; L.mlo = 0; L.mhi = 0;
    const size_t tok = (size_t)b * SEQ + L.t;
    bf16x8 qf[4];
#pragma unroll
    for (int ks = 0; ks < 4; ++ks) qf[ks] = *(const bf16x8*)(qg + tok * 512 + head * 64 + 16 * ks + 8 * hi);
    for (int i = lane; i < 8 * NL_IMP_STRIDE; i += 64) impw[i] = 0.f;
    const int ncmp = qb * 4 + 3 < 511 ? qb * 4 + 3 : 511;
    const int nblk = (ncmp + 63) >> 6;
    const unsigned long long cm = nblk >= 64 ? ~0ull : ((1ull << nblk) - 1ull);
    f32x16 O[2], Ot[2]; float lsum = 0.f;
    O[0] = f32x16{}; O[1] = f32x16{};
    nsa_pass<0>(lds, kcn, vcc, 64, cm, 0ull, qf, L, 1.f, lsum, O, impw);
    lsum += __shfl_xor(lsum, 32);
    const float invc = 1.0f / fmaxf(lsum, 1e-30f);
    float dummy = 0.f;
    nsa_pass<1>(lds, kcn, vcc, 64, cm, 0ull, qf, L, invc, dummy, O, impw);
    const float* gt = gates + tok * 24 + g * 12 + hh * 3;
    const float g0 = gt[0], g1 = gt[1], g2 = gt[2];
#pragma unroll
    for (int dt = 0; dt < 2; ++dt) Ot[dt] = O[dt] * g0;
    {
        const int ncausal = qb + 1;
        for (int qi = 0; qi < 8; ++qi) {
            unsigned long long lo, hi64;
            if (ncausal <= 16) { lo = (1ull << ncausal) - 1ull; hi64 = 0ull; }
            else {
                const int j0 = lane, j1 = lane + 64;
                const bool f0 = (j0 == 0) || (j0 == qb) || (j0 == qb - 1), f1 = (j1 == qb) || (j1 == qb - 1);
                const unsigned k0 = (j0 <= qb && !f0) ? (0x80000000u | (__float_as_uint(impw[qi * NL_IMP_STRIDE + j0]) & 0x7fffff80u) | (unsigned)j0) : 0u;
                const unsigned k1 = (j1 <= qb && !f1) ? (0x80000000u | (__float_as_uint(impw[qi * NL_IMP_STRIDE + j1]) & 0x7fffff80u) | (unsigned)j1) : 0u;
                const int needn = 13;
                unsigned th = 0u;
                for (int bit = 31; bit >= 0; --bit) { const unsigned cand = th | (1u << bit);
                    const int cnt = __popcll(__ballot(k0 >= cand)) + __popcll(__ballot(k1 >= cand));
                    if (cnt >= needn) th = cand; }
                lo = __ballot(f0 || (k0 >= th && k0 != 0u)); hi64 = __ballot(f1 || (k1 >= th && k1 != 0u));
            }
            if (lane == 0) { selm[(wid * 8 + qi) * 2] = lo; selm[(wid * 8 + qi) * 2 + 1] = hi64; }
        }
    }
    __syncthreads();
    unsigned long long ulo = selm[lane * 2], uhi = selm[lane * 2 + 1];
#pragma unroll
    for (int o = 1; o < 64; o <<= 1) { ulo |= __shfl_xor(ulo, o); uhi |= __shfl_xor(uhi, o); }
    L.mlo = selm[(wid * 8 + L.qi) * 2]; L.mhi = selm[(wid * 8 + L.qi) * 2 + 1];
    const bf16_t* kvb = kv + (size_t)b * SEQ * 768 + g * 64;
    O[0] = f32x16{}; O[1] = f32x16{}; lsum = 0.f;
    nsa_pass<2>(lds, kvb + 256, kvb + 384, 768, ulo, uhi, qf, L, 1.f, lsum, O, impw);
    lsum += __shfl_xor(lsum, 32);
    { const float sc = g1 / fmaxf(lsum, 1e-30f);
#pragma unroll
      for (int dt = 0; dt < 2; ++dt) Ot[dt] += O[dt] * sc; }
    {
        const int jlo = qb >= 8 ? qb - 8 : 0;
        unsigned long long wlo = 0ull, whi = 0ull;
        for (int jj = jlo; jj <= qb; ++jj) { if (jj < 64) wlo |= 1ull << jj; else whi |= 1ull << (jj - 64); }
        O[0] = f32x16{}; O[1] = f32x16{}; lsum = 0.f;
        nsa_pass<3>(lds, kvb + 512, kvb + 640, 768, wlo, whi, qf, L, 1.f, lsum, O, impw);
        lsum += __shfl_xor(lsum, 32);
        const float sc = g2 / fmaxf(lsum, 1e-30f);
#pragma unroll
        for (int dt = 0; dt < 2; ++dt) Ot[dt] += O[dt] * sc;
    }
    float ss = 0.f;
#pragma unroll
    for (int dt = 0; dt < 2; ++dt)
#pragma unroll
        for (int r = 0; r < 16; ++r) ss += Ot[dt][r] * Ot[dt][r];
    ss += __shfl_xor(ss, 32);
    const float rstd = rsqrtf(ss * (1.f / 64.f) + RMS_EPS);
#pragma unroll
    for (int dt = 0; dt < 2; ++dt)
#pragma unroll
        for (int r4 = 0; r4 < 4; ++r4) { const int d = 32 * dt + 8 * r4 + 4 * hi; const f32x4 w = *(const f32x4*)(P.attn_out_norm_w + head * 64 + d);
            u32x2 pk; pk.x = cvtpk(Ot[dt][4 * r4] * rstd * w.x, Ot[dt][4 * r4 + 1] * rstd * w.y); pk.y = cvtpk(Ot[dt][4 * r4 + 2] * rstd * w.z, Ot[dt][4 * r4 + 3] * rstd * w.w);
            *(u32x2*)(mix + tok * 1024 + head * 64 + d) = pk; }
    __syncthreads();
}


__device__ __forceinline__ void phase_cvt_small(const Params& P) {
    const int tid = threadIdx.x;
    {
        const int gt = blockIdx.x * NTHREADS + tid, NG = gridDim.x * NTHREADS;
        bf16_t* wo = (bf16_t*)(P.ws + WS_WOUT); bf16_t* wrs = (bf16_t*)(P.ws + WS_WRS); bf16_t* wsd = (bf16_t*)(P.ws + WS_WSD);
        for (int i = gt; i < 1024 * 128; i += NG) { const f32x4 a = *(const f32x4*)(P.w_out + (size_t)i * 8), b2 = *(const f32x4*)(P.w_out + (size_t)i * 8 + 4);
            *(u32x4*)(wo + (size_t)i * 8) = (u32x4){cvtpk(a.x, a.y), cvtpk(a.z, a.w), cvtpk(b2.x, b2.y), cvtpk(b2.z, b2.w)}; }
        for (int i = gt; i < 256 * 128; i += NG) { const f32x4 a = *(const f32x4*)(P.sh_wd + (size_t)i * 8), b2 = *(const f32x4*)(P.sh_wd + (size_t)i * 8 + 4);
            *(u32x4*)(wsd + (size_t)i * 8) = (u32x4){cvtpk(a.x, a.y), cvtpk(a.z, a.w), cvtpk(b2.x, b2.y), cvtpk(b2.z, b2.w)}; }
        for (int i = gt; i < 1024 * 96; i += NG) { const int k = i / 96, c8 = (i % 96) * 8;
            const float* s;
            if (c8 < 256) s = P.router_w + (size_t)k * 256 + c8;
            else { const int cc = c8 - 256, t = cc >> 8, u16 = (cc & 255) >> 4; s = ((u16 & 1) ? P.sh_wu : P.sh_wg) + (size_t)k * 256 + t * 128 + (u16 >> 1) * 16 + (cc & 8); }
            const f32x4 a = *(const f32x4*)s, b2 = *(const f32x4*)(s + 4);
            *(u32x4*)(wrs + (size_t)k * 768 + c8) = (u32x4){cvtpk(a.x, a.y), cvtpk(a.z, a.w), cvtpk(b2.x, b2.y), cvtpk(b2.z, b2.w)}; }
    }
}

__device__ __forceinline__ void route_token(const Params& P, int t, int lane) {
    const float* scores = (const float*)(P.ws + WS_SCORES) + (size_t)t * 256;
    const f32x4 s4 = *(const f32x4*)(scores + 4 * lane); const f32x4 b4 = *(const f32x4*)(P.router_bias + 4 * lane);
    float sc[4] = {s4.x, s4.y, s4.z, s4.w};
    float bs[4] = {s4.x + b4.x, s4.y + b4.y, s4.z + b4.z, s4.w + b4.w};
    float m1 = fmaxf(bs[0], bs[1]), m2 = fminf(bs[0], bs[1]);
    { const float v = bs[2]; const float n1 = fmaxf(m1, v); m2 = fmaxf(fminf(m1, v), m2); m1 = n1; }
    { const float v = bs[3]; const float n1 = fmaxf(m1, v); m2 = fmaxf(fminf(m1, v), m2); m1 = n1; }
#pragma unroll
    for (int o = 1; o < 8; o <<= 1) { const float o1 = __shfl_xor(m1, o), o2 = __shfl_xor(m2, o); const float n1 = fmaxf(m1, o1); m2 = fmaxf(fminf(m1, o1), fmaxf(m2, o2)); m1 = n1; }
    const float gs = m1 + m2;
    const int grp = lane >> 3;
    int rank = 0;
#pragma unroll
    for (int g2 = 0; g2 < 8; ++g2) { const float og = __shfl(gs, g2 * 8); rank += (og > gs || (og == gs && g2 < grp)) ? 1 : 0; }
    const bool gsel = rank < 4;
    float mv[4];
#pragma unroll
    for (int i = 0; i < 4; ++i) mv[i] = gsel ? bs[i] : -INFINITY;
    int myidx = -1; float myw = 0.f; float wsum = 0.f;
#pragma unroll 1
    for (int k = 0; k < 8; ++k) {
        float bv = mv[0]; int bi = 4 * lane;
#pragma unroll
        for (int i = 1; i < 4; ++i) if (mv[i] > bv) { bv = mv[i]; bi = 4 * lane + i; }
#pragma unroll
        for (int o = 1; o < 64; o <<= 1) { const float ov = __shfl_xor(bv, o); const int oi = __shfl_xor(bi, o); if (ov > bv || (ov == bv && oi < bi)) { bv = ov; bi = oi; } }
        const int wl = bi >> 2, wc = bi & 3;
        const float mine = wc == 0 ? sc[0] : (wc == 1 ? sc[1] : (wc == 2 ? sc[2] : sc[3]));
        const float wv = __shfl(mine, wl);
        wsum += wv;
        if (lane == k) { myidx = bi; myw = wv; }
        if (lane == wl) {
#pragma unroll
            for (int i = 0; i < 4; ++i) if (i == wc) mv[i] = -INFINITY; }
    }
    if (lane < 8) {
        int* cnt = (int*)(P.ws + WS_CTL + CTL_CNT);
        const int pos = atomicAdd(cnt + myidx, 1);
        if (pos < BCAP) ((int*)(P.ws + WS_BUCKET))[(size_t)myidx * BCAP + pos] = t * 8 + lane;
        ((float*)(P.ws + WS_RW))[(size_t)t * 8 + lane] = myw / wsum * 2.5f;
    }
}


__device__ __forceinline__ void phase_p4a(const Params& P, LAS unsigned char* lds) {
    typedef Gemm4 G;
    const int tid = opaque_tid(), lane = tid & 63, wid = tid >> 6, wm = wid >> 1, wn = wid & 1, fr = lane & 15, fq = lane >> 4;
    struct F { const Params& P;
        __device__ __forceinline__ void ptrs(int seg, const bf16_t* (&aptr)[2], const bf16_t* (&bptr)[2]) const {
            const int tid = opaque_tid(), lane = tid & 63, wid = tid >> 6, wm = wid >> 1, wn = wid & 1, fr = lane & 15, fq = lane >> 4, c8 = 8 * (tid & 31); (void)wm; (void)wn; (void)fr; (void)fq; (void)c8;
            const int u = blockIdx.x + seg * gridDim.x, rt = u >> 2, ct = u & 3;
            const bf16_t* mix = (const bf16_t*)(P.ws + WS_MIX); const bf16_t* wo = (const bf16_t*)(P.ws + WS_WOUT);
#pragma unroll
            for (int i = 0; i < 2; ++i) { aptr[i] = mix + (size_t)(rt * 256 + G::a_row(i, tid)) * 1024 + 8 * (tid & 3); bptr[i] = wo + (size_t)G::b_k(i, tid) * 1024 + ct * 256 + 8 * (tid & 31); } }
        __device__ __forceinline__ void epi(int seg, f32x4 (&acc)[4][8]) const {
            const int tid = opaque_tid(), lane = tid & 63, wid = tid >> 6, wm = wid >> 1, wn = wid & 1, fr = lane & 15, fq = lane >> 4, c8 = 8 * (tid & 31); (void)wm; (void)wn; (void)fr; (void)fq; (void)c8;
            const int u = blockIdx.x + seg * gridDim.x, rt = u >> 2, ct = u & 3, b = (rt * 256) / SEQ;
            const float* mod = (const float*)(P.ws + WS_MOD) + b * 6144; float* ssp = (float*)(P.ws + WS_SS);
#pragma unroll
            for (int mi = 0; mi < 4; ++mi) { const size_t m = (size_t)(rt * 256 + wm * 64 + mi * 16 + fr); float ss = 0.f;
#pragma unroll
                for (int ni = 0; ni < 8; ++ni) { const int col = ct * 256 + wn * 128 + ni * 16 + 4 * fq;
                    const f32x4 xv = *(const f32x4*)(P.x + m * 1024 + col), gv = *(const f32x4*)(mod + 2048 + col); const f32x4 a = acc[mi][ni];
                    f32x4 o; o.x = xv.x + gv.x * a.x; o.y = xv.y + gv.y * a.y; o.z = xv.z + gv.z * a.z; o.w = xv.w + gv.w * a.w;
                    *(f32x4*)(P.out + m * 1024 + col) = o; ss += (o.x * o.x + o.y * o.y) + (o.z * o.z + o.w * o.w); if (ni & 1) asm volatile("" ::: "memory"); }
                ss += __shfl_xor(ss, 16); ss += __shfl_xor(ss, 32);
                if (fq == 0) ssp[m * 8 + ct * 2 + wn] = ss; } }
    } f{P};
    const int nu = (128 * 4 - (int)blockIdx.x + (int)gridDim.x - 1) / (int)gridDim.x;
    if (nu > 0) G::run_stream(f, nu, 32, 32, (size_t)32 * 1024, lds);
}
__device__ __forceinline__ void phase_p4b(const Params& P) {
    const int lane = threadIdx.x & 63, gw = blockIdx.x * (NTHREADS / 64) + (threadIdx.x >> 6), NGW = gridDim.x * (NTHREADS / 64);
    const float* ssp = (const float*)(P.ws + WS_SS); bf16_t* h2 = (bf16_t*)(P.ws + WS_H);
    for (int m = gw; m < T; m += NGW) {
        const float* mod = (const float*)(P.ws + WS_MOD) + (m / SEQ) * 6144;
        const f32x4 s0 = *(const f32x4*)(ssp + (size_t)m * 8), s1 = *(const f32x4*)(ssp + (size_t)m * 8 + 4);
        const float rstd = rsqrtf(((s0.x + s0.y) + (s0.z + s0.w) + (s1.x + s1.y) + (s1.z + s1.w)) * (1.f / 1024.f) + RMS_EPS);
#pragma unroll
        for (int j = 0; j < 4; ++j) { const int col = (lane + 64 * j) * 4;
            const f32x4 v = *(const f32x4*)(P.out + (size_t)m * 1024 + col), wv = *(const f32x4*)(P.norm2_w + col), scv = *(const f32x4*)(mod + 4096 + col), shv = *(const f32x4*)(mod + 3072 + col);
            u32x2 pk; pk.x = cvtpk(v.x * rstd * wv.x * (1.f + scv.x) + shv.x, v.y * rstd * wv.y * (1.f + scv.y) + shv.y);
            pk.y = cvtpk(v.z * rstd * wv.z * (1.f + scv.z) + shv.z, v.w * rstd * wv.w * (1.f + scv.w) + shv.w);
            *(u32x2*)(h2 + (size_t)m * 1024 + col) = pk; }
    }
}
__device__ __forceinline__ void phase_p4c(const Params& P, LAS unsigned char* lds) {
    typedef Gemm4 G;
    const int tid = opaque_tid(), lane = tid & 63, wid = tid >> 6, wm = wid >> 1, wn = wid & 1, fr = lane & 15, fq = lane >> 4;
    struct F { const Params& P;
        __device__ __forceinline__ void ptrs(int seg, const bf16_t* (&aptr)[2], const bf16_t* (&bptr)[2]) const {
            const int tid = opaque_tid(), lane = tid & 63, wid = tid >> 6, wm = wid >> 1, wn = wid & 1, fr = lane & 15, fq = lane >> 4, c8 = 8 * (tid & 31); (void)wm; (void)wn; (void)fr; (void)fq; (void)c8;
            const int u = blockIdx.x + seg * gridDim.x, rt = u / 3, ct = u % 3;
            const bf16_t* h2 = (const bf16_t*)(P.ws + WS_H); const bf16_t* wrs = (const bf16_t*)(P.ws + WS_WRS);
#pragma unroll
            for (int i = 0; i < 2; ++i) { aptr[i] = h2 + (size_t)(rt * 256 + G::a_row(i, tid)) * 1024 + 8 * (tid & 3); bptr[i] = wrs + (size_t)G::b_k(i, tid) * 768 + ct * 256 + 8 * (tid & 31); } }
        __device__ __forceinline__ void epi(int seg, f32x4 (&acc)[4][8]) const {
            const int tid = opaque_tid(), lane = tid & 63, wid = tid >> 6, wm = wid >> 1, wn = wid & 1, fr = lane & 15, fq = lane >> 4, c8 = 8 * (tid & 31); (void)wm; (void)wn; (void)fr; (void)fq; (void)c8;
            const int u = blockIdx.x + seg * gridDim.x, rt = u / 3, ct = u % 3;
            float* scores = (float*)(P.ws + WS_SCORES); bf16_t* hidS = (bf16_t*)(P.ws + WS_HIDS);
#pragma unroll
            for (int mi = 0; mi < 4; ++mi) { const size_t m = (size_t)(rt * 256 + wm * 64 + mi * 16 + fr);
                if (ct == 0) {
#pragma unroll
                    for (int ni = 0; ni < 8; ++ni) { const f32x4 a = acc[mi][ni];
                        *(f32x4*)(scores + m * 256 + wn * 128 + ni * 16 + 4 * fq) = (f32x4){sigmoidf_(a.x), sigmoidf_(a.y), sigmoidf_(a.z), sigmoidf_(a.w)}; }
                } else {
#pragma unroll
                    for (int j = 0; j < 4; ++j) { const f32x4 g = acc[mi][2 * j], uu = acc[mi][2 * j + 1];
                        u32x2 pk; pk.x = cvtpk(siluf_(g.x) * uu.x, siluf_(g.y) * uu.y); pk.y = cvtpk(siluf_(g.z) * uu.z, siluf_(g.w) * uu.w);
                        *(u32x2*)(hidS + m * 256 + (ct - 1) * 128 + wn * 64 + j * 16 + 4 * fq) = pk; }
                } } }
    } f{P};
    const int nu = (128 * 3 - (int)blockIdx.x + (int)gridDim.x - 1) / (int)gridDim.x;
    if (nu > 0) G::run_stream(f, nu, 32, 32, (size_t)32 * 768, lds);
}
__device__ __forceinline__ void phase_route(const Params& P) {
    const int tid = opaque_tid(), lane = tid & 63, gw = blockIdx.x * (NTHREADS / 64) + (tid >> 6), NGW = gridDim.x * (NTHREADS / 64);
    for (int t = gw; t < T; t += NGW) route_token(P, t, lane);
}
__device__ __forceinline__ void phase_p4d(const Params& P, LAS unsigned char* lds) {
    typedef Gemm4 G;
    const int tid = opaque_tid(), lane = tid & 63, wid = tid >> 6, wm = wid >> 1, wn = wid & 1, fr = lane & 15, fq = lane >> 4;
    struct F { const Params& P;
        __device__ __forceinline__ void ptrs(int seg, const bf16_t* (&aptr)[2], const bf16_t* (&bptr)[2]) const {
            const int tid = opaque_tid(), lane = tid & 63, wid = tid >> 6, wm = wid >> 1, wn = wid & 1, fr = lane & 15, fq = lane >> 4, c8 = 8 * (tid & 31); (void)wm; (void)wn; (void)fr; (void)fq; (void)c8;
            const int u = blockIdx.x + seg * gridDim.x, rt = u >> 2, ct = u & 3;
            const bf16_t* hidS = (const bf16_t*)(P.ws + WS_HIDS); const bf16_t* wsd = (const bf16_t*)(P.ws + WS_WSD);
#pragma unroll
            for (int i = 0; i < 2; ++i) { aptr[i] = hidS + (size_t)(rt * 256 + G::a_row(i, tid)) * 256 + 8 * (tid & 3); bptr[i] = wsd + (size_t)G::b_k(i, tid) * 1024 + ct * 256 + 8 * (tid & 31); } }
        __device__ __forceinline__ void epi(int seg, f32x4 (&acc)[4][8]) const {
            const int tid = opaque_tid(), lane = tid & 63, wid = tid >> 6, wm = wid >> 1, wn = wid & 1, fr = lane & 15, fq = lane >> 4, c8 = 8 * (tid & 31); (void)wm; (void)wn; (void)fr; (void)fq; (void)c8;
            const int u = blockIdx.x + seg * gridDim.x, rt = u >> 2, ct = u & 3;
            bf16_t* ysh = (bf16_t*)(P.ws + WS_YSH);
#pragma unroll
            for (int mi = 0; mi < 4; ++mi) { const size_t m = (size_t)(rt * 256 + wm * 64 + mi * 16 + fr);
#pragma unroll
                for (int ni = 0; ni < 8; ++ni) { const int col = ct * 256 + wn * 128 + ni * 16 + 4 * fq; const f32x4 a = acc[mi][ni];
                    u32x2 pk; pk.x = cvtpk(a.x, a.y); pk.y = cvtpk(a.z, a.w); *(u32x2*)(ysh + m * 1024 + col) = pk; } } }
    } f{P};
    const int nu = (128 * 4 - (int)blockIdx.x + (int)gridDim.x - 1) / (int)gridDim.x;
    if (nu > 0) G::run_stream(f, nu, 8, 32, (size_t)32 * 1024, lds);
}

__device__ __forceinline__ void phase_expert_cvt(const Params& P) {
    const size_t gt = (size_t)blockIdx.x * NTHREADS + threadIdx.x, NG = (size_t)gridDim.x * NTHREADS;
    bf16_t* wgu = (bf16_t*)(P.ws + WS_WBGU); bf16_t* wd = (bf16_t*)(P.ws + WS_WBD);
    for (size_t i = gt; i < (size_t)256 * 1024 * 64; i += NG) {
        const size_t ek = i >> 6; const int c8 = (int)(i & 63) * 8, t = c8 >> 8, u16 = (c8 & 255) >> 4;
        const float* s = ((u16 & 1) ? P.exp_wu : P.exp_wg) + ek * 256 + t * 128 + (u16 >> 1) * 16 + (c8 & 8);
        const f32x4 a = __builtin_nontemporal_load((const f32x4*)s), b2 = __builtin_nontemporal_load((const f32x4*)(s + 4));
        *(u32x4*)(wgu + ek * 512 + c8) = (u32x4){cvtpk(a.x, a.y), cvtpk(a.z, a.w), cvtpk(b2.x, b2.y), cvtpk(b2.z, b2.w)}; }
    for (size_t i = gt; i < (size_t)256 * 256 * 128; i += NG) {
        const f32x4 a = __builtin_nontemporal_load((const f32x4*)(P.exp_wd + i * 8)), b2 = __builtin_nontemporal_load((const f32x4*)(P.exp_wd + i * 8 + 4));
        *(u32x4*)(wd + i * 8) = (u32x4){cvtpk(a.x, a.y), cvtpk(a.z, a.w), cvtpk(b2.x, b2.y), cvtpk(b2.z, b2.w)}; }
}

constexpr int P6_TILES = 64 * 1024, P6_PRE = P6_TILES + 1024, P6_PAIR = P6_PRE + 1040, P6_W = P6_PAIR + 1024;
__device__ __forceinline__ void phase_experts(const Params& P, LAS unsigned char* lds) {
    typedef Gemm4 G;
    const int tid = opaque_tid(), lane = tid & 63, wid = tid >> 6, wm = wid >> 1, wn = wid & 1, fr = lane & 15, fq = lane >> 4;
    const int* cnt = (const int*)(P.ws + WS_CTL + CTL_CNT); const int* bucket = (const int*)(P.ws + WS_BUCKET); const float* rw = (const float*)(P.ws + WS_RW);
    const bf16_t* h2 = (const bf16_t*)(P.ws + WS_H); bf16_t* hidR = (bf16_t*)(P.ws + WS_HIDR) + (size_t)blockIdx.x * 256 * 256; unsigned char* y = (unsigned char*)(P.ws + WS_Y);
    LAS int* tiles = (LAS int*)(lds + P6_TILES); LAS int* pre = (LAS int*)(lds + P6_PRE); LAS int* pairs = (LAS int*)(lds + P6_PAIR); LAS float* wts = (LAS float*)(lds + P6_W);
    const int nx = (gridDim.x % 8 == 0) ? 8 : 1, xl = blockIdx.x % nx, li = blockIdx.x / nx, nloc = gridDim.x / nx, nek = 256 / nx;
    if (tid < nek) { const int c_ = cnt[xl + nx * tid]; tiles[tid] = ((c_ < BCAP ? c_ : BCAP) + 255) >> 8; }
    __syncthreads();
    if (tid < nek) { int s = 0; for (int i = 0; i < tid; ++i) s += tiles[i]; pre[tid] = s; if (tid == nek - 1) pre[nek] = s + tiles[nek - 1]; }
    __syncthreads();
    const int total = pre[nek];
    const int c8 = 8 * (tid & 31), u16 = c8 >> 4;
    for (int u = li; u < total; u += nloc) {
        int lo = 0, hi = nek - 1;
        while (lo < hi) { const int mid = (lo + hi + 1) >> 1; if (pre[mid] <= u) lo = mid; else hi = mid - 1; }
        const int e = xl + nx * lo, tile = u - pre[lo], n = cnt[e] < BCAP ? cnt[e] : BCAP, rows = (n - tile * 256) < 256 ? (n - tile * 256) : 256;
        if (tid < 256) { const int r = tid < rows ? tid : 0; const int pr = bucket[(size_t)e * BCAP + tile * 256 + r]; pairs[tid] = pr; wts[tid] = tid < rows ? rw[pr] : 0.f; }
        __syncthreads();
        {
            struct GU { const bf16_t* h2; LAS int* pairs; const bf16_t* wgu; bf16_t* hidR;
                __device__ __forceinline__ void ptrs(int t, const bf16_t* (&aptr)[2], const bf16_t* (&bptr)[2]) const {
                    const int tid = opaque_tid(), lane = tid & 63, wid = tid >> 6, wm = wid >> 1, wn = wid & 1, fr = lane & 15, fq = lane >> 4, c8 = 8 * (tid & 31); (void)wm; (void)wn; (void)fr; (void)fq; (void)c8;
#pragma unroll
                    for (int i = 0; i < 2; ++i) { aptr[i] = h2 + (size_t)(pairs[G::a_row(i, tid)] >> 3) * 1024 + 8 * (tid & 3);
                        bptr[i] = wgu + (size_t)G::b_k(i, tid) * 512 + t * 256 + c8; } }
                __device__ __forceinline__ void epi(int t, f32x4 (&acc)[4][8]) const {
                    const int tid = opaque_tid(), lane = tid & 63, wid = tid >> 6, wm = wid >> 1, wn = wid & 1, fr = lane & 15, fq = lane >> 4, c8 = 8 * (tid & 31); (void)wm; (void)wn; (void)fr; (void)fq; (void)c8;
#pragma unroll
                    for (int mi = 0; mi < 4; ++mi) { const int rl = wm * 64 + mi * 16 + fr;
#pragma unroll
                        for (int j = 0; j < 4; ++j) { const f32x4 g = acc[mi][2 * j], uu = acc[mi][2 * j + 1];
                            u32x2 pk; pk.x = cvtpk(siluf_(g.x) * uu.x, siluf_(g.y) * uu.y); pk.y = cvtpk(siluf_(g.z) * uu.z, siluf_(g.w) * uu.w);
                            *(u32x2*)(hidR + rl * 256 + t * 128 + wn * 64 + j * 16 + 4 * fq) = pk; } } }
            } f{h2, pairs, (const bf16_t*)(P.ws + WS_WBGU) + (size_t)e * 1024 * 512, hidR};
            G::run_stream(f, 2, 32, 32, (size_t)32 * 512, lds);
        }
        __syncthreads();
        {
            struct DN { bf16_t* hidR; const bf16_t* wd; unsigned char* y; LAS int* pairs; LAS float* wts; int rows;
                __device__ __forceinline__ void ptrs(int ct, const bf16_t* (&aptr)[2], const bf16_t* (&bptr)[2]) const {
                    const int tid = opaque_tid(), lane = tid & 63, wid = tid >> 6, wm = wid >> 1, wn = wid & 1, fr = lane & 15, fq = lane >> 4, c8 = 8 * (tid & 31); (void)wm; (void)wn; (void)fr; (void)fq; (void)c8;
#pragma unroll
                    for (int i = 0; i < 2; ++i) { aptr[i] = hidR + (size_t)G::a_row(i, tid) * 256 + 8 * (tid & 3); bptr[i] = wd + (size_t)G::b_k(i, tid) * 1024 + ct * 256 + c8; } }
                __device__ __forceinline__ void epi(int ct, f32x4 (&acc)[4][8]) const {
                    const int tid = opaque_tid(), lane = tid & 63, wid = tid >> 6, wm = wid >> 1, wn = wid & 1, fr = lane & 15, fq = lane >> 4, c8 = 8 * (tid & 31); (void)wm; (void)wn; (void)fr; (void)fq; (void)c8;
#pragma unroll
                    for (int mi = 0; mi < 4; ++mi) { const int rl = wm * 64 + mi * 16 + fr; const float wgt = wts[rl]; const size_t pr = (size_t)pairs[rl];
                        if (rl < rows) {
#pragma unroll
                            for (int ni = 0; ni < 8; ++ni) { const int col = ct * 256 + wn * 128 + ni * 16 + 4 * fq; const f32x4 a = acc[mi][ni] * (wgt * Y_SCALE);
                                int pk = __builtin_amdgcn_cvt_pk_fp8_f32(a.x, a.y, 0, false); pk = __builtin_amdgcn_cvt_pk_fp8_f32(a.z, a.w, pk, true); *(int*)(y + pr * 1024 + col) = pk; } } } }
            } f{hidR, (const bf16_t*)(P.ws + WS_WBD) + (size_t)e * 256 * 1024, y, pairs, wts, rows};
            G::run_stream(f, 4, 8, 32, (size_t)32 * 1024, lds);
        }
        __syncthreads();
    }
}

__device__ __forceinline__ void phase_combine(const Params& P) {
    const int lane = threadIdx.x & 63, gw = blockIdx.x * (NTHREADS / 64) + (threadIdx.x >> 6), NGW = gridDim.x * (NTHREADS / 64);
    const unsigned char* y = (const unsigned char*)(P.ws + WS_Y);
    typedef float f32x2_ __attribute__((ext_vector_type(2)));
    for (int m = gw; m < T; m += NGW) {
        const float* mod = (const float*)(P.ws + WS_MOD) + (m / SEQ) * 6144 + 5120;
#pragma unroll
        for (int j = 0; j < 2; ++j) { const int col = (lane + 64 * j) * 8;
            f32x4 s0 = (f32x4){0.f, 0.f, 0.f, 0.f}, s1 = s0;
#pragma unroll
            for (int sl = 0; sl < 8; ++sl) { const u32x2 v = *(const u32x2*)(y + ((size_t)m * 8 + sl) * 1024 + col);
                const f32x2_ a = __builtin_amdgcn_cvt_pk_f32_fp8((int)v.x, false), b = __builtin_amdgcn_cvt_pk_f32_fp8((int)v.x, true);
                const f32x2_ c = __builtin_amdgcn_cvt_pk_f32_fp8((int)v.y, false), d = __builtin_amdgcn_cvt_pk_f32_fp8((int)v.y, true);
                s0.x += a.x; s0.y += a.y; s0.z += b.x; s0.w += b.y; s1.x += c.x; s1.y += c.y; s1.z += d.x; s1.w += d.y; }
            const f32x4 g0 = *(const f32x4*)(mod + col), g1 = *(const f32x4*)(mod + col + 4);
            f32x4 o0 = *(const f32x4*)(P.out + (size_t)m * 1024 + col), o1 = *(const f32x4*)(P.out + (size_t)m * 1024 + col + 4);
            const u32x4 sh = *(const u32x4*)((const bf16_t*)(P.ws + WS_YSH) + (size_t)m * 1024 + col);
            const f32x4 h0 = (f32x4){__uint_as_float(sh.x << 16), __uint_as_float(sh.x & 0xffff0000u), __uint_as_float(sh.y << 16), __uint_as_float(sh.y & 0xffff0000u)};
            const f32x4 h1 = (f32x4){__uint_as_float(sh.z << 16), __uint_as_float(sh.z & 0xffff0000u), __uint_as_float(sh.w << 16), __uint_as_float(sh.w & 0xffff0000u)};
            o0 += g0 * (s0 * Y_INV + h0); o1 += g1 * (s1 * Y_INV + h1);
            *(f32x4*)(P.out + (size_t)m * 1024 + col) = o0; *(f32x4*)(P.out + (size_t)m * 1024 + col + 4) = o1; }
    }
}


__device__ __forceinline__ int queue_pull(unsigned* head, volatile LAS unsigned* slot) {
    if (threadIdx.x == 0) *slot = atomicAdd(head, 1u);
    __syncthreads();
    const int v = (int)*slot;
    __syncthreads();
    return v;
}
__device__ __forceinline__ void phase_cmp_h1(const Params& P, LAS unsigned char* lds, volatile LAS unsigned* slot) {
    unsigned* head = (unsigned*)(P.ws + WS_CTL + CTL_Q2);
    for (;;) {
        const int u = queue_pull(head, slot);
        if (u >= 64 + 512) break;
        if (u < 64) compress_unit(P, lds, u); else hgrn_unit<0>(P, lds, u - 64);
    }
}
__device__ __forceinline__ void phase_h23_nsa(const Params& P, LAS unsigned char* lds, volatile LAS unsigned* slot) {
    unsigned* head = (unsigned*)(P.ws + WS_CTL + CTL_Q3);
    for (;;) {
        const int n = queue_pull(head, slot);
        if (n >= 1536) break;
        if (n < 512) nsa_unit(P, lds, (n & 7) * 128 + (127 - (n >> 3)));
        else if (n < 1024) { const int m = n - 512; hgrn_unit<1>(P, lds, (m & 15) * 32 + (31 - (m >> 4))); }
        else { const int m = n - 1024; nsa_unit(P, lds, (m & 7) * 128 + (63 - (m >> 3))); }
    }
}

constexpr int LDS_BYTES = 144 * 1024;
__global__ void __launch_bounds__(NTHREADS) mega(Params P) {
    extern __shared__ __attribute__((aligned(16))) unsigned char smem[];
    LAS unsigned char* lds = (LAS unsigned char*)smem;
    volatile LAS unsigned* xst = (volatile LAS unsigned*)(lds + LDS_BYTES - 16);
    if (threadIdx.x < 4) xst[threadIdx.x] = 0u;
    __syncthreads();
    XcdBarrier xb = xcd_barrier_post((unsigned*)(P.ws + WS_CTL + CTL_BAR), xst);
    phase_mod(P, lds);
    xcd_barrier(xb);
    { const float* mod = (const float*)(P.ws + WS_MOD); norm_mod_rows(P.x, P.norm1_w, mod, mod + 1024, (bf16_t*)(P.ws + WS_H), H1S); }
    xcd_barrier(xb);
    phase_inproj(P, lds);
    xcd_barrier(xb);
    phase_cmp_h1(P, lds, xst + 2);
    xcd_barrier(xb);
    phase_h23_nsa(P, lds, xst + 2);
    phase_cvt_small(P);
    xcd_barrier(xb);
    phase_p4a(P, lds);
    xcd_barrier(xb);
    phase_p4b(P);
    xcd_barrier(xb);
    phase_p4c(P, lds);
    xcd_barrier(xb);
    phase_route(P);
    phase_p4d(P, lds);
    xcd_barrier(xb);
    phase_expert_cvt(P);
    xcd_barrier(xb);
    phase_experts(P, lds);
    xcd_barrier(xb);
    phase_combine(P);
}

extern "C" void kernel_launch(void* const* d_in, const int* in_sizes, int n_in, void* d_out, int out_size, void* d_ws, size_t ws_size, hipStream_t stream) {
    static int grid = 0;
    if (grid == 0) {
        if (n_in != 25 || ws_size < WS_END) { fprintf(stderr, "kernel_launch: unexpected n_in %d or ws_size %zu (need %zu)\n", n_in, ws_size, (size_t)WS_END); grid = -1; return; }
        int dev = 0, cus = 0, per_cu = 0;
        (void)hipGetDevice(&dev); (void)hipDeviceGetAttribute(&cus, hipDeviceAttributeMultiprocessorCount, dev);
        (void)hipFuncSetAttribute((const void*)mega, hipFuncAttributeMaxDynamicSharedMemorySize, LDS_BYTES);
        (void)hipOccupancyMaxActiveBlocksPerMultiprocessor(&per_cu, (const void*)mega, NTHREADS, LDS_BYTES);
        if (per_cu < 1) { fprintf(stderr, "kernel_launch: occupancy query says %d blocks per CU\n", per_cu); grid = -1; return; }
        grid = cus;
    }
    if (grid < 0) return;
    (void)hipMemsetAsync((char*)d_ws + WS_CTL, 0, 64 * 1024, stream);
    Params p{};
    const float** pf = (const float**)&p;
    for (int i = 0; i < 25; ++i) pf[i] = (const float*)d_in[i];
    p.out = (float*)d_out; p.ws = (unsigned char*)d_ws;
    void* args[] = {&p};
    hipError_t e = hipLaunchCooperativeKernel((const void*)mega, dim3(grid), dim3(NTHREADS), args, LDS_BYTES, stream);
    if (e != hipSuccess) fprintf(stderr, "cooperative launch failed: %s (grid %d)\n", hipGetErrorString(e), grid);
}

#ifdef PHASE_TEST
__global__ void __launch_bounds__(NTHREADS) t_p4a(Params P) { extern __shared__ __attribute__((aligned(16))) unsigned char smem[]; phase_p4a(P, (LAS unsigned char*)smem); }
__global__ void __launch_bounds__(NTHREADS) t_p4d(Params P) { extern __shared__ __attribute__((aligned(16))) unsigned char smem[]; phase_p4d(P, (LAS unsigned char*)smem); }
__global__ void __launch_bounds__(NTHREADS) t_p4(Params P) { extern __shared__ __attribute__((aligned(16))) unsigned char smem[]; phase_p4c(P, (LAS unsigned char*)smem); }
__global__ void __launch_bounds__(NTHREADS) t_p6(Params P) { extern __shared__ __attribute__((aligned(16))) unsigned char smem[]; phase_experts(P, (LAS unsigned char*)smem); }
__global__ void __launch_bounds__(NTHREADS) t_nsa(Params P) { extern __shared__ __attribute__((aligned(16))) unsigned char smem[]; nsa_unit(P, (LAS unsigned char*)smem, blockIdx.x); }
__global__ void __launch_bounds__(NTHREADS) t_mod(Params P) { extern __shared__ __attribute__((aligned(16))) unsigned char smem[]; phase_mod(P, (LAS unsigned char*)smem); }
__global__ void __launch_bounds__(NTHREADS) t_inproj(Params P) { extern __shared__ __attribute__((aligned(16))) unsigned char smem[]; phase_inproj(P, (LAS unsigned char*)smem); }
__global__ void __launch_bounds__(NTHREADS) t_cmp(Params P) { extern __shared__ __attribute__((aligned(16))) unsigned char smem[]; compress_unit(P, (LAS unsigned char*)smem, blockIdx.x); }
__global__ void __launch_bounds__(NTHREADS) t_h0(Params P) { extern __shared__ __attribute__((aligned(16))) unsigned char smem[]; hgrn_unit<0>(P, (LAS unsigned char*)smem, blockIdx.x); }
__global__ void __launch_bounds__(NTHREADS) t_h1(Params P) { extern __shared__ __attribute__((aligned(16))) unsigned char smem[]; hgrn_unit<1>(P, (LAS unsigned char*)smem, blockIdx.x); }
#endif
```

```cpp
#include <hip/hip_runtime.h>
#include <hip/hip_cooperative_groups.h>
#include <cstdio>
#include <cstdint>
#include <type_traits>
namespace cg = cooperative_groups;

#define LAS __attribute__((address_space(3)))
typedef unsigned short bf16_t;
typedef short bf16x8 __attribute__((ext_vector_type(8)));
typedef short s16x4 __attribute__((ext_vector_type(4)));
typedef float f32x4 __attribute__((ext_vector_type(4)));
typedef float f32x16 __attribute__((ext_vector_type(16)));
typedef unsigned u32x4 __attribute__((ext_vector_type(4)));
typedef unsigned u32x2 __attribute__((ext_vector_type(2)));

constexpr int D = 1024, BATCH = 4, SEQ = 8192, T = BATCH * SEQ;
constexpr int IN_COLS = 3352;
constexpr int NTHREADS = 512;
constexpr int H1S = 1088;
constexpr float RMS_EPS = 1e-6f;
constexpr float LOG2E = 1.4426950408889634f;
constexpr float Y_SCALE = 16.0f, Y_INV = 1.0f / 16.0f;

constexpr size_t MB = 1024ull * 1024ull;
constexpr size_t WS_CTL    = 0;
constexpr size_t WS_MOD    = 64 * 1024;
constexpr size_t WS_LB     = WS_MOD + 4 * 6144 * 4;
constexpr size_t WS_CB     = WS_LB + 2048;
constexpr size_t WS_H      = 1 * MB;
constexpr size_t WS_SS     = WS_H + 72 * MB;
constexpr size_t WS_RW     = WS_SS + 1 * MB;
constexpr size_t WS_BUCKET = WS_RW + 1 * MB;
constexpr size_t WS_HIDR   = WS_BUCKET + 16 * MB;
constexpr size_t WS_WSM    = WS_HIDR + 32 * MB;
constexpr size_t WS_WOUT   = WS_WSM, WS_WRS = WS_WSM + 2 * MB, WS_WSD = WS_WSM + 4 * MB;
constexpr size_t WS_WBE    = WS_WSM + 5 * MB;
constexpr size_t WS_WBGU   = WS_WBE, WS_WBD = WS_WBE + 256 * MB;
constexpr size_t WS_SCORES = WS_WBE;
constexpr size_t WS_HIDS   = WS_SCORES + 32 * MB;
constexpr size_t WS_WIN    = WS_HIDS + 16 * MB;
constexpr size_t WS_Y      = WS_WBE + 384 * MB;
constexpr size_t WS_Q      = WS_Y;
constexpr size_t WS_KV     = WS_Q + 32 * MB;
constexpr size_t WS_GATES  = WS_KV + 48 * MB;
constexpr size_t WS_HQ     = WS_GATES + 4 * MB;
constexpr size_t WS_LOGF   = WS_HQ + 32 * MB;
constexpr size_t WS_HV     = WS_LOGF + 64 * MB;
constexpr size_t WS_HG     = WS_HV + 32 * MB;
constexpr size_t WS_CMPH   = WS_HG + 32 * MB;
constexpr size_t WS_KC     = WS_CMPH + 4 * MB;
constexpr size_t WS_VC     = WS_KC + 1 * MB;
constexpr size_t WS_HL     = WS_VC + 1 * MB;
constexpr size_t WS_HD     = WS_HL + 32 * MB;
constexpr size_t WS_MIX    = WS_HD + 1 * MB;
constexpr size_t WS_YSH    = WS_Y + 384 * MB;
constexpr size_t WS_END    = WS_YSH + 64 * MB;
constexpr int BCAP = 16384;
constexpr int CTL_CNT = 1024;
constexpr int CTL_Q2 = 2048, CTL_Q3 = 2112;
constexpr int CTL_BAR = 16384;

struct Params {
    const float *x, *c, *ada_w, *ada_b, *norm1_w, *norm2_w, *w_in, *q_norm_w, *k_norm_w, *cmp_pos, *cmp_w1, *cmp_b1, *cmp_w2,
        *attn_out_norm_w, *hgrn_lb, *rec_out_norm_w, *w_out, *router_w, *router_bias, *exp_wg, *exp_wu, *exp_wd, *sh_wg, *sh_wu, *sh_wd;
    float* out;
    unsigned char* ws;
};

typedef __bf16 bf16x2_t __attribute__((ext_vector_type(2)));
__device__ __forceinline__ unsigned cvtpk(float lo, float hi) { bf16x2_t v; v.x = (__bf16)lo; v.y = (__bf16)hi; return __builtin_bit_cast(unsigned, v); }
__device__ __forceinline__ int opaque_tid() { int t = threadIdx.x; asm volatile("" : "+v"(t)); return t; }
__device__ __forceinline__ float bf2f(bf16_t v) { return __uint_as_float(((unsigned)v) << 16); }
__device__ __forceinline__ float sigmoidf_(float v) { return __builtin_amdgcn_rcpf(1.0f + __expf(-v)); }
__device__ __forceinline__ float siluf_(float v) { return v * __builtin_amdgcn_rcpf(1.0f + __expf(-v)); }
__device__ __forceinline__ float wave_sum(float v) {
#pragma unroll
    for (int o = 1; o < 64; o <<= 1) v += __shfl_xor(v, o);
    return v;
}
__device__ __forceinline__ s16x4 lds_tr(const LAS unsigned char* p) {
    return __builtin_bit_cast(s16x4, __builtin_amdgcn_ds_read_tr16_b64_v4i16((LAS s16x4*)p));
}

#define XB_TMO      128
#define XB_XCNT(j)  (256  + 64 * (j))
#define XB_XSUB(j)  (1280 + 64 * (j))
#define XB_XGEN(j)  (2304 + 64 * (j))
#define XB_TOP      3328
#define XB_TOPGEN   3392
#define XCD_BAR_WORDS 3456
#define XB_SPIN_CAP (1u << 22)
__device__ __forceinline__ unsigned xb_ld(unsigned* p)              { return __hip_atomic_load(p, __ATOMIC_RELAXED, __HIP_MEMORY_SCOPE_AGENT); }
__device__ __forceinline__ unsigned xb_add(unsigned* p, unsigned v) { return __hip_atomic_fetch_add(p, v, __ATOMIC_RELAXED, __HIP_MEMORY_SCOPE_AGENT); }
__device__ __forceinline__ unsigned xb_xcc_id() { return (unsigned)__builtin_amdgcn_s_getreg((3 << 11) | 20) & 0xFu; }
#define XB_SPIN(cond, bar) do { unsigned _sp = 0; while (cond) { __builtin_amdgcn_s_sleep(1); \
    if ((++_sp & 255u) == 0u) { if (xb_ld(&(bar)[XB_TMO])) break; if (_sp > XB_SPIN_CAP) { atomicAdd(&(bar)[XB_TMO], 1u); break; } } } } while (0)
struct XcdBarrier { unsigned* bar; unsigned x; volatile LAS unsigned* st; };
__device__ __forceinline__ XcdBarrier xcd_barrier_post(unsigned* bar, volatile LAS unsigned* st) {
    XcdBarrier b; b.bar = bar; b.x = xb_xcc_id(); b.st = st;
    if (threadIdx.x == 0) (void)xb_add(&bar[XB_XCNT(b.x)], 1u);
    return b;
}
__device__ __forceinline__ void xcd_barrier_complete(unsigned* bar, unsigned x, unsigned& nloc, unsigned& nx) {
    const unsigned G = gridDim.x * gridDim.y * gridDim.z;
    unsigned sum, cnt, mine, sp = 0u;
    for (;;) {
        sum = 0u; cnt = 0u; mine = 0u;
#pragma unroll
        for (unsigned j = 0; j < 16; ++j) { const unsigned c = xb_ld(&bar[XB_XCNT(j)]); sum += c; cnt += (c > 0u) ? 1u : 0u; mine = (j == x) ? c : mine; }
        if (sum == G) break;
        __builtin_amdgcn_s_sleep(1);
        if ((++sp & 255u) == 0u) { if (xb_ld(&bar[XB_TMO])) break; if (sp > XB_SPIN_CAP) { atomicAdd(&bar[XB_TMO], 1u); break; } }
    }
    nloc = mine > 0u ? mine : 1u; nx = cnt > 0u ? cnt : 1u;
}
__device__ __forceinline__ void xcd_barrier(const XcdBarrier& b) {
    asm volatile("s_waitcnt vmcnt(0)" ::: "memory");
    __syncthreads();
    if (threadIdx.x == 0) {
        unsigned* bar = b.bar;
        __builtin_amdgcn_s_waitcnt(0);
        unsigned nloc = b.st[0], nx = b.st[1];
        if (nloc == 0u) { xcd_barrier_complete(bar, b.x, nloc, nx); b.st[0] = nloc; b.st[1] = nx; }
        const unsigned old = xb_add(&bar[XB_XSUB(b.x)], 1u);
        const unsigned gen = old / nloc;
        if (old + 1u == (gen + 1u) * nloc) {
            __builtin_amdgcn_fence(__ATOMIC_RELEASE, "agent");
            asm volatile("s_waitcnt vmcnt(0)" ::: "memory");
            const unsigned og = xb_add(&bar[XB_TOP], 1u);
            const unsigned tg = og / nx;
            if (og + 1u == (tg + 1u) * nx) xb_add(&bar[XB_TOPGEN], 1u);
            else XB_SPIN(xb_ld(&bar[XB_TOPGEN]) == tg, bar);
            __builtin_amdgcn_fence(__ATOMIC_ACQUIRE, "agent");
            xb_add(&bar[XB_XGEN(b.x)], 1u);
            asm volatile("s_waitcnt vmcnt(0)" ::: "memory");
        } else {
            XB_SPIN(xb_ld(&bar[XB_XGEN(b.x)]) == gen, bar);
            __builtin_amdgcn_fence(__ATOMIC_ACQUIRE, "agent");
            asm volatile("s_waitcnt vmcnt(0)" ::: "memory");
        }
    }
    __syncthreads();
}

template <int WM, int WN> struct GemmT {
    static constexpr int BM = 64 * WM, BN = 64 * WN;
    static constexpr int A_BYTES = BM * 128, B_BYTES = 64 * BN * 2, STAGE = A_BYTES + B_BYTES, LDS_BYTES = 2 * STAGE;
    static constexpr int NB4 = BN / 32;
    static constexpr int B_ROW4 = BN / 4;

    static __device__ __forceinline__ void run(f32x4 (&acc)[4][4], const bf16_t* const (&arow)[WM], int a_kstride, const float* Bp, int ldb, int KT, LAS unsigned char* lds) {
        const int tid = opaque_tid(), lane = tid & 63, wid = tid >> 6, wm = wid / WN, wn = wid % WN, fr = lane & 15, fq = lane >> 4;
#pragma unroll
        for (int mi = 0; mi < 4; ++mi)
#pragma unroll
            for (int ni = 0; ni < 4; ++ni) acc[mi][ni] = (f32x4){0.f, 0.f, 0.f, 0.f};
        const int achunk = tid & 7;
        u32x4 areg[WM]; f32x4 breg[NB4];
        int a_wr[WM];
#pragma unroll
        for (int p = 0; p < WM; ++p) { const int row = p * 64 + (tid >> 3); a_wr[p] = row * 128 + ((achunk ^ ((row >> 1) & 7)) << 4); }
        int b_wr[NB4]; int b_goff[NB4];
#pragma unroll
        for (int p = 0; p < NB4; ++p) { const int i = tid + NTHREADS * p, k = i / B_ROW4, n = (i % B_ROW4) * 4;
            const int f = (k & 3) | (((k >> 3) & 1) << 2);
            b_wr[p] = A_BYTES + k * (BN * 2) + (((n >> 4) ^ f) << 5) + ((n & 15) << 1); b_goff[p] = k * ldb + n; }
        int a_rd[4][2];
#pragma unroll
        for (int mi = 0; mi < 4; ++mi)
#pragma unroll
            for (int ks = 0; ks < 2; ++ks) { const int row = wm * 64 + mi * 16 + fr, ch = ks * 4 + fq; a_rd[mi][ks] = row * 128 + ((ch ^ ((row >> 1) & 7)) << 4); }
        int b_rd[2][2];
        int b_f[2][2];
#pragma unroll
        for (int ks = 0; ks < 2; ++ks)
#pragma unroll
            for (int t = 0; t < 2; ++t) { const int k = ks * 32 + 8 * fq + 4 * t + (fr >> 2); b_f[ks][t] = (k & 3) | (((k >> 3) & 1) << 2);
                b_rd[ks][t] = A_BYTES + k * (BN * 2) + ((fr & 3) << 3); }

        auto gload = [&](int kt) {
#pragma unroll
            for (int p = 0; p < WM; ++p) areg[p] = *(const u32x4*)(arow[p] + (size_t)kt * a_kstride + achunk * 8);
            const float* bk = Bp + (size_t)kt * 64 * ldb;
#pragma unroll
            for (int p = 0; p < NB4; ++p) breg[p] = *(const f32x4*)(bk + b_goff[p]);
        };
        auto lstore = [&](int buf) {
            LAS unsigned char* base = lds + buf * STAGE;
#pragma unroll
            for (int p = 0; p < WM; ++p) *(LAS u32x4*)(base + a_wr[p]) = areg[p];
#pragma unroll
            for (int p = 0; p < NB4; ++p) { u32x2 w; w.x = cvtpk(breg[p].x, breg[p].y); w.y = cvtpk(breg[p].z, breg[p].w); *(LAS u32x2*)(base + b_wr[p]) = w; }
        };
        gload(0); lstore(0); __syncthreads();
        for (int kt = 0; kt < KT; ++kt) {
            if (kt + 1 < KT) gload(kt + 1);
            __builtin_amdgcn_sched_barrier(0);
            const LAS unsigned char* base = lds + (kt & 1) * STAGE;
#pragma unroll
            for (int ks = 0; ks < 2; ++ks) {
                bf16x8 af[4], bfr[4];
#pragma unroll
                for (int mi = 0; mi < 4; ++mi) af[mi] = *(const LAS bf16x8*)(base + a_rd[mi][ks]);
#pragma unroll
                for (int ni = 0; ni < 4; ++ni) {
                    const int u0 = wn * 4 + ni;
                    const s16x4 lo = lds_tr(base + b_rd[ks][0] + ((u0 ^ b_f[ks][0]) << 5));
                    const s16x4 hi = lds_tr(base + b_rd[ks][1] + ((u0 ^ b_f[ks][1]) << 5));
                    bfr[ni] = (bf16x8){lo[0], lo[1], lo[2], lo[3], hi[0], hi[1], hi[2], hi[3]};
                }
#pragma unroll
                for (int mi = 0; mi < 4; ++mi)
#pragma unroll
                    for (int ni = 0; ni < 4; ++ni) acc[mi][ni] = __builtin_amdgcn_mfma_f32_16x16x32_bf16(bfr[ni], af[mi], acc[mi][ni], 0, 0, 0);
            }
            if (kt + 1 < KT) lstore((kt + 1) & 1);
            __syncthreads();
        }
    }
};

struct Gemm2 {
    static constexpr int A_BYTES = 32768, STAGE = 65536, LDS_BYTES = 2 * STAGE;
    static __device__ __forceinline__ int a_row(int i, int w, int lane) { return (i * 8 + w) * 8 + (lane >> 3); }
    static __device__ __forceinline__ int a_chunk(int row, int lane) { return (lane & 7) ^ ((row >> 1) & 7); }
    static __device__ __forceinline__ int b_k(int i, int w, int lane) { return (i * 8 + w) * 2 + (lane >> 5); }
    static __device__ __forceinline__ int b_n(int k, int lane) { return ((((lane & 31) >> 1) ^ fk2(k)) << 4) + ((lane & 1) << 3); }
    static __device__ __forceinline__ int fk2(int r) { return (r & 3) | (((r >> 3) & 1) << 2); }

    static __device__ __forceinline__ void run(f32x4 (&acc)[4][8], const bf16_t* const (&aptr)[4], int a_kstride, const bf16_t* const (&bptr)[4], size_t b_kstride, int KT, LAS unsigned char* lds) {
        const int tid = opaque_tid(), lane = tid & 63, wid = tid >> 6, wm = wid >> 1, wn = wid & 1, fr = lane & 15, fq = lane >> 4;
        const int wu = __builtin_amdgcn_readfirstlane(wid);
#pragma unroll
        for (int mi = 0; mi < 4; ++mi)
#pragma unroll
            for (int ni = 0; ni < 8; ++ni) acc[mi][ni] = (f32x4){0.f, 0.f, 0.f, 0.f};
        int a_rd[4][2];
#pragma unroll
        for (int mi = 0; mi < 4; ++mi)
#pragma unroll
            for (int ks = 0; ks < 2; ++ks) { const int row = wm * 64 + mi * 16 + fr, ch = ks * 4 + fq; a_rd[mi][ks] = row * 128 + ((ch ^ ((row >> 1) & 7)) << 4); }
        int b_rd[2][2], b_f[2][2];
#pragma unroll
        for (int ks = 0; ks < 2; ++ks)
#pragma unroll
            for (int t = 0; t < 2; ++t) { const int k = ks * 32 + 8 * fq + 4 * t + (fr >> 2); b_f[ks][t] = fk2(k); b_rd[ks][t] = A_BYTES + k * 512 + ((fr & 3) << 3); }
        auto issue = [&](int kt, int buf) {
            LAS unsigned char* base = lds + buf * STAGE + wu * 1024;
#pragma unroll
            for (int i = 0; i < 4; ++i) __builtin_amdgcn_global_load_lds((const unsigned*)(aptr[i] + (size_t)kt * a_kstride), (LAS unsigned*)(base + i * 8192), 16, 0, 0);
#pragma unroll
            for (int i = 0; i < 4; ++i) __builtin_amdgcn_global_load_lds((const unsigned*)(bptr[i] + (size_t)kt * b_kstride), (LAS unsigned*)(base + A_BYTES + i * 8192), 16, 0, 0);
        };
        issue(0, 0);
        for (int kt = 0; kt < KT; ++kt) {
            asm volatile("s_waitcnt vmcnt(0)" ::: "memory");
            __syncthreads();
            if (kt + 1 < KT) issue(kt + 1, (kt + 1) & 1);
            const LAS unsigned char* base = lds + (kt & 1) * STAGE;
#pragma unroll
            for (int ks = 0; ks < 2; ++ks) {
                bf16x8 af[4];
#pragma unroll
                for (int mi = 0; mi < 4; ++mi) af[mi] = *(const LAS bf16x8*)(base + a_rd[mi][ks]);
#pragma unroll
                for (int ni = 0; ni < 8; ++ni) {
                    const int u0 = wn * 8 + ni;
                    const s16x4 lo = lds_tr(base + b_rd[ks][0] + ((u0 ^ b_f[ks][0]) << 5));
                    const s16x4 hi = lds_tr(base + b_rd[ks][1] + ((u0 ^ b_f[ks][1]) << 5));
                    const bf16x8 bfr = (bf16x8){lo[0], lo[1], lo[2], lo[3], hi[0], hi[1], hi[2], hi[3]};
#pragma unroll
                    for (int mi = 0; mi < 4; ++mi) acc[mi][ni] = __builtin_amdgcn_mfma_f32_16x16x32_bf16(bfr, af[mi], acc[mi][ni], 0, 0, 0);
                }
            }
        }
        __syncthreads();
    }
};

__device__ __forceinline__ void glds16(const void* g, unsigned lds_base) {
    unsigned sv; asm volatile("s_mov_b32 %0, m0\n\ts_mov_b32 m0, %2\n\ts_nop 0\n\tglobal_load_lds_dwordx4 %1, off\n\ts_mov_b32 m0, %0" : "=&s"(sv) : "v"(g), "s"(lds_base) : "memory"); }
struct Gemm3 {
    static constexpr int A_BYTES = 16384, STAGE = 32768, LDS_BYTES = 4 * STAGE;
    static __device__ __forceinline__ int a_row(int i, int w, int lane) { return (i * 8 + w) * 16 + (lane >> 2); }
    static __device__ __forceinline__ int a_chunk(int row, int lane) { return (lane & 3) ^ ((row >> 1) & 3); }
    static __device__ __forceinline__ int b_k(int i, int w, int lane) { return (i * 8 + w) * 2 + (lane >> 5); }
    static __device__ __forceinline__ int fk2(int r) { return (r & 3) | (((r >> 3) & 1) << 2); }
    static __device__ __forceinline__ int b_n(int k, int lane) { return ((((lane & 31) >> 1) ^ fk2(k)) << 4) + ((lane & 1) << 3); }
    static __device__ __forceinline__ void run(f32x4 (&acc)[4][8], const bf16_t* const (&aptr)[2], int a_kstride, const bf16_t* const (&bptr)[2], size_t b_kstride, int KT, LAS unsigned char* lds) {
        const int tid = opaque_tid(), lane = tid & 63, wid = tid >> 6, wm = wid >> 1, wn = wid & 1, fr = lane & 15, fq = lane >> 4;
        const int wu = __builtin_amdgcn_readfirstlane(wid);
#pragma unroll
        for (int mi = 0; mi < 4; ++mi)
#pragma unroll
            for (int ni = 0; ni < 8; ++ni) acc[mi][ni] = (f32x4){0.f, 0.f, 0.f, 0.f};
        int a_rd[4];
#pragma unroll
        for (int mi = 0; mi < 4; ++mi) { const int row = wm * 64 + mi * 16 + fr; a_rd[mi] = row * 64 + ((fq ^ ((row >> 1) & 3)) << 4); }
        int b_rd[2], b_f[2];
#pragma unroll
        for (int t = 0; t < 2; ++t) { const int k = 8 * fq + 4 * t + (fr >> 2); b_f[t] = fk2(k); b_rd[t] = A_BYTES + k * 512 + ((fr & 3) << 3); }
        const unsigned lds0 = (unsigned)(uintptr_t)lds + (unsigned)wu * 1024u;
        auto issue = [&](int kt) {
            const unsigned base = (unsigned)__builtin_amdgcn_readfirstlane((int)(lds0 + (unsigned)(kt & 3) * STAGE));
#pragma unroll
            for (int i = 0; i < 2; ++i) glds16(aptr[i] + (size_t)kt * a_kstride, base + i * 8192);
#pragma unroll
            for (int i = 0; i < 2; ++i) glds16(bptr[i] + (size_t)kt * b_kstride, base + A_BYTES + i * 8192);
        };
        const int grp = wu >> 2;
        auto bar = [&]() { asm volatile("s_waitcnt lgkmcnt(0)" ::: "memory"); __builtin_amdgcn_s_barrier(); asm volatile("" ::: "memory"); };
        asm volatile("s_waitcnt vmcnt(0)" ::: "memory");
        issue(0); if (KT > 1) issue(1); if (KT > 2) issue(2);
        if (KT > 2) asm volatile("s_waitcnt vmcnt(8)" ::: "memory"); else if (KT > 1) asm volatile("s_waitcnt vmcnt(4)" ::: "memory"); else asm volatile("s_waitcnt vmcnt(0)" ::: "memory");
        bar();
        if (grp) bar();
#pragma unroll 1
        for (int kt = 0; kt < KT; ++kt) {
            if (kt + 3 < KT) issue(kt + 3);
            const LAS unsigned char* base = lds + (kt & 3) * STAGE;
            bf16x8 af[4], bfr[8];
#pragma unroll
            for (int mi = 0; mi < 4; ++mi) af[mi] = *(const LAS bf16x8*)(base + a_rd[mi]);
#pragma unroll
            for (int ni = 0; ni < 8; ++ni) {
                const int u0 = wn * 8 + ni;
                const s16x4 lo = lds_tr(base + b_rd[0] + ((u0 ^ b_f[0]) << 5));
                const s16x4 hi = lds_tr(base + b_rd[1] + ((u0 ^ b_f[1]) << 5));
                bfr[ni] = (bf16x8){lo[0], lo[1], lo[2], lo[3], hi[0], hi[1], hi[2], hi[3]};
            }
            { const int rem = KT - 2 - kt;
              if (rem >= 2) asm volatile("s_waitcnt vmcnt(8)" ::: "memory"); else if (rem == 1) asm volatile("s_waitcnt vmcnt(4)" ::: "memory"); else asm volatile("s_waitcnt vmcnt(0)" ::: "memory"); }
            bar();
            __builtin_amdgcn_sched_barrier(0);
#pragma unroll
            for (int ni = 0; ni < 8; ++ni)
#pragma unroll
                for (int mi = 0; mi < 4; ++mi) acc[mi][ni] = __builtin_amdgcn_mfma_f32_16x16x32_bf16(bfr[ni], af[mi], acc[mi][ni], 0, 0, 0);
            __builtin_amdgcn_sched_barrier(0);
            bar();
        }
        if (!grp) bar();
    }

    template <class F> static __device__ __forceinline__ void run_stream(F& f, int NSEG, int KT, int a_kstride, size_t b_kstride, LAS unsigned char* lds) {
        const int tid = opaque_tid(), lane = tid & 63, wid = tid >> 6, wm = wid >> 1, wn = wid & 1, fr = lane & 15, fq = lane >> 4;
        const int wu = __builtin_amdgcn_readfirstlane(wid);
        f32x4 acc[4][8];
#pragma unroll
        for (int mi = 0; mi < 4; ++mi)
#pragma unroll
            for (int ni = 0; ni < 8; ++ni) acc[mi][ni] = (f32x4){0.f, 0.f, 0.f, 0.f};
        int a_rd[4];
#pragma unroll
        for (int mi = 0; mi < 4; ++mi) { const int row = wm * 64 + mi * 16 + fr; a_rd[mi] = row * 64 + ((fq ^ ((row >> 1) & 3)) << 4); }
        int b_rd[2], b_f[2];
#pragma unroll
        for (int t = 0; t < 2; ++t) { const int k = 8 * fq + 4 * t + (fr >> 2); b_f[t] = fk2(k); b_rd[t] = A_BYTES + k * 512 + ((fr & 3) << 3); }
        const unsigned lds0 = (unsigned)(uintptr_t)lds + (unsigned)wu * 1024u;
        const bf16_t* aptr[2]; const bf16_t* bptr[2];
        const int total = NSEG * KT;
        int lseg = 0, lkt = 0, lg = 0;
        auto issue = [&]() {
            const unsigned base = (unsigned)__builtin_amdgcn_readfirstlane((int)(lds0 + (unsigned)(lg & 3) * STAGE));
#pragma unroll
            for (int i = 0; i < 2; ++i) glds16(aptr[i] + (size_t)lkt * a_kstride, base + i * 8192);
#pragma unroll
            for (int i = 0; i < 2; ++i) glds16(bptr[i] + (size_t)lkt * b_kstride, base + A_BYTES + i * 8192);
            ++lg; if (++lkt == KT) { lkt = 0; ++lseg; if (lseg < NSEG) f.ptrs(lseg, aptr, bptr); }
        };
        const int grp = wu >> 2;
        auto bar = [&]() { asm volatile("s_waitcnt lgkmcnt(0)" ::: "memory"); __builtin_amdgcn_s_barrier(); asm volatile("" ::: "memory"); };
        f.ptrs(0, aptr, bptr);
        asm volatile("s_waitcnt vmcnt(0)" ::: "memory");
        issue(); if (total > 1) issue(); if (total > 2) issue();
        if (total > 2) asm volatile("s_waitcnt vmcnt(8)" ::: "memory"); else if (total > 1) asm volatile("s_waitcnt vmcnt(4)" ::: "memory"); else asm volatile("s_waitcnt vmcnt(0)" ::: "memory");
        bar();
        if (grp) bar();
        int cseg = 0, ckt = 0;
#pragma unroll 1
        for (int g = 0; g < total; ++g) {
            if (lg < total) issue();
            const LAS unsigned char* base = lds + (g & 3) * STAGE;
            bf16x8 af[4], bfr[8];
#pragma unroll
            for (int mi = 0; mi < 4; ++mi) af[mi] = *(const LAS bf16x8*)(base + a_rd[mi]);
#pragma unroll
            for (int ni = 0; ni < 8; ++ni) {
                const int u0 = wn * 8 + ni;
                const s16x4 lo = lds_tr(base + b_rd[0] + ((u0 ^ b_f[0]) << 5));
                const s16x4 hi = lds_tr(base + b_rd[1] + ((u0 ^ b_f[1]) << 5));
                bfr[ni] = (bf16x8){lo[0], lo[1], lo[2], lo[3], hi[0], hi[1], hi[2], hi[3]};
            }
            { const int rem = total - 2 - g;
              if (rem >= 2) asm volatile("s_waitcnt vmcnt(8)" ::: "memory"); else if (rem == 1) asm volatile("s_waitcnt vmcnt(4)" ::: "memory"); else asm volatile("s_waitcnt vmcnt(0)" ::: "memory"); }
            bar();
            __builtin_amdgcn_sched_barrier(0);
#pragma unroll
            for (int ni = 0; ni < 8; ++ni)
#pragma unroll
                for (int mi = 0; mi < 4; ++mi) acc[mi][ni] = __builtin_amdgcn_mfma_f32_16x16x32_bf16(bfr[ni], af[mi], acc[mi][ni], 0, 0, 0);
            __builtin_amdgcn_sched_barrier(0);
            bar();
            if (++ckt == KT) {
                f.epi(cseg, acc);
#pragma unroll
                for (int mi = 0; mi < 4; ++mi)
#pragma unroll
                    for (int ni = 0; ni < 8; ++ni) acc[mi][ni] = (f32x4){0.f, 0.f, 0.f, 0.f};
                ckt = 0; ++cseg;
            }
        }
        if (!grp) bar();
    }
};

struct Gemm4 {
    static constexpr int A_BYTES = 16384, STAGE = 32768, LDS_BYTES = 2 * STAGE;
    static __device__ __forceinline__ int fk2(int r) { return (r & 3) | (((r >> 3) & 1) << 2); }
    static __device__ __forceinline__ int a_row(int i, int tid) { return (tid >> 2) + 128 * i; }
    static __device__ __forceinline__ int b_k(int i, int tid) { return (tid >> 5) + 16 * i; }
    static __device__ __forceinline__ void run(f32x4 (&acc)[4][8], const bf16_t* const (&aptr)[2], int a_kstride, const bf16_t* const (&bptr)[2], size_t b_kstride, int KT, LAS unsigned char* lds) {
        const int tid = opaque_tid(), lane = tid & 63, wid = tid >> 6, wm = wid >> 1, wn = wid & 1, fr = lane & 15, fq = lane >> 4;
#pragma unroll
        for (int mi = 0; mi < 4; ++mi)
#pragma unroll
            for (int ni = 0; ni < 8; ++ni) acc[mi][ni] = (f32x4){0.f, 0.f, 0.f, 0.f};
        int a_wr[2], b_wr[2];
#pragma unroll
        for (int i = 0; i < 2; ++i) { const int row = a_row(i, tid); a_wr[i] = row * 64 + (((tid & 3) ^ ((row >> 1) & 3)) << 4);
            const int k = b_k(i, tid), n = (tid & 31) * 8; b_wr[i] = A_BYTES + k * 512 + (((n >> 4) ^ fk2(k)) << 5) + ((n & 15) << 1); }
        int a_rd[4];
#pragma unroll
        for (int mi = 0; mi < 4; ++mi) { const int row = wm * 64 + mi * 16 + fr; a_rd[mi] = row * 64 + ((fq ^ ((row >> 1) & 3)) << 4); }
        int b_rd[2], b_f[2];
#pragma unroll
        for (int t = 0; t < 2; ++t) { const int k = 8 * fq + 4 * t + (fr >> 2); b_f[t] = fk2(k); b_rd[t] = A_BYTES + k * 512 + ((fr & 3) << 3); }
        u32x4 ra0[2], rb0[2], ra1[2], rb1[2];
        auto gload = [&](int kt, u32x4 (&ra)[2], u32x4 (&rb)[2]) {
#pragma unroll
            for (int i = 0; i < 2; ++i) { ra[i] = *(const u32x4*)(aptr[i] + (size_t)kt * a_kstride); rb[i] = *(const u32x4*)(bptr[i] + (size_t)kt * b_kstride); }
        };
        auto lstore = [&](int buf, const u32x4 (&ra)[2], const u32x4 (&rb)[2]) {
            LAS unsigned char* base = lds + buf * STAGE;
#pragma unroll
            for (int i = 0; i < 2; ++i) { *(LAS u32x4*)(base + a_wr[i]) = ra[i]; *(LAS u32x4*)(base + b_wr[i]) = rb[i]; }
        };
        auto compute = [&](int buf) {
            const LAS unsigned char* base = lds + buf * STAGE;
            bf16x8 af[4];
#pragma unroll
            for (int mi = 0; mi < 4; ++mi) af[mi] = *(const LAS bf16x8*)(base + a_rd[mi]);
#pragma unroll
            for (int ni = 0; ni < 8; ++ni) {
                const int u0 = wn * 8 + ni;
                const s16x4 lo = lds_tr(base + b_rd[0] + ((u0 ^ b_f[0]) << 5));
                const s16x4 hi = lds_tr(base + b_rd[1] + ((u0 ^ b_f[1]) << 5));
                const bf16x8 bfr = (bf16x8){lo[0], lo[1], lo[2], lo[3], hi[0], hi[1], hi[2], hi[3]};
#pragma unroll
                for (int mi = 0; mi < 4; ++mi) acc[mi][ni] = __builtin_amdgcn_mfma_f32_16x16x32_bf16(bfr, af[mi], acc[mi][ni], 0, 0, 0);
            }
        };
        gload(0, ra0, rb0); gload(1, ra1, rb1);
        lstore(0, ra0, rb0); __syncthreads();
        for (int kt = 0; kt < KT; kt += 2) {
            gload(kt + 2 < KT ? kt + 2 : KT - 1, ra0, rb0);
            __builtin_amdgcn_sched_barrier(0);
            compute(0);
            lstore(1, ra1, rb1);
            __syncthreads();
            gload(kt + 3 < KT ? kt + 3 : KT - 1, ra1, rb1);
            __builtin_amdgcn_sched_barrier(0);
            compute(1);
            lstore(0, ra0, rb0);
            __syncthreads();
        }
    }

    template <class F> static __device__ __forceinline__ void run_stream(F& f, int NSEG, int KT, int a_kstride, size_t b_kstride, LAS unsigned char* lds) {
        const int tid = opaque_tid(), lane = tid & 63, wid = tid >> 6, wm = wid >> 1, wn = wid & 1, fr = lane & 15, fq = lane >> 4;
        f32x4 acc[4][8];
#pragma unroll
        for (int mi = 0; mi < 4; ++mi)
#pragma unroll
            for (int ni = 0; ni < 8; ++ni) acc[mi][ni] = (f32x4){0.f, 0.f, 0.f, 0.f};
        int a_wr[2], b_wr[2];
#pragma unroll
        for (int i = 0; i < 2; ++i) { const int row = a_row(i, tid); a_wr[i] = row * 64 + (((tid & 3) ^ ((row >> 1) & 3)) << 4);
            const int k = b_k(i, tid), n = (tid & 31) * 8; b_wr[i] = A_BYTES + k * 512 + (((n >> 4) ^ fk2(k)) << 5) + ((n & 15) << 1); }
        int a_rd[4];
#pragma unroll
        for (int mi = 0; mi < 4; ++mi) { const int row = wm * 64 + mi * 16 + fr; a_rd[mi] = row * 64 + ((fq ^ ((row >> 1) & 3)) << 4); }
        int b_rd[2], b_f[2];
#pragma unroll
        for (int t = 0; t < 2; ++t) { const int k = 8 * fq + 4 * t + (fr >> 2); b_f[t] = fk2(k); b_rd[t] = A_BYTES + k * 512 + ((fr & 3) << 3); }
        const bf16_t* aptr[2]; const bf16_t* bptr[2];
        u32x4 ra0[2], rb0[2], ra1[2], rb1[2];
        int lseg = 0, lkt = 0;
        auto gload = [&](u32x4 (&ra)[2], u32x4 (&rb)[2]) {
#pragma unroll
            for (int i = 0; i < 2; ++i) { ra[i] = *(const u32x4*)(aptr[i] + (size_t)lkt * a_kstride); rb[i] = *(const u32x4*)(bptr[i] + (size_t)lkt * b_kstride); }
            if (lkt + 1 < KT) ++lkt; else if (lseg + 1 < NSEG) { lkt = 0; ++lseg; f.ptrs(lseg, aptr, bptr); }
        };
        auto lstore = [&](int buf, const u32x4 (&ra)[2], const u32x4 (&rb)[2]) {
            LAS unsigned char* base = lds + buf * STAGE;
#pragma unroll
            for (int i = 0; i < 2; ++i) { *(LAS u32x4*)(base + a_wr[i]) = ra[i]; *(LAS u32x4*)(base + b_wr[i]) = rb[i]; }
        };
        auto compute = [&](int buf) {
            const LAS unsigned char* base = lds + buf * STAGE;
            bf16x8 af[4];
#pragma unroll
            for (int mi = 0; mi < 4; ++mi) af[mi] = *(const LAS bf16x8*)(base + a_rd[mi]);
#pragma unroll
            for (int ni = 0; ni < 8; ++ni) {
                const int u0 = wn * 8 + ni;
                const s16x4 lo = lds_tr(base + b_rd[0] + ((u0 ^ b_f[0]) << 5));
                const s16x4 hi = lds_tr(base + b_rd[1] + ((u0 ^ b_f[1]) << 5));
                const bf16x8 bfr = (bf16x8){lo[0], lo[1], lo[2], lo[3], hi[0], hi[1], hi[2], hi[3]};
#pragma unroll
                for (int mi = 0; mi < 4; ++mi) acc[mi][ni] = __builtin_amdgcn_mfma_f32_16x16x32_bf16(bfr, af[mi], acc[mi][ni], 0, 0, 0);
            }
        };
        f.ptrs(0, aptr, bptr);
        gload(ra0, rb0); gload(ra1, rb1);
        lstore(0, ra0, rb0); __syncthreads();
        int cseg = 0, ckt = 0;
        const int total = NSEG * KT;
#pragma unroll 1
        for (int g = 0; g < total; g += 2) {
            gload(ra0, rb0);
            __builtin_amdgcn_sched_barrier(0);
            compute(0);
            lstore(1, ra1, rb1);
            __syncthreads();
            gload(ra1, rb1);
            __builtin_amdgcn_sched_barrier(0);
            compute(1);
            lstore(0, ra0, rb0);
            __syncthreads();
            ckt += 2;
            if (ckt == KT) {
                f.epi(cseg, acc);
#pragma unroll
                for (int mi = 0; mi < 4; ++mi)
#pragma unroll
                    for (int ni = 0; ni < 8; ++ni) acc[mi][ni] = (f32x4){0.f, 0.f, 0.f, 0.f};
                ckt = 0; ++cseg;
            }
        }
    }
};

template <bool BF32> struct Gemm5 {
    static constexpr int A_BYTES = 16384, STAGE = 32768, LDS_BYTES = 2 * STAGE;
    static __device__ __forceinline__ int fk2(int r) { return (r & 3) | (((r >> 3) & 1) << 2); }
    static __device__ __forceinline__ int a_row(int i, int tid) { return (tid >> 2) + 128 * i; }
    static __device__ __forceinline__ int b_k(int i, int tid) { return (tid >> 5) + 16 * i; }
    typedef typename std::conditional<BF32, float, bf16_t>::type b_t;
    static __device__ __forceinline__ void run(f32x4 (&acc)[4][8], const bf16_t* const (&aptr)[2], int a_kstride, const b_t* const (&bptr)[2], size_t b_kstride, int KT, LAS unsigned char* lds) {
        const int tid = opaque_tid(), lane = tid & 63, wid = tid >> 6, wm = wid >> 1, wn = wid & 1, fr = lane & 15, fq = lane >> 4;
#pragma unroll
        for (int mi = 0; mi < 4; ++mi)
#pragma unroll
            for (int ni = 0; ni < 8; ++ni) acc[mi][ni] = (f32x4){0.f, 0.f, 0.f, 0.f};
        int a_wr[2], b_wr[2];
#pragma unroll
        for (int i = 0; i < 2; ++i) { const int row = a_row(i, tid); a_wr[i] = row * 64 + (((tid & 3) ^ ((row >> 1) & 3)) << 4);
            const int k = b_k(i, tid), n = (tid & 31) * 8; b_wr[i] = A_BYTES + k * 512 + (((n >> 4) ^ fk2(k)) << 5) + ((n & 15) << 1); }
        int a_rd[4];
#pragma unroll
        for (int mi = 0; mi < 4; ++mi) { const int row = wm * 64 + mi * 16 + fr; a_rd[mi] = row * 64 + ((fq ^ ((row >> 1) & 3)) << 4); }
        int b_rd[2], b_f[2];
#pragma unroll
        for (int t = 0; t < 2; ++t) { const int k = 8 * fq + 4 * t + (fr >> 2); b_f[t] = fk2(k); b_rd[t] = A_BYTES + k * 512 + ((fr & 3) << 3); }
        u32x4 ra[2]; u32x4 rb[2]; f32x4 rbf[2][2];
        auto gload = [&](int kt) {
#pragma unroll
            for (int i = 0; i < 2; ++i) { ra[i] = *(const u32x4*)(aptr[i] + (size_t)kt * a_kstride);
                if (BF32) { const float* p = (const float*)bptr[i] + (size_t)kt * b_kstride; rbf[i][0] = *(const f32x4*)p; rbf[i][1] = *(const f32x4*)(p + 4); }
                else rb[i] = *(const u32x4*)((const bf16_t*)bptr[i] + (size_t)kt * b_kstride); }
        };
        auto lstore = [&](int buf) {
            LAS unsigned char* base = lds + buf * STAGE;
#pragma unroll
            for (int i = 0; i < 2; ++i) { *(LAS u32x4*)(base + a_wr[i]) = ra[i];
                if (BF32) { u32x4 w; w.x = cvtpk(rbf[i][0].x, rbf[i][0].y); w.y = cvtpk(rbf[i][0].z, rbf[i][0].w); w.z = cvtpk(rbf[i][1].x, rbf[i][1].y); w.w = cvtpk(rbf[i][1].z, rbf[i][1].w); *(LAS u32x4*)(base + b_wr[i]) = w; }
                else *(LAS u32x4*)(base + b_wr[i]) = rb[i]; }
        };
        auto compute = [&](int buf) {
            const LAS unsigned char* base = lds + buf * STAGE;
            bf16x8 af[4];
#pragma unroll
            for (int mi = 0; mi < 4; ++mi) af[mi] = *(const LAS bf16x8*)(base + a_rd[mi]);
#pragma unroll
            for (int ni = 0; ni < 8; ++ni) {
                const int u0 = wn * 8 + ni;
                const s16x4 lo = lds_tr(base + b_rd[0] + ((u0 ^ b_f[0]) << 5));
                const s16x4 hi = lds_tr(base + b_rd[1] + ((u0 ^ b_f[1]) << 5));
                const bf16x8 bfr = (bf16x8){lo[0], lo[1], lo[2], lo[3], hi[0], hi[1], hi[2], hi[3]};
#pragma unroll
                for (int mi = 0; mi < 4; ++mi) acc[mi][ni] = __builtin_amdgcn_mfma_f32_16x16x32_bf16(bfr, af[mi], acc[mi][ni], 0, 0, 0);
            }
        };
        gload(0); lstore(0); __syncthreads();
#pragma unroll 1
        for (int kt = 0; kt < KT; ++kt) {
            gload(kt + 1 < KT ? kt + 1 : KT - 1);
            __builtin_amdgcn_sched_barrier(0);
            compute(kt & 1);
            lstore((kt + 1) & 1);
            __syncthreads();
        }
    }

    template <class F> static __device__ __forceinline__ void run_stream(F& f, int NSEG, int KT, int a_kstride, size_t b_kstride, LAS unsigned char* lds) {
        const int tid = opaque_tid(), lane = tid & 63, wid = tid >> 6, wm = wid >> 1, wn = wid & 1, fr = lane & 15, fq = lane >> 4;
        f32x4 acc[4][8];
#pragma unroll
        for (int mi = 0; mi < 4; ++mi)
#pragma unroll
            for (int ni = 0; ni < 8; ++ni) acc[mi][ni] = (f32x4){0.f, 0.f, 0.f, 0.f};
        int a_wr[2], b_wr[2];
#pragma unroll
        for (int i = 0; i < 2; ++i) { const int row = a_row(i, tid); a_wr[i] = row * 64 + (((tid & 3) ^ ((row >> 1) & 3)) << 4);
            const int k = b_k(i, tid), n = (tid & 31) * 8; b_wr[i] = A_BYTES + k * 512 + (((n >> 4) ^ fk2(k)) << 5) + ((n & 15) << 1); }
        int a_rd[4];
#pragma unroll
        for (int mi = 0; mi < 4; ++mi) { const int row = wm * 64 + mi * 16 + fr; a_rd[mi] = row * 64 + ((fq ^ ((row >> 1) & 3)) << 4); }
        int b_rd[2], b_f[2];
#pragma unroll
        for (int t = 0; t < 2; ++t) { const int k = 8 * fq + 4 * t + (fr >> 2); b_f[t] = fk2(k); b_rd[t] = A_BYTES + k * 512 + ((fr & 3) << 3); }
        const bf16_t* aptr[2]; const b_t* bptr[2];
        u32x4 ra[2]; u32x4 rb[2]; f32x4 rbf[2][2];
        auto gload = [&](int kt) {
#pragma unroll
            for (int i = 0; i < 2; ++i) { ra[i] = *(const u32x4*)(aptr[i] + (size_t)kt * a_kstride);
                if (BF32) { const float* p = (const float*)bptr[i] + (size_t)kt * b_kstride; rbf[i][0] = *(const f32x4*)p; rbf[i][1] = *(const f32x4*)(p + 4); }
                else rb[i] = *(const u32x4*)((const bf16_t*)bptr[i] + (size_t)kt * b_kstride); }
        };
        auto lstore = [&](int buf) {
            LAS unsigned char* base = lds + buf * STAGE;
#pragma unroll
            for (int i = 0; i < 2; ++i) { *(LAS u32x4*)(base + a_wr[i]) = ra[i];
                if (BF32) { u32x4 w; w.x = cvtpk(rbf[i][0].x, rbf[i][0].y); w.y = cvtpk(rbf[i][0].z, rbf[i][0].w); w.z = cvtpk(rbf[i][1].x, rbf[i][1].y); w.w = cvtpk(rbf[i][1].z, rbf[i][1].w); *(LAS u32x4*)(base + b_wr[i]) = w; }
                else *(LAS u32x4*)(base + b_wr[i]) = rb[i]; }
        };
        auto compute = [&](int buf) {
            const LAS unsigned char* base = lds + buf * STAGE;
            bf16x8 af[4];
#pragma unroll
            for (int mi = 0; mi < 4; ++mi) af[mi] = *(const LAS bf16x8*)(base + a_rd[mi]);
#pragma unroll
            for (int ni = 0; ni < 8; ++ni) {
                const int u0 = wn * 8 + ni;
                const s16x4 lo = lds_tr(base + b_rd[0] + ((u0 ^ b_f[0]) << 5));
                const s16x4 hi = lds_tr(base + b_rd[1] + ((u0 ^ b_f[1]) << 5));
                const bf16x8 bfr = (bf16x8){lo[0], lo[1], lo[2], lo[3], hi[0], hi[1], hi[2], hi[3]};
#pragma unroll
                for (int mi = 0; mi < 4; ++mi) acc[mi][ni] = __builtin_amdgcn_mfma_f32_16x16x32_bf16(bfr, af[mi], acc[mi][ni], 0, 0, 0);
            }
        };
        f.ptrs(0, aptr, bptr);
        gload(0); lstore(0); __syncthreads();
        int seg = 0, kt = 0;
        const int total = NSEG * KT;
#pragma unroll 1
        for (int g = 0; g < total; ++g) {
            int nkt = kt + 1, nsg = seg; if (nkt == KT) { nkt = 0; nsg = seg + 1; }
            if (nkt == 0 && nsg < NSEG) f.ptrs(nsg, aptr, bptr);
            gload(nsg < NSEG ? nkt : KT - 1);
            __builtin_amdgcn_sched_barrier(0);
            compute(g & 1);
            lstore((g + 1) & 1);
            __syncthreads();
            if (nkt == 0) {
                f.epi(seg, acc);
#pragma unroll
                for (int mi = 0; mi < 4; ++mi)
#pragma unroll
                    for (int ni = 0; ni < 8; ++ni) acc[mi][ni] = (f32x4){0.f, 0.f, 0.f, 0.f};
            }
            seg = nsg; kt = nkt;
        }
    }
};

__device__ __forceinline__ void phase_mod(const Params& P, LAS unsigned char* lds) {
    const int tid = threadIdx.x;
    float* mod = (float*)(P.ws + WS_MOD);
    LAS float* sc = (LAS float*)lds;
    LAS float* red = (LAS float*)(lds + 16384);
    for (int i = tid; i < 4096; i += NTHREADS) sc[i] = siluf_(P.c[i]);
    __syncthreads();
    const int kq = tid >> 5, cl = tid & 31;
    for (int u = blockIdx.x; u < 192; u += gridDim.x) {
        const int j = u * 32 + cl;
        float a0 = 0.f, a1 = 0.f, a2 = 0.f, a3 = 0.f;
#pragma unroll 8
        for (int k = kq; k < 1024; k += 16) { const float w = P.ada_w[(size_t)k * 6144 + j];
            a0 += sc[k] * w; a1 += sc[1024 + k] * w; a2 += sc[2048 + k] * w; a3 += sc[3072 + k] * w; }
        red[(kq * 4 + 0) * 32 + cl] = a0; red[(kq * 4 + 1) * 32 + cl] = a1; red[(kq * 4 + 2) * 32 + cl] = a2; red[(kq * 4 + 3) * 32 + cl] = a3;
        __syncthreads();
        if (tid < 128) { const int b = tid >> 5; float s = 0.f;
#pragma unroll
            for (int q = 0; q < 16; ++q) s += red[(q * 4 + b) * 32 + cl];
            mod[b * 6144 + j] = s + P.ada_b[j]; }
        __syncthreads();
    }
    for (int u = blockIdx.x; u < 16; u += gridDim.x) {
        const int sel = u >> 3, j = (u & 7) * 32 + cl;
        const float* w1 = P.cmp_w1 + (size_t)sel * 2048 * 256; const float* pos = P.cmp_pos + sel * 2048;
        float a0 = 0.f;
#pragma unroll 8
        for (int k = kq; k < 2048; k += 16) a0 += pos[k] * w1[(size_t)k * 256 + j];
        red[kq * 32 + cl] = a0;
        __syncthreads();
        if (tid < 32) { float s = 0.f;
#pragma unroll
            for (int q = 0; q < 16; ++q) s += red[q * 32 + cl];
            ((float*)(P.ws + WS_CB))[sel * 256 + j] = s + P.cmp_b1[sel * 256 + j]; }
        __syncthreads();
    }
    {
        bf16_t* wb = (bf16_t*)(P.ws + WS_WIN);
        const int gt = blockIdx.x * NTHREADS + tid, NG = gridDim.x * NTHREADS;
        for (int i = gt; i < 1024 * (3584 / 8); i += NG) { const int k = i / 448, c8 = (i % 448) * 8;
            const int sc_ = c8 < 1280 ? c8 : (c8 < 3328 ? c8 + 24 : c8 - 2048);
            u32x4 o = (u32x4){0u, 0u, 0u, 0u};
            if (c8 < 3352) { const f32x4 a = *(const f32x4*)(P.w_in + (size_t)k * IN_COLS + sc_), b2 = *(const f32x4*)(P.w_in + (size_t)k * IN_COLS + sc_ + 4);
                o.x = cvtpk(a.x, a.y); o.y = cvtpk(a.z, a.w); o.z = cvtpk(b2.x, b2.y); o.w = cvtpk(b2.z, b2.w); }
            *(u32x4*)(wb + (size_t)k * 3584 + c8) = o; }
    }
    if (blockIdx.x == gridDim.x - 2) {
        for (int i = tid; i < 2 * 8 * 64; i += NTHREADS) { const int t2 = i >> 9, bg = (i >> 6) & 7, d = i & 63;
            ((bf16_t*)(P.ws + (t2 ? WS_VC : WS_KC)))[((size_t)bg * 512 + 511) * 64 + d] = 0; }
    }
    if (blockIdx.x == gridDim.x - 1) {
        float* lb = (float*)(P.ws + WS_LB);
        for (int i = tid; i < 512; i += NTHREADS) { const float p0 = P.hgrn_lb[i], p1 = P.hgrn_lb[512 + i]; lb[i] = 1.0f / (1.0f + __expf(p1 - p0)); }
    }
}

__device__ __forceinline__ void norm_mod_rows(const float* x, const float* w, const float* mod_sh, const float* mod_sc, bf16_t* h, int hs) {
    const int lane = threadIdx.x & 63, gw = blockIdx.x * (NTHREADS / 64) + (threadIdx.x >> 6), NGW = gridDim.x * (NTHREADS / 64);
    for (int m = gw; m < T; m += NGW) {
        const int b = m / SEQ;
        const f32x4* xr = (const f32x4*)(x + (size_t)m * D) + lane;
        f32x4 v[4]; float s = 0.f;
#pragma unroll
        for (int j = 0; j < 4; ++j) { v[j] = xr[64 * j]; s += (v[j].x * v[j].x + v[j].y * v[j].y) + (v[j].z * v[j].z + v[j].w * v[j].w); }
        const float rstd = rsqrtf(wave_sum(s) * (1.f / D) + RMS_EPS);
        u32x2* o = (u32x2*)(h + (size_t)m * hs) + lane;
#pragma unroll
        for (int j = 0; j < 4; ++j) {
            const int col = (lane + 64 * j) * 4;
            const f32x4 wv = *(const f32x4*)(w + col), scv = *(const f32x4*)(mod_sc + b * 6144 + col), shv = *(const f32x4*)(mod_sh + b * 6144 + col);
            f32x4 r;
            r.x = v[j].x * rstd * wv.x * (1.f + scv.x) + shv.x; r.y = v[j].y * rstd * wv.y * (1.f + scv.y) + shv.y;
            r.z = v[j].z * rstd * wv.z * (1.f + scv.z) + shv.z; r.w = v[j].w * rstd * wv.w * (1.f + scv.w) + shv.w;
            u32x2 pk; pk.x = cvtpk(r.x, r.y); pk.y = cvtpk(r.z, r.w); o[64 * j] = pk;
        }
    }
}

__device__ __forceinline__ void phase_inproj(const Params& P, LAS unsigned char* lds) {
    constexpr int NRT = T / 256, NCT = 14;
    struct F { const Params& P;
        __device__ __forceinline__ void unit(int seg, int& rt, int& ct) const {
            const int nx = (gridDim.x % 8 == 0) ? 8 : 1, xl = blockIdx.x % nx, li = blockIdx.x / nx, nloc = gridDim.x / nx;
            const int v = li + seg * nloc, rg = v / (NCT * 4), rem = v % (NCT * 4); ct = rem >> 2; rt = xl + nx * (rg * 4 + (rem & 3)); }
        __device__ __forceinline__ void ptrs(int seg, const bf16_t* (&aptr)[2], const bf16_t* (&bptr)[2]) const {
            const int tid = opaque_tid(), lane = tid & 63, wid = tid >> 6; int rt, ct; unit(seg, rt, ct);
            const bf16_t* h1 = (const bf16_t*)(P.ws + WS_H); const bf16_t* wb = (const bf16_t*)(P.ws + WS_WIN);
#pragma unroll
            for (int i = 0; i < 2; ++i) { const int row = Gemm3::a_row(i, wid, lane); aptr[i] = h1 + (size_t)(rt * 256 + row) * H1S + Gemm3::a_chunk(row, lane) * 8;
                const int k = Gemm3::b_k(i, wid, lane); bptr[i] = wb + (size_t)k * 3584 + ct * 256 + Gemm3::b_n(k, lane); } }
        __device__ __forceinline__ void epi(int seg, f32x4 (&acc)[4][8]) const {
            const int tid = opaque_tid(), lane = tid & 63, wid = tid >> 6, wm = wid >> 1, wn = wid & 1, fr = lane & 15, fq = lane >> 4;
            int rt, ct; unit(seg, rt, ct);
            bf16_t* qo = (bf16_t*)(P.ws + WS_Q); bf16_t* kvo = (bf16_t*)(P.ws + WS_KV); float* gates = (float*)(P.ws + WS_GATES);
            bf16_t* hq = (bf16_t*)(P.ws + WS_HQ); float* logf = (float*)(P.ws + WS_LOGF); bf16_t* hv = (bf16_t*)(P.ws + WS_HV); bf16_t* hg = (bf16_t*)(P.ws + WS_HG);
            const float* lb = (const float*)(P.ws + WS_LB);
        const int row0 = rt * 256 + wm * 64 + fr;
            const int cw = wn * 128 + 4 * fq;
            if (ct < 5) {
                const bool is_q = ct < 2; const int seg = (ct - 2) * 2 + wn;
                const bool do_norm = is_q || seg == 2 || seg == 4;
                const float* nw = is_q ? P.q_norm_w : (P.k_norm_w + (seg == 2 ? 64 : 128));
                const float osc = is_q ? 0.125f : 1.0f;
#pragma unroll
                for (int hh = 0; hh < 2; ++hh) {
                    f32x4 wv[4];
#pragma unroll
                    for (int n4 = 0; n4 < 4; ++n4) wv[n4] = do_norm ? *(const f32x4*)(nw + n4 * 16 + 4 * fq) : (f32x4){1.f, 1.f, 1.f, 1.f};
#pragma unroll
                    for (int mi = 0; mi < 4; ++mi) {
                        float rstd = 1.f;
                        if (do_norm) { float s = 0.f;
#pragma unroll
                            for (int n4 = 0; n4 < 4; ++n4) { const f32x4 a = acc[mi][hh * 4 + n4]; s += (a.x * a.x + a.y * a.y) + (a.z * a.z + a.w * a.w); }
                            s += __shfl_xor(s, 16); s += __shfl_xor(s, 32);
                            rstd = rsqrtf(s * (1.f / 64.f) + RMS_EPS) * osc; }
                        const size_t m = (size_t)(row0 + mi * 16);
                        bf16_t* dst = is_q ? (qo + m * 512 + ct * 256 + cw + hh * 64) : (kvo + m * 768 + (ct - 2) * 256 + cw + hh * 64);
#pragma unroll
                        for (int n4 = 0; n4 < 4; ++n4) { const f32x4 a = acc[mi][hh * 4 + n4]; u32x2 pk;
                            pk.x = cvtpk(a.x * rstd * wv[n4].x, a.y * rstd * wv[n4].y); pk.y = cvtpk(a.z * rstd * wv[n4].z, a.w * rstd * wv[n4].w);
                            *(u32x2*)(dst + n4 * 16) = pk; }
                    }
                }
            } else if (ct == 13) {
                if (wn == 0) {
#pragma unroll
                    for (int mi = 0; mi < 4; ++mi) { const size_t m = (size_t)(row0 + mi * 16);
#pragma unroll
                        for (int ni = 0; ni < 2; ++ni) { const int c = ni * 16 + 4 * fq; if (c < 24) { const f32x4 a = acc[mi][ni];
                                *(f32x4*)(gates + m * 24 + c) = (f32x4){sigmoidf_(a.x), sigmoidf_(a.y), sigmoidf_(a.z), sigmoidf_(a.w)}; } } }
                }
            } else {
                const int hs = (ct - 5) >> 1, cc = ((ct - 5) & 1) * 256 + cw;
#pragma unroll
                for (int mi = 0; mi < 4; ++mi) { const size_t m = (size_t)(row0 + mi * 16);
#pragma unroll
                    for (int ni = 0; ni < 8; ++ni) { const f32x4 a = acc[mi][ni]; const int c = cc + ni * 16;
                        if (hs == 0) { const float s = 0.08838834764831845f; u32x2 pk; pk.x = cvtpk(siluf_(a.x) * s, siluf_(a.y) * s); pk.y = cvtpk(siluf_(a.z) * s, siluf_(a.w) * s); *(u32x2*)(hq + m * 512 + c) = pk; }
                        else if (hs == 1) { const f32x4 l = *(const f32x4*)(lb + c); f32x4 o;
                            o.x = __logf(l.x + (1.f - l.x) * sigmoidf_(a.x)); o.y = __logf(l.y + (1.f - l.y) * sigmoidf_(a.y));
                            o.z = __logf(l.z + (1.f - l.z) * sigmoidf_(a.z)); o.w = __logf(l.w + (1.f - l.w) * sigmoidf_(a.w)); *(f32x4*)(logf + m * 512 + c) = o; }
                        else if (hs == 2) { u32x2 pk; pk.x = cvtpk(a.x, a.y); pk.y = cvtpk(a.z, a.w); *(u32x2*)(hv + m * 512 + c) = pk; }
                        else { u32x2 pk; pk.x = cvtpk(sigmoidf_(a.x), sigmoidf_(a.y)); pk.y = cvtpk(sigmoidf_(a.z), sigmoidf_(a.w)); *(u32x2*)(hg + m * 512 + c) = pk; }
                    } }
            }
        }
    } f{P};
    const int nx = (gridDim.x % 8 == 0) ? 8 : 1, li = blockIdx.x / nx, nloc = gridDim.x / nx;
    const int nu = ((NRT / nx) * NCT - li + nloc - 1) / nloc;
    if (nu > 0) Gemm3::run_stream(f, nu, D / 32, 32, (size_t)32 * 3584, lds);
}

__device__ __forceinline__ float gelu_tanh(float x) {
    const float u = 0.7978845608028654f * (x + 0.044715f * x * x * x);
    const float th = 1.0f - 2.0f / (1.0f + __expf(2.0f * u));
    return 0.5f * x * (1.0f + th);
}
__device__ __forceinline__ void compress_unit(const Params& P, LAS unsigned char* lds, int u) {
    typedef GemmT<2, 4> G;
    const int tid = opaque_tid(), lane = tid & 63, wid = tid >> 6, wm = wid >> 2, wn = wid & 3, fr = lane & 15, fq = lane >> 4;
    const int sel = u >> 5, rt = u & 31;
    const bf16_t* kv = (const bf16_t*)(P.ws + WS_KV);
    bf16_t* cmph = (bf16_t*)(P.ws + WS_CMPH) + (size_t)sel * 4096 * 256;
    const float* cb = (const float*)(P.ws + WS_CB) + sel * 256;
    const bf16_t* arow[2];
#pragma unroll
    for (int p = 0; p < 2; ++p) { int r = rt * 128 + p * 64 + (tid >> 3); r = r < 4088 ? r : 4087;
        const int b = r / 1022, rem = r % 1022, i = rem >> 1, g = rem & 1;
        arow[p] = kv + (size_t)(b * SEQ + 16 * i) * 768 + sel * 128 + g * 64; }
    f32x4 acc[4][4];
    G::run(acc, arow, 768, P.cmp_w1 + (size_t)sel * 2048 * 256, 256, 32, lds);
#pragma unroll
    for (int mi = 0; mi < 4; ++mi) { const size_t row = (size_t)(rt * 128 + wm * 64 + mi * 16 + fr);
#pragma unroll
        for (int ni = 0; ni < 4; ++ni) { const int col = wn * 64 + ni * 16 + 4 * fq; const f32x4 a = acc[mi][ni]; const f32x4 bb = *(const f32x4*)(cb + col);
            u32x2 pk; pk.x = cvtpk(gelu_tanh(a.x + bb.x), gelu_tanh(a.y + bb.y)); pk.y = cvtpk(gelu_tanh(a.z + bb.z), gelu_tanh(a.w + bb.w));
            *(u32x2*)(cmph + row * 256 + col) = pk; } }
    __syncthreads();
    {
        const int row = tid >> 2, cq = tid & 3;
        const bf16_t* hr = cmph + (size_t)(rt * 128 + row) * 256;
        const float* w2 = P.cmp_w2 + (size_t)sel * 256 * 64 + cq * 16;
        float o[16];
#pragma unroll
        for (int j = 0; j < 16; ++j) o[j] = 0.f;
        for (int k8 = 0; k8 < 256; k8 += 8) {
            const u32x4 hv = *(const u32x4*)(hr + k8);
#pragma unroll
            for (int kk = 0; kk < 8; ++kk) {
                const unsigned wd = hv[kk >> 1]; const float a = (kk & 1) ? __uint_as_float(wd & 0xffff0000u) : __uint_as_float(wd << 16);
                const float* wr = w2 + (size_t)(k8 + kk) * 64;
#pragma unroll
                for (int j4 = 0; j4 < 4; ++j4) { const f32x4 w = *(const f32x4*)(wr + j4 * 4);
                    o[j4 * 4 + 0] += a * w.x; o[j4 * 4 + 1] += a * w.y; o[j4 * 4 + 2] += a * w.z; o[j4 * 4 + 3] += a * w.w; }
            }
        }
        if (sel == 0) { float s = 0.f;
#pragma unroll
            for (int j = 0; j < 16; ++j) s += o[j] * o[j];
            s += __shfl_xor(s, 1); s += __shfl_xor(s, 2);
            const float rstd = rsqrtf(s * (1.f / 64.f) + RMS_EPS);
#pragma unroll
            for (int j = 0; j < 16; ++j) o[j] *= rstd * P.k_norm_w[cq * 16 + j]; }
        const int r = rt * 128 + row;
        if (r < 4088) { const int b = r / 1022, rem = r % 1022, i = rem >> 1, g = rem & 1;
            bf16_t* dst = (bf16_t*)(P.ws + (sel ? WS_VC : WS_KC)) + ((size_t)(b * 2 + g) * 512 + i) * 64 + cq * 16;
            u32x4 w0, w1;
            w0.x = cvtpk(o[0], o[1]); w0.y = cvtpk(o[2], o[3]); w0.z = cvtpk(o[4], o[5]); w0.w = cvtpk(o[6], o[7]);
            w1.x = cvtpk(o[8], o[9]); w1.y = cvtpk(o[10], o[11]); w1.z = cvtpk(o[12], o[13]); w1.w = cvtpk(o[14], o[15]);
            *(u32x4*)dst = w0; *(u32x4*)(dst + 8) = w1; }
    }
    __syncthreads();
}

__device__ __forceinline__ int off_row128(int row, int ch) { return row * 128 + ((ch ^ ((row >> 1) & 7)) << 4); }
__device__ __forceinline__ int off_row256(int row, int ch) { return row * 256 + ((ch ^ (row & 15)) << 4); }
__device__ __forceinline__ int fk_(int r) { return (r & 3) | (((r >> 3) & 1) << 2); }
__device__ __forceinline__ int off_tr256(int row, int col) { return row * 256 + ((((col >> 4) ^ fk_(row)) << 5) + ((col & 15) << 1)); }
constexpr int HL_QT = 0, HL_KT = 16384, HL_KH = 32768, HL_V = 49152, HL_SB = 65536, HL_P = 98304  , HL_TOT = 106496  , HL_RED = 110592  , HL_END = 111104;

template <int MODE> __device__ __forceinline__ void hgrn_unit(const Params& P, LAS unsigned char* lds, int u) {
    const int tid = opaque_tid(), lane = tid & 63, wid = tid >> 6, fr = lane & 15, fq = lane >> 4;
    const int b = u >> 7, h = (u >> 5) & 3, sc = u & 31;
    const bf16_t* hq = (const bf16_t*)(P.ws + WS_HQ); const float* logf = (const float*)(P.ws + WS_LOGF);
    const bf16_t* hv = (const bf16_t*)(P.ws + WS_HV); const bf16_t* hg = (const bf16_t*)(P.ws + WS_HG);
    float* HLs = (float*)(P.ws + WS_HL); float* HDs = (float*)(P.ws + WS_HD);
    bf16_t* mix = (bf16_t*)(P.ws + WS_MIX);
    LAS float* tot = (LAS float*)(lds + HL_TOT); LAS float* red = (LAS float*)(lds + HL_RED);
    f32x4 st[8];
#pragma unroll
    for (int vt = 0; vt < 8; ++vt) st[vt] = (f32x4){0.f, 0.f, 0.f, 0.f};
    if (MODE == 1) {
        const int kk = 16 * wid + fr;
#pragma unroll 4
        for (int j = 0; j < sc; ++j) {
            const float* Lj = HLs + (size_t)(u - sc + j) * 16384 + kk * 128 + 4 * fq; const float dj = HDs[(size_t)(u - sc + j) * 128 + kk];
#pragma unroll
            for (int vt = 0; vt < 8; ++vt) { const f32x4 l = *(const f32x4*)(Lj + vt * 16); st[vt] = st[vt] * dj + l; }
        }
    }
    float dsum = 0.f;
    const int kp = tid & 63, te = tid >> 6;
    for (int c = 0; c < 4; ++c) {
        const size_t tok0 = (size_t)b * SEQ + sc * 256 + c * 64;
        float lf0[8], lf1[8], cs0[8], cs1[8];
        { float a0 = 0.f, a1 = 0.f;
#pragma unroll
          for (int i = 0; i < 8; ++i) { const float2 v = *(const float2*)(logf + (tok0 + te * 8 + i) * 512 + h * 128 + 2 * kp); lf0[i] = v.x; lf1[i] = v.y; a0 += v.x; a1 += v.y; cs0[i] = a0; cs1[i] = a1; }
          tot[te * 128 + 2 * kp] = a0; tot[te * 128 + 2 * kp + 1] = a1; }
#pragma unroll
        for (int i = 0; i < 2; ++i) { const int pc = tid + NTHREADS * i, row = pc >> 4, c8 = (pc & 15) * 8;
            const u32x4 v = *(const u32x4*)(hv + (tok0 + row) * 512 + h * 128 + c8);
            *(LAS u32x4*)(lds + HL_V + off_tr256(row, c8)) = v; }
        if (MODE == 1 ) {
#pragma unroll
            for (int vt = 0; vt < 8; ++vt) { u32x2 pk; pk.x = cvtpk(st[vt].x, st[vt].y); pk.y = cvtpk(st[vt].z, st[vt].w);
                *(LAS u32x2*)(lds + HL_SB + off_tr256(16 * wid + fr, 16 * vt + 4 * fq)) = pk; }
        }
        __syncthreads();
        float pre0 = 0.f, pre1 = 0.f, last0 = 0.f, last1 = 0.f;
#pragma unroll
        for (int e = 0; e < 8; ++e) { const float t0 = tot[e * 128 + 2 * kp], t1 = tot[e * 128 + 2 * kp + 1]; if (e < te) { pre0 += t0; pre1 += t1; } last0 += t0; last1 += t1; }
#pragma unroll
        for (int i = 0; i < 8; ++i) {
            const int t = te * 8 + i;
            const float c0 = cs0[i] + pre0, c1 = cs1[i] + pre1;
            const float k0 = 1.f - __expf(lf0[i]), k1 = 1.f - __expf(lf1[i]);
            const unsigned khat = cvtpk(k0 * __expf(last0 - c0), k1 * __expf(last1 - c1));
            *(LAS unsigned*)(lds + HL_KH + off_tr256(t, 2 * kp)) = khat;
            if (MODE == 1) {
                const unsigned qraw = *(const unsigned*)(hq + (tok0 + t) * 512 + h * 128 + 2 * kp);
                const float q0 = __uint_as_float(qraw << 16), q1 = __uint_as_float(qraw & 0xffff0000u);
                const unsigned qt = cvtpk(q0 * __expf(c0), q1 * __expf(c1));
                const unsigned kt = cvtpk(k0 * __expf(fminf(-c0, 80.f)), k1 * __expf(fminf(-c1, 80.f)));
                const int o = off_row256(t, kp >> 2) + ((kp & 3) << 2);
                *(LAS unsigned*)(lds + HL_QT + o) = qt; *(LAS unsigned*)(lds + HL_KT + o) = kt;
            }
        }
        const float dec = __expf(tot[0 * 128 + 16 * wid + fr] + tot[1 * 128 + 16 * wid + fr] + tot[2 * 128 + 16 * wid + fr] + tot[3 * 128 + 16 * wid + fr]
                                 + tot[4 * 128 + 16 * wid + fr] + tot[5 * 128 + 16 * wid + fr] + tot[6 * 128 + 16 * wid + fr] + tot[7 * 128 + 16 * wid + fr]);
        if (MODE == 0 && tid < 128) { float s = 0.f;
#pragma unroll
            for (int e = 0; e < 8; ++e) s += tot[e * 128 + tid];
            dsum += s; }
        __syncthreads();
        f32x4 oacc[4];
        if (MODE == 1) {
            { const int tt = wid & 3;
#pragma unroll
              for (int si = 0; si < 2; ++si) { const int stl = 2 * (wid >> 2) + si;
                  f32x4 sacc = (f32x4){0.f, 0.f, 0.f, 0.f};
                  if (stl <= tt) {
#pragma unroll
                      for (int ks = 0; ks < 4; ++ks) {
                          const bf16x8 a = *(const LAS bf16x8*)(lds + HL_KT + off_row256(stl * 16 + fr, ks * 4 + fq));
                          const bf16x8 bq = *(const LAS bf16x8*)(lds + HL_QT + off_row256(tt * 16 + fr, ks * 4 + fq));
                          sacc = __builtin_amdgcn_mfma_f32_16x16x32_bf16(a, bq, sacc, 0, 0, 0);
                      }
                  }
                  const int t = tt * 16 + fr, s0 = stl * 16 + 4 * fq;
                  u32x2 pk; pk.x = cvtpk(s0 + 0 <= t ? sacc.x : 0.f, s0 + 1 <= t ? sacc.y : 0.f); pk.y = cvtpk(s0 + 2 <= t ? sacc.z : 0.f, s0 + 3 <= t ? sacc.w : 0.f);
                  *(LAS u32x2*)(lds + HL_P + off_row128(t, s0 >> 3) + ((s0 & 7) << 1)) = pk; }
            }
            __syncthreads();
            { const int tt = wid >> 1;
#pragma unroll
              for (int i = 0; i < 4; ++i) { const int vt = 4 * (wid & 1) + i;
                  f32x4 a = (f32x4){0.f, 0.f, 0.f, 0.f};
#pragma unroll
                  for (int ks = 0; ks < 2; ++ks) {
                      const int kr = ks * 32 + 8 * fq + (fr >> 2);
                      const s16x4 lo = lds_tr(lds + HL_V + off_tr256(kr, vt * 16 + 4 * (fr & 3))), hi = lds_tr(lds + HL_V + off_tr256(kr + 4, vt * 16 + 4 * (fr & 3)));
                      const bf16x8 va = (bf16x8){lo[0], lo[1], lo[2], lo[3], hi[0], hi[1], hi[2], hi[3]};
                      const bf16x8 pb = *(const LAS bf16x8*)(lds + HL_P + off_row128(tt * 16 + fr, ks * 4 + fq));
                      a = __builtin_amdgcn_mfma_f32_16x16x32_bf16(va, pb, a, 0, 0, 0);
                  }
#pragma unroll
                  for (int ks = 0; ks < 4; ++ks) {
                      const int kr = ks * 32 + 8 * fq + (fr >> 2);
                      const s16x4 lo = lds_tr(lds + HL_SB + off_tr256(kr, vt * 16 + 4 * (fr & 3))), hi = lds_tr(lds + HL_SB + off_tr256(kr + 4, vt * 16 + 4 * (fr & 3)));
                      const bf16x8 sa = (bf16x8){lo[0], lo[1], lo[2], lo[3], hi[0], hi[1], hi[2], hi[3]};
                      const bf16x8 qb = *(const LAS bf16x8*)(lds + HL_QT + off_row256(tt * 16 + fr, ks * 4 + fq));
                      a = __builtin_amdgcn_mfma_f32_16x16x32_bf16(sa, qb, a, 0, 0, 0);
                  }
                  const u32x2 gr = *(const u32x2*)(hg + (tok0 + tt * 16 + fr) * 512 + h * 128 + vt * 16 + 4 * fq);
                  a.x *= __uint_as_float(gr.x << 16); a.y *= __uint_as_float(gr.x & 0xffff0000u); a.z *= __uint_as_float(gr.y << 16); a.w *= __uint_as_float(gr.y & 0xffff0000u);
                  oacc[i] = a; }
              float ss = 0.f;
#pragma unroll
              for (int i = 0; i < 4; ++i) ss += (oacc[i].x * oacc[i].x + oacc[i].y * oacc[i].y) + (oacc[i].z * oacc[i].z + oacc[i].w * oacc[i].w);
              ss += __shfl_xor(ss, 16); ss += __shfl_xor(ss, 32);
              if (fq == 0) red[(tt * 2 + (wid & 1)) * 16 + fr] = ss; }
        }
#pragma unroll
        for (int vt = 0; vt < 8; ++vt) {
            f32x4 a = st[vt] * dec;
#pragma unroll
            for (int ks = 0; ks < 2; ++ks) {
                const int kr = ks * 32 + 8 * fq + (fr >> 2);
                const s16x4 lo = lds_tr(lds + HL_V + off_tr256(kr, vt * 16 + 4 * (fr & 3))), hi = lds_tr(lds + HL_V + off_tr256(kr + 4, vt * 16 + 4 * (fr & 3)));
                const bf16x8 va = (bf16x8){lo[0], lo[1], lo[2], lo[3], hi[0], hi[1], hi[2], hi[3]};
                const s16x4 lo2 = lds_tr(lds + HL_KH + off_tr256(kr, wid * 16 + 4 * (fr & 3))), hi2 = lds_tr(lds + HL_KH + off_tr256(kr + 4, wid * 16 + 4 * (fr & 3)));
                const bf16x8 kb = (bf16x8){lo2[0], lo2[1], lo2[2], lo2[3], hi2[0], hi2[1], hi2[2], hi2[3]};
                a = __builtin_amdgcn_mfma_f32_16x16x32_bf16(va, kb, a, 0, 0, 0);
            }
            st[vt] = a;
        }
        __syncthreads();
        if (MODE == 1) {
            const int tt = wid >> 1; const float ssum = red[(tt * 2) * 16 + fr] + red[(tt * 2 + 1) * 16 + fr];
            const float rstd = rsqrtf(ssum * (1.f / 128.f) + RMS_EPS);
#pragma unroll
            for (int i = 0; i < 4; ++i) { const int v = (4 * (wid & 1) + i) * 16 + 4 * fq; const f32x4 w = *(const f32x4*)(P.rec_out_norm_w + h * 128 + v);
                u32x2 pk; pk.x = cvtpk(oacc[i].x * rstd * w.x, oacc[i].y * rstd * w.y); pk.y = cvtpk(oacc[i].z * rstd * w.z, oacc[i].w * rstd * w.w);
                *(u32x2*)(mix + (tok0 + tt * 16 + fr) * 1024 + 512 + h * 128 + v) = pk; }
        }
    }
    if (MODE == 0) {
#pragma unroll
        for (int vt = 0; vt < 8; ++vt) *(f32x4*)(HLs + (size_t)u * 16384 + (16 * wid + fr) * 128 + vt * 16 + 4 * fq) = st[vt];
        if (tid < 128) HDs[(size_t)u * 128 + tid] = __expf(dsum);
    }
    __syncthreads();
}


constexpr int NL_K = 0, NL_V = 16384, NL_IMP = 32768, NL_IMP_STRIDE = 132, NL_SELM = NL_IMP + 8 * 8 * NL_IMP_STRIDE * 4, NL_END = NL_SELM + 1024;
__device__ __forceinline__ int off_v128(int row, int ch) { return row * 128 + ((ch ^ ((row & 3) << 1)) << 4); }
#define MFMA32(a, b, c) __builtin_amdgcn_mfma_f32_32x32x16_bf16(a, b, c, 0, 0, 0)

struct NsaLane { int t; float sl2; int qi; unsigned long long mlo, mhi; };

template <int MODE> __device__ __forceinline__ void nsa_pass(LAS unsigned char* lds, const bf16_t* Kg, const bf16_t* Vg, int rs, unsigned long long ulo, unsigned long long uhi,
                                                            const bf16x8 (&qf)[4], const NsaLane& L, float inv, float& lsum, f32x16 (&O)[2], LAS float* impw) {
    const int tid = opaque_tid(), lane = tid & 63, hi = lane >> 5, c = lane & 31;
    const int ld_row = tid >> 3, ld_ch = tid & 7;
    const int kw_off = off_row128(ld_row, ld_ch), vw_off = off_v128(ld_row, ld_ch);
    u32x4 k0, v0, k1, v1, k2, v2;
    auto next = [&](int jj) -> int { ++jj; if (jj < 64) { const unsigned long long m = ulo >> jj; if (m) return jj + __builtin_ctzll(m); jj = 64; }
                                     if (jj < 128) { const unsigned long long m = uhi >> (jj - 64); if (m) return jj + __builtin_ctzll(m); } return 128; };
    int jA = next(-1), jB = jA < 128 ? next(jA) : 128, jC = jB < 128 ? next(jB) : 128;
    const int jsafe = jA < 128 ? jA : 0;
    auto ldk = [&](int jj) -> u32x4 { const int q = jj < 128 ? jj : jsafe; return *(const u32x4*)(Kg + (size_t)(q * 64 + ld_row) * rs + ld_ch * 8); };
    auto ldv = [&](int jj) -> u32x4 { const int q = jj < 128 ? jj : jsafe; return *(const u32x4*)(Vg + (size_t)(q * 64 + ld_row) * rs + ld_ch * 8); };
    k0 = ldk(jA); k1 = ldk(jB); k2 = ldk(jC);
    if (MODE != 0) { v0 = ldv(jA); v1 = ldv(jB); v2 = ldv(jC); }
    int it = 0;
    auto step = [&](u32x4& kreg, u32x4& vreg) {
        const int j = jA;
        LAS unsigned char* kb = lds + NL_K + (it & 1) * 8192; LAS unsigned char* vb = lds + NL_V + (it & 1) * 8192;
        *(LAS u32x4*)(kb + kw_off) = kreg; if (MODE != 0) *(LAS u32x4*)(vb + vw_off) = vreg;
        const int jD = jC < 128 ? next(jC) : 128;
        kreg = ldk(jD); if (MODE != 0) vreg = ldv(jD);
        __syncthreads();
        bool need = true; bool selbit = true;
        if (MODE == 2) { selbit = (j < 64 ? (L.mlo >> j) : (L.mhi >> (j - 64))) & 1ull; need = __any(selbit); }
        if (need) {
            f32x16 p0 = {}, p1 = {};
#pragma unroll
            for (int ks = 0; ks < 4; ++ks) {
                const bf16x8 a0 = *(const LAS bf16x8*)(kb + off_row128(c, 2 * ks + hi)), a1 = *(const LAS bf16x8*)(kb + off_row128(32 + c, 2 * ks + hi));
                p0 = MFMA32(a0, qf[ks], p0); p1 = MFMA32(a1, qf[ks], p1);
            }
            const int stride = (MODE <= 1) ? 16 : 1;
            const int dl = (MODE <= 1) ? (L.t - 31 - 16 * (j * 64 + 4 * hi)) : (L.t - (j * 64 + 4 * hi));
            const float nb = -L.sl2 * (float)dl, sls = L.sl2 * (float)stride;
            float rs_ = 0.f;
#pragma unroll
            for (int r = 0; r < 16; ++r) {
                const int ro0 = (r & 3) + 8 * (r >> 2), ro1 = ro0 + 32;
                const int d0 = dl - stride * ro0, d1 = dl - stride * ro1;
                bool v0 = d0 >= 0, v1 = d1 >= 0;
                if (MODE == 3) { v0 = v0 && d0 < 512; v1 = v1 && d1 < 512; }
                if (MODE == 2) { v0 = v0 && selbit; v1 = v1 && selbit; }
                float e0 = __builtin_amdgcn_exp2f(__builtin_fmaf(p0[r], LOG2E, __builtin_fmaf(sls, (float)ro0, nb)));
                float e1 = __builtin_amdgcn_exp2f(__builtin_fmaf(p1[r], LOG2E, __builtin_fmaf(sls, (float)ro1, nb)));
                e0 = v0 ? e0 : 0.f; e1 = v1 ? e1 : 0.f;
                if (MODE == 1) { e0 *= inv; e1 *= inv; }
                p0[r] = e0; p1[r] = e1; rs_ += e0 + e1;
            }
            lsum += rs_;
            if (MODE == 1) {
#pragma unroll
                for (int kt = 0; kt < 2; ++kt)
#pragma unroll
                    for (int i = 0; i < 4; ++i) {
                        float g = kt ? (p1[4 * i] + p1[4 * i + 1]) + (p1[4 * i + 2] + p1[4 * i + 3]) : (p0[4 * i] + p0[4 * i + 1]) + (p0[4 * i + 2] + p0[4 * i + 3]);
                        float l3 = kt ? p1[4 * i + 3] : p0[4 * i + 3];
                        g += __shfl_xor(g, 1); g += __shfl_xor(g, 2); l3 += __shfl_xor(l3, 1); l3 += __shfl_xor(l3, 2);
                        if ((c & 3) == 0) { const int jj = j * 16 + kt * 8 + 2 * i + hi; __hip_atomic_fetch_add(impw + L.qi * NL_IMP_STRIDE + jj, g, __ATOMIC_RELAXED, __HIP_MEMORY_SCOPE_WORKGROUP); __hip_atomic_fetch_add(impw + L.qi * NL_IMP_STRIDE + jj + 1, l3, __ATOMIC_RELAXED, __HIP_MEMORY_SCOPE_WORKGROUP); }
                    }
            }
            if (MODE != 0) {
                bf16x8 pf[4];
#pragma unroll
                for (int s4 = 0; s4 < 4; ++s4) { u32x4 w;
#pragma unroll
                    for (int e = 0; e < 4; ++e) { const int r = 8 * (s4 & 1) + 2 * e; w[e] = (s4 >> 1) ? cvtpk(p1[r], p1[r + 1]) : cvtpk(p0[r], p0[r + 1]); }
                    pf[s4] = __builtin_bit_cast(bf16x8, w); }
                const int g4 = lane >> 4, sub = g4 & 1, i16 = lane & 15, qq = i16 >> 2, pp = i16 & 3;
#pragma unroll
                for (int dt = 0; dt < 2; ++dt)
#pragma unroll
                    for (int s4 = 0; s4 < 4; ++s4) {
                        const int row = 16 * s4 + 4 * hi + qq, ch = 4 * dt + 2 * sub + (pp >> 1);
                        const s16x4 lo = lds_tr(vb + off_v128(row, ch) + 8 * (pp & 1)), hh = lds_tr(vb + off_v128(row + 8, ch) + 8 * (pp & 1));
                        const bf16x8 vf = (bf16x8){lo[0], lo[1], lo[2], lo[3], hh[0], hh[1], hh[2], hh[3]};
                        O[dt] = MFMA32(vf, pf[s4], O[dt]);
                    }
            }
        }
        jA = jB; jB = jC; jC = jD; ++it;
    };
    while (jA < 128) {
        step(k0, v0); if (jA >= 128) break;
        step(k1, v1); if (jA >= 128) break;
        step(k2, v2);
    }
    __syncthreads();
}

__device__ __forceinline__ void nsa_unit(const Params& P, LAS unsigned char* lds, int u) {
    const int tid = opaque_tid(), lane = tid & 63, wid = tid >> 6, hi = lane >> 5, c = lane & 31;
    const int b = u >> 8, g = (u >> 7) & 1, qb = u & 127;
    const bf16_t* qg = (const bf16_t*)(P.ws + WS_Q); const bf16_t* kv = (const bf16_t*)(P.ws + WS_KV);
    const bf16_t* kcn = (const bf16_t*)(P.ws + WS_KC) + (size_t)(b * 2 + g) * 512 * 64; const bf16_t* vcc = (const bf16_t*)(P.ws + WS_VC) + (size_t)(b * 2 + g) * 512 * 64;
    const float* gates = (const float*)(P.ws + WS_GATES); bf16_t* mix = (bf16_t*)(P.ws + WS_MIX);
    LAS float* impw = (LAS float*)(lds + NL_IMP) + wid * 8 * NL_IMP_STRIDE;
    LAS unsigned long long* selm = (LAS unsigned long long*)(lds + NL_SELM);
    NsaLane L; L.qi = c >> 2; const int hh = c & 3, head = g * 4 + hh;
    L.t = qb * 64 + wid * 8 + L.qi; L.sl2 = exp2f(-(float)(head + 1)) * LOG2E; L.mlo = 0; L.mhi = 0;
    const size_t tok = (size_t)b * SEQ + L.t;
    bf16x8 qf[4];
#pragma unroll
    for (int ks = 0; ks < 4; ++ks) qf[ks] = *(const bf16x8*)(qg + tok * 512 + head * 64 + 16 * ks + 8 * hi);
    for (int i = lane; i < 8 * NL_IMP_STRIDE; i += 64) impw[i] = 0.f;
    const int ncmp = qb * 4 + 3 < 511 ? qb * 4 + 3 : 511;
    const int nblk = (ncmp + 63) >> 6;
    const unsigned long long cm = nblk >= 64 ? ~0ull : ((1ull << nblk) - 1ull);
    f32x16 O[2], Ot[2]; float lsum = 0.f;
    O[0] = f32x16{}; O[1] = f32x16{};
    nsa_pass<0>(lds, kcn, vcc, 64, cm, 0ull, qf, L, 1.f, lsum, O, impw);
    lsum += __shfl_xor(lsum, 32);
    const float invc = 1.0f / fmaxf(lsum, 1e-30f);
    float dummy = 0.f;
    nsa_pass<1>(lds, kcn, vcc, 64, cm, 0ull, qf, L, invc, dummy, O, impw);
    const float* gt = gates + tok * 24 + g * 12 + hh * 3;
    const float g0 = gt[0], g1 = gt[1], g2 = gt[2];
#pragma unroll
    for (int dt = 0; dt < 2; ++dt) Ot[dt] = O[dt] * g0;
    {
        const int ncausal = qb + 1;
        for (int qi = 0; qi < 8; ++qi) {
            unsigned long long lo, hi64;
            if (ncausal <= 16) { lo = (1ull << ncausal) - 1ull; hi64 = 0ull; }
            else {
                const int j0 = lane, j1 = lane + 64;
                const bool f0 = (j0 == 0) || (j0 == qb) || (j0 == qb - 1), f1 = (j1 == qb) || (j1 == qb - 1);
                const unsigned k0 = (j0 <= qb && !f0) ? (0x80000000u | (__float_as_uint(impw[qi * NL_IMP_STRIDE + j0]) & 0x7fffff80u) | (unsigned)j0) : 0u;
                const unsigned k1 = (j1 <= qb && !f1) ? (0x80000000u | (__float_as_uint(impw[qi * NL_IMP_STRIDE + j1]) & 0x7fffff80u) | (unsigned)j1) : 0u;
                const int needn = 13;
                unsigned th = 0u;
                for (int bit = 31; bit >= 0; --bit) { const unsigned cand = th | (1u << bit);
                    const int cnt = __popcll(__ballot(k0 >= cand)) + __popcll(__ballot(k1 >= cand));
                    if (cnt >= needn) th = cand; }
                lo = __ballot(f0 || (k0 >= th && k0 != 0u)); hi64 = __ballot(f1 || (k1 >= th && k1 != 0u));
            }
            if (lane == 0) { selm[(wid * 8 + qi) * 2] = lo; selm[(wid * 8 + qi) * 2 + 1] = hi64; }
        }
    }
    __syncthreads();
    unsigned long long ulo = selm[lane * 2], uhi = selm[lane * 2 + 1];
#pragma unroll
    for (int o = 1; o < 64; o <<= 1) { ulo |= __shfl_xor(ulo, o); uhi |= __shfl_xor(uhi, o); }
    L.mlo = selm[(wid * 8 + L.qi) * 2]; L.mhi = selm[(wid * 8 + L.qi) * 2 + 1];
    const bf16_t* kvb = kv + (size_t)b * SEQ * 768 + g * 64;
    O[0] = f32x16{}; O[1] = f32x16{}; lsum = 0.f;
    nsa_pass<2>(lds, kvb + 256, kvb + 384, 768, ulo, uhi, qf, L, 1.f, lsum, O, impw);
    lsum += __shfl_xor(lsum, 32);
    { const float sc = g1 / fmaxf(lsum, 1e-30f);
#pragma unroll
      for (int dt = 0; dt < 2; ++dt) Ot[dt] += O[dt] * sc; }
    {
        const int jlo = qb >= 8 ? qb - 8 : 0;
        unsigned long long wlo = 0ull, whi = 0ull;
        for (int jj = jlo; jj <= qb; ++jj) { if (jj < 64) wlo |= 1ull << jj; else whi |= 1ull << (jj - 64); }
        O[0] = f32x16{}; O[1] = f32x16{}; lsum = 0.f;
        nsa_pass<3>(lds, kvb + 512, kvb + 640, 768, wlo, whi, qf, L, 1.f, lsum, O, impw);
        lsum += __shfl_xor(lsum, 32);
        const float sc = g2 / fmaxf(lsum, 1e-30f);
#pragma unroll
        for (int dt = 0; dt < 2; ++dt) Ot[dt] += O[dt] * sc;
    }
    float ss = 0.f;
#pragma unroll
    for (int dt = 0; dt < 2; ++dt)
#pragma unroll
        for (int r = 0; r < 16; ++r) ss += Ot[dt][r] * Ot[dt][r];
    ss += __shfl_xor(ss, 32);
    const float rstd = rsqrtf(ss * (1.f / 64.f) + RMS_EPS);
#pragma unroll
    for (int dt = 0; dt < 2; ++dt)
#pragma unroll
        for (int r4 = 0; r4 < 4; ++r4) { const int d = 32 * dt + 8 * r4 + 4 * hi; const f32x4 w = *(const f32x4*)(P.attn_out_norm_w + head * 64 + d);
            u32x2 pk; pk.x = cvtpk(Ot[dt][4 * r4] * rstd * w.x, Ot[dt][4 * r4 + 1] * rstd * w.y); pk.y = cvtpk(Ot[dt][4 * r4 + 2] * rstd * w.z, Ot[dt][4 * r4 + 3] * rstd * w.w);
            *(u32x2*)(mix + tok * 1024 + head * 64 + d) = pk; }
    __syncthreads();
}


__device__ __forceinline__ void phase_cvt_small(const Params& P) {
    const int tid = threadIdx.x;
    {
        const int gt = blockIdx.x * NTHREADS + tid, NG = gridDim.x * NTHREADS;
        bf16_t* wo = (bf16_t*)(P.ws + WS_WOUT); bf16_t* wrs = (bf16_t*)(P.ws + WS_WRS); bf16_t* wsd = (bf16_t*)(P.ws + WS_WSD);
        for (int i = gt; i < 1024 * 128; i += NG) { const f32x4 a = *(const f32x4*)(P.w_out + (size_t)i * 8), b2 = *(const f32x4*)(P.w_out + (size_t)i * 8 + 4);
            *(u32x4*)(wo + (size_t)i * 8) = (u32x4){cvtpk(a.x, a.y), cvtpk(a.z, a.w), cvtpk(b2.x, b2.y), cvtpk(b2.z, b2.w)}; }
        for (int i = gt; i < 256 * 128; i += NG) { const f32x4 a = *(const f32x4*)(P.sh_wd + (size_t)i * 8), b2 = *(const f32x4*)(P.sh_wd + (size_t)i * 8 + 4);
            *(u32x4*)(wsd + (size_t)i * 8) = (u32x4){cvtpk(a.x, a.y), cvtpk(a.z, a.w), cvtpk(b2.x, b2.y), cvtpk(b2.z, b2.w)}; }
        for (int i = gt; i < 1024 * 96; i += NG) { const int k = i / 96, c8 = (i % 96) * 8;
            const float* s;
            if (c8 < 256) s = P.router_w + (size_t)k * 256 + c8;
            else { const int cc = c8 - 256, t = cc >> 8, u16 = (cc & 255) >> 4; s = ((u16 & 1) ? P.sh_wu : P.sh_wg) + (size_t)k * 256 + t * 128 + (u16 >> 1) * 16 + (cc & 8); }
            const f32x4 a = *(const f32x4*)s, b2 = *(const f32x4*)(s + 4);
            *(u32x4*)(wrs + (size_t)k * 768 + c8) = (u32x4){cvtpk(a.x, a.y), cvtpk(a.z, a.w), cvtpk(b2.x, b2.y), cvtpk(b2.z, b2.w)}; }
    }
}

__device__ __forceinline__ void route_token(const Params& P, int t, int lane) {
    const float* scores = (const float*)(P.ws + WS_SCORES) + (size_t)t * 256;
    const f32x4 s4 = *(const f32x4*)(scores + 4 * lane); const f32x4 b4 = *(const f32x4*)(P.router_bias + 4 * lane);
    float sc[4] = {s4.x, s4.y, s4.z, s4.w};
    float bs[4] = {s4.x + b4.x, s4.y + b4.y, s4.z + b4.z, s4.w + b4.w};
    float m1 = fmaxf(bs[0], bs[1]), m2 = fminf(bs[0], bs[1]);
    { const float v = bs[2]; const float n1 = fmaxf(m1, v); m2 = fmaxf(fminf(m1, v), m2); m1 = n1; }
    { const float v = bs[3]; const float n1 = fmaxf(m1, v); m2 = fmaxf(fminf(m1, v), m2); m1 = n1; }
#pragma unroll
    for (int o = 1; o < 8; o <<= 1) { const float o1 = __shfl_xor(m1, o), o2 = __shfl_xor(m2, o); const float n1 = fmaxf(m1, o1); m2 = fmaxf(fminf(m1, o1), fmaxf(m2, o2)); m1 = n1; }
    const float gs = m1 + m2;
    const int grp = lane >> 3;
    int rank = 0;
#pragma unroll
    for (int g2 = 0; g2 < 8; ++g2) { const float og = __shfl(gs, g2 * 8); rank += (og > gs || (og == gs && g2 < grp)) ? 1 : 0; }
    const bool gsel = rank < 4;
    float mv[4];
#pragma unroll
    for (int i = 0; i < 4; ++i) mv[i] = gsel ? bs[i] : -INFINITY;
    int myidx = -1; float myw = 0.f; float wsum = 0.f;
#pragma unroll 1
    for (int k = 0; k < 8; ++k) {
        float bv = mv[0]; int bi = 4 * lane;
#pragma unroll
        for (int i = 1; i < 4; ++i) if (mv[i] > bv) { bv = mv[i]; bi = 4 * lane + i; }
#pragma unroll
        for (int o = 1; o < 64; o <<= 1) { const float ov = __shfl_xor(bv, o); const int oi = __shfl_xor(bi, o); if (ov > bv || (ov == bv && oi < bi)) { bv = ov; bi = oi; } }
        const int wl = bi >> 2, wc = bi & 3;
        const float mine = wc == 0 ? sc[0] : (wc == 1 ? sc[1] : (wc == 2 ? sc[2] : sc[3]));
        const float wv = __shfl(mine, wl);
        wsum += wv;
        if (lane == k) { myidx = bi; myw = wv; }
        if (lane == wl) {
#pragma unroll
            for (int i = 0; i < 4; ++i) if (i == wc) mv[i] = -INFINITY; }
    }
    if (lane < 8) {
        int* cnt = (int*)(P.ws + WS_CTL + CTL_CNT);
        const int pos = atomicAdd(cnt + myidx, 1);
        if (pos < BCAP) ((int*)(P.ws + WS_BUCKET))[(size_t)myidx * BCAP + pos] = t * 8 + lane;
        ((float*)(P.ws + WS_RW))[(size_t)t * 8 + lane] = myw / wsum * 2.5f;
    }
}


__device__ __forceinline__ void phase_p4a(const Params& P, LAS unsigned char* lds) {
    typedef Gemm3 G;
    const int tid = opaque_tid(), lane = tid & 63, wid = tid >> 6, wm = wid >> 1, wn = wid & 1, fr = lane & 15, fq = lane >> 4;
    struct F { const Params& P;
        __device__ __forceinline__ void ptrs(int seg, const bf16_t* (&aptr)[2], const bf16_t* (&bptr)[2]) const {
            const int tid = opaque_tid(), lane = tid & 63, wid = tid >> 6, wm = wid >> 1, wn = wid & 1, fr = lane & 15, fq = lane >> 4, c8 = 8 * (tid & 31); (void)wm; (void)wn; (void)fr; (void)fq; (void)c8;
            const int u = blockIdx.x + seg * gridDim.x, rt = u >> 2, ct = u & 3;
            const bf16_t* mix = (const bf16_t*)(P.ws + WS_MIX); const bf16_t* wo = (const bf16_t*)(P.ws + WS_WOUT);
#pragma unroll
            for (int i = 0; i < 2; ++i) { const int row = G::a_row(i, wid, lane); aptr[i] = mix + (size_t)(rt * 256 + row) * 1024 + G::a_chunk(row, lane) * 8;
                const int k = G::b_k(i, wid, lane); bptr[i] = wo + (size_t)k * 1024 + ct * 256 + G::b_n(k, lane); } }
        __device__ __forceinline__ void epi(int seg, f32x4 (&acc)[4][8]) const {
            const int tid = opaque_tid(), lane = tid & 63, wid = tid >> 6, wm = wid >> 1, wn = wid & 1, fr = lane & 15, fq = lane >> 4, c8 = 8 * (tid & 31); (void)wm; (void)wn; (void)fr; (void)fq; (void)c8;
            const int u = blockIdx.x + seg * gridDim.x, rt = u >> 2, ct = u & 3, b = (rt * 256) / SEQ;
            const float* mod = (const float*)(P.ws + WS_MOD) + b * 6144; float* ssp = (float*)(P.ws + WS_SS);
#pragma unroll
            for (int mi = 0; mi < 4; ++mi) { const size_t m = (size_t)(rt * 256 + wm * 64 + mi * 16 + fr); float ss = 0.f;
#pragma unroll
                for (int ni = 0; ni < 8; ++ni) { const int col = ct * 256 + wn * 128 + ni * 16 + 4 * fq;
                    const f32x4 xv = *(const f32x4*)(P.x + m * 1024 + col), gv = *(const f32x4*)(mod + 2048 + col); const f32x4 a = acc[mi][ni];
                    f32x4 o; o.x = xv.x + gv.x * a.x; o.y = xv.y + gv.y * a.y; o.z = xv.z + gv.z * a.z; o.w = xv.w + gv.w * a.w;
                    *(f32x4*)(P.out + m * 1024 + col) = o; ss += (o.x * o.x + o.y * o.y) + (o.z * o.z + o.w * o.w); if (ni & 1) asm volatile("" ::: "memory"); }
                ss += __shfl_xor(ss, 16); ss += __shfl_xor(ss, 32);
                if (fq == 0) ssp[m * 8 + ct * 2 + wn] = ss; } }
    } f{P};
    const int nu = (128 * 4 - (int)blockIdx.x + (int)gridDim.x - 1) / (int)gridDim.x;
    if (nu > 0) G::run_stream(f, nu, 32, 32, (size_t)32 * 1024, lds);
}
__device__ __forceinline__ void phase_p4b(const Params& P) {
    const int lane = threadIdx.x & 63, gw = blockIdx.x * (NTHREADS / 64) + (threadIdx.x >> 6), NGW = gridDim.x * (NTHREADS / 64);
    const float* ssp = (const float*)(P.ws + WS_SS); bf16_t* h2 = (bf16_t*)(P.ws + WS_H);
    for (int m = gw; m < T; m += NGW) {
        const float* mod = (const float*)(P.ws + WS_MOD) + (m / SEQ) * 6144;
        const f32x4 s0 = *(const f32x4*)(ssp + (size_t)m * 8), s1 = *(const f32x4*)(ssp + (size_t)m * 8 + 4);
        const float rstd = rsqrtf(((s0.x + s0.y) + (s0.z + s0.w) + (s1.x + s1.y) + (s1.z + s1.w)) * (1.f / 1024.f) + RMS_EPS);
#pragma unroll
        for (int j = 0; j < 4; ++j) { const int col = (lane + 64 * j) * 4;
            const f32x4 v = *(const f32x4*)(P.out + (size_t)m * 1024 + col), wv = *(const f32x4*)(P.norm2_w + col), scv = *(const f32x4*)(mod + 4096 + col), shv = *(const f32x4*)(mod + 3072 + col);
            u32x2 pk; pk.x = cvtpk(v.x * rstd * wv.x * (1.f + scv.x) + shv.x, v.y * rstd * wv.y * (1.f + scv.y) + shv.y);
            pk.y = cvtpk(v.z * rstd * wv.z * (1.f + scv.z) + shv.z, v.w * rstd * wv.w * (1.f + scv.w) + shv.w);
            *(u32x2*)(h2 + (size_t)m * 1024 + col) = pk; }
    }
}
__device__ __forceinline__ void phase_p4c(const Params& P, LAS unsigned char* lds) {
    typedef Gemm3 G;
    const int tid = opaque_tid(), lane = tid & 63, wid = tid >> 6, wm = wid >> 1, wn = wid & 1, fr = lane & 15, fq = lane >> 4;
    struct F { const Params& P;
        __device__ __forceinline__ void ptrs(int seg, const bf16_t* (&aptr)[2], const bf16_t* (&bptr)[2]) const {
            const int tid = opaque_tid(), lane = tid & 63, wid = tid >> 6, wm = wid >> 1, wn = wid & 1, fr = lane & 15, fq = lane >> 4, c8 = 8 * (tid & 31); (void)wm; (void)wn; (void)fr; (void)fq; (void)c8;
            const int u = blockIdx.x + seg * gridDim.x, rt = u / 3, ct = u % 3;
            const bf16_t* h2 = (const bf16_t*)(P.ws + WS_H); const bf16_t* wrs = (const bf16_t*)(P.ws + WS_WRS);
#pragma unroll
            for (int i = 0; i < 2; ++i) { const int row = G::a_row(i, wid, lane); aptr[i] = h2 + (size_t)(rt * 256 + row) * 1024 + G::a_chunk(row, lane) * 8;
                const int k = G::b_k(i, wid, lane); bptr[i] = wrs + (size_t)k * 768 + ct * 256 + G::b_n(k, lane); } }
        __device__ __forceinline__ void epi(int seg, f32x4 (&acc)[4][8]) const {
            const int tid = opaque_tid(), lane = tid & 63, wid = tid >> 6, wm = wid >> 1, wn = wid & 1, fr = lane & 15, fq = lane >> 4, c8 = 8 * (tid & 31); (void)wm; (void)wn; (void)fr; (void)fq; (void)c8;
            const int u = blockIdx.x + seg * gridDim.x, rt = u / 3, ct = u % 3;
            float* scores = (float*)(P.ws + WS_SCORES); bf16_t* hidS = (bf16_t*)(P.ws + WS_HIDS);
#pragma unroll
            for (int mi = 0; mi < 4; ++mi) { const size_t m = (size_t)(rt * 256 + wm * 64 + mi * 16 + fr);
                if (ct == 0) {
#pragma unroll
                    for (int ni = 0; ni < 8; ++ni) { const f32x4 a = acc[mi][ni];
                        *(f32x4*)(scores + m * 256 + wn * 128 + ni * 16 + 4 * fq) = (f32x4){sigmoidf_(a.x), sigmoidf_(a.y), sigmoidf_(a.z), sigmoidf_(a.w)}; }
                } else {
#pragma unroll
                    for (int j = 0; j < 4; ++j) { const f32x4 g = acc[mi][2 * j], uu = acc[mi][2 * j + 1];
                        u32x2 pk; pk.x = cvtpk(siluf_(g.x) * uu.x, siluf_(g.y) * uu.y); pk.y = cvtpk(siluf_(g.z) * uu.z, siluf_(g.w) * uu.w);
                        *(u32x2*)(hidS + m * 256 + (ct - 1) * 128 + wn * 64 + j * 16 + 4 * fq) = pk; }
                } } }
    } f{P};
    const int nu = (128 * 3 - (int)blockIdx.x + (int)gridDim.x - 1) / (int)gridDim.x;
    if (nu > 0) G::run_stream(f, nu, 32, 32, (size_t)32 * 768, lds);
}
__device__ __forceinline__ void phase_route(const Params& P) {
    const int tid = opaque_tid(), lane = tid & 63, gw = blockIdx.x * (NTHREADS / 64) + (tid >> 6), NGW = gridDim.x * (NTHREADS / 64);
    for (int t = gw; t < T; t += NGW) route_token(P, t, lane);
}
__device__ __forceinline__ void phase_p4d(const Params& P, LAS unsigned char* lds) {
    typedef Gemm3 G;
    const int tid = opaque_tid(), lane = tid & 63, wid = tid >> 6, wm = wid >> 1, wn = wid & 1, fr = lane & 15, fq = lane >> 4;
    struct F { const Params& P;
        __device__ __forceinline__ void ptrs(int seg, const bf16_t* (&aptr)[2], const bf16_t* (&bptr)[2]) const {
            const int tid = opaque_tid(), lane = tid & 63, wid = tid >> 6, wm = wid >> 1, wn = wid & 1, fr = lane & 15, fq = lane >> 4, c8 = 8 * (tid & 31); (void)wm; (void)wn; (void)fr; (void)fq; (void)c8;
            const int u = blockIdx.x + seg * gridDim.x, rt = u >> 2, ct = u & 3;
            const bf16_t* hidS = (const bf16_t*)(P.ws + WS_HIDS); const bf16_t* wsd = (const bf16_t*)(P.ws + WS_WSD);
#pragma unroll
            for (int i = 0; i < 2; ++i) { const int row = G::a_row(i, wid, lane); aptr[i] = hidS + (size_t)(rt * 256 + row) * 256 + G::a_chunk(row, lane) * 8;
                const int k = G::b_k(i, wid, lane); bptr[i] = wsd + (size_t)k * 1024 + ct * 256 + G::b_n(k, lane); } }
        __device__ __forceinline__ void epi(int seg, f32x4 (&acc)[4][8]) const {
            const int tid = opaque_tid(), lane = tid & 63, wid = tid >> 6, wm = wid >> 1, wn = wid & 1, fr = lane & 15, fq = lane >> 4, c8 = 8 * (tid & 31); (void)wm; (void)wn; (void)fr; (void)fq; (void)c8;
            const int u = blockIdx.x + seg * gridDim.x, rt = u >> 2, ct = u & 3;
            bf16_t* ysh = (bf16_t*)(P.ws + WS_YSH);
#pragma unroll
            for (int mi = 0; mi < 4; ++mi) { const size_t m = (size_t)(rt * 256 + wm * 64 + mi * 16 + fr);
#pragma unroll
                for (int ni = 0; ni < 8; ++ni) { const int col = ct * 256 + wn * 128 + ni * 16 + 4 * fq; const f32x4 a = acc[mi][ni];
                    u32x2 pk; pk.x = cvtpk(a.x, a.y); pk.y = cvtpk(a.z, a.w); *(u32x2*)(ysh + m * 1024 + col) = pk; } } }
    } f{P};
    const int nu = (128 * 4 - (int)blockIdx.x + (int)gridDim.x - 1) / (int)gridDim.x;
    if (nu > 0) G::run_stream(f, nu, 8, 32, (size_t)32 * 1024, lds);
}

__device__ __forceinline__ void phase_expert_cvt(const Params& P) {
    const size_t gt = (size_t)blockIdx.x * NTHREADS + threadIdx.x, NG = (size_t)gridDim.x * NTHREADS;
    bf16_t* wgu = (bf16_t*)(P.ws + WS_WBGU); bf16_t* wd = (bf16_t*)(P.ws + WS_WBD);
    for (size_t i = gt; i < (size_t)256 * 1024 * 64; i += NG) {
        const size_t ek = i >> 6; const int c8 = (int)(i & 63) * 8, t = c8 >> 8, u16 = (c8 & 255) >> 4;
        const float* s = ((u16 & 1) ? P.exp_wu : P.exp_wg) + ek * 256 + t * 128 + (u16 >> 1) * 16 + (c8 & 8);
        const f32x4 a = __builtin_nontemporal_load((const f32x4*)s), b2 = __builtin_nontemporal_load((const f32x4*)(s + 4));
        *(u32x4*)(wgu + ek * 512 + c8) = (u32x4){cvtpk(a.x, a.y), cvtpk(a.z, a.w), cvtpk(b2.x, b2.y), cvtpk(b2.z, b2.w)}; }
    for (size_t i = gt; i < (size_t)256 * 256 * 128; i += NG) {
        const size_t ek = i >> 7; const int m0 = (int)(i & 127) * 8, tl = m0 & 255, tile = m0 >> 8;
        const int wnn = tl >> 7, nii = (tl >> 4) & 7, n0 = tl & 15;
        const int ca = tile * 256 + wnn * 128 + 64 * (nii >> 2) + 16 * (n0 >> 2) + 4 * (nii & 3);
        const f32x4 a = __builtin_nontemporal_load((const f32x4*)(P.exp_wd + ek * 1024 + ca)), b2 = __builtin_nontemporal_load((const f32x4*)(P.exp_wd + ek * 1024 + ca + 16));
        *(u32x4*)(wd + ek * 1024 + m0) = (u32x4){cvtpk(a.x, a.y), cvtpk(a.z, a.w), cvtpk(b2.x, b2.y), cvtpk(b2.z, b2.w)}; }
}

constexpr int P6_TILES = 128 * 1024, P6_PRE = P6_TILES + 1024, P6_PAIR = P6_PRE + 1040, P6_W = P6_PAIR + 1024;
__device__ __forceinline__ void phase_experts(const Params& P, LAS unsigned char* lds) {
    typedef Gemm3 G;
    const int tid = opaque_tid(), lane = tid & 63, wid = tid >> 6, wm = wid >> 1, wn = wid & 1, fr = lane & 15, fq = lane >> 4;
    const int* cnt = (const int*)(P.ws + WS_CTL + CTL_CNT); const int* bucket = (const int*)(P.ws + WS_BUCKET); const float* rw = (const float*)(P.ws + WS_RW);
    const bf16_t* h2 = (const bf16_t*)(P.ws + WS_H); bf16_t* hidR = (bf16_t*)(P.ws + WS_HIDR) + (size_t)blockIdx.x * 256 * 256; unsigned char* y = (unsigned char*)(P.ws + WS_Y);
    LAS int* tiles = (LAS int*)(lds + P6_TILES); LAS int* pre = (LAS int*)(lds + P6_PRE); LAS int* pairs = (LAS int*)(lds + P6_PAIR); LAS float* wts = (LAS float*)(lds + P6_W);
    const int nx = (gridDim.x % 8 == 0) ? 8 : 1, xl = blockIdx.x % nx, li = blockIdx.x / nx, nloc = gridDim.x / nx, nek = 256 / nx;
    if (tid < nek) { const int c_ = cnt[xl + nx * tid]; tiles[tid] = ((c_ < BCAP ? c_ : BCAP) + 255) >> 8; }
    __syncthreads();
    if (tid < nek) { int s = 0; for (int i = 0; i < tid; ++i) s += tiles[i]; pre[tid] = s; if (tid == nek - 1) pre[nek] = s + tiles[nek - 1]; }
    __syncthreads();
    const int total = pre[nek];
    const int c8 = 8 * (tid & 31), u16 = c8 >> 4;
    for (int u = li; u < total; u += nloc) {
        int lo = 0, hi = nek - 1;
        while (lo < hi) { const int mid = (lo + hi + 1) >> 1; if (pre[mid] <= u) lo = mid; else hi = mid - 1; }
        const int e = xl + nx * lo, tile = u - pre[lo], n = cnt[e] < BCAP ? cnt[e] : BCAP, rows = (n - tile * 256) < 256 ? (n - tile * 256) : 256;
        if (tid < 256) { const int r = tid < rows ? tid : 0; const int pr = bucket[(size_t)e * BCAP + tile * 256 + r]; pairs[tid] = pr; wts[tid] = tid < rows ? rw[pr] : 0.f; }
        __syncthreads();
        {
            struct GU { const bf16_t* h2; LAS int* pairs; const bf16_t* wgu; bf16_t* hidR;
                __device__ __forceinline__ void ptrs(int t, const bf16_t* (&aptr)[2], const bf16_t* (&bptr)[2]) const {
                    const int tid = opaque_tid(), lane = tid & 63, wid = tid >> 6, wm = wid >> 1, wn = wid & 1, fr = lane & 15, fq = lane >> 4, c8 = 8 * (tid & 31); (void)wm; (void)wn; (void)fr; (void)fq; (void)c8;
#pragma unroll
                    for (int i = 0; i < 2; ++i) { const int row = G::a_row(i, wid, lane); aptr[i] = h2 + (size_t)(pairs[row] >> 3) * 1024 + G::a_chunk(row, lane) * 8;
                        const int k = G::b_k(i, wid, lane); bptr[i] = wgu + (size_t)k * 512 + t * 256 + G::b_n(k, lane); } }
                __device__ __forceinline__ void epi(int t, f32x4 (&acc)[4][8]) const {
                    const int tid = opaque_tid(), lane = tid & 63, wid = tid >> 6, wm = wid >> 1, wn = wid & 1, fr = lane & 15, fq = lane >> 4, c8 = 8 * (tid & 31); (void)wm; (void)wn; (void)fr; (void)fq; (void)c8;
#pragma unroll
                    for (int mi = 0; mi < 4; ++mi) { const int rl = wm * 64 + mi * 16 + fr;
#pragma unroll
                        for (int j = 0; j < 4; ++j) { const f32x4 g = acc[mi][2 * j], uu = acc[mi][2 * j + 1];
                            u32x2 pk; pk.x = cvtpk(siluf_(g.x) * uu.x, siluf_(g.y) * uu.y); pk.y = cvtpk(siluf_(g.z) * uu.z, siluf_(g.w) * uu.w);
                            *(u32x2*)(hidR + rl * 256 + t * 128 + wn * 64 + j * 16 + 4 * fq) = pk; } } }
            } f{h2, pairs, (const bf16_t*)(P.ws + WS_WBGU) + (size_t)e * 1024 * 512, hidR};
            G::run_stream(f, 2, 32, 32, (size_t)32 * 512, lds);
        }
        __syncthreads();
        {
            struct DN { bf16_t* hidR; const bf16_t* wd; unsigned char* y; LAS int* pairs; LAS float* wts; int rows;
                __device__ __forceinline__ void ptrs(int ct, const bf16_t* (&aptr)[2], const bf16_t* (&bptr)[2]) const {
                    const int tid = opaque_tid(), lane = tid & 63, wid = tid >> 6, wm = wid >> 1, wn = wid & 1, fr = lane & 15, fq = lane >> 4, c8 = 8 * (tid & 31); (void)wm; (void)wn; (void)fr; (void)fq; (void)c8;
#pragma unroll
                    for (int i = 0; i < 2; ++i) { const int row = G::a_row(i, wid, lane); aptr[i] = hidR + (size_t)row * 256 + G::a_chunk(row, lane) * 8;
                        const int k = G::b_k(i, wid, lane); bptr[i] = wd + (size_t)k * 1024 + ct * 256 + G::b_n(k, lane); } }
                __device__ __forceinline__ void epi(int ct, f32x4 (&acc)[4][8]) const {
                    const int tid = opaque_tid(), lane = tid & 63, wid = tid >> 6, wm = wid >> 1, wn = wid & 1, fr = lane & 15, fq = lane >> 4, c8 = 8 * (tid & 31); (void)wm; (void)wn; (void)fr; (void)fq; (void)c8;
#pragma unroll
                    for (int mi = 0; mi < 4; ++mi) { const int rl = wm * 64 + mi * 16 + fr; const float wgt = wts[rl]; const size_t pr = (size_t)pairs[rl];
                        if (rl < rows) {
#pragma unroll
                            for (int j2 = 0; j2 < 2; ++j2) { const int col = ct * 256 + wn * 128 + 64 * j2 + 16 * fq; const float sc_ = wgt * Y_SCALE; u32x4 w;
#pragma unroll
                                for (int b2 = 0; b2 < 4; ++b2) { const f32x4 a = acc[mi][4 * j2 + b2] * sc_;
                                    int pk = __builtin_amdgcn_cvt_pk_fp8_f32(a.x, a.y, 0, false); pk = __builtin_amdgcn_cvt_pk_fp8_f32(a.z, a.w, pk, true); w[b2] = (unsigned)pk; }
                                *(u32x4*)(y + pr * 1024 + col) = w; } } } }
            } f{hidR, (const bf16_t*)(P.ws + WS_WBD) + (size_t)e * 256 * 1024, y, pairs, wts, rows};
            G::run_stream(f, 4, 8, 32, (size_t)32 * 1024, lds);
        }
        __syncthreads();
    }
}

__device__ __forceinline__ void phase_combine(const Params& P) {
    const int lane = threadIdx.x & 63, gw = blockIdx.x * (NTHREADS / 64) + (threadIdx.x >> 6), NGW = gridDim.x * (NTHREADS / 64);
    const unsigned char* y = (const unsigned char*)(P.ws + WS_Y);
    typedef float f32x2_ __attribute__((ext_vector_type(2)));
    for (int m = gw; m < T; m += NGW) {
        const float* mod = (const float*)(P.ws + WS_MOD) + (m / SEQ) * 6144 + 5120;
#pragma unroll
        for (int j = 0; j < 2; ++j) { const int col = (lane + 64 * j) * 8;
            f32x4 s0 = (f32x4){0.f, 0.f, 0.f, 0.f}, s1 = s0;
#pragma unroll
            for (int sl = 0; sl < 8; ++sl) { const u32x2 v = *(const u32x2*)(y + ((size_t)m * 8 + sl) * 1024 + col);
                const f32x2_ a = __builtin_amdgcn_cvt_pk_f32_fp8((int)v.x, false), b = __builtin_amdgcn_cvt_pk_f32_fp8((int)v.x, true);
                const f32x2_ c = __builtin_amdgcn_cvt_pk_f32_fp8((int)v.y, false), d = __builtin_amdgcn_cvt_pk_f32_fp8((int)v.y, true);
                s0.x += a.x; s0.y += a.y; s0.z += b.x; s0.w += b.y; s1.x += c.x; s1.y += c.y; s1.z += d.x; s1.w += d.y; }
            const f32x4 g0 = *(const f32x4*)(mod + col), g1 = *(const f32x4*)(mod + col + 4);
            f32x4 o0 = *(const f32x4*)(P.out + (size_t)m * 1024 + col), o1 = *(const f32x4*)(P.out + (size_t)m * 1024 + col + 4);
            const u32x4 sh = *(const u32x4*)((const bf16_t*)(P.ws + WS_YSH) + (size_t)m * 1024 + col);
            const f32x4 h0 = (f32x4){__uint_as_float(sh.x << 16), __uint_as_float(sh.x & 0xffff0000u), __uint_as_float(sh.y << 16), __uint_as_float(sh.y & 0xffff0000u)};
            const f32x4 h1 = (f32x4){__uint_as_float(sh.z << 16), __uint_as_float(sh.z & 0xffff0000u), __uint_as_float(sh.w << 16), __uint_as_float(sh.w & 0xffff0000u)};
            o0 += g0 * (s0 * Y_INV + h0); o1 += g1 * (s1 * Y_INV + h1);
            *(f32x4*)(P.out + (size_t)m * 1024 + col) = o0; *(f32x4*)(P.out + (size_t)m * 1024 + col + 4) = o1; }
    }
}


__device__ __forceinline__ int queue_pull(unsigned* head, volatile LAS unsigned* slot) {
    if (threadIdx.x == 0) *slot = atomicAdd(head, 1u);
    __syncthreads();
    const int v = (int)*slot;
    __syncthreads();
    return v;
}
__device__ __forceinline__ void phase_cmp_h1(const Params& P, LAS unsigned char* lds, volatile LAS unsigned* slot) {
    unsigned* head = (unsigned*)(P.ws + WS_CTL + CTL_Q2);
    for (;;) {
        const int u = queue_pull(head, slot);
        if (u >= 64 + 512) break;
        if (u < 64) compress_unit(P, lds, u); else hgrn_unit<0>(P, lds, u - 64);
    }
}
__device__ __forceinline__ void phase_h23_nsa(const Params& P, LAS unsigned char* lds, volatile LAS unsigned* slot) {
    unsigned* head = (unsigned*)(P.ws + WS_CTL + CTL_Q3);
    for (;;) {
        const int n = queue_pull(head, slot);
        if (n >= 1536) break;
        if (n < 512) nsa_unit(P, lds, (n & 7) * 128 + (127 - (n >> 3)));
        else if (n < 1024) { const int m = n - 512; hgrn_unit<1>(P, lds, (m & 15) * 32 + (31 - (m >> 4))); }
        else { const int m = n - 1024; nsa_unit(P, lds, (m & 7) * 128 + (63 - (m >> 3))); }
    }
}

constexpr int LDS_BYTES = 144 * 1024;
__global__ void __launch_bounds__(NTHREADS) mega(Params P) {
    extern __shared__ __attribute__((aligned(16))) unsigned char smem[];
    LAS unsigned char* lds = (LAS unsigned char*)smem;
    volatile LAS unsigned* xst = (volatile LAS unsigned*)(lds + LDS_BYTES - 16);
    if (threadIdx.x < 4) xst[threadIdx.x] = 0u;
    __syncthreads();
    XcdBarrier xb = xcd_barrier_post((unsigned*)(P.ws + WS_CTL + CTL_BAR), xst);
    phase_mod(P, lds);
    xcd_barrier(xb);
    { const float* mod = (const float*)(P.ws + WS_MOD); norm_mod_rows(P.x, P.norm1_w, mod, mod + 1024, (bf16_t*)(P.ws + WS_H), H1S); }
    xcd_barrier(xb);
    phase_inproj(P, lds);
    xcd_barrier(xb);
    phase_cmp_h1(P, lds, xst + 2);
    xcd_barrier(xb);
    phase_h23_nsa(P, lds, xst + 2);
    phase_cvt_small(P);
    xcd_barrier(xb);
    phase_p4a(P, lds);
    xcd_barrier(xb);
    phase_p4b(P);
    xcd_barrier(xb);
    phase_p4c(P, lds);
    xcd_barrier(xb);
    phase_route(P);
    phase_p4d(P, lds);
    xcd_barrier(xb);
    phase_expert_cvt(P);
    xcd_barrier(xb);
    phase_experts(P, lds);
    xcd_barrier(xb);
    phase_combine(P);
}

extern "C" void kernel_launch(void* const* d_in, const int* in_sizes, int n_in, void* d_out, int out_size, void* d_ws, size_t ws_size, hipStream_t stream) {
    static int grid = 0;
    if (grid == 0) {
        if (n_in != 25 || ws_size < WS_END) { fprintf(stderr, "kernel_launch: unexpected n_in %d or ws_size %zu (need %zu)\n", n_in, ws_size, (size_t)WS_END); grid = -1; return; }
        int dev = 0, cus = 0, per_cu = 0;
        (void)hipGetDevice(&dev); (void)hipDeviceGetAttribute(&cus, hipDeviceAttributeMultiprocessorCount, dev);
        (void)hipFuncSetAttribute((const void*)mega, hipFuncAttributeMaxDynamicSharedMemorySize, LDS_BYTES);
        (void)hipOccupancyMaxActiveBlocksPerMultiprocessor(&per_cu, (const void*)mega, NTHREADS, LDS_BYTES);
        if (per_cu < 1) { fprintf(stderr, "kernel_launch: occupancy query says %d blocks per CU\n", per_cu); grid = -1; return; }
        grid = cus;
    }
    if (grid < 0) return;
    (void)hipMemsetAsync((char*)d_ws + WS_CTL, 0, 64 * 1024, stream);
    Params p{};
    const float** pf = (const float**)&p;
    for (int i = 0; i < 25; ++i) pf[i] = (const float*)d_in[i];
    p.out = (float*)d_out; p.ws = (unsigned char*)d_ws;
    void* args[] = {&p};
    hipError_t e = hipLaunchCooperativeKernel((const void*)mega, dim3(grid), dim3(NTHREADS), args, LDS_BYTES, stream);
    if (e != hipSuccess) fprintf(stderr, "cooperative launch failed: %s (grid %d)\n", hipGetErrorString(e), grid);
}

#ifdef PHASE_TEST
__global__ void __launch_bounds__(NTHREADS) t_p4a(Params P) { extern __shared__ __attribute__((aligned(16))) unsigned char smem[]; phase_p4a(P, (LAS unsigned char*)smem); }
__global__ void __launch_bounds__(NTHREADS) t_p4d(Params P) { extern __shared__ __attribute__((aligned(16))) unsigned char smem[]; phase_p4d(P, (LAS unsigned char*)smem); }
__global__ void __launch_bounds__(NTHREADS) t_p4(Params P) { extern __shared__ __attribute__((aligned(16))) unsigned char smem[]; phase_p4c(P, (LAS unsigned char*)smem); }
__global__ void __launch_bounds__(NTHREADS) t_p6(Params P) { extern __shared__ __attribute__((aligned(16))) unsigned char smem[]; phase_experts(P, (LAS unsigned char*)smem); }
__global__ void __launch_bounds__(NTHREADS) t_nsa(Params P) { extern __shared__ __attribute__((aligned(16))) unsigned char smem[]; nsa_unit(P, (LAS unsigned char*)smem, blockIdx.x); }
__global__ void __launch_bounds__(NTHREADS) t_mod(Params P) { extern __shared__ __attribute__((aligned(16))) unsigned char smem[]; phase_mod(P, (LAS unsigned char*)smem); }
__global__ void __launch_bounds__(NTHREADS) t_inproj(Params P) { extern __shared__ __attribute__((aligned(16))) unsigned char smem[]; phase_inproj(P, (LAS unsigned char*)smem); }
__global__ void __launch_bounds__(NTHREADS) t_cmp(Params P) { extern __shared__ __attribute__((aligned(16))) unsigned char smem[]; compress_unit(P, (LAS unsigned char*)smem, blockIdx.x); }
__global__ void __launch_bounds__(NTHREADS) t_h0(Params P) { extern __shared__ __attribute__((aligned(16))) unsigned char smem[]; hgrn_unit<0>(P, (LAS unsigned char*)smem, blockIdx.x); }
__global__ void __launch_bounds__(NTHREADS) t_h1(Params P) { extern __shared__ __attribute__((aligned(16))) unsigned char smem[]; hgrn_unit<1>(P, (LAS unsigned char*)smem, blockIdx.x); }
#endif
```

```cpp
#include <hip/hip_runtime.h>
#include <hip/hip_cooperative_groups.h>
#include <cstdio>
#include <cstdint>
#include <type_traits>
namespace cg = cooperative_groups;

#define LAS __attribute__((address_space(3)))
typedef unsigned short bf16_t;
typedef short bf16x8 __attribute__((ext_vector_type(8)));
typedef short s16x4 __attribute__((ext_vector_type(4)));
typedef float f32x4 __attribute__((ext_vector_type(4)));
typedef float f32x16 __attribute__((ext_vector_type(16)));
typedef unsigned u32x4 __attribute__((ext_vector_type(4)));
typedef unsigned u32x2 __attribute__((ext_vector_type(2)));

constexpr int D = 1024, BATCH = 4, SEQ = 8192, T = BATCH * SEQ;
constexpr int IN_COLS = 3352;
constexpr int NTHREADS = 512;
constexpr int H1S = 1088;
constexpr float RMS_EPS = 1e-6f;
constexpr float LOG2E = 1.4426950408889634f;
constexpr float Y_SCALE = 16.0f, Y_INV = 1.0f / 16.0f;

constexpr size_t MB = 1024ull * 1024ull;
constexpr size_t WS_CTL    = 0;
constexpr size_t WS_MOD    = 64 * 1024;
constexpr size_t WS_LB     = WS_MOD + 4 * 6144 * 4;
constexpr size_t WS_CB     = WS_LB + 2048;
constexpr size_t WS_H      = 1 * MB;
constexpr size_t WS_SS     = WS_H + 72 * MB;
constexpr size_t WS_RW     = WS_SS + 1 * MB;
constexpr size_t WS_BUCKET = WS_RW + 1 * MB;
constexpr size_t WS_HIDR   = WS_BUCKET + 16 * MB;
constexpr size_t WS_WSM    = WS_HIDR + 32 * MB;
constexpr size_t WS_WOUT   = WS_WSM, WS_WRS = WS_WSM + 2 * MB, WS_WSD = WS_WSM + 4 * MB;
constexpr size_t WS_WBE    = WS_WSM + 5 * MB;
constexpr size_t WS_WBGU   = WS_WBE, WS_WBD = WS_WBE + 256 * MB;
constexpr size_t WS_W8GU   = WS_WBE, WS_W8D = WS_WBE + 128 * MB, WS_H2Q = WS_WBE + 256 * MB;
constexpr float W8_GU_SCALE = 64.0f, W8_D_SCALE = 32.0f, HID8_SCALE = 4.0f;
constexpr size_t WS_SCORES = WS_WBE;
constexpr size_t WS_HIDS   = WS_SCORES + 32 * MB;
constexpr size_t WS_WIN    = WS_HIDS + 16 * MB;
constexpr size_t WS_Y      = WS_WBE + 384 * MB;
constexpr size_t WS_Q      = WS_Y;
constexpr size_t WS_KV     = WS_Q + 32 * MB;
constexpr size_t WS_GATES  = WS_KV + 48 * MB;
constexpr size_t WS_HQ     = WS_GATES + 4 * MB;
constexpr size_t WS_LOGF   = WS_HQ + 32 * MB;
constexpr size_t WS_HV     = WS_LOGF + 64 * MB;
constexpr size_t WS_HG     = WS_HV + 32 * MB;
constexpr size_t WS_CMPH   = WS_HG + 32 * MB;
constexpr size_t WS_KC     = WS_CMPH + 4 * MB;
constexpr size_t WS_VC     = WS_KC + 1 * MB;
constexpr size_t WS_HL     = WS_VC + 1 * MB;
constexpr size_t WS_HD     = WS_HL + 32 * MB;
constexpr size_t WS_MIX    = WS_HD + 1 * MB;
constexpr size_t WS_YSH    = WS_Y + 384 * MB;
constexpr size_t WS_END    = WS_YSH + 64 * MB;
constexpr int BCAP = 16384;
constexpr int CTL_CNT = 1024;
constexpr int CTL_Q2 = 2048, CTL_Q3 = 2112;
constexpr int CTL_BAR = 16384;

struct Params {
    const float *x, *c, *ada_w, *ada_b, *norm1_w, *norm2_w, *w_in, *q_norm_w, *k_norm_w, *cmp_pos, *cmp_w1, *cmp_b1, *cmp_w2,
        *attn_out_norm_w, *hgrn_lb, *rec_out_norm_w, *w_out, *router_w, *router_bias, *exp_wg, *exp_wu, *exp_wd, *sh_wg, *sh_wu, *sh_wd;
    float* out;
    unsigned char* ws;
};

typedef __bf16 bf16x2_t __attribute__((ext_vector_type(2)));
typedef int i32x8 __attribute__((ext_vector_type(8)));
__device__ __forceinline__ unsigned cvtpk(float lo, float hi) { bf16x2_t v; v.x = (__bf16)lo; v.y = (__bf16)hi; return __builtin_bit_cast(unsigned, v); }
__device__ __forceinline__ int opaque_tid() { int t = threadIdx.x; asm volatile("" : "+v"(t)); return t; }
__device__ __forceinline__ float bf2f(bf16_t v) { return __uint_as_float(((unsigned)v) << 16); }
__device__ __forceinline__ float sigmoidf_(float v) { return __builtin_amdgcn_rcpf(1.0f + __expf(-v)); }
__device__ __forceinline__ float siluf_(float v) { return v * __builtin_amdgcn_rcpf(1.0f + __expf(-v)); }
__device__ __forceinline__ float wave_sum(float v) {
#pragma unroll
    for (int o = 1; o < 64; o <<= 1) v += __shfl_xor(v, o);
    return v;
}
__device__ __forceinline__ s16x4 lds_tr(const LAS unsigned char* p) {
    return __builtin_bit_cast(s16x4, __builtin_amdgcn_ds_read_tr16_b64_v4i16((LAS s16x4*)p));
}

#define XB_TMO      128
#define XB_XCNT(j)  (256  + 64 * (j))
#define XB_XSUB(j)  (1280 + 64 * (j))
#define XB_XGEN(j)  (2304 + 64 * (j))
#define XB_TOP      3328
#define XB_TOPGEN   3392
#define XCD_BAR_WORDS 3456
#define XB_SPIN_CAP (1u << 22)
__device__ __forceinline__ unsigned xb_ld(unsigned* p)              { return __hip_atomic_load(p, __ATOMIC_RELAXED, __HIP_MEMORY_SCOPE_AGENT); }
__device__ __forceinline__ unsigned xb_add(unsigned* p, unsigned v) { return __hip_atomic_fetch_add(p, v, __ATOMIC_RELAXED, __HIP_MEMORY_SCOPE_AGENT); }
__device__ __forceinline__ unsigned xb_xcc_id() { return (unsigned)__builtin_amdgcn_s_getreg((3 << 11) | 20) & 0xFu; }
#define XB_SPIN(cond, bar) do { unsigned _sp = 0; while (cond) { __builtin_amdgcn_s_sleep(1); \
    if ((++_sp & 255u) == 0u) { if (xb_ld(&(bar)[XB_TMO])) break; if (_sp > XB_SPIN_CAP) { atomicAdd(&(bar)[XB_TMO], 1u); break; } } } } while (0)
struct XcdBarrier { unsigned* bar; unsigned x; volatile LAS unsigned* st; };
__device__ __forceinline__ XcdBarrier xcd_barrier_post(unsigned* bar, volatile LAS unsigned* st) {
    XcdBarrier b; b.bar = bar; b.x = xb_xcc_id(); b.st = st;
    if (threadIdx.x == 0) (void)xb_add(&bar[XB_XCNT(b.x)], 1u);
    return b;
}
__device__ __forceinline__ void xcd_barrier_complete(unsigned* bar, unsigned x, unsigned& nloc, unsigned& nx) {
    const unsigned G = gridDim.x * gridDim.y * gridDim.z;
    unsigned sum, cnt, mine, sp = 0u;
    for (;;) {
        sum = 0u; cnt = 0u; mine = 0u;
#pragma unroll
        for (unsigned j = 0; j < 16; ++j) { const unsigned c = xb_ld(&bar[XB_XCNT(j)]); sum += c; cnt += (c > 0u) ? 1u : 0u; mine = (j == x) ? c : mine; }
        if (sum == G) break;
        __builtin_amdgcn_s_sleep(1);
        if ((++sp & 255u) == 0u) { if (xb_ld(&bar[XB_TMO])) break; if (sp > XB_SPIN_CAP) { atomicAdd(&bar[XB_TMO], 1u); break; } }
    }
    nloc = mine > 0u ? mine : 1u; nx = cnt > 0u ? cnt : 1u;
}
__device__ __forceinline__ void xcd_barrier(const XcdBarrier& b) {
    asm volatile("s_waitcnt vmcnt(0)" ::: "memory");
    __syncthreads();
    if (threadIdx.x == 0) {
        unsigned* bar = b.bar;
        __builtin_amdgcn_s_waitcnt(0);
        unsigned nloc = b.st[0], nx = b.st[1];
        if (nloc == 0u) { xcd_barrier_complete(bar, b.x, nloc, nx); b.st[0] = nloc; b.st[1] = nx; }
        const unsigned old = xb_add(&bar[XB_XSUB(b.x)], 1u);
        const unsigned gen = old / nloc;
        if (old + 1u == (gen + 1u) * nloc) {
            __builtin_amdgcn_fence(__ATOMIC_RELEASE, "agent");
            asm volatile("s_waitcnt vmcnt(0)" ::: "memory");
            const unsigned og = xb_add(&bar[XB_TOP], 1u);
            const unsigned tg = og / nx;
            if (og + 1u == (tg + 1u) * nx) xb_add(&bar[XB_TOPGEN], 1u);
            else XB_SPIN(xb_ld(&bar[XB_TOPGEN]) == tg, bar);
            __builtin_amdgcn_fence(__ATOMIC_ACQUIRE, "agent");
            xb_add(&bar[XB_XGEN(b.x)], 1u);
            asm volatile("s_waitcnt vmcnt(0)" ::: "memory");
        } else {
            XB_SPIN(xb_ld(&bar[XB_XGEN(b.x)]) == gen, bar);
            __builtin_amdgcn_fence(__ATOMIC_ACQUIRE, "agent");
            asm volatile("s_waitcnt vmcnt(0)" ::: "memory");
        }
    }
    __syncthreads();
}

template <int WM, int WN> struct GemmT {
    static constexpr int BM = 64 * WM, BN = 64 * WN;
    static constexpr int A_BYTES = BM * 128, B_BYTES = 64 * BN * 2, STAGE = A_BYTES + B_BYTES, LDS_BYTES = 2 * STAGE;
    static constexpr int NB4 = BN / 32;
    static constexpr int B_ROW4 = BN / 4;

    static __device__ __forceinline__ void run(f32x4 (&acc)[4][4], const bf16_t* const (&arow)[WM], int a_kstride, const float* Bp, int ldb, int KT, LAS unsigned char* lds) {
        const int tid = opaque_tid(), lane = tid & 63, wid = tid >> 6, wm = wid / WN, wn = wid % WN, fr = lane & 15, fq = lane >> 4;
#pragma unroll
        for (int mi = 0; mi < 4; ++mi)
#pragma unroll
            for (int ni = 0; ni < 4; ++ni) acc[mi][ni] = (f32x4){0.f, 0.f, 0.f, 0.f};
        const int achunk = tid & 7;
        u32x4 areg[WM]; f32x4 breg[NB4];
        int a_wr[WM];
#pragma unroll
        for (int p = 0; p < WM; ++p) { const int row = p * 64 + (tid >> 3); a_wr[p] = row * 128 + ((achunk ^ ((row >> 1) & 7)) << 4); }
        int b_wr[NB4]; int b_goff[NB4];
#pragma unroll
        for (int p = 0; p < NB4; ++p) { const int i = tid + NTHREADS * p, k = i / B_ROW4, n = (i % B_ROW4) * 4;
            const int f = (k & 3) | (((k >> 3) & 1) << 2);
            b_wr[p] = A_BYTES + k * (BN * 2) + (((n >> 4) ^ f) << 5) + ((n & 15) << 1); b_goff[p] = k * ldb + n; }
        int a_rd[4][2];
#pragma unroll
        for (int mi = 0; mi < 4; ++mi)
#pragma unroll
            for (int ks = 0; ks < 2; ++ks) { const int row = wm * 64 + mi * 16 + fr, ch = ks * 4 + fq; a_rd[mi][ks] = row * 128 + ((ch ^ ((row >> 1) & 7)) << 4); }
        int b_rd[2][2];
        int b_f[2][2];
#pragma unroll
        for (int ks = 0; ks < 2; ++ks)
#pragma unroll
            for (int t = 0; t < 2; ++t) { const int k = ks * 32 + 8 * fq + 4 * t + (fr >> 2); b_f[ks][t] = (k & 3) | (((k >> 3) & 1) << 2);
                b_rd[ks][t] = A_BYTES + k * (BN * 2) + ((fr & 3) << 3); }

        auto gload = [&](int kt) {
#pragma unroll
            for (int p = 0; p < WM; ++p) areg[p] = *(const u32x4*)(arow[p] + (size_t)kt * a_kstride + achunk * 8);
            const float* bk = Bp + (size_t)kt * 64 * ldb;
#pragma unroll
            for (int p = 0; p < NB4; ++p) breg[p] = *(const f32x4*)(bk + b_goff[p]);
        };
        auto lstore = [&](int buf) {
            LAS unsigned char* base = lds + buf * STAGE;
#pragma unroll
            for (int p = 0; p < WM; ++p) *(LAS u32x4*)(base + a_wr[p]) = areg[p];
#pragma unroll
            for (int p = 0; p < NB4; ++p) { u32x2 w; w.x = cvtpk(breg[p].x, breg[p].y); w.y = cvtpk(breg[p].z, breg[p].w); *(LAS u32x2*)(base + b_wr[p]) = w; }
        };
        gload(0); lstore(0); __syncthreads();
        for (int kt = 0; kt < KT; ++kt) {
            if (kt + 1 < KT) gload(kt + 1);
            __builtin_amdgcn_sched_barrier(0);
            const LAS unsigned char* base = lds + (kt & 1) * STAGE;
#pragma unroll
            for (int ks = 0; ks < 2; ++ks) {
                bf16x8 af[4], bfr[4];
#pragma unroll
                for (int mi = 0; mi < 4; ++mi) af[mi] = *(const LAS bf16x8*)(base + a_rd[mi][ks]);
#pragma unroll
                for (int ni = 0; ni < 4; ++ni) {
                    const int u0 = wn * 4 + ni;
                    const s16x4 lo = lds_tr(base + b_rd[ks][0] + ((u0 ^ b_f[ks][0]) << 5));
                    const s16x4 hi = lds_tr(base + b_rd[ks][1] + ((u0 ^ b_f[ks][1]) << 5));
                    bfr[ni] = (bf16x8){lo[0], lo[1], lo[2], lo[3], hi[0], hi[1], hi[2], hi[3]};
                }
#pragma unroll
                for (int mi = 0; mi < 4; ++mi)
#pragma unroll
                    for (int ni = 0; ni < 4; ++ni) acc[mi][ni] = __builtin_amdgcn_mfma_f32_16x16x32_bf16(bfr[ni], af[mi], acc[mi][ni], 0, 0, 0);
            }
            if (kt + 1 < KT) lstore((kt + 1) & 1);
            __syncthreads();
        }
    }
};

struct Gemm2 {
    static constexpr int A_BYTES = 32768, STAGE = 65536, LDS_BYTES = 2 * STAGE;
    static __device__ __forceinline__ int a_row(int i, int w, int lane) { return (i * 8 + w) * 8 + (lane >> 3); }
    static __device__ __forceinline__ int a_chunk(int row, int lane) { return (lane & 7) ^ ((row >> 1) & 7); }
    static __device__ __forceinline__ int b_k(int i, int w, int lane) { return (i * 8 + w) * 2 + (lane >> 5); }
    static __device__ __forceinline__ int b_n(int k, int lane) { return ((((lane & 31) >> 1) ^ fk2(k)) << 4) + ((lane & 1) << 3); }
    static __device__ __forceinline__ int fk2(int r) { return (r & 3) | (((r >> 3) & 1) << 2); }

    static __device__ __forceinline__ void run(f32x4 (&acc)[4][8], const bf16_t* const (&aptr)[4], int a_kstride, const bf16_t* const (&bptr)[4], size_t b_kstride, int KT, LAS unsigned char* lds) {
        const int tid = opaque_tid(), lane = tid & 63, wid = tid >> 6, wm = wid >> 1, wn = wid & 1, fr = lane & 15, fq = lane >> 4;
        const int wu = __builtin_amdgcn_readfirstlane(wid);
#pragma unroll
        for (int mi = 0; mi < 4; ++mi)
#pragma unroll
            for (int ni = 0; ni < 8; ++ni) acc[mi][ni] = (f32x4){0.f, 0.f, 0.f, 0.f};
        int a_rd[4][2];
#pragma unroll
        for (int mi = 0; mi < 4; ++mi)
#pragma unroll
            for (int ks = 0; ks < 2; ++ks) { const int row = wm * 64 + mi * 16 + fr, ch = ks * 4 + fq; a_rd[mi][ks] = row * 128 + ((ch ^ ((row >> 1) & 7)) << 4); }
        int b_rd[2][2], b_f[2][2];
#pragma unroll
        for (int ks = 0; ks < 2; ++ks)
#pragma unroll
            for (int t = 0; t < 2; ++t) { const int k = ks * 32 + 8 * fq + 4 * t + (fr >> 2); b_f[ks][t] = fk2(k); b_rd[ks][t] = A_BYTES + k * 512 + ((fr & 3) << 3); }
        auto issue = [&](int kt, int buf) {
            LAS unsigned char* base = lds + buf * STAGE + wu * 1024;
#pragma unroll
            for (int i = 0; i < 4; ++i) __builtin_amdgcn_global_load_lds((const unsigned*)(aptr[i] + (size_t)kt * a_kstride), (LAS unsigned*)(base + i * 8192), 16, 0, 0);
#pragma unroll
            for (int i = 0; i < 4; ++i) __builtin_amdgcn_global_load_lds((const unsigned*)(bptr[i] + (size_t)kt * b_kstride), (LAS unsigned*)(base + A_BYTES + i * 8192), 16, 0, 0);
        };
        issue(0, 0);
        for (int kt = 0; kt < KT; ++kt) {
            asm volatile("s_waitcnt vmcnt(0)" ::: "memory");
            __syncthreads();
            if (kt + 1 < KT) issue(kt + 1, (kt + 1) & 1);
            const LAS unsigned char* base = lds + (kt & 1) * STAGE;
#pragma unroll
            for (int ks = 0; ks < 2; ++ks) {
                bf16x8 af[4];
#pragma unroll
                for (int mi = 0; mi < 4; ++mi) af[mi] = *(const LAS bf16x8*)(base + a_rd[mi][ks]);
#pragma unroll
                for (int ni = 0; ni < 8; ++ni) {
                    const int u0 = wn * 8 + ni;
                    const s16x4 lo = lds_tr(base + b_rd[ks][0] + ((u0 ^ b_f[ks][0]) << 5));
                    const s16x4 hi = lds_tr(base + b_rd[ks][1] + ((u0 ^ b_f[ks][1]) << 5));
                    const bf16x8 bfr = (bf16x8){lo[0], lo[1], lo[2], lo[3], hi[0], hi[1], hi[2], hi[3]};
#pragma unroll
                    for (int mi = 0; mi < 4; ++mi) acc[mi][ni] = __builtin_amdgcn_mfma_f32_16x16x32_bf16(bfr, af[mi], acc[mi][ni], 0, 0, 0);
                }
            }
        }
        __syncthreads();
    }
};

__device__ __forceinline__ void glds16(const void* g, unsigned lds_base) {
    unsigned sv; asm volatile("s_mov_b32 %0, m0\n\ts_mov_b32 m0, %2\n\ts_nop 0\n\tglobal_load_lds_dwordx4 %1, off\n\ts_mov_b32 m0, %0" : "=&s"(sv) : "v"(g), "s"(lds_base) : "memory"); }
struct Gemm3 {
    static constexpr int A_BYTES = 16384, STAGE = 32768, LDS_BYTES = 4 * STAGE;
    static __device__ __forceinline__ int a_row(int i, int w, int lane) { return (i * 8 + w) * 16 + (lane >> 2); }
    static __device__ __forceinline__ int a_chunk(int row, int lane) { return (lane & 3) ^ ((row >> 1) & 3); }
    static __device__ __forceinline__ int b_k(int i, int w, int lane) { return (i * 8 + w) * 2 + (lane >> 5); }
    static __device__ __forceinline__ int fk2(int r) { return (r & 3) | (((r >> 3) & 1) << 2); }
    static __device__ __forceinline__ int b_n(int k, int lane) { return ((((lane & 31) >> 1) ^ fk2(k)) << 4) + ((lane & 1) << 3); }
    static __device__ __forceinline__ void run(f32x4 (&acc)[4][8], const bf16_t* const (&aptr)[2], int a_kstride, const bf16_t* const (&bptr)[2], size_t b_kstride, int KT, LAS unsigned char* lds) {
        const int tid = opaque_tid(), lane = tid & 63, wid = tid >> 6, wm = wid >> 1, wn = wid & 1, fr = lane & 15, fq = lane >> 4;
        const int wu = __builtin_amdgcn_readfirstlane(wid);
#pragma unroll
        for (int mi = 0; mi < 4; ++mi)
#pragma unroll
            for (int ni = 0; ni < 8; ++ni) acc[mi][ni] = (f32x4){0.f, 0.f, 0.f, 0.f};
        int a_rd[4];
#pragma unroll
        for (int mi = 0; mi < 4; ++mi) { const int row = wm * 64 + mi * 16 + fr; a_rd[mi] = row * 64 + ((fq ^ ((row >> 1) & 3)) << 4); }
        int b_rd[2], b_f[2];
#pragma unroll
        for (int t = 0; t < 2; ++t) { const int k = 8 * fq + 4 * t + (fr >> 2); b_f[t] = fk2(k); b_rd[t] = A_BYTES + k * 512 + ((fr & 3) << 3); }
        const unsigned lds0 = (unsigned)(uintptr_t)lds + (unsigned)wu * 1024u;
        auto issue = [&](int kt) {
            const unsigned base = (unsigned)__builtin_amdgcn_readfirstlane((int)(lds0 + (unsigned)(kt & 3) * STAGE));
#pragma unroll
            for (int i = 0; i < 2; ++i) glds16(aptr[i] + (size_t)kt * a_kstride, base + i * 8192);
#pragma unroll
            for (int i = 0; i < 2; ++i) glds16(bptr[i] + (size_t)kt * b_kstride, base + A_BYTES + i * 8192);
        };
        const int grp = wu >> 2;
        auto bar = [&]() { asm volatile("s_waitcnt lgkmcnt(0)" ::: "memory"); __builtin_amdgcn_s_barrier(); asm volatile("" ::: "memory"); };
        asm volatile("s_waitcnt vmcnt(0)" ::: "memory");
        issue(0); if (KT > 1) issue(1); if (KT > 2) issue(2);
        if (KT > 2) asm volatile("s_waitcnt vmcnt(8)" ::: "memory"); else if (KT > 1) asm volatile("s_waitcnt vmcnt(4)" ::: "memory"); else asm volatile("s_waitcnt vmcnt(0)" ::: "memory");
        bar();
        if (grp) bar();
#pragma unroll 1
        for (int kt = 0; kt < KT; ++kt) {
            if (kt + 3 < KT) issue(kt + 3);
            const LAS unsigned char* base = lds + (kt & 3) * STAGE;
            bf16x8 af[4], bfr[8];
#pragma unroll
            for (int mi = 0; mi < 4; ++mi) af[mi] = *(const LAS bf16x8*)(base + a_rd[mi]);
#pragma unroll
            for (int ni = 0; ni < 8; ++ni) {
                const int u0 = wn * 8 + ni;
                const s16x4 lo = lds_tr(base + b_rd[0] + ((u0 ^ b_f[0]) << 5));
                const s16x4 hi = lds_tr(base + b_rd[1] + ((u0 ^ b_f[1]) << 5));
                bfr[ni] = (bf16x8){lo[0], lo[1], lo[2], lo[3], hi[0], hi[1], hi[2], hi[3]};
            }
            { const int rem = KT - 2 - kt;
              if (rem >= 2) asm volatile("s_waitcnt vmcnt(8)" ::: "memory"); else if (rem == 1) asm volatile("s_waitcnt vmcnt(4)" ::: "memory"); else asm volatile("s_waitcnt vmcnt(0)" ::: "memory"); }
            bar();
            __builtin_amdgcn_sched_barrier(0);
#pragma unroll
            for (int ni = 0; ni < 8; ++ni)
#pragma unroll
                for (int mi = 0; mi < 4; ++mi) acc[mi][ni] = __builtin_amdgcn_mfma_f32_16x16x32_bf16(bfr[ni], af[mi], acc[mi][ni], 0, 0, 0);
            __builtin_amdgcn_sched_barrier(0);
            bar();
        }
        if (!grp) bar();
    }

    template <class F> static __device__ __forceinline__ void run_stream(F& f, int NSEG, int KT, int a_kstride, size_t b_kstride, LAS unsigned char* lds) {
        const int tid = opaque_tid(), lane = tid & 63, wid = tid >> 6, wm = wid >> 1, wn = wid & 1, fr = lane & 15, fq = lane >> 4;
        const int wu = __builtin_amdgcn_readfirstlane(wid);
        f32x4 acc[4][8];
#pragma unroll
        for (int mi = 0; mi < 4; ++mi)
#pragma unroll
            for (int ni = 0; ni < 8; ++ni) acc[mi][ni] = (f32x4){0.f, 0.f, 0.f, 0.f};
        int a_rd[4];
#pragma unroll
        for (int mi = 0; mi < 4; ++mi) { const int row = wm * 64 + mi * 16 + fr; a_rd[mi] = row * 64 + ((fq ^ ((row >> 1) & 3)) << 4); }
        int b_rd[2], b_f[2];
#pragma unroll
        for (int t = 0; t < 2; ++t) { const int k = 8 * fq + 4 * t + (fr >> 2); b_f[t] = fk2(k); b_rd[t] = A_BYTES + k * 512 + ((fr & 3) << 3); }
        const unsigned lds0 = (unsigned)(uintptr_t)lds + (unsigned)wu * 1024u;
        const bf16_t* aptr[2]; const bf16_t* bptr[2];
        const int total = NSEG * KT;
        int lseg = 0, lkt = 0, lg = 0;
        auto issue = [&]() {
            const unsigned base = (unsigned)__builtin_amdgcn_readfirstlane((int)(lds0 + (unsigned)(lg & 3) * STAGE));
#pragma unroll
            for (int i = 0; i < 2; ++i) glds16(aptr[i] + (size_t)lkt * a_kstride, base + i * 8192);
#pragma unroll
            for (int i = 0; i < 2; ++i) glds16(bptr[i] + (size_t)lkt * b_kstride, base + A_BYTES + i * 8192);
            ++lg; if (++lkt == KT) { lkt = 0; ++lseg; if (lseg < NSEG) f.ptrs(lseg, aptr, bptr); }
        };
        const int grp = wu >> 2;
        auto bar = [&]() { asm volatile("s_waitcnt lgkmcnt(0)" ::: "memory"); __builtin_amdgcn_s_barrier(); asm volatile("" ::: "memory"); };
        f.ptrs(0, aptr, bptr);
        asm volatile("s_waitcnt vmcnt(0)" ::: "memory");
        issue(); if (total > 1) issue(); if (total > 2) issue();
        if (total > 2) asm volatile("s_waitcnt vmcnt(8)" ::: "memory"); else if (total > 1) asm volatile("s_waitcnt vmcnt(4)" ::: "memory"); else asm volatile("s_waitcnt vmcnt(0)" ::: "memory");
        bar();
        if (grp) bar();
        int cseg = 0, ckt = 0;
#pragma unroll 1
        for (int g = 0; g < total; ++g) {
            if (lg < total) issue();
            const LAS unsigned char* base = lds + (g & 3) * STAGE;
            bf16x8 af[4], bfr[8];
#pragma unroll
            for (int mi = 0; mi < 4; ++mi) af[mi] = *(const LAS bf16x8*)(base + a_rd[mi]);
#pragma unroll
            for (int ni = 0; ni < 8; ++ni) {
                const int u0 = wn * 8 + ni;
                const s16x4 lo = lds_tr(base + b_rd[0] + ((u0 ^ b_f[0]) << 5));
                const s16x4 hi = lds_tr(base + b_rd[1] + ((u0 ^ b_f[1]) << 5));
                bfr[ni] = (bf16x8){lo[0], lo[1], lo[2], lo[3], hi[0], hi[1], hi[2], hi[3]};
            }
            { const int rem = total - 2 - g;
              if (rem >= 2) asm volatile("s_waitcnt vmcnt(8)" ::: "memory"); else if (rem == 1) asm volatile("s_waitcnt vmcnt(4)" ::: "memory"); else asm volatile("s_waitcnt vmcnt(0)" ::: "memory"); }
            bar();
            __builtin_amdgcn_sched_barrier(0);
#pragma unroll
            for (int ni = 0; ni < 8; ++ni)
#pragma unroll
                for (int mi = 0; mi < 4; ++mi) acc[mi][ni] = __builtin_amdgcn_mfma_f32_16x16x32_bf16(bfr[ni], af[mi], acc[mi][ni], 0, 0, 0);
            __builtin_amdgcn_sched_barrier(0);
            bar();
            if (++ckt == KT) {
                f.epi(cseg, acc);
#pragma unroll
                for (int mi = 0; mi < 4; ++mi)
#pragma unroll
                    for (int ni = 0; ni < 8; ++ni) acc[mi][ni] = (f32x4){0.f, 0.f, 0.f, 0.f};
                ckt = 0; ++cseg;
            }
        }
        if (!grp) bar();
    }
};

struct Gemm4 {
    static constexpr int A_BYTES = 16384, STAGE = 32768, LDS_BYTES = 2 * STAGE;
    static __device__ __forceinline__ int fk2(int r) { return (r & 3) | (((r >> 3) & 1) << 2); }
    static __device__ __forceinline__ int a_row(int i, int tid) { return (tid >> 2) + 128 * i; }
    static __device__ __forceinline__ int b_k(int i, int tid) { return (tid >> 5) + 16 * i; }
    static __device__ __forceinline__ void run(f32x4 (&acc)[4][8], const bf16_t* const (&aptr)[2], int a_kstride, const bf16_t* const (&bptr)[2], size_t b_kstride, int KT, LAS unsigned char* lds) {
        const int tid = opaque_tid(), lane = tid & 63, wid = tid >> 6, wm = wid >> 1, wn = wid & 1, fr = lane & 15, fq = lane >> 4;
#pragma unroll
        for (int mi = 0; mi < 4; ++mi)
#pragma unroll
            for (int ni = 0; ni < 8; ++ni) acc[mi][ni] = (f32x4){0.f, 0.f, 0.f, 0.f};
        int a_wr[2], b_wr[2];
#pragma unroll
        for (int i = 0; i < 2; ++i) { const int row = a_row(i, tid); a_wr[i] = row * 64 + (((tid & 3) ^ ((row >> 1) & 3)) << 4);
            const int k = b_k(i, tid), n = (tid & 31) * 8; b_wr[i] = A_BYTES + k * 512 + (((n >> 4) ^ fk2(k)) << 5) + ((n & 15) << 1); }
        int a_rd[4];
#pragma unroll
        for (int mi = 0; mi < 4; ++mi) { const int row = wm * 64 + mi * 16 + fr; a_rd[mi] = row * 64 + ((fq ^ ((row >> 1) & 3)) << 4); }
        int b_rd[2], b_f[2];
#pragma unroll
        for (int t = 0; t < 2; ++t) { const int k = 8 * fq + 4 * t + (fr >> 2); b_f[t] = fk2(k); b_rd[t] = A_BYTES + k * 512 + ((fr & 3) << 3); }
        u32x4 ra0[2], rb0[2], ra1[2], rb1[2];
        auto gload = [&](int kt, u32x4 (&ra)[2], u32x4 (&rb)[2]) {
#pragma unroll
            for (int i = 0; i < 2; ++i) { ra[i] = *(const u32x4*)(aptr[i] + (size_t)kt * a_kstride); rb[i] = *(const u32x4*)(bptr[i] + (size_t)kt * b_kstride); }
        };
        auto lstore = [&](int buf, const u32x4 (&ra)[2], const u32x4 (&rb)[2]) {
            LAS unsigned char* base = lds + buf * STAGE;
#pragma unroll
            for (int i = 0; i < 2; ++i) { *(LAS u32x4*)(base + a_wr[i]) = ra[i]; *(LAS u32x4*)(base + b_wr[i]) = rb[i]; }
        };
        auto compute = [&](int buf) {
            const LAS unsigned char* base = lds + buf * STAGE;
            bf16x8 af[4];
#pragma unroll
            for (int mi = 0; mi < 4; ++mi) af[mi] = *(const LAS bf16x8*)(base + a_rd[mi]);
#pragma unroll
            for (int ni = 0; ni < 8; ++ni) {
                const int u0 = wn * 8 + ni;
                const s16x4 lo = lds_tr(base + b_rd[0] + ((u0 ^ b_f[0]) << 5));
                const s16x4 hi = lds_tr(base + b_rd[1] + ((u0 ^ b_f[1]) << 5));
                const bf16x8 bfr = (bf16x8){lo[0], lo[1], lo[2], lo[3], hi[0], hi[1], hi[2], hi[3]};
#pragma unroll
                for (int mi = 0; mi < 4; ++mi) acc[mi][ni] = __builtin_amdgcn_mfma_f32_16x16x32_bf16(bfr, af[mi], acc[mi][ni], 0, 0, 0);
            }
        };
        gload(0, ra0, rb0); gload(1, ra1, rb1);
        lstore(0, ra0, rb0); __syncthreads();
        for (int kt = 0; kt < KT; kt += 2) {
            gload(kt + 2 < KT ? kt + 2 : KT - 1, ra0, rb0);
            __builtin_amdgcn_sched_barrier(0);
            compute(0);
            lstore(1, ra1, rb1);
            __syncthreads();
            gload(kt + 3 < KT ? kt + 3 : KT - 1, ra1, rb1);
            __builtin_amdgcn_sched_barrier(0);
            compute(1);
            lstore(0, ra0, rb0);
            __syncthreads();
        }
    }

    template <class F> static __device__ __forceinline__ void run_stream(F& f, int NSEG, int KT, int a_kstride, size_t b_kstride, LAS unsigned char* lds) {
        const int tid = opaque_tid(), lane = tid & 63, wid = tid >> 6, wm = wid >> 1, wn = wid & 1, fr = lane & 15, fq = lane >> 4;
        f32x4 acc[4][8];
#pragma unroll
        for (int mi = 0; mi < 4; ++mi)
#pragma unroll
            for (int ni = 0; ni < 8; ++ni) acc[mi][ni] = (f32x4){0.f, 0.f, 0.f, 0.f};
        int a_wr[2], b_wr[2];
#pragma unroll
        for (int i = 0; i < 2; ++i) { const int row = a_row(i, tid); a_wr[i] = row * 64 + (((tid & 3) ^ ((row >> 1) & 3)) << 4);
            const int k = b_k(i, tid), n = (tid & 31) * 8; b_wr[i] = A_BYTES + k * 512 + (((n >> 4) ^ fk2(k)) << 5) + ((n & 15) << 1); }
        int a_rd[4];
#pragma unroll
        for (int mi = 0; mi < 4; ++mi) { const int row = wm * 64 + mi * 16 + fr; a_rd[mi] = row * 64 + ((fq ^ ((row >> 1) & 3)) << 4); }
        int b_rd[2], b_f[2];
#pragma unroll
        for (int t = 0; t < 2; ++t) { const int k = 8 * fq + 4 * t + (fr >> 2); b_f[t] = fk2(k); b_rd[t] = A_BYTES + k * 512 + ((fr & 3) << 3); }
        const bf16_t* aptr[2]; const bf16_t* bptr[2];
        u32x4 ra0[2], rb0[2], ra1[2], rb1[2];
        int lseg = 0, lkt = 0;
        auto gload = [&](u32x4 (&ra)[2], u32x4 (&rb)[2]) {
#pragma unroll
            for (int i = 0; i < 2; ++i) { ra[i] = *(const u32x4*)(aptr[i] + (size_t)lkt * a_kstride); rb[i] = *(const u32x4*)(bptr[i] + (size_t)lkt * b_kstride); }
            if (lkt + 1 < KT) ++lkt; else if (lseg + 1 < NSEG) { lkt = 0; ++lseg; f.ptrs(lseg, aptr, bptr); }
        };
        auto lstore = [&](int buf, const u32x4 (&ra)[2], const u32x4 (&rb)[2]) {
            LAS unsigned char* base = lds + buf * STAGE;
#pragma unroll
            for (int i = 0; i < 2; ++i) { *(LAS u32x4*)(base + a_wr[i]) = ra[i]; *(LAS u32x4*)(base + b_wr[i]) = rb[i]; }
        };
        auto compute = [&](int buf) {
            const LAS unsigned char* base = lds + buf * STAGE;
            bf16x8 af[4];
#pragma unroll
            for (int mi = 0; mi < 4; ++mi) af[mi] = *(const LAS bf16x8*)(base + a_rd[mi]);
#pragma unroll
            for (int ni = 0; ni < 8; ++ni) {
                const int u0 = wn * 8 + ni;
                const s16x4 lo = lds_tr(base + b_rd[0] + ((u0 ^ b_f[0]) << 5));
                const s16x4 hi = lds_tr(base + b_rd[1] + ((u0 ^ b_f[1]) << 5));
                const bf16x8 bfr = (bf16x8){lo[0], lo[1], lo[2], lo[3], hi[0], hi[1], hi[2], hi[3]};
#pragma unroll
                for (int mi = 0; mi < 4; ++mi) acc[mi][ni] = __builtin_amdgcn_mfma_f32_16x16x32_bf16(bfr, af[mi], acc[mi][ni], 0, 0, 0);
            }
        };
        f.ptrs(0, aptr, bptr);
        gload(ra0, rb0); gload(ra1, rb1);
        lstore(0, ra0, rb0); __syncthreads();
        int cseg = 0, ckt = 0;
        const int total = NSEG * KT;
#pragma unroll 1
        for (int g = 0; g < total; g += 2) {
            gload(ra0, rb0);
            __builtin_amdgcn_sched_barrier(0);
            compute(0);
            lstore(1, ra1, rb1);
            __syncthreads();
            gload(ra1, rb1);
            __builtin_amdgcn_sched_barrier(0);
            compute(1);
            lstore(0, ra0, rb0);
            __syncthreads();
            ckt += 2;
            if (ckt == KT) {
                f.epi(cseg, acc);
#pragma unroll
                for (int mi = 0; mi < 4; ++mi)
#pragma unroll
                    for (int ni = 0; ni < 8; ++ni) acc[mi][ni] = (f32x4){0.f, 0.f, 0.f, 0.f};
                ckt = 0; ++cseg;
            }
        }
    }
};

template <bool BF32> struct Gemm5 {
    static constexpr int A_BYTES = 16384, STAGE = 32768, LDS_BYTES = 2 * STAGE;
    static __device__ __forceinline__ int fk2(int r) { return (r & 3) | (((r >> 3) & 1) << 2); }
    static __device__ __forceinline__ int a_row(int i, int tid) { return (tid >> 2) + 128 * i; }
    static __device__ __forceinline__ int b_k(int i, int tid) { return (tid >> 5) + 16 * i; }
    typedef typename std::conditional<BF32, float, bf16_t>::type b_t;
    static __device__ __forceinline__ void run(f32x4 (&acc)[4][8], const bf16_t* const (&aptr)[2], int a_kstride, const b_t* const (&bptr)[2], size_t b_kstride, int KT, LAS unsigned char* lds) {
        const int tid = opaque_tid(), lane = tid & 63, wid = tid >> 6, wm = wid >> 1, wn = wid & 1, fr = lane & 15, fq = lane >> 4;
#pragma unroll
        for (int mi = 0; mi < 4; ++mi)
#pragma unroll
            for (int ni = 0; ni < 8; ++ni) acc[mi][ni] = (f32x4){0.f, 0.f, 0.f, 0.f};
        int a_wr[2], b_wr[2];
#pragma unroll
        for (int i = 0; i < 2; ++i) { const int row = a_row(i, tid); a_wr[i] = row * 64 + (((tid & 3) ^ ((row >> 1) & 3)) << 4);
            const int k = b_k(i, tid), n = (tid & 31) * 8; b_wr[i] = A_BYTES + k * 512 + (((n >> 4) ^ fk2(k)) << 5) + ((n & 15) << 1); }
        int a_rd[4];
#pragma unroll
        for (int mi = 0; mi < 4; ++mi) { const int row = wm * 64 + mi * 16 + fr; a_rd[mi] = row * 64 + ((fq ^ ((row >> 1) & 3)) << 4); }
        int b_rd[2], b_f[2];
#pragma unroll
        for (int t = 0; t < 2; ++t) { const int k = 8 * fq + 4 * t + (fr >> 2); b_f[t] = fk2(k); b_rd[t] = A_BYTES + k * 512 + ((fr & 3) << 3); }
        u32x4 ra[2]; u32x4 rb[2]; f32x4 rbf[2][2];
        auto gload = [&](int kt) {
#pragma unroll
            for (int i = 0; i < 2; ++i) { ra[i] = *(const u32x4*)(aptr[i] + (size_t)kt * a_kstride);
                if (BF32) { const float* p = (const float*)bptr[i] + (size_t)kt * b_kstride; rbf[i][0] = *(const f32x4*)p; rbf[i][1] = *(const f32x4*)(p + 4); }
                else rb[i] = *(const u32x4*)((const bf16_t*)bptr[i] + (size_t)kt * b_kstride); }
        };
        auto lstore = [&](int buf) {
            LAS unsigned char* base = lds + buf * STAGE;
#pragma unroll
            for (int i = 0; i < 2; ++i) { *(LAS u32x4*)(base + a_wr[i]) = ra[i];
                if (BF32) { u32x4 w; w.x = cvtpk(rbf[i][0].x, rbf[i][0].y); w.y = cvtpk(rbf[i][0].z, rbf[i][0].w); w.z = cvtpk(rbf[i][1].x, rbf[i][1].y); w.w = cvtpk(rbf[i][1].z, rbf[i][1].w); *(LAS u32x4*)(base + b_wr[i]) = w; }
                else *(LAS u32x4*)(base + b_wr[i]) = rb[i]; }
        };
        auto compute = [&](int buf) {
            const LAS unsigned char* base = lds + buf * STAGE;
            bf16x8 af[4];
#pragma unroll
            for (int mi = 0; mi < 4; ++mi) af[mi] = *(const LAS bf16x8*)(base + a_rd[mi]);
#pragma unroll
            for (int ni = 0; ni < 8; ++ni) {
                const int u0 = wn * 8 + ni;
                const s16x4 lo = lds_tr(base + b_rd[0] + ((u0 ^ b_f[0]) << 5));
                const s16x4 hi = lds_tr(base + b_rd[1] + ((u0 ^ b_f[1]) << 5));
                const bf16x8 bfr = (bf16x8){lo[0], lo[1], lo[2], lo[3], hi[0], hi[1], hi[2], hi[3]};
#pragma unroll
                for (int mi = 0; mi < 4; ++mi) acc[mi][ni] = __builtin_amdgcn_mfma_f32_16x16x32_bf16(bfr, af[mi], acc[mi][ni], 0, 0, 0);
            }
        };
        gload(0); lstore(0); __syncthreads();
#pragma unroll 1
        for (int kt = 0; kt < KT; ++kt) {
            gload(kt + 1 < KT ? kt + 1 : KT - 1);
            __builtin_amdgcn_sched_barrier(0);
            compute(kt & 1);
            lstore((kt + 1) & 1);
            __syncthreads();
        }
    }

    template <class F> static __device__ __forceinline__ void run_stream(F& f, int NSEG, int KT, int a_kstride, size_t b_kstride, LAS unsigned char* lds) {
        const int tid = opaque_tid(), lane = tid & 63, wid = tid >> 6, wm = wid >> 1, wn = wid & 1, fr = lane & 15, fq = lane >> 4;
        f32x4 acc[4][8];
#pragma unroll
        for (int mi = 0; mi < 4; ++mi)
#pragma unroll
            for (int ni = 0; ni < 8; ++ni) acc[mi][ni] = (f32x4){0.f, 0.f, 0.f, 0.f};
        int a_wr[2], b_wr[2];
#pragma unroll
        for (int i = 0; i < 2; ++i) { const int row = a_row(i, tid); a_wr[i] = row * 64 + (((tid & 3) ^ ((row >> 1) & 3)) << 4);
            const int k = b_k(i, tid), n = (tid & 31) * 8; b_wr[i] = A_BYTES + k * 512 + (((n >> 4) ^ fk2(k)) << 5) + ((n & 15) << 1); }
        int a_rd[4];
#pragma unroll
        for (int mi = 0; mi < 4; ++mi) { const int row = wm * 64 + mi * 16 + fr; a_rd[mi] = row * 64 + ((fq ^ ((row >> 1) & 3)) << 4); }
        int b_rd[2], b_f[2];
#pragma unroll
        for (int t = 0; t < 2; ++t) { const int k = 8 * fq + 4 * t + (fr >> 2); b_f[t] = fk2(k); b_rd[t] = A_BYTES + k * 512 + ((fr & 3) << 3); }
        const bf16_t* aptr[2]; const b_t* bptr[2];
        u32x4 ra[2]; u32x4 rb[2]; f32x4 rbf[2][2];
        auto gload = [&](int kt) {
#pragma unroll
            for (int i = 0; i < 2; ++i) { ra[i] = *(const u32x4*)(aptr[i] + (size_t)kt * a_kstride);
                if (BF32) { const float* p = (const float*)bptr[i] + (size_t)kt * b_kstride; rbf[i][0] = *(const f32x4*)p; rbf[i][1] = *(const f32x4*)(p + 4); }
                else rb[i] = *(const u32x4*)((const bf16_t*)bptr[i] + (size_t)kt * b_kstride); }
        };
        auto lstore = [&](int buf) {
            LAS unsigned char* base = lds + buf * STAGE;
#pragma unroll
            for (int i = 0; i < 2; ++i) { *(LAS u32x4*)(base + a_wr[i]) = ra[i];
                if (BF32) { u32x4 w; w.x = cvtpk(rbf[i][0].x, rbf[i][0].y); w.y = cvtpk(rbf[i][0].z, rbf[i][0].w); w.z = cvtpk(rbf[i][1].x, rbf[i][1].y); w.w = cvtpk(rbf[i][1].z, rbf[i][1].w); *(LAS u32x4*)(base + b_wr[i]) = w; }
                else *(LAS u32x4*)(base + b_wr[i]) = rb[i]; }
        };
        auto compute = [&](int buf) {
            const LAS unsigned char* base = lds + buf * STAGE;
            bf16x8 af[4];
#pragma unroll
            for (int mi = 0; mi < 4; ++mi) af[mi] = *(const LAS bf16x8*)(base + a_rd[mi]);
#pragma unroll
            for (int ni = 0; ni < 8; ++ni) {
                const int u0 = wn * 8 + ni;
                const s16x4 lo = lds_tr(base + b_rd[0] + ((u0 ^ b_f[0]) << 5));
                const s16x4 hi = lds_tr(base + b_rd[1] + ((u0 ^ b_f[1]) << 5));
                const bf16x8 bfr = (bf16x8){lo[0], lo[1], lo[2], lo[3], hi[0], hi[1], hi[2], hi[3]};
#pragma unroll
                for (int mi = 0; mi < 4; ++mi) acc[mi][ni] = __builtin_amdgcn_mfma_f32_16x16x32_bf16(bfr, af[mi], acc[mi][ni], 0, 0, 0);
            }
        };
        f.ptrs(0, aptr, bptr);
        gload(0); lstore(0); __syncthreads();
        int seg = 0, kt = 0;
        const int total = NSEG * KT;
#pragma unroll 1
        for (int g = 0; g < total; ++g) {
            int nkt = kt + 1, nsg = seg; if (nkt == KT) { nkt = 0; nsg = seg + 1; }
            if (nkt == 0 && nsg < NSEG) f.ptrs(nsg, aptr, bptr);
            gload(nsg < NSEG ? nkt : KT - 1);
            __builtin_amdgcn_sched_barrier(0);
            compute(g & 1);
            lstore((g + 1) & 1);
            __syncthreads();
            if (nkt == 0) {
                f.epi(seg, acc);
#pragma unroll
                for (int mi = 0; mi < 4; ++mi)
#pragma unroll
                    for (int ni = 0; ni < 8; ++ni) acc[mi][ni] = (f32x4){0.f, 0.f, 0.f, 0.f};
            }
            seg = nsg; kt = nkt;
        }
    }
};

__device__ __forceinline__ int p2_col(int m0);
__device__ __forceinline__ void phase_mod(const Params& P, LAS unsigned char* lds) {
    const int tid = threadIdx.x;
    float* mod = (float*)(P.ws + WS_MOD);
    LAS float* sc = (LAS float*)lds;
    LAS float* red = (LAS float*)(lds + 16384);
    for (int i = tid; i < 4096; i += NTHREADS) sc[i] = siluf_(P.c[i]);
    __syncthreads();
    const int kq = tid >> 5, cl = tid & 31;
    for (int u = blockIdx.x; u < 192; u += gridDim.x) {
        const int j = u * 32 + cl;
        float a0 = 0.f, a1 = 0.f, a2 = 0.f, a3 = 0.f;
#pragma unroll 8
        for (int k = kq; k < 1024; k += 16) { const float w = P.ada_w[(size_t)k * 6144 + j];
            a0 += sc[k] * w; a1 += sc[1024 + k] * w; a2 += sc[2048 + k] * w; a3 += sc[3072 + k] * w; }
        red[(kq * 4 + 0) * 32 + cl] = a0; red[(kq * 4 + 1) * 32 + cl] = a1; red[(kq * 4 + 2) * 32 + cl] = a2; red[(kq * 4 + 3) * 32 + cl] = a3;
        __syncthreads();
        if (tid < 128) { const int b = tid >> 5; float s = 0.f;
#pragma unroll
            for (int q = 0; q < 16; ++q) s += red[(q * 4 + b) * 32 + cl];
            mod[b * 6144 + j] = s + P.ada_b[j]; }
        __syncthreads();
    }
    for (int u = blockIdx.x; u < 16; u += gridDim.x) {
        const int sel = u >> 3, j = (u & 7) * 32 + cl;
        const float* w1 = P.cmp_w1 + (size_t)sel * 2048 * 256; const float* pos = P.cmp_pos + sel * 2048;
        float a0 = 0.f;
#pragma unroll 8
        for (int k = kq; k < 2048; k += 16) a0 += pos[k] * w1[(size_t)k * 256 + j];
        red[kq * 32 + cl] = a0;
        __syncthreads();
        if (tid < 32) { float s = 0.f;
#pragma unroll
            for (int q = 0; q < 16; ++q) s += red[q * 32 + cl];
            ((float*)(P.ws + WS_CB))[sel * 256 + j] = s + P.cmp_b1[sel * 256 + j]; }
        __syncthreads();
    }
    {
        bf16_t* wb = (bf16_t*)(P.ws + WS_WIN);
        const int gt = blockIdx.x * NTHREADS + tid, NG = gridDim.x * NTHREADS;
        for (int i = gt; i < 1024 * (3584 / 8); i += NG) { const int k = i / 448, m8 = (i % 448) * 8, c8 = (m8 & ~255) + p2_col(m8 & 255);
            const int sc_ = c8 < 1280 ? c8 : (c8 < 3328 ? c8 + 24 : c8 - 2048);
            u32x4 o = (u32x4){0u, 0u, 0u, 0u};
            if (c8 < 3352) { const f32x4 a = *(const f32x4*)(P.w_in + (size_t)k * IN_COLS + sc_); o.x = cvtpk(a.x, a.y); o.y = cvtpk(a.z, a.w); }
            if (c8 + 8 < 3352) { const f32x4 b2 = *(const f32x4*)(P.w_in + (size_t)k * IN_COLS + sc_ + 8); o.z = cvtpk(b2.x, b2.y); o.w = cvtpk(b2.z, b2.w); }
            *(u32x4*)(wb + (size_t)k * 3584 + m8) = o; }
    }
    if (blockIdx.x == gridDim.x - 2) {
        for (int i = tid; i < 2 * 8 * 64; i += NTHREADS) { const int t2 = i >> 9, bg = (i >> 6) & 7, d = i & 63;
            ((bf16_t*)(P.ws + (t2 ? WS_VC : WS_KC)))[((size_t)bg * 512 + 511) * 64 + d] = 0; }
    }
    if (blockIdx.x == gridDim.x - 1) {
        float* lb = (float*)(P.ws + WS_LB);
        for (int i = tid; i < 512; i += NTHREADS) { const float p0 = P.hgrn_lb[i], p1 = P.hgrn_lb[512 + i]; lb[i] = 1.0f / (1.0f + __expf(p1 - p0)); }
    }
}

__device__ __forceinline__ void norm_mod_rows(const float* x, const float* w, const float* mod_sh, const float* mod_sc, bf16_t* h, int hs) {
    const int lane = threadIdx.x & 63, gw = blockIdx.x * (NTHREADS / 64) + (threadIdx.x >> 6), NGW = gridDim.x * (NTHREADS / 64);
    for (int m = gw; m < T; m += NGW) {
        const int b = m / SEQ;
        const f32x4* xr = (const f32x4*)(x + (size_t)m * D) + lane;
        f32x4 v[4]; float s = 0.f;
#pragma unroll
        for (int j = 0; j < 4; ++j) { v[j] = xr[64 * j]; s += (v[j].x * v[j].x + v[j].y * v[j].y) + (v[j].z * v[j].z + v[j].w * v[j].w); }
        const float rstd = rsqrtf(wave_sum(s) * (1.f / D) + RMS_EPS);
        u32x2* o = (u32x2*)(h + (size_t)m * hs) + lane;
#pragma unroll
        for (int j = 0; j < 4; ++j) {
            const int col = (lane + 64 * j) * 4;
            const f32x4 wv = *(const f32x4*)(w + col), scv = *(const f32x4*)(mod_sc + b * 6144 + col), shv = *(const f32x4*)(mod_sh + b * 6144 + col);
            f32x4 r;
            r.x = v[j].x * rstd * wv.x * (1.f + scv.x) + shv.x; r.y = v[j].y * rstd * wv.y * (1.f + scv.y) + shv.y;
            r.z = v[j].z * rstd * wv.z * (1.f + scv.z) + shv.z; r.w = v[j].w * rstd * wv.w * (1.f + scv.w) + shv.w;
            u32x2 pk; pk.x = cvtpk(r.x, r.y); pk.y = cvtpk(r.z, r.w); o[64 * j] = pk;
        }
    }
}

__device__ __forceinline__ void phase_inproj(const Params& P, LAS unsigned char* lds) {
    constexpr int NRT = T / 256, NCT = 14;
    struct F { const Params& P;
        __device__ __forceinline__ void unit(int seg, int& rt, int& ct) const {
            const int nx = (gridDim.x % 8 == 0) ? 8 : 1, xl = blockIdx.x % nx, li = blockIdx.x / nx, nloc = gridDim.x / nx;
            const int v = li + seg * nloc, rg = v / (NCT * 4), rem = v % (NCT * 4); ct = rem >> 2; rt = xl + nx * (rg * 4 + (rem & 3)); }
        __device__ __forceinline__ void ptrs(int seg, const bf16_t* (&aptr)[2], const bf16_t* (&bptr)[2]) const {
            const int tid = opaque_tid(), lane = tid & 63, wid = tid >> 6; int rt, ct; unit(seg, rt, ct);
            const bf16_t* h1 = (const bf16_t*)(P.ws + WS_H); const bf16_t* wb = (const bf16_t*)(P.ws + WS_WIN);
#pragma unroll
            for (int i = 0; i < 2; ++i) { const int row = Gemm3::a_row(i, wid, lane); aptr[i] = h1 + (size_t)(rt * 256 + row) * H1S + Gemm3::a_chunk(row, lane) * 8;
                const int k = Gemm3::b_k(i, wid, lane); bptr[i] = wb + (size_t)k * 3584 + ct * 256 + Gemm3::b_n(k, lane); } }
        __device__ __forceinline__ void epi(int seg, f32x4 (&acc)[4][8]) const {
            const int tid = opaque_tid(), lane = tid & 63, wid = tid >> 6, wm = wid >> 1, wn = wid & 1, fr = lane & 15, fq = lane >> 4;
            int rt, ct; unit(seg, rt, ct);
            bf16_t* qo = (bf16_t*)(P.ws + WS_Q); bf16_t* kvo = (bf16_t*)(P.ws + WS_KV); float* gates = (float*)(P.ws + WS_GATES);
            bf16_t* hq = (bf16_t*)(P.ws + WS_HQ); float* logf = (float*)(P.ws + WS_LOGF); bf16_t* hv = (bf16_t*)(P.ws + WS_HV); bf16_t* hg = (bf16_t*)(P.ws + WS_HG);
            const float* lb = (const float*)(P.ws + WS_LB);
        const int row0 = rt * 256 + wm * 64 + fr;
            const int cw = wn * 128 + 8 * fq;
            if (ct < 5) {
                const bool is_q = ct < 2; const int seg = (ct - 2) * 2 + wn;
                const bool do_norm = is_q || seg == 2 || seg == 4;
                const float* nw = is_q ? P.q_norm_w : (P.k_norm_w + (seg == 2 ? 64 : 128));
                const float osc = is_q ? 0.125f : 1.0f;
#pragma unroll
                for (int hh = 0; hh < 2; ++hh) {
                    f32x4 wv[4];
#pragma unroll
                    for (int n4 = 0; n4 < 4; ++n4) wv[n4] = do_norm ? *(const f32x4*)(nw + (n4 >> 1) * 32 + 8 * fq + (n4 & 1) * 4) : (f32x4){1.f, 1.f, 1.f, 1.f};
#pragma unroll
                    for (int mi = 0; mi < 4; ++mi) {
                        float rstd = 1.f;
                        if (do_norm) { float s = 0.f;
#pragma unroll
                            for (int n4 = 0; n4 < 4; ++n4) { const f32x4 a = acc[mi][hh * 4 + n4]; s += (a.x * a.x + a.y * a.y) + (a.z * a.z + a.w * a.w); }
                            s += __shfl_xor(s, 16); s += __shfl_xor(s, 32);
                            rstd = rsqrtf(s * (1.f / 64.f) + RMS_EPS) * osc; }
                        const size_t m = (size_t)(row0 + mi * 16);
                        bf16_t* dst = is_q ? (qo + m * 512 + ct * 256 + cw + hh * 64) : (kvo + m * 768 + (ct - 2) * 256 + cw + hh * 64);
#pragma unroll
                        for (int jj = 0; jj < 2; ++jj) { const f32x4 a = acc[mi][hh * 4 + 2 * jj], c = acc[mi][hh * 4 + 2 * jj + 1]; const f32x4 w0 = wv[2 * jj], w1 = wv[2 * jj + 1];
                            *(u32x4*)(dst + jj * 32) = (u32x4){cvtpk(a.x * rstd * w0.x, a.y * rstd * w0.y), cvtpk(a.z * rstd * w0.z, a.w * rstd * w0.w),
                                                               cvtpk(c.x * rstd * w1.x, c.y * rstd * w1.y), cvtpk(c.z * rstd * w1.z, c.w * rstd * w1.w)}; }
                    }
                }
            } else if (ct == 13) {
                if (wn == 0 && fq < 3) {
#pragma unroll
                    for (int mi = 0; mi < 4; ++mi) { const size_t m = (size_t)(row0 + mi * 16); const f32x4 a = acc[mi][0], c = acc[mi][1];
                        *(f32x4*)(gates + m * 24 + 8 * fq) = (f32x4){sigmoidf_(a.x), sigmoidf_(a.y), sigmoidf_(a.z), sigmoidf_(a.w)};
                        *(f32x4*)(gates + m * 24 + 8 * fq + 4) = (f32x4){sigmoidf_(c.x), sigmoidf_(c.y), sigmoidf_(c.z), sigmoidf_(c.w)}; }
                }
            } else {
                const int hs = (ct - 5) >> 1, cc = ((ct - 5) & 1) * 256 + cw;
#pragma unroll
                for (int mi = 0; mi < 4; ++mi) { const size_t m = (size_t)(row0 + mi * 16);
#pragma unroll
                    for (int j = 0; j < 4; ++j) { const f32x4 a = acc[mi][2 * j], d = acc[mi][2 * j + 1]; const int c = cc + j * 32;
                        if (hs == 0) { const float s = 0.08838834764831845f;
                            *(u32x4*)(hq + m * 512 + c) = (u32x4){cvtpk(siluf_(a.x) * s, siluf_(a.y) * s), cvtpk(siluf_(a.z) * s, siluf_(a.w) * s), cvtpk(siluf_(d.x) * s, siluf_(d.y) * s), cvtpk(siluf_(d.z) * s, siluf_(d.w) * s)}; }
                        else if (hs == 1) { const f32x4 l = *(const f32x4*)(lb + c), l2 = *(const f32x4*)(lb + c + 4); f32x4 o, o2;
                            o.x = __logf(l.x + (1.f - l.x) * sigmoidf_(a.x)); o.y = __logf(l.y + (1.f - l.y) * sigmoidf_(a.y));
                            o.z = __logf(l.z + (1.f - l.z) * sigmoidf_(a.z)); o.w = __logf(l.w + (1.f - l.w) * sigmoidf_(a.w));
                            o2.x = __logf(l2.x + (1.f - l2.x) * sigmoidf_(d.x)); o2.y = __logf(l2.y + (1.f - l2.y) * sigmoidf_(d.y));
                            o2.z = __logf(l2.z + (1.f - l2.z) * sigmoidf_(d.z)); o2.w = __logf(l2.w + (1.f - l2.w) * sigmoidf_(d.w));
                            *(f32x4*)(logf + m * 512 + c) = o; *(f32x4*)(logf + m * 512 + c + 4) = o2; }
                        else if (hs == 2) { *(u32x4*)(hv + m * 512 + c) = (u32x4){cvtpk(a.x, a.y), cvtpk(a.z, a.w), cvtpk(d.x, d.y), cvtpk(d.z, d.w)}; }
                        else { *(u32x4*)(hg + m * 512 + c) = (u32x4){cvtpk(sigmoidf_(a.x), sigmoidf_(a.y)), cvtpk(sigmoidf_(a.z), sigmoidf_(a.w)), cvtpk(sigmoidf_(d.x), sigmoidf_(d.y)), cvtpk(sigmoidf_(d.z), sigmoidf_(d.w))}; }
                    } }
            }
        }
    } f{P};
    const int nx = (gridDim.x % 8 == 0) ? 8 : 1, li = blockIdx.x / nx, nloc = gridDim.x / nx;
    const int nu = ((NRT / nx) * NCT - li + nloc - 1) / nloc;
    if (nu > 0) Gemm3::run_stream(f, nu, D / 32, 32, (size_t)32 * 3584, lds);
}

__device__ __forceinline__ float gelu_tanh(float x) {
    const float u = 0.7978845608028654f * (x + 0.044715f * x * x * x);
    const float th = 1.0f - 2.0f / (1.0f + __expf(2.0f * u));
    return 0.5f * x * (1.0f + th);
}
__device__ __forceinline__ void compress_unit(const Params& P, LAS unsigned char* lds, int u) {
    typedef GemmT<2, 4> G;
    const int tid = opaque_tid(), lane = tid & 63, wid = tid >> 6, wm = wid >> 2, wn = wid & 3, fr = lane & 15, fq = lane >> 4;
    const int sel = u >> 5, rt = u & 31;
    const bf16_t* kv = (const bf16_t*)(P.ws + WS_KV);
    bf16_t* cmph = (bf16_t*)(P.ws + WS_CMPH) + (size_t)sel * 4096 * 256;
    const float* cb = (const float*)(P.ws + WS_CB) + sel * 256;
    const bf16_t* arow[2];
#pragma unroll
    for (int p = 0; p < 2; ++p) { int r = rt * 128 + p * 64 + (tid >> 3); r = r < 4088 ? r : 4087;
        const int b = r / 1022, rem = r % 1022, i = rem >> 1, g = rem & 1;
        arow[p] = kv + (size_t)(b * SEQ + 16 * i) * 768 + sel * 128 + g * 64; }
    f32x4 acc[4][4];
    G::run(acc, arow, 768, P.cmp_w1 + (size_t)sel * 2048 * 256, 256, 32, lds);
#pragma unroll
    for (int mi = 0; mi < 4; ++mi) { const size_t row = (size_t)(rt * 128 + wm * 64 + mi * 16 + fr);
#pragma unroll
        for (int ni = 0; ni < 4; ++ni) { const int col = wn * 64 + ni * 16 + 4 * fq; const f32x4 a = acc[mi][ni]; const f32x4 bb = *(const f32x4*)(cb + col);
            u32x2 pk; pk.x = cvtpk(gelu_tanh(a.x + bb.x), gelu_tanh(a.y + bb.y)); pk.y = cvtpk(gelu_tanh(a.z + bb.z), gelu_tanh(a.w + bb.w));
            *(u32x2*)(cmph + row * 256 + col) = pk; } }
    __syncthreads();
    {
        const int row = tid >> 2, cq = tid & 3;
        const bf16_t* hr = cmph + (size_t)(rt * 128 + row) * 256;
        const float* w2 = P.cmp_w2 + (size_t)sel * 256 * 64 + cq * 16;
        float o[16];
#pragma unroll
        for (int j = 0; j < 16; ++j) o[j] = 0.f;
        for (int k8 = 0; k8 < 256; k8 += 8) {
            const u32x4 hv = *(const u32x4*)(hr + k8);
#pragma unroll
            for (int kk = 0; kk < 8; ++kk) {
                const unsigned wd = hv[kk >> 1]; const float a = (kk & 1) ? __uint_as_float(wd & 0xffff0000u) : __uint_as_float(wd << 16);
                const float* wr = w2 + (size_t)(k8 + kk) * 64;
#pragma unroll
                for (int j4 = 0; j4 < 4; ++j4) { const f32x4 w = *(const f32x4*)(wr + j4 * 4);
                    o[j4 * 4 + 0] += a * w.x; o[j4 * 4 + 1] += a * w.y; o[j4 * 4 + 2] += a * w.z; o[j4 * 4 + 3] += a * w.w; }
            }
        }
        if (sel == 0) { float s = 0.f;
#pragma unroll
            for (int j = 0; j < 16; ++j) s += o[j] * o[j];
            s += __shfl_xor(s, 1); s += __shfl_xor(s, 2);
            const float rstd = rsqrtf(s * (1.f / 64.f) + RMS_EPS);
#pragma unroll
            for (int j = 0; j < 16; ++j) o[j] *= rstd * P.k_norm_w[cq * 16 + j]; }
        const int r = rt * 128 + row;
        if (r < 4088) { const int b = r / 1022, rem = r % 1022, i = rem >> 1, g = rem & 1;
            bf16_t* dst = (bf16_t*)(P.ws + (sel ? WS_VC : WS_KC)) + ((size_t)(b * 2 + g) * 512 + i) * 64 + cq * 16;
            u32x4 w0, w1;
            w0.x = cvtpk(o[0], o[1]); w0.y = cvtpk(o[2], o[3]); w0.z = cvtpk(o[4], o[5]); w0.w = cvtpk(o[6], o[7]);
            w1.x = cvtpk(o[8], o[9]); w1.y = cvtpk(o[10], o[11]); w1.z = cvtpk(o[12], o[13]); w1.w = cvtpk(o[14], o[15]);
            *(u32x4*)dst = w0; *(u32x4*)(dst + 8) = w1; }
    }
    __syncthreads();
}

__device__ __forceinline__ int off_row128(int row, int ch) { return row * 128 + ((ch ^ ((row >> 1) & 7)) << 4); }
__device__ __forceinline__ int off_row256(int row, int ch) { return row * 256 + ((ch ^ (row & 15)) << 4); }
__device__ __forceinline__ int fk_(int r) { return (r & 3) | (((r >> 3) & 1) << 2); }
__device__ __forceinline__ int off_tr256(int row, int col) { return row * 256 + ((((col >> 4) ^ fk_(row)) << 5) + ((col & 15) << 1)); }
constexpr int HL_QT = 0, HL_KT = 16384, HL_KH = 32768, HL_V = 49152, HL_SB = 65536, HL_P = 98304  , HL_TOT = 106496  , HL_RED = 110592  , HL_END = 111104;

template <int MODE> __device__ __forceinline__ void hgrn_unit(const Params& P, LAS unsigned char* lds, int u) {
    const int tid = opaque_tid(), lane = tid & 63, wid = tid >> 6, fr = lane & 15, fq = lane >> 4;
    const int b = u >> 7, h = (u >> 5) & 3, sc = u & 31;
    const bf16_t* hq = (const bf16_t*)(P.ws + WS_HQ); const float* logf = (const float*)(P.ws + WS_LOGF);
    const bf16_t* hv = (const bf16_t*)(P.ws + WS_HV); const bf16_t* hg = (const bf16_t*)(P.ws + WS_HG);
    float* HLs = (float*)(P.ws + WS_HL); float* HDs = (float*)(P.ws + WS_HD);
    bf16_t* mix = (bf16_t*)(P.ws + WS_MIX);
    LAS float* tot = (LAS float*)(lds + HL_TOT); LAS float* red = (LAS float*)(lds + HL_RED);
    f32x4 st[8];
#pragma unroll
    for (int vt = 0; vt < 8; ++vt) st[vt] = (f32x4){0.f, 0.f, 0.f, 0.f};
    if (MODE == 1) {
        const int kk = 16 * wid + fr;
#pragma unroll 4
        for (int j = 0; j < sc; ++j) {
            const float* Lj = HLs + (size_t)(u - sc + j) * 16384 + kk * 128 + 4 * fq; const float dj = HDs[(size_t)(u - sc + j) * 128 + kk];
#pragma unroll
            for (int vt = 0; vt < 8; ++vt) { const f32x4 l = *(const f32x4*)(Lj + vt * 16); st[vt] = st[vt] * dj + l; }
        }
    }
    float dsum = 0.f;
    const int kp = tid & 63, te = tid >> 6;
    for (int c = 0; c < 4; ++c) {
        const size_t tok0 = (size_t)b * SEQ + sc * 256 + c * 64;
        float lf0[8], lf1[8], cs0[8], cs1[8];
        { float a0 = 0.f, a1 = 0.f;
#pragma unroll
          for (int i = 0; i < 8; ++i) { const float2 v = *(const float2*)(logf + (tok0 + te * 8 + i) * 512 + h * 128 + 2 * kp); lf0[i] = v.x; lf1[i] = v.y; a0 += v.x; a1 += v.y; cs0[i] = a0; cs1[i] = a1; }
          tot[te * 128 + 2 * kp] = a0; tot[te * 128 + 2 * kp + 1] = a1; }
#pragma unroll
        for (int i = 0; i < 2; ++i) { const int pc = tid + NTHREADS * i, row = pc >> 4, c8 = (pc & 15) * 8;
            const u32x4 v = *(const u32x4*)(hv + (tok0 + row) * 512 + h * 128 + c8);
            *(LAS u32x4*)(lds + HL_V + off_tr256(row, c8)) = v; }
        if (MODE == 1 ) {
#pragma unroll
            for (int vt = 0; vt < 8; ++vt) { u32x2 pk; pk.x = cvtpk(st[vt].x, st[vt].y); pk.y = cvtpk(st[vt].z, st[vt].w);
                *(LAS u32x2*)(lds + HL_SB + off_tr256(16 * wid + fr, 16 * vt + 4 * fq)) = pk; }
        }
        __syncthreads();
        float pre0 = 0.f, pre1 = 0.f, last0 = 0.f, last1 = 0.f;
#pragma unroll
        for (int e = 0; e < 8; ++e) { const float t0 = tot[e * 128 + 2 * kp], t1 = tot[e * 128 + 2 * kp + 1]; if (e < te) { pre0 += t0; pre1 += t1; } last0 += t0; last1 += t1; }
#pragma unroll
        for (int i = 0; i < 8; ++i) {
            const int t = te * 8 + i;
            const float c0 = cs0[i] + pre0, c1 = cs1[i] + pre1;
            const float k0 = 1.f - __expf(lf0[i]), k1 = 1.f - __expf(lf1[i]);
            const unsigned khat = cvtpk(k0 * __expf(last0 - c0), k1 * __expf(last1 - c1));
            *(LAS unsigned*)(lds + HL_KH + off_tr256(t, 2 * kp)) = khat;
            if (MODE == 1) {
                const unsigned qraw = *(const unsigned*)(hq + (tok0 + t) * 512 + h * 128 + 2 * kp);
                const float q0 = __uint_as_float(qraw << 16), q1 = __uint_as_float(qraw & 0xffff0000u);
                const unsigned qt = cvtpk(q0 * __expf(c0), q1 * __expf(c1));
                const unsigned kt = cvtpk(k0 * __expf(fminf(-c0, 80.f)), k1 * __expf(fminf(-c1, 80.f)));
                const int o = off_row256(t, kp >> 2) + ((kp & 3) << 2);
                *(LAS unsigned*)(lds + HL_QT + o) = qt; *(LAS unsigned*)(lds + HL_KT + o) = kt;
            }
        }
        const float dec = __expf(tot[0 * 128 + 16 * wid + fr] + tot[1 * 128 + 16 * wid + fr] + tot[2 * 128 + 16 * wid + fr] + tot[3 * 128 + 16 * wid + fr]
                                 + tot[4 * 128 + 16 * wid + fr] + tot[5 * 128 + 16 * wid + fr] + tot[6 * 128 + 16 * wid + fr] + tot[7 * 128 + 16 * wid + fr]);
        if (MODE == 0 && tid < 128) { float s = 0.f;
#pragma unroll
            for (int e = 0; e < 8; ++e) s += tot[e * 128 + tid];
            dsum += s; }
        __syncthreads();
        f32x4 oacc[4];
        if (MODE == 1) {
            { const int tt = wid & 3;
#pragma unroll
              for (int si = 0; si < 2; ++si) { const int stl = 2 * (wid >> 2) + si;
                  f32x4 sacc = (f32x4){0.f, 0.f, 0.f, 0.f};
                  if (stl <= tt) {
#pragma unroll
                      for (int ks = 0; ks < 4; ++ks) {
                          const bf16x8 a = *(const LAS bf16x8*)(lds + HL_KT + off_row256(stl * 16 + fr, ks * 4 + fq));
                          const bf16x8 bq = *(const LAS bf16x8*)(lds + HL_QT + off_row256(tt * 16 + fr, ks * 4 + fq));
                          sacc = __builtin_amdgcn_mfma_f32_16x16x32_bf16(a, bq, sacc, 0, 0, 0);
                      }
                  }
                  const int t = tt * 16 + fr, s0 = stl * 16 + 4 * fq;
                  u32x2 pk; pk.x = cvtpk(s0 + 0 <= t ? sacc.x : 0.f, s0 + 1 <= t ? sacc.y : 0.f); pk.y = cvtpk(s0 + 2 <= t ? sacc.z : 0.f, s0 + 3 <= t ? sacc.w : 0.f);
                  *(LAS u32x2*)(lds + HL_P + off_row128(t, s0 >> 3) + ((s0 & 7) << 1)) = pk; }
            }
            __syncthreads();
            { const int tt = wid >> 1;
#pragma unroll
              for (int i = 0; i < 4; ++i) { const int vt = 4 * (wid & 1) + i;
                  f32x4 a = (f32x4){0.f, 0.f, 0.f, 0.f};
#pragma unroll
                  for (int ks = 0; ks < 2; ++ks) {
                      const int kr = ks * 32 + 8 * fq + (fr >> 2);
                      const s16x4 lo = lds_tr(lds + HL_V + off_tr256(kr, vt * 16 + 4 * (fr & 3))), hi = lds_tr(lds + HL_V + off_tr256(kr + 4, vt * 16 + 4 * (fr & 3)));
                      const bf16x8 va = (bf16x8){lo[0], lo[1], lo[2], lo[3], hi[0], hi[1], hi[2], hi[3]};
                      const bf16x8 pb = *(const LAS bf16x8*)(lds + HL_P + off_row128(tt * 16 + fr, ks * 4 + fq));
                      a = __builtin_amdgcn_mfma_f32_16x16x32_bf16(va, pb, a, 0, 0, 0);
                  }
#pragma unroll
                  for (int ks = 0; ks < 4; ++ks) {
                      const int kr = ks * 32 + 8 * fq + (fr >> 2);
                      const s16x4 lo = lds_tr(lds + HL_SB + off_tr256(kr, vt * 16 + 4 * (fr & 3))), hi = lds_tr(lds + HL_SB + off_tr256(kr + 4, vt * 16 + 4 * (fr & 3)));
                      const bf16x8 sa = (bf16x8){lo[0], lo[1], lo[2], lo[3], hi[0], hi[1], hi[2], hi[3]};
                      const bf16x8 qb = *(const LAS bf16x8*)(lds + HL_QT + off_row256(tt * 16 + fr, ks * 4 + fq));
                      a = __builtin_amdgcn_mfma_f32_16x16x32_bf16(sa, qb, a, 0, 0, 0);
                  }
                  const u32x2 gr = *(const u32x2*)(hg + (tok0 + tt * 16 + fr) * 512 + h * 128 + vt * 16 + 4 * fq);
                  a.x *= __uint_as_float(gr.x << 16); a.y *= __uint_as_float(gr.x & 0xffff0000u); a.z *= __uint_as_float(gr.y << 16); a.w *= __uint_as_float(gr.y & 0xffff0000u);
                  oacc[i] = a; }
              float ss = 0.f;
#pragma unroll
              for (int i = 0; i < 4; ++i) ss += (oacc[i].x * oacc[i].x + oacc[i].y * oacc[i].y) + (oacc[i].z * oacc[i].z + oacc[i].w * oacc[i].w);
              ss += __shfl_xor(ss, 16); ss += __shfl_xor(ss, 32);
              if (fq == 0) red[(tt * 2 + (wid & 1)) * 16 + fr] = ss; }
        }
#pragma unroll
        for (int vt = 0; vt < 8; ++vt) {
            f32x4 a = st[vt] * dec;
#pragma unroll
            for (int ks = 0; ks < 2; ++ks) {
                const int kr = ks * 32 + 8 * fq + (fr >> 2);
                const s16x4 lo = lds_tr(lds + HL_V + off_tr256(kr, vt * 16 + 4 * (fr & 3))), hi = lds_tr(lds + HL_V + off_tr256(kr + 4, vt * 16 + 4 * (fr & 3)));
                const bf16x8 va = (bf16x8){lo[0], lo[1], lo[2], lo[3], hi[0], hi[1], hi[2], hi[3]};
                const s16x4 lo2 = lds_tr(lds + HL_KH + off_tr256(kr, wid * 16 + 4 * (fr & 3))), hi2 = lds_tr(lds + HL_KH + off_tr256(kr + 4, wid * 16 + 4 * (fr & 3)));
                const bf16x8 kb = (bf16x8){lo2[0], lo2[1], lo2[2], lo2[3], hi2[0], hi2[1], hi2[2], hi2[3]};
                a = __builtin_amdgcn_mfma_f32_16x16x32_bf16(va, kb, a, 0, 0, 0);
            }
            st[vt] = a;
        }
        __syncthreads();
        if (MODE == 1) {
            const int tt = wid >> 1; const float ssum = red[(tt * 2) * 16 + fr] + red[(tt * 2 + 1) * 16 + fr];
            const float rstd = rsqrtf(ssum * (1.f / 128.f) + RMS_EPS);
#pragma unroll
            for (int i = 0; i < 4; ++i) { const int v = (4 * (wid & 1) + i) * 16 + 4 * fq; const f32x4 w = *(const f32x4*)(P.rec_out_norm_w + h * 128 + v);
                u32x2 pk; pk.x = cvtpk(oacc[i].x * rstd * w.x, oacc[i].y * rstd * w.y); pk.y = cvtpk(oacc[i].z * rstd * w.z, oacc[i].w * rstd * w.w);
                *(u32x2*)(mix + (tok0 + tt * 16 + fr) * 1024 + 512 + h * 128 + v) = pk; }
        }
    }
    if (MODE == 0) {
#pragma unroll
        for (int vt = 0; vt < 8; ++vt) *(f32x4*)(HLs + (size_t)u * 16384 + (16 * wid + fr) * 128 + vt * 16 + 4 * fq) = st[vt];
        if (tid < 128) HDs[(size_t)u * 128 + tid] = __expf(dsum);
    }
    __syncthreads();
}


constexpr int NL_K = 0, NL_V = 16384, NL_IMP = 32768, NL_IMP_STRIDE = 132, NL_SELM = NL_IMP + 8 * 8 * NL_IMP_STRIDE * 4, NL_END = NL_SELM + 1024;
__device__ __forceinline__ int off_v128(int row, int ch) { return row * 128 + ((ch ^ ((row & 3) << 1)) << 4); }
#define MFMA32(a, b, c) __builtin_amdgcn_mfma_f32_32x32x16_bf16(a, b, c, 0, 0, 0)

struct NsaLane { int t; float sl2; int qi; unsigned long long mlo, mhi; };

template <int MODE> __device__ __forceinline__ void nsa_pass(LAS unsigned char* lds, const bf16_t* Kg, const bf16_t* Vg, int rs, unsigned long long ulo, unsigned long long uhi,
                                                            const bf16x8 (&qf)[4], const NsaLane& L, float inv, float& lsum, f32x16 (&O)[2], LAS float* impw) {
    const int tid = opaque_tid(), lane = tid & 63, hi = lane >> 5, c = lane & 31;
    const int ld_row = tid >> 3, ld_ch = tid & 7;
    const int kw_off = off_row128(ld_row, ld_ch), vw_off = off_v128(ld_row, ld_ch);
    u32x4 k0, v0, k1, v1, k2, v2;
    auto next = [&](int jj) -> int { ++jj; if (jj < 64) { const unsigned long long m = ulo >> jj; if (m) return jj + __builtin_ctzll(m); jj = 64; }
                                     if (jj < 128) { const unsigned long long m = uhi >> (jj - 64); if (m) return jj + __builtin_ctzll(m); } return 128; };
    int jA = next(-1), jB = jA < 128 ? next(jA) : 128, jC = jB < 128 ? next(jB) : 128;
    const int jsafe = jA < 128 ? jA : 0;
    auto ldk = [&](int jj) -> u32x4 { const int q = jj < 128 ? jj : jsafe; return *(const u32x4*)(Kg + (size_t)(q * 64 + ld_row) * rs + ld_ch * 8); };
    auto ldv = [&](int jj) -> u32x4 { const int q = jj < 128 ? jj : jsafe; return *(const u32x4*)(Vg + (size_t)(q * 64 + ld_row) * rs + ld_ch * 8); };
    k0 = ldk(jA); k1 = ldk(jB); k2 = ldk(jC);
    if (MODE != 0) { v0 = ldv(jA); v1 = ldv(jB); v2 = ldv(jC); }
    int it = 0;
    auto step = [&](u32x4& kreg, u32x4& vreg) {
        const int j = jA;
        LAS unsigned char* kb = lds + NL_K + (it & 1) * 8192; LAS unsigned char* vb = lds + NL_V + (it & 1) * 8192;
        *(LAS u32x4*)(kb + kw_off) = kreg; if (MODE != 0) *(LAS u32x4*)(vb + vw_off) = vreg;
        const int jD = jC < 128 ? next(jC) : 128;
        kreg = ldk(jD); if (MODE != 0) vreg = ldv(jD);
        __syncthreads();
        bool need = true; bool selbit = true;
        if (MODE == 2) { selbit = (j < 64 ? (L.mlo >> j) : (L.mhi >> (j - 64))) & 1ull; need = __any(selbit); }
        if (need) {
            f32x16 p0 = {}, p1 = {};
#pragma unroll
            for (int ks = 0; ks < 4; ++ks) {
                const bf16x8 a0 = *(const LAS bf16x8*)(kb + off_row128(c, 2 * ks + hi)), a1 = *(const LAS bf16x8*)(kb + off_row128(32 + c, 2 * ks + hi));
                p0 = MFMA32(a0, qf[ks], p0); p1 = MFMA32(a1, qf[ks], p1);
            }
            const int stride = (MODE <= 1) ? 16 : 1;
            const int dl = (MODE <= 1) ? (L.t - 31 - 16 * (j * 64 + 4 * hi)) : (L.t - (j * 64 + 4 * hi));
            const float nb = -L.sl2 * (float)dl, sls = L.sl2 * (float)stride;
            float rs_ = 0.f;
#pragma unroll
            for (int r = 0; r < 16; ++r) {
                const int ro0 = (r & 3) + 8 * (r >> 2), ro1 = ro0 + 32;
                const int d0 = dl - stride * ro0, d1 = dl - stride * ro1;
                bool v0 = d0 >= 0, v1 = d1 >= 0;
                if (MODE == 3) { v0 = v0 && d0 < 512; v1 = v1 && d1 < 512; }
                if (MODE == 2) { v0 = v0 && selbit; v1 = v1 && selbit; }
                float e0 = __builtin_amdgcn_exp2f(__builtin_fmaf(p0[r], LOG2E, __builtin_fmaf(sls, (float)ro0, nb)));
                float e1 = __builtin_amdgcn_exp2f(__builtin_fmaf(p1[r], LOG2E, __builtin_fmaf(sls, (float)ro1, nb)));
                e0 = v0 ? e0 : 0.f; e1 = v1 ? e1 : 0.f;
                if (MODE == 1) { e0 *= inv; e1 *= inv; }
                p0[r] = e0; p1[r] = e1; rs_ += e0 + e1;
            }
            lsum += rs_;
            if (MODE == 1) {
#pragma unroll
                for (int kt = 0; kt < 2; ++kt)
#pragma unroll
                    for (int i = 0; i < 4; ++i) {
                        float g = kt ? (p1[4 * i] + p1[4 * i + 1]) + (p1[4 * i + 2] + p1[4 * i + 3]) : (p0[4 * i] + p0[4 * i + 1]) + (p0[4 * i + 2] + p0[4 * i + 3]);
                        float l3 = kt ? p1[4 * i + 3] : p0[4 * i + 3];
                        g += __shfl_xor(g, 1); g += __shfl_xor(g, 2); l3 += __shfl_xor(l3, 1); l3 += __shfl_xor(l3, 2);
                        if ((c & 3) == 0) { const int jj = j * 16 + kt * 8 + 2 * i + hi; __hip_atomic_fetch_add(impw + L.qi * NL_IMP_STRIDE + jj, g, __ATOMIC_RELAXED, __HIP_MEMORY_SCOPE_WORKGROUP); __hip_atomic_fetch_add(impw + L.qi * NL_IMP_STRIDE + jj + 1, l3, __ATOMIC_RELAXED, __HIP_MEMORY_SCOPE_WORKGROUP); }
                    }
            }
            if (MODE != 0) {
                bf16x8 pf[4];
#pragma unroll
                for (int s4 = 0; s4 < 4; ++s4) { u32x4 w;
#pragma unroll
                    for (int e = 0; e < 4; ++e) { const int r = 8 * (s4 & 1) + 2 * e; w[e] = (s4 >> 1) ? cvtpk(p1[r], p1[r + 1]) : cvtpk(p0[r], p0[r + 1]); }
                    pf[s4] = __builtin_bit_cast(bf16x8, w); }
                const int g4 = lane >> 4, sub = g4 & 1, i16 = lane & 15, qq = i16 >> 2, pp = i16 & 3;
#pragma unroll
                for (int dt = 0; dt < 2; ++dt)
#pragma unroll
                    for (int s4 = 0; s4 < 4; ++s4) {
                        const int row = 16 * s4 + 4 * hi + qq, ch = 4 * dt + 2 * sub + (pp >> 1);
                        const s16x4 lo = lds_tr(vb + off_v128(row, ch) + 8 * (pp & 1)), hh = lds_tr(vb + off_v128(row + 8, ch) + 8 * (pp & 1));
                        const bf16x8 vf = (bf16x8){lo[0], lo[1], lo[2], lo[3], hh[0], hh[1], hh[2], hh[3]};
                        O[dt] = MFMA32(vf, pf[s4], O[dt]);
                    }
            }
        }
        jA = jB; jB = jC; jC = jD; ++it;
    };
    while (jA < 128) {
        step(k0, v0); if (jA >= 128) break;
        step(k1, v1); if (jA >= 128) break;
        step(k2, v2);
    }
    __syncthreads();
}

__device__ __forceinline__ void nsa_unit(const Params& P, LAS unsigned char* lds, int u) {
    const int tid = opaque_tid(), lane = tid & 63, wid = tid >> 6, hi = lane >> 5, c = lane & 31;
    const int b = u >> 8, g = (u >> 7) & 1, qb = u & 127;
    const bf16_t* qg = (const bf16_t*)(P.ws + WS_Q); const bf16_t* kv = (const bf16_t*)(P.ws + WS_KV);
    const bf16_t* kcn = (const bf16_t*)(P.ws + WS_KC) + (size_t)(b * 2 + g) * 512 * 64; const bf16_t* vcc = (const bf16_t*)(P.ws + WS_VC) + (size_t)(b * 2 + g) * 512 * 64;
    const float* gates = (const float*)(P.ws + WS_GATES); bf16_t* mix = (bf16_t*)(P.ws + WS_MIX);
    LAS float* impw = (LAS float*)(lds + NL_IMP) + wid * 8 * NL_IMP_STRIDE;
    LAS unsigned long long* selm = (LAS unsigned long long*)(lds + NL_SELM);
    NsaLane L; L.qi = c >> 2; const int hh = c & 3, head = g * 4 + hh;
    L.t = qb * 64 + wid * 8 + L.qi; L.sl2 = exp2f(-(float)(head + 1)) * LOG2E; L.mlo = 0; L.mhi = 0;
    const size_t tok = (size_t)b * SEQ + L.t;
    bf16x8 qf[4];
#pragma unroll
    for (int ks = 0; ks < 4; ++ks) qf[ks] = *(const bf16x8*)(qg + tok * 512 + head * 64 + 16 * ks + 8 * hi);
    for (int i = lane; i < 8 * NL_IMP_STRIDE; i += 64) impw[i] = 0.f;
    const int ncmp = qb * 4 + 3 < 511 ? qb * 4 + 3 : 511;
    const int nblk = (ncmp + 63) >> 6;
    const unsigned long long cm = nblk >= 64 ? ~0ull : ((1ull << nblk) - 1ull);
    f32x16 O[2], Ot[2]; float lsum = 0.f;
    O[0] = f32x16{}; O[1] = f32x16{};
    nsa_pass<0>(lds, kcn, vcc, 64, cm, 0ull, qf, L, 1.f, lsum, O, impw);
    lsum += __shfl_xor(lsum, 32);
    const float invc = 1.0f / fmaxf(lsum, 1e-30f);
    float dummy = 0.f;
    nsa_pass<1>(lds, kcn, vcc, 64, cm, 0ull, qf, L, invc, dummy, O, impw);
    const float* gt = gates + tok * 24 + g * 12 + hh * 3;
    const float g0 = gt[0], g1 = gt[1], g2 = gt[2];
#pragma unroll
    for (int dt = 0; dt < 2; ++dt) Ot[dt] = O[dt] * g0;
    {
        const int ncausal = qb + 1;
        for (int qi = 0; qi < 8; ++qi) {
            unsigned long long lo, hi64;
            if (ncausal <= 16) { lo = (1ull << ncausal) - 1ull; hi64 = 0ull; }
            else {
                const int j0 = lane, j1 = lane + 64;
                const bool f0 = (j0 == 0) || (j0 == qb) || (j0 == qb - 1), f1 = (j1 == qb) || (j1 == qb - 1);
                const unsigned k0 = (j0 <= qb && !f0) ? (0x80000000u | (__float_as_uint(impw[qi * NL_IMP_STRIDE + j0]) & 0x7fffff80u) | (unsigned)j0) : 0u;
                const unsigned k1 = (j1 <= qb && !f1) ? (0x80000000u | (__float_as_uint(impw[qi * NL_IMP_STRIDE + j1]) & 0x7fffff80u) | (unsigned)j1) : 0u;
                const int needn = 13;
                unsigned th = 0u;
                for (int bit = 31; bit >= 0; --bit) { const unsigned cand = th | (1u << bit);
                    const int cnt = __popcll(__ballot(k0 >= cand)) + __popcll(__ballot(k1 >= cand));
                    if (cnt >= needn) th = cand; }
                lo = __ballot(f0 || (k0 >= th && k0 != 0u)); hi64 = __ballot(f1 || (k1 >= th && k1 != 0u));
            }
            if (lane == 0) { selm[(wid * 8 + qi) * 2] = lo; selm[(wid * 8 + qi) * 2 + 1] = hi64; }
        }
    }
    __syncthreads();
    unsigned long long ulo = selm[lane * 2], uhi = selm[lane * 2 + 1];
#pragma unroll
    for (int o = 1; o < 64; o <<= 1) { ulo |= __shfl_xor(ulo, o); uhi |= __shfl_xor(uhi, o); }
    L.mlo = selm[(wid * 8 + L.qi) * 2]; L.mhi = selm[(wid * 8 + L.qi) * 2 + 1];
    const bf16_t* kvb = kv + (size_t)b * SEQ * 768 + g * 64;
    O[0] = f32x16{}; O[1] = f32x16{}; lsum = 0.f;
    nsa_pass<2>(lds, kvb + 256, kvb + 384, 768, ulo, uhi, qf, L, 1.f, lsum, O, impw);
    lsum += __shfl_xor(lsum, 32);
    { const float sc = g1 / fmaxf(lsum, 1e-30f);
#pragma unroll
      for (int dt = 0; dt < 2; ++dt) Ot[dt] += O[dt] * sc; }
    {
        const int jlo = qb >= 8 ? qb - 8 : 0;
        unsigned long long wlo = 0ull, whi = 0ull;
        for (int jj = jlo; jj <= qb; ++jj) { if (jj < 64) wlo |= 1ull << jj; else whi |= 1ull << (jj - 64); }
        O[0] = f32x16{}; O[1] = f32x16{}; lsum = 0.f;
        nsa_pass<3>(lds, kvb + 512, kvb + 640, 768, wlo, whi, qf, L, 1.f, lsum, O, impw);
        lsum += __shfl_xor(lsum, 32);
        const float sc = g2 / fmaxf(lsum, 1e-30f);
#pragma unroll
        for (int dt = 0; dt < 2; ++dt) Ot[dt] += O[dt] * sc;
    }
    float ss = 0.f;
#pragma unroll
    for (int dt = 0; dt < 2; ++dt)
#pragma unroll
        for (int r = 0; r < 16; ++r) ss += Ot[dt][r] * Ot[dt][r];
    ss += __shfl_xor(ss, 32);
    const float rstd = rsqrtf(ss * (1.f / 64.f) + RMS_EPS);
#pragma unroll
    for (int dt = 0; dt < 2; ++dt)
#pragma unroll
        for (int r4 = 0; r4 < 4; ++r4) { const int d = 32 * dt + 8 * r4 + 4 * hi; const f32x4 w = *(const f32x4*)(P.attn_out_norm_w + head * 64 + d);
            u32x2 pk; pk.x = cvtpk(Ot[dt][4 * r4] * rstd * w.x, Ot[dt][4 * r4 + 1] * rstd * w.y); pk.y = cvtpk(Ot[dt][4 * r4 + 2] * rstd * w.z, Ot[dt][4 * r4 + 3] * rstd * w.w);
            *(u32x2*)(mix + tok * 1024 + head * 64 + d) = pk; }
    __syncthreads();
}


__device__ __forceinline__ int gu_hcol(int m0) { const int ni = (m0 >> 4) & 7; return 64 * (m0 >> 7) + 32 * (ni >> 2) + 8 * ((m0 & 15) >> 2) + 4 * ((ni >> 1) & 1); }
__device__ __forceinline__ int p2_col(int m0) { const int ni = (m0 >> 4) & 7; return 128 * (m0 >> 7) + 32 * (ni >> 1) + 8 * ((m0 & 15) >> 2) + 4 * (ni & 1); }
__device__ __forceinline__ void phase_cvt_small(const Params& P) {
    const int tid = threadIdx.x;
    {
        const int gt = blockIdx.x * NTHREADS + tid, NG = gridDim.x * NTHREADS;
        bf16_t* wo = (bf16_t*)(P.ws + WS_WOUT); bf16_t* wrs = (bf16_t*)(P.ws + WS_WRS); bf16_t* wsd = (bf16_t*)(P.ws + WS_WSD);
        for (int i = gt; i < 1024 * 128; i += NG) { const f32x4 a = *(const f32x4*)(P.w_out + (size_t)i * 8), b2 = *(const f32x4*)(P.w_out + (size_t)i * 8 + 4);
            *(u32x4*)(wo + (size_t)i * 8) = (u32x4){cvtpk(a.x, a.y), cvtpk(a.z, a.w), cvtpk(b2.x, b2.y), cvtpk(b2.z, b2.w)}; }
        for (int i = gt; i < 256 * 128; i += NG) { const int k = i >> 7, m0 = (i & 127) * 8; const float* s = P.sh_wd + (size_t)k * 1024 + (m0 & ~255) + p2_col(m0 & 255);
            const f32x4 a = *(const f32x4*)s, b2 = *(const f32x4*)(s + 8);
            *(u32x4*)(wsd + (size_t)i * 8) = (u32x4){cvtpk(a.x, a.y), cvtpk(a.z, a.w), cvtpk(b2.x, b2.y), cvtpk(b2.z, b2.w)}; }
        for (int i = gt; i < 1024 * 96; i += NG) { const int k = i / 96, c8 = (i % 96) * 8;
            const float* s; int d2 = 4;
            if (c8 < 256) s = P.router_w + (size_t)k * 256 + c8;
            else { const int cc = c8 - 256, t = cc >> 8; s = ((cc & 16) ? P.sh_wu : P.sh_wg) + (size_t)k * 256 + t * 128 + gu_hcol(cc & 255); d2 = 8; }
            const f32x4 a = *(const f32x4*)s, b2 = *(const f32x4*)(s + d2);
            *(u32x4*)(wrs + (size_t)k * 768 + c8) = (u32x4){cvtpk(a.x, a.y), cvtpk(a.z, a.w), cvtpk(b2.x, b2.y), cvtpk(b2.z, b2.w)}; }
    }
}

__device__ __forceinline__ void route_token(const Params& P, int t, int lane) {
    const float* scores = (const float*)(P.ws + WS_SCORES) + (size_t)t * 256;
    const f32x4 s4 = *(const f32x4*)(scores + 4 * lane); const f32x4 b4 = *(const f32x4*)(P.router_bias + 4 * lane);
    float sc[4] = {s4.x, s4.y, s4.z, s4.w};
    float bs[4] = {s4.x + b4.x, s4.y + b4.y, s4.z + b4.z, s4.w + b4.w};
    float m1 = fmaxf(bs[0], bs[1]), m2 = fminf(bs[0], bs[1]);
    { const float v = bs[2]; const float n1 = fmaxf(m1, v); m2 = fmaxf(fminf(m1, v), m2); m1 = n1; }
    { const float v = bs[3]; const float n1 = fmaxf(m1, v); m2 = fmaxf(fminf(m1, v), m2); m1 = n1; }
#pragma unroll
    for (int o = 1; o < 8; o <<= 1) { const float o1 = __shfl_xor(m1, o), o2 = __shfl_xor(m2, o); const float n1 = fmaxf(m1, o1); m2 = fmaxf(fminf(m1, o1), fmaxf(m2, o2)); m1 = n1; }
    const float gs = m1 + m2;
    const int grp = lane >> 3;
    int rank = 0;
#pragma unroll
    for (int g2 = 0; g2 < 8; ++g2) { const float og = __shfl(gs, g2 * 8); rank += (og > gs || (og == gs && g2 < grp)) ? 1 : 0; }
    const bool gsel = rank < 4;
    float mv[4];
#pragma unroll
    for (int i = 0; i < 4; ++i) mv[i] = gsel ? bs[i] : -INFINITY;
    int myidx = -1; float myw = 0.f; float wsum = 0.f;
#pragma unroll 1
    for (int k = 0; k < 8; ++k) {
        float bv = mv[0]; int bi = 4 * lane;
#pragma unroll
        for (int i = 1; i < 4; ++i) if (mv[i] > bv) { bv = mv[i]; bi = 4 * lane + i; }
#pragma unroll
        for (int o = 1; o < 64; o <<= 1) { const float ov = __shfl_xor(bv, o); const int oi = __shfl_xor(bi, o); if (ov > bv || (ov == bv && oi < bi)) { bv = ov; bi = oi; } }
        const int wl = bi >> 2, wc = bi & 3;
        const float mine = wc == 0 ? sc[0] : (wc == 1 ? sc[1] : (wc == 2 ? sc[2] : sc[3]));
        const float wv = __shfl(mine, wl);
        wsum += wv;
        if (lane == k) { myidx = bi; myw = wv; }
        if (lane == wl) {
#pragma unroll
            for (int i = 0; i < 4; ++i) if (i == wc) mv[i] = -INFINITY; }
    }
    if (lane < 8) {
        int* cnt = (int*)(P.ws + WS_CTL + CTL_CNT);
        const int pos = atomicAdd(cnt + myidx, 1);
        if (pos < BCAP) ((int*)(P.ws + WS_BUCKET))[(size_t)myidx * BCAP + pos] = t * 8 + lane;
        ((float*)(P.ws + WS_RW))[(size_t)t * 8 + lane] = myw / wsum * 2.5f;
    }
}


__device__ __forceinline__ void phase_p4a(const Params& P, LAS unsigned char* lds) {
    typedef Gemm3 G;
    const int tid = opaque_tid(), lane = tid & 63, wid = tid >> 6, wm = wid >> 1, wn = wid & 1, fr = lane & 15, fq = lane >> 4;
    struct F { const Params& P;
        __device__ __forceinline__ void ptrs(int seg, const bf16_t* (&aptr)[2], const bf16_t* (&bptr)[2]) const {
            const int tid = opaque_tid(), lane = tid & 63, wid = tid >> 6, wm = wid >> 1, wn = wid & 1, fr = lane & 15, fq = lane >> 4, c8 = 8 * (tid & 31); (void)wm; (void)wn; (void)fr; (void)fq; (void)c8;
            const int u = blockIdx.x + seg * gridDim.x, rt = u >> 2, ct = u & 3;
            const bf16_t* mix = (const bf16_t*)(P.ws + WS_MIX); const bf16_t* wo = (const bf16_t*)(P.ws + WS_WOUT);
#pragma unroll
            for (int i = 0; i < 2; ++i) { const int row = G::a_row(i, wid, lane); aptr[i] = mix + (size_t)(rt * 256 + row) * 1024 + G::a_chunk(row, lane) * 8;
                const int k = G::b_k(i, wid, lane); bptr[i] = wo + (size_t)k * 1024 + ct * 256 + G::b_n(k, lane); } }
        __device__ __forceinline__ void epi(int seg, f32x4 (&acc)[4][8]) const {
            const int tid = opaque_tid(), lane = tid & 63, wid = tid >> 6, wm = wid >> 1, wn = wid & 1, fr = lane & 15, fq = lane >> 4, c8 = 8 * (tid & 31); (void)wm; (void)wn; (void)fr; (void)fq; (void)c8;
            const int u = blockIdx.x + seg * gridDim.x, rt = u >> 2, ct = u & 3, b = (rt * 256) / SEQ;
            const float* mod = (const float*)(P.ws + WS_MOD) + b * 6144; float* ssp = (float*)(P.ws + WS_SS);
#pragma unroll
            for (int mi = 0; mi < 4; ++mi) { const size_t m = (size_t)(rt * 256 + wm * 64 + mi * 16 + fr); float ss = 0.f;
#pragma unroll
                for (int ni = 0; ni < 8; ++ni) { const int col = ct * 256 + wn * 128 + ni * 16 + 4 * fq;
                    const f32x4 xv = *(const f32x4*)(P.x + m * 1024 + col), gv = *(const f32x4*)(mod + 2048 + col); const f32x4 a = acc[mi][ni];
                    f32x4 o; o.x = xv.x + gv.x * a.x; o.y = xv.y + gv.y * a.y; o.z = xv.z + gv.z * a.z; o.w = xv.w + gv.w * a.w;
                    *(f32x4*)(P.out + m * 1024 + col) = o; ss += (o.x * o.x + o.y * o.y) + (o.z * o.z + o.w * o.w); if (ni & 1) asm volatile("" ::: "memory"); }
                ss += __shfl_xor(ss, 16); ss += __shfl_xor(ss, 32);
                if (fq == 0) ssp[m * 8 + ct * 2 + wn] = ss; } }
    } f{P};
    const int nu = (128 * 4 - (int)blockIdx.x + (int)gridDim.x - 1) / (int)gridDim.x;
    if (nu > 0) G::run_stream(f, nu, 32, 32, (size_t)32 * 1024, lds);
}
__device__ __forceinline__ void phase_p4b(const Params& P) {
    const int lane = threadIdx.x & 63, gw = blockIdx.x * (NTHREADS / 64) + (threadIdx.x >> 6), NGW = gridDim.x * (NTHREADS / 64);
    const float* ssp = (const float*)(P.ws + WS_SS); bf16_t* h2 = (bf16_t*)(P.ws + WS_H);
    for (int m = gw; m < T; m += NGW) {
        const float* mod = (const float*)(P.ws + WS_MOD) + (m / SEQ) * 6144;
        const f32x4 s0 = *(const f32x4*)(ssp + (size_t)m * 8), s1 = *(const f32x4*)(ssp + (size_t)m * 8 + 4);
        const float rstd = rsqrtf(((s0.x + s0.y) + (s0.z + s0.w) + (s1.x + s1.y) + (s1.z + s1.w)) * (1.f / 1024.f) + RMS_EPS);
#pragma unroll
        for (int j = 0; j < 4; ++j) { const int col = (lane + 64 * j) * 4;
            const f32x4 v = *(const f32x4*)(P.out + (size_t)m * 1024 + col), wv = *(const f32x4*)(P.norm2_w + col), scv = *(const f32x4*)(mod + 4096 + col), shv = *(const f32x4*)(mod + 3072 + col);
            const float r0 = v.x * rstd * wv.x * (1.f + scv.x) + shv.x, r1 = v.y * rstd * wv.y * (1.f + scv.y) + shv.y, r2 = v.z * rstd * wv.z * (1.f + scv.z) + shv.z, r3 = v.w * rstd * wv.w * (1.f + scv.w) + shv.w;
            u32x2 pk; pk.x = cvtpk(r0, r1); pk.y = cvtpk(r2, r3);
            *(u32x2*)(h2 + (size_t)m * 1024 + col) = pk;
            int q8 = __builtin_amdgcn_cvt_pk_fp8_f32(r0, r1, 0, false); q8 = __builtin_amdgcn_cvt_pk_fp8_f32(r2, r3, q8, true);
            *(int*)((unsigned char*)(P.ws + WS_H2Q) + (size_t)m * 1024 + col) = q8; }
    }
}
__device__ __forceinline__ void phase_p4c(const Params& P, LAS unsigned char* lds) {
    typedef Gemm3 G;
    const int tid = opaque_tid(), lane = tid & 63, wid = tid >> 6, wm = wid >> 1, wn = wid & 1, fr = lane & 15, fq = lane >> 4;
    struct F { const Params& P;
        __device__ __forceinline__ void ptrs(int seg, const bf16_t* (&aptr)[2], const bf16_t* (&bptr)[2]) const {
            const int tid = opaque_tid(), lane = tid & 63, wid = tid >> 6, wm = wid >> 1, wn = wid & 1, fr = lane & 15, fq = lane >> 4, c8 = 8 * (tid & 31); (void)wm; (void)wn; (void)fr; (void)fq; (void)c8;
            const int u = blockIdx.x + seg * gridDim.x, rt = u / 3, ct = u % 3;
            const bf16_t* h2 = (const bf16_t*)(P.ws + WS_H); const bf16_t* wrs = (const bf16_t*)(P.ws + WS_WRS);
#pragma unroll
            for (int i = 0; i < 2; ++i) { const int row = G::a_row(i, wid, lane); aptr[i] = h2 + (size_t)(rt * 256 + row) * 1024 + G::a_chunk(row, lane) * 8;
                const int k = G::b_k(i, wid, lane); bptr[i] = wrs + (size_t)k * 768 + ct * 256 + G::b_n(k, lane); } }
        __device__ __forceinline__ void epi(int seg, f32x4 (&acc)[4][8]) const {
            const int tid = opaque_tid(), lane = tid & 63, wid = tid >> 6, wm = wid >> 1, wn = wid & 1, fr = lane & 15, fq = lane >> 4, c8 = 8 * (tid & 31); (void)wm; (void)wn; (void)fr; (void)fq; (void)c8;
            const int u = blockIdx.x + seg * gridDim.x, rt = u / 3, ct = u % 3;
            float* scores = (float*)(P.ws + WS_SCORES); bf16_t* hidS = (bf16_t*)(P.ws + WS_HIDS);
#pragma unroll
            for (int mi = 0; mi < 4; ++mi) { const size_t m = (size_t)(rt * 256 + wm * 64 + mi * 16 + fr);
                if (ct == 0) {
#pragma unroll
                    for (int ni = 0; ni < 8; ++ni) { const f32x4 a = acc[mi][ni];
                        *(f32x4*)(scores + m * 256 + wn * 128 + ni * 16 + 4 * fq) = (f32x4){sigmoidf_(a.x), sigmoidf_(a.y), sigmoidf_(a.z), sigmoidf_(a.w)}; }
                } else {
#pragma unroll
                    for (int j2 = 0; j2 < 2; ++j2) { const f32x4 g = acc[mi][4 * j2], uu = acc[mi][4 * j2 + 1], g2 = acc[mi][4 * j2 + 2], u2 = acc[mi][4 * j2 + 3];
                        u32x4 pk; pk.x = cvtpk(siluf_(g.x) * uu.x, siluf_(g.y) * uu.y); pk.y = cvtpk(siluf_(g.z) * uu.z, siluf_(g.w) * uu.w);
                        pk.z = cvtpk(siluf_(g2.x) * u2.x, siluf_(g2.y) * u2.y); pk.w = cvtpk(siluf_(g2.z) * u2.z, siluf_(g2.w) * u2.w);
                        *(u32x4*)(hidS + m * 256 + (ct - 1) * 128 + wn * 64 + j2 * 32 + 8 * fq) = pk; }
                } } }
    } f{P};
    const int nu = (128 * 3 - (int)blockIdx.x + (int)gridDim.x - 1) / (int)gridDim.x;
    if (nu > 0) G::run_stream(f, nu, 32, 32, (size_t)32 * 768, lds);
}
__device__ __forceinline__ void phase_route(const Params& P) {
    const int tid = opaque_tid(), lane = tid & 63, gw = blockIdx.x * (NTHREADS / 64) + (tid >> 6), NGW = gridDim.x * (NTHREADS / 64);
    for (int t = gw; t < T; t += NGW) route_token(P, t, lane);
}
__device__ __forceinline__ void phase_p4d(const Params& P, LAS unsigned char* lds) {
    typedef Gemm3 G;
    const int tid = opaque_tid(), lane = tid & 63, wid = tid >> 6, wm = wid >> 1, wn = wid & 1, fr = lane & 15, fq = lane >> 4;
    struct F { const Params& P;
        __device__ __forceinline__ void ptrs(int seg, const bf16_t* (&aptr)[2], const bf16_t* (&bptr)[2]) const {
            const int tid = opaque_tid(), lane = tid & 63, wid = tid >> 6, wm = wid >> 1, wn = wid & 1, fr = lane & 15, fq = lane >> 4, c8 = 8 * (tid & 31); (void)wm; (void)wn; (void)fr; (void)fq; (void)c8;
            const int u = blockIdx.x + seg * gridDim.x, rt = u >> 2, ct = u & 3;
            const bf16_t* hidS = (const bf16_t*)(P.ws + WS_HIDS); const bf16_t* wsd = (const bf16_t*)(P.ws + WS_WSD);
#pragma unroll
            for (int i = 0; i < 2; ++i) { const int row = G::a_row(i, wid, lane); aptr[i] = hidS + (size_t)(rt * 256 + row) * 256 + G::a_chunk(row, lane) * 8;
                const int k = G::b_k(i, wid, lane); bptr[i] = wsd + (size_t)k * 1024 + ct * 256 + G::b_n(k, lane); } }
        __device__ __forceinline__ void epi(int seg, f32x4 (&acc)[4][8]) const {
            const int tid = opaque_tid(), lane = tid & 63, wid = tid >> 6, wm = wid >> 1, wn = wid & 1, fr = lane & 15, fq = lane >> 4, c8 = 8 * (tid & 31); (void)wm; (void)wn; (void)fr; (void)fq; (void)c8;
            const int u = blockIdx.x + seg * gridDim.x, rt = u >> 2, ct = u & 3;
            bf16_t* ysh = (bf16_t*)(P.ws + WS_YSH);
#pragma unroll
            for (int mi = 0; mi < 4; ++mi) { const size_t m = (size_t)(rt * 256 + wm * 64 + mi * 16 + fr);
#pragma unroll
                for (int j = 0; j < 4; ++j) { const int col = ct * 256 + wn * 128 + j * 32 + 8 * fq; const f32x4 a = acc[mi][2 * j], c = acc[mi][2 * j + 1];
                    *(u32x4*)(ysh + m * 1024 + col) = (u32x4){cvtpk(a.x, a.y), cvtpk(a.z, a.w), cvtpk(c.x, c.y), cvtpk(c.z, c.w)}; } } }
    } f{P};
    const int nu = (128 * 4 - (int)blockIdx.x + (int)gridDim.x - 1) / (int)gridDim.x;
    if (nu > 0) G::run_stream(f, nu, 8, 32, (size_t)32 * 1024, lds);
}

__device__ __forceinline__ void phase_expert_cvt(const Params& P) {
    const size_t gt = (size_t)blockIdx.x * NTHREADS + threadIdx.x, NG = (size_t)gridDim.x * NTHREADS;
    bf16_t* wgu = (bf16_t*)(P.ws + WS_WBGU); bf16_t* wd = (bf16_t*)(P.ws + WS_WBD);
    for (size_t i = gt; i < (size_t)256 * 1024 * 64; i += NG) {
        const size_t ek = i >> 6; const int c8 = (int)(i & 63) * 8, t = c8 >> 8;
        const float* s = ((c8 & 16) ? P.exp_wu : P.exp_wg) + ek * 256 + t * 128 + gu_hcol(c8 & 255);
        const f32x4 a = __builtin_nontemporal_load((const f32x4*)s), b2 = __builtin_nontemporal_load((const f32x4*)(s + 8));
        *(u32x4*)(wgu + ek * 512 + c8) = (u32x4){cvtpk(a.x, a.y), cvtpk(a.z, a.w), cvtpk(b2.x, b2.y), cvtpk(b2.z, b2.w)}; }
    for (size_t i = gt; i < (size_t)256 * 256 * 128; i += NG) {
        const size_t ek = i >> 7; const int m0 = (int)(i & 127) * 8, tl = m0 & 255, tile = m0 >> 8;
        const int wnn = tl >> 7, nii = (tl >> 4) & 7, n0 = tl & 15;
        const int ca = tile * 256 + wnn * 128 + 64 * (nii >> 2) + 16 * (n0 >> 2) + 4 * (nii & 3);
        const f32x4 a = __builtin_nontemporal_load((const f32x4*)(P.exp_wd + ek * 1024 + ca)), b2 = __builtin_nontemporal_load((const f32x4*)(P.exp_wd + ek * 1024 + ca + 16));
        *(u32x4*)(wd + ek * 1024 + m0) = (u32x4){cvtpk(a.x, a.y), cvtpk(a.z, a.w), cvtpk(b2.x, b2.y), cvtpk(b2.z, b2.w)}; }
}

constexpr int P6_TILES = 128 * 1024, P6_PRE = P6_TILES + 1024, P6_PAIR = P6_PRE + 1040, P6_W = P6_PAIR + 1024;
__device__ __forceinline__ void phase_experts(const Params& P, LAS unsigned char* lds) {
    typedef Gemm3 G;
    const int tid = opaque_tid(), lane = tid & 63, wid = tid >> 6, wm = wid >> 1, wn = wid & 1, fr = lane & 15, fq = lane >> 4;
    const int* cnt = (const int*)(P.ws + WS_CTL + CTL_CNT); const int* bucket = (const int*)(P.ws + WS_BUCKET); const float* rw = (const float*)(P.ws + WS_RW);
    const bf16_t* h2 = (const bf16_t*)(P.ws + WS_H); bf16_t* hidR = (bf16_t*)(P.ws + WS_HIDR) + (size_t)blockIdx.x * 256 * 256; unsigned char* y = (unsigned char*)(P.ws + WS_Y);
    LAS int* tiles = (LAS int*)(lds + P6_TILES); LAS int* pre = (LAS int*)(lds + P6_PRE); LAS int* pairs = (LAS int*)(lds + P6_PAIR); LAS float* wts = (LAS float*)(lds + P6_W);
    const int nx = (gridDim.x % 8 == 0) ? 8 : 1, xl = blockIdx.x % nx, li = blockIdx.x / nx, nloc = gridDim.x / nx, nek = 256 / nx;
    if (tid < nek) { const int c_ = cnt[xl + nx * tid]; tiles[tid] = ((c_ < BCAP ? c_ : BCAP) + 255) >> 8; }
    __syncthreads();
    if (tid < nek) { int s = 0; for (int i = 0; i < tid; ++i) s += tiles[i]; pre[tid] = s; if (tid == nek - 1) pre[nek] = s + tiles[nek - 1]; }
    __syncthreads();
    const int total = pre[nek];
    const int c8 = 8 * (tid & 31), u16 = c8 >> 4;
    for (int u = li; u < total; u += nloc) {
        int lo = 0, hi = nek - 1;
        while (lo < hi) { const int mid = (lo + hi + 1) >> 1; if (pre[mid] <= u) lo = mid; else hi = mid - 1; }
        const int e = xl + nx * lo, tile = u - pre[lo], n = cnt[e] < BCAP ? cnt[e] : BCAP, rows = (n - tile * 256) < 256 ? (n - tile * 256) : 256;
        if (tid < 256) { const int r = tid < rows ? tid : 0; const int pr = bucket[(size_t)e * BCAP + tile * 256 + r]; pairs[tid] = pr; wts[tid] = tid < rows ? rw[pr] : 0.f; }
        __syncthreads();
        {
            struct GU { const bf16_t* h2; LAS int* pairs; const bf16_t* wgu; bf16_t* hidR;
                __device__ __forceinline__ void ptrs(int t, const bf16_t* (&aptr)[2], const bf16_t* (&bptr)[2]) const {
                    const int tid = opaque_tid(), lane = tid & 63, wid = tid >> 6, wm = wid >> 1, wn = wid & 1, fr = lane & 15, fq = lane >> 4, c8 = 8 * (tid & 31); (void)wm; (void)wn; (void)fr; (void)fq; (void)c8;
#pragma unroll
                    for (int i = 0; i < 2; ++i) { const int row = G::a_row(i, wid, lane); aptr[i] = h2 + (size_t)(pairs[row] >> 3) * 1024 + G::a_chunk(row, lane) * 8;
                        const int k = G::b_k(i, wid, lane); bptr[i] = wgu + (size_t)k * 512 + t * 256 + G::b_n(k, lane); } }
                __device__ __forceinline__ void epi(int t, f32x4 (&acc)[4][8]) const {
                    const int tid = opaque_tid(), lane = tid & 63, wid = tid >> 6, wm = wid >> 1, wn = wid & 1, fr = lane & 15, fq = lane >> 4, c8 = 8 * (tid & 31); (void)wm; (void)wn; (void)fr; (void)fq; (void)c8;
#pragma unroll
                    for (int mi = 0; mi < 4; ++mi) { const int rl = wm * 64 + mi * 16 + fr;
#pragma unroll
                        for (int j2 = 0; j2 < 2; ++j2) { const f32x4 g = acc[mi][4 * j2], uu = acc[mi][4 * j2 + 1], g2 = acc[mi][4 * j2 + 2], u2 = acc[mi][4 * j2 + 3];
                            u32x4 pk; pk.x = cvtpk(siluf_(g.x) * uu.x, siluf_(g.y) * uu.y); pk.y = cvtpk(siluf_(g.z) * uu.z, siluf_(g.w) * uu.w);
                            pk.z = cvtpk(siluf_(g2.x) * u2.x, siluf_(g2.y) * u2.y); pk.w = cvtpk(siluf_(g2.z) * u2.z, siluf_(g2.w) * u2.w);
                            *(u32x4*)(hidR + rl * 256 + t * 128 + wn * 64 + j2 * 32 + 8 * fq) = pk; } } }
            } f{h2, pairs, (const bf16_t*)(P.ws + WS_WBGU) + (size_t)e * 1024 * 512, hidR};
            G::run_stream(f, 2, 32, 32, (size_t)32 * 512, lds);
        }
        __syncthreads();
        {
            struct DN { bf16_t* hidR; const bf16_t* wd; unsigned char* y; LAS int* pairs; LAS float* wts; int rows;
                __device__ __forceinline__ void ptrs(int ct, const bf16_t* (&aptr)[2], const bf16_t* (&bptr)[2]) const {
                    const int tid = opaque_tid(), lane = tid & 63, wid = tid >> 6, wm = wid >> 1, wn = wid & 1, fr = lane & 15, fq = lane >> 4, c8 = 8 * (tid & 31); (void)wm; (void)wn; (void)fr; (void)fq; (void)c8;
#pragma unroll
                    for (int i = 0; i < 2; ++i) { const int row = G::a_row(i, wid, lane); aptr[i] = hidR + (size_t)row * 256 + G::a_chunk(row, lane) * 8;
                        const int k = G::b_k(i, wid, lane); bptr[i] = wd + (size_t)k * 1024 + ct * 256 + G::b_n(k, lane); } }
                __device__ __forceinline__ void epi(int ct, f32x4 (&acc)[4][8]) const {
                    const int tid = opaque_tid(), lane = tid & 63, wid = tid >> 6, wm = wid >> 1, wn = wid & 1, fr = lane & 15, fq = lane >> 4, c8 = 8 * (tid & 31); (void)wm; (void)wn; (void)fr; (void)fq; (void)c8;
#pragma unroll
                    for (int mi = 0; mi < 4; ++mi) { const int rl = wm * 64 + mi * 16 + fr; const float wgt = wts[rl]; const size_t pr = (size_t)pairs[rl];
                        if (rl < rows) {
#pragma unroll
                            for (int j2 = 0; j2 < 2; ++j2) { const int col = ct * 256 + wn * 128 + 64 * j2 + 16 * fq; const float sc_ = wgt * Y_SCALE; u32x4 w;
#pragma unroll
                                for (int b2 = 0; b2 < 4; ++b2) { const f32x4 a = acc[mi][4 * j2 + b2] * sc_;
                                    int pk = __builtin_amdgcn_cvt_pk_fp8_f32(a.x, a.y, 0, false); pk = __builtin_amdgcn_cvt_pk_fp8_f32(a.z, a.w, pk, true); w[b2] = (unsigned)pk; }
                                *(u32x4*)(y + pr * 1024 + col) = w; } } } }
            } f{hidR, (const bf16_t*)(P.ws + WS_WBD) + (size_t)e * 256 * 1024, y, pairs, wts, rows};
            G::run_stream(f, 4, 8, 32, (size_t)32 * 1024, lds);
        }
        __syncthreads();
    }
}


struct Gemm8 {
    static constexpr int A_BYTES = 16384, STAGE = 32768;
    static __device__ __forceinline__ int t_row(int i, int w, int lane) { return (i * 8 + w) * 16 + (lane >> 2); }
    static __device__ __forceinline__ int t_chunk(int row, int lane) { return (lane & 3) ^ ((row >> 1) & 3); }
    static __device__ __forceinline__ int w_col(int i) { return 16 * ((i >> 2) & 1) + 4 * (i >> 3) + (i & 3); }
    template <class F> static __device__ __forceinline__ void run_stream(F& f, int NSEG, int KT, LAS unsigned char* lds) {
        const int tid = opaque_tid(), lane = tid & 63, wid = tid >> 6, wm = wid >> 1, wn = wid & 1, l31 = lane & 31, hi = lane >> 5;
        const int wu = __builtin_amdgcn_readfirstlane(wid);
        f32x16 acc[2][4];
#pragma unroll
        for (int jt = 0; jt < 2; ++jt)
#pragma unroll
            for (int it = 0; it < 4; ++it)
#pragma unroll
                for (int r = 0; r < 16; ++r) acc[jt][it][r] = 0.f;
        const int sw = (l31 >> 1) & 3;
        const int t_rd0 = (wm * 64 + l31) * 64 + (((2 * hi) ^ sw) << 4), t_rd1 = (wm * 64 + l31) * 64 + (((2 * hi + 1) ^ sw) << 4);
        const int w_rd0 = A_BYTES + (wn * 128 + l31) * 64 + (((2 * hi) ^ sw) << 4), w_rd1 = A_BYTES + (wn * 128 + l31) * 64 + (((2 * hi + 1) ^ sw) << 4);
        const unsigned lds0 = (unsigned)(uintptr_t)lds + (unsigned)wu * 1024u;
        const unsigned char* aptr[2]; const unsigned char* wptr[2];
        const int total = NSEG * KT;
        int lseg = 0, lkt = 0, lg = 0;
        auto issue = [&]() {
            const unsigned base = (unsigned)__builtin_amdgcn_readfirstlane((int)(lds0 + (unsigned)(lg & 3) * STAGE));
#pragma unroll
            for (int i = 0; i < 2; ++i) glds16(aptr[i] + lkt * 64, base + i * 8192);
#pragma unroll
            for (int i = 0; i < 2; ++i) glds16(wptr[i] + lkt * 64, base + A_BYTES + i * 8192);
            ++lg; if (++lkt == KT) { lkt = 0; ++lseg; if (lseg < NSEG) f.ptrs(lseg, aptr, wptr); }
        };
        const int grp = wu >> 2;
        auto bar = [&]() { asm volatile("s_waitcnt lgkmcnt(0)" ::: "memory"); __builtin_amdgcn_s_barrier(); asm volatile("" ::: "memory"); };
        f.ptrs(0, aptr, wptr);
        asm volatile("s_waitcnt vmcnt(0)" ::: "memory");
        issue(); if (total > 1) issue(); if (total > 2) issue();
        if (total > 2) asm volatile("s_waitcnt vmcnt(8)" ::: "memory"); else if (total > 1) asm volatile("s_waitcnt vmcnt(4)" ::: "memory"); else asm volatile("s_waitcnt vmcnt(0)" ::: "memory");
        bar();
        if (grp) bar();
        int cseg = 0, ckt = 0;
#pragma unroll 1
        for (int g = 0; g < total; ++g) {
            if (lg < total) issue();
            const LAS unsigned char* base = lds + (g & 3) * STAGE;
            i32x8 tf[2], wf[4];
#pragma unroll
            for (int jt = 0; jt < 2; ++jt) { const u32x4 lo = *(const LAS u32x4*)(base + t_rd0 + jt * 2048), h4 = *(const LAS u32x4*)(base + t_rd1 + jt * 2048);
                tf[jt] = (i32x8){(int)lo.x, (int)lo.y, (int)lo.z, (int)lo.w, (int)h4.x, (int)h4.y, (int)h4.z, (int)h4.w}; }
#pragma unroll
            for (int it = 0; it < 4; ++it) { const u32x4 lo = *(const LAS u32x4*)(base + w_rd0 + it * 2048), h4 = *(const LAS u32x4*)(base + w_rd1 + it * 2048);
                wf[it] = (i32x8){(int)lo.x, (int)lo.y, (int)lo.z, (int)lo.w, (int)h4.x, (int)h4.y, (int)h4.z, (int)h4.w}; }
            { const int rem = total - 2 - g;
              if (rem >= 2) asm volatile("s_waitcnt vmcnt(8)" ::: "memory"); else if (rem == 1) asm volatile("s_waitcnt vmcnt(4)" ::: "memory"); else asm volatile("s_waitcnt vmcnt(0)" ::: "memory"); }
            bar();
            __builtin_amdgcn_sched_barrier(0);
#pragma unroll
            for (int it = 0; it < 4; ++it)
#pragma unroll
                for (int jt = 0; jt < 2; ++jt) acc[jt][it] = __builtin_amdgcn_mfma_scale_f32_32x32x64_f8f6f4(wf[it], tf[jt], acc[jt][it], 0, 0, 0, 0, 0, 0);
            __builtin_amdgcn_sched_barrier(0);
            bar();
            if (++ckt == KT) {
                f.epi(cseg, acc);
#pragma unroll
                for (int jt = 0; jt < 2; ++jt)
#pragma unroll
                    for (int it = 0; it < 4; ++it)
#pragma unroll
                        for (int r = 0; r < 16; ++r) acc[jt][it][r] = 0.f;
                ckt = 0; ++cseg;
            }
        }
        if (!grp) bar();
    }
};
__device__ __forceinline__ unsigned pk4_fp8(float a, float b, float c, float d) { int pk = __builtin_amdgcn_cvt_pk_fp8_f32(a, b, 0, false); pk = __builtin_amdgcn_cvt_pk_fp8_f32(c, d, pk, true); return (unsigned)pk; }

__device__ __forceinline__ void phase_expert_cvt8(const Params& P) {
    const int tid = opaque_tid(), lane = tid & 63, gw = blockIdx.x * (NTHREADS / 64) + (tid >> 6), NGW = gridDim.x * (NTHREADS / 64);
    unsigned char* wgu = (unsigned char*)(P.ws + WS_W8GU); unsigned char* wd = (unsigned char*)(P.ws + WS_W8D);
    for (int u = gw; u < 256 * 8 * 8; u += NGW) {
        const int rg = u & 7, kb = (u >> 3) & 7, e = u >> 6;
        const int q = rg * 64 + lane, t = q >> 8, ql = q & 255, wnn = ql >> 7, it = (ql >> 5) & 3, i = ql & 31;
        const int h = t * 128 + wnn * 64 + (it >> 1) * 32 + Gemm8::w_col(i);
        const float* s = ((it & 1) ? P.exp_wu : P.exp_wg) + (size_t)e * 1024 * 256 + (size_t)(kb * 128) * 256 + h;
        unsigned char* o = wgu + ((size_t)e * 512 + q) * 1024 + kb * 128;
#pragma unroll
        for (int hf = 0; hf < 2; ++hf) { float v[64];
#pragma unroll
            for (int j = 0; j < 64; ++j) v[j] = __builtin_nontemporal_load(s + (size_t)(hf * 64 + j) * 256);
#pragma unroll
            for (int j = 0; j < 4; ++j) { const float c_ = W8_GU_SCALE; u32x4 w;
                w.x = pk4_fp8(v[16 * j] * c_, v[16 * j + 1] * c_, v[16 * j + 2] * c_, v[16 * j + 3] * c_); w.y = pk4_fp8(v[16 * j + 4] * c_, v[16 * j + 5] * c_, v[16 * j + 6] * c_, v[16 * j + 7] * c_);
                w.z = pk4_fp8(v[16 * j + 8] * c_, v[16 * j + 9] * c_, v[16 * j + 10] * c_, v[16 * j + 11] * c_); w.w = pk4_fp8(v[16 * j + 12] * c_, v[16 * j + 13] * c_, v[16 * j + 14] * c_, v[16 * j + 15] * c_);
                *(u32x4*)(o + hf * 64 + j * 16) = w; } }
    }
    for (int u = gw; u < 256 * 2 * 16; u += NGW) {
        const int rg = u & 15, kb = (u >> 4) & 1, e = u >> 5;
        const int q = rg * 64 + lane, i = q & 31;
        const int col = (q & ~31) + Gemm8::w_col(i);
        const float* s = P.exp_wd + (size_t)e * 256 * 1024 + (size_t)(kb * 128) * 1024 + col;
        unsigned char* o = wd + ((size_t)e * 1024 + q) * 256 + kb * 128;
#pragma unroll
        for (int hf = 0; hf < 2; ++hf) { float v[64];
#pragma unroll
            for (int j = 0; j < 64; ++j) v[j] = __builtin_nontemporal_load(s + (size_t)(hf * 64 + j) * 1024);
#pragma unroll
            for (int j = 0; j < 4; ++j) { const float c_ = W8_D_SCALE; u32x4 w;
                w.x = pk4_fp8(v[16 * j] * c_, v[16 * j + 1] * c_, v[16 * j + 2] * c_, v[16 * j + 3] * c_); w.y = pk4_fp8(v[16 * j + 4] * c_, v[16 * j + 5] * c_, v[16 * j + 6] * c_, v[16 * j + 7] * c_);
                w.z = pk4_fp8(v[16 * j + 8] * c_, v[16 * j + 9] * c_, v[16 * j + 10] * c_, v[16 * j + 11] * c_); w.w = pk4_fp8(v[16 * j + 12] * c_, v[16 * j + 13] * c_, v[16 * j + 14] * c_, v[16 * j + 15] * c_);
                *(u32x4*)(o + hf * 64 + j * 16) = w; } }
    }
}

__device__ __forceinline__ void phase_experts8(const Params& P, LAS unsigned char* lds) {
    typedef Gemm8 G;
    const int tid = opaque_tid();
    const int* cnt = (const int*)(P.ws + WS_CTL + CTL_CNT); const int* bucket = (const int*)(P.ws + WS_BUCKET); const float* rw = (const float*)(P.ws + WS_RW);
    const unsigned char* h2q = (const unsigned char*)(P.ws + WS_H2Q); unsigned char* hidR = (unsigned char*)(P.ws + WS_HIDR) + (size_t)blockIdx.x * 256 * 256; unsigned char* y = (unsigned char*)(P.ws + WS_Y);
    LAS int* tiles = (LAS int*)(lds + P6_TILES); LAS int* pre = (LAS int*)(lds + P6_PRE); LAS int* pairs = (LAS int*)(lds + P6_PAIR); LAS float* wts = (LAS float*)(lds + P6_W);
    const int nx = (gridDim.x % 8 == 0) ? 8 : 1, xl = blockIdx.x % nx, li = blockIdx.x / nx, nloc = gridDim.x / nx, nek = 256 / nx;
    if (tid < nek) { const int c_ = cnt[xl + nx * tid]; tiles[tid] = ((c_ < BCAP ? c_ : BCAP) + 255) >> 8; }
    __syncthreads();
    if (tid < nek) { int s = 0; for (int i = 0; i < tid; ++i) s += tiles[i]; pre[tid] = s; if (tid == nek - 1) pre[nek] = s + tiles[nek - 1]; }
    __syncthreads();
    const int total = pre[nek];
    for (int u = li; u < total; u += nloc) {
        int lo = 0, hi_ = nek - 1;
        while (lo < hi_) { const int mid = (lo + hi_ + 1) >> 1; if (pre[mid] <= u) lo = mid; else hi_ = mid - 1; }
        const int e = xl + nx * lo, tile = u - pre[lo], n = cnt[e] < BCAP ? cnt[e] : BCAP, rows = (n - tile * 256) < 256 ? (n - tile * 256) : 256;
        if (tid < 256) { const int r = tid < rows ? tid : 0; const int pr = bucket[(size_t)e * BCAP + tile * 256 + r]; pairs[tid] = pr; wts[tid] = tid < rows ? rw[pr] : 0.f; }
        __syncthreads();
        {
            struct GU { const unsigned char* h2q; LAS int* pairs; const unsigned char* wgu; unsigned char* hidR;
                __device__ __forceinline__ void ptrs(int t, const unsigned char* (&aptr)[2], const unsigned char* (&wptr)[2]) const {
                    const int tid = opaque_tid(), lane = tid & 63, wid = tid >> 6;
#pragma unroll
                    for (int i = 0; i < 2; ++i) { const int row = G::t_row(i, wid, lane); aptr[i] = h2q + (size_t)(pairs[row] >> 3) * 1024 + G::t_chunk(row, lane) * 16;
                        wptr[i] = wgu + (size_t)(t * 256 + row) * 1024 + G::t_chunk(row, lane) * 16; } }
                __device__ __forceinline__ void epi(int t, f32x16 (&acc)[2][4]) const {
                    const int tid = opaque_tid(), lane = tid & 63, wid = tid >> 6, wm = wid >> 1, wn = wid & 1, l31 = lane & 31, hi = lane >> 5;
                    const float sg = 1.0f / W8_GU_SCALE;
#pragma unroll
                    for (int jt = 0; jt < 2; ++jt) { const int rl = wm * 64 + jt * 32 + l31;
#pragma unroll
                        for (int p = 0; p < 2; ++p) { u32x4 w;
#pragma unroll
                            for (int q4 = 0; q4 < 4; ++q4) { float hv[4];
#pragma unroll
                                for (int r = 0; r < 4; ++r) { const float g = acc[jt][2 * p][4 * q4 + r] * sg, uu = acc[jt][2 * p + 1][4 * q4 + r] * (sg * HID8_SCALE); hv[r] = siluf_(g) * uu; }
                                w[q4] = pk4_fp8(hv[0], hv[1], hv[2], hv[3]); }
                            *(u32x4*)(hidR + rl * 256 + t * 128 + wn * 64 + p * 32 + 16 * hi) = w; } } }
            } f{h2q, pairs, (const unsigned char*)(P.ws + WS_W8GU) + (size_t)e * 512 * 1024, hidR};
            G::run_stream(f, 2, 16, lds);
        }
        __syncthreads();
        {
            struct DN { const unsigned char* hidR; const unsigned char* wd; unsigned char* y; LAS int* pairs; LAS float* wts; int rows;
                __device__ __forceinline__ void ptrs(int ct, const unsigned char* (&aptr)[2], const unsigned char* (&wptr)[2]) const {
                    const int tid = opaque_tid(), lane = tid & 63, wid = tid >> 6;
#pragma unroll
                    for (int i = 0; i < 2; ++i) { const int row = G::t_row(i, wid, lane); aptr[i] = hidR + (size_t)row * 256 + G::t_chunk(row, lane) * 16;
                        wptr[i] = wd + (size_t)(ct * 256 + row) * 256 + G::t_chunk(row, lane) * 16; } }
                __device__ __forceinline__ void epi(int ct, f32x16 (&acc)[2][4]) const {
                    const int tid = opaque_tid(), lane = tid & 63, wid = tid >> 6, wm = wid >> 1, wn = wid & 1, l31 = lane & 31, hi = lane >> 5;
#pragma unroll
                    for (int jt = 0; jt < 2; ++jt) { const int rl = wm * 64 + jt * 32 + l31; const float sc_ = wts[rl] * (Y_SCALE / (W8_D_SCALE * HID8_SCALE)); const size_t pr = (size_t)pairs[rl];
                        if (rl < rows) {
#pragma unroll
                            for (int it = 0; it < 4; ++it) { u32x4 w;
#pragma unroll
                                for (int q4 = 0; q4 < 4; ++q4) w[q4] = pk4_fp8(acc[jt][it][4 * q4] * sc_, acc[jt][it][4 * q4 + 1] * sc_, acc[jt][it][4 * q4 + 2] * sc_, acc[jt][it][4 * q4 + 3] * sc_);
                                *(u32x4*)(y + pr * 1024 + ct * 256 + wn * 128 + it * 32 + 16 * hi) = w; } } } }
            } f{hidR, (const unsigned char*)(P.ws + WS_W8D) + (size_t)e * 1024 * 256, y, pairs, wts, rows};
            G::run_stream(f, 4, 4, lds);
        }
        __syncthreads();
    }
}

__device__ __forceinline__ void phase_combine(const Params& P) {
    const int lane = threadIdx.x & 63, gw = blockIdx.x * (NTHREADS / 64) + (threadIdx.x >> 6), NGW = gridDim.x * (NTHREADS / 64);
    const unsigned char* y = (const unsigned char*)(P.ws + WS_Y);
    typedef float f32x2_ __attribute__((ext_vector_type(2)));
    for (int m = gw; m < T; m += NGW) {
        const float* mod = (const float*)(P.ws + WS_MOD) + (m / SEQ) * 6144 + 5120;
#pragma unroll
        for (int j = 0; j < 2; ++j) { const int col = (lane + 64 * j) * 8;
            f32x4 s0 = (f32x4){0.f, 0.f, 0.f, 0.f}, s1 = s0;
#pragma unroll
            for (int sl = 0; sl < 8; ++sl) { const u32x2 v = *(const u32x2*)(y + ((size_t)m * 8 + sl) * 1024 + col);
                const f32x2_ a = __builtin_amdgcn_cvt_pk_f32_fp8((int)v.x, false), b = __builtin_amdgcn_cvt_pk_f32_fp8((int)v.x, true);
                const f32x2_ c = __builtin_amdgcn_cvt_pk_f32_fp8((int)v.y, false), d = __builtin_amdgcn_cvt_pk_f32_fp8((int)v.y, true);
                s0.x += a.x; s0.y += a.y; s0.z += b.x; s0.w += b.y; s1.x += c.x; s1.y += c.y; s1.z += d.x; s1.w += d.y; }
            const f32x4 g0 = *(const f32x4*)(mod + col), g1 = *(const f32x4*)(mod + col + 4);
            f32x4 o0 = *(const f32x4*)(P.out + (size_t)m * 1024 + col), o1 = *(const f32x4*)(P.out + (size_t)m * 1024 + col + 4);
            const u32x4 sh = *(const u32x4*)((const bf16_t*)(P.ws + WS_YSH) + (size_t)m * 1024 + col);
            const f32x4 h0 = (f32x4){__uint_as_float(sh.x << 16), __uint_as_float(sh.x & 0xffff0000u), __uint_as_float(sh.y << 16), __uint_as_float(sh.y & 0xffff0000u)};
            const f32x4 h1 = (f32x4){__uint_as_float(sh.z << 16), __uint_as_float(sh.z & 0xffff0000u), __uint_as_float(sh.w << 16), __uint_as_float(sh.w & 0xffff0000u)};
            o0 += g0 * (s0 * Y_INV + h0); o1 += g1 * (s1 * Y_INV + h1);
            *(f32x4*)(P.out + (size_t)m * 1024 + col) = o0; *(f32x4*)(P.out + (size_t)m * 1024 + col + 4) = o1; }
    }
}


__device__ __forceinline__ int queue_pull(unsigned* head, volatile LAS unsigned* slot) {
    if (threadIdx.x == 0) *slot = atomicAdd(head, 1u);
    __syncthreads();
    const int v = (int)*slot;
    __syncthreads();
    return v;
}
__device__ __forceinline__ void phase_cmp_h1(const Params& P, LAS unsigned char* lds, volatile LAS unsigned* slot) {
    unsigned* head = (unsigned*)(P.ws + WS_CTL + CTL_Q2);
    for (;;) {
        const int u = queue_pull(head, slot);
        if (u >= 64 + 512) break;
        if (u < 64) compress_unit(P, lds, u); else hgrn_unit<0>(P, lds, u - 64);
    }
}
__device__ __forceinline__ void phase_h23_nsa(const Params& P, LAS unsigned char* lds, volatile LAS unsigned* slot) {
    unsigned* head = (unsigned*)(P.ws + WS_CTL + CTL_Q3);
    for (;;) {
        const int n = queue_pull(head, slot);
        if (n >= 1536) break;
        if (n < 512) nsa_unit(P, lds, (n & 7) * 128 + (127 - (n >> 3)));
        else if (n < 1024) { const int m = n - 512; hgrn_unit<1>(P, lds, (m & 15) * 32 + (31 - (m >> 4))); }
        else { const int m = n - 1024; nsa_unit(P, lds, (m & 7) * 128 + (63 - (m >> 3))); }
    }
}

constexpr int LDS_BYTES = 144 * 1024;
__global__ void __launch_bounds__(NTHREADS) mega(Params P) {
    extern __shared__ __attribute__((aligned(16))) unsigned char smem[];
    LAS unsigned char* lds = (LAS unsigned char*)smem;
    volatile LAS unsigned* xst = (volatile LAS unsigned*)(lds + LDS_BYTES - 16);
    if (threadIdx.x < 4) xst[threadIdx.x] = 0u;
    __syncthreads();
    XcdBarrier xb = xcd_barrier_post((unsigned*)(P.ws + WS_CTL + CTL_BAR), xst);
    phase_mod(P, lds);
    xcd_barrier(xb);
    { const float* mod = (const float*)(P.ws + WS_MOD); norm_mod_rows(P.x, P.norm1_w, mod, mod + 1024, (bf16_t*)(P.ws + WS_H), H1S); }
    xcd_barrier(xb);
    phase_inproj(P, lds);
    xcd_barrier(xb);
    phase_cmp_h1(P, lds, xst + 2);
    xcd_barrier(xb);
    phase_h23_nsa(P, lds, xst + 2);
    phase_cvt_small(P);
    xcd_barrier(xb);
    phase_p4a(P, lds);
    xcd_barrier(xb);
    phase_p4b(P);
    xcd_barrier(xb);
    phase_p4c(P, lds);
    xcd_barrier(xb);
    phase_route(P);
    phase_p4d(P, lds);
    xcd_barrier(xb);
    phase_expert_cvt8(P);
    xcd_barrier(xb);
    phase_experts8(P, lds);
    xcd_barrier(xb);
    phase_combine(P);
}

extern "C" void kernel_launch(void* const* d_in, const int* in_sizes, int n_in, void* d_out, int out_size, void* d_ws, size_t ws_size, hipStream_t stream) {
    static int grid = 0;
    if (grid == 0) {
        if (n_in != 25 || ws_size < WS_END) { fprintf(stderr, "kernel_launch: unexpected n_in %d or ws_size %zu (need %zu)\n", n_in, ws_size, (size_t)WS_END); grid = -1; return; }
        int dev = 0, cus = 0, per_cu = 0;
        (void)hipGetDevice(&dev); (void)hipDeviceGetAttribute(&cus, hipDeviceAttributeMultiprocessorCount, dev);
        (void)hipFuncSetAttribute((const void*)mega, hipFuncAttributeMaxDynamicSharedMemorySize, LDS_BYTES);
        (void)hipOccupancyMaxActiveBlocksPerMultiprocessor(&per_cu, (const void*)mega, NTHREADS, LDS_BYTES);
        if (per_cu < 1) { fprintf(stderr, "kernel_launch: occupancy query says %d blocks per CU\n", per_cu); grid = -1; return; }
        grid = cus;
    }
    if (grid < 0) return;
    (void)hipMemsetAsync((char*)d_ws + WS_CTL, 0, 64 * 1024, stream);
    Params p{};
    const float** pf = (const float**)&p;
    for (int i = 0; i < 25; ++i) pf[i] = (const float*)d_in[i];
    p.out = (float*)d_out; p.ws = (unsigned char*)d_ws;
    void* args[] = {&p};
    hipError_t e = hipLaunchCooperativeKernel((const void*)mega, dim3(grid), dim3(NTHREADS), args, LDS_BYTES, stream);
    if (e != hipSuccess) fprintf(stderr, "cooperative launch failed: %s (grid %d)\n", hipGetErrorString(e), grid);
}

#ifdef PHASE_TEST
__global__ void __launch_bounds__(NTHREADS) t_p4a(Params P) { extern __shared__ __attribute__((aligned(16))) unsigned char smem[]; phase_p4a(P, (LAS unsigned char*)smem); }
__global__ void __launch_bounds__(NTHREADS) t_p4d(Params P) { extern __shared__ __attribute__((aligned(16))) unsigned char smem[]; phase_p4d(P, (LAS unsigned char*)smem); }
__global__ void __launch_bounds__(NTHREADS) t_p4(Params P) { extern __shared__ __attribute__((aligned(16))) unsigned char smem[]; phase_p4c(P, (LAS unsigned char*)smem); }
__global__ void __launch_bounds__(NTHREADS) t_p6(Params P) { extern __shared__ __attribute__((aligned(16))) unsigned char smem[]; phase_experts(P, (LAS unsigned char*)smem); }
__global__ void __launch_bounds__(NTHREADS) t_nsa(Params P) { extern __shared__ __attribute__((aligned(16))) unsigned char smem[]; nsa_unit(P, (LAS unsigned char*)smem, blockIdx.x); }
__global__ void __launch_bounds__(NTHREADS) t_mod(Params P) { extern __shared__ __attribute__((aligned(16))) unsigned char smem[]; phase_mod(P, (LAS unsigned char*)smem); }
__global__ void __launch_bounds__(NTHREADS) t_inproj(Params P) { extern __shared__ __attribute__((aligned(16))) unsigned char smem[]; phase_inproj(P, (LAS unsigned char*)smem); }
__global__ void __launch_bounds__(NTHREADS) t_cmp(Params P) { extern __shared__ __attribute__((aligned(16))) unsigned char smem[]; compress_unit(P, (LAS unsigned char*)smem, blockIdx.x); }
__global__ void __launch_bounds__(NTHREADS) t_h0(Params P) { extern __shared__ __attribute__((aligned(16))) unsigned char smem[]; hgrn_unit<0>(P, (LAS unsigned char*)smem, blockIdx.x); }
__global__ void __launch_bounds__(NTHREADS) t_h1(Params P) { extern __shared__ __attribute__((aligned(16))) unsigned char smem[]; hgrn_unit<1>(P, (LAS unsigned char*)smem, blockIdx.x); }
#endif
```

```cpp
#include <hip/hip_runtime.h>
#include <hip/hip_cooperative_groups.h>
#include <cstdio>
#include <cstdint>
#include <type_traits>
namespace cg = cooperative_groups;

#define LAS __attribute__((address_space(3)))
typedef unsigned short bf16_t;
typedef short bf16x8 __attribute__((ext_vector_type(8)));
typedef short s16x4 __attribute__((ext_vector_type(4)));
typedef float f32x4 __attribute__((ext_vector_type(4)));
typedef float f32x16 __attribute__((ext_vector_type(16)));
typedef unsigned u32x4 __attribute__((ext_vector_type(4)));
typedef unsigned u32x2 __attribute__((ext_vector_type(2)));

constexpr int D = 1024, BATCH = 4, SEQ = 8192, T = BATCH * SEQ;
constexpr int IN_COLS = 3352;
constexpr int NTHREADS = 512;
constexpr int H1S = 1088;
constexpr float RMS_EPS = 1e-6f;
constexpr float LOG2E = 1.4426950408889634f;
constexpr float Y_SCALE = 16.0f, Y_INV = 1.0f / 16.0f;

constexpr size_t MB = 1024ull * 1024ull;
constexpr size_t WS_CTL    = 0;
constexpr size_t WS_MOD    = 64 * 1024;
constexpr size_t WS_LB     = WS_MOD + 4 * 6144 * 4;
constexpr size_t WS_CB     = WS_LB + 2048;
constexpr size_t WS_H      = 1 * MB;
constexpr size_t WS_SS     = WS_H + 72 * MB;
constexpr size_t WS_RW     = WS_SS + 1 * MB;
constexpr size_t WS_BUCKET = WS_RW + 1 * MB;
constexpr size_t WS_HIDR   = WS_BUCKET + 16 * MB;
constexpr size_t WS_WSM    = WS_HIDR + 32 * MB;
constexpr size_t WS_WOUT   = WS_WSM, WS_WRS = WS_WSM + 2 * MB, WS_WSD = WS_WSM + 4 * MB;
constexpr size_t WS_WBE    = WS_WSM + 5 * MB;
constexpr size_t WS_WBGU   = WS_WBE, WS_WBD = WS_WBE + 256 * MB;
constexpr size_t WS_W8GU   = WS_WBE, WS_W8D = WS_WBE + 128 * MB, WS_H2Q = WS_WBE + 256 * MB;
constexpr float W8_GU_SCALE = 64.0f, W8_D_SCALE = 32.0f, HID8_SCALE = 4.0f;
constexpr size_t WS_SCORES = WS_WBE;
constexpr size_t WS_HIDS   = WS_SCORES + 32 * MB;
constexpr size_t WS_WIN    = WS_HIDS + 16 * MB;
constexpr size_t WS_Y      = WS_WBE + 384 * MB;
constexpr size_t WS_Q      = WS_Y;
constexpr size_t WS_KV     = WS_Q + 32 * MB;
constexpr size_t WS_GATES  = WS_KV + 48 * MB;
constexpr size_t WS_HQ     = WS_GATES + 4 * MB;
constexpr size_t WS_LOGF   = WS_HQ + 32 * MB;
constexpr size_t WS_HV     = WS_LOGF + 64 * MB;
constexpr size_t WS_HG     = WS_HV + 32 * MB;
constexpr size_t WS_CMPH   = WS_HG + 32 * MB;
constexpr size_t WS_KC     = WS_CMPH + 4 * MB;
constexpr size_t WS_VC     = WS_KC + 1 * MB;
constexpr size_t WS_HL     = WS_VC + 1 * MB;
constexpr size_t WS_HD     = WS_HL + 32 * MB;
constexpr size_t WS_MIX    = WS_HD + 1 * MB;
constexpr size_t WS_YSH    = WS_Y + 384 * MB;
constexpr size_t WS_END    = WS_YSH + 64 * MB;
constexpr int BCAP = 16384;
constexpr int CTL_CNT = 1024;
constexpr int CTL_Q2 = 2048, CTL_Q3 = 2112;
constexpr int CTL_BAR = 16384;

struct Params {
    const float *x, *c, *ada_w, *ada_b, *norm1_w, *norm2_w, *w_in, *q_norm_w, *k_norm_w, *cmp_pos, *cmp_w1, *cmp_b1, *cmp_w2,
        *attn_out_norm_w, *hgrn_lb, *rec_out_norm_w, *w_out, *router_w, *router_bias, *exp_wg, *exp_wu, *exp_wd, *sh_wg, *sh_wu, *sh_wd;
    float* out;
    unsigned char* ws;
};

typedef __bf16 bf16x2_t __attribute__((ext_vector_type(2)));
typedef int i32x8 __attribute__((ext_vector_type(8)));
__device__ __forceinline__ unsigned cvtpk(float lo, float hi) { bf16x2_t v; v.x = (__bf16)lo; v.y = (__bf16)hi; return __builtin_bit_cast(unsigned, v); }
__device__ __forceinline__ int opaque_tid() { int t = threadIdx.x; asm volatile("" : "+v"(t)); return t; }
__device__ __forceinline__ float bf2f(bf16_t v) { return __uint_as_float(((unsigned)v) << 16); }
__device__ __forceinline__ float sigmoidf_(float v) { return __builtin_amdgcn_rcpf(1.0f + __expf(-v)); }
__device__ __forceinline__ float siluf_(float v) { return v * __builtin_amdgcn_rcpf(1.0f + __expf(-v)); }
__device__ __forceinline__ float wave_sum(float v) {
#pragma unroll
    for (int o = 1; o < 64; o <<= 1) v += __shfl_xor(v, o);
    return v;
}
__device__ __forceinline__ s16x4 lds_tr(const LAS unsigned char* p) {
    return __builtin_bit_cast(s16x4, __builtin_amdgcn_ds_read_tr16_b64_v4i16((LAS s16x4*)p));
}

#define XB_TMO      128
#define XB_XCNT(j)  (256  + 64 * (j))
#define XB_XSUB(j)  (1280 + 64 * (j))
#define XB_XGEN(j)  (2304 + 64 * (j))
#define XB_TOP      3328
#define XB_TOPGEN   3392
#define XCD_BAR_WORDS 3456
#define XB_SPIN_CAP (1u << 22)
__device__ __forceinline__ unsigned xb_ld(unsigned* p)              { return __hip_atomic_load(p, __ATOMIC_RELAXED, __HIP_MEMORY_SCOPE_AGENT); }
__device__ __forceinline__ unsigned xb_add(unsigned* p, unsigned v) { return __hip_atomic_fetch_add(p, v, __ATOMIC_RELAXED, __HIP_MEMORY_SCOPE_AGENT); }
__device__ __forceinline__ unsigned xb_xcc_id() { return (unsigned)__builtin_amdgcn_s_getreg((3 << 11) | 20) & 0xFu; }
#define XB_SPIN(cond, bar) do { unsigned _sp = 0; while (cond) { __builtin_amdgcn_s_sleep(1); \
    if ((++_sp & 255u) == 0u) { if (xb_ld(&(bar)[XB_TMO])) break; if (_sp > XB_SPIN_CAP) { atomicAdd(&(bar)[XB_TMO], 1u); break; } } } } while (0)
struct XcdBarrier { unsigned* bar; unsigned x; volatile LAS unsigned* st; };
__device__ __forceinline__ XcdBarrier xcd_barrier_post(unsigned* bar, volatile LAS unsigned* st) {
    XcdBarrier b; b.bar = bar; b.x = xb_xcc_id(); b.st = st;
    if (threadIdx.x == 0) (void)xb_add(&bar[XB_XCNT(b.x)], 1u);
    return b;
}
__device__ __forceinline__ void xcd_barrier_complete(unsigned* bar, unsigned x, unsigned& nloc, unsigned& nx) {
    const unsigned G = gridDim.x * gridDim.y * gridDim.z;
    unsigned sum, cnt, mine, sp = 0u;
    for (;;) {
        sum = 0u; cnt = 0u; mine = 0u;
#pragma unroll
        for (unsigned j = 0; j < 16; ++j) { const unsigned c = xb_ld(&bar[XB_XCNT(j)]); sum += c; cnt += (c > 0u) ? 1u : 0u; mine = (j == x) ? c : mine; }
        if (sum == G) break;
        __builtin_amdgcn_s_sleep(1);
        if ((++sp & 255u) == 0u) { if (xb_ld(&bar[XB_TMO])) break; if (sp > XB_SPIN_CAP) { atomicAdd(&bar[XB_TMO], 1u); break; } }
    }
    nloc = mine > 0u ? mine : 1u; nx = cnt > 0u ? cnt : 1u;
}
__device__ __forceinline__ void xcd_barrier(const XcdBarrier& b) {
    asm volatile("s_waitcnt vmcnt(0)" ::: "memory");
    __syncthreads();
    if (threadIdx.x == 0) {
        unsigned* bar = b.bar;
        __builtin_amdgcn_s_waitcnt(0);
        unsigned nloc = b.st[0], nx = b.st[1];
        if (nloc == 0u) { xcd_barrier_complete(bar, b.x, nloc, nx); b.st[0] = nloc; b.st[1] = nx; }
        const unsigned old = xb_add(&bar[XB_XSUB(b.x)], 1u);
        const unsigned gen = old / nloc;
        if (old + 1u == (gen + 1u) * nloc) {
            __builtin_amdgcn_fence(__ATOMIC_RELEASE, "agent");
            asm volatile("s_waitcnt vmcnt(0)" ::: "memory");
            const unsigned og = xb_add(&bar[XB_TOP], 1u);
            const unsigned tg = og / nx;
            if (og + 1u == (tg + 1u) * nx) xb_add(&bar[XB_TOPGEN], 1u);
            else XB_SPIN(xb_ld(&bar[XB_TOPGEN]) == tg, bar);
            __builtin_amdgcn_fence(__ATOMIC_ACQUIRE, "agent");
            xb_add(&bar[XB_XGEN(b.x)], 1u);
            asm volatile("s_waitcnt vmcnt(0)" ::: "memory");
        } else {
            XB_SPIN(xb_ld(&bar[XB_XGEN(b.x)]) == gen, bar);
            __builtin_amdgcn_fence(__ATOMIC_ACQUIRE, "agent");
            asm volatile("s_waitcnt vmcnt(0)" ::: "memory");
        }
    }
    __syncthreads();
}

template <int WM, int WN> struct GemmT {
    static constexpr int BM = 64 * WM, BN = 64 * WN;
    static constexpr int A_BYTES = BM * 128, B_BYTES = 64 * BN * 2, STAGE = A_BYTES + B_BYTES, LDS_BYTES = 2 * STAGE;
    static constexpr int NB4 = BN / 32;
    static constexpr int B_ROW4 = BN / 4;

    static __device__ __forceinline__ void run(f32x4 (&acc)[4][4], const bf16_t* const (&arow)[WM], int a_kstride, const float* Bp, int ldb, int KT, LAS unsigned char* lds) {
        const int tid = opaque_tid(), lane = tid & 63, wid = tid >> 6, wm = wid / WN, wn = wid % WN, fr = lane & 15, fq = lane >> 4;
#pragma unroll
        for (int mi = 0; mi < 4; ++mi)
#pragma unroll
            for (int ni = 0; ni < 4; ++ni) acc[mi][ni] = (f32x4){0.f, 0.f, 0.f, 0.f};
        const int achunk = tid & 7;
        u32x4 areg[WM]; f32x4 breg[NB4];
        int a_wr[WM];
#pragma unroll
        for (int p = 0; p < WM; ++p) { const int row = p * 64 + (tid >> 3); a_wr[p] = row * 128 + ((achunk ^ ((row >> 1) & 7)) << 4); }
        int b_wr[NB4]; int b_goff[NB4];
#pragma unroll
        for (int p = 0; p < NB4; ++p) { const int i = tid + NTHREADS * p, k = i / B_ROW4, n = (i % B_ROW4) * 4;
            const int f = (k & 3) | (((k >> 3) & 1) << 2);
            b_wr[p] = A_BYTES + k * (BN * 2) + (((n >> 4) ^ f) << 5) + ((n & 15) << 1); b_goff[p] = k * ldb + n; }
        int a_rd[4][2];
#pragma unroll
        for (int mi = 0; mi < 4; ++mi)
#pragma unroll
            for (int ks = 0; ks < 2; ++ks) { const int row = wm * 64 + mi * 16 + fr, ch = ks * 4 + fq; a_rd[mi][ks] = row * 128 + ((ch ^ ((row >> 1) & 7)) << 4); }
        int b_rd[2][2];
        int b_f[2][2];
#pragma unroll
        for (int ks = 0; ks < 2; ++ks)
#pragma unroll
            for (int t = 0; t < 2; ++t) { const int k = ks * 32 + 8 * fq + 4 * t + (fr >> 2); b_f[ks][t] = (k & 3) | (((k >> 3) & 1) << 2);
                b_rd[ks][t] = A_BYTES + k * (BN * 2) + ((fr & 3) << 3); }

        auto gload = [&](int kt) {
#pragma unroll
            for (int p = 0; p < WM; ++p) areg[p] = *(const u32x4*)(arow[p] + (size_t)kt * a_kstride + achunk * 8);
            const float* bk = Bp + (size_t)kt * 64 * ldb;
#pragma unroll
            for (int p = 0; p < NB4; ++p) breg[p] = *(const f32x4*)(bk + b_goff[p]);
        };
        auto lstore = [&](int buf) {
            LAS unsigned char* base = lds + buf * STAGE;
#pragma unroll
            for (int p = 0; p < WM; ++p) *(LAS u32x4*)(base + a_wr[p]) = areg[p];
#pragma unroll
            for (int p = 0; p < NB4; ++p) { u32x2 w; w.x = cvtpk(breg[p].x, breg[p].y); w.y = cvtpk(breg[p].z, breg[p].w); *(LAS u32x2*)(base + b_wr[p]) = w; }
        };
        gload(0); lstore(0); __syncthreads();
        for (int kt = 0; kt < KT; ++kt) {
            if (kt + 1 < KT) gload(kt + 1);
            __builtin_amdgcn_sched_barrier(0);
            const LAS unsigned char* base = lds + (kt & 1) * STAGE;
#pragma unroll
            for (int ks = 0; ks < 2; ++ks) {
                bf16x8 af[4], bfr[4];
#pragma unroll
                for (int mi = 0; mi < 4; ++mi) af[mi] = *(const LAS bf16x8*)(base + a_rd[mi][ks]);
#pragma unroll
                for (int ni = 0; ni < 4; ++ni) {
                    const int u0 = wn * 4 + ni;
                    const s16x4 lo = lds_tr(base + b_rd[ks][0] + ((u0 ^ b_f[ks][0]) << 5));
                    const s16x4 hi = lds_tr(base + b_rd[ks][1] + ((u0 ^ b_f[ks][1]) << 5));
                    bfr[ni] = (bf16x8){lo[0], lo[1], lo[2], lo[3], hi[0], hi[1], hi[2], hi[3]};
                }
#pragma unroll
                for (int mi = 0; mi < 4; ++mi)
#pragma unroll
                    for (int ni = 0; ni < 4; ++ni) acc[mi][ni] = __builtin_amdgcn_mfma_f32_16x16x32_bf16(bfr[ni], af[mi], acc[mi][ni], 0, 0, 0);
            }
            if (kt + 1 < KT) lstore((kt + 1) & 1);
            __syncthreads();
        }
    }
};

struct Gemm2 {
    static constexpr int A_BYTES = 32768, STAGE = 65536, LDS_BYTES = 2 * STAGE;
    static __device__ __forceinline__ int a_row(int i, int w, int lane) { return (i * 8 + w) * 8 + (lane >> 3); }
    static __device__ __forceinline__ int a_chunk(int row, int lane) { return (lane & 7) ^ ((row >> 1) & 7); }
    static __device__ __forceinline__ int b_k(int i, int w, int lane) { return (i * 8 + w) * 2 + (lane >> 5); }
    static __device__ __forceinline__ int b_n(int k, int lane) { return ((((lane & 31) >> 1) ^ fk2(k)) << 4) + ((lane & 1) << 3); }
    static __device__ __forceinline__ int fk2(int r) { return (r & 3) | (((r >> 3) & 1) << 2); }

    static __device__ __forceinline__ void run(f32x4 (&acc)[4][8], const bf16_t* const (&aptr)[4], int a_kstride, const bf16_t* const (&bptr)[4], size_t b_kstride, int KT, LAS unsigned char* lds) {
        const int tid = opaque_tid(), lane = tid & 63, wid = tid >> 6, wm = wid >> 1, wn = wid & 1, fr = lane & 15, fq = lane >> 4;
        const int wu = __builtin_amdgcn_readfirstlane(wid);
#pragma unroll
        for (int mi = 0; mi < 4; ++mi)
#pragma unroll
            for (int ni = 0; ni < 8; ++ni) acc[mi][ni] = (f32x4){0.f, 0.f, 0.f, 0.f};
        int a_rd[4][2];
#pragma unroll
        for (int mi = 0; mi < 4; ++mi)
#pragma unroll
            for (int ks = 0; ks < 2; ++ks) { const int row = wm * 64 + mi * 16 + fr, ch = ks * 4 + fq; a_rd[mi][ks] = row * 128 + ((ch ^ ((row >> 1) & 7)) << 4); }
        int b_rd[2][2], b_f[2][2];
#pragma unroll
        for (int ks = 0; ks < 2; ++ks)
#pragma unroll
            for (int t = 0; t < 2; ++t) { const int k = ks * 32 + 8 * fq + 4 * t + (fr >> 2); b_f[ks][t] = fk2(k); b_rd[ks][t] = A_BYTES + k * 512 + ((fr & 3) << 3); }
        auto issue = [&](int kt, int buf) {
            LAS unsigned char* base = lds + buf * STAGE + wu * 1024;
#pragma unroll
            for (int i = 0; i < 4; ++i) __builtin_amdgcn_global_load_lds((const unsigned*)(aptr[i] + (size_t)kt * a_kstride), (LAS unsigned*)(base + i * 8192), 16, 0, 0);
#pragma unroll
            for (int i = 0; i < 4; ++i) __builtin_amdgcn_global_load_lds((const unsigned*)(bptr[i] + (size_t)kt * b_kstride), (LAS unsigned*)(base + A_BYTES + i * 8192), 16, 0, 0);
        };
        issue(0, 0);
        for (int kt = 0; kt < KT; ++kt) {
            asm volatile("s_waitcnt vmcnt(0)" ::: "memory");
            __syncthreads();
            if (kt + 1 < KT) issue(kt + 1, (kt + 1) & 1);
            const LAS unsigned char* base = lds + (kt & 1) * STAGE;
#pragma unroll
            for (int ks = 0; ks < 2; ++ks) {
                bf16x8 af[4];
#pragma unroll
                for (int mi = 0; mi < 4; ++mi) af[mi] = *(const LAS bf16x8*)(base + a_rd[mi][ks]);
#pragma unroll
                for (int ni = 0; ni < 8; ++ni) {
                    const int u0 = wn * 8 + ni;
                    const s16x4 lo = lds_tr(base + b_rd[ks][0] + ((u0 ^ b_f[ks][0]) << 5));
                    const s16x4 hi = lds_tr(base + b_rd[ks][1] + ((u0 ^ b_f[ks][1]) << 5));
                    const bf16x8 bfr = (bf16x8){lo[0], lo[1], lo[2], lo[3], hi[0], hi[1], hi[2], hi[3]};
#pragma unroll
                    for (int mi = 0; mi < 4; ++mi) acc[mi][ni] = __builtin_amdgcn_mfma_f32_16x16x32_bf16(bfr, af[mi], acc[mi][ni], 0, 0, 0);
                }
            }
        }
        __syncthreads();
    }
};

__device__ __forceinline__ void glds16(const void* g, unsigned lds_base) {
    unsigned sv; asm volatile("s_mov_b32 %0, m0\n\ts_mov_b32 m0, %2\n\ts_nop 0\n\tglobal_load_lds_dwordx4 %1, off\n\ts_mov_b32 m0, %0" : "=&s"(sv) : "v"(g), "s"(lds_base) : "memory"); }
struct Gemm3 {
    static constexpr int A_BYTES = 16384, STAGE = 32768, LDS_BYTES = 4 * STAGE;
    static __device__ __forceinline__ int a_row(int i, int w, int lane) { return (i * 8 + w) * 16 + (lane >> 2); }
    static __device__ __forceinline__ int a_chunk(int row, int lane) { return (lane & 3) ^ ((row >> 1) & 3); }
    static __device__ __forceinline__ int b_k(int i, int w, int lane) { return (i * 8 + w) * 2 + (lane >> 5); }
    static __device__ __forceinline__ int fk2(int r) { return (r & 3) | (((r >> 3) & 1) << 2); }
    static __device__ __forceinline__ int b_n(int k, int lane) { return ((((lane & 31) >> 1) ^ fk2(k)) << 4) + ((lane & 1) << 3); }
    static __device__ __forceinline__ void run(f32x4 (&acc)[4][8], const bf16_t* const (&aptr)[2], int a_kstride, const bf16_t* const (&bptr)[2], size_t b_kstride, int KT, LAS unsigned char* lds) {
        const int tid = opaque_tid(), lane = tid & 63, wid = tid >> 6, wm = wid >> 1, wn = wid & 1, fr = lane & 15, fq = lane >> 4;
        const int wu = __builtin_amdgcn_readfirstlane(wid);
#pragma unroll
        for (int mi = 0; mi < 4; ++mi)
#pragma unroll
            for (int ni = 0; ni < 8; ++ni) acc[mi][ni] = (f32x4){0.f, 0.f, 0.f, 0.f};
        int a_rd[4];
#pragma unroll
        for (int mi = 0; mi < 4; ++mi) { const int row = wm * 64 + mi * 16 + fr; a_rd[mi] = row * 64 + ((fq ^ ((row >> 1) & 3)) << 4); }
        int b_rd[2], b_f[2];
#pragma unroll
        for (int t = 0; t < 2; ++t) { const int k = 8 * fq + 4 * t + (fr >> 2); b_f[t] = fk2(k); b_rd[t] = A_BYTES + k * 512 + ((fr & 3) << 3); }
        const unsigned lds0 = (unsigned)(uintptr_t)lds + (unsigned)wu * 1024u;
        auto issue = [&](int kt) {
            const unsigned base = (unsigned)__builtin_amdgcn_readfirstlane((int)(lds0 + (unsigned)(kt & 3) * STAGE));
#pragma unroll
            for (int i = 0; i < 2; ++i) glds16(aptr[i] + (size_t)kt * a_kstride, base + i * 8192);
#pragma unroll
            for (int i = 0; i < 2; ++i) glds16(bptr[i] + (size_t)kt * b_kstride, base + A_BYTES + i * 8192);
        };
        const int grp = wu >> 2;
        auto bar = [&]() { asm volatile("s_waitcnt lgkmcnt(0)" ::: "memory"); __builtin_amdgcn_s_barrier(); asm volatile("" ::: "memory"); };
        asm volatile("s_waitcnt vmcnt(0)" ::: "memory");
        issue(0); if (KT > 1) issue(1); if (KT > 2) issue(2);
        if (KT > 2) asm volatile("s_waitcnt vmcnt(8)" ::: "memory"); else if (KT > 1) asm volatile("s_waitcnt vmcnt(4)" ::: "memory"); else asm volatile("s_waitcnt vmcnt(0)" ::: "memory");
        bar();
        if (grp) bar();
#pragma unroll 1
        for (int kt = 0; kt < KT; ++kt) {
            if (kt + 3 < KT) issue(kt + 3);
            const LAS unsigned char* base = lds + (kt & 3) * STAGE;
            bf16x8 af[4], bfr[8];
#pragma unroll
            for (int mi = 0; mi < 4; ++mi) af[mi] = *(const LAS bf16x8*)(base + a_rd[mi]);
#pragma unroll
            for (int ni = 0; ni < 8; ++ni) {
                const int u0 = wn * 8 + ni;
                const s16x4 lo = lds_tr(base + b_rd[0] + ((u0 ^ b_f[0]) << 5));
                const s16x4 hi = lds_tr(base + b_rd[1] + ((u0 ^ b_f[1]) << 5));
                bfr[ni] = (bf16x8){lo[0], lo[1], lo[2], lo[3], hi[0], hi[1], hi[2], hi[3]};
            }
            { const int rem = KT - 2 - kt;
              if (rem >= 2) asm volatile("s_waitcnt vmcnt(8)" ::: "memory"); else if (rem == 1) asm volatile("s_waitcnt vmcnt(4)" ::: "memory"); else asm volatile("s_waitcnt vmcnt(0)" ::: "memory"); }
            bar();
            __builtin_amdgcn_sched_barrier(0);
#pragma unroll
            for (int ni = 0; ni < 8; ++ni)
#pragma unroll
                for (int mi = 0; mi < 4; ++mi) acc[mi][ni] = __builtin_amdgcn_mfma_f32_16x16x32_bf16(bfr[ni], af[mi], acc[mi][ni], 0, 0, 0);
            __builtin_amdgcn_sched_barrier(0);
            bar();
        }
        if (!grp) bar();
    }

    template <class F> static __device__ __forceinline__ void run_stream(F& f, int NSEG, int KT, int a_kstride, size_t b_kstride, LAS unsigned char* lds) {
        const int tid = opaque_tid(), lane = tid & 63, wid = tid >> 6, wm = wid >> 1, wn = wid & 1, fr = lane & 15, fq = lane >> 4;
        const int wu = __builtin_amdgcn_readfirstlane(wid);
        f32x4 acc[4][8];
#pragma unroll
        for (int mi = 0; mi < 4; ++mi)
#pragma unroll
            for (int ni = 0; ni < 8; ++ni) acc[mi][ni] = (f32x4){0.f, 0.f, 0.f, 0.f};
        int a_rd[4];
#pragma unroll
        for (int mi = 0; mi < 4; ++mi) { const int row = wm * 64 + mi * 16 + fr; a_rd[mi] = row * 64 + ((fq ^ ((row >> 1) & 3)) << 4); }
        int b_rd[2], b_f[2];
#pragma unroll
        for (int t = 0; t < 2; ++t) { const int k = 8 * fq + 4 * t + (fr >> 2); b_f[t] = fk2(k); b_rd[t] = A_BYTES + k * 512 + ((fr & 3) << 3); }
        const unsigned lds0 = (unsigned)(uintptr_t)lds + (unsigned)wu * 1024u;
        const bf16_t* aptr[2]; const bf16_t* bptr[2];
        const int total = NSEG * KT;
        int lseg = 0, lkt = 0, lg = 0;
        auto issue = [&]() {
            const unsigned base = (unsigned)__builtin_amdgcn_readfirstlane((int)(lds0 + (unsigned)(lg & 3) * STAGE));
#pragma unroll
            for (int i = 0; i < 2; ++i) glds16(aptr[i] + (size_t)lkt * a_kstride, base + i * 8192);
#pragma unroll
            for (int i = 0; i < 2; ++i) glds16(bptr[i] + (size_t)lkt * b_kstride, base + A_BYTES + i * 8192);
            ++lg; if (++lkt == KT) { lkt = 0; ++lseg; if (lseg < NSEG) f.ptrs(lseg, aptr, bptr); }
        };
        const int grp = wu >> 2;
        auto bar = [&]() { asm volatile("s_waitcnt lgkmcnt(0)" ::: "memory"); __builtin_amdgcn_s_barrier(); asm volatile("" ::: "memory"); };
        f.ptrs(0, aptr, bptr);
        asm volatile("s_waitcnt vmcnt(0)" ::: "memory");
        issue(); if (total > 1) issue(); if (total > 2) issue();
        if (total > 2) asm volatile("s_waitcnt vmcnt(8)" ::: "memory"); else if (total > 1) asm volatile("s_waitcnt vmcnt(4)" ::: "memory"); else asm volatile("s_waitcnt vmcnt(0)" ::: "memory");
        bar();
        if (grp) bar();
        int cseg = 0, ckt = 0;
#pragma unroll 1
        for (int g = 0; g < total; ++g) {
            if (lg < total) issue();
            const LAS unsigned char* base = lds + (g & 3) * STAGE;
            bf16x8 af[4], bfr[8];
#pragma unroll
            for (int mi = 0; mi < 4; ++mi) af[mi] = *(const LAS bf16x8*)(base + a_rd[mi]);
#pragma unroll
            for (int ni = 0; ni < 8; ++ni) {
                const int u0 = wn * 8 + ni;
                const s16x4 lo = lds_tr(base + b_rd[0] + ((u0 ^ b_f[0]) << 5));
                const s16x4 hi = lds_tr(base + b_rd[1] + ((u0 ^ b_f[1]) << 5));
                bfr[ni] = (bf16x8){lo[0], lo[1], lo[2], lo[3], hi[0], hi[1], hi[2], hi[3]};
            }
            { const int rem = total - 2 - g;
              if (rem >= 2) asm volatile("s_waitcnt vmcnt(8)" ::: "memory"); else if (rem == 1) asm volatile("s_waitcnt vmcnt(4)" ::: "memory"); else asm volatile("s_waitcnt vmcnt(0)" ::: "memory"); }
            bar();
            __builtin_amdgcn_sched_barrier(0);
#pragma unroll
            for (int ni = 0; ni < 8; ++ni)
#pragma unroll
                for (int mi = 0; mi < 4; ++mi) acc[mi][ni] = __builtin_amdgcn_mfma_f32_16x16x32_bf16(bfr[ni], af[mi], acc[mi][ni], 0, 0, 0);
            __builtin_amdgcn_sched_barrier(0);
            bar();
            if (++ckt == KT) {
                if (!grp) bar();
                f.epi(cseg, acc);
#pragma unroll
                for (int mi = 0; mi < 4; ++mi)
#pragma unroll
                    for (int ni = 0; ni < 8; ++ni) acc[mi][ni] = (f32x4){0.f, 0.f, 0.f, 0.f};
                ckt = 0; ++cseg;
                if (grp) bar();
            }
        }
        if (!grp) bar();
    }
};

struct Gemm4 {
    static constexpr int A_BYTES = 16384, STAGE = 32768, LDS_BYTES = 2 * STAGE;
    static __device__ __forceinline__ int fk2(int r) { return (r & 3) | (((r >> 3) & 1) << 2); }
    static __device__ __forceinline__ int a_row(int i, int tid) { return (tid >> 2) + 128 * i; }
    static __device__ __forceinline__ int b_k(int i, int tid) { return (tid >> 5) + 16 * i; }
    static __device__ __forceinline__ void run(f32x4 (&acc)[4][8], const bf16_t* const (&aptr)[2], int a_kstride, const bf16_t* const (&bptr)[2], size_t b_kstride, int KT, LAS unsigned char* lds) {
        const int tid = opaque_tid(), lane = tid & 63, wid = tid >> 6, wm = wid >> 1, wn = wid & 1, fr = lane & 15, fq = lane >> 4;
#pragma unroll
        for (int mi = 0; mi < 4; ++mi)
#pragma unroll
            for (int ni = 0; ni < 8; ++ni) acc[mi][ni] = (f32x4){0.f, 0.f, 0.f, 0.f};
        int a_wr[2], b_wr[2];
#pragma unroll
        for (int i = 0; i < 2; ++i) { const int row = a_row(i, tid); a_wr[i] = row * 64 + (((tid & 3) ^ ((row >> 1) & 3)) << 4);
            const int k = b_k(i, tid), n = (tid & 31) * 8; b_wr[i] = A_BYTES + k * 512 + (((n >> 4) ^ fk2(k)) << 5) + ((n & 15) << 1); }
        int a_rd[4];
#pragma unroll
        for (int mi = 0; mi < 4; ++mi) { const int row = wm * 64 + mi * 16 + fr; a_rd[mi] = row * 64 + ((fq ^ ((row >> 1) & 3)) << 4); }
        int b_rd[2], b_f[2];
#pragma unroll
        for (int t = 0; t < 2; ++t) { const int k = 8 * fq + 4 * t + (fr >> 2); b_f[t] = fk2(k); b_rd[t] = A_BYTES + k * 512 + ((fr & 3) << 3); }
        u32x4 ra0[2], rb0[2], ra1[2], rb1[2];
        auto gload = [&](int kt, u32x4 (&ra)[2], u32x4 (&rb)[2]) {
#pragma unroll
            for (int i = 0; i < 2; ++i) { ra[i] = *(const u32x4*)(aptr[i] + (size_t)kt * a_kstride); rb[i] = *(const u32x4*)(bptr[i] + (size_t)kt * b_kstride); }
        };
        auto lstore = [&](int buf, const u32x4 (&ra)[2], const u32x4 (&rb)[2]) {
            LAS unsigned char* base = lds + buf * STAGE;
#pragma unroll
            for (int i = 0; i < 2; ++i) { *(LAS u32x4*)(base + a_wr[i]) = ra[i]; *(LAS u32x4*)(base + b_wr[i]) = rb[i]; }
        };
        auto compute = [&](int buf) {
            const LAS unsigned char* base = lds + buf * STAGE;
            bf16x8 af[4];
#pragma unroll
            for (int mi = 0; mi < 4; ++mi) af[mi] = *(const LAS bf16x8*)(base + a_rd[mi]);
#pragma unroll
            for (int ni = 0; ni < 8; ++ni) {
                const int u0 = wn * 8 + ni;
                const s16x4 lo = lds_tr(base + b_rd[0] + ((u0 ^ b_f[0]) << 5));
                const s16x4 hi = lds_tr(base + b_rd[1] + ((u0 ^ b_f[1]) << 5));
                const bf16x8 bfr = (bf16x8){lo[0], lo[1], lo[2], lo[3], hi[0], hi[1], hi[2], hi[3]};
#pragma unroll
                for (int mi = 0; mi < 4; ++mi) acc[mi][ni] = __builtin_amdgcn_mfma_f32_16x16x32_bf16(bfr, af[mi], acc[mi][ni], 0, 0, 0);
            }
        };
        gload(0, ra0, rb0); gload(1, ra1, rb1);
        lstore(0, ra0, rb0); __syncthreads();
        for (int kt = 0; kt < KT; kt += 2) {
            gload(kt + 2 < KT ? kt + 2 : KT - 1, ra0, rb0);
            __builtin_amdgcn_sched_barrier(0);
            compute(0);
            lstore(1, ra1, rb1);
            __syncthreads();
            gload(kt + 3 < KT ? kt + 3 : KT - 1, ra1, rb1);
            __builtin_amdgcn_sched_barrier(0);
            compute(1);
            lstore(0, ra0, rb0);
            __syncthreads();
        }
    }

    template <class F> static __device__ __forceinline__ void run_stream(F& f, int NSEG, int KT, int a_kstride, size_t b_kstride, LAS unsigned char* lds) {
        const int tid = opaque_tid(), lane = tid & 63, wid = tid >> 6, wm = wid >> 1, wn = wid & 1, fr = lane & 15, fq = lane >> 4;
        f32x4 acc[4][8];
#pragma unroll
        for (int mi = 0; mi < 4; ++mi)
#pragma unroll
            for (int ni = 0; ni < 8; ++ni) acc[mi][ni] = (f32x4){0.f, 0.f, 0.f, 0.f};
        int a_wr[2], b_wr[2];
#pragma unroll
        for (int i = 0; i < 2; ++i) { const int row = a_row(i, tid); a_wr[i] = row * 64 + (((tid & 3) ^ ((row >> 1) & 3)) << 4);
            const int k = b_k(i, tid), n = (tid & 31) * 8; b_wr[i] = A_BYTES + k * 512 + (((n >> 4) ^ fk2(k)) << 5) + ((n & 15) << 1); }
        int a_rd[4];
#pragma unroll
        for (int mi = 0; mi < 4; ++mi) { const int row = wm * 64 + mi * 16 + fr; a_rd[mi] = row * 64 + ((fq ^ ((row >> 1) & 3)) << 4); }
        int b_rd[2], b_f[2];
#pragma unroll
        for (int t = 0; t < 2; ++t) { const int k = 8 * fq + 4 * t + (fr >> 2); b_f[t] = fk2(k); b_rd[t] = A_BYTES + k * 512 + ((fr & 3) << 3); }
        const bf16_t* aptr[2]; const bf16_t* bptr[2];
        u32x4 ra0[2], rb0[2], ra1[2], rb1[2];
        int lseg = 0, lkt = 0;
        auto gload = [&](u32x4 (&ra)[2], u32x4 (&rb)[2]) {
#pragma unroll
            for (int i = 0; i < 2; ++i) { ra[i] = *(const u32x4*)(aptr[i] + (size_t)lkt * a_kstride); rb[i] = *(const u32x4*)(bptr[i] + (size_t)lkt * b_kstride); }
            if (lkt + 1 < KT) ++lkt; else if (lseg + 1 < NSEG) { lkt = 0; ++lseg; f.ptrs(lseg, aptr, bptr); }
        };
        auto lstore = [&](int buf, const u32x4 (&ra)[2], const u32x4 (&rb)[2]) {
            LAS unsigned char* base = lds + buf * STAGE;
#pragma unroll
            for (int i = 0; i < 2; ++i) { *(LAS u32x4*)(base + a_wr[i]) = ra[i]; *(LAS u32x4*)(base + b_wr[i]) = rb[i]; }
        };
        auto compute = [&](int buf) {
            const LAS unsigned char* base = lds + buf * STAGE;
            bf16x8 af[4];
#pragma unroll
            for (int mi = 0; mi < 4; ++mi) af[mi] = *(const LAS bf16x8*)(base + a_rd[mi]);
#pragma unroll
            for (int ni = 0; ni < 8; ++ni) {
                const int u0 = wn * 8 + ni;
                const s16x4 lo = lds_tr(base + b_rd[0] + ((u0 ^ b_f[0]) << 5));
                const s16x4 hi = lds_tr(base + b_rd[1] + ((u0 ^ b_f[1]) << 5));
                const bf16x8 bfr = (bf16x8){lo[0], lo[1], lo[2], lo[3], hi[0], hi[1], hi[2], hi[3]};
#pragma unroll
                for (int mi = 0; mi < 4; ++mi) acc[mi][ni] = __builtin_amdgcn_mfma_f32_16x16x32_bf16(bfr, af[mi], acc[mi][ni], 0, 0, 0);
            }
        };
        f.ptrs(0, aptr, bptr);
        gload(ra0, rb0); gload(ra1, rb1);
        lstore(0, ra0, rb0); __syncthreads();
        int cseg = 0, ckt = 0;
        const int total = NSEG * KT;
#pragma unroll 1
        for (int g = 0; g < total; g += 2) {
            gload(ra0, rb0);
            __builtin_amdgcn_sched_barrier(0);
            compute(0);
            lstore(1, ra1, rb1);
            __syncthreads();
            gload(ra1, rb1);
            __builtin_amdgcn_sched_barrier(0);
            compute(1);
            lstore(0, ra0, rb0);
            __syncthreads();
            ckt += 2;
            if (ckt == KT) {
                f.epi(cseg, acc);
#pragma unroll
                for (int mi = 0; mi < 4; ++mi)
#pragma unroll
                    for (int ni = 0; ni < 8; ++ni) acc[mi][ni] = (f32x4){0.f, 0.f, 0.f, 0.f};
                ckt = 0; ++cseg;
            }
        }
    }
};

template <bool BF32> struct Gemm5 {
    static constexpr int A_BYTES = 16384, STAGE = 32768, LDS_BYTES = 2 * STAGE;
    static __device__ __forceinline__ int fk2(int r) { return (r & 3) | (((r >> 3) & 1) << 2); }
    static __device__ __forceinline__ int a_row(int i, int tid) { return (tid >> 2) + 128 * i; }
    static __device__ __forceinline__ int b_k(int i, int tid) { return (tid >> 5) + 16 * i; }
    typedef typename std::conditional<BF32, float, bf16_t>::type b_t;
    static __device__ __forceinline__ void run(f32x4 (&acc)[4][8], const bf16_t* const (&aptr)[2], int a_kstride, const b_t* const (&bptr)[2], size_t b_kstride, int KT, LAS unsigned char* lds) {
        const int tid = opaque_tid(), lane = tid & 63, wid = tid >> 6, wm = wid >> 1, wn = wid & 1, fr = lane & 15, fq = lane >> 4;
#pragma unroll
        for (int mi = 0; mi < 4; ++mi)
#pragma unroll
            for (int ni = 0; ni < 8; ++ni) acc[mi][ni] = (f32x4){0.f, 0.f, 0.f, 0.f};
        int a_wr[2], b_wr[2];
#pragma unroll
        for (int i = 0; i < 2; ++i) { const int row = a_row(i, tid); a_wr[i] = row * 64 + (((tid & 3) ^ ((row >> 1) & 3)) << 4);
            const int k = b_k(i, tid), n = (tid & 31) * 8; b_wr[i] = A_BYTES + k * 512 + (((n >> 4) ^ fk2(k)) << 5) + ((n & 15) << 1); }
        int a_rd[4];
#pragma unroll
        for (int mi = 0; mi < 4; ++mi) { const int row = wm * 64 + mi * 16 + fr; a_rd[mi] = row * 64 + ((fq ^ ((row >> 1) & 3)) << 4); }
        int b_rd[2], b_f[2];
#pragma unroll
        for (int t = 0; t < 2; ++t) { const int k = 8 * fq + 4 * t + (fr >> 2); b_f[t] = fk2(k); b_rd[t] = A_BYTES + k * 512 + ((fr & 3) << 3); }
        u32x4 ra[2]; u32x4 rb[2]; f32x4 rbf[2][2];
        auto gload = [&](int kt) {
#pragma unroll
            for (int i = 0; i < 2; ++i) { ra[i] = *(const u32x4*)(aptr[i] + (size_t)kt * a_kstride);
                if (BF32) { const float* p = (const float*)bptr[i] + (size_t)kt * b_kstride; rbf[i][0] = *(const f32x4*)p; rbf[i][1] = *(const f32x4*)(p + 4); }
                else rb[i] = *(const u32x4*)((const bf16_t*)bptr[i] + (size_t)kt * b_kstride); }
        };
        auto lstore = [&](int buf) {
            LAS unsigned char* base = lds + buf * STAGE;
#pragma unroll
            for (int i = 0; i < 2; ++i) { *(LAS u32x4*)(base + a_wr[i]) = ra[i];
                if (BF32) { u32x4 w; w.x = cvtpk(rbf[i][0].x, rbf[i][0].y); w.y = cvtpk(rbf[i][0].z, rbf[i][0].w); w.z = cvtpk(rbf[i][1].x, rbf[i][1].y); w.w = cvtpk(rbf[i][1].z, rbf[i][1].w); *(LAS u32x4*)(base + b_wr[i]) = w; }
                else *(LAS u32x4*)(base + b_wr[i]) = rb[i]; }
        };
        auto compute = [&](int buf) {
            const LAS unsigned char* base = lds + buf * STAGE;
            bf16x8 af[4];
#pragma unroll
            for (int mi = 0; mi < 4; ++mi) af[mi] = *(const LAS bf16x8*)(base + a_rd[mi]);
#pragma unroll
            for (int ni = 0; ni < 8; ++ni) {
                const int u0 = wn * 8 + ni;
                const s16x4 lo = lds_tr(base + b_rd[0] + ((u0 ^ b_f[0]) << 5));
                const s16x4 hi = lds_tr(base + b_rd[1] + ((u0 ^ b_f[1]) << 5));
                const bf16x8 bfr = (bf16x8){lo[0], lo[1], lo[2], lo[3], hi[0], hi[1], hi[2], hi[3]};
#pragma unroll
                for (int mi = 0; mi < 4; ++mi) acc[mi][ni] = __builtin_amdgcn_mfma_f32_16x16x32_bf16(bfr, af[mi], acc[mi][ni], 0, 0, 0);
            }
        };
        gload(0); lstore(0); __syncthreads();
#pragma unroll 1
        for (int kt = 0; kt < KT; ++kt) {
            gload(kt + 1 < KT ? kt + 1 : KT - 1);
            __builtin_amdgcn_sched_barrier(0);
            compute(kt & 1);
            lstore((kt + 1) & 1);
            __syncthreads();
        }
    }

    template <class F> static __device__ __forceinline__ void run_stream(F& f, int NSEG, int KT, int a_kstride, size_t b_kstride, LAS unsigned char* lds) {
        const int tid = opaque_tid(), lane = tid & 63, wid = tid >> 6, wm = wid >> 1, wn = wid & 1, fr = lane & 15, fq = lane >> 4;
        f32x4 acc[4][8];
#pragma unroll
        for (int mi = 0; mi < 4; ++mi)
#pragma unroll
            for (int ni = 0; ni < 8; ++ni) acc[mi][ni] = (f32x4){0.f, 0.f, 0.f, 0.f};
        int a_wr[2], b_wr[2];
#pragma unroll
        for (int i = 0; i < 2; ++i) { const int row = a_row(i, tid); a_wr[i] = row * 64 + (((tid & 3) ^ ((row >> 1) & 3)) << 4);
            const int k = b_k(i, tid), n = (tid & 31) * 8; b_wr[i] = A_BYTES + k * 512 + (((n >> 4) ^ fk2(k)) << 5) + ((n & 15) << 1); }
        int a_rd[4];
#pragma unroll
        for (int mi = 0; mi < 4; ++mi) { const int row = wm * 64 + mi * 16 + fr; a_rd[mi] = row * 64 + ((fq ^ ((row >> 1) & 3)) << 4); }
        int b_rd[2], b_f[2];
#pragma unroll
        for (int t = 0; t < 2; ++t) { const int k = 8 * fq + 4 * t + (fr >> 2); b_f[t] = fk2(k); b_rd[t] = A_BYTES + k * 512 + ((fr & 3) << 3); }
        const bf16_t* aptr[2]; const b_t* bptr[2];
        u32x4 ra[2]; u32x4 rb[2]; f32x4 rbf[2][2];
        auto gload = [&](int kt) {
#pragma unroll
            for (int i = 0; i < 2; ++i) { ra[i] = *(const u32x4*)(aptr[i] + (size_t)kt * a_kstride);
                if (BF32) { const float* p = (const float*)bptr[i] + (size_t)kt * b_kstride; rbf[i][0] = *(const f32x4*)p; rbf[i][1] = *(const f32x4*)(p + 4); }
                else rb[i] = *(const u32x4*)((const bf16_t*)bptr[i] + (size_t)kt * b_kstride); }
        };
        auto lstore = [&](int buf) {
            LAS unsigned char* base = lds + buf * STAGE;
#pragma unroll
            for (int i = 0; i < 2; ++i) { *(LAS u32x4*)(base + a_wr[i]) = ra[i];
                if (BF32) { u32x4 w; w.x = cvtpk(rbf[i][0].x, rbf[i][0].y); w.y = cvtpk(rbf[i][0].z, rbf[i][0].w); w.z = cvtpk(rbf[i][1].x, rbf[i][1].y); w.w = cvtpk(rbf[i][1].z, rbf[i][1].w); *(LAS u32x4*)(base + b_wr[i]) = w; }
                else *(LAS u32x4*)(base + b_wr[i]) = rb[i]; }
        };
        auto compute = [&](int buf) {
            const LAS unsigned char* base = lds + buf * STAGE;
            bf16x8 af[4];
#pragma unroll
            for (int mi = 0; mi < 4; ++mi) af[mi] = *(const LAS bf16x8*)(base + a_rd[mi]);
#pragma unroll
            for (int ni = 0; ni < 8; ++ni) {
                const int u0 = wn * 8 + ni;
                const s16x4 lo = lds_tr(base + b_rd[0] + ((u0 ^ b_f[0]) << 5));
                const s16x4 hi = lds_tr(base + b_rd[1] + ((u0 ^ b_f[1]) << 5));
                const bf16x8 bfr = (bf16x8){lo[0], lo[1], lo[2], lo[3], hi[0], hi[1], hi[2], hi[3]};
#pragma unroll
                for (int mi = 0; mi < 4; ++mi) acc[mi][ni] = __builtin_amdgcn_mfma_f32_16x16x32_bf16(bfr, af[mi], acc[mi][ni], 0, 0, 0);
            }
        };
        f.ptrs(0, aptr, bptr);
        gload(0); lstore(0); __syncthreads();
        int seg = 0, kt = 0;
        const int total = NSEG * KT;
#pragma unroll 1
        for (int g = 0; g < total; ++g) {
            int nkt = kt + 1, nsg = seg; if (nkt == KT) { nkt = 0; nsg = seg + 1; }
            if (nkt == 0 && nsg < NSEG) f.ptrs(nsg, aptr, bptr);
            gload(nsg < NSEG ? nkt : KT - 1);
            __builtin_amdgcn_sched_barrier(0);
            compute(g & 1);
            lstore((g + 1) & 1);
            __syncthreads();
            if (nkt == 0) {
                f.epi(seg, acc);
#pragma unroll
                for (int mi = 0; mi < 4; ++mi)
#pragma unroll
                    for (int ni = 0; ni < 8; ++ni) acc[mi][ni] = (f32x4){0.f, 0.f, 0.f, 0.f};
            }
            seg = nsg; kt = nkt;
        }
    }
};

__device__ __forceinline__ int p2_col(int m0);
__device__ __forceinline__ void phase_mod(const Params& P, LAS unsigned char* lds) {
    const int tid = threadIdx.x;
    float* mod = (float*)(P.ws + WS_MOD);
    LAS float* sc = (LAS float*)lds;
    LAS float* red = (LAS float*)(lds + 16384);
    for (int i = tid; i < 4096; i += NTHREADS) sc[i] = siluf_(P.c[i]);
    __syncthreads();
    const int kq = tid >> 5, cl = tid & 31;
    for (int u = blockIdx.x; u < 192; u += gridDim.x) {
        const int j = u * 32 + cl;
        float a0 = 0.f, a1 = 0.f, a2 = 0.f, a3 = 0.f;
#pragma unroll 8
        for (int k = kq; k < 1024; k += 16) { const float w = P.ada_w[(size_t)k * 6144 + j];
            a0 += sc[k] * w; a1 += sc[1024 + k] * w; a2 += sc[2048 + k] * w; a3 += sc[3072 + k] * w; }
        red[(kq * 4 + 0) * 32 + cl] = a0; red[(kq * 4 + 1) * 32 + cl] = a1; red[(kq * 4 + 2) * 32 + cl] = a2; red[(kq * 4 + 3) * 32 + cl] = a3;
        __syncthreads();
        if (tid < 128) { const int b = tid >> 5; float s = 0.f;
#pragma unroll
            for (int q = 0; q < 16; ++q) s += red[(q * 4 + b) * 32 + cl];
            mod[b * 6144 + j] = s + P.ada_b[j]; }
        __syncthreads();
    }
    for (int u = blockIdx.x; u < 16; u += gridDim.x) {
        const int sel = u >> 3, j = (u & 7) * 32 + cl;
        const float* w1 = P.cmp_w1 + (size_t)sel * 2048 * 256; const float* pos = P.cmp_pos + sel * 2048;
        float a0 = 0.f;
#pragma unroll 8
        for (int k = kq; k < 2048; k += 16) a0 += pos[k] * w1[(size_t)k * 256 + j];
        red[kq * 32 + cl] = a0;
        __syncthreads();
        if (tid < 32) { float s = 0.f;
#pragma unroll
            for (int q = 0; q < 16; ++q) s += red[q * 32 + cl];
            ((float*)(P.ws + WS_CB))[sel * 256 + j] = s + P.cmp_b1[sel * 256 + j]; }
        __syncthreads();
    }
    {
        bf16_t* wb = (bf16_t*)(P.ws + WS_WIN);
        const int gt = blockIdx.x * NTHREADS + tid, NG = gridDim.x * NTHREADS;
        for (int i = gt; i < 1024 * (3584 / 8); i += NG) { const int k = i / 448, m8 = (i % 448) * 8, c8 = (m8 & ~255) + p2_col(m8 & 255);
            const int sc_ = c8 < 1280 ? c8 : (c8 < 3328 ? c8 + 24 : c8 - 2048);
            u32x4 o = (u32x4){0u, 0u, 0u, 0u};
            if (c8 < 3352) { const f32x4 a = *(const f32x4*)(P.w_in + (size_t)k * IN_COLS + sc_); o.x = cvtpk(a.x, a.y); o.y = cvtpk(a.z, a.w); }
            if (c8 + 8 < 3352) { const f32x4 b2 = *(const f32x4*)(P.w_in + (size_t)k * IN_COLS + sc_ + 8); o.z = cvtpk(b2.x, b2.y); o.w = cvtpk(b2.z, b2.w); }
            *(u32x4*)(wb + (size_t)k * 3584 + m8) = o; }
    }
    if (blockIdx.x == gridDim.x - 2) {
        for (int i = tid; i < 2 * 8 * 64; i += NTHREADS) { const int t2 = i >> 9, bg = (i >> 6) & 7, d = i & 63;
            ((bf16_t*)(P.ws + (t2 ? WS_VC : WS_KC)))[((size_t)bg * 512 + 511) * 64 + d] = 0; }
    }
    if (blockIdx.x == gridDim.x - 1) {
        float* lb = (float*)(P.ws + WS_LB);
        for (int i = tid; i < 512; i += NTHREADS) { const float p0 = P.hgrn_lb[i], p1 = P.hgrn_lb[512 + i]; lb[i] = 1.0f / (1.0f + __expf(p1 - p0)); }
    }
}

__device__ __forceinline__ void norm_mod_rows(const float* x, const float* w, const float* mod_sh, const float* mod_sc, bf16_t* h, int hs) {
    const int lane = threadIdx.x & 63, gw = blockIdx.x * (NTHREADS / 64) + (threadIdx.x >> 6), NGW = gridDim.x * (NTHREADS / 64);
    for (int m = gw; m < T; m += NGW) {
        const int b = m / SEQ;
        const f32x4* xr = (const f32x4*)(x + (size_t)m * D) + lane;
        f32x4 v[4]; float s = 0.f;
#pragma unroll
        for (int j = 0; j < 4; ++j) { v[j] = xr[64 * j]; s += (v[j].x * v[j].x + v[j].y * v[j].y) + (v[j].z * v[j].z + v[j].w * v[j].w); }
        const float rstd = rsqrtf(wave_sum(s) * (1.f / D) + RMS_EPS);
        u32x2* o = (u32x2*)(h + (size_t)m * hs) + lane;
#pragma unroll
        for (int j = 0; j < 4; ++j) {
            const int col = (lane + 64 * j) * 4;
            const f32x4 wv = *(const f32x4*)(w + col), scv = *(const f32x4*)(mod_sc + b * 6144 + col), shv = *(const f32x4*)(mod_sh + b * 6144 + col);
            f32x4 r;
            r.x = v[j].x * rstd * wv.x * (1.f + scv.x) + shv.x; r.y = v[j].y * rstd * wv.y * (1.f + scv.y) + shv.y;
            r.z = v[j].z * rstd * wv.z * (1.f + scv.z) + shv.z; r.w = v[j].w * rstd * wv.w * (1.f + scv.w) + shv.w;
            u32x2 pk; pk.x = cvtpk(r.x, r.y); pk.y = cvtpk(r.z, r.w); o[64 * j] = pk;
        }
    }
}

__device__ __forceinline__ void phase_inproj(const Params& P, LAS unsigned char* lds) {
    constexpr int NRT = T / 256, NCT = 14;
    struct F { const Params& P;
        __device__ __forceinline__ void unit(int seg, int& rt, int& ct) const {
            const int nx = (gridDim.x % 8 == 0) ? 8 : 1, xl = blockIdx.x % nx, li = blockIdx.x / nx, nloc = gridDim.x / nx;
            const int v = li + seg * nloc, rg = v / (NCT * 4), rem = v % (NCT * 4); ct = rem >> 2; rt = xl + nx * (rg * 4 + (rem & 3)); }
        __device__ __forceinline__ void ptrs(int seg, const bf16_t* (&aptr)[2], const bf16_t* (&bptr)[2]) const {
            const int tid = opaque_tid(), lane = tid & 63, wid = tid >> 6; int rt, ct; unit(seg, rt, ct);
            const bf16_t* h1 = (const bf16_t*)(P.ws + WS_H); const bf16_t* wb = (const bf16_t*)(P.ws + WS_WIN);
#pragma unroll
            for (int i = 0; i < 2; ++i) { const int row = Gemm3::a_row(i, wid, lane); aptr[i] = h1 + (size_t)(rt * 256 + row) * H1S + Gemm3::a_chunk(row, lane) * 8;
                const int k = Gemm3::b_k(i, wid, lane); bptr[i] = wb + (size_t)k * 3584 + ct * 256 + Gemm3::b_n(k, lane); } }
        __device__ __forceinline__ void epi(int seg, f32x4 (&acc)[4][8]) const {
            const int tid = opaque_tid(), lane = tid & 63, wid = tid >> 6, wm = wid >> 1, wn = wid & 1, fr = lane & 15, fq = lane >> 4;
            int rt, ct; unit(seg, rt, ct);
            bf16_t* qo = (bf16_t*)(P.ws + WS_Q); bf16_t* kvo = (bf16_t*)(P.ws + WS_KV); float* gates = (float*)(P.ws + WS_GATES);
            bf16_t* hq = (bf16_t*)(P.ws + WS_HQ); float* logf = (float*)(P.ws + WS_LOGF); bf16_t* hv = (bf16_t*)(P.ws + WS_HV); bf16_t* hg = (bf16_t*)(P.ws + WS_HG);
            const float* lb = (const float*)(P.ws + WS_LB);
        const int row0 = rt * 256 + wm * 64 + fr;
            const int cw = wn * 128 + 8 * fq;
            if (ct < 5) {
                const bool is_q = ct < 2; const int seg = (ct - 2) * 2 + wn;
                const bool do_norm = is_q || seg == 2 || seg == 4;
                const float* nw = is_q ? P.q_norm_w : (P.k_norm_w + (seg == 2 ? 64 : 128));
                const float osc = is_q ? 0.125f : 1.0f;
#pragma unroll
                for (int hh = 0; hh < 2; ++hh) {
                    f32x4 wv[4];
#pragma unroll
                    for (int n4 = 0; n4 < 4; ++n4) wv[n4] = do_norm ? *(const f32x4*)(nw + (n4 >> 1) * 32 + 8 * fq + (n4 & 1) * 4) : (f32x4){1.f, 1.f, 1.f, 1.f};
#pragma unroll
                    for (int mi = 0; mi < 4; ++mi) {
                        float rstd = 1.f;
                        if (do_norm) { float s = 0.f;
#pragma unroll
                            for (int n4 = 0; n4 < 4; ++n4) { const f32x4 a = acc[mi][hh * 4 + n4]; s += (a.x * a.x + a.y * a.y) + (a.z * a.z + a.w * a.w); }
                            s += __shfl_xor(s, 16); s += __shfl_xor(s, 32);
                            rstd = rsqrtf(s * (1.f / 64.f) + RMS_EPS) * osc; }
                        const size_t m = (size_t)(row0 + mi * 16);
                        bf16_t* dst = is_q ? (qo + m * 512 + ct * 256 + cw + hh * 64) : (kvo + m * 768 + (ct - 2) * 256 + cw + hh * 64);
#pragma unroll
                        for (int jj = 0; jj < 2; ++jj) { const f32x4 a = acc[mi][hh * 4 + 2 * jj], c = acc[mi][hh * 4 + 2 * jj + 1]; const f32x4 w0 = wv[2 * jj], w1 = wv[2 * jj + 1];
                            *(u32x4*)(dst + jj * 32) = (u32x4){cvtpk(a.x * rstd * w0.x, a.y * rstd * w0.y), cvtpk(a.z * rstd * w0.z, a.w * rstd * w0.w),
                                                               cvtpk(c.x * rstd * w1.x, c.y * rstd * w1.y), cvtpk(c.z * rstd * w1.z, c.w * rstd * w1.w)}; }
                    }
                }
            } else if (ct == 13) {
                if (wn == 0 && fq < 3) {
#pragma unroll
                    for (int mi = 0; mi < 4; ++mi) { const size_t m = (size_t)(row0 + mi * 16); const f32x4 a = acc[mi][0], c = acc[mi][1];
                        *(f32x4*)(gates + m * 24 + 8 * fq) = (f32x4){sigmoidf_(a.x), sigmoidf_(a.y), sigmoidf_(a.z), sigmoidf_(a.w)};
                        *(f32x4*)(gates + m * 24 + 8 * fq + 4) = (f32x4){sigmoidf_(c.x), sigmoidf_(c.y), sigmoidf_(c.z), sigmoidf_(c.w)}; }
                }
            } else {
                const int hs = (ct - 5) >> 1, cc = ((ct - 5) & 1) * 256 + cw;
#pragma unroll
                for (int mi = 0; mi < 4; ++mi) { const size_t m = (size_t)(row0 + mi * 16);
#pragma unroll
                    for (int j = 0; j < 4; ++j) { const f32x4 a = acc[mi][2 * j], d = acc[mi][2 * j + 1]; const int c = cc + j * 32;
                        if (hs == 0) { const float s = 0.08838834764831845f;
                            *(u32x4*)(hq + m * 512 + c) = (u32x4){cvtpk(siluf_(a.x) * s, siluf_(a.y) * s), cvtpk(siluf_(a.z) * s, siluf_(a.w) * s), cvtpk(siluf_(d.x) * s, siluf_(d.y) * s), cvtpk(siluf_(d.z) * s, siluf_(d.w) * s)}; }
                        else if (hs == 1) { const f32x4 l = *(const f32x4*)(lb + c), l2 = *(const f32x4*)(lb + c + 4); f32x4 o, o2;
                            o.x = __logf(l.x + (1.f - l.x) * sigmoidf_(a.x)); o.y = __logf(l.y + (1.f - l.y) * sigmoidf_(a.y));
                            o.z = __logf(l.z + (1.f - l.z) * sigmoidf_(a.z)); o.w = __logf(l.w + (1.f - l.w) * sigmoidf_(a.w));
                            o2.x = __logf(l2.x + (1.f - l2.x) * sigmoidf_(d.x)); o2.y = __logf(l2.y + (1.f - l2.y) * sigmoidf_(d.y));
                            o2.z = __logf(l2.z + (1.f - l2.z) * sigmoidf_(d.z)); o2.w = __logf(l2.w + (1.f - l2.w) * sigmoidf_(d.w));
                            *(f32x4*)(logf + m * 512 + c) = o; *(f32x4*)(logf + m * 512 + c + 4) = o2; }
                        else if (hs == 2) { *(u32x4*)(hv + m * 512 + c) = (u32x4){cvtpk(a.x, a.y), cvtpk(a.z, a.w), cvtpk(d.x, d.y), cvtpk(d.z, d.w)}; }
                        else { *(u32x4*)(hg + m * 512 + c) = (u32x4){cvtpk(sigmoidf_(a.x), sigmoidf_(a.y)), cvtpk(sigmoidf_(a.z), sigmoidf_(a.w)), cvtpk(sigmoidf_(d.x), sigmoidf_(d.y)), cvtpk(sigmoidf_(d.z), sigmoidf_(d.w))}; }
                    } }
            }
        }
    } f{P};
    const int nx = (gridDim.x % 8 == 0) ? 8 : 1, li = blockIdx.x / nx, nloc = gridDim.x / nx;
    const int nu = ((NRT / nx) * NCT - li + nloc - 1) / nloc;
    if (nu > 0) Gemm3::run_stream(f, nu, D / 32, 32, (size_t)32 * 3584, lds);
}

__device__ __forceinline__ float gelu_tanh(float x) {
    const float u = 0.7978845608028654f * (x + 0.044715f * x * x * x);
    const float th = 1.0f - 2.0f / (1.0f + __expf(2.0f * u));
    return 0.5f * x * (1.0f + th);
}
__device__ __forceinline__ void compress_unit(const Params& P, LAS unsigned char* lds, int u) {
    typedef GemmT<2, 4> G;
    const int tid = opaque_tid(), lane = tid & 63, wid = tid >> 6, wm = wid >> 2, wn = wid & 3, fr = lane & 15, fq = lane >> 4;
    const int sel = u >> 5, rt = u & 31;
    const bf16_t* kv = (const bf16_t*)(P.ws + WS_KV);
    bf16_t* cmph = (bf16_t*)(P.ws + WS_CMPH) + (size_t)sel * 4096 * 256;
    const float* cb = (const float*)(P.ws + WS_CB) + sel * 256;
    const bf16_t* arow[2];
#pragma unroll
    for (int p = 0; p < 2; ++p) { int r = rt * 128 + p * 64 + (tid >> 3); r = r < 4088 ? r : 4087;
        const int b = r / 1022, rem = r % 1022, i = rem >> 1, g = rem & 1;
        arow[p] = kv + (size_t)(b * SEQ + 16 * i) * 768 + sel * 128 + g * 64; }
    f32x4 acc[4][4];
    G::run(acc, arow, 768, P.cmp_w1 + (size_t)sel * 2048 * 256, 256, 32, lds);
#pragma unroll
    for (int mi = 0; mi < 4; ++mi) { const size_t row = (size_t)(rt * 128 + wm * 64 + mi * 16 + fr);
#pragma unroll
        for (int ni = 0; ni < 4; ++ni) { const int col = wn * 64 + ni * 16 + 4 * fq; const f32x4 a = acc[mi][ni]; const f32x4 bb = *(const f32x4*)(cb + col);
            u32x2 pk; pk.x = cvtpk(gelu_tanh(a.x + bb.x), gelu_tanh(a.y + bb.y)); pk.y = cvtpk(gelu_tanh(a.z + bb.z), gelu_tanh(a.w + bb.w));
            *(u32x2*)(cmph + row * 256 + col) = pk; } }
    __syncthreads();
    {
        const int row = tid >> 2, cq = tid & 3;
        const bf16_t* hr = cmph + (size_t)(rt * 128 + row) * 256;
        const float* w2 = P.cmp_w2 + (size_t)sel * 256 * 64 + cq * 16;
        float o[16];
#pragma unroll
        for (int j = 0; j < 16; ++j) o[j] = 0.f;
        for (int k8 = 0; k8 < 256; k8 += 8) {
            const u32x4 hv = *(const u32x4*)(hr + k8);
#pragma unroll
            for (int kk = 0; kk < 8; ++kk) {
                const unsigned wd = hv[kk >> 1]; const float a = (kk & 1) ? __uint_as_float(wd & 0xffff0000u) : __uint_as_float(wd << 16);
                const float* wr = w2 + (size_t)(k8 + kk) * 64;
#pragma unroll
                for (int j4 = 0; j4 < 4; ++j4) { const f32x4 w = *(const f32x4*)(wr + j4 * 4);
                    o[j4 * 4 + 0] += a * w.x; o[j4 * 4 + 1] += a * w.y; o[j4 * 4 + 2] += a * w.z; o[j4 * 4 + 3] += a * w.w; }
            }
        }
        if (sel == 0) { float s = 0.f;
#pragma unroll
            for (int j = 0; j < 16; ++j) s += o[j] * o[j];
            s += __shfl_xor(s, 1); s += __shfl_xor(s, 2);
            const float rstd = rsqrtf(s * (1.f / 64.f) + RMS_EPS);
#pragma unroll
            for (int j = 0; j < 16; ++j) o[j] *= rstd * P.k_norm_w[cq * 16 + j]; }
        const int r = rt * 128 + row;
        if (r < 4088) { const int b = r / 1022, rem = r % 1022, i = rem >> 1, g = rem & 1;
            bf16_t* dst = (bf16_t*)(P.ws + (sel ? WS_VC : WS_KC)) + ((size_t)(b * 2 + g) * 512 + i) * 64 + cq * 16;
            u32x4 w0, w1;
            w0.x = cvtpk(o[0], o[1]); w0.y = cvtpk(o[2], o[3]); w0.z = cvtpk(o[4], o[5]); w0.w = cvtpk(o[6], o[7]);
            w1.x = cvtpk(o[8], o[9]); w1.y = cvtpk(o[10], o[11]); w1.z = cvtpk(o[12], o[13]); w1.w = cvtpk(o[14], o[15]);
            *(u32x4*)dst = w0; *(u32x4*)(dst + 8) = w1; }
    }
    __syncthreads();
}

__device__ __forceinline__ int off_row128(int row, int ch) { return row * 128 + ((ch ^ ((row >> 1) & 7)) << 4); }
__device__ __forceinline__ int off_row256(int row, int ch) { return row * 256 + ((ch ^ (row & 15)) << 4); }
__device__ __forceinline__ int fk_(int r) { return (r & 3) | (((r >> 3) & 1) << 2); }
__device__ __forceinline__ int off_tr256(int row, int col) { return row * 256 + ((((col >> 4) ^ fk_(row)) << 5) + ((col & 15) << 1)); }
constexpr int HL_QT = 0, HL_KT = 16384, HL_KH = 32768, HL_V = 49152, HL_SB = 65536, HL_P = 98304  , HL_TOT = 106496  , HL_RED = 110592  , HL_END = 111104;

template <int MODE> __device__ __forceinline__ void hgrn_unit(const Params& P, LAS unsigned char* lds, int u) {
    const int tid = opaque_tid(), lane = tid & 63, wid = tid >> 6, fr = lane & 15, fq = lane >> 4;
    const int b = u >> 7, h = (u >> 5) & 3, sc = u & 31;
    const bf16_t* hq = (const bf16_t*)(P.ws + WS_HQ); const float* logf = (const float*)(P.ws + WS_LOGF);
    const bf16_t* hv = (const bf16_t*)(P.ws + WS_HV); const bf16_t* hg = (const bf16_t*)(P.ws + WS_HG);
    float* HLs = (float*)(P.ws + WS_HL); float* HDs = (float*)(P.ws + WS_HD);
    bf16_t* mix = (bf16_t*)(P.ws + WS_MIX);
    LAS float* tot = (LAS float*)(lds + HL_TOT); LAS float* red = (LAS float*)(lds + HL_RED);
    f32x4 st[8];
#pragma unroll
    for (int vt = 0; vt < 8; ++vt) st[vt] = (f32x4){0.f, 0.f, 0.f, 0.f};
    if (MODE == 1) {
        const int kk = 16 * wid + fr;
#pragma unroll 4
        for (int j = 0; j < sc; ++j) {
            const float* Lj = HLs + (size_t)(u - sc + j) * 16384 + kk * 128 + 4 * fq; const float dj = HDs[(size_t)(u - sc + j) * 128 + kk];
#pragma unroll
            for (int vt = 0; vt < 8; ++vt) { const f32x4 l = *(const f32x4*)(Lj + vt * 16); st[vt] = st[vt] * dj + l; }
        }
    }
    float dsum = 0.f;
    const int kp = tid & 63, te = tid >> 6;
    for (int c = 0; c < 4; ++c) {
        const size_t tok0 = (size_t)b * SEQ + sc * 256 + c * 64;
        float lf0[8], lf1[8], cs0[8], cs1[8];
        { float a0 = 0.f, a1 = 0.f;
#pragma unroll
          for (int i = 0; i < 8; ++i) { const float2 v = *(const float2*)(logf + (tok0 + te * 8 + i) * 512 + h * 128 + 2 * kp); lf0[i] = v.x; lf1[i] = v.y; a0 += v.x; a1 += v.y; cs0[i] = a0; cs1[i] = a1; }
          tot[te * 128 + 2 * kp] = a0; tot[te * 128 + 2 * kp + 1] = a1; }
#pragma unroll
        for (int i = 0; i < 2; ++i) { const int pc = tid + NTHREADS * i, row = pc >> 4, c8 = (pc & 15) * 8;
            const u32x4 v = *(const u32x4*)(hv + (tok0 + row) * 512 + h * 128 + c8);
            *(LAS u32x4*)(lds + HL_V + off_tr256(row, c8)) = v; }
        if (MODE == 1 ) {
#pragma unroll
            for (int vt = 0; vt < 8; ++vt) { u32x2 pk; pk.x = cvtpk(st[vt].x, st[vt].y); pk.y = cvtpk(st[vt].z, st[vt].w);
                *(LAS u32x2*)(lds + HL_SB + off_tr256(16 * wid + fr, 16 * vt + 4 * fq)) = pk; }
        }
        __syncthreads();
        float pre0 = 0.f, pre1 = 0.f, last0 = 0.f, last1 = 0.f;
#pragma unroll
        for (int e = 0; e < 8; ++e) { const float t0 = tot[e * 128 + 2 * kp], t1 = tot[e * 128 + 2 * kp + 1]; if (e < te) { pre0 += t0; pre1 += t1; } last0 += t0; last1 += t1; }
#pragma unroll
        for (int i = 0; i < 8; ++i) {
            const int t = te * 8 + i;
            const float c0 = cs0[i] + pre0, c1 = cs1[i] + pre1;
            const float k0 = 1.f - __expf(lf0[i]), k1 = 1.f - __expf(lf1[i]);
            const unsigned khat = cvtpk(k0 * __expf(last0 - c0), k1 * __expf(last1 - c1));
            *(LAS unsigned*)(lds + HL_KH + off_tr256(t, 2 * kp)) = khat;
            if (MODE == 1) {
                const unsigned qraw = *(const unsigned*)(hq + (tok0 + t) * 512 + h * 128 + 2 * kp);
                const float q0 = __uint_as_float(qraw << 16), q1 = __uint_as_float(qraw & 0xffff0000u);
                const unsigned qt = cvtpk(q0 * __expf(c0), q1 * __expf(c1));
                const unsigned kt = cvtpk(k0 * __expf(fminf(-c0, 80.f)), k1 * __expf(fminf(-c1, 80.f)));
                const int o = off_row256(t, kp >> 2) + ((kp & 3) << 2);
                *(LAS unsigned*)(lds + HL_QT + o) = qt; *(LAS unsigned*)(lds + HL_KT + o) = kt;
            }
        }
        const float dec = __expf(tot[0 * 128 + 16 * wid + fr] + tot[1 * 128 + 16 * wid + fr] + tot[2 * 128 + 16 * wid + fr] + tot[3 * 128 + 16 * wid + fr]
                                 + tot[4 * 128 + 16 * wid + fr] + tot[5 * 128 + 16 * wid + fr] + tot[6 * 128 + 16 * wid + fr] + tot[7 * 128 + 16 * wid + fr]);
        if (MODE == 0 && tid < 128) { float s = 0.f;
#pragma unroll
            for (int e = 0; e < 8; ++e) s += tot[e * 128 + tid];
            dsum += s; }
        __syncthreads();
        f32x4 oacc[4];
        if (MODE == 1) {
            { const int tt = wid & 3;
#pragma unroll
              for (int si = 0; si < 2; ++si) { const int stl = 2 * (wid >> 2) + si;
                  f32x4 sacc = (f32x4){0.f, 0.f, 0.f, 0.f};
                  if (stl <= tt) {
#pragma unroll
                      for (int ks = 0; ks < 4; ++ks) {
                          const bf16x8 a = *(const LAS bf16x8*)(lds + HL_KT + off_row256(stl * 16 + fr, ks * 4 + fq));
                          const bf16x8 bq = *(const LAS bf16x8*)(lds + HL_QT + off_row256(tt * 16 + fr, ks * 4 + fq));
                          sacc = __builtin_amdgcn_mfma_f32_16x16x32_bf16(a, bq, sacc, 0, 0, 0);
                      }
                  }
                  const int t = tt * 16 + fr, s0 = stl * 16 + 4 * fq;
                  u32x2 pk; pk.x = cvtpk(s0 + 0 <= t ? sacc.x : 0.f, s0 + 1 <= t ? sacc.y : 0.f); pk.y = cvtpk(s0 + 2 <= t ? sacc.z : 0.f, s0 + 3 <= t ? sacc.w : 0.f);
                  *(LAS u32x2*)(lds + HL_P + off_row128(t, s0 >> 3) + ((s0 & 7) << 1)) = pk; }
            }
            __syncthreads();
            { const int tt = wid >> 1;
#pragma unroll
              for (int i = 0; i < 4; ++i) { const int vt = 4 * (wid & 1) + i;
                  f32x4 a = (f32x4){0.f, 0.f, 0.f, 0.f};
#pragma unroll
                  for (int ks = 0; ks < 2; ++ks) {
                      const int kr = ks * 32 + 8 * fq + (fr >> 2);
                      const s16x4 lo = lds_tr(lds + HL_V + off_tr256(kr, vt * 16 + 4 * (fr & 3))), hi = lds_tr(lds + HL_V + off_tr256(kr + 4, vt * 16 + 4 * (fr & 3)));
                      const bf16x8 va = (bf16x8){lo[0], lo[1], lo[2], lo[3], hi[0], hi[1], hi[2], hi[3]};
                      const bf16x8 pb = *(const LAS bf16x8*)(lds + HL_P + off_row128(tt * 16 + fr, ks * 4 + fq));
                      a = __builtin_amdgcn_mfma_f32_16x16x32_bf16(va, pb, a, 0, 0, 0);
                  }
#pragma unroll
                  for (int ks = 0; ks < 4; ++ks) {
                      const int kr = ks * 32 + 8 * fq + (fr >> 2);
                      const s16x4 lo = lds_tr(lds + HL_SB + off_tr256(kr, vt * 16 + 4 * (fr & 3))), hi = lds_tr(lds + HL_SB + off_tr256(kr + 4, vt * 16 + 4 * (fr & 3)));
                      const bf16x8 sa = (bf16x8){lo[0], lo[1], lo[2], lo[3], hi[0], hi[1], hi[2], hi[3]};
                      const bf16x8 qb = *(const LAS bf16x8*)(lds + HL_QT + off_row256(tt * 16 + fr, ks * 4 + fq));
                      a = __builtin_amdgcn_mfma_f32_16x16x32_bf16(sa, qb, a, 0, 0, 0);
                  }
                  const u32x2 gr = *(const u32x2*)(hg + (tok0 + tt * 16 + fr) * 512 + h * 128 + vt * 16 + 4 * fq);
                  a.x *= __uint_as_float(gr.x << 16); a.y *= __uint_as_float(gr.x & 0xffff0000u); a.z *= __uint_as_float(gr.y << 16); a.w *= __uint_as_float(gr.y & 0xffff0000u);
                  oacc[i] = a; }
              float ss = 0.f;
#pragma unroll
              for (int i = 0; i < 4; ++i) ss += (oacc[i].x * oacc[i].x + oacc[i].y * oacc[i].y) + (oacc[i].z * oacc[i].z + oacc[i].w * oacc[i].w);
              ss += __shfl_xor(ss, 16); ss += __shfl_xor(ss, 32);
              if (fq == 0) red[(tt * 2 + (wid & 1)) * 16 + fr] = ss; }
        }
#pragma unroll
        for (int vt = 0; vt < 8; ++vt) {
            f32x4 a = st[vt] * dec;
#pragma unroll
            for (int ks = 0; ks < 2; ++ks) {
                const int kr = ks * 32 + 8 * fq + (fr >> 2);
                const s16x4 lo = lds_tr(lds + HL_V + off_tr256(kr, vt * 16 + 4 * (fr & 3))), hi = lds_tr(lds + HL_V + off_tr256(kr + 4, vt * 16 + 4 * (fr & 3)));
                const bf16x8 va = (bf16x8){lo[0], lo[1], lo[2], lo[3], hi[0], hi[1], hi[2], hi[3]};
                const s16x4 lo2 = lds_tr(lds + HL_KH + off_tr256(kr, wid * 16 + 4 * (fr & 3))), hi2 = lds_tr(lds + HL_KH + off_tr256(kr + 4, wid * 16 + 4 * (fr & 3)));
                const bf16x8 kb = (bf16x8){lo2[0], lo2[1], lo2[2], lo2[3], hi2[0], hi2[1], hi2[2], hi2[3]};
                a = __builtin_amdgcn_mfma_f32_16x16x32_bf16(va, kb, a, 0, 0, 0);
            }
            st[vt] = a;
        }
        __syncthreads();
        if (MODE == 1) {
            const int tt = wid >> 1; const float ssum = red[(tt * 2) * 16 + fr] + red[(tt * 2 + 1) * 16 + fr];
            const float rstd = rsqrtf(ssum * (1.f / 128.f) + RMS_EPS);
#pragma unroll
            for (int i = 0; i < 4; ++i) { const int v = (4 * (wid & 1) + i) * 16 + 4 * fq; const f32x4 w = *(const f32x4*)(P.rec_out_norm_w + h * 128 + v);
                u32x2 pk; pk.x = cvtpk(oacc[i].x * rstd * w.x, oacc[i].y * rstd * w.y); pk.y = cvtpk(oacc[i].z * rstd * w.z, oacc[i].w * rstd * w.w);
                *(u32x2*)(mix + (tok0 + tt * 16 + fr) * 1024 + 512 + h * 128 + v) = pk; }
        }
    }
    if (MODE == 0) {
#pragma unroll
        for (int vt = 0; vt < 8; ++vt) *(f32x4*)(HLs + (size_t)u * 16384 + (16 * wid + fr) * 128 + vt * 16 + 4 * fq) = st[vt];
        if (tid < 128) HDs[(size_t)u * 128 + tid] = __expf(dsum);
    }
    __syncthreads();
}


constexpr int NL_K = 0, NL_V = 16384, NL_IMP = 32768, NL_IMP_STRIDE = 132, NL_SELM = NL_IMP + 8 * 8 * NL_IMP_STRIDE * 4, NL_END = NL_SELM + 1024;
__device__ __forceinline__ int off_v128(int row, int ch) { return row * 128 + ((ch ^ ((row & 3) << 1)) << 4); }
#define MFMA32(a, b, c) __builtin_amdgcn_mfma_f32_32x32x16_bf16(a, b, c, 0, 0, 0)

struct NsaLane { int t; float sl2; int qi; unsigned long long mlo, mhi; };

template <int MODE> __device__ __forceinline__ void nsa_pass(LAS unsigned char* lds, const bf16_t* Kg, const bf16_t* Vg, int rs, unsigned long long ulo, unsigned long long uhi,
                                                            const bf16x8 (&qf)[4], const NsaLane& L, float inv, float& lsum, f32x16 (&O)[2], LAS float* impw) {
    const int tid = opaque_tid(), lane = tid & 63, hi = lane >> 5, c = lane & 31;
    const int ld_row = tid >> 3, ld_ch = tid & 7;
    const int kw_off = off_row128(ld_row, ld_ch), vw_off = off_v128(ld_row, ld_ch);
    u32x4 k0, v0, k1, v1, k2, v2;
    auto next = [&](int jj) -> int { ++jj; if (jj < 64) { const unsigned long long m = ulo >> jj; if (m) return jj + __builtin_ctzll(m); jj = 64; }
                                     if (jj < 128) { const unsigned long long m = uhi >> (jj - 64); if (m) return jj + __builtin_ctzll(m); } return 128; };
    int jA = next(-1), jB = jA < 128 ? next(jA) : 128, jC = jB < 128 ? next(jB) : 128;
    const int jsafe = jA < 128 ? jA : 0;
    auto ldk = [&](int jj) -> u32x4 { const int q = jj < 128 ? jj : jsafe; return *(const u32x4*)(Kg + (size_t)(q * 64 + ld_row) * rs + ld_ch * 8); };
    auto ldv = [&](int jj) -> u32x4 { const int q = jj < 128 ? jj : jsafe; return *(const u32x4*)(Vg + (size_t)(q * 64 + ld_row) * rs + ld_ch * 8); };
    k0 = ldk(jA); k1 = ldk(jB); k2 = ldk(jC);
    if (MODE != 0) { v0 = ldv(jA); v1 = ldv(jB); v2 = ldv(jC); }
    int it = 0;
    auto step = [&](u32x4& kreg, u32x4& vreg) {
        const int j = jA;
        LAS unsigned char* kb = lds + NL_K + (it & 1) * 8192; LAS unsigned char* vb = lds + NL_V + (it & 1) * 8192;
        *(LAS u32x4*)(kb + kw_off) = kreg; if (MODE != 0) *(LAS u32x4*)(vb + vw_off) = vreg;
        const int jD = jC < 128 ? next(jC) : 128;
        kreg = ldk(jD); if (MODE != 0) vreg = ldv(jD);
        __syncthreads();
        bool need = true; bool selbit = true;
        if (MODE == 2) { selbit = (j < 64 ? (L.mlo >> j) : (L.mhi >> (j - 64))) & 1ull; need = __any(selbit); }
        if (need) {
            f32x16 p0 = {}, p1 = {};
#pragma unroll
            for (int ks = 0; ks < 4; ++ks) {
                const bf16x8 a0 = *(const LAS bf16x8*)(kb + off_row128(c, 2 * ks + hi)), a1 = *(const LAS bf16x8*)(kb + off_row128(32 + c, 2 * ks + hi));
                p0 = MFMA32(a0, qf[ks], p0); p1 = MFMA32(a1, qf[ks], p1);
            }
            const int stride = (MODE <= 1) ? 16 : 1;
            const int dl = (MODE <= 1) ? (L.t - 31 - 16 * (j * 64 + 4 * hi)) : (L.t - (j * 64 + 4 * hi));
            const float nb = -L.sl2 * (float)dl, sls = L.sl2 * (float)stride;
            float rs_ = 0.f;
#pragma unroll
            for (int r = 0; r < 16; ++r) {
                const int ro0 = (r & 3) + 8 * (r >> 2), ro1 = ro0 + 32;
                const int d0 = dl - stride * ro0, d1 = dl - stride * ro1;
                bool v0 = d0 >= 0, v1 = d1 >= 0;
                if (MODE == 3) { v0 = v0 && d0 < 512; v1 = v1 && d1 < 512; }
                if (MODE == 2) { v0 = v0 && selbit; v1 = v1 && selbit; }
                float e0 = __builtin_amdgcn_exp2f(__builtin_fmaf(p0[r], LOG2E, __builtin_fmaf(sls, (float)ro0, nb)));
                float e1 = __builtin_amdgcn_exp2f(__builtin_fmaf(p1[r], LOG2E, __builtin_fmaf(sls, (float)ro1, nb)));
                e0 = v0 ? e0 : 0.f; e1 = v1 ? e1 : 0.f;
                if (MODE == 1) { e0 *= inv; e1 *= inv; }
                p0[r] = e0; p1[r] = e1; rs_ += e0 + e1;
            }
            lsum += rs_;
            if (MODE == 1) {
#pragma unroll
                for (int kt = 0; kt < 2; ++kt)
#pragma unroll
                    for (int i = 0; i < 4; ++i) {
                        float g = kt ? (p1[4 * i] + p1[4 * i + 1]) + (p1[4 * i + 2] + p1[4 * i + 3]) : (p0[4 * i] + p0[4 * i + 1]) + (p0[4 * i + 2] + p0[4 * i + 3]);
                        float l3 = kt ? p1[4 * i + 3] : p0[4 * i + 3];
                        g += __shfl_xor(g, 1); g += __shfl_xor(g, 2); l3 += __shfl_xor(l3, 1); l3 += __shfl_xor(l3, 2);
                        if ((c & 3) == 0) { const int jj = j * 16 + kt * 8 + 2 * i + hi; __hip_atomic_fetch_add(impw + L.qi * NL_IMP_STRIDE + jj, g, __ATOMIC_RELAXED, __HIP_MEMORY_SCOPE_WORKGROUP); __hip_atomic_fetch_add(impw + L.qi * NL_IMP_STRIDE + jj + 1, l3, __ATOMIC_RELAXED, __HIP_MEMORY_SCOPE_WORKGROUP); }
                    }
            }
            if (MODE != 0) {
                bf16x8 pf[4];
#pragma unroll
                for (int s4 = 0; s4 < 4; ++s4) { u32x4 w;
#pragma unroll
                    for (int e = 0; e < 4; ++e) { const int r = 8 * (s4 & 1) + 2 * e; w[e] = (s4 >> 1) ? cvtpk(p1[r], p1[r + 1]) : cvtpk(p0[r], p0[r + 1]); }
                    pf[s4] = __builtin_bit_cast(bf16x8, w); }
                const int g4 = lane >> 4, sub = g4 & 1, i16 = lane & 15, qq = i16 >> 2, pp = i16 & 3;
#pragma unroll
                for (int dt = 0; dt < 2; ++dt)
#pragma unroll
                    for (int s4 = 0; s4 < 4; ++s4) {
                        const int row = 16 * s4 + 4 * hi + qq, ch = 4 * dt + 2 * sub + (pp >> 1);
                        const s16x4 lo = lds_tr(vb + off_v128(row, ch) + 8 * (pp & 1)), hh = lds_tr(vb + off_v128(row + 8, ch) + 8 * (pp & 1));
                        const bf16x8 vf = (bf16x8){lo[0], lo[1], lo[2], lo[3], hh[0], hh[1], hh[2], hh[3]};
                        O[dt] = MFMA32(vf, pf[s4], O[dt]);
                    }
            }
        }
        jA = jB; jB = jC; jC = jD; ++it;
    };
    while (jA < 128) {
        step(k0, v0); if (jA >= 128) break;
        step(k1, v1); if (jA >= 128) break;
        step(k2, v2);
    }
    __syncthreads();
}

__device__ __forceinline__ void nsa_unit(const Params& P, LAS unsigned char* lds, int u) {
    const int tid = opaque_tid(), lane = tid & 63, wid = tid >> 6, hi = lane >> 5, c = lane & 31;
    const int b = u >> 8, g = (u >> 7) & 1, qb = u & 127;
    const bf16_t* qg = (const bf16_t*)(P.ws + WS_Q); const bf16_t* kv = (const bf16_t*)(P.ws + WS_KV);
    const bf16_t* kcn = (const bf16_t*)(P.ws + WS_KC) + (size_t)(b * 2 + g) * 512 * 64; const bf16_t* vcc = (const bf16_t*)(P.ws + WS_VC) + (size_t)(b * 2 + g) * 512 * 64;
    const float* gates = (const float*)(P.ws + WS_GATES); bf16_t* mix = (bf16_t*)(P.ws + WS_MIX);
    LAS float* impw = (LAS float*)(lds + NL_IMP) + wid * 8 * NL_IMP_STRIDE;
    LAS unsigned long long* selm = (LAS unsigned long long*)(lds + NL_SELM);
    NsaLane L; L.qi = c >> 2; const int hh = c & 3, head = g * 4 + hh;
    L.t = qb * 64 + wid * 8 + L.qi; L.sl2 = exp2f(-(float)(head + 1)) * LOG2E; L.mlo = 0; L.mhi = 0;
    const size_t tok = (size_t)b * SEQ + L.t;
    bf16x8 qf[4];
#pragma unroll
    for (int ks = 0; ks < 4; ++ks) qf[ks] = *(const bf16x8*)(qg + tok * 512 + head * 64 + 16 * ks + 8 * hi);
    for (int i = lane; i < 8 * NL_IMP_STRIDE; i += 64) impw[i] = 0.f;
    const int ncmp = qb * 4 + 3 < 511 ? qb * 4 + 3 : 511;
    const int nblk = (ncmp + 63) >> 6;
    const unsigned long long cm = nblk >= 64 ? ~0ull : ((1ull << nblk) - 1ull);
    f32x16 O[2], Ot[2]; float lsum = 0.f;
    O[0] = f32x16{}; O[1] = f32x16{};
    nsa_pass<0>(lds, kcn, vcc, 64, cm, 0ull, qf, L, 1.f, lsum, O, impw);
    lsum += __shfl_xor(lsum, 32);
    const float invc = 1.0f / fmaxf(lsum, 1e-30f);
    float dummy = 0.f;
    nsa_pass<1>(lds, kcn, vcc, 64, cm, 0ull, qf, L, invc, dummy, O, impw);
    const float* gt = gates + tok * 24 + g * 12 + hh * 3;
    const float g0 = gt[0], g1 = gt[1], g2 = gt[2];
#pragma unroll
    for (int dt = 0; dt < 2; ++dt) Ot[dt] = O[dt] * g0;
    {
        const int ncausal = qb + 1;
        for (int qi = 0; qi < 8; ++qi) {
            unsigned long long lo, hi64;
            if (ncausal <= 16) { lo = (1ull << ncausal) - 1ull; hi64 = 0ull; }
            else {
                const int j0 = lane, j1 = lane + 64;
                const bool f0 = (j0 == 0) || (j0 == qb) || (j0 == qb - 1), f1 = (j1 == qb) || (j1 == qb - 1);
                const unsigned k0 = (j0 <= qb && !f0) ? (0x80000000u | (__float_as_uint(impw[qi * NL_IMP_STRIDE + j0]) & 0x7fffff80u) | (unsigned)j0) : 0u;
                const unsigned k1 = (j1 <= qb && !f1) ? (0x80000000u | (__float_as_uint(impw[qi * NL_IMP_STRIDE + j1]) & 0x7fffff80u) | (unsigned)j1) : 0u;
                const int needn = 13;
                unsigned th = 0u;
                for (int bit = 31; bit >= 0; --bit) { const unsigned cand = th | (1u << bit);
                    const int cnt = __popcll(__ballot(k0 >= cand)) + __popcll(__ballot(k1 >= cand));
                    if (cnt >= needn) th = cand; }
                lo = __ballot(f0 || (k0 >= th && k0 != 0u)); hi64 = __ballot(f1 || (k1 >= th && k1 != 0u));
            }
            if (lane == 0) { selm[(wid * 8 + qi) * 2] = lo; selm[(wid * 8 + qi) * 2 + 1] = hi64; }
        }
    }
    __syncthreads();
    unsigned long long ulo = selm[lane * 2], uhi = selm[lane * 2 + 1];
#pragma unroll
    for (int o = 1; o < 64; o <<= 1) { ulo |= __shfl_xor(ulo, o); uhi |= __shfl_xor(uhi, o); }
    L.mlo = selm[(wid * 8 + L.qi) * 2]; L.mhi = selm[(wid * 8 + L.qi) * 2 + 1];
    const bf16_t* kvb = kv + (size_t)b * SEQ * 768 + g * 64;
    O[0] = f32x16{}; O[1] = f32x16{}; lsum = 0.f;
    nsa_pass<2>(lds, kvb + 256, kvb + 384, 768, ulo, uhi, qf, L, 1.f, lsum, O, impw);
    lsum += __shfl_xor(lsum, 32);
    { const float sc = g1 / fmaxf(lsum, 1e-30f);
#pragma unroll
      for (int dt = 0; dt < 2; ++dt) Ot[dt] += O[dt] * sc; }
    {
        const int jlo = qb >= 8 ? qb - 8 : 0;
        unsigned long long wlo = 0ull, whi = 0ull;
        for (int jj = jlo; jj <= qb; ++jj) { if (jj < 64) wlo |= 1ull << jj; else whi |= 1ull << (jj - 64); }
        O[0] = f32x16{}; O[1] = f32x16{}; lsum = 0.f;
        nsa_pass<3>(lds, kvb + 512, kvb + 640, 768, wlo, whi, qf, L, 1.f, lsum, O, impw);
        lsum += __shfl_xor(lsum, 32);
        const float sc = g2 / fmaxf(lsum, 1e-30f);
#pragma unroll
        for (int dt = 0; dt < 2; ++dt) Ot[dt] += O[dt] * sc;
    }
    float ss = 0.f;
#pragma unroll
    for (int dt = 0; dt < 2; ++dt)
#pragma unroll
        for (int r = 0; r < 16; ++r) ss += Ot[dt][r] * Ot[dt][r];
    ss += __shfl_xor(ss, 32);
    const float rstd = rsqrtf(ss * (1.f / 64.f) + RMS_EPS);
#pragma unroll
    for (int dt = 0; dt < 2; ++dt)
#pragma unroll
        for (int r4 = 0; r4 < 4; ++r4) { const int d = 32 * dt + 8 * r4 + 4 * hi; const f32x4 w = *(const f32x4*)(P.attn_out_norm_w + head * 64 + d);
            u32x2 pk; pk.x = cvtpk(Ot[dt][4 * r4] * rstd * w.x, Ot[dt][4 * r4 + 1] * rstd * w.y); pk.y = cvtpk(Ot[dt][4 * r4 + 2] * rstd * w.z, Ot[dt][4 * r4 + 3] * rstd * w.w);
            *(u32x2*)(mix + tok * 1024 + head * 64 + d) = pk; }
    __syncthreads();
}


__device__ __forceinline__ int gu_hcol(int m0) { const int ni = (m0 >> 4) & 7; return 64 * (m0 >> 7) + 32 * (ni >> 2) + 8 * ((m0 & 15) >> 2) + 4 * ((ni >> 1) & 1); }
__device__ __forceinline__ int p2_col(int m0) { const int ni = (m0 >> 4) & 7; return 128 * (m0 >> 7) + 32 * (ni >> 1) + 8 * ((m0 & 15) >> 2) + 4 * (ni & 1); }
__device__ __forceinline__ void phase_cvt_small(const Params& P) {
    const int tid = threadIdx.x;
    {
        const int gt = blockIdx.x * NTHREADS + tid, NG = gridDim.x * NTHREADS;
        bf16_t* wo = (bf16_t*)(P.ws + WS_WOUT); bf16_t* wrs = (bf16_t*)(P.ws + WS_WRS); bf16_t* wsd = (bf16_t*)(P.ws + WS_WSD);
        for (int i = gt; i < 1024 * 128; i += NG) { const f32x4 a = *(const f32x4*)(P.w_out + (size_t)i * 8), b2 = *(const f32x4*)(P.w_out + (size_t)i * 8 + 4);
            *(u32x4*)(wo + (size_t)i * 8) = (u32x4){cvtpk(a.x, a.y), cvtpk(a.z, a.w), cvtpk(b2.x, b2.y), cvtpk(b2.z, b2.w)}; }
        for (int i = gt; i < 256 * 128; i += NG) { const int k = i >> 7, m0 = (i & 127) * 8; const float* s = P.sh_wd + (size_t)k * 1024 + (m0 & ~255) + p2_col(m0 & 255);
            const f32x4 a = *(const f32x4*)s, b2 = *(const f32x4*)(s + 8);
            *(u32x4*)(wsd + (size_t)i * 8) = (u32x4){cvtpk(a.x, a.y), cvtpk(a.z, a.w), cvtpk(b2.x, b2.y), cvtpk(b2.z, b2.w)}; }
        for (int i = gt; i < 1024 * 96; i += NG) { const int k = i / 96, c8 = (i % 96) * 8;
            const float* s; int d2 = 4;
            if (c8 < 256) s = P.router_w + (size_t)k * 256 + c8;
            else { const int cc = c8 - 256, t = cc >> 8; s = ((cc & 16) ? P.sh_wu : P.sh_wg) + (size_t)k * 256 + t * 128 + gu_hcol(cc & 255); d2 = 8; }
            const f32x4 a = *(const f32x4*)s, b2 = *(const f32x4*)(s + d2);
            *(u32x4*)(wrs + (size_t)k * 768 + c8) = (u32x4){cvtpk(a.x, a.y), cvtpk(a.z, a.w), cvtpk(b2.x, b2.y), cvtpk(b2.z, b2.w)}; }
    }
}

__device__ __forceinline__ void route_token(const Params& P, int t, int lane) {
    const float* scores = (const float*)(P.ws + WS_SCORES) + (size_t)t * 256;
    const f32x4 s4 = *(const f32x4*)(scores + 4 * lane); const f32x4 b4 = *(const f32x4*)(P.router_bias + 4 * lane);
    float sc[4] = {s4.x, s4.y, s4.z, s4.w};
    float bs[4] = {s4.x + b4.x, s4.y + b4.y, s4.z + b4.z, s4.w + b4.w};
    float m1 = fmaxf(bs[0], bs[1]), m2 = fminf(bs[0], bs[1]);
    { const float v = bs[2]; const float n1 = fmaxf(m1, v); m2 = fmaxf(fminf(m1, v), m2); m1 = n1; }
    { const float v = bs[3]; const float n1 = fmaxf(m1, v); m2 = fmaxf(fminf(m1, v), m2); m1 = n1; }
#pragma unroll
    for (int o = 1; o < 8; o <<= 1) { const float o1 = __shfl_xor(m1, o), o2 = __shfl_xor(m2, o); const float n1 = fmaxf(m1, o1); m2 = fmaxf(fminf(m1, o1), fmaxf(m2, o2)); m1 = n1; }
    const float gs = m1 + m2;
    const int grp = lane >> 3;
    int rank = 0;
#pragma unroll
    for (int g2 = 0; g2 < 8; ++g2) { const float og = __shfl(gs, g2 * 8); rank += (og > gs || (og == gs && g2 < grp)) ? 1 : 0; }
    const bool gsel = rank < 4;
    float mv[4];
#pragma unroll
    for (int i = 0; i < 4; ++i) mv[i] = gsel ? bs[i] : -INFINITY;
    int myidx = -1; float myw = 0.f; float wsum = 0.f;
#pragma unroll 1
    for (int k = 0; k < 8; ++k) {
        float bv = mv[0]; int bi = 4 * lane;
#pragma unroll
        for (int i = 1; i < 4; ++i) if (mv[i] > bv) { bv = mv[i]; bi = 4 * lane + i; }
#pragma unroll
        for (int o = 1; o < 64; o <<= 1) { const float ov = __shfl_xor(bv, o); const int oi = __shfl_xor(bi, o); if (ov > bv || (ov == bv && oi < bi)) { bv = ov; bi = oi; } }
        const int wl = bi >> 2, wc = bi & 3;
        const float mine = wc == 0 ? sc[0] : (wc == 1 ? sc[1] : (wc == 2 ? sc[2] : sc[3]));
        const float wv = __shfl(mine, wl);
        wsum += wv;
        if (lane == k) { myidx = bi; myw = wv; }
        if (lane == wl) {
#pragma unroll
            for (int i = 0; i < 4; ++i) if (i == wc) mv[i] = -INFINITY; }
    }
    if (lane < 8) {
        int* cnt = (int*)(P.ws + WS_CTL + CTL_CNT);
        const int pos = atomicAdd(cnt + myidx, 1);
        if (pos < BCAP) ((int*)(P.ws + WS_BUCKET))[(size_t)myidx * BCAP + pos] = t * 8 + lane;
        ((float*)(P.ws + WS_RW))[(size_t)t * 8 + lane] = myw / wsum * 2.5f;
    }
}


__device__ __forceinline__ void phase_p4a(const Params& P, LAS unsigned char* lds) {
    typedef Gemm3 G;
    const int tid = opaque_tid(), lane = tid & 63, wid = tid >> 6, wm = wid >> 1, wn = wid & 1, fr = lane & 15, fq = lane >> 4;
    struct F { const Params& P;
        __device__ __forceinline__ void ptrs(int seg, const bf16_t* (&aptr)[2], const bf16_t* (&bptr)[2]) const {
            const int tid = opaque_tid(), lane = tid & 63, wid = tid >> 6, wm = wid >> 1, wn = wid & 1, fr = lane & 15, fq = lane >> 4, c8 = 8 * (tid & 31); (void)wm; (void)wn; (void)fr; (void)fq; (void)c8;
            const int u = blockIdx.x + seg * gridDim.x, rt = u >> 2, ct = u & 3;
            const bf16_t* mix = (const bf16_t*)(P.ws + WS_MIX); const bf16_t* wo = (const bf16_t*)(P.ws + WS_WOUT);
#pragma unroll
            for (int i = 0; i < 2; ++i) { const int row = G::a_row(i, wid, lane); aptr[i] = mix + (size_t)(rt * 256 + row) * 1024 + G::a_chunk(row, lane) * 8;
                const int k = G::b_k(i, wid, lane); bptr[i] = wo + (size_t)k * 1024 + ct * 256 + G::b_n(k, lane); } }
        __device__ __forceinline__ void epi(int seg, f32x4 (&acc)[4][8]) const {
            const int tid = opaque_tid(), lane = tid & 63, wid = tid >> 6, wm = wid >> 1, wn = wid & 1, fr = lane & 15, fq = lane >> 4, c8 = 8 * (tid & 31); (void)wm; (void)wn; (void)fr; (void)fq; (void)c8;
            const int u = blockIdx.x + seg * gridDim.x, rt = u >> 2, ct = u & 3, b = (rt * 256) / SEQ;
            const float* mod = (const float*)(P.ws + WS_MOD) + b * 6144; float* ssp = (float*)(P.ws + WS_SS);
#pragma unroll
            for (int mi = 0; mi < 4; ++mi) { const size_t m = (size_t)(rt * 256 + wm * 64 + mi * 16 + fr); float ss = 0.f;
#pragma unroll
                for (int ni = 0; ni < 8; ++ni) { const int col = ct * 256 + wn * 128 + ni * 16 + 4 * fq;
                    const f32x4 xv = *(const f32x4*)(P.x + m * 1024 + col), gv = *(const f32x4*)(mod + 2048 + col); const f32x4 a = acc[mi][ni];
                    f32x4 o; o.x = xv.x + gv.x * a.x; o.y = xv.y + gv.y * a.y; o.z = xv.z + gv.z * a.z; o.w = xv.w + gv.w * a.w;
                    *(f32x4*)(P.out + m * 1024 + col) = o; ss += (o.x * o.x + o.y * o.y) + (o.z * o.z + o.w * o.w); if (ni & 1) asm volatile("" ::: "memory"); }
                ss += __shfl_xor(ss, 16); ss += __shfl_xor(ss, 32);
                if (fq == 0) ssp[m * 8 + ct * 2 + wn] = ss; } }
    } f{P};
    const int nu = (128 * 4 - (int)blockIdx.x + (int)gridDim.x - 1) / (int)gridDim.x;
    if (nu > 0) G::run_stream(f, nu, 32, 32, (size_t)32 * 1024, lds);
}
__device__ __forceinline__ void phase_p4b(const Params& P) {
    const int lane = threadIdx.x & 63, gw = blockIdx.x * (NTHREADS / 64) + (threadIdx.x >> 6), NGW = gridDim.x * (NTHREADS / 64);
    const float* ssp = (const float*)(P.ws + WS_SS); bf16_t* h2 = (bf16_t*)(P.ws + WS_H);
    for (int m = gw; m < T; m += NGW) {
        const float* mod = (const float*)(P.ws + WS_MOD) + (m / SEQ) * 6144;
        const f32x4 s0 = *(const f32x4*)(ssp + (size_t)m * 8), s1 = *(const f32x4*)(ssp + (size_t)m * 8 + 4);
        const float rstd = rsqrtf(((s0.x + s0.y) + (s0.z + s0.w) + (s1.x + s1.y) + (s1.z + s1.w)) * (1.f / 1024.f) + RMS_EPS);
#pragma unroll
        for (int j = 0; j < 4; ++j) { const int col = (lane + 64 * j) * 4;
            const f32x4 v = *(const f32x4*)(P.out + (size_t)m * 1024 + col), wv = *(const f32x4*)(P.norm2_w + col), scv = *(const f32x4*)(mod + 4096 + col), shv = *(const f32x4*)(mod + 3072 + col);
            const float r0 = v.x * rstd * wv.x * (1.f + scv.x) + shv.x, r1 = v.y * rstd * wv.y * (1.f + scv.y) + shv.y, r2 = v.z * rstd * wv.z * (1.f + scv.z) + shv.z, r3 = v.w * rstd * wv.w * (1.f + scv.w) + shv.w;
            u32x2 pk; pk.x = cvtpk(r0, r1); pk.y = cvtpk(r2, r3);
            *(u32x2*)(h2 + (size_t)m * 1024 + col) = pk;
            int q8 = __builtin_amdgcn_cvt_pk_fp8_f32(r0, r1, 0, false); q8 = __builtin_amdgcn_cvt_pk_fp8_f32(r2, r3, q8, true);
            *(int*)((unsigned char*)(P.ws + WS_H2Q) + (size_t)m * 1024 + col) = q8; }
    }
}
__device__ __forceinline__ void phase_p4c(const Params& P, LAS unsigned char* lds) {
    typedef Gemm3 G;
    const int tid = opaque_tid(), lane = tid & 63, wid = tid >> 6, wm = wid >> 1, wn = wid & 1, fr = lane & 15, fq = lane >> 4;
    struct F { const Params& P;
        __device__ __forceinline__ void ptrs(int seg, const bf16_t* (&aptr)[2], const bf16_t* (&bptr)[2]) const {
            const int tid = opaque_tid(), lane = tid & 63, wid = tid >> 6, wm = wid >> 1, wn = wid & 1, fr = lane & 15, fq = lane >> 4, c8 = 8 * (tid & 31); (void)wm; (void)wn; (void)fr; (void)fq; (void)c8;
            const int u = blockIdx.x + seg * gridDim.x, rt = u / 3, ct = u % 3;
            const bf16_t* h2 = (const bf16_t*)(P.ws + WS_H); const bf16_t* wrs = (const bf16_t*)(P.ws + WS_WRS);
#pragma unroll
            for (int i = 0; i < 2; ++i) { const int row = G::a_row(i, wid, lane); aptr[i] = h2 + (size_t)(rt * 256 + row) * 1024 + G::a_chunk(row, lane) * 8;
                const int k = G::b_k(i, wid, lane); bptr[i] = wrs + (size_t)k * 768 + ct * 256 + G::b_n(k, lane); } }
        __device__ __forceinline__ void epi(int seg, f32x4 (&acc)[4][8]) const {
            const int tid = opaque_tid(), lane = tid & 63, wid = tid >> 6, wm = wid >> 1, wn = wid & 1, fr = lane & 15, fq = lane >> 4, c8 = 8 * (tid & 31); (void)wm; (void)wn; (void)fr; (void)fq; (void)c8;
            const int u = blockIdx.x + seg * gridDim.x, rt = u / 3, ct = u % 3;
            float* scores = (float*)(P.ws + WS_SCORES); bf16_t* hidS = (bf16_t*)(P.ws + WS_HIDS);
#pragma unroll
            for (int mi = 0; mi < 4; ++mi) { const size_t m = (size_t)(rt * 256 + wm * 64 + mi * 16 + fr);
                if (ct == 0) {
#pragma unroll
                    for (int ni = 0; ni < 8; ++ni) { const f32x4 a = acc[mi][ni];
                        *(f32x4*)(scores + m * 256 + wn * 128 + ni * 16 + 4 * fq) = (f32x4){sigmoidf_(a.x), sigmoidf_(a.y), sigmoidf_(a.z), sigmoidf_(a.w)}; }
                } else {
#pragma unroll
                    for (int j2 = 0; j2 < 2; ++j2) { const f32x4 g = acc[mi][4 * j2], uu = acc[mi][4 * j2 + 1], g2 = acc[mi][4 * j2 + 2], u2 = acc[mi][4 * j2 + 3];
                        u32x4 pk; pk.x = cvtpk(siluf_(g.x) * uu.x, siluf_(g.y) * uu.y); pk.y = cvtpk(siluf_(g.z) * uu.z, siluf_(g.w) * uu.w);
                        pk.z = cvtpk(siluf_(g2.x) * u2.x, siluf_(g2.y) * u2.y); pk.w = cvtpk(siluf_(g2.z) * u2.z, siluf_(g2.w) * u2.w);
                        *(u32x4*)(hidS + m * 256 + (ct - 1) * 128 + wn * 64 + j2 * 32 + 8 * fq) = pk; }
                } } }
    } f{P};
    const int nu = (128 * 3 - (int)blockIdx.x + (int)gridDim.x - 1) / (int)gridDim.x;
    if (nu > 0) G::run_stream(f, nu, 32, 32, (size_t)32 * 768, lds);
}
__device__ __forceinline__ void phase_route(const Params& P) {
    const int tid = opaque_tid(), lane = tid & 63, gw = blockIdx.x * (NTHREADS / 64) + (tid >> 6), NGW = gridDim.x * (NTHREADS / 64);
    for (int t = gw; t < T; t += NGW) route_token(P, t, lane);
}
__device__ __forceinline__ void phase_p4d(const Params& P, LAS unsigned char* lds) {
    typedef Gemm3 G;
    const int tid = opaque_tid(), lane = tid & 63, wid = tid >> 6, wm = wid >> 1, wn = wid & 1, fr = lane & 15, fq = lane >> 4;
    struct F { const Params& P;
        __device__ __forceinline__ void ptrs(int seg, const bf16_t* (&aptr)[2], const bf16_t* (&bptr)[2]) const {
            const int tid = opaque_tid(), lane = tid & 63, wid = tid >> 6, wm = wid >> 1, wn = wid & 1, fr = lane & 15, fq = lane >> 4, c8 = 8 * (tid & 31); (void)wm; (void)wn; (void)fr; (void)fq; (void)c8;
            const int u = blockIdx.x + seg * gridDim.x, rt = u >> 2, ct = u & 3;
            const bf16_t* hidS = (const bf16_t*)(P.ws + WS_HIDS); const bf16_t* wsd = (const bf16_t*)(P.ws + WS_WSD);
#pragma unroll
            for (int i = 0; i < 2; ++i) { const int row = G::a_row(i, wid, lane); aptr[i] = hidS + (size_t)(rt * 256 + row) * 256 + G::a_chunk(row, lane) * 8;
                const int k = G::b_k(i, wid, lane); bptr[i] = wsd + (size_t)k * 1024 + ct * 256 + G::b_n(k, lane); } }
        __device__ __forceinline__ void epi(int seg, f32x4 (&acc)[4][8]) const {
            const int tid = opaque_tid(), lane = tid & 63, wid = tid >> 6, wm = wid >> 1, wn = wid & 1, fr = lane & 15, fq = lane >> 4, c8 = 8 * (tid & 31); (void)wm; (void)wn; (void)fr; (void)fq; (void)c8;
            const int u = blockIdx.x + seg * gridDim.x, rt = u >> 2, ct = u & 3;
            bf16_t* ysh = (bf16_t*)(P.ws + WS_YSH);
#pragma unroll
            for (int mi = 0; mi < 4; ++mi) { const size_t m = (size_t)(rt * 256 + wm * 64 + mi * 16 + fr);
#pragma unroll
                for (int j = 0; j < 4; ++j) { const int col = ct * 256 + wn * 128 + j * 32 + 8 * fq; const f32x4 a = acc[mi][2 * j], c = acc[mi][2 * j + 1];
                    *(u32x4*)(ysh + m * 1024 + col) = (u32x4){cvtpk(a.x, a.y), cvtpk(a.z, a.w), cvtpk(c.x, c.y), cvtpk(c.z, c.w)}; } } }
    } f{P};
    const int nu = (128 * 4 - (int)blockIdx.x + (int)gridDim.x - 1) / (int)gridDim.x;
    if (nu > 0) G::run_stream(f, nu, 8, 32, (size_t)32 * 1024, lds);
}

__device__ __forceinline__ void phase_expert_cvt(const Params& P) {
    const size_t gt = (size_t)blockIdx.x * NTHREADS + threadIdx.x, NG = (size_t)gridDim.x * NTHREADS;
    bf16_t* wgu = (bf16_t*)(P.ws + WS_WBGU); bf16_t* wd = (bf16_t*)(P.ws + WS_WBD);
    for (size_t i = gt; i < (size_t)256 * 1024 * 64; i += NG) {
        const size_t ek = i >> 6; const int c8 = (int)(i & 63) * 8, t = c8 >> 8;
        const float* s = ((c8 & 16) ? P.exp_wu : P.exp_wg) + ek * 256 + t * 128 + gu_hcol(c8 & 255);
        const f32x4 a = __builtin_nontemporal_load((const f32x4*)s), b2 = __builtin_nontemporal_load((const f32x4*)(s + 8));
        *(u32x4*)(wgu + ek * 512 + c8) = (u32x4){cvtpk(a.x, a.y), cvtpk(a.z, a.w), cvtpk(b2.x, b2.y), cvtpk(b2.z, b2.w)}; }
    for (size_t i = gt; i < (size_t)256 * 256 * 128; i += NG) {
        const size_t ek = i >> 7; const int m0 = (int)(i & 127) * 8, tl = m0 & 255, tile = m0 >> 8;
        const int wnn = tl >> 7, nii = (tl >> 4) & 7, n0 = tl & 15;
        const int ca = tile * 256 + wnn * 128 + 64 * (nii >> 2) + 16 * (n0 >> 2) + 4 * (nii & 3);
        const f32x4 a = __builtin_nontemporal_load((const f32x4*)(P.exp_wd + ek * 1024 + ca)), b2 = __builtin_nontemporal_load((const f32x4*)(P.exp_wd + ek * 1024 + ca + 16));
        *(u32x4*)(wd + ek * 1024 + m0) = (u32x4){cvtpk(a.x, a.y), cvtpk(a.z, a.w), cvtpk(b2.x, b2.y), cvtpk(b2.z, b2.w)}; }
}

constexpr int P6_TILES = 128 * 1024, P6_PRE = P6_TILES + 1024, P6_PAIR = P6_PRE + 1040, P6_W = P6_PAIR + 1024;
__device__ __forceinline__ void phase_experts(const Params& P, LAS unsigned char* lds) {
    typedef Gemm3 G;
    const int tid = opaque_tid(), lane = tid & 63, wid = tid >> 6, wm = wid >> 1, wn = wid & 1, fr = lane & 15, fq = lane >> 4;
    const int* cnt = (const int*)(P.ws + WS_CTL + CTL_CNT); const int* bucket = (const int*)(P.ws + WS_BUCKET); const float* rw = (const float*)(P.ws + WS_RW);
    const bf16_t* h2 = (const bf16_t*)(P.ws + WS_H); bf16_t* hidR = (bf16_t*)(P.ws + WS_HIDR) + (size_t)blockIdx.x * 256 * 256; unsigned char* y = (unsigned char*)(P.ws + WS_Y);
    LAS int* tiles = (LAS int*)(lds + P6_TILES); LAS int* pre = (LAS int*)(lds + P6_PRE); LAS int* pairs = (LAS int*)(lds + P6_PAIR); LAS float* wts = (LAS float*)(lds + P6_W);
    const int nx = (gridDim.x % 8 == 0) ? 8 : 1, xl = blockIdx.x % nx, li = blockIdx.x / nx, nloc = gridDim.x / nx, nek = 256 / nx;
    if (tid < nek) { const int c_ = cnt[xl + nx * tid]; tiles[tid] = ((c_ < BCAP ? c_ : BCAP) + 255) >> 8; }
    __syncthreads();
    if (tid < nek) { int s = 0; for (int i = 0; i < tid; ++i) s += tiles[i]; pre[tid] = s; if (tid == nek - 1) pre[nek] = s + tiles[nek - 1]; }
    __syncthreads();
    const int total = pre[nek];
    const int c8 = 8 * (tid & 31), u16 = c8 >> 4;
    for (int u = li; u < total; u += nloc) {
        int lo = 0, hi = nek - 1;
        while (lo < hi) { const int mid = (lo + hi + 1) >> 1; if (pre[mid] <= u) lo = mid; else hi = mid - 1; }
        const int e = xl + nx * lo, tile = u - pre[lo], n = cnt[e] < BCAP ? cnt[e] : BCAP, rows = (n - tile * 256) < 256 ? (n - tile * 256) : 256;
        if (tid < 256) { const int r = tid < rows ? tid : 0; const int pr = bucket[(size_t)e * BCAP + tile * 256 + r]; pairs[tid] = pr; wts[tid] = tid < rows ? rw[pr] : 0.f; }
        __syncthreads();
        {
            struct GU { const bf16_t* h2; LAS int* pairs; const bf16_t* wgu; bf16_t* hidR;
                __device__ __forceinline__ void ptrs(int t, const bf16_t* (&aptr)[2], const bf16_t* (&bptr)[2]) const {
                    const int tid = opaque_tid(), lane = tid & 63, wid = tid >> 6, wm = wid >> 1, wn = wid & 1, fr = lane & 15, fq = lane >> 4, c8 = 8 * (tid & 31); (void)wm; (void)wn; (void)fr; (void)fq; (void)c8;
#pragma unroll
                    for (int i = 0; i < 2; ++i) { const int row = G::a_row(i, wid, lane); aptr[i] = h2 + (size_t)(pairs[row] >> 3) * 1024 + G::a_chunk(row, lane) * 8;
                        const int k = G::b_k(i, wid, lane); bptr[i] = wgu + (size_t)k * 512 + t * 256 + G::b_n(k, lane); } }
                __device__ __forceinline__ void epi(int t, f32x4 (&acc)[4][8]) const {
                    const int tid = opaque_tid(), lane = tid & 63, wid = tid >> 6, wm = wid >> 1, wn = wid & 1, fr = lane & 15, fq = lane >> 4, c8 = 8 * (tid & 31); (void)wm; (void)wn; (void)fr; (void)fq; (void)c8;
#pragma unroll
                    for (int mi = 0; mi < 4; ++mi) { const int rl = wm * 64 + mi * 16 + fr;
#pragma unroll
                        for (int j2 = 0; j2 < 2; ++j2) { const f32x4 g = acc[mi][4 * j2], uu = acc[mi][4 * j2 + 1], g2 = acc[mi][4 * j2 + 2], u2 = acc[mi][4 * j2 + 3];
                            u32x4 pk; pk.x = cvtpk(siluf_(g.x) * uu.x, siluf_(g.y) * uu.y); pk.y = cvtpk(siluf_(g.z) * uu.z, siluf_(g.w) * uu.w);
                            pk.z = cvtpk(siluf_(g2.x) * u2.x, siluf_(g2.y) * u2.y); pk.w = cvtpk(siluf_(g2.z) * u2.z, siluf_(g2.w) * u2.w);
                            *(u32x4*)(hidR + rl * 256 + t * 128 + wn * 64 + j2 * 32 + 8 * fq) = pk; } } }
            } f{h2, pairs, (const bf16_t*)(P.ws + WS_WBGU) + (size_t)e * 1024 * 512, hidR};
            G::run_stream(f, 2, 32, 32, (size_t)32 * 512, lds);
        }
        __syncthreads();
        {
            struct DN { bf16_t* hidR; const bf16_t* wd; unsigned char* y; LAS int* pairs; LAS float* wts; int rows;
                __device__ __forceinline__ void ptrs(int ct, const bf16_t* (&aptr)[2], const bf16_t* (&bptr)[2]) const {
                    const int tid = opaque_tid(), lane = tid & 63, wid = tid >> 6, wm = wid >> 1, wn = wid & 1, fr = lane & 15, fq = lane >> 4, c8 = 8 * (tid & 31); (void)wm; (void)wn; (void)fr; (void)fq; (void)c8;
#pragma unroll
                    for (int i = 0; i < 2; ++i) { const int row = G::a_row(i, wid, lane); aptr[i] = hidR + (size_t)row * 256 + G::a_chunk(row, lane) * 8;
                        const int k = G::b_k(i, wid, lane); bptr[i] = wd + (size_t)k * 1024 + ct * 256 + G::b_n(k, lane); } }
                __device__ __forceinline__ void epi(int ct, f32x4 (&acc)[4][8]) const {
                    const int tid = opaque_tid(), lane = tid & 63, wid = tid >> 6, wm = wid >> 1, wn = wid & 1, fr = lane & 15, fq = lane >> 4, c8 = 8 * (tid & 31); (void)wm; (void)wn; (void)fr; (void)fq; (void)c8;
#pragma unroll
                    for (int mi = 0; mi < 4; ++mi) { const int rl = wm * 64 + mi * 16 + fr; const float wgt = wts[rl]; const size_t pr = (size_t)pairs[rl];
                        if (rl < rows) {
#pragma unroll
                            for (int j2 = 0; j2 < 2; ++j2) { const int col = ct * 256 + wn * 128 + 64 * j2 + 16 * fq; const float sc_ = wgt * Y_SCALE; u32x4 w;
#pragma unroll
                                for (int b2 = 0; b2 < 4; ++b2) { const f32x4 a = acc[mi][4 * j2 + b2] * sc_;
                                    int pk = __builtin_amdgcn_cvt_pk_fp8_f32(a.x, a.y, 0, false); pk = __builtin_amdgcn_cvt_pk_fp8_f32(a.z, a.w, pk, true); w[b2] = (unsigned)pk; }
                                *(u32x4*)(y + pr * 1024 + col) = w; } } } }
            } f{hidR, (const bf16_t*)(P.ws + WS_WBD) + (size_t)e * 256 * 1024, y, pairs, wts, rows};
            G::run_stream(f, 4, 8, 32, (size_t)32 * 1024, lds);
        }
        __syncthreads();
    }
}


struct Gemm8 {
    static constexpr int A_BYTES = 16384, STAGE = 32768;
    static __device__ __forceinline__ int t_row(int i, int w, int lane) { return (i * 8 + w) * 16 + (lane >> 2); }
    static __device__ __forceinline__ int t_chunk(int row, int lane) { return (lane & 3) ^ ((row >> 1) & 3); }
    static __device__ __forceinline__ int w_col(int i) { return 16 * ((i >> 2) & 1) + 4 * (i >> 3) + (i & 3); }
    template <class F> static __device__ __forceinline__ void run_stream(F& f, int NSEG, int KT, LAS unsigned char* lds) {
        const int tid = opaque_tid(), lane = tid & 63, wid = tid >> 6, wm = wid >> 1, wn = wid & 1, l31 = lane & 31, hi = lane >> 5;
        const int wu = __builtin_amdgcn_readfirstlane(wid);
        f32x16 acc[2][4];
#pragma unroll
        for (int jt = 0; jt < 2; ++jt)
#pragma unroll
            for (int it = 0; it < 4; ++it)
#pragma unroll
                for (int r = 0; r < 16; ++r) acc[jt][it][r] = 0.f;
        const int sw = (l31 >> 1) & 3;
        const int t_rd0 = (wm * 64 + l31) * 64 + (((2 * hi) ^ sw) << 4), t_rd1 = (wm * 64 + l31) * 64 + (((2 * hi + 1) ^ sw) << 4);
        const int w_rd0 = A_BYTES + (wn * 128 + l31) * 64 + (((2 * hi) ^ sw) << 4), w_rd1 = A_BYTES + (wn * 128 + l31) * 64 + (((2 * hi + 1) ^ sw) << 4);
        const unsigned lds0 = (unsigned)(uintptr_t)lds + (unsigned)wu * 1024u;
        const unsigned char* aptr[2]; const unsigned char* wptr[2];
        const int total = NSEG * KT;
        int lseg = 0, lkt = 0, lg = 0;
        auto issue = [&]() {
            const unsigned base = (unsigned)__builtin_amdgcn_readfirstlane((int)(lds0 + (unsigned)(lg & 3) * STAGE));
#pragma unroll
            for (int i = 0; i < 2; ++i) glds16(aptr[i] + lkt * 64, base + i * 8192);
#pragma unroll
            for (int i = 0; i < 2; ++i) glds16(wptr[i] + lkt * 64, base + A_BYTES + i * 8192);
            ++lg; if (++lkt == KT) { lkt = 0; ++lseg; if (lseg < NSEG) f.ptrs(lseg, aptr, wptr); }
        };
        const int grp = wu >> 2;
        auto bar = [&]() { asm volatile("s_waitcnt lgkmcnt(0)" ::: "memory"); __builtin_amdgcn_s_barrier(); asm volatile("" ::: "memory"); };
        f.ptrs(0, aptr, wptr);
        asm volatile("s_waitcnt vmcnt(0)" ::: "memory");
        issue(); if (total > 1) issue(); if (total > 2) issue();
        if (total > 2) asm volatile("s_waitcnt vmcnt(8)" ::: "memory"); else if (total > 1) asm volatile("s_waitcnt vmcnt(4)" ::: "memory"); else asm volatile("s_waitcnt vmcnt(0)" ::: "memory");
        bar();
        if (grp) bar();
        int cseg = 0, ckt = 0;
#pragma unroll 1
        for (int g = 0; g < total; ++g) {
            if (lg < total) issue();
            const LAS unsigned char* base = lds + (g & 3) * STAGE;
            i32x8 tf[2], wf[4];
#pragma unroll
            for (int jt = 0; jt < 2; ++jt) { const u32x4 lo = *(const LAS u32x4*)(base + t_rd0 + jt * 2048), h4 = *(const LAS u32x4*)(base + t_rd1 + jt * 2048);
                tf[jt] = (i32x8){(int)lo.x, (int)lo.y, (int)lo.z, (int)lo.w, (int)h4.x, (int)h4.y, (int)h4.z, (int)h4.w}; }
#pragma unroll
            for (int it = 0; it < 4; ++it) { const u32x4 lo = *(const LAS u32x4*)(base + w_rd0 + it * 2048), h4 = *(const LAS u32x4*)(base + w_rd1 + it * 2048);
                wf[it] = (i32x8){(int)lo.x, (int)lo.y, (int)lo.z, (int)lo.w, (int)h4.x, (int)h4.y, (int)h4.z, (int)h4.w}; }
            { const int rem = total - 2 - g;
              if (rem >= 2) asm volatile("s_waitcnt vmcnt(8)" ::: "memory"); else if (rem == 1) asm volatile("s_waitcnt vmcnt(4)" ::: "memory"); else asm volatile("s_waitcnt vmcnt(0)" ::: "memory"); }
            bar();
            __builtin_amdgcn_sched_barrier(0);
#pragma unroll
            for (int it = 0; it < 4; ++it)
#pragma unroll
                for (int jt = 0; jt < 2; ++jt) acc[jt][it] = __builtin_amdgcn_mfma_scale_f32_32x32x64_f8f6f4(wf[it], tf[jt], acc[jt][it], 0, 0, 0, 0, 0, 0);
            __builtin_amdgcn_sched_barrier(0);
            bar();
            if (++ckt == KT) {
                if (!grp) bar();
                f.epi(cseg, acc);
#pragma unroll
                for (int jt = 0; jt < 2; ++jt)
#pragma unroll
                    for (int it = 0; it < 4; ++it)
#pragma unroll
                        for (int r = 0; r < 16; ++r) acc[jt][it][r] = 0.f;
                ckt = 0; ++cseg;
                if (grp) bar();
            }
        }
        if (!grp) bar();
    }
};
__device__ __forceinline__ unsigned pk4_fp8(float a, float b, float c, float d) { int pk = __builtin_amdgcn_cvt_pk_fp8_f32(a, b, 0, false); pk = __builtin_amdgcn_cvt_pk_fp8_f32(c, d, pk, true); return (unsigned)pk; }

__device__ __forceinline__ void phase_expert_cvt8(const Params& P) {
    const int tid = opaque_tid(), lane = tid & 63, gw = blockIdx.x * (NTHREADS / 64) + (tid >> 6), NGW = gridDim.x * (NTHREADS / 64);
    unsigned char* wgu = (unsigned char*)(P.ws + WS_W8GU); unsigned char* wd = (unsigned char*)(P.ws + WS_W8D);
    for (int u = gw; u < 256 * 8 * 8; u += NGW) {
        const int rg = u & 7, kb = (u >> 3) & 7, e = u >> 6;
        const int q = rg * 64 + lane, t = q >> 8, ql = q & 255, wnn = ql >> 7, it = (ql >> 5) & 3, i = ql & 31;
        const int h = t * 128 + wnn * 64 + (it >> 1) * 32 + Gemm8::w_col(i);
        const float* s = ((it & 1) ? P.exp_wu : P.exp_wg) + (size_t)e * 1024 * 256 + (size_t)(kb * 128) * 256 + h;
        unsigned char* o = wgu + ((size_t)e * 512 + q) * 1024 + kb * 128;
        { float v[128];
#pragma unroll
            for (int j = 0; j < 128; ++j) v[j] = __builtin_nontemporal_load(s + (size_t)j * 256);
#pragma unroll
            for (int j = 0; j < 8; ++j) { const float c_ = W8_GU_SCALE; u32x4 w;
                w.x = pk4_fp8(v[16 * j] * c_, v[16 * j + 1] * c_, v[16 * j + 2] * c_, v[16 * j + 3] * c_); w.y = pk4_fp8(v[16 * j + 4] * c_, v[16 * j + 5] * c_, v[16 * j + 6] * c_, v[16 * j + 7] * c_);
                w.z = pk4_fp8(v[16 * j + 8] * c_, v[16 * j + 9] * c_, v[16 * j + 10] * c_, v[16 * j + 11] * c_); w.w = pk4_fp8(v[16 * j + 12] * c_, v[16 * j + 13] * c_, v[16 * j + 14] * c_, v[16 * j + 15] * c_);
                *(u32x4*)(o + j * 16) = w; } }
    }
    for (int u = gw; u < 256 * 2 * 16; u += NGW) {
        const int rg = u & 15, kb = (u >> 4) & 1, e = u >> 5;
        const int q = rg * 64 + lane, i = q & 31;
        const int col = (q & ~31) + Gemm8::w_col(i);
        const float* s = P.exp_wd + (size_t)e * 256 * 1024 + (size_t)(kb * 128) * 1024 + col;
        unsigned char* o = wd + ((size_t)e * 1024 + q) * 256 + kb * 128;
        { float v[128];
#pragma unroll
            for (int j = 0; j < 128; ++j) v[j] = __builtin_nontemporal_load(s + (size_t)j * 1024);
#pragma unroll
            for (int j = 0; j < 8; ++j) { const float c_ = W8_D_SCALE; u32x4 w;
                w.x = pk4_fp8(v[16 * j] * c_, v[16 * j + 1] * c_, v[16 * j + 2] * c_, v[16 * j + 3] * c_); w.y = pk4_fp8(v[16 * j + 4] * c_, v[16 * j + 5] * c_, v[16 * j + 6] * c_, v[16 * j + 7] * c_);
                w.z = pk4_fp8(v[16 * j + 8] * c_, v[16 * j + 9] * c_, v[16 * j + 10] * c_, v[16 * j + 11] * c_); w.w = pk4_fp8(v[16 * j + 12] * c_, v[16 * j + 13] * c_, v[16 * j + 14] * c_, v[16 * j + 15] * c_);
                *(u32x4*)(o + j * 16) = w; } }
    }
}

template <int PM> __device__ __forceinline__ void phase_experts8(const Params& P, LAS unsigned char* lds) {
    typedef Gemm8 G;
    const int tid = opaque_tid();
    const int* cnt = (const int*)(P.ws + WS_CTL + CTL_CNT); const int* bucket = (const int*)(P.ws + WS_BUCKET); const float* rw = (const float*)(P.ws + WS_RW);
    const unsigned char* h2q = (const unsigned char*)(P.ws + WS_H2Q); unsigned char* hidR = (unsigned char*)(P.ws + WS_HIDR) + (size_t)blockIdx.x * 256 * 256; unsigned char* y = (unsigned char*)(P.ws + WS_Y);
    LAS int* tiles = (LAS int*)(lds + P6_TILES); LAS int* pre = (LAS int*)(lds + P6_PRE); LAS int* pairs = (LAS int*)(lds + P6_PAIR); LAS float* wts = (LAS float*)(lds + P6_W);
    const int nx = (gridDim.x % 8 == 0) ? 8 : 1, xl = blockIdx.x % nx, li = blockIdx.x / nx, nloc = gridDim.x / nx, nek = 256 / nx;
    if (tid < nek) { const int c_ = cnt[xl + nx * tid]; tiles[tid] = ((c_ < BCAP ? c_ : BCAP) + 255) >> 8; }
    __syncthreads();
    if (tid < nek) { int s = 0; for (int i = 0; i < tid; ++i) s += tiles[i]; pre[tid] = s; if (tid == nek - 1) pre[nek] = s + tiles[nek - 1]; }
    __syncthreads();
    const int total = pre[nek];
    for (int u = li; u < total; u += nloc) {
        int lo = 0, hi_ = nek - 1;
        while (lo < hi_) { const int mid = (lo + hi_ + 1) >> 1; if (pre[mid] <= u) lo = mid; else hi_ = mid - 1; }
        const int e = xl + nx * lo, tile = u - pre[lo], n = cnt[e] < BCAP ? cnt[e] : BCAP, rows = (n - tile * 256) < 256 ? (n - tile * 256) : 256;
        if (tid < 256) { const int r = tid < rows ? tid : 0; const int pr = bucket[(size_t)e * BCAP + tile * 256 + r]; pairs[tid] = pr; wts[tid] = tid < rows ? rw[pr] : 0.f; }
        __syncthreads();
        {
            struct GU { const unsigned char* h2q; LAS int* pairs; const unsigned char* wgu; unsigned char* hidR;
                __device__ __forceinline__ void ptrs(int t, const unsigned char* (&aptr)[2], const unsigned char* (&wptr)[2]) const {
                    const int tid = opaque_tid(), lane = tid & 63, wid = tid >> 6;
#pragma unroll
                    for (int i = 0; i < 2; ++i) { const int row = G::t_row(i, wid, lane); aptr[i] = h2q + (size_t)(pairs[row] >> 3) * 1024 + G::t_chunk(row, lane) * 16;
                        wptr[i] = wgu + (size_t)(t * 256 + row) * 1024 + G::t_chunk(row, lane) * 16; } }
                __device__ __forceinline__ void epi(int t, f32x16 (&acc)[2][4]) const {
                    const int tid = opaque_tid(), lane = tid & 63, wid = tid >> 6, wm = wid >> 1, wn = wid & 1, l31 = lane & 31, hi = lane >> 5;
                    if (PM == 2) return;
                    const float sg = 1.0f / W8_GU_SCALE;
#pragma unroll
                    for (int jt = 0; jt < 2; ++jt) { const int rl = wm * 64 + jt * 32 + l31;
#pragma unroll
                        for (int p = 0; p < 2; ++p) { u32x4 w;
#pragma unroll
                            for (int q4 = 0; q4 < 4; ++q4) { float hv[4];
#pragma unroll
                                for (int r = 0; r < 4; ++r) { const float g = acc[jt][2 * p][4 * q4 + r] * sg, uu = acc[jt][2 * p + 1][4 * q4 + r] * (sg * HID8_SCALE); hv[r] = siluf_(g) * uu; }
                                w[q4] = pk4_fp8(hv[0], hv[1], hv[2], hv[3]); }
                            *(u32x4*)(hidR + rl * 256 + t * 128 + wn * 64 + p * 32 + 16 * hi) = w; } } }
            } f{h2q, pairs, (const unsigned char*)(P.ws + WS_W8GU) + (size_t)e * 512 * 1024, hidR};
            if (PM != 3) G::run_stream(f, 2, 16, lds);
        }
        __syncthreads();
        {
            struct DN { const unsigned char* hidR; const unsigned char* wd; unsigned char* y; LAS int* pairs; LAS float* wts; int rows;
                __device__ __forceinline__ void ptrs(int ct, const unsigned char* (&aptr)[2], const unsigned char* (&wptr)[2]) const {
                    const int tid = opaque_tid(), lane = tid & 63, wid = tid >> 6;
#pragma unroll
                    for (int i = 0; i < 2; ++i) { const int row = G::t_row(i, wid, lane); aptr[i] = hidR + (size_t)row * 256 + G::t_chunk(row, lane) * 16;
                        wptr[i] = wd + (size_t)(ct * 256 + row) * 256 + G::t_chunk(row, lane) * 16; } }
                __device__ __forceinline__ void epi(int ct, f32x16 (&acc)[2][4]) const {
                    const int tid = opaque_tid(), lane = tid & 63, wid = tid >> 6, wm = wid >> 1, wn = wid & 1, l31 = lane & 31, hi = lane >> 5;
                    if (PM == 3) return;
#pragma unroll
                    for (int jt = 0; jt < 2; ++jt) { const int rl = wm * 64 + jt * 32 + l31; const float sc_ = wts[rl] * (Y_SCALE / (W8_D_SCALE * HID8_SCALE)); const size_t pr = (size_t)pairs[rl];
                        if (rl < rows) {
#pragma unroll
                            for (int it = 0; it < 4; ++it) { u32x4 w;
#pragma unroll
                                for (int q4 = 0; q4 < 4; ++q4) w[q4] = pk4_fp8(acc[jt][it][4 * q4] * sc_, acc[jt][it][4 * q4 + 1] * sc_, acc[jt][it][4 * q4 + 2] * sc_, acc[jt][it][4 * q4 + 3] * sc_);
                                *(u32x4*)(y + pr * 1024 + ct * 256 + wn * 128 + it * 32 + 16 * hi) = w; } } } }
            } f{hidR, (const unsigned char*)(P.ws + WS_W8D) + (size_t)e * 1024 * 256, y, pairs, wts, rows};
            if (PM == 0 || PM == 3) G::run_stream(f, 4, 4, lds);
        }
        __syncthreads();
    }
}

__device__ __forceinline__ void phase_combine(const Params& P) {
    const int lane = threadIdx.x & 63, gw = blockIdx.x * (NTHREADS / 64) + (threadIdx.x >> 6), NGW = gridDim.x * (NTHREADS / 64);
    const unsigned char* y = (const unsigned char*)(P.ws + WS_Y);
    typedef float f32x2_ __attribute__((ext_vector_type(2)));
    for (int m = gw; m < T; m += NGW) {
        const float* mod = (const float*)(P.ws + WS_MOD) + (m / SEQ) * 6144 + 5120;
#pragma unroll
        for (int j = 0; j < 2; ++j) { const int col = (lane + 64 * j) * 8;
            f32x4 s0 = (f32x4){0.f, 0.f, 0.f, 0.f}, s1 = s0;
#pragma unroll
            for (int sl = 0; sl < 8; ++sl) { const u32x2 v = *(const u32x2*)(y + ((size_t)m * 8 + sl) * 1024 + col);
                const f32x2_ a = __builtin_amdgcn_cvt_pk_f32_fp8((int)v.x, false), b = __builtin_amdgcn_cvt_pk_f32_fp8((int)v.x, true);
                const f32x2_ c = __builtin_amdgcn_cvt_pk_f32_fp8((int)v.y, false), d = __builtin_amdgcn_cvt_pk_f32_fp8((int)v.y, true);
                s0.x += a.x; s0.y += a.y; s0.z += b.x; s0.w += b.y; s1.x += c.x; s1.y += c.y; s1.z += d.x; s1.w += d.y; }
            const f32x4 g0 = *(const f32x4*)(mod + col), g1 = *(const f32x4*)(mod + col + 4);
            f32x4 o0 = *(const f32x4*)(P.out + (size_t)m * 1024 + col), o1 = *(const f32x4*)(P.out + (size_t)m * 1024 + col + 4);
            const u32x4 sh = *(const u32x4*)((const bf16_t*)(P.ws + WS_YSH) + (size_t)m * 1024 + col);
            const f32x4 h0 = (f32x4){__uint_as_float(sh.x << 16), __uint_as_float(sh.x & 0xffff0000u), __uint_as_float(sh.y << 16), __uint_as_float(sh.y & 0xffff0000u)};
            const f32x4 h1 = (f32x4){__uint_as_float(sh.z << 16), __uint_as_float(sh.z & 0xffff0000u), __uint_as_float(sh.w << 16), __uint_as_float(sh.w & 0xffff0000u)};
            o0 += g0 * (s0 * Y_INV + h0); o1 += g1 * (s1 * Y_INV + h1);
            *(f32x4*)(P.out + (size_t)m * 1024 + col) = o0; *(f32x4*)(P.out + (size_t)m * 1024 + col + 4) = o1; }
    }
}


__device__ __forceinline__ int queue_pull(unsigned* head, volatile LAS unsigned* slot) {
    if (threadIdx.x == 0) *slot = atomicAdd(head, 1u);
    __syncthreads();
    const int v = (int)*slot;
    __syncthreads();
    return v;
}
__device__ __forceinline__ void phase_cmp_h1(const Params& P, LAS unsigned char* lds, volatile LAS unsigned* slot) {
    unsigned* head = (unsigned*)(P.ws + WS_CTL + CTL_Q2);
    for (;;) {
        const int u = queue_pull(head, slot);
        if (u >= 64 + 512) break;
        if (u < 64) compress_unit(P, lds, u); else hgrn_unit<0>(P, lds, u - 64);
    }
}
__device__ __forceinline__ void phase_h23_nsa(const Params& P, LAS unsigned char* lds, volatile LAS unsigned* slot) {
    unsigned* head = (unsigned*)(P.ws + WS_CTL + CTL_Q3);
    for (;;) {
        const int n = queue_pull(head, slot);
        if (n >= 1536) break;
        if (n < 512) nsa_unit(P, lds, (n & 7) * 128 + (127 - (n >> 3)));
        else if (n < 1024) { const int m = n - 512; hgrn_unit<1>(P, lds, (m & 15) * 32 + (31 - (m >> 4))); }
        else { const int m = n - 1024; nsa_unit(P, lds, (m & 7) * 128 + (63 - (m >> 3))); }
    }
}

constexpr int LDS_BYTES = 144 * 1024;
__global__ void __launch_bounds__(NTHREADS) mega(Params P) {
    extern __shared__ __attribute__((aligned(16))) unsigned char smem[];
    LAS unsigned char* lds = (LAS unsigned char*)smem;
    volatile LAS unsigned* xst = (volatile LAS unsigned*)(lds + LDS_BYTES - 16);
    if (threadIdx.x < 4) xst[threadIdx.x] = 0u;
    __syncthreads();
    XcdBarrier xb = xcd_barrier_post((unsigned*)(P.ws + WS_CTL + CTL_BAR), xst);
    phase_mod(P, lds);
    xcd_barrier(xb);
    { const float* mod = (const float*)(P.ws + WS_MOD); norm_mod_rows(P.x, P.norm1_w, mod, mod + 1024, (bf16_t*)(P.ws + WS_H), H1S); }
    xcd_barrier(xb);
    phase_inproj(P, lds);
    xcd_barrier(xb);
    phase_cmp_h1(P, lds, xst + 2);
    xcd_barrier(xb);
    phase_h23_nsa(P, lds, xst + 2);
    phase_cvt_small(P);
    xcd_barrier(xb);
    phase_p4a(P, lds);
    xcd_barrier(xb);
    phase_p4b(P);
    xcd_barrier(xb);
    phase_p4c(P, lds);
    xcd_barrier(xb);
    phase_route(P);
    phase_p4d(P, lds);
    xcd_barrier(xb);
    phase_expert_cvt8(P);
    xcd_barrier(xb);
    phase_experts8<0>(P, lds);
    xcd_barrier(xb);
    phase_combine(P);
}

extern "C" void kernel_launch(void* const* d_in, const int* in_sizes, int n_in, void* d_out, int out_size, void* d_ws, size_t ws_size, hipStream_t stream) {
    static int grid = 0;
    if (grid == 0) {
        if (n_in != 25 || ws_size < WS_END) { fprintf(stderr, "kernel_launch: unexpected n_in %d or ws_size %zu (need %zu)\n", n_in, ws_size, (size_t)WS_END); grid = -1; return; }
        int dev = 0, cus = 0, per_cu = 0;
        (void)hipGetDevice(&dev); (void)hipDeviceGetAttribute(&cus, hipDeviceAttributeMultiprocessorCount, dev);
        (void)hipFuncSetAttribute((const void*)mega, hipFuncAttributeMaxDynamicSharedMemorySize, LDS_BYTES);
        (void)hipOccupancyMaxActiveBlocksPerMultiprocessor(&per_cu, (const void*)mega, NTHREADS, LDS_BYTES);
        if (per_cu < 1) { fprintf(stderr, "kernel_launch: occupancy query says %d blocks per CU\n", per_cu); grid = -1; return; }
        grid = cus;
    }
    if (grid < 0) return;
    (void)hipMemsetAsync((char*)d_ws + WS_CTL, 0, 64 * 1024, stream);
    Params p{};
    const float** pf = (const float**)&p;
    for (int i = 0; i < 25; ++i) pf[i] = (const float*)d_in[i];
    p.out = (float*)d_out; p.ws = (unsigned char*)d_ws;
    void* args[] = {&p};
    hipError_t e = hipLaunchCooperativeKernel((const void*)mega, dim3(grid), dim3(NTHREADS), args, LDS_BYTES, stream);
    if (e != hipSuccess) fprintf(stderr, "cooperative launch failed: %s (grid %d)\n", hipGetErrorString(e), grid);
}

#ifdef PHASE_TEST
__global__ void __launch_bounds__(NTHREADS) t_p4a(Params P) { extern __shared__ __attribute__((aligned(16))) unsigned char smem[]; phase_p4a(P, (LAS unsigned char*)smem); }
__global__ void __launch_bounds__(NTHREADS) t_p4d(Params P) { extern __shared__ __attribute__((aligned(16))) unsigned char smem[]; phase_p4d(P, (LAS unsigned char*)smem); }
__global__ void __launch_bounds__(NTHREADS) t_p4(Params P) { extern __shared__ __attribute__((aligned(16))) unsigned char smem[]; phase_p4c(P, (LAS unsigned char*)smem); }
__global__ void __launch_bounds__(NTHREADS) t_p6(Params P) { extern __shared__ __attribute__((aligned(16))) unsigned char smem[]; phase_experts(P, (LAS unsigned char*)smem); }
__global__ void __launch_bounds__(NTHREADS) t_nsa(Params P) { extern __shared__ __attribute__((aligned(16))) unsigned char smem[]; nsa_unit(P, (LAS unsigned char*)smem, blockIdx.x); }
__global__ void __launch_bounds__(NTHREADS) t_mod(Params P) { extern __shared__ __attribute__((aligned(16))) unsigned char smem[]; phase_mod(P, (LAS unsigned char*)smem); }
__global__ void __launch_bounds__(NTHREADS) t_inproj(Params P) { extern __shared__ __attribute__((aligned(16))) unsigned char smem[]; phase_inproj(P, (LAS unsigned char*)smem); }
__global__ void __launch_bounds__(NTHREADS) t_cmp(Params P) { extern __shared__ __attribute__((aligned(16))) unsigned char smem[]; compress_unit(P, (LAS unsigned char*)smem, blockIdx.x); }
__global__ void __launch_bounds__(NTHREADS) t_h0(Params P) { extern __shared__ __attribute__((aligned(16))) unsigned char smem[]; hgrn_unit<0>(P, (LAS unsigned char*)smem, blockIdx.x); }
__global__ void __launch_bounds__(NTHREADS) t_h1(Params P) { extern __shared__ __attribute__((aligned(16))) unsigned char smem[]; hgrn_unit<1>(P, (LAS unsigned char*)smem, blockIdx.x); }
#endif
```

```cpp
#include <hip/hip_runtime.h>
#include <hip/hip_cooperative_groups.h>
#include <cstdio>
#include <cstdint>
#include <type_traits>
namespace cg = cooperative_groups;

#define LAS __attribute__((address_space(3)))
typedef unsigned short bf16_t;
typedef short bf16x8 __attribute__((ext_vector_type(8)));
typedef short s16x4 __attribute__((ext_vector_type(4)));
typedef float f32x4 __attribute__((ext_vector_type(4)));
typedef float f32x16 __attribute__((ext_vector_type(16)));
typedef unsigned u32x4 __attribute__((ext_vector_type(4)));
typedef unsigned u32x2 __attribute__((ext_vector_type(2)));

constexpr int D = 1024, BATCH = 4, SEQ = 8192, T = BATCH * SEQ;
constexpr int IN_COLS = 3352;
constexpr int NTHREADS = 512;
constexpr int H1S = 1088;
constexpr float RMS_EPS = 1e-6f;
constexpr float LOG2E = 1.4426950408889634f;
constexpr float Y_SCALE = 16.0f, Y_INV = 1.0f / 16.0f;

constexpr size_t MB = 1024ull * 1024ull;
constexpr size_t WS_CTL    = 0;
constexpr size_t WS_MOD    = 64 * 1024;
constexpr size_t WS_LB     = WS_MOD + 4 * 6144 * 4;
constexpr size_t WS_CB     = WS_LB + 2048;
constexpr size_t WS_H      = 1 * MB;
constexpr size_t WS_SS     = WS_H + 72 * MB;
constexpr size_t WS_RW     = WS_SS + 1 * MB;
constexpr size_t WS_BUCKET = WS_RW + 1 * MB;
constexpr size_t WS_HIDR   = WS_BUCKET + 16 * MB;
constexpr size_t WS_WSM    = WS_HIDR + 32 * MB;
constexpr size_t WS_WOUT   = WS_WSM, WS_WRS = WS_WSM + 2 * MB, WS_WSD = WS_WSM + 4 * MB;
constexpr size_t WS_WBE    = WS_WSM + 5 * MB;
constexpr size_t WS_WBGU   = WS_WBE, WS_WBD = WS_WBE + 256 * MB;
constexpr size_t WS_W8GU   = WS_WBE, WS_W8D = WS_WBE + 128 * MB, WS_H2Q = WS_WBE + 256 * MB;
constexpr float W8_GU_SCALE = 64.0f, W8_D_SCALE = 32.0f, HID8_SCALE = 4.0f;
constexpr size_t WS_SCORES = WS_WBE;
constexpr size_t WS_HIDS   = WS_SCORES + 32 * MB;
constexpr size_t WS_WIN    = WS_HIDS + 16 * MB;
constexpr size_t WS_Y      = WS_WBE + 384 * MB;
constexpr size_t WS_Q      = WS_Y;
constexpr size_t WS_KV     = WS_Q + 32 * MB;
constexpr size_t WS_GATES  = WS_KV + 48 * MB;
constexpr size_t WS_HQ     = WS_GATES + 4 * MB;
constexpr size_t WS_LOGF   = WS_HQ + 32 * MB;
constexpr size_t WS_HV     = WS_LOGF + 64 * MB;
constexpr size_t WS_HG     = WS_HV + 32 * MB;
constexpr size_t WS_CMPH   = WS_HG + 32 * MB;
constexpr size_t WS_KC     = WS_CMPH + 4 * MB;
constexpr size_t WS_VC     = WS_KC + 1 * MB;
constexpr size_t WS_HL     = WS_VC + 1 * MB;
constexpr size_t WS_HD     = WS_HL + 32 * MB;
constexpr size_t WS_MIX    = WS_HD + 1 * MB;
constexpr size_t WS_YSH    = WS_Y + 384 * MB;
constexpr size_t WS_END    = WS_YSH + 64 * MB;
constexpr int BCAP = 16384;
constexpr int CTL_CNT = 1024;
constexpr int CTL_Q2 = 2048, CTL_Q3 = 2112;
constexpr int CTL_BAR = 16384;

struct Params {
    const float *x, *c, *ada_w, *ada_b, *norm1_w, *norm2_w, *w_in, *q_norm_w, *k_norm_w, *cmp_pos, *cmp_w1, *cmp_b1, *cmp_w2,
        *attn_out_norm_w, *hgrn_lb, *rec_out_norm_w, *w_out, *router_w, *router_bias, *exp_wg, *exp_wu, *exp_wd, *sh_wg, *sh_wu, *sh_wd;
    float* out;
    unsigned char* ws;
};

typedef __bf16 bf16x2_t __attribute__((ext_vector_type(2)));
typedef int i32x8 __attribute__((ext_vector_type(8)));
__device__ __forceinline__ unsigned cvtpk(float lo, float hi) { bf16x2_t v; v.x = (__bf16)lo; v.y = (__bf16)hi; return __builtin_bit_cast(unsigned, v); }
__device__ __forceinline__ int opaque_tid() { int t = threadIdx.x; asm volatile("" : "+v"(t)); return t; }
__device__ __forceinline__ float bf2f(bf16_t v) { return __uint_as_float(((unsigned)v) << 16); }
__device__ __forceinline__ float sigmoidf_(float v) { return __builtin_amdgcn_rcpf(1.0f + __expf(-v)); }
__device__ __forceinline__ float siluf_(float v) { return v * __builtin_amdgcn_rcpf(1.0f + __expf(-v)); }
__device__ __forceinline__ float wave_sum(float v) {
#pragma unroll
    for (int o = 1; o < 64; o <<= 1) v += __shfl_xor(v, o);
    return v;
}
__device__ __forceinline__ s16x4 lds_tr(const LAS unsigned char* p) {
    return __builtin_bit_cast(s16x4, __builtin_amdgcn_ds_read_tr16_b64_v4i16((LAS s16x4*)p));
}

#define XB_TMO      128
#define XB_XCNT(j)  (256  + 64 * (j))
#define XB_XSUB(j)  (1280 + 64 * (j))
#define XB_XGEN(j)  (2304 + 64 * (j))
#define XB_TOP      3328
#define XB_TOPGEN   3392
#define XCD_BAR_WORDS 3456
#define XB_SPIN_CAP (1u << 22)
__device__ __forceinline__ unsigned xb_ld(unsigned* p)              { return __hip_atomic_load(p, __ATOMIC_RELAXED, __HIP_MEMORY_SCOPE_AGENT); }
__device__ __forceinline__ unsigned xb_add(unsigned* p, unsigned v) { return __hip_atomic_fetch_add(p, v, __ATOMIC_RELAXED, __HIP_MEMORY_SCOPE_AGENT); }
__device__ __forceinline__ unsigned xb_xcc_id() { return (unsigned)__builtin_amdgcn_s_getreg((3 << 11) | 20) & 0xFu; }
#define XB_SPIN(cond, bar) do { unsigned _sp = 0; while (cond) { __builtin_amdgcn_s_sleep(1); \
    if ((++_sp & 255u) == 0u) { if (xb_ld(&(bar)[XB_TMO])) break; if (_sp > XB_SPIN_CAP) { atomicAdd(&(bar)[XB_TMO], 1u); break; } } } } while (0)
struct XcdBarrier { unsigned* bar; unsigned x; volatile LAS unsigned* st; };
__device__ __forceinline__ XcdBarrier xcd_barrier_post(unsigned* bar, volatile LAS unsigned* st) {
    XcdBarrier b; b.bar = bar; b.x = xb_xcc_id(); b.st = st;
    if (threadIdx.x == 0) (void)xb_add(&bar[XB_XCNT(b.x)], 1u);
    return b;
}
__device__ __forceinline__ void xcd_barrier_complete(unsigned* bar, unsigned x, unsigned& nloc, unsigned& nx) {
    const unsigned G = gridDim.x * gridDim.y * gridDim.z;
    unsigned sum, cnt, mine, sp = 0u;
    for (;;) {
        sum = 0u; cnt = 0u; mine = 0u;
#pragma unroll
        for (unsigned j = 0; j < 16; ++j) { const unsigned c = xb_ld(&bar[XB_XCNT(j)]); sum += c; cnt += (c > 0u) ? 1u : 0u; mine = (j == x) ? c : mine; }
        if (sum == G) break;
        __builtin_amdgcn_s_sleep(1);
        if ((++sp & 255u) == 0u) { if (xb_ld(&bar[XB_TMO])) break; if (sp > XB_SPIN_CAP) { atomicAdd(&bar[XB_TMO], 1u); break; } }
    }
    nloc = mine > 0u ? mine : 1u; nx = cnt > 0u ? cnt : 1u;
}
__device__ __forceinline__ void xcd_barrier(const XcdBarrier& b) {
    asm volatile("s_waitcnt vmcnt(0)" ::: "memory");
    __syncthreads();
    if (threadIdx.x == 0) {
        unsigned* bar = b.bar;
        __builtin_amdgcn_s_waitcnt(0);
        unsigned nloc = b.st[0], nx = b.st[1];
        if (nloc == 0u) { xcd_barrier_complete(bar, b.x, nloc, nx); b.st[0] = nloc; b.st[1] = nx; }
        const unsigned old = xb_add(&bar[XB_XSUB(b.x)], 1u);
        const unsigned gen = old / nloc;
        if (old + 1u == (gen + 1u) * nloc) {
            __builtin_amdgcn_fence(__ATOMIC_RELEASE, "agent");
            asm volatile("s_waitcnt vmcnt(0)" ::: "memory");
            const unsigned og = xb_add(&bar[XB_TOP], 1u);
            const unsigned tg = og / nx;
            if (og + 1u == (tg + 1u) * nx) xb_add(&bar[XB_TOPGEN], 1u);
            else XB_SPIN(xb_ld(&bar[XB_TOPGEN]) == tg, bar);
            __builtin_amdgcn_fence(__ATOMIC_ACQUIRE, "agent");
            xb_add(&bar[XB_XGEN(b.x)], 1u);
            asm volatile("s_waitcnt vmcnt(0)" ::: "memory");
        } else {
            XB_SPIN(xb_ld(&bar[XB_XGEN(b.x)]) == gen, bar);
            __builtin_amdgcn_fence(__ATOMIC_ACQUIRE, "agent");
            asm volatile("s_waitcnt vmcnt(0)" ::: "memory");
        }
    }
    __syncthreads();
}

template <int WM, int WN> struct GemmT {
    static constexpr int BM = 64 * WM, BN = 64 * WN;
    static constexpr int A_BYTES = BM * 128, B_BYTES = 64 * BN * 2, STAGE = A_BYTES + B_BYTES, LDS_BYTES = 2 * STAGE;
    static constexpr int NB4 = BN / 32;
    static constexpr int B_ROW4 = BN / 4;

    static __device__ __forceinline__ void run(f32x4 (&acc)[4][4], const bf16_t* const (&arow)[WM], int a_kstride, const float* Bp, int ldb, int KT, LAS unsigned char* lds) {
        const int tid = opaque_tid(), lane = tid & 63, wid = tid >> 6, wm = wid / WN, wn = wid % WN, fr = lane & 15, fq = lane >> 4;
#pragma unroll
        for (int mi = 0; mi < 4; ++mi)
#pragma unroll
            for (int ni = 0; ni < 4; ++ni) acc[mi][ni] = (f32x4){0.f, 0.f, 0.f, 0.f};
        const int achunk = tid & 7;
        u32x4 areg[WM]; f32x4 breg[NB4];
        int a_wr[WM];
#pragma unroll
        for (int p = 0; p < WM; ++p) { const int row = p * 64 + (tid >> 3); a_wr[p] = row * 128 + ((achunk ^ ((row >> 1) & 7)) << 4); }
        int b_wr[NB4]; int b_goff[NB4];
#pragma unroll
        for (int p = 0; p < NB4; ++p) { const int i = tid + NTHREADS * p, k = i / B_ROW4, n = (i % B_ROW4) * 4;
            const int f = (k & 3) | (((k >> 3) & 1) << 2);
            b_wr[p] = A_BYTES + k * (BN * 2) + (((n >> 4) ^ f) << 5) + ((n & 15) << 1); b_goff[p] = k * ldb + n; }
        int a_rd[4][2];
#pragma unroll
        for (int mi = 0; mi < 4; ++mi)
#pragma unroll
            for (int ks = 0; ks < 2; ++ks) { const int row = wm * 64 + mi * 16 + fr, ch = ks * 4 + fq; a_rd[mi][ks] = row * 128 + ((ch ^ ((row >> 1) & 7)) << 4); }
        int b_rd[2][2];
        int b_f[2][2];
#pragma unroll
        for (int ks = 0; ks < 2; ++ks)
#pragma unroll
            for (int t = 0; t < 2; ++t) { const int k = ks * 32 + 8 * fq + 4 * t + (fr >> 2); b_f[ks][t] = (k & 3) | (((k >> 3) & 1) << 2);
                b_rd[ks][t] = A_BYTES + k * (BN * 2) + ((fr & 3) << 3); }

        auto gload = [&](int kt) {
#pragma unroll
            for (int p = 0; p < WM; ++p) areg[p] = *(const u32x4*)(arow[p] + (size_t)kt * a_kstride + achunk * 8);
            const float* bk = Bp + (size_t)kt * 64 * ldb;
#pragma unroll
            for (int p = 0; p < NB4; ++p) breg[p] = *(const f32x4*)(bk + b_goff[p]);
        };
        auto lstore = [&](int buf) {
            LAS unsigned char* base = lds + buf * STAGE;
#pragma unroll
            for (int p = 0; p < WM; ++p) *(LAS u32x4*)(base + a_wr[p]) = areg[p];
#pragma unroll
            for (int p = 0; p < NB4; ++p) { u32x2 w; w.x = cvtpk(breg[p].x, breg[p].y); w.y = cvtpk(breg[p].z, breg[p].w); *(LAS u32x2*)(base + b_wr[p]) = w; }
        };
        gload(0); lstore(0); __syncthreads();
        for (int kt = 0; kt < KT; ++kt) {
            if (kt + 1 < KT) gload(kt + 1);
            __builtin_amdgcn_sched_barrier(0);
            const LAS unsigned char* base = lds + (kt & 1) * STAGE;
#pragma unroll
            for (int ks = 0; ks < 2; ++ks) {
                bf16x8 af[4], bfr[4];
#pragma unroll
                for (int mi = 0; mi < 4; ++mi) af[mi] = *(const LAS bf16x8*)(base + a_rd[mi][ks]);
#pragma unroll
                for (int ni = 0; ni < 4; ++ni) {
                    const int u0 = wn * 4 + ni;
                    const s16x4 lo = lds_tr(base + b_rd[ks][0] + ((u0 ^ b_f[ks][0]) << 5));
                    const s16x4 hi = lds_tr(base + b_rd[ks][1] + ((u0 ^ b_f[ks][1]) << 5));
                    bfr[ni] = (bf16x8){lo[0], lo[1], lo[2], lo[3], hi[0], hi[1], hi[2], hi[3]};
                }
#pragma unroll
                for (int mi = 0; mi < 4; ++mi)
#pragma unroll
                    for (int ni = 0; ni < 4; ++ni) acc[mi][ni] = __builtin_amdgcn_mfma_f32_16x16x32_bf16(bfr[ni], af[mi], acc[mi][ni], 0, 0, 0);
            }
            if (kt + 1 < KT) lstore((kt + 1) & 1);
            __syncthreads();
        }
    }
};

struct Gemm2 {
    static constexpr int A_BYTES = 32768, STAGE = 65536, LDS_BYTES = 2 * STAGE;
    static __device__ __forceinline__ int a_row(int i, int w, int lane) { return (i * 8 + w) * 8 + (lane >> 3); }
    static __device__ __forceinline__ int a_chunk(int row, int lane) { return (lane & 7) ^ ((row >> 1) & 7); }
    static __device__ __forceinline__ int b_k(int i, int w, int lane) { return (i * 8 + w) * 2 + (lane >> 5); }
    static __device__ __forceinline__ int b_n(int k, int lane) { return ((((lane & 31) >> 1) ^ fk2(k)) << 4) + ((lane & 1) << 3); }
    static __device__ __forceinline__ int fk2(int r) { return (r & 3) | (((r >> 3) & 1) << 2); }

    static __device__ __forceinline__ void run(f32x4 (&acc)[4][8], const bf16_t* const (&aptr)[4], int a_kstride, const bf16_t* const (&bptr)[4], size_t b_kstride, int KT, LAS unsigned char* lds) {
        const int tid = opaque_tid(), lane = tid & 63, wid = tid >> 6, wm = wid >> 1, wn = wid & 1, fr = lane & 15, fq = lane >> 4;
        const int wu = __builtin_amdgcn_readfirstlane(wid);
#pragma unroll
        for (int mi = 0; mi < 4; ++mi)
#pragma unroll
            for (int ni = 0; ni < 8; ++ni) acc[mi][ni] = (f32x4){0.f, 0.f, 0.f, 0.f};
        int a_rd[4][2];
#pragma unroll
        for (int mi = 0; mi < 4; ++mi)
#pragma unroll
            for (int ks = 0; ks < 2; ++ks) { const int row = wm * 64 + mi * 16 + fr, ch = ks * 4 + fq; a_rd[mi][ks] = row * 128 + ((ch ^ ((row >> 1) & 7)) << 4); }
        int b_rd[2][2], b_f[2][2];
#pragma unroll
        for (int ks = 0; ks < 2; ++ks)
#pragma unroll
            for (int t = 0; t < 2; ++t) { const int k = ks * 32 + 8 * fq + 4 * t + (fr >> 2); b_f[ks][t] = fk2(k); b_rd[ks][t] = A_BYTES + k * 512 + ((fr & 3) << 3); }
        auto issue = [&](int kt, int buf) {
            LAS unsigned char* base = lds + buf * STAGE + wu * 1024;
#pragma unroll
            for (int i = 0; i < 4; ++i) __builtin_amdgcn_global_load_lds((const unsigned*)(aptr[i] + (size_t)kt * a_kstride), (LAS unsigned*)(base + i * 8192), 16, 0, 0);
#pragma unroll
            for (int i = 0; i < 4; ++i) __builtin_amdgcn_global_load_lds((const unsigned*)(bptr[i] + (size_t)kt * b_kstride), (LAS unsigned*)(base + A_BYTES + i * 8192), 16, 0, 0);
        };
        issue(0, 0);
        for (int kt = 0; kt < KT; ++kt) {
            asm volatile("s_waitcnt vmcnt(0)" ::: "memory");
            __syncthreads();
            if (kt + 1 < KT) issue(kt + 1, (kt + 1) & 1);
            const LAS unsigned char* base = lds + (kt & 1) * STAGE;
#pragma unroll
            for (int ks = 0; ks < 2; ++ks) {
                bf16x8 af[4];
#pragma unroll
                for (int mi = 0; mi < 4; ++mi) af[mi] = *(const LAS bf16x8*)(base + a_rd[mi][ks]);
#pragma unroll
                for (int ni = 0; ni < 8; ++ni) {
                    const int u0 = wn * 8 + ni;
                    const s16x4 lo = lds_tr(base + b_rd[ks][0] + ((u0 ^ b_f[ks][0]) << 5));
                    const s16x4 hi = lds_tr(base + b_rd[ks][1] + ((u0 ^ b_f[ks][1]) << 5));
                    const bf16x8 bfr = (bf16x8){lo[0], lo[1], lo[2], lo[3], hi[0], hi[1], hi[2], hi[3]};
#pragma unroll
                    for (int mi = 0; mi < 4; ++mi) acc[mi][ni] = __builtin_amdgcn_mfma_f32_16x16x32_bf16(bfr, af[mi], acc[mi][ni], 0, 0, 0);
                }
            }
        }
        __syncthreads();
    }
};

__device__ __forceinline__ void glds16(const void* g, unsigned lds_base) {
    unsigned sv; asm volatile("s_mov_b32 %0, m0\n\ts_mov_b32 m0, %2\n\ts_nop 0\n\tglobal_load_lds_dwordx4 %1, off\n\ts_mov_b32 m0, %0" : "=&s"(sv) : "v"(g), "s"(lds_base) : "memory"); }
struct Gemm3 {
    static constexpr int A_BYTES = 16384, STAGE = 32768, LDS_BYTES = 4 * STAGE;
    static __device__ __forceinline__ int a_row(int i, int w, int lane) { return (i * 8 + w) * 16 + (lane >> 2); }
    static __device__ __forceinline__ int a_chunk(int row, int lane) { return (lane & 3) ^ ((row >> 1) & 3); }
    static __device__ __forceinline__ int b_k(int i, int w, int lane) { return (i * 8 + w) * 2 + (lane >> 5); }
    static __device__ __forceinline__ int fk2(int r) { return (r & 3) | (((r >> 3) & 1) << 2); }
    static __device__ __forceinline__ int b_n(int k, int lane) { return ((((lane & 31) >> 1) ^ fk2(k)) << 4) + ((lane & 1) << 3); }
    static __device__ __forceinline__ void run(f32x4 (&acc)[4][8], const bf16_t* const (&aptr)[2], int a_kstride, const bf16_t* const (&bptr)[2], size_t b_kstride, int KT, LAS unsigned char* lds) {
        const int tid = opaque_tid(), lane = tid & 63, wid = tid >> 6, wm = wid >> 1, wn = wid & 1, fr = lane & 15, fq = lane >> 4;
        const int wu = __builtin_amdgcn_readfirstlane(wid);
#pragma unroll
        for (int mi = 0; mi < 4; ++mi)
#pragma unroll
            for (int ni = 0; ni < 8; ++ni) acc[mi][ni] = (f32x4){0.f, 0.f, 0.f, 0.f};
        int a_rd[4];
#pragma unroll
        for (int mi = 0; mi < 4; ++mi) { const int row = wm * 64 + mi * 16 + fr; a_rd[mi] = row * 64 + ((fq ^ ((row >> 1) & 3)) << 4); }
        int b_rd[2], b_f[2];
#pragma unroll
        for (int t = 0; t < 2; ++t) { const int k = 8 * fq + 4 * t + (fr >> 2); b_f[t] = fk2(k); b_rd[t] = A_BYTES + k * 512 + ((fr & 3) << 3); }
        const unsigned lds0 = (unsigned)(uintptr_t)lds + (unsigned)wu * 1024u;
        auto issue = [&](int kt) {
            const unsigned base = (unsigned)__builtin_amdgcn_readfirstlane((int)(lds0 + (unsigned)(kt & 3) * STAGE));
#pragma unroll
            for (int i = 0; i < 2; ++i) glds16(aptr[i] + (size_t)kt * a_kstride, base + i * 8192);
#pragma unroll
            for (int i = 0; i < 2; ++i) glds16(bptr[i] + (size_t)kt * b_kstride, base + A_BYTES + i * 8192);
        };
        const int grp = wu >> 2;
        auto bar = [&]() { asm volatile("s_waitcnt lgkmcnt(0)" ::: "memory"); __builtin_amdgcn_s_barrier(); asm volatile("" ::: "memory"); };
        asm volatile("s_waitcnt vmcnt(0)" ::: "memory");
        issue(0); if (KT > 1) issue(1); if (KT > 2) issue(2);
        if (KT > 2) asm volatile("s_waitcnt vmcnt(8)" ::: "memory"); else if (KT > 1) asm volatile("s_waitcnt vmcnt(4)" ::: "memory"); else asm volatile("s_waitcnt vmcnt(0)" ::: "memory");
        bar();
        if (grp) bar();
#pragma unroll 1
        for (int kt = 0; kt < KT; ++kt) {
            if (kt + 3 < KT) issue(kt + 3);
            const LAS unsigned char* base = lds + (kt & 3) * STAGE;
            bf16x8 af[4], bfr[8];
#pragma unroll
            for (int mi = 0; mi < 4; ++mi) af[mi] = *(const LAS bf16x8*)(base + a_rd[mi]);
#pragma unroll
            for (int ni = 0; ni < 8; ++ni) {
                const int u0 = wn * 8 + ni;
                const s16x4 lo = lds_tr(base + b_rd[0] + ((u0 ^ b_f[0]) << 5));
                const s16x4 hi = lds_tr(base + b_rd[1] + ((u0 ^ b_f[1]) << 5));
                bfr[ni] = (bf16x8){lo[0], lo[1], lo[2], lo[3], hi[0], hi[1], hi[2], hi[3]};
            }
            { const int rem = KT - 2 - kt;
              if (rem >= 2) asm volatile("s_waitcnt vmcnt(8)" ::: "memory"); else if (rem == 1) asm volatile("s_waitcnt vmcnt(4)" ::: "memory"); else asm volatile("s_waitcnt vmcnt(0)" ::: "memory"); }
            bar();
            __builtin_amdgcn_sched_barrier(0);
#pragma unroll
            for (int ni = 0; ni < 8; ++ni)
#pragma unroll
                for (int mi = 0; mi < 4; ++mi) acc[mi][ni] = __builtin_amdgcn_mfma_f32_16x16x32_bf16(bfr[ni], af[mi], acc[mi][ni], 0, 0, 0);
            __builtin_amdgcn_sched_barrier(0);
            bar();
        }
        if (!grp) bar();
    }

    template <class F> static __device__ __forceinline__ void run_stream(F& f, int NSEG, int KT, int a_kstride, size_t b_kstride, LAS unsigned char* lds) {
        const int tid = opaque_tid(), lane = tid & 63, wid = tid >> 6, wm = wid >> 1, wn = wid & 1, fr = lane & 15, fq = lane >> 4;
        const int wu = __builtin_amdgcn_readfirstlane(wid);
        f32x4 acc[4][8];
#pragma unroll
        for (int mi = 0; mi < 4; ++mi)
#pragma unroll
            for (int ni = 0; ni < 8; ++ni) acc[mi][ni] = (f32x4){0.f, 0.f, 0.f, 0.f};
        int a_rd[4];
#pragma unroll
        for (int mi = 0; mi < 4; ++mi) { const int row = wm * 64 + mi * 16 + fr; a_rd[mi] = row * 64 + ((fq ^ ((row >> 1) & 3)) << 4); }
        int b_rd[2], b_f[2];
#pragma unroll
        for (int t = 0; t < 2; ++t) { const int k = 8 * fq + 4 * t + (fr >> 2); b_f[t] = fk2(k); b_rd[t] = A_BYTES + k * 512 + ((fr & 3) << 3); }
        const unsigned lds0 = (unsigned)(uintptr_t)lds + (unsigned)wu * 1024u;
        const bf16_t* aptr[2]; const bf16_t* bptr[2];
        const int total = NSEG * KT;
        int lseg = 0, lkt = 0, lg = 0;
        auto issue = [&]() {
            const unsigned base = (unsigned)__builtin_amdgcn_readfirstlane((int)(lds0 + (unsigned)(lg & 3) * STAGE));
#pragma unroll
            for (int i = 0; i < 2; ++i) glds16(aptr[i] + (size_t)lkt * a_kstride, base + i * 8192);
#pragma unroll
            for (int i = 0; i < 2; ++i) glds16(bptr[i] + (size_t)lkt * b_kstride, base + A_BYTES + i * 8192);
            ++lg; if (++lkt == KT) { lkt = 0; ++lseg; if (lseg < NSEG) f.ptrs(lseg, aptr, bptr); }
        };
        const int grp = wu >> 2;
        auto bar = [&]() { asm volatile("s_waitcnt lgkmcnt(0)" ::: "memory"); __builtin_amdgcn_s_barrier(); asm volatile("" ::: "memory"); };
        f.ptrs(0, aptr, bptr);
        asm volatile("s_waitcnt vmcnt(0)" ::: "memory");
        issue(); if (total > 1) issue(); if (total > 2) issue();
        if (total > 2) asm volatile("s_waitcnt vmcnt(8)" ::: "memory"); else if (total > 1) asm volatile("s_waitcnt vmcnt(4)" ::: "memory"); else asm volatile("s_waitcnt vmcnt(0)" ::: "memory");
        bar();
        if (grp) bar();
        int cseg = 0, ckt = 0;
#pragma unroll 1
        for (int g = 0; g < total; ++g) {
            if (lg < total) issue();
            const LAS unsigned char* base = lds + (g & 3) * STAGE;
            bf16x8 af[4], bfr[8];
#pragma unroll
            for (int mi = 0; mi < 4; ++mi) af[mi] = *(const LAS bf16x8*)(base + a_rd[mi]);
#pragma unroll
            for (int ni = 0; ni < 8; ++ni) {
                const int u0 = wn * 8 + ni;
                const s16x4 lo = lds_tr(base + b_rd[0] + ((u0 ^ b_f[0]) << 5));
                const s16x4 hi = lds_tr(base + b_rd[1] + ((u0 ^ b_f[1]) << 5));
                bfr[ni] = (bf16x8){lo[0], lo[1], lo[2], lo[3], hi[0], hi[1], hi[2], hi[3]};
            }
            { const int rem = total - 2 - g;
              if (rem >= 2) asm volatile("s_waitcnt vmcnt(8)" ::: "memory"); else if (rem == 1) asm volatile("s_waitcnt vmcnt(4)" ::: "memory"); else asm volatile("s_waitcnt vmcnt(0)" ::: "memory"); }
            bar();
            __builtin_amdgcn_sched_barrier(0);
#pragma unroll
            for (int ni = 0; ni < 8; ++ni)
#pragma unroll
                for (int mi = 0; mi < 4; ++mi) acc[mi][ni] = __builtin_amdgcn_mfma_f32_16x16x32_bf16(bfr[ni], af[mi], acc[mi][ni], 0, 0, 0);
            __builtin_amdgcn_sched_barrier(0);
            bar();
            if (++ckt == KT) {
                if (!grp) bar();
                f.epi(cseg, acc);
#pragma unroll
                for (int mi = 0; mi < 4; ++mi)
#pragma unroll
                    for (int ni = 0; ni < 8; ++ni) acc[mi][ni] = (f32x4){0.f, 0.f, 0.f, 0.f};
                ckt = 0; ++cseg;
                if (grp) bar();
            }
        }
        if (!grp) bar();
    }
};

struct Gemm8 {
    static constexpr int A_BYTES = 16384, STAGE = 32768;
    static __device__ __forceinline__ int t_row(int i, int w, int lane) { return (i * 8 + w) * 16 + (lane >> 2); }
    static __device__ __forceinline__ int t_chunk(int row, int lane) { return (lane & 3) ^ ((row >> 1) & 3); }
    static __device__ __forceinline__ int w_col(int i) { return 16 * ((i >> 2) & 1) + 4 * (i >> 3) + (i & 3); }
    template <class F> static __device__ __forceinline__ void run_stream(F& f, int NSEG, int KT, LAS unsigned char* lds) {
        const int tid = opaque_tid(), lane = tid & 63, wid = tid >> 6, wm = wid >> 1, wn = wid & 1, l31 = lane & 31, hi = lane >> 5;
        const int wu = __builtin_amdgcn_readfirstlane(wid);
        f32x16 acc[2][4];
#pragma unroll
        for (int jt = 0; jt < 2; ++jt)
#pragma unroll
            for (int it = 0; it < 4; ++it)
#pragma unroll
                for (int r = 0; r < 16; ++r) acc[jt][it][r] = 0.f;
        const int sw = (l31 >> 1) & 3;
        const int t_rd0 = (wm * 64 + l31) * 64 + (((2 * hi) ^ sw) << 4), t_rd1 = (wm * 64 + l31) * 64 + (((2 * hi + 1) ^ sw) << 4);
        const int w_rd0 = A_BYTES + (wn * 128 + l31) * 64 + (((2 * hi) ^ sw) << 4), w_rd1 = A_BYTES + (wn * 128 + l31) * 64 + (((2 * hi + 1) ^ sw) << 4);
        const unsigned lds0 = (unsigned)(uintptr_t)lds + (unsigned)wu * 1024u;
        const unsigned char* aptr[2]; const unsigned char* wptr[2];
        const int total = NSEG * KT;
        int lseg = 0, lkt = 0, lg = 0;
        auto issue = [&]() {
            const unsigned base = (unsigned)__builtin_amdgcn_readfirstlane((int)(lds0 + (unsigned)(lg & 3) * STAGE));
#pragma unroll
            for (int i = 0; i < 2; ++i) glds16(aptr[i] + lkt * 64, base + i * 8192);
#pragma unroll
            for (int i = 0; i < 2; ++i) glds16(wptr[i] + lkt * 64, base + A_BYTES + i * 8192);
            ++lg; if (++lkt == KT) { lkt = 0; ++lseg; if (lseg < NSEG) f.ptrs(lseg, aptr, wptr); }
        };
        const int grp = wu >> 2;
        auto bar = [&]() { asm volatile("s_waitcnt lgkmcnt(0)" ::: "memory"); __builtin_amdgcn_s_barrier(); asm volatile("" ::: "memory"); };
        f.ptrs(0, aptr, wptr);
        asm volatile("s_waitcnt vmcnt(0)" ::: "memory");
        issue(); if (total > 1) issue(); if (total > 2) issue();
        if (total > 2) asm volatile("s_waitcnt vmcnt(8)" ::: "memory"); else if (total > 1) asm volatile("s_waitcnt vmcnt(4)" ::: "memory"); else asm volatile("s_waitcnt vmcnt(0)" ::: "memory");
        bar();
        if (grp) bar();
        int cseg = 0, ckt = 0;
#pragma unroll 1
        for (int g = 0; g < total; ++g) {
            if (lg < total) issue();
            const LAS unsigned char* base = lds + (g & 3) * STAGE;
            i32x8 tf[2], wf[4];
#pragma unroll
            for (int jt = 0; jt < 2; ++jt) { const u32x4 lo = *(const LAS u32x4*)(base + t_rd0 + jt * 2048), h4 = *(const LAS u32x4*)(base + t_rd1 + jt * 2048);
                tf[jt] = (i32x8){(int)lo.x, (int)lo.y, (int)lo.z, (int)lo.w, (int)h4.x, (int)h4.y, (int)h4.z, (int)h4.w}; }
#pragma unroll
            for (int it = 0; it < 4; ++it) { const u32x4 lo = *(const LAS u32x4*)(base + w_rd0 + it * 2048), h4 = *(const LAS u32x4*)(base + w_rd1 + it * 2048);
                wf[it] = (i32x8){(int)lo.x, (int)lo.y, (int)lo.z, (int)lo.w, (int)h4.x, (int)h4.y, (int)h4.z, (int)h4.w}; }
            { const int rem = total - 2 - g;
              if (rem >= 2) asm volatile("s_waitcnt vmcnt(8)" ::: "memory"); else if (rem == 1) asm volatile("s_waitcnt vmcnt(4)" ::: "memory"); else asm volatile("s_waitcnt vmcnt(0)" ::: "memory"); }
            bar();
            __builtin_amdgcn_sched_barrier(0);
#pragma unroll
            for (int it = 0; it < 4; ++it)
#pragma unroll
                for (int jt = 0; jt < 2; ++jt) acc[jt][it] = __builtin_amdgcn_mfma_scale_f32_32x32x64_f8f6f4(wf[it], tf[jt], acc[jt][it], 0, 0, 0, F::wscale(it), 0, 127);
            __builtin_amdgcn_sched_barrier(0);
            bar();
            if (++ckt == KT) {
                if (!grp) bar();
                f.epi(cseg, acc);
#pragma unroll
                for (int jt = 0; jt < 2; ++jt)
#pragma unroll
                    for (int it = 0; it < 4; ++it)
#pragma unroll
                        for (int r = 0; r < 16; ++r) acc[jt][it][r] = 0.f;
                ckt = 0; ++cseg;
                if (grp) bar();
            }
        }
        if (!grp) bar();
    }
};

struct Gemm4 {
    static constexpr int A_BYTES = 16384, STAGE = 32768, LDS_BYTES = 2 * STAGE;
    static __device__ __forceinline__ int fk2(int r) { return (r & 3) | (((r >> 3) & 1) << 2); }
    static __device__ __forceinline__ int a_row(int i, int tid) { return (tid >> 2) + 128 * i; }
    static __device__ __forceinline__ int b_k(int i, int tid) { return (tid >> 5) + 16 * i; }
    static __device__ __forceinline__ void run(f32x4 (&acc)[4][8], const bf16_t* const (&aptr)[2], int a_kstride, const bf16_t* const (&bptr)[2], size_t b_kstride, int KT, LAS unsigned char* lds) {
        const int tid = opaque_tid(), lane = tid & 63, wid = tid >> 6, wm = wid >> 1, wn = wid & 1, fr = lane & 15, fq = lane >> 4;
#pragma unroll
        for (int mi = 0; mi < 4; ++mi)
#pragma unroll
            for (int ni = 0; ni < 8; ++ni) acc[mi][ni] = (f32x4){0.f, 0.f, 0.f, 0.f};
        int a_wr[2], b_wr[2];
#pragma unroll
        for (int i = 0; i < 2; ++i) { const int row = a_row(i, tid); a_wr[i] = row * 64 + (((tid & 3) ^ ((row >> 1) & 3)) << 4);
            const int k = b_k(i, tid), n = (tid & 31) * 8; b_wr[i] = A_BYTES + k * 512 + (((n >> 4) ^ fk2(k)) << 5) + ((n & 15) << 1); }
        int a_rd[4];
#pragma unroll
        for (int mi = 0; mi < 4; ++mi) { const int row = wm * 64 + mi * 16 + fr; a_rd[mi] = row * 64 + ((fq ^ ((row >> 1) & 3)) << 4); }
        int b_rd[2], b_f[2];
#pragma unroll
        for (int t = 0; t < 2; ++t) { const int k = 8 * fq + 4 * t + (fr >> 2); b_f[t] = fk2(k); b_rd[t] = A_BYTES + k * 512 + ((fr & 3) << 3); }
        u32x4 ra0[2], rb0[2], ra1[2], rb1[2];
        auto gload = [&](int kt, u32x4 (&ra)[2], u32x4 (&rb)[2]) {
#pragma unroll
            for (int i = 0; i < 2; ++i) { ra[i] = *(const u32x4*)(aptr[i] + (size_t)kt * a_kstride); rb[i] = *(const u32x4*)(bptr[i] + (size_t)kt * b_kstride); }
        };
        auto lstore = [&](int buf, const u32x4 (&ra)[2], const u32x4 (&rb)[2]) {
            LAS unsigned char* base = lds + buf * STAGE;
#pragma unroll
            for (int i = 0; i < 2; ++i) { *(LAS u32x4*)(base + a_wr[i]) = ra[i]; *(LAS u32x4*)(base + b_wr[i]) = rb[i]; }
        };
        auto compute = [&](int buf) {
            const LAS unsigned char* base = lds + buf * STAGE;
            bf16x8 af[4];
#pragma unroll
            for (int mi = 0; mi < 4; ++mi) af[mi] = *(const LAS bf16x8*)(base + a_rd[mi]);
#pragma unroll
            for (int ni = 0; ni < 8; ++ni) {
                const int u0 = wn * 8 + ni;
                const s16x4 lo = lds_tr(base + b_rd[0] + ((u0 ^ b_f[0]) << 5));
                const s16x4 hi = lds_tr(base + b_rd[1] + ((u0 ^ b_f[1]) << 5));
                const bf16x8 bfr = (bf16x8){lo[0], lo[1], lo[2], lo[3], hi[0], hi[1], hi[2], hi[3]};
#pragma unroll
                for (int mi = 0; mi < 4; ++mi) acc[mi][ni] = __builtin_amdgcn_mfma_f32_16x16x32_bf16(bfr, af[mi], acc[mi][ni], 0, 0, 0);
            }
        };
        gload(0, ra0, rb0); gload(1, ra1, rb1);
        lstore(0, ra0, rb0); __syncthreads();
        for (int kt = 0; kt < KT; kt += 2) {
            gload(kt + 2 < KT ? kt + 2 : KT - 1, ra0, rb0);
            __builtin_amdgcn_sched_barrier(0);
            compute(0);
            lstore(1, ra1, rb1);
            __syncthreads();
            gload(kt + 3 < KT ? kt + 3 : KT - 1, ra1, rb1);
            __builtin_amdgcn_sched_barrier(0);
            compute(1);
            lstore(0, ra0, rb0);
            __syncthreads();
        }
    }

    template <class F> static __device__ __forceinline__ void run_stream(F& f, int NSEG, int KT, int a_kstride, size_t b_kstride, LAS unsigned char* lds) {
        const int tid = opaque_tid(), lane = tid & 63, wid = tid >> 6, wm = wid >> 1, wn = wid & 1, fr = lane & 15, fq = lane >> 4;
        f32x4 acc[4][8];
#pragma unroll
        for (int mi = 0; mi < 4; ++mi)
#pragma unroll
            for (int ni = 0; ni < 8; ++ni) acc[mi][ni] = (f32x4){0.f, 0.f, 0.f, 0.f};
        int a_wr[2], b_wr[2];
#pragma unroll
        for (int i = 0; i < 2; ++i) { const int row = a_row(i, tid); a_wr[i] = row * 64 + (((tid & 3) ^ ((row >> 1) & 3)) << 4);
            const int k = b_k(i, tid), n = (tid & 31) * 8; b_wr[i] = A_BYTES + k * 512 + (((n >> 4) ^ fk2(k)) << 5) + ((n & 15) << 1); }
        int a_rd[4];
#pragma unroll
        for (int mi = 0; mi < 4; ++mi) { const int row = wm * 64 + mi * 16 + fr; a_rd[mi] = row * 64 + ((fq ^ ((row >> 1) & 3)) << 4); }
        int b_rd[2], b_f[2];
#pragma unroll
        for (int t = 0; t < 2; ++t) { const int k = 8 * fq + 4 * t + (fr >> 2); b_f[t] = fk2(k); b_rd[t] = A_BYTES + k * 512 + ((fr & 3) << 3); }
        const bf16_t* aptr[2]; const bf16_t* bptr[2];
        u32x4 ra0[2], rb0[2], ra1[2], rb1[2];
        int lseg = 0, lkt = 0;
        auto gload = [&](u32x4 (&ra)[2], u32x4 (&rb)[2]) {
#pragma unroll
            for (int i = 0; i < 2; ++i) { ra[i] = *(const u32x4*)(aptr[i] + (size_t)lkt * a_kstride); rb[i] = *(const u32x4*)(bptr[i] + (size_t)lkt * b_kstride); }
            if (lkt + 1 < KT) ++lkt; else if (lseg + 1 < NSEG) { lkt = 0; ++lseg; f.ptrs(lseg, aptr, bptr); }
        };
        auto lstore = [&](int buf, const u32x4 (&ra)[2], const u32x4 (&rb)[2]) {
            LAS unsigned char* base = lds + buf * STAGE;
#pragma unroll
            for (int i = 0; i < 2; ++i) { *(LAS u32x4*)(base + a_wr[i]) = ra[i]; *(LAS u32x4*)(base + b_wr[i]) = rb[i]; }
        };
        auto compute = [&](int buf) {
            const LAS unsigned char* base = lds + buf * STAGE;
            bf16x8 af[4];
#pragma unroll
            for (int mi = 0; mi < 4; ++mi) af[mi] = *(const LAS bf16x8*)(base + a_rd[mi]);
#pragma unroll
            for (int ni = 0; ni < 8; ++ni) {
                const int u0 = wn * 8 + ni;
                const s16x4 lo = lds_tr(base + b_rd[0] + ((u0 ^ b_f[0]) << 5));
                const s16x4 hi = lds_tr(base + b_rd[1] + ((u0 ^ b_f[1]) << 5));
                const bf16x8 bfr = (bf16x8){lo[0], lo[1], lo[2], lo[3], hi[0], hi[1], hi[2], hi[3]};
#pragma unroll
                for (int mi = 0; mi < 4; ++mi) acc[mi][ni] = __builtin_amdgcn_mfma_f32_16x16x32_bf16(bfr, af[mi], acc[mi][ni], 0, 0, 0);
            }
        };
        f.ptrs(0, aptr, bptr);
        gload(ra0, rb0); gload(ra1, rb1);
        lstore(0, ra0, rb0); __syncthreads();
        int cseg = 0, ckt = 0;
        const int total = NSEG * KT;
#pragma unroll 1
        for (int g = 0; g < total; g += 2) {
            gload(ra0, rb0);
            __builtin_amdgcn_sched_barrier(0);
            compute(0);
            lstore(1, ra1, rb1);
            __syncthreads();
            gload(ra1, rb1);
            __builtin_amdgcn_sched_barrier(0);
            compute(1);
            lstore(0, ra0, rb0);
            __syncthreads();
            ckt += 2;
            if (ckt == KT) {
                f.epi(cseg, acc);
#pragma unroll
                for (int mi = 0; mi < 4; ++mi)
#pragma unroll
                    for (int ni = 0; ni < 8; ++ni) acc[mi][ni] = (f32x4){0.f, 0.f, 0.f, 0.f};
                ckt = 0; ++cseg;
            }
        }
    }
};

template <bool BF32> struct Gemm5 {
    static constexpr int A_BYTES = 16384, STAGE = 32768, LDS_BYTES = 2 * STAGE;
    static __device__ __forceinline__ int fk2(int r) { return (r & 3) | (((r >> 3) & 1) << 2); }
    static __device__ __forceinline__ int a_row(int i, int tid) { return (tid >> 2) + 128 * i; }
    static __device__ __forceinline__ int b_k(int i, int tid) { return (tid >> 5) + 16 * i; }
    typedef typename std::conditional<BF32, float, bf16_t>::type b_t;
    static __device__ __forceinline__ void run(f32x4 (&acc)[4][8], const bf16_t* const (&aptr)[2], int a_kstride, const b_t* const (&bptr)[2], size_t b_kstride, int KT, LAS unsigned char* lds) {
        const int tid = opaque_tid(), lane = tid & 63, wid = tid >> 6, wm = wid >> 1, wn = wid & 1, fr = lane & 15, fq = lane >> 4;
#pragma unroll
        for (int mi = 0; mi < 4; ++mi)
#pragma unroll
            for (int ni = 0; ni < 8; ++ni) acc[mi][ni] = (f32x4){0.f, 0.f, 0.f, 0.f};
        int a_wr[2], b_wr[2];
#pragma unroll
        for (int i = 0; i < 2; ++i) { const int row = a_row(i, tid); a_wr[i] = row * 64 + (((tid & 3) ^ ((row >> 1) & 3)) << 4);
            const int k = b_k(i, tid), n = (tid & 31) * 8; b_wr[i] = A_BYTES + k * 512 + (((n >> 4) ^ fk2(k)) << 5) + ((n & 15) << 1); }
        int a_rd[4];
#pragma unroll
        for (int mi = 0; mi < 4; ++mi) { const int row = wm * 64 + mi * 16 + fr; a_rd[mi] = row * 64 + ((fq ^ ((row >> 1) & 3)) << 4); }
        int b_rd[2], b_f[2];
#pragma unroll
        for (int t = 0; t < 2; ++t) { const int k = 8 * fq + 4 * t + (fr >> 2); b_f[t] = fk2(k); b_rd[t] = A_BYTES + k * 512 + ((fr & 3) << 3); }
        u32x4 ra[2]; u32x4 rb[2]; f32x4 rbf[2][2];
        auto gload = [&](int kt) {
#pragma unroll
            for (int i = 0; i < 2; ++i) { ra[i] = *(const u32x4*)(aptr[i] + (size_t)kt * a_kstride);
                if (BF32) { const float* p = (const float*)bptr[i] + (size_t)kt * b_kstride; rbf[i][0] = *(const f32x4*)p; rbf[i][1] = *(const f32x4*)(p + 4); }
                else rb[i] = *(const u32x4*)((const bf16_t*)bptr[i] + (size_t)kt * b_kstride); }
        };
        auto lstore = [&](int buf) {
            LAS unsigned char* base = lds + buf * STAGE;
#pragma unroll
            for (int i = 0; i < 2; ++i) { *(LAS u32x4*)(base + a_wr[i]) = ra[i];
                if (BF32) { u32x4 w; w.x = cvtpk(rbf[i][0].x, rbf[i][0].y); w.y = cvtpk(rbf[i][0].z, rbf[i][0].w); w.z = cvtpk(rbf[i][1].x, rbf[i][1].y); w.w = cvtpk(rbf[i][1].z, rbf[i][1].w); *(LAS u32x4*)(base + b_wr[i]) = w; }
                else *(LAS u32x4*)(base + b_wr[i]) = rb[i]; }
        };
        auto compute = [&](int buf) {
            const LAS unsigned char* base = lds + buf * STAGE;
            bf16x8 af[4];
#pragma unroll
            for (int mi = 0; mi < 4; ++mi) af[mi] = *(const LAS bf16x8*)(base + a_rd[mi]);
#pragma unroll
            for (int ni = 0; ni < 8; ++ni) {
                const int u0 = wn * 8 + ni;
                const s16x4 lo = lds_tr(base + b_rd[0] + ((u0 ^ b_f[0]) << 5));
                const s16x4 hi = lds_tr(base + b_rd[1] + ((u0 ^ b_f[1]) << 5));
                const bf16x8 bfr = (bf16x8){lo[0], lo[1], lo[2], lo[3], hi[0], hi[1], hi[2], hi[3]};
#pragma unroll
                for (int mi = 0; mi < 4; ++mi) acc[mi][ni] = __builtin_amdgcn_mfma_f32_16x16x32_bf16(bfr, af[mi], acc[mi][ni], 0, 0, 0);
            }
        };
        gload(0); lstore(0); __syncthreads();
#pragma unroll 1
        for (int kt = 0; kt < KT; ++kt) {
            gload(kt + 1 < KT ? kt + 1 : KT - 1);
            __builtin_amdgcn_sched_barrier(0);
            compute(kt & 1);
            lstore((kt + 1) & 1);
            __syncthreads();
        }
    }

    template <class F> static __device__ __forceinline__ void run_stream(F& f, int NSEG, int KT, int a_kstride, size_t b_kstride, LAS unsigned char* lds) {
        const int tid = opaque_tid(), lane = tid & 63, wid = tid >> 6, wm = wid >> 1, wn = wid & 1, fr = lane & 15, fq = lane >> 4;
        f32x4 acc[4][8];
#pragma unroll
        for (int mi = 0; mi < 4; ++mi)
#pragma unroll
            for (int ni = 0; ni < 8; ++ni) acc[mi][ni] = (f32x4){0.f, 0.f, 0.f, 0.f};
        int a_wr[2], b_wr[2];
#pragma unroll
        for (int i = 0; i < 2; ++i) { const int row = a_row(i, tid); a_wr[i] = row * 64 + (((tid & 3) ^ ((row >> 1) & 3)) << 4);
            const int k = b_k(i, tid), n = (tid & 31) * 8; b_wr[i] = A_BYTES + k * 512 + (((n >> 4) ^ fk2(k)) << 5) + ((n & 15) << 1); }
        int a_rd[4];
#pragma unroll
        for (int mi = 0; mi < 4; ++mi) { const int row = wm * 64 + mi * 16 + fr; a_rd[mi] = row * 64 + ((fq ^ ((row >> 1) & 3)) << 4); }
        int b_rd[2], b_f[2];
#pragma unroll
        for (int t = 0; t < 2; ++t) { const int k = 8 * fq + 4 * t + (fr >> 2); b_f[t] = fk2(k); b_rd[t] = A_BYTES + k * 512 + ((fr & 3) << 3); }
        const bf16_t* aptr[2]; const b_t* bptr[2];
        u32x4 ra[2]; u32x4 rb[2]; f32x4 rbf[2][2];
        auto gload = [&](int kt) {
#pragma unroll
            for (int i = 0; i < 2; ++i) { ra[i] = *(const u32x4*)(aptr[i] + (size_t)kt * a_kstride);
                if (BF32) { const float* p = (const float*)bptr[i] + (size_t)kt * b_kstride; rbf[i][0] = *(const f32x4*)p; rbf[i][1] = *(const f32x4*)(p + 4); }
                else rb[i] = *(const u32x4*)((const bf16_t*)bptr[i] + (size_t)kt * b_kstride); }
        };
        auto lstore = [&](int buf) {
            LAS unsigned char* base = lds + buf * STAGE;
#pragma unroll
            for (int i = 0; i < 2; ++i) { *(LAS u32x4*)(base + a_wr[i]) = ra[i];
                if (BF32) { u32x4 w; w.x = cvtpk(rbf[i][0].x, rbf[i][0].y); w.y = cvtpk(rbf[i][0].z, rbf[i][0].w); w.z = cvtpk(rbf[i][1].x, rbf[i][1].y); w.w = cvtpk(rbf[i][1].z, rbf[i][1].w); *(LAS u32x4*)(base + b_wr[i]) = w; }
                else *(LAS u32x4*)(base + b_wr[i]) = rb[i]; }
        };
        auto compute = [&](int buf) {
            const LAS unsigned char* base = lds + buf * STAGE;
            bf16x8 af[4];
#pragma unroll
            for (int mi = 0; mi < 4; ++mi) af[mi] = *(const LAS bf16x8*)(base + a_rd[mi]);
#pragma unroll
            for (int ni = 0; ni < 8; ++ni) {
                const int u0 = wn * 8 + ni;
                const s16x4 lo = lds_tr(base + b_rd[0] + ((u0 ^ b_f[0]) << 5));
                const s16x4 hi = lds_tr(base + b_rd[1] + ((u0 ^ b_f[1]) << 5));
                const bf16x8 bfr = (bf16x8){lo[0], lo[1], lo[2], lo[3], hi[0], hi[1], hi[2], hi[3]};
#pragma unroll
                for (int mi = 0; mi < 4; ++mi) acc[mi][ni] = __builtin_amdgcn_mfma_f32_16x16x32_bf16(bfr, af[mi], acc[mi][ni], 0, 0, 0);
            }
        };
        f.ptrs(0, aptr, bptr);
        gload(0); lstore(0); __syncthreads();
        int seg = 0, kt = 0;
        const int total = NSEG * KT;
#pragma unroll 1
        for (int g = 0; g < total; ++g) {
            int nkt = kt + 1, nsg = seg; if (nkt == KT) { nkt = 0; nsg = seg + 1; }
            if (nkt == 0 && nsg < NSEG) f.ptrs(nsg, aptr, bptr);
            gload(nsg < NSEG ? nkt : KT - 1);
            __builtin_amdgcn_sched_barrier(0);
            compute(g & 1);
            lstore((g + 1) & 1);
            __syncthreads();
            if (nkt == 0) {
                f.epi(seg, acc);
#pragma unroll
                for (int mi = 0; mi < 4; ++mi)
#pragma unroll
                    for (int ni = 0; ni < 8; ++ni) acc[mi][ni] = (f32x4){0.f, 0.f, 0.f, 0.f};
            }
            seg = nsg; kt = nkt;
        }
    }
};

__device__ __forceinline__ int p2_col(int m0);
__device__ __forceinline__ unsigned pk4_fp8(float a, float b, float c, float d) { int pk = __builtin_amdgcn_cvt_pk_fp8_f32(a, b, 0, false); pk = __builtin_amdgcn_cvt_pk_fp8_f32(c, d, pk, true); return (unsigned)pk; }
__device__ __forceinline__ int w8_col(int i) { return 16 * ((i >> 2) & 1) + 4 * (i >> 3) + (i & 3); }
__device__ __forceinline__ void phase_mod(const Params& P, LAS unsigned char* lds) {
    const int tid = threadIdx.x;
    float* mod = (float*)(P.ws + WS_MOD);
    LAS float* sc = (LAS float*)lds;
    LAS float* red = (LAS float*)(lds + 16384);
    for (int i = tid; i < 4096; i += NTHREADS) sc[i] = siluf_(P.c[i]);
    __syncthreads();
    const int kq = tid >> 5, cl = tid & 31;
    for (int u = blockIdx.x; u < 192; u += gridDim.x) {
        const int j = u * 32 + cl;
        float a0 = 0.f, a1 = 0.f, a2 = 0.f, a3 = 0.f;
#pragma unroll 8
        for (int k = kq; k < 1024; k += 16) { const float w = P.ada_w[(size_t)k * 6144 + j];
            a0 += sc[k] * w; a1 += sc[1024 + k] * w; a2 += sc[2048 + k] * w; a3 += sc[3072 + k] * w; }
        red[(kq * 4 + 0) * 32 + cl] = a0; red[(kq * 4 + 1) * 32 + cl] = a1; red[(kq * 4 + 2) * 32 + cl] = a2; red[(kq * 4 + 3) * 32 + cl] = a3;
        __syncthreads();
        if (tid < 128) { const int b = tid >> 5; float s = 0.f;
#pragma unroll
            for (int q = 0; q < 16; ++q) s += red[(q * 4 + b) * 32 + cl];
            mod[b * 6144 + j] = s + P.ada_b[j]; }
        __syncthreads();
    }
    for (int u = blockIdx.x; u < 16; u += gridDim.x) {
        const int sel = u >> 3, j = (u & 7) * 32 + cl;
        const float* w1 = P.cmp_w1 + (size_t)sel * 2048 * 256; const float* pos = P.cmp_pos + sel * 2048;
        float a0 = 0.f;
#pragma unroll 8
        for (int k = kq; k < 2048; k += 16) a0 += pos[k] * w1[(size_t)k * 256 + j];
        red[kq * 32 + cl] = a0;
        __syncthreads();
        if (tid < 32) { float s = 0.f;
#pragma unroll
            for (int q = 0; q < 16; ++q) s += red[q * 32 + cl];
            ((float*)(P.ws + WS_CB))[sel * 256 + j] = s + P.cmp_b1[sel * 256 + j]; }
        __syncthreads();
    }
    {
        unsigned char* wb = (unsigned char*)(P.ws + WS_WIN);
        const int lane = tid & 63, gw = blockIdx.x * (NTHREADS / 64) + (tid >> 6), NGW = gridDim.x * (NTHREADS / 64);
        for (int u = gw; u < 56 * 16; u += NGW) {
            const int rg = u % 56, kb = u / 56, q = rg * 64 + lane, c8 = (q & ~31) + w8_col(q & 31);
            const int sc_ = c8 < 1280 ? c8 : (c8 < 3328 ? c8 + 24 : c8 - 2048);
            const float* s = P.w_in + (size_t)(kb * 64) * IN_COLS + (c8 < 3352 ? sc_ : 0);
            float v[64];
#pragma unroll
            for (int j = 0; j < 64; ++j) v[j] = s[(size_t)j * IN_COLS];
            const float c_ = c8 < 3352 ? 64.0f : 0.0f;
#pragma unroll
            for (int j = 0; j < 4; ++j) { u32x4 w;
                w.x = pk4_fp8(v[16 * j] * c_, v[16 * j + 1] * c_, v[16 * j + 2] * c_, v[16 * j + 3] * c_); w.y = pk4_fp8(v[16 * j + 4] * c_, v[16 * j + 5] * c_, v[16 * j + 6] * c_, v[16 * j + 7] * c_);
                w.z = pk4_fp8(v[16 * j + 8] * c_, v[16 * j + 9] * c_, v[16 * j + 10] * c_, v[16 * j + 11] * c_); w.w = pk4_fp8(v[16 * j + 12] * c_, v[16 * j + 13] * c_, v[16 * j + 14] * c_, v[16 * j + 15] * c_);
                *(u32x4*)(wb + (size_t)q * 1024 + kb * 64 + j * 16) = w; }
        }
    }
    if (blockIdx.x == gridDim.x - 2) {
        for (int i = tid; i < 2 * 8 * 64; i += NTHREADS) { const int t2 = i >> 9, bg = (i >> 6) & 7, d = i & 63;
            ((bf16_t*)(P.ws + (t2 ? WS_VC : WS_KC)))[((size_t)bg * 512 + 511) * 64 + d] = 0; }
    }
    if (blockIdx.x == gridDim.x - 1) {
        float* lb = (float*)(P.ws + WS_LB);
        for (int i = tid; i < 512; i += NTHREADS) { const float p0 = P.hgrn_lb[i], p1 = P.hgrn_lb[512 + i]; lb[i] = 1.0f / (1.0f + __expf(p1 - p0)); }
    }
}

__device__ __forceinline__ void norm_mod_rows(const float* x, const float* w, const float* mod_sh, const float* mod_sc, unsigned char* h, int hs) {
    const int lane = threadIdx.x & 63, gw = blockIdx.x * (NTHREADS / 64) + (threadIdx.x >> 6), NGW = gridDim.x * (NTHREADS / 64);
    for (int m = gw; m < T; m += NGW) {
        const int b = m / SEQ;
        const f32x4* xr = (const f32x4*)(x + (size_t)m * D) + lane;
        f32x4 v[4]; float s = 0.f;
#pragma unroll
        for (int j = 0; j < 4; ++j) { v[j] = xr[64 * j]; s += (v[j].x * v[j].x + v[j].y * v[j].y) + (v[j].z * v[j].z + v[j].w * v[j].w); }
        const float rstd = rsqrtf(wave_sum(s) * (1.f / D) + RMS_EPS);
        unsigned* o = (unsigned*)(h + (size_t)m * hs) + lane;
#pragma unroll
        for (int j = 0; j < 4; ++j) {
            const int col = (lane + 64 * j) * 4;
            const f32x4 wv = *(const f32x4*)(w + col), scv = *(const f32x4*)(mod_sc + b * 6144 + col), shv = *(const f32x4*)(mod_sh + b * 6144 + col);
            f32x4 r;
            r.x = v[j].x * rstd * wv.x * (1.f + scv.x) + shv.x; r.y = v[j].y * rstd * wv.y * (1.f + scv.y) + shv.y;
            r.z = v[j].z * rstd * wv.z * (1.f + scv.z) + shv.z; r.w = v[j].w * rstd * wv.w * (1.f + scv.w) + shv.w;
            o[64 * j] = pk4_fp8(r.x, r.y, r.z, r.w);
        }
    }
}

__device__ __forceinline__ void phase_inproj(const Params& P, LAS unsigned char* lds) {
    constexpr int NRT = T / 256, NCT = 14;
    struct F { const Params& P;
        static __device__ __forceinline__ int wscale(int) { return 121; }
        __device__ __forceinline__ void unit(int seg, int& rt, int& ct) const {
            const int nx = (gridDim.x % 8 == 0) ? 8 : 1, xl = blockIdx.x % nx, li = blockIdx.x / nx, nloc = gridDim.x / nx;
            const int v = li + seg * nloc, rg = v / (NCT * 4), rem = v % (NCT * 4); ct = rem >> 2; rt = xl + nx * (rg * 4 + (rem & 3)); }
        __device__ __forceinline__ void ptrs(int seg, const unsigned char* (&aptr)[2], const unsigned char* (&wptr)[2]) const {
            const int tid = opaque_tid(), lane = tid & 63, wid = tid >> 6; int rt, ct; unit(seg, rt, ct);
            const unsigned char* h1 = (const unsigned char*)(P.ws + WS_H); const unsigned char* wb = (const unsigned char*)(P.ws + WS_WIN);
#pragma unroll
            for (int i = 0; i < 2; ++i) { const int row = Gemm8::t_row(i, wid, lane); aptr[i] = h1 + (size_t)(rt * 256 + row) * H1S + Gemm8::t_chunk(row, lane) * 16;
                wptr[i] = wb + (size_t)(ct * 256 + row) * 1024 + Gemm8::t_chunk(row, lane) * 16; } }
        __device__ __forceinline__ void epi(int seg, f32x16 (&acc)[2][4]) const {
            const int tid = opaque_tid(), lane = tid & 63, wid = tid >> 6, wm = wid >> 1, wn = wid & 1, l31 = lane & 31, hi = lane >> 5;
            int rt, ct; unit(seg, rt, ct);
            bf16_t* qo = (bf16_t*)(P.ws + WS_Q); bf16_t* kvo = (bf16_t*)(P.ws + WS_KV); float* gates = (float*)(P.ws + WS_GATES);
            bf16_t* hq = (bf16_t*)(P.ws + WS_HQ); float* logf = (float*)(P.ws + WS_LOGF); bf16_t* hv = (bf16_t*)(P.ws + WS_HV); bf16_t* hg = (bf16_t*)(P.ws + WS_HG);
            const float* lb = (const float*)(P.ws + WS_LB);
            const int row0 = rt * 256 + wm * 64 + l31;
            if (ct < 5) {
                const bool is_q = ct < 2; const int sg = (ct - 2) * 2 + wn;
                const bool do_norm = is_q || sg == 2 || sg == 4;
                const float* nw = is_q ? P.q_norm_w : (P.k_norm_w + (sg == 2 ? 64 : 128));
                const float osc = is_q ? 0.125f : 1.0f;
#pragma unroll
                for (int hh = 0; hh < 2; ++hh) {
#pragma unroll
                    for (int jt = 0; jt < 2; ++jt) {
                        float rstd = 1.f;
                        if (do_norm) { float s = 0.f;
#pragma unroll
                            for (int t2 = 0; t2 < 2; ++t2)
#pragma unroll
                                for (int r = 0; r < 16; ++r) { const float a = acc[jt][2 * hh + t2][r]; s += a * a; }
                            s += __shfl_xor(s, 32);
                            rstd = rsqrtf(s * (1.f / 64.f) + RMS_EPS) * osc; }
                        const size_t m = (size_t)(row0 + jt * 32);
                        bf16_t* dst = is_q ? (qo + m * 512 + ct * 256 + wn * 128 + hh * 64 + 16 * hi) : (kvo + m * 768 + (ct - 2) * 256 + wn * 128 + hh * 64 + 16 * hi);
#pragma unroll
                        for (int t2 = 0; t2 < 2; ++t2) { u32x4 w0, w1;
#pragma unroll
                            for (int q4 = 0; q4 < 4; ++q4) { const f32x4 wv = do_norm ? *(const f32x4*)(nw + t2 * 32 + 16 * hi + 4 * q4) : (f32x4){1.f, 1.f, 1.f, 1.f};
                                const unsigned lo = cvtpk(acc[jt][2 * hh + t2][4 * q4] * rstd * wv.x, acc[jt][2 * hh + t2][4 * q4 + 1] * rstd * wv.y), hi2 = cvtpk(acc[jt][2 * hh + t2][4 * q4 + 2] * rstd * wv.z, acc[jt][2 * hh + t2][4 * q4 + 3] * rstd * wv.w);
                                if (q4 < 2) { w0[2 * q4] = lo; w0[2 * q4 + 1] = hi2; } else { w1[2 * (q4 - 2)] = lo; w1[2 * (q4 - 2) + 1] = hi2; } }
                            *(u32x4*)(dst + t2 * 32) = w0; *(u32x4*)(dst + t2 * 32 + 8) = w1; }
                    }
                }
            } else if (ct == 13) {
                if (wn == 0) {
#pragma unroll
                    for (int jt = 0; jt < 2; ++jt) { const size_t m = (size_t)(row0 + jt * 32);
#pragma unroll
                        for (int q4 = 0; q4 < 4; ++q4) { const int c = 16 * hi + 4 * q4; if (c < 24) {
                                *(f32x4*)(gates + m * 24 + c) = (f32x4){sigmoidf_(acc[jt][0][4 * q4]), sigmoidf_(acc[jt][0][4 * q4 + 1]), sigmoidf_(acc[jt][0][4 * q4 + 2]), sigmoidf_(acc[jt][0][4 * q4 + 3])}; } } }
                }
            } else {
                const int hs = (ct - 5) >> 1, cc = ((ct - 5) & 1) * 256 + wn * 128 + 16 * hi;
#pragma unroll
                for (int jt = 0; jt < 2; ++jt) { const size_t m = (size_t)(row0 + jt * 32);
#pragma unroll
                    for (int it = 0; it < 4; ++it) { const int c = cc + it * 32;
                        if (hs == 1) {
#pragma unroll
                            for (int q4 = 0; q4 < 4; ++q4) { const f32x4 l = *(const f32x4*)(lb + c + 4 * q4); f32x4 o;
                                o.x = __logf(l.x + (1.f - l.x) * sigmoidf_(acc[jt][it][4 * q4])); o.y = __logf(l.y + (1.f - l.y) * sigmoidf_(acc[jt][it][4 * q4 + 1]));
                                o.z = __logf(l.z + (1.f - l.z) * sigmoidf_(acc[jt][it][4 * q4 + 2])); o.w = __logf(l.w + (1.f - l.w) * sigmoidf_(acc[jt][it][4 * q4 + 3]));
                                *(f32x4*)(logf + m * 512 + c + 4 * q4) = o; }
                        } else { float v[16];
#pragma unroll
                            for (int r = 0; r < 16; ++r) { const float a = acc[jt][it][r]; v[r] = hs == 0 ? siluf_(a) * 0.08838834764831845f : (hs == 2 ? a : sigmoidf_(a)); }
                            bf16_t* dst = (hs == 0 ? hq : (hs == 2 ? hv : hg)) + m * 512 + c;
                            *(u32x4*)dst = (u32x4){cvtpk(v[0], v[1]), cvtpk(v[2], v[3]), cvtpk(v[4], v[5]), cvtpk(v[6], v[7])};
                            *(u32x4*)(dst + 8) = (u32x4){cvtpk(v[8], v[9]), cvtpk(v[10], v[11]), cvtpk(v[12], v[13]), cvtpk(v[14], v[15])}; }
                    } }
            }
        }
    } f{P};
    const int nx = (gridDim.x % 8 == 0) ? 8 : 1, li = blockIdx.x / nx, nloc = gridDim.x / nx;
    const int nu = ((NRT / nx) * NCT - li + nloc - 1) / nloc;
    if (nu > 0) Gemm8::run_stream(f, nu, D / 64, lds);
}

__device__ __forceinline__ float gelu_tanh(float x) {
    const float u = 0.7978845608028654f * (x + 0.044715f * x * x * x);
    const float th = 1.0f - 2.0f / (1.0f + __expf(2.0f * u));
    return 0.5f * x * (1.0f + th);
}
__device__ __forceinline__ void compress_unit(const Params& P, LAS unsigned char* lds, int u) {
    typedef GemmT<2, 4> G;
    const int tid = opaque_tid(), lane = tid & 63, wid = tid >> 6, wm = wid >> 2, wn = wid & 3, fr = lane & 15, fq = lane >> 4;
    const int sel = u >> 5, rt = u & 31;
    const bf16_t* kv = (const bf16_t*)(P.ws + WS_KV);
    bf16_t* cmph = (bf16_t*)(P.ws + WS_CMPH) + (size_t)sel * 4096 * 256;
    const float* cb = (const float*)(P.ws + WS_CB) + sel * 256;
    const bf16_t* arow[2];
#pragma unroll
    for (int p = 0; p < 2; ++p) { int r = rt * 128 + p * 64 + (tid >> 3); r = r < 4088 ? r : 4087;
        const int b = r / 1022, rem = r % 1022, i = rem >> 1, g = rem & 1;
        arow[p] = kv + (size_t)(b * SEQ + 16 * i) * 768 + sel * 128 + g * 64; }
    f32x4 acc[4][4];
    G::run(acc, arow, 768, P.cmp_w1 + (size_t)sel * 2048 * 256, 256, 32, lds);
#pragma unroll
    for (int mi = 0; mi < 4; ++mi) { const size_t row = (size_t)(rt * 128 + wm * 64 + mi * 16 + fr);
#pragma unroll
        for (int ni = 0; ni < 4; ++ni) { const int col = wn * 64 + ni * 16 + 4 * fq; const f32x4 a = acc[mi][ni]; const f32x4 bb = *(const f32x4*)(cb + col);
            u32x2 pk; pk.x = cvtpk(gelu_tanh(a.x + bb.x), gelu_tanh(a.y + bb.y)); pk.y = cvtpk(gelu_tanh(a.z + bb.z), gelu_tanh(a.w + bb.w));
            *(u32x2*)(cmph + row * 256 + col) = pk; } }
    __syncthreads();
    {
        const int row = tid >> 2, cq = tid & 3;
        const bf16_t* hr = cmph + (size_t)(rt * 128 + row) * 256;
        const float* w2 = P.cmp_w2 + (size_t)sel * 256 * 64 + cq * 16;
        float o[16];
#pragma unroll
        for (int j = 0; j < 16; ++j) o[j] = 0.f;
        for (int k8 = 0; k8 < 256; k8 += 8) {
            const u32x4 hv = *(const u32x4*)(hr + k8);
#pragma unroll
            for (int kk = 0; kk < 8; ++kk) {
                const unsigned wd = hv[kk >> 1]; const float a = (kk & 1) ? __uint_as_float(wd & 0xffff0000u) : __uint_as_float(wd << 16);
                const float* wr = w2 + (size_t)(k8 + kk) * 64;
#pragma unroll
                for (int j4 = 0; j4 < 4; ++j4) { const f32x4 w = *(const f32x4*)(wr + j4 * 4);
                    o[j4 * 4 + 0] += a * w.x; o[j4 * 4 + 1] += a * w.y; o[j4 * 4 + 2] += a * w.z; o[j4 * 4 + 3] += a * w.w; }
            }
        }
        if (sel == 0) { float s = 0.f;
#pragma unroll
            for (int j = 0; j < 16; ++j) s += o[j] * o[j];
            s += __shfl_xor(s, 1); s += __shfl_xor(s, 2);
            const float rstd = rsqrtf(s * (1.f / 64.f) + RMS_EPS);
#pragma unroll
            for (int j = 0; j < 16; ++j) o[j] *= rstd * P.k_norm_w[cq * 16 + j]; }
        const int r = rt * 128 + row;
        if (r < 4088) { const int b = r / 1022, rem = r % 1022, i = rem >> 1, g = rem & 1;
            bf16_t* dst = (bf16_t*)(P.ws + (sel ? WS_VC : WS_KC)) + ((size_t)(b * 2 + g) * 512 + i) * 64 + cq * 16;
            u32x4 w0, w1;
            w0.x = cvtpk(o[0], o[1]); w0.y = cvtpk(o[2], o[3]); w0.z = cvtpk(o[4], o[5]); w0.w = cvtpk(o[6], o[7]);
            w1.x = cvtpk(o[8], o[9]); w1.y = cvtpk(o[10], o[11]); w1.z = cvtpk(o[12], o[13]); w1.w = cvtpk(o[14], o[15]);
            *(u32x4*)dst = w0; *(u32x4*)(dst + 8) = w1; }
    }
    __syncthreads();
}

__device__ __forceinline__ int off_row128(int row, int ch) { return row * 128 + ((ch ^ ((row >> 1) & 7)) << 4); }
__device__ __forceinline__ int off_row256(int row, int ch) { return row * 256 + ((ch ^ (row & 15)) << 4); }
__device__ __forceinline__ int fk_(int r) { return (r & 3) | (((r >> 3) & 1) << 2); }
__device__ __forceinline__ int off_tr256(int row, int col) { return row * 256 + ((((col >> 4) ^ fk_(row)) << 5) + ((col & 15) << 1)); }
constexpr int HL_QT = 0, HL_KT = 16384, HL_KH = 32768, HL_V = 49152, HL_SB = 65536, HL_P = 98304  , HL_TOT = 106496  , HL_RED = 110592  , HL_END = 111104;

template <int MODE> __device__ __forceinline__ void hgrn_unit(const Params& P, LAS unsigned char* lds, int u) {
    const int tid = opaque_tid(), lane = tid & 63, wid = tid >> 6, fr = lane & 15, fq = lane >> 4;
    const int b = u >> 7, h = (u >> 5) & 3, sc = u & 31;
    const bf16_t* hq = (const bf16_t*)(P.ws + WS_HQ); const float* logf = (const float*)(P.ws + WS_LOGF);
    const bf16_t* hv = (const bf16_t*)(P.ws + WS_HV); const bf16_t* hg = (const bf16_t*)(P.ws + WS_HG);
    float* HLs = (float*)(P.ws + WS_HL); float* HDs = (float*)(P.ws + WS_HD);
    bf16_t* mix = (bf16_t*)(P.ws + WS_MIX);
    LAS float* tot = (LAS float*)(lds + HL_TOT); LAS float* red = (LAS float*)(lds + HL_RED);
    f32x4 st[8];
#pragma unroll
    for (int vt = 0; vt < 8; ++vt) st[vt] = (f32x4){0.f, 0.f, 0.f, 0.f};
    if (MODE == 1) {
        const int kk = 16 * wid + fr;
#pragma unroll 4
        for (int j = 0; j < sc; ++j) {
            const float* Lj = HLs + (size_t)(u - sc + j) * 16384 + kk * 128 + 4 * fq; const float dj = HDs[(size_t)(u - sc + j) * 128 + kk];
#pragma unroll
            for (int vt = 0; vt < 8; ++vt) { const f32x4 l = *(const f32x4*)(Lj + vt * 16); st[vt] = st[vt] * dj + l; }
        }
    }
    float dsum = 0.f;
    const int kp = tid & 63, te = tid >> 6;
    for (int c = 0; c < 4; ++c) {
        const size_t tok0 = (size_t)b * SEQ + sc * 256 + c * 64;
        float lf0[8], lf1[8], cs0[8], cs1[8];
        { float a0 = 0.f, a1 = 0.f;
#pragma unroll
          for (int i = 0; i < 8; ++i) { const float2 v = *(const float2*)(logf + (tok0 + te * 8 + i) * 512 + h * 128 + 2 * kp); lf0[i] = v.x; lf1[i] = v.y; a0 += v.x; a1 += v.y; cs0[i] = a0; cs1[i] = a1; }
          tot[te * 128 + 2 * kp] = a0; tot[te * 128 + 2 * kp + 1] = a1; }
#pragma unroll
        for (int i = 0; i < 2; ++i) { const int pc = tid + NTHREADS * i, row = pc >> 4, c8 = (pc & 15) * 8;
            const u32x4 v = *(const u32x4*)(hv + (tok0 + row) * 512 + h * 128 + c8);
            *(LAS u32x4*)(lds + HL_V + off_tr256(row, c8)) = v; }
        if (MODE == 1 ) {
#pragma unroll
            for (int vt = 0; vt < 8; ++vt) { u32x2 pk; pk.x = cvtpk(st[vt].x, st[vt].y); pk.y = cvtpk(st[vt].z, st[vt].w);
                *(LAS u32x2*)(lds + HL_SB + off_tr256(16 * wid + fr, 16 * vt + 4 * fq)) = pk; }
        }
        __syncthreads();
        float pre0 = 0.f, pre1 = 0.f, last0 = 0.f, last1 = 0.f;
#pragma unroll
        for (int e = 0; e < 8; ++e) { const float t0 = tot[e * 128 + 2 * kp], t1 = tot[e * 128 + 2 * kp + 1]; if (e < te) { pre0 += t0; pre1 += t1; } last0 += t0; last1 += t1; }
#pragma unroll
        for (int i = 0; i < 8; ++i) {
            const int t = te * 8 + i;
            const float c0 = cs0[i] + pre0, c1 = cs1[i] + pre1;
            const float k0 = 1.f - __expf(lf0[i]), k1 = 1.f - __expf(lf1[i]);
            const unsigned khat = cvtpk(k0 * __expf(last0 - c0), k1 * __expf(last1 - c1));
            *(LAS unsigned*)(lds + HL_KH + off_tr256(t, 2 * kp)) = khat;
            if (MODE == 1) {
                const unsigned qraw = *(const unsigned*)(hq + (tok0 + t) * 512 + h * 128 + 2 * kp);
                const float q0 = __uint_as_float(qraw << 16), q1 = __uint_as_float(qraw & 0xffff0000u);
                const unsigned qt = cvtpk(q0 * __expf(c0), q1 * __expf(c1));
                const unsigned kt = cvtpk(k0 * __expf(fminf(-c0, 80.f)), k1 * __expf(fminf(-c1, 80.f)));
                const int o = off_row256(t, kp >> 2) + ((kp & 3) << 2);
                *(LAS unsigned*)(lds + HL_QT + o) = qt; *(LAS unsigned*)(lds + HL_KT + o) = kt;
            }
        }
        const float dec = __expf(tot[0 * 128 + 16 * wid + fr] + tot[1 * 128 + 16 * wid + fr] + tot[2 * 128 + 16 * wid + fr] + tot[3 * 128 + 16 * wid + fr]
                                 + tot[4 * 128 + 16 * wid + fr] + tot[5 * 128 + 16 * wid + fr] + tot[6 * 128 + 16 * wid + fr] + tot[7 * 128 + 16 * wid + fr]);
        if (MODE == 0 && tid < 128) { float s = 0.f;
#pragma unroll
            for (int e = 0; e < 8; ++e) s += tot[e * 128 + tid];
            dsum += s; }
        __syncthreads();
        f32x4 oacc[4];
        if (MODE == 1) {
            { const int tt = wid & 3;
#pragma unroll
              for (int si = 0; si < 2; ++si) { const int stl = 2 * (wid >> 2) + si;
                  f32x4 sacc = (f32x4){0.f, 0.f, 0.f, 0.f};
                  if (stl <= tt) {
#pragma unroll
                      for (int ks = 0; ks < 4; ++ks) {
                          const bf16x8 a = *(const LAS bf16x8*)(lds + HL_KT + off_row256(stl * 16 + fr, ks * 4 + fq));
                          const bf16x8 bq = *(const LAS bf16x8*)(lds + HL_QT + off_row256(tt * 16 + fr, ks * 4 + fq));
                          sacc = __builtin_amdgcn_mfma_f32_16x16x32_bf16(a, bq, sacc, 0, 0, 0);
                      }
                  }
                  const int t = tt * 16 + fr, s0 = stl * 16 + 4 * fq;
                  u32x2 pk; pk.x = cvtpk(s0 + 0 <= t ? sacc.x : 0.f, s0 + 1 <= t ? sacc.y : 0.f); pk.y = cvtpk(s0 + 2 <= t ? sacc.z : 0.f, s0 + 3 <= t ? sacc.w : 0.f);
                  *(LAS u32x2*)(lds + HL_P + off_row128(t, s0 >> 3) + ((s0 & 7) << 1)) = pk; }
            }
            __syncthreads();
            { const int tt = wid >> 1;
#pragma unroll
              for (int i = 0; i < 4; ++i) { const int vt = 4 * (wid & 1) + i;
                  f32x4 a = (f32x4){0.f, 0.f, 0.f, 0.f};
#pragma unroll
                  for (int ks = 0; ks < 2; ++ks) {
                      const int kr = ks * 32 + 8 * fq + (fr >> 2);
                      const s16x4 lo = lds_tr(lds + HL_V + off_tr256(kr, vt * 16 + 4 * (fr & 3))), hi = lds_tr(lds + HL_V + off_tr256(kr + 4, vt * 16 + 4 * (fr & 3)));
                      const bf16x8 va = (bf16x8){lo[0], lo[1], lo[2], lo[3], hi[0], hi[1], hi[2], hi[3]};
                      const bf16x8 pb = *(const LAS bf16x8*)(lds + HL_P + off_row128(tt * 16 + fr, ks * 4 + fq));
                      a = __builtin_amdgcn_mfma_f32_16x16x32_bf16(va, pb, a, 0, 0, 0);
                  }
#pragma unroll
                  for (int ks = 0; ks < 4; ++ks) {
                      const int kr = ks * 32 + 8 * fq + (fr >> 2);
                      const s16x4 lo = lds_tr(lds + HL_SB + off_tr256(kr, vt * 16 + 4 * (fr & 3))), hi = lds_tr(lds + HL_SB + off_tr256(kr + 4, vt * 16 + 4 * (fr & 3)));
                      const bf16x8 sa = (bf16x8){lo[0], lo[1], lo[2], lo[3], hi[0], hi[1], hi[2], hi[3]};
                      const bf16x8 qb = *(const LAS bf16x8*)(lds + HL_QT + off_row256(tt * 16 + fr, ks * 4 + fq));
                      a = __builtin_amdgcn_mfma_f32_16x16x32_bf16(sa, qb, a, 0, 0, 0);
                  }
                  const u32x2 gr = *(const u32x2*)(hg + (tok0 + tt * 16 + fr) * 512 + h * 128 + vt * 16 + 4 * fq);
                  a.x *= __uint_as_float(gr.x << 16); a.y *= __uint_as_float(gr.x & 0xffff0000u); a.z *= __uint_as_float(gr.y << 16); a.w *= __uint_as_float(gr.y & 0xffff0000u);
                  oacc[i] = a; }
              float ss = 0.f;
#pragma unroll
              for (int i = 0; i < 4; ++i) ss += (oacc[i].x * oacc[i].x + oacc[i].y * oacc[i].y) + (oacc[i].z * oacc[i].z + oacc[i].w * oacc[i].w);
              ss += __shfl_xor(ss, 16); ss += __shfl_xor(ss, 32);
              if (fq == 0) red[(tt * 2 + (wid & 1)) * 16 + fr] = ss; }
        }
#pragma unroll
        for (int vt = 0; vt < 8; ++vt) {
            f32x4 a = st[vt] * dec;
#pragma unroll
            for (int ks = 0; ks < 2; ++ks) {
                const int kr = ks * 32 + 8 * fq + (fr >> 2);
                const s16x4 lo = lds_tr(lds + HL_V + off_tr256(kr, vt * 16 + 4 * (fr & 3))), hi = lds_tr(lds + HL_V + off_tr256(kr + 4, vt * 16 + 4 * (fr & 3)));
                const bf16x8 va = (bf16x8){lo[0], lo[1], lo[2], lo[3], hi[0], hi[1], hi[2], hi[3]};
                const s16x4 lo2 = lds_tr(lds + HL_KH + off_tr256(kr, wid * 16 + 4 * (fr & 3))), hi2 = lds_tr(lds + HL_KH + off_tr256(kr + 4, wid * 16 + 4 * (fr & 3)));
                const bf16x8 kb = (bf16x8){lo2[0], lo2[1], lo2[2], lo2[3], hi2[0], hi2[1], hi2[2], hi2[3]};
                a = __builtin_amdgcn_mfma_f32_16x16x32_bf16(va, kb, a, 0, 0, 0);
            }
            st[vt] = a;
        }
        __syncthreads();
        if (MODE == 1) {
            const int tt = wid >> 1; const float ssum = red[(tt * 2) * 16 + fr] + red[(tt * 2 + 1) * 16 + fr];
            const float rstd = rsqrtf(ssum * (1.f / 128.f) + RMS_EPS);
#pragma unroll
            for (int i = 0; i < 4; ++i) { const int v = (4 * (wid & 1) + i) * 16 + 4 * fq; const f32x4 w = *(const f32x4*)(P.rec_out_norm_w + h * 128 + v);
                u32x2 pk; pk.x = cvtpk(oacc[i].x * rstd * w.x, oacc[i].y * rstd * w.y); pk.y = cvtpk(oacc[i].z * rstd * w.z, oacc[i].w * rstd * w.w);
                *(u32x2*)(mix + (tok0 + tt * 16 + fr) * 1024 + 512 + h * 128 + v) = pk; }
        }
    }
    if (MODE == 0) {
#pragma unroll
        for (int vt = 0; vt < 8; ++vt) *(f32x4*)(HLs + (size_t)u * 16384 + (16 * wid + fr) * 128 + vt * 16 + 4 * fq) = st[vt];
        if (tid < 128) HDs[(size_t)u * 128 + tid] = __expf(dsum);
    }
    __syncthreads();
}


constexpr int NL_K = 0, NL_V = 16384, NL_IMP = 32768, NL_IMP_STRIDE = 132, NL_SELM = NL_IMP + 8 * 8 * NL_IMP_STRIDE * 4, NL_END = NL_SELM + 1024;
__device__ __forceinline__ int off_v128(int row, int ch) { return row * 128 + ((ch ^ ((row & 3) << 1)) << 4); }
#define MFMA32(a, b, c) __builtin_amdgcn_mfma_f32_32x32x16_bf16(a, b, c, 0, 0, 0)

struct NsaLane { int t; float sl2; int qi; unsigned long long mlo, mhi; };

template <int MODE> __device__ __forceinline__ void nsa_pass(LAS unsigned char* lds, const bf16_t* Kg, const bf16_t* Vg, int rs, unsigned long long ulo, unsigned long long uhi,
                                                            const bf16x8 (&qf)[4], const NsaLane& L, float inv, float& lsum, f32x16 (&O)[2], LAS float* impw) {
    const int tid = opaque_tid(), lane = tid & 63, hi = lane >> 5, c = lane & 31;
    const int ld_row = tid >> 3, ld_ch = tid & 7;
    const int kw_off = off_row128(ld_row, ld_ch), vw_off = off_v128(ld_row, ld_ch);
    u32x4 k0, v0, k1, v1, k2, v2;
    auto next = [&](int jj) -> int { ++jj; if (jj < 64) { const unsigned long long m = ulo >> jj; if (m) return jj + __builtin_ctzll(m); jj = 64; }
                                     if (jj < 128) { const unsigned long long m = uhi >> (jj - 64); if (m) return jj + __builtin_ctzll(m); } return 128; };
    int jA = next(-1), jB = jA < 128 ? next(jA) : 128, jC = jB < 128 ? next(jB) : 128;
    const int jsafe = jA < 128 ? jA : 0;
    auto ldk = [&](int jj) -> u32x4 { const int q = jj < 128 ? jj : jsafe; return *(const u32x4*)(Kg + (size_t)(q * 64 + ld_row) * rs + ld_ch * 8); };
    auto ldv = [&](int jj) -> u32x4 { const int q = jj < 128 ? jj : jsafe; return *(const u32x4*)(Vg + (size_t)(q * 64 + ld_row) * rs + ld_ch * 8); };
    k0 = ldk(jA); k1 = ldk(jB); k2 = ldk(jC);
    if (MODE != 0) { v0 = ldv(jA); v1 = ldv(jB); v2 = ldv(jC); }
    int it = 0;
    auto step = [&](u32x4& kreg, u32x4& vreg) {
        const int j = jA;
        LAS unsigned char* kb = lds + NL_K + (it & 1) * 8192; LAS unsigned char* vb = lds + NL_V + (it & 1) * 8192;
        *(LAS u32x4*)(kb + kw_off) = kreg; if (MODE != 0) *(LAS u32x4*)(vb + vw_off) = vreg;
        const int jD = jC < 128 ? next(jC) : 128;
        kreg = ldk(jD); if (MODE != 0) vreg = ldv(jD);
        __syncthreads();
        bool need = true; bool selbit = true;
        if (MODE == 2) { selbit = (j < 64 ? (L.mlo >> j) : (L.mhi >> (j - 64))) & 1ull; need = __any(selbit); }
        if (need) {
            f32x16 p0 = {}, p1 = {};
#pragma unroll
            for (int ks = 0; ks < 4; ++ks) {
                const bf16x8 a0 = *(const LAS bf16x8*)(kb + off_row128(c, 2 * ks + hi)), a1 = *(const LAS bf16x8*)(kb + off_row128(32 + c, 2 * ks + hi));
                p0 = MFMA32(a0, qf[ks], p0); p1 = MFMA32(a1, qf[ks], p1);
            }
            const int stride = (MODE <= 1) ? 16 : 1;
            const int dl = (MODE <= 1) ? (L.t - 31 - 16 * (j * 64 + 4 * hi)) : (L.t - (j * 64 + 4 * hi));
            const float nb = -L.sl2 * (float)dl, sls = L.sl2 * (float)stride;
            float rs_ = 0.f;
#pragma unroll
            for (int r = 0; r < 16; ++r) {
                const int ro0 = (r & 3) + 8 * (r >> 2), ro1 = ro0 + 32;
                const int d0 = dl - stride * ro0, d1 = dl - stride * ro1;
                bool v0 = d0 >= 0, v1 = d1 >= 0;
                if (MODE == 3) { v0 = v0 && d0 < 512; v1 = v1 && d1 < 512; }
                if (MODE == 2) { v0 = v0 && selbit; v1 = v1 && selbit; }
                float e0 = __builtin_amdgcn_exp2f(__builtin_fmaf(p0[r], LOG2E, __builtin_fmaf(sls, (float)ro0, nb)));
                float e1 = __builtin_amdgcn_exp2f(__builtin_fmaf(p1[r], LOG2E, __builtin_fmaf(sls, (float)ro1, nb)));
                e0 = v0 ? e0 : 0.f; e1 = v1 ? e1 : 0.f;
                if (MODE == 1) { e0 *= inv; e1 *= inv; }
                p0[r] = e0; p1[r] = e1; rs_ += e0 + e1;
            }
            lsum += rs_;
            if (MODE == 1) {
#pragma unroll
                for (int kt = 0; kt < 2; ++kt)
#pragma unroll
                    for (int i = 0; i < 4; ++i) {
                        float g = kt ? (p1[4 * i] + p1[4 * i + 1]) + (p1[4 * i + 2] + p1[4 * i + 3]) : (p0[4 * i] + p0[4 * i + 1]) + (p0[4 * i + 2] + p0[4 * i + 3]);
                        float l3 = kt ? p1[4 * i + 3] : p0[4 * i + 3];
                        g += __shfl_xor(g, 1); g += __shfl_xor(g, 2); l3 += __shfl_xor(l3, 1); l3 += __shfl_xor(l3, 2);
                        if ((c & 3) == 0) { const int jj = j * 16 + kt * 8 + 2 * i + hi; __hip_atomic_fetch_add(impw + L.qi * NL_IMP_STRIDE + jj, g, __ATOMIC_RELAXED, __HIP_MEMORY_SCOPE_WORKGROUP); __hip_atomic_fetch_add(impw + L.qi * NL_IMP_STRIDE + jj + 1, l3, __ATOMIC_RELAXED, __HIP_MEMORY_SCOPE_WORKGROUP); }
                    }
            }
            if (MODE != 0) {
                bf16x8 pf[4];
#pragma unroll
                for (int s4 = 0; s4 < 4; ++s4) { u32x4 w;
#pragma unroll
                    for (int e = 0; e < 4; ++e) { const int r = 8 * (s4 & 1) + 2 * e; w[e] = (s4 >> 1) ? cvtpk(p1[r], p1[r + 1]) : cvtpk(p0[r], p0[r + 1]); }
                    pf[s4] = __builtin_bit_cast(bf16x8, w); }
                const int g4 = lane >> 4, sub = g4 & 1, i16 = lane & 15, qq = i16 >> 2, pp = i16 & 3;
#pragma unroll
                for (int dt = 0; dt < 2; ++dt)
#pragma unroll
                    for (int s4 = 0; s4 < 4; ++s4) {
                        const int row = 16 * s4 + 4 * hi + qq, ch = 4 * dt + 2 * sub + (pp >> 1);
                        const s16x4 lo = lds_tr(vb + off_v128(row, ch) + 8 * (pp & 1)), hh = lds_tr(vb + off_v128(row + 8, ch) + 8 * (pp & 1));
                        const bf16x8 vf = (bf16x8){lo[0], lo[1], lo[2], lo[3], hh[0], hh[1], hh[2], hh[3]};
                        O[dt] = MFMA32(vf, pf[s4], O[dt]);
                    }
            }
        }
        jA = jB; jB = jC; jC = jD; ++it;
    };
    while (jA < 128) {
        step(k0, v0); if (jA >= 128) break;
        step(k1, v1); if (jA >= 128) break;
        step(k2, v2);
    }
    __syncthreads();
}

__device__ __forceinline__ void nsa_unit(const Params& P, LAS unsigned char* lds, int u) {
    const int tid = opaque_tid(), lane = tid & 63, wid = tid >> 6, hi = lane >> 5, c = lane & 31;
    const int b = u >> 8, g = (u >> 7) & 1, qb = u & 127;
    const bf16_t* qg = (const bf16_t*)(P.ws + WS_Q); const bf16_t* kv = (const bf16_t*)(P.ws + WS_KV);
    const bf16_t* kcn = (const bf16_t*)(P.ws + WS_KC) + (size_t)(b * 2 + g) * 512 * 64; const bf16_t* vcc = (const bf16_t*)(P.ws + WS_VC) + (size_t)(b * 2 + g) * 512 * 64;
    const float* gates = (const float*)(P.ws + WS_GATES); bf16_t* mix = (bf16_t*)(P.ws + WS_MIX);
    LAS float* impw = (LAS float*)(lds + NL_IMP) + wid * 8 * NL_IMP_STRIDE;
    LAS unsigned long long* selm = (LAS unsigned long long*)(lds + NL_SELM);
    NsaLane L; L.qi = c >> 2; const int hh = c & 3, head = g * 4 + hh;
    L.t = qb * 64 + wid * 8 + L.qi; L.sl2 = exp2f(-(float)(head + 1)) * LOG2E; L.mlo = 0; L.mhi = 0;
    const size_t tok = (size_t)b * SEQ + L.t;
    bf16x8 qf[4];
#pragma unroll
    for (int ks = 0; ks < 4; ++ks) qf[ks] = *(const bf16x8*)(qg + tok * 512 + head * 64 + 16 * ks + 8 * hi);
    for (int i = lane; i < 8 * NL_IMP_STRIDE; i += 64) impw[i] = 0.f;
    const int ncmp = qb * 4 + 3 < 511 ? qb * 4 + 3 : 511;
    const int nblk = (ncmp + 63) >> 6;
    const unsigned long long cm = nblk >= 64 ? ~0ull : ((1ull << nblk) - 1ull);
    f32x16 O[2], Ot[2]; float lsum = 0.f;
    O[0] = f32x16{}; O[1] = f32x16{};
    nsa_pass<0>(lds, kcn, vcc, 64, cm, 0ull, qf, L, 1.f, lsum, O, impw);
    lsum += __shfl_xor(lsum, 32);
    const float invc = 1.0f / fmaxf(lsum, 1e-30f);
    float dummy = 0.f;
    nsa_pass<1>(lds, kcn, vcc, 64, cm, 0ull, qf, L, invc, dummy, O, impw);
    const float* gt = gates + tok * 24 + g * 12 + hh * 3;
    const float g0 = gt[0], g1 = gt[1], g2 = gt[2];
#pragma unroll
    for (int dt = 0; dt < 2; ++dt) Ot[dt] = O[dt] * g0;
    {
        const int ncausal = qb + 1;
        for (int qi = 0; qi < 8; ++qi) {
            unsigned long long lo, hi64;
            if (ncausal <= 16) { lo = (1ull << ncausal) - 1ull; hi64 = 0ull; }
            else {
                const int j0 = lane, j1 = lane + 64;
                const bool f0 = (j0 == 0) || (j0 == qb) || (j0 == qb - 1), f1 = (j1 == qb) || (j1 == qb - 1);
                const unsigned k0 = (j0 <= qb && !f0) ? (0x80000000u | (__float_as_uint(impw[qi * NL_IMP_STRIDE + j0]) & 0x7fffff80u) | (unsigned)j0) : 0u;
                const unsigned k1 = (j1 <= qb && !f1) ? (0x80000000u | (__float_as_uint(impw[qi * NL_IMP_STRIDE + j1]) & 0x7fffff80u) | (unsigned)j1) : 0u;
                const int needn = 13;
                unsigned th = 0u;
                for (int bit = 31; bit >= 0; --bit) { const unsigned cand = th | (1u << bit);
                    const int cnt = __popcll(__ballot(k0 >= cand)) + __popcll(__ballot(k1 >= cand));
                    if (cnt >= needn) th = cand; }
                lo = __ballot(f0 || (k0 >= th && k0 != 0u)); hi64 = __ballot(f1 || (k1 >= th && k1 != 0u));
            }
            if (lane == 0) { selm[(wid * 8 + qi) * 2] = lo; selm[(wid * 8 + qi) * 2 + 1] = hi64; }
        }
    }
    __syncthreads();
    unsigned long long ulo = selm[lane * 2], uhi = selm[lane * 2 + 1];
#pragma unroll
    for (int o = 1; o < 64; o <<= 1) { ulo |= __shfl_xor(ulo, o); uhi |= __shfl_xor(uhi, o); }
    L.mlo = selm[(wid * 8 + L.qi) * 2]; L.mhi = selm[(wid * 8 + L.qi) * 2 + 1];
    const bf16_t* kvb = kv + (size_t)b * SEQ * 768 + g * 64;
    O[0] = f32x16{}; O[1] = f32x16{}; lsum = 0.f;
    nsa_pass<2>(lds, kvb + 256, kvb + 384, 768, ulo, uhi, qf, L, 1.f, lsum, O, impw);
    lsum += __shfl_xor(lsum, 32);
    { const float sc = g1 / fmaxf(lsum, 1e-30f);
#pragma unroll
      for (int dt = 0; dt < 2; ++dt) Ot[dt] += O[dt] * sc; }
    {
        const int jlo = qb >= 8 ? qb - 8 : 0;
        unsigned long long wlo = 0ull, whi = 0ull;
        for (int jj = jlo; jj <= qb; ++jj) { if (jj < 64) wlo |= 1ull << jj; else whi |= 1ull << (jj - 64); }
        O[0] = f32x16{}; O[1] = f32x16{}; lsum = 0.f;
        nsa_pass<3>(lds, kvb + 512, kvb + 640, 768, wlo, whi, qf, L, 1.f, lsum, O, impw);
        lsum += __shfl_xor(lsum, 32);
        const float sc = g2 / fmaxf(lsum, 1e-30f);
#pragma unroll
        for (int dt = 0; dt < 2; ++dt) Ot[dt] += O[dt] * sc;
    }
    float ss = 0.f;
#pragma unroll
    for (int dt = 0; dt < 2; ++dt)
#pragma unroll
        for (int r = 0; r < 16; ++r) ss += Ot[dt][r] * Ot[dt][r];
    ss += __shfl_xor(ss, 32);
    const float rstd = rsqrtf(ss * (1.f / 64.f) + RMS_EPS);
#pragma unroll
    for (int dt = 0; dt < 2; ++dt)
#pragma unroll
        for (int r4 = 0; r4 < 4; ++r4) { const int d = 32 * dt + 8 * r4 + 4 * hi; const f32x4 w = *(const f32x4*)(P.attn_out_norm_w + head * 64 + d);
            u32x2 pk; pk.x = cvtpk(Ot[dt][4 * r4] * rstd * w.x, Ot[dt][4 * r4 + 1] * rstd * w.y); pk.y = cvtpk(Ot[dt][4 * r4 + 2] * rstd * w.z, Ot[dt][4 * r4 + 3] * rstd * w.w);
            *(u32x2*)(mix + tok * 1024 + head * 64 + d) = pk; }
    __syncthreads();
}


__device__ __forceinline__ int gu_hcol(int m0) { const int ni = (m0 >> 4) & 7; return 64 * (m0 >> 7) + 32 * (ni >> 2) + 8 * ((m0 & 15) >> 2) + 4 * ((ni >> 1) & 1); }
__device__ __forceinline__ int p2_col(int m0) { const int ni = (m0 >> 4) & 7; return 128 * (m0 >> 7) + 32 * (ni >> 1) + 8 * ((m0 & 15) >> 2) + 4 * (ni & 1); }
__device__ __forceinline__ void phase_cvt_small(const Params& P) {
    const int tid = threadIdx.x;
    {
        const int gt = blockIdx.x * NTHREADS + tid, NG = gridDim.x * NTHREADS;
        bf16_t* wo = (bf16_t*)(P.ws + WS_WOUT); bf16_t* wrs = (bf16_t*)(P.ws + WS_WRS); bf16_t* wsd = (bf16_t*)(P.ws + WS_WSD);
        for (int i = gt; i < 1024 * 128; i += NG) { const f32x4 a = *(const f32x4*)(P.w_out + (size_t)i * 8), b2 = *(const f32x4*)(P.w_out + (size_t)i * 8 + 4);
            *(u32x4*)(wo + (size_t)i * 8) = (u32x4){cvtpk(a.x, a.y), cvtpk(a.z, a.w), cvtpk(b2.x, b2.y), cvtpk(b2.z, b2.w)}; }
        for (int i = gt; i < 256 * 128; i += NG) { const int k = i >> 7, m0 = (i & 127) * 8; const float* s = P.sh_wd + (size_t)k * 1024 + (m0 & ~255) + p2_col(m0 & 255);
            const f32x4 a = *(const f32x4*)s, b2 = *(const f32x4*)(s + 8);
            *(u32x4*)(wsd + (size_t)i * 8) = (u32x4){cvtpk(a.x, a.y), cvtpk(a.z, a.w), cvtpk(b2.x, b2.y), cvtpk(b2.z, b2.w)}; }
        for (int i = gt; i < 1024 * 96; i += NG) { const int k = i / 96, c8 = (i % 96) * 8;
            const float* s; int d2 = 4;
            if (c8 < 256) s = P.router_w + (size_t)k * 256 + c8;
            else { const int cc = c8 - 256, t = cc >> 8; s = ((cc & 16) ? P.sh_wu : P.sh_wg) + (size_t)k * 256 + t * 128 + gu_hcol(cc & 255); d2 = 8; }
            const f32x4 a = *(const f32x4*)s, b2 = *(const f32x4*)(s + d2);
            *(u32x4*)(wrs + (size_t)k * 768 + c8) = (u32x4){cvtpk(a.x, a.y), cvtpk(a.z, a.w), cvtpk(b2.x, b2.y), cvtpk(b2.z, b2.w)}; }
    }
}

__device__ __forceinline__ void route_token(const Params& P, int t, int lane) {
    const float* scores = (const float*)(P.ws + WS_SCORES) + (size_t)t * 256;
    const f32x4 s4 = *(const f32x4*)(scores + 4 * lane); const f32x4 b4 = *(const f32x4*)(P.router_bias + 4 * lane);
    float sc[4] = {s4.x, s4.y, s4.z, s4.w};
    float bs[4] = {s4.x + b4.x, s4.y + b4.y, s4.z + b4.z, s4.w + b4.w};
    float m1 = fmaxf(bs[0], bs[1]), m2 = fminf(bs[0], bs[1]);
    { const float v = bs[2]; const float n1 = fmaxf(m1, v); m2 = fmaxf(fminf(m1, v), m2); m1 = n1; }
    { const float v = bs[3]; const float n1 = fmaxf(m1, v); m2 = fmaxf(fminf(m1, v), m2); m1 = n1; }
#pragma unroll
    for (int o = 1; o < 8; o <<= 1) { const float o1 = __shfl_xor(m1, o), o2 = __shfl_xor(m2, o); const float n1 = fmaxf(m1, o1); m2 = fmaxf(fminf(m1, o1), fmaxf(m2, o2)); m1 = n1; }
    const float gs = m1 + m2;
    const int grp = lane >> 3;
    int rank = 0;
#pragma unroll
    for (int g2 = 0; g2 < 8; ++g2) { const float og = __shfl(gs, g2 * 8); rank += (og > gs || (og == gs && g2 < grp)) ? 1 : 0; }
    const bool gsel = rank < 4;
    float mv[4];
#pragma unroll
    for (int i = 0; i < 4; ++i) mv[i] = gsel ? bs[i] : -INFINITY;
    int myidx = -1; float myw = 0.f; float wsum = 0.f;
#pragma unroll 1
    for (int k = 0; k < 8; ++k) {
        float bv = mv[0]; int bi = 4 * lane;
#pragma unroll
        for (int i = 1; i < 4; ++i) if (mv[i] > bv) { bv = mv[i]; bi = 4 * lane + i; }
#pragma unroll
        for (int o = 1; o < 64; o <<= 1) { const float ov = __shfl_xor(bv, o); const int oi = __shfl_xor(bi, o); if (ov > bv || (ov == bv && oi < bi)) { bv = ov; bi = oi; } }
        const int wl = bi >> 2, wc = bi & 3;
        const float mine = wc == 0 ? sc[0] : (wc == 1 ? sc[1] : (wc == 2 ? sc[2] : sc[3]));
        const float wv = __shfl(mine, wl);
        wsum += wv;
        if (lane == k) { myidx = bi; myw = wv; }
        if (lane == wl) {
#pragma unroll
            for (int i = 0; i < 4; ++i) if (i == wc) mv[i] = -INFINITY; }
    }
    if (lane < 8) {
        int* cnt = (int*)(P.ws + WS_CTL + CTL_CNT);
        const int pos = atomicAdd(cnt + myidx, 1);
        if (pos < BCAP) ((int*)(P.ws + WS_BUCKET))[(size_t)myidx * BCAP + pos] = t * 8 + lane;
        ((float*)(P.ws + WS_RW))[(size_t)t * 8 + lane] = myw / wsum * 2.5f;
    }
}


__device__ __forceinline__ void phase_p4a(const Params& P, LAS unsigned char* lds) {
    typedef Gemm3 G;
    const int tid = opaque_tid(), lane = tid & 63, wid = tid >> 6, wm = wid >> 1, wn = wid & 1, fr = lane & 15, fq = lane >> 4;
    struct F { const Params& P;
        __device__ __forceinline__ void ptrs(int seg, const bf16_t* (&aptr)[2], const bf16_t* (&bptr)[2]) const {
            const int tid = opaque_tid(), lane = tid & 63, wid = tid >> 6, wm = wid >> 1, wn = wid & 1, fr = lane & 15, fq = lane >> 4, c8 = 8 * (tid & 31); (void)wm; (void)wn; (void)fr; (void)fq; (void)c8;
            const int u = blockIdx.x + seg * gridDim.x, rt = u >> 2, ct = u & 3;
            const bf16_t* mix = (const bf16_t*)(P.ws + WS_MIX); const bf16_t* wo = (const bf16_t*)(P.ws + WS_WOUT);
#pragma unroll
            for (int i = 0; i < 2; ++i) { const int row = G::a_row(i, wid, lane); aptr[i] = mix + (size_t)(rt * 256 + row) * 1024 + G::a_chunk(row, lane) * 8;
                const int k = G::b_k(i, wid, lane); bptr[i] = wo + (size_t)k * 1024 + ct * 256 + G::b_n(k, lane); } }
        __device__ __forceinline__ void epi(int seg, f32x4 (&acc)[4][8]) const {
            const int tid = opaque_tid(), lane = tid & 63, wid = tid >> 6, wm = wid >> 1, wn = wid & 1, fr = lane & 15, fq = lane >> 4, c8 = 8 * (tid & 31); (void)wm; (void)wn; (void)fr; (void)fq; (void)c8;
            const int u = blockIdx.x + seg * gridDim.x, rt = u >> 2, ct = u & 3, b = (rt * 256) / SEQ;
            const float* mod = (const float*)(P.ws + WS_MOD) + b * 6144; float* ssp = (float*)(P.ws + WS_SS);
#pragma unroll
            for (int mi = 0; mi < 4; ++mi) { const size_t m = (size_t)(rt * 256 + wm * 64 + mi * 16 + fr); float ss = 0.f;
#pragma unroll
                for (int ni = 0; ni < 8; ++ni) { const int col = ct * 256 + wn * 128 + ni * 16 + 4 * fq;
                    const f32x4 xv = *(const f32x4*)(P.x + m * 1024 + col), gv = *(const f32x4*)(mod + 2048 + col); const f32x4 a = acc[mi][ni];
                    f32x4 o; o.x = xv.x + gv.x * a.x; o.y = xv.y + gv.y * a.y; o.z = xv.z + gv.z * a.z; o.w = xv.w + gv.w * a.w;
                    *(f32x4*)(P.out + m * 1024 + col) = o; ss += (o.x * o.x + o.y * o.y) + (o.z * o.z + o.w * o.w); if (ni & 1) asm volatile("" ::: "memory"); }
                ss += __shfl_xor(ss, 16); ss += __shfl_xor(ss, 32);
                if (fq == 0) ssp[m * 8 + ct * 2 + wn] = ss; } }
    } f{P};
    const int nu = (128 * 4 - (int)blockIdx.x + (int)gridDim.x - 1) / (int)gridDim.x;
    if (nu > 0) G::run_stream(f, nu, 32, 32, (size_t)32 * 1024, lds);
}
__device__ __forceinline__ void phase_p4b(const Params& P) {
    const int lane = threadIdx.x & 63, gw = blockIdx.x * (NTHREADS / 64) + (threadIdx.x >> 6), NGW = gridDim.x * (NTHREADS / 64);
    const float* ssp = (const float*)(P.ws + WS_SS); bf16_t* h2 = (bf16_t*)(P.ws + WS_H);
    for (int m = gw; m < T; m += NGW) {
        const float* mod = (const float*)(P.ws + WS_MOD) + (m / SEQ) * 6144;
        const f32x4 s0 = *(const f32x4*)(ssp + (size_t)m * 8), s1 = *(const f32x4*)(ssp + (size_t)m * 8 + 4);
        const float rstd = rsqrtf(((s0.x + s0.y) + (s0.z + s0.w) + (s1.x + s1.y) + (s1.z + s1.w)) * (1.f / 1024.f) + RMS_EPS);
#pragma unroll
        for (int j = 0; j < 4; ++j) { const int col = (lane + 64 * j) * 4;
            const f32x4 v = *(const f32x4*)(P.out + (size_t)m * 1024 + col), wv = *(const f32x4*)(P.norm2_w + col), scv = *(const f32x4*)(mod + 4096 + col), shv = *(const f32x4*)(mod + 3072 + col);
            const float r0 = v.x * rstd * wv.x * (1.f + scv.x) + shv.x, r1 = v.y * rstd * wv.y * (1.f + scv.y) + shv.y, r2 = v.z * rstd * wv.z * (1.f + scv.z) + shv.z, r3 = v.w * rstd * wv.w * (1.f + scv.w) + shv.w;
            u32x2 pk; pk.x = cvtpk(r0, r1); pk.y = cvtpk(r2, r3);
            *(u32x2*)(h2 + (size_t)m * 1024 + col) = pk;
            int q8 = __builtin_amdgcn_cvt_pk_fp8_f32(r0, r1, 0, false); q8 = __builtin_amdgcn_cvt_pk_fp8_f32(r2, r3, q8, true);
            *(int*)((unsigned char*)(P.ws + WS_H2Q) + (size_t)m * 1024 + col) = q8; }
    }
}
__device__ __forceinline__ void phase_p4c(const Params& P, LAS unsigned char* lds) {
    typedef Gemm3 G;
    const int tid = opaque_tid(), lane = tid & 63, wid = tid >> 6, wm = wid >> 1, wn = wid & 1, fr = lane & 15, fq = lane >> 4;
    struct F { const Params& P;
        __device__ __forceinline__ void ptrs(int seg, const bf16_t* (&aptr)[2], const bf16_t* (&bptr)[2]) const {
            const int tid = opaque_tid(), lane = tid & 63, wid = tid >> 6, wm = wid >> 1, wn = wid & 1, fr = lane & 15, fq = lane >> 4, c8 = 8 * (tid & 31); (void)wm; (void)wn; (void)fr; (void)fq; (void)c8;
            const int u = blockIdx.x + seg * gridDim.x, rt = u / 3, ct = u % 3;
            const bf16_t* h2 = (const bf16_t*)(P.ws + WS_H); const bf16_t* wrs = (const bf16_t*)(P.ws + WS_WRS);
#pragma unroll
            for (int i = 0; i < 2; ++i) { const int row = G::a_row(i, wid, lane); aptr[i] = h2 + (size_t)(rt * 256 + row) * 1024 + G::a_chunk(row, lane) * 8;
                const int k = G::b_k(i, wid, lane); bptr[i] = wrs + (size_t)k * 768 + ct * 256 + G::b_n(k, lane); } }
        __device__ __forceinline__ void epi(int seg, f32x4 (&acc)[4][8]) const {
            const int tid = opaque_tid(), lane = tid & 63, wid = tid >> 6, wm = wid >> 1, wn = wid & 1, fr = lane & 15, fq = lane >> 4, c8 = 8 * (tid & 31); (void)wm; (void)wn; (void)fr; (void)fq; (void)c8;
            const int u = blockIdx.x + seg * gridDim.x, rt = u / 3, ct = u % 3;
            float* scores = (float*)(P.ws + WS_SCORES); bf16_t* hidS = (bf16_t*)(P.ws + WS_HIDS);
#pragma unroll
            for (int mi = 0; mi < 4; ++mi) { const size_t m = (size_t)(rt * 256 + wm * 64 + mi * 16 + fr);
                if (ct == 0) {
#pragma unroll
                    for (int ni = 0; ni < 8; ++ni) { const f32x4 a = acc[mi][ni];
                        *(f32x4*)(scores + m * 256 + wn * 128 + ni * 16 + 4 * fq) = (f32x4){sigmoidf_(a.x), sigmoidf_(a.y), sigmoidf_(a.z), sigmoidf_(a.w)}; }
                } else {
#pragma unroll
                    for (int j2 = 0; j2 < 2; ++j2) { const f32x4 g = acc[mi][4 * j2], uu = acc[mi][4 * j2 + 1], g2 = acc[mi][4 * j2 + 2], u2 = acc[mi][4 * j2 + 3];
                        u32x4 pk; pk.x = cvtpk(siluf_(g.x) * uu.x, siluf_(g.y) * uu.y); pk.y = cvtpk(siluf_(g.z) * uu.z, siluf_(g.w) * uu.w);
                        pk.z = cvtpk(siluf_(g2.x) * u2.x, siluf_(g2.y) * u2.y); pk.w = cvtpk(siluf_(g2.z) * u2.z, siluf_(g2.w) * u2.w);
                        *(u32x4*)(hidS + m * 256 + (ct - 1) * 128 + wn * 64 + j2 * 32 + 8 * fq) = pk; }
                } } }
    } f{P};
    const int nu = (128 * 3 - (int)blockIdx.x + (int)gridDim.x - 1) / (int)gridDim.x;
    if (nu > 0) G::run_stream(f, nu, 32, 32, (size_t)32 * 768, lds);
}
__device__ __forceinline__ void phase_route(const Params& P) {
    const int tid = opaque_tid(), lane = tid & 63, gw = blockIdx.x * (NTHREADS / 64) + (tid >> 6), NGW = gridDim.x * (NTHREADS / 64);
    for (int t = gw; t < T; t += NGW) route_token(P, t, lane);
}
__device__ __forceinline__ void phase_p4d(const Params& P, LAS unsigned char* lds) {
    typedef Gemm3 G;
    const int tid = opaque_tid(), lane = tid & 63, wid = tid >> 6, wm = wid >> 1, wn = wid & 1, fr = lane & 15, fq = lane >> 4;
    struct F { const Params& P;
        __device__ __forceinline__ void ptrs(int seg, const bf16_t* (&aptr)[2], const bf16_t* (&bptr)[2]) const {
            const int tid = opaque_tid(), lane = tid & 63, wid = tid >> 6, wm = wid >> 1, wn = wid & 1, fr = lane & 15, fq = lane >> 4, c8 = 8 * (tid & 31); (void)wm; (void)wn; (void)fr; (void)fq; (void)c8;
            const int u = blockIdx.x + seg * gridDim.x, rt = u >> 2, ct = u & 3;
            const bf16_t* hidS = (const bf16_t*)(P.ws + WS_HIDS); const bf16_t* wsd = (const bf16_t*)(P.ws + WS_WSD);
#pragma unroll
            for (int i = 0; i < 2; ++i) { const int row = G::a_row(i, wid, lane); aptr[i] = hidS + (size_t)(rt * 256 + row) * 256 + G::a_chunk(row, lane) * 8;
                const int k = G::b_k(i, wid, lane); bptr[i] = wsd + (size_t)k * 1024 + ct * 256 + G::b_n(k, lane); } }
        __device__ __forceinline__ void epi(int seg, f32x4 (&acc)[4][8]) const {
            const int tid = opaque_tid(), lane = tid & 63, wid = tid >> 6, wm = wid >> 1, wn = wid & 1, fr = lane & 15, fq = lane >> 4, c8 = 8 * (tid & 31); (void)wm; (void)wn; (void)fr; (void)fq; (void)c8;
            const int u = blockIdx.x + seg * gridDim.x, rt = u >> 2, ct = u & 3;
            bf16_t* ysh = (bf16_t*)(P.ws + WS_YSH);
#pragma unroll
            for (int mi = 0; mi < 4; ++mi) { const size_t m = (size_t)(rt * 256 + wm * 64 + mi * 16 + fr);
#pragma unroll
                for (int j = 0; j < 4; ++j) { const int col = ct * 256 + wn * 128 + j * 32 + 8 * fq; const f32x4 a = acc[mi][2 * j], c = acc[mi][2 * j + 1];
                    *(u32x4*)(ysh + m * 1024 + col) = (u32x4){cvtpk(a.x, a.y), cvtpk(a.z, a.w), cvtpk(c.x, c.y), cvtpk(c.z, c.w)}; } } }
    } f{P};
    const int nu = (128 * 4 - (int)blockIdx.x + (int)gridDim.x - 1) / (int)gridDim.x;
    if (nu > 0) G::run_stream(f, nu, 8, 32, (size_t)32 * 1024, lds);
}

__device__ __forceinline__ void phase_expert_cvt(const Params& P) {
    const size_t gt = (size_t)blockIdx.x * NTHREADS + threadIdx.x, NG = (size_t)gridDim.x * NTHREADS;
    bf16_t* wgu = (bf16_t*)(P.ws + WS_WBGU); bf16_t* wd = (bf16_t*)(P.ws + WS_WBD);
    for (size_t i = gt; i < (size_t)256 * 1024 * 64; i += NG) {
        const size_t ek = i >> 6; const int c8 = (int)(i & 63) * 8, t = c8 >> 8;
        const float* s = ((c8 & 16) ? P.exp_wu : P.exp_wg) + ek * 256 + t * 128 + gu_hcol(c8 & 255);
        const f32x4 a = __builtin_nontemporal_load((const f32x4*)s), b2 = __builtin_nontemporal_load((const f32x4*)(s + 8));
        *(u32x4*)(wgu + ek * 512 + c8) = (u32x4){cvtpk(a.x, a.y), cvtpk(a.z, a.w), cvtpk(b2.x, b2.y), cvtpk(b2.z, b2.w)}; }
    for (size_t i = gt; i < (size_t)256 * 256 * 128; i += NG) {
        const size_t ek = i >> 7; const int m0 = (int)(i & 127) * 8, tl = m0 & 255, tile = m0 >> 8;
        const int wnn = tl >> 7, nii = (tl >> 4) & 7, n0 = tl & 15;
        const int ca = tile * 256 + wnn * 128 + 64 * (nii >> 2) + 16 * (n0 >> 2) + 4 * (nii & 3);
        const f32x4 a = __builtin_nontemporal_load((const f32x4*)(P.exp_wd + ek * 1024 + ca)), b2 = __builtin_nontemporal_load((const f32x4*)(P.exp_wd + ek * 1024 + ca + 16));
        *(u32x4*)(wd + ek * 1024 + m0) = (u32x4){cvtpk(a.x, a.y), cvtpk(a.z, a.w), cvtpk(b2.x, b2.y), cvtpk(b2.z, b2.w)}; }
}

constexpr int P6_TILES = 128 * 1024, P6_PRE = P6_TILES + 1024, P6_PAIR = P6_PRE + 1040, P6_W = P6_PAIR + 1024;
__device__ __forceinline__ void phase_experts(const Params& P, LAS unsigned char* lds) {
    typedef Gemm3 G;
    const int tid = opaque_tid(), lane = tid & 63, wid = tid >> 6, wm = wid >> 1, wn = wid & 1, fr = lane & 15, fq = lane >> 4;
    const int* cnt = (const int*)(P.ws + WS_CTL + CTL_CNT); const int* bucket = (const int*)(P.ws + WS_BUCKET); const float* rw = (const float*)(P.ws + WS_RW);
    const bf16_t* h2 = (const bf16_t*)(P.ws + WS_H); bf16_t* hidR = (bf16_t*)(P.ws + WS_HIDR) + (size_t)blockIdx.x * 256 * 256; unsigned char* y = (unsigned char*)(P.ws + WS_Y);
    LAS int* tiles = (LAS int*)(lds + P6_TILES); LAS int* pre = (LAS int*)(lds + P6_PRE); LAS int* pairs = (LAS int*)(lds + P6_PAIR); LAS float* wts = (LAS float*)(lds + P6_W);
    const int nx = (gridDim.x % 8 == 0) ? 8 : 1, xl = blockIdx.x % nx, li = blockIdx.x / nx, nloc = gridDim.x / nx, nek = 256 / nx;
    if (tid < nek) { const int c_ = cnt[xl + nx * tid]; tiles[tid] = ((c_ < BCAP ? c_ : BCAP) + 255) >> 8; }
    __syncthreads();
    if (tid < nek) { int s = 0; for (int i = 0; i < tid; ++i) s += tiles[i]; pre[tid] = s; if (tid == nek - 1) pre[nek] = s + tiles[nek - 1]; }
    __syncthreads();
    const int total = pre[nek];
    const int c8 = 8 * (tid & 31), u16 = c8 >> 4;
    for (int u = li; u < total; u += nloc) {
        int lo = 0, hi = nek - 1;
        while (lo < hi) { const int mid = (lo + hi + 1) >> 1; if (pre[mid] <= u) lo = mid; else hi = mid - 1; }
        const int e = xl + nx * lo, tile = u - pre[lo], n = cnt[e] < BCAP ? cnt[e] : BCAP, rows = (n - tile * 256) < 256 ? (n - tile * 256) : 256;
        if (tid < 256) { const int r = tid < rows ? tid : 0; const int pr = bucket[(size_t)e * BCAP + tile * 256 + r]; pairs[tid] = pr; wts[tid] = tid < rows ? rw[pr] : 0.f; }
        __syncthreads();
        {
            struct GU { const bf16_t* h2; LAS int* pairs; const bf16_t* wgu; bf16_t* hidR;
                __device__ __forceinline__ void ptrs(int t, const bf16_t* (&aptr)[2], const bf16_t* (&bptr)[2]) const {
                    const int tid = opaque_tid(), lane = tid & 63, wid = tid >> 6, wm = wid >> 1, wn = wid & 1, fr = lane & 15, fq = lane >> 4, c8 = 8 * (tid & 31); (void)wm; (void)wn; (void)fr; (void)fq; (void)c8;
#pragma unroll
                    for (int i = 0; i < 2; ++i) { const int row = G::a_row(i, wid, lane); aptr[i] = h2 + (size_t)(pairs[row] >> 3) * 1024 + G::a_chunk(row, lane) * 8;
                        const int k = G::b_k(i, wid, lane); bptr[i] = wgu + (size_t)k * 512 + t * 256 + G::b_n(k, lane); } }
                __device__ __forceinline__ void epi(int t, f32x4 (&acc)[4][8]) const {
                    const int tid = opaque_tid(), lane = tid & 63, wid = tid >> 6, wm = wid >> 1, wn = wid & 1, fr = lane & 15, fq = lane >> 4, c8 = 8 * (tid & 31); (void)wm; (void)wn; (void)fr; (void)fq; (void)c8;
#pragma unroll
                    for (int mi = 0; mi < 4; ++mi) { const int rl = wm * 64 + mi * 16 + fr;
#pragma unroll
                        for (int j2 = 0; j2 < 2; ++j2) { const f32x4 g = acc[mi][4 * j2], uu = acc[mi][4 * j2 + 1], g2 = acc[mi][4 * j2 + 2], u2 = acc[mi][4 * j2 + 3];
                            u32x4 pk; pk.x = cvtpk(siluf_(g.x) * uu.x, siluf_(g.y) * uu.y); pk.y = cvtpk(siluf_(g.z) * uu.z, siluf_(g.w) * uu.w);
                            pk.z = cvtpk(siluf_(g2.x) * u2.x, siluf_(g2.y) * u2.y); pk.w = cvtpk(siluf_(g2.z) * u2.z, siluf_(g2.w) * u2.w);
                            *(u32x4*)(hidR + rl * 256 + t * 128 + wn * 64 + j2 * 32 + 8 * fq) = pk; } } }
            } f{h2, pairs, (const bf16_t*)(P.ws + WS_WBGU) + (size_t)e * 1024 * 512, hidR};
            G::run_stream(f, 2, 32, 32, (size_t)32 * 512, lds);
        }
        __syncthreads();
        {
            struct DN { bf16_t* hidR; const bf16_t* wd; unsigned char* y; LAS int* pairs; LAS float* wts; int rows;
                __device__ __forceinline__ void ptrs(int ct, const bf16_t* (&aptr)[2], const bf16_t* (&bptr)[2]) const {
                    const int tid = opaque_tid(), lane = tid & 63, wid = tid >> 6, wm = wid >> 1, wn = wid & 1, fr = lane & 15, fq = lane >> 4, c8 = 8 * (tid & 31); (void)wm; (void)wn; (void)fr; (void)fq; (void)c8;
#pragma unroll
                    for (int i = 0; i < 2; ++i) { const int row = G::a_row(i, wid, lane); aptr[i] = hidR + (size_t)row * 256 + G::a_chunk(row, lane) * 8;
                        const int k = G::b_k(i, wid, lane); bptr[i] = wd + (size_t)k * 1024 + ct * 256 + G::b_n(k, lane); } }
                __device__ __forceinline__ void epi(int ct, f32x4 (&acc)[4][8]) const {
                    const int tid = opaque_tid(), lane = tid & 63, wid = tid >> 6, wm = wid >> 1, wn = wid & 1, fr = lane & 15, fq = lane >> 4, c8 = 8 * (tid & 31); (void)wm; (void)wn; (void)fr; (void)fq; (void)c8;
#pragma unroll
                    for (int mi = 0; mi < 4; ++mi) { const int rl = wm * 64 + mi * 16 + fr; const float wgt = wts[rl]; const size_t pr = (size_t)pairs[rl];
                        if (rl < rows) {
#pragma unroll
                            for (int j2 = 0; j2 < 2; ++j2) { const int col = ct * 256 + wn * 128 + 64 * j2 + 16 * fq; const float sc_ = wgt * Y_SCALE; u32x4 w;
#pragma unroll
                                for (int b2 = 0; b2 < 4; ++b2) { const f32x4 a = acc[mi][4 * j2 + b2] * sc_;
                                    int pk = __builtin_amdgcn_cvt_pk_fp8_f32(a.x, a.y, 0, false); pk = __builtin_amdgcn_cvt_pk_fp8_f32(a.z, a.w, pk, true); w[b2] = (unsigned)pk; }
                                *(u32x4*)(y + pr * 1024 + col) = w; } } } }
            } f{hidR, (const bf16_t*)(P.ws + WS_WBD) + (size_t)e * 256 * 1024, y, pairs, wts, rows};
            G::run_stream(f, 4, 8, 32, (size_t)32 * 1024, lds);
        }
        __syncthreads();
    }
}


__device__ __forceinline__ void phase_expert_cvt8(const Params& P) {
    const int tid = opaque_tid(), lane = tid & 63, gw = blockIdx.x * (NTHREADS / 64) + (tid >> 6), NGW = gridDim.x * (NTHREADS / 64);
    unsigned char* wgu = (unsigned char*)(P.ws + WS_W8GU); unsigned char* wd = (unsigned char*)(P.ws + WS_W8D);
    for (int u = gw; u < 256 * 8 * 8; u += NGW) {
        const int rg = u & 7, kb = (u >> 3) & 7, e = u >> 6;
        const int q = rg * 64 + lane, t = q >> 8, ql = q & 255, wnn = ql >> 7, it = (ql >> 5) & 3, i = ql & 31;
        const int h = t * 128 + wnn * 64 + (it >> 1) * 32 + Gemm8::w_col(i);
        const float* s = ((it & 1) ? P.exp_wu : P.exp_wg) + (size_t)e * 1024 * 256 + (size_t)(kb * 128) * 256 + h;
        unsigned char* o = wgu + ((size_t)e * 512 + q) * 1024 + kb * 128;
        { float v[128];
#pragma unroll
            for (int j = 0; j < 128; ++j) v[j] = __builtin_nontemporal_load(s + (size_t)j * 256);
#pragma unroll
            for (int j = 0; j < 8; ++j) { const float c_ = W8_GU_SCALE; u32x4 w;
                w.x = pk4_fp8(v[16 * j] * c_, v[16 * j + 1] * c_, v[16 * j + 2] * c_, v[16 * j + 3] * c_); w.y = pk4_fp8(v[16 * j + 4] * c_, v[16 * j + 5] * c_, v[16 * j + 6] * c_, v[16 * j + 7] * c_);
                w.z = pk4_fp8(v[16 * j + 8] * c_, v[16 * j + 9] * c_, v[16 * j + 10] * c_, v[16 * j + 11] * c_); w.w = pk4_fp8(v[16 * j + 12] * c_, v[16 * j + 13] * c_, v[16 * j + 14] * c_, v[16 * j + 15] * c_);
                *(u32x4*)(o + j * 16) = w; } }
    }
    for (int u = gw; u < 256 * 2 * 16; u += NGW) {
        const int rg = u & 15, kb = (u >> 4) & 1, e = u >> 5;
        const int q = rg * 64 + lane, i = q & 31;
        const int col = (q & ~31) + Gemm8::w_col(i);
        const float* s = P.exp_wd + (size_t)e * 256 * 1024 + (size_t)(kb * 128) * 1024 + col;
        unsigned char* o = wd + ((size_t)e * 1024 + q) * 256 + kb * 128;
        { float v[128];
#pragma unroll
            for (int j = 0; j < 128; ++j) v[j] = __builtin_nontemporal_load(s + (size_t)j * 1024);
#pragma unroll
            for (int j = 0; j < 8; ++j) { const float c_ = W8_D_SCALE; u32x4 w;
                w.x = pk4_fp8(v[16 * j] * c_, v[16 * j + 1] * c_, v[16 * j + 2] * c_, v[16 * j + 3] * c_); w.y = pk4_fp8(v[16 * j + 4] * c_, v[16 * j + 5] * c_, v[16 * j + 6] * c_, v[16 * j + 7] * c_);
                w.z = pk4_fp8(v[16 * j + 8] * c_, v[16 * j + 9] * c_, v[16 * j + 10] * c_, v[16 * j + 11] * c_); w.w = pk4_fp8(v[16 * j + 12] * c_, v[16 * j + 13] * c_, v[16 * j + 14] * c_, v[16 * j + 15] * c_);
                *(u32x4*)(o + j * 16) = w; } }
    }
}

template <int PM> __device__ __forceinline__ void phase_experts8(const Params& P, LAS unsigned char* lds) {
    typedef Gemm8 G;
    const int tid = opaque_tid();
    const int* cnt = (const int*)(P.ws + WS_CTL + CTL_CNT); const int* bucket = (const int*)(P.ws + WS_BUCKET); const float* rw = (const float*)(P.ws + WS_RW);
    const unsigned char* h2q = (const unsigned char*)(P.ws + WS_H2Q); unsigned char* hidR = (unsigned char*)(P.ws + WS_HIDR) + (size_t)blockIdx.x * 256 * 256; unsigned char* y = (unsigned char*)(P.ws + WS_Y);
    LAS int* tiles = (LAS int*)(lds + P6_TILES); LAS int* pre = (LAS int*)(lds + P6_PRE); LAS int* pairs = (LAS int*)(lds + P6_PAIR); LAS float* wts = (LAS float*)(lds + P6_W);
    const int nx = (gridDim.x % 8 == 0) ? 8 : 1, xl = blockIdx.x % nx, li = blockIdx.x / nx, nloc = gridDim.x / nx, nek = 256 / nx;
    if (tid < nek) { const int c_ = cnt[xl + nx * tid]; tiles[tid] = ((c_ < BCAP ? c_ : BCAP) + 255) >> 8; }
    __syncthreads();
    if (tid < nek) { int s = 0; for (int i = 0; i < tid; ++i) s += tiles[i]; pre[tid] = s; if (tid == nek - 1) pre[nek] = s + tiles[nek - 1]; }
    __syncthreads();
    const int total = pre[nek];
    for (int u = li; u < total; u += nloc) {
        int lo = 0, hi_ = nek - 1;
        while (lo < hi_) { const int mid = (lo + hi_ + 1) >> 1; if (pre[mid] <= u) lo = mid; else hi_ = mid - 1; }
        const int e = xl + nx * lo, tile = u - pre[lo], n = cnt[e] < BCAP ? cnt[e] : BCAP, rows = (n - tile * 256) < 256 ? (n - tile * 256) : 256;
        if (tid < 256) { const int r = tid < rows ? tid : 0; const int pr = bucket[(size_t)e * BCAP + tile * 256 + r]; pairs[tid] = pr; wts[tid] = tid < rows ? rw[pr] : 0.f; }
        __syncthreads();
        {
            struct GU { const unsigned char* h2q; LAS int* pairs; const unsigned char* wgu; unsigned char* hidR;
                static __device__ __forceinline__ int wscale(int it) { return (it & 1) ? 123 : 121; }
                __device__ __forceinline__ void ptrs(int t, const unsigned char* (&aptr)[2], const unsigned char* (&wptr)[2]) const {
                    const int tid = opaque_tid(), lane = tid & 63, wid = tid >> 6;
#pragma unroll
                    for (int i = 0; i < 2; ++i) { const int row = G::t_row(i, wid, lane); aptr[i] = h2q + (size_t)(pairs[row] >> 3) * 1024 + G::t_chunk(row, lane) * 16;
                        wptr[i] = wgu + (size_t)(t * 256 + row) * 1024 + G::t_chunk(row, lane) * 16; } }
                __device__ __forceinline__ void epi(int t, f32x16 (&acc)[2][4]) const {
                    const int tid = opaque_tid(), lane = tid & 63, wid = tid >> 6, wm = wid >> 1, wn = wid & 1, l31 = lane & 31, hi = lane >> 5;
                    if (PM == 2) return;
#pragma unroll
                    for (int jt = 0; jt < 2; ++jt) { const int rl = wm * 64 + jt * 32 + l31;
#pragma unroll
                        for (int p = 0; p < 2; ++p) {
                            float e[16], hv[16];
#pragma unroll
                            for (int r = 0; r < 16; ++r) e[r] = __builtin_amdgcn_exp2f(acc[jt][2 * p][r] * -LOG2E);
                            __builtin_amdgcn_sched_barrier(0);
#pragma unroll
                            for (int r = 0; r < 16; ++r) { e[r] = __builtin_amdgcn_rcpf(1.0f + e[r]); hv[r] = acc[jt][2 * p][r] * acc[jt][2 * p + 1][r]; }
                            __builtin_amdgcn_sched_barrier(0);
                            u32x4 w;
#pragma unroll
                            for (int q4 = 0; q4 < 4; ++q4) w[q4] = pk4_fp8(hv[4 * q4] * e[4 * q4], hv[4 * q4 + 1] * e[4 * q4 + 1], hv[4 * q4 + 2] * e[4 * q4 + 2], hv[4 * q4 + 3] * e[4 * q4 + 3]);
                            *(u32x4*)(hidR + rl * 256 + t * 128 + wn * 64 + p * 32 + 16 * hi) = w; } } }
            } f{h2q, pairs, (const unsigned char*)(P.ws + WS_W8GU) + (size_t)e * 512 * 1024, hidR};
            if (PM != 3) G::run_stream(f, 2, 16, lds);
        }
        __syncthreads();
        {
            struct DN { const unsigned char* hidR; const unsigned char* wd; unsigned char* y; LAS int* pairs; LAS float* wts; int rows;
                static __device__ __forceinline__ int wscale(int) { return 120; }
                __device__ __forceinline__ void ptrs(int ct, const unsigned char* (&aptr)[2], const unsigned char* (&wptr)[2]) const {
                    const int tid = opaque_tid(), lane = tid & 63, wid = tid >> 6;
#pragma unroll
                    for (int i = 0; i < 2; ++i) { const int row = G::t_row(i, wid, lane); aptr[i] = hidR + (size_t)row * 256 + G::t_chunk(row, lane) * 16;
                        wptr[i] = wd + (size_t)(ct * 256 + row) * 256 + G::t_chunk(row, lane) * 16; } }
                __device__ __forceinline__ void epi(int ct, f32x16 (&acc)[2][4]) const {
                    const int tid = opaque_tid(), lane = tid & 63, wid = tid >> 6, wm = wid >> 1, wn = wid & 1, l31 = lane & 31, hi = lane >> 5;
                    if (PM == 3) return;
#pragma unroll
                    for (int jt = 0; jt < 2; ++jt) { const int rl = wm * 64 + jt * 32 + l31; const float sc_ = wts[rl] * Y_SCALE; const size_t pr = (size_t)pairs[rl];
                        if (rl < rows) {
#pragma unroll
                            for (int it = 0; it < 4; ++it) { u32x4 w;
#pragma unroll
                                for (int q4 = 0; q4 < 4; ++q4) w[q4] = pk4_fp8(acc[jt][it][4 * q4] * sc_, acc[jt][it][4 * q4 + 1] * sc_, acc[jt][it][4 * q4 + 2] * sc_, acc[jt][it][4 * q4 + 3] * sc_);
                                *(u32x4*)(y + pr * 1024 + ct * 256 + wn * 128 + it * 32 + 16 * hi) = w; } } } }
            } f{hidR, (const unsigned char*)(P.ws + WS_W8D) + (size_t)e * 1024 * 256, y, pairs, wts, rows};
            if (PM == 0 || PM == 3) G::run_stream(f, 4, 4, lds);
        }
        __syncthreads();
    }
}

__device__ __forceinline__ void phase_combine(const Params& P) {
    const int lane = threadIdx.x & 63, gw = blockIdx.x * (NTHREADS / 64) + (threadIdx.x >> 6), NGW = gridDim.x * (NTHREADS / 64);
    const unsigned char* y = (const unsigned char*)(P.ws + WS_Y);
    typedef float f32x2_ __attribute__((ext_vector_type(2)));
    for (int m = gw; m < T; m += NGW) {
        const float* mod = (const float*)(P.ws + WS_MOD) + (m / SEQ) * 6144 + 5120;
#pragma unroll
        for (int j = 0; j < 2; ++j) { const int col = (lane + 64 * j) * 8;
            f32x4 s0 = (f32x4){0.f, 0.f, 0.f, 0.f}, s1 = s0;
#pragma unroll
            for (int sl = 0; sl < 8; ++sl) { const u32x2 v = *(const u32x2*)(y + ((size_t)m * 8 + sl) * 1024 + col);
                const f32x2_ a = __builtin_amdgcn_cvt_pk_f32_fp8((int)v.x, false), b = __builtin_amdgcn_cvt_pk_f32_fp8((int)v.x, true);
                const f32x2_ c = __builtin_amdgcn_cvt_pk_f32_fp8((int)v.y, false), d = __builtin_amdgcn_cvt_pk_f32_fp8((int)v.y, true);
                s0.x += a.x; s0.y += a.y; s0.z += b.x; s0.w += b.y; s1.x += c.x; s1.y += c.y; s1.z += d.x; s1.w += d.y; }
            const f32x4 g0 = *(const f32x4*)(mod + col), g1 = *(const f32x4*)(mod + col + 4);
            f32x4 o0 = *(const f32x4*)(P.out + (size_t)m * 1024 + col), o1 = *(const f32x4*)(P.out + (size_t)m * 1024 + col + 4);
            const u32x4 sh = *(const u32x4*)((const bf16_t*)(P.ws + WS_YSH) + (size_t)m * 1024 + col);
            const f32x4 h0 = (f32x4){__uint_as_float(sh.x << 16), __uint_as_float(sh.x & 0xffff0000u), __uint_as_float(sh.y << 16), __uint_as_float(sh.y & 0xffff0000u)};
            const f32x4 h1 = (f32x4){__uint_as_float(sh.z << 16), __uint_as_float(sh.z & 0xffff0000u), __uint_as_float(sh.w << 16), __uint_as_float(sh.w & 0xffff0000u)};
            o0 += g0 * (s0 * Y_INV + h0); o1 += g1 * (s1 * Y_INV + h1);
            *(f32x4*)(P.out + (size_t)m * 1024 + col) = o0; *(f32x4*)(P.out + (size_t)m * 1024 + col + 4) = o1; }
    }
}


__device__ __forceinline__ int queue_pull(unsigned* head, volatile LAS unsigned* slot) {
    if (threadIdx.x == 0) *slot = atomicAdd(head, 1u);
    __syncthreads();
    const int v = (int)*slot;
    __syncthreads();
    return v;
}
__device__ __forceinline__ void phase_cmp_h1(const Params& P, LAS unsigned char* lds, volatile LAS unsigned* slot) {
    unsigned* head = (unsigned*)(P.ws + WS_CTL + CTL_Q2);
    for (;;) {
        const int u = queue_pull(head, slot);
        if (u >= 64 + 512) break;
        if (u < 64) compress_unit(P, lds, u); else hgrn_unit<0>(P, lds, u - 64);
    }
}
__device__ __forceinline__ void phase_h23_nsa(const Params& P, LAS unsigned char* lds, volatile LAS unsigned* slot) {
    unsigned* head = (unsigned*)(P.ws + WS_CTL + CTL_Q3);
    for (;;) {
        const int n = queue_pull(head, slot);
        if (n >= 1536) break;
        if (n < 512) nsa_unit(P, lds, (n & 7) * 128 + (127 - (n >> 3)));
        else if (n < 1024) { const int m = n - 512; hgrn_unit<1>(P, lds, (m & 15) * 32 + (31 - (m >> 4))); }
        else { const int m = n - 1024; nsa_unit(P, lds, (m & 7) * 128 + (63 - (m >> 3))); }
    }
}

constexpr int LDS_BYTES = 144 * 1024;
__global__ void __launch_bounds__(NTHREADS) mega(Params P) {
    extern __shared__ __attribute__((aligned(16))) unsigned char smem[];
    LAS unsigned char* lds = (LAS unsigned char*)smem;
    volatile LAS unsigned* xst = (volatile LAS unsigned*)(lds + LDS_BYTES - 16);
    if (threadIdx.x < 4) xst[threadIdx.x] = 0u;
    __syncthreads();
    XcdBarrier xb = xcd_barrier_post((unsigned*)(P.ws + WS_CTL + CTL_BAR), xst);
    phase_mod(P, lds);
    xcd_barrier(xb);
    { const float* mod = (const float*)(P.ws + WS_MOD); norm_mod_rows(P.x, P.norm1_w, mod, mod + 1024, (unsigned char*)(P.ws + WS_H), H1S); }
    xcd_barrier(xb);
    phase_inproj(P, lds);
    xcd_barrier(xb);
    phase_cmp_h1(P, lds, xst + 2);
    xcd_barrier(xb);
    phase_h23_nsa(P, lds, xst + 2);
    phase_cvt_small(P);
    xcd_barrier(xb);
    phase_p4a(P, lds);
    xcd_barrier(xb);
    phase_p4b(P);
    xcd_barrier(xb);
    phase_p4c(P, lds);
    xcd_barrier(xb);
    phase_route(P);
    phase_p4d(P, lds);
    xcd_barrier(xb);
    phase_expert_cvt8(P);
    xcd_barrier(xb);
    phase_experts8<0>(P, lds);
    xcd_barrier(xb);
    phase_combine(P);
}

extern "C" void kernel_launch(void* const* d_in, const int* in_sizes, int n_in, void* d_out, int out_size, void* d_ws, size_t ws_size, hipStream_t stream) {
    static int grid = 0;
    if (grid == 0) {
        if (n_in != 25 || ws_size < WS_END) { fprintf(stderr, "kernel_launch: unexpected n_in %d or ws_size %zu (need %zu)\n", n_in, ws_size, (size_t)WS_END); grid = -1; return; }
        int dev = 0, cus = 0, per_cu = 0;
        (void)hipGetDevice(&dev); (void)hipDeviceGetAttribute(&cus, hipDeviceAttributeMultiprocessorCount, dev);
        (void)hipFuncSetAttribute((const void*)mega, hipFuncAttributeMaxDynamicSharedMemorySize, LDS_BYTES);
        (void)hipOccupancyMaxActiveBlocksPerMultiprocessor(&per_cu, (const void*)mega, NTHREADS, LDS_BYTES);
        if (per_cu < 1) { fprintf(stderr, "kernel_launch: occupancy query says %d blocks per CU\n", per_cu); grid = -1; return; }
        grid = cus;
    }
    if (grid < 0) return;
    (void)hipMemsetAsync((char*)d_ws + WS_CTL, 0, 64 * 1024, stream);
    Params p{};
    const float** pf = (const float**)&p;
    for (int i = 0; i < 25; ++i) pf[i] = (const float*)d_in[i];
    p.out = (float*)d_out; p.ws = (unsigned char*)d_ws;
    void* args[] = {&p};
    hipError_t e = hipLaunchCooperativeKernel((const void*)mega, dim3(grid), dim3(NTHREADS), args, LDS_BYTES, stream);
    if (e != hipSuccess) fprintf(stderr, "cooperative launch failed: %s (grid %d)\n", hipGetErrorString(e), grid);
}

#ifdef PHASE_TEST
__global__ void __launch_bounds__(NTHREADS) t_p4a(Params P) { extern __shared__ __attribute__((aligned(16))) unsigned char smem[]; phase_p4a(P, (LAS unsigned char*)smem); }
__global__ void __launch_bounds__(NTHREADS) t_p4d(Params P) { extern __shared__ __attribute__((aligned(16))) unsigned char smem[]; phase_p4d(P, (LAS unsigned char*)smem); }
__global__ void __launch_bounds__(NTHREADS) t_p4(Params P) { extern __shared__ __attribute__((aligned(16))) unsigned char smem[]; phase_p4c(P, (LAS unsigned char*)smem); }
__global__ void __launch_bounds__(NTHREADS) t_p6(Params P) { extern __shared__ __attribute__((aligned(16))) unsigned char smem[]; phase_experts(P, (LAS unsigned char*)smem); }
__global__ void __launch_bounds__(NTHREADS) t_nsa(Params P) { extern __shared__ __attribute__((aligned(16))) unsigned char smem[]; nsa_unit(P, (LAS unsigned char*)smem, blockIdx.x); }
__global__ void __launch_bounds__(NTHREADS) t_mod(Params P) { extern __shared__ __attribute__((aligned(16))) unsigned char smem[]; phase_mod(P, (LAS unsigned char*)smem); }
__global__ void __launch_bounds__(NTHREADS) t_inproj(Params P) { extern __shared__ __attribute__((aligned(16))) unsigned char smem[]; phase_inproj(P, (LAS unsigned char*)smem); }
__global__ void __launch_bounds__(NTHREADS) t_cmp(Params P) { extern __shared__ __attribute__((aligned(16))) unsigned char smem[]; compress_unit(P, (LAS unsigned char*)smem, blockIdx.x); }
__global__ void __launch_bounds__(NTHREADS) t_h0(Params P) { extern __shared__ __attribute__((aligned(16))) unsigned char smem[]; hgrn_unit<0>(P, (LAS unsigned char*)smem, blockIdx.x); }
__global__ void __launch_bounds__(NTHREADS) t_h1(Params P) { extern __shared__ __attribute__((aligned(16))) unsigned char smem[]; hgrn_unit<1>(P, (LAS unsigned char*)smem, blockIdx.x); }
#endif
```

```cpp
#include <hip/hip_runtime.h>
#include <hip/hip_cooperative_groups.h>
#include <cstdio>
#include <cstdint>
#include <type_traits>
namespace cg = cooperative_groups;

#define LAS __attribute__((address_space(3)))
typedef unsigned short bf16_t;
typedef short bf16x8 __attribute__((ext_vector_type(8)));
typedef short s16x4 __attribute__((ext_vector_type(4)));
typedef float f32x4 __attribute__((ext_vector_type(4)));
typedef float f32x16 __attribute__((ext_vector_type(16)));
typedef unsigned u32x4 __attribute__((ext_vector_type(4)));
typedef unsigned u32x2 __attribute__((ext_vector_type(2)));

constexpr int D = 1024, BATCH = 4, SEQ = 8192, T = BATCH * SEQ;
constexpr int IN_COLS = 3352;
constexpr int NTHREADS = 512;
constexpr int H1S = 1088;
constexpr float RMS_EPS = 1e-6f;
constexpr float LOG2E = 1.4426950408889634f;
constexpr float Y_SCALE = 16.0f, Y_INV = 1.0f / 16.0f;

constexpr size_t MB = 1024ull * 1024ull;
constexpr size_t WS_CTL    = 0;
constexpr size_t WS_MOD    = 64 * 1024;
constexpr size_t WS_LB     = WS_MOD + 4 * 6144 * 4;
constexpr size_t WS_CB     = WS_LB + 2048;
constexpr size_t WS_H      = 1 * MB;
constexpr size_t WS_SS     = WS_H + 72 * MB;
constexpr size_t WS_RW     = WS_SS + 1 * MB;
constexpr size_t WS_BUCKET = WS_RW + 1 * MB;
constexpr size_t WS_HIDR   = WS_BUCKET + 16 * MB;
constexpr size_t WS_WSM    = WS_HIDR + 32 * MB;
constexpr size_t WS_WOUT   = WS_WSM, WS_WRS = WS_WSM + 2 * MB, WS_WSD = WS_WSM + 4 * MB;
constexpr size_t WS_WBE    = WS_WSM + 5 * MB;
constexpr size_t WS_WBGU   = WS_WBE, WS_WBD = WS_WBE + 256 * MB;
constexpr size_t WS_W8GU   = WS_WBE, WS_W8D = WS_WBE + 128 * MB, WS_H2Q = WS_WBE + 256 * MB;
constexpr size_t WS_X1     = WS_WBE + 192 * MB;
constexpr float W8_GU_SCALE = 64.0f, W8_D_SCALE = 32.0f, HID8_SCALE = 4.0f;
constexpr size_t WS_SCORES = WS_WBE;
constexpr size_t WS_HIDS   = WS_SCORES + 32 * MB;
constexpr size_t WS_WIN    = WS_HIDS + 16 * MB;
constexpr size_t WS_Y      = WS_WBE + 384 * MB;
constexpr size_t WS_Q      = WS_Y;
constexpr size_t WS_KV     = WS_Q + 32 * MB;
constexpr size_t WS_GATES  = WS_KV + 48 * MB;
constexpr size_t WS_HQ     = WS_GATES + 4 * MB;
constexpr size_t WS_LOGF   = WS_HQ + 32 * MB;
constexpr size_t WS_HV     = WS_LOGF + 64 * MB;
constexpr size_t WS_HG     = WS_HV + 32 * MB;
constexpr size_t WS_CMPH   = WS_HG + 32 * MB;
constexpr size_t WS_KC     = WS_CMPH + 4 * MB;
constexpr size_t WS_VC     = WS_KC + 1 * MB;
constexpr size_t WS_HL     = WS_VC + 1 * MB;
constexpr size_t WS_HD     = WS_HL + 32 * MB;
constexpr size_t WS_MIX    = WS_HD + 1 * MB;
constexpr size_t WS_YSH    = WS_Y + 384 * MB;
constexpr size_t WS_END    = WS_YSH + 64 * MB;
constexpr int BCAP = 16384;
constexpr int CTL_CNT = 1024;
constexpr int CTL_Q2 = 2048, CTL_Q3 = 2112;
constexpr int CTL_BAR = 16384;

struct Params {
    const float *x, *c, *ada_w, *ada_b, *norm1_w, *norm2_w, *w_in, *q_norm_w, *k_norm_w, *cmp_pos, *cmp_w1, *cmp_b1, *cmp_w2,
        *attn_out_norm_w, *hgrn_lb, *rec_out_norm_w, *w_out, *router_w, *router_bias, *exp_wg, *exp_wu, *exp_wd, *sh_wg, *sh_wu, *sh_wd;
    float* out;
    unsigned char* ws;
};

typedef __bf16 bf16x2_t __attribute__((ext_vector_type(2)));
typedef int i32x8 __attribute__((ext_vector_type(8)));
__device__ __forceinline__ unsigned cvtpk(float lo, float hi) { bf16x2_t v; v.x = (__bf16)lo; v.y = (__bf16)hi; return __builtin_bit_cast(unsigned, v); }
__device__ __forceinline__ int opaque_tid() { int t = threadIdx.x; asm volatile("" : "+v"(t)); return t; }
__device__ __forceinline__ float bf2f(bf16_t v) { return __uint_as_float(((unsigned)v) << 16); }
__device__ __forceinline__ float sigmoidf_(float v) { return __builtin_amdgcn_rcpf(1.0f + __expf(-v)); }
__device__ __forceinline__ float siluf_(float v) { return v * __builtin_amdgcn_rcpf(1.0f + __expf(-v)); }
__device__ __forceinline__ float wave_sum(float v) {
#pragma unroll
    for (int o = 1; o < 64; o <<= 1) v += __shfl_xor(v, o);
    return v;
}
__device__ __forceinline__ s16x4 lds_tr(const LAS unsigned char* p) {
    return __builtin_bit_cast(s16x4, __builtin_amdgcn_ds_read_tr16_b64_v4i16((LAS s16x4*)p));
}

#define XB_TMO      128
#define XB_XCNT(j)  (256  + 64 * (j))
#define XB_XSUB(j)  (1280 + 64 * (j))
#define XB_XGEN(j)  (2304 + 64 * (j))
#define XB_TOP      3328
#define XB_TOPGEN   3392
#define XCD_BAR_WORDS 3456
#define XB_SPIN_CAP (1u << 22)
__device__ __forceinline__ unsigned xb_ld(unsigned* p)              { return __hip_atomic_load(p, __ATOMIC_RELAXED, __HIP_MEMORY_SCOPE_AGENT); }
__device__ __forceinline__ unsigned xb_add(unsigned* p, unsigned v) { return __hip_atomic_fetch_add(p, v, __ATOMIC_RELAXED, __HIP_MEMORY_SCOPE_AGENT); }
__device__ __forceinline__ unsigned xb_xcc_id() { return (unsigned)__builtin_amdgcn_s_getreg((3 << 11) | 20) & 0xFu; }
#define XB_SPIN(cond, bar) do { unsigned _sp = 0; while (cond) { __builtin_amdgcn_s_sleep(1); \
    if ((++_sp & 255u) == 0u) { if (xb_ld(&(bar)[XB_TMO])) break; if (_sp > XB_SPIN_CAP) { atomicAdd(&(bar)[XB_TMO], 1u); break; } } } } while (0)
struct XcdBarrier { unsigned* bar; unsigned x; volatile LAS unsigned* st; };
__device__ __forceinline__ XcdBarrier xcd_barrier_post(unsigned* bar, volatile LAS unsigned* st) {
    XcdBarrier b; b.bar = bar; b.x = xb_xcc_id(); b.st = st;
    if (threadIdx.x == 0) (void)xb_add(&bar[XB_XCNT(b.x)], 1u);
    return b;
}
__device__ __forceinline__ void xcd_barrier_complete(unsigned* bar, unsigned x, unsigned& nloc, unsigned& nx) {
    const unsigned G = gridDim.x * gridDim.y * gridDim.z;
    unsigned sum, cnt, mine, sp = 0u;
    for (;;) {
        sum = 0u; cnt = 0u; mine = 0u;
#pragma unroll
        for (unsigned j = 0; j < 16; ++j) { const unsigned c = xb_ld(&bar[XB_XCNT(j)]); sum += c; cnt += (c > 0u) ? 1u : 0u; mine = (j == x) ? c : mine; }
        if (sum == G) break;
        __builtin_amdgcn_s_sleep(1);
        if ((++sp & 255u) == 0u) { if (xb_ld(&bar[XB_TMO])) break; if (sp > XB_SPIN_CAP) { atomicAdd(&bar[XB_TMO], 1u); break; } }
    }
    nloc = mine > 0u ? mine : 1u; nx = cnt > 0u ? cnt : 1u;
}
__device__ __forceinline__ void xcd_barrier(const XcdBarrier& b) {
    asm volatile("s_waitcnt vmcnt(0)" ::: "memory");
    __syncthreads();
    if (threadIdx.x == 0) {
        unsigned* bar = b.bar;
        __builtin_amdgcn_s_waitcnt(0);
        unsigned nloc = b.st[0], nx = b.st[1];
        if (nloc == 0u) { xcd_barrier_complete(bar, b.x, nloc, nx); b.st[0] = nloc; b.st[1] = nx; }
        const unsigned old = xb_add(&bar[XB_XSUB(b.x)], 1u);
        const unsigned gen = old / nloc;
        if (old + 1u == (gen + 1u) * nloc) {
            __builtin_amdgcn_fence(__ATOMIC_RELEASE, "agent");
            asm volatile("s_waitcnt vmcnt(0)" ::: "memory");
            const unsigned og = xb_add(&bar[XB_TOP], 1u);
            const unsigned tg = og / nx;
            if (og + 1u == (tg + 1u) * nx) xb_add(&bar[XB_TOPGEN], 1u);
            else XB_SPIN(xb_ld(&bar[XB_TOPGEN]) == tg, bar);
            __builtin_amdgcn_fence(__ATOMIC_ACQUIRE, "agent");
            xb_add(&bar[XB_XGEN(b.x)], 1u);
            asm volatile("s_waitcnt vmcnt(0)" ::: "memory");
        } else {
            XB_SPIN(xb_ld(&bar[XB_XGEN(b.x)]) == gen, bar);
            __builtin_amdgcn_fence(__ATOMIC_ACQUIRE, "agent");
            asm volatile("s_waitcnt vmcnt(0)" ::: "memory");
        }
    }
    __syncthreads();
}

template <int WM, int WN> struct GemmT {
    static constexpr int BM = 64 * WM, BN = 64 * WN;
    static constexpr int A_BYTES = BM * 128, B_BYTES = 64 * BN * 2, STAGE = A_BYTES + B_BYTES, LDS_BYTES = 2 * STAGE;
    static constexpr int NB4 = BN / 32;
    static constexpr int B_ROW4 = BN / 4;

    static __device__ __forceinline__ void run(f32x4 (&acc)[4][4], const bf16_t* const (&arow)[WM], int a_kstride, const float* Bp, int ldb, int KT, LAS unsigned char* lds) {
        const int tid = opaque_tid(), lane = tid & 63, wid = tid >> 6, wm = wid / WN, wn = wid % WN, fr = lane & 15, fq = lane >> 4;
#pragma unroll
        for (int mi = 0; mi < 4; ++mi)
#pragma unroll
            for (int ni = 0; ni < 4; ++ni) acc[mi][ni] = (f32x4){0.f, 0.f, 0.f, 0.f};
        const int achunk = tid & 7;
        u32x4 areg[WM]; f32x4 breg[NB4];
        int a_wr[WM];
#pragma unroll
        for (int p = 0; p < WM; ++p) { const int row = p * 64 + (tid >> 3); a_wr[p] = row * 128 + ((achunk ^ ((row >> 1) & 7)) << 4); }
        int b_wr[NB4]; int b_goff[NB4];
#pragma unroll
        for (int p = 0; p < NB4; ++p) { const int i = tid + NTHREADS * p, k = i / B_ROW4, n = (i % B_ROW4) * 4;
            const int f = (k & 3) | (((k >> 3) & 1) << 2);
            b_wr[p] = A_BYTES + k * (BN * 2) + (((n >> 4) ^ f) << 5) + ((n & 15) << 1); b_goff[p] = k * ldb + n; }
        int a_rd[4][2];
#pragma unroll
        for (int mi = 0; mi < 4; ++mi)
#pragma unroll
            for (int ks = 0; ks < 2; ++ks) { const int row = wm * 64 + mi * 16 + fr, ch = ks * 4 + fq; a_rd[mi][ks] = row * 128 + ((ch ^ ((row >> 1) & 7)) << 4); }
        int b_rd[2][2];
        int b_f[2][2];
#pragma unroll
        for (int ks = 0; ks < 2; ++ks)
#pragma unroll
            for (int t = 0; t < 2; ++t) { const int k = ks * 32 + 8 * fq + 4 * t + (fr >> 2); b_f[ks][t] = (k & 3) | (((k >> 3) & 1) << 2);
                b_rd[ks][t] = A_BYTES + k * (BN * 2) + ((fr & 3) << 3); }

        auto gload = [&](int kt) {
#pragma unroll
            for (int p = 0; p < WM; ++p) areg[p] = *(const u32x4*)(arow[p] + (size_t)kt * a_kstride + achunk * 8);
            const float* bk = Bp + (size_t)kt * 64 * ldb;
#pragma unroll
            for (int p = 0; p < NB4; ++p) breg[p] = *(const f32x4*)(bk + b_goff[p]);
        };
        auto lstore = [&](int buf) {
            LAS unsigned char* base = lds + buf * STAGE;
#pragma unroll
            for (int p = 0; p < WM; ++p) *(LAS u32x4*)(base + a_wr[p]) = areg[p];
#pragma unroll
            for (int p = 0; p < NB4; ++p) { u32x2 w; w.x = cvtpk(breg[p].x, breg[p].y); w.y = cvtpk(breg[p].z, breg[p].w); *(LAS u32x2*)(base + b_wr[p]) = w; }
        };
        gload(0); lstore(0); __syncthreads();
        for (int kt = 0; kt < KT; ++kt) {
            if (kt + 1 < KT) gload(kt + 1);
            __builtin_amdgcn_sched_barrier(0);
            const LAS unsigned char* base = lds + (kt & 1) * STAGE;
#pragma unroll
            for (int ks = 0; ks < 2; ++ks) {
                bf16x8 af[4], bfr[4];
#pragma unroll
                for (int mi = 0; mi < 4; ++mi) af[mi] = *(const LAS bf16x8*)(base + a_rd[mi][ks]);
#pragma unroll
                for (int ni = 0; ni < 4; ++ni) {
                    const int u0 = wn * 4 + ni;
                    const s16x4 lo = lds_tr(base + b_rd[ks][0] + ((u0 ^ b_f[ks][0]) << 5));
                    const s16x4 hi = lds_tr(base + b_rd[ks][1] + ((u0 ^ b_f[ks][1]) << 5));
                    bfr[ni] = (bf16x8){lo[0], lo[1], lo[2], lo[3], hi[0], hi[1], hi[2], hi[3]};
                }
#pragma unroll
                for (int mi = 0; mi < 4; ++mi)
#pragma unroll
                    for (int ni = 0; ni < 4; ++ni) acc[mi][ni] = __builtin_amdgcn_mfma_f32_16x16x32_bf16(bfr[ni], af[mi], acc[mi][ni], 0, 0, 0);
            }
            if (kt + 1 < KT) lstore((kt + 1) & 1);
            __syncthreads();
        }
    }
};

struct Gemm2 {
    static constexpr int A_BYTES = 32768, STAGE = 65536, LDS_BYTES = 2 * STAGE;
    static __device__ __forceinline__ int a_row(int i, int w, int lane) { return (i * 8 + w) * 8 + (lane >> 3); }
    static __device__ __forceinline__ int a_chunk(int row, int lane) { return (lane & 7) ^ ((row >> 1) & 7); }
    static __device__ __forceinline__ int b_k(int i, int w, int lane) { return (i * 8 + w) * 2 + (lane >> 5); }
    static __device__ __forceinline__ int b_n(int k, int lane) { return ((((lane & 31) >> 1) ^ fk2(k)) << 4) + ((lane & 1) << 3); }
    static __device__ __forceinline__ int fk2(int r) { return (r & 3) | (((r >> 3) & 1) << 2); }

    static __device__ __forceinline__ void run(f32x4 (&acc)[4][8], const bf16_t* const (&aptr)[4], int a_kstride, const bf16_t* const (&bptr)[4], size_t b_kstride, int KT, LAS unsigned char* lds) {
        const int tid = opaque_tid(), lane = tid & 63, wid = tid >> 6, wm = wid >> 1, wn = wid & 1, fr = lane & 15, fq = lane >> 4;
        const int wu = __builtin_amdgcn_readfirstlane(wid);
#pragma unroll
        for (int mi = 0; mi < 4; ++mi)
#pragma unroll
            for (int ni = 0; ni < 8; ++ni) acc[mi][ni] = (f32x4){0.f, 0.f, 0.f, 0.f};
        int a_rd[4][2];
#pragma unroll
        for (int mi = 0; mi < 4; ++mi)
#pragma unroll
            for (int ks = 0; ks < 2; ++ks) { const int row = wm * 64 + mi * 16 + fr, ch = ks * 4 + fq; a_rd[mi][ks] = row * 128 + ((ch ^ ((row >> 1) & 7)) << 4); }
        int b_rd[2][2], b_f[2][2];
#pragma unroll
        for (int ks = 0; ks < 2; ++ks)
#pragma unroll
            for (int t = 0; t < 2; ++t) { const int k = ks * 32 + 8 * fq + 4 * t + (fr >> 2); b_f[ks][t] = fk2(k); b_rd[ks][t] = A_BYTES + k * 512 + ((fr & 3) << 3); }
        auto issue = [&](int kt, int buf) {
            LAS unsigned char* base = lds + buf * STAGE + wu * 1024;
#pragma unroll
            for (int i = 0; i < 4; ++i) __builtin_amdgcn_global_load_lds((const unsigned*)(aptr[i] + (size_t)kt * a_kstride), (LAS unsigned*)(base + i * 8192), 16, 0, 0);
#pragma unroll
            for (int i = 0; i < 4; ++i) __builtin_amdgcn_global_load_lds((const unsigned*)(bptr[i] + (size_t)kt * b_kstride), (LAS unsigned*)(base + A_BYTES + i * 8192), 16, 0, 0);
        };
        issue(0, 0);
        for (int kt = 0; kt < KT; ++kt) {
            asm volatile("s_waitcnt vmcnt(0)" ::: "memory");
            __syncthreads();
            if (kt + 1 < KT) issue(kt + 1, (kt + 1) & 1);
            const LAS unsigned char* base = lds + (kt & 1) * STAGE;
#pragma unroll
            for (int ks = 0; ks < 2; ++ks) {
                bf16x8 af[4];
#pragma unroll
                for (int mi = 0; mi < 4; ++mi) af[mi] = *(const LAS bf16x8*)(base + a_rd[mi][ks]);
#pragma unroll
                for (int ni = 0; ni < 8; ++ni) {
                    const int u0 = wn * 8 + ni;
                    const s16x4 lo = lds_tr(base + b_rd[ks][0] + ((u0 ^ b_f[ks][0]) << 5));
                    const s16x4 hi = lds_tr(base + b_rd[ks][1] + ((u0 ^ b_f[ks][1]) << 5));
                    const bf16x8 bfr = (bf16x8){lo[0], lo[1], lo[2], lo[3], hi[0], hi[1], hi[2], hi[3]};
#pragma unroll
                    for (int mi = 0; mi < 4; ++mi) acc[mi][ni] = __builtin_amdgcn_mfma_f32_16x16x32_bf16(bfr, af[mi], acc[mi][ni], 0, 0, 0);
                }
            }
        }
        __syncthreads();
    }
};

__device__ __forceinline__ void glds16(const void* g, unsigned lds_base) {
    unsigned sv; asm volatile("s_mov_b32 %0, m0\n\ts_mov_b32 m0, %2\n\ts_nop 0\n\tglobal_load_lds_dwordx4 %1, off\n\ts_mov_b32 m0, %0" : "=&s"(sv) : "v"(g), "s"(lds_base) : "memory"); }
struct Gemm3 {
    static constexpr int A_BYTES = 16384, STAGE = 32768, LDS_BYTES = 4 * STAGE;
    static __device__ __forceinline__ int a_row(int i, int w, int lane) { return (i * 8 + w) * 16 + (lane >> 2); }
    static __device__ __forceinline__ int a_chunk(int row, int lane) { return (lane & 3) ^ ((row >> 1) & 3); }
    static __device__ __forceinline__ int b_k(int i, int w, int lane) { return (i * 8 + w) * 2 + (lane >> 5); }
    static __device__ __forceinline__ int fk2(int r) { return (r & 3) | (((r >> 3) & 1) << 2); }
    static __device__ __forceinline__ int b_n(int k, int lane) { return ((((lane & 31) >> 1) ^ fk2(k)) << 4) + ((lane & 1) << 3); }
    static __device__ __forceinline__ void run(f32x4 (&acc)[4][8], const bf16_t* const (&aptr)[2], int a_kstride, const bf16_t* const (&bptr)[2], size_t b_kstride, int KT, LAS unsigned char* lds) {
        const int tid = opaque_tid(), lane = tid & 63, wid = tid >> 6, wm = wid >> 1, wn = wid & 1, fr = lane & 15, fq = lane >> 4;
        const int wu = __builtin_amdgcn_readfirstlane(wid);
#pragma unroll
        for (int mi = 0; mi < 4; ++mi)
#pragma unroll
            for (int ni = 0; ni < 8; ++ni) acc[mi][ni] = (f32x4){0.f, 0.f, 0.f, 0.f};
        int a_rd[4];
#pragma unroll
        for (int mi = 0; mi < 4; ++mi) { const int row = wm * 64 + mi * 16 + fr; a_rd[mi] = row * 64 + ((fq ^ ((row >> 1) & 3)) << 4); }
        int b_rd[2], b_f[2];
#pragma unroll
        for (int t = 0; t < 2; ++t) { const int k = 8 * fq + 4 * t + (fr >> 2); b_f[t] = fk2(k); b_rd[t] = A_BYTES + k * 512 + ((fr & 3) << 3); }
        const unsigned lds0 = (unsigned)(uintptr_t)lds + (unsigned)wu * 1024u;
        auto issue = [&](int kt) {
            const unsigned base = (unsigned)__builtin_amdgcn_readfirstlane((int)(lds0 + (unsigned)(kt & 3) * STAGE));
#pragma unroll
            for (int i = 0; i < 2; ++i) glds16(aptr[i] + (size_t)kt * a_kstride, base + i * 8192);
#pragma unroll
            for (int i = 0; i < 2; ++i) glds16(bptr[i] + (size_t)kt * b_kstride, base + A_BYTES + i * 8192);
        };
        const int grp = wu >> 2;
        auto bar = [&]() { asm volatile("s_waitcnt lgkmcnt(0)" ::: "memory"); __builtin_amdgcn_s_barrier(); asm volatile("" ::: "memory"); };
        asm volatile("s_waitcnt vmcnt(0)" ::: "memory");
        issue(0); if (KT > 1) issue(1); if (KT > 2) issue(2);
        if (KT > 2) asm volatile("s_waitcnt vmcnt(8)" ::: "memory"); else if (KT > 1) asm volatile("s_waitcnt vmcnt(4)" ::: "memory"); else asm volatile("s_waitcnt vmcnt(0)" ::: "memory");
        bar();
        if (grp) bar();
#pragma unroll 1
        for (int kt = 0; kt < KT; ++kt) {
            if (kt + 3 < KT) issue(kt + 3);
            const LAS unsigned char* base = lds + (kt & 3) * STAGE;
            bf16x8 af[4], bfr[8];
#pragma unroll
            for (int mi = 0; mi < 4; ++mi) af[mi] = *(const LAS bf16x8*)(base + a_rd[mi]);
#pragma unroll
            for (int ni = 0; ni < 8; ++ni) {
                const int u0 = wn * 8 + ni;
                const s16x4 lo = lds_tr(base + b_rd[0] + ((u0 ^ b_f[0]) << 5));
                const s16x4 hi = lds_tr(base + b_rd[1] + ((u0 ^ b_f[1]) << 5));
                bfr[ni] = (bf16x8){lo[0], lo[1], lo[2], lo[3], hi[0], hi[1], hi[2], hi[3]};
            }
            { const int rem = KT - 2 - kt;
              if (rem >= 2) asm volatile("s_waitcnt vmcnt(8)" ::: "memory"); else if (rem == 1) asm volatile("s_waitcnt vmcnt(4)" ::: "memory"); else asm volatile("s_waitcnt vmcnt(0)" ::: "memory"); }
            bar();
            __builtin_amdgcn_sched_barrier(0);
#pragma unroll
            for (int ni = 0; ni < 8; ++ni)
#pragma unroll
                for (int mi = 0; mi < 4; ++mi) acc[mi][ni] = __builtin_amdgcn_mfma_f32_16x16x32_bf16(bfr[ni], af[mi], acc[mi][ni], 0, 0, 0);
            __builtin_amdgcn_sched_barrier(0);
            bar();
        }
        if (!grp) bar();
    }

    template <class F> static __device__ __forceinline__ void run_stream(F& f, int NSEG, int KT, int a_kstride, size_t b_kstride, LAS unsigned char* lds) {
        const int tid = opaque_tid(), lane = tid & 63, wid = tid >> 6, wm = wid >> 1, wn = wid & 1, fr = lane & 15, fq = lane >> 4;
        const int wu = __builtin_amdgcn_readfirstlane(wid);
        f32x4 acc[4][8];
#pragma unroll
        for (int mi = 0; mi < 4; ++mi)
#pragma unroll
            for (int ni = 0; ni < 8; ++ni) acc[mi][ni] = (f32x4){0.f, 0.f, 0.f, 0.f};
        int a_rd[4];
#pragma unroll
        for (int mi = 0; mi < 4; ++mi) { const int row = wm * 64 + mi * 16 + fr; a_rd[mi] = row * 64 + ((fq ^ ((row >> 1) & 3)) << 4); }
        int b_rd[2], b_f[2];
#pragma unroll
        for (int t = 0; t < 2; ++t) { const int k = 8 * fq + 4 * t + (fr >> 2); b_f[t] = fk2(k); b_rd[t] = A_BYTES + k * 512 + ((fr & 3) << 3); }
        const unsigned lds0 = (unsigned)(uintptr_t)lds + (unsigned)wu * 1024u;
        const bf16_t* aptr[2]; const bf16_t* bptr[2];
        const int total = NSEG * KT;
        int lseg = 0, lkt = 0, lg = 0;
        auto issue = [&]() {
            const unsigned base = (unsigned)__builtin_amdgcn_readfirstlane((int)(lds0 + (unsigned)(lg & 3) * STAGE));
#pragma unroll
            for (int i = 0; i < 2; ++i) glds16(aptr[i] + (size_t)lkt * a_kstride, base + i * 8192);
#pragma unroll
            for (int i = 0; i < 2; ++i) glds16(bptr[i] + (size_t)lkt * b_kstride, base + A_BYTES + i * 8192);
            ++lg; if (++lkt == KT) { lkt = 0; ++lseg; if (lseg < NSEG) f.ptrs(lseg, aptr, bptr); }
        };
        const int grp = wu >> 2;
        auto bar = [&]() { asm volatile("s_waitcnt lgkmcnt(0)" ::: "memory"); __builtin_amdgcn_s_barrier(); asm volatile("" ::: "memory"); };
        f.ptrs(0, aptr, bptr);
        asm volatile("s_waitcnt vmcnt(0)" ::: "memory");
        issue(); if (total > 1) issue(); if (total > 2) issue();
        if (total > 2) asm volatile("s_waitcnt vmcnt(8)" ::: "memory"); else if (total > 1) asm volatile("s_waitcnt vmcnt(4)" ::: "memory"); else asm volatile("s_waitcnt vmcnt(0)" ::: "memory");
        bar();
        if (grp) bar();
        int cseg = 0, ckt = 0;
#pragma unroll 1
        for (int g = 0; g < total; ++g) {
            if (lg < total) issue();
            const LAS unsigned char* base = lds + (g & 3) * STAGE;
            bf16x8 af[4], bfr[8];
#pragma unroll
            for (int mi = 0; mi < 4; ++mi) af[mi] = *(const LAS bf16x8*)(base + a_rd[mi]);
#pragma unroll
            for (int ni = 0; ni < 8; ++ni) {
                const int u0 = wn * 8 + ni;
                const s16x4 lo = lds_tr(base + b_rd[0] + ((u0 ^ b_f[0]) << 5));
                const s16x4 hi = lds_tr(base + b_rd[1] + ((u0 ^ b_f[1]) << 5));
                bfr[ni] = (bf16x8){lo[0], lo[1], lo[2], lo[3], hi[0], hi[1], hi[2], hi[3]};
            }
            { const int rem = total - 2 - g;
              if (rem >= 2) asm volatile("s_waitcnt vmcnt(8)" ::: "memory"); else if (rem == 1) asm volatile("s_waitcnt vmcnt(4)" ::: "memory"); else asm volatile("s_waitcnt vmcnt(0)" ::: "memory"); }
            bar();
            __builtin_amdgcn_sched_barrier(0);
#pragma unroll
            for (int ni = 0; ni < 8; ++ni)
#pragma unroll
                for (int mi = 0; mi < 4; ++mi) acc[mi][ni] = __builtin_amdgcn_mfma_f32_16x16x32_bf16(bfr[ni], af[mi], acc[mi][ni], 0, 0, 0);
            __builtin_amdgcn_sched_barrier(0);
            bar();
            if (++ckt == KT) {
                if (!grp) bar();
                f.epi(cseg, acc);
#pragma unroll
                for (int mi = 0; mi < 4; ++mi)
#pragma unroll
                    for (int ni = 0; ni < 8; ++ni) acc[mi][ni] = (f32x4){0.f, 0.f, 0.f, 0.f};
                ckt = 0; ++cseg;
                if (grp) bar();
            }
        }
        if (!grp) bar();
    }
};

struct Gemm8 {
    static constexpr int A_BYTES = 16384, STAGE = 32768;
    static __device__ __forceinline__ int t_row(int i, int w, int lane) { return (i * 8 + w) * 16 + (lane >> 2); }
    static __device__ __forceinline__ int t_chunk(int row, int lane) { return (lane & 3) ^ ((row >> 1) & 3); }
    static __device__ __forceinline__ int w_col(int i) { return 16 * ((i >> 2) & 1) + 4 * (i >> 3) + (i & 3); }
    template <class F> static __device__ __forceinline__ void run_stream(F& f, int NSEG, int KT, LAS unsigned char* lds) {
        const int tid = opaque_tid(), lane = tid & 63, wid = tid >> 6, wm = wid >> 1, wn = wid & 1, l31 = lane & 31, hi = lane >> 5;
        const int wu = __builtin_amdgcn_readfirstlane(wid);
        f32x16 acc[2][4];
#pragma unroll
        for (int jt = 0; jt < 2; ++jt)
#pragma unroll
            for (int it = 0; it < 4; ++it)
#pragma unroll
                for (int r = 0; r < 16; ++r) acc[jt][it][r] = 0.f;
        const int sw = (l31 >> 1) & 3;
        const int t_rd0 = (wm * 64 + l31) * 64 + (((2 * hi) ^ sw) << 4), t_rd1 = (wm * 64 + l31) * 64 + (((2 * hi + 1) ^ sw) << 4);
        const int w_rd0 = A_BYTES + (wn * 128 + l31) * 64 + (((2 * hi) ^ sw) << 4), w_rd1 = A_BYTES + (wn * 128 + l31) * 64 + (((2 * hi + 1) ^ sw) << 4);
        const unsigned lds0 = (unsigned)(uintptr_t)lds + (unsigned)wu * 1024u;
        const unsigned char* aptr[2]; const unsigned char* wptr[2];
        const int total = NSEG * KT;
        int lseg = 0, lkt = 0, lg = 0;
        auto issue = [&]() {
            const unsigned base = (unsigned)__builtin_amdgcn_readfirstlane((int)(lds0 + (unsigned)(lg & 3) * STAGE));
#pragma unroll
            for (int i = 0; i < 2; ++i) glds16(aptr[i] + lkt * 64, base + i * 8192);
#pragma unroll
            for (int i = 0; i < 2; ++i) glds16(wptr[i] + lkt * 64, base + A_BYTES + i * 8192);
            ++lg; if (++lkt == KT) { lkt = 0; ++lseg; if (lseg < NSEG) f.ptrs(lseg, aptr, wptr); }
        };
        const int grp = wu >> 2;
        auto bar = [&]() { asm volatile("s_waitcnt lgkmcnt(0)" ::: "memory"); __builtin_amdgcn_s_barrier(); asm volatile("" ::: "memory"); };
        f.ptrs(0, aptr, wptr);
        asm volatile("s_waitcnt vmcnt(0)" ::: "memory");
        issue(); if (total > 1) issue(); if (total > 2) issue();
        if (total > 2) asm volatile("s_waitcnt vmcnt(8)" ::: "memory"); else if (total > 1) asm volatile("s_waitcnt vmcnt(4)" ::: "memory"); else asm volatile("s_waitcnt vmcnt(0)" ::: "memory");
        bar();
        if (grp) bar();
        int cseg = 0, ckt = 0;
#pragma unroll 1
        for (int g = 0; g < total; ++g) {
            if (lg < total) issue();
            const LAS unsigned char* base = lds + (g & 3) * STAGE;
            i32x8 tf[2], wf[4];
#pragma unroll
            for (int jt = 0; jt < 2; ++jt) { const u32x4 lo = *(const LAS u32x4*)(base + t_rd0 + jt * 2048), h4 = *(const LAS u32x4*)(base + t_rd1 + jt * 2048);
                tf[jt] = (i32x8){(int)lo.x, (int)lo.y, (int)lo.z, (int)lo.w, (int)h4.x, (int)h4.y, (int)h4.z, (int)h4.w}; }
#pragma unroll
            for (int it = 0; it < 4; ++it) { const u32x4 lo = *(const LAS u32x4*)(base + w_rd0 + it * 2048), h4 = *(const LAS u32x4*)(base + w_rd1 + it * 2048);
                wf[it] = (i32x8){(int)lo.x, (int)lo.y, (int)lo.z, (int)lo.w, (int)h4.x, (int)h4.y, (int)h4.z, (int)h4.w}; }
            { const int rem = total - 2 - g;
              if (rem >= 2) asm volatile("s_waitcnt vmcnt(8)" ::: "memory"); else if (rem == 1) asm volatile("s_waitcnt vmcnt(4)" ::: "memory"); else asm volatile("s_waitcnt vmcnt(0)" ::: "memory"); }
            bar();
            __builtin_amdgcn_sched_barrier(0);
#pragma unroll
            for (int it = 0; it < 4; ++it)
#pragma unroll
                for (int jt = 0; jt < 2; ++jt) acc[jt][it] = __builtin_amdgcn_mfma_scale_f32_32x32x64_f8f6f4(wf[it], tf[jt], acc[jt][it], 0, 0, 0, F::wscale(it), 0, 127);
            __builtin_amdgcn_sched_barrier(0);
            bar();
            if (++ckt == KT) {
                if (!grp) bar();
                f.epi(cseg, acc);
#pragma unroll
                for (int jt = 0; jt < 2; ++jt)
#pragma unroll
                    for (int it = 0; it < 4; ++it)
#pragma unroll
                        for (int r = 0; r < 16; ++r) acc[jt][it][r] = 0.f;
                ckt = 0; ++cseg;
                if (grp) bar();
            }
        }
        if (!grp) bar();
    }
};

struct Gemm4 {
    static constexpr int A_BYTES = 16384, STAGE = 32768, LDS_BYTES = 2 * STAGE;
    static __device__ __forceinline__ int fk2(int r) { return (r & 3) | (((r >> 3) & 1) << 2); }
    static __device__ __forceinline__ int a_row(int i, int tid) { return (tid >> 2) + 128 * i; }
    static __device__ __forceinline__ int b_k(int i, int tid) { return (tid >> 5) + 16 * i; }
    static __device__ __forceinline__ void run(f32x4 (&acc)[4][8], const bf16_t* const (&aptr)[2], int a_kstride, const bf16_t* const (&bptr)[2], size_t b_kstride, int KT, LAS unsigned char* lds) {
        const int tid = opaque_tid(), lane = tid & 63, wid = tid >> 6, wm = wid >> 1, wn = wid & 1, fr = lane & 15, fq = lane >> 4;
#pragma unroll
        for (int mi = 0; mi < 4; ++mi)
#pragma unroll
            for (int ni = 0; ni < 8; ++ni) acc[mi][ni] = (f32x4){0.f, 0.f, 0.f, 0.f};
        int a_wr[2], b_wr[2];
#pragma unroll
        for (int i = 0; i < 2; ++i) { const int row = a_row(i, tid); a_wr[i] = row * 64 + (((tid & 3) ^ ((row >> 1) & 3)) << 4);
            const int k = b_k(i, tid), n = (tid & 31) * 8; b_wr[i] = A_BYTES + k * 512 + (((n >> 4) ^ fk2(k)) << 5) + ((n & 15) << 1); }
        int a_rd[4];
#pragma unroll
        for (int mi = 0; mi < 4; ++mi) { const int row = wm * 64 + mi * 16 + fr; a_rd[mi] = row * 64 + ((fq ^ ((row >> 1) & 3)) << 4); }
        int b_rd[2], b_f[2];
#pragma unroll
        for (int t = 0; t < 2; ++t) { const int k = 8 * fq + 4 * t + (fr >> 2); b_f[t] = fk2(k); b_rd[t] = A_BYTES + k * 512 + ((fr & 3) << 3); }
        u32x4 ra0[2], rb0[2], ra1[2], rb1[2];
        auto gload = [&](int kt, u32x4 (&ra)[2], u32x4 (&rb)[2]) {
#pragma unroll
            for (int i = 0; i < 2; ++i) { ra[i] = *(const u32x4*)(aptr[i] + (size_t)kt * a_kstride); rb[i] = *(const u32x4*)(bptr[i] + (size_t)kt * b_kstride); }
        };
        auto lstore = [&](int buf, const u32x4 (&ra)[2], const u32x4 (&rb)[2]) {
            LAS unsigned char* base = lds + buf * STAGE;
#pragma unroll
            for (int i = 0; i < 2; ++i) { *(LAS u32x4*)(base + a_wr[i]) = ra[i]; *(LAS u32x4*)(base + b_wr[i]) = rb[i]; }
        };
        auto compute = [&](int buf) {
            const LAS unsigned char* base = lds + buf * STAGE;
            bf16x8 af[4];
#pragma unroll
            for (int mi = 0; mi < 4; ++mi) af[mi] = *(const LAS bf16x8*)(base + a_rd[mi]);
#pragma unroll
            for (int ni = 0; ni < 8; ++ni) {
                const int u0 = wn * 8 + ni;
                const s16x4 lo = lds_tr(base + b_rd[0] + ((u0 ^ b_f[0]) << 5));
                const s16x4 hi = lds_tr(base + b_rd[1] + ((u0 ^ b_f[1]) << 5));
                const bf16x8 bfr = (bf16x8){lo[0], lo[1], lo[2], lo[3], hi[0], hi[1], hi[2], hi[3]};
#pragma unroll
                for (int mi = 0; mi < 4; ++mi) acc[mi][ni] = __builtin_amdgcn_mfma_f32_16x16x32_bf16(bfr, af[mi], acc[mi][ni], 0, 0, 0);
            }
        };
        gload(0, ra0, rb0); gload(1, ra1, rb1);
        lstore(0, ra0, rb0); __syncthreads();
        for (int kt = 0; kt < KT; kt += 2) {
            gload(kt + 2 < KT ? kt + 2 : KT - 1, ra0, rb0);
            __builtin_amdgcn_sched_barrier(0);
            compute(0);
            lstore(1, ra1, rb1);
            __syncthreads();
            gload(kt + 3 < KT ? kt + 3 : KT - 1, ra1, rb1);
            __builtin_amdgcn_sched_barrier(0);
            compute(1);
            lstore(0, ra0, rb0);
            __syncthreads();
        }
    }

    template <class F> static __device__ __forceinline__ void run_stream(F& f, int NSEG, int KT, int a_kstride, size_t b_kstride, LAS unsigned char* lds) {
        const int tid = opaque_tid(), lane = tid & 63, wid = tid >> 6, wm = wid >> 1, wn = wid & 1, fr = lane & 15, fq = lane >> 4;
        f32x4 acc[4][8];
#pragma unroll
        for (int mi = 0; mi < 4; ++mi)
#pragma unroll
            for (int ni = 0; ni < 8; ++ni) acc[mi][ni] = (f32x4){0.f, 0.f, 0.f, 0.f};
        int a_wr[2], b_wr[2];
#pragma unroll
        for (int i = 0; i < 2; ++i) { const int row = a_row(i, tid); a_wr[i] = row * 64 + (((tid & 3) ^ ((row >> 1) & 3)) << 4);
            const int k = b_k(i, tid), n = (tid & 31) * 8; b_wr[i] = A_BYTES + k * 512 + (((n >> 4) ^ fk2(k)) << 5) + ((n & 15) << 1); }
        int a_rd[4];
#pragma unroll
        for (int mi = 0; mi < 4; ++mi) { const int row = wm * 64 + mi * 16 + fr; a_rd[mi] = row * 64 + ((fq ^ ((row >> 1) & 3)) << 4); }
        int b_rd[2], b_f[2];
#pragma unroll
        for (int t = 0; t < 2; ++t) { const int k = 8 * fq + 4 * t + (fr >> 2); b_f[t] = fk2(k); b_rd[t] = A_BYTES + k * 512 + ((fr & 3) << 3); }
        const bf16_t* aptr[2]; const bf16_t* bptr[2];
        u32x4 ra0[2], rb0[2], ra1[2], rb1[2];
        int lseg = 0, lkt = 0;
        auto gload = [&](u32x4 (&ra)[2], u32x4 (&rb)[2]) {
#pragma unroll
            for (int i = 0; i < 2; ++i) { ra[i] = *(const u32x4*)(aptr[i] + (size_t)lkt * a_kstride); rb[i] = *(const u32x4*)(bptr[i] + (size_t)lkt * b_kstride); }
            if (lkt + 1 < KT) ++lkt; else if (lseg + 1 < NSEG) { lkt = 0; ++lseg; f.ptrs(lseg, aptr, bptr); }
        };
        auto lstore = [&](int buf, const u32x4 (&ra)[2], const u32x4 (&rb)[2]) {
            LAS unsigned char* base = lds + buf * STAGE;
#pragma unroll
            for (int i = 0; i < 2; ++i) { *(LAS u32x4*)(base + a_wr[i]) = ra[i]; *(LAS u32x4*)(base + b_wr[i]) = rb[i]; }
        };
        auto compute = [&](int buf) {
            const LAS unsigned char* base = lds + buf * STAGE;
            bf16x8 af[4];
#pragma unroll
            for (int mi = 0; mi < 4; ++mi) af[mi] = *(const LAS bf16x8*)(base + a_rd[mi]);
#pragma unroll
            for (int ni = 0; ni < 8; ++ni) {
                const int u0 = wn * 8 + ni;
                const s16x4 lo = lds_tr(base + b_rd[0] + ((u0 ^ b_f[0]) << 5));
                const s16x4 hi = lds_tr(base + b_rd[1] + ((u0 ^ b_f[1]) << 5));
                const bf16x8 bfr = (bf16x8){lo[0], lo[1], lo[2], lo[3], hi[0], hi[1], hi[2], hi[3]};
#pragma unroll
                for (int mi = 0; mi < 4; ++mi) acc[mi][ni] = __builtin_amdgcn_mfma_f32_16x16x32_bf16(bfr, af[mi], acc[mi][ni], 0, 0, 0);
            }
        };
        f.ptrs(0, aptr, bptr);
        gload(ra0, rb0); gload(ra1, rb1);
        lstore(0, ra0, rb0); __syncthreads();
        int cseg = 0, ckt = 0;
        const int total = NSEG * KT;
#pragma unroll 1
        for (int g = 0; g < total; g += 2) {
            gload(ra0, rb0);
            __builtin_amdgcn_sched_barrier(0);
            compute(0);
            lstore(1, ra1, rb1);
            __syncthreads();
            gload(ra1, rb1);
            __builtin_amdgcn_sched_barrier(0);
            compute(1);
            lstore(0, ra0, rb0);
            __syncthreads();
            ckt += 2;
            if (ckt == KT) {
                f.epi(cseg, acc);
#pragma unroll
                for (int mi = 0; mi < 4; ++mi)
#pragma unroll
                    for (int ni = 0; ni < 8; ++ni) acc[mi][ni] = (f32x4){0.f, 0.f, 0.f, 0.f};
                ckt = 0; ++cseg;
            }
        }
    }
};

template <bool BF32> struct Gemm5 {
    static constexpr int A_BYTES = 16384, STAGE = 32768, LDS_BYTES = 2 * STAGE;
    static __device__ __forceinline__ int fk2(int r) { return (r & 3) | (((r >> 3) & 1) << 2); }
    static __device__ __forceinline__ int a_row(int i, int tid) { return (tid >> 2) + 128 * i; }
    static __device__ __forceinline__ int b_k(int i, int tid) { return (tid >> 5) + 16 * i; }
    typedef typename std::conditional<BF32, float, bf16_t>::type b_t;
    static __device__ __forceinline__ void run(f32x4 (&acc)[4][8], const bf16_t* const (&aptr)[2], int a_kstride, const b_t* const (&bptr)[2], size_t b_kstride, int KT, LAS unsigned char* lds) {
        const int tid = opaque_tid(), lane = tid & 63, wid = tid >> 6, wm = wid >> 1, wn = wid & 1, fr = lane & 15, fq = lane >> 4;
#pragma unroll
        for (int mi = 0; mi < 4; ++mi)
#pragma unroll
            for (int ni = 0; ni < 8; ++ni) acc[mi][ni] = (f32x4){0.f, 0.f, 0.f, 0.f};
        int a_wr[2], b_wr[2];
#pragma unroll
        for (int i = 0; i < 2; ++i) { const int row = a_row(i, tid); a_wr[i] = row * 64 + (((tid & 3) ^ ((row >> 1) & 3)) << 4);
            const int k = b_k(i, tid), n = (tid & 31) * 8; b_wr[i] = A_BYTES + k * 512 + (((n >> 4) ^ fk2(k)) << 5) + ((n & 15) << 1); }
        int a_rd[4];
#pragma unroll
        for (int mi = 0; mi < 4; ++mi) { const int row = wm * 64 + mi * 16 + fr; a_rd[mi] = row * 64 + ((fq ^ ((row >> 1) & 3)) << 4); }
        int b_rd[2], b_f[2];
#pragma unroll
        for (int t = 0; t < 2; ++t) { const int k = 8 * fq + 4 * t + (fr >> 2); b_f[t] = fk2(k); b_rd[t] = A_BYTES + k * 512 + ((fr & 3) << 3); }
        u32x4 ra[2]; u32x4 rb[2]; f32x4 rbf[2][2];
        auto gload = [&](int kt) {
#pragma unroll
            for (int i = 0; i < 2; ++i) { ra[i] = *(const u32x4*)(aptr[i] + (size_t)kt * a_kstride);
                if (BF32) { const float* p = (const float*)bptr[i] + (size_t)kt * b_kstride; rbf[i][0] = *(const f32x4*)p; rbf[i][1] = *(const f32x4*)(p + 4); }
                else rb[i] = *(const u32x4*)((const bf16_t*)bptr[i] + (size_t)kt * b_kstride); }
        };
        auto lstore = [&](int buf) {
            LAS unsigned char* base = lds + buf * STAGE;
#pragma unroll
            for (int i = 0; i < 2; ++i) { *(LAS u32x4*)(base + a_wr[i]) = ra[i];
                if (BF32) { u32x4 w; w.x = cvtpk(rbf[i][0].x, rbf[i][0].y); w.y = cvtpk(rbf[i][0].z, rbf[i][0].w); w.z = cvtpk(rbf[i][1].x, rbf[i][1].y); w.w = cvtpk(rbf[i][1].z, rbf[i][1].w); *(LAS u32x4*)(base + b_wr[i]) = w; }
                else *(LAS u32x4*)(base + b_wr[i]) = rb[i]; }
        };
        auto compute = [&](int buf) {
            const LAS unsigned char* base = lds + buf * STAGE;
            bf16x8 af[4];
#pragma unroll
            for (int mi = 0; mi < 4; ++mi) af[mi] = *(const LAS bf16x8*)(base + a_rd[mi]);
#pragma unroll
            for (int ni = 0; ni < 8; ++ni) {
                const int u0 = wn * 8 + ni;
                const s16x4 lo = lds_tr(base + b_rd[0] + ((u0 ^ b_f[0]) << 5));
                const s16x4 hi = lds_tr(base + b_rd[1] + ((u0 ^ b_f[1]) << 5));
                const bf16x8 bfr = (bf16x8){lo[0], lo[1], lo[2], lo[3], hi[0], hi[1], hi[2], hi[3]};
#pragma unroll
                for (int mi = 0; mi < 4; ++mi) acc[mi][ni] = __builtin_amdgcn_mfma_f32_16x16x32_bf16(bfr, af[mi], acc[mi][ni], 0, 0, 0);
            }
        };
        gload(0); lstore(0); __syncthreads();
#pragma unroll 1
        for (int kt = 0; kt < KT; ++kt) {
            gload(kt + 1 < KT ? kt + 1 : KT - 1);
            __builtin_amdgcn_sched_barrier(0);
            compute(kt & 1);
            lstore((kt + 1) & 1);
            __syncthreads();
        }
    }

    template <class F> static __device__ __forceinline__ void run_stream(F& f, int NSEG, int KT, int a_kstride, size_t b_kstride, LAS unsigned char* lds) {
        const int tid = opaque_tid(), lane = tid & 63, wid = tid >> 6, wm = wid >> 1, wn = wid & 1, fr = lane & 15, fq = lane >> 4;
        f32x4 acc[4][8];
#pragma unroll
        for (int mi = 0; mi < 4; ++mi)
#pragma unroll
            for (int ni = 0; ni < 8; ++ni) acc[mi][ni] = (f32x4){0.f, 0.f, 0.f, 0.f};
        int a_wr[2], b_wr[2];
#pragma unroll
        for (int i = 0; i < 2; ++i) { const int row = a_row(i, tid); a_wr[i] = row * 64 + (((tid & 3) ^ ((row >> 1) & 3)) << 4);
            const int k = b_k(i, tid), n = (tid & 31) * 8; b_wr[i] = A_BYTES + k * 512 + (((n >> 4) ^ fk2(k)) << 5) + ((n & 15) << 1); }
        int a_rd[4];
#pragma unroll
        for (int mi = 0; mi < 4; ++mi) { const int row = wm * 64 + mi * 16 + fr; a_rd[mi] = row * 64 + ((fq ^ ((row >> 1) & 3)) << 4); }
        int b_rd[2], b_f[2];
#pragma unroll
        for (int t = 0; t < 2; ++t) { const int k = 8 * fq + 4 * t + (fr >> 2); b_f[t] = fk2(k); b_rd[t] = A_BYTES + k * 512 + ((fr & 3) << 3); }
        const bf16_t* aptr[2]; const b_t* bptr[2];
        u32x4 ra[2]; u32x4 rb[2]; f32x4 rbf[2][2];
        auto gload = [&](int kt) {
#pragma unroll
            for (int i = 0; i < 2; ++i) { ra[i] = *(const u32x4*)(aptr[i] + (size_t)kt * a_kstride);
                if (BF32) { const float* p = (const float*)bptr[i] + (size_t)kt * b_kstride; rbf[i][0] = *(const f32x4*)p; rbf[i][1] = *(const f32x4*)(p + 4); }
                else rb[i] = *(const u32x4*)((const bf16_t*)bptr[i] + (size_t)kt * b_kstride); }
        };
        auto lstore = [&](int buf) {
            LAS unsigned char* base = lds + buf * STAGE;
#pragma unroll
            for (int i = 0; i < 2; ++i) { *(LAS u32x4*)(base + a_wr[i]) = ra[i];
                if (BF32) { u32x4 w; w.x = cvtpk(rbf[i][0].x, rbf[i][0].y); w.y = cvtpk(rbf[i][0].z, rbf[i][0].w); w.z = cvtpk(rbf[i][1].x, rbf[i][1].y); w.w = cvtpk(rbf[i][1].z, rbf[i][1].w); *(LAS u32x4*)(base + b_wr[i]) = w; }
                else *(LAS u32x4*)(base + b_wr[i]) = rb[i]; }
        };
        auto compute = [&](int buf) {
            const LAS unsigned char* base = lds + buf * STAGE;
            bf16x8 af[4];
#pragma unroll
            for (int mi = 0; mi < 4; ++mi) af[mi] = *(const LAS bf16x8*)(base + a_rd[mi]);
#pragma unroll
            for (int ni = 0; ni < 8; ++ni) {
                const int u0 = wn * 8 + ni;
                const s16x4 lo = lds_tr(base + b_rd[0] + ((u0 ^ b_f[0]) << 5));
                const s16x4 hi = lds_tr(base + b_rd[1] + ((u0 ^ b_f[1]) << 5));
                const bf16x8 bfr = (bf16x8){lo[0], lo[1], lo[2], lo[3], hi[0], hi[1], hi[2], hi[3]};
#pragma unroll
                for (int mi = 0; mi < 4; ++mi) acc[mi][ni] = __builtin_amdgcn_mfma_f32_16x16x32_bf16(bfr, af[mi], acc[mi][ni], 0, 0, 0);
            }
        };
        f.ptrs(0, aptr, bptr);
        gload(0); lstore(0); __syncthreads();
        int seg = 0, kt = 0;
        const int total = NSEG * KT;
#pragma unroll 1
        for (int g = 0; g < total; ++g) {
            int nkt = kt + 1, nsg = seg; if (nkt == KT) { nkt = 0; nsg = seg + 1; }
            if (nkt == 0 && nsg < NSEG) f.ptrs(nsg, aptr, bptr);
            gload(nsg < NSEG ? nkt : KT - 1);
            __builtin_amdgcn_sched_barrier(0);
            compute(g & 1);
            lstore((g + 1) & 1);
            __syncthreads();
            if (nkt == 0) {
                f.epi(seg, acc);
#pragma unroll
                for (int mi = 0; mi < 4; ++mi)
#pragma unroll
                    for (int ni = 0; ni < 8; ++ni) acc[mi][ni] = (f32x4){0.f, 0.f, 0.f, 0.f};
            }
            seg = nsg; kt = nkt;
        }
    }
};

__device__ __forceinline__ int p2_col(int m0);
__device__ __forceinline__ unsigned pk4_fp8(float a, float b, float c, float d) { int pk = __builtin_amdgcn_cvt_pk_fp8_f32(a, b, 0, false); pk = __builtin_amdgcn_cvt_pk_fp8_f32(c, d, pk, true); return (unsigned)pk; }
__device__ __forceinline__ int w8_col(int i) { return 16 * ((i >> 2) & 1) + 4 * (i >> 3) + (i & 3); }
__device__ __forceinline__ void phase_mod(const Params& P, LAS unsigned char* lds) {
    const int tid = threadIdx.x;
    float* mod = (float*)(P.ws + WS_MOD);
    LAS float* sc = (LAS float*)lds;
    LAS float* red = (LAS float*)(lds + 16384);
    for (int i = tid; i < 4096; i += NTHREADS) sc[i] = siluf_(P.c[i]);
    __syncthreads();
    const int kq = tid >> 5, cl = tid & 31;
    for (int u = blockIdx.x; u < 192; u += gridDim.x) {
        const int j = u * 32 + cl;
        float a0 = 0.f, a1 = 0.f, a2 = 0.f, a3 = 0.f;
#pragma unroll 8
        for (int k = kq; k < 1024; k += 16) { const float w = P.ada_w[(size_t)k * 6144 + j];
            a0 += sc[k] * w; a1 += sc[1024 + k] * w; a2 += sc[2048 + k] * w; a3 += sc[3072 + k] * w; }
        red[(kq * 4 + 0) * 32 + cl] = a0; red[(kq * 4 + 1) * 32 + cl] = a1; red[(kq * 4 + 2) * 32 + cl] = a2; red[(kq * 4 + 3) * 32 + cl] = a3;
        __syncthreads();
        if (tid < 128) { const int b = tid >> 5; float s = 0.f;
#pragma unroll
            for (int q = 0; q < 16; ++q) s += red[(q * 4 + b) * 32 + cl];
            mod[b * 6144 + j] = s + P.ada_b[j]; }
        __syncthreads();
    }
    for (int u = blockIdx.x; u < 16; u += gridDim.x) {
        const int sel = u >> 3, j = (u & 7) * 32 + cl;
        const float* w1 = P.cmp_w1 + (size_t)sel * 2048 * 256; const float* pos = P.cmp_pos + sel * 2048;
        float a0 = 0.f;
#pragma unroll 8
        for (int k = kq; k < 2048; k += 16) a0 += pos[k] * w1[(size_t)k * 256 + j];
        red[kq * 32 + cl] = a0;
        __syncthreads();
        if (tid < 32) { float s = 0.f;
#pragma unroll
            for (int q = 0; q < 16; ++q) s += red[q * 32 + cl];
            ((float*)(P.ws + WS_CB))[sel * 256 + j] = s + P.cmp_b1[sel * 256 + j]; }
        __syncthreads();
    }
    {
        unsigned char* wb = (unsigned char*)(P.ws + WS_WIN);
        const int lane = tid & 63, gw = blockIdx.x * (NTHREADS / 64) + (tid >> 6), NGW = gridDim.x * (NTHREADS / 64);
        for (int u = gw; u < 56 * 16; u += NGW) {
            const int rg = u % 56, kb = u / 56, q = rg * 64 + lane, c8 = (q & ~31) + w8_col(q & 31);
            const int sc_ = c8 < 1280 ? c8 : (c8 < 3328 ? c8 + 24 : c8 - 2048);
            const float* s = P.w_in + (size_t)(kb * 64) * IN_COLS + (c8 < 3352 ? sc_ : 0);
            float v[64];
#pragma unroll
            for (int j = 0; j < 64; ++j) v[j] = s[(size_t)j * IN_COLS];
            const float c_ = c8 < 3352 ? 64.0f : 0.0f;
#pragma unroll
            for (int j = 0; j < 4; ++j) { u32x4 w;
                w.x = pk4_fp8(v[16 * j] * c_, v[16 * j + 1] * c_, v[16 * j + 2] * c_, v[16 * j + 3] * c_); w.y = pk4_fp8(v[16 * j + 4] * c_, v[16 * j + 5] * c_, v[16 * j + 6] * c_, v[16 * j + 7] * c_);
                w.z = pk4_fp8(v[16 * j + 8] * c_, v[16 * j + 9] * c_, v[16 * j + 10] * c_, v[16 * j + 11] * c_); w.w = pk4_fp8(v[16 * j + 12] * c_, v[16 * j + 13] * c_, v[16 * j + 14] * c_, v[16 * j + 15] * c_);
                *(u32x4*)(wb + (size_t)q * 1024 + kb * 64 + j * 16) = w; }
        }
    }
    if (blockIdx.x == gridDim.x - 2) {
        for (int i = tid; i < 2 * 8 * 64; i += NTHREADS) { const int t2 = i >> 9, bg = (i >> 6) & 7, d = i & 63;
            ((bf16_t*)(P.ws + (t2 ? WS_VC : WS_KC)))[((size_t)bg * 512 + 511) * 64 + d] = 0; }
    }
    if (blockIdx.x == gridDim.x - 1) {
        float* lb = (float*)(P.ws + WS_LB);
        for (int i = tid; i < 512; i += NTHREADS) { const float p0 = P.hgrn_lb[i], p1 = P.hgrn_lb[512 + i]; lb[i] = 1.0f / (1.0f + __expf(p1 - p0)); }
    }
}

__device__ __forceinline__ void norm_mod_rows(const float* x, const float* w, const float* mod_sh, const float* mod_sc, unsigned char* h, int hs) {
    const int lane = threadIdx.x & 63, gw = blockIdx.x * (NTHREADS / 64) + (threadIdx.x >> 6), NGW = gridDim.x * (NTHREADS / 64);
    for (int m = gw; m < T; m += NGW) {
        const int b = m / SEQ;
        const f32x4* xr = (const f32x4*)(x + (size_t)m * D) + lane;
        f32x4 v[4]; float s = 0.f;
#pragma unroll
        for (int j = 0; j < 4; ++j) { v[j] = xr[64 * j]; s += (v[j].x * v[j].x + v[j].y * v[j].y) + (v[j].z * v[j].z + v[j].w * v[j].w); }
        const float rstd = rsqrtf(wave_sum(s) * (1.f / D) + RMS_EPS);
        unsigned* o = (unsigned*)(h + (size_t)m * hs) + lane;
#pragma unroll
        for (int j = 0; j < 4; ++j) {
            const int col = (lane + 64 * j) * 4;
            const f32x4 wv = *(const f32x4*)(w + col), scv = *(const f32x4*)(mod_sc + b * 6144 + col), shv = *(const f32x4*)(mod_sh + b * 6144 + col);
            f32x4 r;
            r.x = v[j].x * rstd * wv.x * (1.f + scv.x) + shv.x; r.y = v[j].y * rstd * wv.y * (1.f + scv.y) + shv.y;
            r.z = v[j].z * rstd * wv.z * (1.f + scv.z) + shv.z; r.w = v[j].w * rstd * wv.w * (1.f + scv.w) + shv.w;
            o[64 * j] = pk4_fp8(r.x, r.y, r.z, r.w);
        }
    }
}

__device__ __forceinline__ void phase_inproj(const Params& P, LAS unsigned char* lds) {
    constexpr int NRT = T / 256, NCT = 14;
    struct F { const Params& P;
        static __device__ __forceinline__ int wscale(int) { return 121; }
        __device__ __forceinline__ void unit(int seg, int& rt, int& ct) const {
            const int nx = (gridDim.x % 8 == 0) ? 8 : 1, xl = blockIdx.x % nx, li = blockIdx.x / nx, nloc = gridDim.x / nx;
            const int v = li + seg * nloc, rg = v / (NCT * 4), rem = v % (NCT * 4); ct = rem >> 2; rt = xl + nx * (rg * 4 + (rem & 3)); }
        __device__ __forceinline__ void ptrs(int seg, const unsigned char* (&aptr)[2], const unsigned char* (&wptr)[2]) const {
            const int tid = opaque_tid(), lane = tid & 63, wid = tid >> 6; int rt, ct; unit(seg, rt, ct);
            const unsigned char* h1 = (const unsigned char*)(P.ws + WS_H); const unsigned char* wb = (const unsigned char*)(P.ws + WS_WIN);
#pragma unroll
            for (int i = 0; i < 2; ++i) { const int row = Gemm8::t_row(i, wid, lane); aptr[i] = h1 + (size_t)(rt * 256 + row) * H1S + Gemm8::t_chunk(row, lane) * 16;
                wptr[i] = wb + (size_t)(ct * 256 + row) * 1024 + Gemm8::t_chunk(row, lane) * 16; } }
        __device__ __forceinline__ void epi(int seg, f32x16 (&acc)[2][4]) const {
            const int tid = opaque_tid(), lane = tid & 63, wid = tid >> 6, wm = wid >> 1, wn = wid & 1, l31 = lane & 31, hi = lane >> 5;
            int rt, ct; unit(seg, rt, ct);
            bf16_t* qo = (bf16_t*)(P.ws + WS_Q); bf16_t* kvo = (bf16_t*)(P.ws + WS_KV); float* gates = (float*)(P.ws + WS_GATES);
            bf16_t* hq = (bf16_t*)(P.ws + WS_HQ); bf16_t* logf = (bf16_t*)(P.ws + WS_LOGF); bf16_t* hv = (bf16_t*)(P.ws + WS_HV); bf16_t* hg = (bf16_t*)(P.ws + WS_HG);
            const float* lb = (const float*)(P.ws + WS_LB);
            const int row0 = rt * 256 + wm * 64 + l31;
            if (ct < 5) {
                const bool is_q = ct < 2; const int sg = (ct - 2) * 2 + wn;
                const bool do_norm = is_q || sg == 2 || sg == 4;
                const float* nw = is_q ? P.q_norm_w : (P.k_norm_w + (sg == 2 ? 64 : 128));
                const float osc = is_q ? 0.125f : 1.0f;
#pragma unroll
                for (int hh = 0; hh < 2; ++hh) {
#pragma unroll
                    for (int jt = 0; jt < 2; ++jt) {
                        float rstd = 1.f;
                        if (do_norm) { float s = 0.f;
#pragma unroll
                            for (int t2 = 0; t2 < 2; ++t2)
#pragma unroll
                                for (int r = 0; r < 16; ++r) { const float a = acc[jt][2 * hh + t2][r]; s += a * a; }
                            s += __shfl_xor(s, 32);
                            rstd = rsqrtf(s * (1.f / 64.f) + RMS_EPS) * osc; }
                        const size_t m = (size_t)(row0 + jt * 32);
                        bf16_t* dst = is_q ? (qo + m * 512 + ct * 256 + wn * 128 + hh * 64 + 16 * hi) : (kvo + m * 768 + (ct - 2) * 256 + wn * 128 + hh * 64 + 16 * hi);
#pragma unroll
                        for (int t2 = 0; t2 < 2; ++t2) { u32x4 w0, w1;
#pragma unroll
                            for (int q4 = 0; q4 < 4; ++q4) { const f32x4 wv = do_norm ? *(const f32x4*)(nw + t2 * 32 + 16 * hi + 4 * q4) : (f32x4){1.f, 1.f, 1.f, 1.f};
                                const unsigned lo = cvtpk(acc[jt][2 * hh + t2][4 * q4] * rstd * wv.x, acc[jt][2 * hh + t2][4 * q4 + 1] * rstd * wv.y), hi2 = cvtpk(acc[jt][2 * hh + t2][4 * q4 + 2] * rstd * wv.z, acc[jt][2 * hh + t2][4 * q4 + 3] * rstd * wv.w);
                                if (q4 < 2) { w0[2 * q4] = lo; w0[2 * q4 + 1] = hi2; } else { w1[2 * (q4 - 2)] = lo; w1[2 * (q4 - 2) + 1] = hi2; } }
                            *(u32x4*)(dst + t2 * 32) = w0; *(u32x4*)(dst + t2 * 32 + 8) = w1; }
                    }
                }
            } else if (ct == 13) {
                if (wn == 0) {
#pragma unroll
                    for (int jt = 0; jt < 2; ++jt) { const size_t m = (size_t)(row0 + jt * 32);
#pragma unroll
                        for (int q4 = 0; q4 < 4; ++q4) { const int c = 16 * hi + 4 * q4; if (c < 24) {
                                *(f32x4*)(gates + m * 24 + c) = (f32x4){sigmoidf_(acc[jt][0][4 * q4]), sigmoidf_(acc[jt][0][4 * q4 + 1]), sigmoidf_(acc[jt][0][4 * q4 + 2]), sigmoidf_(acc[jt][0][4 * q4 + 3])}; } } }
                }
            } else {
                const int hs = (ct - 5) >> 1, cc = ((ct - 5) & 1) * 256 + wn * 128 + 16 * hi;
#pragma unroll
                for (int jt = 0; jt < 2; ++jt) { const size_t m = (size_t)(row0 + jt * 32);
#pragma unroll
                    for (int it = 0; it < 4; ++it) { const int c = cc + it * 32;
                        if (hs == 1) { unsigned w8[8];
#pragma unroll
                            for (int q4 = 0; q4 < 4; ++q4) { const f32x4 l = *(const f32x4*)(lb + c + 4 * q4); f32x4 o;
                                o.x = __logf(l.x + (1.f - l.x) * sigmoidf_(acc[jt][it][4 * q4])); o.y = __logf(l.y + (1.f - l.y) * sigmoidf_(acc[jt][it][4 * q4 + 1]));
                                o.z = __logf(l.z + (1.f - l.z) * sigmoidf_(acc[jt][it][4 * q4 + 2])); o.w = __logf(l.w + (1.f - l.w) * sigmoidf_(acc[jt][it][4 * q4 + 3]));
                                w8[2 * q4] = cvtpk(o.x, o.y); w8[2 * q4 + 1] = cvtpk(o.z, o.w); }
                            *(u32x4*)(logf + m * 512 + c) = (u32x4){w8[0], w8[1], w8[2], w8[3]}; *(u32x4*)(logf + m * 512 + c + 8) = (u32x4){w8[4], w8[5], w8[6], w8[7]};
                        } else { float v[16];
#pragma unroll
                            for (int r = 0; r < 16; ++r) { const float a = acc[jt][it][r]; v[r] = hs == 0 ? siluf_(a) * 0.08838834764831845f : (hs == 2 ? a : sigmoidf_(a)); }
                            bf16_t* dst = (hs == 0 ? hq : (hs == 2 ? hv : hg)) + m * 512 + c;
                            *(u32x4*)dst = (u32x4){cvtpk(v[0], v[1]), cvtpk(v[2], v[3]), cvtpk(v[4], v[5]), cvtpk(v[6], v[7])};
                            *(u32x4*)(dst + 8) = (u32x4){cvtpk(v[8], v[9]), cvtpk(v[10], v[11]), cvtpk(v[12], v[13]), cvtpk(v[14], v[15])}; }
                    } }
            }
        }
    } f{P};
    const int nx = (gridDim.x % 8 == 0) ? 8 : 1, li = blockIdx.x / nx, nloc = gridDim.x / nx;
    const int nu = ((NRT / nx) * NCT - li + nloc - 1) / nloc;
    if (nu > 0) Gemm8::run_stream(f, nu, D / 64, lds);
}

__device__ __forceinline__ float gelu_tanh(float x) {
    const float u = 0.7978845608028654f * (x + 0.044715f * x * x * x);
    const float th = 1.0f - 2.0f / (1.0f + __expf(2.0f * u));
    return 0.5f * x * (1.0f + th);
}
__device__ __forceinline__ void compress_unit(const Params& P, LAS unsigned char* lds, int u) {
    typedef GemmT<2, 4> G;
    const int tid = opaque_tid(), lane = tid & 63, wid = tid >> 6, wm = wid >> 2, wn = wid & 3, fr = lane & 15, fq = lane >> 4;
    const int sel = u >> 5, rt = u & 31;
    const bf16_t* kv = (const bf16_t*)(P.ws + WS_KV);
    bf16_t* cmph = (bf16_t*)(P.ws + WS_CMPH) + (size_t)sel * 4096 * 256;
    const float* cb = (const float*)(P.ws + WS_CB) + sel * 256;
    const bf16_t* arow[2];
#pragma unroll
    for (int p = 0; p < 2; ++p) { int r = rt * 128 + p * 64 + (tid >> 3); r = r < 4088 ? r : 4087;
        const int b = r / 1022, rem = r % 1022, i = rem >> 1, g = rem & 1;
        arow[p] = kv + (size_t)(b * SEQ + 16 * i) * 768 + sel * 128 + g * 64; }
    f32x4 acc[4][4];
    G::run(acc, arow, 768, P.cmp_w1 + (size_t)sel * 2048 * 256, 256, 32, lds);
#pragma unroll
    for (int mi = 0; mi < 4; ++mi) { const size_t row = (size_t)(rt * 128 + wm * 64 + mi * 16 + fr);
#pragma unroll
        for (int ni = 0; ni < 4; ++ni) { const int col = wn * 64 + ni * 16 + 4 * fq; const f32x4 a = acc[mi][ni]; const f32x4 bb = *(const f32x4*)(cb + col);
            u32x2 pk; pk.x = cvtpk(gelu_tanh(a.x + bb.x), gelu_tanh(a.y + bb.y)); pk.y = cvtpk(gelu_tanh(a.z + bb.z), gelu_tanh(a.w + bb.w));
            *(u32x2*)(cmph + row * 256 + col) = pk; } }
    __syncthreads();
    {
        const int row = tid >> 2, cq = tid & 3;
        const bf16_t* hr = cmph + (size_t)(rt * 128 + row) * 256;
        const float* w2 = P.cmp_w2 + (size_t)sel * 256 * 64 + cq * 16;
        float o[16];
#pragma unroll
        for (int j = 0; j < 16; ++j) o[j] = 0.f;
        for (int k8 = 0; k8 < 256; k8 += 8) {
            const u32x4 hv = *(const u32x4*)(hr + k8);
#pragma unroll
            for (int kk = 0; kk < 8; ++kk) {
                const unsigned wd = hv[kk >> 1]; const float a = (kk & 1) ? __uint_as_float(wd & 0xffff0000u) : __uint_as_float(wd << 16);
                const float* wr = w2 + (size_t)(k8 + kk) * 64;
#pragma unroll
                for (int j4 = 0; j4 < 4; ++j4) { const f32x4 w = *(const f32x4*)(wr + j4 * 4);
                    o[j4 * 4 + 0] += a * w.x; o[j4 * 4 + 1] += a * w.y; o[j4 * 4 + 2] += a * w.z; o[j4 * 4 + 3] += a * w.w; }
            }
        }
        if (sel == 0) { float s = 0.f;
#pragma unroll
            for (int j = 0; j < 16; ++j) s += o[j] * o[j];
            s += __shfl_xor(s, 1); s += __shfl_xor(s, 2);
            const float rstd = rsqrtf(s * (1.f / 64.f) + RMS_EPS);
#pragma unroll
            for (int j = 0; j < 16; ++j) o[j] *= rstd * P.k_norm_w[cq * 16 + j]; }
        const int r = rt * 128 + row;
        if (r < 4088) { const int b = r / 1022, rem = r % 1022, i = rem >> 1, g = rem & 1;
            bf16_t* dst = (bf16_t*)(P.ws + (sel ? WS_VC : WS_KC)) + ((size_t)(b * 2 + g) * 512 + i) * 64 + cq * 16;
            u32x4 w0, w1;
            w0.x = cvtpk(o[0], o[1]); w0.y = cvtpk(o[2], o[3]); w0.z = cvtpk(o[4], o[5]); w0.w = cvtpk(o[6], o[7]);
            w1.x = cvtpk(o[8], o[9]); w1.y = cvtpk(o[10], o[11]); w1.z = cvtpk(o[12], o[13]); w1.w = cvtpk(o[14], o[15]);
            *(u32x4*)dst = w0; *(u32x4*)(dst + 8) = w1; }
    }
    __syncthreads();
}

__device__ __forceinline__ int off_row128(int row, int ch) { return row * 128 + ((ch ^ ((row >> 1) & 7)) << 4); }
__device__ __forceinline__ int off_row256(int row, int ch) { return row * 256 + ((ch ^ (row & 15)) << 4); }
__device__ __forceinline__ int fk_(int r) { return (r & 3) | (((r >> 3) & 1) << 2); }
__device__ __forceinline__ int off_tr256(int row, int col) { return row * 256 + ((((col >> 4) ^ fk_(row)) << 5) + ((col & 15) << 1)); }
constexpr int HL_QT = 0, HL_KT = 16384, HL_KH = 32768, HL_V = 49152, HL_SB = 65536, HL_P = 98304  , HL_TOT = 106496  , HL_RED = 110592  , HL_END = 111104;

template <int MODE> __device__ __forceinline__ void hgrn_unit(const Params& P, LAS unsigned char* lds, int u) {
    const int tid = opaque_tid(), lane = tid & 63, wid = tid >> 6, fr = lane & 15, fq = lane >> 4;
    const int b = u >> 7, h = (u >> 5) & 3, sc = u & 31;
    const bf16_t* hq = (const bf16_t*)(P.ws + WS_HQ); const bf16_t* logf = (const bf16_t*)(P.ws + WS_LOGF);
    const bf16_t* hv = (const bf16_t*)(P.ws + WS_HV); const bf16_t* hg = (const bf16_t*)(P.ws + WS_HG);
    float* HLs = (float*)(P.ws + WS_HL); float* HDs = (float*)(P.ws + WS_HD);
    bf16_t* mix = (bf16_t*)(P.ws + WS_MIX);
    LAS float* tot = (LAS float*)(lds + HL_TOT); LAS float* red = (LAS float*)(lds + HL_RED);
    f32x4 st[8];
#pragma unroll
    for (int vt = 0; vt < 8; ++vt) st[vt] = (f32x4){0.f, 0.f, 0.f, 0.f};
    if (MODE == 1) {
        const int kk = 16 * wid + fr;
#pragma unroll 4
        for (int j = 0; j < sc; ++j) {
            const float* Lj = HLs + (size_t)(u - sc + j) * 16384 + kk * 128 + 4 * fq; const float dj = HDs[(size_t)(u - sc + j) * 128 + kk];
#pragma unroll
            for (int vt = 0; vt < 8; ++vt) { const f32x4 l = *(const f32x4*)(Lj + vt * 16); st[vt] = st[vt] * dj + l; }
        }
    }
    float dsum = 0.f;
    const int kp = tid & 63, te = tid >> 6;
    for (int c = 0; c < 4; ++c) {
        const size_t tok0 = (size_t)b * SEQ + sc * 256 + c * 64;
        float lf0[8], lf1[8], cs0[8], cs1[8];
        { float a0 = 0.f, a1 = 0.f;
#pragma unroll
          for (int i = 0; i < 8; ++i) { const unsigned vr = *(const unsigned*)(logf + (tok0 + te * 8 + i) * 512 + h * 128 + 2 * kp); const float vx = __uint_as_float(vr << 16), vy = __uint_as_float(vr & 0xffff0000u); lf0[i] = vx; lf1[i] = vy; a0 += vx; a1 += vy; cs0[i] = a0; cs1[i] = a1; }
          tot[te * 128 + 2 * kp] = a0; tot[te * 128 + 2 * kp + 1] = a1; }
#pragma unroll
        for (int i = 0; i < 2; ++i) { const int pc = tid + NTHREADS * i, row = pc >> 4, c8 = (pc & 15) * 8;
            const u32x4 v = *(const u32x4*)(hv + (tok0 + row) * 512 + h * 128 + c8);
            *(LAS u32x4*)(lds + HL_V + off_tr256(row, c8)) = v; }
        if (MODE == 1 ) {
#pragma unroll
            for (int vt = 0; vt < 8; ++vt) { u32x2 pk; pk.x = cvtpk(st[vt].x, st[vt].y); pk.y = cvtpk(st[vt].z, st[vt].w);
                *(LAS u32x2*)(lds + HL_SB + off_tr256(16 * wid + fr, 16 * vt + 4 * fq)) = pk; }
        }
        __syncthreads();
        float pre0 = 0.f, pre1 = 0.f, last0 = 0.f, last1 = 0.f;
#pragma unroll
        for (int e = 0; e < 8; ++e) { const float t0 = tot[e * 128 + 2 * kp], t1 = tot[e * 128 + 2 * kp + 1]; if (e < te) { pre0 += t0; pre1 += t1; } last0 += t0; last1 += t1; }
#pragma unroll
        for (int i = 0; i < 8; ++i) {
            const int t = te * 8 + i;
            const float c0 = cs0[i] + pre0, c1 = cs1[i] + pre1;
            const float k0 = 1.f - __expf(lf0[i]), k1 = 1.f - __expf(lf1[i]);
            const unsigned khat = cvtpk(k0 * __expf(last0 - c0), k1 * __expf(last1 - c1));
            *(LAS unsigned*)(lds + HL_KH + off_tr256(t, 2 * kp)) = khat;
            if (MODE == 1) {
                const unsigned qraw = *(const unsigned*)(hq + (tok0 + t) * 512 + h * 128 + 2 * kp);
                const float q0 = __uint_as_float(qraw << 16), q1 = __uint_as_float(qraw & 0xffff0000u);
                const unsigned qt = cvtpk(q0 * __expf(c0), q1 * __expf(c1));
                const unsigned kt = cvtpk(k0 * __expf(fminf(-c0, 80.f)), k1 * __expf(fminf(-c1, 80.f)));
                const int o = off_row256(t, kp >> 2) + ((kp & 3) << 2);
                *(LAS unsigned*)(lds + HL_QT + o) = qt; *(LAS unsigned*)(lds + HL_KT + o) = kt;
            }
        }
        const float dec = __expf(tot[0 * 128 + 16 * wid + fr] + tot[1 * 128 + 16 * wid + fr] + tot[2 * 128 + 16 * wid + fr] + tot[3 * 128 + 16 * wid + fr]
                                 + tot[4 * 128 + 16 * wid + fr] + tot[5 * 128 + 16 * wid + fr] + tot[6 * 128 + 16 * wid + fr] + tot[7 * 128 + 16 * wid + fr]);
        if (MODE == 0 && tid < 128) { float s = 0.f;
#pragma unroll
            for (int e = 0; e < 8; ++e) s += tot[e * 128 + tid];
            dsum += s; }
        __syncthreads();
        f32x4 oacc[4];
        if (MODE == 1) {
            { const int tt = wid & 3;
#pragma unroll
              for (int si = 0; si < 2; ++si) { const int stl = 2 * (wid >> 2) + si;
                  f32x4 sacc = (f32x4){0.f, 0.f, 0.f, 0.f};
                  if (stl <= tt) {
#pragma unroll
                      for (int ks = 0; ks < 4; ++ks) {
                          const bf16x8 a = *(const LAS bf16x8*)(lds + HL_KT + off_row256(stl * 16 + fr, ks * 4 + fq));
                          const bf16x8 bq = *(const LAS bf16x8*)(lds + HL_QT + off_row256(tt * 16 + fr, ks * 4 + fq));
                          sacc = __builtin_amdgcn_mfma_f32_16x16x32_bf16(a, bq, sacc, 0, 0, 0);
                      }
                  }
                  const int t = tt * 16 + fr, s0 = stl * 16 + 4 * fq;
                  u32x2 pk; pk.x = cvtpk(s0 + 0 <= t ? sacc.x : 0.f, s0 + 1 <= t ? sacc.y : 0.f); pk.y = cvtpk(s0 + 2 <= t ? sacc.z : 0.f, s0 + 3 <= t ? sacc.w : 0.f);
                  *(LAS u32x2*)(lds + HL_P + off_row128(t, s0 >> 3) + ((s0 & 7) << 1)) = pk; }
            }
            __syncthreads();
            { const int tt = wid >> 1;
#pragma unroll
              for (int i = 0; i < 4; ++i) { const int vt = 4 * (wid & 1) + i;
                  f32x4 a = (f32x4){0.f, 0.f, 0.f, 0.f};
#pragma unroll
                  for (int ks = 0; ks < 2; ++ks) {
                      const int kr = ks * 32 + 8 * fq + (fr >> 2);
                      const s16x4 lo = lds_tr(lds + HL_V + off_tr256(kr, vt * 16 + 4 * (fr & 3))), hi = lds_tr(lds + HL_V + off_tr256(kr + 4, vt * 16 + 4 * (fr & 3)));
                      const bf16x8 va = (bf16x8){lo[0], lo[1], lo[2], lo[3], hi[0], hi[1], hi[2], hi[3]};
                      const bf16x8 pb = *(const LAS bf16x8*)(lds + HL_P + off_row128(tt * 16 + fr, ks * 4 + fq));
                      a = __builtin_amdgcn_mfma_f32_16x16x32_bf16(va, pb, a, 0, 0, 0);
                  }
#pragma unroll
                  for (int ks = 0; ks < 4; ++ks) {
                      const int kr = ks * 32 + 8 * fq + (fr >> 2);
                      const s16x4 lo = lds_tr(lds + HL_SB + off_tr256(kr, vt * 16 + 4 * (fr & 3))), hi = lds_tr(lds + HL_SB + off_tr256(kr + 4, vt * 16 + 4 * (fr & 3)));
                      const bf16x8 sa = (bf16x8){lo[0], lo[1], lo[2], lo[3], hi[0], hi[1], hi[2], hi[3]};
                      const bf16x8 qb = *(const LAS bf16x8*)(lds + HL_QT + off_row256(tt * 16 + fr, ks * 4 + fq));
                      a = __builtin_amdgcn_mfma_f32_16x16x32_bf16(sa, qb, a, 0, 0, 0);
                  }
                  const u32x2 gr = *(const u32x2*)(hg + (tok0 + tt * 16 + fr) * 512 + h * 128 + vt * 16 + 4 * fq);
                  a.x *= __uint_as_float(gr.x << 16); a.y *= __uint_as_float(gr.x & 0xffff0000u); a.z *= __uint_as_float(gr.y << 16); a.w *= __uint_as_float(gr.y & 0xffff0000u);
                  oacc[i] = a; }
              float ss = 0.f;
#pragma unroll
              for (int i = 0; i < 4; ++i) ss += (oacc[i].x * oacc[i].x + oacc[i].y * oacc[i].y) + (oacc[i].z * oacc[i].z + oacc[i].w * oacc[i].w);
              ss += __shfl_xor(ss, 16); ss += __shfl_xor(ss, 32);
              if (fq == 0) red[(tt * 2 + (wid & 1)) * 16 + fr] = ss; }
        }
#pragma unroll
        for (int vt = 0; vt < 8; ++vt) {
            f32x4 a = st[vt] * dec;
#pragma unroll
            for (int ks = 0; ks < 2; ++ks) {
                const int kr = ks * 32 + 8 * fq + (fr >> 2);
                const s16x4 lo = lds_tr(lds + HL_V + off_tr256(kr, vt * 16 + 4 * (fr & 3))), hi = lds_tr(lds + HL_V + off_tr256(kr + 4, vt * 16 + 4 * (fr & 3)));
                const bf16x8 va = (bf16x8){lo[0], lo[1], lo[2], lo[3], hi[0], hi[1], hi[2], hi[3]};
                const s16x4 lo2 = lds_tr(lds + HL_KH + off_tr256(kr, wid * 16 + 4 * (fr & 3))), hi2 = lds_tr(lds + HL_KH + off_tr256(kr + 4, wid * 16 + 4 * (fr & 3)));
                const bf16x8 kb = (bf16x8){lo2[0], lo2[1], lo2[2], lo2[3], hi2[0], hi2[1], hi2[2], hi2[3]};
                a = __builtin_amdgcn_mfma_f32_16x16x32_bf16(va, kb, a, 0, 0, 0);
            }
            st[vt] = a;
        }
        __syncthreads();
        if (MODE == 1) {
            const int tt = wid >> 1; const float ssum = red[(tt * 2) * 16 + fr] + red[(tt * 2 + 1) * 16 + fr];
            const float rstd = rsqrtf(ssum * (1.f / 128.f) + RMS_EPS);
#pragma unroll
            for (int i = 0; i < 4; ++i) { const int v = (4 * (wid & 1) + i) * 16 + 4 * fq; const f32x4 w = *(const f32x4*)(P.rec_out_norm_w + h * 128 + v);
                u32x2 pk; pk.x = cvtpk(oacc[i].x * rstd * w.x, oacc[i].y * rstd * w.y); pk.y = cvtpk(oacc[i].z * rstd * w.z, oacc[i].w * rstd * w.w);
                *(u32x2*)(mix + (tok0 + tt * 16 + fr) * 1024 + 512 + h * 128 + v) = pk; }
        }
    }
    if (MODE == 0) {
#pragma unroll
        for (int vt = 0; vt < 8; ++vt) *(f32x4*)(HLs + (size_t)u * 16384 + (16 * wid + fr) * 128 + vt * 16 + 4 * fq) = st[vt];
        if (tid < 128) HDs[(size_t)u * 128 + tid] = __expf(dsum);
    }
    __syncthreads();
}


constexpr int NL_K = 0, NL_V = 16384, NL_IMP = 32768, NL_IMP_STRIDE = 132, NL_SELM = NL_IMP + 8 * 8 * NL_IMP_STRIDE * 4, NL_END = NL_SELM + 1024;
__device__ __forceinline__ int off_v128(int row, int ch) { return row * 128 + ((ch ^ ((row & 3) << 1)) << 4); }
#define MFMA32(a, b, c) __builtin_amdgcn_mfma_f32_32x32x16_bf16(a, b, c, 0, 0, 0)

struct NsaLane { int t; float sl2; int qi; unsigned long long mlo, mhi; };

template <int MODE> __device__ __forceinline__ void nsa_pass(LAS unsigned char* lds, const bf16_t* Kg, const bf16_t* Vg, int rs, unsigned long long ulo, unsigned long long uhi,
                                                            const bf16x8 (&qf)[4], const NsaLane& L, float inv, float& lsum, f32x16 (&O)[2], LAS float* impw) {
    const int tid = opaque_tid(), lane = tid & 63, hi = lane >> 5, c = lane & 31;
    const int ld_row = tid >> 3, ld_ch = tid & 7;
    const int kw_off = off_row128(ld_row, ld_ch), vw_off = off_v128(ld_row, ld_ch);
    u32x4 k0, v0, k1, v1, k2, v2;
    auto next = [&](int jj) -> int { ++jj; if (jj < 64) { const unsigned long long m = ulo >> jj; if (m) return jj + __builtin_ctzll(m); jj = 64; }
                                     if (jj < 128) { const unsigned long long m = uhi >> (jj - 64); if (m) return jj + __builtin_ctzll(m); } return 128; };
    int jA = next(-1), jB = jA < 128 ? next(jA) : 128, jC = jB < 128 ? next(jB) : 128;
    const int jsafe = jA < 128 ? jA : 0;
    auto ldk = [&](int jj) -> u32x4 { const int q = jj < 128 ? jj : jsafe; return *(const u32x4*)(Kg + (size_t)(q * 64 + ld_row) * rs + ld_ch * 8); };
    auto ldv = [&](int jj) -> u32x4 { const int q = jj < 128 ? jj : jsafe; return *(const u32x4*)(Vg + (size_t)(q * 64 + ld_row) * rs + ld_ch * 8); };
    k0 = ldk(jA); k1 = ldk(jB); k2 = ldk(jC);
    if (MODE != 0) { v0 = ldv(jA); v1 = ldv(jB); v2 = ldv(jC); }
    int it = 0;
    auto step = [&](u32x4& kreg, u32x4& vreg) {
        const int j = jA;
        LAS unsigned char* kb = lds + NL_K + (it & 1) * 8192; LAS unsigned char* vb = lds + NL_V + (it & 1) * 8192;
        *(LAS u32x4*)(kb + kw_off) = kreg; if (MODE != 0) *(LAS u32x4*)(vb + vw_off) = vreg;
        const int jD = jC < 128 ? next(jC) : 128;
        kreg = ldk(jD); if (MODE != 0) vreg = ldv(jD);
        __syncthreads();
        bool need = true; bool selbit = true;
        if (MODE == 2) { selbit = (j < 64 ? (L.mlo >> j) : (L.mhi >> (j - 64))) & 1ull; need = __any(selbit); }
        if (need) {
            f32x16 p0 = {}, p1 = {};
#pragma unroll
            for (int ks = 0; ks < 4; ++ks) {
                const bf16x8 a0 = *(const LAS bf16x8*)(kb + off_row128(c, 2 * ks + hi)), a1 = *(const LAS bf16x8*)(kb + off_row128(32 + c, 2 * ks + hi));
                p0 = MFMA32(a0, qf[ks], p0); p1 = MFMA32(a1, qf[ks], p1);
            }
            const int stride = (MODE <= 1) ? 16 : 1;
            const int dl = (MODE <= 1) ? (L.t - 31 - 16 * (j * 64 + 4 * hi)) : (L.t - (j * 64 + 4 * hi));
            const float nb = -L.sl2 * (float)dl, sls = L.sl2 * (float)stride;
            float rs_ = 0.f;
#pragma unroll
            for (int r = 0; r < 16; ++r) {
                const int ro0 = (r & 3) + 8 * (r >> 2), ro1 = ro0 + 32;
                const int d0 = dl - stride * ro0, d1 = dl - stride * ro1;
                bool v0 = d0 >= 0, v1 = d1 >= 0;
                if (MODE == 3) { v0 = v0 && d0 < 512; v1 = v1 && d1 < 512; }
                if (MODE == 2) { v0 = v0 && selbit; v1 = v1 && selbit; }
                float e0 = __builtin_amdgcn_exp2f(__builtin_fmaf(p0[r], LOG2E, __builtin_fmaf(sls, (float)ro0, nb)));
                float e1 = __builtin_amdgcn_exp2f(__builtin_fmaf(p1[r], LOG2E, __builtin_fmaf(sls, (float)ro1, nb)));
                e0 = v0 ? e0 : 0.f; e1 = v1 ? e1 : 0.f;
                if (MODE == 1) { e0 *= inv; e1 *= inv; }
                p0[r] = e0; p1[r] = e1; rs_ += e0 + e1;
            }
            lsum += rs_;
            if (MODE == 1) {
#pragma unroll
                for (int kt = 0; kt < 2; ++kt)
#pragma unroll
                    for (int i = 0; i < 4; ++i) {
                        float g = kt ? (p1[4 * i] + p1[4 * i + 1]) + (p1[4 * i + 2] + p1[4 * i + 3]) : (p0[4 * i] + p0[4 * i + 1]) + (p0[4 * i + 2] + p0[4 * i + 3]);
                        float l3 = kt ? p1[4 * i + 3] : p0[4 * i + 3];
                        g += __shfl_xor(g, 1); g += __shfl_xor(g, 2); l3 += __shfl_xor(l3, 1); l3 += __shfl_xor(l3, 2);
                        if ((c & 3) == 0) { const int jj = j * 16 + kt * 8 + 2 * i + hi; __hip_atomic_fetch_add(impw + L.qi * NL_IMP_STRIDE + jj, g, __ATOMIC_RELAXED, __HIP_MEMORY_SCOPE_WORKGROUP); __hip_atomic_fetch_add(impw + L.qi * NL_IMP_STRIDE + jj + 1, l3, __ATOMIC_RELAXED, __HIP_MEMORY_SCOPE_WORKGROUP); }
                    }
            }
            if (MODE != 0) {
                bf16x8 pf[4];
#pragma unroll
                for (int s4 = 0; s4 < 4; ++s4) { u32x4 w;
#pragma unroll
                    for (int e = 0; e < 4; ++e) { const int r = 8 * (s4 & 1) + 2 * e; w[e] = (s4 >> 1) ? cvtpk(p1[r], p1[r + 1]) : cvtpk(p0[r], p0[r + 1]); }
                    pf[s4] = __builtin_bit_cast(bf16x8, w); }
                const int g4 = lane >> 4, sub = g4 & 1, i16 = lane & 15, qq = i16 >> 2, pp = i16 & 3;
#pragma unroll
                for (int dt = 0; dt < 2; ++dt)
#pragma unroll
                    for (int s4 = 0; s4 < 4; ++s4) {
                        const int row = 16 * s4 + 4 * hi + qq, ch = 4 * dt + 2 * sub + (pp >> 1);
                        const s16x4 lo = lds_tr(vb + off_v128(row, ch) + 8 * (pp & 1)), hh = lds_tr(vb + off_v128(row + 8, ch) + 8 * (pp & 1));
                        const bf16x8 vf = (bf16x8){lo[0], lo[1], lo[2], lo[3], hh[0], hh[1], hh[2], hh[3]};
                        O[dt] = MFMA32(vf, pf[s4], O[dt]);
                    }
            }
        }
        jA = jB; jB = jC; jC = jD; ++it;
    };
    while (jA < 128) {
        step(k0, v0); if (jA >= 128) break;
        step(k1, v1); if (jA >= 128) break;
        step(k2, v2);
    }
    __syncthreads();
}

__device__ __forceinline__ void nsa_unit(const Params& P, LAS unsigned char* lds, int u) {
    const int tid = opaque_tid(), lane = tid & 63, wid = tid >> 6, hi = lane >> 5, c = lane & 31;
    const int b = u >> 8, g = (u >> 7) & 1, qb = u & 127;
    const bf16_t* qg = (const bf16_t*)(P.ws + WS_Q); const bf16_t* kv = (const bf16_t*)(P.ws + WS_KV);
    const bf16_t* kcn = (const bf16_t*)(P.ws + WS_KC) + (size_t)(b * 2 + g) * 512 * 64; const bf16_t* vcc = (const bf16_t*)(P.ws + WS_VC) + (size_t)(b * 2 + g) * 512 * 64;
    const float* gates = (const float*)(P.ws + WS_GATES); bf16_t* mix = (bf16_t*)(P.ws + WS_MIX);
    LAS float* impw = (LAS float*)(lds + NL_IMP) + wid * 8 * NL_IMP_STRIDE;
    LAS unsigned long long* selm = (LAS unsigned long long*)(lds + NL_SELM);
    NsaLane L; L.qi = c >> 2; const int hh = c & 3, head = g * 4 + hh;
    L.t = qb * 64 + wid * 8 + L.qi; L.sl2 = exp2f(-(float)(head + 1)) * LOG2E; L.mlo = 0; L.mhi = 0;
    const size_t tok = (size_t)b * SEQ + L.t;
    bf16x8 qf[4];
#pragma unroll
    for (int ks = 0; ks < 4; ++ks) qf[ks] = *(const bf16x8*)(qg + tok * 512 + head * 64 + 16 * ks + 8 * hi);
    for (int i = lane; i < 8 * NL_IMP_STRIDE; i += 64) impw[i] = 0.f;
    const int ncmp = qb * 4 + 3 < 511 ? qb * 4 + 3 : 511;
    const int nblk = (ncmp + 63) >> 6;
    const unsigned long long cm = nblk >= 64 ? ~0ull : ((1ull << nblk) - 1ull);
    f32x16 O[2], Ot[2]; float lsum = 0.f;
    O[0] = f32x16{}; O[1] = f32x16{};
    nsa_pass<0>(lds, kcn, vcc, 64, cm, 0ull, qf, L, 1.f, lsum, O, impw);
    lsum += __shfl_xor(lsum, 32);
    const float invc = 1.0f / fmaxf(lsum, 1e-30f);
    float dummy = 0.f;
    nsa_pass<1>(lds, kcn, vcc, 64, cm, 0ull, qf, L, invc, dummy, O, impw);
    const float* gt = gates + tok * 24 + g * 12 + hh * 3;
    const float g0 = gt[0], g1 = gt[1], g2 = gt[2];
#pragma unroll
    for (int dt = 0; dt < 2; ++dt) Ot[dt] = O[dt] * g0;
    {
        const int ncausal = qb + 1;
        for (int qi = 0; qi < 8; ++qi) {
            unsigned long long lo, hi64;
            if (ncausal <= 16) { lo = (1ull << ncausal) - 1ull; hi64 = 0ull; }
            else {
                const int j0 = lane, j1 = lane + 64;
                const bool f0 = (j0 == 0) || (j0 == qb) || (j0 == qb - 1), f1 = (j1 == qb) || (j1 == qb - 1);
                const unsigned k0 = (j0 <= qb && !f0) ? (0x80000000u | (__float_as_uint(impw[qi * NL_IMP_STRIDE + j0]) & 0x7fffff80u) | (unsigned)j0) : 0u;
                const unsigned k1 = (j1 <= qb && !f1) ? (0x80000000u | (__float_as_uint(impw[qi * NL_IMP_STRIDE + j1]) & 0x7fffff80u) | (unsigned)j1) : 0u;
                const int needn = 13;
                unsigned th = 0u;
                for (int bit = 31; bit >= 0; --bit) { const unsigned cand = th | (1u << bit);
                    const int cnt = __popcll(__ballot(k0 >= cand)) + __popcll(__ballot(k1 >= cand));
                    if (cnt >= needn) th = cand; }
                lo = __ballot(f0 || (k0 >= th && k0 != 0u)); hi64 = __ballot(f1 || (k1 >= th && k1 != 0u));
            }
            if (lane == 0) { selm[(wid * 8 + qi) * 2] = lo; selm[(wid * 8 + qi) * 2 + 1] = hi64; }
        }
    }
    __syncthreads();
    unsigned long long ulo = selm[lane * 2], uhi = selm[lane * 2 + 1];
#pragma unroll
    for (int o = 1; o < 64; o <<= 1) { ulo |= __shfl_xor(ulo, o); uhi |= __shfl_xor(uhi, o); }
    L.mlo = selm[(wid * 8 + L.qi) * 2]; L.mhi = selm[(wid * 8 + L.qi) * 2 + 1];
    const bf16_t* kvb = kv + (size_t)b * SEQ * 768 + g * 64;
    O[0] = f32x16{}; O[1] = f32x16{}; lsum = 0.f;
    nsa_pass<2>(lds, kvb + 256, kvb + 384, 768, ulo, uhi, qf, L, 1.f, lsum, O, impw);
    lsum += __shfl_xor(lsum, 32);
    { const float sc = g1 / fmaxf(lsum, 1e-30f);
#pragma unroll
      for (int dt = 0; dt < 2; ++dt) Ot[dt] += O[dt] * sc; }
    {
        const int jlo = qb >= 8 ? qb - 8 : 0;
        unsigned long long wlo = 0ull, whi = 0ull;
        for (int jj = jlo; jj <= qb; ++jj) { if (jj < 64) wlo |= 1ull << jj; else whi |= 1ull << (jj - 64); }
        O[0] = f32x16{}; O[1] = f32x16{}; lsum = 0.f;
        nsa_pass<3>(lds, kvb + 512, kvb + 640, 768, wlo, whi, qf, L, 1.f, lsum, O, impw);
        lsum += __shfl_xor(lsum, 32);
        const float sc = g2 / fmaxf(lsum, 1e-30f);
#pragma unroll
        for (int dt = 0; dt < 2; ++dt) Ot[dt] += O[dt] * sc;
    }
    float ss = 0.f;
#pragma unroll
    for (int dt = 0; dt < 2; ++dt)
#pragma unroll
        for (int r = 0; r < 16; ++r) ss += Ot[dt][r] * Ot[dt][r];
    ss += __shfl_xor(ss, 32);
    const float rstd = rsqrtf(ss * (1.f / 64.f) + RMS_EPS);
#pragma unroll
    for (int dt = 0; dt < 2; ++dt)
#pragma unroll
        for (int r4 = 0; r4 < 4; ++r4) { const int d = 32 * dt + 8 * r4 + 4 * hi; const f32x4 w = *(const f32x4*)(P.attn_out_norm_w + head * 64 + d);
            u32x2 pk; pk.x = cvtpk(Ot[dt][4 * r4] * rstd * w.x, Ot[dt][4 * r4 + 1] * rstd * w.y); pk.y = cvtpk(Ot[dt][4 * r4 + 2] * rstd * w.z, Ot[dt][4 * r4 + 3] * rstd * w.w);
            *(u32x2*)(mix + tok * 1024 + head * 64 + d) = pk; }
    __syncthreads();
}


__device__ __forceinline__ int gu_hcol(int m0) { const int ni = (m0 >> 4) & 7; return 64 * (m0 >> 7) + 32 * (ni >> 2) + 8 * ((m0 & 15) >> 2) + 4 * ((ni >> 1) & 1); }
__device__ __forceinline__ int p2_col(int m0) { const int ni = (m0 >> 4) & 7; return 128 * (m0 >> 7) + 32 * (ni >> 1) + 8 * ((m0 & 15) >> 2) + 4 * (ni & 1); }
__device__ __forceinline__ void phase_cvt_small(const Params& P) {
    const int tid = threadIdx.x;
    {
        const int gt = blockIdx.x * NTHREADS + tid, NG = gridDim.x * NTHREADS;
        bf16_t* wo = (bf16_t*)(P.ws + WS_WOUT); bf16_t* wrs = (bf16_t*)(P.ws + WS_WRS); bf16_t* wsd = (bf16_t*)(P.ws + WS_WSD);
        for (int i = gt; i < 1024 * 128; i += NG) { const int k = i >> 7, m0 = (i & 127) * 8; const float* s = P.w_out + (size_t)k * 1024 + (m0 & ~255) + p2_col(m0 & 255);
            const f32x4 a = *(const f32x4*)s, b2 = *(const f32x4*)(s + 8);
            *(u32x4*)(wo + (size_t)i * 8) = (u32x4){cvtpk(a.x, a.y), cvtpk(a.z, a.w), cvtpk(b2.x, b2.y), cvtpk(b2.z, b2.w)}; }
        for (int i = gt; i < 256 * 128; i += NG) { const int k = i >> 7, m0 = (i & 127) * 8; const float* s = P.sh_wd + (size_t)k * 1024 + (m0 & ~255) + p2_col(m0 & 255);
            const f32x4 a = *(const f32x4*)s, b2 = *(const f32x4*)(s + 8);
            *(u32x4*)(wsd + (size_t)i * 8) = (u32x4){cvtpk(a.x, a.y), cvtpk(a.z, a.w), cvtpk(b2.x, b2.y), cvtpk(b2.z, b2.w)}; }
        for (int i = gt; i < 1024 * 96; i += NG) { const int k = i / 96, c8 = (i % 96) * 8;
            const float* s; int d2 = 4;
            if (c8 < 256) s = P.router_w + (size_t)k * 256 + c8;
            else { const int cc = c8 - 256, t = cc >> 8; s = ((cc & 16) ? P.sh_wu : P.sh_wg) + (size_t)k * 256 + t * 128 + gu_hcol(cc & 255); d2 = 8; }
            const f32x4 a = *(const f32x4*)s, b2 = *(const f32x4*)(s + d2);
            *(u32x4*)(wrs + (size_t)k * 768 + c8) = (u32x4){cvtpk(a.x, a.y), cvtpk(a.z, a.w), cvtpk(b2.x, b2.y), cvtpk(b2.z, b2.w)}; }
    }
}

__device__ __forceinline__ void route_token(const Params& P, int t, int lane) {
    const float* scores = (const float*)(P.ws + WS_SCORES) + (size_t)t * 256;
    const f32x4 s4 = *(const f32x4*)(scores + 4 * lane); const f32x4 b4 = *(const f32x4*)(P.router_bias + 4 * lane);
    float sc[4] = {s4.x, s4.y, s4.z, s4.w};
    float bs[4] = {s4.x + b4.x, s4.y + b4.y, s4.z + b4.z, s4.w + b4.w};
    float m1 = fmaxf(bs[0], bs[1]), m2 = fminf(bs[0], bs[1]);
    { const float v = bs[2]; const float n1 = fmaxf(m1, v); m2 = fmaxf(fminf(m1, v), m2); m1 = n1; }
    { const float v = bs[3]; const float n1 = fmaxf(m1, v); m2 = fmaxf(fminf(m1, v), m2); m1 = n1; }
#pragma unroll
    for (int o = 1; o < 8; o <<= 1) { const float o1 = __shfl_xor(m1, o), o2 = __shfl_xor(m2, o); const float n1 = fmaxf(m1, o1); m2 = fmaxf(fminf(m1, o1), fmaxf(m2, o2)); m1 = n1; }
    const float gs = m1 + m2;
    const int grp = lane >> 3;
    int rank = 0;
#pragma unroll
    for (int g2 = 0; g2 < 8; ++g2) { const float og = __shfl(gs, g2 * 8); rank += (og > gs || (og == gs && g2 < grp)) ? 1 : 0; }
    const bool gsel = rank < 4;
    float mv[4];
#pragma unroll
    for (int i = 0; i < 4; ++i) mv[i] = gsel ? bs[i] : -INFINITY;
    int myidx = -1; float myw = 0.f; float wsum = 0.f;
#pragma unroll 1
    for (int k = 0; k < 8; ++k) {
        float bv = mv[0]; int bi = 4 * lane;
#pragma unroll
        for (int i = 1; i < 4; ++i) if (mv[i] > bv) { bv = mv[i]; bi = 4 * lane + i; }
#pragma unroll
        for (int o = 1; o < 64; o <<= 1) { const float ov = __shfl_xor(bv, o); const int oi = __shfl_xor(bi, o); if (ov > bv || (ov == bv && oi < bi)) { bv = ov; bi = oi; } }
        const int wl = bi >> 2, wc = bi & 3;
        const float mine = wc == 0 ? sc[0] : (wc == 1 ? sc[1] : (wc == 2 ? sc[2] : sc[3]));
        const float wv = __shfl(mine, wl);
        wsum += wv;
        if (lane == k) { myidx = bi; myw = wv; }
        if (lane == wl) {
#pragma unroll
            for (int i = 0; i < 4; ++i) if (i == wc) mv[i] = -INFINITY; }
    }
    if (lane < 8) {
        int* cnt = (int*)(P.ws + WS_CTL + CTL_CNT);
        const int pos = atomicAdd(cnt + myidx, 1);
        if (pos < BCAP) ((int*)(P.ws + WS_BUCKET))[(size_t)myidx * BCAP + pos] = t * 8 + lane;
        ((float*)(P.ws + WS_RW))[(size_t)t * 8 + lane] = myw / wsum * 2.5f;
    }
}


__device__ __forceinline__ void phase_p4a(const Params& P, LAS unsigned char* lds) {
    typedef Gemm3 G;
    const int tid = opaque_tid(), lane = tid & 63, wid = tid >> 6, wm = wid >> 1, wn = wid & 1, fr = lane & 15, fq = lane >> 4;
    struct F { const Params& P;
        __device__ __forceinline__ void ptrs(int seg, const bf16_t* (&aptr)[2], const bf16_t* (&bptr)[2]) const {
            const int tid = opaque_tid(), lane = tid & 63, wid = tid >> 6, wm = wid >> 1, wn = wid & 1, fr = lane & 15, fq = lane >> 4, c8 = 8 * (tid & 31); (void)wm; (void)wn; (void)fr; (void)fq; (void)c8;
            const int u = blockIdx.x + seg * gridDim.x, rt = u >> 2, ct = u & 3;
            const bf16_t* mix = (const bf16_t*)(P.ws + WS_MIX); const bf16_t* wo = (const bf16_t*)(P.ws + WS_WOUT);
#pragma unroll
            for (int i = 0; i < 2; ++i) { const int row = G::a_row(i, wid, lane); aptr[i] = mix + (size_t)(rt * 256 + row) * 1024 + G::a_chunk(row, lane) * 8;
                const int k = G::b_k(i, wid, lane); bptr[i] = wo + (size_t)k * 1024 + ct * 256 + G::b_n(k, lane); } }
        __device__ __forceinline__ void epi(int seg, f32x4 (&acc)[4][8]) const {
            const int tid = opaque_tid(), lane = tid & 63, wid = tid >> 6, wm = wid >> 1, wn = wid & 1, fr = lane & 15, fq = lane >> 4, c8 = 8 * (tid & 31); (void)wm; (void)wn; (void)fr; (void)fq; (void)c8;
            const int u = blockIdx.x + seg * gridDim.x, rt = u >> 2, ct = u & 3, b = (rt * 256) / SEQ;
            const float* mod = (const float*)(P.ws + WS_MOD) + b * 6144; float* ssp = (float*)(P.ws + WS_SS); bf16_t* x1 = (bf16_t*)(P.ws + WS_X1);
#pragma unroll
            for (int mi = 0; mi < 4; ++mi) { const size_t m = (size_t)(rt * 256 + wm * 64 + mi * 16 + fr); float ss = 0.f;
#pragma unroll
                for (int j = 0; j < 4; ++j) { const int col = ct * 256 + wn * 128 + j * 32 + 8 * fq;
                    const f32x4 xv = *(const f32x4*)(P.x + m * 1024 + col), xw = *(const f32x4*)(P.x + m * 1024 + col + 4), gv = *(const f32x4*)(mod + 2048 + col), gw = *(const f32x4*)(mod + 2048 + col + 4);
                    const f32x4 a = acc[mi][2 * j], c = acc[mi][2 * j + 1];
                    f32x4 o, o2; o.x = xv.x + gv.x * a.x; o.y = xv.y + gv.y * a.y; o.z = xv.z + gv.z * a.z; o.w = xv.w + gv.w * a.w;
                    o2.x = xw.x + gw.x * c.x; o2.y = xw.y + gw.y * c.y; o2.z = xw.z + gw.z * c.z; o2.w = xw.w + gw.w * c.w;
                    *(u32x4*)(x1 + m * 1024 + col) = (u32x4){cvtpk(o.x, o.y), cvtpk(o.z, o.w), cvtpk(o2.x, o2.y), cvtpk(o2.z, o2.w)};
                    ss += ((o.x * o.x + o.y * o.y) + (o.z * o.z + o.w * o.w)) + ((o2.x * o2.x + o2.y * o2.y) + (o2.z * o2.z + o2.w * o2.w)); if (j & 1) asm volatile("" ::: "memory"); }
                ss += __shfl_xor(ss, 16); ss += __shfl_xor(ss, 32);
                if (fq == 0) ssp[m * 8 + ct * 2 + wn] = ss; } }
    } f{P};
    const int nu = (128 * 4 - (int)blockIdx.x + (int)gridDim.x - 1) / (int)gridDim.x;
    if (nu > 0) G::run_stream(f, nu, 32, 32, (size_t)32 * 1024, lds);
}
__device__ __forceinline__ void phase_p4b(const Params& P) {
    const int lane = threadIdx.x & 63, gw = blockIdx.x * (NTHREADS / 64) + (threadIdx.x >> 6), NGW = gridDim.x * (NTHREADS / 64);
    const float* ssp = (const float*)(P.ws + WS_SS); bf16_t* h2 = (bf16_t*)(P.ws + WS_H);
    for (int m = gw; m < T; m += NGW) {
        const float* mod = (const float*)(P.ws + WS_MOD) + (m / SEQ) * 6144;
        const f32x4 s0 = *(const f32x4*)(ssp + (size_t)m * 8), s1 = *(const f32x4*)(ssp + (size_t)m * 8 + 4);
        const float rstd = rsqrtf(((s0.x + s0.y) + (s0.z + s0.w) + (s1.x + s1.y) + (s1.z + s1.w)) * (1.f / 1024.f) + RMS_EPS);
#pragma unroll
        for (int j = 0; j < 4; ++j) { const int col = (lane + 64 * j) * 4;
            const u32x2 xr = *(const u32x2*)((const bf16_t*)(P.ws + WS_X1) + (size_t)m * 1024 + col);
            const f32x4 v = (f32x4){__uint_as_float(xr.x << 16), __uint_as_float(xr.x & 0xffff0000u), __uint_as_float(xr.y << 16), __uint_as_float(xr.y & 0xffff0000u)}, wv = *(const f32x4*)(P.norm2_w + col), scv = *(const f32x4*)(mod + 4096 + col), shv = *(const f32x4*)(mod + 3072 + col);
            const float r0 = v.x * rstd * wv.x * (1.f + scv.x) + shv.x, r1 = v.y * rstd * wv.y * (1.f + scv.y) + shv.y, r2 = v.z * rstd * wv.z * (1.f + scv.z) + shv.z, r3 = v.w * rstd * wv.w * (1.f + scv.w) + shv.w;
            u32x2 pk; pk.x = cvtpk(r0, r1); pk.y = cvtpk(r2, r3);
            *(u32x2*)(h2 + (size_t)m * 1024 + col) = pk;
            int q8 = __builtin_amdgcn_cvt_pk_fp8_f32(r0, r1, 0, false); q8 = __builtin_amdgcn_cvt_pk_fp8_f32(r2, r3, q8, true);
            *(int*)((unsigned char*)(P.ws + WS_H2Q) + (size_t)m * 1024 + col) = q8; }
    }
}
__device__ __forceinline__ void phase_p4c(const Params& P, LAS unsigned char* lds) {
    typedef Gemm3 G;
    const int tid = opaque_tid(), lane = tid & 63, wid = tid >> 6, wm = wid >> 1, wn = wid & 1, fr = lane & 15, fq = lane >> 4;
    struct F { const Params& P;
        __device__ __forceinline__ void ptrs(int seg, const bf16_t* (&aptr)[2], const bf16_t* (&bptr)[2]) const {
            const int tid = opaque_tid(), lane = tid & 63, wid = tid >> 6, wm = wid >> 1, wn = wid & 1, fr = lane & 15, fq = lane >> 4, c8 = 8 * (tid & 31); (void)wm; (void)wn; (void)fr; (void)fq; (void)c8;
            const int u = blockIdx.x + seg * gridDim.x, rt = u / 3, ct = u % 3;
            const bf16_t* h2 = (const bf16_t*)(P.ws + WS_H); const bf16_t* wrs = (const bf16_t*)(P.ws + WS_WRS);
#pragma unroll
            for (int i = 0; i < 2; ++i) { const int row = G::a_row(i, wid, lane); aptr[i] = h2 + (size_t)(rt * 256 + row) * 1024 + G::a_chunk(row, lane) * 8;
                const int k = G::b_k(i, wid, lane); bptr[i] = wrs + (size_t)k * 768 + ct * 256 + G::b_n(k, lane); } }
        __device__ __forceinline__ void epi(int seg, f32x4 (&acc)[4][8]) const {
            const int tid = opaque_tid(), lane = tid & 63, wid = tid >> 6, wm = wid >> 1, wn = wid & 1, fr = lane & 15, fq = lane >> 4, c8 = 8 * (tid & 31); (void)wm; (void)wn; (void)fr; (void)fq; (void)c8;
            const int u = blockIdx.x + seg * gridDim.x, rt = u / 3, ct = u % 3;
            float* scores = (float*)(P.ws + WS_SCORES); bf16_t* hidS = (bf16_t*)(P.ws + WS_HIDS);
#pragma unroll
            for (int mi = 0; mi < 4; ++mi) { const size_t m = (size_t)(rt * 256 + wm * 64 + mi * 16 + fr);
                if (ct == 0) {
#pragma unroll
                    for (int ni = 0; ni < 8; ++ni) { const f32x4 a = acc[mi][ni];
                        *(f32x4*)(scores + m * 256 + wn * 128 + ni * 16 + 4 * fq) = (f32x4){sigmoidf_(a.x), sigmoidf_(a.y), sigmoidf_(a.z), sigmoidf_(a.w)}; }
                } else {
#pragma unroll
                    for (int j2 = 0; j2 < 2; ++j2) { const f32x4 g = acc[mi][4 * j2], uu = acc[mi][4 * j2 + 1], g2 = acc[mi][4 * j2 + 2], u2 = acc[mi][4 * j2 + 3];
                        u32x4 pk; pk.x = cvtpk(siluf_(g.x) * uu.x, siluf_(g.y) * uu.y); pk.y = cvtpk(siluf_(g.z) * uu.z, siluf_(g.w) * uu.w);
                        pk.z = cvtpk(siluf_(g2.x) * u2.x, siluf_(g2.y) * u2.y); pk.w = cvtpk(siluf_(g2.z) * u2.z, siluf_(g2.w) * u2.w);
                        *(u32x4*)(hidS + m * 256 + (ct - 1) * 128 + wn * 64 + j2 * 32 + 8 * fq) = pk; }
                } } }
    } f{P};
    const int nu = (128 * 3 - (int)blockIdx.x + (int)gridDim.x - 1) / (int)gridDim.x;
    if (nu > 0) G::run_stream(f, nu, 32, 32, (size_t)32 * 768, lds);
}
__device__ __forceinline__ void phase_route(const Params& P) {
    const int tid = opaque_tid(), lane = tid & 63, gw = blockIdx.x * (NTHREADS / 64) + (tid >> 6), NGW = gridDim.x * (NTHREADS / 64);
    for (int t = gw; t < T; t += NGW) route_token(P, t, lane);
}
__device__ __forceinline__ void phase_p4d(const Params& P, LAS unsigned char* lds) {
    typedef Gemm3 G;
    const int tid = opaque_tid(), lane = tid & 63, wid = tid >> 6, wm = wid >> 1, wn = wid & 1, fr = lane & 15, fq = lane >> 4;
    struct F { const Params& P;
        __device__ __forceinline__ void ptrs(int seg, const bf16_t* (&aptr)[2], const bf16_t* (&bptr)[2]) const {
            const int tid = opaque_tid(), lane = tid & 63, wid = tid >> 6, wm = wid >> 1, wn = wid & 1, fr = lane & 15, fq = lane >> 4, c8 = 8 * (tid & 31); (void)wm; (void)wn; (void)fr; (void)fq; (void)c8;
            const int u = blockIdx.x + seg * gridDim.x, rt = u >> 2, ct = u & 3;
            const bf16_t* hidS = (const bf16_t*)(P.ws + WS_HIDS); const bf16_t* wsd = (const bf16_t*)(P.ws + WS_WSD);
#pragma unroll
            for (int i = 0; i < 2; ++i) { const int row = G::a_row(i, wid, lane); aptr[i] = hidS + (size_t)(rt * 256 + row) * 256 + G::a_chunk(row, lane) * 8;
                const int k = G::b_k(i, wid, lane); bptr[i] = wsd + (size_t)k * 1024 + ct * 256 + G::b_n(k, lane); } }
        __device__ __forceinline__ void epi(int seg, f32x4 (&acc)[4][8]) const {
            const int tid = opaque_tid(), lane = tid & 63, wid = tid >> 6, wm = wid >> 1, wn = wid & 1, fr = lane & 15, fq = lane >> 4, c8 = 8 * (tid & 31); (void)wm; (void)wn; (void)fr; (void)fq; (void)c8;
            const int u = blockIdx.x + seg * gridDim.x, rt = u >> 2, ct = u & 3;
            unsigned char* ysh = (unsigned char*)(P.ws + WS_YSH);
#pragma unroll
            for (int mi = 0; mi < 4; ++mi) { const size_t m = (size_t)(rt * 256 + wm * 64 + mi * 16 + fr);
#pragma unroll
                for (int j = 0; j < 4; ++j) { const int col = ct * 256 + wn * 128 + j * 32 + 8 * fq; const f32x4 a = acc[mi][2 * j] * Y_SCALE, c = acc[mi][2 * j + 1] * Y_SCALE;
                    *(u32x2*)(ysh + m * 1024 + col) = (u32x2){pk4_fp8(a.x, a.y, a.z, a.w), pk4_fp8(c.x, c.y, c.z, c.w)}; } } }
    } f{P};
    const int nu = (128 * 4 - (int)blockIdx.x + (int)gridDim.x - 1) / (int)gridDim.x;
    if (nu > 0) G::run_stream(f, nu, 8, 32, (size_t)32 * 1024, lds);
}

__device__ __forceinline__ void phase_expert_cvt(const Params& P) {
    const size_t gt = (size_t)blockIdx.x * NTHREADS + threadIdx.x, NG = (size_t)gridDim.x * NTHREADS;
    bf16_t* wgu = (bf16_t*)(P.ws + WS_WBGU); bf16_t* wd = (bf16_t*)(P.ws + WS_WBD);
    for (size_t i = gt; i < (size_t)256 * 1024 * 64; i += NG) {
        const size_t ek = i >> 6; const int c8 = (int)(i & 63) * 8, t = c8 >> 8;
        const float* s = ((c8 & 16) ? P.exp_wu : P.exp_wg) + ek * 256 + t * 128 + gu_hcol(c8 & 255);
        const f32x4 a = __builtin_nontemporal_load((const f32x4*)s), b2 = __builtin_nontemporal_load((const f32x4*)(s + 8));
        *(u32x4*)(wgu + ek * 512 + c8) = (u32x4){cvtpk(a.x, a.y), cvtpk(a.z, a.w), cvtpk(b2.x, b2.y), cvtpk(b2.z, b2.w)}; }
    for (size_t i = gt; i < (size_t)256 * 256 * 128; i += NG) {
        const size_t ek = i >> 7; const int m0 = (int)(i & 127) * 8, tl = m0 & 255, tile = m0 >> 8;
        const int wnn = tl >> 7, nii = (tl >> 4) & 7, n0 = tl & 15;
        const int ca = tile * 256 + wnn * 128 + 64 * (nii >> 2) + 16 * (n0 >> 2) + 4 * (nii & 3);
        const f32x4 a = __builtin_nontemporal_load((const f32x4*)(P.exp_wd + ek * 1024 + ca)), b2 = __builtin_nontemporal_load((const f32x4*)(P.exp_wd + ek * 1024 + ca + 16));
        *(u32x4*)(wd + ek * 1024 + m0) = (u32x4){cvtpk(a.x, a.y), cvtpk(a.z, a.w), cvtpk(b2.x, b2.y), cvtpk(b2.z, b2.w)}; }
}

constexpr int P6_TILES = 128 * 1024, P6_PRE = P6_TILES + 1024, P6_PAIR = P6_PRE + 1040, P6_W = P6_PAIR + 1024;
__device__ __forceinline__ void phase_experts(const Params& P, LAS unsigned char* lds) {
    typedef Gemm3 G;
    const int tid = opaque_tid(), lane = tid & 63, wid = tid >> 6, wm = wid >> 1, wn = wid & 1, fr = lane & 15, fq = lane >> 4;
    const int* cnt = (const int*)(P.ws + WS_CTL + CTL_CNT); const int* bucket = (const int*)(P.ws + WS_BUCKET); const float* rw = (const float*)(P.ws + WS_RW);
    const bf16_t* h2 = (const bf16_t*)(P.ws + WS_H); bf16_t* hidR = (bf16_t*)(P.ws + WS_HIDR) + (size_t)blockIdx.x * 256 * 256; unsigned char* y = (unsigned char*)(P.ws + WS_Y);
    LAS int* tiles = (LAS int*)(lds + P6_TILES); LAS int* pre = (LAS int*)(lds + P6_PRE); LAS int* pairs = (LAS int*)(lds + P6_PAIR); LAS float* wts = (LAS float*)(lds + P6_W);
    const int nx = (gridDim.x % 8 == 0) ? 8 : 1, xl = blockIdx.x % nx, li = blockIdx.x / nx, nloc = gridDim.x / nx, nek = 256 / nx;
    if (tid < nek) { const int c_ = cnt[xl + nx * tid]; tiles[tid] = ((c_ < BCAP ? c_ : BCAP) + 255) >> 8; }
    __syncthreads();
    if (tid < nek) { int s = 0; for (int i = 0; i < tid; ++i) s += tiles[i]; pre[tid] = s; if (tid == nek - 1) pre[nek] = s + tiles[nek - 1]; }
    __syncthreads();
    const int total = pre[nek];
    const int c8 = 8 * (tid & 31), u16 = c8 >> 4;
    for (int u = li; u < total; u += nloc) {
        int lo = 0, hi = nek - 1;
        while (lo < hi) { const int mid = (lo + hi + 1) >> 1; if (pre[mid] <= u) lo = mid; else hi = mid - 1; }
        const int e = xl + nx * lo, tile = u - pre[lo], n = cnt[e] < BCAP ? cnt[e] : BCAP, rows = (n - tile * 256) < 256 ? (n - tile * 256) : 256;
        if (tid < 256) { const int r = tid < rows ? tid : 0; const int pr = bucket[(size_t)e * BCAP + tile * 256 + r]; pairs[tid] = pr; wts[tid] = tid < rows ? rw[pr] : 0.f; }
        __syncthreads();
        {
            struct GU { const bf16_t* h2; LAS int* pairs; const bf16_t* wgu; bf16_t* hidR;
                __device__ __forceinline__ void ptrs(int t, const bf16_t* (&aptr)[2], const bf16_t* (&bptr)[2]) const {
                    const int tid = opaque_tid(), lane = tid & 63, wid = tid >> 6, wm = wid >> 1, wn = wid & 1, fr = lane & 15, fq = lane >> 4, c8 = 8 * (tid & 31); (void)wm; (void)wn; (void)fr; (void)fq; (void)c8;
#pragma unroll
                    for (int i = 0; i < 2; ++i) { const int row = G::a_row(i, wid, lane); aptr[i] = h2 + (size_t)(pairs[row] >> 3) * 1024 + G::a_chunk(row, lane) * 8;
                        const int k = G::b_k(i, wid, lane); bptr[i] = wgu + (size_t)k * 512 + t * 256 + G::b_n(k, lane); } }
                __device__ __forceinline__ void epi(int t, f32x4 (&acc)[4][8]) const {
                    const int tid = opaque_tid(), lane = tid & 63, wid = tid >> 6, wm = wid >> 1, wn = wid & 1, fr = lane & 15, fq = lane >> 4, c8 = 8 * (tid & 31); (void)wm; (void)wn; (void)fr; (void)fq; (void)c8;
#pragma unroll
                    for (int mi = 0; mi < 4; ++mi) { const int rl = wm * 64 + mi * 16 + fr;
#pragma unroll
                        for (int j2 = 0; j2 < 2; ++j2) { const f32x4 g = acc[mi][4 * j2], uu = acc[mi][4 * j2 + 1], g2 = acc[mi][4 * j2 + 2], u2 = acc[mi][4 * j2 + 3];
                            u32x4 pk; pk.x = cvtpk(siluf_(g.x) * uu.x, siluf_(g.y) * uu.y); pk.y = cvtpk(siluf_(g.z) * uu.z, siluf_(g.w) * uu.w);
                            pk.z = cvtpk(siluf_(g2.x) * u2.x, siluf_(g2.y) * u2.y); pk.w = cvtpk(siluf_(g2.z) * u2.z, siluf_(g2.w) * u2.w);
                            *(u32x4*)(hidR + rl * 256 + t * 128 + wn * 64 + j2 * 32 + 8 * fq) = pk; } } }
            } f{h2, pairs, (const bf16_t*)(P.ws + WS_WBGU) + (size_t)e * 1024 * 512, hidR};
            G::run_stream(f, 2, 32, 32, (size_t)32 * 512, lds);
        }
        __syncthreads();
        {
            struct DN { bf16_t* hidR; const bf16_t* wd; unsigned char* y; LAS int* pairs; LAS float* wts; int rows;
                __device__ __forceinline__ void ptrs(int ct, const bf16_t* (&aptr)[2], const bf16_t* (&bptr)[2]) const {
                    const int tid = opaque_tid(), lane = tid & 63, wid = tid >> 6, wm = wid >> 1, wn = wid & 1, fr = lane & 15, fq = lane >> 4, c8 = 8 * (tid & 31); (void)wm; (void)wn; (void)fr; (void)fq; (void)c8;
#pragma unroll
                    for (int i = 0; i < 2; ++i) { const int row = G::a_row(i, wid, lane); aptr[i] = hidR + (size_t)row * 256 + G::a_chunk(row, lane) * 8;
                        const int k = G::b_k(i, wid, lane); bptr[i] = wd + (size_t)k * 1024 + ct * 256 + G::b_n(k, lane); } }
                __device__ __forceinline__ void epi(int ct, f32x4 (&acc)[4][8]) const {
                    const int tid = opaque_tid(), lane = tid & 63, wid = tid >> 6, wm = wid >> 1, wn = wid & 1, fr = lane & 15, fq = lane >> 4, c8 = 8 * (tid & 31); (void)wm; (void)wn; (void)fr; (void)fq; (void)c8;
#pragma unroll
                    for (int mi = 0; mi < 4; ++mi) { const int rl = wm * 64 + mi * 16 + fr; const float wgt = wts[rl]; const size_t pr = (size_t)pairs[rl];
                        if (rl < rows) {
#pragma unroll
                            for (int j2 = 0; j2 < 2; ++j2) { const int col = ct * 256 + wn * 128 + 64 * j2 + 16 * fq; const float sc_ = wgt * Y_SCALE; u32x4 w;
#pragma unroll
                                for (int b2 = 0; b2 < 4; ++b2) { const f32x4 a = acc[mi][4 * j2 + b2] * sc_;
                                    int pk = __builtin_amdgcn_cvt_pk_fp8_f32(a.x, a.y, 0, false); pk = __builtin_amdgcn_cvt_pk_fp8_f32(a.z, a.w, pk, true); w[b2] = (unsigned)pk; }
                                *(u32x4*)(y + pr * 1024 + col) = w; } } } }
            } f{hidR, (const bf16_t*)(P.ws + WS_WBD) + (size_t)e * 256 * 1024, y, pairs, wts, rows};
            G::run_stream(f, 4, 8, 32, (size_t)32 * 1024, lds);
        }
        __syncthreads();
    }
}


__device__ __forceinline__ void phase_expert_cvt8(const Params& P) {
    const int tid = opaque_tid(), lane = tid & 63, gw = blockIdx.x * (NTHREADS / 64) + (tid >> 6), NGW = gridDim.x * (NTHREADS / 64);
    unsigned char* wgu = (unsigned char*)(P.ws + WS_W8GU); unsigned char* wd = (unsigned char*)(P.ws + WS_W8D);
    for (int u = gw; u < 256 * 8 * 8; u += NGW) {
        const int rg = u & 7, kb = (u >> 3) & 7, e = u >> 6;
        const int q = rg * 64 + lane, t = q >> 8, ql = q & 255, wnn = ql >> 7, it = (ql >> 5) & 3, i = ql & 31;
        const int h = t * 128 + wnn * 64 + (it >> 1) * 32 + Gemm8::w_col(i);
        const float* s = ((it & 1) ? P.exp_wu : P.exp_wg) + (size_t)e * 1024 * 256 + (size_t)(kb * 128) * 256 + h;
        unsigned char* o = wgu + ((size_t)e * 512 + q) * 1024 + kb * 128;
        { float v[128];
#pragma unroll
            for (int j = 0; j < 128; ++j) v[j] = __builtin_nontemporal_load(s + (size_t)j * 256);
#pragma unroll
            for (int j = 0; j < 8; ++j) { const float c_ = W8_GU_SCALE; u32x4 w;
                w.x = pk4_fp8(v[16 * j] * c_, v[16 * j + 1] * c_, v[16 * j + 2] * c_, v[16 * j + 3] * c_); w.y = pk4_fp8(v[16 * j + 4] * c_, v[16 * j + 5] * c_, v[16 * j + 6] * c_, v[16 * j + 7] * c_);
                w.z = pk4_fp8(v[16 * j + 8] * c_, v[16 * j + 9] * c_, v[16 * j + 10] * c_, v[16 * j + 11] * c_); w.w = pk4_fp8(v[16 * j + 12] * c_, v[16 * j + 13] * c_, v[16 * j + 14] * c_, v[16 * j + 15] * c_);
                *(u32x4*)(o + j * 16) = w; } }
    }
    for (int u = gw; u < 256 * 2 * 16; u += NGW) {
        const int rg = u & 15, kb = (u >> 4) & 1, e = u >> 5;
        const int q = rg * 64 + lane, i = q & 31;
        const int col = (q & ~31) + Gemm8::w_col(i);
        const float* s = P.exp_wd + (size_t)e * 256 * 1024 + (size_t)(kb * 128) * 1024 + col;
        unsigned char* o = wd + ((size_t)e * 1024 + q) * 256 + kb * 128;
        { float v[128];
#pragma unroll
            for (int j = 0; j < 128; ++j) v[j] = __builtin_nontemporal_load(s + (size_t)j * 1024);
#pragma unroll
            for (int j = 0; j < 8; ++j) { const float c_ = W8_D_SCALE; u32x4 w;
                w.x = pk4_fp8(v[16 * j] * c_, v[16 * j + 1] * c_, v[16 * j + 2] * c_, v[16 * j + 3] * c_); w.y = pk4_fp8(v[16 * j + 4] * c_, v[16 * j + 5] * c_, v[16 * j + 6] * c_, v[16 * j + 7] * c_);
                w.z = pk4_fp8(v[16 * j + 8] * c_, v[16 * j + 9] * c_, v[16 * j + 10] * c_, v[16 * j + 11] * c_); w.w = pk4_fp8(v[16 * j + 12] * c_, v[16 * j + 13] * c_, v[16 * j + 14] * c_, v[16 * j + 15] * c_);
                *(u32x4*)(o + j * 16) = w; } }
    }
}

template <int PM> __device__ __forceinline__ void phase_experts8(const Params& P, LAS unsigned char* lds) {
    typedef Gemm8 G;
    const int tid = opaque_tid();
    const int* cnt = (const int*)(P.ws + WS_CTL + CTL_CNT); const int* bucket = (const int*)(P.ws + WS_BUCKET); const float* rw = (const float*)(P.ws + WS_RW);
    const unsigned char* h2q = (const unsigned char*)(P.ws + WS_H2Q); unsigned char* hidR = (unsigned char*)(P.ws + WS_HIDR) + (size_t)blockIdx.x * 256 * 256; unsigned char* y = (unsigned char*)(P.ws + WS_Y);
    LAS int* tiles = (LAS int*)(lds + P6_TILES); LAS int* pre = (LAS int*)(lds + P6_PRE); LAS int* pairs = (LAS int*)(lds + P6_PAIR); LAS float* wts = (LAS float*)(lds + P6_W);
    const int nx = (gridDim.x % 8 == 0) ? 8 : 1, xl = blockIdx.x % nx, li = blockIdx.x / nx, nloc = gridDim.x / nx, nek = 256 / nx;
    if (tid < nek) { const int c_ = cnt[xl + nx * tid]; tiles[tid] = ((c_ < BCAP ? c_ : BCAP) + 255) >> 8; }
    __syncthreads();
    if (tid < nek) { int s = 0; for (int i = 0; i < tid; ++i) s += tiles[i]; pre[tid] = s; if (tid == nek - 1) pre[nek] = s + tiles[nek - 1]; }
    __syncthreads();
    const int total = pre[nek];
    for (int u = li; u < total; u += nloc) {
        int lo = 0, hi_ = nek - 1;
        while (lo < hi_) { const int mid = (lo + hi_ + 1) >> 1; if (pre[mid] <= u) lo = mid; else hi_ = mid - 1; }
        const int e = xl + nx * lo, tile = u - pre[lo], n = cnt[e] < BCAP ? cnt[e] : BCAP, rows = (n - tile * 256) < 256 ? (n - tile * 256) : 256;
        if (tid < 256) { const int r = tid < rows ? tid : 0; const int pr = bucket[(size_t)e * BCAP + tile * 256 + r]; pairs[tid] = pr; wts[tid] = tid < rows ? rw[pr] : 0.f; }
        __syncthreads();
        {
            struct GU { const unsigned char* h2q; LAS int* pairs; const unsigned char* wgu; unsigned char* hidR;
                static __device__ __forceinline__ int wscale(int it) { return (it & 1) ? 123 : 121; }
                __device__ __forceinline__ void ptrs(int t, const unsigned char* (&aptr)[2], const unsigned char* (&wptr)[2]) const {
                    const int tid = opaque_tid(), lane = tid & 63, wid = tid >> 6;
#pragma unroll
                    for (int i = 0; i < 2; ++i) { const int row = G::t_row(i, wid, lane); aptr[i] = h2q + (size_t)(pairs[row] >> 3) * 1024 + G::t_chunk(row, lane) * 16;
                        wptr[i] = wgu + (size_t)(t * 256 + row) * 1024 + G::t_chunk(row, lane) * 16; } }
                __device__ __forceinline__ void epi(int t, f32x16 (&acc)[2][4]) const {
                    const int tid = opaque_tid(), lane = tid & 63, wid = tid >> 6, wm = wid >> 1, wn = wid & 1, l31 = lane & 31, hi = lane >> 5;
                    if (PM == 2) return;
#pragma unroll
                    for (int jt = 0; jt < 2; ++jt) { const int rl = wm * 64 + jt * 32 + l31;
#pragma unroll
                        for (int p = 0; p < 2; ++p) {
                            float e[16], hv[16];
#pragma unroll
                            for (int r = 0; r < 16; ++r) e[r] = __builtin_amdgcn_exp2f(acc[jt][2 * p][r] * -LOG2E);
                            __builtin_amdgcn_sched_barrier(0);
#pragma unroll
                            for (int r = 0; r < 16; ++r) { e[r] = __builtin_amdgcn_rcpf(1.0f + e[r]); hv[r] = acc[jt][2 * p][r] * acc[jt][2 * p + 1][r]; }
                            __builtin_amdgcn_sched_barrier(0);
                            u32x4 w;
#pragma unroll
                            for (int q4 = 0; q4 < 4; ++q4) w[q4] = pk4_fp8(hv[4 * q4] * e[4 * q4], hv[4 * q4 + 1] * e[4 * q4 + 1], hv[4 * q4 + 2] * e[4 * q4 + 2], hv[4 * q4 + 3] * e[4 * q4 + 3]);
                            *(u32x4*)(hidR + rl * 256 + t * 128 + wn * 64 + p * 32 + 16 * hi) = w; } } }
            } f{h2q, pairs, (const unsigned char*)(P.ws + WS_W8GU) + (size_t)e * 512 * 1024, hidR};
            if (PM != 3) G::run_stream(f, 2, 16, lds);
        }
        __syncthreads();
        {
            struct DN { const unsigned char* hidR; const unsigned char* wd; unsigned char* y; LAS int* pairs; LAS float* wts; int rows;
                static __device__ __forceinline__ int wscale(int) { return 120; }
                __device__ __forceinline__ void ptrs(int ct, const unsigned char* (&aptr)[2], const unsigned char* (&wptr)[2]) const {
                    const int tid = opaque_tid(), lane = tid & 63, wid = tid >> 6;
#pragma unroll
                    for (int i = 0; i < 2; ++i) { const int row = G::t_row(i, wid, lane); aptr[i] = hidR + (size_t)row * 256 + G::t_chunk(row, lane) * 16;
                        wptr[i] = wd + (size_t)(ct * 256 + row) * 256 + G::t_chunk(row, lane) * 16; } }
                __device__ __forceinline__ void epi(int ct, f32x16 (&acc)[2][4]) const {
                    const int tid = opaque_tid(), lane = tid & 63, wid = tid >> 6, wm = wid >> 1, wn = wid & 1, l31 = lane & 31, hi = lane >> 5;
                    if (PM == 3) return;
#pragma unroll
                    for (int jt = 0; jt < 2; ++jt) { const int rl = wm * 64 + jt * 32 + l31; const float sc_ = wts[rl] * Y_SCALE; const size_t pr = (size_t)pairs[rl];
                        if (rl < rows) {
#pragma unroll
                            for (int it = 0; it < 4; ++it) { u32x4 w;
#pragma unroll
                                for (int q4 = 0; q4 < 4; ++q4) w[q4] = pk4_fp8(acc[jt][it][4 * q4] * sc_, acc[jt][it][4 * q4 + 1] * sc_, acc[jt][it][4 * q4 + 2] * sc_, acc[jt][it][4 * q4 + 3] * sc_);
                                *(u32x4*)(y + pr * 1024 + ct * 256 + wn * 128 + it * 32 + 16 * hi) = w; } } } }
            } f{hidR, (const unsigned char*)(P.ws + WS_W8D) + (size_t)e * 1024 * 256, y, pairs, wts, rows};
            if (PM == 0 || PM == 3) G::run_stream(f, 4, 4, lds);
        }
        __syncthreads();
    }
}

__device__ __forceinline__ void phase_combine(const Params& P) {
    const int lane = threadIdx.x & 63, gw = blockIdx.x * (NTHREADS / 64) + (threadIdx.x >> 6), NGW = gridDim.x * (NTHREADS / 64);
    const unsigned char* y = (const unsigned char*)(P.ws + WS_Y);
    typedef float f32x2_ __attribute__((ext_vector_type(2)));
    for (int m = gw; m < T; m += NGW) {
        const float* mod = (const float*)(P.ws + WS_MOD) + (m / SEQ) * 6144 + 5120;
#pragma unroll
        for (int j = 0; j < 2; ++j) { const int col = (lane + 64 * j) * 8;
            f32x4 s0 = (f32x4){0.f, 0.f, 0.f, 0.f}, s1 = s0;
#pragma unroll
            for (int sl = 0; sl < 9; ++sl) { const u32x2 v = sl < 8 ? *(const u32x2*)(y + ((size_t)m * 8 + sl) * 1024 + col) : *(const u32x2*)((const unsigned char*)(P.ws + WS_YSH) + (size_t)m * 1024 + col);
                const f32x2_ a = __builtin_amdgcn_cvt_pk_f32_fp8((int)v.x, false), b = __builtin_amdgcn_cvt_pk_f32_fp8((int)v.x, true);
                const f32x2_ c = __builtin_amdgcn_cvt_pk_f32_fp8((int)v.y, false), d = __builtin_amdgcn_cvt_pk_f32_fp8((int)v.y, true);
                s0.x += a.x; s0.y += a.y; s0.z += b.x; s0.w += b.y; s1.x += c.x; s1.y += c.y; s1.z += d.x; s1.w += d.y; }
            const f32x4 g0 = *(const f32x4*)(mod + col), g1 = *(const f32x4*)(mod + col + 4);
            const u32x4 xr = *(const u32x4*)((const bf16_t*)(P.ws + WS_X1) + (size_t)m * 1024 + col);
            f32x4 o0 = (f32x4){__uint_as_float(xr.x << 16), __uint_as_float(xr.x & 0xffff0000u), __uint_as_float(xr.y << 16), __uint_as_float(xr.y & 0xffff0000u)};
            f32x4 o1 = (f32x4){__uint_as_float(xr.z << 16), __uint_as_float(xr.z & 0xffff0000u), __uint_as_float(xr.w << 16), __uint_as_float(xr.w & 0xffff0000u)};
            o0 += g0 * (s0 * Y_INV); o1 += g1 * (s1 * Y_INV);
            *(f32x4*)(P.out + (size_t)m * 1024 + col) = o0; *(f32x4*)(P.out + (size_t)m * 1024 + col + 4) = o1; }
    }
}


__device__ __forceinline__ int queue_pull(unsigned* head, volatile LAS unsigned* slot) {
    if (threadIdx.x == 0) *slot = atomicAdd(head, 1u);
    __syncthreads();
    const int v = (int)*slot;
    __syncthreads();
    return v;
}
__device__ __forceinline__ void phase_cmp_h1(const Params& P, LAS unsigned char* lds, volatile LAS unsigned* slot) {
    unsigned* head = (unsigned*)(P.ws + WS_CTL + CTL_Q2);
    for (;;) {
        const int u = queue_pull(head, slot);
        if (u >= 64 + 512) break;
        if (u < 64) compress_unit(P, lds, u); else hgrn_unit<0>(P, lds, u - 64);
    }
}
__device__ __forceinline__ void phase_h23_nsa(const Params& P, LAS unsigned char* lds, volatile LAS unsigned* slot) {
    unsigned* head = (unsigned*)(P.ws + WS_CTL + CTL_Q3);
    for (;;) {
        const int n = queue_pull(head, slot);
        if (n >= 1536) break;
        if (n < 512) nsa_unit(P, lds, (n & 7) * 128 + (127 - (n >> 3)));
        else if (n < 1024) { const int m = n - 512; hgrn_unit<1>(P, lds, (m & 15) * 32 + (31 - (m >> 4))); }
        else { const int m = n - 1024; nsa_unit(P, lds, (m & 7) * 128 + (63 - (m >> 3))); }
    }
}

constexpr int LDS_BYTES = 144 * 1024;
__global__ void __launch_bounds__(NTHREADS) mega(Params P) {
    extern __shared__ __attribute__((aligned(16))) unsigned char smem[];
    LAS unsigned char* lds = (LAS unsigned char*)smem;
    volatile LAS unsigned* xst = (volatile LAS unsigned*)(lds + LDS_BYTES - 16);
    if (threadIdx.x < 4) xst[threadIdx.x] = 0u;
    __syncthreads();
    XcdBarrier xb = xcd_barrier_post((unsigned*)(P.ws + WS_CTL + CTL_BAR), xst);
    phase_mod(P, lds);
    xcd_barrier(xb);
    { const float* mod = (const float*)(P.ws + WS_MOD); norm_mod_rows(P.x, P.norm1_w, mod, mod + 1024, (unsigned char*)(P.ws + WS_H), H1S); }
    xcd_barrier(xb);
    phase_inproj(P, lds);
    xcd_barrier(xb);
    phase_cmp_h1(P, lds, xst + 2);
    xcd_barrier(xb);
    phase_h23_nsa(P, lds, xst + 2);
    phase_cvt_small(P);
    xcd_barrier(xb);
    phase_p4a(P, lds);
    xcd_barrier(xb);
    phase_p4b(P);
    xcd_barrier(xb);
    phase_p4c(P, lds);
    xcd_barrier(xb);
    phase_route(P);
    phase_p4d(P, lds);
    xcd_barrier(xb);
    phase_expert_cvt8(P);
    xcd_barrier(xb);
    phase_experts8<0>(P, lds);
    xcd_barrier(xb);
    phase_combine(P);
}

extern "C" void kernel_launch(void* const* d_in, const int* in_sizes, int n_in, void* d_out, int out_size, void* d_ws, size_t ws_size, hipStream_t stream) {
    static int grid = 0;
    if (grid == 0) {
        if (n_in != 25 || ws_size < WS_END) { fprintf(stderr, "kernel_launch: unexpected n_in %d or ws_size %zu (need %zu)\n", n_in, ws_size, (size_t)WS_END); grid = -1; return; }
        int dev = 0, cus = 0, per_cu = 0;
        (void)hipGetDevice(&dev); (void)hipDeviceGetAttribute(&cus, hipDeviceAttributeMultiprocessorCount, dev);
        (void)hipFuncSetAttribute((const void*)mega, hipFuncAttributeMaxDynamicSharedMemorySize, LDS_BYTES);
        (void)hipOccupancyMaxActiveBlocksPerMultiprocessor(&per_cu, (const void*)mega, NTHREADS, LDS_BYTES);
        if (per_cu < 1) { fprintf(stderr, "kernel_launch: occupancy query says %d blocks per CU\n", per_cu); grid = -1; return; }
        grid = cus;
    }
    if (grid < 0) return;
    (void)hipMemsetAsync((char*)d_ws + WS_CTL, 0, 64 * 1024, stream);
    Params p{};
    const float** pf = (const float**)&p;
    for (int i = 0; i < 25; ++i) pf[i] = (const float*)d_in[i];
    p.out = (float*)d_out; p.ws = (unsigned char*)d_ws;
    void* args[] = {&p};
    hipError_t e = hipLaunchCooperativeKernel((const void*)mega, dim3(grid), dim3(NTHREADS), args, LDS_BYTES, stream);
    if (e != hipSuccess) fprintf(stderr, "cooperative launch failed: %s (grid %d)\n", hipGetErrorString(e), grid);
}

#ifdef PHASE_TEST
__global__ void __launch_bounds__(NTHREADS) t_p4a(Params P) { extern __shared__ __attribute__((aligned(16))) unsigned char smem[]; phase_p4a(P, (LAS unsigned char*)smem); }
__global__ void __launch_bounds__(NTHREADS) t_p4d(Params P) { extern __shared__ __attribute__((aligned(16))) unsigned char smem[]; phase_p4d(P, (LAS unsigned char*)smem); }
__global__ void __launch_bounds__(NTHREADS) t_p4(Params P) { extern __shared__ __attribute__((aligned(16))) unsigned char smem[]; phase_p4c(P, (LAS unsigned char*)smem); }
__global__ void __launch_bounds__(NTHREADS) t_p6(Params P) { extern __shared__ __attribute__((aligned(16))) unsigned char smem[]; phase_experts(P, (LAS unsigned char*)smem); }
__global__ void __launch_bounds__(NTHREADS) t_nsa(Params P) { extern __shared__ __attribute__((aligned(16))) unsigned char smem[]; nsa_unit(P, (LAS unsigned char*)smem, blockIdx.x); }
__global__ void __launch_bounds__(NTHREADS) t_mod(Params P) { extern __shared__ __attribute__((aligned(16))) unsigned char smem[]; phase_mod(P, (LAS unsigned char*)smem); }
__global__ void __launch_bounds__(NTHREADS) t_inproj(Params P) { extern __shared__ __attribute__((aligned(16))) unsigned char smem[]; phase_inproj(P, (LAS unsigned char*)smem); }
__global__ void __launch_bounds__(NTHREADS) t_cmp(Params P) { extern __shared__ __attribute__((aligned(16))) unsigned char smem[]; compress_unit(P, (LAS unsigned char*)smem, blockIdx.x); }
__global__ void __launch_bounds__(NTHREADS) t_h0(Params P) { extern __shared__ __attribute__((aligned(16))) unsigned char smem[]; hgrn_unit<0>(P, (LAS unsigned char*)smem, blockIdx.x); }
__global__ void __launch_bounds__(NTHREADS) t_h1(Params P) { extern __shared__ __attribute__((aligned(16))) unsigned char smem[]; hgrn_unit<1>(P, (LAS unsigned char*)smem, blockIdx.x); }
#endif
```

```cpp
#include <hip/hip_runtime.h>
#include <hip/hip_cooperative_groups.h>
#include <cstdio>
#include <cstdint>
#include <type_traits>
namespace cg = cooperative_groups;

#define LAS __attribute__((address_space(3)))
typedef unsigned short bf16_t;
typedef short bf16x8 __attribute__((ext_vector_type(8)));
typedef short s16x4 __attribute__((ext_vector_type(4)));
typedef float f32x4 __attribute__((ext_vector_type(4)));
typedef float f32x16 __attribute__((ext_vector_type(16)));
typedef unsigned u32x4 __attribute__((ext_vector_type(4)));
typedef unsigned u32x2 __attribute__((ext_vector_type(2)));

constexpr int D = 1024, BATCH = 4, SEQ = 8192, T = BATCH * SEQ;
constexpr int IN_COLS = 3352;
constexpr int NTHREADS = 512;
constexpr int H1S = 1088;
constexpr float RMS_EPS = 1e-6f;
constexpr float LOG2E = 1.4426950408889634f;
constexpr float Y_SCALE = 16.0f, Y_INV = 1.0f / 16.0f;

constexpr size_t MB = 1024ull * 1024ull;
constexpr size_t WS_CTL    = 0;
constexpr size_t WS_MOD    = 64 * 1024;
constexpr size_t WS_LB     = WS_MOD + 4 * 6144 * 4;
constexpr size_t WS_CB     = WS_LB + 2048;
constexpr size_t WS_H      = 1 * MB;
constexpr size_t WS_SS     = WS_H + 72 * MB;
constexpr size_t WS_RW     = WS_SS + 1 * MB;
constexpr size_t WS_BUCKET = WS_RW + 1 * MB;
constexpr size_t WS_HIDR   = WS_BUCKET + 16 * MB;
constexpr size_t WS_WSM    = WS_HIDR + 32 * MB;
constexpr size_t WS_WOUT   = WS_WSM, WS_WRS = WS_WSM + 2 * MB, WS_WSD = WS_WSM + 4 * MB;
constexpr size_t WS_WBE    = WS_WSM + 5 * MB;
constexpr size_t WS_WBGU   = WS_WBE, WS_WBD = WS_WBE + 256 * MB;
constexpr size_t WS_W8GU   = WS_WBE, WS_W8D = WS_WBE + 128 * MB, WS_H2Q = WS_WBE + 256 * MB;
constexpr size_t WS_X1     = WS_WBE + 192 * MB;
constexpr float W8_GU_SCALE = 64.0f, W8_D_SCALE = 32.0f, HID8_SCALE = 4.0f;
constexpr size_t WS_SCORES = WS_WBE;
constexpr size_t WS_HIDS   = WS_SCORES + 32 * MB;
constexpr size_t WS_WIN    = WS_HIDS + 16 * MB;
constexpr size_t WS_Y      = WS_WBE + 384 * MB;
constexpr size_t WS_Q      = WS_Y;
constexpr size_t WS_KV     = WS_Q + 32 * MB;
constexpr size_t WS_GATES  = WS_KV + 48 * MB;
constexpr size_t WS_HQ     = WS_GATES + 4 * MB;
constexpr size_t WS_LOGF   = WS_HQ + 32 * MB;
constexpr size_t WS_HV     = WS_LOGF + 64 * MB;
constexpr size_t WS_HG     = WS_HV + 32 * MB;
constexpr size_t WS_CMPH   = WS_HG + 32 * MB;
constexpr size_t WS_KC     = WS_CMPH + 4 * MB;
constexpr size_t WS_VC     = WS_KC + 1 * MB;
constexpr size_t WS_HL     = WS_VC + 1 * MB;
constexpr size_t WS_HD     = WS_HL + 32 * MB;
constexpr size_t WS_MIX    = WS_HD + 1 * MB;
constexpr size_t WS_YSH    = WS_Y + 384 * MB;
constexpr size_t WS_END    = WS_YSH + 64 * MB;
constexpr int BCAP = 16384;
constexpr int CTL_CNT = 1024;
constexpr int CTL_Q2 = 2048, CTL_Q3 = 2112;
constexpr int CTL_BAR = 16384;

struct Params {
    const float *x, *c, *ada_w, *ada_b, *norm1_w, *norm2_w, *w_in, *q_norm_w, *k_norm_w, *cmp_pos, *cmp_w1, *cmp_b1, *cmp_w2,
        *attn_out_norm_w, *hgrn_lb, *rec_out_norm_w, *w_out, *router_w, *router_bias, *exp_wg, *exp_wu, *exp_wd, *sh_wg, *sh_wu, *sh_wd;
    float* out;
    unsigned char* ws;
};

typedef __bf16 bf16x2_t __attribute__((ext_vector_type(2)));
typedef int i32x8 __attribute__((ext_vector_type(8)));
__device__ __forceinline__ unsigned cvtpk(float lo, float hi) { bf16x2_t v; v.x = (__bf16)lo; v.y = (__bf16)hi; return __builtin_bit_cast(unsigned, v); }
__device__ __forceinline__ int opaque_tid() { int t = threadIdx.x; asm volatile("" : "+v"(t)); return t; }
__device__ __forceinline__ float bf2f(bf16_t v) { return __uint_as_float(((unsigned)v) << 16); }
__device__ __forceinline__ float sigmoidf_(float v) { return __builtin_amdgcn_rcpf(1.0f + __expf(-v)); }
__device__ __forceinline__ float siluf_(float v) { return v * __builtin_amdgcn_rcpf(1.0f + __expf(-v)); }
__device__ __forceinline__ float wave_sum(float v) {
#pragma unroll
    for (int o = 1; o < 64; o <<= 1) v += __shfl_xor(v, o);
    return v;
}
__device__ __forceinline__ s16x4 lds_tr(const LAS unsigned char* p) {
    return __builtin_bit_cast(s16x4, __builtin_amdgcn_ds_read_tr16_b64_v4i16((LAS s16x4*)p));
}

#define XB_TMO      128
#define XB_XCNT(j)  (256  + 64 * (j))
#define XB_XSUB(j)  (1280 + 64 * (j))
#define XB_XGEN(j)  (2304 + 64 * (j))
#define XB_TOP      3328
#define XB_TOPGEN   3392
#define XCD_BAR_WORDS 3456
#define XB_SPIN_CAP (1u << 22)
__device__ __forceinline__ unsigned xb_ld(unsigned* p)              { return __hip_atomic_load(p, __ATOMIC_RELAXED, __HIP_MEMORY_SCOPE_AGENT); }
__device__ __forceinline__ unsigned xb_add(unsigned* p, unsigned v) { return __hip_atomic_fetch_add(p, v, __ATOMIC_RELAXED, __HIP_MEMORY_SCOPE_AGENT); }
__device__ __forceinline__ unsigned xb_xcc_id() { return (unsigned)__builtin_amdgcn_s_getreg((3 << 11) | 20) & 0xFu; }
#define XB_SPIN(cond, bar) do { unsigned _sp = 0; while (cond) { __builtin_amdgcn_s_sleep(1); \
    if ((++_sp & 255u) == 0u) { if (xb_ld(&(bar)[XB_TMO])) break; if (_sp > XB_SPIN_CAP) { atomicAdd(&(bar)[XB_TMO], 1u); break; } } } } while (0)
struct XcdBarrier { unsigned* bar; unsigned x; volatile LAS unsigned* st; };
__device__ __forceinline__ XcdBarrier xcd_barrier_post(unsigned* bar, volatile LAS unsigned* st) {
    XcdBarrier b; b.bar = bar; b.x = xb_xcc_id(); b.st = st;
    if (threadIdx.x == 0) (void)xb_add(&bar[XB_XCNT(b.x)], 1u);
    return b;
}
__device__ __forceinline__ void xcd_barrier_complete(unsigned* bar, unsigned x, unsigned& nloc, unsigned& nx) {
    const unsigned G = gridDim.x * gridDim.y * gridDim.z;
    unsigned sum, cnt, mine, sp = 0u;
    for (;;) {
        sum = 0u; cnt = 0u; mine = 0u;
#pragma unroll
        for (unsigned j = 0; j < 16; ++j) { const unsigned c = xb_ld(&bar[XB_XCNT(j)]); sum += c; cnt += (c > 0u) ? 1u : 0u; mine = (j == x) ? c : mine; }
        if (sum == G) break;
        __builtin_amdgcn_s_sleep(1);
        if ((++sp & 255u) == 0u) { if (xb_ld(&bar[XB_TMO])) break; if (sp > XB_SPIN_CAP) { atomicAdd(&bar[XB_TMO], 1u); break; } }
    }
    nloc = mine > 0u ? mine : 1u; nx = cnt > 0u ? cnt : 1u;
}
__device__ __forceinline__ void xcd_barrier(const XcdBarrier& b) {
    asm volatile("s_waitcnt vmcnt(0)" ::: "memory");
    __syncthreads();
    if (threadIdx.x == 0) {
        unsigned* bar = b.bar;
        __builtin_amdgcn_s_waitcnt(0);
        unsigned nloc = b.st[0], nx = b.st[1];
        if (nloc == 0u) { xcd_barrier_complete(bar, b.x, nloc, nx); b.st[0] = nloc; b.st[1] = nx; }
        const unsigned old = xb_add(&bar[XB_XSUB(b.x)], 1u);
        const unsigned gen = old / nloc;
        if (old + 1u == (gen + 1u) * nloc) {
            __builtin_amdgcn_fence(__ATOMIC_RELEASE, "agent");
            asm volatile("s_waitcnt vmcnt(0)" ::: "memory");
            const unsigned og = xb_add(&bar[XB_TOP], 1u);
            const unsigned tg = og / nx;
            if (og + 1u == (tg + 1u) * nx) xb_add(&bar[XB_TOPGEN], 1u);
            else XB_SPIN(xb_ld(&bar[XB_TOPGEN]) == tg, bar);
            __builtin_amdgcn_fence(__ATOMIC_ACQUIRE, "agent");
            xb_add(&bar[XB_XGEN(b.x)], 1u);
            asm volatile("s_waitcnt vmcnt(0)" ::: "memory");
        } else {
            XB_SPIN(xb_ld(&bar[XB_XGEN(b.x)]) == gen, bar);
            __builtin_amdgcn_fence(__ATOMIC_ACQUIRE, "agent");
            asm volatile("s_waitcnt vmcnt(0)" ::: "memory");
        }
    }
    __syncthreads();
}

template <int WM, int WN> struct GemmT {
    static constexpr int BM = 64 * WM, BN = 64 * WN;
    static constexpr int A_BYTES = BM * 128, B_BYTES = 64 * BN * 2, STAGE = A_BYTES + B_BYTES, LDS_BYTES = 2 * STAGE;
    static constexpr int NB4 = BN / 32;
    static constexpr int B_ROW4 = BN / 4;

    static __device__ __forceinline__ void run(f32x4 (&acc)[4][4], const bf16_t* const (&arow)[WM], int a_kstride, const float* Bp, int ldb, int KT, LAS unsigned char* lds) {
        const int tid = opaque_tid(), lane = tid & 63, wid = tid >> 6, wm = wid / WN, wn = wid % WN, fr = lane & 15, fq = lane >> 4;
#pragma unroll
        for (int mi = 0; mi < 4; ++mi)
#pragma unroll
            for (int ni = 0; ni < 4; ++ni) acc[mi][ni] = (f32x4){0.f, 0.f, 0.f, 0.f};
        const int achunk = tid & 7;
        u32x4 areg[WM]; f32x4 breg[NB4];
        int a_wr[WM];
#pragma unroll
        for (int p = 0; p < WM; ++p) { const int row = p * 64 + (tid >> 3); a_wr[p] = row * 128 + ((achunk ^ ((row >> 1) & 7)) << 4); }
        int b_wr[NB4]; int b_goff[NB4];
#pragma unroll
        for (int p = 0; p < NB4; ++p) { const int i = tid + NTHREADS * p, k = i / B_ROW4, n = (i % B_ROW4) * 4;
            const int f = (k & 3) | (((k >> 3) & 1) << 2);
            b_wr[p] = A_BYTES + k * (BN * 2) + (((n >> 4) ^ f) << 5) + ((n & 15) << 1); b_goff[p] = k * ldb + n; }
        int a_rd[4][2];
#pragma unroll
        for (int mi = 0; mi < 4; ++mi)
#pragma unroll
            for (int ks = 0; ks < 2; ++ks) { const int row = wm * 64 + mi * 16 + fr, ch = ks * 4 + fq; a_rd[mi][ks] = row * 128 + ((ch ^ ((row >> 1) & 7)) << 4); }
        int b_rd[2][2];
        int b_f[2][2];
#pragma unroll
        for (int ks = 0; ks < 2; ++ks)
#pragma unroll
            for (int t = 0; t < 2; ++t) { const int k = ks * 32 + 8 * fq + 4 * t + (fr >> 2); b_f[ks][t] = (k & 3) | (((k >> 3) & 1) << 2);
                b_rd[ks][t] = A_BYTES + k * (BN * 2) + ((fr & 3) << 3); }

        auto gload = [&](int kt) {
#pragma unroll
            for (int p = 0; p < WM; ++p) areg[p] = *(const u32x4*)(arow[p] + (size_t)kt * a_kstride + achunk * 8);
            const float* bk = Bp + (size_t)kt * 64 * ldb;
#pragma unroll
            for (int p = 0; p < NB4; ++p) breg[p] = *(const f32x4*)(bk + b_goff[p]);
        };
        auto lstore = [&](int buf) {
            LAS unsigned char* base = lds + buf * STAGE;
#pragma unroll
            for (int p = 0; p < WM; ++p) *(LAS u32x4*)(base + a_wr[p]) = areg[p];
#pragma unroll
            for (int p = 0; p < NB4; ++p) { u32x2 w; w.x = cvtpk(breg[p].x, breg[p].y); w.y = cvtpk(breg[p].z, breg[p].w); *(LAS u32x2*)(base + b_wr[p]) = w; }
        };
        gload(0); lstore(0); __syncthreads();
        for (int kt = 0; kt < KT; ++kt) {
            if (kt + 1 < KT) gload(kt + 1);
            __builtin_amdgcn_sched_barrier(0);
            const LAS unsigned char* base = lds + (kt & 1) * STAGE;
#pragma unroll
            for (int ks = 0; ks < 2; ++ks) {
                bf16x8 af[4], bfr[4];
#pragma unroll
                for (int mi = 0; mi < 4; ++mi) af[mi] = *(const LAS bf16x8*)(base + a_rd[mi][ks]);
#pragma unroll
                for (int ni = 0; ni < 4; ++ni) {
                    const int u0 = wn * 4 + ni;
                    const s16x4 lo = lds_tr(base + b_rd[ks][0] + ((u0 ^ b_f[ks][0]) << 5));
                    const s16x4 hi = lds_tr(base + b_rd[ks][1] + ((u0 ^ b_f[ks][1]) << 5));
                    bfr[ni] = (bf16x8){lo[0], lo[1], lo[2], lo[3], hi[0], hi[1], hi[2], hi[3]};
                }
#pragma unroll
                for (int mi = 0; mi < 4; ++mi)
#pragma unroll
                    for (int ni = 0; ni < 4; ++ni) acc[mi][ni] = __builtin_amdgcn_mfma_f32_16x16x32_bf16(bfr[ni], af[mi], acc[mi][ni], 0, 0, 0);
            }
            if (kt + 1 < KT) lstore((kt + 1) & 1);
            __syncthreads();
        }
    }
};

struct Gemm2 {
    static constexpr int A_BYTES = 32768, STAGE = 65536, LDS_BYTES = 2 * STAGE;
    static __device__ __forceinline__ int a_row(int i, int w, int lane) { return (i * 8 + w) * 8 + (lane >> 3); }
    static __device__ __forceinline__ int a_chunk(int row, int lane) { return (lane & 7) ^ ((row >> 1) & 7); }
    static __device__ __forceinline__ int b_k(int i, int w, int lane) { return (i * 8 + w) * 2 + (lane >> 5); }
    static __device__ __forceinline__ int b_n(int k, int lane) { return ((((lane & 31) >> 1) ^ fk2(k)) << 4) + ((lane & 1) << 3); }
    static __device__ __forceinline__ int fk2(int r) { return (r & 3) | (((r >> 3) & 1) << 2); }

    static __device__ __forceinline__ void run(f32x4 (&acc)[4][8], const bf16_t* const (&aptr)[4], int a_kstride, const bf16_t* const (&bptr)[4], size_t b_kstride, int KT, LAS unsigned char* lds) {
        const int tid = opaque_tid(), lane = tid & 63, wid = tid >> 6, wm = wid >> 1, wn = wid & 1, fr = lane & 15, fq = lane >> 4;
        const int wu = __builtin_amdgcn_readfirstlane(wid);
#pragma unroll
        for (int mi = 0; mi < 4; ++mi)
#pragma unroll
            for (int ni = 0; ni < 8; ++ni) acc[mi][ni] = (f32x4){0.f, 0.f, 0.f, 0.f};
        int a_rd[4][2];
#pragma unroll
        for (int mi = 0; mi < 4; ++mi)
#pragma unroll
            for (int ks = 0; ks < 2; ++ks) { const int row = wm * 64 + mi * 16 + fr, ch = ks * 4 + fq; a_rd[mi][ks] = row * 128 + ((ch ^ ((row >> 1) & 7)) << 4); }
        int b_rd[2][2], b_f[2][2];
#pragma unroll
        for (int ks = 0; ks < 2; ++ks)
#pragma unroll
            for (int t = 0; t < 2; ++t) { const int k = ks * 32 + 8 * fq + 4 * t + (fr >> 2); b_f[ks][t] = fk2(k); b_rd[ks][t] = A_BYTES + k * 512 + ((fr & 3) << 3); }
        auto issue = [&](int kt, int buf) {
            LAS unsigned char* base = lds + buf * STAGE + wu * 1024;
#pragma unroll
            for (int i = 0; i < 4; ++i) __builtin_amdgcn_global_load_lds((const unsigned*)(aptr[i] + (size_t)kt * a_kstride), (LAS unsigned*)(base + i * 8192), 16, 0, 0);
#pragma unroll
            for (int i = 0; i < 4; ++i) __builtin_amdgcn_global_load_lds((const unsigned*)(bptr[i] + (size_t)kt * b_kstride), (LAS unsigned*)(base + A_BYTES + i * 8192), 16, 0, 0);
        };
        issue(0, 0);
        for (int kt = 0; kt < KT; ++kt) {
            asm volatile("s_waitcnt vmcnt(0)" ::: "memory");
            __syncthreads();
            if (kt + 1 < KT) issue(kt + 1, (kt + 1) & 1);
            const LAS unsigned char* base = lds + (kt & 1) * STAGE;
#pragma unroll
            for (int ks = 0; ks < 2; ++ks) {
                bf16x8 af[4];
#pragma unroll
                for (int mi = 0; mi < 4; ++mi) af[mi] = *(const LAS bf16x8*)(base + a_rd[mi][ks]);
#pragma unroll
                for (int ni = 0; ni < 8; ++ni) {
                    const int u0 = wn * 8 + ni;
                    const s16x4 lo = lds_tr(base + b_rd[ks][0] + ((u0 ^ b_f[ks][0]) << 5));
                    const s16x4 hi = lds_tr(base + b_rd[ks][1] + ((u0 ^ b_f[ks][1]) << 5));
                    const bf16x8 bfr = (bf16x8){lo[0], lo[1], lo[2], lo[3], hi[0], hi[1], hi[2], hi[3]};
#pragma unroll
                    for (int mi = 0; mi < 4; ++mi) acc[mi][ni] = __builtin_amdgcn_mfma_f32_16x16x32_bf16(bfr, af[mi], acc[mi][ni], 0, 0, 0);
                }
            }
        }
        __syncthreads();
    }
};

__device__ __forceinline__ void glds16(const void* g, unsigned lds_base) {
    unsigned sv; asm volatile("s_mov_b32 %0, m0\n\ts_mov_b32 m0, %2\n\ts_nop 0\n\tglobal_load_lds_dwordx4 %1, off\n\ts_mov_b32 m0, %0" : "=&s"(sv) : "v"(g), "s"(lds_base) : "memory"); }
struct Gemm3 {
    static constexpr int A_BYTES = 16384, STAGE = 32768, LDS_BYTES = 4 * STAGE;
    static __device__ __forceinline__ int a_row(int i, int w, int lane) { return (i * 8 + w) * 16 + (lane >> 2); }
    static __device__ __forceinline__ int a_chunk(int row, int lane) { return (lane & 3) ^ ((row >> 1) & 3); }
    static __device__ __forceinline__ int b_k(int i, int w, int lane) { return (i * 8 + w) * 2 + (lane >> 5); }
    static __device__ __forceinline__ int fk2(int r) { return (r & 3) | (((r >> 3) & 1) << 2); }
    static __device__ __forceinline__ int b_n(int k, int lane) { return ((((lane & 31) >> 1) ^ fk2(k)) << 4) + ((lane & 1) << 3); }
    static __device__ __forceinline__ void run(f32x4 (&acc)[4][8], const bf16_t* const (&aptr)[2], int a_kstride, const bf16_t* const (&bptr)[2], size_t b_kstride, int KT, LAS unsigned char* lds) {
        const int tid = opaque_tid(), lane = tid & 63, wid = tid >> 6, wm = wid >> 1, wn = wid & 1, fr = lane & 15, fq = lane >> 4;
        const int wu = __builtin_amdgcn_readfirstlane(wid);
#pragma unroll
        for (int mi = 0; mi < 4; ++mi)
#pragma unroll
            for (int ni = 0; ni < 8; ++ni) acc[mi][ni] = (f32x4){0.f, 0.f, 0.f, 0.f};
        int a_rd[4];
#pragma unroll
        for (int mi = 0; mi < 4; ++mi) { const int row = wm * 64 + mi * 16 + fr; a_rd[mi] = row * 64 + ((fq ^ ((row >> 1) & 3)) << 4); }
        int b_rd[2], b_f[2];
#pragma unroll
        for (int t = 0; t < 2; ++t) { const int k = 8 * fq + 4 * t + (fr >> 2); b_f[t] = fk2(k); b_rd[t] = A_BYTES + k * 512 + ((fr & 3) << 3); }
        const unsigned lds0 = (unsigned)(uintptr_t)lds + (unsigned)wu * 1024u;
        auto issue = [&](int kt) {
            const unsigned base = (unsigned)__builtin_amdgcn_readfirstlane((int)(lds0 + (unsigned)(kt & 3) * STAGE));
#pragma unroll
            for (int i = 0; i < 2; ++i) glds16(aptr[i] + (size_t)kt * a_kstride, base + i * 8192);
#pragma unroll
            for (int i = 0; i < 2; ++i) glds16(bptr[i] + (size_t)kt * b_kstride, base + A_BYTES + i * 8192);
        };
        const int grp = wu >> 2;
        auto bar = [&]() { asm volatile("s_waitcnt lgkmcnt(0)" ::: "memory"); __builtin_amdgcn_s_barrier(); asm volatile("" ::: "memory"); };
        asm volatile("s_waitcnt vmcnt(0)" ::: "memory");
        issue(0); if (KT > 1) issue(1); if (KT > 2) issue(2);
        if (KT > 2) asm volatile("s_waitcnt vmcnt(8)" ::: "memory"); else if (KT > 1) asm volatile("s_waitcnt vmcnt(4)" ::: "memory"); else asm volatile("s_waitcnt vmcnt(0)" ::: "memory");
        bar();
        if (grp) bar();
#pragma unroll 1
        for (int kt = 0; kt < KT; ++kt) {
            if (kt + 3 < KT) issue(kt + 3);
            const LAS unsigned char* base = lds + (kt & 3) * STAGE;
            bf16x8 af[4], bfr[8];
#pragma unroll
            for (int mi = 0; mi < 4; ++mi) af[mi] = *(const LAS bf16x8*)(base + a_rd[mi]);
#pragma unroll
            for (int ni = 0; ni < 8; ++ni) {
                const int u0 = wn * 8 + ni;
                const s16x4 lo = lds_tr(base + b_rd[0] + ((u0 ^ b_f[0]) << 5));
                const s16x4 hi = lds_tr(base + b_rd[1] + ((u0 ^ b_f[1]) << 5));
                bfr[ni] = (bf16x8){lo[0], lo[1], lo[2], lo[3], hi[0], hi[1], hi[2], hi[3]};
            }
            { const int rem = KT - 2 - kt;
              if (rem >= 2) asm volatile("s_waitcnt vmcnt(8)" ::: "memory"); else if (rem == 1) asm volatile("s_waitcnt vmcnt(4)" ::: "memory"); else asm volatile("s_waitcnt vmcnt(0)" ::: "memory"); }
            bar();
            __builtin_amdgcn_sched_barrier(0);
#pragma unroll
            for (int ni = 0; ni < 8; ++ni)
#pragma unroll
                for (int mi = 0; mi < 4; ++mi) acc[mi][ni] = __builtin_amdgcn_mfma_f32_16x16x32_bf16(bfr[ni], af[mi], acc[mi][ni], 0, 0, 0);
            __builtin_amdgcn_sched_barrier(0);
            bar();
        }
        if (!grp) bar();
    }

    template <class F> static __device__ __forceinline__ void run_stream(F& f, int NSEG, int KT, int a_kstride, size_t b_kstride, LAS unsigned char* lds) {
        const int tid = opaque_tid(), lane = tid & 63, wid = tid >> 6, wm = wid >> 1, wn = wid & 1, fr = lane & 15, fq = lane >> 4;
        const int wu = __builtin_amdgcn_readfirstlane(wid);
        f32x4 acc[4][8];
#pragma unroll
        for (int mi = 0; mi < 4; ++mi)
#pragma unroll
            for (int ni = 0; ni < 8; ++ni) acc[mi][ni] = (f32x4){0.f, 0.f, 0.f, 0.f};
        int a_rd[4];
#pragma unroll
        for (int mi = 0; mi < 4; ++mi) { const int row = wm * 64 + mi * 16 + fr; a_rd[mi] = row * 64 + ((fq ^ ((row >> 1) & 3)) << 4); }
        int b_rd[2], b_f[2];
#pragma unroll
        for (int t = 0; t < 2; ++t) { const int k = 8 * fq + 4 * t + (fr >> 2); b_f[t] = fk2(k); b_rd[t] = A_BYTES + k * 512 + ((fr & 3) << 3); }
        const unsigned lds0 = (unsigned)(uintptr_t)lds + (unsigned)wu * 1024u;
        const bf16_t* aptr[2]; const bf16_t* bptr[2];
        const int total = NSEG * KT;
        int lseg = 0, lkt = 0, lg = 0;
        auto issue = [&]() {
            const unsigned base = (unsigned)__builtin_amdgcn_readfirstlane((int)(lds0 + (unsigned)(lg & 3) * STAGE));
#pragma unroll
            for (int i = 0; i < 2; ++i) glds16(aptr[i] + (size_t)lkt * a_kstride, base + i * 8192);
#pragma unroll
            for (int i = 0; i < 2; ++i) glds16(bptr[i] + (size_t)lkt * b_kstride, base + A_BYTES + i * 8192);
            ++lg; if (++lkt == KT) { lkt = 0; ++lseg; if (lseg < NSEG) f.ptrs(lseg, aptr, bptr); }
        };
        const int grp = wu >> 2;
        auto bar = [&]() { asm volatile("s_waitcnt lgkmcnt(0)" ::: "memory"); __builtin_amdgcn_s_barrier(); asm volatile("" ::: "memory"); };
        f.ptrs(0, aptr, bptr);
        asm volatile("s_waitcnt vmcnt(0)" ::: "memory");
        issue(); if (total > 1) issue(); if (total > 2) issue();
        if (total > 2) asm volatile("s_waitcnt vmcnt(8)" ::: "memory"); else if (total > 1) asm volatile("s_waitcnt vmcnt(4)" ::: "memory"); else asm volatile("s_waitcnt vmcnt(0)" ::: "memory");
        bar();
        if (grp) bar();
        int cseg = 0, ckt = 0;
#pragma unroll 1
        for (int g = 0; g < total; ++g) {
            if (lg < total) issue();
            const LAS unsigned char* base = lds + (g & 3) * STAGE;
            bf16x8 af[4], bfr[8];
#pragma unroll
            for (int mi = 0; mi < 4; ++mi) af[mi] = *(const LAS bf16x8*)(base + a_rd[mi]);
#pragma unroll
            for (int ni = 0; ni < 8; ++ni) {
                const int u0 = wn * 8 + ni;
                const s16x4 lo = lds_tr(base + b_rd[0] + ((u0 ^ b_f[0]) << 5));
                const s16x4 hi = lds_tr(base + b_rd[1] + ((u0 ^ b_f[1]) << 5));
                bfr[ni] = (bf16x8){lo[0], lo[1], lo[2], lo[3], hi[0], hi[1], hi[2], hi[3]};
            }
            { const int rem = total - 2 - g;
              if (rem >= 2) asm volatile("s_waitcnt vmcnt(8)" ::: "memory"); else if (rem == 1) asm volatile("s_waitcnt vmcnt(4)" ::: "memory"); else asm volatile("s_waitcnt vmcnt(0)" ::: "memory"); }
            bar();
            __builtin_amdgcn_sched_barrier(0);
#pragma unroll
            for (int ni = 0; ni < 8; ++ni)
#pragma unroll
                for (int mi = 0; mi < 4; ++mi) acc[mi][ni] = __builtin_amdgcn_mfma_f32_16x16x32_bf16(bfr[ni], af[mi], acc[mi][ni], 0, 0, 0);
            __builtin_amdgcn_sched_barrier(0);
            bar();
            if (++ckt == KT) {
                if (!grp) bar();
                f.epi(cseg, acc);
#pragma unroll
                for (int mi = 0; mi < 4; ++mi)
#pragma unroll
                    for (int ni = 0; ni < 8; ++ni) acc[mi][ni] = (f32x4){0.f, 0.f, 0.f, 0.f};
                ckt = 0; ++cseg;
                if (grp) bar();
            }
        }
        if (!grp) bar();
    }
};

struct Gemm8 {
    static constexpr int A_BYTES = 16384, STAGE = 32768;
    static __device__ __forceinline__ int t_row(int i, int w, int lane) { return (i * 8 + w) * 16 + (lane >> 2); }
    static __device__ __forceinline__ int t_chunk(int row, int lane) { return (lane & 3) ^ ((row >> 1) & 3); }
    static __device__ __forceinline__ int w_col(int i) { return 16 * ((i >> 2) & 1) + 4 * (i >> 3) + (i & 3); }
    template <class F> static __device__ __forceinline__ void run_stream(F& f, int NSEG, int KT, LAS unsigned char* lds) {
        const int tid = opaque_tid(), lane = tid & 63, wid = tid >> 6, wm = wid >> 1, wn = wid & 1, l31 = lane & 31, hi = lane >> 5;
        const int wu = __builtin_amdgcn_readfirstlane(wid);
        f32x16 acc[2][4];
#pragma unroll
        for (int jt = 0; jt < 2; ++jt)
#pragma unroll
            for (int it = 0; it < 4; ++it)
#pragma unroll
                for (int r = 0; r < 16; ++r) acc[jt][it][r] = 0.f;
        const int sw = (l31 >> 1) & 3;
        const int t_rd0 = (wm * 64 + l31) * 64 + (((2 * hi) ^ sw) << 4), t_rd1 = (wm * 64 + l31) * 64 + (((2 * hi + 1) ^ sw) << 4);
        const int w_rd0 = A_BYTES + (wn * 128 + l31) * 64 + (((2 * hi) ^ sw) << 4), w_rd1 = A_BYTES + (wn * 128 + l31) * 64 + (((2 * hi + 1) ^ sw) << 4);
        const unsigned lds0 = (unsigned)(uintptr_t)lds + (unsigned)wu * 1024u;
        const unsigned char* aptr[2]; const unsigned char* wptr[2];
        const int total = NSEG * KT;
        int lseg = 0, lkt = 0, lg = 0;
        auto issue = [&]() {
            const unsigned base = (unsigned)__builtin_amdgcn_readfirstlane((int)(lds0 + (unsigned)(lg & 3) * STAGE));
#pragma unroll
            for (int i = 0; i < 2; ++i) glds16(aptr[i] + lkt * 64, base + i * 8192);
#pragma unroll
            for (int i = 0; i < 2; ++i) glds16(wptr[i] + lkt * 64, base + A_BYTES + i * 8192);
            ++lg; if (++lkt == KT) { lkt = 0; ++lseg; if (lseg < NSEG) f.ptrs(lseg, aptr, wptr); }
        };
        const int grp = wu >> 2;
        auto bar = [&]() { asm volatile("s_waitcnt lgkmcnt(0)" ::: "memory"); __builtin_amdgcn_s_barrier(); asm volatile("" ::: "memory"); };
        f.ptrs(0, aptr, wptr);
        asm volatile("s_waitcnt vmcnt(0)" ::: "memory");
        issue(); if (total > 1) issue(); if (total > 2) issue();
        if (total > 2) asm volatile("s_waitcnt vmcnt(8)" ::: "memory"); else if (total > 1) asm volatile("s_waitcnt vmcnt(4)" ::: "memory"); else asm volatile("s_waitcnt vmcnt(0)" ::: "memory");
        bar();
        if (grp) bar();
        int cseg = 0, ckt = 0;
#pragma unroll 1
        for (int g = 0; g < total; ++g) {
            if (lg < total) issue();
            const LAS unsigned char* base = lds + (g & 3) * STAGE;
            i32x8 tf[2], wf[4];
#pragma unroll
            for (int jt = 0; jt < 2; ++jt) { const u32x4 lo = *(const LAS u32x4*)(base + t_rd0 + jt * 2048), h4 = *(const LAS u32x4*)(base + t_rd1 + jt * 2048);
                tf[jt] = (i32x8){(int)lo.x, (int)lo.y, (int)lo.z, (int)lo.w, (int)h4.x, (int)h4.y, (int)h4.z, (int)h4.w}; }
#pragma unroll
            for (int it = 0; it < 4; ++it) { const u32x4 lo = *(const LAS u32x4*)(base + w_rd0 + it * 2048), h4 = *(const LAS u32x4*)(base + w_rd1 + it * 2048);
                wf[it] = (i32x8){(int)lo.x, (int)lo.y, (int)lo.z, (int)lo.w, (int)h4.x, (int)h4.y, (int)h4.z, (int)h4.w}; }
            { const int rem = total - 2 - g;
              if (rem >= 2) asm volatile("s_waitcnt vmcnt(8)" ::: "memory"); else if (rem == 1) asm volatile("s_waitcnt vmcnt(4)" ::: "memory"); else asm volatile("s_waitcnt vmcnt(0)" ::: "memory"); }
            bar();
            __builtin_amdgcn_sched_barrier(0);
#pragma unroll
            for (int it = 0; it < 4; ++it)
#pragma unroll
                for (int jt = 0; jt < 2; ++jt) acc[jt][it] = __builtin_amdgcn_mfma_scale_f32_32x32x64_f8f6f4(wf[it], tf[jt], acc[jt][it], 0, 0, 0, F::wscale(it), 0, 127);
            __builtin_amdgcn_sched_barrier(0);
            bar();
            if (++ckt == KT) {
                if (!grp) bar();
                f.epi(cseg, acc);
#pragma unroll
                for (int jt = 0; jt < 2; ++jt)
#pragma unroll
                    for (int it = 0; it < 4; ++it)
#pragma unroll
                        for (int r = 0; r < 16; ++r) acc[jt][it][r] = 0.f;
                ckt = 0; ++cseg;
                if (grp) bar();
            }
        }
        if (!grp) bar();
    }
};

struct Gemm4 {
    static constexpr int A_BYTES = 16384, STAGE = 32768, LDS_BYTES = 2 * STAGE;
    static __device__ __forceinline__ int fk2(int r) { return (r & 3) | (((r >> 3) & 1) << 2); }
    static __device__ __forceinline__ int a_row(int i, int tid) { return (tid >> 2) + 128 * i; }
    static __device__ __forceinline__ int b_k(int i, int tid) { return (tid >> 5) + 16 * i; }
    static __device__ __forceinline__ void run(f32x4 (&acc)[4][8], const bf16_t* const (&aptr)[2], int a_kstride, const bf16_t* const (&bptr)[2], size_t b_kstride, int KT, LAS unsigned char* lds) {
        const int tid = opaque_tid(), lane = tid & 63, wid = tid >> 6, wm = wid >> 1, wn = wid & 1, fr = lane & 15, fq = lane >> 4;
#pragma unroll
        for (int mi = 0; mi < 4; ++mi)
#pragma unroll
            for (int ni = 0; ni < 8; ++ni) acc[mi][ni] = (f32x4){0.f, 0.f, 0.f, 0.f};
        int a_wr[2], b_wr[2];
#pragma unroll
        for (int i = 0; i < 2; ++i) { const int row = a_row(i, tid); a_wr[i] = row * 64 + (((tid & 3) ^ ((row >> 1) & 3)) << 4);
            const int k = b_k(i, tid), n = (tid & 31) * 8; b_wr[i] = A_BYTES + k * 512 + (((n >> 4) ^ fk2(k)) << 5) + ((n & 15) << 1); }
        int a_rd[4];
#pragma unroll
        for (int mi = 0; mi < 4; ++mi) { const int row = wm * 64 + mi * 16 + fr; a_rd[mi] = row * 64 + ((fq ^ ((row >> 1) & 3)) << 4); }
        int b_rd[2], b_f[2];
#pragma unroll
        for (int t = 0; t < 2; ++t) { const int k = 8 * fq + 4 * t + (fr >> 2); b_f[t] = fk2(k); b_rd[t] = A_BYTES + k * 512 + ((fr & 3) << 3); }
        u32x4 ra0[2], rb0[2], ra1[2], rb1[2];
        auto gload = [&](int kt, u32x4 (&ra)[2], u32x4 (&rb)[2]) {
#pragma unroll
            for (int i = 0; i < 2; ++i) { ra[i] = *(const u32x4*)(aptr[i] + (size_t)kt * a_kstride); rb[i] = *(const u32x4*)(bptr[i] + (size_t)kt * b_kstride); }
        };
        auto lstore = [&](int buf, const u32x4 (&ra)[2], const u32x4 (&rb)[2]) {
            LAS unsigned char* base = lds + buf * STAGE;
#pragma unroll
            for (int i = 0; i < 2; ++i) { *(LAS u32x4*)(base + a_wr[i]) = ra[i]; *(LAS u32x4*)(base + b_wr[i]) = rb[i]; }
        };
        auto compute = [&](int buf) {
            const LAS unsigned char* base = lds + buf * STAGE;
            bf16x8 af[4];
#pragma unroll
            for (int mi = 0; mi < 4; ++mi) af[mi] = *(const LAS bf16x8*)(base + a_rd[mi]);
#pragma unroll
            for (int ni = 0; ni < 8; ++ni) {
                const int u0 = wn * 8 + ni;
                const s16x4 lo = lds_tr(base + b_rd[0] + ((u0 ^ b_f[0]) << 5));
                const s16x4 hi = lds_tr(base + b_rd[1] + ((u0 ^ b_f[1]) << 5));
                const bf16x8 bfr = (bf16x8){lo[0], lo[1], lo[2], lo[3], hi[0], hi[1], hi[2], hi[3]};
#pragma unroll
                for (int mi = 0; mi < 4; ++mi) acc[mi][ni] = __builtin_amdgcn_mfma_f32_16x16x32_bf16(bfr, af[mi], acc[mi][ni], 0, 0, 0);
            }
        };
        gload(0, ra0, rb0); gload(1, ra1, rb1);
        lstore(0, ra0, rb0); __syncthreads();
        for (int kt = 0; kt < KT; kt += 2) {
            gload(kt + 2 < KT ? kt + 2 : KT - 1, ra0, rb0);
            __builtin_amdgcn_sched_barrier(0);
            compute(0);
            lstore(1, ra1, rb1);
            __syncthreads();
            gload(kt + 3 < KT ? kt + 3 : KT - 1, ra1, rb1);
            __builtin_amdgcn_sched_barrier(0);
            compute(1);
            lstore(0, ra0, rb0);
            __syncthreads();
        }
    }

    template <class F> static __device__ __forceinline__ void run_stream(F& f, int NSEG, int KT, int a_kstride, size_t b_kstride, LAS unsigned char* lds) {
        const int tid = opaque_tid(), lane = tid & 63, wid = tid >> 6, wm = wid >> 1, wn = wid & 1, fr = lane & 15, fq = lane >> 4;
        f32x4 acc[4][8];
#pragma unroll
        for (int mi = 0; mi < 4; ++mi)
#pragma unroll
            for (int ni = 0; ni < 8; ++ni) acc[mi][ni] = (f32x4){0.f, 0.f, 0.f, 0.f};
        int a_wr[2], b_wr[2];
#pragma unroll
        for (int i = 0; i < 2; ++i) { const int row = a_row(i, tid); a_wr[i] = row * 64 + (((tid & 3) ^ ((row >> 1) & 3)) << 4);
            const int k = b_k(i, tid), n = (tid & 31) * 8; b_wr[i] = A_BYTES + k * 512 + (((n >> 4) ^ fk2(k)) << 5) + ((n & 15) << 1); }
        int a_rd[4];
#pragma unroll
        for (int mi = 0; mi < 4; ++mi) { const int row = wm * 64 + mi * 16 + fr; a_rd[mi] = row * 64 + ((fq ^ ((row >> 1) & 3)) << 4); }
        int b_rd[2], b_f[2];
#pragma unroll
        for (int t = 0; t < 2; ++t) { const int k = 8 * fq + 4 * t + (fr >> 2); b_f[t] = fk2(k); b_rd[t] = A_BYTES + k * 512 + ((fr & 3) << 3); }
        const bf16_t* aptr[2]; const bf16_t* bptr[2];
        u32x4 ra0[2], rb0[2], ra1[2], rb1[2];
        int lseg = 0, lkt = 0;
        auto gload = [&](u32x4 (&ra)[2], u32x4 (&rb)[2]) {
#pragma unroll
            for (int i = 0; i < 2; ++i) { ra[i] = *(const u32x4*)(aptr[i] + (size_t)lkt * a_kstride); rb[i] = *(const u32x4*)(bptr[i] + (size_t)lkt * b_kstride); }
            if (lkt + 1 < KT) ++lkt; else if (lseg + 1 < NSEG) { lkt = 0; ++lseg; f.ptrs(lseg, aptr, bptr); }
        };
        auto lstore = [&](int buf, const u32x4 (&ra)[2], const u32x4 (&rb)[2]) {
            LAS unsigned char* base = lds + buf * STAGE;
#pragma unroll
            for (int i = 0; i < 2; ++i) { *(LAS u32x4*)(base + a_wr[i]) = ra[i]; *(LAS u32x4*)(base + b_wr[i]) = rb[i]; }
        };
        auto compute = [&](int buf) {
            const LAS unsigned char* base = lds + buf * STAGE;
            bf16x8 af[4];
#pragma unroll
            for (int mi = 0; mi < 4; ++mi) af[mi] = *(const LAS bf16x8*)(base + a_rd[mi]);
#pragma unroll
            for (int ni = 0; ni < 8; ++ni) {
                const int u0 = wn * 8 + ni;
                const s16x4 lo = lds_tr(base + b_rd[0] + ((u0 ^ b_f[0]) << 5));
                const s16x4 hi = lds_tr(base + b_rd[1] + ((u0 ^ b_f[1]) << 5));
                const bf16x8 bfr = (bf16x8){lo[0], lo[1], lo[2], lo[3], hi[0], hi[1], hi[2], hi[3]};
#pragma unroll
                for (int mi = 0; mi < 4; ++mi) acc[mi][ni] = __builtin_amdgcn_mfma_f32_16x16x32_bf16(bfr, af[mi], acc[mi][ni], 0, 0, 0);
            }
        };
        f.ptrs(0, aptr, bptr);
        gload(ra0, rb0); gload(ra1, rb1);
        lstore(0, ra0, rb0); __syncthreads();
        int cseg = 0, ckt = 0;
        const int total = NSEG * KT;
#pragma unroll 1
        for (int g = 0; g < total; g += 2) {
            gload(ra0, rb0);
            __builtin_amdgcn_sched_barrier(0);
            compute(0);
            lstore(1, ra1, rb1);
            __syncthreads();
            gload(ra1, rb1);
            __builtin_amdgcn_sched_barrier(0);
            compute(1);
            lstore(0, ra0, rb0);
            __syncthreads();
            ckt += 2;
            if (ckt == KT) {
                f.epi(cseg, acc);
#pragma unroll
                for (int mi = 0; mi < 4; ++mi)
#pragma unroll
                    for (int ni = 0; ni < 8; ++ni) acc[mi][ni] = (f32x4){0.f, 0.f, 0.f, 0.f};
                ckt = 0; ++cseg;
            }
        }
    }
};

template <bool BF32> struct Gemm5 {
    static constexpr int A_BYTES = 16384, STAGE = 32768, LDS_BYTES = 2 * STAGE;
    static __device__ __forceinline__ int fk2(int r) { return (r & 3) | (((r >> 3) & 1) << 2); }
    static __device__ __forceinline__ int a_row(int i, int tid) { return (tid >> 2) + 128 * i; }
    static __device__ __forceinline__ int b_k(int i, int tid) { return (tid >> 5) + 16 * i; }
    typedef typename std::conditional<BF32, float, bf16_t>::type b_t;
    static __device__ __forceinline__ void run(f32x4 (&acc)[4][8], const bf16_t* const (&aptr)[2], int a_kstride, const b_t* const (&bptr)[2], size_t b_kstride, int KT, LAS unsigned char* lds) {
        const int tid = opaque_tid(), lane = tid & 63, wid = tid >> 6, wm = wid >> 1, wn = wid & 1, fr = lane & 15, fq = lane >> 4;
#pragma unroll
        for (int mi = 0; mi < 4; ++mi)
#pragma unroll
            for (int ni = 0; ni < 8; ++ni) acc[mi][ni] = (f32x4){0.f, 0.f, 0.f, 0.f};
        int a_wr[2], b_wr[2];
#pragma unroll
        for (int i = 0; i < 2; ++i) { const int row = a_row(i, tid); a_wr[i] = row * 64 + (((tid & 3) ^ ((row >> 1) & 3)) << 4);
            const int k = b_k(i, tid), n = (tid & 31) * 8; b_wr[i] = A_BYTES + k * 512 + (((n >> 4) ^ fk2(k)) << 5) + ((n & 15) << 1); }
        int a_rd[4];
#pragma unroll
        for (int mi = 0; mi < 4; ++mi) { const int row = wm * 64 + mi * 16 + fr; a_rd[mi] = row * 64 + ((fq ^ ((row >> 1) & 3)) << 4); }
        int b_rd[2], b_f[2];
#pragma unroll
        for (int t = 0; t < 2; ++t) { const int k = 8 * fq + 4 * t + (fr >> 2); b_f[t] = fk2(k); b_rd[t] = A_BYTES + k * 512 + ((fr & 3) << 3); }
        u32x4 ra[2]; u32x4 rb[2]; f32x4 rbf[2][2];
        auto gload = [&](int kt) {
#pragma unroll
            for (int i = 0; i < 2; ++i) { ra[i] = *(const u32x4*)(aptr[i] + (size_t)kt * a_kstride);
                if (BF32) { const float* p = (const float*)bptr[i] + (size_t)kt * b_kstride; rbf[i][0] = *(const f32x4*)p; rbf[i][1] = *(const f32x4*)(p + 4); }
                else rb[i] = *(const u32x4*)((const bf16_t*)bptr[i] + (size_t)kt * b_kstride); }
        };
        auto lstore = [&](int buf) {
            LAS unsigned char* base = lds + buf * STAGE;
#pragma unroll
            for (int i = 0; i < 2; ++i) { *(LAS u32x4*)(base + a_wr[i]) = ra[i];
                if (BF32) { u32x4 w; w.x = cvtpk(rbf[i][0].x, rbf[i][0].y); w.y = cvtpk(rbf[i][0].z, rbf[i][0].w); w.z = cvtpk(rbf[i][1].x, rbf[i][1].y); w.w = cvtpk(rbf[i][1].z, rbf[i][1].w); *(LAS u32x4*)(base + b_wr[i]) = w; }
                else *(LAS u32x4*)(base + b_wr[i]) = rb[i]; }
        };
        auto compute = [&](int buf) {
            const LAS unsigned char* base = lds + buf * STAGE;
            bf16x8 af[4];
#pragma unroll
            for (int mi = 0; mi < 4; ++mi) af[mi] = *(const LAS bf16x8*)(base + a_rd[mi]);
#pragma unroll
            for (int ni = 0; ni < 8; ++ni) {
                const int u0 = wn * 8 + ni;
                const s16x4 lo = lds_tr(base + b_rd[0] + ((u0 ^ b_f[0]) << 5));
                const s16x4 hi = lds_tr(base + b_rd[1] + ((u0 ^ b_f[1]) << 5));
                const bf16x8 bfr = (bf16x8){lo[0], lo[1], lo[2], lo[3], hi[0], hi[1], hi[2], hi[3]};
#pragma unroll
                for (int mi = 0; mi < 4; ++mi) acc[mi][ni] = __builtin_amdgcn_mfma_f32_16x16x32_bf16(bfr, af[mi], acc[mi][ni], 0, 0, 0);
            }
        };
        gload(0); lstore(0); __syncthreads();
#pragma unroll 1
        for (int kt = 0; kt < KT; ++kt) {
            gload(kt + 1 < KT ? kt + 1 : KT - 1);
            __builtin_amdgcn_sched_barrier(0);
            compute(kt & 1);
            lstore((kt + 1) & 1);
            __syncthreads();
        }
    }

    template <class F> static __device__ __forceinline__ void run_stream(F& f, int NSEG, int KT, int a_kstride, size_t b_kstride, LAS unsigned char* lds) {
        const int tid = opaque_tid(), lane = tid & 63, wid = tid >> 6, wm = wid >> 1, wn = wid & 1, fr = lane & 15, fq = lane >> 4;
        f32x4 acc[4][8];
#pragma unroll
        for (int mi = 0; mi < 4; ++mi)
#pragma unroll
            for (int ni = 0; ni < 8; ++ni) acc[mi][ni] = (f32x4){0.f, 0.f, 0.f, 0.f};
        int a_wr[2], b_wr[2];
#pragma unroll
        for (int i = 0; i < 2; ++i) { const int row = a_row(i, tid); a_wr[i] = row * 64 + (((tid & 3) ^ ((row >> 1) & 3)) << 4);
            const int k = b_k(i, tid), n = (tid & 31) * 8; b_wr[i] = A_BYTES + k * 512 + (((n >> 4) ^ fk2(k)) << 5) + ((n & 15) << 1); }
        int a_rd[4];
#pragma unroll
        for (int mi = 0; mi < 4; ++mi) { const int row = wm * 64 + mi * 16 + fr; a_rd[mi] = row * 64 + ((fq ^ ((row >> 1) & 3)) << 4); }
        int b_rd[2], b_f[2];
#pragma unroll
        for (int t = 0; t < 2; ++t) { const int k = 8 * fq + 4 * t + (fr >> 2); b_f[t] = fk2(k); b_rd[t] = A_BYTES + k * 512 + ((fr & 3) << 3); }
        const bf16_t* aptr[2]; const b_t* bptr[2];
        u32x4 ra[2]; u32x4 rb[2]; f32x4 rbf[2][2];
        auto gload = [&](int kt) {
#pragma unroll
            for (int i = 0; i < 2; ++i) { ra[i] = *(const u32x4*)(aptr[i] + (size_t)kt * a_kstride);
                if (BF32) { const float* p = (const float*)bptr[i] + (size_t)kt * b_kstride; rbf[i][0] = *(const f32x4*)p; rbf[i][1] = *(const f32x4*)(p + 4); }
                else rb[i] = *(const u32x4*)((const bf16_t*)bptr[i] + (size_t)kt * b_kstride); }
        };
        auto lstore = [&](int buf) {
            LAS unsigned char* base = lds + buf * STAGE;
#pragma unroll
            for (int i = 0; i < 2; ++i) { *(LAS u32x4*)(base + a_wr[i]) = ra[i];
                if (BF32) { u32x4 w; w.x = cvtpk(rbf[i][0].x, rbf[i][0].y); w.y = cvtpk(rbf[i][0].z, rbf[i][0].w); w.z = cvtpk(rbf[i][1].x, rbf[i][1].y); w.w = cvtpk(rbf[i][1].z, rbf[i][1].w); *(LAS u32x4*)(base + b_wr[i]) = w; }
                else *(LAS u32x4*)(base + b_wr[i]) = rb[i]; }
        };
        auto compute = [&](int buf) {
            const LAS unsigned char* base = lds + buf * STAGE;
            bf16x8 af[4];
#pragma unroll
            for (int mi = 0; mi < 4; ++mi) af[mi] = *(const LAS bf16x8*)(base + a_rd[mi]);
#pragma unroll
            for (int ni = 0; ni < 8; ++ni) {
                const int u0 = wn * 8 + ni;
                const s16x4 lo = lds_tr(base + b_rd[0] + ((u0 ^ b_f[0]) << 5));
                const s16x4 hi = lds_tr(base + b_rd[1] + ((u0 ^ b_f[1]) << 5));
                const bf16x8 bfr = (bf16x8){lo[0], lo[1], lo[2], lo[3], hi[0], hi[1], hi[2], hi[3]};
#pragma unroll
                for (int mi = 0; mi < 4; ++mi) acc[mi][ni] = __builtin_amdgcn_mfma_f32_16x16x32_bf16(bfr, af[mi], acc[mi][ni], 0, 0, 0);
            }
        };
        f.ptrs(0, aptr, bptr);
        gload(0); lstore(0); __syncthreads();
        int seg = 0, kt = 0;
        const int total = NSEG * KT;
#pragma unroll 1
        for (int g = 0; g < total; ++g) {
            int nkt = kt + 1, nsg = seg; if (nkt == KT) { nkt = 0; nsg = seg + 1; }
            if (nkt == 0 && nsg < NSEG) f.ptrs(nsg, aptr, bptr);
            gload(nsg < NSEG ? nkt : KT - 1);
            __builtin_amdgcn_sched_barrier(0);
            compute(g & 1);
            lstore((g + 1) & 1);
            __syncthreads();
            if (nkt == 0) {
                f.epi(seg, acc);
#pragma unroll
                for (int mi = 0; mi < 4; ++mi)
#pragma unroll
                    for (int ni = 0; ni < 8; ++ni) acc[mi][ni] = (f32x4){0.f, 0.f, 0.f, 0.f};
            }
            seg = nsg; kt = nkt;
        }
    }
};

__device__ __forceinline__ int p2_col(int m0);
__device__ __forceinline__ unsigned pk4_fp8(float a, float b, float c, float d) { int pk = __builtin_amdgcn_cvt_pk_fp8_f32(a, b, 0, false); pk = __builtin_amdgcn_cvt_pk_fp8_f32(c, d, pk, true); return (unsigned)pk; }
__device__ __forceinline__ int w8_col(int i) { return 16 * ((i >> 2) & 1) + 4 * (i >> 3) + (i & 3); }
__device__ __forceinline__ void phase_mod(const Params& P, LAS unsigned char* lds) {
    const int tid = threadIdx.x;
    float* mod = (float*)(P.ws + WS_MOD);
    LAS float* sc = (LAS float*)lds;
    LAS float* red = (LAS float*)(lds + 16384);
    for (int i = tid; i < 4096; i += NTHREADS) sc[i] = siluf_(P.c[i]);
    __syncthreads();
    const int kq = tid >> 5, cl = tid & 31;
    for (int u = blockIdx.x; u < 192; u += gridDim.x) {
        const int j = u * 32 + cl;
        float a0 = 0.f, a1 = 0.f, a2 = 0.f, a3 = 0.f;
#pragma unroll 8
        for (int k = kq; k < 1024; k += 16) { const float w = P.ada_w[(size_t)k * 6144 + j];
            a0 += sc[k] * w; a1 += sc[1024 + k] * w; a2 += sc[2048 + k] * w; a3 += sc[3072 + k] * w; }
        red[(kq * 4 + 0) * 32 + cl] = a0; red[(kq * 4 + 1) * 32 + cl] = a1; red[(kq * 4 + 2) * 32 + cl] = a2; red[(kq * 4 + 3) * 32 + cl] = a3;
        __syncthreads();
        if (tid < 128) { const int b = tid >> 5; float s = 0.f;
#pragma unroll
            for (int q = 0; q < 16; ++q) s += red[(q * 4 + b) * 32 + cl];
            mod[b * 6144 + j] = s + P.ada_b[j]; }
        __syncthreads();
    }
    for (int u = blockIdx.x; u < 16; u += gridDim.x) {
        const int sel = u >> 3, j = (u & 7) * 32 + cl;
        const float* w1 = P.cmp_w1 + (size_t)sel * 2048 * 256; const float* pos = P.cmp_pos + sel * 2048;
        float a0 = 0.f;
#pragma unroll 8
        for (int k = kq; k < 2048; k += 16) a0 += pos[k] * w1[(size_t)k * 256 + j];
        red[kq * 32 + cl] = a0;
        __syncthreads();
        if (tid < 32) { float s = 0.f;
#pragma unroll
            for (int q = 0; q < 16; ++q) s += red[q * 32 + cl];
            ((float*)(P.ws + WS_CB))[sel * 256 + j] = s + P.cmp_b1[sel * 256 + j]; }
        __syncthreads();
    }
    {
        unsigned char* wb = (unsigned char*)(P.ws + WS_WIN);
        const int lane = tid & 63, gw = blockIdx.x * (NTHREADS / 64) + (tid >> 6), NGW = gridDim.x * (NTHREADS / 64);
        for (int u = gw; u < 56 * 16; u += NGW) {
            const int rg = u % 56, kb = u / 56, q = rg * 64 + lane, c8 = (q & ~31) + w8_col(q & 31);
            const int sc_ = c8 < 1280 ? c8 : (c8 < 3328 ? c8 + 24 : c8 - 2048);
            const float* s = P.w_in + (size_t)(kb * 64) * IN_COLS + (c8 < 3352 ? sc_ : 0);
            float v[64];
#pragma unroll
            for (int j = 0; j < 64; ++j) v[j] = s[(size_t)j * IN_COLS];
            const float c_ = c8 < 3352 ? 64.0f : 0.0f;
#pragma unroll
            for (int j = 0; j < 4; ++j) { u32x4 w;
                w.x = pk4_fp8(v[16 * j] * c_, v[16 * j + 1] * c_, v[16 * j + 2] * c_, v[16 * j + 3] * c_); w.y = pk4_fp8(v[16 * j + 4] * c_, v[16 * j + 5] * c_, v[16 * j + 6] * c_, v[16 * j + 7] * c_);
                w.z = pk4_fp8(v[16 * j + 8] * c_, v[16 * j + 9] * c_, v[16 * j + 10] * c_, v[16 * j + 11] * c_); w.w = pk4_fp8(v[16 * j + 12] * c_, v[16 * j + 13] * c_, v[16 * j + 14] * c_, v[16 * j + 15] * c_);
                *(u32x4*)(wb + (size_t)q * 1024 + kb * 64 + j * 16) = w; }
        }
    }
    if (blockIdx.x == gridDim.x - 2) {
        for (int i = tid; i < 2 * 8 * 64; i += NTHREADS) { const int t2 = i >> 9, bg = (i >> 6) & 7, d = i & 63;
            ((bf16_t*)(P.ws + (t2 ? WS_VC : WS_KC)))[((size_t)bg * 512 + 511) * 64 + d] = 0; }
    }
    if (blockIdx.x == gridDim.x - 1) {
        float* lb = (float*)(P.ws + WS_LB);
        for (int i = tid; i < 512; i += NTHREADS) { const float p0 = P.hgrn_lb[i], p1 = P.hgrn_lb[512 + i]; lb[i] = 1.0f / (1.0f + __expf(p1 - p0)); }
    }
}

__device__ __forceinline__ void norm_mod_rows(const float* x, const float* w, const float* mod_sh, const float* mod_sc, unsigned char* h, int hs) {
    const int lane = threadIdx.x & 63, gw = blockIdx.x * (NTHREADS / 64) + (threadIdx.x >> 6), NGW = gridDim.x * (NTHREADS / 64);
    for (int m = gw; m < T; m += NGW) {
        const int b = m / SEQ;
        const f32x4* xr = (const f32x4*)(x + (size_t)m * D) + lane;
        f32x4 v[4]; float s = 0.f;
#pragma unroll
        for (int j = 0; j < 4; ++j) { v[j] = xr[64 * j]; s += (v[j].x * v[j].x + v[j].y * v[j].y) + (v[j].z * v[j].z + v[j].w * v[j].w); }
        const float rstd = rsqrtf(wave_sum(s) * (1.f / D) + RMS_EPS);
        unsigned* o = (unsigned*)(h + (size_t)m * hs) + lane;
#pragma unroll
        for (int j = 0; j < 4; ++j) {
            const int col = (lane + 64 * j) * 4;
            const f32x4 wv = *(const f32x4*)(w + col), scv = *(const f32x4*)(mod_sc + b * 6144 + col), shv = *(const f32x4*)(mod_sh + b * 6144 + col);
            f32x4 r;
            r.x = v[j].x * rstd * wv.x * (1.f + scv.x) + shv.x; r.y = v[j].y * rstd * wv.y * (1.f + scv.y) + shv.y;
            r.z = v[j].z * rstd * wv.z * (1.f + scv.z) + shv.z; r.w = v[j].w * rstd * wv.w * (1.f + scv.w) + shv.w;
            o[64 * j] = pk4_fp8(r.x, r.y, r.z, r.w);
        }
    }
}

__device__ __forceinline__ void phase_inproj(const Params& P, LAS unsigned char* lds) {
    constexpr int NRT = T / 256, NCT = 14;
    struct F { const Params& P;
        static __device__ __forceinline__ int wscale(int) { return 121; }
        __device__ __forceinline__ void unit(int seg, int& rt, int& ct) const {
            const int nx = (gridDim.x % 8 == 0) ? 8 : 1, xl = blockIdx.x % nx, li = blockIdx.x / nx, nloc = gridDim.x / nx;
            const int v = li + seg * nloc, rg = v / (NCT * 4), rem = v % (NCT * 4); ct = rem >> 2; rt = xl + nx * (rg * 4 + (rem & 3)); }
        __device__ __forceinline__ void ptrs(int seg, const unsigned char* (&aptr)[2], const unsigned char* (&wptr)[2]) const {
            const int tid = opaque_tid(), lane = tid & 63, wid = tid >> 6; int rt, ct; unit(seg, rt, ct);
            const unsigned char* h1 = (const unsigned char*)(P.ws + WS_H); const unsigned char* wb = (const unsigned char*)(P.ws + WS_WIN);
#pragma unroll
            for (int i = 0; i < 2; ++i) { const int row = Gemm8::t_row(i, wid, lane); aptr[i] = h1 + (size_t)(rt * 256 + row) * H1S + Gemm8::t_chunk(row, lane) * 16;
                wptr[i] = wb + (size_t)(ct * 256 + row) * 1024 + Gemm8::t_chunk(row, lane) * 16; } }
        __device__ __forceinline__ void epi(int seg, f32x16 (&acc)[2][4]) const {
            const int tid = opaque_tid(), lane = tid & 63, wid = tid >> 6, wm = wid >> 1, wn = wid & 1, l31 = lane & 31, hi = lane >> 5;
            int rt, ct; unit(seg, rt, ct);
            bf16_t* qo = (bf16_t*)(P.ws + WS_Q); bf16_t* kvo = (bf16_t*)(P.ws + WS_KV); float* gates = (float*)(P.ws + WS_GATES);
            bf16_t* hq = (bf16_t*)(P.ws + WS_HQ); bf16_t* logf = (bf16_t*)(P.ws + WS_LOGF); bf16_t* hv = (bf16_t*)(P.ws + WS_HV); bf16_t* hg = (bf16_t*)(P.ws + WS_HG);
            const float* lb = (const float*)(P.ws + WS_LB);
            const int row0 = rt * 256 + wm * 64 + l31;
            if (ct < 5) {
                const bool is_q = ct < 2; const int sg = (ct - 2) * 2 + wn;
                const bool do_norm = is_q || sg == 2 || sg == 4;
                const float* nw = is_q ? P.q_norm_w : (P.k_norm_w + (sg == 2 ? 64 : 128));
                const float osc = is_q ? 0.125f : 1.0f;
#pragma unroll
                for (int hh = 0; hh < 2; ++hh) {
#pragma unroll
                    for (int jt = 0; jt < 2; ++jt) {
                        float rstd = 1.f;
                        if (do_norm) { float s = 0.f;
#pragma unroll
                            for (int t2 = 0; t2 < 2; ++t2)
#pragma unroll
                                for (int r = 0; r < 16; ++r) { const float a = acc[jt][2 * hh + t2][r]; s += a * a; }
                            s += __shfl_xor(s, 32);
                            rstd = rsqrtf(s * (1.f / 64.f) + RMS_EPS) * osc; }
                        const size_t m = (size_t)(row0 + jt * 32);
                        bf16_t* dst = is_q ? (qo + m * 512 + ct * 256 + wn * 128 + hh * 64 + 16 * hi) : (kvo + m * 768 + (ct - 2) * 256 + wn * 128 + hh * 64 + 16 * hi);
#pragma unroll
                        for (int t2 = 0; t2 < 2; ++t2) { u32x4 w0, w1;
#pragma unroll
                            for (int q4 = 0; q4 < 4; ++q4) { const f32x4 wv = do_norm ? *(const f32x4*)(nw + t2 * 32 + 16 * hi + 4 * q4) : (f32x4){1.f, 1.f, 1.f, 1.f};
                                const unsigned lo = cvtpk(acc[jt][2 * hh + t2][4 * q4] * rstd * wv.x, acc[jt][2 * hh + t2][4 * q4 + 1] * rstd * wv.y), hi2 = cvtpk(acc[jt][2 * hh + t2][4 * q4 + 2] * rstd * wv.z, acc[jt][2 * hh + t2][4 * q4 + 3] * rstd * wv.w);
                                if (q4 < 2) { w0[2 * q4] = lo; w0[2 * q4 + 1] = hi2; } else { w1[2 * (q4 - 2)] = lo; w1[2 * (q4 - 2) + 1] = hi2; } }
                            *(u32x4*)(dst + t2 * 32) = w0; *(u32x4*)(dst + t2 * 32 + 8) = w1; }
                    }
                }
            } else if (ct == 13) {
                if (wn == 0) {
#pragma unroll
                    for (int jt = 0; jt < 2; ++jt) { const size_t m = (size_t)(row0 + jt * 32);
#pragma unroll
                        for (int q4 = 0; q4 < 4; ++q4) { const int c = 16 * hi + 4 * q4; if (c < 24) {
                                *(f32x4*)(gates + m * 24 + c) = (f32x4){sigmoidf_(acc[jt][0][4 * q4]), sigmoidf_(acc[jt][0][4 * q4 + 1]), sigmoidf_(acc[jt][0][4 * q4 + 2]), sigmoidf_(acc[jt][0][4 * q4 + 3])}; } } }
                }
            } else {
                const int hs = (ct - 5) >> 1, cc = ((ct - 5) & 1) * 256 + wn * 128 + 16 * hi;
#pragma unroll
                for (int jt = 0; jt < 2; ++jt) { const size_t m = (size_t)(row0 + jt * 32);
#pragma unroll
                    for (int it = 0; it < 4; ++it) { const int c = cc + it * 32;
                        if (hs == 1) { unsigned w8[8];
#pragma unroll
                            for (int q4 = 0; q4 < 4; ++q4) { const f32x4 l = *(const f32x4*)(lb + c + 4 * q4); f32x4 o;
                                o.x = __logf(l.x + (1.f - l.x) * sigmoidf_(acc[jt][it][4 * q4])); o.y = __logf(l.y + (1.f - l.y) * sigmoidf_(acc[jt][it][4 * q4 + 1]));
                                o.z = __logf(l.z + (1.f - l.z) * sigmoidf_(acc[jt][it][4 * q4 + 2])); o.w = __logf(l.w + (1.f - l.w) * sigmoidf_(acc[jt][it][4 * q4 + 3]));
                                w8[2 * q4] = cvtpk(o.x, o.y); w8[2 * q4 + 1] = cvtpk(o.z, o.w); }
                            *(u32x4*)(logf + m * 512 + c) = (u32x4){w8[0], w8[1], w8[2], w8[3]}; *(u32x4*)(logf + m * 512 + c + 8) = (u32x4){w8[4], w8[5], w8[6], w8[7]};
                        } else { float v[16];
#pragma unroll
                            for (int r = 0; r < 16; ++r) { const float a = acc[jt][it][r]; v[r] = hs == 0 ? siluf_(a) * 0.08838834764831845f : (hs == 2 ? a : sigmoidf_(a)); }
                            bf16_t* dst = (hs == 0 ? hq : (hs == 2 ? hv : hg)) + m * 512 + c;
                            *(u32x4*)dst = (u32x4){cvtpk(v[0], v[1]), cvtpk(v[2], v[3]), cvtpk(v[4], v[5]), cvtpk(v[6], v[7])};
                            *(u32x4*)(dst + 8) = (u32x4){cvtpk(v[8], v[9]), cvtpk(v[10], v[11]), cvtpk(v[12], v[13]), cvtpk(v[14], v[15])}; }
                    } }
            }
        }
    } f{P};
    const int nx = (gridDim.x % 8 == 0) ? 8 : 1, li = blockIdx.x / nx, nloc = gridDim.x / nx;
    const int nu = ((NRT / nx) * NCT - li + nloc - 1) / nloc;
    if (nu > 0) Gemm8::run_stream(f, nu, D / 64, lds);
}

__device__ __forceinline__ float gelu_tanh(float x) {
    const float u = 0.7978845608028654f * (x + 0.044715f * x * x * x);
    const float th = 1.0f - 2.0f / (1.0f + __expf(2.0f * u));
    return 0.5f * x * (1.0f + th);
}
__device__ __forceinline__ void compress_unit(const Params& P, LAS unsigned char* lds, int u) {
    typedef GemmT<2, 4> G;
    const int tid = opaque_tid(), lane = tid & 63, wid = tid >> 6, wm = wid >> 2, wn = wid & 3, fr = lane & 15, fq = lane >> 4;
    const int sel = u >> 5, rt = u & 31;
    const bf16_t* kv = (const bf16_t*)(P.ws + WS_KV);
    bf16_t* cmph = (bf16_t*)(P.ws + WS_CMPH) + (size_t)sel * 4096 * 256;
    const float* cb = (const float*)(P.ws + WS_CB) + sel * 256;
    const bf16_t* arow[2];
#pragma unroll
    for (int p = 0; p < 2; ++p) { int r = rt * 128 + p * 64 + (tid >> 3); r = r < 4088 ? r : 4087;
        const int b = r / 1022, rem = r % 1022, i = rem >> 1, g = rem & 1;
        arow[p] = kv + (size_t)(b * SEQ + 16 * i) * 768 + sel * 128 + g * 64; }
    f32x4 acc[4][4];
    G::run(acc, arow, 768, P.cmp_w1 + (size_t)sel * 2048 * 256, 256, 32, lds);
#pragma unroll
    for (int mi = 0; mi < 4; ++mi) { const size_t row = (size_t)(rt * 128 + wm * 64 + mi * 16 + fr);
#pragma unroll
        for (int ni = 0; ni < 4; ++ni) { const int col = wn * 64 + ni * 16 + 4 * fq; const f32x4 a = acc[mi][ni]; const f32x4 bb = *(const f32x4*)(cb + col);
            u32x2 pk; pk.x = cvtpk(gelu_tanh(a.x + bb.x), gelu_tanh(a.y + bb.y)); pk.y = cvtpk(gelu_tanh(a.z + bb.z), gelu_tanh(a.w + bb.w));
            *(u32x2*)(cmph + row * 256 + col) = pk; } }
    __syncthreads();
    {
        const int row = tid >> 2, cq = tid & 3;
        const bf16_t* hr = cmph + (size_t)(rt * 128 + row) * 256;
        const float* w2 = P.cmp_w2 + (size_t)sel * 256 * 64 + cq * 16;
        float o[16];
#pragma unroll
        for (int j = 0; j < 16; ++j) o[j] = 0.f;
        for (int k8 = 0; k8 < 256; k8 += 8) {
            const u32x4 hv = *(const u32x4*)(hr + k8);
#pragma unroll
            for (int kk = 0; kk < 8; ++kk) {
                const unsigned wd = hv[kk >> 1]; const float a = (kk & 1) ? __uint_as_float(wd & 0xffff0000u) : __uint_as_float(wd << 16);
                const float* wr = w2 + (size_t)(k8 + kk) * 64;
#pragma unroll
                for (int j4 = 0; j4 < 4; ++j4) { const f32x4 w = *(const f32x4*)(wr + j4 * 4);
                    o[j4 * 4 + 0] += a * w.x; o[j4 * 4 + 1] += a * w.y; o[j4 * 4 + 2] += a * w.z; o[j4 * 4 + 3] += a * w.w; }
            }
        }
        if (sel == 0) { float s = 0.f;
#pragma unroll
            for (int j = 0; j < 16; ++j) s += o[j] * o[j];
            s += __shfl_xor(s, 1); s += __shfl_xor(s, 2);
            const float rstd = rsqrtf(s * (1.f / 64.f) + RMS_EPS);
#pragma unroll
            for (int j = 0; j < 16; ++j) o[j] *= rstd * P.k_norm_w[cq * 16 + j]; }
        const int r = rt * 128 + row;
        if (r < 4088) { const int b = r / 1022, rem = r % 1022, i = rem >> 1, g = rem & 1;
            bf16_t* dst = (bf16_t*)(P.ws + (sel ? WS_VC : WS_KC)) + ((size_t)(b * 2 + g) * 512 + i) * 64 + cq * 16;
            u32x4 w0, w1;
            w0.x = cvtpk(o[0], o[1]); w0.y = cvtpk(o[2], o[3]); w0.z = cvtpk(o[4], o[5]); w0.w = cvtpk(o[6], o[7]);
            w1.x = cvtpk(o[8], o[9]); w1.y = cvtpk(o[10], o[11]); w1.z = cvtpk(o[12], o[13]); w1.w = cvtpk(o[14], o[15]);
            *(u32x4*)dst = w0; *(u32x4*)(dst + 8) = w1; }
    }
    __syncthreads();
}

__device__ __forceinline__ int off_row128(int row, int ch) { return row * 128 + ((ch ^ ((row >> 1) & 7)) << 4); }
__device__ __forceinline__ int off_row256(int row, int ch) { return row * 256 + ((ch ^ (row & 15)) << 4); }
__device__ __forceinline__ int fk_(int r) { return (r & 3) | (((r >> 3) & 1) << 2); }
__device__ __forceinline__ int off_tr256(int row, int col) { return row * 256 + ((((col >> 4) ^ fk_(row)) << 5) + ((col & 15) << 1)); }
constexpr int HL_QT = 0, HL_KT = 16384, HL_KH = 32768, HL_V = 49152, HL_SB = 65536, HL_P = 98304  , HL_TOT = 106496  , HL_RED = 110592  , HL_END = 111104;

template <int MODE> __device__ __forceinline__ void hgrn_unit(const Params& P, LAS unsigned char* lds, int u) {
    const int tid = opaque_tid(), lane = tid & 63, wid = tid >> 6, fr = lane & 15, fq = lane >> 4;
    const int b = u >> 7, h = (u >> 5) & 3, sc = u & 31;
    const bf16_t* hq = (const bf16_t*)(P.ws + WS_HQ); const bf16_t* logf = (const bf16_t*)(P.ws + WS_LOGF);
    const bf16_t* hv = (const bf16_t*)(P.ws + WS_HV); const bf16_t* hg = (const bf16_t*)(P.ws + WS_HG);
    float* HLs = (float*)(P.ws + WS_HL); float* HDs = (float*)(P.ws + WS_HD);
    bf16_t* mix = (bf16_t*)(P.ws + WS_MIX);
    LAS float* tot = (LAS float*)(lds + HL_TOT); LAS float* red = (LAS float*)(lds + HL_RED);
    f32x4 st[8];
#pragma unroll
    for (int vt = 0; vt < 8; ++vt) st[vt] = (f32x4){0.f, 0.f, 0.f, 0.f};
    if (MODE == 1) {
        const float* Lj = HLs + (size_t)u * 16384 + (16 * wid + fr) * 128 + 4 * fq;
#pragma unroll
        for (int vt = 0; vt < 8; ++vt) st[vt] = *(const f32x4*)(Lj + vt * 16);
    }
    float dsum = 0.f;
    const int kp = tid & 63, te = tid >> 6;
    for (int c = 0; c < 4; ++c) {
        const size_t tok0 = (size_t)b * SEQ + sc * 256 + c * 64;
        float lf0[8], lf1[8], cs0[8], cs1[8];
        { float a0 = 0.f, a1 = 0.f;
#pragma unroll
          for (int i = 0; i < 8; ++i) { const unsigned vr = *(const unsigned*)(logf + (tok0 + te * 8 + i) * 512 + h * 128 + 2 * kp); const float vx = __uint_as_float(vr << 16), vy = __uint_as_float(vr & 0xffff0000u); lf0[i] = vx; lf1[i] = vy; a0 += vx; a1 += vy; cs0[i] = a0; cs1[i] = a1; }
          tot[te * 128 + 2 * kp] = a0; tot[te * 128 + 2 * kp + 1] = a1; }
        unsigned qpre[8];
        if (MODE == 1) {
#pragma unroll
            for (int i = 0; i < 8; ++i) qpre[i] = *(const unsigned*)(hq + (tok0 + te * 8 + i) * 512 + h * 128 + 2 * kp);
        }
        u32x2 gpre[4];
        if (MODE == 1) {
#pragma unroll
            for (int i = 0; i < 4; ++i) gpre[i] = *(const u32x2*)(hg + (tok0 + (wid >> 1) * 16 + fr) * 512 + h * 128 + (4 * (wid & 1) + i) * 16 + 4 * fq);
        }
#pragma unroll
        for (int i = 0; i < 2; ++i) { const int pc = tid + NTHREADS * i, row = pc >> 4, c8 = (pc & 15) * 8;
            const u32x4 v = *(const u32x4*)(hv + (tok0 + row) * 512 + h * 128 + c8);
            *(LAS u32x4*)(lds + HL_V + off_tr256(row, c8)) = v; }
        if (MODE == 1 ) {
#pragma unroll
            for (int vt = 0; vt < 8; ++vt) { u32x2 pk; pk.x = cvtpk(st[vt].x, st[vt].y); pk.y = cvtpk(st[vt].z, st[vt].w);
                *(LAS u32x2*)(lds + HL_SB + off_tr256(16 * wid + fr, 16 * vt + 4 * fq)) = pk; }
        }
        __syncthreads();
        float pre0 = 0.f, pre1 = 0.f, last0 = 0.f, last1 = 0.f;
#pragma unroll
        for (int e = 0; e < 8; ++e) { const float t0 = tot[e * 128 + 2 * kp], t1 = tot[e * 128 + 2 * kp + 1]; if (e < te) { pre0 += t0; pre1 += t1; } last0 += t0; last1 += t1; }
#pragma unroll
        for (int i = 0; i < 8; ++i) {
            const int t = te * 8 + i;
            const float c0 = cs0[i] + pre0, c1 = cs1[i] + pre1;
            const float k0 = 1.f - __expf(lf0[i]), k1 = 1.f - __expf(lf1[i]);
            const unsigned khat = cvtpk(k0 * __expf(last0 - c0), k1 * __expf(last1 - c1));
            *(LAS unsigned*)(lds + HL_KH + off_tr256(t, 2 * kp)) = khat;
            if (MODE == 1) {
                const unsigned qraw = qpre[i];
                const float q0 = __uint_as_float(qraw << 16), q1 = __uint_as_float(qraw & 0xffff0000u);
                const unsigned qt = cvtpk(q0 * __expf(c0), q1 * __expf(c1));
                const unsigned kt = cvtpk(k0 * __expf(fminf(-c0, 80.f)), k1 * __expf(fminf(-c1, 80.f)));
                const int o = off_row256(t, kp >> 2) + ((kp & 3) << 2);
                *(LAS unsigned*)(lds + HL_QT + o) = qt; *(LAS unsigned*)(lds + HL_KT + o) = kt;
            }
        }
        const float dec = __expf(tot[0 * 128 + 16 * wid + fr] + tot[1 * 128 + 16 * wid + fr] + tot[2 * 128 + 16 * wid + fr] + tot[3 * 128 + 16 * wid + fr]
                                 + tot[4 * 128 + 16 * wid + fr] + tot[5 * 128 + 16 * wid + fr] + tot[6 * 128 + 16 * wid + fr] + tot[7 * 128 + 16 * wid + fr]);
        if (MODE == 0 && tid < 128) { float s = 0.f;
#pragma unroll
            for (int e = 0; e < 8; ++e) s += tot[e * 128 + tid];
            dsum += s; }
        __syncthreads();
        f32x4 oacc[4];
        if (MODE == 1) {
            { const int tt = wid & 3;
#pragma unroll
              for (int si = 0; si < 2; ++si) { const int stl = 2 * (wid >> 2) + si;
                  f32x4 sacc = (f32x4){0.f, 0.f, 0.f, 0.f};
                  if (stl <= tt) {
#pragma unroll
                      for (int ks = 0; ks < 4; ++ks) {
                          const bf16x8 a = *(const LAS bf16x8*)(lds + HL_KT + off_row256(stl * 16 + fr, ks * 4 + fq));
                          const bf16x8 bq = *(const LAS bf16x8*)(lds + HL_QT + off_row256(tt * 16 + fr, ks * 4 + fq));
                          sacc = __builtin_amdgcn_mfma_f32_16x16x32_bf16(a, bq, sacc, 0, 0, 0);
                      }
                  }
                  const int t = tt * 16 + fr, s0 = stl * 16 + 4 * fq;
                  u32x2 pk; pk.x = cvtpk(s0 + 0 <= t ? sacc.x : 0.f, s0 + 1 <= t ? sacc.y : 0.f); pk.y = cvtpk(s0 + 2 <= t ? sacc.z : 0.f, s0 + 3 <= t ? sacc.w : 0.f);
                  *(LAS u32x2*)(lds + HL_P + off_row128(t, s0 >> 3) + ((s0 & 7) << 1)) = pk; }
            }
            __syncthreads();
            { const int tt = wid >> 1;
#pragma unroll
              for (int i = 0; i < 4; ++i) { const int vt = 4 * (wid & 1) + i;
                  f32x4 a = (f32x4){0.f, 0.f, 0.f, 0.f};
#pragma unroll
                  for (int ks = 0; ks < 2; ++ks) {
                      const int kr = ks * 32 + 8 * fq + (fr >> 2);
                      const s16x4 lo = lds_tr(lds + HL_V + off_tr256(kr, vt * 16 + 4 * (fr & 3))), hi = lds_tr(lds + HL_V + off_tr256(kr + 4, vt * 16 + 4 * (fr & 3)));
                      const bf16x8 va = (bf16x8){lo[0], lo[1], lo[2], lo[3], hi[0], hi[1], hi[2], hi[3]};
                      const bf16x8 pb = *(const LAS bf16x8*)(lds + HL_P + off_row128(tt * 16 + fr, ks * 4 + fq));
                      a = __builtin_amdgcn_mfma_f32_16x16x32_bf16(va, pb, a, 0, 0, 0);
                  }
#pragma unroll
                  for (int ks = 0; ks < 4; ++ks) {
                      const int kr = ks * 32 + 8 * fq + (fr >> 2);
                      const s16x4 lo = lds_tr(lds + HL_SB + off_tr256(kr, vt * 16 + 4 * (fr & 3))), hi = lds_tr(lds + HL_SB + off_tr256(kr + 4, vt * 16 + 4 * (fr & 3)));
                      const bf16x8 sa = (bf16x8){lo[0], lo[1], lo[2], lo[3], hi[0], hi[1], hi[2], hi[3]};
                      const bf16x8 qb = *(const LAS bf16x8*)(lds + HL_QT + off_row256(tt * 16 + fr, ks * 4 + fq));
                      a = __builtin_amdgcn_mfma_f32_16x16x32_bf16(sa, qb, a, 0, 0, 0);
                  }
                  const u32x2 gr = gpre[i];
                  a.x *= __uint_as_float(gr.x << 16); a.y *= __uint_as_float(gr.x & 0xffff0000u); a.z *= __uint_as_float(gr.y << 16); a.w *= __uint_as_float(gr.y & 0xffff0000u);
                  oacc[i] = a; }
              float ss = 0.f;
#pragma unroll
              for (int i = 0; i < 4; ++i) ss += (oacc[i].x * oacc[i].x + oacc[i].y * oacc[i].y) + (oacc[i].z * oacc[i].z + oacc[i].w * oacc[i].w);
              ss += __shfl_xor(ss, 16); ss += __shfl_xor(ss, 32);
              if (fq == 0) red[(tt * 2 + (wid & 1)) * 16 + fr] = ss; }
        }
#pragma unroll
        for (int vt = 0; vt < 8; ++vt) {
            f32x4 a = st[vt] * dec;
#pragma unroll
            for (int ks = 0; ks < 2; ++ks) {
                const int kr = ks * 32 + 8 * fq + (fr >> 2);
                const s16x4 lo = lds_tr(lds + HL_V + off_tr256(kr, vt * 16 + 4 * (fr & 3))), hi = lds_tr(lds + HL_V + off_tr256(kr + 4, vt * 16 + 4 * (fr & 3)));
                const bf16x8 va = (bf16x8){lo[0], lo[1], lo[2], lo[3], hi[0], hi[1], hi[2], hi[3]};
                const s16x4 lo2 = lds_tr(lds + HL_KH + off_tr256(kr, wid * 16 + 4 * (fr & 3))), hi2 = lds_tr(lds + HL_KH + off_tr256(kr + 4, wid * 16 + 4 * (fr & 3)));
                const bf16x8 kb = (bf16x8){lo2[0], lo2[1], lo2[2], lo2[3], hi2[0], hi2[1], hi2[2], hi2[3]};
                a = __builtin_amdgcn_mfma_f32_16x16x32_bf16(va, kb, a, 0, 0, 0);
            }
            st[vt] = a;
        }
        __syncthreads();
        if (MODE == 1) {
            const int tt = wid >> 1; const float ssum = red[(tt * 2) * 16 + fr] + red[(tt * 2 + 1) * 16 + fr];
            const float rstd = rsqrtf(ssum * (1.f / 128.f) + RMS_EPS);
#pragma unroll
            for (int i = 0; i < 4; ++i) { const int v = (4 * (wid & 1) + i) * 16 + 4 * fq; const f32x4 w = *(const f32x4*)(P.rec_out_norm_w + h * 128 + v);
                u32x2 pk; pk.x = cvtpk(oacc[i].x * rstd * w.x, oacc[i].y * rstd * w.y); pk.y = cvtpk(oacc[i].z * rstd * w.z, oacc[i].w * rstd * w.w);
                *(u32x2*)(mix + (tok0 + tt * 16 + fr) * 1024 + 512 + h * 128 + v) = pk; }
        }
    }
    if (MODE == 0) {
#pragma unroll
        for (int vt = 0; vt < 8; ++vt) *(f32x4*)(HLs + (size_t)u * 16384 + (16 * wid + fr) * 128 + vt * 16 + 4 * fq) = st[vt];
        if (tid < 128) HDs[(size_t)u * 128 + tid] = __expf(dsum);
    }
    __syncthreads();
}


__device__ __forceinline__ void phase_hgrn_prefix(const Params& P) {
    float* HLs = (float*)(P.ws + WS_HL); const float* HDs = (const float*)(P.ws + WS_HD);
    const int gt = blockIdx.x * NTHREADS + threadIdx.x, NG = gridDim.x * NTHREADS;
    for (int e = gt; e < 16 * 4096; e += NG) {
        const int bh = e >> 12, q = e & 4095, kk = q >> 5;
        float* base = HLs + (size_t)bh * 32 * 16384 + q * 4; const float* db = HDs + (size_t)bh * 32 * 128 + kk;
        f32x4 s = (f32x4){0.f, 0.f, 0.f, 0.f};
#pragma unroll 1
        for (int g8 = 0; g8 < 32; g8 += 8) { f32x4 l[8]; float d[8];
#pragma unroll
            for (int j = 0; j < 8; ++j) { l[j] = *(const f32x4*)(base + (size_t)(g8 + j) * 16384); d[j] = db[(g8 + j) * 128]; }
#pragma unroll
            for (int j = 0; j < 8; ++j) { *(f32x4*)(base + (size_t)(g8 + j) * 16384) = s; s = s * d[j] + l[j]; } }
    }
}

constexpr int NL_K = 0, NL_V = 16384, NL_IMP = 32768, NL_IMP_STRIDE = 132, NL_SELM = NL_IMP + 8 * 8 * NL_IMP_STRIDE * 4, NL_END = NL_SELM + 1024;
__device__ __forceinline__ int off_v128(int row, int ch) { return row * 128 + ((ch ^ ((row & 3) << 1)) << 4); }
#define MFMA32(a, b, c) __builtin_amdgcn_mfma_f32_32x32x16_bf16(a, b, c, 0, 0, 0)

struct NsaLane { int t; float sl2; int qi; unsigned long long mlo, mhi; };

template <int MODE> __device__ __forceinline__ void nsa_pass(LAS unsigned char* lds, const bf16_t* Kg, const bf16_t* Vg, int rs, unsigned long long ulo, unsigned long long uhi,
                                                            const bf16x8 (&qf)[4], const NsaLane& L, float inv, float& lsum, f32x16 (&O)[2], LAS float* impw) {
    const int tid = opaque_tid(), lane = tid & 63, hi = lane >> 5, c = lane & 31;
    const int ld_row = tid >> 3, ld_ch = tid & 7;
    const int kw_off = off_row128(ld_row, ld_ch), vw_off = off_v128(ld_row, ld_ch);
    u32x4 k0, v0, k1, v1, k2, v2;
    auto next = [&](int jj) -> int { ++jj; if (jj < 64) { const unsigned long long m = ulo >> jj; if (m) return jj + __builtin_ctzll(m); jj = 64; }
                                     if (jj < 128) { const unsigned long long m = uhi >> (jj - 64); if (m) return jj + __builtin_ctzll(m); } return 128; };
    int jA = next(-1), jB = jA < 128 ? next(jA) : 128, jC = jB < 128 ? next(jB) : 128;
    const int jsafe = jA < 128 ? jA : 0;
    auto ldk = [&](int jj) -> u32x4 { const int q = jj < 128 ? jj : jsafe; return *(const u32x4*)(Kg + (size_t)(q * 64 + ld_row) * rs + ld_ch * 8); };
    auto ldv = [&](int jj) -> u32x4 { const int q = jj < 128 ? jj : jsafe; return *(const u32x4*)(Vg + (size_t)(q * 64 + ld_row) * rs + ld_ch * 8); };
    k0 = ldk(jA); k1 = ldk(jB); k2 = ldk(jC);
    if (MODE != 0) { v0 = ldv(jA); v1 = ldv(jB); v2 = ldv(jC); }
    int it = 0;
    auto step = [&](u32x4& kreg, u32x4& vreg) {
        const int j = jA;
        LAS unsigned char* kb = lds + NL_K + (it & 1) * 8192; LAS unsigned char* vb = lds + NL_V + (it & 1) * 8192;
        *(LAS u32x4*)(kb + kw_off) = kreg; if (MODE != 0) *(LAS u32x4*)(vb + vw_off) = vreg;
        const int jD = jC < 128 ? next(jC) : 128;
        kreg = ldk(jD); if (MODE != 0) vreg = ldv(jD);
        __syncthreads();
        bool need = true; bool selbit = true;
        if (MODE == 2) { selbit = (j < 64 ? (L.mlo >> j) : (L.mhi >> (j - 64))) & 1ull; need = __any(selbit); }
        if (need) {
            f32x16 p0 = {}, p1 = {};
#pragma unroll
            for (int ks = 0; ks < 4; ++ks) {
                const bf16x8 a0 = *(const LAS bf16x8*)(kb + off_row128(c, 2 * ks + hi)), a1 = *(const LAS bf16x8*)(kb + off_row128(32 + c, 2 * ks + hi));
                p0 = MFMA32(a0, qf[ks], p0); p1 = MFMA32(a1, qf[ks], p1);
            }
            const int stride = (MODE <= 1) ? 16 : 1;
            const int dl = (MODE <= 1) ? (L.t - 31 - 16 * (j * 64 + 4 * hi)) : (L.t - (j * 64 + 4 * hi));
            const float nb = -L.sl2 * (float)dl, sls = L.sl2 * (float)stride;
            float rs_ = 0.f;
#pragma unroll
            for (int r = 0; r < 16; ++r) {
                const int ro0 = (r & 3) + 8 * (r >> 2), ro1 = ro0 + 32;
                const int d0 = dl - stride * ro0, d1 = dl - stride * ro1;
                bool v0 = d0 >= 0, v1 = d1 >= 0;
                if (MODE == 3) { v0 = v0 && d0 < 512; v1 = v1 && d1 < 512; }
                if (MODE == 2) { v0 = v0 && selbit; v1 = v1 && selbit; }
                float e0 = __builtin_amdgcn_exp2f(__builtin_fmaf(p0[r], LOG2E, __builtin_fmaf(sls, (float)ro0, nb)));
                float e1 = __builtin_amdgcn_exp2f(__builtin_fmaf(p1[r], LOG2E, __builtin_fmaf(sls, (float)ro1, nb)));
                e0 = v0 ? e0 : 0.f; e1 = v1 ? e1 : 0.f;
                if (MODE == 1) { e0 *= inv; e1 *= inv; }
                p0[r] = e0; p1[r] = e1; rs_ += e0 + e1;
            }
            lsum += rs_;
            if (MODE == 1) {
#pragma unroll
                for (int kt = 0; kt < 2; ++kt)
#pragma unroll
                    for (int i = 0; i < 4; ++i) {
                        float g = kt ? (p1[4 * i] + p1[4 * i + 1]) + (p1[4 * i + 2] + p1[4 * i + 3]) : (p0[4 * i] + p0[4 * i + 1]) + (p0[4 * i + 2] + p0[4 * i + 3]);
                        float l3 = kt ? p1[4 * i + 3] : p0[4 * i + 3];
                        g += __shfl_xor(g, 1); g += __shfl_xor(g, 2); l3 += __shfl_xor(l3, 1); l3 += __shfl_xor(l3, 2);
                        if ((c & 3) == 0) { const int jj = j * 16 + kt * 8 + 2 * i + hi; __hip_atomic_fetch_add(impw + L.qi * NL_IMP_STRIDE + jj, g, __ATOMIC_RELAXED, __HIP_MEMORY_SCOPE_WORKGROUP); __hip_atomic_fetch_add(impw + L.qi * NL_IMP_STRIDE + jj + 1, l3, __ATOMIC_RELAXED, __HIP_MEMORY_SCOPE_WORKGROUP); }
                    }
            }
            if (MODE != 0) {
                bf16x8 pf[4];
#pragma unroll
                for (int s4 = 0; s4 < 4; ++s4) { u32x4 w;
#pragma unroll
                    for (int e = 0; e < 4; ++e) { const int r = 8 * (s4 & 1) + 2 * e; w[e] = (s4 >> 1) ? cvtpk(p1[r], p1[r + 1]) : cvtpk(p0[r], p0[r + 1]); }
                    pf[s4] = __builtin_bit_cast(bf16x8, w); }
                const int g4 = lane >> 4, sub = g4 & 1, i16 = lane & 15, qq = i16 >> 2, pp = i16 & 3;
#pragma unroll
                for (int dt = 0; dt < 2; ++dt)
#pragma unroll
                    for (int s4 = 0; s4 < 4; ++s4) {
                        const int row = 16 * s4 + 4 * hi + qq, ch = 4 * dt + 2 * sub + (pp >> 1);
                        const s16x4 lo = lds_tr(vb + off_v128(row, ch) + 8 * (pp & 1)), hh = lds_tr(vb + off_v128(row + 8, ch) + 8 * (pp & 1));
                        const bf16x8 vf = (bf16x8){lo[0], lo[1], lo[2], lo[3], hh[0], hh[1], hh[2], hh[3]};
                        O[dt] = MFMA32(vf, pf[s4], O[dt]);
                    }
            }
        }
        jA = jB; jB = jC; jC = jD; ++it;
    };
    while (jA < 128) {
        step(k0, v0); if (jA >= 128) break;
        step(k1, v1); if (jA >= 128) break;
        step(k2, v2);
    }
    __syncthreads();
}

__device__ __forceinline__ void nsa_unit(const Params& P, LAS unsigned char* lds, int u) {
    const int tid = opaque_tid(), lane = tid & 63, wid = tid >> 6, hi = lane >> 5, c = lane & 31;
    const int b = u >> 8, g = (u >> 7) & 1, qb = u & 127;
    const bf16_t* qg = (const bf16_t*)(P.ws + WS_Q); const bf16_t* kv = (const bf16_t*)(P.ws + WS_KV);
    const bf16_t* kcn = (const bf16_t*)(P.ws + WS_KC) + (size_t)(b * 2 + g) * 512 * 64; const bf16_t* vcc = (const bf16_t*)(P.ws + WS_VC) + (size_t)(b * 2 + g) * 512 * 64;
    const float* gates = (const float*)(P.ws + WS_GATES); bf16_t* mix = (bf16_t*)(P.ws + WS_MIX);
    LAS float* impw = (LAS float*)(lds + NL_IMP) + wid * 8 * NL_IMP_STRIDE;
    LAS unsigned long long* selm = (LAS unsigned long long*)(lds + NL_SELM);
    NsaLane L; L.qi = c >> 2; const int hh = c & 3, head = g * 4 + hh;
    L.t = qb * 64 + wid * 8 + L.qi; L.sl2 = exp2f(-(float)(head + 1)) * LOG2E; L.mlo = 0; L.mhi = 0;
    const size_t tok = (size_t)b * SEQ + L.t;
    bf16x8 qf[4];
#pragma unroll
    for (int ks = 0; ks < 4; ++ks) qf[ks] = *(const bf16x8*)(qg + tok * 512 + head * 64 + 16 * ks + 8 * hi);
    for (int i = lane; i < 8 * NL_IMP_STRIDE; i += 64) impw[i] = 0.f;
    const int ncmp = qb * 4 + 3 < 511 ? qb * 4 + 3 : 511;
    const int nblk = (ncmp + 63) >> 6;
    const unsigned long long cm = nblk >= 64 ? ~0ull : ((1ull << nblk) - 1ull);
    f32x16 O[2], Ot[2]; float lsum = 0.f;
    O[0] = f32x16{}; O[1] = f32x16{};
    nsa_pass<0>(lds, kcn, vcc, 64, cm, 0ull, qf, L, 1.f, lsum, O, impw);
    lsum += __shfl_xor(lsum, 32);
    const float invc = 1.0f / fmaxf(lsum, 1e-30f);
    float dummy = 0.f;
    nsa_pass<1>(lds, kcn, vcc, 64, cm, 0ull, qf, L, invc, dummy, O, impw);
    const float* gt = gates + tok * 24 + g * 12 + hh * 3;
    const float g0 = gt[0], g1 = gt[1], g2 = gt[2];
#pragma unroll
    for (int dt = 0; dt < 2; ++dt) Ot[dt] = O[dt] * g0;
    {
        const int ncausal = qb + 1;
        for (int qi = 0; qi < 8; ++qi) {
            unsigned long long lo, hi64;
            if (ncausal <= 16) { lo = (1ull << ncausal) - 1ull; hi64 = 0ull; }
            else {
                const int j0 = lane, j1 = lane + 64;
                const bool f0 = (j0 == 0) || (j0 == qb) || (j0 == qb - 1), f1 = (j1 == qb) || (j1 == qb - 1);
                const unsigned k0 = (j0 <= qb && !f0) ? (0x80000000u | (__float_as_uint(impw[qi * NL_IMP_STRIDE + j0]) & 0x7fffff80u) | (unsigned)j0) : 0u;
                const unsigned k1 = (j1 <= qb && !f1) ? (0x80000000u | (__float_as_uint(impw[qi * NL_IMP_STRIDE + j1]) & 0x7fffff80u) | (unsigned)j1) : 0u;
                const int needn = 13;
                unsigned th = 0u;
                for (int bit = 31; bit >= 0; --bit) { const unsigned cand = th | (1u << bit);
                    const int cnt = __popcll(__ballot(k0 >= cand)) + __popcll(__ballot(k1 >= cand));
                    if (cnt >= needn) th = cand; }
                lo = __ballot(f0 || (k0 >= th && k0 != 0u)); hi64 = __ballot(f1 || (k1 >= th && k1 != 0u));
            }
            if (lane == 0) { selm[(wid * 8 + qi) * 2] = lo; selm[(wid * 8 + qi) * 2 + 1] = hi64; }
        }
    }
    __syncthreads();
    unsigned long long ulo = selm[lane * 2], uhi = selm[lane * 2 + 1];
#pragma unroll
    for (int o = 1; o < 64; o <<= 1) { ulo |= __shfl_xor(ulo, o); uhi |= __shfl_xor(uhi, o); }
    L.mlo = selm[(wid * 8 + L.qi) * 2]; L.mhi = selm[(wid * 8 + L.qi) * 2 + 1];
    const bf16_t* kvb = kv + (size_t)b * SEQ * 768 + g * 64;
    O[0] = f32x16{}; O[1] = f32x16{}; lsum = 0.f;
    nsa_pass<2>(lds, kvb + 256, kvb + 384, 768, ulo, uhi, qf, L, 1.f, lsum, O, impw);
    lsum += __shfl_xor(lsum, 32);
    { const float sc = g1 / fmaxf(lsum, 1e-30f);
#pragma unroll
      for (int dt = 0; dt < 2; ++dt) Ot[dt] += O[dt] * sc; }
    {
        const int jlo = qb >= 8 ? qb - 8 : 0;
        unsigned long long wlo = 0ull, whi = 0ull;
        for (int jj = jlo; jj <= qb; ++jj) { if (jj < 64) wlo |= 1ull << jj; else whi |= 1ull << (jj - 64); }
        O[0] = f32x16{}; O[1] = f32x16{}; lsum = 0.f;
        nsa_pass<3>(lds, kvb + 512, kvb + 640, 768, wlo, whi, qf, L, 1.f, lsum, O, impw);
        lsum += __shfl_xor(lsum, 32);
        const float sc = g2 / fmaxf(lsum, 1e-30f);
#pragma unroll
        for (int dt = 0; dt < 2; ++dt) Ot[dt] += O[dt] * sc;
    }
    float ss = 0.f;
#pragma unroll
    for (int dt = 0; dt < 2; ++dt)
#pragma unroll
        for (int r = 0; r < 16; ++r) ss += Ot[dt][r] * Ot[dt][r];
    ss += __shfl_xor(ss, 32);
    const float rstd = rsqrtf(ss * (1.f / 64.f) + RMS_EPS);
#pragma unroll
    for (int dt = 0; dt < 2; ++dt)
#pragma unroll
        for (int r4 = 0; r4 < 4; ++r4) { const int d = 32 * dt + 8 * r4 + 4 * hi; const f32x4 w = *(const f32x4*)(P.attn_out_norm_w + head * 64 + d);
            u32x2 pk; pk.x = cvtpk(Ot[dt][4 * r4] * rstd * w.x, Ot[dt][4 * r4 + 1] * rstd * w.y); pk.y = cvtpk(Ot[dt][4 * r4 + 2] * rstd * w.z, Ot[dt][4 * r4 + 3] * rstd * w.w);
            *(u32x2*)(mix + tok * 1024 + head * 64 + d) = pk; }
    __syncthreads();
}


__device__ __forceinline__ int gu_hcol(int m0) { const int ni = (m0 >> 4) & 7; return 64 * (m0 >> 7) + 32 * (ni >> 2) + 8 * ((m0 & 15) >> 2) + 4 * ((ni >> 1) & 1); }
__device__ __forceinline__ int p2_col(int m0) { const int ni = (m0 >> 4) & 7; return 128 * (m0 >> 7) + 32 * (ni >> 1) + 8 * ((m0 & 15) >> 2) + 4 * (ni & 1); }
__device__ __forceinline__ void phase_cvt_small(const Params& P) {
    const int tid = threadIdx.x;
    {
        const int gt = blockIdx.x * NTHREADS + tid, NG = gridDim.x * NTHREADS;
        bf16_t* wo = (bf16_t*)(P.ws + WS_WOUT); bf16_t* wrs = (bf16_t*)(P.ws + WS_WRS); bf16_t* wsd = (bf16_t*)(P.ws + WS_WSD);
        for (int i = gt; i < 1024 * 128; i += NG) { const int k = i >> 7, m0 = (i & 127) * 8; const float* s = P.w_out + (size_t)k * 1024 + (m0 & ~255) + p2_col(m0 & 255);
            const f32x4 a = *(const f32x4*)s, b2 = *(const f32x4*)(s + 8);
            *(u32x4*)(wo + (size_t)i * 8) = (u32x4){cvtpk(a.x, a.y), cvtpk(a.z, a.w), cvtpk(b2.x, b2.y), cvtpk(b2.z, b2.w)}; }
        for (int i = gt; i < 256 * 128; i += NG) { const int k = i >> 7, m0 = (i & 127) * 8; const float* s = P.sh_wd + (size_t)k * 1024 + (m0 & ~255) + p2_col(m0 & 255);
            const f32x4 a = *(const f32x4*)s, b2 = *(const f32x4*)(s + 8);
            *(u32x4*)(wsd + (size_t)i * 8) = (u32x4){cvtpk(a.x, a.y), cvtpk(a.z, a.w), cvtpk(b2.x, b2.y), cvtpk(b2.z, b2.w)}; }
        for (int i = gt; i < 1024 * 96; i += NG) { const int k = i / 96, c8 = (i % 96) * 8;
            const float* s; int d2 = 4;
            if (c8 < 256) s = P.router_w + (size_t)k * 256 + c8;
            else { const int cc = c8 - 256, t = cc >> 8; s = ((cc & 16) ? P.sh_wu : P.sh_wg) + (size_t)k * 256 + t * 128 + gu_hcol(cc & 255); d2 = 8; }
            const f32x4 a = *(const f32x4*)s, b2 = *(const f32x4*)(s + d2);
            *(u32x4*)(wrs + (size_t)k * 768 + c8) = (u32x4){cvtpk(a.x, a.y), cvtpk(a.z, a.w), cvtpk(b2.x, b2.y), cvtpk(b2.z, b2.w)}; }
    }
}

__device__ __forceinline__ void route_token(const Params& P, int t, int lane) {
    const float* scores = (const float*)(P.ws + WS_SCORES) + (size_t)t * 256;
    const f32x4 s4 = *(const f32x4*)(scores + 4 * lane); const f32x4 b4 = *(const f32x4*)(P.router_bias + 4 * lane);
    float sc[4] = {s4.x, s4.y, s4.z, s4.w};
    float bs[4] = {s4.x + b4.x, s4.y + b4.y, s4.z + b4.z, s4.w + b4.w};
    float m1 = fmaxf(bs[0], bs[1]), m2 = fminf(bs[0], bs[1]);
    { const float v = bs[2]; const float n1 = fmaxf(m1, v); m2 = fmaxf(fminf(m1, v), m2); m1 = n1; }
    { const float v = bs[3]; const float n1 = fmaxf(m1, v); m2 = fmaxf(fminf(m1, v), m2); m1 = n1; }
#pragma unroll
    for (int o = 1; o < 8; o <<= 1) { const float o1 = __shfl_xor(m1, o), o2 = __shfl_xor(m2, o); const float n1 = fmaxf(m1, o1); m2 = fmaxf(fminf(m1, o1), fmaxf(m2, o2)); m1 = n1; }
    const float gs = m1 + m2;
    const int grp = lane >> 3;
    int rank = 0;
#pragma unroll
    for (int g2 = 0; g2 < 8; ++g2) { const float og = __shfl(gs, g2 * 8); rank += (og > gs || (og == gs && g2 < grp)) ? 1 : 0; }
    const bool gsel = rank < 4;
    float mv[4];
#pragma unroll
    for (int i = 0; i < 4; ++i) mv[i] = gsel ? bs[i] : -INFINITY;
    int myidx = -1; float myw = 0.f; float wsum = 0.f;
#pragma unroll 1
    for (int k = 0; k < 8; ++k) {
        float bv = mv[0]; int bi = 4 * lane;
#pragma unroll
        for (int i = 1; i < 4; ++i) if (mv[i] > bv) { bv = mv[i]; bi = 4 * lane + i; }
#pragma unroll
        for (int o = 1; o < 64; o <<= 1) { const float ov = __shfl_xor(bv, o); const int oi = __shfl_xor(bi, o); if (ov > bv || (ov == bv && oi < bi)) { bv = ov; bi = oi; } }
        const int wl = bi >> 2, wc = bi & 3;
        const float mine = wc == 0 ? sc[0] : (wc == 1 ? sc[1] : (wc == 2 ? sc[2] : sc[3]));
        const float wv = __shfl(mine, wl);
        wsum += wv;
        if (lane == k) { myidx = bi; myw = wv; }
        if (lane == wl) {
#pragma unroll
            for (int i = 0; i < 4; ++i) if (i == wc) mv[i] = -INFINITY; }
    }
    if (lane < 8) {
        int* cnt = (int*)(P.ws + WS_CTL + CTL_CNT);
        const int pos = atomicAdd(cnt + myidx, 1);
        if (pos < BCAP) ((int*)(P.ws + WS_BUCKET))[(size_t)myidx * BCAP + pos] = t * 8 + lane;
        ((float*)(P.ws + WS_RW))[(size_t)t * 8 + lane] = myw / wsum * 2.5f;
    }
}


__device__ __forceinline__ void phase_p4a(const Params& P, LAS unsigned char* lds) {
    typedef Gemm3 G;
    const int tid = opaque_tid(), lane = tid & 63, wid = tid >> 6, wm = wid >> 1, wn = wid & 1, fr = lane & 15, fq = lane >> 4;
    struct F { const Params& P;
        __device__ __forceinline__ void ptrs(int seg, const bf16_t* (&aptr)[2], const bf16_t* (&bptr)[2]) const {
            const int tid = opaque_tid(), lane = tid & 63, wid = tid >> 6, wm = wid >> 1, wn = wid & 1, fr = lane & 15, fq = lane >> 4, c8 = 8 * (tid & 31); (void)wm; (void)wn; (void)fr; (void)fq; (void)c8;
            const int u = blockIdx.x + seg * gridDim.x, rt = u >> 2, ct = u & 3;
            const bf16_t* mix = (const bf16_t*)(P.ws + WS_MIX); const bf16_t* wo = (const bf16_t*)(P.ws + WS_WOUT);
#pragma unroll
            for (int i = 0; i < 2; ++i) { const int row = G::a_row(i, wid, lane); aptr[i] = mix + (size_t)(rt * 256 + row) * 1024 + G::a_chunk(row, lane) * 8;
                const int k = G::b_k(i, wid, lane); bptr[i] = wo + (size_t)k * 1024 + ct * 256 + G::b_n(k, lane); } }
        __device__ __forceinline__ void epi(int seg, f32x4 (&acc)[4][8]) const {
            const int tid = opaque_tid(), lane = tid & 63, wid = tid >> 6, wm = wid >> 1, wn = wid & 1, fr = lane & 15, fq = lane >> 4, c8 = 8 * (tid & 31); (void)wm; (void)wn; (void)fr; (void)fq; (void)c8;
            const int u = blockIdx.x + seg * gridDim.x, rt = u >> 2, ct = u & 3, b = (rt * 256) / SEQ;
            const float* mod = (const float*)(P.ws + WS_MOD) + b * 6144; float* ssp = (float*)(P.ws + WS_SS); bf16_t* x1 = (bf16_t*)(P.ws + WS_X1);
#pragma unroll
            for (int mi = 0; mi < 4; ++mi) { const size_t m = (size_t)(rt * 256 + wm * 64 + mi * 16 + fr); float ss = 0.f;
#pragma unroll
                for (int j = 0; j < 4; ++j) { const int col = ct * 256 + wn * 128 + j * 32 + 8 * fq;
                    const f32x4 xv = *(const f32x4*)(P.x + m * 1024 + col), xw = *(const f32x4*)(P.x + m * 1024 + col + 4), gv = *(const f32x4*)(mod + 2048 + col), gw = *(const f32x4*)(mod + 2048 + col + 4);
                    const f32x4 a = acc[mi][2 * j], c = acc[mi][2 * j + 1];
                    f32x4 o, o2; o.x = xv.x + gv.x * a.x; o.y = xv.y + gv.y * a.y; o.z = xv.z + gv.z * a.z; o.w = xv.w + gv.w * a.w;
                    o2.x = xw.x + gw.x * c.x; o2.y = xw.y + gw.y * c.y; o2.z = xw.z + gw.z * c.z; o2.w = xw.w + gw.w * c.w;
                    *(u32x4*)(x1 + m * 1024 + col) = (u32x4){cvtpk(o.x, o.y), cvtpk(o.z, o.w), cvtpk(o2.x, o2.y), cvtpk(o2.z, o2.w)};
                    ss += ((o.x * o.x + o.y * o.y) + (o.z * o.z + o.w * o.w)) + ((o2.x * o2.x + o2.y * o2.y) + (o2.z * o2.z + o2.w * o2.w)); if (j & 1) asm volatile("" ::: "memory"); }
                ss += __shfl_xor(ss, 16); ss += __shfl_xor(ss, 32);
                if (fq == 0) ssp[m * 8 + ct * 2 + wn] = ss; } }
    } f{P};
    const int nu = (128 * 4 - (int)blockIdx.x + (int)gridDim.x - 1) / (int)gridDim.x;
    if (nu > 0) G::run_stream(f, nu, 32, 32, (size_t)32 * 1024, lds);
}
__device__ __forceinline__ void phase_p4b(const Params& P) {
    const int lane = threadIdx.x & 63, gw = blockIdx.x * (NTHREADS / 64) + (threadIdx.x >> 6), NGW = gridDim.x * (NTHREADS / 64);
    const float* ssp = (const float*)(P.ws + WS_SS); bf16_t* h2 = (bf16_t*)(P.ws + WS_H);
    for (int m = gw; m < T; m += NGW) {
        const float* mod = (const float*)(P.ws + WS_MOD) + (m / SEQ) * 6144;
        const f32x4 s0 = *(const f32x4*)(ssp + (size_t)m * 8), s1 = *(const f32x4*)(ssp + (size_t)m * 8 + 4);
        const float rstd = rsqrtf(((s0.x + s0.y) + (s0.z + s0.w) + (s1.x + s1.y) + (s1.z + s1.w)) * (1.f / 1024.f) + RMS_EPS);
#pragma unroll
        for (int j = 0; j < 4; ++j) { const int col = (lane + 64 * j) * 4;
            const u32x2 xr = *(const u32x2*)((const bf16_t*)(P.ws + WS_X1) + (size_t)m * 1024 + col);
            const f32x4 v = (f32x4){__uint_as_float(xr.x << 16), __uint_as_float(xr.x & 0xffff0000u), __uint_as_float(xr.y << 16), __uint_as_float(xr.y & 0xffff0000u)}, wv = *(const f32x4*)(P.norm2_w + col), scv = *(const f32x4*)(mod + 4096 + col), shv = *(const f32x4*)(mod + 3072 + col);
            const float r0 = v.x * rstd * wv.x * (1.f + scv.x) + shv.x, r1 = v.y * rstd * wv.y * (1.f + scv.y) + shv.y, r2 = v.z * rstd * wv.z * (1.f + scv.z) + shv.z, r3 = v.w * rstd * wv.w * (1.f + scv.w) + shv.w;
            u32x2 pk; pk.x = cvtpk(r0, r1); pk.y = cvtpk(r2, r3);
            *(u32x2*)(h2 + (size_t)m * 1024 + col) = pk;
            int q8 = __builtin_amdgcn_cvt_pk_fp8_f32(r0, r1, 0, false); q8 = __builtin_amdgcn_cvt_pk_fp8_f32(r2, r3, q8, true);
            *(int*)((unsigned char*)(P.ws + WS_H2Q) + (size_t)m * 1024 + col) = q8; }
    }
}
__device__ __forceinline__ void phase_p4c(const Params& P, LAS unsigned char* lds) {
    typedef Gemm3 G;
    const int tid = opaque_tid(), lane = tid & 63, wid = tid >> 6, wm = wid >> 1, wn = wid & 1, fr = lane & 15, fq = lane >> 4;
    struct F { const Params& P;
        __device__ __forceinline__ void ptrs(int seg, const bf16_t* (&aptr)[2], const bf16_t* (&bptr)[2]) const {
            const int tid = opaque_tid(), lane = tid & 63, wid = tid >> 6, wm = wid >> 1, wn = wid & 1, fr = lane & 15, fq = lane >> 4, c8 = 8 * (tid & 31); (void)wm; (void)wn; (void)fr; (void)fq; (void)c8;
            const int u = blockIdx.x + seg * gridDim.x, rt = u / 3, ct = u % 3;
            const bf16_t* h2 = (const bf16_t*)(P.ws + WS_H); const bf16_t* wrs = (const bf16_t*)(P.ws + WS_WRS);
#pragma unroll
            for (int i = 0; i < 2; ++i) { const int row = G::a_row(i, wid, lane); aptr[i] = h2 + (size_t)(rt * 256 + row) * 1024 + G::a_chunk(row, lane) * 8;
                const int k = G::b_k(i, wid, lane); bptr[i] = wrs + (size_t)k * 768 + ct * 256 + G::b_n(k, lane); } }
        __device__ __forceinline__ void epi(int seg, f32x4 (&acc)[4][8]) const {
            const int tid = opaque_tid(), lane = tid & 63, wid = tid >> 6, wm = wid >> 1, wn = wid & 1, fr = lane & 15, fq = lane >> 4, c8 = 8 * (tid & 31); (void)wm; (void)wn; (void)fr; (void)fq; (void)c8;
            const int u = blockIdx.x + seg * gridDim.x, rt = u / 3, ct = u % 3;
            float* scores = (float*)(P.ws + WS_SCORES); bf16_t* hidS = (bf16_t*)(P.ws + WS_HIDS);
#pragma unroll
            for (int mi = 0; mi < 4; ++mi) { const size_t m = (size_t)(rt * 256 + wm * 64 + mi * 16 + fr);
                if (ct == 0) {
#pragma unroll
                    for (int ni = 0; ni < 8; ++ni) { const f32x4 a = acc[mi][ni];
                        *(f32x4*)(scores + m * 256 + wn * 128 + ni * 16 + 4 * fq) = (f32x4){sigmoidf_(a.x), sigmoidf_(a.y), sigmoidf_(a.z), sigmoidf_(a.w)}; }
                } else {
#pragma unroll
                    for (int j2 = 0; j2 < 2; ++j2) { const f32x4 g = acc[mi][4 * j2], uu = acc[mi][4 * j2 + 1], g2 = acc[mi][4 * j2 + 2], u2 = acc[mi][4 * j2 + 3];
                        u32x4 pk; pk.x = cvtpk(siluf_(g.x) * uu.x, siluf_(g.y) * uu.y); pk.y = cvtpk(siluf_(g.z) * uu.z, siluf_(g.w) * uu.w);
                        pk.z = cvtpk(siluf_(g2.x) * u2.x, siluf_(g2.y) * u2.y); pk.w = cvtpk(siluf_(g2.z) * u2.z, siluf_(g2.w) * u2.w);
                        *(u32x4*)(hidS + m * 256 + (ct - 1) * 128 + wn * 64 + j2 * 32 + 8 * fq) = pk; }
                } } }
    } f{P};
    const int nu = (128 * 3 - (int)blockIdx.x + (int)gridDim.x - 1) / (int)gridDim.x;
    if (nu > 0) G::run_stream(f, nu, 32, 32, (size_t)32 * 768, lds);
}
__device__ __forceinline__ void phase_route(const Params& P) {
    const int tid = opaque_tid(), lane = tid & 63, gw = blockIdx.x * (NTHREADS / 64) + (tid >> 6), NGW = gridDim.x * (NTHREADS / 64);
    for (int t = gw; t < T; t += NGW) route_token(P, t, lane);
}
__device__ __forceinline__ void phase_p4d(const Params& P, LAS unsigned char* lds) {
    typedef Gemm3 G;
    const int tid = opaque_tid(), lane = tid & 63, wid = tid >> 6, wm = wid >> 1, wn = wid & 1, fr = lane & 15, fq = lane >> 4;
    struct F { const Params& P;
        __device__ __forceinline__ void ptrs(int seg, const bf16_t* (&aptr)[2], const bf16_t* (&bptr)[2]) const {
            const int tid = opaque_tid(), lane = tid & 63, wid = tid >> 6, wm = wid >> 1, wn = wid & 1, fr = lane & 15, fq = lane >> 4, c8 = 8 * (tid & 31); (void)wm; (void)wn; (void)fr; (void)fq; (void)c8;
            const int u = blockIdx.x + seg * gridDim.x, rt = u >> 2, ct = u & 3;
            const bf16_t* hidS = (const bf16_t*)(P.ws + WS_HIDS); const bf16_t* wsd = (const bf16_t*)(P.ws + WS_WSD);
#pragma unroll
            for (int i = 0; i < 2; ++i) { const int row = G::a_row(i, wid, lane); aptr[i] = hidS + (size_t)(rt * 256 + row) * 256 + G::a_chunk(row, lane) * 8;
                const int k = G::b_k(i, wid, lane); bptr[i] = wsd + (size_t)k * 1024 + ct * 256 + G::b_n(k, lane); } }
        __device__ __forceinline__ void epi(int seg, f32x4 (&acc)[4][8]) const {
            const int tid = opaque_tid(), lane = tid & 63, wid = tid >> 6, wm = wid >> 1, wn = wid & 1, fr = lane & 15, fq = lane >> 4, c8 = 8 * (tid & 31); (void)wm; (void)wn; (void)fr; (void)fq; (void)c8;
            const int u = blockIdx.x + seg * gridDim.x, rt = u >> 2, ct = u & 3;
            unsigned char* ysh = (unsigned char*)(P.ws + WS_YSH);
#pragma unroll
            for (int mi = 0; mi < 4; ++mi) { const size_t m = (size_t)(rt * 256 + wm * 64 + mi * 16 + fr);
#pragma unroll
                for (int j = 0; j < 4; ++j) { const int col = ct * 256 + wn * 128 + j * 32 + 8 * fq; const f32x4 a = acc[mi][2 * j] * Y_SCALE, c = acc[mi][2 * j + 1] * Y_SCALE;
                    *(u32x2*)(ysh + m * 1024 + col) = (u32x2){pk4_fp8(a.x, a.y, a.z, a.w), pk4_fp8(c.x, c.y, c.z, c.w)}; } } }
    } f{P};
    const int nu = (128 * 4 - (int)blockIdx.x + (int)gridDim.x - 1) / (int)gridDim.x;
    if (nu > 0) G::run_stream(f, nu, 8, 32, (size_t)32 * 1024, lds);
}

__device__ __forceinline__ void phase_expert_cvt(const Params& P) {
    const size_t gt = (size_t)blockIdx.x * NTHREADS + threadIdx.x, NG = (size_t)gridDim.x * NTHREADS;
    bf16_t* wgu = (bf16_t*)(P.ws + WS_WBGU); bf16_t* wd = (bf16_t*)(P.ws + WS_WBD);
    for (size_t i = gt; i < (size_t)256 * 1024 * 64; i += NG) {
        const size_t ek = i >> 6; const int c8 = (int)(i & 63) * 8, t = c8 >> 8;
        const float* s = ((c8 & 16) ? P.exp_wu : P.exp_wg) + ek * 256 + t * 128 + gu_hcol(c8 & 255);
        const f32x4 a = __builtin_nontemporal_load((const f32x4*)s), b2 = __builtin_nontemporal_load((const f32x4*)(s + 8));
        *(u32x4*)(wgu + ek * 512 + c8) = (u32x4){cvtpk(a.x, a.y), cvtpk(a.z, a.w), cvtpk(b2.x, b2.y), cvtpk(b2.z, b2.w)}; }
    for (size_t i = gt; i < (size_t)256 * 256 * 128; i += NG) {
        const size_t ek = i >> 7; const int m0 = (int)(i & 127) * 8, tl = m0 & 255, tile = m0 >> 8;
        const int wnn = tl >> 7, nii = (tl >> 4) & 7, n0 = tl & 15;
        const int ca = tile * 256 + wnn * 128 + 64 * (nii >> 2) + 16 * (n0 >> 2) + 4 * (nii & 3);
        const f32x4 a = __builtin_nontemporal_load((const f32x4*)(P.exp_wd + ek * 1024 + ca)), b2 = __builtin_nontemporal_load((const f32x4*)(P.exp_wd + ek * 1024 + ca + 16));
        *(u32x4*)(wd + ek * 1024 + m0) = (u32x4){cvtpk(a.x, a.y), cvtpk(a.z, a.w), cvtpk(b2.x, b2.y), cvtpk(b2.z, b2.w)}; }
}

constexpr int P6_TILES = 128 * 1024, P6_PRE = P6_TILES + 1024, P6_PAIR = P6_PRE + 1040, P6_W = P6_PAIR + 1024;
__device__ __forceinline__ void phase_experts(const Params& P, LAS unsigned char* lds) {
    typedef Gemm3 G;
    const int tid = opaque_tid(), lane = tid & 63, wid = tid >> 6, wm = wid >> 1, wn = wid & 1, fr = lane & 15, fq = lane >> 4;
    const int* cnt = (const int*)(P.ws + WS_CTL + CTL_CNT); const int* bucket = (const int*)(P.ws + WS_BUCKET); const float* rw = (const float*)(P.ws + WS_RW);
    const bf16_t* h2 = (const bf16_t*)(P.ws + WS_H); bf16_t* hidR = (bf16_t*)(P.ws + WS_HIDR) + (size_t)blockIdx.x * 256 * 256; unsigned char* y = (unsigned char*)(P.ws + WS_Y);
    LAS int* tiles = (LAS int*)(lds + P6_TILES); LAS int* pre = (LAS int*)(lds + P6_PRE); LAS int* pairs = (LAS int*)(lds + P6_PAIR); LAS float* wts = (LAS float*)(lds + P6_W);
    const int nx = (gridDim.x % 8 == 0) ? 8 : 1, xl = blockIdx.x % nx, li = blockIdx.x / nx, nloc = gridDim.x / nx, nek = 256 / nx;
    if (tid < nek) { const int c_ = cnt[xl + nx * tid]; tiles[tid] = ((c_ < BCAP ? c_ : BCAP) + 255) >> 8; }
    __syncthreads();
    if (tid < nek) { int s = 0; for (int i = 0; i < tid; ++i) s += tiles[i]; pre[tid] = s; if (tid == nek - 1) pre[nek] = s + tiles[nek - 1]; }
    __syncthreads();
    const int total = pre[nek];
    const int c8 = 8 * (tid & 31), u16 = c8 >> 4;
    for (int u = li; u < total; u += nloc) {
        int lo = 0, hi = nek - 1;
        while (lo < hi) { const int mid = (lo + hi + 1) >> 1; if (pre[mid] <= u) lo = mid; else hi = mid - 1; }
        const int e = xl + nx * lo, tile = u - pre[lo], n = cnt[e] < BCAP ? cnt[e] : BCAP, rows = (n - tile * 256) < 256 ? (n - tile * 256) : 256;
        if (tid < 256) { const int r = tid < rows ? tid : 0; const int pr = bucket[(size_t)e * BCAP + tile * 256 + r]; pairs[tid] = pr; wts[tid] = tid < rows ? rw[pr] : 0.f; }
        __syncthreads();
        {
            struct GU { const bf16_t* h2; LAS int* pairs; const bf16_t* wgu; bf16_t* hidR;
                __device__ __forceinline__ void ptrs(int t, const bf16_t* (&aptr)[2], const bf16_t* (&bptr)[2]) const {
                    const int tid = opaque_tid(), lane = tid & 63, wid = tid >> 6, wm = wid >> 1, wn = wid & 1, fr = lane & 15, fq = lane >> 4, c8 = 8 * (tid & 31); (void)wm; (void)wn; (void)fr; (void)fq; (void)c8;
#pragma unroll
                    for (int i = 0; i < 2; ++i) { const int row = G::a_row(i, wid, lane); aptr[i] = h2 + (size_t)(pairs[row] >> 3) * 1024 + G::a_chunk(row, lane) * 8;
                        const int k = G::b_k(i, wid, lane); bptr[i] = wgu + (size_t)k * 512 + t * 256 + G::b_n(k, lane); } }
                __device__ __forceinline__ void epi(int t, f32x4 (&acc)[4][8]) const {
                    const int tid = opaque_tid(), lane = tid & 63, wid = tid >> 6, wm = wid >> 1, wn = wid & 1, fr = lane & 15, fq = lane >> 4, c8 = 8 * (tid & 31); (void)wm; (void)wn; (void)fr; (void)fq; (void)c8;
#pragma unroll
                    for (int mi = 0; mi < 4; ++mi) { const int rl = wm * 64 + mi * 16 + fr;
#pragma unroll
                        for (int j2 = 0; j2 < 2; ++j2) { const f32x4 g = acc[mi][4 * j2], uu = acc[mi][4 * j2 + 1], g2 = acc[mi][4 * j2 + 2], u2 = acc[mi][4 * j2 + 3];
                            u32x4 pk; pk.x = cvtpk(siluf_(g.x) * uu.x, siluf_(g.y) * uu.y); pk.y = cvtpk(siluf_(g.z) * uu.z, siluf_(g.w) * uu.w);
                            pk.z = cvtpk(siluf_(g2.x) * u2.x, siluf_(g2.y) * u2.y); pk.w = cvtpk(siluf_(g2.z) * u2.z, siluf_(g2.w) * u2.w);
                            *(u32x4*)(hidR + rl * 256 + t * 128 + wn * 64 + j2 * 32 + 8 * fq) = pk; } } }
            } f{h2, pairs, (const bf16_t*)(P.ws + WS_WBGU) + (size_t)e * 1024 * 512, hidR};
            G::run_stream(f, 2, 32, 32, (size_t)32 * 512, lds);
        }
        __syncthreads();
        {
            struct DN { bf16_t* hidR; const bf16_t* wd; unsigned char* y; LAS int* pairs; LAS float* wts; int rows;
                __device__ __forceinline__ void ptrs(int ct, const bf16_t* (&aptr)[2], const bf16_t* (&bptr)[2]) const {
                    const int tid = opaque_tid(), lane = tid & 63, wid = tid >> 6, wm = wid >> 1, wn = wid & 1, fr = lane & 15, fq = lane >> 4, c8 = 8 * (tid & 31); (void)wm; (void)wn; (void)fr; (void)fq; (void)c8;
#pragma unroll
                    for (int i = 0; i < 2; ++i) { const int row = G::a_row(i, wid, lane); aptr[i] = hidR + (size_t)row * 256 + G::a_chunk(row, lane) * 8;
                        const int k = G::b_k(i, wid, lane); bptr[i] = wd + (size_t)k * 1024 + ct * 256 + G::b_n(k, lane); } }
                __device__ __forceinline__ void epi(int ct, f32x4 (&acc)[4][8]) const {
                    const int tid = opaque_tid(), lane = tid & 63, wid = tid >> 6, wm = wid >> 1, wn = wid & 1, fr = lane & 15, fq = lane >> 4, c8 = 8 * (tid & 31); (void)wm; (void)wn; (void)fr; (void)fq; (void)c8;
#pragma unroll
                    for (int mi = 0; mi < 4; ++mi) { const int rl = wm * 64 + mi * 16 + fr; const float wgt = wts[rl]; const size_t pr = (size_t)pairs[rl];
                        if (rl < rows) {
#pragma unroll
                            for (int j2 = 0; j2 < 2; ++j2) { const int col = ct * 256 + wn * 128 + 64 * j2 + 16 * fq; const float sc_ = wgt * Y_SCALE; u32x4 w;
#pragma unroll
                                for (int b2 = 0; b2 < 4; ++b2) { const f32x4 a = acc[mi][4 * j2 + b2] * sc_;
                                    int pk = __builtin_amdgcn_cvt_pk_fp8_f32(a.x, a.y, 0, false); pk = __builtin_amdgcn_cvt_pk_fp8_f32(a.z, a.w, pk, true); w[b2] = (unsigned)pk; }
                                *(u32x4*)(y + pr * 1024 + col) = w; } } } }
            } f{hidR, (const bf16_t*)(P.ws + WS_WBD) + (size_t)e * 256 * 1024, y, pairs, wts, rows};
            G::run_stream(f, 4, 8, 32, (size_t)32 * 1024, lds);
        }
        __syncthreads();
    }
}


__device__ __forceinline__ void phase_expert_cvt8(const Params& P) {
    const int tid = opaque_tid(), lane = tid & 63, gw = blockIdx.x * (NTHREADS / 64) + (tid >> 6), NGW = gridDim.x * (NTHREADS / 64);
    unsigned char* wgu = (unsigned char*)(P.ws + WS_W8GU); unsigned char* wd = (unsigned char*)(P.ws + WS_W8D);
    for (int u = gw; u < 256 * 8 * 8; u += NGW) {
        const int rg = u & 7, kb = (u >> 3) & 7, e = u >> 6;
        const int q = rg * 64 + lane, t = q >> 8, ql = q & 255, wnn = ql >> 7, it = (ql >> 5) & 3, i = ql & 31;
        const int h = t * 128 + wnn * 64 + (it >> 1) * 32 + Gemm8::w_col(i);
        const float* s = ((it & 1) ? P.exp_wu : P.exp_wg) + (size_t)e * 1024 * 256 + (size_t)(kb * 128) * 256 + h;
        unsigned char* o = wgu + ((size_t)e * 512 + q) * 1024 + kb * 128;
        { float v[128];
#pragma unroll
            for (int j = 0; j < 128; ++j) v[j] = __builtin_nontemporal_load(s + (size_t)j * 256);
#pragma unroll
            for (int j = 0; j < 8; ++j) { const float c_ = W8_GU_SCALE; u32x4 w;
                w.x = pk4_fp8(v[16 * j] * c_, v[16 * j + 1] * c_, v[16 * j + 2] * c_, v[16 * j + 3] * c_); w.y = pk4_fp8(v[16 * j + 4] * c_, v[16 * j + 5] * c_, v[16 * j + 6] * c_, v[16 * j + 7] * c_);
                w.z = pk4_fp8(v[16 * j + 8] * c_, v[16 * j + 9] * c_, v[16 * j + 10] * c_, v[16 * j + 11] * c_); w.w = pk4_fp8(v[16 * j + 12] * c_, v[16 * j + 13] * c_, v[16 * j + 14] * c_, v[16 * j + 15] * c_);
                *(u32x4*)(o + j * 16) = w; } }
    }
    for (int u = gw; u < 256 * 2 * 16; u += NGW) {
        const int rg = u & 15, kb = (u >> 4) & 1, e = u >> 5;
        const int q = rg * 64 + lane, i = q & 31;
        const int col = (q & ~31) + Gemm8::w_col(i);
        const float* s = P.exp_wd + (size_t)e * 256 * 1024 + (size_t)(kb * 128) * 1024 + col;
        unsigned char* o = wd + ((size_t)e * 1024 + q) * 256 + kb * 128;
        { float v[128];
#pragma unroll
            for (int j = 0; j < 128; ++j) v[j] = __builtin_nontemporal_load(s + (size_t)j * 1024);
#pragma unroll
            for (int j = 0; j < 8; ++j) { const float c_ = W8_D_SCALE; u32x4 w;
                w.x = pk4_fp8(v[16 * j] * c_, v[16 * j + 1] * c_, v[16 * j + 2] * c_, v[16 * j + 3] * c_); w.y = pk4_fp8(v[16 * j + 4] * c_, v[16 * j + 5] * c_, v[16 * j + 6] * c_, v[16 * j + 7] * c_);
                w.z = pk4_fp8(v[16 * j + 8] * c_, v[16 * j + 9] * c_, v[16 * j + 10] * c_, v[16 * j + 11] * c_); w.w = pk4_fp8(v[16 * j + 12] * c_, v[16 * j + 13] * c_, v[16 * j + 14] * c_, v[16 * j + 15] * c_);
                *(u32x4*)(o + j * 16) = w; } }
    }
}

template <int PM> __device__ __forceinline__ void phase_experts8(const Params& P, LAS unsigned char* lds) {
    typedef Gemm8 G;
    const int tid = opaque_tid();
    const int* cnt = (const int*)(P.ws + WS_CTL + CTL_CNT); const int* bucket = (const int*)(P.ws + WS_BUCKET); const float* rw = (const float*)(P.ws + WS_RW);
    const unsigned char* h2q = (const unsigned char*)(P.ws + WS_H2Q); unsigned char* hidR = (unsigned char*)(P.ws + WS_HIDR) + (size_t)blockIdx.x * 256 * 256; unsigned char* y = (unsigned char*)(P.ws + WS_Y);
    LAS int* tiles = (LAS int*)(lds + P6_TILES); LAS int* pre = (LAS int*)(lds + P6_PRE); LAS int* pairs = (LAS int*)(lds + P6_PAIR); LAS float* wts = (LAS float*)(lds + P6_W);
    const int nx = (gridDim.x % 8 == 0) ? 8 : 1, xl = blockIdx.x % nx, li = blockIdx.x / nx, nloc = gridDim.x / nx, nek = 256 / nx;
    if (tid < nek) { const int c_ = cnt[xl + nx * tid]; tiles[tid] = ((c_ < BCAP ? c_ : BCAP) + 255) >> 8; }
    __syncthreads();
    if (tid < nek) { int s = 0; for (int i = 0; i < tid; ++i) s += tiles[i]; pre[tid] = s; if (tid == nek - 1) pre[nek] = s + tiles[nek - 1]; }
    __syncthreads();
    const int total = pre[nek];
    for (int u = li; u < total; u += nloc) {
        int lo = 0, hi_ = nek - 1;
        while (lo < hi_) { const int mid = (lo + hi_ + 1) >> 1; if (pre[mid] <= u) lo = mid; else hi_ = mid - 1; }
        const int e = xl + nx * lo, tile = u - pre[lo], n = cnt[e] < BCAP ? cnt[e] : BCAP, rows = (n - tile * 256) < 256 ? (n - tile * 256) : 256;
        if (tid < 256) { const int r = tid < rows ? tid : 0; const int pr = bucket[(size_t)e * BCAP + tile * 256 + r]; pairs[tid] = pr; wts[tid] = tid < rows ? rw[pr] : 0.f; }
        __syncthreads();
        {
            struct GU { const unsigned char* h2q; LAS int* pairs; const unsigned char* wgu; unsigned char* hidR;
                static __device__ __forceinline__ int wscale(int it) { return (it & 1) ? 123 : 121; }
                __device__ __forceinline__ void ptrs(int t, const unsigned char* (&aptr)[2], const unsigned char* (&wptr)[2]) const {
                    const int tid = opaque_tid(), lane = tid & 63, wid = tid >> 6;
#pragma unroll
                    for (int i = 0; i < 2; ++i) { const int row = G::t_row(i, wid, lane); aptr[i] = h2q + (size_t)(pairs[row] >> 3) * 1024 + G::t_chunk(row, lane) * 16;
                        wptr[i] = wgu + (size_t)(t * 256 + row) * 1024 + G::t_chunk(row, lane) * 16; } }
                __device__ __forceinline__ void epi(int t, f32x16 (&acc)[2][4]) const {
                    const int tid = opaque_tid(), lane = tid & 63, wid = tid >> 6, wm = wid >> 1, wn = wid & 1, l31 = lane & 31, hi = lane >> 5;
                    if (PM == 2) return;
#pragma unroll
                    for (int jt = 0; jt < 2; ++jt) { const int rl = wm * 64 + jt * 32 + l31;
#pragma unroll
                        for (int p = 0; p < 2; ++p) {
                            float e[16], hv[16];
#pragma unroll
                            for (int r = 0; r < 16; ++r) e[r] = __builtin_amdgcn_exp2f(acc[jt][2 * p][r] * -LOG2E);
                            __builtin_amdgcn_sched_barrier(0);
#pragma unroll
                            for (int r = 0; r < 16; ++r) { e[r] = __builtin_amdgcn_rcpf(1.0f + e[r]); hv[r] = acc[jt][2 * p][r] * acc[jt][2 * p + 1][r]; }
                            __builtin_amdgcn_sched_barrier(0);
                            u32x4 w;
#pragma unroll
                            for (int q4 = 0; q4 < 4; ++q4) w[q4] = pk4_fp8(hv[4 * q4] * e[4 * q4], hv[4 * q4 + 1] * e[4 * q4 + 1], hv[4 * q4 + 2] * e[4 * q4 + 2], hv[4 * q4 + 3] * e[4 * q4 + 3]);
                            *(u32x4*)(hidR + rl * 256 + t * 128 + wn * 64 + p * 32 + 16 * hi) = w; } } }
            } f{h2q, pairs, (const unsigned char*)(P.ws + WS_W8GU) + (size_t)e * 512 * 1024, hidR};
            if (PM != 3) G::run_stream(f, 2, 16, lds);
        }
        __syncthreads();
        {
            struct DN { const unsigned char* hidR; const unsigned char* wd; unsigned char* y; LAS int* pairs; LAS float* wts; int rows;
                static __device__ __forceinline__ int wscale(int) { return 120; }
                __device__ __forceinline__ void ptrs(int ct, const unsigned char* (&aptr)[2], const unsigned char* (&wptr)[2]) const {
                    const int tid = opaque_tid(), lane = tid & 63, wid = tid >> 6;
#pragma unroll
                    for (int i = 0; i < 2; ++i) { const int row = G::t_row(i, wid, lane); aptr[i] = hidR + (size_t)row * 256 + G::t_chunk(row, lane) * 16;
                        wptr[i] = wd + (size_t)(ct * 256 + row) * 256 + G::t_chunk(row, lane) * 16; } }
                __device__ __forceinline__ void epi(int ct, f32x16 (&acc)[2][4]) const {
                    const int tid = opaque_tid(), lane = tid & 63, wid = tid >> 6, wm = wid >> 1, wn = wid & 1, l31 = lane & 31, hi = lane >> 5;
                    if (PM == 3) return;
#pragma unroll
                    for (int jt = 0; jt < 2; ++jt) { const int rl = wm * 64 + jt * 32 + l31; const float sc_ = wts[rl] * Y_SCALE; const size_t pr = (size_t)pairs[rl];
                        if (rl < rows) {
#pragma unroll
                            for (int it = 0; it < 4; ++it) { u32x4 w;
#pragma unroll
                                for (int q4 = 0; q4 < 4; ++q4) w[q4] = pk4_fp8(acc[jt][it][4 * q4] * sc_, acc[jt][it][4 * q4 + 1] * sc_, acc[jt][it][4 * q4 + 2] * sc_, acc[jt][it][4 * q4 + 3] * sc_);
                                *(u32x4*)(y + pr * 1024 + ct * 256 + wn * 128 + it * 32 + 16 * hi) = w; } } } }
            } f{hidR, (const unsigned char*)(P.ws + WS_W8D) + (size_t)e * 1024 * 256, y, pairs, wts, rows};
            if (PM == 0 || PM == 3) G::run_stream(f, 4, 4, lds);
        }
        __syncthreads();
    }
}

__device__ __forceinline__ void phase_combine(const Params& P) {
    const int lane = threadIdx.x & 63, gw = blockIdx.x * (NTHREADS / 64) + (threadIdx.x >> 6), NGW = gridDim.x * (NTHREADS / 64);
    const unsigned char* y = (const unsigned char*)(P.ws + WS_Y);
    typedef float f32x2_ __attribute__((ext_vector_type(2)));
    for (int m = gw; m < T; m += NGW) {
        const float* mod = (const float*)(P.ws + WS_MOD) + (m / SEQ) * 6144 + 5120;
#pragma unroll
        for (int j = 0; j < 2; ++j) { const int col = (lane + 64 * j) * 8;
            f32x4 s0 = (f32x4){0.f, 0.f, 0.f, 0.f}, s1 = s0;
#pragma unroll
            for (int sl = 0; sl < 9; ++sl) { const u32x2 v = sl < 8 ? *(const u32x2*)(y + ((size_t)m * 8 + sl) * 1024 + col) : *(const u32x2*)((const unsigned char*)(P.ws + WS_YSH) + (size_t)m * 1024 + col);
                const f32x2_ a = __builtin_amdgcn_cvt_pk_f32_fp8((int)v.x, false), b = __builtin_amdgcn_cvt_pk_f32_fp8((int)v.x, true);
                const f32x2_ c = __builtin_amdgcn_cvt_pk_f32_fp8((int)v.y, false), d = __builtin_amdgcn_cvt_pk_f32_fp8((int)v.y, true);
                s0.x += a.x; s0.y += a.y; s0.z += b.x; s0.w += b.y; s1.x += c.x; s1.y += c.y; s1.z += d.x; s1.w += d.y; }
            const f32x4 g0 = *(const f32x4*)(mod + col), g1 = *(const f32x4*)(mod + col + 4);
            const u32x4 xr = *(const u32x4*)((const bf16_t*)(P.ws + WS_X1) + (size_t)m * 1024 + col);
            f32x4 o0 = (f32x4){__uint_as_float(xr.x << 16), __uint_as_float(xr.x & 0xffff0000u), __uint_as_float(xr.y << 16), __uint_as_float(xr.y & 0xffff0000u)};
            f32x4 o1 = (f32x4){__uint_as_float(xr.z << 16), __uint_as_float(xr.z & 0xffff0000u), __uint_as_float(xr.w << 16), __uint_as_float(xr.w & 0xffff0000u)};
            o0 += g0 * (s0 * Y_INV); o1 += g1 * (s1 * Y_INV);
            *(f32x4*)(P.out + (size_t)m * 1024 + col) = o0; *(f32x4*)(P.out + (size_t)m * 1024 + col + 4) = o1; }
    }
}


__device__ __forceinline__ int queue_pull(unsigned* head, volatile LAS unsigned* slot) {
    if (threadIdx.x == 0) *slot = atomicAdd(head, 1u);
    __syncthreads();
    const int v = (int)*slot;
    __syncthreads();
    return v;
}
__device__ __forceinline__ void phase_cmp_h1(const Params& P, LAS unsigned char* lds, volatile LAS unsigned* slot) {
    unsigned* head = (unsigned*)(P.ws + WS_CTL + CTL_Q2);
    for (;;) {
        const int u = queue_pull(head, slot);
        if (u >= 64 + 512) break;
        if (u < 64) compress_unit(P, lds, u); else hgrn_unit<0>(P, lds, u - 64);
    }
}
__device__ __forceinline__ void phase_h23_nsa(const Params& P, LAS unsigned char* lds, volatile LAS unsigned* slot) {
    unsigned* head = (unsigned*)(P.ws + WS_CTL + CTL_Q3);
    for (;;) {
        const int n = queue_pull(head, slot);
        if (n >= 1536) break;
        if (n < 512) nsa_unit(P, lds, (n & 7) * 128 + (127 - (n >> 3)));
        else if (n < 1024) { const int m = n - 512; hgrn_unit<1>(P, lds, (m & 15) * 32 + (31 - (m >> 4))); }
        else { const int m = n - 1024; nsa_unit(P, lds, (m & 7) * 128 + (63 - (m >> 3))); }
    }
}

constexpr int LDS_BYTES = 144 * 1024;
__global__ void __launch_bounds__(NTHREADS) mega(Params P) {
    extern __shared__ __attribute__((aligned(16))) unsigned char smem[];
    LAS unsigned char* lds = (LAS unsigned char*)smem;
    volatile LAS unsigned* xst = (volatile LAS unsigned*)(lds + LDS_BYTES - 16);
    if (threadIdx.x < 4) xst[threadIdx.x] = 0u;
    __syncthreads();
    XcdBarrier xb = xcd_barrier_post((unsigned*)(P.ws + WS_CTL + CTL_BAR), xst);
    phase_mod(P, lds);
    xcd_barrier(xb);
    { const float* mod = (const float*)(P.ws + WS_MOD); norm_mod_rows(P.x, P.norm1_w, mod, mod + 1024, (unsigned char*)(P.ws + WS_H), H1S); }
    xcd_barrier(xb);
    phase_inproj(P, lds);
    xcd_barrier(xb);
    phase_cmp_h1(P, lds, xst + 2);
    xcd_barrier(xb);
    phase_hgrn_prefix(P);
    xcd_barrier(xb);
    phase_h23_nsa(P, lds, xst + 2);
    phase_cvt_small(P);
    xcd_barrier(xb);
    phase_p4a(P, lds);
    xcd_barrier(xb);
    phase_p4b(P);
    xcd_barrier(xb);
    phase_p4c(P, lds);
    xcd_barrier(xb);
    phase_route(P);
    phase_p4d(P, lds);
    xcd_barrier(xb);
    phase_expert_cvt8(P);
    xcd_barrier(xb);
    phase_experts8<0>(P, lds);
    xcd_barrier(xb);
    phase_combine(P);
}

extern "C" void kernel_launch(void* const* d_in, const int* in_sizes, int n_in, void* d_out, int out_size, void* d_ws, size_t ws_size, hipStream_t stream) {
    static int grid = 0;
    if (grid == 0) {
        if (n_in != 25 || ws_size < WS_END) { fprintf(stderr, "kernel_launch: unexpected n_in %d or ws_size %zu (need %zu)\n", n_in, ws_size, (size_t)WS_END); grid = -1; return; }
        int dev = 0, cus = 0, per_cu = 0;
        (void)hipGetDevice(&dev); (void)hipDeviceGetAttribute(&cus, hipDeviceAttributeMultiprocessorCount, dev);
        (void)hipFuncSetAttribute((const void*)mega, hipFuncAttributeMaxDynamicSharedMemorySize, LDS_BYTES);
        (void)hipOccupancyMaxActiveBlocksPerMultiprocessor(&per_cu, (const void*)mega, NTHREADS, LDS_BYTES);
        if (per_cu < 1) { fprintf(stderr, "kernel_launch: occupancy query says %d blocks per CU\n", per_cu); grid = -1; return; }
        grid = cus;
    }
    if (grid < 0) return;
    (void)hipMemsetAsync((char*)d_ws + WS_CTL, 0, 64 * 1024, stream);
    Params p{};
    const float** pf = (const float**)&p;
    for (int i = 0; i < 25; ++i) pf[i] = (const float*)d_in[i];
    p.out = (float*)d_out; p.ws = (unsigned char*)d_ws;
    void* args[] = {&p};
    hipError_t e = hipLaunchCooperativeKernel((const void*)mega, dim3(grid), dim3(NTHREADS), args, LDS_BYTES, stream);
    if (e != hipSuccess) fprintf(stderr, "cooperative launch failed: %s (grid %d)\n", hipGetErrorString(e), grid);
}

#ifdef PHASE_TEST
__global__ void __launch_bounds__(NTHREADS) t_p4a(Params P) { extern __shared__ __attribute__((aligned(16))) unsigned char smem[]; phase_p4a(P, (LAS unsigned char*)smem); }
__global__ void __launch_bounds__(NTHREADS) t_p4d(Params P) { extern __shared__ __attribute__((aligned(16))) unsigned char smem[]; phase_p4d(P, (LAS unsigned char*)smem); }
__global__ void __launch_bounds__(NTHREADS) t_p4(Params P) { extern __shared__ __attribute__((aligned(16))) unsigned char smem[]; phase_p4c(P, (LAS unsigned char*)smem); }
__global__ void __launch_bounds__(NTHREADS) t_p6(Params P) { extern __shared__ __attribute__((aligned(16))) unsigned char smem[]; phase_experts(P, (LAS unsigned char*)smem); }
__global__ void __launch_bounds__(NTHREADS) t_nsa(Params P) { extern __shared__ __attribute__((aligned(16))) unsigned char smem[]; nsa_unit(P, (LAS unsigned char*)smem, blockIdx.x); }
__global__ void __launch_bounds__(NTHREADS) t_mod(Params P) { extern __shared__ __attribute__((aligned(16))) unsigned char smem[]; phase_mod(P, (LAS unsigned char*)smem); }
__global__ void __launch_bounds__(NTHREADS) t_inproj(Params P) { extern __shared__ __attribute__((aligned(16))) unsigned char smem[]; phase_inproj(P, (LAS unsigned char*)smem); }
__global__ void __launch_bounds__(NTHREADS) t_cmp(Params P) { extern __shared__ __attribute__((aligned(16))) unsigned char smem[]; compress_unit(P, (LAS unsigned char*)smem, blockIdx.x); }
__global__ void __launch_bounds__(NTHREADS) t_h0(Params P) { extern __shared__ __attribute__((aligned(16))) unsigned char smem[]; hgrn_unit<0>(P, (LAS unsigned char*)smem, blockIdx.x); }
__global__ void __launch_bounds__(NTHREADS) t_h1(Params P) { extern __shared__ __attribute__((aligned(16))) unsigned char smem[]; hgrn_unit<1>(P, (LAS unsigned char*)smem, blockIdx.x); }
#endif
```

```cpp
#include <hip/hip_runtime.h>
#include <hip/hip_cooperative_groups.h>
#include <cstdio>
#include <cstdint>
#include <type_traits>
namespace cg = cooperative_groups;

#define LAS __attribute__((address_space(3)))
typedef unsigned short bf16_t;
typedef short bf16x8 __attribute__((ext_vector_type(8)));
typedef short s16x4 __attribute__((ext_vector_type(4)));
typedef float f32x4 __attribute__((ext_vector_type(4)));
typedef float f32x16 __attribute__((ext_vector_type(16)));
typedef unsigned u32x4 __attribute__((ext_vector_type(4)));
typedef unsigned u32x2 __attribute__((ext_vector_type(2)));

constexpr int D = 1024, BATCH = 4, SEQ = 8192, T = BATCH * SEQ;
constexpr int IN_COLS = 3352;
constexpr int NTHREADS = 512;
constexpr int H1S = 1088;
constexpr float RMS_EPS = 1e-6f;
constexpr float LOG2E = 1.4426950408889634f;
constexpr float Y_SCALE = 16.0f, Y_INV = 1.0f / 16.0f;

constexpr size_t MB = 1024ull * 1024ull;
constexpr size_t WS_CTL    = 0;
constexpr size_t WS_MOD    = 64 * 1024;
constexpr size_t WS_LB     = WS_MOD + 4 * 6144 * 4;
constexpr size_t WS_CB     = WS_LB + 2048;
constexpr size_t WS_H      = 1 * MB;
constexpr size_t WS_SS     = WS_H + 72 * MB;
constexpr size_t WS_RW     = WS_SS + 1 * MB;
constexpr size_t WS_BUCKET = WS_RW + 1 * MB;
constexpr size_t WS_HIDR   = WS_BUCKET + 16 * MB;
constexpr size_t WS_WSM    = WS_HIDR + 32 * MB;
constexpr size_t WS_WOUT   = WS_WSM, WS_WRS = WS_WSM + 2 * MB, WS_WSD = WS_WSM + 4 * MB;
constexpr size_t WS_WBE    = WS_WSM + 5 * MB;
constexpr size_t WS_WBGU   = WS_WBE, WS_WBD = WS_WBE + 256 * MB;
constexpr size_t WS_W8GU   = WS_WBE, WS_W8D = WS_WBE + 128 * MB, WS_H2Q = WS_WBE + 256 * MB;
constexpr size_t WS_X1     = WS_WBE + 192 * MB;
constexpr float W8_GU_SCALE = 64.0f, W8_D_SCALE = 32.0f, HID8_SCALE = 4.0f;
constexpr size_t WS_SCORES = WS_WBE + 288 * MB;
constexpr size_t WS_HIDS   = WS_SCORES + 32 * MB;
constexpr size_t WS_WIN    = WS_WBE + 48 * MB;
constexpr size_t WS_Y      = WS_WBE + 384 * MB;
constexpr size_t WS_Q      = WS_Y;
constexpr size_t WS_KV     = WS_Q + 32 * MB;
constexpr size_t WS_GATES  = WS_KV + 48 * MB;
constexpr size_t WS_HQ     = WS_GATES + 4 * MB;
constexpr size_t WS_LOGF   = WS_HQ + 32 * MB;
constexpr size_t WS_HV     = WS_LOGF + 64 * MB;
constexpr size_t WS_HG     = WS_HV + 32 * MB;
constexpr size_t WS_CMPH   = WS_HG + 32 * MB;
constexpr size_t WS_KC     = WS_CMPH + 4 * MB;
constexpr size_t WS_VC     = WS_KC + 1 * MB;
constexpr size_t WS_HL     = WS_VC + 1 * MB;
constexpr size_t WS_HD     = WS_HL + 32 * MB;
constexpr size_t WS_MIX    = WS_HD + 1 * MB;
constexpr size_t WS_YSH    = WS_Y + 384 * MB;
constexpr size_t WS_END    = WS_YSH + 64 * MB;
constexpr int BCAP = 16384;
constexpr int CTL_CNT = 1024;
constexpr int CTL_Q2 = 2048, CTL_Q3 = 2112;
constexpr int CTL_BAR = 16384;

struct Params {
    const float *x, *c, *ada_w, *ada_b, *norm1_w, *norm2_w, *w_in, *q_norm_w, *k_norm_w, *cmp_pos, *cmp_w1, *cmp_b1, *cmp_w2,
        *attn_out_norm_w, *hgrn_lb, *rec_out_norm_w, *w_out, *router_w, *router_bias, *exp_wg, *exp_wu, *exp_wd, *sh_wg, *sh_wu, *sh_wd;
    float* out;
    unsigned char* ws;
};

typedef __bf16 bf16x2_t __attribute__((ext_vector_type(2)));
typedef int i32x8 __attribute__((ext_vector_type(8)));
__device__ __forceinline__ unsigned cvtpk(float lo, float hi) { bf16x2_t v; v.x = (__bf16)lo; v.y = (__bf16)hi; return __builtin_bit_cast(unsigned, v); }
__device__ __forceinline__ int opaque_tid() { int t = threadIdx.x; asm volatile("" : "+v"(t)); return t; }
__device__ __forceinline__ float bf2f(bf16_t v) { return __uint_as_float(((unsigned)v) << 16); }
__device__ __forceinline__ float sigmoidf_(float v) { return __builtin_amdgcn_rcpf(1.0f + __expf(-v)); }
__device__ __forceinline__ float siluf_(float v) { return v * __builtin_amdgcn_rcpf(1.0f + __expf(-v)); }
__device__ __forceinline__ float wave_sum(float v) {
#pragma unroll
    for (int o = 1; o < 64; o <<= 1) v += __shfl_xor(v, o);
    return v;
}
__device__ __forceinline__ s16x4 lds_tr(const LAS unsigned char* p) {
    return __builtin_bit_cast(s16x4, __builtin_amdgcn_ds_read_tr16_b64_v4i16((LAS s16x4*)p));
}

#define XB_TMO      128
#define XB_XCNT(j)  (256  + 64 * (j))
#define XB_XSUB(j)  (1280 + 64 * (j))
#define XB_XGEN(j)  (2304 + 64 * (j))
#define XB_TOP      3328
#define XB_TOPGEN   3392
#define XCD_BAR_WORDS 3456
#define XB_SPIN_CAP (1u << 22)
__device__ __forceinline__ unsigned xb_ld(unsigned* p)              { return __hip_atomic_load(p, __ATOMIC_RELAXED, __HIP_MEMORY_SCOPE_AGENT); }
__device__ __forceinline__ unsigned xb_add(unsigned* p, unsigned v) { return __hip_atomic_fetch_add(p, v, __ATOMIC_RELAXED, __HIP_MEMORY_SCOPE_AGENT); }
__device__ __forceinline__ unsigned xb_xcc_id() { return (unsigned)__builtin_amdgcn_s_getreg((3 << 11) | 20) & 0xFu; }
#define XB_SPIN(cond, bar) do { unsigned _sp = 0; while (cond) { __builtin_amdgcn_s_sleep(1); \
    if ((++_sp & 255u) == 0u) { if (xb_ld(&(bar)[XB_TMO])) break; if (_sp > XB_SPIN_CAP) { atomicAdd(&(bar)[XB_TMO], 1u); break; } } } } while (0)
struct XcdBarrier { unsigned* bar; unsigned x; volatile LAS unsigned* st; };
__device__ __forceinline__ XcdBarrier xcd_barrier_post(unsigned* bar, volatile LAS unsigned* st) {
    XcdBarrier b; b.bar = bar; b.x = xb_xcc_id(); b.st = st;
    if (threadIdx.x == 0) (void)xb_add(&bar[XB_XCNT(b.x)], 1u);
    return b;
}
__device__ __forceinline__ void xcd_barrier_complete(unsigned* bar, unsigned x, unsigned& nloc, unsigned& nx) {
    const unsigned G = gridDim.x * gridDim.y * gridDim.z;
    unsigned sum, cnt, mine, sp = 0u;
    for (;;) {
        sum = 0u; cnt = 0u; mine = 0u;
#pragma unroll
        for (unsigned j = 0; j < 16; ++j) { const unsigned c = xb_ld(&bar[XB_XCNT(j)]); sum += c; cnt += (c > 0u) ? 1u : 0u; mine = (j == x) ? c : mine; }
        if (sum == G) break;
        __builtin_amdgcn_s_sleep(1);
        if ((++sp & 255u) == 0u) { if (xb_ld(&bar[XB_TMO])) break; if (sp > XB_SPIN_CAP) { atomicAdd(&bar[XB_TMO], 1u); break; } }
    }
    nloc = mine > 0u ? mine : 1u; nx = cnt > 0u ? cnt : 1u;
}
__device__ __forceinline__ void xcd_barrier(const XcdBarrier& b) {
    asm volatile("s_waitcnt vmcnt(0)" ::: "memory");
    __syncthreads();
    if (threadIdx.x == 0) {
        unsigned* bar = b.bar;
        __builtin_amdgcn_s_waitcnt(0);
        unsigned nloc = b.st[0], nx = b.st[1];
        if (nloc == 0u) { xcd_barrier_complete(bar, b.x, nloc, nx); b.st[0] = nloc; b.st[1] = nx; }
        const unsigned old = xb_add(&bar[XB_XSUB(b.x)], 1u);
        const unsigned gen = old / nloc;
        if (old + 1u == (gen + 1u) * nloc) {
            __builtin_amdgcn_fence(__ATOMIC_RELEASE, "agent");
            asm volatile("s_waitcnt vmcnt(0)" ::: "memory");
            const unsigned og = xb_add(&bar[XB_TOP], 1u);
            const unsigned tg = og / nx;
            if (og + 1u == (tg + 1u) * nx) xb_add(&bar[XB_TOPGEN], 1u);
            else XB_SPIN(xb_ld(&bar[XB_TOPGEN]) == tg, bar);
            __builtin_amdgcn_fence(__ATOMIC_ACQUIRE, "agent");
            xb_add(&bar[XB_XGEN(b.x)], 1u);
            asm volatile("s_waitcnt vmcnt(0)" ::: "memory");
        } else {
            XB_SPIN(xb_ld(&bar[XB_XGEN(b.x)]) == gen, bar);
            __builtin_amdgcn_fence(__ATOMIC_ACQUIRE, "agent");
            asm volatile("s_waitcnt vmcnt(0)" ::: "memory");
        }
    }
    __syncthreads();
}

template <int WM, int WN> struct GemmT {
    static constexpr int BM = 64 * WM, BN = 64 * WN;
    static constexpr int A_BYTES = BM * 128, B_BYTES = 64 * BN * 2, STAGE = A_BYTES + B_BYTES, LDS_BYTES = 2 * STAGE;
    static constexpr int NB4 = BN / 32;
    static constexpr int B_ROW4 = BN / 4;

    static __device__ __forceinline__ void run(f32x4 (&acc)[4][4], const bf16_t* const (&arow)[WM], int a_kstride, const float* Bp, int ldb, int KT, LAS unsigned char* lds) {
        const int tid = opaque_tid(), lane = tid & 63, wid = tid >> 6, wm = wid / WN, wn = wid % WN, fr = lane & 15, fq = lane >> 4;
#pragma unroll
        for (int mi = 0; mi < 4; ++mi)
#pragma unroll
            for (int ni = 0; ni < 4; ++ni) acc[mi][ni] = (f32x4){0.f, 0.f, 0.f, 0.f};
        const int achunk = tid & 7;
        u32x4 areg[WM]; f32x4 breg[NB4];
        int a_wr[WM];
#pragma unroll
        for (int p = 0; p < WM; ++p) { const int row = p * 64 + (tid >> 3); a_wr[p] = row * 128 + ((achunk ^ ((row >> 1) & 7)) << 4); }
        int b_wr[NB4]; int b_goff[NB4];
#pragma unroll
        for (int p = 0; p < NB4; ++p) { const int i = tid + NTHREADS * p, k = i / B_ROW4, n = (i % B_ROW4) * 4;
            const int f = (k & 3) | (((k >> 3) & 1) << 2);
            b_wr[p] = A_BYTES + k * (BN * 2) + (((n >> 4) ^ f) << 5) + ((n & 15) << 1); b_goff[p] = k * ldb + n; }
        int a_rd[4][2];
#pragma unroll
        for (int mi = 0; mi < 4; ++mi)
#pragma unroll
            for (int ks = 0; ks < 2; ++ks) { const int row = wm * 64 + mi * 16 + fr, ch = ks * 4 + fq; a_rd[mi][ks] = row * 128 + ((ch ^ ((row >> 1) & 7)) << 4); }
        int b_rd[2][2];
        int b_f[2][2];
#pragma unroll
        for (int ks = 0; ks < 2; ++ks)
#pragma unroll
            for (int t = 0; t < 2; ++t) { const int k = ks * 32 + 8 * fq + 4 * t + (fr >> 2); b_f[ks][t] = (k & 3) | (((k >> 3) & 1) << 2);
                b_rd[ks][t] = A_BYTES + k * (BN * 2) + ((fr & 3) << 3); }

        auto gload = [&](int kt) {
#pragma unroll
            for (int p = 0; p < WM; ++p) areg[p] = *(const u32x4*)(arow[p] + (size_t)kt * a_kstride + achunk * 8);
            const float* bk = Bp + (size_t)kt * 64 * ldb;
#pragma unroll
            for (int p = 0; p < NB4; ++p) breg[p] = *(const f32x4*)(bk + b_goff[p]);
        };
        auto lstore = [&](int buf) {
            LAS unsigned char* base = lds + buf * STAGE;
#pragma unroll
            for (int p = 0; p < WM; ++p) *(LAS u32x4*)(base + a_wr[p]) = areg[p];
#pragma unroll
            for (int p = 0; p < NB4; ++p) { u32x2 w; w.x = cvtpk(breg[p].x, breg[p].y); w.y = cvtpk(breg[p].z, breg[p].w); *(LAS u32x2*)(base + b_wr[p]) = w; }
        };
        gload(0); lstore(0); __syncthreads();
        for (int kt = 0; kt < KT; ++kt) {
            if (kt + 1 < KT) gload(kt + 1);
            __builtin_amdgcn_sched_barrier(0);
            const LAS unsigned char* base = lds + (kt & 1) * STAGE;
#pragma unroll
            for (int ks = 0; ks < 2; ++ks) {
                bf16x8 af[4], bfr[4];
#pragma unroll
                for (int mi = 0; mi < 4; ++mi) af[mi] = *(const LAS bf16x8*)(base + a_rd[mi][ks]);
#pragma unroll
                for (int ni = 0; ni < 4; ++ni) {
                    const int u0 = wn * 4 + ni;
                    const s16x4 lo = lds_tr(base + b_rd[ks][0] + ((u0 ^ b_f[ks][0]) << 5));
                    const s16x4 hi = lds_tr(base + b_rd[ks][1] + ((u0 ^ b_f[ks][1]) << 5));
                    bfr[ni] = (bf16x8){lo[0], lo[1], lo[2], lo[3], hi[0], hi[1], hi[2], hi[3]};
                }
#pragma unroll
                for (int mi = 0; mi < 4; ++mi)
#pragma unroll
                    for (int ni = 0; ni < 4; ++ni) acc[mi][ni] = __builtin_amdgcn_mfma_f32_16x16x32_bf16(bfr[ni], af[mi], acc[mi][ni], 0, 0, 0);
            }
            if (kt + 1 < KT) lstore((kt + 1) & 1);
            __syncthreads();
        }
    }
};

struct Gemm2 {
    static constexpr int A_BYTES = 32768, STAGE = 65536, LDS_BYTES = 2 * STAGE;
    static __device__ __forceinline__ int a_row(int i, int w, int lane) { return (i * 8 + w) * 8 + (lane >> 3); }
    static __device__ __forceinline__ int a_chunk(int row, int lane) { return (lane & 7) ^ ((row >> 1) & 7); }
    static __device__ __forceinline__ int b_k(int i, int w, int lane) { return (i * 8 + w) * 2 + (lane >> 5); }
    static __device__ __forceinline__ int b_n(int k, int lane) { return ((((lane & 31) >> 1) ^ fk2(k)) << 4) + ((lane & 1) << 3); }
    static __device__ __forceinline__ int fk2(int r) { return (r & 3) | (((r >> 3) & 1) << 2); }

    static __device__ __forceinline__ void run(f32x4 (&acc)[4][8], const bf16_t* const (&aptr)[4], int a_kstride, const bf16_t* const (&bptr)[4], size_t b_kstride, int KT, LAS unsigned char* lds) {
        const int tid = opaque_tid(), lane = tid & 63, wid = tid >> 6, wm = wid >> 1, wn = wid & 1, fr = lane & 15, fq = lane >> 4;
        const int wu = __builtin_amdgcn_readfirstlane(wid);
#pragma unroll
        for (int mi = 0; mi < 4; ++mi)
#pragma unroll
            for (int ni = 0; ni < 8; ++ni) acc[mi][ni] = (f32x4){0.f, 0.f, 0.f, 0.f};
        int a_rd[4][2];
#pragma unroll
        for (int mi = 0; mi < 4; ++mi)
#pragma unroll
            for (int ks = 0; ks < 2; ++ks) { const int row = wm * 64 + mi * 16 + fr, ch = ks * 4 + fq; a_rd[mi][ks] = row * 128 + ((ch ^ ((row >> 1) & 7)) << 4); }
        int b_rd[2][2], b_f[2][2];
#pragma unroll
        for (int ks = 0; ks < 2; ++ks)
#pragma unroll
            for (int t = 0; t < 2; ++t) { const int k = ks * 32 + 8 * fq + 4 * t + (fr >> 2); b_f[ks][t] = fk2(k); b_rd[ks][t] = A_BYTES + k * 512 + ((fr & 3) << 3); }
        auto issue = [&](int kt, int buf) {
            LAS unsigned char* base = lds + buf * STAGE + wu * 1024;
#pragma unroll
            for (int i = 0; i < 4; ++i) __builtin_amdgcn_global_load_lds((const unsigned*)(aptr[i] + (size_t)kt * a_kstride), (LAS unsigned*)(base + i * 8192), 16, 0, 0);
#pragma unroll
            for (int i = 0; i < 4; ++i) __builtin_amdgcn_global_load_lds((const unsigned*)(bptr[i] + (size_t)kt * b_kstride), (LAS unsigned*)(base + A_BYTES + i * 8192), 16, 0, 0);
        };
        issue(0, 0);
        for (int kt = 0; kt < KT; ++kt) {
            asm volatile("s_waitcnt vmcnt(0)" ::: "memory");
            __syncthreads();
            if (kt + 1 < KT) issue(kt + 1, (kt + 1) & 1);
            const LAS unsigned char* base = lds + (kt & 1) * STAGE;
#pragma unroll
            for (int ks = 0; ks < 2; ++ks) {
                bf16x8 af[4];
#pragma unroll
                for (int mi = 0; mi < 4; ++mi) af[mi] = *(const LAS bf16x8*)(base + a_rd[mi][ks]);
#pragma unroll
                for (int ni = 0; ni < 8; ++ni) {
                    const int u0 = wn * 8 + ni;
                    const s16x4 lo = lds_tr(base + b_rd[ks][0] + ((u0 ^ b_f[ks][0]) << 5));
                    const s16x4 hi = lds_tr(base + b_rd[ks][1] + ((u0 ^ b_f[ks][1]) << 5));
                    const bf16x8 bfr = (bf16x8){lo[0], lo[1], lo[2], lo[3], hi[0], hi[1], hi[2], hi[3]};
#pragma unroll
                    for (int mi = 0; mi < 4; ++mi) acc[mi][ni] = __builtin_amdgcn_mfma_f32_16x16x32_bf16(bfr, af[mi], acc[mi][ni], 0, 0, 0);
                }
            }
        }
        __syncthreads();
    }
};

__device__ __forceinline__ void glds16(const void* g, unsigned lds_base) {
    unsigned sv; asm volatile("s_mov_b32 %0, m0\n\ts_mov_b32 m0, %2\n\ts_nop 0\n\tglobal_load_lds_dwordx4 %1, off\n\ts_mov_b32 m0, %0" : "=&s"(sv) : "v"(g), "s"(lds_base) : "memory"); }
struct Gemm3 {
    static constexpr int A_BYTES = 16384, STAGE = 32768, LDS_BYTES = 4 * STAGE;
    static __device__ __forceinline__ int a_row(int i, int w, int lane) { return (i * 8 + w) * 16 + (lane >> 2); }
    static __device__ __forceinline__ int a_chunk(int row, int lane) { return (lane & 3) ^ ((row >> 1) & 3); }
    static __device__ __forceinline__ int b_k(int i, int w, int lane) { return (i * 8 + w) * 2 + (lane >> 5); }
    static __device__ __forceinline__ int fk2(int r) { return (r & 3) | (((r >> 3) & 1) << 2); }
    static __device__ __forceinline__ int b_n(int k, int lane) { return ((((lane & 31) >> 1) ^ fk2(k)) << 4) + ((lane & 1) << 3); }
    static __device__ __forceinline__ void run(f32x4 (&acc)[4][8], const bf16_t* const (&aptr)[2], int a_kstride, const bf16_t* const (&bptr)[2], size_t b_kstride, int KT, LAS unsigned char* lds) {
        const int tid = opaque_tid(), lane = tid & 63, wid = tid >> 6, wm = wid >> 1, wn = wid & 1, fr = lane & 15, fq = lane >> 4;
        const int wu = __builtin_amdgcn_readfirstlane(wid);
#pragma unroll
        for (int mi = 0; mi < 4; ++mi)
#pragma unroll
            for (int ni = 0; ni < 8; ++ni) acc[mi][ni] = (f32x4){0.f, 0.f, 0.f, 0.f};
        int a_rd[4];
#pragma unroll
        for (int mi = 0; mi < 4; ++mi) { const int row = wm * 64 + mi * 16 + fr; a_rd[mi] = row * 64 + ((fq ^ ((row >> 1) & 3)) << 4); }
        int b_rd[2], b_f[2];
#pragma unroll
        for (int t = 0; t < 2; ++t) { const int k = 8 * fq + 4 * t + (fr >> 2); b_f[t] = fk2(k); b_rd[t] = A_BYTES + k * 512 + ((fr & 3) << 3); }
        const unsigned lds0 = (unsigned)(uintptr_t)lds + (unsigned)wu * 1024u;
        auto issue = [&](int kt) {
            const unsigned base = (unsigned)__builtin_amdgcn_readfirstlane((int)(lds0 + (unsigned)(kt & 3) * STAGE));
#pragma unroll
            for (int i = 0; i < 2; ++i) glds16(aptr[i] + (size_t)kt * a_kstride, base + i * 8192);
#pragma unroll
            for (int i = 0; i < 2; ++i) glds16(bptr[i] + (size_t)kt * b_kstride, base + A_BYTES + i * 8192);
        };
        const int grp = wu >> 2;
        auto bar = [&]() { asm volatile("s_waitcnt lgkmcnt(0)" ::: "memory"); __builtin_amdgcn_s_barrier(); asm volatile("" ::: "memory"); };
        asm volatile("s_waitcnt vmcnt(0)" ::: "memory");
        issue(0); if (KT > 1) issue(1); if (KT > 2) issue(2);
        if (KT > 2) asm volatile("s_waitcnt vmcnt(8)" ::: "memory"); else if (KT > 1) asm volatile("s_waitcnt vmcnt(4)" ::: "memory"); else asm volatile("s_waitcnt vmcnt(0)" ::: "memory");
        bar();
        if (grp) bar();
#pragma unroll 1
        for (int kt = 0; kt < KT; ++kt) {
            if (kt + 3 < KT) issue(kt + 3);
            const LAS unsigned char* base = lds + (kt & 3) * STAGE;
            bf16x8 af[4], bfr[8];
#pragma unroll
            for (int mi = 0; mi < 4; ++mi) af[mi] = *(const LAS bf16x8*)(base + a_rd[mi]);
#pragma unroll
            for (int ni = 0; ni < 8; ++ni) {
                const int u0 = wn * 8 + ni;
                const s16x4 lo = lds_tr(base + b_rd[0] + ((u0 ^ b_f[0]) << 5));
                const s16x4 hi = lds_tr(base + b_rd[1] + ((u0 ^ b_f[1]) << 5));
                bfr[ni] = (bf16x8){lo[0], lo[1], lo[2], lo[3], hi[0], hi[1], hi[2], hi[3]};
            }
            { const int rem = KT - 2 - kt;
              if (rem >= 2) asm volatile("s_waitcnt vmcnt(8)" ::: "memory"); else if (rem == 1) asm volatile("s_waitcnt vmcnt(4)" ::: "memory"); else asm volatile("s_waitcnt vmcnt(0)" ::: "memory"); }
            bar();
            __builtin_amdgcn_sched_barrier(0);
#pragma unroll
            for (int ni = 0; ni < 8; ++ni)
#pragma unroll
                for (int mi = 0; mi < 4; ++mi) acc[mi][ni] = __builtin_amdgcn_mfma_f32_16x16x32_bf16(bfr[ni], af[mi], acc[mi][ni], 0, 0, 0);
            __builtin_amdgcn_sched_barrier(0);
            bar();
        }
        if (!grp) bar();
    }

    template <class F> static __device__ __forceinline__ void run_stream(F& f, int NSEG, int KT, int a_kstride, size_t b_kstride, LAS unsigned char* lds) {
        const int tid = opaque_tid(), lane = tid & 63, wid = tid >> 6, wm = wid >> 1, wn = wid & 1, fr = lane & 15, fq = lane >> 4;
        const int wu = __builtin_amdgcn_readfirstlane(wid);
        f32x4 acc[4][8];
#pragma unroll
        for (int mi = 0; mi < 4; ++mi)
#pragma unroll
            for (int ni = 0; ni < 8; ++ni) acc[mi][ni] = (f32x4){0.f, 0.f, 0.f, 0.f};
        int a_rd[4];
#pragma unroll
        for (int mi = 0; mi < 4; ++mi) { const int row = wm * 64 + mi * 16 + fr; a_rd[mi] = row * 64 + ((fq ^ ((row >> 1) & 3)) << 4); }
        int b_rd[2], b_f[2];
#pragma unroll
        for (int t = 0; t < 2; ++t) { const int k = 8 * fq + 4 * t + (fr >> 2); b_f[t] = fk2(k); b_rd[t] = A_BYTES + k * 512 + ((fr & 3) << 3); }
        const unsigned lds0 = (unsigned)(uintptr_t)lds + (unsigned)wu * 1024u;
        const bf16_t* aptr[2]; const bf16_t* bptr[2];
        const int total = NSEG * KT;
        int lseg = 0, lkt = 0, lg = 0;
        auto issue = [&]() {
            const unsigned base = (unsigned)__builtin_amdgcn_readfirstlane((int)(lds0 + (unsigned)(lg & 3) * STAGE));
#pragma unroll
            for (int i = 0; i < 2; ++i) glds16(aptr[i] + (size_t)lkt * a_kstride, base + i * 8192);
#pragma unroll
            for (int i = 0; i < 2; ++i) glds16(bptr[i] + (size_t)lkt * b_kstride, base + A_BYTES + i * 8192);
            ++lg; if (++lkt == KT) { lkt = 0; ++lseg; if (lseg < NSEG) f.ptrs(lseg, aptr, bptr); }
        };
        const int grp = wu >> 2;
        auto bar = [&]() { asm volatile("s_waitcnt lgkmcnt(0)" ::: "memory"); __builtin_amdgcn_s_barrier(); asm volatile("" ::: "memory"); };
        f.ptrs(0, aptr, bptr);
        asm volatile("s_waitcnt vmcnt(0)" ::: "memory");
        issue(); if (total > 1) issue(); if (total > 2) issue();
        if (total > 2) asm volatile("s_waitcnt vmcnt(8)" ::: "memory"); else if (total > 1) asm volatile("s_waitcnt vmcnt(4)" ::: "memory"); else asm volatile("s_waitcnt vmcnt(0)" ::: "memory");
        bar();
        if (grp) bar();
        int cseg = 0, ckt = 0;
#pragma unroll 1
        for (int g = 0; g < total; ++g) {
            if (lg < total) issue();
            const LAS unsigned char* base = lds + (g & 3) * STAGE;
            bf16x8 af[4], bfr[8];
#pragma unroll
            for (int mi = 0; mi < 4; ++mi) af[mi] = *(const LAS bf16x8*)(base + a_rd[mi]);
#pragma unroll
            for (int ni = 0; ni < 8; ++ni) {
                const int u0 = wn * 8 + ni;
                const s16x4 lo = lds_tr(base + b_rd[0] + ((u0 ^ b_f[0]) << 5));
                const s16x4 hi = lds_tr(base + b_rd[1] + ((u0 ^ b_f[1]) << 5));
                bfr[ni] = (bf16x8){lo[0], lo[1], lo[2], lo[3], hi[0], hi[1], hi[2], hi[3]};
            }
            { const int rem = total - 2 - g;
              if (rem >= 2) asm volatile("s_waitcnt vmcnt(8)" ::: "memory"); else if (rem == 1) asm volatile("s_waitcnt vmcnt(4)" ::: "memory"); else asm volatile("s_waitcnt vmcnt(0)" ::: "memory"); }
            bar();
            __builtin_amdgcn_sched_barrier(0);
#pragma unroll
            for (int ni = 0; ni < 8; ++ni)
#pragma unroll
                for (int mi = 0; mi < 4; ++mi) acc[mi][ni] = __builtin_amdgcn_mfma_f32_16x16x32_bf16(bfr[ni], af[mi], acc[mi][ni], 0, 0, 0);
            __builtin_amdgcn_sched_barrier(0);
            bar();
            if (++ckt == KT) {
                if (!grp) bar();
                f.epi(cseg, acc);
#pragma unroll
                for (int mi = 0; mi < 4; ++mi)
#pragma unroll
                    for (int ni = 0; ni < 8; ++ni) acc[mi][ni] = (f32x4){0.f, 0.f, 0.f, 0.f};
                ckt = 0; ++cseg;
                if (grp) bar();
            }
        }
        if (!grp) bar();
    }
};

struct Gemm8 {
    static constexpr int A_BYTES = 16384, STAGE = 32768;
    static __device__ __forceinline__ int t_row(int i, int w, int lane) { return (i * 8 + w) * 16 + (lane >> 2); }
    static __device__ __forceinline__ int t_chunk(int row, int lane) { return (lane & 3) ^ ((row >> 1) & 3); }
    static __device__ __forceinline__ int w_col(int i) { return 16 * ((i >> 2) & 1) + 4 * (i >> 3) + (i & 3); }
    template <class F> static __device__ __forceinline__ void run_stream(F& f, int NSEG, int KT, LAS unsigned char* lds) {
        const int tid = opaque_tid(), lane = tid & 63, wid = tid >> 6, wm = wid >> 1, wn = wid & 1, l31 = lane & 31, hi = lane >> 5;
        const int wu = __builtin_amdgcn_readfirstlane(wid);
        f32x16 acc[2][4];
#pragma unroll
        for (int jt = 0; jt < 2; ++jt)
#pragma unroll
            for (int it = 0; it < 4; ++it)
#pragma unroll
                for (int r = 0; r < 16; ++r) acc[jt][it][r] = 0.f;
        const int sw = (l31 >> 1) & 3;
        const int t_rd0 = (wm * 64 + l31) * 64 + (((2 * hi) ^ sw) << 4), t_rd1 = (wm * 64 + l31) * 64 + (((2 * hi + 1) ^ sw) << 4);
        const int w_rd0 = A_BYTES + (wn * 128 + l31) * 64 + (((2 * hi) ^ sw) << 4), w_rd1 = A_BYTES + (wn * 128 + l31) * 64 + (((2 * hi + 1) ^ sw) << 4);
        const unsigned lds0 = (unsigned)(uintptr_t)lds + (unsigned)wu * 1024u;
        const unsigned char* aptr[2]; const unsigned char* wptr[2];
        const int total = NSEG * KT;
        int lseg = 0, lkt = 0, lg = 0;
        auto issue = [&]() {
            const unsigned base = (unsigned)__builtin_amdgcn_readfirstlane((int)(lds0 + (unsigned)(lg & 3) * STAGE));
#pragma unroll
            for (int i = 0; i < 2; ++i) glds16(aptr[i] + lkt * 64, base + i * 8192);
#pragma unroll
            for (int i = 0; i < 2; ++i) glds16(wptr[i] + lkt * 64, base + A_BYTES + i * 8192);
            ++lg; if (++lkt == KT) { lkt = 0; ++lseg; if (lseg < NSEG) f.ptrs(lseg, aptr, wptr); }
        };
        const int grp = wu >> 2;
        auto bar = [&]() { asm volatile("s_waitcnt lgkmcnt(0)" ::: "memory"); __builtin_amdgcn_s_barrier(); asm volatile("" ::: "memory"); };
        f.ptrs(0, aptr, wptr);
        asm volatile("s_waitcnt vmcnt(0)" ::: "memory");
        issue(); if (total > 1) issue(); if (total > 2) issue();
        if (total > 2) asm volatile("s_waitcnt vmcnt(8)" ::: "memory"); else if (total > 1) asm volatile("s_waitcnt vmcnt(4)" ::: "memory"); else asm volatile("s_waitcnt vmcnt(0)" ::: "memory");
        bar();
        if (grp) bar();
        int cseg = 0, ckt = 0;
#pragma unroll 1
        for (int g = 0; g < total; ++g) {
            if (lg < total) issue();
            const LAS unsigned char* base = lds + (g & 3) * STAGE;
            i32x8 tf[2], wf[4];
#pragma unroll
            for (int jt = 0; jt < 2; ++jt) { const u32x4 lo = *(const LAS u32x4*)(base + t_rd0 + jt * 2048), h4 = *(const LAS u32x4*)(base + t_rd1 + jt * 2048);
                tf[jt] = (i32x8){(int)lo.x, (int)lo.y, (int)lo.z, (int)lo.w, (int)h4.x, (int)h4.y, (int)h4.z, (int)h4.w}; }
#pragma unroll
            for (int it = 0; it < 4; ++it) { const u32x4 lo = *(const LAS u32x4*)(base + w_rd0 + it * 2048), h4 = *(const LAS u32x4*)(base + w_rd1 + it * 2048);
                wf[it] = (i32x8){(int)lo.x, (int)lo.y, (int)lo.z, (int)lo.w, (int)h4.x, (int)h4.y, (int)h4.z, (int)h4.w}; }
            { const int rem = total - 2 - g;
              if (rem >= 2) asm volatile("s_waitcnt vmcnt(8)" ::: "memory"); else if (rem == 1) asm volatile("s_waitcnt vmcnt(4)" ::: "memory"); else asm volatile("s_waitcnt vmcnt(0)" ::: "memory"); }
            bar();
            __builtin_amdgcn_sched_barrier(0);
#pragma unroll
            for (int it = 0; it < 4; ++it)
#pragma unroll
                for (int jt = 0; jt < 2; ++jt) acc[jt][it] = __builtin_amdgcn_mfma_scale_f32_32x32x64_f8f6f4(wf[it], tf[jt], acc[jt][it], 0, 0, 0, F::wscale(it), 0, 127);
            __builtin_amdgcn_sched_barrier(0);
            bar();
            if (++ckt == KT) {
                if (!grp) bar();
                f.epi(cseg, acc);
#pragma unroll
                for (int jt = 0; jt < 2; ++jt)
#pragma unroll
                    for (int it = 0; it < 4; ++it)
#pragma unroll
                        for (int r = 0; r < 16; ++r) acc[jt][it][r] = 0.f;
                ckt = 0; ++cseg;
                if (grp) bar();
            }
        }
        if (!grp) bar();
    }
};

struct Gemm4 {
    static constexpr int A_BYTES = 16384, STAGE = 32768, LDS_BYTES = 2 * STAGE;
    static __device__ __forceinline__ int fk2(int r) { return (r & 3) | (((r >> 3) & 1) << 2); }
    static __device__ __forceinline__ int a_row(int i, int tid) { return (tid >> 2) + 128 * i; }
    static __device__ __forceinline__ int b_k(int i, int tid) { return (tid >> 5) + 16 * i; }
    static __device__ __forceinline__ void run(f32x4 (&acc)[4][8], const bf16_t* const (&aptr)[2], int a_kstride, const bf16_t* const (&bptr)[2], size_t b_kstride, int KT, LAS unsigned char* lds) {
        const int tid = opaque_tid(), lane = tid & 63, wid = tid >> 6, wm = wid >> 1, wn = wid & 1, fr = lane & 15, fq = lane >> 4;
#pragma unroll
        for (int mi = 0; mi < 4; ++mi)
#pragma unroll
            for (int ni = 0; ni < 8; ++ni) acc[mi][ni] = (f32x4){0.f, 0.f, 0.f, 0.f};
        int a_wr[2], b_wr[2];
#pragma unroll
        for (int i = 0; i < 2; ++i) { const int row = a_row(i, tid); a_wr[i] = row * 64 + (((tid & 3) ^ ((row >> 1) & 3)) << 4);
            const int k = b_k(i, tid), n = (tid & 31) * 8; b_wr[i] = A_BYTES + k * 512 + (((n >> 4) ^ fk2(k)) << 5) + ((n & 15) << 1); }
        int a_rd[4];
#pragma unroll
        for (int mi = 0; mi < 4; ++mi) { const int row = wm * 64 + mi * 16 + fr; a_rd[mi] = row * 64 + ((fq ^ ((row >> 1) & 3)) << 4); }
        int b_rd[2], b_f[2];
#pragma unroll
        for (int t = 0; t < 2; ++t) { const int k = 8 * fq + 4 * t + (fr >> 2); b_f[t] = fk2(k); b_rd[t] = A_BYTES + k * 512 + ((fr & 3) << 3); }
        u32x4 ra0[2], rb0[2], ra1[2], rb1[2];
        auto gload = [&](int kt, u32x4 (&ra)[2], u32x4 (&rb)[2]) {
#pragma unroll
            for (int i = 0; i < 2; ++i) { ra[i] = *(const u32x4*)(aptr[i] + (size_t)kt * a_kstride); rb[i] = *(const u32x4*)(bptr[i] + (size_t)kt * b_kstride); }
        };
        auto lstore = [&](int buf, const u32x4 (&ra)[2], const u32x4 (&rb)[2]) {
            LAS unsigned char* base = lds + buf * STAGE;
#pragma unroll
            for (int i = 0; i < 2; ++i) { *(LAS u32x4*)(base + a_wr[i]) = ra[i]; *(LAS u32x4*)(base + b_wr[i]) = rb[i]; }
        };
        auto compute = [&](int buf) {
            const LAS unsigned char* base = lds + buf * STAGE;
            bf16x8 af[4];
#pragma unroll
            for (int mi = 0; mi < 4; ++mi) af[mi] = *(const LAS bf16x8*)(base + a_rd[mi]);
#pragma unroll
            for (int ni = 0; ni < 8; ++ni) {
                const int u0 = wn * 8 + ni;
                const s16x4 lo = lds_tr(base + b_rd[0] + ((u0 ^ b_f[0]) << 5));
                const s16x4 hi = lds_tr(base + b_rd[1] + ((u0 ^ b_f[1]) << 5));
                const bf16x8 bfr = (bf16x8){lo[0], lo[1], lo[2], lo[3], hi[0], hi[1], hi[2], hi[3]};
#pragma unroll
                for (int mi = 0; mi < 4; ++mi) acc[mi][ni] = __builtin_amdgcn_mfma_f32_16x16x32_bf16(bfr, af[mi], acc[mi][ni], 0, 0, 0);
            }
        };
        gload(0, ra0, rb0); gload(1, ra1, rb1);
        lstore(0, ra0, rb0); __syncthreads();
        for (int kt = 0; kt < KT; kt += 2) {
            gload(kt + 2 < KT ? kt + 2 : KT - 1, ra0, rb0);
            __builtin_amdgcn_sched_barrier(0);
            compute(0);
            lstore(1, ra1, rb1);
            __syncthreads();
            gload(kt + 3 < KT ? kt + 3 : KT - 1, ra1, rb1);
            __builtin_amdgcn_sched_barrier(0);
            compute(1);
            lstore(0, ra0, rb0);
            __syncthreads();
        }
    }

    template <class F> static __device__ __forceinline__ void run_stream(F& f, int NSEG, int KT, int a_kstride, size_t b_kstride, LAS unsigned char* lds) {
        const int tid = opaque_tid(), lane = tid & 63, wid = tid >> 6, wm = wid >> 1, wn = wid & 1, fr = lane & 15, fq = lane >> 4;
        f32x4 acc[4][8];
#pragma unroll
        for (int mi = 0; mi < 4; ++mi)
#pragma unroll
            for (int ni = 0; ni < 8; ++ni) acc[mi][ni] = (f32x4){0.f, 0.f, 0.f, 0.f};
        int a_wr[2], b_wr[2];
#pragma unroll
        for (int i = 0; i < 2; ++i) { const int row = a_row(i, tid); a_wr[i] = row * 64 + (((tid & 3) ^ ((row >> 1) & 3)) << 4);
            const int k = b_k(i, tid), n = (tid & 31) * 8; b_wr[i] = A_BYTES + k * 512 + (((n >> 4) ^ fk2(k)) << 5) + ((n & 15) << 1); }
        int a_rd[4];
#pragma unroll
        for (int mi = 0; mi < 4; ++mi) { const int row = wm * 64 + mi * 16 + fr; a_rd[mi] = row * 64 + ((fq ^ ((row >> 1) & 3)) << 4); }
        int b_rd[2], b_f[2];
#pragma unroll
        for (int t = 0; t < 2; ++t) { const int k = 8 * fq + 4 * t + (fr >> 2); b_f[t] = fk2(k); b_rd[t] = A_BYTES + k * 512 + ((fr & 3) << 3); }
        const bf16_t* aptr[2]; const bf16_t* bptr[2];
        u32x4 ra0[2], rb0[2], ra1[2], rb1[2];
        int lseg = 0, lkt = 0;
        auto gload = [&](u32x4 (&ra)[2], u32x4 (&rb)[2]) {
#pragma unroll
            for (int i = 0; i < 2; ++i) { ra[i] = *(const u32x4*)(aptr[i] + (size_t)lkt * a_kstride); rb[i] = *(const u32x4*)(bptr[i] + (size_t)lkt * b_kstride); }
            if (lkt + 1 < KT) ++lkt; else if (lseg + 1 < NSEG) { lkt = 0; ++lseg; f.ptrs(lseg, aptr, bptr); }
        };
        auto lstore = [&](int buf, const u32x4 (&ra)[2], const u32x4 (&rb)[2]) {
            LAS unsigned char* base = lds + buf * STAGE;
#pragma unroll
            for (int i = 0; i < 2; ++i) { *(LAS u32x4*)(base + a_wr[i]) = ra[i]; *(LAS u32x4*)(base + b_wr[i]) = rb[i]; }
        };
        auto compute = [&](int buf) {
            const LAS unsigned char* base = lds + buf * STAGE;
            bf16x8 af[4];
#pragma unroll
            for (int mi = 0; mi < 4; ++mi) af[mi] = *(const LAS bf16x8*)(base + a_rd[mi]);
#pragma unroll
            for (int ni = 0; ni < 8; ++ni) {
                const int u0 = wn * 8 + ni;
                const s16x4 lo = lds_tr(base + b_rd[0] + ((u0 ^ b_f[0]) << 5));
                const s16x4 hi = lds_tr(base + b_rd[1] + ((u0 ^ b_f[1]) << 5));
                const bf16x8 bfr = (bf16x8){lo[0], lo[1], lo[2], lo[3], hi[0], hi[1], hi[2], hi[3]};
#pragma unroll
                for (int mi = 0; mi < 4; ++mi) acc[mi][ni] = __builtin_amdgcn_mfma_f32_16x16x32_bf16(bfr, af[mi], acc[mi][ni], 0, 0, 0);
            }
        };
        f.ptrs(0, aptr, bptr);
        gload(ra0, rb0); gload(ra1, rb1);
        lstore(0, ra0, rb0); __syncthreads();
        int cseg = 0, ckt = 0;
        const int total = NSEG * KT;
#pragma unroll 1
        for (int g = 0; g < total; g += 2) {
            gload(ra0, rb0);
            __builtin_amdgcn_sched_barrier(0);
            compute(0);
            lstore(1, ra1, rb1);
            __syncthreads();
            gload(ra1, rb1);
            __builtin_amdgcn_sched_barrier(0);
            compute(1);
            lstore(0, ra0, rb0);
            __syncthreads();
            ckt += 2;
            if (ckt == KT) {
                f.epi(cseg, acc);
#pragma unroll
                for (int mi = 0; mi < 4; ++mi)
#pragma unroll
                    for (int ni = 0; ni < 8; ++ni) acc[mi][ni] = (f32x4){0.f, 0.f, 0.f, 0.f};
                ckt = 0; ++cseg;
            }
        }
    }
};

template <bool BF32> struct Gemm5 {
    static constexpr int A_BYTES = 16384, STAGE = 32768, LDS_BYTES = 2 * STAGE;
    static __device__ __forceinline__ int fk2(int r) { return (r & 3) | (((r >> 3) & 1) << 2); }
    static __device__ __forceinline__ int a_row(int i, int tid) { return (tid >> 2) + 128 * i; }
    static __device__ __forceinline__ int b_k(int i, int tid) { return (tid >> 5) + 16 * i; }
    typedef typename std::conditional<BF32, float, bf16_t>::type b_t;
    static __device__ __forceinline__ void run(f32x4 (&acc)[4][8], const bf16_t* const (&aptr)[2], int a_kstride, const b_t* const (&bptr)[2], size_t b_kstride, int KT, LAS unsigned char* lds) {
        const int tid = opaque_tid(), lane = tid & 63, wid = tid >> 6, wm = wid >> 1, wn = wid & 1, fr = lane & 15, fq = lane >> 4;
#pragma unroll
        for (int mi = 0; mi < 4; ++mi)
#pragma unroll
            for (int ni = 0; ni < 8; ++ni) acc[mi][ni] = (f32x4){0.f, 0.f, 0.f, 0.f};
        int a_wr[2], b_wr[2];
#pragma unroll
        for (int i = 0; i < 2; ++i) { const int row = a_row(i, tid); a_wr[i] = row * 64 + (((tid & 3) ^ ((row >> 1) & 3)) << 4);
            const int k = b_k(i, tid), n = (tid & 31) * 8; b_wr[i] = A_BYTES + k * 512 + (((n >> 4) ^ fk2(k)) << 5) + ((n & 15) << 1); }
        int a_rd[4];
#pragma unroll
        for (int mi = 0; mi < 4; ++mi) { const int row = wm * 64 + mi * 16 + fr; a_rd[mi] = row * 64 + ((fq ^ ((row >> 1) & 3)) << 4); }
        int b_rd[2], b_f[2];
#pragma unroll
        for (int t = 0; t < 2; ++t) { const int k = 8 * fq + 4 * t + (fr >> 2); b_f[t] = fk2(k); b_rd[t] = A_BYTES + k * 512 + ((fr & 3) << 3); }
        u32x4 ra[2]; u32x4 rb[2]; f32x4 rbf[2][2];
        auto gload = [&](int kt) {
#pragma unroll
            for (int i = 0; i < 2; ++i) { ra[i] = *(const u32x4*)(aptr[i] + (size_t)kt * a_kstride);
                if (BF32) { const float* p = (const float*)bptr[i] + (size_t)kt * b_kstride; rbf[i][0] = *(const f32x4*)p; rbf[i][1] = *(const f32x4*)(p + 4); }
                else rb[i] = *(const u32x4*)((const bf16_t*)bptr[i] + (size_t)kt * b_kstride); }
        };
        auto lstore = [&](int buf) {
            LAS unsigned char* base = lds + buf * STAGE;
#pragma unroll
            for (int i = 0; i < 2; ++i) { *(LAS u32x4*)(base + a_wr[i]) = ra[i];
                if (BF32) { u32x4 w; w.x = cvtpk(rbf[i][0].x, rbf[i][0].y); w.y = cvtpk(rbf[i][0].z, rbf[i][0].w); w.z = cvtpk(rbf[i][1].x, rbf[i][1].y); w.w = cvtpk(rbf[i][1].z, rbf[i][1].w); *(LAS u32x4*)(base + b_wr[i]) = w; }
                else *(LAS u32x4*)(base + b_wr[i]) = rb[i]; }
        };
        auto compute = [&](int buf) {
            const LAS unsigned char* base = lds + buf * STAGE;
            bf16x8 af[4];
#pragma unroll
            for (int mi = 0; mi < 4; ++mi) af[mi] = *(const LAS bf16x8*)(base + a_rd[mi]);
#pragma unroll
            for (int ni = 0; ni < 8; ++ni) {
                const int u0 = wn * 8 + ni;
                const s16x4 lo = lds_tr(base + b_rd[0] + ((u0 ^ b_f[0]) << 5));
                const s16x4 hi = lds_tr(base + b_rd[1] + ((u0 ^ b_f[1]) << 5));
                const bf16x8 bfr = (bf16x8){lo[0], lo[1], lo[2], lo[3], hi[0], hi[1], hi[2], hi[3]};
#pragma unroll
                for (int mi = 0; mi < 4; ++mi) acc[mi][ni] = __builtin_amdgcn_mfma_f32_16x16x32_bf16(bfr, af[mi], acc[mi][ni], 0, 0, 0);
            }
        };
        gload(0); lstore(0); __syncthreads();
#pragma unroll 1
        for (int kt = 0; kt < KT; ++kt) {
            gload(kt + 1 < KT ? kt + 1 : KT - 1);
            __builtin_amdgcn_sched_barrier(0);
            compute(kt & 1);
            lstore((kt + 1) & 1);
            __syncthreads();
        }
    }

    template <class F> static __device__ __forceinline__ void run_stream(F& f, int NSEG, int KT, int a_kstride, size_t b_kstride, LAS unsigned char* lds) {
        const int tid = opaque_tid(), lane = tid & 63, wid = tid >> 6, wm = wid >> 1, wn = wid & 1, fr = lane & 15, fq = lane >> 4;
        f32x4 acc[4][8];
#pragma unroll
        for (int mi = 0; mi < 4; ++mi)
#pragma unroll
            for (int ni = 0; ni < 8; ++ni) acc[mi][ni] = (f32x4){0.f, 0.f, 0.f, 0.f};
        int a_wr[2], b_wr[2];
#pragma unroll
        for (int i = 0; i < 2; ++i) { const int row = a_row(i, tid); a_wr[i] = row * 64 + (((tid & 3) ^ ((row >> 1) & 3)) << 4);
            const int k = b_k(i, tid), n = (tid & 31) * 8; b_wr[i] = A_BYTES + k * 512 + (((n >> 4) ^ fk2(k)) << 5) + ((n & 15) << 1); }
        int a_rd[4];
#pragma unroll
        for (int mi = 0; mi < 4; ++mi) { const int row = wm * 64 + mi * 16 + fr; a_rd[mi] = row * 64 + ((fq ^ ((row >> 1) & 3)) << 4); }
        int b_rd[2], b_f[2];
#pragma unroll
        for (int t = 0; t < 2; ++t) { const int k = 8 * fq + 4 * t + (fr >> 2); b_f[t] = fk2(k); b_rd[t] = A_BYTES + k * 512 + ((fr & 3) << 3); }
        const bf16_t* aptr[2]; const b_t* bptr[2];
        u32x4 ra[2]; u32x4 rb[2]; f32x4 rbf[2][2];
        auto gload = [&](int kt) {
#pragma unroll
            for (int i = 0; i < 2; ++i) { ra[i] = *(const u32x4*)(aptr[i] + (size_t)kt * a_kstride);
                if (BF32) { const float* p = (const float*)bptr[i] + (size_t)kt * b_kstride; rbf[i][0] = *(const f32x4*)p; rbf[i][1] = *(const f32x4*)(p + 4); }
                else rb[i] = *(const u32x4*)((const bf16_t*)bptr[i] + (size_t)kt * b_kstride); }
        };
        auto lstore = [&](int buf) {
            LAS unsigned char* base = lds + buf * STAGE;
#pragma unroll
            for (int i = 0; i < 2; ++i) { *(LAS u32x4*)(base + a_wr[i]) = ra[i];
                if (BF32) { u32x4 w; w.x = cvtpk(rbf[i][0].x, rbf[i][0].y); w.y = cvtpk(rbf[i][0].z, rbf[i][0].w); w.z = cvtpk(rbf[i][1].x, rbf[i][1].y); w.w = cvtpk(rbf[i][1].z, rbf[i][1].w); *(LAS u32x4*)(base + b_wr[i]) = w; }
                else *(LAS u32x4*)(base + b_wr[i]) = rb[i]; }
        };
        auto compute = [&](int buf) {
            const LAS unsigned char* base = lds + buf * STAGE;
            bf16x8 af[4];
#pragma unroll
            for (int mi = 0; mi < 4; ++mi) af[mi] = *(const LAS bf16x8*)(base + a_rd[mi]);
#pragma unroll
            for (int ni = 0; ni < 8; ++ni) {
                const int u0 = wn * 8 + ni;
                const s16x4 lo = lds_tr(base + b_rd[0] + ((u0 ^ b_f[0]) << 5));
                const s16x4 hi = lds_tr(base + b_rd[1] + ((u0 ^ b_f[1]) << 5));
                const bf16x8 bfr = (bf16x8){lo[0], lo[1], lo[2], lo[3], hi[0], hi[1], hi[2], hi[3]};
#pragma unroll
                for (int mi = 0; mi < 4; ++mi) acc[mi][ni] = __builtin_amdgcn_mfma_f32_16x16x32_bf16(bfr, af[mi], acc[mi][ni], 0, 0, 0);
            }
        };
        f.ptrs(0, aptr, bptr);
        gload(0); lstore(0); __syncthreads();
        int seg = 0, kt = 0;
        const int total = NSEG * KT;
#pragma unroll 1
        for (int g = 0; g < total; ++g) {
            int nkt = kt + 1, nsg = seg; if (nkt == KT) { nkt = 0; nsg = seg + 1; }
            if (nkt == 0 && nsg < NSEG) f.ptrs(nsg, aptr, bptr);
            gload(nsg < NSEG ? nkt : KT - 1);
            __builtin_amdgcn_sched_barrier(0);
            compute(g & 1);
            lstore((g + 1) & 1);
            __syncthreads();
            if (nkt == 0) {
                f.epi(seg, acc);
#pragma unroll
                for (int mi = 0; mi < 4; ++mi)
#pragma unroll
                    for (int ni = 0; ni < 8; ++ni) acc[mi][ni] = (f32x4){0.f, 0.f, 0.f, 0.f};
            }
            seg = nsg; kt = nkt;
        }
    }
};

__device__ __forceinline__ int p2_col(int m0);
__device__ __forceinline__ unsigned pk4_fp8(float a, float b, float c, float d) { int pk = __builtin_amdgcn_cvt_pk_fp8_f32(a, b, 0, false); pk = __builtin_amdgcn_cvt_pk_fp8_f32(c, d, pk, true); return (unsigned)pk; }
__device__ __forceinline__ int w8_col(int i) { return 16 * ((i >> 2) & 1) + 4 * (i >> 3) + (i & 3); }
__device__ __forceinline__ void phase_mod(const Params& P, LAS unsigned char* lds) {
    const int tid = threadIdx.x;
    float* mod = (float*)(P.ws + WS_MOD);
    LAS float* sc = (LAS float*)lds;
    LAS float* red = (LAS float*)(lds + 16384);
    for (int i = tid; i < 4096; i += NTHREADS) sc[i] = siluf_(P.c[i]);
    __syncthreads();
    const int kq = tid >> 5, cl = tid & 31;
    for (int u = blockIdx.x; u < 192; u += gridDim.x) {
        const int j = u * 32 + cl;
        float a0 = 0.f, a1 = 0.f, a2 = 0.f, a3 = 0.f;
#pragma unroll 8
        for (int k = kq; k < 1024; k += 16) { const float w = P.ada_w[(size_t)k * 6144 + j];
            a0 += sc[k] * w; a1 += sc[1024 + k] * w; a2 += sc[2048 + k] * w; a3 += sc[3072 + k] * w; }
        red[(kq * 4 + 0) * 32 + cl] = a0; red[(kq * 4 + 1) * 32 + cl] = a1; red[(kq * 4 + 2) * 32 + cl] = a2; red[(kq * 4 + 3) * 32 + cl] = a3;
        __syncthreads();
        if (tid < 128) { const int b = tid >> 5; float s = 0.f;
#pragma unroll
            for (int q = 0; q < 16; ++q) s += red[(q * 4 + b) * 32 + cl];
            mod[b * 6144 + j] = s + P.ada_b[j]; }
        __syncthreads();
    }
    for (int u = blockIdx.x; u < 16; u += gridDim.x) {
        const int sel = u >> 3, j = (u & 7) * 32 + cl;
        const float* w1 = P.cmp_w1 + (size_t)sel * 2048 * 256; const float* pos = P.cmp_pos + sel * 2048;
        float a0 = 0.f;
#pragma unroll 8
        for (int k = kq; k < 2048; k += 16) a0 += pos[k] * w1[(size_t)k * 256 + j];
        red[kq * 32 + cl] = a0;
        __syncthreads();
        if (tid < 32) { float s = 0.f;
#pragma unroll
            for (int q = 0; q < 16; ++q) s += red[q * 32 + cl];
            ((float*)(P.ws + WS_CB))[sel * 256 + j] = s + P.cmp_b1[sel * 256 + j]; }
        __syncthreads();
    }
    {
        unsigned char* wb = (unsigned char*)(P.ws + WS_WIN);
        const int lane = tid & 63, gw = blockIdx.x * (NTHREADS / 64) + (tid >> 6), NGW = gridDim.x * (NTHREADS / 64);
        for (int u = gw; u < 56 * 16; u += NGW) {
            const int rg = u % 56, kb = u / 56, q = rg * 64 + lane, c8 = (q & ~31) + w8_col(q & 31);
            const int sc_ = c8 < 1280 ? c8 : (c8 < 3328 ? c8 + 24 : c8 - 2048);
            const float* s = P.w_in + (size_t)(kb * 64) * IN_COLS + (c8 < 3352 ? sc_ : 0);
            float v[64];
#pragma unroll
            for (int j = 0; j < 64; ++j) v[j] = s[(size_t)j * IN_COLS];
            const float c_ = c8 < 3352 ? 64.0f : 0.0f;
#pragma unroll
            for (int j = 0; j < 4; ++j) { u32x4 w;
                w.x = pk4_fp8(v[16 * j] * c_, v[16 * j + 1] * c_, v[16 * j + 2] * c_, v[16 * j + 3] * c_); w.y = pk4_fp8(v[16 * j + 4] * c_, v[16 * j + 5] * c_, v[16 * j + 6] * c_, v[16 * j + 7] * c_);
                w.z = pk4_fp8(v[16 * j + 8] * c_, v[16 * j + 9] * c_, v[16 * j + 10] * c_, v[16 * j + 11] * c_); w.w = pk4_fp8(v[16 * j + 12] * c_, v[16 * j + 13] * c_, v[16 * j + 14] * c_, v[16 * j + 15] * c_);
                *(u32x4*)(wb + (size_t)q * 1024 + kb * 64 + j * 16) = w; }
        }
    }
    if (blockIdx.x == gridDim.x - 2) {
        for (int i = tid; i < 2 * 8 * 64; i += NTHREADS) { const int t2 = i >> 9, bg = (i >> 6) & 7, d = i & 63;
            ((bf16_t*)(P.ws + (t2 ? WS_VC : WS_KC)))[((size_t)bg * 512 + 511) * 64 + d] = 0; }
    }
    if (blockIdx.x == gridDim.x - 1) {
        float* lb = (float*)(P.ws + WS_LB);
        for (int i = tid; i < 512; i += NTHREADS) { const float p0 = P.hgrn_lb[i], p1 = P.hgrn_lb[512 + i]; lb[i] = 1.0f / (1.0f + __expf(p1 - p0)); }
    }
}

__device__ __forceinline__ void norm_mod_rows(const float* x, const float* w, const float* mod_sh, const float* mod_sc, unsigned char* h, int hs) {
    const int lane = threadIdx.x & 63, gw = blockIdx.x * (NTHREADS / 64) + (threadIdx.x >> 6), NGW = gridDim.x * (NTHREADS / 64);
    for (int m = gw; m < T; m += NGW) {
        const int b = m / SEQ;
        const f32x4* xr = (const f32x4*)(x + (size_t)m * D) + lane;
        f32x4 v[4]; float s = 0.f;
#pragma unroll
        for (int j = 0; j < 4; ++j) { v[j] = xr[64 * j]; s += (v[j].x * v[j].x + v[j].y * v[j].y) + (v[j].z * v[j].z + v[j].w * v[j].w); }
        const float rstd = rsqrtf(wave_sum(s) * (1.f / D) + RMS_EPS);
        unsigned* o = (unsigned*)(h + (size_t)m * hs) + lane;
#pragma unroll
        for (int j = 0; j < 4; ++j) {
            const int col = (lane + 64 * j) * 4;
            const f32x4 wv = *(const f32x4*)(w + col), scv = *(const f32x4*)(mod_sc + b * 6144 + col), shv = *(const f32x4*)(mod_sh + b * 6144 + col);
            f32x4 r;
            r.x = v[j].x * rstd * wv.x * (1.f + scv.x) + shv.x; r.y = v[j].y * rstd * wv.y * (1.f + scv.y) + shv.y;
            r.z = v[j].z * rstd * wv.z * (1.f + scv.z) + shv.z; r.w = v[j].w * rstd * wv.w * (1.f + scv.w) + shv.w;
            o[64 * j] = pk4_fp8(r.x, r.y, r.z, r.w);
        }
    }
}

__device__ __forceinline__ void phase_inproj(const Params& P, LAS unsigned char* lds) {
    constexpr int NRT = T / 256, NCT = 14;
    struct F { const Params& P;
        static __device__ __forceinline__ int wscale(int) { return 121; }
        __device__ __forceinline__ void unit(int seg, int& rt, int& ct) const {
            const int nx = (gridDim.x % 8 == 0) ? 8 : 1, xl = blockIdx.x % nx, li = blockIdx.x / nx, nloc = gridDim.x / nx;
            const int v = li + seg * nloc, rg = v / (NCT * 4), rem = v % (NCT * 4); ct = rem >> 2; rt = xl + nx * (rg * 4 + (rem & 3)); }
        __device__ __forceinline__ void ptrs(int seg, const unsigned char* (&aptr)[2], const unsigned char* (&wptr)[2]) const {
            const int tid = opaque_tid(), lane = tid & 63, wid = tid >> 6; int rt, ct; unit(seg, rt, ct);
            const unsigned char* h1 = (const unsigned char*)(P.ws + WS_H); const unsigned char* wb = (const unsigned char*)(P.ws + WS_WIN);
#pragma unroll
            for (int i = 0; i < 2; ++i) { const int row = Gemm8::t_row(i, wid, lane); aptr[i] = h1 + (size_t)(rt * 256 + row) * H1S + Gemm8::t_chunk(row, lane) * 16;
                wptr[i] = wb + (size_t)(ct * 256 + row) * 1024 + Gemm8::t_chunk(row, lane) * 16; } }
        __device__ __forceinline__ void epi(int seg, f32x16 (&acc)[2][4]) const {
            const int tid = opaque_tid(), lane = tid & 63, wid = tid >> 6, wm = wid >> 1, wn = wid & 1, l31 = lane & 31, hi = lane >> 5;
            int rt, ct; unit(seg, rt, ct);
            bf16_t* qo = (bf16_t*)(P.ws + WS_Q); bf16_t* kvo = (bf16_t*)(P.ws + WS_KV); float* gates = (float*)(P.ws + WS_GATES);
            bf16_t* hq = (bf16_t*)(P.ws + WS_HQ); bf16_t* logf = (bf16_t*)(P.ws + WS_LOGF); bf16_t* hv = (bf16_t*)(P.ws + WS_HV); bf16_t* hg = (bf16_t*)(P.ws + WS_HG);
            const float* lb = (const float*)(P.ws + WS_LB);
            const int row0 = rt * 256 + wm * 64 + l31;
            if (ct < 5) {
                const bool is_q = ct < 2; const int sg = (ct - 2) * 2 + wn;
                const bool do_norm = is_q || sg == 2 || sg == 4;
                const float* nw = is_q ? P.q_norm_w : (P.k_norm_w + (sg == 2 ? 64 : 128));
                const float osc = is_q ? 0.125f : 1.0f;
#pragma unroll
                for (int hh = 0; hh < 2; ++hh) {
#pragma unroll
                    for (int jt = 0; jt < 2; ++jt) {
                        float rstd = 1.f;
                        if (do_norm) { float s = 0.f;
#pragma unroll
                            for (int t2 = 0; t2 < 2; ++t2)
#pragma unroll
                                for (int r = 0; r < 16; ++r) { const float a = acc[jt][2 * hh + t2][r]; s += a * a; }
                            s += __shfl_xor(s, 32);
                            rstd = rsqrtf(s * (1.f / 64.f) + RMS_EPS) * osc; }
                        const size_t m = (size_t)(row0 + jt * 32);
                        bf16_t* dst = is_q ? (qo + m * 512 + ct * 256 + wn * 128 + hh * 64 + 16 * hi) : (kvo + m * 768 + (ct - 2) * 256 + wn * 128 + hh * 64 + 16 * hi);
#pragma unroll
                        for (int t2 = 0; t2 < 2; ++t2) { u32x4 w0, w1;
#pragma unroll
                            for (int q4 = 0; q4 < 4; ++q4) { const f32x4 wv = do_norm ? *(const f32x4*)(nw + t2 * 32 + 16 * hi + 4 * q4) : (f32x4){1.f, 1.f, 1.f, 1.f};
                                const unsigned lo = cvtpk(acc[jt][2 * hh + t2][4 * q4] * rstd * wv.x, acc[jt][2 * hh + t2][4 * q4 + 1] * rstd * wv.y), hi2 = cvtpk(acc[jt][2 * hh + t2][4 * q4 + 2] * rstd * wv.z, acc[jt][2 * hh + t2][4 * q4 + 3] * rstd * wv.w);
                                if (q4 < 2) { w0[2 * q4] = lo; w0[2 * q4 + 1] = hi2; } else { w1[2 * (q4 - 2)] = lo; w1[2 * (q4 - 2) + 1] = hi2; } }
                            *(u32x4*)(dst + t2 * 32) = w0; *(u32x4*)(dst + t2 * 32 + 8) = w1; }
                    }
                }
            } else if (ct == 13) {
                if (wn == 0) {
#pragma unroll
                    for (int jt = 0; jt < 2; ++jt) { const size_t m = (size_t)(row0 + jt * 32);
#pragma unroll
                        for (int q4 = 0; q4 < 4; ++q4) { const int c = 16 * hi + 4 * q4; if (c < 24) {
                                *(f32x4*)(gates + m * 24 + c) = (f32x4){sigmoidf_(acc[jt][0][4 * q4]), sigmoidf_(acc[jt][0][4 * q4 + 1]), sigmoidf_(acc[jt][0][4 * q4 + 2]), sigmoidf_(acc[jt][0][4 * q4 + 3])}; } } }
                }
            } else {
                const int hs = (ct - 5) >> 1, cc = ((ct - 5) & 1) * 256 + wn * 128 + 16 * hi;
#pragma unroll
                for (int jt = 0; jt < 2; ++jt) { const size_t m = (size_t)(row0 + jt * 32);
#pragma unroll
                    for (int it = 0; it < 4; ++it) { const int c = cc + it * 32;
                        if (hs == 1) { unsigned w8[8];
#pragma unroll
                            for (int q4 = 0; q4 < 4; ++q4) { const f32x4 l = *(const f32x4*)(lb + c + 4 * q4); f32x4 o;
                                o.x = __logf(l.x + (1.f - l.x) * sigmoidf_(acc[jt][it][4 * q4])); o.y = __logf(l.y + (1.f - l.y) * sigmoidf_(acc[jt][it][4 * q4 + 1]));
                                o.z = __logf(l.z + (1.f - l.z) * sigmoidf_(acc[jt][it][4 * q4 + 2])); o.w = __logf(l.w + (1.f - l.w) * sigmoidf_(acc[jt][it][4 * q4 + 3]));
                                w8[2 * q4] = cvtpk(o.x, o.y); w8[2 * q4 + 1] = cvtpk(o.z, o.w); }
                            *(u32x4*)(logf + m * 512 + c) = (u32x4){w8[0], w8[1], w8[2], w8[3]}; *(u32x4*)(logf + m * 512 + c + 8) = (u32x4){w8[4], w8[5], w8[6], w8[7]};
                        } else { float v[16];
#pragma unroll
                            for (int r = 0; r < 16; ++r) { const float a = acc[jt][it][r]; v[r] = hs == 0 ? siluf_(a) * 0.08838834764831845f : (hs == 2 ? a : sigmoidf_(a)); }
                            bf16_t* dst = (hs == 0 ? hq : (hs == 2 ? hv : hg)) + m * 512 + c;
                            *(u32x4*)dst = (u32x4){cvtpk(v[0], v[1]), cvtpk(v[2], v[3]), cvtpk(v[4], v[5]), cvtpk(v[6], v[7])};
                            *(u32x4*)(dst + 8) = (u32x4){cvtpk(v[8], v[9]), cvtpk(v[10], v[11]), cvtpk(v[12], v[13]), cvtpk(v[14], v[15])}; }
                    } }
            }
        }
    } f{P};
    const int nx = (gridDim.x % 8 == 0) ? 8 : 1, li = blockIdx.x / nx, nloc = gridDim.x / nx;
    const int nu = ((NRT / nx) * NCT - li + nloc - 1) / nloc;
    if (nu > 0) Gemm8::run_stream(f, nu, D / 64, lds);
}

__device__ __forceinline__ float gelu_tanh(float x) {
    const float u = 0.7978845608028654f * (x + 0.044715f * x * x * x);
    const float th = 1.0f - 2.0f / (1.0f + __expf(2.0f * u));
    return 0.5f * x * (1.0f + th);
}
__device__ __forceinline__ void compress_unit(const Params& P, LAS unsigned char* lds, int u) {
    typedef GemmT<2, 4> G;
    const int tid = opaque_tid(), lane = tid & 63, wid = tid >> 6, wm = wid >> 2, wn = wid & 3, fr = lane & 15, fq = lane >> 4;
    const int sel = u >> 5, rt = u & 31;
    const bf16_t* kv = (const bf16_t*)(P.ws + WS_KV);
    bf16_t* cmph = (bf16_t*)(P.ws + WS_CMPH) + (size_t)sel * 4096 * 256;
    const float* cb = (const float*)(P.ws + WS_CB) + sel * 256;
    const bf16_t* arow[2];
#pragma unroll
    for (int p = 0; p < 2; ++p) { int r = rt * 128 + p * 64 + (tid >> 3); r = r < 4088 ? r : 4087;
        const int b = r / 1022, rem = r % 1022, i = rem >> 1, g = rem & 1;
        arow[p] = kv + (size_t)(b * SEQ + 16 * i) * 768 + sel * 128 + g * 64; }
    f32x4 acc[4][4];
    G::run(acc, arow, 768, P.cmp_w1 + (size_t)sel * 2048 * 256, 256, 32, lds);
#pragma unroll
    for (int mi = 0; mi < 4; ++mi) { const size_t row = (size_t)(rt * 128 + wm * 64 + mi * 16 + fr);
#pragma unroll
        for (int ni = 0; ni < 4; ++ni) { const int col = wn * 64 + ni * 16 + 4 * fq; const f32x4 a = acc[mi][ni]; const f32x4 bb = *(const f32x4*)(cb + col);
            u32x2 pk; pk.x = cvtpk(gelu_tanh(a.x + bb.x), gelu_tanh(a.y + bb.y)); pk.y = cvtpk(gelu_tanh(a.z + bb.z), gelu_tanh(a.w + bb.w));
            *(u32x2*)(cmph + row * 256 + col) = pk; } }
    __syncthreads();
    {
        const int row = tid >> 2, cq = tid & 3;
        const bf16_t* hr = cmph + (size_t)(rt * 128 + row) * 256;
        const float* w2 = P.cmp_w2 + (size_t)sel * 256 * 64 + cq * 16;
        float o[16];
#pragma unroll
        for (int j = 0; j < 16; ++j) o[j] = 0.f;
        for (int k8 = 0; k8 < 256; k8 += 8) {
            const u32x4 hv = *(const u32x4*)(hr + k8);
#pragma unroll
            for (int kk = 0; kk < 8; ++kk) {
                const unsigned wd = hv[kk >> 1]; const float a = (kk & 1) ? __uint_as_float(wd & 0xffff0000u) : __uint_as_float(wd << 16);
                const float* wr = w2 + (size_t)(k8 + kk) * 64;
#pragma unroll
                for (int j4 = 0; j4 < 4; ++j4) { const f32x4 w = *(const f32x4*)(wr + j4 * 4);
                    o[j4 * 4 + 0] += a * w.x; o[j4 * 4 + 1] += a * w.y; o[j4 * 4 + 2] += a * w.z; o[j4 * 4 + 3] += a * w.w; }
            }
        }
        if (sel == 0) { float s = 0.f;
#pragma unroll
            for (int j = 0; j < 16; ++j) s += o[j] * o[j];
            s += __shfl_xor(s, 1); s += __shfl_xor(s, 2);
            const float rstd = rsqrtf(s * (1.f / 64.f) + RMS_EPS);
#pragma unroll
            for (int j = 0; j < 16; ++j) o[j] *= rstd * P.k_norm_w[cq * 16 + j]; }
        const int r = rt * 128 + row;
        if (r < 4088) { const int b = r / 1022, rem = r % 1022, i = rem >> 1, g = rem & 1;
            bf16_t* dst = (bf16_t*)(P.ws + (sel ? WS_VC : WS_KC)) + ((size_t)(b * 2 + g) * 512 + i) * 64 + cq * 16;
            u32x4 w0, w1;
            w0.x = cvtpk(o[0], o[1]); w0.y = cvtpk(o[2], o[3]); w0.z = cvtpk(o[4], o[5]); w0.w = cvtpk(o[6], o[7]);
            w1.x = cvtpk(o[8], o[9]); w1.y = cvtpk(o[10], o[11]); w1.z = cvtpk(o[12], o[13]); w1.w = cvtpk(o[14], o[15]);
            *(u32x4*)dst = w0; *(u32x4*)(dst + 8) = w1; }
    }
    __syncthreads();
}

__device__ __forceinline__ int off_row128(int row, int ch) { return row * 128 + ((ch ^ ((row >> 1) & 7)) << 4); }
__device__ __forceinline__ int off_row256(int row, int ch) { return row * 256 + ((ch ^ (row & 15)) << 4); }
__device__ __forceinline__ int fk_(int r) { return (r & 3) | (((r >> 3) & 1) << 2); }
__device__ __forceinline__ int off_tr256(int row, int col) { return row * 256 + ((((col >> 4) ^ fk_(row)) << 5) + ((col & 15) << 1)); }
constexpr int HL_QT = 0, HL_KT = 16384, HL_KH = 32768, HL_V = 49152, HL_SB = 65536, HL_P = 98304  , HL_TOT = 106496  , HL_RED = 110592  , HL_END = 111104;

template <int MODE> __device__ __forceinline__ void hgrn_unit(const Params& P, LAS unsigned char* lds, int u) {
    const int tid = opaque_tid(), lane = tid & 63, wid = tid >> 6, fr = lane & 15, fq = lane >> 4;
    const int b = u >> 7, h = (u >> 5) & 3, sc = u & 31;
    const bf16_t* hq = (const bf16_t*)(P.ws + WS_HQ); const bf16_t* logf = (const bf16_t*)(P.ws + WS_LOGF);
    const bf16_t* hv = (const bf16_t*)(P.ws + WS_HV); const bf16_t* hg = (const bf16_t*)(P.ws + WS_HG);
    float* HLs = (float*)(P.ws + WS_HL); float* HDs = (float*)(P.ws + WS_HD);
    bf16_t* mix = (bf16_t*)(P.ws + WS_MIX);
    LAS float* tot = (LAS float*)(lds + HL_TOT); LAS float* red = (LAS float*)(lds + HL_RED);
    f32x4 st[8];
#pragma unroll
    for (int vt = 0; vt < 8; ++vt) st[vt] = (f32x4){0.f, 0.f, 0.f, 0.f};
    if (MODE == 1) {
        const float* Lj = HLs + (size_t)u * 16384 + (16 * wid + fr) * 128 + 4 * fq;
#pragma unroll
        for (int vt = 0; vt < 8; ++vt) st[vt] = *(const f32x4*)(Lj + vt * 16);
    }
    float dsum = 0.f;
    const int kp = tid & 63, te = tid >> 6;
    for (int c = 0; c < 4; ++c) {
        const size_t tok0 = (size_t)b * SEQ + sc * 256 + c * 64;
        float lf0[8], lf1[8], cs0[8], cs1[8];
        { float a0 = 0.f, a1 = 0.f;
#pragma unroll
          for (int i = 0; i < 8; ++i) { const unsigned vr = *(const unsigned*)(logf + (tok0 + te * 8 + i) * 512 + h * 128 + 2 * kp); const float vx = __uint_as_float(vr << 16), vy = __uint_as_float(vr & 0xffff0000u); lf0[i] = vx; lf1[i] = vy; a0 += vx; a1 += vy; cs0[i] = a0; cs1[i] = a1; }
          tot[te * 128 + 2 * kp] = a0; tot[te * 128 + 2 * kp + 1] = a1; }
        unsigned qpre[8];
        if (MODE == 1) {
#pragma unroll
            for (int i = 0; i < 8; ++i) qpre[i] = *(const unsigned*)(hq + (tok0 + te * 8 + i) * 512 + h * 128 + 2 * kp);
        }
        u32x2 gpre[4];
        if (MODE == 1) {
#pragma unroll
            for (int i = 0; i < 4; ++i) gpre[i] = *(const u32x2*)(hg + (tok0 + (wid >> 1) * 16 + fr) * 512 + h * 128 + (4 * (wid & 1) + i) * 16 + 4 * fq);
        }
#pragma unroll
        for (int i = 0; i < 2; ++i) { const int pc = tid + NTHREADS * i, row = pc >> 4, c8 = (pc & 15) * 8;
            const u32x4 v = *(const u32x4*)(hv + (tok0 + row) * 512 + h * 128 + c8);
            *(LAS u32x4*)(lds + HL_V + off_tr256(row, c8)) = v; }
        if (MODE == 1 ) {
#pragma unroll
            for (int vt = 0; vt < 8; ++vt) { u32x2 pk; pk.x = cvtpk(st[vt].x, st[vt].y); pk.y = cvtpk(st[vt].z, st[vt].w);
                *(LAS u32x2*)(lds + HL_SB + off_tr256(16 * wid + fr, 16 * vt + 4 * fq)) = pk; }
        }
        __syncthreads();
        float pre0 = 0.f, pre1 = 0.f, last0 = 0.f, last1 = 0.f;
#pragma unroll
        for (int e = 0; e < 8; ++e) { const float t0 = tot[e * 128 + 2 * kp], t1 = tot[e * 128 + 2 * kp + 1]; if (e < te) { pre0 += t0; pre1 += t1; } last0 += t0; last1 += t1; }
#pragma unroll
        for (int i = 0; i < 8; ++i) {
            const int t = te * 8 + i;
            const float c0 = cs0[i] + pre0, c1 = cs1[i] + pre1;
            const float k0 = 1.f - __expf(lf0[i]), k1 = 1.f - __expf(lf1[i]);
            const unsigned khat = cvtpk(k0 * __expf(last0 - c0), k1 * __expf(last1 - c1));
            *(LAS unsigned*)(lds + HL_KH + off_tr256(t, 2 * kp)) = khat;
            if (MODE == 1) {
                const unsigned qraw = qpre[i];
                const float q0 = __uint_as_float(qraw << 16), q1 = __uint_as_float(qraw & 0xffff0000u);
                const unsigned qt = cvtpk(q0 * __expf(c0), q1 * __expf(c1));
                const unsigned kt = cvtpk(k0 * __expf(fminf(-c0, 80.f)), k1 * __expf(fminf(-c1, 80.f)));
                const int o = off_row256(t, kp >> 2) + ((kp & 3) << 2);
                *(LAS unsigned*)(lds + HL_QT + o) = qt; *(LAS unsigned*)(lds + HL_KT + o) = kt;
            }
        }
        const float dec = __expf(tot[0 * 128 + 16 * wid + fr] + tot[1 * 128 + 16 * wid + fr] + tot[2 * 128 + 16 * wid + fr] + tot[3 * 128 + 16 * wid + fr]
                                 + tot[4 * 128 + 16 * wid + fr] + tot[5 * 128 + 16 * wid + fr] + tot[6 * 128 + 16 * wid + fr] + tot[7 * 128 + 16 * wid + fr]);
        if (MODE == 0 && tid < 128) { float s = 0.f;
#pragma unroll
            for (int e = 0; e < 8; ++e) s += tot[e * 128 + tid];
            dsum += s; }
        __syncthreads();
        f32x4 oacc[4];
        if (MODE == 1) {
            { const int tt = wid & 3;
#pragma unroll
              for (int si = 0; si < 2; ++si) { const int stl = 2 * (wid >> 2) + si;
                  f32x4 sacc = (f32x4){0.f, 0.f, 0.f, 0.f};
                  if (stl <= tt) {
#pragma unroll
                      for (int ks = 0; ks < 4; ++ks) {
                          const bf16x8 a = *(const LAS bf16x8*)(lds + HL_KT + off_row256(stl * 16 + fr, ks * 4 + fq));
                          const bf16x8 bq = *(const LAS bf16x8*)(lds + HL_QT + off_row256(tt * 16 + fr, ks * 4 + fq));
                          sacc = __builtin_amdgcn_mfma_f32_16x16x32_bf16(a, bq, sacc, 0, 0, 0);
                      }
                  }
                  const int t = tt * 16 + fr, s0 = stl * 16 + 4 * fq;
                  u32x2 pk; pk.x = cvtpk(s0 + 0 <= t ? sacc.x : 0.f, s0 + 1 <= t ? sacc.y : 0.f); pk.y = cvtpk(s0 + 2 <= t ? sacc.z : 0.f, s0 + 3 <= t ? sacc.w : 0.f);
                  *(LAS u32x2*)(lds + HL_P + off_row128(t, s0 >> 3) + ((s0 & 7) << 1)) = pk; }
            }
            __syncthreads();
            { const int tt = wid >> 1;
#pragma unroll
              for (int i = 0; i < 4; ++i) { const int vt = 4 * (wid & 1) + i;
                  f32x4 a = (f32x4){0.f, 0.f, 0.f, 0.f};
#pragma unroll
                  for (int ks = 0; ks < 2; ++ks) {
                      const int kr = ks * 32 + 8 * fq + (fr >> 2);
                      const s16x4 lo = lds_tr(lds + HL_V + off_tr256(kr, vt * 16 + 4 * (fr & 3))), hi = lds_tr(lds + HL_V + off_tr256(kr + 4, vt * 16 + 4 * (fr & 3)));
                      const bf16x8 va = (bf16x8){lo[0], lo[1], lo[2], lo[3], hi[0], hi[1], hi[2], hi[3]};
                      const bf16x8 pb = *(const LAS bf16x8*)(lds + HL_P + off_row128(tt * 16 + fr, ks * 4 + fq));
                      a = __builtin_amdgcn_mfma_f32_16x16x32_bf16(va, pb, a, 0, 0, 0);
                  }
#pragma unroll
                  for (int ks = 0; ks < 4; ++ks) {
                      const int kr = ks * 32 + 8 * fq + (fr >> 2);
                      const s16x4 lo = lds_tr(lds + HL_SB + off_tr256(kr, vt * 16 + 4 * (fr & 3))), hi = lds_tr(lds + HL_SB + off_tr256(kr + 4, vt * 16 + 4 * (fr & 3)));
                      const bf16x8 sa = (bf16x8){lo[0], lo[1], lo[2], lo[3], hi[0], hi[1], hi[2], hi[3]};
                      const bf16x8 qb = *(const LAS bf16x8*)(lds + HL_QT + off_row256(tt * 16 + fr, ks * 4 + fq));
                      a = __builtin_amdgcn_mfma_f32_16x16x32_bf16(sa, qb, a, 0, 0, 0);
                  }
                  const u32x2 gr = gpre[i];
                  a.x *= __uint_as_float(gr.x << 16); a.y *= __uint_as_float(gr.x & 0xffff0000u); a.z *= __uint_as_float(gr.y << 16); a.w *= __uint_as_float(gr.y & 0xffff0000u);
                  oacc[i] = a; }
              float ss = 0.f;
#pragma unroll
              for (int i = 0; i < 4; ++i) ss += (oacc[i].x * oacc[i].x + oacc[i].y * oacc[i].y) + (oacc[i].z * oacc[i].z + oacc[i].w * oacc[i].w);
              ss += __shfl_xor(ss, 16); ss += __shfl_xor(ss, 32);
              if (fq == 0) red[(tt * 2 + (wid & 1)) * 16 + fr] = ss; }
        }
#pragma unroll
        for (int vt = 0; vt < 8; ++vt) {
            f32x4 a = st[vt] * dec;
#pragma unroll
            for (int ks = 0; ks < 2; ++ks) {
                const int kr = ks * 32 + 8 * fq + (fr >> 2);
                const s16x4 lo = lds_tr(lds + HL_V + off_tr256(kr, vt * 16 + 4 * (fr & 3))), hi = lds_tr(lds + HL_V + off_tr256(kr + 4, vt * 16 + 4 * (fr & 3)));
                const bf16x8 va = (bf16x8){lo[0], lo[1], lo[2], lo[3], hi[0], hi[1], hi[2], hi[3]};
                const s16x4 lo2 = lds_tr(lds + HL_KH + off_tr256(kr, wid * 16 + 4 * (fr & 3))), hi2 = lds_tr(lds + HL_KH + off_tr256(kr + 4, wid * 16 + 4 * (fr & 3)));
                const bf16x8 kb = (bf16x8){lo2[0], lo2[1], lo2[2], lo2[3], hi2[0], hi2[1], hi2[2], hi2[3]};
                a = __builtin_amdgcn_mfma_f32_16x16x32_bf16(va, kb, a, 0, 0, 0);
            }
            st[vt] = a;
        }
        __syncthreads();
        if (MODE == 1) {
            const int tt = wid >> 1; const float ssum = red[(tt * 2) * 16 + fr] + red[(tt * 2 + 1) * 16 + fr];
            const float rstd = rsqrtf(ssum * (1.f / 128.f) + RMS_EPS);
#pragma unroll
            for (int i = 0; i < 4; ++i) { const int v = (4 * (wid & 1) + i) * 16 + 4 * fq; const f32x4 w = *(const f32x4*)(P.rec_out_norm_w + h * 128 + v);
                u32x2 pk; pk.x = cvtpk(oacc[i].x * rstd * w.x, oacc[i].y * rstd * w.y); pk.y = cvtpk(oacc[i].z * rstd * w.z, oacc[i].w * rstd * w.w);
                *(u32x2*)(mix + (tok0 + tt * 16 + fr) * 1024 + 512 + h * 128 + v) = pk; }
        }
    }
    if (MODE == 0) {
#pragma unroll
        for (int vt = 0; vt < 8; ++vt) *(f32x4*)(HLs + (size_t)u * 16384 + (16 * wid + fr) * 128 + vt * 16 + 4 * fq) = st[vt];
        if (tid < 128) HDs[(size_t)u * 128 + tid] = __expf(dsum);
    }
    __syncthreads();
}


__device__ __forceinline__ void phase_hgrn_prefix(const Params& P) {
    float* HLs = (float*)(P.ws + WS_HL); const float* HDs = (const float*)(P.ws + WS_HD);
    const int gt = blockIdx.x * NTHREADS + threadIdx.x, NG = gridDim.x * NTHREADS;
    for (int e = gt; e < 16 * 4096; e += NG) {
        const int bh = e >> 12, q = e & 4095, kk = q >> 5;
        float* base = HLs + (size_t)bh * 32 * 16384 + q * 4; const float* db = HDs + (size_t)bh * 32 * 128 + kk;
        f32x4 s = (f32x4){0.f, 0.f, 0.f, 0.f};
#pragma unroll 1
        for (int g8 = 0; g8 < 32; g8 += 8) { f32x4 l[8]; float d[8];
#pragma unroll
            for (int j = 0; j < 8; ++j) { l[j] = *(const f32x4*)(base + (size_t)(g8 + j) * 16384); d[j] = db[(g8 + j) * 128]; }
#pragma unroll
            for (int j = 0; j < 8; ++j) { *(f32x4*)(base + (size_t)(g8 + j) * 16384) = s; s = s * d[j] + l[j]; } }
    }
}

constexpr int NL_K = 0, NL_V = 16384, NL_IMP = 32768, NL_IMP_STRIDE = 132, NL_SELM = NL_IMP + 8 * 8 * NL_IMP_STRIDE * 4, NL_END = NL_SELM + 1024;
__device__ __forceinline__ int off_v128(int row, int ch) { return row * 128 + ((ch ^ ((row & 3) << 1)) << 4); }
#define MFMA32(a, b, c) __builtin_amdgcn_mfma_f32_32x32x16_bf16(a, b, c, 0, 0, 0)

struct NsaLane { int t; float sl2; int qi; unsigned long long mlo, mhi; };

template <int MODE> __device__ __forceinline__ void nsa_pass(LAS unsigned char* lds, const bf16_t* Kg, const bf16_t* Vg, int rs, unsigned long long ulo, unsigned long long uhi,
                                                            const bf16x8 (&qf)[4], const NsaLane& L, float inv, float& lsum, f32x16 (&O)[2], LAS float* impw) {
    const int tid = opaque_tid(), lane = tid & 63, hi = lane >> 5, c = lane & 31;
    const int ld_row = tid >> 3, ld_ch = tid & 7;
    const int kw_off = off_row128(ld_row, ld_ch), vw_off = off_v128(ld_row, ld_ch);
    u32x4 k0, v0, k1, v1, k2, v2;
    auto next = [&](int jj) -> int { ++jj; if (jj < 64) { const unsigned long long m = ulo >> jj; if (m) return jj + __builtin_ctzll(m); jj = 64; }
                                     if (jj < 128) { const unsigned long long m = uhi >> (jj - 64); if (m) return jj + __builtin_ctzll(m); } return 128; };
    int jA = next(-1), jB = jA < 128 ? next(jA) : 128, jC = jB < 128 ? next(jB) : 128;
    const int jsafe = jA < 128 ? jA : 0;
    auto ldk = [&](int jj) -> u32x4 { const int q = jj < 128 ? jj : jsafe; return *(const u32x4*)(Kg + (size_t)(q * 64 + ld_row) * rs + ld_ch * 8); };
    auto ldv = [&](int jj) -> u32x4 { const int q = jj < 128 ? jj : jsafe; return *(const u32x4*)(Vg + (size_t)(q * 64 + ld_row) * rs + ld_ch * 8); };
    k0 = ldk(jA); k1 = ldk(jB); k2 = ldk(jC);
    if (MODE != 0) { v0 = ldv(jA); v1 = ldv(jB); v2 = ldv(jC); }
    int it = 0;
    auto step = [&](u32x4& kreg, u32x4& vreg) {
        const int j = jA;
        LAS unsigned char* kb = lds + NL_K + (it & 1) * 8192; LAS unsigned char* vb = lds + NL_V + (it & 1) * 8192;
        *(LAS u32x4*)(kb + kw_off) = kreg; if (MODE != 0) *(LAS u32x4*)(vb + vw_off) = vreg;
        const int jD = jC < 128 ? next(jC) : 128;
        kreg = ldk(jD); if (MODE != 0) vreg = ldv(jD);
        __syncthreads();
        bool need = true; bool selbit = true;
        if (MODE == 2) { selbit = (j < 64 ? (L.mlo >> j) : (L.mhi >> (j - 64))) & 1ull; need = __any(selbit); }
        if (need) {
            f32x16 p0 = {}, p1 = {};
#pragma unroll
            for (int ks = 0; ks < 4; ++ks) {
                const bf16x8 a0 = *(const LAS bf16x8*)(kb + off_row128(c, 2 * ks + hi)), a1 = *(const LAS bf16x8*)(kb + off_row128(32 + c, 2 * ks + hi));
                p0 = MFMA32(a0, qf[ks], p0); p1 = MFMA32(a1, qf[ks], p1);
            }
            const int stride = (MODE <= 1) ? 16 : 1;
            const int dl = (MODE <= 1) ? (L.t - 31 - 16 * (j * 64 + 4 * hi)) : (L.t - (j * 64 + 4 * hi));
            const float nb = -L.sl2 * (float)dl, sls = L.sl2 * (float)stride;
            float rs_ = 0.f;
#pragma unroll
            for (int r = 0; r < 16; ++r) {
                const int ro0 = (r & 3) + 8 * (r >> 2), ro1 = ro0 + 32;
                const int d0 = dl - stride * ro0, d1 = dl - stride * ro1;
                bool v0 = d0 >= 0, v1 = d1 >= 0;
                if (MODE == 3) { v0 = v0 && d0 < 512; v1 = v1 && d1 < 512; }
                if (MODE == 2) { v0 = v0 && selbit; v1 = v1 && selbit; }
                float e0 = __builtin_amdgcn_exp2f(__builtin_fmaf(p0[r], LOG2E, __builtin_fmaf(sls, (float)ro0, nb)));
                float e1 = __builtin_amdgcn_exp2f(__builtin_fmaf(p1[r], LOG2E, __builtin_fmaf(sls, (float)ro1, nb)));
                e0 = v0 ? e0 : 0.f; e1 = v1 ? e1 : 0.f;
                if (MODE == 1) { e0 *= inv; e1 *= inv; }
                p0[r] = e0; p1[r] = e1; rs_ += e0 + e1;
            }
            lsum += rs_;
            if (MODE == 1) {
#pragma unroll
                for (int kt = 0; kt < 2; ++kt)
#pragma unroll
                    for (int i = 0; i < 4; ++i) {
                        float g = kt ? (p1[4 * i] + p1[4 * i + 1]) + (p1[4 * i + 2] + p1[4 * i + 3]) : (p0[4 * i] + p0[4 * i + 1]) + (p0[4 * i + 2] + p0[4 * i + 3]);
                        float l3 = kt ? p1[4 * i + 3] : p0[4 * i + 3];
                        g += __shfl_xor(g, 1); g += __shfl_xor(g, 2); l3 += __shfl_xor(l3, 1); l3 += __shfl_xor(l3, 2);
                        if ((c & 3) == 0) { const int jj = j * 16 + kt * 8 + 2 * i + hi; __hip_atomic_fetch_add(impw + L.qi * NL_IMP_STRIDE + jj, g, __ATOMIC_RELAXED, __HIP_MEMORY_SCOPE_WORKGROUP); __hip_atomic_fetch_add(impw + L.qi * NL_IMP_STRIDE + jj + 1, l3, __ATOMIC_RELAXED, __HIP_MEMORY_SCOPE_WORKGROUP); }
                    }
            }
            if (MODE != 0) {
                bf16x8 pf[4];
#pragma unroll
                for (int s4 = 0; s4 < 4; ++s4) { u32x4 w;
#pragma unroll
                    for (int e = 0; e < 4; ++e) { const int r = 8 * (s4 & 1) + 2 * e; w[e] = (s4 >> 1) ? cvtpk(p1[r], p1[r + 1]) : cvtpk(p0[r], p0[r + 1]); }
                    pf[s4] = __builtin_bit_cast(bf16x8, w); }
                const int g4 = lane >> 4, sub = g4 & 1, i16 = lane & 15, qq = i16 >> 2, pp = i16 & 3;
#pragma unroll
                for (int dt = 0; dt < 2; ++dt)
#pragma unroll
                    for (int s4 = 0; s4 < 4; ++s4) {
                        const int row = 16 * s4 + 4 * hi + qq, ch = 4 * dt + 2 * sub + (pp >> 1);
                        const s16x4 lo = lds_tr(vb + off_v128(row, ch) + 8 * (pp & 1)), hh = lds_tr(vb + off_v128(row + 8, ch) + 8 * (pp & 1));
                        const bf16x8 vf = (bf16x8){lo[0], lo[1], lo[2], lo[3], hh[0], hh[1], hh[2], hh[3]};
                        O[dt] = MFMA32(vf, pf[s4], O[dt]);
                    }
            }
        }
        jA = jB; jB = jC; jC = jD; ++it;
    };
    while (jA < 128) {
        step(k0, v0); if (jA >= 128) break;
        step(k1, v1); if (jA >= 128) break;
        step(k2, v2);
    }
    __syncthreads();
}

__device__ __forceinline__ void nsa_unit(const Params& P, LAS unsigned char* lds, int u) {
    const int tid = opaque_tid(), lane = tid & 63, wid = tid >> 6, hi = lane >> 5, c = lane & 31;
    const int b = u >> 8, g = (u >> 7) & 1, qb = u & 127;
    const bf16_t* qg = (const bf16_t*)(P.ws + WS_Q); const bf16_t* kv = (const bf16_t*)(P.ws + WS_KV);
    const bf16_t* kcn = (const bf16_t*)(P.ws + WS_KC) + (size_t)(b * 2 + g) * 512 * 64; const bf16_t* vcc = (const bf16_t*)(P.ws + WS_VC) + (size_t)(b * 2 + g) * 512 * 64;
    const float* gates = (const float*)(P.ws + WS_GATES); bf16_t* mix = (bf16_t*)(P.ws + WS_MIX);
    LAS float* impw = (LAS float*)(lds + NL_IMP) + wid * 8 * NL_IMP_STRIDE;
    LAS unsigned long long* selm = (LAS unsigned long long*)(lds + NL_SELM);
    NsaLane L; L.qi = c >> 2; const int hh = c & 3, head = g * 4 + hh;
    L.t = qb * 64 + wid * 8 + L.qi; L.sl2 = exp2f(-(float)(head + 1)) * LOG2E; L.mlo = 0; L.mhi = 0;
    const size_t tok = (size_t)b * SEQ + L.t;
    bf16x8 qf[4];
#pragma unroll
    for (int ks = 0; ks < 4; ++ks) qf[ks] = *(const bf16x8*)(qg + tok * 512 + head * 64 + 16 * ks + 8 * hi);
    for (int i = lane; i < 8 * NL_IMP_STRIDE; i += 64) impw[i] = 0.f;
    const int ncmp = qb * 4 + 3 < 511 ? qb * 4 + 3 : 511;
    const int nblk = (ncmp + 63) >> 6;
    const unsigned long long cm = nblk >= 64 ? ~0ull : ((1ull << nblk) - 1ull);
    f32x16 O[2], Ot[2]; float lsum = 0.f;
    O[0] = f32x16{}; O[1] = f32x16{};
    nsa_pass<0>(lds, kcn, vcc, 64, cm, 0ull, qf, L, 1.f, lsum, O, impw);
    lsum += __shfl_xor(lsum, 32);
    const float invc = 1.0f / fmaxf(lsum, 1e-30f);
    float dummy = 0.f;
    nsa_pass<1>(lds, kcn, vcc, 64, cm, 0ull, qf, L, invc, dummy, O, impw);
    const float* gt = gates + tok * 24 + g * 12 + hh * 3;
    const float g0 = gt[0], g1 = gt[1], g2 = gt[2];
#pragma unroll
    for (int dt = 0; dt < 2; ++dt) Ot[dt] = O[dt] * g0;
    {
        const int ncausal = qb + 1;
        for (int qi = 0; qi < 8; ++qi) {
            unsigned long long lo, hi64;
            if (ncausal <= 16) { lo = (1ull << ncausal) - 1ull; hi64 = 0ull; }
            else {
                const int j0 = lane, j1 = lane + 64;
                const bool f0 = (j0 == 0) || (j0 == qb) || (j0 == qb - 1), f1 = (j1 == qb) || (j1 == qb - 1);
                const unsigned k0 = (j0 <= qb && !f0) ? (0x80000000u | (__float_as_uint(impw[qi * NL_IMP_STRIDE + j0]) & 0x7fffff80u) | (unsigned)j0) : 0u;
                const unsigned k1 = (j1 <= qb && !f1) ? (0x80000000u | (__float_as_uint(impw[qi * NL_IMP_STRIDE + j1]) & 0x7fffff80u) | (unsigned)j1) : 0u;
                const int needn = 13;
                unsigned th = 0u;
                for (int bit = 31; bit >= 0; --bit) { const unsigned cand = th | (1u << bit);
                    const int cnt = __popcll(__ballot(k0 >= cand)) + __popcll(__ballot(k1 >= cand));
                    if (cnt >= needn) th = cand; }
                lo = __ballot(f0 || (k0 >= th && k0 != 0u)); hi64 = __ballot(f1 || (k1 >= th && k1 != 0u));
            }
            if (lane == 0) { selm[(wid * 8 + qi) * 2] = lo; selm[(wid * 8 + qi) * 2 + 1] = hi64; }
        }
    }
    __syncthreads();
    unsigned long long ulo = selm[lane * 2], uhi = selm[lane * 2 + 1];
#pragma unroll
    for (int o = 1; o < 64; o <<= 1) { ulo |= __shfl_xor(ulo, o); uhi |= __shfl_xor(uhi, o); }
    L.mlo = selm[(wid * 8 + L.qi) * 2]; L.mhi = selm[(wid * 8 + L.qi) * 2 + 1];
    const bf16_t* kvb = kv + (size_t)b * SEQ * 768 + g * 64;
    O[0] = f32x16{}; O[1] = f32x16{}; lsum = 0.f;
    nsa_pass<2>(lds, kvb + 256, kvb + 384, 768, ulo, uhi, qf, L, 1.f, lsum, O, impw);
    lsum += __shfl_xor(lsum, 32);
    { const float sc = g1 / fmaxf(lsum, 1e-30f);
#pragma unroll
      for (int dt = 0; dt < 2; ++dt) Ot[dt] += O[dt] * sc; }
    {
        const int jlo = qb >= 8 ? qb - 8 : 0;
        unsigned long long wlo = 0ull, whi = 0ull;
        for (int jj = jlo; jj <= qb; ++jj) { if (jj < 64) wlo |= 1ull << jj; else whi |= 1ull << (jj - 64); }
        O[0] = f32x16{}; O[1] = f32x16{}; lsum = 0.f;
        nsa_pass<3>(lds, kvb + 512, kvb + 640, 768, wlo, whi, qf, L, 1.f, lsum, O, impw);
        lsum += __shfl_xor(lsum, 32);
        const float sc = g2 / fmaxf(lsum, 1e-30f);
#pragma unroll
        for (int dt = 0; dt < 2; ++dt) Ot[dt] += O[dt] * sc;
    }
    float ss = 0.f;
#pragma unroll
    for (int dt = 0; dt < 2; ++dt)
#pragma unroll
        for (int r = 0; r < 16; ++r) ss += Ot[dt][r] * Ot[dt][r];
    ss += __shfl_xor(ss, 32);
    const float rstd = rsqrtf(ss * (1.f / 64.f) + RMS_EPS);
#pragma unroll
    for (int dt = 0; dt < 2; ++dt)
#pragma unroll
        for (int r4 = 0; r4 < 4; ++r4) { const int d = 32 * dt + 8 * r4 + 4 * hi; const f32x4 w = *(const f32x4*)(P.attn_out_norm_w + head * 64 + d);
            u32x2 pk; pk.x = cvtpk(Ot[dt][4 * r4] * rstd * w.x, Ot[dt][4 * r4 + 1] * rstd * w.y); pk.y = cvtpk(Ot[dt][4 * r4 + 2] * rstd * w.z, Ot[dt][4 * r4 + 3] * rstd * w.w);
            *(u32x2*)(mix + tok * 1024 + head * 64 + d) = pk; }
    __syncthreads();
}


__device__ __forceinline__ int gu_hcol(int m0) { const int ni = (m0 >> 4) & 7; return 64 * (m0 >> 7) + 32 * (ni >> 2) + 8 * ((m0 & 15) >> 2) + 4 * ((ni >> 1) & 1); }
__device__ __forceinline__ int p2_col(int m0) { const int ni = (m0 >> 4) & 7; return 128 * (m0 >> 7) + 32 * (ni >> 1) + 8 * ((m0 & 15) >> 2) + 4 * (ni & 1); }
__device__ __forceinline__ void phase_cvt_small(const Params& P) {
    const int tid = threadIdx.x;
    {
        const int gt = blockIdx.x * NTHREADS + tid, NG = gridDim.x * NTHREADS;
        bf16_t* wo = (bf16_t*)(P.ws + WS_WOUT); bf16_t* wrs = (bf16_t*)(P.ws + WS_WRS); bf16_t* wsd = (bf16_t*)(P.ws + WS_WSD);
        for (int i = gt; i < 1024 * 128; i += NG) { const int k = i >> 7, m0 = (i & 127) * 8; const float* s = P.w_out + (size_t)k * 1024 + (m0 & ~255) + p2_col(m0 & 255);
            const f32x4 a = *(const f32x4*)s, b2 = *(const f32x4*)(s + 8);
            *(u32x4*)(wo + (size_t)i * 8) = (u32x4){cvtpk(a.x, a.y), cvtpk(a.z, a.w), cvtpk(b2.x, b2.y), cvtpk(b2.z, b2.w)}; }
        for (int i = gt; i < 256 * 128; i += NG) { const int k = i >> 7, m0 = (i & 127) * 8; const float* s = P.sh_wd + (size_t)k * 1024 + (m0 & ~255) + p2_col(m0 & 255);
            const f32x4 a = *(const f32x4*)s, b2 = *(const f32x4*)(s + 8);
            *(u32x4*)(wsd + (size_t)i * 8) = (u32x4){cvtpk(a.x, a.y), cvtpk(a.z, a.w), cvtpk(b2.x, b2.y), cvtpk(b2.z, b2.w)}; }
        for (int i = gt; i < 1024 * 96; i += NG) { const int k = i / 96, c8 = (i % 96) * 8;
            const float* s; int d2 = 4;
            if (c8 < 256) s = P.router_w + (size_t)k * 256 + c8;
            else { const int cc = c8 - 256, t = cc >> 8; s = ((cc & 16) ? P.sh_wu : P.sh_wg) + (size_t)k * 256 + t * 128 + gu_hcol(cc & 255); d2 = 8; }
            const f32x4 a = *(const f32x4*)s, b2 = *(const f32x4*)(s + d2);
            *(u32x4*)(wrs + (size_t)k * 768 + c8) = (u32x4){cvtpk(a.x, a.y), cvtpk(a.z, a.w), cvtpk(b2.x, b2.y), cvtpk(b2.z, b2.w)}; }
    }
}

__device__ __forceinline__ void route_token(const Params& P, int t, int lane) {
    const float* scores = (const float*)(P.ws + WS_SCORES) + (size_t)t * 256;
    const f32x4 s4 = *(const f32x4*)(scores + 4 * lane); const f32x4 b4 = *(const f32x4*)(P.router_bias + 4 * lane);
    float sc[4] = {s4.x, s4.y, s4.z, s4.w};
    float bs[4] = {s4.x + b4.x, s4.y + b4.y, s4.z + b4.z, s4.w + b4.w};
    float m1 = fmaxf(bs[0], bs[1]), m2 = fminf(bs[0], bs[1]);
    { const float v = bs[2]; const float n1 = fmaxf(m1, v); m2 = fmaxf(fminf(m1, v), m2); m1 = n1; }
    { const float v = bs[3]; const float n1 = fmaxf(m1, v); m2 = fmaxf(fminf(m1, v), m2); m1 = n1; }
#pragma unroll
    for (int o = 1; o < 8; o <<= 1) { const float o1 = __shfl_xor(m1, o), o2 = __shfl_xor(m2, o); const float n1 = fmaxf(m1, o1); m2 = fmaxf(fminf(m1, o1), fmaxf(m2, o2)); m1 = n1; }
    const float gs = m1 + m2;
    const int grp = lane >> 3;
    int rank = 0;
#pragma unroll
    for (int g2 = 0; g2 < 8; ++g2) { const float og = __shfl(gs, g2 * 8); rank += (og > gs || (og == gs && g2 < grp)) ? 1 : 0; }
    const bool gsel = rank < 4;
    float mv[4];
#pragma unroll
    for (int i = 0; i < 4; ++i) mv[i] = gsel ? bs[i] : -INFINITY;
    int myidx = -1; float myw = 0.f; float wsum = 0.f;
#pragma unroll 1
    for (int k = 0; k < 8; ++k) {
        float bv = mv[0]; int bi = 4 * lane;
#pragma unroll
        for (int i = 1; i < 4; ++i) if (mv[i] > bv) { bv = mv[i]; bi = 4 * lane + i; }
#pragma unroll
        for (int o = 1; o < 64; o <<= 1) { const float ov = __shfl_xor(bv, o); const int oi = __shfl_xor(bi, o); if (ov > bv || (ov == bv && oi < bi)) { bv = ov; bi = oi; } }
        const int wl = bi >> 2, wc = bi & 3;
        const float mine = wc == 0 ? sc[0] : (wc == 1 ? sc[1] : (wc == 2 ? sc[2] : sc[3]));
        const float wv = __shfl(mine, wl);
        wsum += wv;
        if (lane == k) { myidx = bi; myw = wv; }
        if (lane == wl) {
#pragma unroll
            for (int i = 0; i < 4; ++i) if (i == wc) mv[i] = -INFINITY; }
    }
    if (lane < 8) {
        int* cnt = (int*)(P.ws + WS_CTL + CTL_CNT);
        const int pos = atomicAdd(cnt + myidx, 1);
        if (pos < BCAP) ((int*)(P.ws + WS_BUCKET))[(size_t)myidx * BCAP + pos] = t * 8 + lane;
        ((float*)(P.ws + WS_RW))[(size_t)t * 8 + lane] = myw / wsum * 2.5f;
    }
}


__device__ __forceinline__ void phase_p4a(const Params& P, LAS unsigned char* lds) {
    typedef Gemm3 G;
    const int tid = opaque_tid(), lane = tid & 63, wid = tid >> 6, wm = wid >> 1, wn = wid & 1, fr = lane & 15, fq = lane >> 4;
    struct F { const Params& P;
        __device__ __forceinline__ void ptrs(int seg, const bf16_t* (&aptr)[2], const bf16_t* (&bptr)[2]) const {
            const int tid = opaque_tid(), lane = tid & 63, wid = tid >> 6, wm = wid >> 1, wn = wid & 1, fr = lane & 15, fq = lane >> 4, c8 = 8 * (tid & 31); (void)wm; (void)wn; (void)fr; (void)fq; (void)c8;
            const int u = blockIdx.x + seg * gridDim.x, rt = u >> 2, ct = u & 3;
            const bf16_t* mix = (const bf16_t*)(P.ws + WS_MIX); const bf16_t* wo = (const bf16_t*)(P.ws + WS_WOUT);
#pragma unroll
            for (int i = 0; i < 2; ++i) { const int row = G::a_row(i, wid, lane); aptr[i] = mix + (size_t)(rt * 256 + row) * 1024 + G::a_chunk(row, lane) * 8;
                const int k = G::b_k(i, wid, lane); bptr[i] = wo + (size_t)k * 1024 + ct * 256 + G::b_n(k, lane); } }
        __device__ __forceinline__ void epi(int seg, f32x4 (&acc)[4][8]) const {
            const int tid = opaque_tid(), lane = tid & 63, wid = tid >> 6, wm = wid >> 1, wn = wid & 1, fr = lane & 15, fq = lane >> 4, c8 = 8 * (tid & 31); (void)wm; (void)wn; (void)fr; (void)fq; (void)c8;
            const int u = blockIdx.x + seg * gridDim.x, rt = u >> 2, ct = u & 3, b = (rt * 256) / SEQ;
            const float* mod = (const float*)(P.ws + WS_MOD) + b * 6144; float* ssp = (float*)(P.ws + WS_SS); bf16_t* x1 = (bf16_t*)(P.ws + WS_X1);
#pragma unroll
            for (int mi = 0; mi < 4; ++mi) { const size_t m = (size_t)(rt * 256 + wm * 64 + mi * 16 + fr); float ss = 0.f;
#pragma unroll
                for (int j = 0; j < 4; ++j) { const int col = ct * 256 + wn * 128 + j * 32 + 8 * fq;
                    const f32x4 xv = *(const f32x4*)(P.x + m * 1024 + col), xw = *(const f32x4*)(P.x + m * 1024 + col + 4), gv = *(const f32x4*)(mod + 2048 + col), gw = *(const f32x4*)(mod + 2048 + col + 4);
                    const f32x4 a = acc[mi][2 * j], c = acc[mi][2 * j + 1];
                    f32x4 o, o2; o.x = xv.x + gv.x * a.x; o.y = xv.y + gv.y * a.y; o.z = xv.z + gv.z * a.z; o.w = xv.w + gv.w * a.w;
                    o2.x = xw.x + gw.x * c.x; o2.y = xw.y + gw.y * c.y; o2.z = xw.z + gw.z * c.z; o2.w = xw.w + gw.w * c.w;
                    *(u32x4*)(x1 + m * 1024 + col) = (u32x4){cvtpk(o.x, o.y), cvtpk(o.z, o.w), cvtpk(o2.x, o2.y), cvtpk(o2.z, o2.w)};
                    ss += ((o.x * o.x + o.y * o.y) + (o.z * o.z + o.w * o.w)) + ((o2.x * o2.x + o2.y * o2.y) + (o2.z * o2.z + o2.w * o2.w)); if (j & 1) asm volatile("" ::: "memory"); }
                ss += __shfl_xor(ss, 16); ss += __shfl_xor(ss, 32);
                if (fq == 0) ssp[m * 8 + ct * 2 + wn] = ss; } }
    } f{P};
    const int nu = (128 * 4 - (int)blockIdx.x + (int)gridDim.x - 1) / (int)gridDim.x;
    if (nu > 0) G::run_stream(f, nu, 32, 32, (size_t)32 * 1024, lds);
}
__device__ __forceinline__ void phase_p4b(const Params& P) {
    const int lane = threadIdx.x & 63, gw = blockIdx.x * (NTHREADS / 64) + (threadIdx.x >> 6), NGW = gridDim.x * (NTHREADS / 64);
    const float* ssp = (const float*)(P.ws + WS_SS); bf16_t* h2 = (bf16_t*)(P.ws + WS_H);
    for (int m = gw; m < T; m += NGW) {
        const float* mod = (const float*)(P.ws + WS_MOD) + (m / SEQ) * 6144;
        const f32x4 s0 = *(const f32x4*)(ssp + (size_t)m * 8), s1 = *(const f32x4*)(ssp + (size_t)m * 8 + 4);
        const float rstd = rsqrtf(((s0.x + s0.y) + (s0.z + s0.w) + (s1.x + s1.y) + (s1.z + s1.w)) * (1.f / 1024.f) + RMS_EPS);
#pragma unroll
        for (int j = 0; j < 4; ++j) { const int col = (lane + 64 * j) * 4;
            const u32x2 xr = *(const u32x2*)((const bf16_t*)(P.ws + WS_X1) + (size_t)m * 1024 + col);
            const f32x4 v = (f32x4){__uint_as_float(xr.x << 16), __uint_as_float(xr.x & 0xffff0000u), __uint_as_float(xr.y << 16), __uint_as_float(xr.y & 0xffff0000u)}, wv = *(const f32x4*)(P.norm2_w + col), scv = *(const f32x4*)(mod + 4096 + col), shv = *(const f32x4*)(mod + 3072 + col);
            const float r0 = v.x * rstd * wv.x * (1.f + scv.x) + shv.x, r1 = v.y * rstd * wv.y * (1.f + scv.y) + shv.y, r2 = v.z * rstd * wv.z * (1.f + scv.z) + shv.z, r3 = v.w * rstd * wv.w * (1.f + scv.w) + shv.w;
            u32x2 pk; pk.x = cvtpk(r0, r1); pk.y = cvtpk(r2, r3);
            *(u32x2*)(h2 + (size_t)m * 1024 + col) = pk;
            int q8 = __builtin_amdgcn_cvt_pk_fp8_f32(r0, r1, 0, false); q8 = __builtin_amdgcn_cvt_pk_fp8_f32(r2, r3, q8, true);
            *(int*)((unsigned char*)(P.ws + WS_H2Q) + (size_t)m * 1024 + col) = q8; }
    }
}
__device__ __forceinline__ void phase_p4c(const Params& P, LAS unsigned char* lds) {
    typedef Gemm3 G;
    const int tid = opaque_tid(), lane = tid & 63, wid = tid >> 6, wm = wid >> 1, wn = wid & 1, fr = lane & 15, fq = lane >> 4;
    struct F { const Params& P;
        __device__ __forceinline__ void ptrs(int seg, const bf16_t* (&aptr)[2], const bf16_t* (&bptr)[2]) const {
            const int tid = opaque_tid(), lane = tid & 63, wid = tid >> 6, wm = wid >> 1, wn = wid & 1, fr = lane & 15, fq = lane >> 4, c8 = 8 * (tid & 31); (void)wm; (void)wn; (void)fr; (void)fq; (void)c8;
            const int u = blockIdx.x + seg * gridDim.x, rt = u / 3, ct = u % 3;
            const bf16_t* h2 = (const bf16_t*)(P.ws + WS_H); const bf16_t* wrs = (const bf16_t*)(P.ws + WS_WRS);
#pragma unroll
            for (int i = 0; i < 2; ++i) { const int row = G::a_row(i, wid, lane); aptr[i] = h2 + (size_t)(rt * 256 + row) * 1024 + G::a_chunk(row, lane) * 8;
                const int k = G::b_k(i, wid, lane); bptr[i] = wrs + (size_t)k * 768 + ct * 256 + G::b_n(k, lane); } }
        __device__ __forceinline__ void epi(int seg, f32x4 (&acc)[4][8]) const {
            const int tid = opaque_tid(), lane = tid & 63, wid = tid >> 6, wm = wid >> 1, wn = wid & 1, fr = lane & 15, fq = lane >> 4, c8 = 8 * (tid & 31); (void)wm; (void)wn; (void)fr; (void)fq; (void)c8;
            const int u = blockIdx.x + seg * gridDim.x, rt = u / 3, ct = u % 3;
            float* scores = (float*)(P.ws + WS_SCORES); bf16_t* hidS = (bf16_t*)(P.ws + WS_HIDS);
#pragma unroll
            for (int mi = 0; mi < 4; ++mi) { const size_t m = (size_t)(rt * 256 + wm * 64 + mi * 16 + fr);
                if (ct == 0) {
#pragma unroll
                    for (int ni = 0; ni < 8; ++ni) { const f32x4 a = acc[mi][ni];
                        *(f32x4*)(scores + m * 256 + wn * 128 + ni * 16 + 4 * fq) = (f32x4){sigmoidf_(a.x), sigmoidf_(a.y), sigmoidf_(a.z), sigmoidf_(a.w)}; }
                } else {
#pragma unroll
                    for (int j2 = 0; j2 < 2; ++j2) { const f32x4 g = acc[mi][4 * j2], uu = acc[mi][4 * j2 + 1], g2 = acc[mi][4 * j2 + 2], u2 = acc[mi][4 * j2 + 3];
                        u32x4 pk; pk.x = cvtpk(siluf_(g.x) * uu.x, siluf_(g.y) * uu.y); pk.y = cvtpk(siluf_(g.z) * uu.z, siluf_(g.w) * uu.w);
                        pk.z = cvtpk(siluf_(g2.x) * u2.x, siluf_(g2.y) * u2.y); pk.w = cvtpk(siluf_(g2.z) * u2.z, siluf_(g2.w) * u2.w);
                        *(u32x4*)(hidS + m * 256 + (ct - 1) * 128 + wn * 64 + j2 * 32 + 8 * fq) = pk; }
                } } }
    } f{P};
    const int nu = (128 * 3 - (int)blockIdx.x + (int)gridDim.x - 1) / (int)gridDim.x;
    if (nu > 0) G::run_stream(f, nu, 32, 32, (size_t)32 * 768, lds);
}
__device__ __forceinline__ void phase_route(const Params& P) {
    const int tid = opaque_tid(), lane = tid & 63, gw = blockIdx.x * (NTHREADS / 64) + (tid >> 6), NGW = gridDim.x * (NTHREADS / 64);
    for (int t = gw; t < T; t += NGW) route_token(P, t, lane);
}
__device__ __forceinline__ void phase_p4d(const Params& P, LAS unsigned char* lds) {
    typedef Gemm3 G;
    const int tid = opaque_tid(), lane = tid & 63, wid = tid >> 6, wm = wid >> 1, wn = wid & 1, fr = lane & 15, fq = lane >> 4;
    struct F { const Params& P;
        __device__ __forceinline__ void ptrs(int seg, const bf16_t* (&aptr)[2], const bf16_t* (&bptr)[2]) const {
            const int tid = opaque_tid(), lane = tid & 63, wid = tid >> 6, wm = wid >> 1, wn = wid & 1, fr = lane & 15, fq = lane >> 4, c8 = 8 * (tid & 31); (void)wm; (void)wn; (void)fr; (void)fq; (void)c8;
            const int u = blockIdx.x + seg * gridDim.x, rt = u >> 2, ct = u & 3;
            const bf16_t* hidS = (const bf16_t*)(P.ws + WS_HIDS); const bf16_t* wsd = (const bf16_t*)(P.ws + WS_WSD);
#pragma unroll
            for (int i = 0; i < 2; ++i) { const int row = G::a_row(i, wid, lane); aptr[i] = hidS + (size_t)(rt * 256 + row) * 256 + G::a_chunk(row, lane) * 8;
                const int k = G::b_k(i, wid, lane); bptr[i] = wsd + (size_t)k * 1024 + ct * 256 + G::b_n(k, lane); } }
        __device__ __forceinline__ void epi(int seg, f32x4 (&acc)[4][8]) const {
            const int tid = opaque_tid(), lane = tid & 63, wid = tid >> 6, wm = wid >> 1, wn = wid & 1, fr = lane & 15, fq = lane >> 4, c8 = 8 * (tid & 31); (void)wm; (void)wn; (void)fr; (void)fq; (void)c8;
            const int u = blockIdx.x + seg * gridDim.x, rt = u >> 2, ct = u & 3;
            unsigned char* ysh = (unsigned char*)(P.ws + WS_YSH);
#pragma unroll
            for (int mi = 0; mi < 4; ++mi) { const size_t m = (size_t)(rt * 256 + wm * 64 + mi * 16 + fr);
#pragma unroll
                for (int j = 0; j < 4; ++j) { const int col = ct * 256 + wn * 128 + j * 32 + 8 * fq; const f32x4 a = acc[mi][2 * j] * Y_SCALE, c = acc[mi][2 * j + 1] * Y_SCALE;
                    *(u32x2*)(ysh + m * 1024 + col) = (u32x2){pk4_fp8(a.x, a.y, a.z, a.w), pk4_fp8(c.x, c.y, c.z, c.w)}; } } }
    } f{P};
    const int nu = (128 * 4 - (int)blockIdx.x + (int)gridDim.x - 1) / (int)gridDim.x;
    if (nu > 0) G::run_stream(f, nu, 8, 32, (size_t)32 * 1024, lds);
}

__device__ __forceinline__ void phase_expert_cvt(const Params& P) {
    const size_t gt = (size_t)blockIdx.x * NTHREADS + threadIdx.x, NG = (size_t)gridDim.x * NTHREADS;
    bf16_t* wgu = (bf16_t*)(P.ws + WS_WBGU); bf16_t* wd = (bf16_t*)(P.ws + WS_WBD);
    for (size_t i = gt; i < (size_t)256 * 1024 * 64; i += NG) {
        const size_t ek = i >> 6; const int c8 = (int)(i & 63) * 8, t = c8 >> 8;
        const float* s = ((c8 & 16) ? P.exp_wu : P.exp_wg) + ek * 256 + t * 128 + gu_hcol(c8 & 255);
        const f32x4 a = __builtin_nontemporal_load((const f32x4*)s), b2 = __builtin_nontemporal_load((const f32x4*)(s + 8));
        *(u32x4*)(wgu + ek * 512 + c8) = (u32x4){cvtpk(a.x, a.y), cvtpk(a.z, a.w), cvtpk(b2.x, b2.y), cvtpk(b2.z, b2.w)}; }
    for (size_t i = gt; i < (size_t)256 * 256 * 128; i += NG) {
        const size_t ek = i >> 7; const int m0 = (int)(i & 127) * 8, tl = m0 & 255, tile = m0 >> 8;
        const int wnn = tl >> 7, nii = (tl >> 4) & 7, n0 = tl & 15;
        const int ca = tile * 256 + wnn * 128 + 64 * (nii >> 2) + 16 * (n0 >> 2) + 4 * (nii & 3);
        const f32x4 a = __builtin_nontemporal_load((const f32x4*)(P.exp_wd + ek * 1024 + ca)), b2 = __builtin_nontemporal_load((const f32x4*)(P.exp_wd + ek * 1024 + ca + 16));
        *(u32x4*)(wd + ek * 1024 + m0) = (u32x4){cvtpk(a.x, a.y), cvtpk(a.z, a.w), cvtpk(b2.x, b2.y), cvtpk(b2.z, b2.w)}; }
}

constexpr int P6_TILES = 128 * 1024, P6_PRE = P6_TILES + 1024, P6_PAIR = P6_PRE + 1040, P6_W = P6_PAIR + 1024;
__device__ __forceinline__ void phase_experts(const Params& P, LAS unsigned char* lds) {
    typedef Gemm3 G;
    const int tid = opaque_tid(), lane = tid & 63, wid = tid >> 6, wm = wid >> 1, wn = wid & 1, fr = lane & 15, fq = lane >> 4;
    const int* cnt = (const int*)(P.ws + WS_CTL + CTL_CNT); const int* bucket = (const int*)(P.ws + WS_BUCKET); const float* rw = (const float*)(P.ws + WS_RW);
    const bf16_t* h2 = (const bf16_t*)(P.ws + WS_H); bf16_t* hidR = (bf16_t*)(P.ws + WS_HIDR) + (size_t)blockIdx.x * 256 * 256; unsigned char* y = (unsigned char*)(P.ws + WS_Y);
    LAS int* tiles = (LAS int*)(lds + P6_TILES); LAS int* pre = (LAS int*)(lds + P6_PRE); LAS int* pairs = (LAS int*)(lds + P6_PAIR); LAS float* wts = (LAS float*)(lds + P6_W);
    const int nx = (gridDim.x % 8 == 0) ? 8 : 1, xl = blockIdx.x % nx, li = blockIdx.x / nx, nloc = gridDim.x / nx, nek = 256 / nx;
    if (tid < nek) { const int c_ = cnt[xl + nx * tid]; tiles[tid] = ((c_ < BCAP ? c_ : BCAP) + 255) >> 8; }
    __syncthreads();
    if (tid < nek) { int s = 0; for (int i = 0; i < tid; ++i) s += tiles[i]; pre[tid] = s; if (tid == nek - 1) pre[nek] = s + tiles[nek - 1]; }
    __syncthreads();
    const int total = pre[nek];
    const int c8 = 8 * (tid & 31), u16 = c8 >> 4;
    for (int u = li; u < total; u += nloc) {
        int lo = 0, hi = nek - 1;
        while (lo < hi) { const int mid = (lo + hi + 1) >> 1; if (pre[mid] <= u) lo = mid; else hi = mid - 1; }
        const int e = xl + nx * lo, tile = u - pre[lo], n = cnt[e] < BCAP ? cnt[e] : BCAP, rows = (n - tile * 256) < 256 ? (n - tile * 256) : 256;
        if (tid < 256) { const int r = tid < rows ? tid : 0; const int pr = bucket[(size_t)e * BCAP + tile * 256 + r]; pairs[tid] = pr; wts[tid] = tid < rows ? rw[pr] : 0.f; }
        __syncthreads();
        {
            struct GU { const bf16_t* h2; LAS int* pairs; const bf16_t* wgu; bf16_t* hidR;
                __device__ __forceinline__ void ptrs(int t, const bf16_t* (&aptr)[2], const bf16_t* (&bptr)[2]) const {
                    const int tid = opaque_tid(), lane = tid & 63, wid = tid >> 6, wm = wid >> 1, wn = wid & 1, fr = lane & 15, fq = lane >> 4, c8 = 8 * (tid & 31); (void)wm; (void)wn; (void)fr; (void)fq; (void)c8;
#pragma unroll
                    for (int i = 0; i < 2; ++i) { const int row = G::a_row(i, wid, lane); aptr[i] = h2 + (size_t)(pairs[row] >> 3) * 1024 + G::a_chunk(row, lane) * 8;
                        const int k = G::b_k(i, wid, lane); bptr[i] = wgu + (size_t)k * 512 + t * 256 + G::b_n(k, lane); } }
                __device__ __forceinline__ void epi(int t, f32x4 (&acc)[4][8]) const {
                    const int tid = opaque_tid(), lane = tid & 63, wid = tid >> 6, wm = wid >> 1, wn = wid & 1, fr = lane & 15, fq = lane >> 4, c8 = 8 * (tid & 31); (void)wm; (void)wn; (void)fr; (void)fq; (void)c8;
#pragma unroll
                    for (int mi = 0; mi < 4; ++mi) { const int rl = wm * 64 + mi * 16 + fr;
#pragma unroll
                        for (int j2 = 0; j2 < 2; ++j2) { const f32x4 g = acc[mi][4 * j2], uu = acc[mi][4 * j2 + 1], g2 = acc[mi][4 * j2 + 2], u2 = acc[mi][4 * j2 + 3];
                            u32x4 pk; pk.x = cvtpk(siluf_(g.x) * uu.x, siluf_(g.y) * uu.y); pk.y = cvtpk(siluf_(g.z) * uu.z, siluf_(g.w) * uu.w);
                            pk.z = cvtpk(siluf_(g2.x) * u2.x, siluf_(g2.y) * u2.y); pk.w = cvtpk(siluf_(g2.z) * u2.z, siluf_(g2.w) * u2.w);
                            *(u32x4*)(hidR + rl * 256 + t * 128 + wn * 64 + j2 * 32 + 8 * fq) = pk; } } }
            } f{h2, pairs, (const bf16_t*)(P.ws + WS_WBGU) + (size_t)e * 1024 * 512, hidR};
            G::run_stream(f, 2, 32, 32, (size_t)32 * 512, lds);
        }
        __syncthreads();
        {
            struct DN { bf16_t* hidR; const bf16_t* wd; unsigned char* y; LAS int* pairs; LAS float* wts; int rows;
                __device__ __forceinline__ void ptrs(int ct, const bf16_t* (&aptr)[2], const bf16_t* (&bptr)[2]) const {
                    const int tid = opaque_tid(), lane = tid & 63, wid = tid >> 6, wm = wid >> 1, wn = wid & 1, fr = lane & 15, fq = lane >> 4, c8 = 8 * (tid & 31); (void)wm; (void)wn; (void)fr; (void)fq; (void)c8;
#pragma unroll
                    for (int i = 0; i < 2; ++i) { const int row = G::a_row(i, wid, lane); aptr[i] = hidR + (size_t)row * 256 + G::a_chunk(row, lane) * 8;
                        const int k = G::b_k(i, wid, lane); bptr[i] = wd + (size_t)k * 1024 + ct * 256 + G::b_n(k, lane); } }
                __device__ __forceinline__ void epi(int ct, f32x4 (&acc)[4][8]) const {
                    const int tid = opaque_tid(), lane = tid & 63, wid = tid >> 6, wm = wid >> 1, wn = wid & 1, fr = lane & 15, fq = lane >> 4, c8 = 8 * (tid & 31); (void)wm; (void)wn; (void)fr; (void)fq; (void)c8;
#pragma unroll
                    for (int mi = 0; mi < 4; ++mi) { const int rl = wm * 64 + mi * 16 + fr; const float wgt = wts[rl]; const size_t pr = (size_t)pairs[rl];
                        if (rl < rows) {
#pragma unroll
                            for (int j2 = 0; j2 < 2; ++j2) { const int col = ct * 256 + wn * 128 + 64 * j2 + 16 * fq; const float sc_ = wgt * Y_SCALE; u32x4 w;
#pragma unroll
                                for (int b2 = 0; b2 < 4; ++b2) { const f32x4 a = acc[mi][4 * j2 + b2] * sc_;
                                    int pk = __builtin_amdgcn_cvt_pk_fp8_f32(a.x, a.y, 0, false); pk = __builtin_amdgcn_cvt_pk_fp8_f32(a.z, a.w, pk, true); w[b2] = (unsigned)pk; }
                                *(u32x4*)(y + pr * 1024 + col) = w; } } } }
            } f{hidR, (const bf16_t*)(P.ws + WS_WBD) + (size_t)e * 256 * 1024, y, pairs, wts, rows};
            G::run_stream(f, 4, 8, 32, (size_t)32 * 1024, lds);
        }
        __syncthreads();
    }
}


__device__ __forceinline__ void cvt8_store_rows(LAS unsigned char* wl, int lane, const u32x4 (&w)[8], unsigned char* obase, size_t row_stride) {
#pragma unroll
    for (int j = 0; j < 8; ++j) *(LAS u32x4*)(wl + lane * 144 + j * 16) = w[j];
    asm volatile("s_waitcnt lgkmcnt(0)" ::: "memory");
#pragma unroll
    for (int i = 0; i < 8; ++i) { const int r = (lane >> 3) + 8 * i; const u32x4 v = *(const LAS u32x4*)(wl + r * 144 + (lane & 7) * 16); *(u32x4*)(obase + (size_t)r * row_stride + (lane & 7) * 16) = v; }
    asm volatile("s_waitcnt lgkmcnt(0)" ::: "memory");
}
__device__ __forceinline__ void cvt8_item(const Params& P, LAS unsigned char* lds, int item) {
    const int tid = opaque_tid(), lane = tid & 63, wv = tid >> 6;
    unsigned char* wgu = (unsigned char*)(P.ws + WS_W8GU); unsigned char* wd = (unsigned char*)(P.ws + WS_W8D);
    LAS unsigned char* wl = lds + wv * 9216;
    const int NGW = 1;
    if (item < 1024)
    for (int u = item * 16 + wv * 2; u < item * 16 + wv * 2 + 2; u += NGW) {
        const int rg = u & 7, kb = (u >> 3) & 7, e = u >> 6;
        const int q = rg * 64 + lane, t = q >> 8, ql = q & 255, wnn = ql >> 7, it = (ql >> 5) & 3, i = ql & 31;
        const int h = t * 128 + wnn * 64 + (it >> 1) * 32 + Gemm8::w_col(i);
        const float* s = ((it & 1) ? P.exp_wu : P.exp_wg) + (size_t)e * 1024 * 256 + (size_t)(kb * 128) * 256 + h;
        unsigned char* o = wgu + ((size_t)e * 512 + rg * 64) * 1024 + kb * 128;
        { float v[128]; u32x4 wq[8];
#pragma unroll
            for (int j = 0; j < 128; ++j) v[j] = __builtin_nontemporal_load(s + (size_t)j * 256);
#pragma unroll
            for (int j = 0; j < 8; ++j) { const float c_ = W8_GU_SCALE; u32x4 w;
                w.x = pk4_fp8(v[16 * j] * c_, v[16 * j + 1] * c_, v[16 * j + 2] * c_, v[16 * j + 3] * c_); w.y = pk4_fp8(v[16 * j + 4] * c_, v[16 * j + 5] * c_, v[16 * j + 6] * c_, v[16 * j + 7] * c_);
                w.z = pk4_fp8(v[16 * j + 8] * c_, v[16 * j + 9] * c_, v[16 * j + 10] * c_, v[16 * j + 11] * c_); w.w = pk4_fp8(v[16 * j + 12] * c_, v[16 * j + 13] * c_, v[16 * j + 14] * c_, v[16 * j + 15] * c_);
                wq[j] = w; }
            cvt8_store_rows(wl, lane, wq, o, 1024); }
    }
    if (item >= 1024)
    for (int u = (item - 1024) * 16 + wv * 2; u < (item - 1024) * 16 + wv * 2 + 2; u += NGW) {
        const int rg = u & 15, kb = (u >> 4) & 1, e = u >> 5;
        const int q = rg * 64 + lane, i = q & 31;
        const int col = (q & ~31) + Gemm8::w_col(i);
        const float* s = P.exp_wd + (size_t)e * 256 * 1024 + (size_t)(kb * 128) * 1024 + col;
        unsigned char* o = wd + ((size_t)e * 1024 + rg * 64) * 256 + kb * 128;
        { float v[128]; u32x4 wq[8];
#pragma unroll
            for (int j = 0; j < 128; ++j) v[j] = __builtin_nontemporal_load(s + (size_t)j * 1024);
#pragma unroll
            for (int j = 0; j < 8; ++j) { const float c_ = W8_D_SCALE; u32x4 w;
                w.x = pk4_fp8(v[16 * j] * c_, v[16 * j + 1] * c_, v[16 * j + 2] * c_, v[16 * j + 3] * c_); w.y = pk4_fp8(v[16 * j + 4] * c_, v[16 * j + 5] * c_, v[16 * j + 6] * c_, v[16 * j + 7] * c_);
                w.z = pk4_fp8(v[16 * j + 8] * c_, v[16 * j + 9] * c_, v[16 * j + 10] * c_, v[16 * j + 11] * c_); w.w = pk4_fp8(v[16 * j + 12] * c_, v[16 * j + 13] * c_, v[16 * j + 14] * c_, v[16 * j + 15] * c_);
                wq[j] = w; }
            cvt8_store_rows(wl, lane, wq, o, 256); }
    }
}

template <int PM> __device__ __forceinline__ void phase_experts8(const Params& P, LAS unsigned char* lds) {
    typedef Gemm8 G;
    const int tid = opaque_tid();
    const int* cnt = (const int*)(P.ws + WS_CTL + CTL_CNT); const int* bucket = (const int*)(P.ws + WS_BUCKET); const float* rw = (const float*)(P.ws + WS_RW);
    const unsigned char* h2q = (const unsigned char*)(P.ws + WS_H2Q); unsigned char* hidR = (unsigned char*)(P.ws + WS_HIDR) + (size_t)blockIdx.x * 256 * 256; unsigned char* y = (unsigned char*)(P.ws + WS_Y);
    LAS int* tiles = (LAS int*)(lds + P6_TILES); LAS int* pre = (LAS int*)(lds + P6_PRE); LAS int* pairs = (LAS int*)(lds + P6_PAIR); LAS float* wts = (LAS float*)(lds + P6_W);
    const int nx = (gridDim.x % 8 == 0) ? 8 : 1, xl = blockIdx.x % nx, li = blockIdx.x / nx, nloc = gridDim.x / nx, nek = 256 / nx;
    if (tid < nek) { const int c_ = cnt[xl + nx * tid]; tiles[tid] = ((c_ < BCAP ? c_ : BCAP) + 255) >> 8; }
    __syncthreads();
    if (tid < nek) { int s = 0; for (int i = 0; i < tid; ++i) s += tiles[i]; pre[tid] = s; if (tid == nek - 1) pre[nek] = s + tiles[nek - 1]; }
    __syncthreads();
    const int total = pre[nek];
    for (int u = li; u < total; u += nloc) {
        int lo = 0, hi_ = nek - 1;
        while (lo < hi_) { const int mid = (lo + hi_ + 1) >> 1; if (pre[mid] <= u) lo = mid; else hi_ = mid - 1; }
        const int e = xl + nx * lo, tile = u - pre[lo], n = cnt[e] < BCAP ? cnt[e] : BCAP, rows = (n - tile * 256) < 256 ? (n - tile * 256) : 256;
        if (tid < 256) { const int r = tid < rows ? tid : 0; const int pr = bucket[(size_t)e * BCAP + tile * 256 + r]; pairs[tid] = pr; wts[tid] = tid < rows ? rw[pr] : 0.f; }
        __syncthreads();
        {
            struct GU { const unsigned char* h2q; LAS int* pairs; const unsigned char* wgu; unsigned char* hidR;
                static __device__ __forceinline__ int wscale(int it) { return (it & 1) ? 123 : 121; }
                __device__ __forceinline__ void ptrs(int t, const unsigned char* (&aptr)[2], const unsigned char* (&wptr)[2]) const {
                    const int tid = opaque_tid(), lane = tid & 63, wid = tid >> 6;
#pragma unroll
                    for (int i = 0; i < 2; ++i) { const int row = G::t_row(i, wid, lane); aptr[i] = h2q + (size_t)(pairs[row] >> 3) * 1024 + G::t_chunk(row, lane) * 16;
                        wptr[i] = wgu + (size_t)(t * 256 + row) * 1024 + G::t_chunk(row, lane) * 16; } }
                __device__ __forceinline__ void epi(int t, f32x16 (&acc)[2][4]) const {
                    const int tid = opaque_tid(), lane = tid & 63, wid = tid >> 6, wm = wid >> 1, wn = wid & 1, l31 = lane & 31, hi = lane >> 5;
                    if (PM == 2) return;
#pragma unroll
                    for (int jt = 0; jt < 2; ++jt) { const int rl = wm * 64 + jt * 32 + l31;
#pragma unroll
                        for (int p = 0; p < 2; ++p) {
                            float e[16], hv[16];
#pragma unroll
                            for (int r = 0; r < 16; ++r) e[r] = __builtin_amdgcn_exp2f(acc[jt][2 * p][r] * -LOG2E);
                            __builtin_amdgcn_sched_barrier(0);
#pragma unroll
                            for (int r = 0; r < 16; ++r) { e[r] = __builtin_amdgcn_rcpf(1.0f + e[r]); hv[r] = acc[jt][2 * p][r] * acc[jt][2 * p + 1][r]; }
                            __builtin_amdgcn_sched_barrier(0);
                            u32x4 w;
#pragma unroll
                            for (int q4 = 0; q4 < 4; ++q4) w[q4] = pk4_fp8(hv[4 * q4] * e[4 * q4], hv[4 * q4 + 1] * e[4 * q4 + 1], hv[4 * q4 + 2] * e[4 * q4 + 2], hv[4 * q4 + 3] * e[4 * q4 + 3]);
                            *(u32x4*)(hidR + rl * 256 + t * 128 + wn * 64 + p * 32 + 16 * hi) = w; } } }
            } f{h2q, pairs, (const unsigned char*)(P.ws + WS_W8GU) + (size_t)e * 512 * 1024, hidR};
            if (PM != 3) G::run_stream(f, 2, 16, lds);
        }
        __syncthreads();
        {
            struct DN { const unsigned char* hidR; const unsigned char* wd; unsigned char* y; LAS int* pairs; LAS float* wts; int rows;
                static __device__ __forceinline__ int wscale(int) { return 120; }
                __device__ __forceinline__ void ptrs(int ct, const unsigned char* (&aptr)[2], const unsigned char* (&wptr)[2]) const {
                    const int tid = opaque_tid(), lane = tid & 63, wid = tid >> 6;
#pragma unroll
                    for (int i = 0; i < 2; ++i) { const int row = G::t_row(i, wid, lane); aptr[i] = hidR + (size_t)row * 256 + G::t_chunk(row, lane) * 16;
                        wptr[i] = wd + (size_t)(ct * 256 + row) * 256 + G::t_chunk(row, lane) * 16; } }
                __device__ __forceinline__ void epi(int ct, f32x16 (&acc)[2][4]) const {
                    const int tid = opaque_tid(), lane = tid & 63, wid = tid >> 6, wm = wid >> 1, wn = wid & 1, l31 = lane & 31, hi = lane >> 5;
                    if (PM == 3) return;
#pragma unroll
                    for (int jt = 0; jt < 2; ++jt) { const int rl = wm * 64 + jt * 32 + l31; const float sc_ = wts[rl] * Y_SCALE; const size_t pr = (size_t)pairs[rl];
                        if (rl < rows) {
#pragma unroll
                            for (int it = 0; it < 4; ++it) { u32x4 w;
#pragma unroll
                                for (int q4 = 0; q4 < 4; ++q4) w[q4] = pk4_fp8(acc[jt][it][4 * q4] * sc_, acc[jt][it][4 * q4 + 1] * sc_, acc[jt][it][4 * q4 + 2] * sc_, acc[jt][it][4 * q4 + 3] * sc_);
                                *(u32x4*)(y + pr * 1024 + ct * 256 + wn * 128 + it * 32 + 16 * hi) = w; } } } }
            } f{hidR, (const unsigned char*)(P.ws + WS_W8D) + (size_t)e * 1024 * 256, y, pairs, wts, rows};
            if (PM == 0 || PM == 3) G::run_stream(f, 4, 4, lds);
        }
        __syncthreads();
    }
}

__device__ __forceinline__ void phase_combine(const Params& P) {
    const int lane = threadIdx.x & 63, gw = blockIdx.x * (NTHREADS / 64) + (threadIdx.x >> 6), NGW = gridDim.x * (NTHREADS / 64);
    const unsigned char* y = (const unsigned char*)(P.ws + WS_Y);
    typedef float f32x2_ __attribute__((ext_vector_type(2)));
    for (int m = gw; m < T; m += NGW) {
        const float* mod = (const float*)(P.ws + WS_MOD) + (m / SEQ) * 6144 + 5120;
#pragma unroll
        for (int j = 0; j < 2; ++j) { const int col = (lane + 64 * j) * 8;
            f32x4 s0 = (f32x4){0.f, 0.f, 0.f, 0.f}, s1 = s0;
#pragma unroll
            for (int sl = 0; sl < 9; ++sl) { const u32x2 v = sl < 8 ? *(const u32x2*)(y + ((size_t)m * 8 + sl) * 1024 + col) : *(const u32x2*)((const unsigned char*)(P.ws + WS_YSH) + (size_t)m * 1024 + col);
                const f32x2_ a = __builtin_amdgcn_cvt_pk_f32_fp8((int)v.x, false), b = __builtin_amdgcn_cvt_pk_f32_fp8((int)v.x, true);
                const f32x2_ c = __builtin_amdgcn_cvt_pk_f32_fp8((int)v.y, false), d = __builtin_amdgcn_cvt_pk_f32_fp8((int)v.y, true);
                s0.x += a.x; s0.y += a.y; s0.z += b.x; s0.w += b.y; s1.x += c.x; s1.y += c.y; s1.z += d.x; s1.w += d.y; }
            const f32x4 g0 = *(const f32x4*)(mod + col), g1 = *(const f32x4*)(mod + col + 4);
            const u32x4 xr = *(const u32x4*)((const bf16_t*)(P.ws + WS_X1) + (size_t)m * 1024 + col);
            f32x4 o0 = (f32x4){__uint_as_float(xr.x << 16), __uint_as_float(xr.x & 0xffff0000u), __uint_as_float(xr.y << 16), __uint_as_float(xr.y & 0xffff0000u)};
            f32x4 o1 = (f32x4){__uint_as_float(xr.z << 16), __uint_as_float(xr.z & 0xffff0000u), __uint_as_float(xr.w << 16), __uint_as_float(xr.w & 0xffff0000u)};
            o0 += g0 * (s0 * Y_INV); o1 += g1 * (s1 * Y_INV);
            *(f32x4*)(P.out + (size_t)m * 1024 + col) = o0; *(f32x4*)(P.out + (size_t)m * 1024 + col + 4) = o1; }
    }
}


__device__ __forceinline__ int queue_pull(unsigned* head, volatile LAS unsigned* slot) {
    if (threadIdx.x == 0) *slot = atomicAdd(head, 1u);
    __syncthreads();
    const int v = (int)*slot;
    __syncthreads();
    return v;
}
__device__ __forceinline__ void phase_cmp_h1(const Params& P, LAS unsigned char* lds, volatile LAS unsigned* slot) {
    unsigned* head = (unsigned*)(P.ws + WS_CTL + CTL_Q2);
    for (;;) {
        const int u = queue_pull(head, slot);
        if (u >= 64 + 512) break;
        if (u < 64) compress_unit(P, lds, u); else hgrn_unit<0>(P, lds, u - 64);
    }
}
__device__ __forceinline__ void phase_h23_nsa(const Params& P, LAS unsigned char* lds, volatile LAS unsigned* slot) {
    unsigned* head = (unsigned*)(P.ws + WS_CTL + CTL_Q3);
    for (;;) {
        const int n2 = queue_pull(head, slot);
        if (n2 >= 3072) break;
        if (n2 & 1) { cvt8_item(P, lds, n2 >> 1); continue; }
        const int n = n2 >> 1;
        if (n < 512) nsa_unit(P, lds, (n & 7) * 128 + (127 - (n >> 3)));
        else if (n < 1024) { const int m = n - 512; hgrn_unit<1>(P, lds, (m & 15) * 32 + (31 - (m >> 4))); }
        else { const int m = n - 1024; nsa_unit(P, lds, (m & 7) * 128 + (63 - (m >> 3))); }
    }
}

constexpr int LDS_BYTES = 144 * 1024;
__global__ void __launch_bounds__(NTHREADS) mega(Params P) {
    extern __shared__ __attribute__((aligned(16))) unsigned char smem[];
    LAS unsigned char* lds = (LAS unsigned char*)smem;
    volatile LAS unsigned* xst = (volatile LAS unsigned*)(lds + LDS_BYTES - 16);
    if (threadIdx.x < 4) xst[threadIdx.x] = 0u;
    __syncthreads();
    XcdBarrier xb = xcd_barrier_post((unsigned*)(P.ws + WS_CTL + CTL_BAR), xst);
    phase_mod(P, lds);
    xcd_barrier(xb);
    { const float* mod = (const float*)(P.ws + WS_MOD); norm_mod_rows(P.x, P.norm1_w, mod, mod + 1024, (unsigned char*)(P.ws + WS_H), H1S); }
    xcd_barrier(xb);
    phase_inproj(P, lds);
    xcd_barrier(xb);
    phase_cmp_h1(P, lds, xst + 2);
    xcd_barrier(xb);
    phase_hgrn_prefix(P);
    xcd_barrier(xb);
    phase_h23_nsa(P, lds, xst + 2);
    phase_cvt_small(P);
    xcd_barrier(xb);
    phase_p4a(P, lds);
    xcd_barrier(xb);
    phase_p4b(P);
    xcd_barrier(xb);
    phase_p4c(P, lds);
    xcd_barrier(xb);
    phase_route(P);
    phase_p4d(P, lds);
    xcd_barrier(xb);
    phase_experts8<0>(P, lds);
    xcd_barrier(xb);
    phase_combine(P);
}

extern "C" void kernel_launch(void* const* d_in, const int* in_sizes, int n_in, void* d_out, int out_size, void* d_ws, size_t ws_size, hipStream_t stream) {
    static int grid = 0;
    if (grid == 0) {
        if (n_in != 25 || ws_size < WS_END) { fprintf(stderr, "kernel_launch: unexpected n_in %d or ws_size %zu (need %zu)\n", n_in, ws_size, (size_t)WS_END); grid = -1; return; }
        int dev = 0, cus = 0, per_cu = 0;
        (void)hipGetDevice(&dev); (void)hipDeviceGetAttribute(&cus, hipDeviceAttributeMultiprocessorCount, dev);
        (void)hipFuncSetAttribute((const void*)mega, hipFuncAttributeMaxDynamicSharedMemorySize, LDS_BYTES);
        (void)hipOccupancyMaxActiveBlocksPerMultiprocessor(&per_cu, (const void*)mega, NTHREADS, LDS_BYTES);
        if (per_cu < 1) { fprintf(stderr, "kernel_launch: occupancy query says %d blocks per CU\n", per_cu); grid = -1; return; }
        grid = cus;
    }
    if (grid < 0) return;
    (void)hipMemsetAsync((char*)d_ws + WS_CTL, 0, 64 * 1024, stream);
    Params p{};
    const float** pf = (const float**)&p;
    for (int i = 0; i < 25; ++i) pf[i] = (const float*)d_in[i];
    p.out = (float*)d_out; p.ws = (unsigned char*)d_ws;
    void* args[] = {&p};
    hipError_t e = hipLaunchCooperativeKernel((const void*)mega, dim3(grid), dim3(NTHREADS), args, LDS_BYTES, stream);
    if (e != hipSuccess) fprintf(stderr, "cooperative launch failed: %s (grid %d)\n", hipGetErrorString(e), grid);
}

#ifdef PHASE_TEST
__global__ void __launch_bounds__(NTHREADS) t_p4a(Params P) { extern __shared__ __attribute__((aligned(16))) unsigned char smem[]; phase_p4a(P, (LAS unsigned char*)smem); }
__global__ void __launch_bounds__(NTHREADS) t_p4d(Params P) { extern __shared__ __attribute__((aligned(16))) unsigned char smem[]; phase_p4d(P, (LAS unsigned char*)smem); }
__global__ void __launch_bounds__(NTHREADS) t_p4(Params P) { extern __shared__ __attribute__((aligned(16))) unsigned char smem[]; phase_p4c(P, (LAS unsigned char*)smem); }
__global__ void __launch_bounds__(NTHREADS) t_p6(Params P) { extern __shared__ __attribute__((aligned(16))) unsigned char smem[]; phase_experts(P, (LAS unsigned char*)smem); }
__global__ void __launch_bounds__(NTHREADS) t_nsa(Params P) { extern __shared__ __attribute__((aligned(16))) unsigned char smem[]; nsa_unit(P, (LAS unsigned char*)smem, blockIdx.x); }
__global__ void __launch_bounds__(NTHREADS) t_mod(Params P) { extern __shared__ __attribute__((aligned(16))) unsigned char smem[]; phase_mod(P, (LAS unsigned char*)smem); }
__global__ void __launch_bounds__(NTHREADS) t_inproj(Params P) { extern __shared__ __attribute__((aligned(16))) unsigned char smem[]; phase_inproj(P, (LAS unsigned char*)smem); }
__global__ void __launch_bounds__(NTHREADS) t_cmp(Params P) { extern __shared__ __attribute__((aligned(16))) unsigned char smem[]; compress_unit(P, (LAS unsigned char*)smem, blockIdx.x); }
__global__ void __launch_bounds__(NTHREADS) t_h0(Params P) { extern __shared__ __attribute__((aligned(16))) unsigned char smem[]; hgrn_unit<0>(P, (LAS unsigned char*)smem, blockIdx.x); }
__global__ void __launch_bounds__(NTHREADS) t_h1(Params P) { extern __shared__ __attribute__((aligned(16))) unsigned char smem[]; hgrn_unit<1>(P, (LAS unsigned char*)smem, blockIdx.x); }
#endif
```

```cpp
#include <hip/hip_runtime.h>
#include <hip/hip_cooperative_groups.h>
#include <cstdio>
#include <cstdint>
#include <type_traits>
namespace cg = cooperative_groups;

#define LAS __attribute__((address_space(3)))
typedef unsigned short bf16_t;
typedef short bf16x8 __attribute__((ext_vector_type(8)));
typedef short s16x4 __attribute__((ext_vector_type(4)));
typedef float f32x4 __attribute__((ext_vector_type(4)));
typedef float f32x16 __attribute__((ext_vector_type(16)));
typedef unsigned u32x4 __attribute__((ext_vector_type(4)));
typedef unsigned u32x2 __attribute__((ext_vector_type(2)));

constexpr int D = 1024, BATCH = 4, SEQ = 8192, T = BATCH * SEQ;
constexpr int IN_COLS = 3352;
constexpr int NTHREADS = 512;
constexpr int H1S = 1088;
constexpr float RMS_EPS = 1e-6f;
constexpr float LOG2E = 1.4426950408889634f;
constexpr float Y_SCALE = 16.0f, Y_INV = 1.0f / 16.0f;

constexpr size_t MB = 1024ull * 1024ull;
constexpr size_t WS_CTL    = 0;
constexpr size_t WS_MOD    = 64 * 1024;
constexpr size_t WS_LB     = WS_MOD + 4 * 6144 * 4;
constexpr size_t WS_CB     = WS_LB + 2048;
constexpr size_t WS_H      = 1 * MB;
constexpr size_t WS_SS     = WS_H + 72 * MB;
constexpr size_t WS_RW     = WS_SS + 1 * MB;
constexpr size_t WS_BUCKET = WS_RW + 1 * MB;
constexpr size_t WS_HIDR   = WS_BUCKET + 16 * MB;
constexpr size_t WS_WSM    = WS_HIDR + 32 * MB;
constexpr size_t WS_WOUT   = WS_WSM, WS_WRS = WS_WSM + 2 * MB, WS_WSD = WS_WSM + 4 * MB;
constexpr size_t WS_WBE    = WS_WSM + 5 * MB;
constexpr size_t WS_WBGU   = WS_WBE, WS_WBD = WS_WBE + 256 * MB;
constexpr size_t WS_W8GU   = WS_WBE, WS_W8D = WS_WBE + 128 * MB, WS_H2Q = WS_WBE + 256 * MB;
constexpr size_t WS_X1     = WS_WBE + 192 * MB;
constexpr float W8_GU_SCALE = 64.0f, W8_D_SCALE = 32.0f, HID8_SCALE = 4.0f;
constexpr size_t WS_SCORES = WS_WBE + 288 * MB;
constexpr size_t WS_HIDS   = WS_SCORES + 32 * MB;
constexpr size_t WS_WIN    = WS_WBE + 48 * MB;
constexpr size_t WS_Y      = WS_WBE + 384 * MB;
constexpr size_t WS_Q      = WS_Y;
constexpr size_t WS_KV     = WS_Q + 32 * MB;
constexpr size_t WS_GATES  = WS_KV + 48 * MB;
constexpr size_t WS_HQ     = WS_GATES + 4 * MB;
constexpr size_t WS_LOGF   = WS_HQ + 32 * MB;
constexpr size_t WS_HV     = WS_LOGF + 64 * MB;
constexpr size_t WS_HG     = WS_HV + 32 * MB;
constexpr size_t WS_CMPH   = WS_HG + 32 * MB;
constexpr size_t WS_KC     = WS_CMPH + 4 * MB;
constexpr size_t WS_VC     = WS_KC + 1 * MB;
constexpr size_t WS_HL     = WS_VC + 1 * MB;
constexpr size_t WS_HD     = WS_HL + 32 * MB;
constexpr size_t WS_MIX    = WS_HD + 1 * MB;
constexpr size_t WS_YSH    = WS_Y + 384 * MB;
constexpr size_t WS_END    = WS_YSH + 64 * MB;
constexpr int BCAP = 16384;
constexpr int CTL_CNT = 1024;
constexpr int CTL_Q2 = 2048, CTL_Q3 = 2112;
constexpr int CTL_BAR = 16384;

struct Params {
    const float *x, *c, *ada_w, *ada_b, *norm1_w, *norm2_w, *w_in, *q_norm_w, *k_norm_w, *cmp_pos, *cmp_w1, *cmp_b1, *cmp_w2,
        *attn_out_norm_w, *hgrn_lb, *rec_out_norm_w, *w_out, *router_w, *router_bias, *exp_wg, *exp_wu, *exp_wd, *sh_wg, *sh_wu, *sh_wd;
    float* out;
    unsigned char* ws;
};

typedef __bf16 bf16x2_t __attribute__((ext_vector_type(2)));
typedef int i32x8 __attribute__((ext_vector_type(8)));
__device__ __forceinline__ unsigned cvtpk(float lo, float hi) { bf16x2_t v; v.x = (__bf16)lo; v.y = (__bf16)hi; return __builtin_bit_cast(unsigned, v); }
__device__ __forceinline__ int opaque_tid() { int t = threadIdx.x; asm volatile("" : "+v"(t)); return t; }
__device__ __forceinline__ float bf2f(bf16_t v) { return __uint_as_float(((unsigned)v) << 16); }
__device__ __forceinline__ float sigmoidf_(float v) { return __builtin_amdgcn_rcpf(1.0f + __expf(-v)); }
__device__ __forceinline__ float siluf_(float v) { return v * __builtin_amdgcn_rcpf(1.0f + __expf(-v)); }
__device__ __forceinline__ float wave_sum(float v) {
#pragma unroll
    for (int o = 1; o < 64; o <<= 1) v += __shfl_xor(v, o);
    return v;
}
__device__ __forceinline__ s16x4 lds_tr(const LAS unsigned char* p) {
    return __builtin_bit_cast(s16x4, __builtin_amdgcn_ds_read_tr16_b64_v4i16((LAS s16x4*)p));
}

#define XB_TMO      128
#define XB_XCNT(j)  (256  + 64 * (j))
#define XB_XSUB(j)  (1280 + 64 * (j))
#define XB_XGEN(j)  (2304 + 64 * (j))
#define XB_TOP      3328
#define XB_TOPGEN   3392
#define XCD_BAR_WORDS 3456
#define XB_SPIN_CAP (1u << 22)
__device__ __forceinline__ unsigned xb_ld(unsigned* p)              { return __hip_atomic_load(p, __ATOMIC_RELAXED, __HIP_MEMORY_SCOPE_AGENT); }
__device__ __forceinline__ unsigned xb_add(unsigned* p, unsigned v) { return __hip_atomic_fetch_add(p, v, __ATOMIC_RELAXED, __HIP_MEMORY_SCOPE_AGENT); }
__device__ __forceinline__ unsigned xb_xcc_id() { return (unsigned)__builtin_amdgcn_s_getreg((3 << 11) | 20) & 0xFu; }
#define XB_SPIN(cond, bar) do { unsigned _sp = 0; while (cond) { __builtin_amdgcn_s_sleep(1); \
    if ((++_sp & 255u) == 0u) { if (xb_ld(&(bar)[XB_TMO])) break; if (_sp > XB_SPIN_CAP) { atomicAdd(&(bar)[XB_TMO], 1u); break; } } } } while (0)
struct XcdBarrier { unsigned* bar; unsigned x; volatile LAS unsigned* st; };
__device__ __forceinline__ XcdBarrier xcd_barrier_post(unsigned* bar, volatile LAS unsigned* st) {
    XcdBarrier b; b.bar = bar; b.x = xb_xcc_id(); b.st = st;
    if (threadIdx.x == 0) (void)xb_add(&bar[XB_XCNT(b.x)], 1u);
    return b;
}
__device__ __forceinline__ void xcd_barrier_complete(unsigned* bar, unsigned x, unsigned& nloc, unsigned& nx) {
    const unsigned G = gridDim.x * gridDim.y * gridDim.z;
    unsigned sum, cnt, mine, sp = 0u;
    for (;;) {
        sum = 0u; cnt = 0u; mine = 0u;
#pragma unroll
        for (unsigned j = 0; j < 16; ++j) { const unsigned c = xb_ld(&bar[XB_XCNT(j)]); sum += c; cnt += (c > 0u) ? 1u : 0u; mine = (j == x) ? c : mine; }
        if (sum == G) break;
        __builtin_amdgcn_s_sleep(1);
        if ((++sp & 255u) == 0u) { if (xb_ld(&bar[XB_TMO])) break; if (sp > XB_SPIN_CAP) { atomicAdd(&bar[XB_TMO], 1u); break; } }
    }
    nloc = mine > 0u ? mine : 1u; nx = cnt > 0u ? cnt : 1u;
}
__device__ __forceinline__ void xcd_barrier(const XcdBarrier& b) {
    asm volatile("s_waitcnt vmcnt(0)" ::: "memory");
    __syncthreads();
    if (threadIdx.x == 0) {
        unsigned* bar = b.bar;
        __builtin_amdgcn_s_waitcnt(0);
        unsigned nloc = b.st[0], nx = b.st[1];
        if (nloc == 0u) { xcd_barrier_complete(bar, b.x, nloc, nx); b.st[0] = nloc; b.st[1] = nx; }
        const unsigned old = xb_add(&bar[XB_XSUB(b.x)], 1u);
        const unsigned gen = old / nloc;
        if (old + 1u == (gen + 1u) * nloc) {
            __builtin_amdgcn_fence(__ATOMIC_RELEASE, "agent");
            asm volatile("s_waitcnt vmcnt(0)" ::: "memory");
            const unsigned og = xb_add(&bar[XB_TOP], 1u);
            const unsigned tg = og / nx;
            if (og + 1u == (tg + 1u) * nx) xb_add(&bar[XB_TOPGEN], 1u);
            else XB_SPIN(xb_ld(&bar[XB_TOPGEN]) == tg, bar);
            __builtin_amdgcn_fence(__ATOMIC_ACQUIRE, "agent");
            xb_add(&bar[XB_XGEN(b.x)], 1u);
            asm volatile("s_waitcnt vmcnt(0)" ::: "memory");
        } else {
            XB_SPIN(xb_ld(&bar[XB_XGEN(b.x)]) == gen, bar);
            __builtin_amdgcn_fence(__ATOMIC_ACQUIRE, "agent");
            asm volatile("s_waitcnt vmcnt(0)" ::: "memory");
        }
    }
    __syncthreads();
}

template <int WM, int WN> struct GemmT {
    static constexpr int BM = 64 * WM, BN = 64 * WN;
    static constexpr int A_BYTES = BM * 128, B_BYTES = 64 * BN * 2, STAGE = A_BYTES + B_BYTES, LDS_BYTES = 2 * STAGE;
    static constexpr int NB4 = BN / 32;
    static constexpr int B_ROW4 = BN / 4;

    static __device__ __forceinline__ void run(f32x4 (&acc)[4][4], const bf16_t* const (&arow)[WM], int a_kstride, const float* Bp, int ldb, int KT, LAS unsigned char* lds) {
        const int tid = opaque_tid(), lane = tid & 63, wid = tid >> 6, wm = wid / WN, wn = wid % WN, fr = lane & 15, fq = lane >> 4;
#pragma unroll
        for (int mi = 0; mi < 4; ++mi)
#pragma unroll
            for (int ni = 0; ni < 4; ++ni) acc[mi][ni] = (f32x4){0.f, 0.f, 0.f, 0.f};
        const int achunk = tid & 7;
        u32x4 areg[WM]; f32x4 breg[NB4];
        int a_wr[WM];
#pragma unroll
        for (int p = 0; p < WM; ++p) { const int row = p * 64 + (tid >> 3); a_wr[p] = row * 128 + ((achunk ^ ((row >> 1) & 7)) << 4); }
        int b_wr[NB4]; int b_goff[NB4];
#pragma unroll
        for (int p = 0; p < NB4; ++p) { const int i = tid + NTHREADS * p, k = i / B_ROW4, n = (i % B_ROW4) * 4;
            const int f = (k & 3) | (((k >> 3) & 1) << 2);
            b_wr[p] = A_BYTES + k * (BN * 2) + (((n >> 4) ^ f) << 5) + ((n & 15) << 1); b_goff[p] = k * ldb + n; }
        int a_rd[4][2];
#pragma unroll
        for (int mi = 0; mi < 4; ++mi)
#pragma unroll
            for (int ks = 0; ks < 2; ++ks) { const int row = wm * 64 + mi * 16 + fr, ch = ks * 4 + fq; a_rd[mi][ks] = row * 128 + ((ch ^ ((row >> 1) & 7)) << 4); }
        int b_rd[2][2];
        int b_f[2][2];
#pragma unroll
        for (int ks = 0; ks < 2; ++ks)
#pragma unroll
            for (int t = 0; t < 2; ++t) { const int k = ks * 32 + 8 * fq + 4 * t + (fr >> 2); b_f[ks][t] = (k & 3) | (((k >> 3) & 1) << 2);
                b_rd[ks][t] = A_BYTES + k * (BN * 2) + ((fr & 3) << 3); }

        auto gload = [&](int kt) {
#pragma unroll
            for (int p = 0; p < WM; ++p) areg[p] = *(const u32x4*)(arow[p] + (size_t)kt * a_kstride + achunk * 8);
            const float* bk = Bp + (size_t)kt * 64 * ldb;
#pragma unroll
            for (int p = 0; p < NB4; ++p) breg[p] = *(const f32x4*)(bk + b_goff[p]);
        };
        auto lstore = [&](int buf) {
            LAS unsigned char* base = lds + buf * STAGE;
#pragma unroll
            for (int p = 0; p < WM; ++p) *(LAS u32x4*)(base + a_wr[p]) = areg[p];
#pragma unroll
            for (int p = 0; p < NB4; ++p) { u32x2 w; w.x = cvtpk(breg[p].x, breg[p].y); w.y = cvtpk(breg[p].z, breg[p].w); *(LAS u32x2*)(base + b_wr[p]) = w; }
        };
        gload(0); lstore(0); __syncthreads();
        for (int kt = 0; kt < KT; ++kt) {
            if (kt + 1 < KT) gload(kt + 1);
            __builtin_amdgcn_sched_barrier(0);
            const LAS unsigned char* base = lds + (kt & 1) * STAGE;
#pragma unroll
            for (int ks = 0; ks < 2; ++ks) {
                bf16x8 af[4], bfr[4];
#pragma unroll
                for (int mi = 0; mi < 4; ++mi) af[mi] = *(const LAS bf16x8*)(base + a_rd[mi][ks]);
#pragma unroll
                for (int ni = 0; ni < 4; ++ni) {
                    const int u0 = wn * 4 + ni;
                    const s16x4 lo = lds_tr(base + b_rd[ks][0] + ((u0 ^ b_f[ks][0]) << 5));
                    const s16x4 hi = lds_tr(base + b_rd[ks][1] + ((u0 ^ b_f[ks][1]) << 5));
                    bfr[ni] = (bf16x8){lo[0], lo[1], lo[2], lo[3], hi[0], hi[1], hi[2], hi[3]};
                }
#pragma unroll
                for (int mi = 0; mi < 4; ++mi)
#pragma unroll
                    for (int ni = 0; ni < 4; ++ni) acc[mi][ni] = __builtin_amdgcn_mfma_f32_16x16x32_bf16(bfr[ni], af[mi], acc[mi][ni], 0, 0, 0);
            }
            if (kt + 1 < KT) lstore((kt + 1) & 1);
            __syncthreads();
        }
    }
};

struct Gemm2 {
    static constexpr int A_BYTES = 32768, STAGE = 65536, LDS_BYTES = 2 * STAGE;
    static __device__ __forceinline__ int a_row(int i, int w, int lane) { return (i * 8 + w) * 8 + (lane >> 3); }
    static __device__ __forceinline__ int a_chunk(int row, int lane) { return (lane & 7) ^ ((row >> 1) & 7); }
    static __device__ __forceinline__ int b_k(int i, int w, int lane) { return (i * 8 + w) * 2 + (lane >> 5); }
    static __device__ __forceinline__ int b_n(int k, int lane) { return ((((lane & 31) >> 1) ^ fk2(k)) << 4) + ((lane & 1) << 3); }
    static __device__ __forceinline__ int fk2(int r) { return (r & 3) | (((r >> 3) & 1) << 2); }

    static __device__ __forceinline__ void run(f32x4 (&acc)[4][8], const bf16_t* const (&aptr)[4], int a_kstride, const bf16_t* const (&bptr)[4], size_t b_kstride, int KT, LAS unsigned char* lds) {
        const int tid = opaque_tid(), lane = tid & 63, wid = tid >> 6, wm = wid >> 1, wn = wid & 1, fr = lane & 15, fq = lane >> 4;
        const int wu = __builtin_amdgcn_readfirstlane(wid);
#pragma unroll
        for (int mi = 0; mi < 4; ++mi)
#pragma unroll
            for (int ni = 0; ni < 8; ++ni) acc[mi][ni] = (f32x4){0.f, 0.f, 0.f, 0.f};
        int a_rd[4][2];
#pragma unroll
        for (int mi = 0; mi < 4; ++mi)
#pragma unroll
            for (int ks = 0; ks < 2; ++ks) { const int row = wm * 64 + mi * 16 + fr, ch = ks * 4 + fq; a_rd[mi][ks] = row * 128 + ((ch ^ ((row >> 1) & 7)) << 4); }
        int b_rd[2][2], b_f[2][2];
#pragma unroll
        for (int ks = 0; ks < 2; ++ks)
#pragma unroll
            for (int t = 0; t < 2; ++t) { const int k = ks * 32 + 8 * fq + 4 * t + (fr >> 2); b_f[ks][t] = fk2(k); b_rd[ks][t] = A_BYTES + k * 512 + ((fr & 3) << 3); }
        auto issue = [&](int kt, int buf) {
            LAS unsigned char* base = lds + buf * STAGE + wu * 1024;
#pragma unroll
            for (int i = 0; i < 4; ++i) __builtin_amdgcn_global_load_lds((const unsigned*)(aptr[i] + (size_t)kt * a_kstride), (LAS unsigned*)(base + i * 8192), 16, 0, 0);
#pragma unroll
            for (int i = 0; i < 4; ++i) __builtin_amdgcn_global_load_lds((const unsigned*)(bptr[i] + (size_t)kt * b_kstride), (LAS unsigned*)(base + A_BYTES + i * 8192), 16, 0, 0);
        };
        issue(0, 0);
        for (int kt = 0; kt < KT; ++kt) {
            asm volatile("s_waitcnt vmcnt(0)" ::: "memory");
            __syncthreads();
            if (kt + 1 < KT) issue(kt + 1, (kt + 1) & 1);
            const LAS unsigned char* base = lds + (kt & 1) * STAGE;
#pragma unroll
            for (int ks = 0; ks < 2; ++ks) {
                bf16x8 af[4];
#pragma unroll
                for (int mi = 0; mi < 4; ++mi) af[mi] = *(const LAS bf16x8*)(base + a_rd[mi][ks]);
#pragma unroll
                for (int ni = 0; ni < 8; ++ni) {
                    const int u0 = wn * 8 + ni;
                    const s16x4 lo = lds_tr(base + b_rd[ks][0] + ((u0 ^ b_f[ks][0]) << 5));
                    const s16x4 hi = lds_tr(base + b_rd[ks][1] + ((u0 ^ b_f[ks][1]) << 5));
                    const bf16x8 bfr = (bf16x8){lo[0], lo[1], lo[2], lo[3], hi[0], hi[1], hi[2], hi[3]};
#pragma unroll
                    for (int mi = 0; mi < 4; ++mi) acc[mi][ni] = __builtin_amdgcn_mfma_f32_16x16x32_bf16(bfr, af[mi], acc[mi][ni], 0, 0, 0);
                }
            }
        }
        __syncthreads();
    }
};

__device__ __forceinline__ void glds16(const void* g, unsigned lds_base) {
    unsigned sv; asm volatile("s_mov_b32 %0, m0\n\ts_mov_b32 m0, %2\n\ts_nop 0\n\tglobal_load_lds_dwordx4 %1, off\n\ts_mov_b32 m0, %0" : "=&s"(sv) : "v"(g), "s"(lds_base) : "memory"); }
struct Gemm3 {
    static constexpr int A_BYTES = 16384, STAGE = 32768, LDS_BYTES = 4 * STAGE;
    static __device__ __forceinline__ int a_row(int i, int w, int lane) { return (i * 8 + w) * 16 + (lane >> 2); }
    static __device__ __forceinline__ int a_chunk(int row, int lane) { return (lane & 3) ^ ((row >> 1) & 3); }
    static __device__ __forceinline__ int b_k(int i, int w, int lane) { return (i * 8 + w) * 2 + (lane >> 5); }
    static __device__ __forceinline__ int fk2(int r) { return (r & 3) | (((r >> 3) & 1) << 2); }
    static __device__ __forceinline__ int b_n(int k, int lane) { return ((((lane & 31) >> 1) ^ fk2(k)) << 4) + ((lane & 1) << 3); }
    static __device__ __forceinline__ void run(f32x4 (&acc)[4][8], const bf16_t* const (&aptr)[2], int a_kstride, const bf16_t* const (&bptr)[2], size_t b_kstride, int KT, LAS unsigned char* lds) {
        const int tid = opaque_tid(), lane = tid & 63, wid = tid >> 6, wm = wid >> 1, wn = wid & 1, fr = lane & 15, fq = lane >> 4;
        const int wu = __builtin_amdgcn_readfirstlane(wid);
#pragma unroll
        for (int mi = 0; mi < 4; ++mi)
#pragma unroll
            for (int ni = 0; ni < 8; ++ni) acc[mi][ni] = (f32x4){0.f, 0.f, 0.f, 0.f};
        int a_rd[4];
#pragma unroll
        for (int mi = 0; mi < 4; ++mi) { const int row = wm * 64 + mi * 16 + fr; a_rd[mi] = row * 64 + ((fq ^ ((row >> 1) & 3)) << 4); }
        int b_rd[2], b_f[2];
#pragma unroll
        for (int t = 0; t < 2; ++t) { const int k = 8 * fq + 4 * t + (fr >> 2); b_f[t] = fk2(k); b_rd[t] = A_BYTES + k * 512 + ((fr & 3) << 3); }
        const unsigned lds0 = (unsigned)(uintptr_t)lds + (unsigned)wu * 1024u;
        auto issue = [&](int kt) {
            const unsigned base = (unsigned)__builtin_amdgcn_readfirstlane((int)(lds0 + (unsigned)(kt & 3) * STAGE));
#pragma unroll
            for (int i = 0; i < 2; ++i) glds16(aptr[i] + (size_t)kt * a_kstride, base + i * 8192);
#pragma unroll
            for (int i = 0; i < 2; ++i) glds16(bptr[i] + (size_t)kt * b_kstride, base + A_BYTES + i * 8192);
        };
        const int grp = wu >> 2;
        auto bar = [&]() { asm volatile("s_waitcnt lgkmcnt(0)" ::: "memory"); __builtin_amdgcn_s_barrier(); asm volatile("" ::: "memory"); };
        asm volatile("s_waitcnt vmcnt(0)" ::: "memory");
        issue(0); if (KT > 1) issue(1); if (KT > 2) issue(2);
        if (KT > 2) asm volatile("s_waitcnt vmcnt(8)" ::: "memory"); else if (KT > 1) asm volatile("s_waitcnt vmcnt(4)" ::: "memory"); else asm volatile("s_waitcnt vmcnt(0)" ::: "memory");
        bar();
        if (grp) bar();
#pragma unroll 1
        for (int kt = 0; kt < KT; ++kt) {
            if (kt + 3 < KT) issue(kt + 3);
            const LAS unsigned char* base = lds + (kt & 3) * STAGE;
            bf16x8 af[4], bfr[8];
#pragma unroll
            for (int mi = 0; mi < 4; ++mi) af[mi] = *(const LAS bf16x8*)(base + a_rd[mi]);
#pragma unroll
            for (int ni = 0; ni < 8; ++ni) {
                const int u0 = wn * 8 + ni;
                const s16x4 lo = lds_tr(base + b_rd[0] + ((u0 ^ b_f[0]) << 5));
                const s16x4 hi = lds_tr(base + b_rd[1] + ((u0 ^ b_f[1]) << 5));
                bfr[ni] = (bf16x8){lo[0], lo[1], lo[2], lo[3], hi[0], hi[1], hi[2], hi[3]};
            }
            { const int rem = KT - 2 - kt;
              if (rem >= 2) asm volatile("s_waitcnt vmcnt(8)" ::: "memory"); else if (rem == 1) asm volatile("s_waitcnt vmcnt(4)" ::: "memory"); else asm volatile("s_waitcnt vmcnt(0)" ::: "memory"); }
            bar();
            __builtin_amdgcn_sched_barrier(0);
#pragma unroll
            for (int ni = 0; ni < 8; ++ni)
#pragma unroll
                for (int mi = 0; mi < 4; ++mi) acc[mi][ni] = __builtin_amdgcn_mfma_f32_16x16x32_bf16(bfr[ni], af[mi], acc[mi][ni], 0, 0, 0);
            __builtin_amdgcn_sched_barrier(0);
            bar();
        }
        if (!grp) bar();
    }

    template <class F> static __device__ __forceinline__ void run_stream(F& f, int NSEG, int KT, int a_kstride, size_t b_kstride, LAS unsigned char* lds) {
        const int tid = opaque_tid(), lane = tid & 63, wid = tid >> 6, wm = wid >> 1, wn = wid & 1, fr = lane & 15, fq = lane >> 4;
        const int wu = __builtin_amdgcn_readfirstlane(wid);
        f32x4 acc[4][8];
#pragma unroll
        for (int mi = 0; mi < 4; ++mi)
#pragma unroll
            for (int ni = 0; ni < 8; ++ni) acc[mi][ni] = (f32x4){0.f, 0.f, 0.f, 0.f};
        int a_rd[4];
#pragma unroll
        for (int mi = 0; mi < 4; ++mi) { const int row = wm * 64 + mi * 16 + fr; a_rd[mi] = row * 64 + ((fq ^ ((row >> 1) & 3)) << 4); }
        int b_rd[2], b_f[2];
#pragma unroll
        for (int t = 0; t < 2; ++t) { const int k = 8 * fq + 4 * t + (fr >> 2); b_f[t] = fk2(k); b_rd[t] = A_BYTES + k * 512 + ((fr & 3) << 3); }
        const unsigned lds0 = (unsigned)(uintptr_t)lds + (unsigned)wu * 1024u;
        const bf16_t* aptr[2]; const bf16_t* bptr[2];
        const int total = NSEG * KT;
        int lseg = 0, lkt = 0, lg = 0;
        auto issue = [&]() {
            const unsigned base = (unsigned)__builtin_amdgcn_readfirstlane((int)(lds0 + (unsigned)(lg & 3) * STAGE));
#pragma unroll
            for (int i = 0; i < 2; ++i) glds16(aptr[i] + (size_t)lkt * a_kstride, base + i * 8192);
#pragma unroll
            for (int i = 0; i < 2; ++i) glds16(bptr[i] + (size_t)lkt * b_kstride, base + A_BYTES + i * 8192);
            ++lg; if (++lkt == KT) { lkt = 0; ++lseg; if (lseg < NSEG) f.ptrs(lseg, aptr, bptr); }
        };
        const int grp = wu >> 2;
        auto bar = [&]() { asm volatile("s_waitcnt lgkmcnt(0)" ::: "memory"); __builtin_amdgcn_s_barrier(); asm volatile("" ::: "memory"); };
        f.ptrs(0, aptr, bptr);
        asm volatile("s_waitcnt vmcnt(0)" ::: "memory");
        issue(); if (total > 1) issue(); if (total > 2) issue();
        if (total > 2) asm volatile("s_waitcnt vmcnt(8)" ::: "memory"); else if (total > 1) asm volatile("s_waitcnt vmcnt(4)" ::: "memory"); else asm volatile("s_waitcnt vmcnt(0)" ::: "memory");
        bar();
        if (grp) bar();
        int cseg = 0, ckt = 0;
#pragma unroll 1
        for (int g = 0; g < total; ++g) {
            if (lg < total) issue();
            const LAS unsigned char* base = lds + (g & 3) * STAGE;
            bf16x8 af[4], bfr[8];
#pragma unroll
            for (int mi = 0; mi < 4; ++mi) af[mi] = *(const LAS bf16x8*)(base + a_rd[mi]);
#pragma unroll
            for (int ni = 0; ni < 8; ++ni) {
                const int u0 = wn * 8 + ni;
                const s16x4 lo = lds_tr(base + b_rd[0] + ((u0 ^ b_f[0]) << 5));
                const s16x4 hi = lds_tr(base + b_rd[1] + ((u0 ^ b_f[1]) << 5));
                bfr[ni] = (bf16x8){lo[0], lo[1], lo[2], lo[3], hi[0], hi[1], hi[2], hi[3]};
            }
            { const int rem = total - 2 - g;
              if (rem >= 2) asm volatile("s_waitcnt vmcnt(8)" ::: "memory"); else if (rem == 1) asm volatile("s_waitcnt vmcnt(4)" ::: "memory"); else asm volatile("s_waitcnt vmcnt(0)" ::: "memory"); }
            bar();
            __builtin_amdgcn_sched_barrier(0);
#pragma unroll
            for (int ni = 0; ni < 8; ++ni)
#pragma unroll
                for (int mi = 0; mi < 4; ++mi) acc[mi][ni] = __builtin_amdgcn_mfma_f32_16x16x32_bf16(bfr[ni], af[mi], acc[mi][ni], 0, 0, 0);
            __builtin_amdgcn_sched_barrier(0);
            bar();
            if (++ckt == KT) {
                if (!grp) bar();
                f.epi(cseg, acc);
#pragma unroll
                for (int mi = 0; mi < 4; ++mi)
#pragma unroll
                    for (int ni = 0; ni < 8; ++ni) acc[mi][ni] = (f32x4){0.f, 0.f, 0.f, 0.f};
                ckt = 0; ++cseg;
                if (grp) bar();
            }
        }
        if (!grp) bar();
    }
};

struct Gemm8 {
    static constexpr int A_BYTES = 16384, STAGE = 32768;
    static __device__ __forceinline__ int t_row(int i, int w, int lane) { return (i * 8 + w) * 16 + (lane >> 2); }
    static __device__ __forceinline__ int t_chunk(int row, int lane) { return (lane & 3) ^ ((row >> 1) & 3); }
    static __device__ __forceinline__ int w_col(int i) { return 16 * ((i >> 2) & 1) + 4 * (i >> 3) + (i & 3); }
    template <class F> static __device__ __forceinline__ void run_stream(F& f, int NSEG, int KT, LAS unsigned char* lds) {
        const int tid = opaque_tid(), lane = tid & 63, wid = tid >> 6, wm = wid >> 1, wn = wid & 1, l31 = lane & 31, hi = lane >> 5;
        const int wu = __builtin_amdgcn_readfirstlane(wid);
        f32x16 acc[2][4];
#pragma unroll
        for (int jt = 0; jt < 2; ++jt)
#pragma unroll
            for (int it = 0; it < 4; ++it)
#pragma unroll
                for (int r = 0; r < 16; ++r) acc[jt][it][r] = 0.f;
        const int sw = (l31 >> 1) & 3;
        const int t_rd0 = (wm * 64 + l31) * 64 + (((2 * hi) ^ sw) << 4), t_rd1 = (wm * 64 + l31) * 64 + (((2 * hi + 1) ^ sw) << 4);
        const int w_rd0 = A_BYTES + (wn * 128 + l31) * 64 + (((2 * hi) ^ sw) << 4), w_rd1 = A_BYTES + (wn * 128 + l31) * 64 + (((2 * hi + 1) ^ sw) << 4);
        const unsigned lds0 = (unsigned)(uintptr_t)lds + (unsigned)wu * 1024u;
        const unsigned char* aptr[2]; const unsigned char* wptr[2];
        const int total = NSEG * KT;
        int lseg = 0, lkt = 0, lg = 0;
        auto issue = [&]() {
            const unsigned base = (unsigned)__builtin_amdgcn_readfirstlane((int)(lds0 + (unsigned)(lg & 3) * STAGE));
#pragma unroll
            for (int i = 0; i < 2; ++i) glds16(aptr[i] + lkt * 64, base + i * 8192);
#pragma unroll
            for (int i = 0; i < 2; ++i) glds16(wptr[i] + lkt * 64, base + A_BYTES + i * 8192);
            ++lg; if (++lkt == KT) { lkt = 0; ++lseg; if (lseg < NSEG) f.ptrs(lseg, aptr, wptr); }
        };
        const int grp = wu >> 2;
        auto bar = [&]() { asm volatile("s_waitcnt lgkmcnt(0)" ::: "memory"); __builtin_amdgcn_s_barrier(); asm volatile("" ::: "memory"); };
        f.ptrs(0, aptr, wptr);
        asm volatile("s_waitcnt vmcnt(0)" ::: "memory");
        issue(); if (total > 1) issue(); if (total > 2) issue();
        if (total > 2) asm volatile("s_waitcnt vmcnt(8)" ::: "memory"); else if (total > 1) asm volatile("s_waitcnt vmcnt(4)" ::: "memory"); else asm volatile("s_waitcnt vmcnt(0)" ::: "memory");
        bar();
        if (grp) bar();
        int cseg = 0, ckt = 0;
#pragma unroll 1
        for (int g = 0; g < total; ++g) {
            if (lg < total) issue();
            const LAS unsigned char* base = lds + (g & 3) * STAGE;
            i32x8 tf[2], wf[4];
#pragma unroll
            for (int jt = 0; jt < 2; ++jt) { const u32x4 lo = *(const LAS u32x4*)(base + t_rd0 + jt * 2048), h4 = *(const LAS u32x4*)(base + t_rd1 + jt * 2048);
                tf[jt] = (i32x8){(int)lo.x, (int)lo.y, (int)lo.z, (int)lo.w, (int)h4.x, (int)h4.y, (int)h4.z, (int)h4.w}; }
#pragma unroll
            for (int it = 0; it < 4; ++it) { const u32x4 lo = *(const LAS u32x4*)(base + w_rd0 + it * 2048), h4 = *(const LAS u32x4*)(base + w_rd1 + it * 2048);
                wf[it] = (i32x8){(int)lo.x, (int)lo.y, (int)lo.z, (int)lo.w, (int)h4.x, (int)h4.y, (int)h4.z, (int)h4.w}; }
            { const int rem = total - 2 - g;
              if (rem >= 2) asm volatile("s_waitcnt vmcnt(8)" ::: "memory"); else if (rem == 1) asm volatile("s_waitcnt vmcnt(4)" ::: "memory"); else asm volatile("s_waitcnt vmcnt(0)" ::: "memory"); }
            bar();
            __builtin_amdgcn_sched_barrier(0);
#pragma unroll
            for (int it = 0; it < 4; ++it)
#pragma unroll
                for (int jt = 0; jt < 2; ++jt) acc[jt][it] = __builtin_amdgcn_mfma_scale_f32_32x32x64_f8f6f4(wf[it], tf[jt], acc[jt][it], 0, 0, 0, F::wscale(it), 0, 127);
            __builtin_amdgcn_sched_barrier(0);
            bar();
            if (++ckt == KT) {
                if (!grp) bar();
                f.epi(cseg, acc);
#pragma unroll
                for (int jt = 0; jt < 2; ++jt)
#pragma unroll
                    for (int it = 0; it < 4; ++it)
#pragma unroll
                        for (int r = 0; r < 16; ++r) acc[jt][it][r] = 0.f;
                ckt = 0; ++cseg;
                if (grp) bar();
            }
        }
        if (!grp) bar();
    }
};

struct Gemm4 {
    static constexpr int A_BYTES = 16384, STAGE = 32768, LDS_BYTES = 2 * STAGE;
    static __device__ __forceinline__ int fk2(int r) { return (r & 3) | (((r >> 3) & 1) << 2); }
    static __device__ __forceinline__ int a_row(int i, int tid) { return (tid >> 2) + 128 * i; }
    static __device__ __forceinline__ int b_k(int i, int tid) { return (tid >> 5) + 16 * i; }
    static __device__ __forceinline__ void run(f32x4 (&acc)[4][8], const bf16_t* const (&aptr)[2], int a_kstride, const bf16_t* const (&bptr)[2], size_t b_kstride, int KT, LAS unsigned char* lds) {
        const int tid = opaque_tid(), lane = tid & 63, wid = tid >> 6, wm = wid >> 1, wn = wid & 1, fr = lane & 15, fq = lane >> 4;
#pragma unroll
        for (int mi = 0; mi < 4; ++mi)
#pragma unroll
            for (int ni = 0; ni < 8; ++ni) acc[mi][ni] = (f32x4){0.f, 0.f, 0.f, 0.f};
        int a_wr[2], b_wr[2];
#pragma unroll
        for (int i = 0; i < 2; ++i) { const int row = a_row(i, tid); a_wr[i] = row * 64 + (((tid & 3) ^ ((row >> 1) & 3)) << 4);
            const int k = b_k(i, tid), n = (tid & 31) * 8; b_wr[i] = A_BYTES + k * 512 + (((n >> 4) ^ fk2(k)) << 5) + ((n & 15) << 1); }
        int a_rd[4];
#pragma unroll
        for (int mi = 0; mi < 4; ++mi) { const int row = wm * 64 + mi * 16 + fr; a_rd[mi] = row * 64 + ((fq ^ ((row >> 1) & 3)) << 4); }
        int b_rd[2], b_f[2];
#pragma unroll
        for (int t = 0; t < 2; ++t) { const int k = 8 * fq + 4 * t + (fr >> 2); b_f[t] = fk2(k); b_rd[t] = A_BYTES + k * 512 + ((fr & 3) << 3); }
        u32x4 ra0[2], rb0[2], ra1[2], rb1[2];
        auto gload = [&](int kt, u32x4 (&ra)[2], u32x4 (&rb)[2]) {
#pragma unroll
            for (int i = 0; i < 2; ++i) { ra[i] = *(const u32x4*)(aptr[i] + (size_t)kt * a_kstride); rb[i] = *(const u32x4*)(bptr[i] + (size_t)kt * b_kstride); }
        };
        auto lstore = [&](int buf, const u32x4 (&ra)[2], const u32x4 (&rb)[2]) {
            LAS unsigned char* base = lds + buf * STAGE;
#pragma unroll
            for (int i = 0; i < 2; ++i) { *(LAS u32x4*)(base + a_wr[i]) = ra[i]; *(LAS u32x4*)(base + b_wr[i]) = rb[i]; }
        };
        auto compute = [&](int buf) {
            const LAS unsigned char* base = lds + buf * STAGE;
            bf16x8 af[4];
#pragma unroll
            for (int mi = 0; mi < 4; ++mi) af[mi] = *(const LAS bf16x8*)(base + a_rd[mi]);
#pragma unroll
            for (int ni = 0; ni < 8; ++ni) {
                const int u0 = wn * 8 + ni;
                const s16x4 lo = lds_tr(base + b_rd[0] + ((u0 ^ b_f[0]) << 5));
                const s16x4 hi = lds_tr(base + b_rd[1] + ((u0 ^ b_f[1]) << 5));
                const bf16x8 bfr = (bf16x8){lo[0], lo[1], lo[2], lo[3], hi[0], hi[1], hi[2], hi[3]};
#pragma unroll
                for (int mi = 0; mi < 4; ++mi) acc[mi][ni] = __builtin_amdgcn_mfma_f32_16x16x32_bf16(bfr, af[mi], acc[mi][ni], 0, 0, 0);
            }
        };
        gload(0, ra0, rb0); gload(1, ra1, rb1);
        lstore(0, ra0, rb0); __syncthreads();
        for (int kt = 0; kt < KT; kt += 2) {
            gload(kt + 2 < KT ? kt + 2 : KT - 1, ra0, rb0);
            __builtin_amdgcn_sched_barrier(0);
            compute(0);
            lstore(1, ra1, rb1);
            __syncthreads();
            gload(kt + 3 < KT ? kt + 3 : KT - 1, ra1, rb1);
            __builtin_amdgcn_sched_barrier(0);
            compute(1);
            lstore(0, ra0, rb0);
            __syncthreads();
        }
    }

    template <class F> static __device__ __forceinline__ void run_stream(F& f, int NSEG, int KT, int a_kstride, size_t b_kstride, LAS unsigned char* lds) {
        const int tid = opaque_tid(), lane = tid & 63, wid = tid >> 6, wm = wid >> 1, wn = wid & 1, fr = lane & 15, fq = lane >> 4;
        f32x4 acc[4][8];
#pragma unroll
        for (int mi = 0; mi < 4; ++mi)
#pragma unroll
            for (int ni = 0; ni < 8; ++ni) acc[mi][ni] = (f32x4){0.f, 0.f, 0.f, 0.f};
        int a_wr[2], b_wr[2];
#pragma unroll
        for (int i = 0; i < 2; ++i) { const int row = a_row(i, tid); a_wr[i] = row * 64 + (((tid & 3) ^ ((row >> 1) & 3)) << 4);
            const int k = b_k(i, tid), n = (tid & 31) * 8; b_wr[i] = A_BYTES + k * 512 + (((n >> 4) ^ fk2(k)) << 5) + ((n & 15) << 1); }
        int a_rd[4];
#pragma unroll
        for (int mi = 0; mi < 4; ++mi) { const int row = wm * 64 + mi * 16 + fr; a_rd[mi] = row * 64 + ((fq ^ ((row >> 1) & 3)) << 4); }
        int b_rd[2], b_f[2];
#pragma unroll
        for (int t = 0; t < 2; ++t) { const int k = 8 * fq + 4 * t + (fr >> 2); b_f[t] = fk2(k); b_rd[t] = A_BYTES + k * 512 + ((fr & 3) << 3); }
        const bf16_t* aptr[2]; const bf16_t* bptr[2];
        u32x4 ra0[2], rb0[2], ra1[2], rb1[2];
        int lseg = 0, lkt = 0;
        auto gload = [&](u32x4 (&ra)[2], u32x4 (&rb)[2]) {
#pragma unroll
            for (int i = 0; i < 2; ++i) { ra[i] = *(const u32x4*)(aptr[i] + (size_t)lkt * a_kstride); rb[i] = *(const u32x4*)(bptr[i] + (size_t)lkt * b_kstride); }
            if (lkt + 1 < KT) ++lkt; else if (lseg + 1 < NSEG) { lkt = 0; ++lseg; f.ptrs(lseg, aptr, bptr); }
        };
        auto lstore = [&](int buf, const u32x4 (&ra)[2], const u32x4 (&rb)[2]) {
            LAS unsigned char* base = lds + buf * STAGE;
#pragma unroll
            for (int i = 0; i < 2; ++i) { *(LAS u32x4*)(base + a_wr[i]) = ra[i]; *(LAS u32x4*)(base + b_wr[i]) = rb[i]; }
        };
        auto compute = [&](int buf) {
            const LAS unsigned char* base = lds + buf * STAGE;
            bf16x8 af[4];
#pragma unroll
            for (int mi = 0; mi < 4; ++mi) af[mi] = *(const LAS bf16x8*)(base + a_rd[mi]);
#pragma unroll
            for (int ni = 0; ni < 8; ++ni) {
                const int u0 = wn * 8 + ni;
                const s16x4 lo = lds_tr(base + b_rd[0] + ((u0 ^ b_f[0]) << 5));
                const s16x4 hi = lds_tr(base + b_rd[1] + ((u0 ^ b_f[1]) << 5));
                const bf16x8 bfr = (bf16x8){lo[0], lo[1], lo[2], lo[3], hi[0], hi[1], hi[2], hi[3]};
#pragma unroll
                for (int mi = 0; mi < 4; ++mi) acc[mi][ni] = __builtin_amdgcn_mfma_f32_16x16x32_bf16(bfr, af[mi], acc[mi][ni], 0, 0, 0);
            }
        };
        f.ptrs(0, aptr, bptr);
        gload(ra0, rb0); gload(ra1, rb1);
        lstore(0, ra0, rb0); __syncthreads();
        int cseg = 0, ckt = 0;
        const int total = NSEG * KT;
#pragma unroll 1
        for (int g = 0; g < total; g += 2) {
            gload(ra0, rb0);
            __builtin_amdgcn_sched_barrier(0);
            compute(0);
            lstore(1, ra1, rb1);
            __syncthreads();
            gload(ra1, rb1);
            __builtin_amdgcn_sched_barrier(0);
            compute(1);
            lstore(0, ra0, rb0);
            __syncthreads();
            ckt += 2;
            if (ckt == KT) {
                f.epi(cseg, acc);
#pragma unroll
                for (int mi = 0; mi < 4; ++mi)
#pragma unroll
                    for (int ni = 0; ni < 8; ++ni) acc[mi][ni] = (f32x4){0.f, 0.f, 0.f, 0.f};
                ckt = 0; ++cseg;
            }
        }
    }
};

template <bool BF32> struct Gemm5 {
    static constexpr int A_BYTES = 16384, STAGE = 32768, LDS_BYTES = 2 * STAGE;
    static __device__ __forceinline__ int fk2(int r) { return (r & 3) | (((r >> 3) & 1) << 2); }
    static __device__ __forceinline__ int a_row(int i, int tid) { return (tid >> 2) + 128 * i; }
    static __device__ __forceinline__ int b_k(int i, int tid) { return (tid >> 5) + 16 * i; }
    typedef typename std::conditional<BF32, float, bf16_t>::type b_t;
    static __device__ __forceinline__ void run(f32x4 (&acc)[4][8], const bf16_t* const (&aptr)[2], int a_kstride, const b_t* const (&bptr)[2], size_t b_kstride, int KT, LAS unsigned char* lds) {
        const int tid = opaque_tid(), lane = tid & 63, wid = tid >> 6, wm = wid >> 1, wn = wid & 1, fr = lane & 15, fq = lane >> 4;
#pragma unroll
        for (int mi = 0; mi < 4; ++mi)
#pragma unroll
            for (int ni = 0; ni < 8; ++ni) acc[mi][ni] = (f32x4){0.f, 0.f, 0.f, 0.f};
        int a_wr[2], b_wr[2];
#pragma unroll
        for (int i = 0; i < 2; ++i) { const int row = a_row(i, tid); a_wr[i] = row * 64 + (((tid & 3) ^ ((row >> 1) & 3)) << 4);
            const int k = b_k(i, tid), n = (tid & 31) * 8; b_wr[i] = A_BYTES + k * 512 + (((n >> 4) ^ fk2(k)) << 5) + ((n & 15) << 1); }
        int a_rd[4];
#pragma unroll
        for (int mi = 0; mi < 4; ++mi) { const int row = wm * 64 + mi * 16 + fr; a_rd[mi] = row * 64 + ((fq ^ ((row >> 1) & 3)) << 4); }
        int b_rd[2], b_f[2];
#pragma unroll
        for (int t = 0; t < 2; ++t) { const int k = 8 * fq + 4 * t + (fr >> 2); b_f[t] = fk2(k); b_rd[t] = A_BYTES + k * 512 + ((fr & 3) << 3); }
        u32x4 ra[2]; u32x4 rb[2]; f32x4 rbf[2][2];
        auto gload = [&](int kt) {
#pragma unroll
            for (int i = 0; i < 2; ++i) { ra[i] = *(const u32x4*)(aptr[i] + (size_t)kt * a_kstride);
                if (BF32) { const float* p = (const float*)bptr[i] + (size_t)kt * b_kstride; rbf[i][0] = *(const f32x4*)p; rbf[i][1] = *(const f32x4*)(p + 4); }
                else rb[i] = *(const u32x4*)((const bf16_t*)bptr[i] + (size_t)kt * b_kstride); }
        };
        auto lstore = [&](int buf) {
            LAS unsigned char* base = lds + buf * STAGE;
#pragma unroll
            for (int i = 0; i < 2; ++i) { *(LAS u32x4*)(base + a_wr[i]) = ra[i];
                if (BF32) { u32x4 w; w.x = cvtpk(rbf[i][0].x, rbf[i][0].y); w.y = cvtpk(rbf[i][0].z, rbf[i][0].w); w.z = cvtpk(rbf[i][1].x, rbf[i][1].y); w.w = cvtpk(rbf[i][1].z, rbf[i][1].w); *(LAS u32x4*)(base + b_wr[i]) = w; }
                else *(LAS u32x4*)(base + b_wr[i]) = rb[i]; }
        };
        auto compute = [&](int buf) {
            const LAS unsigned char* base = lds + buf * STAGE;
            bf16x8 af[4];
#pragma unroll
            for (int mi = 0; mi < 4; ++mi) af[mi] = *(const LAS bf16x8*)(base + a_rd[mi]);
#pragma unroll
            for (int ni = 0; ni < 8; ++ni) {
                const int u0 = wn * 8 + ni;
                const s16x4 lo = lds_tr(base + b_rd[0] + ((u0 ^ b_f[0]) << 5));
                const s16x4 hi = lds_tr(base + b_rd[1] + ((u0 ^ b_f[1]) << 5));
                const bf16x8 bfr = (bf16x8){lo[0], lo[1], lo[2], lo[3], hi[0], hi[1], hi[2], hi[3]};
#pragma unroll
                for (int mi = 0; mi < 4; ++mi) acc[mi][ni] = __builtin_amdgcn_mfma_f32_16x16x32_bf16(bfr, af[mi], acc[mi][ni], 0, 0, 0);
            }
        };
        gload(0); lstore(0); __syncthreads();
#pragma unroll 1
        for (int kt = 0; kt < KT; ++kt) {
            gload(kt + 1 < KT ? kt + 1 : KT - 1);
            __builtin_amdgcn_sched_barrier(0);
            compute(kt & 1);
            lstore((kt + 1) & 1);
            __syncthreads();
        }
    }

    template <class F> static __device__ __forceinline__ void run_stream(F& f, int NSEG, int KT, int a_kstride, size_t b_kstride, LAS unsigned char* lds) {
        const int tid = opaque_tid(), lane = tid & 63, wid = tid >> 6, wm = wid >> 1, wn = wid & 1, fr = lane & 15, fq = lane >> 4;
        f32x4 acc[4][8];
#pragma unroll
        for (int mi = 0; mi < 4; ++mi)
#pragma unroll
            for (int ni = 0; ni < 8; ++ni) acc[mi][ni] = (f32x4){0.f, 0.f, 0.f, 0.f};
        int a_wr[2], b_wr[2];
#pragma unroll
        for (int i = 0; i < 2; ++i) { const int row = a_row(i, tid); a_wr[i] = row * 64 + (((tid & 3) ^ ((row >> 1) & 3)) << 4);
            const int k = b_k(i, tid), n = (tid & 31) * 8; b_wr[i] = A_BYTES + k * 512 + (((n >> 4) ^ fk2(k)) << 5) + ((n & 15) << 1); }
        int a_rd[4];
#pragma unroll
        for (int mi = 0; mi < 4; ++mi) { const int row = wm * 64 + mi * 16 + fr; a_rd[mi] = row * 64 + ((fq ^ ((row >> 1) & 3)) << 4); }
        int b_rd[2], b_f[2];
#pragma unroll
        for (int t = 0; t < 2; ++t) { const int k = 8 * fq + 4 * t + (fr >> 2); b_f[t] = fk2(k); b_rd[t] = A_BYTES + k * 512 + ((fr & 3) << 3); }
        const bf16_t* aptr[2]; const b_t* bptr[2];
        u32x4 ra[2]; u32x4 rb[2]; f32x4 rbf[2][2];
        auto gload = [&](int kt) {
#pragma unroll
            for (int i = 0; i < 2; ++i) { ra[i] = *(const u32x4*)(aptr[i] + (size_t)kt * a_kstride);
                if (BF32) { const float* p = (const float*)bptr[i] + (size_t)kt * b_kstride; rbf[i][0] = *(const f32x4*)p; rbf[i][1] = *(const f32x4*)(p + 4); }
                else rb[i] = *(const u32x4*)((const bf16_t*)bptr[i] + (size_t)kt * b_kstride); }
        };
        auto lstore = [&](int buf) {
            LAS unsigned char* base = lds + buf * STAGE;
#pragma unroll
            for (int i = 0; i < 2; ++i) { *(LAS u32x4*)(base + a_wr[i]) = ra[i];
                if (BF32) { u32x4 w; w.x = cvtpk(rbf[i][0].x, rbf[i][0].y); w.y = cvtpk(rbf[i][0].z, rbf[i][0].w); w.z = cvtpk(rbf[i][1].x, rbf[i][1].y); w.w = cvtpk(rbf[i][1].z, rbf[i][1].w); *(LAS u32x4*)(base + b_wr[i]) = w; }
                else *(LAS u32x4*)(base + b_wr[i]) = rb[i]; }
        };
        auto compute = [&](int buf) {
            const LAS unsigned char* base = lds + buf * STAGE;
            bf16x8 af[4];
#pragma unroll
            for (int mi = 0; mi < 4; ++mi) af[mi] = *(const LAS bf16x8*)(base + a_rd[mi]);
#pragma unroll
            for (int ni = 0; ni < 8; ++ni) {
                const int u0 = wn * 8 + ni;
                const s16x4 lo = lds_tr(base + b_rd[0] + ((u0 ^ b_f[0]) << 5));
                const s16x4 hi = lds_tr(base + b_rd[1] + ((u0 ^ b_f[1]) << 5));
                const bf16x8 bfr = (bf16x8){lo[0], lo[1], lo[2], lo[3], hi[0], hi[1], hi[2], hi[3]};
#pragma unroll
                for (int mi = 0; mi < 4; ++mi) acc[mi][ni] = __builtin_amdgcn_mfma_f32_16x16x32_bf16(bfr, af[mi], acc[mi][ni], 0, 0, 0);
            }
        };
        f.ptrs(0, aptr, bptr);
        gload(0); lstore(0); __syncthreads();
        int seg = 0, kt = 0;
        const int total = NSEG * KT;
#pragma unroll 1
        for (int g = 0; g < total; ++g) {
            int nkt = kt + 1, nsg = seg; if (nkt == KT) { nkt = 0; nsg = seg + 1; }
            if (nkt == 0 && nsg < NSEG) f.ptrs(nsg, aptr, bptr);
            gload(nsg < NSEG ? nkt : KT - 1);
            __builtin_amdgcn_sched_barrier(0);
            compute(g & 1);
            lstore((g + 1) & 1);
            __syncthreads();
            if (nkt == 0) {
                f.epi(seg, acc);
#pragma unroll
                for (int mi = 0; mi < 4; ++mi)
#pragma unroll
                    for (int ni = 0; ni < 8; ++ni) acc[mi][ni] = (f32x4){0.f, 0.f, 0.f, 0.f};
            }
            seg = nsg; kt = nkt;
        }
    }
};

__device__ __forceinline__ int p2_col(int m0);
__device__ __forceinline__ unsigned pk4_fp8(float a, float b, float c, float d) { int pk = __builtin_amdgcn_cvt_pk_fp8_f32(a, b, 0, false); pk = __builtin_amdgcn_cvt_pk_fp8_f32(c, d, pk, true); return (unsigned)pk; }
__device__ __forceinline__ int w8_col(int i) { return 16 * ((i >> 2) & 1) + 4 * (i >> 3) + (i & 3); }
__device__ __forceinline__ void phase_mod(const Params& P, LAS unsigned char* lds) {
    const int tid = threadIdx.x;
    float* mod = (float*)(P.ws + WS_MOD);
    LAS float* sc = (LAS float*)lds;
    LAS float* red = (LAS float*)(lds + 16384);
    for (int i = tid; i < 4096; i += NTHREADS) sc[i] = siluf_(P.c[i]);
    __syncthreads();
    const int kq = tid >> 5, cl = tid & 31;
    for (int u = blockIdx.x; u < 192; u += gridDim.x) {
        const int j = u * 32 + cl;
        float a0 = 0.f, a1 = 0.f, a2 = 0.f, a3 = 0.f;
#pragma unroll 8
        for (int k = kq; k < 1024; k += 16) { const float w = P.ada_w[(size_t)k * 6144 + j];
            a0 += sc[k] * w; a1 += sc[1024 + k] * w; a2 += sc[2048 + k] * w; a3 += sc[3072 + k] * w; }
        red[(kq * 4 + 0) * 32 + cl] = a0; red[(kq * 4 + 1) * 32 + cl] = a1; red[(kq * 4 + 2) * 32 + cl] = a2; red[(kq * 4 + 3) * 32 + cl] = a3;
        __syncthreads();
        if (tid < 128) { const int b = tid >> 5; float s = 0.f;
#pragma unroll
            for (int q = 0; q < 16; ++q) s += red[(q * 4 + b) * 32 + cl];
            mod[b * 6144 + j] = s + P.ada_b[j]; }
        __syncthreads();
    }
    for (int u = blockIdx.x; u < 16; u += gridDim.x) {
        const int sel = u >> 3, j = (u & 7) * 32 + cl;
        const float* w1 = P.cmp_w1 + (size_t)sel * 2048 * 256; const float* pos = P.cmp_pos + sel * 2048;
        float a0 = 0.f;
#pragma unroll 8
        for (int k = kq; k < 2048; k += 16) a0 += pos[k] * w1[(size_t)k * 256 + j];
        red[kq * 32 + cl] = a0;
        __syncthreads();
        if (tid < 32) { float s = 0.f;
#pragma unroll
            for (int q = 0; q < 16; ++q) s += red[q * 32 + cl];
            ((float*)(P.ws + WS_CB))[sel * 256 + j] = s + P.cmp_b1[sel * 256 + j]; }
        __syncthreads();
    }
    {
        unsigned char* wb = (unsigned char*)(P.ws + WS_WIN);
        const int lane = tid & 63, gw = blockIdx.x * (NTHREADS / 64) + (tid >> 6), NGW = gridDim.x * (NTHREADS / 64);
        for (int u = gw; u < 56 * 16; u += NGW) {
            const int rg = u % 56, kb = u / 56, q = rg * 64 + lane, c8 = (q & ~31) + w8_col(q & 31);
            const int sc_ = c8 < 1280 ? c8 : (c8 < 3328 ? c8 + 24 : c8 - 2048);
            const float* s = P.w_in + (size_t)(kb * 64) * IN_COLS + (c8 < 3352 ? sc_ : 0);
            float v[64];
#pragma unroll
            for (int j = 0; j < 64; ++j) v[j] = s[(size_t)j * IN_COLS];
            const float c_ = c8 < 3352 ? 64.0f : 0.0f;
#pragma unroll
            for (int j = 0; j < 4; ++j) { u32x4 w;
                w.x = pk4_fp8(v[16 * j] * c_, v[16 * j + 1] * c_, v[16 * j + 2] * c_, v[16 * j + 3] * c_); w.y = pk4_fp8(v[16 * j + 4] * c_, v[16 * j + 5] * c_, v[16 * j + 6] * c_, v[16 * j + 7] * c_);
                w.z = pk4_fp8(v[16 * j + 8] * c_, v[16 * j + 9] * c_, v[16 * j + 10] * c_, v[16 * j + 11] * c_); w.w = pk4_fp8(v[16 * j + 12] * c_, v[16 * j + 13] * c_, v[16 * j + 14] * c_, v[16 * j + 15] * c_);
                *(u32x4*)(wb + (size_t)q * 1024 + kb * 64 + j * 16) = w; }
        }
    }
    if (blockIdx.x == gridDim.x - 2) {
        for (int i = tid; i < 2 * 8 * 64; i += NTHREADS) { const int t2 = i >> 9, bg = (i >> 6) & 7, d = i & 63;
            ((bf16_t*)(P.ws + (t2 ? WS_VC : WS_KC)))[((size_t)bg * 512 + 511) * 64 + d] = 0; }
    }
    if (blockIdx.x == gridDim.x - 1) {
        float* lb = (float*)(P.ws + WS_LB);
        for (int i = tid; i < 512; i += NTHREADS) { const float p0 = P.hgrn_lb[i], p1 = P.hgrn_lb[512 + i]; lb[i] = 1.0f / (1.0f + __expf(p1 - p0)); }
    }
}

__device__ __forceinline__ void norm_mod_rows(const float* x, const float* w, const float* mod_sh, const float* mod_sc, unsigned char* h, int hs) {
    const int lane = threadIdx.x & 63, gw = blockIdx.x * (NTHREADS / 64) + (threadIdx.x >> 6), NGW = gridDim.x * (NTHREADS / 64);
    for (int m = gw; m < T; m += NGW) {
        const int b = m / SEQ;
        const f32x4* xr = (const f32x4*)(x + (size_t)m * D) + lane;
        f32x4 v[4]; float s = 0.f;
#pragma unroll
        for (int j = 0; j < 4; ++j) { v[j] = xr[64 * j]; s += (v[j].x * v[j].x + v[j].y * v[j].y) + (v[j].z * v[j].z + v[j].w * v[j].w); }
        const float rstd = rsqrtf(wave_sum(s) * (1.f / D) + RMS_EPS);
        unsigned* o = (unsigned*)(h + (size_t)m * hs) + lane;
#pragma unroll
        for (int j = 0; j < 4; ++j) {
            const int col = (lane + 64 * j) * 4;
            const f32x4 wv = *(const f32x4*)(w + col), scv = *(const f32x4*)(mod_sc + b * 6144 + col), shv = *(const f32x4*)(mod_sh + b * 6144 + col);
            f32x4 r;
            r.x = v[j].x * rstd * wv.x * (1.f + scv.x) + shv.x; r.y = v[j].y * rstd * wv.y * (1.f + scv.y) + shv.y;
            r.z = v[j].z * rstd * wv.z * (1.f + scv.z) + shv.z; r.w = v[j].w * rstd * wv.w * (1.f + scv.w) + shv.w;
            o[64 * j] = pk4_fp8(r.x, r.y, r.z, r.w);
        }
    }
}

__device__ __forceinline__ void phase_inproj(const Params& P, LAS unsigned char* lds) {
    constexpr int NRT = T / 256, NCT = 14;
    struct F { const Params& P;
        static __device__ __forceinline__ int wscale(int) { return 121; }
        __device__ __forceinline__ void unit(int seg, int& rt, int& ct) const {
            const int nx = (gridDim.x % 8 == 0) ? 8 : 1, xl = blockIdx.x % nx, li = blockIdx.x / nx, nloc = gridDim.x / nx;
            const int v = li + seg * nloc, rg = v / (NCT * 4), rem = v % (NCT * 4); ct = rem >> 2; rt = xl + nx * (rg * 4 + (rem & 3)); }
        __device__ __forceinline__ void ptrs(int seg, const unsigned char* (&aptr)[2], const unsigned char* (&wptr)[2]) const {
            const int tid = opaque_tid(), lane = tid & 63, wid = tid >> 6; int rt, ct; unit(seg, rt, ct);
            const unsigned char* h1 = (const unsigned char*)(P.ws + WS_H); const unsigned char* wb = (const unsigned char*)(P.ws + WS_WIN);
#pragma unroll
            for (int i = 0; i < 2; ++i) { const int row = Gemm8::t_row(i, wid, lane); aptr[i] = h1 + (size_t)(rt * 256 + row) * H1S + Gemm8::t_chunk(row, lane) * 16;
                wptr[i] = wb + (size_t)(ct * 256 + row) * 1024 + Gemm8::t_chunk(row, lane) * 16; } }
        __device__ __forceinline__ void epi(int seg, f32x16 (&acc)[2][4]) const {
            const int tid = opaque_tid(), lane = tid & 63, wid = tid >> 6, wm = wid >> 1, wn = wid & 1, l31 = lane & 31, hi = lane >> 5;
            int rt, ct; unit(seg, rt, ct);
            bf16_t* qo = (bf16_t*)(P.ws + WS_Q); bf16_t* kvo = (bf16_t*)(P.ws + WS_KV); float* gates = (float*)(P.ws + WS_GATES);
            bf16_t* hq = (bf16_t*)(P.ws + WS_HQ); bf16_t* logf = (bf16_t*)(P.ws + WS_LOGF); bf16_t* hv = (bf16_t*)(P.ws + WS_HV); bf16_t* hg = (bf16_t*)(P.ws + WS_HG);
            const float* lb = (const float*)(P.ws + WS_LB);
            const int row0 = rt * 256 + wm * 64 + l31;
            if (ct < 5) {
                const bool is_q = ct < 2; const int sg = (ct - 2) * 2 + wn;
                const bool do_norm = is_q || sg == 2 || sg == 4;
                const float* nw = is_q ? P.q_norm_w : (P.k_norm_w + (sg == 2 ? 64 : 128));
                const float osc = is_q ? 0.125f : 1.0f;
#pragma unroll
                for (int hh = 0; hh < 2; ++hh) {
#pragma unroll
                    for (int jt = 0; jt < 2; ++jt) {
                        float rstd = 1.f;
                        if (do_norm) { float s = 0.f;
#pragma unroll
                            for (int t2 = 0; t2 < 2; ++t2)
#pragma unroll
                                for (int r = 0; r < 16; ++r) { const float a = acc[jt][2 * hh + t2][r]; s += a * a; }
                            s += __shfl_xor(s, 32);
                            rstd = rsqrtf(s * (1.f / 64.f) + RMS_EPS) * osc; }
                        const size_t m = (size_t)(row0 + jt * 32);
                        bf16_t* dst = is_q ? (qo + m * 512 + ct * 256 + wn * 128 + hh * 64 + 16 * hi) : (kvo + m * 768 + (ct - 2) * 256 + wn * 128 + hh * 64 + 16 * hi);
#pragma unroll
                        for (int t2 = 0; t2 < 2; ++t2) { u32x4 w0, w1;
#pragma unroll
                            for (int q4 = 0; q4 < 4; ++q4) { const f32x4 wv = do_norm ? *(const f32x4*)(nw + t2 * 32 + 16 * hi + 4 * q4) : (f32x4){1.f, 1.f, 1.f, 1.f};
                                const unsigned lo = cvtpk(acc[jt][2 * hh + t2][4 * q4] * rstd * wv.x, acc[jt][2 * hh + t2][4 * q4 + 1] * rstd * wv.y), hi2 = cvtpk(acc[jt][2 * hh + t2][4 * q4 + 2] * rstd * wv.z, acc[jt][2 * hh + t2][4 * q4 + 3] * rstd * wv.w);
                                if (q4 < 2) { w0[2 * q4] = lo; w0[2 * q4 + 1] = hi2; } else { w1[2 * (q4 - 2)] = lo; w1[2 * (q4 - 2) + 1] = hi2; } }
                            *(u32x4*)(dst + t2 * 32) = w0; *(u32x4*)(dst + t2 * 32 + 8) = w1; }
                    }
                }
            } else if (ct == 13) {
                if (wn == 0) {
#pragma unroll
                    for (int jt = 0; jt < 2; ++jt) { const size_t m = (size_t)(row0 + jt * 32);
#pragma unroll
                        for (int q4 = 0; q4 < 4; ++q4) { const int c = 16 * hi + 4 * q4; if (c < 24) {
                                *(f32x4*)(gates + m * 24 + c) = (f32x4){sigmoidf_(acc[jt][0][4 * q4]), sigmoidf_(acc[jt][0][4 * q4 + 1]), sigmoidf_(acc[jt][0][4 * q4 + 2]), sigmoidf_(acc[jt][0][4 * q4 + 3])}; } } }
                }
            } else {
                const int hs = (ct - 5) >> 1, cc = ((ct - 5) & 1) * 256 + wn * 128 + 16 * hi;
#pragma unroll
                for (int jt = 0; jt < 2; ++jt) { const size_t m = (size_t)(row0 + jt * 32);
#pragma unroll
                    for (int it = 0; it < 4; ++it) { const int c = cc + it * 32;
                        if (hs == 1) { unsigned w8[8];
#pragma unroll
                            for (int q4 = 0; q4 < 4; ++q4) { const f32x4 l = *(const f32x4*)(lb + c + 4 * q4); f32x4 o;
                                o.x = __logf(l.x + (1.f - l.x) * sigmoidf_(acc[jt][it][4 * q4])); o.y = __logf(l.y + (1.f - l.y) * sigmoidf_(acc[jt][it][4 * q4 + 1]));
                                o.z = __logf(l.z + (1.f - l.z) * sigmoidf_(acc[jt][it][4 * q4 + 2])); o.w = __logf(l.w + (1.f - l.w) * sigmoidf_(acc[jt][it][4 * q4 + 3]));
                                w8[2 * q4] = cvtpk(o.x, o.y); w8[2 * q4 + 1] = cvtpk(o.z, o.w); }
                            *(u32x4*)(logf + m * 512 + c) = (u32x4){w8[0], w8[1], w8[2], w8[3]}; *(u32x4*)(logf + m * 512 + c + 8) = (u32x4){w8[4], w8[5], w8[6], w8[7]};
                        } else { float v[16];
#pragma unroll
                            for (int r = 0; r < 16; ++r) { const float a = acc[jt][it][r]; v[r] = hs == 0 ? siluf_(a) * 0.08838834764831845f : (hs == 2 ? a : sigmoidf_(a)); }
                            bf16_t* dst = (hs == 0 ? hq : (hs == 2 ? hv : hg)) + m * 512 + c;
                            *(u32x4*)dst = (u32x4){cvtpk(v[0], v[1]), cvtpk(v[2], v[3]), cvtpk(v[4], v[5]), cvtpk(v[6], v[7])};
                            *(u32x4*)(dst + 8) = (u32x4){cvtpk(v[8], v[9]), cvtpk(v[10], v[11]), cvtpk(v[12], v[13]), cvtpk(v[14], v[15])}; }
                    } }
            }
        }
    } f{P};
    const int nx = (gridDim.x % 8 == 0) ? 8 : 1, li = blockIdx.x / nx, nloc = gridDim.x / nx;
    const int nu = ((NRT / nx) * NCT - li + nloc - 1) / nloc;
    if (nu > 0) Gemm8::run_stream(f, nu, D / 64, lds);
}

__device__ __forceinline__ float gelu_tanh(float x) {
    const float u = 0.7978845608028654f * (x + 0.044715f * x * x * x);
    const float th = 1.0f - 2.0f / (1.0f + __expf(2.0f * u));
    return 0.5f * x * (1.0f + th);
}
__device__ __forceinline__ void compress_unit(const Params& P, LAS unsigned char* lds, int u) {
    typedef GemmT<2, 4> G;
    const int tid = opaque_tid(), lane = tid & 63, wid = tid >> 6, wm = wid >> 2, wn = wid & 3, fr = lane & 15, fq = lane >> 4;
    const int sel = u >> 5, rt = u & 31;
    const bf16_t* kv = (const bf16_t*)(P.ws + WS_KV);
    bf16_t* cmph = (bf16_t*)(P.ws + WS_CMPH) + (size_t)sel * 4096 * 256;
    const float* cb = (const float*)(P.ws + WS_CB) + sel * 256;
    const bf16_t* arow[2];
#pragma unroll
    for (int p = 0; p < 2; ++p) { int r = rt * 128 + p * 64 + (tid >> 3); r = r < 4088 ? r : 4087;
        const int b = r / 1022, rem = r % 1022, i = rem >> 1, g = rem & 1;
        arow[p] = kv + (size_t)(b * SEQ + 16 * i) * 768 + sel * 128 + g * 64; }
    f32x4 acc[4][4];
    G::run(acc, arow, 768, P.cmp_w1 + (size_t)sel * 2048 * 256, 256, 32, lds);
#pragma unroll
    for (int mi = 0; mi < 4; ++mi) { const size_t row = (size_t)(rt * 128 + wm * 64 + mi * 16 + fr);
#pragma unroll
        for (int ni = 0; ni < 4; ++ni) { const int col = wn * 64 + ni * 16 + 4 * fq; const f32x4 a = acc[mi][ni]; const f32x4 bb = *(const f32x4*)(cb + col);
            u32x2 pk; pk.x = cvtpk(gelu_tanh(a.x + bb.x), gelu_tanh(a.y + bb.y)); pk.y = cvtpk(gelu_tanh(a.z + bb.z), gelu_tanh(a.w + bb.w));
            *(u32x2*)(cmph + row * 256 + col) = pk; } }
    __syncthreads();
    {
        const int row = tid >> 2, cq = tid & 3;
        const bf16_t* hr = cmph + (size_t)(rt * 128 + row) * 256;
        const float* w2 = P.cmp_w2 + (size_t)sel * 256 * 64 + cq * 16;
        float o[16];
#pragma unroll
        for (int j = 0; j < 16; ++j) o[j] = 0.f;
        for (int k8 = 0; k8 < 256; k8 += 8) {
            const u32x4 hv = *(const u32x4*)(hr + k8);
#pragma unroll
            for (int kk = 0; kk < 8; ++kk) {
                const unsigned wd = hv[kk >> 1]; const float a = (kk & 1) ? __uint_as_float(wd & 0xffff0000u) : __uint_as_float(wd << 16);
                const float* wr = w2 + (size_t)(k8 + kk) * 64;
#pragma unroll
                for (int j4 = 0; j4 < 4; ++j4) { const f32x4 w = *(const f32x4*)(wr + j4 * 4);
                    o[j4 * 4 + 0] += a * w.x; o[j4 * 4 + 1] += a * w.y; o[j4 * 4 + 2] += a * w.z; o[j4 * 4 + 3] += a * w.w; }
            }
        }
        if (sel == 0) { float s = 0.f;
#pragma unroll
            for (int j = 0; j < 16; ++j) s += o[j] * o[j];
            s += __shfl_xor(s, 1); s += __shfl_xor(s, 2);
            const float rstd = rsqrtf(s * (1.f / 64.f) + RMS_EPS);
#pragma unroll
            for (int j = 0; j < 16; ++j) o[j] *= rstd * P.k_norm_w[cq * 16 + j]; }
        const int r = rt * 128 + row;
        if (r < 4088) { const int b = r / 1022, rem = r % 1022, i = rem >> 1, g = rem & 1;
            bf16_t* dst = (bf16_t*)(P.ws + (sel ? WS_VC : WS_KC)) + ((size_t)(b * 2 + g) * 512 + i) * 64 + cq * 16;
            u32x4 w0, w1;
            w0.x = cvtpk(o[0], o[1]); w0.y = cvtpk(o[2], o[3]); w0.z = cvtpk(o[4], o[5]); w0.w = cvtpk(o[6], o[7]);
            w1.x = cvtpk(o[8], o[9]); w1.y = cvtpk(o[10], o[11]); w1.z = cvtpk(o[12], o[13]); w1.w = cvtpk(o[14], o[15]);
            *(u32x4*)dst = w0; *(u32x4*)(dst + 8) = w1; }
    }
    __syncthreads();
}

__device__ __forceinline__ int off_row128(int row, int ch) { return row * 128 + ((ch ^ ((row >> 1) & 7)) << 4); }
__device__ __forceinline__ int off_row256(int row, int ch) { return row * 256 + ((ch ^ (row & 15)) << 4); }
__device__ __forceinline__ int fk_(int r) { return (r & 3) | (((r >> 3) & 1) << 2); }
__device__ __forceinline__ int off_tr256(int row, int col) { return row * 256 + ((((col >> 4) ^ fk_(row)) << 5) + ((col & 15) << 1)); }
constexpr int HL_QT = 0, HL_KT = 16384, HL_KH = 32768, HL_V = 49152, HL_SB = 65536, HL_P = 98304  , HL_TOT = 106496  , HL_RED = 110592  , HL_END = 111104;

template <int MODE> __device__ __forceinline__ void hgrn_unit(const Params& P, LAS unsigned char* lds, int u) {
    const int tid = opaque_tid(), lane = tid & 63, wid = tid >> 6, fr = lane & 15, fq = lane >> 4;
    const int b = u >> 7, h = (u >> 5) & 3, sc = u & 31;
    const bf16_t* hq = (const bf16_t*)(P.ws + WS_HQ); const bf16_t* logf = (const bf16_t*)(P.ws + WS_LOGF);
    const bf16_t* hv = (const bf16_t*)(P.ws + WS_HV); const bf16_t* hg = (const bf16_t*)(P.ws + WS_HG);
    float* HLs = (float*)(P.ws + WS_HL); float* HDs = (float*)(P.ws + WS_HD);
    bf16_t* mix = (bf16_t*)(P.ws + WS_MIX);
    LAS float* tot = (LAS float*)(lds + HL_TOT); LAS float* red = (LAS float*)(lds + HL_RED);
    f32x4 st[8];
#pragma unroll
    for (int vt = 0; vt < 8; ++vt) st[vt] = (f32x4){0.f, 0.f, 0.f, 0.f};
    if (MODE == 1) {
        const float* Lj = HLs + (size_t)u * 16384 + (16 * wid + fr) * 128 + 4 * fq;
#pragma unroll
        for (int vt = 0; vt < 8; ++vt) st[vt] = *(const f32x4*)(Lj + vt * 16);
    }
    float dsum = 0.f;
    const int kp = tid & 63, te = tid >> 6;
    for (int c = 0; c < 4; ++c) {
        const size_t tok0 = (size_t)b * SEQ + sc * 256 + c * 64;
        float lf0[8], lf1[8], cs0[8], cs1[8];
        { float a0 = 0.f, a1 = 0.f;
#pragma unroll
          for (int i = 0; i < 8; ++i) { const unsigned vr = *(const unsigned*)(logf + (tok0 + te * 8 + i) * 512 + h * 128 + 2 * kp); const float vx = __uint_as_float(vr << 16), vy = __uint_as_float(vr & 0xffff0000u); lf0[i] = vx; lf1[i] = vy; a0 += vx; a1 += vy; cs0[i] = a0; cs1[i] = a1; }
          tot[te * 128 + 2 * kp] = a0; tot[te * 128 + 2 * kp + 1] = a1; }
        unsigned qpre[8];
        if (MODE == 1) {
#pragma unroll
            for (int i = 0; i < 8; ++i) qpre[i] = *(const unsigned*)(hq + (tok0 + te * 8 + i) * 512 + h * 128 + 2 * kp);
        }
        u32x2 gpre[4];
        if (MODE == 1) {
#pragma unroll
            for (int i = 0; i < 4; ++i) gpre[i] = *(const u32x2*)(hg + (tok0 + (wid >> 1) * 16 + fr) * 512 + h * 128 + (4 * (wid & 1) + i) * 16 + 4 * fq);
        }
#pragma unroll
        for (int i = 0; i < 2; ++i) { const int pc = tid + NTHREADS * i, row = pc >> 4, c8 = (pc & 15) * 8;
            const u32x4 v = *(const u32x4*)(hv + (tok0 + row) * 512 + h * 128 + c8);
            *(LAS u32x4*)(lds + HL_V + off_tr256(row, c8)) = v; }
        if (MODE == 1 ) {
#pragma unroll
            for (int vt = 0; vt < 8; ++vt) { u32x2 pk; pk.x = cvtpk(st[vt].x, st[vt].y); pk.y = cvtpk(st[vt].z, st[vt].w);
                *(LAS u32x2*)(lds + HL_SB + off_tr256(16 * wid + fr, 16 * vt + 4 * fq)) = pk; }
        }
        __syncthreads();
        float pre0 = 0.f, pre1 = 0.f, last0 = 0.f, last1 = 0.f;
#pragma unroll
        for (int e = 0; e < 8; ++e) { const float t0 = tot[e * 128 + 2 * kp], t1 = tot[e * 128 + 2 * kp + 1]; if (e < te) { pre0 += t0; pre1 += t1; } last0 += t0; last1 += t1; }
#pragma unroll
        for (int i = 0; i < 8; ++i) {
            const int t = te * 8 + i;
            const float c0 = cs0[i] + pre0, c1 = cs1[i] + pre1;
            const float k0 = 1.f - __expf(lf0[i]), k1 = 1.f - __expf(lf1[i]);
            const unsigned khat = cvtpk(k0 * __expf(last0 - c0), k1 * __expf(last1 - c1));
            *(LAS unsigned*)(lds + HL_KH + off_tr256(t, 2 * kp)) = khat;
            if (MODE == 1) {
                const unsigned qraw = qpre[i];
                const float q0 = __uint_as_float(qraw << 16), q1 = __uint_as_float(qraw & 0xffff0000u);
                const unsigned qt = cvtpk(q0 * __expf(c0), q1 * __expf(c1));
                const unsigned kt = cvtpk(k0 * __expf(fminf(-c0, 80.f)), k1 * __expf(fminf(-c1, 80.f)));
                const int o = off_row256(t, kp >> 2) + ((kp & 3) << 2);
                *(LAS unsigned*)(lds + HL_QT + o) = qt; *(LAS unsigned*)(lds + HL_KT + o) = kt;
            }
        }
        const float dec = __expf(tot[0 * 128 + 16 * wid + fr] + tot[1 * 128 + 16 * wid + fr] + tot[2 * 128 + 16 * wid + fr] + tot[3 * 128 + 16 * wid + fr]
                                 + tot[4 * 128 + 16 * wid + fr] + tot[5 * 128 + 16 * wid + fr] + tot[6 * 128 + 16 * wid + fr] + tot[7 * 128 + 16 * wid + fr]);
        if (MODE == 0 && tid < 128) { float s = 0.f;
#pragma unroll
            for (int e = 0; e < 8; ++e) s += tot[e * 128 + tid];
            dsum += s; }
        __syncthreads();
        f32x4 oacc[4];
        if (MODE == 1) {
            { const int tt = wid & 3;
#pragma unroll
              for (int si = 0; si < 2; ++si) { const int stl = 2 * (wid >> 2) + si;
                  f32x4 sacc = (f32x4){0.f, 0.f, 0.f, 0.f};
                  if (stl <= tt) {
#pragma unroll
                      for (int ks = 0; ks < 4; ++ks) {
                          const bf16x8 a = *(const LAS bf16x8*)(lds + HL_KT + off_row256(stl * 16 + fr, ks * 4 + fq));
                          const bf16x8 bq = *(const LAS bf16x8*)(lds + HL_QT + off_row256(tt * 16 + fr, ks * 4 + fq));
                          sacc = __builtin_amdgcn_mfma_f32_16x16x32_bf16(a, bq, sacc, 0, 0, 0);
                      }
                  }
                  const int t = tt * 16 + fr, s0 = stl * 16 + 4 * fq;
                  u32x2 pk; pk.x = cvtpk(s0 + 0 <= t ? sacc.x : 0.f, s0 + 1 <= t ? sacc.y : 0.f); pk.y = cvtpk(s0 + 2 <= t ? sacc.z : 0.f, s0 + 3 <= t ? sacc.w : 0.f);
                  *(LAS u32x2*)(lds + HL_P + off_row128(t, s0 >> 3) + ((s0 & 7) << 1)) = pk; }
            }
            __syncthreads();
            { const int tt = wid >> 1;
#pragma unroll
              for (int i = 0; i < 4; ++i) { const int vt = 4 * (wid & 1) + i;
                  f32x4 a = (f32x4){0.f, 0.f, 0.f, 0.f};
#pragma unroll
                  for (int ks = 0; ks < 2; ++ks) {
                      const int kr = ks * 32 + 8 * fq + (fr >> 2);
                      const s16x4 lo = lds_tr(lds + HL_V + off_tr256(kr, vt * 16 + 4 * (fr & 3))), hi = lds_tr(lds + HL_V + off_tr256(kr + 4, vt * 16 + 4 * (fr & 3)));
                      const bf16x8 va = (bf16x8){lo[0], lo[1], lo[2], lo[3], hi[0], hi[1], hi[2], hi[3]};
                      const bf16x8 pb = *(const LAS bf16x8*)(lds + HL_P + off_row128(tt * 16 + fr, ks * 4 + fq));
                      a = __builtin_amdgcn_mfma_f32_16x16x32_bf16(va, pb, a, 0, 0, 0);
                  }
#pragma unroll
                  for (int ks = 0; ks < 4; ++ks) {
                      const int kr = ks * 32 + 8 * fq + (fr >> 2);
                      const s16x4 lo = lds_tr(lds + HL_SB + off_tr256(kr, vt * 16 + 4 * (fr & 3))), hi = lds_tr(lds + HL_SB + off_tr256(kr + 4, vt * 16 + 4 * (fr & 3)));
                      const bf16x8 sa = (bf16x8){lo[0], lo[1], lo[2], lo[3], hi[0], hi[1], hi[2], hi[3]};
                      const bf16x8 qb = *(const LAS bf16x8*)(lds + HL_QT + off_row256(tt * 16 + fr, ks * 4 + fq));
                      a = __builtin_amdgcn_mfma_f32_16x16x32_bf16(sa, qb, a, 0, 0, 0);
                  }
                  const u32x2 gr = gpre[i];
                  a.x *= __uint_as_float(gr.x << 16); a.y *= __uint_as_float(gr.x & 0xffff0000u); a.z *= __uint_as_float(gr.y << 16); a.w *= __uint_as_float(gr.y & 0xffff0000u);
                  oacc[i] = a; }
              float ss = 0.f;
#pragma unroll
              for (int i = 0; i < 4; ++i) ss += (oacc[i].x * oacc[i].x + oacc[i].y * oacc[i].y) + (oacc[i].z * oacc[i].z + oacc[i].w * oacc[i].w);
              ss += __shfl_xor(ss, 16); ss += __shfl_xor(ss, 32);
              if (fq == 0) red[(tt * 2 + (wid & 1)) * 16 + fr] = ss; }
        }
#pragma unroll
        for (int vt = 0; vt < 8; ++vt) {
            f32x4 a = st[vt] * dec;
#pragma unroll
            for (int ks = 0; ks < 2; ++ks) {
                const int kr = ks * 32 + 8 * fq + (fr >> 2);
                const s16x4 lo = lds_tr(lds + HL_V + off_tr256(kr, vt * 16 + 4 * (fr & 3))), hi = lds_tr(lds + HL_V + off_tr256(kr + 4, vt * 16 + 4 * (fr & 3)));
                const bf16x8 va = (bf16x8){lo[0], lo[1], lo[2], lo[3], hi[0], hi[1], hi[2], hi[3]};
                const s16x4 lo2 = lds_tr(lds + HL_KH + off_tr256(kr, wid * 16 + 4 * (fr & 3))), hi2 = lds_tr(lds + HL_KH + off_tr256(kr + 4, wid * 16 + 4 * (fr & 3)));
                const bf16x8 kb = (bf16x8){lo2[0], lo2[1], lo2[2], lo2[3], hi2[0], hi2[1], hi2[2], hi2[3]};
                a = __builtin_amdgcn_mfma_f32_16x16x32_bf16(va, kb, a, 0, 0, 0);
            }
            st[vt] = a;
        }
        __syncthreads();
        if (MODE == 1) {
            const int tt = wid >> 1; const float ssum = red[(tt * 2) * 16 + fr] + red[(tt * 2 + 1) * 16 + fr];
            const float rstd = rsqrtf(ssum * (1.f / 128.f) + RMS_EPS);
#pragma unroll
            for (int i = 0; i < 4; ++i) { const int v = (4 * (wid & 1) + i) * 16 + 4 * fq; const f32x4 w = *(const f32x4*)(P.rec_out_norm_w + h * 128 + v);
                u32x2 pk; pk.x = cvtpk(oacc[i].x * rstd * w.x, oacc[i].y * rstd * w.y); pk.y = cvtpk(oacc[i].z * rstd * w.z, oacc[i].w * rstd * w.w);
                *(u32x2*)(mix + (tok0 + tt * 16 + fr) * 1024 + 512 + h * 128 + v) = pk; }
        }
    }
    if (MODE == 0) {
#pragma unroll
        for (int vt = 0; vt < 8; ++vt) *(f32x4*)(HLs + (size_t)u * 16384 + (16 * wid + fr) * 128 + vt * 16 + 4 * fq) = st[vt];
        if (tid < 128) HDs[(size_t)u * 128 + tid] = __expf(dsum);
    }
    __syncthreads();
}


__device__ __forceinline__ void phase_hgrn_prefix(const Params& P) {
    float* HLs = (float*)(P.ws + WS_HL); const float* HDs = (const float*)(P.ws + WS_HD);
    const int gt = blockIdx.x * NTHREADS + threadIdx.x, NG = gridDim.x * NTHREADS;
    for (int e = gt; e < 16 * 4096; e += NG) {
        const int bh = e >> 12, q = e & 4095, kk = q >> 5;
        float* base = HLs + (size_t)bh * 32 * 16384 + q * 4; const float* db = HDs + (size_t)bh * 32 * 128 + kk;
        f32x4 s = (f32x4){0.f, 0.f, 0.f, 0.f};
#pragma unroll 1
        for (int g8 = 0; g8 < 32; g8 += 8) { f32x4 l[8]; float d[8];
#pragma unroll
            for (int j = 0; j < 8; ++j) { l[j] = *(const f32x4*)(base + (size_t)(g8 + j) * 16384); d[j] = db[(g8 + j) * 128]; }
#pragma unroll
            for (int j = 0; j < 8; ++j) { *(f32x4*)(base + (size_t)(g8 + j) * 16384) = s; s = s * d[j] + l[j]; } }
    }
}

constexpr int NL_K = 0, NL_V = 16384, NL_IMP = 32768, NL_IMP_STRIDE = 132, NL_SELM = NL_IMP + 8 * 8 * NL_IMP_STRIDE * 4, NL_END = NL_SELM + 1024;
__device__ __forceinline__ int off_v128(int row, int ch) { return row * 128 + ((ch ^ ((row & 3) << 1)) << 4); }
#define MFMA32(a, b, c) __builtin_amdgcn_mfma_f32_32x32x16_bf16(a, b, c, 0, 0, 0)

struct NsaLane { int t; float sl2; int qi; unsigned long long mlo, mhi; };

template <int MODE> __device__ __forceinline__ void nsa_pass(LAS unsigned char* lds, const bf16_t* Kg, const bf16_t* Vg, int rs, unsigned long long ulo, unsigned long long uhi,
                                                            const bf16x8 (&qf)[4], const NsaLane& L, float inv, float& lsum, f32x16 (&O)[2], LAS float* impw) {
    const int tid = opaque_tid(), lane = tid & 63, hi = lane >> 5, c = lane & 31;
    const int ld_row = tid >> 3, ld_ch = tid & 7;
    const int kw_off = off_row128(ld_row, ld_ch), vw_off = off_v128(ld_row, ld_ch);
    u32x4 k0, v0, k1, v1, k2, v2;
    auto next = [&](int jj) -> int { ++jj; if (jj < 64) { const unsigned long long m = ulo >> jj; if (m) return jj + __builtin_ctzll(m); jj = 64; }
                                     if (jj < 128) { const unsigned long long m = uhi >> (jj - 64); if (m) return jj + __builtin_ctzll(m); } return 128; };
    int jA = next(-1), jB = jA < 128 ? next(jA) : 128, jC = jB < 128 ? next(jB) : 128;
    const int jsafe = jA < 128 ? jA : 0;
    auto ldk = [&](int jj) -> u32x4 { const int q = jj < 128 ? jj : jsafe; return *(const u32x4*)(Kg + (size_t)(q * 64 + ld_row) * rs + ld_ch * 8); };
    auto ldv = [&](int jj) -> u32x4 { const int q = jj < 128 ? jj : jsafe; return *(const u32x4*)(Vg + (size_t)(q * 64 + ld_row) * rs + ld_ch * 8); };
    k0 = ldk(jA); k1 = ldk(jB); k2 = ldk(jC);
    if (MODE != 0) { v0 = ldv(jA); v1 = ldv(jB); v2 = ldv(jC); }
    int it = 0;
    auto step = [&](u32x4& kreg, u32x4& vreg) {
        const int j = jA;
        LAS unsigned char* kb = lds + NL_K + (it & 1) * 8192; LAS unsigned char* vb = lds + NL_V + (it & 1) * 8192;
        *(LAS u32x4*)(kb + kw_off) = kreg; if (MODE != 0) *(LAS u32x4*)(vb + vw_off) = vreg;
        const int jD = jC < 128 ? next(jC) : 128;
        kreg = ldk(jD); if (MODE != 0) vreg = ldv(jD);
        __syncthreads();
        bool need = true; bool selbit = true;
        if (MODE == 2) { selbit = (j < 64 ? (L.mlo >> j) : (L.mhi >> (j - 64))) & 1ull; need = __any(selbit); }
        if (need) {
            f32x16 p0 = {}, p1 = {};
#pragma unroll
            for (int ks = 0; ks < 4; ++ks) {
                const bf16x8 a0 = *(const LAS bf16x8*)(kb + off_row128(c, 2 * ks + hi)), a1 = *(const LAS bf16x8*)(kb + off_row128(32 + c, 2 * ks + hi));
                p0 = MFMA32(a0, qf[ks], p0); p1 = MFMA32(a1, qf[ks], p1);
            }
            const int stride = (MODE <= 1) ? 16 : 1;
            const int dl = (MODE <= 1) ? (L.t - 31 - 16 * (j * 64 + 4 * hi)) : (L.t - (j * 64 + 4 * hi));
            const float nb = -L.sl2 * (float)dl, sls = L.sl2 * (float)stride;
            float rs_ = 0.f;
#pragma unroll
            for (int r = 0; r < 16; ++r) {
                const int ro0 = (r & 3) + 8 * (r >> 2), ro1 = ro0 + 32;
                const int d0 = dl - stride * ro0, d1 = dl - stride * ro1;
                bool v0 = d0 >= 0, v1 = d1 >= 0;
                if (MODE == 3) { v0 = v0 && d0 < 512; v1 = v1 && d1 < 512; }
                if (MODE == 2) { v0 = v0 && selbit; v1 = v1 && selbit; }
                float e0 = __builtin_amdgcn_exp2f(__builtin_fmaf(p0[r], LOG2E, __builtin_fmaf(sls, (float)ro0, nb)));
                float e1 = __builtin_amdgcn_exp2f(__builtin_fmaf(p1[r], LOG2E, __builtin_fmaf(sls, (float)ro1, nb)));
                e0 = v0 ? e0 : 0.f; e1 = v1 ? e1 : 0.f;
                if (MODE == 1) { e0 *= inv; e1 *= inv; }
                p0[r] = e0; p1[r] = e1; rs_ += e0 + e1;
            }
            lsum += rs_;
            if (MODE == 1) {
#pragma unroll
                for (int kt = 0; kt < 2; ++kt)
#pragma unroll
                    for (int i = 0; i < 4; ++i) {
                        float g = kt ? (p1[4 * i] + p1[4 * i + 1]) + (p1[4 * i + 2] + p1[4 * i + 3]) : (p0[4 * i] + p0[4 * i + 1]) + (p0[4 * i + 2] + p0[4 * i + 3]);
                        float l3 = kt ? p1[4 * i + 3] : p0[4 * i + 3];
                        g += __shfl_xor(g, 1); g += __shfl_xor(g, 2); l3 += __shfl_xor(l3, 1); l3 += __shfl_xor(l3, 2);
                        if ((c & 3) == 0) { const int jj = j * 16 + kt * 8 + 2 * i + hi; __hip_atomic_fetch_add(impw + L.qi * NL_IMP_STRIDE + jj, g, __ATOMIC_RELAXED, __HIP_MEMORY_SCOPE_WORKGROUP); __hip_atomic_fetch_add(impw + L.qi * NL_IMP_STRIDE + jj + 1, l3, __ATOMIC_RELAXED, __HIP_MEMORY_SCOPE_WORKGROUP); }
                    }
            }
            if (MODE != 0) {
                bf16x8 pf[4];
#pragma unroll
                for (int s4 = 0; s4 < 4; ++s4) { u32x4 w;
#pragma unroll
                    for (int e = 0; e < 4; ++e) { const int r = 8 * (s4 & 1) + 2 * e; w[e] = (s4 >> 1) ? cvtpk(p1[r], p1[r + 1]) : cvtpk(p0[r], p0[r + 1]); }
                    pf[s4] = __builtin_bit_cast(bf16x8, w); }
                const int g4 = lane >> 4, sub = g4 & 1, i16 = lane & 15, qq = i16 >> 2, pp = i16 & 3;
#pragma unroll
                for (int dt = 0; dt < 2; ++dt)
#pragma unroll
                    for (int s4 = 0; s4 < 4; ++s4) {
                        const int row = 16 * s4 + 4 * hi + qq, ch = 4 * dt + 2 * sub + (pp >> 1);
                        const s16x4 lo = lds_tr(vb + off_v128(row, ch) + 8 * (pp & 1)), hh = lds_tr(vb + off_v128(row + 8, ch) + 8 * (pp & 1));
                        const bf16x8 vf = (bf16x8){lo[0], lo[1], lo[2], lo[3], hh[0], hh[1], hh[2], hh[3]};
                        O[dt] = MFMA32(vf, pf[s4], O[dt]);
                    }
            }
        }
        jA = jB; jB = jC; jC = jD; ++it;
    };
    while (jA < 128) {
        step(k0, v0); if (jA >= 128) break;
        step(k1, v1); if (jA >= 128) break;
        step(k2, v2);
    }
    __syncthreads();
}

__device__ __forceinline__ void nsa_unit(const Params& P, LAS unsigned char* lds, int u) {
    const int tid = opaque_tid(), lane = tid & 63, wid = tid >> 6, hi = lane >> 5, c = lane & 31;
    const int b = u >> 8, g = (u >> 7) & 1, qb = u & 127;
    const bf16_t* qg = (const bf16_t*)(P.ws + WS_Q); const bf16_t* kv = (const bf16_t*)(P.ws + WS_KV);
    const bf16_t* kcn = (const bf16_t*)(P.ws + WS_KC) + (size_t)(b * 2 + g) * 512 * 64; const bf16_t* vcc = (const bf16_t*)(P.ws + WS_VC) + (size_t)(b * 2 + g) * 512 * 64;
    const float* gates = (const float*)(P.ws + WS_GATES); bf16_t* mix = (bf16_t*)(P.ws + WS_MIX);
    LAS float* impw = (LAS float*)(lds + NL_IMP) + wid * 8 * NL_IMP_STRIDE;
    LAS unsigned long long* selm = (LAS unsigned long long*)(lds + NL_SELM);
    NsaLane L; L.qi = c >> 2; const int hh = c & 3, head = g * 4 + hh;
    L.t = qb * 64 + wid * 8 + L.qi; L.sl2 = exp2f(-(float)(head + 1)) * LOG2E; L.mlo = 0; L.mhi = 0;
    const size_t tok = (size_t)b * SEQ + L.t;
    bf16x8 qf[4];
#pragma unroll
    for (int ks = 0; ks < 4; ++ks) qf[ks] = *(const bf16x8*)(qg + tok * 512 + head * 64 + 16 * ks + 8 * hi);
    for (int i = lane; i < 8 * NL_IMP_STRIDE; i += 64) impw[i] = 0.f;
    const int ncmp = qb * 4 + 3 < 511 ? qb * 4 + 3 : 511;
    const int nblk = (ncmp + 63) >> 6;
    const unsigned long long cm = nblk >= 64 ? ~0ull : ((1ull << nblk) - 1ull);
    f32x16 O[2], Ot[2]; float lsum = 0.f;
    O[0] = f32x16{}; O[1] = f32x16{};
    nsa_pass<0>(lds, kcn, vcc, 64, cm, 0ull, qf, L, 1.f, lsum, O, impw);
    lsum += __shfl_xor(lsum, 32);
    const float invc = 1.0f / fmaxf(lsum, 1e-30f);
    float dummy = 0.f;
    nsa_pass<1>(lds, kcn, vcc, 64, cm, 0ull, qf, L, invc, dummy, O, impw);
    const float* gt = gates + tok * 24 + g * 12 + hh * 3;
    const float g0 = gt[0], g1 = gt[1], g2 = gt[2];
#pragma unroll
    for (int dt = 0; dt < 2; ++dt) Ot[dt] = O[dt] * g0;
    {
        const int ncausal = qb + 1;
        for (int qi = 0; qi < 8; ++qi) {
            unsigned long long lo, hi64;
            if (ncausal <= 16) { lo = (1ull << ncausal) - 1ull; hi64 = 0ull; }
            else {
                const int j0 = lane, j1 = lane + 64;
                const bool f0 = (j0 == 0) || (j0 == qb) || (j0 == qb - 1), f1 = (j1 == qb) || (j1 == qb - 1);
                const unsigned k0 = (j0 <= qb && !f0) ? (0x80000000u | (__float_as_uint(impw[qi * NL_IMP_STRIDE + j0]) & 0x7fffff80u) | (unsigned)j0) : 0u;
                const unsigned k1 = (j1 <= qb && !f1) ? (0x80000000u | (__float_as_uint(impw[qi * NL_IMP_STRIDE + j1]) & 0x7fffff80u) | (unsigned)j1) : 0u;
                const int needn = 13;
                unsigned th = 0u;
                for (int bit = 31; bit >= 0; --bit) { const unsigned cand = th | (1u << bit);
                    const int cnt = __popcll(__ballot(k0 >= cand)) + __popcll(__ballot(k1 >= cand));
                    if (cnt >= needn) th = cand; }
                lo = __ballot(f0 || (k0 >= th && k0 != 0u)); hi64 = __ballot(f1 || (k1 >= th && k1 != 0u));
            }
            if (lane == 0) { selm[(wid * 8 + qi) * 2] = lo; selm[(wid * 8 + qi) * 2 + 1] = hi64; }
        }
    }
    __syncthreads();
    unsigned long long ulo = selm[lane * 2], uhi = selm[lane * 2 + 1];
#pragma unroll
    for (int o = 1; o < 64; o <<= 1) { ulo |= __shfl_xor(ulo, o); uhi |= __shfl_xor(uhi, o); }
    L.mlo = selm[(wid * 8 + L.qi) * 2]; L.mhi = selm[(wid * 8 + L.qi) * 2 + 1];
    const bf16_t* kvb = kv + (size_t)b * SEQ * 768 + g * 64;
    O[0] = f32x16{}; O[1] = f32x16{}; lsum = 0.f;
    nsa_pass<2>(lds, kvb + 256, kvb + 384, 768, ulo, uhi, qf, L, 1.f, lsum, O, impw);
    lsum += __shfl_xor(lsum, 32);
    { const float sc = g1 / fmaxf(lsum, 1e-30f);
#pragma unroll
      for (int dt = 0; dt < 2; ++dt) Ot[dt] += O[dt] * sc; }
    {
        const int jlo = qb >= 8 ? qb - 8 : 0;
        unsigned long long wlo = 0ull, whi = 0ull;
        for (int jj = jlo; jj <= qb; ++jj) { if (jj < 64) wlo |= 1ull << jj; else whi |= 1ull << (jj - 64); }
        O[0] = f32x16{}; O[1] = f32x16{}; lsum = 0.f;
        nsa_pass<3>(lds, kvb + 512, kvb + 640, 768, wlo, whi, qf, L, 1.f, lsum, O, impw);
        lsum += __shfl_xor(lsum, 32);
        const float sc = g2 / fmaxf(lsum, 1e-30f);
#pragma unroll
        for (int dt = 0; dt < 2; ++dt) Ot[dt] += O[dt] * sc;
    }
    float ss = 0.f;
#pragma unroll
    for (int dt = 0; dt < 2; ++dt)
#pragma unroll
        for (int r = 0; r < 16; ++r) ss += Ot[dt][r] * Ot[dt][r];
    ss += __shfl_xor(ss, 32);
    const float rstd = rsqrtf(ss * (1.f / 64.f) + RMS_EPS);
#pragma unroll
    for (int dt = 0; dt < 2; ++dt)
#pragma unroll
        for (int r4 = 0; r4 < 4; ++r4) { const int d = 32 * dt + 8 * r4 + 4 * hi; const f32x4 w = *(const f32x4*)(P.attn_out_norm_w + head * 64 + d);
            u32x2 pk; pk.x = cvtpk(Ot[dt][4 * r4] * rstd * w.x, Ot[dt][4 * r4 + 1] * rstd * w.y); pk.y = cvtpk(Ot[dt][4 * r4 + 2] * rstd * w.z, Ot[dt][4 * r4 + 3] * rstd * w.w);
            *(u32x2*)(mix + tok * 1024 + head * 64 + d) = pk; }
    __syncthreads();
}


__device__ __forceinline__ int gu_hcol(int m0) { const int ni = (m0 >> 4) & 7; return 64 * (m0 >> 7) + 32 * (ni >> 2) + 8 * ((m0 & 15) >> 2) + 4 * ((ni >> 1) & 1); }
__device__ __forceinline__ int p2_col(int m0) { const int ni = (m0 >> 4) & 7; return 128 * (m0 >> 7) + 32 * (ni >> 1) + 8 * ((m0 & 15) >> 2) + 4 * (ni & 1); }
__device__ __forceinline__ void phase_cvt_small(const Params& P) {
    const int tid = threadIdx.x;
    {
        const int gt = blockIdx.x * NTHREADS + tid, NG = gridDim.x * NTHREADS;
        bf16_t* wo = (bf16_t*)(P.ws + WS_WOUT); bf16_t* wrs = (bf16_t*)(P.ws + WS_WRS); bf16_t* wsd = (bf16_t*)(P.ws + WS_WSD);
        for (int i = gt; i < 1024 * 128; i += NG) { const int k = i >> 7, m0 = (i & 127) * 8; const float* s = P.w_out + (size_t)k * 1024 + (m0 & ~255) + p2_col(m0 & 255);
            const f32x4 a = *(const f32x4*)s, b2 = *(const f32x4*)(s + 8);
            *(u32x4*)(wo + (size_t)i * 8) = (u32x4){cvtpk(a.x, a.y), cvtpk(a.z, a.w), cvtpk(b2.x, b2.y), cvtpk(b2.z, b2.w)}; }
        for (int i = gt; i < 256 * 128; i += NG) { const int k = i >> 7, m0 = (i & 127) * 8; const float* s = P.sh_wd + (size_t)k * 1024 + (m0 & ~255) + p2_col(m0 & 255);
            const f32x4 a = *(const f32x4*)s, b2 = *(const f32x4*)(s + 8);
            *(u32x4*)(wsd + (size_t)i * 8) = (u32x4){cvtpk(a.x, a.y), cvtpk(a.z, a.w), cvtpk(b2.x, b2.y), cvtpk(b2.z, b2.w)}; }
        for (int i = gt; i < 1024 * 96; i += NG) { const int k = i / 96, c8 = (i % 96) * 8;
            const float* s; int d2 = 4;
            if (c8 < 256) s = P.router_w + (size_t)k * 256 + c8;
            else { const int cc = c8 - 256, t = cc >> 8; s = ((cc & 16) ? P.sh_wu : P.sh_wg) + (size_t)k * 256 + t * 128 + gu_hcol(cc & 255); d2 = 8; }
            const f32x4 a = *(const f32x4*)s, b2 = *(const f32x4*)(s + d2);
            *(u32x4*)(wrs + (size_t)k * 768 + c8) = (u32x4){cvtpk(a.x, a.y), cvtpk(a.z, a.w), cvtpk(b2.x, b2.y), cvtpk(b2.z, b2.w)}; }
    }
}

__device__ __forceinline__ void route_token(const Params& P, int t, int lane) {
    const float* scores = (const float*)(P.ws + WS_SCORES) + (size_t)t * 256;
    const f32x4 s4 = *(const f32x4*)(scores + 4 * lane); const f32x4 b4 = *(const f32x4*)(P.router_bias + 4 * lane);
    float sc[4] = {s4.x, s4.y, s4.z, s4.w};
    float bs[4] = {s4.x + b4.x, s4.y + b4.y, s4.z + b4.z, s4.w + b4.w};
    float m1 = fmaxf(bs[0], bs[1]), m2 = fminf(bs[0], bs[1]);
    { const float v = bs[2]; const float n1 = fmaxf(m1, v); m2 = fmaxf(fminf(m1, v), m2); m1 = n1; }
    { const float v = bs[3]; const float n1 = fmaxf(m1, v); m2 = fmaxf(fminf(m1, v), m2); m1 = n1; }
#pragma unroll
    for (int o = 1; o < 8; o <<= 1) { const float o1 = __shfl_xor(m1, o), o2 = __shfl_xor(m2, o); const float n1 = fmaxf(m1, o1); m2 = fmaxf(fminf(m1, o1), fmaxf(m2, o2)); m1 = n1; }
    const float gs = m1 + m2;
    const int grp = lane >> 3;
    int rank = 0;
#pragma unroll
    for (int g2 = 0; g2 < 8; ++g2) { const float og = __shfl(gs, g2 * 8); rank += (og > gs || (og == gs && g2 < grp)) ? 1 : 0; }
    const bool gsel = rank < 4;
    float mv[4];
#pragma unroll
    for (int i = 0; i < 4; ++i) mv[i] = gsel ? bs[i] : -INFINITY;
    int myidx = -1; float myw = 0.f; float wsum = 0.f;
#pragma unroll 1
    for (int k = 0; k < 8; ++k) {
        float bv = mv[0]; int bi = 4 * lane;
#pragma unroll
        for (int i = 1; i < 4; ++i) if (mv[i] > bv) { bv = mv[i]; bi = 4 * lane + i; }
#pragma unroll
        for (int o = 1; o < 64; o <<= 1) { const float ov = __shfl_xor(bv, o); const int oi = __shfl_xor(bi, o); if (ov > bv || (ov == bv && oi < bi)) { bv = ov; bi = oi; } }
        const int wl = bi >> 2, wc = bi & 3;
        const float mine = wc == 0 ? sc[0] : (wc == 1 ? sc[1] : (wc == 2 ? sc[2] : sc[3]));
        const float wv = __shfl(mine, wl);
        wsum += wv;
        if (lane == k) { myidx = bi; myw = wv; }
        if (lane == wl) {
#pragma unroll
            for (int i = 0; i < 4; ++i) if (i == wc) mv[i] = -INFINITY; }
    }
    if (lane < 8) {
        int* cnt = (int*)(P.ws + WS_CTL + CTL_CNT);
        const int pos = atomicAdd(cnt + myidx, 1);
        if (pos < BCAP) ((int*)(P.ws + WS_BUCKET))[(size_t)myidx * BCAP + pos] = t * 8 + lane;
        ((float*)(P.ws + WS_RW))[(size_t)t * 8 + lane] = myw / wsum * 2.5f;
    }
}


__device__ __forceinline__ void phase_p4a(const Params& P, LAS unsigned char* lds) {
    typedef Gemm3 G;
    const int tid = opaque_tid(), lane = tid & 63, wid = tid >> 6, wm = wid >> 1, wn = wid & 1, fr = lane & 15, fq = lane >> 4;
    struct F { const Params& P;
        __device__ __forceinline__ void ptrs(int seg, const bf16_t* (&aptr)[2], const bf16_t* (&bptr)[2]) const {
            const int tid = opaque_tid(), lane = tid & 63, wid = tid >> 6, wm = wid >> 1, wn = wid & 1, fr = lane & 15, fq = lane >> 4, c8 = 8 * (tid & 31); (void)wm; (void)wn; (void)fr; (void)fq; (void)c8;
            const int u = blockIdx.x + seg * gridDim.x, rt = u >> 2, ct = u & 3;
            const bf16_t* mix = (const bf16_t*)(P.ws + WS_MIX); const bf16_t* wo = (const bf16_t*)(P.ws + WS_WOUT);
#pragma unroll
            for (int i = 0; i < 2; ++i) { const int row = G::a_row(i, wid, lane); aptr[i] = mix + (size_t)(rt * 256 + row) * 1024 + G::a_chunk(row, lane) * 8;
                const int k = G::b_k(i, wid, lane); bptr[i] = wo + (size_t)k * 1024 + ct * 256 + G::b_n(k, lane); } }
        __device__ __forceinline__ void epi(int seg, f32x4 (&acc)[4][8]) const {
            const int tid = opaque_tid(), lane = tid & 63, wid = tid >> 6, wm = wid >> 1, wn = wid & 1, fr = lane & 15, fq = lane >> 4, c8 = 8 * (tid & 31); (void)wm; (void)wn; (void)fr; (void)fq; (void)c8;
            const int u = blockIdx.x + seg * gridDim.x, rt = u >> 2, ct = u & 3, b = (rt * 256) / SEQ;
            const float* mod = (const float*)(P.ws + WS_MOD) + b * 6144; float* ssp = (float*)(P.ws + WS_SS); bf16_t* x1 = (bf16_t*)(P.ws + WS_X1);
#pragma unroll
            for (int mi = 0; mi < 4; ++mi) { const size_t m = (size_t)(rt * 256 + wm * 64 + mi * 16 + fr); float ss = 0.f;
#pragma unroll
                for (int j = 0; j < 4; ++j) { const int col = ct * 256 + wn * 128 + j * 32 + 8 * fq;
                    const f32x4 xv = *(const f32x4*)(P.x + m * 1024 + col), xw = *(const f32x4*)(P.x + m * 1024 + col + 4), gv = *(const f32x4*)(mod + 2048 + col), gw = *(const f32x4*)(mod + 2048 + col + 4);
                    const f32x4 a = acc[mi][2 * j], c = acc[mi][2 * j + 1];
                    f32x4 o, o2; o.x = xv.x + gv.x * a.x; o.y = xv.y + gv.y * a.y; o.z = xv.z + gv.z * a.z; o.w = xv.w + gv.w * a.w;
                    o2.x = xw.x + gw.x * c.x; o2.y = xw.y + gw.y * c.y; o2.z = xw.z + gw.z * c.z; o2.w = xw.w + gw.w * c.w;
                    *(u32x4*)(x1 + m * 1024 + col) = (u32x4){cvtpk(o.x, o.y), cvtpk(o.z, o.w), cvtpk(o2.x, o2.y), cvtpk(o2.z, o2.w)};
                    ss += ((o.x * o.x + o.y * o.y) + (o.z * o.z + o.w * o.w)) + ((o2.x * o2.x + o2.y * o2.y) + (o2.z * o2.z + o2.w * o2.w)); if (j & 1) asm volatile("" ::: "memory"); }
                ss += __shfl_xor(ss, 16); ss += __shfl_xor(ss, 32);
                if (fq == 0) ssp[m * 8 + ct * 2 + wn] = ss; } }
    } f{P};
    const int nu = (128 * 4 - (int)blockIdx.x + (int)gridDim.x - 1) / (int)gridDim.x;
    if (nu > 0) G::run_stream(f, nu, 32, 32, (size_t)32 * 1024, lds);
}
__device__ __forceinline__ void phase_p4b(const Params& P) {
    const int lane = threadIdx.x & 63, gw = blockIdx.x * (NTHREADS / 64) + (threadIdx.x >> 6), NGW = gridDim.x * (NTHREADS / 64);
    const float* ssp = (const float*)(P.ws + WS_SS); bf16_t* h2 = (bf16_t*)(P.ws + WS_H);
    for (int m = gw; m < T; m += NGW) {
        const float* mod = (const float*)(P.ws + WS_MOD) + (m / SEQ) * 6144;
        const f32x4 s0 = *(const f32x4*)(ssp + (size_t)m * 8), s1 = *(const f32x4*)(ssp + (size_t)m * 8 + 4);
        const float rstd = rsqrtf(((s0.x + s0.y) + (s0.z + s0.w) + (s1.x + s1.y) + (s1.z + s1.w)) * (1.f / 1024.f) + RMS_EPS);
#pragma unroll
        for (int j = 0; j < 4; ++j) { const int col = (lane + 64 * j) * 4;
            const u32x2 xr = *(const u32x2*)((const bf16_t*)(P.ws + WS_X1) + (size_t)m * 1024 + col);
            const f32x4 v = (f32x4){__uint_as_float(xr.x << 16), __uint_as_float(xr.x & 0xffff0000u), __uint_as_float(xr.y << 16), __uint_as_float(xr.y & 0xffff0000u)}, wv = *(const f32x4*)(P.norm2_w + col), scv = *(const f32x4*)(mod + 4096 + col), shv = *(const f32x4*)(mod + 3072 + col);
            const float r0 = v.x * rstd * wv.x * (1.f + scv.x) + shv.x, r1 = v.y * rstd * wv.y * (1.f + scv.y) + shv.y, r2 = v.z * rstd * wv.z * (1.f + scv.z) + shv.z, r3 = v.w * rstd * wv.w * (1.f + scv.w) + shv.w;
            u32x2 pk; pk.x = cvtpk(r0, r1); pk.y = cvtpk(r2, r3);
            *(u32x2*)(h2 + (size_t)m * 1024 + col) = pk;
            int q8 = __builtin_amdgcn_cvt_pk_fp8_f32(r0, r1, 0, false); q8 = __builtin_amdgcn_cvt_pk_fp8_f32(r2, r3, q8, true);
            *(int*)((unsigned char*)(P.ws + WS_H2Q) + (size_t)m * 1024 + col) = q8; }
    }
}
__device__ __forceinline__ void phase_p4c(const Params& P, LAS unsigned char* lds) {
    typedef Gemm3 G;
    const int tid = opaque_tid(), lane = tid & 63, wid = tid >> 6, wm = wid >> 1, wn = wid & 1, fr = lane & 15, fq = lane >> 4;
    struct F { const Params& P;
        __device__ __forceinline__ void ptrs(int seg, const bf16_t* (&aptr)[2], const bf16_t* (&bptr)[2]) const {
            const int tid = opaque_tid(), lane = tid & 63, wid = tid >> 6, wm = wid >> 1, wn = wid & 1, fr = lane & 15, fq = lane >> 4, c8 = 8 * (tid & 31); (void)wm; (void)wn; (void)fr; (void)fq; (void)c8;
            const int u = blockIdx.x + seg * gridDim.x, rt = u / 3, ct = u % 3;
            const bf16_t* h2 = (const bf16_t*)(P.ws + WS_H); const bf16_t* wrs = (const bf16_t*)(P.ws + WS_WRS);
#pragma unroll
            for (int i = 0; i < 2; ++i) { const int row = G::a_row(i, wid, lane); aptr[i] = h2 + (size_t)(rt * 256 + row) * 1024 + G::a_chunk(row, lane) * 8;
                const int k = G::b_k(i, wid, lane); bptr[i] = wrs + (size_t)k * 768 + ct * 256 + G::b_n(k, lane); } }
        __device__ __forceinline__ void epi(int seg, f32x4 (&acc)[4][8]) const {
            const int tid = opaque_tid(), lane = tid & 63, wid = tid >> 6, wm = wid >> 1, wn = wid & 1, fr = lane & 15, fq = lane >> 4, c8 = 8 * (tid & 31); (void)wm; (void)wn; (void)fr; (void)fq; (void)c8;
            const int u = blockIdx.x + seg * gridDim.x, rt = u / 3, ct = u % 3;
            float* scores = (float*)(P.ws + WS_SCORES); bf16_t* hidS = (bf16_t*)(P.ws + WS_HIDS);
#pragma unroll
            for (int mi = 0; mi < 4; ++mi) { const size_t m = (size_t)(rt * 256 + wm * 64 + mi * 16 + fr);
                if (ct == 0) {
#pragma unroll
                    for (int ni = 0; ni < 8; ++ni) { const f32x4 a = acc[mi][ni];
                        *(f32x4*)(scores + m * 256 + wn * 128 + ni * 16 + 4 * fq) = (f32x4){sigmoidf_(a.x), sigmoidf_(a.y), sigmoidf_(a.z), sigmoidf_(a.w)}; }
                } else {
#pragma unroll
                    for (int j2 = 0; j2 < 2; ++j2) { const f32x4 g = acc[mi][4 * j2], uu = acc[mi][4 * j2 + 1], g2 = acc[mi][4 * j2 + 2], u2 = acc[mi][4 * j2 + 3];
                        u32x4 pk; pk.x = cvtpk(siluf_(g.x) * uu.x, siluf_(g.y) * uu.y); pk.y = cvtpk(siluf_(g.z) * uu.z, siluf_(g.w) * uu.w);
                        pk.z = cvtpk(siluf_(g2.x) * u2.x, siluf_(g2.y) * u2.y); pk.w = cvtpk(siluf_(g2.z) * u2.z, siluf_(g2.w) * u2.w);
                        *(u32x4*)(hidS + m * 256 + (ct - 1) * 128 + wn * 64 + j2 * 32 + 8 * fq) = pk; }
                } } }
    } f{P};
    const int nu = (128 * 3 - (int)blockIdx.x + (int)gridDim.x - 1) / (int)gridDim.x;
    if (nu > 0) G::run_stream(f, nu, 32, 32, (size_t)32 * 768, lds);
}
__device__ __forceinline__ void phase_route(const Params& P) {
    const int tid = opaque_tid(), lane = tid & 63, gw = blockIdx.x * (NTHREADS / 64) + (tid >> 6), NGW = gridDim.x * (NTHREADS / 64);
    for (int t = gw; t < T; t += NGW) route_token(P, t, lane);
}
__device__ __forceinline__ void phase_p4d(const Params& P, LAS unsigned char* lds) {
    typedef Gemm3 G;
    const int tid = opaque_tid(), lane = tid & 63, wid = tid >> 6, wm = wid >> 1, wn = wid & 1, fr = lane & 15, fq = lane >> 4;
    struct F { const Params& P;
        __device__ __forceinline__ void ptrs(int seg, const bf16_t* (&aptr)[2], const bf16_t* (&bptr)[2]) const {
            const int tid = opaque_tid(), lane = tid & 63, wid = tid >> 6, wm = wid >> 1, wn = wid & 1, fr = lane & 15, fq = lane >> 4, c8 = 8 * (tid & 31); (void)wm; (void)wn; (void)fr; (void)fq; (void)c8;
            const int u = blockIdx.x + seg * gridDim.x, rt = u >> 2, ct = u & 3;
            const bf16_t* hidS = (const bf16_t*)(P.ws + WS_HIDS); const bf16_t* wsd = (const bf16_t*)(P.ws + WS_WSD);
#pragma unroll
            for (int i = 0; i < 2; ++i) { const int row = G::a_row(i, wid, lane); aptr[i] = hidS + (size_t)(rt * 256 + row) * 256 + G::a_chunk(row, lane) * 8;
                const int k = G::b_k(i, wid, lane); bptr[i] = wsd + (size_t)k * 1024 + ct * 256 + G::b_n(k, lane); } }
        __device__ __forceinline__ void epi(int seg, f32x4 (&acc)[4][8]) const {
            const int tid = opaque_tid(), lane = tid & 63, wid = tid >> 6, wm = wid >> 1, wn = wid & 1, fr = lane & 15, fq = lane >> 4, c8 = 8 * (tid & 31); (void)wm; (void)wn; (void)fr; (void)fq; (void)c8;
            const int u = blockIdx.x + seg * gridDim.x, rt = u >> 2, ct = u & 3;
            unsigned char* ysh = (unsigned char*)(P.ws + WS_YSH);
#pragma unroll
            for (int mi = 0; mi < 4; ++mi) { const size_t m = (size_t)(rt * 256 + wm * 64 + mi * 16 + fr);
#pragma unroll
                for (int j = 0; j < 4; ++j) { const int col = ct * 256 + wn * 128 + j * 32 + 8 * fq; const f32x4 a = acc[mi][2 * j] * Y_SCALE, c = acc[mi][2 * j + 1] * Y_SCALE;
                    *(u32x2*)(ysh + m * 1024 + col) = (u32x2){pk4_fp8(a.x, a.y, a.z, a.w), pk4_fp8(c.x, c.y, c.z, c.w)}; } } }
    } f{P};
    const int nu = (128 * 4 - (int)blockIdx.x + (int)gridDim.x - 1) / (int)gridDim.x;
    if (nu > 0) G::run_stream(f, nu, 8, 32, (size_t)32 * 1024, lds);
}

__device__ __forceinline__ void phase_expert_cvt(const Params& P) {
    const size_t gt = (size_t)blockIdx.x * NTHREADS + threadIdx.x, NG = (size_t)gridDim.x * NTHREADS;
    bf16_t* wgu = (bf16_t*)(P.ws + WS_WBGU); bf16_t* wd = (bf16_t*)(P.ws + WS_WBD);
    for (size_t i = gt; i < (size_t)256 * 1024 * 64; i += NG) {
        const size_t ek = i >> 6; const int c8 = (int)(i & 63) * 8, t = c8 >> 8;
        const float* s = ((c8 & 16) ? P.exp_wu : P.exp_wg) + ek * 256 + t * 128 + gu_hcol(c8 & 255);
        const f32x4 a = __builtin_nontemporal_load((const f32x4*)s), b2 = __builtin_nontemporal_load((const f32x4*)(s + 8));
        *(u32x4*)(wgu + ek * 512 + c8) = (u32x4){cvtpk(a.x, a.y), cvtpk(a.z, a.w), cvtpk(b2.x, b2.y), cvtpk(b2.z, b2.w)}; }
    for (size_t i = gt; i < (size_t)256 * 256 * 128; i += NG) {
        const size_t ek = i >> 7; const int m0 = (int)(i & 127) * 8, tl = m0 & 255, tile = m0 >> 8;
        const int wnn = tl >> 7, nii = (tl >> 4) & 7, n0 = tl & 15;
        const int ca = tile * 256 + wnn * 128 + 64 * (nii >> 2) + 16 * (n0 >> 2) + 4 * (nii & 3);
        const f32x4 a = __builtin_nontemporal_load((const f32x4*)(P.exp_wd + ek * 1024 + ca)), b2 = __builtin_nontemporal_load((const f32x4*)(P.exp_wd + ek * 1024 + ca + 16));
        *(u32x4*)(wd + ek * 1024 + m0) = (u32x4){cvtpk(a.x, a.y), cvtpk(a.z, a.w), cvtpk(b2.x, b2.y), cvtpk(b2.z, b2.w)}; }
}

constexpr int P6_TILES = 128 * 1024, P6_PRE = P6_TILES + 1024, P6_PAIR = P6_PRE + 1040, P6_W = P6_PAIR + 1024;
__device__ __forceinline__ void phase_experts(const Params& P, LAS unsigned char* lds) {
    typedef Gemm3 G;
    const int tid = opaque_tid(), lane = tid & 63, wid = tid >> 6, wm = wid >> 1, wn = wid & 1, fr = lane & 15, fq = lane >> 4;
    const int* cnt = (const int*)(P.ws + WS_CTL + CTL_CNT); const int* bucket = (const int*)(P.ws + WS_BUCKET); const float* rw = (const float*)(P.ws + WS_RW);
    const bf16_t* h2 = (const bf16_t*)(P.ws + WS_H); bf16_t* hidR = (bf16_t*)(P.ws + WS_HIDR) + (size_t)blockIdx.x * 256 * 256; unsigned char* y = (unsigned char*)(P.ws + WS_Y);
    LAS int* tiles = (LAS int*)(lds + P6_TILES); LAS int* pre = (LAS int*)(lds + P6_PRE); LAS int* pairs = (LAS int*)(lds + P6_PAIR); LAS float* wts = (LAS float*)(lds + P6_W);
    const int nx = (gridDim.x % 8 == 0) ? 8 : 1, xl = blockIdx.x % nx, li = blockIdx.x / nx, nloc = gridDim.x / nx, nek = 256 / nx;
    if (tid < nek) { const int c_ = cnt[xl + nx * tid]; tiles[tid] = ((c_ < BCAP ? c_ : BCAP) + 255) >> 8; }
    __syncthreads();
    if (tid < nek) { int s = 0; for (int i = 0; i < tid; ++i) s += tiles[i]; pre[tid] = s; if (tid == nek - 1) pre[nek] = s + tiles[nek - 1]; }
    __syncthreads();
    const int total = pre[nek];
    const int c8 = 8 * (tid & 31), u16 = c8 >> 4;
    for (int u = li; u < total; u += nloc) {
        int lo = 0, hi = nek - 1;
        while (lo < hi) { const int mid = (lo + hi + 1) >> 1; if (pre[mid] <= u) lo = mid; else hi = mid - 1; }
        const int e = xl + nx * lo, tile = u - pre[lo], n = cnt[e] < BCAP ? cnt[e] : BCAP, rows = (n - tile * 256) < 256 ? (n - tile * 256) : 256;
        if (tid < 256) { const int r = tid < rows ? tid : 0; const int pr = bucket[(size_t)e * BCAP + tile * 256 + r]; pairs[tid] = pr; wts[tid] = tid < rows ? rw[pr] : 0.f; }
        __syncthreads();
        {
            struct GU { const bf16_t* h2; LAS int* pairs; const bf16_t* wgu; bf16_t* hidR;
                __device__ __forceinline__ void ptrs(int t, const bf16_t* (&aptr)[2], const bf16_t* (&bptr)[2]) const {
                    const int tid = opaque_tid(), lane = tid & 63, wid = tid >> 6, wm = wid >> 1, wn = wid & 1, fr = lane & 15, fq = lane >> 4, c8 = 8 * (tid & 31); (void)wm; (void)wn; (void)fr; (void)fq; (void)c8;
#pragma unroll
                    for (int i = 0; i < 2; ++i) { const int row = G::a_row(i, wid, lane); aptr[i] = h2 + (size_t)(pairs[row] >> 3) * 1024 + G::a_chunk(row, lane) * 8;
                        const int k = G::b_k(i, wid, lane); bptr[i] = wgu + (size_t)k * 512 + t * 256 + G::b_n(k, lane); } }
                __device__ __forceinline__ void epi(int t, f32x4 (&acc)[4][8]) const {
                    const int tid = opaque_tid(), lane = tid & 63, wid = tid >> 6, wm = wid >> 1, wn = wid & 1, fr = lane & 15, fq = lane >> 4, c8 = 8 * (tid & 31); (void)wm; (void)wn; (void)fr; (void)fq; (void)c8;
#pragma unroll
                    for (int mi = 0; mi < 4; ++mi) { const int rl = wm * 64 + mi * 16 + fr;
#pragma unroll
                        for (int j2 = 0; j2 < 2; ++j2) { const f32x4 g = acc[mi][4 * j2], uu = acc[mi][4 * j2 + 1], g2 = acc[mi][4 * j2 + 2], u2 = acc[mi][4 * j2 + 3];
                            u32x4 pk; pk.x = cvtpk(siluf_(g.x) * uu.x, siluf_(g.y) * uu.y); pk.y = cvtpk(siluf_(g.z) * uu.z, siluf_(g.w) * uu.w);
                            pk.z = cvtpk(siluf_(g2.x) * u2.x, siluf_(g2.y) * u2.y); pk.w = cvtpk(siluf_(g2.z) * u2.z, siluf_(g2.w) * u2.w);
                            *(u32x4*)(hidR + rl * 256 + t * 128 + wn * 64 + j2 * 32 + 8 * fq) = pk; } } }
            } f{h2, pairs, (const bf16_t*)(P.ws + WS_WBGU) + (size_t)e * 1024 * 512, hidR};
            G::run_stream(f, 2, 32, 32, (size_t)32 * 512, lds);
        }
        __syncthreads();
        {
            struct DN { bf16_t* hidR; const bf16_t* wd; unsigned char* y; LAS int* pairs; LAS float* wts; int rows;
                __device__ __forceinline__ void ptrs(int ct, const bf16_t* (&aptr)[2], const bf16_t* (&bptr)[2]) const {
                    const int tid = opaque_tid(), lane = tid & 63, wid = tid >> 6, wm = wid >> 1, wn = wid & 1, fr = lane & 15, fq = lane >> 4, c8 = 8 * (tid & 31); (void)wm; (void)wn; (void)fr; (void)fq; (void)c8;
#pragma unroll
                    for (int i = 0; i < 2; ++i) { const int row = G::a_row(i, wid, lane); aptr[i] = hidR + (size_t)row * 256 + G::a_chunk(row, lane) * 8;
                        const int k = G::b_k(i, wid, lane); bptr[i] = wd + (size_t)k * 1024 + ct * 256 + G::b_n(k, lane); } }
                __device__ __forceinline__ void epi(int ct, f32x4 (&acc)[4][8]) const {
                    const int tid = opaque_tid(), lane = tid & 63, wid = tid >> 6, wm = wid >> 1, wn = wid & 1, fr = lane & 15, fq = lane >> 4, c8 = 8 * (tid & 31); (void)wm; (void)wn; (void)fr; (void)fq; (void)c8;
#pragma unroll
                    for (int mi = 0; mi < 4; ++mi) { const int rl = wm * 64 + mi * 16 + fr; const float wgt = wts[rl]; const size_t pr = (size_t)pairs[rl];
                        if (rl < rows) {
#pragma unroll
                            for (int j2 = 0; j2 < 2; ++j2) { const int col = ct * 256 + wn * 128 + 64 * j2 + 16 * fq; const float sc_ = wgt * Y_SCALE; u32x4 w;
#pragma unroll
                                for (int b2 = 0; b2 < 4; ++b2) { const f32x4 a = acc[mi][4 * j2 + b2] * sc_;
                                    int pk = __builtin_amdgcn_cvt_pk_fp8_f32(a.x, a.y, 0, false); pk = __builtin_amdgcn_cvt_pk_fp8_f32(a.z, a.w, pk, true); w[b2] = (unsigned)pk; }
                                *(u32x4*)(y + pr * 1024 + col) = w; } } } }
            } f{hidR, (const bf16_t*)(P.ws + WS_WBD) + (size_t)e * 256 * 1024, y, pairs, wts, rows};
            G::run_stream(f, 4, 8, 32, (size_t)32 * 1024, lds);
        }
        __syncthreads();
    }
}


__device__ __forceinline__ void cvt8_store_rows(LAS unsigned char* wl, int lane, const u32x4 (&w)[8], unsigned char* obase, size_t row_stride) {
#pragma unroll
    for (int j = 0; j < 8; ++j) *(LAS u32x4*)(wl + lane * 144 + j * 16) = w[j];
    asm volatile("s_waitcnt lgkmcnt(0)" ::: "memory");
#pragma unroll
    for (int i = 0; i < 8; ++i) { const int r = (lane >> 3) + 8 * i; const u32x4 v = *(const LAS u32x4*)(wl + r * 144 + (lane & 7) * 16); *(u32x4*)(obase + (size_t)r * row_stride + (lane & 7) * 16) = v; }
    asm volatile("s_waitcnt lgkmcnt(0)" ::: "memory");
}
__device__ __forceinline__ void cvt8_item(const Params& P, LAS unsigned char* lds, int item) {
    const int tid = opaque_tid(), lane = tid & 63, wv = tid >> 6;
    unsigned char* wgu = (unsigned char*)(P.ws + WS_W8GU); unsigned char* wd = (unsigned char*)(P.ws + WS_W8D);
    LAS unsigned char* wl = lds + wv * 9216;
    const int NGW = 1;
    if (item < 1024)
    for (int u = item * 16 + wv * 2; u < item * 16 + wv * 2 + 2; u += NGW) {
        const int rg = u & 7, kb = (u >> 3) & 7, e = u >> 6;
        const int q = rg * 64 + lane, t = q >> 8, ql = q & 255, wnn = ql >> 7, it = (ql >> 5) & 3, i = ql & 31;
        const int h = t * 128 + wnn * 64 + (it >> 1) * 32 + Gemm8::w_col(i);
        const float* s = ((it & 1) ? P.exp_wu : P.exp_wg) + (size_t)e * 1024 * 256 + (size_t)(kb * 128) * 256 + h;
        unsigned char* o = wgu + ((size_t)e * 512 + rg * 64) * 1024 + kb * 128;
        { float v[128]; u32x4 wq[8];
#pragma unroll
            for (int j = 0; j < 128; ++j) v[j] = __builtin_nontemporal_load(s + (size_t)j * 256);
#pragma unroll
            for (int j = 0; j < 8; ++j) { const float c_ = W8_GU_SCALE; u32x4 w;
                w.x = pk4_fp8(v[16 * j] * c_, v[16 * j + 1] * c_, v[16 * j + 2] * c_, v[16 * j + 3] * c_); w.y = pk4_fp8(v[16 * j + 4] * c_, v[16 * j + 5] * c_, v[16 * j + 6] * c_, v[16 * j + 7] * c_);
                w.z = pk4_fp8(v[16 * j + 8] * c_, v[16 * j + 9] * c_, v[16 * j + 10] * c_, v[16 * j + 11] * c_); w.w = pk4_fp8(v[16 * j + 12] * c_, v[16 * j + 13] * c_, v[16 * j + 14] * c_, v[16 * j + 15] * c_);
                wq[j] = w; }
            cvt8_store_rows(wl, lane, wq, o, 1024); }
    }
    if (item >= 1024)
    for (int u = (item - 1024) * 16 + wv * 2; u < (item - 1024) * 16 + wv * 2 + 2; u += NGW) {
        const int rg = u & 15, kb = (u >> 4) & 1, e = u >> 5;
        const int q = rg * 64 + lane, i = q & 31;
        const int col = (q & ~31) + Gemm8::w_col(i);
        const float* s = P.exp_wd + (size_t)e * 256 * 1024 + (size_t)(kb * 128) * 1024 + col;
        unsigned char* o = wd + ((size_t)e * 1024 + rg * 64) * 256 + kb * 128;
        { float v[128]; u32x4 wq[8];
#pragma unroll
            for (int j = 0; j < 128; ++j) v[j] = __builtin_nontemporal_load(s + (size_t)j * 1024);
#pragma unroll
            for (int j = 0; j < 8; ++j) { const float c_ = W8_D_SCALE; u32x4 w;
                w.x = pk4_fp8(v[16 * j] * c_, v[16 * j + 1] * c_, v[16 * j + 2] * c_, v[16 * j + 3] * c_); w.y = pk4_fp8(v[16 * j + 4] * c_, v[16 * j + 5] * c_, v[16 * j + 6] * c_, v[16 * j + 7] * c_);
                w.z = pk4_fp8(v[16 * j + 8] * c_, v[16 * j + 9] * c_, v[16 * j + 10] * c_, v[16 * j + 11] * c_); w.w = pk4_fp8(v[16 * j + 12] * c_, v[16 * j + 13] * c_, v[16 * j + 14] * c_, v[16 * j + 15] * c_);
                wq[j] = w; }
            cvt8_store_rows(wl, lane, wq, o, 256); }
    }
}

template <int PM> __device__ __forceinline__ void phase_experts8(const Params& P, LAS unsigned char* lds) {
    typedef Gemm8 G;
    const int tid = opaque_tid();
    const int* cnt = (const int*)(P.ws + WS_CTL + CTL_CNT); const int* bucket = (const int*)(P.ws + WS_BUCKET); const float* rw = (const float*)(P.ws + WS_RW);
    const unsigned char* h2q = (const unsigned char*)(P.ws + WS_H2Q); unsigned char* hidR = (unsigned char*)(P.ws + WS_HIDR) + (size_t)blockIdx.x * 256 * 256; unsigned char* y = (unsigned char*)(P.ws + WS_Y);
    LAS int* tiles = (LAS int*)(lds + P6_TILES); LAS int* pre = (LAS int*)(lds + P6_PRE); LAS int* pairs = (LAS int*)(lds + P6_PAIR); LAS float* wts = (LAS float*)(lds + P6_W);
    const int nx = (gridDim.x % 8 == 0) ? 8 : 1, xl = blockIdx.x % nx, li = blockIdx.x / nx, nloc = gridDim.x / nx, nek = 256 / nx;
    if (tid < nek) { const int c_ = cnt[xl + nx * tid]; tiles[tid] = ((c_ < BCAP ? c_ : BCAP) + 255) >> 8; }
    __syncthreads();
    if (tid < nek) { int s = 0; for (int i = 0; i < tid; ++i) s += tiles[i]; pre[tid] = s; if (tid == nek - 1) pre[nek] = s + tiles[nek - 1]; }
    __syncthreads();
    const int total = pre[nek];
    for (int u = li; u < total; u += nloc) {
        int lo = 0, hi_ = nek - 1;
        while (lo < hi_) { const int mid = (lo + hi_ + 1) >> 1; if (pre[mid] <= u) lo = mid; else hi_ = mid - 1; }
        const int e = xl + nx * lo, tile = u - pre[lo], n = cnt[e] < BCAP ? cnt[e] : BCAP, rows = (n - tile * 256) < 256 ? (n - tile * 256) : 256;
        if (tid < 256) { const int r = tid < rows ? tid : 0; const int pr = bucket[(size_t)e * BCAP + tile * 256 + r]; pairs[tid] = pr; wts[tid] = tid < rows ? rw[pr] : 0.f; }
        __syncthreads();
        {
            struct GU { const unsigned char* h2q; LAS int* pairs; const unsigned char* wgu; unsigned char* hidR;
                static __device__ __forceinline__ int wscale(int it) { return (it & 1) ? 123 : 121; }
                __device__ __forceinline__ void ptrs(int t, const unsigned char* (&aptr)[2], const unsigned char* (&wptr)[2]) const {
                    const int tid = opaque_tid(), lane = tid & 63, wid = tid >> 6;
#pragma unroll
                    for (int i = 0; i < 2; ++i) { const int row = G::t_row(i, wid, lane); aptr[i] = h2q + (size_t)(pairs[row] >> 3) * 1024 + G::t_chunk(row, lane) * 16;
                        wptr[i] = wgu + (size_t)(t * 256 + row) * 1024 + G::t_chunk(row, lane) * 16; } }
                __device__ __forceinline__ void epi(int t, f32x16 (&acc)[2][4]) const {
                    const int tid = opaque_tid(), lane = tid & 63, wid = tid >> 6, wm = wid >> 1, wn = wid & 1, l31 = lane & 31, hi = lane >> 5;
                    if (PM == 2) return;
#pragma unroll
                    for (int jt = 0; jt < 2; ++jt) { const int rl = wm * 64 + jt * 32 + l31;
#pragma unroll
                        for (int p = 0; p < 2; ++p) {
                            float e[16], hv[16];
#pragma unroll
                            for (int r = 0; r < 16; ++r) e[r] = __builtin_amdgcn_exp2f(acc[jt][2 * p][r] * -LOG2E);
                            __builtin_amdgcn_sched_barrier(0);
#pragma unroll
                            for (int r = 0; r < 16; ++r) { e[r] = __builtin_amdgcn_rcpf(1.0f + e[r]); hv[r] = acc[jt][2 * p][r] * acc[jt][2 * p + 1][r]; }
                            __builtin_amdgcn_sched_barrier(0);
                            u32x4 w;
#pragma unroll
                            for (int q4 = 0; q4 < 4; ++q4) w[q4] = pk4_fp8(hv[4 * q4] * e[4 * q4], hv[4 * q4 + 1] * e[4 * q4 + 1], hv[4 * q4 + 2] * e[4 * q4 + 2], hv[4 * q4 + 3] * e[4 * q4 + 3]);
                            *(u32x4*)(hidR + rl * 256 + t * 128 + wn * 64 + p * 32 + 16 * hi) = w; } } }
            } f{h2q, pairs, (const unsigned char*)(P.ws + WS_W8GU) + (size_t)e * 512 * 1024, hidR};
            if (PM != 3) G::run_stream(f, 2, 16, lds);
        }
        __syncthreads();
        {
            struct DN { const unsigned char* hidR; const unsigned char* wd; unsigned char* y; LAS int* pairs; LAS float* wts; int rows;
                static __device__ __forceinline__ int wscale(int) { return 120; }
                __device__ __forceinline__ void ptrs(int ct, const unsigned char* (&aptr)[2], const unsigned char* (&wptr)[2]) const {
                    const int tid = opaque_tid(), lane = tid & 63, wid = tid >> 6;
#pragma unroll
                    for (int i = 0; i < 2; ++i) { const int row = G::t_row(i, wid, lane); aptr[i] = hidR + (size_t)row * 256 + G::t_chunk(row, lane) * 16;
                        wptr[i] = wd + (size_t)(ct * 256 + row) * 256 + G::t_chunk(row, lane) * 16; } }
                __device__ __forceinline__ void epi(int ct, f32x16 (&acc)[2][4]) const {
                    const int tid = opaque_tid(), lane = tid & 63, wid = tid >> 6, wm = wid >> 1, wn = wid & 1, l31 = lane & 31, hi = lane >> 5;
                    if (PM == 3) return;
#pragma unroll
                    for (int jt = 0; jt < 2; ++jt) { const int rl = wm * 64 + jt * 32 + l31; const float sc_ = wts[rl] * Y_SCALE; const size_t pr = (size_t)pairs[rl];
                        if (rl < rows) {
#pragma unroll
                            for (int it = 0; it < 4; ++it) { u32x4 w;
#pragma unroll
                                for (int q4 = 0; q4 < 4; ++q4) w[q4] = pk4_fp8(acc[jt][it][4 * q4] * sc_, acc[jt][it][4 * q4 + 1] * sc_, acc[jt][it][4 * q4 + 2] * sc_, acc[jt][it][4 * q4 + 3] * sc_);
                                *(u32x4*)(y + pr * 1024 + ct * 256 + wn * 128 + it * 32 + 16 * hi) = w; } } } }
            } f{hidR, (const unsigned char*)(P.ws + WS_W8D) + (size_t)e * 1024 * 256, y, pairs, wts, rows};
            if (PM == 0 || PM == 3) G::run_stream(f, 4, 4, lds);
        }
        __syncthreads();
    }
}

__device__ __forceinline__ void phase_combine(const Params& P) {
    const int lane = threadIdx.x & 63, gw = blockIdx.x * (NTHREADS / 64) + (threadIdx.x >> 6), NGW = gridDim.x * (NTHREADS / 64);
    const unsigned char* y = (const unsigned char*)(P.ws + WS_Y);
    typedef float f32x2_ __attribute__((ext_vector_type(2)));
    for (int m = gw; m < T; m += NGW) {
        const float* mod = (const float*)(P.ws + WS_MOD) + (m / SEQ) * 6144 + 5120;
#pragma unroll
        for (int j = 0; j < 2; ++j) { const int col = (lane + 64 * j) * 8;
            f32x4 s0 = (f32x4){0.f, 0.f, 0.f, 0.f}, s1 = s0;
#pragma unroll
            for (int sl = 0; sl < 9; ++sl) { const u32x2 v = sl < 8 ? *(const u32x2*)(y + ((size_t)m * 8 + sl) * 1024 + col) : *(const u32x2*)((const unsigned char*)(P.ws + WS_YSH) + (size_t)m * 1024 + col);
                const f32x2_ a = __builtin_amdgcn_cvt_pk_f32_fp8((int)v.x, false), b = __builtin_amdgcn_cvt_pk_f32_fp8((int)v.x, true);
                const f32x2_ c = __builtin_amdgcn_cvt_pk_f32_fp8((int)v.y, false), d = __builtin_amdgcn_cvt_pk_f32_fp8((int)v.y, true);
                s0.x += a.x; s0.y += a.y; s0.z += b.x; s0.w += b.y; s1.x += c.x; s1.y += c.y; s1.z += d.x; s1.w += d.y; }
            const f32x4 g0 = *(const f32x4*)(mod + col), g1 = *(const f32x4*)(mod + col + 4);
            const u32x4 xr = *(const u32x4*)((const bf16_t*)(P.ws + WS_X1) + (size_t)m * 1024 + col);
            f32x4 o0 = (f32x4){__uint_as_float(xr.x << 16), __uint_as_float(xr.x & 0xffff0000u), __uint_as_float(xr.y << 16), __uint_as_float(xr.y & 0xffff0000u)};
            f32x4 o1 = (f32x4){__uint_as_float(xr.z << 16), __uint_as_float(xr.z & 0xffff0000u), __uint_as_float(xr.w << 16), __uint_as_float(xr.w & 0xffff0000u)};
            o0 += g0 * (s0 * Y_INV); o1 += g1 * (s1 * Y_INV);
            *(f32x4*)(P.out + (size_t)m * 1024 + col) = o0; *(f32x4*)(P.out + (size_t)m * 1024 + col + 4) = o1; }
    }
}


__device__ __forceinline__ int queue_pull(unsigned* head, volatile LAS unsigned* slot) {
    if (threadIdx.x == 0) *slot = atomicAdd(head, 1u);
    __syncthreads();
    const int v = (int)*slot;
    __syncthreads();
    return v;
}
__device__ __forceinline__ void phase_cmp_h1(const Params& P, LAS unsigned char* lds, volatile LAS unsigned* slot) {
    unsigned* head = (unsigned*)(P.ws + WS_CTL + CTL_Q2);
    for (;;) {
        const int u5 = queue_pull(head, slot);
        if (u5 >= 960) break;
        const int g5 = u5 / 5, p5 = u5 % 5;
        if (p5 & 1) { cvt8_item(P, lds, g5 * 2 + (p5 >> 1)); continue; }
        const int u = g5 * 3 + (p5 >> 1);
        if (u < 64) compress_unit(P, lds, u); else hgrn_unit<0>(P, lds, u - 64);
    }
}
__device__ __forceinline__ void phase_h23_nsa(const Params& P, LAS unsigned char* lds, volatile LAS unsigned* slot) {
    unsigned* head = (unsigned*)(P.ws + WS_CTL + CTL_Q3);
    for (;;) {
        const int n2 = queue_pull(head, slot);
        if (n2 >= 2688) break;
        const int g7 = n2 / 7, p7 = n2 % 7;
        if (p7 & 1) { cvt8_item(P, lds, 384 + g7 * 3 + (p7 >> 1)); continue; }
        const int n = g7 * 4 + (p7 >> 1);
        if (n < 512) nsa_unit(P, lds, (n & 7) * 128 + (127 - (n >> 3)));
        else if (n < 1024) { const int m = n - 512; hgrn_unit<1>(P, lds, (m & 15) * 32 + (31 - (m >> 4))); }
        else { const int m = n - 1024; nsa_unit(P, lds, (m & 7) * 128 + (63 - (m >> 3))); }
    }
}

constexpr int LDS_BYTES = 144 * 1024;
__global__ void __launch_bounds__(NTHREADS) mega(Params P) {
    extern __shared__ __attribute__((aligned(16))) unsigned char smem[];
    LAS unsigned char* lds = (LAS unsigned char*)smem;
    volatile LAS unsigned* xst = (volatile LAS unsigned*)(lds + LDS_BYTES - 16);
    if (threadIdx.x < 4) xst[threadIdx.x] = 0u;
    __syncthreads();
    XcdBarrier xb = xcd_barrier_post((unsigned*)(P.ws + WS_CTL + CTL_BAR), xst);
    phase_mod(P, lds);
    xcd_barrier(xb);
    { const float* mod = (const float*)(P.ws + WS_MOD); norm_mod_rows(P.x, P.norm1_w, mod, mod + 1024, (unsigned char*)(P.ws + WS_H), H1S); }
    xcd_barrier(xb);
    phase_inproj(P, lds);
    xcd_barrier(xb);
    phase_cmp_h1(P, lds, xst + 2);
    xcd_barrier(xb);
    phase_hgrn_prefix(P);
    xcd_barrier(xb);
    phase_h23_nsa(P, lds, xst + 2);
    phase_cvt_small(P);
    xcd_barrier(xb);
    phase_p4a(P, lds);
    xcd_barrier(xb);
    phase_p4b(P);
    xcd_barrier(xb);
    phase_p4c(P, lds);
    xcd_barrier(xb);
    phase_route(P);
    phase_p4d(P, lds);
    xcd_barrier(xb);
    phase_experts8<0>(P, lds);
    xcd_barrier(xb);
    phase_combine(P);
}

extern "C" void kernel_launch(void* const* d_in, const int* in_sizes, int n_in, void* d_out, int out_size, void* d_ws, size_t ws_size, hipStream_t stream) {
    static int grid = 0;
    if (grid == 0) {
        if (n_in != 25 || ws_size < WS_END) { fprintf(stderr, "kernel_launch: unexpected n_in %d or ws_size %zu (need %zu)\n", n_in, ws_size, (size_t)WS_END); grid = -1; return; }
        int dev = 0, cus = 0, per_cu = 0;
        (void)hipGetDevice(&dev); (void)hipDeviceGetAttribute(&cus, hipDeviceAttributeMultiprocessorCount, dev);
        (void)hipFuncSetAttribute((const void*)mega, hipFuncAttributeMaxDynamicSharedMemorySize, LDS_BYTES);
        (void)hipOccupancyMaxActiveBlocksPerMultiprocessor(&per_cu, (const void*)mega, NTHREADS, LDS_BYTES);
        if (per_cu < 1) { fprintf(stderr, "kernel_launch: occupancy query says %d blocks per CU\n", per_cu); grid = -1; return; }
        grid = cus;
    }
    if (grid < 0) return;
    (void)hipMemsetAsync((char*)d_ws + WS_CTL, 0, 64 * 1024, stream);
    Params p{};
    const float** pf = (const float**)&p;
    for (int i = 0; i < 25; ++i) pf[i] = (const float*)d_in[i];
    p.out = (float*)d_out; p.ws = (unsigned char*)d_ws;
    void* args[] = {&p};
    hipError_t e = hipLaunchCooperativeKernel((const void*)mega, dim3(grid), dim3(NTHREADS), args, LDS_BYTES, stream);
    if (e != hipSuccess) fprintf(stderr, "cooperative launch failed: %s (grid %d)\n", hipGetErrorString(e), grid);
}

#ifdef PHASE_TEST
__global__ void __launch_bounds__(NTHREADS) t_p4a(Params P) { extern __shared__ __attribute__((aligned(16))) unsigned char smem[]; phase_p4a(P, (LAS unsigned char*)smem); }
__global__ void __launch_bounds__(NTHREADS) t_p4d(Params P) { extern __shared__ __attribute__((aligned(16))) unsigned char smem[]; phase_p4d(P, (LAS unsigned char*)smem); }
__global__ void __launch_bounds__(NTHREADS) t_p4(Params P) { extern __shared__ __attribute__((aligned(16))) unsigned char smem[]; phase_p4c(P, (LAS unsigned char*)smem); }
__global__ void __launch_bounds__(NTHREADS) t_p6(Params P) { extern __shared__ __attribute__((aligned(16))) unsigned char smem[]; phase_experts(P, (LAS unsigned char*)smem); }
__global__ void __launch_bounds__(NTHREADS) t_nsa(Params P) { extern __shared__ __attribute__((aligned(16))) unsigned char smem[]; nsa_unit(P, (LAS unsigned char*)smem, blockIdx.x); }
__global__ void __launch_bounds__(NTHREADS) t_mod(Params P) { extern __shared__ __attribute__((aligned(16))) unsigned char smem[]; phase_mod(P, (LAS unsigned char*)smem); }
__global__ void __launch_bounds__(NTHREADS) t_inproj(Params P) { extern __shared__ __attribute__((aligned(16))) unsigned char smem[]; phase_inproj(P, (LAS unsigned char*)smem); }
__global__ void __launch_bounds__(NTHREADS) t_cmp(Params P) { extern __shared__ __attribute__((aligned(16))) unsigned char smem[]; compress_unit(P, (LAS unsigned char*)smem, blockIdx.x); }
__global__ void __launch_bounds__(NTHREADS) t_h0(Params P) { extern __shared__ __attribute__((aligned(16))) unsigned char smem[]; hgrn_unit<0>(P, (LAS unsigned char*)smem, blockIdx.x); }
__global__ void __launch_bounds__(NTHREADS) t_h1(Params P) { extern __shared__ __attribute__((aligned(16))) unsigned char smem[]; hgrn_unit<1>(P, (LAS unsigned char*)smem, blockIdx.x); }
#endif
```

```cpp
#include <hip/hip_runtime.h>
#include <hip/hip_cooperative_groups.h>
#include <cstdio>
#include <cstdint>
#include <type_traits>
namespace cg = cooperative_groups;

#define LAS __attribute__((address_space(3)))
typedef unsigned short bf16_t;
typedef short bf16x8 __attribute__((ext_vector_type(8)));
typedef short s16x4 __attribute__((ext_vector_type(4)));
typedef float f32x4 __attribute__((ext_vector_type(4)));
typedef float f32x16 __attribute__((ext_vector_type(16)));
typedef unsigned u32x4 __attribute__((ext_vector_type(4)));
typedef unsigned u32x2 __attribute__((ext_vector_type(2)));

constexpr int D = 1024, BATCH = 4, SEQ = 8192, T = BATCH * SEQ;
constexpr int IN_COLS = 3352;
constexpr int NTHREADS = 512;
constexpr int H1S = 1088;
constexpr float RMS_EPS = 1e-6f;
constexpr float LOG2E = 1.4426950408889634f;
constexpr float Y_SCALE = 16.0f, Y_INV = 1.0f / 16.0f;

constexpr size_t MB = 1024ull * 1024ull;
constexpr size_t WS_CTL    = 0;
constexpr size_t WS_MOD    = 64 * 1024;
constexpr size_t WS_LB     = WS_MOD + 4 * 6144 * 4;
constexpr size_t WS_CB     = WS_LB + 2048;
constexpr size_t WS_H      = 1 * MB;
constexpr size_t WS_SS     = WS_H + 72 * MB;
constexpr size_t WS_RW     = WS_SS + 1 * MB;
constexpr size_t WS_BUCKET = WS_RW + 1 * MB;
constexpr size_t WS_HIDR   = WS_BUCKET + 16 * MB;
constexpr size_t WS_WSM    = WS_HIDR + 32 * MB;
constexpr size_t WS_WOUT   = WS_WSM, WS_WRS = WS_WSM + 2 * MB, WS_WSD = WS_WSM + 4 * MB;
constexpr size_t WS_WBE    = WS_WSM + 5 * MB;
constexpr size_t WS_WBGU   = WS_WBE, WS_WBD = WS_WBE + 256 * MB;
constexpr size_t WS_W8GU   = WS_WBE, WS_W8D = WS_WBE + 128 * MB, WS_H2Q = WS_WBE + 256 * MB;
constexpr size_t WS_X1     = WS_WBE + 192 * MB;
constexpr float W8_GU_SCALE = 64.0f, W8_D_SCALE = 32.0f, HID8_SCALE = 4.0f;
constexpr size_t WS_SCORES = WS_WBE + 288 * MB;
constexpr size_t WS_HIDS   = WS_SCORES + 32 * MB;
constexpr size_t WS_WIN    = WS_WBE + 48 * MB;
constexpr size_t WS_Y      = WS_WBE + 384 * MB;
constexpr size_t WS_Q      = WS_Y;
constexpr size_t WS_KV     = WS_Q + 32 * MB;
constexpr size_t WS_GATES  = WS_KV + 48 * MB;
constexpr size_t WS_HQ     = WS_GATES + 4 * MB;
constexpr size_t WS_LOGF   = WS_HQ + 32 * MB;
constexpr size_t WS_HV     = WS_LOGF + 64 * MB;
constexpr size_t WS_HG     = WS_HV + 32 * MB;
constexpr size_t WS_CMPH   = WS_HG + 32 * MB;
constexpr size_t WS_KC     = WS_CMPH + 4 * MB;
constexpr size_t WS_VC     = WS_KC + 1 * MB;
constexpr size_t WS_HL     = WS_VC + 1 * MB;
constexpr size_t WS_HD     = WS_HL + 32 * MB;
constexpr size_t WS_MIX    = WS_HD + 1 * MB;
constexpr size_t WS_YSH    = WS_Y + 384 * MB;
constexpr size_t WS_END    = WS_YSH + 64 * MB;
constexpr int BCAP = 16384;
constexpr int CTL_CNT = 32768;
constexpr int CNT_STRIDE = 32;
constexpr int CTL_Q2 = 2048, CTL_Q3 = 2112;
constexpr int CTL_BAR = 16384;

struct Params {
    const float *x, *c, *ada_w, *ada_b, *norm1_w, *norm2_w, *w_in, *q_norm_w, *k_norm_w, *cmp_pos, *cmp_w1, *cmp_b1, *cmp_w2,
        *attn_out_norm_w, *hgrn_lb, *rec_out_norm_w, *w_out, *router_w, *router_bias, *exp_wg, *exp_wu, *exp_wd, *sh_wg, *sh_wu, *sh_wd;
    float* out;
    unsigned char* ws;
};

typedef __bf16 bf16x2_t __attribute__((ext_vector_type(2)));
typedef int i32x8 __attribute__((ext_vector_type(8)));
__device__ __forceinline__ unsigned cvtpk(float lo, float hi) { bf16x2_t v; v.x = (__bf16)lo; v.y = (__bf16)hi; return __builtin_bit_cast(unsigned, v); }
__device__ __forceinline__ int opaque_tid() { int t = threadIdx.x; asm volatile("" : "+v"(t)); return t; }
__device__ __forceinline__ float bf2f(bf16_t v) { return __uint_as_float(((unsigned)v) << 16); }
__device__ __forceinline__ float sigmoidf_(float v) { return __builtin_amdgcn_rcpf(1.0f + __expf(-v)); }
__device__ __forceinline__ float siluf_(float v) { return v * __builtin_amdgcn_rcpf(1.0f + __expf(-v)); }
__device__ __forceinline__ float wave_sum(float v) {
#pragma unroll
    for (int o = 1; o < 64; o <<= 1) v += __shfl_xor(v, o);
    return v;
}
__device__ __forceinline__ s16x4 lds_tr(const LAS unsigned char* p) {
    return __builtin_bit_cast(s16x4, __builtin_amdgcn_ds_read_tr16_b64_v4i16((LAS s16x4*)p));
}

#define XB_TMO      128
#define XB_XCNT(j)  (256  + 64 * (j))
#define XB_XSUB(j)  (1280 + 64 * (j))
#define XB_XGEN(j)  (2304 + 64 * (j))
#define XB_TOP      3328
#define XB_TOPGEN   3392
#define XCD_BAR_WORDS 3456
#define XB_SPIN_CAP (1u << 22)
__device__ __forceinline__ unsigned xb_ld(unsigned* p)              { return __hip_atomic_load(p, __ATOMIC_RELAXED, __HIP_MEMORY_SCOPE_AGENT); }
__device__ __forceinline__ unsigned xb_add(unsigned* p, unsigned v) { return __hip_atomic_fetch_add(p, v, __ATOMIC_RELAXED, __HIP_MEMORY_SCOPE_AGENT); }
__device__ __forceinline__ unsigned xb_xcc_id() { return (unsigned)__builtin_amdgcn_s_getreg((3 << 11) | 20) & 0xFu; }
#define XB_SPIN(cond, bar) do { unsigned _sp = 0; while (cond) { __builtin_amdgcn_s_sleep(1); \
    if ((++_sp & 255u) == 0u) { if (xb_ld(&(bar)[XB_TMO])) break; if (_sp > XB_SPIN_CAP) { atomicAdd(&(bar)[XB_TMO], 1u); break; } } } } while (0)
struct XcdBarrier { unsigned* bar; unsigned x; volatile LAS unsigned* st; };
__device__ __forceinline__ XcdBarrier xcd_barrier_post(unsigned* bar, volatile LAS unsigned* st) {
    XcdBarrier b; b.bar = bar; b.x = xb_xcc_id(); b.st = st;
    if (threadIdx.x == 0) (void)xb_add(&bar[XB_XCNT(b.x)], 1u);
    return b;
}
__device__ __forceinline__ void xcd_barrier_complete(unsigned* bar, unsigned x, unsigned& nloc, unsigned& nx) {
    const unsigned G = gridDim.x * gridDim.y * gridDim.z;
    unsigned sum, cnt, mine, sp = 0u;
    for (;;) {
        sum = 0u; cnt = 0u; mine = 0u;
#pragma unroll
        for (unsigned j = 0; j < 16; ++j) { const unsigned c = xb_ld(&bar[XB_XCNT(j)]); sum += c; cnt += (c > 0u) ? 1u : 0u; mine = (j == x) ? c : mine; }
        if (sum == G) break;
        __builtin_amdgcn_s_sleep(1);
        if ((++sp & 255u) == 0u) { if (xb_ld(&bar[XB_TMO])) break; if (sp > XB_SPIN_CAP) { atomicAdd(&bar[XB_TMO], 1u); break; } }
    }
    nloc = mine > 0u ? mine : 1u; nx = cnt > 0u ? cnt : 1u;
}
__device__ __forceinline__ void xcd_barrier(const XcdBarrier& b) {
    asm volatile("s_waitcnt vmcnt(0)" ::: "memory");
    __syncthreads();
    if (threadIdx.x == 0) {
        unsigned* bar = b.bar;
        __builtin_amdgcn_s_waitcnt(0);
        unsigned nloc = b.st[0], nx = b.st[1];
        if (nloc == 0u) { xcd_barrier_complete(bar, b.x, nloc, nx); b.st[0] = nloc; b.st[1] = nx; }
        const unsigned old = xb_add(&bar[XB_XSUB(b.x)], 1u);
        const unsigned gen = old / nloc;
        if (old + 1u == (gen + 1u) * nloc) {
            __builtin_amdgcn_fence(__ATOMIC_RELEASE, "agent");
            asm volatile("s_waitcnt vmcnt(0)" ::: "memory");
            const unsigned og = xb_add(&bar[XB_TOP], 1u);
            const unsigned tg = og / nx;
            if (og + 1u == (tg + 1u) * nx) xb_add(&bar[XB_TOPGEN], 1u);
            else XB_SPIN(xb_ld(&bar[XB_TOPGEN]) == tg, bar);
            __builtin_amdgcn_fence(__ATOMIC_ACQUIRE, "agent");
            xb_add(&bar[XB_XGEN(b.x)], 1u);
            asm volatile("s_waitcnt vmcnt(0)" ::: "memory");
        } else {
            XB_SPIN(xb_ld(&bar[XB_XGEN(b.x)]) == gen, bar);
            __builtin_amdgcn_fence(__ATOMIC_ACQUIRE, "agent");
            asm volatile("s_waitcnt vmcnt(0)" ::: "memory");
        }
    }
    __syncthreads();
}

template <int WM, int WN> struct GemmT {
    static constexpr int BM = 64 * WM, BN = 64 * WN;
    static constexpr int A_BYTES = BM * 128, B_BYTES = 64 * BN * 2, STAGE = A_BYTES + B_BYTES, LDS_BYTES = 2 * STAGE;
    static constexpr int NB4 = BN / 32;
    static constexpr int B_ROW4 = BN / 4;

    static __device__ __forceinline__ void run(f32x4 (&acc)[4][4], const bf16_t* const (&arow)[WM], int a_kstride, const float* Bp, int ldb, int KT, LAS unsigned char* lds) {
        const int tid = opaque_tid(), lane = tid & 63, wid = tid >> 6, wm = wid / WN, wn = wid % WN, fr = lane & 15, fq = lane >> 4;
#pragma unroll
        for (int mi = 0; mi < 4; ++mi)
#pragma unroll
            for (int ni = 0; ni < 4; ++ni) acc[mi][ni] = (f32x4){0.f, 0.f, 0.f, 0.f};
        const int achunk = tid & 7;
        u32x4 areg[WM]; f32x4 breg[NB4];
        int a_wr[WM];
#pragma unroll
        for (int p = 0; p < WM; ++p) { const int row = p * 64 + (tid >> 3); a_wr[p] = row * 128 + ((achunk ^ ((row >> 1) & 7)) << 4); }
        int b_wr[NB4]; int b_goff[NB4];
#pragma unroll
        for (int p = 0; p < NB4; ++p) { const int i = tid + NTHREADS * p, k = i / B_ROW4, n = (i % B_ROW4) * 4;
            const int f = (k & 3) | (((k >> 3) & 1) << 2);
            b_wr[p] = A_BYTES + k * (BN * 2) + (((n >> 4) ^ f) << 5) + ((n & 15) << 1); b_goff[p] = k * ldb + n; }
        int a_rd[4][2];
#pragma unroll
        for (int mi = 0; mi < 4; ++mi)
#pragma unroll
            for (int ks = 0; ks < 2; ++ks) { const int row = wm * 64 + mi * 16 + fr, ch = ks * 4 + fq; a_rd[mi][ks] = row * 128 + ((ch ^ ((row >> 1) & 7)) << 4); }
        int b_rd[2][2];
        int b_f[2][2];
#pragma unroll
        for (int ks = 0; ks < 2; ++ks)
#pragma unroll
            for (int t = 0; t < 2; ++t) { const int k = ks * 32 + 8 * fq + 4 * t + (fr >> 2); b_f[ks][t] = (k & 3) | (((k >> 3) & 1) << 2);
                b_rd[ks][t] = A_BYTES + k * (BN * 2) + ((fr & 3) << 3); }

        auto gload = [&](int kt) {
#pragma unroll
            for (int p = 0; p < WM; ++p) areg[p] = *(const u32x4*)(arow[p] + (size_t)kt * a_kstride + achunk * 8);
            const float* bk = Bp + (size_t)kt * 64 * ldb;
#pragma unroll
            for (int p = 0; p < NB4; ++p) breg[p] = *(const f32x4*)(bk + b_goff[p]);
        };
        auto lstore = [&](int buf) {
            LAS unsigned char* base = lds + buf * STAGE;
#pragma unroll
            for (int p = 0; p < WM; ++p) *(LAS u32x4*)(base + a_wr[p]) = areg[p];
#pragma unroll
            for (int p = 0; p < NB4; ++p) { u32x2 w; w.x = cvtpk(breg[p].x, breg[p].y); w.y = cvtpk(breg[p].z, breg[p].w); *(LAS u32x2*)(base + b_wr[p]) = w; }
        };
        gload(0); lstore(0); __syncthreads();
        for (int kt = 0; kt < KT; ++kt) {
            if (kt + 1 < KT) gload(kt + 1);
            __builtin_amdgcn_sched_barrier(0);
            const LAS unsigned char* base = lds + (kt & 1) * STAGE;
#pragma unroll
            for (int ks = 0; ks < 2; ++ks) {
                bf16x8 af[4], bfr[4];
#pragma unroll
                for (int mi = 0; mi < 4; ++mi) af[mi] = *(const LAS bf16x8*)(base + a_rd[mi][ks]);
#pragma unroll
                for (int ni = 0; ni < 4; ++ni) {
                    const int u0 = wn * 4 + ni;
                    const s16x4 lo = lds_tr(base + b_rd[ks][0] + ((u0 ^ b_f[ks][0]) << 5));
                    const s16x4 hi = lds_tr(base + b_rd[ks][1] + ((u0 ^ b_f[ks][1]) << 5));
                    bfr[ni] = (bf16x8){lo[0], lo[1], lo[2], lo[3], hi[0], hi[1], hi[2], hi[3]};
                }
#pragma unroll
                for (int mi = 0; mi < 4; ++mi)
#pragma unroll
                    for (int ni = 0; ni < 4; ++ni) acc[mi][ni] = __builtin_amdgcn_mfma_f32_16x16x32_bf16(bfr[ni], af[mi], acc[mi][ni], 0, 0, 0);
            }
            if (kt + 1 < KT) lstore((kt + 1) & 1);
            __syncthreads();
        }
    }
};

struct Gemm2 {
    static constexpr int A_BYTES = 32768, STAGE = 65536, LDS_BYTES = 2 * STAGE;
    static __device__ __forceinline__ int a_row(int i, int w, int lane) { return (i * 8 + w) * 8 + (lane >> 3); }
    static __device__ __forceinline__ int a_chunk(int row, int lane) { return (lane & 7) ^ ((row >> 1) & 7); }
    static __device__ __forceinline__ int b_k(int i, int w, int lane) { return (i * 8 + w) * 2 + (lane >> 5); }
    static __device__ __forceinline__ int b_n(int k, int lane) { return ((((lane & 31) >> 1) ^ fk2(k)) << 4) + ((lane & 1) << 3); }
    static __device__ __forceinline__ int fk2(int r) { return (r & 3) | (((r >> 3) & 1) << 2); }

    static __device__ __forceinline__ void run(f32x4 (&acc)[4][8], const bf16_t* const (&aptr)[4], int a_kstride, const bf16_t* const (&bptr)[4], size_t b_kstride, int KT, LAS unsigned char* lds) {
        const int tid = opaque_tid(), lane = tid & 63, wid = tid >> 6, wm = wid >> 1, wn = wid & 1, fr = lane & 15, fq = lane >> 4;
        const int wu = __builtin_amdgcn_readfirstlane(wid);
#pragma unroll
        for (int mi = 0; mi < 4; ++mi)
#pragma unroll
            for (int ni = 0; ni < 8; ++ni) acc[mi][ni] = (f32x4){0.f, 0.f, 0.f, 0.f};
        int a_rd[4][2];
#pragma unroll
        for (int mi = 0; mi < 4; ++mi)
#pragma unroll
            for (int ks = 0; ks < 2; ++ks) { const int row = wm * 64 + mi * 16 + fr, ch = ks * 4 + fq; a_rd[mi][ks] = row * 128 + ((ch ^ ((row >> 1) & 7)) << 4); }
        int b_rd[2][2], b_f[2][2];
#pragma unroll
        for (int ks = 0; ks < 2; ++ks)
#pragma unroll
            for (int t = 0; t < 2; ++t) { const int k = ks * 32 + 8 * fq + 4 * t + (fr >> 2); b_f[ks][t] = fk2(k); b_rd[ks][t] = A_BYTES + k * 512 + ((fr & 3) << 3); }
        auto issue = [&](int kt, int buf) {
            LAS unsigned char* base = lds + buf * STAGE + wu * 1024;
#pragma unroll
            for (int i = 0; i < 4; ++i) __builtin_amdgcn_global_load_lds((const unsigned*)(aptr[i] + (size_t)kt * a_kstride), (LAS unsigned*)(base + i * 8192), 16, 0, 0);
#pragma unroll
            for (int i = 0; i < 4; ++i) __builtin_amdgcn_global_load_lds((const unsigned*)(bptr[i] + (size_t)kt * b_kstride), (LAS unsigned*)(base + A_BYTES + i * 8192), 16, 0, 0);
        };
        issue(0, 0);
        for (int kt = 0; kt < KT; ++kt) {
            asm volatile("s_waitcnt vmcnt(0)" ::: "memory");
            __syncthreads();
            if (kt + 1 < KT) issue(kt + 1, (kt + 1) & 1);
            const LAS unsigned char* base = lds + (kt & 1) * STAGE;
#pragma unroll
            for (int ks = 0; ks < 2; ++ks) {
                bf16x8 af[4];
#pragma unroll
                for (int mi = 0; mi < 4; ++mi) af[mi] = *(const LAS bf16x8*)(base + a_rd[mi][ks]);
#pragma unroll
                for (int ni = 0; ni < 8; ++ni) {
                    const int u0 = wn * 8 + ni;
                    const s16x4 lo = lds_tr(base + b_rd[ks][0] + ((u0 ^ b_f[ks][0]) << 5));
                    const s16x4 hi = lds_tr(base + b_rd[ks][1] + ((u0 ^ b_f[ks][1]) << 5));
                    const bf16x8 bfr = (bf16x8){lo[0], lo[1], lo[2], lo[3], hi[0], hi[1], hi[2], hi[3]};
#pragma unroll
                    for (int mi = 0; mi < 4; ++mi) acc[mi][ni] = __builtin_amdgcn_mfma_f32_16x16x32_bf16(bfr, af[mi], acc[mi][ni], 0, 0, 0);
                }
            }
        }
        __syncthreads();
    }
};

__device__ __forceinline__ void glds16(const void* g, unsigned lds_base) {
    unsigned sv; asm volatile("s_mov_b32 %0, m0\n\ts_mov_b32 m0, %2\n\ts_nop 0\n\tglobal_load_lds_dwordx4 %1, off\n\ts_mov_b32 m0, %0" : "=&s"(sv) : "v"(g), "s"(lds_base) : "memory"); }
struct Gemm3 {
    static constexpr int A_BYTES = 16384, STAGE = 32768, LDS_BYTES = 4 * STAGE;
    static __device__ __forceinline__ int a_row(int i, int w, int lane) { return (i * 8 + w) * 16 + (lane >> 2); }
    static __device__ __forceinline__ int a_chunk(int row, int lane) { return (lane & 3) ^ ((row >> 1) & 3); }
    static __device__ __forceinline__ int b_k(int i, int w, int lane) { return (i * 8 + w) * 2 + (lane >> 5); }
    static __device__ __forceinline__ int fk2(int r) { return (r & 3) | (((r >> 3) & 1) << 2); }
    static __device__ __forceinline__ int b_n(int k, int lane) { return ((((lane & 31) >> 1) ^ fk2(k)) << 4) + ((lane & 1) << 3); }
    static __device__ __forceinline__ void run(f32x4 (&acc)[4][8], const bf16_t* const (&aptr)[2], int a_kstride, const bf16_t* const (&bptr)[2], size_t b_kstride, int KT, LAS unsigned char* lds) {
        const int tid = opaque_tid(), lane = tid & 63, wid = tid >> 6, wm = wid >> 1, wn = wid & 1, fr = lane & 15, fq = lane >> 4;
        const int wu = __builtin_amdgcn_readfirstlane(wid);
#pragma unroll
        for (int mi = 0; mi < 4; ++mi)
#pragma unroll
            for (int ni = 0; ni < 8; ++ni) acc[mi][ni] = (f32x4){0.f, 0.f, 0.f, 0.f};
        int a_rd[4];
#pragma unroll
        for (int mi = 0; mi < 4; ++mi) { const int row = wm * 64 + mi * 16 + fr; a_rd[mi] = row * 64 + ((fq ^ ((row >> 1) & 3)) << 4); }
        int b_rd[2], b_f[2];
#pragma unroll
        for (int t = 0; t < 2; ++t) { const int k = 8 * fq + 4 * t + (fr >> 2); b_f[t] = fk2(k); b_rd[t] = A_BYTES + k * 512 + ((fr & 3) << 3); }
        const unsigned lds0 = (unsigned)(uintptr_t)lds + (unsigned)wu * 1024u;
        auto issue = [&](int kt) {
            const unsigned base = (unsigned)__builtin_amdgcn_readfirstlane((int)(lds0 + (unsigned)(kt & 3) * STAGE));
#pragma unroll
            for (int i = 0; i < 2; ++i) glds16(aptr[i] + (size_t)kt * a_kstride, base + i * 8192);
#pragma unroll
            for (int i = 0; i < 2; ++i) glds16(bptr[i] + (size_t)kt * b_kstride, base + A_BYTES + i * 8192);
        };
        const int grp = wu >> 2;
        auto bar = [&]() { asm volatile("s_waitcnt lgkmcnt(0)" ::: "memory"); __builtin_amdgcn_s_barrier(); asm volatile("" ::: "memory"); };
        asm volatile("s_waitcnt vmcnt(0)" ::: "memory");
        issue(0); if (KT > 1) issue(1); if (KT > 2) issue(2);
        if (KT > 2) asm volatile("s_waitcnt vmcnt(8)" ::: "memory"); else if (KT > 1) asm volatile("s_waitcnt vmcnt(4)" ::: "memory"); else asm volatile("s_waitcnt vmcnt(0)" ::: "memory");
        bar();
        if (grp) bar();
#pragma unroll 1
        for (int kt = 0; kt < KT; ++kt) {
            if (kt + 3 < KT) issue(kt + 3);
            const LAS unsigned char* base = lds + (kt & 3) * STAGE;
            bf16x8 af[4], bfr[8];
#pragma unroll
            for (int mi = 0; mi < 4; ++mi) af[mi] = *(const LAS bf16x8*)(base + a_rd[mi]);
#pragma unroll
            for (int ni = 0; ni < 8; ++ni) {
                const int u0 = wn * 8 + ni;
                const s16x4 lo = lds_tr(base + b_rd[0] + ((u0 ^ b_f[0]) << 5));
                const s16x4 hi = lds_tr(base + b_rd[1] + ((u0 ^ b_f[1]) << 5));
                bfr[ni] = (bf16x8){lo[0], lo[1], lo[2], lo[3], hi[0], hi[1], hi[2], hi[3]};
            }
            { const int rem = KT - 2 - kt;
              if (rem >= 2) asm volatile("s_waitcnt vmcnt(8)" ::: "memory"); else if (rem == 1) asm volatile("s_waitcnt vmcnt(4)" ::: "memory"); else asm volatile("s_waitcnt vmcnt(0)" ::: "memory"); }
            bar();
            __builtin_amdgcn_sched_barrier(0);
#pragma unroll
            for (int ni = 0; ni < 8; ++ni)
#pragma unroll
                for (int mi = 0; mi < 4; ++mi) acc[mi][ni] = __builtin_amdgcn_mfma_f32_16x16x32_bf16(bfr[ni], af[mi], acc[mi][ni], 0, 0, 0);
            __builtin_amdgcn_sched_barrier(0);
            bar();
        }
        if (!grp) bar();
    }

    template <class F> static __device__ __forceinline__ void run_stream(F& f, int NSEG, int KT, int a_kstride, size_t b_kstride, LAS unsigned char* lds) {
        const int tid = opaque_tid(), lane = tid & 63, wid = tid >> 6, wm = wid >> 1, wn = wid & 1, fr = lane & 15, fq = lane >> 4;
        const int wu = __builtin_amdgcn_readfirstlane(wid);
        f32x4 acc[4][8];
#pragma unroll
        for (int mi = 0; mi < 4; ++mi)
#pragma unroll
            for (int ni = 0; ni < 8; ++ni) acc[mi][ni] = (f32x4){0.f, 0.f, 0.f, 0.f};
        int a_rd[4];
#pragma unroll
        for (int mi = 0; mi < 4; ++mi) { const int row = wm * 64 + mi * 16 + fr; a_rd[mi] = row * 64 + ((fq ^ ((row >> 1) & 3)) << 4); }
        int b_rd[2], b_f[2];
#pragma unroll
        for (int t = 0; t < 2; ++t) { const int k = 8 * fq + 4 * t + (fr >> 2); b_f[t] = fk2(k); b_rd[t] = A_BYTES + k * 512 + ((fr & 3) << 3); }
        const unsigned lds0 = (unsigned)(uintptr_t)lds + (unsigned)wu * 1024u;
        const bf16_t* aptr[2]; const bf16_t* bptr[2];
        const int total = NSEG * KT;
        int lseg = 0, lkt = 0, lg = 0;
        auto issue = [&]() {
            const unsigned base = (unsigned)__builtin_amdgcn_readfirstlane((int)(lds0 + (unsigned)(lg & 3) * STAGE));
#pragma unroll
            for (int i = 0; i < 2; ++i) glds16(aptr[i] + (size_t)lkt * a_kstride, base + i * 8192);
#pragma unroll
            for (int i = 0; i < 2; ++i) glds16(bptr[i] + (size_t)lkt * b_kstride, base + A_BYTES + i * 8192);
            ++lg; if (++lkt == KT) { lkt = 0; ++lseg; if (lseg < NSEG) f.ptrs(lseg, aptr, bptr); }
        };
        const int grp = wu >> 2;
        auto bar = [&]() { asm volatile("s_waitcnt lgkmcnt(0)" ::: "memory"); __builtin_amdgcn_s_barrier(); asm volatile("" ::: "memory"); };
        f.ptrs(0, aptr, bptr);
        asm volatile("s_waitcnt vmcnt(0)" ::: "memory");
        issue(); if (total > 1) issue(); if (total > 2) issue();
        if (total > 2) asm volatile("s_waitcnt vmcnt(8)" ::: "memory"); else if (total > 1) asm volatile("s_waitcnt vmcnt(4)" ::: "memory"); else asm volatile("s_waitcnt vmcnt(0)" ::: "memory");
        bar();
        if (grp) bar();
        int cseg = 0, ckt = 0;
#pragma unroll 1
        for (int g = 0; g < total; ++g) {
            if (lg < total) issue();
            const LAS unsigned char* base = lds + (g & 3) * STAGE;
            bf16x8 af[4], bfr[8];
#pragma unroll
            for (int mi = 0; mi < 4; ++mi) af[mi] = *(const LAS bf16x8*)(base + a_rd[mi]);
#pragma unroll
            for (int ni = 0; ni < 8; ++ni) {
                const int u0 = wn * 8 + ni;
                const s16x4 lo = lds_tr(base + b_rd[0] + ((u0 ^ b_f[0]) << 5));
                const s16x4 hi = lds_tr(base + b_rd[1] + ((u0 ^ b_f[1]) << 5));
                bfr[ni] = (bf16x8){lo[0], lo[1], lo[2], lo[3], hi[0], hi[1], hi[2], hi[3]};
            }
            { const int rem = total - 2 - g;
              if (rem >= 2) asm volatile("s_waitcnt vmcnt(8)" ::: "memory"); else if (rem == 1) asm volatile("s_waitcnt vmcnt(4)" ::: "memory"); else asm volatile("s_waitcnt vmcnt(0)" ::: "memory"); }
            bar();
            __builtin_amdgcn_sched_barrier(0);
#pragma unroll
            for (int ni = 0; ni < 8; ++ni)
#pragma unroll
                for (int mi = 0; mi < 4; ++mi) acc[mi][ni] = __builtin_amdgcn_mfma_f32_16x16x32_bf16(bfr[ni], af[mi], acc[mi][ni], 0, 0, 0);
            __builtin_amdgcn_sched_barrier(0);
            bar();
            if (++ckt == KT) {
                if (!grp) bar();
                f.epi(cseg, acc);
#pragma unroll
                for (int mi = 0; mi < 4; ++mi)
#pragma unroll
                    for (int ni = 0; ni < 8; ++ni) acc[mi][ni] = (f32x4){0.f, 0.f, 0.f, 0.f};
                ckt = 0; ++cseg;
                if (grp) bar();
            }
        }
        if (!grp) bar();
    }
};

struct Gemm8 {
    static constexpr int A_BYTES = 16384, STAGE = 32768;
    static __device__ __forceinline__ int t_row(int i, int w, int lane) { return (i * 8 + w) * 16 + (lane >> 2); }
    static __device__ __forceinline__ int t_chunk(int row, int lane) { return (lane & 3) ^ ((row >> 1) & 3); }
    static __device__ __forceinline__ int w_col(int i) { return 16 * ((i >> 2) & 1) + 4 * (i >> 3) + (i & 3); }
    template <class F> static __device__ __forceinline__ void run_stream(F& f, int NSEG, int KT, LAS unsigned char* lds) {
        const int tid = opaque_tid(), lane = tid & 63, wid = tid >> 6, wm = wid >> 1, wn = wid & 1, l31 = lane & 31, hi = lane >> 5;
        const int wu = __builtin_amdgcn_readfirstlane(wid);
        f32x16 acc[2][4];
#pragma unroll
        for (int jt = 0; jt < 2; ++jt)
#pragma unroll
            for (int it = 0; it < 4; ++it)
#pragma unroll
                for (int r = 0; r < 16; ++r) acc[jt][it][r] = 0.f;
        const int sw = (l31 >> 1) & 3;
        const int t_rd0 = (wm * 64 + l31) * 64 + (((2 * hi) ^ sw) << 4), t_rd1 = (wm * 64 + l31) * 64 + (((2 * hi + 1) ^ sw) << 4);
        const int w_rd0 = A_BYTES + (wn * 128 + l31) * 64 + (((2 * hi) ^ sw) << 4), w_rd1 = A_BYTES + (wn * 128 + l31) * 64 + (((2 * hi + 1) ^ sw) << 4);
        const unsigned lds0 = (unsigned)(uintptr_t)lds + (unsigned)wu * 1024u;
        const unsigned char* aptr[2]; const unsigned char* wptr[2];
        const int total = NSEG * KT;
        int lseg = 0, lkt = 0, lg = 0;
        auto issue = [&]() {
            const unsigned base = (unsigned)__builtin_amdgcn_readfirstlane((int)(lds0 + (unsigned)(lg & 3) * STAGE));
#pragma unroll
            for (int i = 0; i < 2; ++i) glds16(aptr[i] + lkt * 64, base + i * 8192);
#pragma unroll
            for (int i = 0; i < 2; ++i) glds16(wptr[i] + lkt * 64, base + A_BYTES + i * 8192);
            ++lg; if (++lkt == KT) { lkt = 0; ++lseg; if (lseg < NSEG) f.ptrs(lseg, aptr, wptr); }
        };
        const int grp = wu >> 2;
        auto bar = [&]() { asm volatile("s_waitcnt lgkmcnt(0)" ::: "memory"); __builtin_amdgcn_s_barrier(); asm volatile("" ::: "memory"); };
        f.ptrs(0, aptr, wptr);
        asm volatile("s_waitcnt vmcnt(0)" ::: "memory");
        issue(); if (total > 1) issue(); if (total > 2) issue();
        if (total > 2) asm volatile("s_waitcnt vmcnt(8)" ::: "memory"); else if (total > 1) asm volatile("s_waitcnt vmcnt(4)" ::: "memory"); else asm volatile("s_waitcnt vmcnt(0)" ::: "memory");
        bar();
        if (grp) bar();
        int cseg = 0, ckt = 0;
#pragma unroll 1
        for (int g = 0; g < total; ++g) {
            if (lg < total) issue();
            const LAS unsigned char* base = lds + (g & 3) * STAGE;
            i32x8 tf[2], wf[4];
#pragma unroll
            for (int jt = 0; jt < 2; ++jt) { const u32x4 lo = *(const LAS u32x4*)(base + t_rd0 + jt * 2048), h4 = *(const LAS u32x4*)(base + t_rd1 + jt * 2048);
                tf[jt] = (i32x8){(int)lo.x, (int)lo.y, (int)lo.z, (int)lo.w, (int)h4.x, (int)h4.y, (int)h4.z, (int)h4.w}; }
#pragma unroll
            for (int it = 0; it < 4; ++it) { const u32x4 lo = *(const LAS u32x4*)(base + w_rd0 + it * 2048), h4 = *(const LAS u32x4*)(base + w_rd1 + it * 2048);
                wf[it] = (i32x8){(int)lo.x, (int)lo.y, (int)lo.z, (int)lo.w, (int)h4.x, (int)h4.y, (int)h4.z, (int)h4.w}; }
            { const int rem = total - 2 - g;
              if (rem >= 2) asm volatile("s_waitcnt vmcnt(8)" ::: "memory"); else if (rem == 1) asm volatile("s_waitcnt vmcnt(4)" ::: "memory"); else asm volatile("s_waitcnt vmcnt(0)" ::: "memory"); }
            bar();
            __builtin_amdgcn_sched_barrier(0);
#pragma unroll
            for (int it = 0; it < 4; ++it)
#pragma unroll
                for (int jt = 0; jt < 2; ++jt) acc[jt][it] = __builtin_amdgcn_mfma_scale_f32_32x32x64_f8f6f4(wf[it], tf[jt], acc[jt][it], 0, 0, 0, F::wscale(it), 0, 127);
            __builtin_amdgcn_sched_barrier(0);
            bar();
            if (++ckt == KT) {
                if (!grp) bar();
                f.epi(cseg, acc);
#pragma unroll
                for (int jt = 0; jt < 2; ++jt)
#pragma unroll
                    for (int it = 0; it < 4; ++it)
#pragma unroll
                        for (int r = 0; r < 16; ++r) acc[jt][it][r] = 0.f;
                ckt = 0; ++cseg;
                if (grp) bar();
            }
        }
        if (!grp) bar();
    }
};

struct Gemm4 {
    static constexpr int A_BYTES = 16384, STAGE = 32768, LDS_BYTES = 2 * STAGE;
    static __device__ __forceinline__ int fk2(int r) { return (r & 3) | (((r >> 3) & 1) << 2); }
    static __device__ __forceinline__ int a_row(int i, int tid) { return (tid >> 2) + 128 * i; }
    static __device__ __forceinline__ int b_k(int i, int tid) { return (tid >> 5) + 16 * i; }
    static __device__ __forceinline__ void run(f32x4 (&acc)[4][8], const bf16_t* const (&aptr)[2], int a_kstride, const bf16_t* const (&bptr)[2], size_t b_kstride, int KT, LAS unsigned char* lds) {
        const int tid = opaque_tid(), lane = tid & 63, wid = tid >> 6, wm = wid >> 1, wn = wid & 1, fr = lane & 15, fq = lane >> 4;
#pragma unroll
        for (int mi = 0; mi < 4; ++mi)
#pragma unroll
            for (int ni = 0; ni < 8; ++ni) acc[mi][ni] = (f32x4){0.f, 0.f, 0.f, 0.f};
        int a_wr[2], b_wr[2];
#pragma unroll
        for (int i = 0; i < 2; ++i) { const int row = a_row(i, tid); a_wr[i] = row * 64 + (((tid & 3) ^ ((row >> 1) & 3)) << 4);
            const int k = b_k(i, tid), n = (tid & 31) * 8; b_wr[i] = A_BYTES + k * 512 + (((n >> 4) ^ fk2(k)) << 5) + ((n & 15) << 1); }
        int a_rd[4];
#pragma unroll
        for (int mi = 0; mi < 4; ++mi) { const int row = wm * 64 + mi * 16 + fr; a_rd[mi] = row * 64 + ((fq ^ ((row >> 1) & 3)) << 4); }
        int b_rd[2], b_f[2];
#pragma unroll
        for (int t = 0; t < 2; ++t) { const int k = 8 * fq + 4 * t + (fr >> 2); b_f[t] = fk2(k); b_rd[t] = A_BYTES + k * 512 + ((fr & 3) << 3); }
        u32x4 ra0[2], rb0[2], ra1[2], rb1[2];
        auto gload = [&](int kt, u32x4 (&ra)[2], u32x4 (&rb)[2]) {
#pragma unroll
            for (int i = 0; i < 2; ++i) { ra[i] = *(const u32x4*)(aptr[i] + (size_t)kt * a_kstride); rb[i] = *(const u32x4*)(bptr[i] + (size_t)kt * b_kstride); }
        };
        auto lstore = [&](int buf, const u32x4 (&ra)[2], const u32x4 (&rb)[2]) {
            LAS unsigned char* base = lds + buf * STAGE;
#pragma unroll
            for (int i = 0; i < 2; ++i) { *(LAS u32x4*)(base + a_wr[i]) = ra[i]; *(LAS u32x4*)(base + b_wr[i]) = rb[i]; }
        };
        auto compute = [&](int buf) {
            const LAS unsigned char* base = lds + buf * STAGE;
            bf16x8 af[4];
#pragma unroll
            for (int mi = 0; mi < 4; ++mi) af[mi] = *(const LAS bf16x8*)(base + a_rd[mi]);
#pragma unroll
            for (int ni = 0; ni < 8; ++ni) {
                const int u0 = wn * 8 + ni;
                const s16x4 lo = lds_tr(base + b_rd[0] + ((u0 ^ b_f[0]) << 5));
                const s16x4 hi = lds_tr(base + b_rd[1] + ((u0 ^ b_f[1]) << 5));
                const bf16x8 bfr = (bf16x8){lo[0], lo[1], lo[2], lo[3], hi[0], hi[1], hi[2], hi[3]};
#pragma unroll
                for (int mi = 0; mi < 4; ++mi) acc[mi][ni] = __builtin_amdgcn_mfma_f32_16x16x32_bf16(bfr, af[mi], acc[mi][ni], 0, 0, 0);
            }
        };
        gload(0, ra0, rb0); gload(1, ra1, rb1);
        lstore(0, ra0, rb0); __syncthreads();
        for (int kt = 0; kt < KT; kt += 2) {
            gload(kt + 2 < KT ? kt + 2 : KT - 1, ra0, rb0);
            __builtin_amdgcn_sched_barrier(0);
            compute(0);
            lstore(1, ra1, rb1);
            __syncthreads();
            gload(kt + 3 < KT ? kt + 3 : KT - 1, ra1, rb1);
            __builtin_amdgcn_sched_barrier(0);
            compute(1);
            lstore(0, ra0, rb0);
            __syncthreads();
        }
    }

    template <class F> static __device__ __forceinline__ void run_stream(F& f, int NSEG, int KT, int a_kstride, size_t b_kstride, LAS unsigned char* lds) {
        const int tid = opaque_tid(), lane = tid & 63, wid = tid >> 6, wm = wid >> 1, wn = wid & 1, fr = lane & 15, fq = lane >> 4;
        f32x4 acc[4][8];
#pragma unroll
        for (int mi = 0; mi < 4; ++mi)
#pragma unroll
            for (int ni = 0; ni < 8; ++ni) acc[mi][ni] = (f32x4){0.f, 0.f, 0.f, 0.f};
        int a_wr[2], b_wr[2];
#pragma unroll
        for (int i = 0; i < 2; ++i) { const int row = a_row(i, tid); a_wr[i] = row * 64 + (((tid & 3) ^ ((row >> 1) & 3)) << 4);
            const int k = b_k(i, tid), n = (tid & 31) * 8; b_wr[i] = A_BYTES + k * 512 + (((n >> 4) ^ fk2(k)) << 5) + ((n & 15) << 1); }
        int a_rd[4];
#pragma unroll
        for (int mi = 0; mi < 4; ++mi) { const int row = wm * 64 + mi * 16 + fr; a_rd[mi] = row * 64 + ((fq ^ ((row >> 1) & 3)) << 4); }
        int b_rd[2], b_f[2];
#pragma unroll
        for (int t = 0; t < 2; ++t) { const int k = 8 * fq + 4 * t + (fr >> 2); b_f[t] = fk2(k); b_rd[t] = A_BYTES + k * 512 + ((fr & 3) << 3); }
        const bf16_t* aptr[2]; const bf16_t* bptr[2];
        u32x4 ra0[2], rb0[2], ra1[2], rb1[2];
        int lseg = 0, lkt = 0;
        auto gload = [&](u32x4 (&ra)[2], u32x4 (&rb)[2]) {
#pragma unroll
            for (int i = 0; i < 2; ++i) { ra[i] = *(const u32x4*)(aptr[i] + (size_t)lkt * a_kstride); rb[i] = *(const u32x4*)(bptr[i] + (size_t)lkt * b_kstride); }
            if (lkt + 1 < KT) ++lkt; else if (lseg + 1 < NSEG) { lkt = 0; ++lseg; f.ptrs(lseg, aptr, bptr); }
        };
        auto lstore = [&](int buf, const u32x4 (&ra)[2], const u32x4 (&rb)[2]) {
            LAS unsigned char* base = lds + buf * STAGE;
#pragma unroll
            for (int i = 0; i < 2; ++i) { *(LAS u32x4*)(base + a_wr[i]) = ra[i]; *(LAS u32x4*)(base + b_wr[i]) = rb[i]; }
        };
        auto compute = [&](int buf) {
            const LAS unsigned char* base = lds + buf * STAGE;
            bf16x8 af[4];
#pragma unroll
            for (int mi = 0; mi < 4; ++mi) af[mi] = *(const LAS bf16x8*)(base + a_rd[mi]);
#pragma unroll
            for (int ni = 0; ni < 8; ++ni) {
                const int u0 = wn * 8 + ni;
                const s16x4 lo = lds_tr(base + b_rd[0] + ((u0 ^ b_f[0]) << 5));
                const s16x4 hi = lds_tr(base + b_rd[1] + ((u0 ^ b_f[1]) << 5));
                const bf16x8 bfr = (bf16x8){lo[0], lo[1], lo[2], lo[3], hi[0], hi[1], hi[2], hi[3]};
#pragma unroll
                for (int mi = 0; mi < 4; ++mi) acc[mi][ni] = __builtin_amdgcn_mfma_f32_16x16x32_bf16(bfr, af[mi], acc[mi][ni], 0, 0, 0);
            }
        };
        f.ptrs(0, aptr, bptr);
        gload(ra0, rb0); gload(ra1, rb1);
        lstore(0, ra0, rb0); __syncthreads();
        int cseg = 0, ckt = 0;
        const int total = NSEG * KT;
#pragma unroll 1
        for (int g = 0; g < total; g += 2) {
            gload(ra0, rb0);
            __builtin_amdgcn_sched_barrier(0);
            compute(0);
            lstore(1, ra1, rb1);
            __syncthreads();
            gload(ra1, rb1);
            __builtin_amdgcn_sched_barrier(0);
            compute(1);
            lstore(0, ra0, rb0);
            __syncthreads();
            ckt += 2;
            if (ckt == KT) {
                f.epi(cseg, acc);
#pragma unroll
                for (int mi = 0; mi < 4; ++mi)
#pragma unroll
                    for (int ni = 0; ni < 8; ++ni) acc[mi][ni] = (f32x4){0.f, 0.f, 0.f, 0.f};
                ckt = 0; ++cseg;
            }
        }
    }
};

template <bool BF32> struct Gemm5 {
    static constexpr int A_BYTES = 16384, STAGE = 32768, LDS_BYTES = 2 * STAGE;
    static __device__ __forceinline__ int fk2(int r) { return (r & 3) | (((r >> 3) & 1) << 2); }
    static __device__ __forceinline__ int a_row(int i, int tid) { return (tid >> 2) + 128 * i; }
    static __device__ __forceinline__ int b_k(int i, int tid) { return (tid >> 5) + 16 * i; }
    typedef typename std::conditional<BF32, float, bf16_t>::type b_t;
    static __device__ __forceinline__ void run(f32x4 (&acc)[4][8], const bf16_t* const (&aptr)[2], int a_kstride, const b_t* const (&bptr)[2], size_t b_kstride, int KT, LAS unsigned char* lds) {
        const int tid = opaque_tid(), lane = tid & 63, wid = tid >> 6, wm = wid >> 1, wn = wid & 1, fr = lane & 15, fq = lane >> 4;
#pragma unroll
        for (int mi = 0; mi < 4; ++mi)
#pragma unroll
            for (int ni = 0; ni < 8; ++ni) acc[mi][ni] = (f32x4){0.f, 0.f, 0.f, 0.f};
        int a_wr[2], b_wr[2];
#pragma unroll
        for (int i = 0; i < 2; ++i) { const int row = a_row(i, tid); a_wr[i] = row * 64 + (((tid & 3) ^ ((row >> 1) & 3)) << 4);
            const int k = b_k(i, tid), n = (tid & 31) * 8; b_wr[i] = A_BYTES + k * 512 + (((n >> 4) ^ fk2(k)) << 5) + ((n & 15) << 1); }
        int a_rd[4];
#pragma unroll
        for (int mi = 0; mi < 4; ++mi) { const int row = wm * 64 + mi * 16 + fr; a_rd[mi] = row * 64 + ((fq ^ ((row >> 1) & 3)) << 4); }
        int b_rd[2], b_f[2];
#pragma unroll
        for (int t = 0; t < 2; ++t) { const int k = 8 * fq + 4 * t + (fr >> 2); b_f[t] = fk2(k); b_rd[t] = A_BYTES + k * 512 + ((fr & 3) << 3); }
        u32x4 ra[2]; u32x4 rb[2]; f32x4 rbf[2][2];
        auto gload = [&](int kt) {
#pragma unroll
            for (int i = 0; i < 2; ++i) { ra[i] = *(const u32x4*)(aptr[i] + (size_t)kt * a_kstride);
                if (BF32) { const float* p = (const float*)bptr[i] + (size_t)kt * b_kstride; rbf[i][0] = *(const f32x4*)p; rbf[i][1] = *(const f32x4*)(p + 4); }
                else rb[i] = *(const u32x4*)((const bf16_t*)bptr[i] + (size_t)kt * b_kstride); }
        };
        auto lstore = [&](int buf) {
            LAS unsigned char* base = lds + buf * STAGE;
#pragma unroll
            for (int i = 0; i < 2; ++i) { *(LAS u32x4*)(base + a_wr[i]) = ra[i];
                if (BF32) { u32x4 w; w.x = cvtpk(rbf[i][0].x, rbf[i][0].y); w.y = cvtpk(rbf[i][0].z, rbf[i][0].w); w.z = cvtpk(rbf[i][1].x, rbf[i][1].y); w.w = cvtpk(rbf[i][1].z, rbf[i][1].w); *(LAS u32x4*)(base + b_wr[i]) = w; }
                else *(LAS u32x4*)(base + b_wr[i]) = rb[i]; }
        };
        auto compute = [&](int buf) {
            const LAS unsigned char* base = lds + buf * STAGE;
            bf16x8 af[4];
#pragma unroll
            for (int mi = 0; mi < 4; ++mi) af[mi] = *(const LAS bf16x8*)(base + a_rd[mi]);
#pragma unroll
            for (int ni = 0; ni < 8; ++ni) {
                const int u0 = wn * 8 + ni;
                const s16x4 lo = lds_tr(base + b_rd[0] + ((u0 ^ b_f[0]) << 5));
                const s16x4 hi = lds_tr(base + b_rd[1] + ((u0 ^ b_f[1]) << 5));
                const bf16x8 bfr = (bf16x8){lo[0], lo[1], lo[2], lo[3], hi[0], hi[1], hi[2], hi[3]};
#pragma unroll
                for (int mi = 0; mi < 4; ++mi) acc[mi][ni] = __builtin_amdgcn_mfma_f32_16x16x32_bf16(bfr, af[mi], acc[mi][ni], 0, 0, 0);
            }
        };
        gload(0); lstore(0); __syncthreads();
#pragma unroll 1
        for (int kt = 0; kt < KT; ++kt) {
            gload(kt + 1 < KT ? kt + 1 : KT - 1);
            __builtin_amdgcn_sched_barrier(0);
            compute(kt & 1);
            lstore((kt + 1) & 1);
            __syncthreads();
        }
    }

    template <class F> static __device__ __forceinline__ void run_stream(F& f, int NSEG, int KT, int a_kstride, size_t b_kstride, LAS unsigned char* lds) {
        const int tid = opaque_tid(), lane = tid & 63, wid = tid >> 6, wm = wid >> 1, wn = wid & 1, fr = lane & 15, fq = lane >> 4;
        f32x4 acc[4][8];
#pragma unroll
        for (int mi = 0; mi < 4; ++mi)
#pragma unroll
            for (int ni = 0; ni < 8; ++ni) acc[mi][ni] = (f32x4){0.f, 0.f, 0.f, 0.f};
        int a_wr[2], b_wr[2];
#pragma unroll
        for (int i = 0; i < 2; ++i) { const int row = a_row(i, tid); a_wr[i] = row * 64 + (((tid & 3) ^ ((row >> 1) & 3)) << 4);
            const int k = b_k(i, tid), n = (tid & 31) * 8; b_wr[i] = A_BYTES + k * 512 + (((n >> 4) ^ fk2(k)) << 5) + ((n & 15) << 1); }
        int a_rd[4];
#pragma unroll
        for (int mi = 0; mi < 4; ++mi) { const int row = wm * 64 + mi * 16 + fr; a_rd[mi] = row * 64 + ((fq ^ ((row >> 1) & 3)) << 4); }
        int b_rd[2], b_f[2];
#pragma unroll
        for (int t = 0; t < 2; ++t) { const int k = 8 * fq + 4 * t + (fr >> 2); b_f[t] = fk2(k); b_rd[t] = A_BYTES + k * 512 + ((fr & 3) << 3); }
        const bf16_t* aptr[2]; const b_t* bptr[2];
        u32x4 ra[2]; u32x4 rb[2]; f32x4 rbf[2][2];
        auto gload = [&](int kt) {
#pragma unroll
            for (int i = 0; i < 2; ++i) { ra[i] = *(const u32x4*)(aptr[i] + (size_t)kt * a_kstride);
                if (BF32) { const float* p = (const float*)bptr[i] + (size_t)kt * b_kstride; rbf[i][0] = *(const f32x4*)p; rbf[i][1] = *(const f32x4*)(p + 4); }
                else rb[i] = *(const u32x4*)((const bf16_t*)bptr[i] + (size_t)kt * b_kstride); }
        };
        auto lstore = [&](int buf) {
            LAS unsigned char* base = lds + buf * STAGE;
#pragma unroll
            for (int i = 0; i < 2; ++i) { *(LAS u32x4*)(base + a_wr[i]) = ra[i];
                if (BF32) { u32x4 w; w.x = cvtpk(rbf[i][0].x, rbf[i][0].y); w.y = cvtpk(rbf[i][0].z, rbf[i][0].w); w.z = cvtpk(rbf[i][1].x, rbf[i][1].y); w.w = cvtpk(rbf[i][1].z, rbf[i][1].w); *(LAS u32x4*)(base + b_wr[i]) = w; }
                else *(LAS u32x4*)(base + b_wr[i]) = rb[i]; }
        };
        auto compute = [&](int buf) {
            const LAS unsigned char* base = lds + buf * STAGE;
            bf16x8 af[4];
#pragma unroll
            for (int mi = 0; mi < 4; ++mi) af[mi] = *(const LAS bf16x8*)(base + a_rd[mi]);
#pragma unroll
            for (int ni = 0; ni < 8; ++ni) {
                const int u0 = wn * 8 + ni;
                const s16x4 lo = lds_tr(base + b_rd[0] + ((u0 ^ b_f[0]) << 5));
                const s16x4 hi = lds_tr(base + b_rd[1] + ((u0 ^ b_f[1]) << 5));
                const bf16x8 bfr = (bf16x8){lo[0], lo[1], lo[2], lo[3], hi[0], hi[1], hi[2], hi[3]};
#pragma unroll
                for (int mi = 0; mi < 4; ++mi) acc[mi][ni] = __builtin_amdgcn_mfma_f32_16x16x32_bf16(bfr, af[mi], acc[mi][ni], 0, 0, 0);
            }
        };
        f.ptrs(0, aptr, bptr);
        gload(0); lstore(0); __syncthreads();
        int seg = 0, kt = 0;
        const int total = NSEG * KT;
#pragma unroll 1
        for (int g = 0; g < total; ++g) {
            int nkt = kt + 1, nsg = seg; if (nkt == KT) { nkt = 0; nsg = seg + 1; }
            if (nkt == 0 && nsg < NSEG) f.ptrs(nsg, aptr, bptr);
            gload(nsg < NSEG ? nkt : KT - 1);
            __builtin_amdgcn_sched_barrier(0);
            compute(g & 1);
            lstore((g + 1) & 1);
            __syncthreads();
            if (nkt == 0) {
                f.epi(seg, acc);
#pragma unroll
                for (int mi = 0; mi < 4; ++mi)
#pragma unroll
                    for (int ni = 0; ni < 8; ++ni) acc[mi][ni] = (f32x4){0.f, 0.f, 0.f, 0.f};
            }
            seg = nsg; kt = nkt;
        }
    }
};

__device__ __forceinline__ int p2_col(int m0);
__device__ __forceinline__ unsigned pk4_fp8(float a, float b, float c, float d) { int pk = __builtin_amdgcn_cvt_pk_fp8_f32(a, b, 0, false); pk = __builtin_amdgcn_cvt_pk_fp8_f32(c, d, pk, true); return (unsigned)pk; }
__device__ __forceinline__ int w8_col(int i) { return 16 * ((i >> 2) & 1) + 4 * (i >> 3) + (i & 3); }
__device__ __forceinline__ void phase_mod(const Params& P, LAS unsigned char* lds) {
    const int tid = threadIdx.x;
    float* mod = (float*)(P.ws + WS_MOD);
    LAS float* sc = (LAS float*)lds;
    LAS float* red = (LAS float*)(lds + 16384);
    for (int i = tid; i < 4096; i += NTHREADS) sc[i] = siluf_(P.c[i]);
    __syncthreads();
    const int kq = tid >> 5, cl = tid & 31;
    for (int u = blockIdx.x; u < 192; u += gridDim.x) {
        const int j = u * 32 + cl;
        float a0 = 0.f, a1 = 0.f, a2 = 0.f, a3 = 0.f;
#pragma unroll 8
        for (int k = kq; k < 1024; k += 16) { const float w = P.ada_w[(size_t)k * 6144 + j];
            a0 += sc[k] * w; a1 += sc[1024 + k] * w; a2 += sc[2048 + k] * w; a3 += sc[3072 + k] * w; }
        red[(kq * 4 + 0) * 32 + cl] = a0; red[(kq * 4 + 1) * 32 + cl] = a1; red[(kq * 4 + 2) * 32 + cl] = a2; red[(kq * 4 + 3) * 32 + cl] = a3;
        __syncthreads();
        if (tid < 128) { const int b = tid >> 5; float s = 0.f;
#pragma unroll
            for (int q = 0; q < 16; ++q) s += red[(q * 4 + b) * 32 + cl];
            mod[b * 6144 + j] = s + P.ada_b[j]; }
        __syncthreads();
    }
    for (int u = blockIdx.x; u < 16; u += gridDim.x) {
        const int sel = u >> 3, j = (u & 7) * 32 + cl;
        const float* w1 = P.cmp_w1 + (size_t)sel * 2048 * 256; const float* pos = P.cmp_pos + sel * 2048;
        float a0 = 0.f;
#pragma unroll 8
        for (int k = kq; k < 2048; k += 16) a0 += pos[k] * w1[(size_t)k * 256 + j];
        red[kq * 32 + cl] = a0;
        __syncthreads();
        if (tid < 32) { float s = 0.f;
#pragma unroll
            for (int q = 0; q < 16; ++q) s += red[q * 32 + cl];
            ((float*)(P.ws + WS_CB))[sel * 256 + j] = s + P.cmp_b1[sel * 256 + j]; }
        __syncthreads();
    }
    {
        unsigned char* wb = (unsigned char*)(P.ws + WS_WIN);
        const int lane = tid & 63, gw = blockIdx.x * (NTHREADS / 64) + (tid >> 6), NGW = gridDim.x * (NTHREADS / 64);
        for (int u = gw; u < 56 * 16; u += NGW) {
            const int rg = u % 56, kb = u / 56, q = rg * 64 + lane, c8 = (q & ~31) + w8_col(q & 31);
            const int sc_ = c8 < 1280 ? c8 : (c8 < 3328 ? c8 + 24 : c8 - 2048);
            const float* s = P.w_in + (size_t)(kb * 64) * IN_COLS + (c8 < 3352 ? sc_ : 0);
            float v[64];
#pragma unroll
            for (int j = 0; j < 64; ++j) v[j] = s[(size_t)j * IN_COLS];
            const float c_ = c8 < 3352 ? 64.0f : 0.0f;
#pragma unroll
            for (int j = 0; j < 4; ++j) { u32x4 w;
                w.x = pk4_fp8(v[16 * j] * c_, v[16 * j + 1] * c_, v[16 * j + 2] * c_, v[16 * j + 3] * c_); w.y = pk4_fp8(v[16 * j + 4] * c_, v[16 * j + 5] * c_, v[16 * j + 6] * c_, v[16 * j + 7] * c_);
                w.z = pk4_fp8(v[16 * j + 8] * c_, v[16 * j + 9] * c_, v[16 * j + 10] * c_, v[16 * j + 11] * c_); w.w = pk4_fp8(v[16 * j + 12] * c_, v[16 * j + 13] * c_, v[16 * j + 14] * c_, v[16 * j + 15] * c_);
                *(u32x4*)(wb + (size_t)q * 1024 + kb * 64 + j * 16) = w; }
        }
    }
    if (blockIdx.x == gridDim.x - 2) {
        for (int i = tid; i < 2 * 8 * 64; i += NTHREADS) { const int t2 = i >> 9, bg = (i >> 6) & 7, d = i & 63;
            ((bf16_t*)(P.ws + (t2 ? WS_VC : WS_KC)))[((size_t)bg * 512 + 511) * 64 + d] = 0; }
    }
    if (blockIdx.x == gridDim.x - 1) {
        float* lb = (float*)(P.ws + WS_LB);
        for (int i = tid; i < 512; i += NTHREADS) { const float p0 = P.hgrn_lb[i], p1 = P.hgrn_lb[512 + i]; lb[i] = 1.0f / (1.0f + __expf(p1 - p0)); }
    }
}

__device__ __forceinline__ void norm_mod_rows(const float* x, const float* w, const float* mod_sh, const float* mod_sc, unsigned char* h, int hs) {
    const int lane = threadIdx.x & 63, gw = blockIdx.x * (NTHREADS / 64) + (threadIdx.x >> 6), NGW = gridDim.x * (NTHREADS / 64);
    for (int m = gw; m < T; m += NGW) {
        const int b = m / SEQ;
        const f32x4* xr = (const f32x4*)(x + (size_t)m * D) + lane;
        f32x4 v[4]; float s = 0.f;
#pragma unroll
        for (int j = 0; j < 4; ++j) { v[j] = xr[64 * j]; s += (v[j].x * v[j].x + v[j].y * v[j].y) + (v[j].z * v[j].z + v[j].w * v[j].w); }
        const float rstd = rsqrtf(wave_sum(s) * (1.f / D) + RMS_EPS);
        unsigned* o = (unsigned*)(h + (size_t)m * hs) + lane;
#pragma unroll
        for (int j = 0; j < 4; ++j) {
            const int col = (lane + 64 * j) * 4;
            const f32x4 wv = *(const f32x4*)(w + col), scv = *(const f32x4*)(mod_sc + b * 6144 + col), shv = *(const f32x4*)(mod_sh + b * 6144 + col);
            f32x4 r;
            r.x = v[j].x * rstd * wv.x * (1.f + scv.x) + shv.x; r.y = v[j].y * rstd * wv.y * (1.f + scv.y) + shv.y;
            r.z = v[j].z * rstd * wv.z * (1.f + scv.z) + shv.z; r.w = v[j].w * rstd * wv.w * (1.f + scv.w) + shv.w;
            o[64 * j] = pk4_fp8(r.x, r.y, r.z, r.w);
        }
    }
}

__device__ __forceinline__ void phase_inproj(const Params& P, LAS unsigned char* lds) {
    constexpr int NRT = T / 256, NCT = 14;
    struct F { const Params& P;
        static __device__ __forceinline__ int wscale(int) { return 121; }
        __device__ __forceinline__ void unit(int seg, int& rt, int& ct) const {
            const int nx = (gridDim.x % 8 == 0) ? 8 : 1, xl = blockIdx.x % nx, li = blockIdx.x / nx, nloc = gridDim.x / nx;
            const int v = li + seg * nloc, rg = v / (NCT * 4), rem = v % (NCT * 4); ct = rem >> 2; rt = xl + nx * (rg * 4 + (rem & 3)); }
        __device__ __forceinline__ void ptrs(int seg, const unsigned char* (&aptr)[2], const unsigned char* (&wptr)[2]) const {
            const int tid = opaque_tid(), lane = tid & 63, wid = tid >> 6; int rt, ct; unit(seg, rt, ct);
            const unsigned char* h1 = (const unsigned char*)(P.ws + WS_H); const unsigned char* wb = (const unsigned char*)(P.ws + WS_WIN);
#pragma unroll
            for (int i = 0; i < 2; ++i) { const int row = Gemm8::t_row(i, wid, lane); aptr[i] = h1 + (size_t)(rt * 256 + row) * H1S + Gemm8::t_chunk(row, lane) * 16;
                wptr[i] = wb + (size_t)(ct * 256 + row) * 1024 + Gemm8::t_chunk(row, lane) * 16; } }
        __device__ __forceinline__ void epi(int seg, f32x16 (&acc)[2][4]) const {
            const int tid = opaque_tid(), lane = tid & 63, wid = tid >> 6, wm = wid >> 1, wn = wid & 1, l31 = lane & 31, hi = lane >> 5;
            int rt, ct; unit(seg, rt, ct);
            bf16_t* qo = (bf16_t*)(P.ws + WS_Q); bf16_t* kvo = (bf16_t*)(P.ws + WS_KV); float* gates = (float*)(P.ws + WS_GATES);
            bf16_t* hq = (bf16_t*)(P.ws + WS_HQ); bf16_t* logf = (bf16_t*)(P.ws + WS_LOGF); bf16_t* hv = (bf16_t*)(P.ws + WS_HV); bf16_t* hg = (bf16_t*)(P.ws + WS_HG);
            const float* lb = (const float*)(P.ws + WS_LB);
            const int row0 = rt * 256 + wm * 64 + l31;
            if (ct < 5) {
                const bool is_q = ct < 2; const int sg = (ct - 2) * 2 + wn;
                const bool do_norm = is_q || sg == 2 || sg == 4;
                const float* nw = is_q ? P.q_norm_w : (P.k_norm_w + (sg == 2 ? 64 : 128));
                const float osc = is_q ? 0.125f : 1.0f;
#pragma unroll
                for (int hh = 0; hh < 2; ++hh) {
#pragma unroll
                    for (int jt = 0; jt < 2; ++jt) {
                        float rstd = 1.f;
                        if (do_norm) { float s = 0.f;
#pragma unroll
                            for (int t2 = 0; t2 < 2; ++t2)
#pragma unroll
                                for (int r = 0; r < 16; ++r) { const float a = acc[jt][2 * hh + t2][r]; s += a * a; }
                            s += __shfl_xor(s, 32);
                            rstd = rsqrtf(s * (1.f / 64.f) + RMS_EPS) * osc; }
                        const size_t m = (size_t)(row0 + jt * 32);
                        bf16_t* dst = is_q ? (qo + m * 512 + ct * 256 + wn * 128 + hh * 64 + 16 * hi) : (kvo + m * 768 + (ct - 2) * 256 + wn * 128 + hh * 64 + 16 * hi);
#pragma unroll
                        for (int t2 = 0; t2 < 2; ++t2) { u32x4 w0, w1;
#pragma unroll
                            for (int q4 = 0; q4 < 4; ++q4) { const f32x4 wv = do_norm ? *(const f32x4*)(nw + t2 * 32 + 16 * hi + 4 * q4) : (f32x4){1.f, 1.f, 1.f, 1.f};
                                const unsigned lo = cvtpk(acc[jt][2 * hh + t2][4 * q4] * rstd * wv.x, acc[jt][2 * hh + t2][4 * q4 + 1] * rstd * wv.y), hi2 = cvtpk(acc[jt][2 * hh + t2][4 * q4 + 2] * rstd * wv.z, acc[jt][2 * hh + t2][4 * q4 + 3] * rstd * wv.w);
                                if (q4 < 2) { w0[2 * q4] = lo; w0[2 * q4 + 1] = hi2; } else { w1[2 * (q4 - 2)] = lo; w1[2 * (q4 - 2) + 1] = hi2; } }
                            *(u32x4*)(dst + t2 * 32) = w0; *(u32x4*)(dst + t2 * 32 + 8) = w1; }
                    }
                }
            } else if (ct == 13) {
                if (wn == 0) {
#pragma unroll
                    for (int jt = 0; jt < 2; ++jt) { const size_t m = (size_t)(row0 + jt * 32);
#pragma unroll
                        for (int q4 = 0; q4 < 4; ++q4) { const int c = 16 * hi + 4 * q4; if (c < 24) {
                                *(f32x4*)(gates + m * 24 + c) = (f32x4){sigmoidf_(acc[jt][0][4 * q4]), sigmoidf_(acc[jt][0][4 * q4 + 1]), sigmoidf_(acc[jt][0][4 * q4 + 2]), sigmoidf_(acc[jt][0][4 * q4 + 3])}; } } }
                }
            } else {
                const int hs = (ct - 5) >> 1, cc = ((ct - 5) & 1) * 256 + wn * 128 + 16 * hi;
#pragma unroll
                for (int jt = 0; jt < 2; ++jt) { const size_t m = (size_t)(row0 + jt * 32);
#pragma unroll
                    for (int it = 0; it < 4; ++it) { const int c = cc + it * 32;
                        if (hs == 1) { unsigned w8[8];
#pragma unroll
                            for (int q4 = 0; q4 < 4; ++q4) { const f32x4 l = *(const f32x4*)(lb + c + 4 * q4); f32x4 o;
                                o.x = __logf(l.x + (1.f - l.x) * sigmoidf_(acc[jt][it][4 * q4])); o.y = __logf(l.y + (1.f - l.y) * sigmoidf_(acc[jt][it][4 * q4 + 1]));
                                o.z = __logf(l.z + (1.f - l.z) * sigmoidf_(acc[jt][it][4 * q4 + 2])); o.w = __logf(l.w + (1.f - l.w) * sigmoidf_(acc[jt][it][4 * q4 + 3]));
                                w8[2 * q4] = cvtpk(o.x, o.y); w8[2 * q4 + 1] = cvtpk(o.z, o.w); }
                            *(u32x4*)(logf + m * 512 + c) = (u32x4){w8[0], w8[1], w8[2], w8[3]}; *(u32x4*)(logf + m * 512 + c + 8) = (u32x4){w8[4], w8[5], w8[6], w8[7]};
                        } else { float v[16];
#pragma unroll
                            for (int r = 0; r < 16; ++r) { const float a = acc[jt][it][r]; v[r] = hs == 0 ? siluf_(a) * 0.08838834764831845f : (hs == 2 ? a : sigmoidf_(a)); }
                            bf16_t* dst = (hs == 0 ? hq : (hs == 2 ? hv : hg)) + m * 512 + c;
                            *(u32x4*)dst = (u32x4){cvtpk(v[0], v[1]), cvtpk(v[2], v[3]), cvtpk(v[4], v[5]), cvtpk(v[6], v[7])};
                            *(u32x4*)(dst + 8) = (u32x4){cvtpk(v[8], v[9]), cvtpk(v[10], v[11]), cvtpk(v[12], v[13]), cvtpk(v[14], v[15])}; }
                    } }
            }
        }
    } f{P};
    const int nx = (gridDim.x % 8 == 0) ? 8 : 1, li = blockIdx.x / nx, nloc = gridDim.x / nx;
    const int nu = ((NRT / nx) * NCT - li + nloc - 1) / nloc;
    if (nu > 0) Gemm8::run_stream(f, nu, D / 64, lds);
}

__device__ __forceinline__ float gelu_tanh(float x) {
    const float u = 0.7978845608028654f * (x + 0.044715f * x * x * x);
    const float th = 1.0f - 2.0f / (1.0f + __expf(2.0f * u));
    return 0.5f * x * (1.0f + th);
}
__device__ __forceinline__ void compress_unit(const Params& P, LAS unsigned char* lds, int u) {
    typedef GemmT<2, 4> G;
    const int tid = opaque_tid(), lane = tid & 63, wid = tid >> 6, wm = wid >> 2, wn = wid & 3, fr = lane & 15, fq = lane >> 4;
    const int sel = u >> 5, rt = u & 31;
    const bf16_t* kv = (const bf16_t*)(P.ws + WS_KV);
    bf16_t* cmph = (bf16_t*)(P.ws + WS_CMPH) + (size_t)sel * 4096 * 256;
    const float* cb = (const float*)(P.ws + WS_CB) + sel * 256;
    const bf16_t* arow[2];
#pragma unroll
    for (int p = 0; p < 2; ++p) { int r = rt * 128 + p * 64 + (tid >> 3); r = r < 4088 ? r : 4087;
        const int b = r / 1022, rem = r % 1022, i = rem >> 1, g = rem & 1;
        arow[p] = kv + (size_t)(b * SEQ + 16 * i) * 768 + sel * 128 + g * 64; }
    f32x4 acc[4][4];
    G::run(acc, arow, 768, P.cmp_w1 + (size_t)sel * 2048 * 256, 256, 32, lds);
#pragma unroll
    for (int mi = 0; mi < 4; ++mi) { const size_t row = (size_t)(rt * 128 + wm * 64 + mi * 16 + fr);
#pragma unroll
        for (int ni = 0; ni < 4; ++ni) { const int col = wn * 64 + ni * 16 + 4 * fq; const f32x4 a = acc[mi][ni]; const f32x4 bb = *(const f32x4*)(cb + col);
            u32x2 pk; pk.x = cvtpk(gelu_tanh(a.x + bb.x), gelu_tanh(a.y + bb.y)); pk.y = cvtpk(gelu_tanh(a.z + bb.z), gelu_tanh(a.w + bb.w));
            *(u32x2*)(cmph + row * 256 + col) = pk; } }
    __syncthreads();
    {
        const int row = tid >> 2, cq = tid & 3;
        const bf16_t* hr = cmph + (size_t)(rt * 128 + row) * 256;
        const float* w2 = P.cmp_w2 + (size_t)sel * 256 * 64 + cq * 16;
        float o[16];
#pragma unroll
        for (int j = 0; j < 16; ++j) o[j] = 0.f;
        for (int k8 = 0; k8 < 256; k8 += 8) {
            const u32x4 hv = *(const u32x4*)(hr + k8);
#pragma unroll
            for (int kk = 0; kk < 8; ++kk) {
                const unsigned wd = hv[kk >> 1]; const float a = (kk & 1) ? __uint_as_float(wd & 0xffff0000u) : __uint_as_float(wd << 16);
                const float* wr = w2 + (size_t)(k8 + kk) * 64;
#pragma unroll
                for (int j4 = 0; j4 < 4; ++j4) { const f32x4 w = *(const f32x4*)(wr + j4 * 4);
                    o[j4 * 4 + 0] += a * w.x; o[j4 * 4 + 1] += a * w.y; o[j4 * 4 + 2] += a * w.z; o[j4 * 4 + 3] += a * w.w; }
            }
        }
        if (sel == 0) { float s = 0.f;
#pragma unroll
            for (int j = 0; j < 16; ++j) s += o[j] * o[j];
            s += __shfl_xor(s, 1); s += __shfl_xor(s, 2);
            const float rstd = rsqrtf(s * (1.f / 64.f) + RMS_EPS);
#pragma unroll
            for (int j = 0; j < 16; ++j) o[j] *= rstd * P.k_norm_w[cq * 16 + j]; }
        const int r = rt * 128 + row;
        if (r < 4088) { const int b = r / 1022, rem = r % 1022, i = rem >> 1, g = rem & 1;
            bf16_t* dst = (bf16_t*)(P.ws + (sel ? WS_VC : WS_KC)) + ((size_t)(b * 2 + g) * 512 + i) * 64 + cq * 16;
            u32x4 w0, w1;
            w0.x = cvtpk(o[0], o[1]); w0.y = cvtpk(o[2], o[3]); w0.z = cvtpk(o[4], o[5]); w0.w = cvtpk(o[6], o[7]);
            w1.x = cvtpk(o[8], o[9]); w1.y = cvtpk(o[10], o[11]); w1.z = cvtpk(o[12], o[13]); w1.w = cvtpk(o[14], o[15]);
            *(u32x4*)dst = w0; *(u32x4*)(dst + 8) = w1; }
    }
    __syncthreads();
}

__device__ __forceinline__ int off_row128(int row, int ch) { return row * 128 + ((ch ^ ((row >> 1) & 7)) << 4); }
__device__ __forceinline__ int off_row256(int row, int ch) { return row * 256 + ((ch ^ (row & 15)) << 4); }
__device__ __forceinline__ int fk_(int r) { return (r & 3) | (((r >> 3) & 1) << 2); }
__device__ __forceinline__ int off_tr256(int row, int col) { return row * 256 + ((((col >> 4) ^ fk_(row)) << 5) + ((col & 15) << 1)); }
constexpr int HL_QT = 0, HL_KT = 16384, HL_KH = 32768, HL_V = 49152, HL_SB = 65536, HL_P = 98304  , HL_TOT = 106496  , HL_RED = 110592  , HL_END = 111104;

template <int MODE> __device__ __forceinline__ void hgrn_unit(const Params& P, LAS unsigned char* lds, int u) {
    const int tid = opaque_tid(), lane = tid & 63, wid = tid >> 6, fr = lane & 15, fq = lane >> 4;
    const int b = u >> 7, h = (u >> 5) & 3, sc = u & 31;
    const bf16_t* hq = (const bf16_t*)(P.ws + WS_HQ); const bf16_t* logf = (const bf16_t*)(P.ws + WS_LOGF);
    const bf16_t* hv = (const bf16_t*)(P.ws + WS_HV); const bf16_t* hg = (const bf16_t*)(P.ws + WS_HG);
    float* HLs = (float*)(P.ws + WS_HL); float* HDs = (float*)(P.ws + WS_HD);
    bf16_t* mix = (bf16_t*)(P.ws + WS_MIX);
    LAS float* tot = (LAS float*)(lds + HL_TOT); LAS float* red = (LAS float*)(lds + HL_RED);
    f32x4 st[8];
#pragma unroll
    for (int vt = 0; vt < 8; ++vt) st[vt] = (f32x4){0.f, 0.f, 0.f, 0.f};
    if (MODE == 1) {
        const float* Lj = HLs + (size_t)u * 16384 + (16 * wid + fr) * 128 + 4 * fq;
#pragma unroll
        for (int vt = 0; vt < 8; ++vt) st[vt] = *(const f32x4*)(Lj + vt * 16);
    }
    float dsum = 0.f;
    const int kp = tid & 63, te = tid >> 6;
    for (int c = 0; c < 4; ++c) {
        const size_t tok0 = (size_t)b * SEQ + sc * 256 + c * 64;
        float lf0[8], lf1[8], cs0[8], cs1[8];
        { float a0 = 0.f, a1 = 0.f;
#pragma unroll
          for (int i = 0; i < 8; ++i) { const unsigned vr = *(const unsigned*)(logf + (tok0 + te * 8 + i) * 512 + h * 128 + 2 * kp); const float vx = __uint_as_float(vr << 16), vy = __uint_as_float(vr & 0xffff0000u); lf0[i] = vx; lf1[i] = vy; a0 += vx; a1 += vy; cs0[i] = a0; cs1[i] = a1; }
          tot[te * 128 + 2 * kp] = a0; tot[te * 128 + 2 * kp + 1] = a1; }
        unsigned qpre[8];
        if (MODE == 1) {
#pragma unroll
            for (int i = 0; i < 8; ++i) qpre[i] = *(const unsigned*)(hq + (tok0 + te * 8 + i) * 512 + h * 128 + 2 * kp);
        }
        u32x2 gpre[4];
        if (MODE == 1) {
#pragma unroll
            for (int i = 0; i < 4; ++i) gpre[i] = *(const u32x2*)(hg + (tok0 + (wid >> 1) * 16 + fr) * 512 + h * 128 + (4 * (wid & 1) + i) * 16 + 4 * fq);
        }
#pragma unroll
        for (int i = 0; i < 2; ++i) { const int pc = tid + NTHREADS * i, row = pc >> 4, c8 = (pc & 15) * 8;
            const u32x4 v = *(const u32x4*)(hv + (tok0 + row) * 512 + h * 128 + c8);
            *(LAS u32x4*)(lds + HL_V + off_tr256(row, c8)) = v; }
        if (MODE == 1 ) {
#pragma unroll
            for (int vt = 0; vt < 8; ++vt) { u32x2 pk; pk.x = cvtpk(st[vt].x, st[vt].y); pk.y = cvtpk(st[vt].z, st[vt].w);
                *(LAS u32x2*)(lds + HL_SB + off_tr256(16 * wid + fr, 16 * vt + 4 * fq)) = pk; }
        }
        __syncthreads();
        float pre0 = 0.f, pre1 = 0.f, last0 = 0.f, last1 = 0.f;
#pragma unroll
        for (int e = 0; e < 8; ++e) { const float t0 = tot[e * 128 + 2 * kp], t1 = tot[e * 128 + 2 * kp + 1]; if (e < te) { pre0 += t0; pre1 += t1; } last0 += t0; last1 += t1; }
#pragma unroll
        for (int i = 0; i < 8; ++i) {
            const int t = te * 8 + i;
            const float c0 = cs0[i] + pre0, c1 = cs1[i] + pre1;
            const float k0 = 1.f - __expf(lf0[i]), k1 = 1.f - __expf(lf1[i]);
            const unsigned khat = cvtpk(k0 * __expf(last0 - c0), k1 * __expf(last1 - c1));
            *(LAS unsigned*)(lds + HL_KH + off_tr256(t, 2 * kp)) = khat;
            if (MODE == 1) {
                const unsigned qraw = qpre[i];
                const float q0 = __uint_as_float(qraw << 16), q1 = __uint_as_float(qraw & 0xffff0000u);
                const unsigned qt = cvtpk(q0 * __expf(c0), q1 * __expf(c1));
                const unsigned kt = cvtpk(k0 * __expf(fminf(-c0, 80.f)), k1 * __expf(fminf(-c1, 80.f)));
                const int o = off_row256(t, kp >> 2) + ((kp & 3) << 2);
                *(LAS unsigned*)(lds + HL_QT + o) = qt; *(LAS unsigned*)(lds + HL_KT + o) = kt;
            }
        }
        const float dec = __expf(tot[0 * 128 + 16 * wid + fr] + tot[1 * 128 + 16 * wid + fr] + tot[2 * 128 + 16 * wid + fr] + tot[3 * 128 + 16 * wid + fr]
                                 + tot[4 * 128 + 16 * wid + fr] + tot[5 * 128 + 16 * wid + fr] + tot[6 * 128 + 16 * wid + fr] + tot[7 * 128 + 16 * wid + fr]);
        if (MODE == 0 && tid < 128) { float s = 0.f;
#pragma unroll
            for (int e = 0; e < 8; ++e) s += tot[e * 128 + tid];
            dsum += s; }
        __syncthreads();
        f32x4 oacc[4];
        if (MODE == 1) {
            { const int tt = wid & 3;
#pragma unroll
              for (int si = 0; si < 2; ++si) { const int stl = 2 * (wid >> 2) + si;
                  f32x4 sacc = (f32x4){0.f, 0.f, 0.f, 0.f};
                  if (stl <= tt) {
#pragma unroll
                      for (int ks = 0; ks < 4; ++ks) {
                          const bf16x8 a = *(const LAS bf16x8*)(lds + HL_KT + off_row256(stl * 16 + fr, ks * 4 + fq));
                          const bf16x8 bq = *(const LAS bf16x8*)(lds + HL_QT + off_row256(tt * 16 + fr, ks * 4 + fq));
                          sacc = __builtin_amdgcn_mfma_f32_16x16x32_bf16(a, bq, sacc, 0, 0, 0);
                      }
                  }
                  const int t = tt * 16 + fr, s0 = stl * 16 + 4 * fq;
                  u32x2 pk; pk.x = cvtpk(s0 + 0 <= t ? sacc.x : 0.f, s0 + 1 <= t ? sacc.y : 0.f); pk.y = cvtpk(s0 + 2 <= t ? sacc.z : 0.f, s0 + 3 <= t ? sacc.w : 0.f);
                  *(LAS u32x2*)(lds + HL_P + off_row128(t, s0 >> 3) + ((s0 & 7) << 1)) = pk; }
            }
            __syncthreads();
            { const int tt = wid >> 1;
#pragma unroll
              for (int i = 0; i < 4; ++i) { const int vt = 4 * (wid & 1) + i;
                  f32x4 a = (f32x4){0.f, 0.f, 0.f, 0.f};
#pragma unroll
                  for (int ks = 0; ks < 2; ++ks) {
                      const int kr = ks * 32 + 8 * fq + (fr >> 2);
                      const s16x4 lo = lds_tr(lds + HL_V + off_tr256(kr, vt * 16 + 4 * (fr & 3))), hi = lds_tr(lds + HL_V + off_tr256(kr + 4, vt * 16 + 4 * (fr & 3)));
                      const bf16x8 va = (bf16x8){lo[0], lo[1], lo[2], lo[3], hi[0], hi[1], hi[2], hi[3]};
                      const bf16x8 pb = *(const LAS bf16x8*)(lds + HL_P + off_row128(tt * 16 + fr, ks * 4 + fq));
                      a = __builtin_amdgcn_mfma_f32_16x16x32_bf16(va, pb, a, 0, 0, 0);
                  }
#pragma unroll
                  for (int ks = 0; ks < 4; ++ks) {
                      const int kr = ks * 32 + 8 * fq + (fr >> 2);
                      const s16x4 lo = lds_tr(lds + HL_SB + off_tr256(kr, vt * 16 + 4 * (fr & 3))), hi = lds_tr(lds + HL_SB + off_tr256(kr + 4, vt * 16 + 4 * (fr & 3)));
                      const bf16x8 sa = (bf16x8){lo[0], lo[1], lo[2], lo[3], hi[0], hi[1], hi[2], hi[3]};
                      const bf16x8 qb = *(const LAS bf16x8*)(lds + HL_QT + off_row256(tt * 16 + fr, ks * 4 + fq));
                      a = __builtin_amdgcn_mfma_f32_16x16x32_bf16(sa, qb, a, 0, 0, 0);
                  }
                  const u32x2 gr = gpre[i];
                  a.x *= __uint_as_float(gr.x << 16); a.y *= __uint_as_float(gr.x & 0xffff0000u); a.z *= __uint_as_float(gr.y << 16); a.w *= __uint_as_float(gr.y & 0xffff0000u);
                  oacc[i] = a; }
              float ss = 0.f;
#pragma unroll
              for (int i = 0; i < 4; ++i) ss += (oacc[i].x * oacc[i].x + oacc[i].y * oacc[i].y) + (oacc[i].z * oacc[i].z + oacc[i].w * oacc[i].w);
              ss += __shfl_xor(ss, 16); ss += __shfl_xor(ss, 32);
              if (fq == 0) red[(tt * 2 + (wid & 1)) * 16 + fr] = ss; }
        }
#pragma unroll
        for (int vt = 0; vt < 8; ++vt) {
            f32x4 a = st[vt] * dec;
#pragma unroll
            for (int ks = 0; ks < 2; ++ks) {
                const int kr = ks * 32 + 8 * fq + (fr >> 2);
                const s16x4 lo = lds_tr(lds + HL_V + off_tr256(kr, vt * 16 + 4 * (fr & 3))), hi = lds_tr(lds + HL_V + off_tr256(kr + 4, vt * 16 + 4 * (fr & 3)));
                const bf16x8 va = (bf16x8){lo[0], lo[1], lo[2], lo[3], hi[0], hi[1], hi[2], hi[3]};
                const s16x4 lo2 = lds_tr(lds + HL_KH + off_tr256(kr, wid * 16 + 4 * (fr & 3))), hi2 = lds_tr(lds + HL_KH + off_tr256(kr + 4, wid * 16 + 4 * (fr & 3)));
                const bf16x8 kb = (bf16x8){lo2[0], lo2[1], lo2[2], lo2[3], hi2[0], hi2[1], hi2[2], hi2[3]};
                a = __builtin_amdgcn_mfma_f32_16x16x32_bf16(va, kb, a, 0, 0, 0);
            }
            st[vt] = a;
        }
        __syncthreads();
        if (MODE == 1) {
            const int tt = wid >> 1; const float ssum = red[(tt * 2) * 16 + fr] + red[(tt * 2 + 1) * 16 + fr];
            const float rstd = rsqrtf(ssum * (1.f / 128.f) + RMS_EPS);
#pragma unroll
            for (int i = 0; i < 4; ++i) { const int v = (4 * (wid & 1) + i) * 16 + 4 * fq; const f32x4 w = *(const f32x4*)(P.rec_out_norm_w + h * 128 + v);
                u32x2 pk; pk.x = cvtpk(oacc[i].x * rstd * w.x, oacc[i].y * rstd * w.y); pk.y = cvtpk(oacc[i].z * rstd * w.z, oacc[i].w * rstd * w.w);
                *(u32x2*)(mix + (tok0 + tt * 16 + fr) * 1024 + 512 + h * 128 + v) = pk; }
        }
    }
    if (MODE == 0) {
#pragma unroll
        for (int vt = 0; vt < 8; ++vt) *(f32x4*)(HLs + (size_t)u * 16384 + (16 * wid + fr) * 128 + vt * 16 + 4 * fq) = st[vt];
        if (tid < 128) HDs[(size_t)u * 128 + tid] = __expf(dsum);
    }
    __syncthreads();
}


__device__ __forceinline__ void phase_hgrn_prefix(const Params& P) {
    float* HLs = (float*)(P.ws + WS_HL); const float* HDs = (const float*)(P.ws + WS_HD);
    const int gt = blockIdx.x * NTHREADS + threadIdx.x, NG = gridDim.x * NTHREADS;
    for (int e = gt; e < 16 * 4096; e += NG) {
        const int bh = e >> 12, q = e & 4095, kk = q >> 5;
        float* base = HLs + (size_t)bh * 32 * 16384 + q * 4; const float* db = HDs + (size_t)bh * 32 * 128 + kk;
        f32x4 s = (f32x4){0.f, 0.f, 0.f, 0.f};
#pragma unroll 1
        for (int g8 = 0; g8 < 32; g8 += 8) { f32x4 l[8]; float d[8];
#pragma unroll
            for (int j = 0; j < 8; ++j) { l[j] = *(const f32x4*)(base + (size_t)(g8 + j) * 16384); d[j] = db[(g8 + j) * 128]; }
#pragma unroll
            for (int j = 0; j < 8; ++j) { *(f32x4*)(base + (size_t)(g8 + j) * 16384) = s; s = s * d[j] + l[j]; } }
    }
}

constexpr int NL_K = 0, NL_V = 16384, NL_IMP = 32768, NL_IMP_STRIDE = 132, NL_SELM = NL_IMP + 8 * 8 * NL_IMP_STRIDE * 4, NL_END = NL_SELM + 1024;
__device__ __forceinline__ int off_v128(int row, int ch) { return row * 128 + ((ch ^ ((row & 3) << 1)) << 4); }
#define MFMA32(a, b, c) __builtin_amdgcn_mfma_f32_32x32x16_bf16(a, b, c, 0, 0, 0)

struct NsaLane { int t; float sl2; int qi; unsigned long long mlo, mhi; };

template <int MODE> __device__ __forceinline__ void nsa_pass(LAS unsigned char* lds, const bf16_t* Kg, const bf16_t* Vg, int rs, unsigned long long ulo, unsigned long long uhi,
                                                            const bf16x8 (&qf)[4], const NsaLane& L, float inv, float& lsum, f32x16 (&O)[2], LAS float* impw) {
    const int tid = opaque_tid(), lane = tid & 63, hi = lane >> 5, c = lane & 31;
    const int ld_row = tid >> 3, ld_ch = tid & 7;
    const int kw_off = off_row128(ld_row, ld_ch), vw_off = off_v128(ld_row, ld_ch);
    u32x4 k0, v0, k1, v1, k2, v2;
    auto next = [&](int jj) -> int { ++jj; if (jj < 64) { const unsigned long long m = ulo >> jj; if (m) return jj + __builtin_ctzll(m); jj = 64; }
                                     if (jj < 128) { const unsigned long long m = uhi >> (jj - 64); if (m) return jj + __builtin_ctzll(m); } return 128; };
    int jA = next(-1), jB = jA < 128 ? next(jA) : 128, jC = jB < 128 ? next(jB) : 128;
    const int jsafe = jA < 128 ? jA : 0;
    auto ldk = [&](int jj) -> u32x4 { const int q = jj < 128 ? jj : jsafe; return *(const u32x4*)(Kg + (size_t)(q * 64 + ld_row) * rs + ld_ch * 8); };
    auto ldv = [&](int jj) -> u32x4 { const int q = jj < 128 ? jj : jsafe; return *(const u32x4*)(Vg + (size_t)(q * 64 + ld_row) * rs + ld_ch * 8); };
    k0 = ldk(jA); k1 = ldk(jB); k2 = ldk(jC);
    if (MODE != 0) { v0 = ldv(jA); v1 = ldv(jB); v2 = ldv(jC); }
    int it = 0;
    auto step = [&](u32x4& kreg, u32x4& vreg) {
        const int j = jA;
        LAS unsigned char* kb = lds + NL_K + (it & 1) * 8192; LAS unsigned char* vb = lds + NL_V + (it & 1) * 8192;
        *(LAS u32x4*)(kb + kw_off) = kreg; if (MODE != 0) *(LAS u32x4*)(vb + vw_off) = vreg;
        const int jD = jC < 128 ? next(jC) : 128;
        kreg = ldk(jD); if (MODE != 0) vreg = ldv(jD);
        __syncthreads();
        bool need = true; bool selbit = true;
        if (MODE == 2) { selbit = (j < 64 ? (L.mlo >> j) : (L.mhi >> (j - 64))) & 1ull; need = __any(selbit); }
        if (need) {
            f32x16 p0 = {}, p1 = {};
#pragma unroll
            for (int ks = 0; ks < 4; ++ks) {
                const bf16x8 a0 = *(const LAS bf16x8*)(kb + off_row128(c, 2 * ks + hi)), a1 = *(const LAS bf16x8*)(kb + off_row128(32 + c, 2 * ks + hi));
                p0 = MFMA32(a0, qf[ks], p0); p1 = MFMA32(a1, qf[ks], p1);
            }
            const int stride = (MODE <= 1) ? 16 : 1;
            const int dl = (MODE <= 1) ? (L.t - 31 - 16 * (j * 64 + 4 * hi)) : (L.t - (j * 64 + 4 * hi));
            const float nb = -L.sl2 * (float)dl, sls = L.sl2 * (float)stride;
            float rs_ = 0.f;
#pragma unroll
            for (int r = 0; r < 16; ++r) {
                const int ro0 = (r & 3) + 8 * (r >> 2), ro1 = ro0 + 32;
                const int d0 = dl - stride * ro0, d1 = dl - stride * ro1;
                bool v0 = d0 >= 0, v1 = d1 >= 0;
                if (MODE == 3) { v0 = v0 && d0 < 512; v1 = v1 && d1 < 512; }
                if (MODE == 2) { v0 = v0 && selbit; v1 = v1 && selbit; }
                float e0 = __builtin_amdgcn_exp2f(__builtin_fmaf(p0[r], LOG2E, __builtin_fmaf(sls, (float)ro0, nb)));
                float e1 = __builtin_amdgcn_exp2f(__builtin_fmaf(p1[r], LOG2E, __builtin_fmaf(sls, (float)ro1, nb)));
                e0 = v0 ? e0 : 0.f; e1 = v1 ? e1 : 0.f;
                if (MODE == 1) { e0 *= inv; e1 *= inv; }
                p0[r] = e0; p1[r] = e1; rs_ += e0 + e1;
            }
            lsum += rs_;
            if (MODE == 1) {
#pragma unroll
                for (int kt = 0; kt < 2; ++kt)
#pragma unroll
                    for (int i = 0; i < 4; ++i) {
                        float g = kt ? (p1[4 * i] + p1[4 * i + 1]) + (p1[4 * i + 2] + p1[4 * i + 3]) : (p0[4 * i] + p0[4 * i + 1]) + (p0[4 * i + 2] + p0[4 * i + 3]);
                        float l3 = kt ? p1[4 * i + 3] : p0[4 * i + 3];
                        g += __shfl_xor(g, 1); g += __shfl_xor(g, 2); l3 += __shfl_xor(l3, 1); l3 += __shfl_xor(l3, 2);
                        if ((c & 3) == 0) { const int jj = j * 16 + kt * 8 + 2 * i + hi; __hip_atomic_fetch_add(impw + L.qi * NL_IMP_STRIDE + jj, g, __ATOMIC_RELAXED, __HIP_MEMORY_SCOPE_WORKGROUP); __hip_atomic_fetch_add(impw + L.qi * NL_IMP_STRIDE + jj + 1, l3, __ATOMIC_RELAXED, __HIP_MEMORY_SCOPE_WORKGROUP); }
                    }
            }
            if (MODE != 0) {
                bf16x8 pf[4];
#pragma unroll
                for (int s4 = 0; s4 < 4; ++s4) { u32x4 w;
#pragma unroll
                    for (int e = 0; e < 4; ++e) { const int r = 8 * (s4 & 1) + 2 * e; w[e] = (s4 >> 1) ? cvtpk(p1[r], p1[r + 1]) : cvtpk(p0[r], p0[r + 1]); }
                    pf[s4] = __builtin_bit_cast(bf16x8, w); }
                const int g4 = lane >> 4, sub = g4 & 1, i16 = lane & 15, qq = i16 >> 2, pp = i16 & 3;
#pragma unroll
                for (int dt = 0; dt < 2; ++dt)
#pragma unroll
                    for (int s4 = 0; s4 < 4; ++s4) {
                        const int row = 16 * s4 + 4 * hi + qq, ch = 4 * dt + 2 * sub + (pp >> 1);
                        const s16x4 lo = lds_tr(vb + off_v128(row, ch) + 8 * (pp & 1)), hh = lds_tr(vb + off_v128(row + 8, ch) + 8 * (pp & 1));
                        const bf16x8 vf = (bf16x8){lo[0], lo[1], lo[2], lo[3], hh[0], hh[1], hh[2], hh[3]};
                        O[dt] = MFMA32(vf, pf[s4], O[dt]);
                    }
            }
        }
        jA = jB; jB = jC; jC = jD; ++it;
    };
    while (jA < 128) {
        step(k0, v0); if (jA >= 128) break;
        step(k1, v1); if (jA >= 128) break;
        step(k2, v2);
    }
    __syncthreads();
}

__device__ __forceinline__ void nsa_unit(const Params& P, LAS unsigned char* lds, int u) {
    const int tid = opaque_tid(), lane = tid & 63, wid = tid >> 6, hi = lane >> 5, c = lane & 31;
    const int b = u >> 8, g = (u >> 7) & 1, qb = u & 127;
    const bf16_t* qg = (const bf16_t*)(P.ws + WS_Q); const bf16_t* kv = (const bf16_t*)(P.ws + WS_KV);
    const bf16_t* kcn = (const bf16_t*)(P.ws + WS_KC) + (size_t)(b * 2 + g) * 512 * 64; const bf16_t* vcc = (const bf16_t*)(P.ws + WS_VC) + (size_t)(b * 2 + g) * 512 * 64;
    const float* gates = (const float*)(P.ws + WS_GATES); bf16_t* mix = (bf16_t*)(P.ws + WS_MIX);
    LAS float* impw = (LAS float*)(lds + NL_IMP) + wid * 8 * NL_IMP_STRIDE;
    LAS unsigned long long* selm = (LAS unsigned long long*)(lds + NL_SELM);
    NsaLane L; L.qi = c >> 2; const int hh = c & 3, head = g * 4 + hh;
    L.t = qb * 64 + wid * 8 + L.qi; L.sl2 = exp2f(-(float)(head + 1)) * LOG2E; L.mlo = 0; L.mhi = 0;
    const size_t tok = (size_t)b * SEQ + L.t;
    bf16x8 qf[4];
#pragma unroll
    for (int ks = 0; ks < 4; ++ks) qf[ks] = *(const bf16x8*)(qg + tok * 512 + head * 64 + 16 * ks + 8 * hi);
    for (int i = lane; i < 8 * NL_IMP_STRIDE; i += 64) impw[i] = 0.f;
    const int ncmp = qb * 4 + 3 < 511 ? qb * 4 + 3 : 511;
    const int nblk = (ncmp + 63) >> 6;
    const unsigned long long cm = nblk >= 64 ? ~0ull : ((1ull << nblk) - 1ull);
    f32x16 O[2], Ot[2]; float lsum = 0.f;
    O[0] = f32x16{}; O[1] = f32x16{};
    nsa_pass<0>(lds, kcn, vcc, 64, cm, 0ull, qf, L, 1.f, lsum, O, impw);
    lsum += __shfl_xor(lsum, 32);
    const float invc = 1.0f / fmaxf(lsum, 1e-30f);
    float dummy = 0.f;
    nsa_pass<1>(lds, kcn, vcc, 64, cm, 0ull, qf, L, invc, dummy, O, impw);
    const float* gt = gates + tok * 24 + g * 12 + hh * 3;
    const float g0 = gt[0], g1 = gt[1], g2 = gt[2];
#pragma unroll
    for (int dt = 0; dt < 2; ++dt) Ot[dt] = O[dt] * g0;
    {
        const int ncausal = qb + 1;
        for (int qi = 0; qi < 8; ++qi) {
            unsigned long long lo, hi64;
            if (ncausal <= 16) { lo = (1ull << ncausal) - 1ull; hi64 = 0ull; }
            else {
                const int j0 = lane, j1 = lane + 64;
                const bool f0 = (j0 == 0) || (j0 == qb) || (j0 == qb - 1), f1 = (j1 == qb) || (j1 == qb - 1);
                const unsigned k0 = (j0 <= qb && !f0) ? (0x80000000u | (__float_as_uint(impw[qi * NL_IMP_STRIDE + j0]) & 0x7fffff80u) | (unsigned)j0) : 0u;
                const unsigned k1 = (j1 <= qb && !f1) ? (0x80000000u | (__float_as_uint(impw[qi * NL_IMP_STRIDE + j1]) & 0x7fffff80u) | (unsigned)j1) : 0u;
                const int needn = 13;
                unsigned th = 0u;
                for (int bit = 31; bit >= 0; --bit) { const unsigned cand = th | (1u << bit);
                    const int cnt = __popcll(__ballot(k0 >= cand)) + __popcll(__ballot(k1 >= cand));
                    if (cnt >= needn) th = cand; }
                lo = __ballot(f0 || (k0 >= th && k0 != 0u)); hi64 = __ballot(f1 || (k1 >= th && k1 != 0u));
            }
            if (lane == 0) { selm[(wid * 8 + qi) * 2] = lo; selm[(wid * 8 + qi) * 2 + 1] = hi64; }
        }
    }
    __syncthreads();
    unsigned long long ulo = selm[lane * 2], uhi = selm[lane * 2 + 1];
#pragma unroll
    for (int o = 1; o < 64; o <<= 1) { ulo |= __shfl_xor(ulo, o); uhi |= __shfl_xor(uhi, o); }
    L.mlo = selm[(wid * 8 + L.qi) * 2]; L.mhi = selm[(wid * 8 + L.qi) * 2 + 1];
    const bf16_t* kvb = kv + (size_t)b * SEQ * 768 + g * 64;
    O[0] = f32x16{}; O[1] = f32x16{}; lsum = 0.f;
    nsa_pass<2>(lds, kvb + 256, kvb + 384, 768, ulo, uhi, qf, L, 1.f, lsum, O, impw);
    lsum += __shfl_xor(lsum, 32);
    { const float sc = g1 / fmaxf(lsum, 1e-30f);
#pragma unroll
      for (int dt = 0; dt < 2; ++dt) Ot[dt] += O[dt] * sc; }
    {
        const int jlo = qb >= 8 ? qb - 8 : 0;
        unsigned long long wlo = 0ull, whi = 0ull;
        for (int jj = jlo; jj <= qb; ++jj) { if (jj < 64) wlo |= 1ull << jj; else whi |= 1ull << (jj - 64); }
        O[0] = f32x16{}; O[1] = f32x16{}; lsum = 0.f;
        nsa_pass<3>(lds, kvb + 512, kvb + 640, 768, wlo, whi, qf, L, 1.f, lsum, O, impw);
        lsum += __shfl_xor(lsum, 32);
        const float sc = g2 / fmaxf(lsum, 1e-30f);
#pragma unroll
        for (int dt = 0; dt < 2; ++dt) Ot[dt] += O[dt] * sc;
    }
    float ss = 0.f;
#pragma unroll
    for (int dt = 0; dt < 2; ++dt)
#pragma unroll
        for (int r = 0; r < 16; ++r) ss += Ot[dt][r] * Ot[dt][r];
    ss += __shfl_xor(ss, 32);
    const float rstd = rsqrtf(ss * (1.f / 64.f) + RMS_EPS);
#pragma unroll
    for (int dt = 0; dt < 2; ++dt)
#pragma unroll
        for (int r4 = 0; r4 < 4; ++r4) { const int d = 32 * dt + 8 * r4 + 4 * hi; const f32x4 w = *(const f32x4*)(P.attn_out_norm_w + head * 64 + d);
            u32x2 pk; pk.x = cvtpk(Ot[dt][4 * r4] * rstd * w.x, Ot[dt][4 * r4 + 1] * rstd * w.y); pk.y = cvtpk(Ot[dt][4 * r4 + 2] * rstd * w.z, Ot[dt][4 * r4 + 3] * rstd * w.w);
            *(u32x2*)(mix + tok * 1024 + head * 64 + d) = pk; }
    __syncthreads();
}


__device__ __forceinline__ int gu_hcol(int m0) { const int ni = (m0 >> 4) & 7; return 64 * (m0 >> 7) + 32 * (ni >> 2) + 8 * ((m0 & 15) >> 2) + 4 * ((ni >> 1) & 1); }
__device__ __forceinline__ int p2_col(int m0) { const int ni = (m0 >> 4) & 7; return 128 * (m0 >> 7) + 32 * (ni >> 1) + 8 * ((m0 & 15) >> 2) + 4 * (ni & 1); }
__device__ __forceinline__ void phase_cvt_small(const Params& P) {
    const int tid = threadIdx.x;
    {
        const int gt = blockIdx.x * NTHREADS + tid, NG = gridDim.x * NTHREADS;
        bf16_t* wo = (bf16_t*)(P.ws + WS_WOUT); bf16_t* wrs = (bf16_t*)(P.ws + WS_WRS); bf16_t* wsd = (bf16_t*)(P.ws + WS_WSD);
        for (int i = gt; i < 1024 * 128; i += NG) { const int k = i >> 7, m0 = (i & 127) * 8; const float* s = P.w_out + (size_t)k * 1024 + (m0 & ~255) + p2_col(m0 & 255);
            const f32x4 a = *(const f32x4*)s, b2 = *(const f32x4*)(s + 8);
            *(u32x4*)(wo + (size_t)i * 8) = (u32x4){cvtpk(a.x, a.y), cvtpk(a.z, a.w), cvtpk(b2.x, b2.y), cvtpk(b2.z, b2.w)}; }
        for (int i = gt; i < 256 * 128; i += NG) { const int k = i >> 7, m0 = (i & 127) * 8; const float* s = P.sh_wd + (size_t)k * 1024 + (m0 & ~255) + p2_col(m0 & 255);
            const f32x4 a = *(const f32x4*)s, b2 = *(const f32x4*)(s + 8);
            *(u32x4*)(wsd + (size_t)i * 8) = (u32x4){cvtpk(a.x, a.y), cvtpk(a.z, a.w), cvtpk(b2.x, b2.y), cvtpk(b2.z, b2.w)}; }
        for (int i = gt; i < 1024 * 96; i += NG) { const int k = i / 96, c8 = (i % 96) * 8;
            const float* s; int d2 = 4;
            if (c8 < 256) s = P.router_w + (size_t)k * 256 + c8;
            else { const int cc = c8 - 256, t = cc >> 8; s = ((cc & 16) ? P.sh_wu : P.sh_wg) + (size_t)k * 256 + t * 128 + gu_hcol(cc & 255); d2 = 8; }
            const f32x4 a = *(const f32x4*)s, b2 = *(const f32x4*)(s + d2);
            *(u32x4*)(wrs + (size_t)k * 768 + c8) = (u32x4){cvtpk(a.x, a.y), cvtpk(a.z, a.w), cvtpk(b2.x, b2.y), cvtpk(b2.z, b2.w)}; }
    }
}

__device__ __forceinline__ void route_token(const Params& P, int t, int lane, int& out_idx, float& out_w) {
    const float* scores = (const float*)(P.ws + WS_SCORES) + (size_t)t * 256;
    const f32x4 s4 = *(const f32x4*)(scores + 4 * lane); const f32x4 b4 = *(const f32x4*)(P.router_bias + 4 * lane);
    float sc[4] = {s4.x, s4.y, s4.z, s4.w};
    float bs[4] = {s4.x + b4.x, s4.y + b4.y, s4.z + b4.z, s4.w + b4.w};
    float m1 = fmaxf(bs[0], bs[1]), m2 = fminf(bs[0], bs[1]);
    { const float v = bs[2]; const float n1 = fmaxf(m1, v); m2 = fmaxf(fminf(m1, v), m2); m1 = n1; }
    { const float v = bs[3]; const float n1 = fmaxf(m1, v); m2 = fmaxf(fminf(m1, v), m2); m1 = n1; }
#pragma unroll
    for (int o = 1; o < 8; o <<= 1) { const float o1 = __shfl_xor(m1, o), o2 = __shfl_xor(m2, o); const float n1 = fmaxf(m1, o1); m2 = fmaxf(fminf(m1, o1), fmaxf(m2, o2)); m1 = n1; }
    const float gs = m1 + m2;
    const int grp = lane >> 3;
    int rank = 0;
#pragma unroll
    for (int g2 = 0; g2 < 8; ++g2) { const float og = __shfl(gs, g2 * 8); rank += (og > gs || (og == gs && g2 < grp)) ? 1 : 0; }
    const bool gsel = rank < 4;
    float mv[4];
#pragma unroll
    for (int i = 0; i < 4; ++i) mv[i] = gsel ? bs[i] : -INFINITY;
    int myidx = -1; float myw = 0.f; float wsum = 0.f;
#pragma unroll 1
    for (int k = 0; k < 8; ++k) {
        float bv = mv[0]; int bi = 4 * lane;
#pragma unroll
        for (int i = 1; i < 4; ++i) if (mv[i] > bv) { bv = mv[i]; bi = 4 * lane + i; }
#pragma unroll
        for (int o = 1; o < 64; o <<= 1) { const float ov = __shfl_xor(bv, o); const int oi = __shfl_xor(bi, o); if (ov > bv || (ov == bv && oi < bi)) { bv = ov; bi = oi; } }
        const int wl = bi >> 2, wc = bi & 3;
        const float mine = wc == 0 ? sc[0] : (wc == 1 ? sc[1] : (wc == 2 ? sc[2] : sc[3]));
        const float wv = __shfl(mine, wl);
        wsum += wv;
        if (lane == k) { myidx = bi; myw = wv; }
        if (lane == wl) {
#pragma unroll
            for (int i = 0; i < 4; ++i) if (i == wc) mv[i] = -INFINITY; }
    }
    out_idx = myidx; out_w = myw / wsum * 2.5f;
}


__device__ __forceinline__ void phase_p4a(const Params& P, LAS unsigned char* lds) {
    typedef Gemm3 G;
    const int tid = opaque_tid(), lane = tid & 63, wid = tid >> 6, wm = wid >> 1, wn = wid & 1, fr = lane & 15, fq = lane >> 4;
    struct F { const Params& P;
        __device__ __forceinline__ void ptrs(int seg, const bf16_t* (&aptr)[2], const bf16_t* (&bptr)[2]) const {
            const int tid = opaque_tid(), lane = tid & 63, wid = tid >> 6, wm = wid >> 1, wn = wid & 1, fr = lane & 15, fq = lane >> 4, c8 = 8 * (tid & 31); (void)wm; (void)wn; (void)fr; (void)fq; (void)c8;
            const int u = blockIdx.x + seg * gridDim.x, rt = u >> 2, ct = u & 3;
            const bf16_t* mix = (const bf16_t*)(P.ws + WS_MIX); const bf16_t* wo = (const bf16_t*)(P.ws + WS_WOUT);
#pragma unroll
            for (int i = 0; i < 2; ++i) { const int row = G::a_row(i, wid, lane); aptr[i] = mix + (size_t)(rt * 256 + row) * 1024 + G::a_chunk(row, lane) * 8;
                const int k = G::b_k(i, wid, lane); bptr[i] = wo + (size_t)k * 1024 + ct * 256 + G::b_n(k, lane); } }
        __device__ __forceinline__ void epi(int seg, f32x4 (&acc)[4][8]) const {
            const int tid = opaque_tid(), lane = tid & 63, wid = tid >> 6, wm = wid >> 1, wn = wid & 1, fr = lane & 15, fq = lane >> 4, c8 = 8 * (tid & 31); (void)wm; (void)wn; (void)fr; (void)fq; (void)c8;
            const int u = blockIdx.x + seg * gridDim.x, rt = u >> 2, ct = u & 3, b = (rt * 256) / SEQ;
            const float* mod = (const float*)(P.ws + WS_MOD) + b * 6144; float* ssp = (float*)(P.ws + WS_SS); bf16_t* x1 = (bf16_t*)(P.ws + WS_X1);
#pragma unroll
            for (int mi = 0; mi < 4; ++mi) { const size_t m = (size_t)(rt * 256 + wm * 64 + mi * 16 + fr); float ss = 0.f;
#pragma unroll
                for (int j = 0; j < 4; ++j) { const int col = ct * 256 + wn * 128 + j * 32 + 8 * fq;
                    const f32x4 xv = *(const f32x4*)(P.x + m * 1024 + col), xw = *(const f32x4*)(P.x + m * 1024 + col + 4), gv = *(const f32x4*)(mod + 2048 + col), gw = *(const f32x4*)(mod + 2048 + col + 4);
                    const f32x4 a = acc[mi][2 * j], c = acc[mi][2 * j + 1];
                    f32x4 o, o2; o.x = xv.x + gv.x * a.x; o.y = xv.y + gv.y * a.y; o.z = xv.z + gv.z * a.z; o.w = xv.w + gv.w * a.w;
                    o2.x = xw.x + gw.x * c.x; o2.y = xw.y + gw.y * c.y; o2.z = xw.z + gw.z * c.z; o2.w = xw.w + gw.w * c.w;
                    *(u32x4*)(x1 + m * 1024 + col) = (u32x4){cvtpk(o.x, o.y), cvtpk(o.z, o.w), cvtpk(o2.x, o2.y), cvtpk(o2.z, o2.w)};
                    ss += ((o.x * o.x + o.y * o.y) + (o.z * o.z + o.w * o.w)) + ((o2.x * o2.x + o2.y * o2.y) + (o2.z * o2.z + o2.w * o2.w)); if (j & 1) asm volatile("" ::: "memory"); }
                ss += __shfl_xor(ss, 16); ss += __shfl_xor(ss, 32);
                if (fq == 0) ssp[m * 8 + ct * 2 + wn] = ss; } }
    } f{P};
    const int nu = (128 * 4 - (int)blockIdx.x + (int)gridDim.x - 1) / (int)gridDim.x;
    if (nu > 0) G::run_stream(f, nu, 32, 32, (size_t)32 * 1024, lds);
}
__device__ __forceinline__ void phase_p4b(const Params& P) {
    const int lane = threadIdx.x & 63, gw = blockIdx.x * (NTHREADS / 64) + (threadIdx.x >> 6), NGW = gridDim.x * (NTHREADS / 64);
    const float* ssp = (const float*)(P.ws + WS_SS); bf16_t* h2 = (bf16_t*)(P.ws + WS_H);
    for (int m = gw; m < T; m += NGW) {
        const float* mod = (const float*)(P.ws + WS_MOD) + (m / SEQ) * 6144;
        const f32x4 s0 = *(const f32x4*)(ssp + (size_t)m * 8), s1 = *(const f32x4*)(ssp + (size_t)m * 8 + 4);
        const float rstd = rsqrtf(((s0.x + s0.y) + (s0.z + s0.w) + (s1.x + s1.y) + (s1.z + s1.w)) * (1.f / 1024.f) + RMS_EPS);
#pragma unroll
        for (int j = 0; j < 4; ++j) { const int col = (lane + 64 * j) * 4;
            const u32x2 xr = *(const u32x2*)((const bf16_t*)(P.ws + WS_X1) + (size_t)m * 1024 + col);
            const f32x4 v = (f32x4){__uint_as_float(xr.x << 16), __uint_as_float(xr.x & 0xffff0000u), __uint_as_float(xr.y << 16), __uint_as_float(xr.y & 0xffff0000u)}, wv = *(const f32x4*)(P.norm2_w + col), scv = *(const f32x4*)(mod + 4096 + col), shv = *(const f32x4*)(mod + 3072 + col);
            const float r0 = v.x * rstd * wv.x * (1.f + scv.x) + shv.x, r1 = v.y * rstd * wv.y * (1.f + scv.y) + shv.y, r2 = v.z * rstd * wv.z * (1.f + scv.z) + shv.z, r3 = v.w * rstd * wv.w * (1.f + scv.w) + shv.w;
            u32x2 pk; pk.x = cvtpk(r0, r1); pk.y = cvtpk(r2, r3);
            *(u32x2*)(h2 + (size_t)m * 1024 + col) = pk;
            int q8 = __builtin_amdgcn_cvt_pk_fp8_f32(r0, r1, 0, false); q8 = __builtin_amdgcn_cvt_pk_fp8_f32(r2, r3, q8, true);
            *(int*)((unsigned char*)(P.ws + WS_H2Q) + (size_t)m * 1024 + col) = q8; }
    }
}
__device__ __forceinline__ void phase_p4c(const Params& P, LAS unsigned char* lds) {
    typedef Gemm3 G;
    const int tid = opaque_tid(), lane = tid & 63, wid = tid >> 6, wm = wid >> 1, wn = wid & 1, fr = lane & 15, fq = lane >> 4;
    struct F { const Params& P;
        __device__ __forceinline__ void ptrs(int seg, const bf16_t* (&aptr)[2], const bf16_t* (&bptr)[2]) const {
            const int tid = opaque_tid(), lane = tid & 63, wid = tid >> 6, wm = wid >> 1, wn = wid & 1, fr = lane & 15, fq = lane >> 4, c8 = 8 * (tid & 31); (void)wm; (void)wn; (void)fr; (void)fq; (void)c8;
            const int u = blockIdx.x + seg * gridDim.x, rt = u / 3, ct = u % 3;
            const bf16_t* h2 = (const bf16_t*)(P.ws + WS_H); const bf16_t* wrs = (const bf16_t*)(P.ws + WS_WRS);
#pragma unroll
            for (int i = 0; i < 2; ++i) { const int row = G::a_row(i, wid, lane); aptr[i] = h2 + (size_t)(rt * 256 + row) * 1024 + G::a_chunk(row, lane) * 8;
                const int k = G::b_k(i, wid, lane); bptr[i] = wrs + (size_t)k * 768 + ct * 256 + G::b_n(k, lane); } }
        __device__ __forceinline__ void epi(int seg, f32x4 (&acc)[4][8]) const {
            const int tid = opaque_tid(), lane = tid & 63, wid = tid >> 6, wm = wid >> 1, wn = wid & 1, fr = lane & 15, fq = lane >> 4, c8 = 8 * (tid & 31); (void)wm; (void)wn; (void)fr; (void)fq; (void)c8;
            const int u = blockIdx.x + seg * gridDim.x, rt = u / 3, ct = u % 3;
            float* scores = (float*)(P.ws + WS_SCORES); bf16_t* hidS = (bf16_t*)(P.ws + WS_HIDS);
#pragma unroll
            for (int mi = 0; mi < 4; ++mi) { const size_t m = (size_t)(rt * 256 + wm * 64 + mi * 16 + fr);
                if (ct == 0) {
#pragma unroll
                    for (int ni = 0; ni < 8; ++ni) { const f32x4 a = acc[mi][ni];
                        *(f32x4*)(scores + m * 256 + wn * 128 + ni * 16 + 4 * fq) = (f32x4){sigmoidf_(a.x), sigmoidf_(a.y), sigmoidf_(a.z), sigmoidf_(a.w)}; }
                } else {
#pragma unroll
                    for (int j2 = 0; j2 < 2; ++j2) { const f32x4 g = acc[mi][4 * j2], uu = acc[mi][4 * j2 + 1], g2 = acc[mi][4 * j2 + 2], u2 = acc[mi][4 * j2 + 3];
                        u32x4 pk; pk.x = cvtpk(siluf_(g.x) * uu.x, siluf_(g.y) * uu.y); pk.y = cvtpk(siluf_(g.z) * uu.z, siluf_(g.w) * uu.w);
                        pk.z = cvtpk(siluf_(g2.x) * u2.x, siluf_(g2.y) * u2.y); pk.w = cvtpk(siluf_(g2.z) * u2.z, siluf_(g2.w) * u2.w);
                        *(u32x4*)(hidS + m * 256 + (ct - 1) * 128 + wn * 64 + j2 * 32 + 8 * fq) = pk; }
                } } }
    } f{P};
    const int nu = (128 * 3 - (int)blockIdx.x + (int)gridDim.x - 1) / (int)gridDim.x;
    if (nu > 0) G::run_stream(f, nu, 32, 32, (size_t)32 * 768, lds);
}
__device__ __forceinline__ void phase_route(const Params& P, LAS unsigned char* lds) {
    const int tid = opaque_tid(), lane = tid & 63, wid = tid >> 6;
    LAS int* lcnt = (LAS int*)lds; LAS int* lbase = lcnt + 256; LAS int* lrec = lbase + 256; LAS float* lw = (LAS float*)(lrec + 512);
    int* cnt = (int*)(P.ws + WS_CTL + CTL_CNT);
    for (int t0 = blockIdx.x * 64; t0 < T; t0 += gridDim.x * 64) {
        if (tid < 256) lcnt[tid] = 0;
        __syncthreads();
#pragma unroll 1
        for (int i = 0; i < 8; ++i) { const int tl = wid * 8 + i; int idx; float w;
            route_token(P, t0 + tl, lane, idx, w);
            if (lane < 8) { const int rank = __hip_atomic_fetch_add(lcnt + idx, 1, __ATOMIC_RELAXED, __HIP_MEMORY_SCOPE_WORKGROUP); lrec[tl * 8 + lane] = idx | (rank << 8); lw[tl * 8 + lane] = w; } }
        __syncthreads();
        if (tid < 256) { const int c = lcnt[tid]; lbase[tid] = c ? atomicAdd(cnt + tid * CNT_STRIDE, c) : 0; }
        __syncthreads();
        { const int rec = lrec[tid], e = rec & 255, pos = lbase[e] + (rec >> 8); const int slotid = (t0 + (tid >> 3)) * 8 + (tid & 7);
          if (pos < BCAP) ((int*)(P.ws + WS_BUCKET))[(size_t)e * BCAP + pos] = slotid;
          ((float*)(P.ws + WS_RW))[slotid] = lw[tid]; }
        __syncthreads();
    }
}
__device__ __forceinline__ void phase_p4d(const Params& P, LAS unsigned char* lds) {
    typedef Gemm3 G;
    const int tid = opaque_tid(), lane = tid & 63, wid = tid >> 6, wm = wid >> 1, wn = wid & 1, fr = lane & 15, fq = lane >> 4;
    struct F { const Params& P;
        __device__ __forceinline__ void ptrs(int seg, const bf16_t* (&aptr)[2], const bf16_t* (&bptr)[2]) const {
            const int tid = opaque_tid(), lane = tid & 63, wid = tid >> 6, wm = wid >> 1, wn = wid & 1, fr = lane & 15, fq = lane >> 4, c8 = 8 * (tid & 31); (void)wm; (void)wn; (void)fr; (void)fq; (void)c8;
            const int u = blockIdx.x + seg * gridDim.x, rt = u >> 2, ct = u & 3;
            const bf16_t* hidS = (const bf16_t*)(P.ws + WS_HIDS); const bf16_t* wsd = (const bf16_t*)(P.ws + WS_WSD);
#pragma unroll
            for (int i = 0; i < 2; ++i) { const int row = G::a_row(i, wid, lane); aptr[i] = hidS + (size_t)(rt * 256 + row) * 256 + G::a_chunk(row, lane) * 8;
                const int k = G::b_k(i, wid, lane); bptr[i] = wsd + (size_t)k * 1024 + ct * 256 + G::b_n(k, lane); } }
        __device__ __forceinline__ void epi(int seg, f32x4 (&acc)[4][8]) const {
            const int tid = opaque_tid(), lane = tid & 63, wid = tid >> 6, wm = wid >> 1, wn = wid & 1, fr = lane & 15, fq = lane >> 4, c8 = 8 * (tid & 31); (void)wm; (void)wn; (void)fr; (void)fq; (void)c8;
            const int u = blockIdx.x + seg * gridDim.x, rt = u >> 2, ct = u & 3;
            unsigned char* ysh = (unsigned char*)(P.ws + WS_YSH);
#pragma unroll
            for (int mi = 0; mi < 4; ++mi) { const size_t m = (size_t)(rt * 256 + wm * 64 + mi * 16 + fr);
#pragma unroll
                for (int j = 0; j < 4; ++j) { const int col = ct * 256 + wn * 128 + j * 32 + 8 * fq; const f32x4 a = acc[mi][2 * j] * Y_SCALE, c = acc[mi][2 * j + 1] * Y_SCALE;
                    *(u32x2*)(ysh + m * 1024 + col) = (u32x2){pk4_fp8(a.x, a.y, a.z, a.w), pk4_fp8(c.x, c.y, c.z, c.w)}; } } }
    } f{P};
    const int nu = (128 * 4 - (int)blockIdx.x + (int)gridDim.x - 1) / (int)gridDim.x;
    if (nu > 0) G::run_stream(f, nu, 8, 32, (size_t)32 * 1024, lds);
}

__device__ __forceinline__ void phase_expert_cvt(const Params& P) {
    const size_t gt = (size_t)blockIdx.x * NTHREADS + threadIdx.x, NG = (size_t)gridDim.x * NTHREADS;
    bf16_t* wgu = (bf16_t*)(P.ws + WS_WBGU); bf16_t* wd = (bf16_t*)(P.ws + WS_WBD);
    for (size_t i = gt; i < (size_t)256 * 1024 * 64; i += NG) {
        const size_t ek = i >> 6; const int c8 = (int)(i & 63) * 8, t = c8 >> 8;
        const float* s = ((c8 & 16) ? P.exp_wu : P.exp_wg) + ek * 256 + t * 128 + gu_hcol(c8 & 255);
        const f32x4 a = __builtin_nontemporal_load((const f32x4*)s), b2 = __builtin_nontemporal_load((const f32x4*)(s + 8));
        *(u32x4*)(wgu + ek * 512 + c8) = (u32x4){cvtpk(a.x, a.y), cvtpk(a.z, a.w), cvtpk(b2.x, b2.y), cvtpk(b2.z, b2.w)}; }
    for (size_t i = gt; i < (size_t)256 * 256 * 128; i += NG) {
        const size_t ek = i >> 7; const int m0 = (int)(i & 127) * 8, tl = m0 & 255, tile = m0 >> 8;
        const int wnn = tl >> 7, nii = (tl >> 4) & 7, n0 = tl & 15;
        const int ca = tile * 256 + wnn * 128 + 64 * (nii >> 2) + 16 * (n0 >> 2) + 4 * (nii & 3);
        const f32x4 a = __builtin_nontemporal_load((const f32x4*)(P.exp_wd + ek * 1024 + ca)), b2 = __builtin_nontemporal_load((const f32x4*)(P.exp_wd + ek * 1024 + ca + 16));
        *(u32x4*)(wd + ek * 1024 + m0) = (u32x4){cvtpk(a.x, a.y), cvtpk(a.z, a.w), cvtpk(b2.x, b2.y), cvtpk(b2.z, b2.w)}; }
}

constexpr int P6_TILES = 128 * 1024, P6_PRE = P6_TILES + 1024, P6_PAIR = P6_PRE + 1040, P6_W = P6_PAIR + 1024;
__device__ __forceinline__ void phase_experts(const Params& P, LAS unsigned char* lds) {
    typedef Gemm3 G;
    const int tid = opaque_tid(), lane = tid & 63, wid = tid >> 6, wm = wid >> 1, wn = wid & 1, fr = lane & 15, fq = lane >> 4;
    const int* cnt = (const int*)(P.ws + WS_CTL + CTL_CNT); const int* bucket = (const int*)(P.ws + WS_BUCKET); const float* rw = (const float*)(P.ws + WS_RW);
    const bf16_t* h2 = (const bf16_t*)(P.ws + WS_H); bf16_t* hidR = (bf16_t*)(P.ws + WS_HIDR) + (size_t)blockIdx.x * 256 * 256; unsigned char* y = (unsigned char*)(P.ws + WS_Y);
    LAS int* tiles = (LAS int*)(lds + P6_TILES); LAS int* pre = (LAS int*)(lds + P6_PRE); LAS int* pairs = (LAS int*)(lds + P6_PAIR); LAS float* wts = (LAS float*)(lds + P6_W);
    const int nx = (gridDim.x % 8 == 0) ? 8 : 1, xl = blockIdx.x % nx, li = blockIdx.x / nx, nloc = gridDim.x / nx, nek = 256 / nx;
    if (tid < nek) { const int c_ = cnt[(xl + nx * tid) * CNT_STRIDE]; tiles[tid] = ((c_ < BCAP ? c_ : BCAP) + 255) >> 8; }
    __syncthreads();
    if (tid < nek) { int s = 0; for (int i = 0; i < tid; ++i) s += tiles[i]; pre[tid] = s; if (tid == nek - 1) pre[nek] = s + tiles[nek - 1]; }
    __syncthreads();
    const int total = pre[nek];
    const int c8 = 8 * (tid & 31), u16 = c8 >> 4;
    for (int u = li; u < total; u += nloc) {
        int lo = 0, hi = nek - 1;
        while (lo < hi) { const int mid = (lo + hi + 1) >> 1; if (pre[mid] <= u) lo = mid; else hi = mid - 1; }
        const int e = xl + nx * lo, tile = u - pre[lo], n = cnt[e * CNT_STRIDE] < BCAP ? cnt[e * CNT_STRIDE] : BCAP, rows = (n - tile * 256) < 256 ? (n - tile * 256) : 256;
        if (tid < 256) { const int r = tid < rows ? tid : 0; const int pr = bucket[(size_t)e * BCAP + tile * 256 + r]; pairs[tid] = pr; wts[tid] = tid < rows ? rw[pr] : 0.f; }
        __syncthreads();
        {
            struct GU { const bf16_t* h2; LAS int* pairs; const bf16_t* wgu; bf16_t* hidR;
                __device__ __forceinline__ void ptrs(int t, const bf16_t* (&aptr)[2], const bf16_t* (&bptr)[2]) const {
                    const int tid = opaque_tid(), lane = tid & 63, wid = tid >> 6, wm = wid >> 1, wn = wid & 1, fr = lane & 15, fq = lane >> 4, c8 = 8 * (tid & 31); (void)wm; (void)wn; (void)fr; (void)fq; (void)c8;
#pragma unroll
                    for (int i = 0; i < 2; ++i) { const int row = G::a_row(i, wid, lane); aptr[i] = h2 + (size_t)(pairs[row] >> 3) * 1024 + G::a_chunk(row, lane) * 8;
                        const int k = G::b_k(i, wid, lane); bptr[i] = wgu + (size_t)k * 512 + t * 256 + G::b_n(k, lane); } }
                __device__ __forceinline__ void epi(int t, f32x4 (&acc)[4][8]) const {
                    const int tid = opaque_tid(), lane = tid & 63, wid = tid >> 6, wm = wid >> 1, wn = wid & 1, fr = lane & 15, fq = lane >> 4, c8 = 8 * (tid & 31); (void)wm; (void)wn; (void)fr; (void)fq; (void)c8;
#pragma unroll
                    for (int mi = 0; mi < 4; ++mi) { const int rl = wm * 64 + mi * 16 + fr;
#pragma unroll
                        for (int j2 = 0; j2 < 2; ++j2) { const f32x4 g = acc[mi][4 * j2], uu = acc[mi][4 * j2 + 1], g2 = acc[mi][4 * j2 + 2], u2 = acc[mi][4 * j2 + 3];
                            u32x4 pk; pk.x = cvtpk(siluf_(g.x) * uu.x, siluf_(g.y) * uu.y); pk.y = cvtpk(siluf_(g.z) * uu.z, siluf_(g.w) * uu.w);
                            pk.z = cvtpk(siluf_(g2.x) * u2.x, siluf_(g2.y) * u2.y); pk.w = cvtpk(siluf_(g2.z) * u2.z, siluf_(g2.w) * u2.w);
                            *(u32x4*)(hidR + rl * 256 + t * 128 + wn * 64 + j2 * 32 + 8 * fq) = pk; } } }
            } f{h2, pairs, (const bf16_t*)(P.ws + WS_WBGU) + (size_t)e * 1024 * 512, hidR};
            G::run_stream(f, 2, 32, 32, (size_t)32 * 512, lds);
        }
        __syncthreads();
        {
            struct DN { bf16_t* hidR; const bf16_t* wd; unsigned char* y; LAS int* pairs; LAS float* wts; int rows;
                __device__ __forceinline__ void ptrs(int ct, const bf16_t* (&aptr)[2], const bf16_t* (&bptr)[2]) const {
                    const int tid = opaque_tid(), lane = tid & 63, wid = tid >> 6, wm = wid >> 1, wn = wid & 1, fr = lane & 15, fq = lane >> 4, c8 = 8 * (tid & 31); (void)wm; (void)wn; (void)fr; (void)fq; (void)c8;
#pragma unroll
                    for (int i = 0; i < 2; ++i) { const int row = G::a_row(i, wid, lane); aptr[i] = hidR + (size_t)row * 256 + G::a_chunk(row, lane) * 8;
                        const int k = G::b_k(i, wid, lane); bptr[i] = wd + (size_t)k * 1024 + ct * 256 + G::b_n(k, lane); } }
                __device__ __forceinline__ void epi(int ct, f32x4 (&acc)[4][8]) const {
                    const int tid = opaque_tid(), lane = tid & 63, wid = tid >> 6, wm = wid >> 1, wn = wid & 1, fr = lane & 15, fq = lane >> 4, c8 = 8 * (tid & 31); (void)wm; (void)wn; (void)fr; (void)fq; (void)c8;
#pragma unroll
                    for (int mi = 0; mi < 4; ++mi) { const int rl = wm * 64 + mi * 16 + fr; const float wgt = wts[rl]; const size_t pr = (size_t)pairs[rl];
                        if (rl < rows) {
#pragma unroll
                            for (int j2 = 0; j2 < 2; ++j2) { const int col = ct * 256 + wn * 128 + 64 * j2 + 16 * fq; const float sc_ = wgt * Y_SCALE; u32x4 w;
#pragma unroll
                                for (int b2 = 0; b2 < 4; ++b2) { const f32x4 a = acc[mi][4 * j2 + b2] * sc_;
                                    int pk = __builtin_amdgcn_cvt_pk_fp8_f32(a.x, a.y, 0, false); pk = __builtin_amdgcn_cvt_pk_fp8_f32(a.z, a.w, pk, true); w[b2] = (unsigned)pk; }
                                *(u32x4*)(y + pr * 1024 + col) = w; } } } }
            } f{hidR, (const bf16_t*)(P.ws + WS_WBD) + (size_t)e * 256 * 1024, y, pairs, wts, rows};
            G::run_stream(f, 4, 8, 32, (size_t)32 * 1024, lds);
        }
        __syncthreads();
    }
}


__device__ __forceinline__ void cvt8_store_rows(LAS unsigned char* wl, int lane, const u32x4 (&w)[8], unsigned char* obase, size_t row_stride) {
#pragma unroll
    for (int j = 0; j < 8; ++j) *(LAS u32x4*)(wl + lane * 144 + j * 16) = w[j];
    asm volatile("s_waitcnt lgkmcnt(0)" ::: "memory");
#pragma unroll
    for (int i = 0; i < 8; ++i) { const int r = (lane >> 3) + 8 * i; const u32x4 v = *(const LAS u32x4*)(wl + r * 144 + (lane & 7) * 16); *(u32x4*)(obase + (size_t)r * row_stride + (lane & 7) * 16) = v; }
    asm volatile("s_waitcnt lgkmcnt(0)" ::: "memory");
}
__device__ __forceinline__ void cvt8_item(const Params& P, LAS unsigned char* lds, int item) {
    const int tid = opaque_tid(), lane = tid & 63, wv = tid >> 6;
    unsigned char* wgu = (unsigned char*)(P.ws + WS_W8GU); unsigned char* wd = (unsigned char*)(P.ws + WS_W8D);
    LAS unsigned char* wl = lds + wv * 9216;
    const int NGW = 1;
    if (item < 1024)
    for (int u = item * 16 + wv * 2; u < item * 16 + wv * 2 + 2; u += NGW) {
        const int rg = u & 7, kb = (u >> 3) & 7, e = u >> 6;
        const int q = rg * 64 + lane, t = q >> 8, ql = q & 255, wnn = ql >> 7, it = (ql >> 5) & 3, i = ql & 31;
        const int h = t * 128 + wnn * 64 + (it >> 1) * 32 + Gemm8::w_col(i);
        const float* s = ((it & 1) ? P.exp_wu : P.exp_wg) + (size_t)e * 1024 * 256 + (size_t)(kb * 128) * 256 + h;
        unsigned char* o = wgu + ((size_t)e * 512 + rg * 64) * 1024 + kb * 128;
        { float v[128]; u32x4 wq[8];
#pragma unroll
            for (int j = 0; j < 128; ++j) v[j] = __builtin_nontemporal_load(s + (size_t)j * 256);
#pragma unroll
            for (int j = 0; j < 8; ++j) { const float c_ = W8_GU_SCALE; u32x4 w;
                w.x = pk4_fp8(v[16 * j] * c_, v[16 * j + 1] * c_, v[16 * j + 2] * c_, v[16 * j + 3] * c_); w.y = pk4_fp8(v[16 * j + 4] * c_, v[16 * j + 5] * c_, v[16 * j + 6] * c_, v[16 * j + 7] * c_);
                w.z = pk4_fp8(v[16 * j + 8] * c_, v[16 * j + 9] * c_, v[16 * j + 10] * c_, v[16 * j + 11] * c_); w.w = pk4_fp8(v[16 * j + 12] * c_, v[16 * j + 13] * c_, v[16 * j + 14] * c_, v[16 * j + 15] * c_);
                wq[j] = w; }
            cvt8_store_rows(wl, lane, wq, o, 1024); }
    }
    if (item >= 1024)
    for (int u = (item - 1024) * 16 + wv * 2; u < (item - 1024) * 16 + wv * 2 + 2; u += NGW) {
        const int rg = u & 15, kb = (u >> 4) & 1, e = u >> 5;
        const int q = rg * 64 + lane, i = q & 31;
        const int col = (q & ~31) + Gemm8::w_col(i);
        const float* s = P.exp_wd + (size_t)e * 256 * 1024 + (size_t)(kb * 128) * 1024 + col;
        unsigned char* o = wd + ((size_t)e * 1024 + rg * 64) * 256 + kb * 128;
        { float v[128]; u32x4 wq[8];
#pragma unroll
            for (int j = 0; j < 128; ++j) v[j] = __builtin_nontemporal_load(s + (size_t)j * 1024);
#pragma unroll
            for (int j = 0; j < 8; ++j) { const float c_ = W8_D_SCALE; u32x4 w;
                w.x = pk4_fp8(v[16 * j] * c_, v[16 * j + 1] * c_, v[16 * j + 2] * c_, v[16 * j + 3] * c_); w.y = pk4_fp8(v[16 * j + 4] * c_, v[16 * j + 5] * c_, v[16 * j + 6] * c_, v[16 * j + 7] * c_);
                w.z = pk4_fp8(v[16 * j + 8] * c_, v[16 * j + 9] * c_, v[16 * j + 10] * c_, v[16 * j + 11] * c_); w.w = pk4_fp8(v[16 * j + 12] * c_, v[16 * j + 13] * c_, v[16 * j + 14] * c_, v[16 * j + 15] * c_);
                wq[j] = w; }
            cvt8_store_rows(wl, lane, wq, o, 256); }
    }
}

template <int PM> __device__ __forceinline__ void phase_experts8(const Params& P, LAS unsigned char* lds) {
    typedef Gemm8 G;
    const int tid = opaque_tid();
    const int* cnt = (const int*)(P.ws + WS_CTL + CTL_CNT); const int* bucket = (const int*)(P.ws + WS_BUCKET); const float* rw = (const float*)(P.ws + WS_RW);
    const unsigned char* h2q = (const unsigned char*)(P.ws + WS_H2Q); unsigned char* hidR = (unsigned char*)(P.ws + WS_HIDR) + (size_t)blockIdx.x * 256 * 256; unsigned char* y = (unsigned char*)(P.ws + WS_Y);
    LAS int* tiles = (LAS int*)(lds + P6_TILES); LAS int* pre = (LAS int*)(lds + P6_PRE); LAS int* pairs = (LAS int*)(lds + P6_PAIR); LAS float* wts = (LAS float*)(lds + P6_W);
    const int nx = (gridDim.x % 8 == 0) ? 8 : 1, xl = blockIdx.x % nx, li = blockIdx.x / nx, nloc = gridDim.x / nx, nek = 256 / nx;
    if (tid < nek) { const int c_ = cnt[(xl + nx * tid) * CNT_STRIDE]; tiles[tid] = ((c_ < BCAP ? c_ : BCAP) + 255) >> 8; }
    __syncthreads();
    if (tid < nek) { int s = 0; for (int i = 0; i < tid; ++i) s += tiles[i]; pre[tid] = s; if (tid == nek - 1) pre[nek] = s + tiles[nek - 1]; }
    __syncthreads();
    const int total = pre[nek];
    for (int u = li; u < total; u += nloc) {
        int lo = 0, hi_ = nek - 1;
        while (lo < hi_) { const int mid = (lo + hi_ + 1) >> 1; if (pre[mid] <= u) lo = mid; else hi_ = mid - 1; }
        const int e = xl + nx * lo, tile = u - pre[lo], n = cnt[e * CNT_STRIDE] < BCAP ? cnt[e * CNT_STRIDE] : BCAP, rows = (n - tile * 256) < 256 ? (n - tile * 256) : 256;
        if (tid < 256) { const int r = tid < rows ? tid : 0; const int pr = bucket[(size_t)e * BCAP + tile * 256 + r]; pairs[tid] = pr; wts[tid] = tid < rows ? rw[pr] : 0.f; }
        __syncthreads();
        {
            struct GU { const unsigned char* h2q; LAS int* pairs; const unsigned char* wgu; unsigned char* hidR;
                static __device__ __forceinline__ int wscale(int it) { return (it & 1) ? 123 : 121; }
                __device__ __forceinline__ void ptrs(int t, const unsigned char* (&aptr)[2], const unsigned char* (&wptr)[2]) const {
                    const int tid = opaque_tid(), lane = tid & 63, wid = tid >> 6;
#pragma unroll
                    for (int i = 0; i < 2; ++i) { const int row = G::t_row(i, wid, lane); aptr[i] = h2q + (size_t)(pairs[row] >> 3) * 1024 + G::t_chunk(row, lane) * 16;
                        wptr[i] = wgu + (size_t)(t * 256 + row) * 1024 + G::t_chunk(row, lane) * 16; } }
                __device__ __forceinline__ void epi(int t, f32x16 (&acc)[2][4]) const {
                    const int tid = opaque_tid(), lane = tid & 63, wid = tid >> 6, wm = wid >> 1, wn = wid & 1, l31 = lane & 31, hi = lane >> 5;
                    if (PM == 2) return;
#pragma unroll
                    for (int jt = 0; jt < 2; ++jt) { const int rl = wm * 64 + jt * 32 + l31;
#pragma unroll
                        for (int p = 0; p < 2; ++p) {
                            float e[16], hv[16];
#pragma unroll
                            for (int r = 0; r < 16; ++r) e[r] = __builtin_amdgcn_exp2f(acc[jt][2 * p][r] * -LOG2E);
                            __builtin_amdgcn_sched_barrier(0);
#pragma unroll
                            for (int r = 0; r < 16; ++r) { e[r] = __builtin_amdgcn_rcpf(1.0f + e[r]); hv[r] = acc[jt][2 * p][r] * acc[jt][2 * p + 1][r]; }
                            __builtin_amdgcn_sched_barrier(0);
                            u32x4 w;
#pragma unroll
                            for (int q4 = 0; q4 < 4; ++q4) w[q4] = pk4_fp8(hv[4 * q4] * e[4 * q4], hv[4 * q4 + 1] * e[4 * q4 + 1], hv[4 * q4 + 2] * e[4 * q4 + 2], hv[4 * q4 + 3] * e[4 * q4 + 3]);
                            *(u32x4*)(hidR + rl * 256 + t * 128 + wn * 64 + p * 32 + 16 * hi) = w; } } }
            } f{h2q, pairs, (const unsigned char*)(P.ws + WS_W8GU) + (size_t)e * 512 * 1024, hidR};
            if (PM != 3) G::run_stream(f, 2, 16, lds);
        }
        __syncthreads();
        {
            struct DN { const unsigned char* hidR; const unsigned char* wd; unsigned char* y; LAS int* pairs; LAS float* wts; int rows;
                static __device__ __forceinline__ int wscale(int) { return 120; }
                __device__ __forceinline__ void ptrs(int ct, const unsigned char* (&aptr)[2], const unsigned char* (&wptr)[2]) const {
                    const int tid = opaque_tid(), lane = tid & 63, wid = tid >> 6;
#pragma unroll
                    for (int i = 0; i < 2; ++i) { const int row = G::t_row(i, wid, lane); aptr[i] = hidR + (size_t)row * 256 + G::t_chunk(row, lane) * 16;
                        wptr[i] = wd + (size_t)(ct * 256 + row) * 256 + G::t_chunk(row, lane) * 16; } }
                __device__ __forceinline__ void epi(int ct, f32x16 (&acc)[2][4]) const {
                    const int tid = opaque_tid(), lane = tid & 63, wid = tid >> 6, wm = wid >> 1, wn = wid & 1, l31 = lane & 31, hi = lane >> 5;
                    if (PM == 3) return;
#pragma unroll
                    for (int jt = 0; jt < 2; ++jt) { const int rl = wm * 64 + jt * 32 + l31; const float sc_ = wts[rl] * Y_SCALE; const size_t pr = (size_t)pairs[rl];
                        if (rl < rows) {
#pragma unroll
                            for (int it = 0; it < 4; ++it) { u32x4 w;
#pragma unroll
                                for (int q4 = 0; q4 < 4; ++q4) w[q4] = pk4_fp8(acc[jt][it][4 * q4] * sc_, acc[jt][it][4 * q4 + 1] * sc_, acc[jt][it][4 * q4 + 2] * sc_, acc[jt][it][4 * q4 + 3] * sc_);
                                *(u32x4*)(y + pr * 1024 + ct * 256 + wn * 128 + it * 32 + 16 * hi) = w; } } } }
            } f{hidR, (const unsigned char*)(P.ws + WS_W8D) + (size_t)e * 1024 * 256, y, pairs, wts, rows};
            if (PM == 0 || PM == 3) G::run_stream(f, 4, 4, lds);
        }
        __syncthreads();
    }
}

__device__ __forceinline__ void phase_combine(const Params& P) {
    const int lane = threadIdx.x & 63, gw = blockIdx.x * (NTHREADS / 64) + (threadIdx.x >> 6), NGW = gridDim.x * (NTHREADS / 64);
    const unsigned char* y = (const unsigned char*)(P.ws + WS_Y);
    typedef float f32x2_ __attribute__((ext_vector_type(2)));
    for (int m = gw; m < T; m += NGW) {
        const float* mod = (const float*)(P.ws + WS_MOD) + (m / SEQ) * 6144 + 5120;
#pragma unroll
        for (int j = 0; j < 2; ++j) { const int col = (lane + 64 * j) * 8;
            f32x4 s0 = (f32x4){0.f, 0.f, 0.f, 0.f}, s1 = s0;
#pragma unroll
            for (int sl = 0; sl < 9; ++sl) { const u32x2 v = sl < 8 ? *(const u32x2*)(y + ((size_t)m * 8 + sl) * 1024 + col) : *(const u32x2*)((const unsigned char*)(P.ws + WS_YSH) + (size_t)m * 1024 + col);
                const f32x2_ a = __builtin_amdgcn_cvt_pk_f32_fp8((int)v.x, false), b = __builtin_amdgcn_cvt_pk_f32_fp8((int)v.x, true);
                const f32x2_ c = __builtin_amdgcn_cvt_pk_f32_fp8((int)v.y, false), d = __builtin_amdgcn_cvt_pk_f32_fp8((int)v.y, true);
                s0.x += a.x; s0.y += a.y; s0.z += b.x; s0.w += b.y; s1.x += c.x; s1.y += c.y; s1.z += d.x; s1.w += d.y; }
            const f32x4 g0 = *(const f32x4*)(mod + col), g1 = *(const f32x4*)(mod + col + 4);
            const u32x4 xr = *(const u32x4*)((const bf16_t*)(P.ws + WS_X1) + (size_t)m * 1024 + col);
            f32x4 o0 = (f32x4){__uint_as_float(xr.x << 16), __uint_as_float(xr.x & 0xffff0000u), __uint_as_float(xr.y << 16), __uint_as_float(xr.y & 0xffff0000u)};
            f32x4 o1 = (f32x4){__uint_as_float(xr.z << 16), __uint_as_float(xr.z & 0xffff0000u), __uint_as_float(xr.w << 16), __uint_as_float(xr.w & 0xffff0000u)};
            o0 += g0 * (s0 * Y_INV); o1 += g1 * (s1 * Y_INV);
            *(f32x4*)(P.out + (size_t)m * 1024 + col) = o0; *(f32x4*)(P.out + (size_t)m * 1024 + col + 4) = o1; }
    }
}


__device__ __forceinline__ int queue_pull(unsigned* head, volatile LAS unsigned* slot) {
    if (threadIdx.x == 0) *slot = atomicAdd(head, 1u);
    __syncthreads();
    const int v = (int)*slot;
    __syncthreads();
    return v;
}
__device__ __forceinline__ void phase_cmp_h1(const Params& P, LAS unsigned char* lds, volatile LAS unsigned* slot) {
    unsigned* head = (unsigned*)(P.ws + WS_CTL + CTL_Q2);
    for (;;) {
        const int u5 = queue_pull(head, slot);
        if (u5 >= 960) break;
        const int g5 = u5 / 5, p5 = u5 % 5;
        if (p5 & 1) { cvt8_item(P, lds, g5 * 2 + (p5 >> 1)); continue; }
        const int u = g5 * 3 + (p5 >> 1);
        if (u < 64) compress_unit(P, lds, u); else hgrn_unit<0>(P, lds, u - 64);
    }
}
__device__ __forceinline__ void phase_h23_nsa(const Params& P, LAS unsigned char* lds, volatile LAS unsigned* slot) {
    unsigned* head = (unsigned*)(P.ws + WS_CTL + CTL_Q3);
    for (;;) {
        const int n2 = queue_pull(head, slot);
        if (n2 >= 2688) break;
        const int g7 = n2 / 7, p7 = n2 % 7;
        if (p7 & 1) { cvt8_item(P, lds, 384 + g7 * 3 + (p7 >> 1)); continue; }
        const int n = g7 * 4 + (p7 >> 1);
        if (n < 512) nsa_unit(P, lds, (n & 7) * 128 + (127 - (n >> 3)));
        else if (n < 1024) { const int m = n - 512; hgrn_unit<1>(P, lds, (m & 15) * 32 + (31 - (m >> 4))); }
        else { const int m = n - 1024; nsa_unit(P, lds, (m & 7) * 128 + (63 - (m >> 3))); }
    }
}

constexpr int LDS_BYTES = 144 * 1024;
__global__ void __launch_bounds__(NTHREADS) mega(Params P) {
    extern __shared__ __attribute__((aligned(16))) unsigned char smem[];
    LAS unsigned char* lds = (LAS unsigned char*)smem;
    volatile LAS unsigned* xst = (volatile LAS unsigned*)(lds + LDS_BYTES - 16);
    if (threadIdx.x < 4) xst[threadIdx.x] = 0u;
    __syncthreads();
    XcdBarrier xb = xcd_barrier_post((unsigned*)(P.ws + WS_CTL + CTL_BAR), xst);
    phase_mod(P, lds);
    xcd_barrier(xb);
    { const float* mod = (const float*)(P.ws + WS_MOD); norm_mod_rows(P.x, P.norm1_w, mod, mod + 1024, (unsigned char*)(P.ws + WS_H), H1S); }
    xcd_barrier(xb);
    phase_inproj(P, lds);
    xcd_barrier(xb);
    phase_cmp_h1(P, lds, xst + 2);
    xcd_barrier(xb);
    phase_hgrn_prefix(P);
    xcd_barrier(xb);
    phase_h23_nsa(P, lds, xst + 2);
    phase_cvt_small(P);
    xcd_barrier(xb);
    phase_p4a(P, lds);
    xcd_barrier(xb);
    phase_p4b(P);
    xcd_barrier(xb);
    phase_p4c(P, lds);
    xcd_barrier(xb);
    phase_route(P, lds);
    phase_p4d(P, lds);
    xcd_barrier(xb);
    phase_experts8<0>(P, lds);
    xcd_barrier(xb);
    phase_combine(P);
}

extern "C" void kernel_launch(void* const* d_in, const int* in_sizes, int n_in, void* d_out, int out_size, void* d_ws, size_t ws_size, hipStream_t stream) {
    static int grid = 0;
    if (grid == 0) {
        if (n_in != 25 || ws_size < WS_END) { fprintf(stderr, "kernel_launch: unexpected n_in %d or ws_size %zu (need %zu)\n", n_in, ws_size, (size_t)WS_END); grid = -1; return; }
        int dev = 0, cus = 0, per_cu = 0;
        (void)hipGetDevice(&dev); (void)hipDeviceGetAttribute(&cus, hipDeviceAttributeMultiprocessorCount, dev);
        (void)hipFuncSetAttribute((const void*)mega, hipFuncAttributeMaxDynamicSharedMemorySize, LDS_BYTES);
        (void)hipOccupancyMaxActiveBlocksPerMultiprocessor(&per_cu, (const void*)mega, NTHREADS, LDS_BYTES);
        if (per_cu < 1) { fprintf(stderr, "kernel_launch: occupancy query says %d blocks per CU\n", per_cu); grid = -1; return; }
        grid = cus;
    }
    if (grid < 0) return;
    (void)hipMemsetAsync((char*)d_ws + WS_CTL, 0, 64 * 1024, stream);
    Params p{};
    const float** pf = (const float**)&p;
    for (int i = 0; i < 25; ++i) pf[i] = (const float*)d_in[i];
    p.out = (float*)d_out; p.ws = (unsigned char*)d_ws;
    void* args[] = {&p};
    hipError_t e = hipLaunchCooperativeKernel((const void*)mega, dim3(grid), dim3(NTHREADS), args, LDS_BYTES, stream);
    if (e != hipSuccess) fprintf(stderr, "cooperative launch failed: %s (grid %d)\n", hipGetErrorString(e), grid);
}

#ifdef PHASE_TEST
__global__ void __launch_bounds__(NTHREADS) t_p4a(Params P) { extern __shared__ __attribute__((aligned(16))) unsigned char smem[]; phase_p4a(P, (LAS unsigned char*)smem); }
__global__ void __launch_bounds__(NTHREADS) t_p4d(Params P) { extern __shared__ __attribute__((aligned(16))) unsigned char smem[]; phase_p4d(P, (LAS unsigned char*)smem); }
__global__ void __launch_bounds__(NTHREADS) t_p4(Params P) { extern __shared__ __attribute__((aligned(16))) unsigned char smem[]; phase_p4c(P, (LAS unsigned char*)smem); }
__global__ void __launch_bounds__(NTHREADS) t_p6(Params P) { extern __shared__ __attribute__((aligned(16))) unsigned char smem[]; phase_experts(P, (LAS unsigned char*)smem); }
__global__ void __launch_bounds__(NTHREADS) t_nsa(Params P) { extern __shared__ __attribute__((aligned(16))) unsigned char smem[]; nsa_unit(P, (LAS unsigned char*)smem, blockIdx.x); }
__global__ void __launch_bounds__(NTHREADS) t_mod(Params P) { extern __shared__ __attribute__((aligned(16))) unsigned char smem[]; phase_mod(P, (LAS unsigned char*)smem); }
__global__ void __launch_bounds__(NTHREADS) t_inproj(Params P) { extern __shared__ __attribute__((aligned(16))) unsigned char smem[]; phase_inproj(P, (LAS unsigned char*)smem); }
__global__ void __launch_bounds__(NTHREADS) t_cmp(Params P) { extern __shared__ __attribute__((aligned(16))) unsigned char smem[]; compress_unit(P, (LAS unsigned char*)smem, blockIdx.x); }
__global__ void __launch_bounds__(NTHREADS) t_h0(Params P) { extern __shared__ __attribute__((aligned(16))) unsigned char smem[]; hgrn_unit<0>(P, (LAS unsigned char*)smem, blockIdx.x); }
__global__ void __launch_bounds__(NTHREADS) t_h1(Params P) { extern __shared__ __attribute__((aligned(16))) unsigned char smem[]; hgrn_unit<1>(P, (LAS unsigned char*)smem, blockIdx.x); }
#endif
```

```cpp
#include <hip/hip_runtime.h>
#include <hip/hip_cooperative_groups.h>
#include <cstdio>
#include <cstdint>
#include <type_traits>
namespace cg = cooperative_groups;

#define LAS __attribute__((address_space(3)))
typedef unsigned short bf16_t;
typedef short bf16x8 __attribute__((ext_vector_type(8)));
typedef short s16x4 __attribute__((ext_vector_type(4)));
typedef float f32x4 __attribute__((ext_vector_type(4)));
typedef float f32x16 __attribute__((ext_vector_type(16)));
typedef unsigned u32x4 __attribute__((ext_vector_type(4)));
typedef unsigned u32x2 __attribute__((ext_vector_type(2)));

constexpr int D = 1024, BATCH = 4, SEQ = 8192, T = BATCH * SEQ;
constexpr int IN_COLS = 3352;
constexpr int NTHREADS = 512;
constexpr int H1S = 1088;
constexpr float RMS_EPS = 1e-6f;
constexpr float LOG2E = 1.4426950408889634f;
constexpr float Y_SCALE = 16.0f, Y_INV = 1.0f / 16.0f;

constexpr size_t MB = 1024ull * 1024ull;
constexpr size_t WS_CTL    = 0;
constexpr size_t WS_MOD    = 64 * 1024;
constexpr size_t WS_LB     = WS_MOD + 4 * 6144 * 4;
constexpr size_t WS_CB     = WS_LB + 2048;
constexpr size_t WS_H      = 1 * MB;
constexpr size_t WS_SS     = WS_H + 72 * MB;
constexpr size_t WS_RW     = WS_SS + 1 * MB;
constexpr size_t WS_BUCKET = WS_RW + 1 * MB;
constexpr size_t WS_HIDR   = WS_BUCKET + 16 * MB;
constexpr size_t WS_CW1    = WS_HIDR + 16 * MB;
constexpr size_t WS_CW2T   = WS_CW1 + 2 * MB;
constexpr size_t WS_WSM    = WS_HIDR + 32 * MB;
constexpr size_t WS_WOUT   = WS_WSM, WS_WRS = WS_WSM + 2 * MB, WS_WSD = WS_WSM + 4 * MB;
constexpr size_t WS_WBE    = WS_WSM + 5 * MB;
constexpr size_t WS_WBGU   = WS_WBE, WS_WBD = WS_WBE + 256 * MB;
constexpr size_t WS_W8GU   = WS_WBE, WS_W8D = WS_WBE + 128 * MB, WS_H2Q = WS_WBE + 256 * MB;
constexpr size_t WS_X1     = WS_WBE + 192 * MB;
constexpr float W8_GU_SCALE = 64.0f, W8_D_SCALE = 32.0f, HID8_SCALE = 4.0f;
constexpr size_t WS_SCORES = WS_WBE + 288 * MB;
constexpr size_t WS_HIDS   = WS_SCORES + 32 * MB;
constexpr size_t WS_WIN    = WS_WBE + 48 * MB;
constexpr size_t WS_Y      = WS_WBE + 384 * MB;
constexpr size_t WS_Q      = WS_Y;
constexpr size_t WS_KV     = WS_Q + 32 * MB;
constexpr size_t WS_GATES  = WS_KV + 48 * MB;
constexpr size_t WS_HQ     = WS_GATES + 4 * MB;
constexpr size_t WS_LOGF   = WS_HQ + 32 * MB;
constexpr size_t WS_HV     = WS_LOGF + 64 * MB;
constexpr size_t WS_HG     = WS_HV + 32 * MB;
constexpr size_t WS_CMPH   = WS_HG + 32 * MB;
constexpr size_t WS_KC     = WS_CMPH + 4 * MB;
constexpr size_t WS_VC     = WS_KC + 1 * MB;
constexpr size_t WS_HL     = WS_VC + 1 * MB;
constexpr size_t WS_HD     = WS_HL + 32 * MB;
constexpr size_t WS_MIX    = WS_HD + 1 * MB;
constexpr size_t WS_YSH    = WS_Y + 384 * MB;
constexpr size_t WS_END    = WS_YSH + 64 * MB;
constexpr int BCAP = 16384;
constexpr int CTL_CNT = 32768;
constexpr int CNT_STRIDE = 32;
constexpr int CTL_Q2 = 2048, CTL_Q3 = 2112;
constexpr int CTL_BAR = 16384;

struct Params {
    const float *x, *c, *ada_w, *ada_b, *norm1_w, *norm2_w, *w_in, *q_norm_w, *k_norm_w, *cmp_pos, *cmp_w1, *cmp_b1, *cmp_w2,
        *attn_out_norm_w, *hgrn_lb, *rec_out_norm_w, *w_out, *router_w, *router_bias, *exp_wg, *exp_wu, *exp_wd, *sh_wg, *sh_wu, *sh_wd;
    float* out;
    unsigned char* ws;
};

typedef __bf16 bf16x2_t __attribute__((ext_vector_type(2)));
typedef int i32x8 __attribute__((ext_vector_type(8)));
__device__ __forceinline__ unsigned cvtpk(float lo, float hi) { bf16x2_t v; v.x = (__bf16)lo; v.y = (__bf16)hi; return __builtin_bit_cast(unsigned, v); }
__device__ __forceinline__ int opaque_tid() { int t = threadIdx.x; asm volatile("" : "+v"(t)); return t; }
__device__ __forceinline__ float bf2f(bf16_t v) { return __uint_as_float(((unsigned)v) << 16); }
__device__ __forceinline__ float sigmoidf_(float v) { return __builtin_amdgcn_rcpf(1.0f + __expf(-v)); }
__device__ __forceinline__ float siluf_(float v) { return v * __builtin_amdgcn_rcpf(1.0f + __expf(-v)); }
__device__ __forceinline__ float wave_sum(float v) {
    v += __int_as_float(__builtin_amdgcn_update_dpp(0, __float_as_int(v), 0xB1, 0xF, 0xF, true));
    v += __int_as_float(__builtin_amdgcn_update_dpp(0, __float_as_int(v), 0x4E, 0xF, 0xF, true));
    v += __int_as_float(__builtin_amdgcn_update_dpp(0, __float_as_int(v), 0x141, 0xF, 0xF, true));
    v += __int_as_float(__builtin_amdgcn_update_dpp(0, __float_as_int(v), 0x140, 0xF, 0xF, true));
    const int b = __float_as_int(v);
    return (__int_as_float(__builtin_amdgcn_readlane(b, 0)) + __int_as_float(__builtin_amdgcn_readlane(b, 16))) + (__int_as_float(__builtin_amdgcn_readlane(b, 32)) + __int_as_float(__builtin_amdgcn_readlane(b, 48)));
}
__device__ __forceinline__ s16x4 lds_tr(const LAS unsigned char* p) {
    return __builtin_bit_cast(s16x4, __builtin_amdgcn_ds_read_tr16_b64_v4i16((LAS s16x4*)p));
}

#define XB_TMO      128
#define XB_XCNT(j)  (256  + 64 * (j))
#define XB_XSUB(j)  (1280 + 64 * (j))
#define XB_XGEN(j)  (2304 + 64 * (j))
#define XB_TOP      3328
#define XB_TOPGEN   3392
#define XCD_BAR_WORDS 3456
#define XB_SPIN_CAP (1u << 22)
__device__ __forceinline__ unsigned xb_ld(unsigned* p)              { return __hip_atomic_load(p, __ATOMIC_RELAXED, __HIP_MEMORY_SCOPE_AGENT); }
__device__ __forceinline__ unsigned xb_add(unsigned* p, unsigned v) { return __hip_atomic_fetch_add(p, v, __ATOMIC_RELAXED, __HIP_MEMORY_SCOPE_AGENT); }
__device__ __forceinline__ unsigned xb_xcc_id() { return (unsigned)__builtin_amdgcn_s_getreg((3 << 11) | 20) & 0xFu; }
#define XB_SPIN(cond, bar) do { unsigned _sp = 0; while (cond) { __builtin_amdgcn_s_sleep(1); \
    if ((++_sp & 255u) == 0u) { if (xb_ld(&(bar)[XB_TMO])) break; if (_sp > XB_SPIN_CAP) { atomicAdd(&(bar)[XB_TMO], 1u); break; } } } } while (0)
struct XcdBarrier { unsigned* bar; unsigned x; volatile LAS unsigned* st; };
__device__ __forceinline__ XcdBarrier xcd_barrier_post(unsigned* bar, volatile LAS unsigned* st) {
    XcdBarrier b; b.bar = bar; b.x = xb_xcc_id(); b.st = st;
    if (threadIdx.x == 0) (void)xb_add(&bar[XB_XCNT(b.x)], 1u);
    return b;
}
__device__ __forceinline__ void xcd_barrier_complete(unsigned* bar, unsigned x, unsigned& nloc, unsigned& nx) {
    const unsigned G = gridDim.x * gridDim.y * gridDim.z;
    unsigned sum, cnt, mine, sp = 0u;
    for (;;) {
        sum = 0u; cnt = 0u; mine = 0u;
#pragma unroll
        for (unsigned j = 0; j < 16; ++j) { const unsigned c = xb_ld(&bar[XB_XCNT(j)]); sum += c; cnt += (c > 0u) ? 1u : 0u; mine = (j == x) ? c : mine; }
        if (sum == G) break;
        __builtin_amdgcn_s_sleep(1);
        if ((++sp & 255u) == 0u) { if (xb_ld(&bar[XB_TMO])) break; if (sp > XB_SPIN_CAP) { atomicAdd(&bar[XB_TMO], 1u); break; } }
    }
    nloc = mine > 0u ? mine : 1u; nx = cnt > 0u ? cnt : 1u;
}
__device__ __forceinline__ void xcd_barrier(const XcdBarrier& b) {
    asm volatile("s_waitcnt vmcnt(0)" ::: "memory");
    __syncthreads();
    if (threadIdx.x == 0) {
        unsigned* bar = b.bar;
        __builtin_amdgcn_s_waitcnt(0);
        unsigned nloc = b.st[0], nx = b.st[1];
        if (nloc == 0u) { xcd_barrier_complete(bar, b.x, nloc, nx); b.st[0] = nloc; b.st[1] = nx; }
        const unsigned old = xb_add(&bar[XB_XSUB(b.x)], 1u);
        const unsigned gen = old / nloc;
        if (old + 1u == (gen + 1u) * nloc) {
            __builtin_amdgcn_fence(__ATOMIC_RELEASE, "agent");
            asm volatile("s_waitcnt vmcnt(0)" ::: "memory");
            const unsigned og = xb_add(&bar[XB_TOP], 1u);
            const unsigned tg = og / nx;
            if (og + 1u == (tg + 1u) * nx) xb_add(&bar[XB_TOPGEN], 1u);
            else XB_SPIN(xb_ld(&bar[XB_TOPGEN]) == tg, bar);
            __builtin_amdgcn_fence(__ATOMIC_ACQUIRE, "agent");
            xb_add(&bar[XB_XGEN(b.x)], 1u);
            asm volatile("s_waitcnt vmcnt(0)" ::: "memory");
        } else {
            XB_SPIN(xb_ld(&bar[XB_XGEN(b.x)]) == gen, bar);
            __builtin_amdgcn_fence(__ATOMIC_ACQUIRE, "agent");
            asm volatile("s_waitcnt vmcnt(0)" ::: "memory");
        }
    }
    __syncthreads();
}

template <int WM, int WN> struct GemmT {
    static constexpr int BM = 64 * WM, BN = 64 * WN;
    static constexpr int A_BYTES = BM * 128, B_BYTES = 64 * BN * 2, STAGE = A_BYTES + B_BYTES, LDS_BYTES = 2 * STAGE;
    static constexpr int NB4 = BN / 32;
    static constexpr int B_ROW4 = BN / 4;

    static __device__ __forceinline__ void run(f32x4 (&acc)[4][4], const bf16_t* const (&arow)[WM], int a_kstride, const float* Bp, int ldb, int KT, LAS unsigned char* lds) {
        const int tid = opaque_tid(), lane = tid & 63, wid = tid >> 6, wm = wid / WN, wn = wid % WN, fr = lane & 15, fq = lane >> 4;
#pragma unroll
        for (int mi = 0; mi < 4; ++mi)
#pragma unroll
            for (int ni = 0; ni < 4; ++ni) acc[mi][ni] = (f32x4){0.f, 0.f, 0.f, 0.f};
        const int achunk = tid & 7;
        u32x4 areg[WM]; f32x4 breg[NB4];
        int a_wr[WM];
#pragma unroll
        for (int p = 0; p < WM; ++p) { const int row = p * 64 + (tid >> 3); a_wr[p] = row * 128 + ((achunk ^ ((row >> 1) & 7)) << 4); }
        int b_wr[NB4]; int b_goff[NB4];
#pragma unroll
        for (int p = 0; p < NB4; ++p) { const int i = tid + NTHREADS * p, k = i / B_ROW4, n = (i % B_ROW4) * 4;
            const int f = (k & 3) | (((k >> 3) & 1) << 2);
            b_wr[p] = A_BYTES + k * (BN * 2) + (((n >> 4) ^ f) << 5) + ((n & 15) << 1); b_goff[p] = k * ldb + n; }
        int a_rd[4][2];
#pragma unroll
        for (int mi = 0; mi < 4; ++mi)
#pragma unroll
            for (int ks = 0; ks < 2; ++ks) { const int row = wm * 64 + mi * 16 + fr, ch = ks * 4 + fq; a_rd[mi][ks] = row * 128 + ((ch ^ ((row >> 1) & 7)) << 4); }
        int b_rd[2][2];
        int b_f[2][2];
#pragma unroll
        for (int ks = 0; ks < 2; ++ks)
#pragma unroll
            for (int t = 0; t < 2; ++t) { const int k = ks * 32 + 8 * fq + 4 * t + (fr >> 2); b_f[ks][t] = (k & 3) | (((k >> 3) & 1) << 2);
                b_rd[ks][t] = A_BYTES + k * (BN * 2) + ((fr & 3) << 3); }

        auto gload = [&](int kt) {
#pragma unroll
            for (int p = 0; p < WM; ++p) areg[p] = *(const u32x4*)(arow[p] + (size_t)kt * a_kstride + achunk * 8);
            const float* bk = Bp + (size_t)kt * 64 * ldb;
#pragma unroll
            for (int p = 0; p < NB4; ++p) breg[p] = *(const f32x4*)(bk + b_goff[p]);
        };
        auto lstore = [&](int buf) {
            LAS unsigned char* base = lds + buf * STAGE;
#pragma unroll
            for (int p = 0; p < WM; ++p) *(LAS u32x4*)(base + a_wr[p]) = areg[p];
#pragma unroll
            for (int p = 0; p < NB4; ++p) { u32x2 w; w.x = cvtpk(breg[p].x, breg[p].y); w.y = cvtpk(breg[p].z, breg[p].w); *(LAS u32x2*)(base + b_wr[p]) = w; }
        };
        gload(0); lstore(0); __syncthreads();
        for (int kt = 0; kt < KT; ++kt) {
            if (kt + 1 < KT) gload(kt + 1);
            __builtin_amdgcn_sched_barrier(0);
            const LAS unsigned char* base = lds + (kt & 1) * STAGE;
#pragma unroll
            for (int ks = 0; ks < 2; ++ks) {
                bf16x8 af[4], bfr[4];
#pragma unroll
                for (int mi = 0; mi < 4; ++mi) af[mi] = *(const LAS bf16x8*)(base + a_rd[mi][ks]);
#pragma unroll
                for (int ni = 0; ni < 4; ++ni) {
                    const int u0 = wn * 4 + ni;
                    const s16x4 lo = lds_tr(base + b_rd[ks][0] + ((u0 ^ b_f[ks][0]) << 5));
                    const s16x4 hi = lds_tr(base + b_rd[ks][1] + ((u0 ^ b_f[ks][1]) << 5));
                    bfr[ni] = (bf16x8){lo[0], lo[1], lo[2], lo[3], hi[0], hi[1], hi[2], hi[3]};
                }
#pragma unroll
                for (int mi = 0; mi < 4; ++mi)
#pragma unroll
                    for (int ni = 0; ni < 4; ++ni) acc[mi][ni] = __builtin_amdgcn_mfma_f32_16x16x32_bf16(bfr[ni], af[mi], acc[mi][ni], 0, 0, 0);
            }
            if (kt + 1 < KT) lstore((kt + 1) & 1);
            __syncthreads();
        }
    }
};

struct Gemm2 {
    static constexpr int A_BYTES = 32768, STAGE = 65536, LDS_BYTES = 2 * STAGE;
    static __device__ __forceinline__ int a_row(int i, int w, int lane) { return (i * 8 + w) * 8 + (lane >> 3); }
    static __device__ __forceinline__ int a_chunk(int row, int lane) { return (lane & 7) ^ ((row >> 1) & 7); }
    static __device__ __forceinline__ int b_k(int i, int w, int lane) { return (i * 8 + w) * 2 + (lane >> 5); }
    static __device__ __forceinline__ int b_n(int k, int lane) { return ((((lane & 31) >> 1) ^ fk2(k)) << 4) + ((lane & 1) << 3); }
    static __device__ __forceinline__ int fk2(int r) { return (r & 3) | (((r >> 3) & 1) << 2); }

    static __device__ __forceinline__ void run(f32x4 (&acc)[4][8], const bf16_t* const (&aptr)[4], int a_kstride, const bf16_t* const (&bptr)[4], size_t b_kstride, int KT, LAS unsigned char* lds) {
        const int tid = opaque_tid(), lane = tid & 63, wid = tid >> 6, wm = wid >> 1, wn = wid & 1, fr = lane & 15, fq = lane >> 4;
        const int wu = __builtin_amdgcn_readfirstlane(wid);
#pragma unroll
        for (int mi = 0; mi < 4; ++mi)
#pragma unroll
            for (int ni = 0; ni < 8; ++ni) acc[mi][ni] = (f32x4){0.f, 0.f, 0.f, 0.f};
        int a_rd[4][2];
#pragma unroll
        for (int mi = 0; mi < 4; ++mi)
#pragma unroll
            for (int ks = 0; ks < 2; ++ks) { const int row = wm * 64 + mi * 16 + fr, ch = ks * 4 + fq; a_rd[mi][ks] = row * 128 + ((ch ^ ((row >> 1) & 7)) << 4); }
        int b_rd[2][2], b_f[2][2];
#pragma unroll
        for (int ks = 0; ks < 2; ++ks)
#pragma unroll
            for (int t = 0; t < 2; ++t) { const int k = ks * 32 + 8 * fq + 4 * t + (fr >> 2); b_f[ks][t] = fk2(k); b_rd[ks][t] = A_BYTES + k * 512 + ((fr & 3) << 3); }
        auto issue = [&](int kt, int buf) {
            LAS unsigned char* base = lds + buf * STAGE + wu * 1024;
#pragma unroll
            for (int i = 0; i < 4; ++i) __builtin_amdgcn_global_load_lds((const unsigned*)(aptr[i] + (size_t)kt * a_kstride), (LAS unsigned*)(base + i * 8192), 16, 0, 0);
#pragma unroll
            for (int i = 0; i < 4; ++i) __builtin_amdgcn_global_load_lds((const unsigned*)(bptr[i] + (size_t)kt * b_kstride), (LAS unsigned*)(base + A_BYTES + i * 8192), 16, 0, 0);
        };
        issue(0, 0);
        for (int kt = 0; kt < KT; ++kt) {
            asm volatile("s_waitcnt vmcnt(0)" ::: "memory");
            __syncthreads();
            if (kt + 1 < KT) issue(kt + 1, (kt + 1) & 1);
            const LAS unsigned char* base = lds + (kt & 1) * STAGE;
#pragma unroll
            for (int ks = 0; ks < 2; ++ks) {
                bf16x8 af[4];
#pragma unroll
                for (int mi = 0; mi < 4; ++mi) af[mi] = *(const LAS bf16x8*)(base + a_rd[mi][ks]);
#pragma unroll
                for (int ni = 0; ni < 8; ++ni) {
                    const int u0 = wn * 8 + ni;
                    const s16x4 lo = lds_tr(base + b_rd[ks][0] + ((u0 ^ b_f[ks][0]) << 5));
                    const s16x4 hi = lds_tr(base + b_rd[ks][1] + ((u0 ^ b_f[ks][1]) << 5));
                    const bf16x8 bfr = (bf16x8){lo[0], lo[1], lo[2], lo[3], hi[0], hi[1], hi[2], hi[3]};
#pragma unroll
                    for (int mi = 0; mi < 4; ++mi) acc[mi][ni] = __builtin_amdgcn_mfma_f32_16x16x32_bf16(bfr, af[mi], acc[mi][ni], 0, 0, 0);
                }
            }
        }
        __syncthreads();
    }
};

__device__ __forceinline__ void glds16(const void* g, unsigned lds_base) {
    unsigned sv; asm volatile("s_mov_b32 %0, m0\n\ts_mov_b32 m0, %2\n\ts_nop 0\n\tglobal_load_lds_dwordx4 %1, off\n\ts_mov_b32 m0, %0" : "=&s"(sv) : "v"(g), "s"(lds_base) : "memory"); }
struct Gemm3 {
    static constexpr int A_BYTES = 16384, STAGE = 32768, LDS_BYTES = 4 * STAGE;
    static __device__ __forceinline__ int a_row(int i, int w, int lane) { return (i * 8 + w) * 16 + (lane >> 2); }
    static __device__ __forceinline__ int a_chunk(int row, int lane) { return (lane & 3) ^ ((row >> 2) & 3); }
    static __device__ __forceinline__ int b_k(int i, int w, int lane) { return (i * 8 + w) * 2 + (lane >> 5); }
    static __device__ __forceinline__ int fk2(int r) { return (r & 3) | (((r >> 3) & 1) << 2); }
    static __device__ __forceinline__ int b_n(int k, int lane) { return ((((lane & 31) >> 1) ^ fk2(k)) << 4) + ((lane & 1) << 3); }
    template <bool ZERO = true> static __device__ __forceinline__ void run(f32x4 (&acc)[4][8], const bf16_t* const (&aptr)[2], int a_kstride, const bf16_t* const (&bptr)[2], size_t b_kstride, int KT, LAS unsigned char* lds) {
        const int tid = opaque_tid(), lane = tid & 63, wid = tid >> 6, wm = wid >> 1, wn = wid & 1, fr = lane & 15, fq = lane >> 4;
        const int wu = __builtin_amdgcn_readfirstlane(wid);
        if (ZERO) {
#pragma unroll
        for (int mi = 0; mi < 4; ++mi)
#pragma unroll
            for (int ni = 0; ni < 8; ++ni) acc[mi][ni] = (f32x4){0.f, 0.f, 0.f, 0.f}; }
        int a_rd[4];
#pragma unroll
        for (int mi = 0; mi < 4; ++mi) { const int row = wm * 64 + mi * 16 + fr; a_rd[mi] = row * 64 + ((fq ^ ((row >> 2) & 3)) << 4); }
        int b_rd[2], b_f[2];
#pragma unroll
        for (int t = 0; t < 2; ++t) { const int k = 8 * fq + 4 * t + (fr >> 2); b_f[t] = fk2(k); b_rd[t] = A_BYTES + k * 512 + ((fr & 3) << 3); }
        const unsigned lds0 = (unsigned)(uintptr_t)lds + (unsigned)wu * 1024u;
        auto issue = [&](int kt) {
            const unsigned base = (unsigned)__builtin_amdgcn_readfirstlane((int)(lds0 + (unsigned)(kt & 3) * STAGE));
#pragma unroll
            for (int i = 0; i < 2; ++i) glds16(aptr[i] + (size_t)kt * a_kstride, base + i * 8192);
#pragma unroll
            for (int i = 0; i < 2; ++i) glds16(bptr[i] + (size_t)kt * b_kstride, base + A_BYTES + i * 8192);
        };
        const int grp = wu >> 2;
        auto bar = [&]() { asm volatile("s_waitcnt lgkmcnt(0)" ::: "memory"); __builtin_amdgcn_s_barrier(); asm volatile("" ::: "memory"); };
        asm volatile("s_waitcnt vmcnt(0)" ::: "memory");
        issue(0); if (KT > 1) issue(1); if (KT > 2) issue(2);
        if (KT > 2) asm volatile("s_waitcnt vmcnt(8)" ::: "memory"); else if (KT > 1) asm volatile("s_waitcnt vmcnt(4)" ::: "memory"); else asm volatile("s_waitcnt vmcnt(0)" ::: "memory");
        bar();
        if (grp) bar();
#pragma unroll 1
        for (int kt = 0; kt < KT; ++kt) {
            if (kt + 3 < KT) issue(kt + 3);
            const LAS unsigned char* base = lds + (kt & 3) * STAGE;
            bf16x8 af[4], bfr[8];
#pragma unroll
            for (int mi = 0; mi < 4; ++mi) af[mi] = *(const LAS bf16x8*)(base + a_rd[mi]);
#pragma unroll
            for (int ni = 0; ni < 8; ++ni) {
                const int u0 = wn * 8 + ni;
                const s16x4 lo = lds_tr(base + b_rd[0] + ((u0 ^ b_f[0]) << 5));
                const s16x4 hi = lds_tr(base + b_rd[1] + ((u0 ^ b_f[1]) << 5));
                bfr[ni] = (bf16x8){lo[0], lo[1], lo[2], lo[3], hi[0], hi[1], hi[2], hi[3]};
            }
            { const int rem = KT - 2 - kt;
              if (rem >= 2) asm volatile("s_waitcnt vmcnt(8)" ::: "memory"); else if (rem == 1) asm volatile("s_waitcnt vmcnt(4)" ::: "memory"); else asm volatile("s_waitcnt vmcnt(0)" ::: "memory"); }
            bar();
            __builtin_amdgcn_sched_barrier(0);
#pragma unroll
            for (int ni = 0; ni < 8; ++ni)
#pragma unroll
                for (int mi = 0; mi < 4; ++mi) acc[mi][ni] = __builtin_amdgcn_mfma_f32_16x16x32_bf16(bfr[ni], af[mi], acc[mi][ni], 0, 0, 0);
            __builtin_amdgcn_sched_barrier(0);
            bar();
        }
        if (!grp) bar();
    }

    template <class F> static __device__ __forceinline__ void run_stream(F& f, int NSEG, int KT, int a_kstride, size_t b_kstride, LAS unsigned char* lds) {
        const int tid = opaque_tid(), lane = tid & 63, wid = tid >> 6, wm = wid >> 1, wn = wid & 1, fr = lane & 15, fq = lane >> 4;
        const int wu = __builtin_amdgcn_readfirstlane(wid);
        f32x4 acc[4][8];
#pragma unroll
        for (int mi = 0; mi < 4; ++mi)
#pragma unroll
            for (int ni = 0; ni < 8; ++ni) acc[mi][ni] = (f32x4){0.f, 0.f, 0.f, 0.f};
        int a_rd[4];
#pragma unroll
        for (int mi = 0; mi < 4; ++mi) { const int row = wm * 64 + mi * 16 + fr; a_rd[mi] = row * 64 + ((fq ^ ((row >> 2) & 3)) << 4); }
        int b_rd[2], b_f[2];
#pragma unroll
        for (int t = 0; t < 2; ++t) { const int k = 8 * fq + 4 * t + (fr >> 2); b_f[t] = fk2(k); b_rd[t] = A_BYTES + k * 512 + ((fr & 3) << 3); }
        const unsigned lds0 = (unsigned)(uintptr_t)lds + (unsigned)wu * 1024u;
        const bf16_t* aptr[2]; const bf16_t* bptr[2];
        const int total = NSEG * KT;
        int lseg = 0, lkt = 0, lg = 0;
        auto issue = [&]() {
            const unsigned base = (unsigned)__builtin_amdgcn_readfirstlane((int)(lds0 + (unsigned)(lg & 3) * STAGE));
#pragma unroll
            for (int i = 0; i < 2; ++i) glds16(aptr[i] + (size_t)lkt * a_kstride, base + i * 8192);
#pragma unroll
            for (int i = 0; i < 2; ++i) glds16(bptr[i] + (size_t)lkt * b_kstride, base + A_BYTES + i * 8192);
            ++lg; if (++lkt == KT) { lkt = 0; ++lseg; if (lseg < NSEG) f.ptrs(lseg, aptr, bptr); }
        };
        const int grp = wu >> 2;
        auto bar = [&]() { asm volatile("s_waitcnt lgkmcnt(0)" ::: "memory"); __builtin_amdgcn_s_barrier(); asm volatile("" ::: "memory"); };
        f.ptrs(0, aptr, bptr);
        asm volatile("s_waitcnt vmcnt(0)" ::: "memory");
        issue(); if (total > 1) issue(); if (total > 2) issue();
        if (total > 2) asm volatile("s_waitcnt vmcnt(8)" ::: "memory"); else if (total > 1) asm volatile("s_waitcnt vmcnt(4)" ::: "memory"); else asm volatile("s_waitcnt vmcnt(0)" ::: "memory");
        bar();
        if (grp) bar();
        int cseg = 0, ckt = 0;
#pragma unroll 1
        for (int g = 0; g < total; ++g) {
            if (lg < total) issue();
            const LAS unsigned char* base = lds + (g & 3) * STAGE;
            bf16x8 af[4], bfr[8];
#pragma unroll
            for (int mi = 0; mi < 4; ++mi) af[mi] = *(const LAS bf16x8*)(base + a_rd[mi]);
#pragma unroll
            for (int ni = 0; ni < 8; ++ni) {
                const int u0 = wn * 8 + ni;
                const s16x4 lo = lds_tr(base + b_rd[0] + ((u0 ^ b_f[0]) << 5));
                const s16x4 hi = lds_tr(base + b_rd[1] + ((u0 ^ b_f[1]) << 5));
                bfr[ni] = (bf16x8){lo[0], lo[1], lo[2], lo[3], hi[0], hi[1], hi[2], hi[3]};
            }
            { const int rem = total - 2 - g;
              if (rem >= 2) asm volatile("s_waitcnt vmcnt(8)" ::: "memory"); else if (rem == 1) asm volatile("s_waitcnt vmcnt(4)" ::: "memory"); else asm volatile("s_waitcnt vmcnt(0)" ::: "memory"); }
            bar();
            __builtin_amdgcn_sched_barrier(0);
#pragma unroll
            for (int ni = 0; ni < 8; ++ni)
#pragma unroll
                for (int mi = 0; mi < 4; ++mi) acc[mi][ni] = __builtin_amdgcn_mfma_f32_16x16x32_bf16(bfr[ni], af[mi], acc[mi][ni], 0, 0, 0);
            __builtin_amdgcn_sched_barrier(0);
            bar();
            if (++ckt == KT) {
                if (!grp) bar();
                f.epi(cseg, acc);
#pragma unroll
                for (int mi = 0; mi < 4; ++mi)
#pragma unroll
                    for (int ni = 0; ni < 8; ++ni) acc[mi][ni] = (f32x4){0.f, 0.f, 0.f, 0.f};
                ckt = 0; ++cseg;
                if (grp) bar();
            }
        }
        if (!grp) bar();
    }
};

struct Gemm8 {
    static constexpr int A_BYTES = 16384, STAGE = 32768;
    static __device__ __forceinline__ int t_row(int i, int w, int lane) { return (i * 8 + w) * 16 + (lane >> 2); }
    static __device__ __forceinline__ int t_chunk(int row, int lane) { return (lane & 3) ^ ((row >> 2) & 3); }
    static __device__ __forceinline__ int w_col(int i) { return 16 * ((i >> 2) & 1) + 4 * (i >> 3) + (i & 3); }
    template <class F> static __device__ __forceinline__ void run_stream(F& f, int NSEG, int KT, LAS unsigned char* lds) {
        const int tid = opaque_tid(), lane = tid & 63, wid = tid >> 6, wm = wid >> 1, wn = wid & 1, l31 = lane & 31, hi = lane >> 5;
        const int wu = __builtin_amdgcn_readfirstlane(wid);
        f32x16 acc[2][4];
#pragma unroll
        for (int jt = 0; jt < 2; ++jt)
#pragma unroll
            for (int it = 0; it < 4; ++it)
#pragma unroll
                for (int r = 0; r < 16; ++r) acc[jt][it][r] = 0.f;
        const int sw = (l31 >> 2) & 3;
        const int t_rd0 = (wm * 64 + l31) * 64 + (((2 * hi) ^ sw) << 4), t_rd1 = (wm * 64 + l31) * 64 + (((2 * hi + 1) ^ sw) << 4);
        const int w_rd0 = A_BYTES + (wn * 128 + l31) * 64 + (((2 * hi) ^ sw) << 4), w_rd1 = A_BYTES + (wn * 128 + l31) * 64 + (((2 * hi + 1) ^ sw) << 4);
        const unsigned lds0 = (unsigned)(uintptr_t)lds + (unsigned)wu * 1024u;
        const unsigned char* aptr[2]; const unsigned char* wptr[2];
        const int total = NSEG * KT;
        int lseg = 0, lkt = 0, lg = 0;
        auto issue = [&]() {
            const unsigned base = (unsigned)__builtin_amdgcn_readfirstlane((int)(lds0 + (unsigned)(lg & 3) * STAGE));
#pragma unroll
            for (int i = 0; i < 2; ++i) glds16(aptr[i] + lkt * 64, base + i * 8192);
#pragma unroll
            for (int i = 0; i < 2; ++i) glds16(wptr[i] + lkt * 64, base + A_BYTES + i * 8192);
            ++lg; if (++lkt == KT) { lkt = 0; ++lseg; if (lseg < NSEG) f.ptrs(lseg, aptr, wptr); }
        };
        const int grp = wu >> 2;
        auto bar = [&]() { asm volatile("s_waitcnt lgkmcnt(0)" ::: "memory"); __builtin_amdgcn_s_barrier(); asm volatile("" ::: "memory"); };
        f.ptrs(0, aptr, wptr);
        asm volatile("s_waitcnt vmcnt(0)" ::: "memory");
        issue(); if (total > 1) issue(); if (total > 2) issue();
        if (total > 2) asm volatile("s_waitcnt vmcnt(8)" ::: "memory"); else if (total > 1) asm volatile("s_waitcnt vmcnt(4)" ::: "memory"); else asm volatile("s_waitcnt vmcnt(0)" ::: "memory");
        bar();
        if (grp) bar();
        int cseg = 0, ckt = 0;
#pragma unroll 1
        for (int g = 0; g < total; ++g) {
            if (lg < total) issue();
            const LAS unsigned char* base = lds + (g & 3) * STAGE;
            i32x8 tf[2], wf[4];
#pragma unroll
            for (int jt = 0; jt < 2; ++jt) { const u32x4 lo = *(const LAS u32x4*)(base + t_rd0 + jt * 2048), h4 = *(const LAS u32x4*)(base + t_rd1 + jt * 2048);
                tf[jt] = (i32x8){(int)lo.x, (int)lo.y, (int)lo.z, (int)lo.w, (int)h4.x, (int)h4.y, (int)h4.z, (int)h4.w}; }
#pragma unroll
            for (int it = 0; it < 4; ++it) { const u32x4 lo = *(const LAS u32x4*)(base + w_rd0 + it * 2048), h4 = *(const LAS u32x4*)(base + w_rd1 + it * 2048);
                wf[it] = (i32x8){(int)lo.x, (int)lo.y, (int)lo.z, (int)lo.w, (int)h4.x, (int)h4.y, (int)h4.z, (int)h4.w}; }
            { const int rem = total - 2 - g;
              if (rem >= 2) asm volatile("s_waitcnt vmcnt(8)" ::: "memory"); else if (rem == 1) asm volatile("s_waitcnt vmcnt(4)" ::: "memory"); else asm volatile("s_waitcnt vmcnt(0)" ::: "memory"); }
            bar();
            __builtin_amdgcn_sched_barrier(0);
#pragma unroll
            for (int it = 0; it < 4; ++it)
#pragma unroll
                for (int jt = 0; jt < 2; ++jt) acc[jt][it] = __builtin_amdgcn_mfma_scale_f32_32x32x64_f8f6f4(wf[it], tf[jt], acc[jt][it], 0, 0, 0, F::wscale(it), 0, 127);
            __builtin_amdgcn_sched_barrier(0);
            bar();
            if (++ckt == KT) {
                if (!grp) bar();
                f.epi(cseg, acc);
#pragma unroll
                for (int jt = 0; jt < 2; ++jt)
#pragma unroll
                    for (int it = 0; it < 4; ++it)
#pragma unroll
                        for (int r = 0; r < 16; ++r) acc[jt][it][r] = 0.f;
                ckt = 0; ++cseg;
                if (grp) bar();
            }
        }
        if (!grp) bar();
    }
};

struct Gemm4 {
    static constexpr int A_BYTES = 16384, STAGE = 32768, LDS_BYTES = 2 * STAGE;
    static __device__ __forceinline__ int fk2(int r) { return (r & 3) | (((r >> 3) & 1) << 2); }
    static __device__ __forceinline__ int a_row(int i, int tid) { return (tid >> 2) + 128 * i; }
    static __device__ __forceinline__ int b_k(int i, int tid) { return (tid >> 5) + 16 * i; }
    static __device__ __forceinline__ void run(f32x4 (&acc)[4][8], const bf16_t* const (&aptr)[2], int a_kstride, const bf16_t* const (&bptr)[2], size_t b_kstride, int KT, LAS unsigned char* lds) {
        const int tid = opaque_tid(), lane = tid & 63, wid = tid >> 6, wm = wid >> 1, wn = wid & 1, fr = lane & 15, fq = lane >> 4;
#pragma unroll
        for (int mi = 0; mi < 4; ++mi)
#pragma unroll
            for (int ni = 0; ni < 8; ++ni) acc[mi][ni] = (f32x4){0.f, 0.f, 0.f, 0.f};
        int a_wr[2], b_wr[2];
#pragma unroll
        for (int i = 0; i < 2; ++i) { const int row = a_row(i, tid); a_wr[i] = row * 64 + (((tid & 3) ^ ((row >> 1) & 3)) << 4);
            const int k = b_k(i, tid), n = (tid & 31) * 8; b_wr[i] = A_BYTES + k * 512 + (((n >> 4) ^ fk2(k)) << 5) + ((n & 15) << 1); }
        int a_rd[4];
#pragma unroll
        for (int mi = 0; mi < 4; ++mi) { const int row = wm * 64 + mi * 16 + fr; a_rd[mi] = row * 64 + ((fq ^ ((row >> 1) & 3)) << 4); }
        int b_rd[2], b_f[2];
#pragma unroll
        for (int t = 0; t < 2; ++t) { const int k = 8 * fq + 4 * t + (fr >> 2); b_f[t] = fk2(k); b_rd[t] = A_BYTES + k * 512 + ((fr & 3) << 3); }
        u32x4 ra0[2], rb0[2], ra1[2], rb1[2];
        auto gload = [&](int kt, u32x4 (&ra)[2], u32x4 (&rb)[2]) {
#pragma unroll
            for (int i = 0; i < 2; ++i) { ra[i] = *(const u32x4*)(aptr[i] + (size_t)kt * a_kstride); rb[i] = *(const u32x4*)(bptr[i] + (size_t)kt * b_kstride); }
        };
        auto lstore = [&](int buf, const u32x4 (&ra)[2], const u32x4 (&rb)[2]) {
            LAS unsigned char* base = lds + buf * STAGE;
#pragma unroll
            for (int i = 0; i < 2; ++i) { *(LAS u32x4*)(base + a_wr[i]) = ra[i]; *(LAS u32x4*)(base + b_wr[i]) = rb[i]; }
        };
        auto compute = [&](int buf) {
            const LAS unsigned char* base = lds + buf * STAGE;
            bf16x8 af[4];
#pragma unroll
            for (int mi = 0; mi < 4; ++mi) af[mi] = *(const LAS bf16x8*)(base + a_rd[mi]);
#pragma unroll
            for (int ni = 0; ni < 8; ++ni) {
                const int u0 = wn * 8 + ni;
                const s16x4 lo = lds_tr(base + b_rd[0] + ((u0 ^ b_f[0]) << 5));
                const s16x4 hi = lds_tr(base + b_rd[1] + ((u0 ^ b_f[1]) << 5));
                const bf16x8 bfr = (bf16x8){lo[0], lo[1], lo[2], lo[3], hi[0], hi[1], hi[2], hi[3]};
#pragma unroll
                for (int mi = 0; mi < 4; ++mi) acc[mi][ni] = __builtin_amdgcn_mfma_f32_16x16x32_bf16(bfr, af[mi], acc[mi][ni], 0, 0, 0);
            }
        };
        gload(0, ra0, rb0); gload(1, ra1, rb1);
        lstore(0, ra0, rb0); __syncthreads();
        for (int kt = 0; kt < KT; kt += 2) {
            gload(kt + 2 < KT ? kt + 2 : KT - 1, ra0, rb0);
            __builtin_amdgcn_sched_barrier(0);
            compute(0);
            lstore(1, ra1, rb1);
            __syncthreads();
            gload(kt + 3 < KT ? kt + 3 : KT - 1, ra1, rb1);
            __builtin_amdgcn_sched_barrier(0);
            compute(1);
            lstore(0, ra0, rb0);
            __syncthreads();
        }
    }

    template <class F> static __device__ __forceinline__ void run_stream(F& f, int NSEG, int KT, int a_kstride, size_t b_kstride, LAS unsigned char* lds) {
        const int tid = opaque_tid(), lane = tid & 63, wid = tid >> 6, wm = wid >> 1, wn = wid & 1, fr = lane & 15, fq = lane >> 4;
        f32x4 acc[4][8];
#pragma unroll
        for (int mi = 0; mi < 4; ++mi)
#pragma unroll
            for (int ni = 0; ni < 8; ++ni) acc[mi][ni] = (f32x4){0.f, 0.f, 0.f, 0.f};
        int a_wr[2], b_wr[2];
#pragma unroll
        for (int i = 0; i < 2; ++i) { const int row = a_row(i, tid); a_wr[i] = row * 64 + (((tid & 3) ^ ((row >> 1) & 3)) << 4);
            const int k = b_k(i, tid), n = (tid & 31) * 8; b_wr[i] = A_BYTES + k * 512 + (((n >> 4) ^ fk2(k)) << 5) + ((n & 15) << 1); }
        int a_rd[4];
#pragma unroll
        for (int mi = 0; mi < 4; ++mi) { const int row = wm * 64 + mi * 16 + fr; a_rd[mi] = row * 64 + ((fq ^ ((row >> 1) & 3)) << 4); }
        int b_rd[2], b_f[2];
#pragma unroll
        for (int t = 0; t < 2; ++t) { const int k = 8 * fq + 4 * t + (fr >> 2); b_f[t] = fk2(k); b_rd[t] = A_BYTES + k * 512 + ((fr & 3) << 3); }
        const bf16_t* aptr[2]; const bf16_t* bptr[2];
        u32x4 ra0[2], rb0[2], ra1[2], rb1[2];
        int lseg = 0, lkt = 0;
        auto gload = [&](u32x4 (&ra)[2], u32x4 (&rb)[2]) {
#pragma unroll
            for (int i = 0; i < 2; ++i) { ra[i] = *(const u32x4*)(aptr[i] + (size_t)lkt * a_kstride); rb[i] = *(const u32x4*)(bptr[i] + (size_t)lkt * b_kstride); }
            if (lkt + 1 < KT) ++lkt; else if (lseg + 1 < NSEG) { lkt = 0; ++lseg; f.ptrs(lseg, aptr, bptr); }
        };
        auto lstore = [&](int buf, const u32x4 (&ra)[2], const u32x4 (&rb)[2]) {
            LAS unsigned char* base = lds + buf * STAGE;
#pragma unroll
            for (int i = 0; i < 2; ++i) { *(LAS u32x4*)(base + a_wr[i]) = ra[i]; *(LAS u32x4*)(base + b_wr[i]) = rb[i]; }
        };
        auto compute = [&](int buf) {
            const LAS unsigned char* base = lds + buf * STAGE;
            bf16x8 af[4];
#pragma unroll
            for (int mi = 0; mi < 4; ++mi) af[mi] = *(const LAS bf16x8*)(base + a_rd[mi]);
#pragma unroll
            for (int ni = 0; ni < 8; ++ni) {
                const int u0 = wn * 8 + ni;
                const s16x4 lo = lds_tr(base + b_rd[0] + ((u0 ^ b_f[0]) << 5));
                const s16x4 hi = lds_tr(base + b_rd[1] + ((u0 ^ b_f[1]) << 5));
                const bf16x8 bfr = (bf16x8){lo[0], lo[1], lo[2], lo[3], hi[0], hi[1], hi[2], hi[3]};
#pragma unroll
                for (int mi = 0; mi < 4; ++mi) acc[mi][ni] = __builtin_amdgcn_mfma_f32_16x16x32_bf16(bfr, af[mi], acc[mi][ni], 0, 0, 0);
            }
        };
        f.ptrs(0, aptr, bptr);
        gload(ra0, rb0); gload(ra1, rb1);
        lstore(0, ra0, rb0); __syncthreads();
        int cseg = 0, ckt = 0;
        const int total = NSEG * KT;
#pragma unroll 1
        for (int g = 0; g < total; g += 2) {
            gload(ra0, rb0);
            __builtin_amdgcn_sched_barrier(0);
            compute(0);
            lstore(1, ra1, rb1);
            __syncthreads();
            gload(ra1, rb1);
            __builtin_amdgcn_sched_barrier(0);
            compute(1);
            lstore(0, ra0, rb0);
            __syncthreads();
            ckt += 2;
            if (ckt == KT) {
                f.epi(cseg, acc);
#pragma unroll
                for (int mi = 0; mi < 4; ++mi)
#pragma unroll
                    for (int ni = 0; ni < 8; ++ni) acc[mi][ni] = (f32x4){0.f, 0.f, 0.f, 0.f};
                ckt = 0; ++cseg;
            }
        }
    }
};

template <bool BF32> struct Gemm5 {
    static constexpr int A_BYTES = 16384, STAGE = 32768, LDS_BYTES = 2 * STAGE;
    static __device__ __forceinline__ int fk2(int r) { return (r & 3) | (((r >> 3) & 1) << 2); }
    static __device__ __forceinline__ int a_row(int i, int tid) { return (tid >> 2) + 128 * i; }
    static __device__ __forceinline__ int b_k(int i, int tid) { return (tid >> 5) + 16 * i; }
    typedef typename std::conditional<BF32, float, bf16_t>::type b_t;
    static __device__ __forceinline__ void run(f32x4 (&acc)[4][8], const bf16_t* const (&aptr)[2], int a_kstride, const b_t* const (&bptr)[2], size_t b_kstride, int KT, LAS unsigned char* lds) {
        const int tid = opaque_tid(), lane = tid & 63, wid = tid >> 6, wm = wid >> 1, wn = wid & 1, fr = lane & 15, fq = lane >> 4;
#pragma unroll
        for (int mi = 0; mi < 4; ++mi)
#pragma unroll
            for (int ni = 0; ni < 8; ++ni) acc[mi][ni] = (f32x4){0.f, 0.f, 0.f, 0.f};
        int a_wr[2], b_wr[2];
#pragma unroll
        for (int i = 0; i < 2; ++i) { const int row = a_row(i, tid); a_wr[i] = row * 64 + (((tid & 3) ^ ((row >> 1) & 3)) << 4);
            const int k = b_k(i, tid), n = (tid & 31) * 8; b_wr[i] = A_BYTES + k * 512 + (((n >> 4) ^ fk2(k)) << 5) + ((n & 15) << 1); }
        int a_rd[4];
#pragma unroll
        for (int mi = 0; mi < 4; ++mi) { const int row = wm * 64 + mi * 16 + fr; a_rd[mi] = row * 64 + ((fq ^ ((row >> 1) & 3)) << 4); }
        int b_rd[2], b_f[2];
#pragma unroll
        for (int t = 0; t < 2; ++t) { const int k = 8 * fq + 4 * t + (fr >> 2); b_f[t] = fk2(k); b_rd[t] = A_BYTES + k * 512 + ((fr & 3) << 3); }
        u32x4 ra[2]; u32x4 rb[2]; f32x4 rbf[2][2];
        auto gload = [&](int kt) {
#pragma unroll
            for (int i = 0; i < 2; ++i) { ra[i] = *(const u32x4*)(aptr[i] + (size_t)kt * a_kstride);
                if (BF32) { const float* p = (const float*)bptr[i] + (size_t)kt * b_kstride; rbf[i][0] = *(const f32x4*)p; rbf[i][1] = *(const f32x4*)(p + 4); }
                else rb[i] = *(const u32x4*)((const bf16_t*)bptr[i] + (size_t)kt * b_kstride); }
        };
        auto lstore = [&](int buf) {
            LAS unsigned char* base = lds + buf * STAGE;
#pragma unroll
            for (int i = 0; i < 2; ++i) { *(LAS u32x4*)(base + a_wr[i]) = ra[i];
                if (BF32) { u32x4 w; w.x = cvtpk(rbf[i][0].x, rbf[i][0].y); w.y = cvtpk(rbf[i][0].z, rbf[i][0].w); w.z = cvtpk(rbf[i][1].x, rbf[i][1].y); w.w = cvtpk(rbf[i][1].z, rbf[i][1].w); *(LAS u32x4*)(base + b_wr[i]) = w; }
                else *(LAS u32x4*)(base + b_wr[i]) = rb[i]; }
        };
        auto compute = [&](int buf) {
            const LAS unsigned char* base = lds + buf * STAGE;
            bf16x8 af[4];
#pragma unroll
            for (int mi = 0; mi < 4; ++mi) af[mi] = *(const LAS bf16x8*)(base + a_rd[mi]);
#pragma unroll
            for (int ni = 0; ni < 8; ++ni) {
                const int u0 = wn * 8 + ni;
                const s16x4 lo = lds_tr(base + b_rd[0] + ((u0 ^ b_f[0]) << 5));
                const s16x4 hi = lds_tr(base + b_rd[1] + ((u0 ^ b_f[1]) << 5));
                const bf16x8 bfr = (bf16x8){lo[0], lo[1], lo[2], lo[3], hi[0], hi[1], hi[2], hi[3]};
#pragma unroll
                for (int mi = 0; mi < 4; ++mi) acc[mi][ni] = __builtin_amdgcn_mfma_f32_16x16x32_bf16(bfr, af[mi], acc[mi][ni], 0, 0, 0);
            }
        };
        gload(0); lstore(0); __syncthreads();
#pragma unroll 1
        for (int kt = 0; kt < KT; ++kt) {
            gload(kt + 1 < KT ? kt + 1 : KT - 1);
            __builtin_amdgcn_sched_barrier(0);
            compute(kt & 1);
            lstore((kt + 1) & 1);
            __syncthreads();
        }
    }

    template <class F> static __device__ __forceinline__ void run_stream(F& f, int NSEG, int KT, int a_kstride, size_t b_kstride, LAS unsigned char* lds) {
        const int tid = opaque_tid(), lane = tid & 63, wid = tid >> 6, wm = wid >> 1, wn = wid & 1, fr = lane & 15, fq = lane >> 4;
        f32x4 acc[4][8];
#pragma unroll
        for (int mi = 0; mi < 4; ++mi)
#pragma unroll
            for (int ni = 0; ni < 8; ++ni) acc[mi][ni] = (f32x4){0.f, 0.f, 0.f, 0.f};
        int a_wr[2], b_wr[2];
#pragma unroll
        for (int i = 0; i < 2; ++i) { const int row = a_row(i, tid); a_wr[i] = row * 64 + (((tid & 3) ^ ((row >> 1) & 3)) << 4);
            const int k = b_k(i, tid), n = (tid & 31) * 8; b_wr[i] = A_BYTES + k * 512 + (((n >> 4) ^ fk2(k)) << 5) + ((n & 15) << 1); }
        int a_rd[4];
#pragma unroll
        for (int mi = 0; mi < 4; ++mi) { const int row = wm * 64 + mi * 16 + fr; a_rd[mi] = row * 64 + ((fq ^ ((row >> 1) & 3)) << 4); }
        int b_rd[2], b_f[2];
#pragma unroll
        for (int t = 0; t < 2; ++t) { const int k = 8 * fq + 4 * t + (fr >> 2); b_f[t] = fk2(k); b_rd[t] = A_BYTES + k * 512 + ((fr & 3) << 3); }
        const bf16_t* aptr[2]; const b_t* bptr[2];
        u32x4 ra[2]; u32x4 rb[2]; f32x4 rbf[2][2];
        auto gload = [&](int kt) {
#pragma unroll
            for (int i = 0; i < 2; ++i) { ra[i] = *(const u32x4*)(aptr[i] + (size_t)kt * a_kstride);
                if (BF32) { const float* p = (const float*)bptr[i] + (size_t)kt * b_kstride; rbf[i][0] = *(const f32x4*)p; rbf[i][1] = *(const f32x4*)(p + 4); }
                else rb[i] = *(const u32x4*)((const bf16_t*)bptr[i] + (size_t)kt * b_kstride); }
        };
        auto lstore = [&](int buf) {
            LAS unsigned char* base = lds + buf * STAGE;
#pragma unroll
            for (int i = 0; i < 2; ++i) { *(LAS u32x4*)(base + a_wr[i]) = ra[i];
                if (BF32) { u32x4 w; w.x = cvtpk(rbf[i][0].x, rbf[i][0].y); w.y = cvtpk(rbf[i][0].z, rbf[i][0].w); w.z = cvtpk(rbf[i][1].x, rbf[i][1].y); w.w = cvtpk(rbf[i][1].z, rbf[i][1].w); *(LAS u32x4*)(base + b_wr[i]) = w; }
                else *(LAS u32x4*)(base + b_wr[i]) = rb[i]; }
        };
        auto compute = [&](int buf) {
            const LAS unsigned char* base = lds + buf * STAGE;
            bf16x8 af[4];
#pragma unroll
            for (int mi = 0; mi < 4; ++mi) af[mi] = *(const LAS bf16x8*)(base + a_rd[mi]);
#pragma unroll
            for (int ni = 0; ni < 8; ++ni) {
                const int u0 = wn * 8 + ni;
                const s16x4 lo = lds_tr(base + b_rd[0] + ((u0 ^ b_f[0]) << 5));
                const s16x4 hi = lds_tr(base + b_rd[1] + ((u0 ^ b_f[1]) << 5));
                const bf16x8 bfr = (bf16x8){lo[0], lo[1], lo[2], lo[3], hi[0], hi[1], hi[2], hi[3]};
#pragma unroll
                for (int mi = 0; mi < 4; ++mi) acc[mi][ni] = __builtin_amdgcn_mfma_f32_16x16x32_bf16(bfr, af[mi], acc[mi][ni], 0, 0, 0);
            }
        };
        f.ptrs(0, aptr, bptr);
        gload(0); lstore(0); __syncthreads();
        int seg = 0, kt = 0;
        const int total = NSEG * KT;
#pragma unroll 1
        for (int g = 0; g < total; ++g) {
            int nkt = kt + 1, nsg = seg; if (nkt == KT) { nkt = 0; nsg = seg + 1; }
            if (nkt == 0 && nsg < NSEG) f.ptrs(nsg, aptr, bptr);
            gload(nsg < NSEG ? nkt : KT - 1);
            __builtin_amdgcn_sched_barrier(0);
            compute(g & 1);
            lstore((g + 1) & 1);
            __syncthreads();
            if (nkt == 0) {
                f.epi(seg, acc);
#pragma unroll
                for (int mi = 0; mi < 4; ++mi)
#pragma unroll
                    for (int ni = 0; ni < 8; ++ni) acc[mi][ni] = (f32x4){0.f, 0.f, 0.f, 0.f};
            }
            seg = nsg; kt = nkt;
        }
    }
};

__device__ __forceinline__ int p2_col(int m0);
__device__ __forceinline__ unsigned pk4_fp8(float a, float b, float c, float d) { int pk = __builtin_amdgcn_cvt_pk_fp8_f32(a, b, 0, false); pk = __builtin_amdgcn_cvt_pk_fp8_f32(c, d, pk, true); return (unsigned)pk; }
__device__ __forceinline__ int w8_col(int i) { return 16 * ((i >> 2) & 1) + 4 * (i >> 3) + (i & 3); }
__device__ __forceinline__ void phase_mod(const Params& P, LAS unsigned char* lds) {
    const int tid = threadIdx.x;
    float* mod = (float*)(P.ws + WS_MOD);
    LAS float* sc = (LAS float*)lds;
    LAS float* red = (LAS float*)(lds + 16384);
    for (int i = tid; i < 4096; i += NTHREADS) sc[i] = siluf_(P.c[i]);
    __syncthreads();
    const int kq = tid >> 5, cl = tid & 31;
    for (int u = blockIdx.x; u < 192; u += gridDim.x) {
        const int j = u * 32 + cl;
        float a0 = 0.f, a1 = 0.f, a2 = 0.f, a3 = 0.f;
        {   float w[64];
#pragma unroll
            for (int i = 0; i < 64; ++i) w[i] = P.ada_w[(size_t)(kq + 16 * i) * 6144 + j];
#pragma unroll
            for (int i = 0; i < 64; ++i) { const int k = kq + 16 * i; a0 += sc[k] * w[i]; a1 += sc[1024 + k] * w[i]; a2 += sc[2048 + k] * w[i]; a3 += sc[3072 + k] * w[i]; } }
        red[(kq * 4 + 0) * 32 + cl] = a0; red[(kq * 4 + 1) * 32 + cl] = a1; red[(kq * 4 + 2) * 32 + cl] = a2; red[(kq * 4 + 3) * 32 + cl] = a3;
        __syncthreads();
        if (tid < 128) { const int b = tid >> 5; float s = 0.f;
#pragma unroll
            for (int q = 0; q < 16; ++q) s += red[(q * 4 + b) * 32 + cl];
            mod[b * 6144 + j] = s + P.ada_b[j]; }
        __syncthreads();
    }
    for (int u = (gridDim.x >= 208 ? (int)blockIdx.x - 192 : (int)blockIdx.x); u < 16; u += gridDim.x) {
        if (u < 0) continue;
        const int sel = u >> 3, j = (u & 7) * 32 + cl;
        const float* w1 = P.cmp_w1 + (size_t)sel * 2048 * 256; const float* pos = P.cmp_pos + sel * 2048;
        float a0 = 0.f;
#pragma unroll 32
        for (int k = kq; k < 2048; k += 16) a0 += pos[k] * w1[(size_t)k * 256 + j];
        red[kq * 32 + cl] = a0;
        __syncthreads();
        if (tid < 32) { float s = 0.f;
#pragma unroll
            for (int q = 0; q < 16; ++q) s += red[q * 32 + cl];
            ((float*)(P.ws + WS_CB))[sel * 256 + j] = s + P.cmp_b1[sel * 256 + j]; }
        __syncthreads();
    }
    {
        unsigned char* wb = (unsigned char*)(P.ws + WS_WIN);
        const int lane = tid & 63, gw = blockIdx.x * (NTHREADS / 64) + (tid >> 6), NGW = gridDim.x * (NTHREADS / 64);
        for (int u = gw; u < 56 * 16; u += NGW) {
            const int rg = u % 56, kb = u / 56, q = rg * 64 + lane, c8 = (q & ~31) + w8_col(q & 31);
            const int sc_ = c8 < 1280 ? c8 : (c8 < 3328 ? c8 + 24 : c8 - 2048);
            const float* s = P.w_in + (size_t)(kb * 64) * IN_COLS + (c8 < 3352 ? sc_ : 0);
            float v[64];
#pragma unroll
            for (int j = 0; j < 64; ++j) v[j] = s[(size_t)j * IN_COLS];
            const float c_ = c8 < 3352 ? 64.0f : 0.0f;
#pragma unroll
            for (int j = 0; j < 4; ++j) { u32x4 w;
                w.x = pk4_fp8(v[16 * j] * c_, v[16 * j + 1] * c_, v[16 * j + 2] * c_, v[16 * j + 3] * c_); w.y = pk4_fp8(v[16 * j + 4] * c_, v[16 * j + 5] * c_, v[16 * j + 6] * c_, v[16 * j + 7] * c_);
                w.z = pk4_fp8(v[16 * j + 8] * c_, v[16 * j + 9] * c_, v[16 * j + 10] * c_, v[16 * j + 11] * c_); w.w = pk4_fp8(v[16 * j + 12] * c_, v[16 * j + 13] * c_, v[16 * j + 14] * c_, v[16 * j + 15] * c_);
                *(u32x4*)(wb + (size_t)q * 1024 + kb * 64 + j * 16) = w; }
        }
    }
    {
        bf16_t* wc = (bf16_t*)(P.ws + WS_CW1);
        const int gt = blockIdx.x * NTHREADS + tid, NG = gridDim.x * NTHREADS;
        for (int i = gt; i < 2 * 2048 * 256 / 8; i += NG) { const f32x4 a = *(const f32x4*)(P.cmp_w1 + (size_t)i * 8), b2 = *(const f32x4*)(P.cmp_w1 + (size_t)i * 8 + 4);
            *(u32x4*)(wc + (size_t)i * 8) = (u32x4){cvtpk(a.x, a.y), cvtpk(a.z, a.w), cvtpk(b2.x, b2.y), cvtpk(b2.z, b2.w)}; }
    }
    {
        bf16_t* wt = (bf16_t*)(P.ws + WS_CW2T);
        const int gt = blockIdx.x * NTHREADS + tid, NG = gridDim.x * NTHREADS;
        for (int i = gt; i < 2 * 64 * 256; i += NG) { const int sel = i >> 14, n = (i >> 8) & 63, k = i & 255;
            wt[i] = (bf16_t)(cvtpk(P.cmp_w2[(size_t)sel * 256 * 64 + k * 64 + n], 0.f) & 0xffffu); }
    }
    if (blockIdx.x == gridDim.x - 2) {
        for (int i = tid; i < 2 * 8 * 64; i += NTHREADS) { const int t2 = i >> 9, bg = (i >> 6) & 7, d = i & 63;
            ((bf16_t*)(P.ws + (t2 ? WS_VC : WS_KC)))[((size_t)bg * 512 + 511) * 64 + d] = 0; }
    }
    if (blockIdx.x == gridDim.x - 1) {
        float* lb = (float*)(P.ws + WS_LB);
        for (int i = tid; i < 512; i += NTHREADS) { const float p0 = P.hgrn_lb[i], p1 = P.hgrn_lb[512 + i]; lb[i] = 1.0f / (1.0f + __expf(p1 - p0)); }
    }
}

__device__ __forceinline__ void norm_mod_rows(const float* __restrict__ x, const float* __restrict__ w, const float* __restrict__ mod_sh, const float* __restrict__ mod_sc, unsigned char* __restrict__ h, int hs) {
    const int lane = threadIdx.x & 63, gw = blockIdx.x * (NTHREADS / 64) + (threadIdx.x >> 6), NGW = gridDim.x * (NTHREADS / 64);
    for (int b = 0; b < BATCH; ++b) {
        f32x4 ga[4], sh[4];
#pragma unroll
        for (int j = 0; j < 4; ++j) { const int col = (lane + 64 * j) * 4; const f32x4 wv = *(const f32x4*)(w + col), scv = *(const f32x4*)(mod_sc + b * 6144 + col); sh[j] = *(const f32x4*)(mod_sh + b * 6144 + col);
            ga[j] = (f32x4){wv.x * (1.f + scv.x), wv.y * (1.f + scv.y), wv.z * (1.f + scv.z), wv.w * (1.f + scv.w)}; }
        for (int m0 = b * SEQ + gw; m0 < (b + 1) * SEQ; m0 += 2 * NGW) {
            const int m1 = m0 + NGW < (b + 1) * SEQ ? m0 + NGW : m0;
            f32x4 v[2][4]; float s[2] = {0.f, 0.f};
#pragma unroll
            for (int r = 0; r < 2; ++r) { const f32x4* xr = (const f32x4*)(x + (size_t)(r ? m1 : m0) * D) + lane;
#pragma unroll
                for (int j = 0; j < 4; ++j) v[r][j] = __builtin_nontemporal_load(xr + 64 * j); }
#pragma unroll
            for (int r = 0; r < 2; ++r)
#pragma unroll
                for (int j = 0; j < 4; ++j) s[r] += (v[r][j].x * v[r][j].x + v[r][j].y * v[r][j].y) + (v[r][j].z * v[r][j].z + v[r][j].w * v[r][j].w);
#pragma unroll
            for (int r = 0; r < 2; ++r) { const int m = r ? m1 : m0;
                if (r == 1 && m1 == m0) break;
                const float rstd = rsqrtf(wave_sum(s[r]) * (1.f / D) + RMS_EPS);
                unsigned* o = (unsigned*)(h + (size_t)m * hs) + lane;
#pragma unroll
                for (int j = 0; j < 4; ++j) o[64 * j] = pk4_fp8(v[r][j].x * rstd * ga[j].x + sh[j].x, v[r][j].y * rstd * ga[j].y + sh[j].y, v[r][j].z * rstd * ga[j].z + sh[j].z, v[r][j].w * rstd * ga[j].w + sh[j].w);
            }
        }
    }
}

__device__ __forceinline__ void phase_inproj(const Params& P, LAS unsigned char* lds) {
    constexpr int NRT = T / 256, NCT = 14;
    struct F { const Params& P;
        static __device__ __forceinline__ int wscale(int) { return 121; }
        __device__ __forceinline__ void unit(int seg, int& rt, int& ct) const {
            const int nx = (gridDim.x % 8 == 0) ? 8 : 1, xl = blockIdx.x % nx, li = blockIdx.x / nx, nloc = gridDim.x / nx;
            const int v = li + seg * nloc, rg = v / (NCT * 4), rem = v % (NCT * 4); ct = rem >> 2; rt = xl + nx * (rg * 4 + (rem & 3)); }
        __device__ __forceinline__ void ptrs(int seg, const unsigned char* (&aptr)[2], const unsigned char* (&wptr)[2]) const {
            const int tid = opaque_tid(), lane = tid & 63, wid = tid >> 6; int rt, ct; unit(seg, rt, ct);
            const unsigned char* h1 = (const unsigned char*)(P.ws + WS_H); const unsigned char* wb = (const unsigned char*)(P.ws + WS_WIN);
#pragma unroll
            for (int i = 0; i < 2; ++i) { const int row = Gemm8::t_row(i, wid, lane); aptr[i] = h1 + (size_t)(rt * 256 + row) * H1S + Gemm8::t_chunk(row, lane) * 16;
                wptr[i] = wb + (size_t)(ct * 256 + row) * 1024 + Gemm8::t_chunk(row, lane) * 16; } }
        __device__ __forceinline__ void epi(int seg, f32x16 (&acc)[2][4]) const {
            const int tid = opaque_tid(), lane = tid & 63, wid = tid >> 6, wm = wid >> 1, wn = wid & 1, l31 = lane & 31, hi = lane >> 5;
            int rt, ct; unit(seg, rt, ct);
            bf16_t* qo = (bf16_t*)(P.ws + WS_Q); bf16_t* kvo = (bf16_t*)(P.ws + WS_KV); float* gates = (float*)(P.ws + WS_GATES);
            bf16_t* hq = (bf16_t*)(P.ws + WS_HQ); bf16_t* logf = (bf16_t*)(P.ws + WS_LOGF); bf16_t* hv = (bf16_t*)(P.ws + WS_HV); bf16_t* hg = (bf16_t*)(P.ws + WS_HG);
            const float* lb = (const float*)(P.ws + WS_LB);
            const int row0 = rt * 256 + wm * 64 + l31;
            if (ct < 5) {
                const bool is_q = ct < 2; const int sg = (ct - 2) * 2 + wn;
                const bool do_norm = is_q || sg == 2 || sg == 4;
                const float* nw = is_q ? P.q_norm_w : (P.k_norm_w + (sg == 2 ? 64 : 128));
                const float osc = is_q ? 0.125f : 1.0f;
#pragma unroll
                for (int hh = 0; hh < 2; ++hh) {
#pragma unroll
                    for (int jt = 0; jt < 2; ++jt) {
                        float rstd = 1.f;
                        if (do_norm) { float s = 0.f;
#pragma unroll
                            for (int t2 = 0; t2 < 2; ++t2)
#pragma unroll
                                for (int r = 0; r < 16; ++r) { const float a = acc[jt][2 * hh + t2][r]; s += a * a; }
                            s += __shfl_xor(s, 32);
                            rstd = rsqrtf(s * (1.f / 64.f) + RMS_EPS) * osc; }
                        const size_t m = (size_t)(row0 + jt * 32);
                        bf16_t* dst = is_q ? (qo + m * 512 + ct * 256 + wn * 128 + hh * 64 + 16 * hi) : (kvo + m * 768 + (ct - 2) * 256 + wn * 128 + hh * 64 + 16 * hi);
#pragma unroll
                        for (int t2 = 0; t2 < 2; ++t2) { u32x4 w0, w1;
#pragma unroll
                            for (int q4 = 0; q4 < 4; ++q4) { const f32x4 wv = do_norm ? *(const f32x4*)(nw + t2 * 32 + 16 * hi + 4 * q4) : (f32x4){1.f, 1.f, 1.f, 1.f};
                                const unsigned lo = cvtpk(acc[jt][2 * hh + t2][4 * q4] * rstd * wv.x, acc[jt][2 * hh + t2][4 * q4 + 1] * rstd * wv.y), hi2 = cvtpk(acc[jt][2 * hh + t2][4 * q4 + 2] * rstd * wv.z, acc[jt][2 * hh + t2][4 * q4 + 3] * rstd * wv.w);
                                if (q4 < 2) { w0[2 * q4] = lo; w0[2 * q4 + 1] = hi2; } else { w1[2 * (q4 - 2)] = lo; w1[2 * (q4 - 2) + 1] = hi2; } }
                            *(u32x4*)(dst + t2 * 32) = w0; *(u32x4*)(dst + t2 * 32 + 8) = w1; }
                    }
                }
            } else if (ct == 13) {
                if (wn == 0) {
#pragma unroll
                    for (int jt = 0; jt < 2; ++jt) { const size_t m = (size_t)(row0 + jt * 32);
#pragma unroll
                        for (int q4 = 0; q4 < 4; ++q4) { const int c = 16 * hi + 4 * q4; if (c < 24) {
                                *(f32x4*)(gates + m * 24 + c) = (f32x4){sigmoidf_(acc[jt][0][4 * q4]), sigmoidf_(acc[jt][0][4 * q4 + 1]), sigmoidf_(acc[jt][0][4 * q4 + 2]), sigmoidf_(acc[jt][0][4 * q4 + 3])}; } } }
                }
            } else {
                const int hs = (ct - 5) >> 1, cc = ((ct - 5) & 1) * 256 + wn * 128 + 16 * hi;
#pragma unroll
                for (int jt = 0; jt < 2; ++jt) { const size_t m = (size_t)(row0 + jt * 32);
#pragma unroll
                    for (int it = 0; it < 4; ++it) { const int c = cc + it * 32;
                        if (hs == 1) { unsigned w8[8];
#pragma unroll
                            for (int q4 = 0; q4 < 4; ++q4) { const f32x4 l = *(const f32x4*)(lb + c + 4 * q4); f32x4 o;
                                o.x = __logf(l.x + (1.f - l.x) * sigmoidf_(acc[jt][it][4 * q4])); o.y = __logf(l.y + (1.f - l.y) * sigmoidf_(acc[jt][it][4 * q4 + 1]));
                                o.z = __logf(l.z + (1.f - l.z) * sigmoidf_(acc[jt][it][4 * q4 + 2])); o.w = __logf(l.w + (1.f - l.w) * sigmoidf_(acc[jt][it][4 * q4 + 3]));
                                w8[2 * q4] = cvtpk(o.x, o.y); w8[2 * q4 + 1] = cvtpk(o.z, o.w); }
                            *(u32x4*)(logf + m * 512 + c) = (u32x4){w8[0], w8[1], w8[2], w8[3]}; *(u32x4*)(logf + m * 512 + c + 8) = (u32x4){w8[4], w8[5], w8[6], w8[7]};
                        } else { float v[16];
#pragma unroll
                            for (int r = 0; r < 16; ++r) { const float a = acc[jt][it][r]; v[r] = hs == 0 ? siluf_(a) * 0.08838834764831845f : (hs == 2 ? a : sigmoidf_(a)); }
                            bf16_t* dst = (hs == 0 ? hq : (hs == 2 ? hv : hg)) + m * 512 + c;
                            *(u32x4*)dst = (u32x4){cvtpk(v[0], v[1]), cvtpk(v[2], v[3]), cvtpk(v[4], v[5]), cvtpk(v[6], v[7])};
                            *(u32x4*)(dst + 8) = (u32x4){cvtpk(v[8], v[9]), cvtpk(v[10], v[11]), cvtpk(v[12], v[13]), cvtpk(v[14], v[15])}; }
                    } }
            }
        }
    } f{P};
    const int nx = (gridDim.x % 8 == 0) ? 8 : 1, li = blockIdx.x / nx, nloc = gridDim.x / nx;
    const int nu = ((NRT / nx) * NCT - li + nloc - 1) / nloc;
    if (nu > 0) Gemm8::run_stream(f, nu, D / 64, lds);
}

__device__ __forceinline__ float gelu_tanh(float x) {
    const float u = 0.7978845608028654f * (x + 0.044715f * x * x * x);
    const float th = 1.0f - 2.0f / (1.0f + __expf(2.0f * u));
    return 0.5f * x * (1.0f + th);
}
__device__ __forceinline__ void compress_unit(const Params& P, LAS unsigned char* lds, int u) {
    typedef Gemm3 G;
    const int tid = opaque_tid(), lane = tid & 63, wid = tid >> 6, wm = wid >> 1, wn = wid & 1, fr = lane & 15, fq = lane >> 4;
    const int sel = u >> 4, rt = u & 15;
    const bf16_t* kv = (const bf16_t*)(P.ws + WS_KV);
    bf16_t* cmph = (bf16_t*)(P.ws + WS_CMPH) + (size_t)sel * 4096 * 256;
    const float* cb = (const float*)(P.ws + WS_CB) + sel * 256;
    const bf16_t* w1b = (const bf16_t*)(P.ws + WS_CW1) + (size_t)sel * 2048 * 256;
    const bf16_t* aptr[2]; const bf16_t* bptr[2];
#pragma unroll
    for (int p = 0; p < 2; ++p) { const int row = G::a_row(p, wid, lane); int r = rt * 256 + row; r = r < 4088 ? r : 4087;
        const int b = r / 1022, rem = r % 1022, i = rem >> 1, g = rem & 1;
        aptr[p] = kv + (size_t)(b * SEQ + 16 * i) * 768 + sel * 128 + g * 64 + G::a_chunk(row, lane) * 8;
        const int k = G::b_k(p, wid, lane); bptr[p] = w1b + (size_t)k * 256 + G::b_n(k, lane); }
    f32x4 acc[4][8];
    G::run<true>(acc, aptr, 768, bptr, (size_t)64 * 256, 32, lds);
    { const bf16_t* a2[2] = {aptr[0] + 32, aptr[1] + 32}; const bf16_t* b2[2] = {bptr[0] + 32 * 256, bptr[1] + 32 * 256};
      G::run<false>(acc, a2, 768, b2, (size_t)64 * 256, 32, lds); }
#pragma unroll
    for (int mi = 0; mi < 4; ++mi) { const int row = wm * 64 + mi * 16 + fr;
#pragma unroll
        for (int ni = 0; ni < 8; ++ni) { const int col = wn * 128 + ni * 16 + 4 * fq; const f32x4 a = acc[mi][ni]; const f32x4 bb = *(const f32x4*)(cb + col);
            u32x2 pk; pk.x = cvtpk(gelu_tanh(a.x + bb.x), gelu_tanh(a.y + bb.y)); pk.y = cvtpk(gelu_tanh(a.z + bb.z), gelu_tanh(a.w + bb.w));
            *(LAS u32x2*)(lds + row * 512 + (((col >> 3) ^ (row & 31)) << 4) + ((col & 4) << 1)) = pk; } }
    __syncthreads();
    {
        const bf16_t* w2t = (const bf16_t*)(P.ws + WS_CW2T) + (size_t)sel * 64 * 256;
        f32x4 o[2][4];
#pragma unroll
        for (int mt = 0; mt < 2; ++mt)
#pragma unroll
            for (int nt = 0; nt < 4; ++nt) o[mt][nt] = (f32x4){0.f, 0.f, 0.f, 0.f};
#pragma unroll
        for (int ks = 0; ks < 8; ++ks) {
            bf16x8 hb[2], wa[4];
#pragma unroll
            for (int mt = 0; mt < 2; ++mt) { const int row = wid * 32 + mt * 16 + fr; hb[mt] = *(const LAS bf16x8*)(lds + row * 512 + (((ks * 4 + fq) ^ (row & 31)) << 4)); }
#pragma unroll
            for (int nt = 0; nt < 4; ++nt) wa[nt] = *(const bf16x8*)(w2t + (size_t)(nt * 16 + fr) * 256 + ks * 32 + 8 * fq);
#pragma unroll
            for (int mt = 0; mt < 2; ++mt)
#pragma unroll
                for (int nt = 0; nt < 4; ++nt) o[mt][nt] = __builtin_amdgcn_mfma_f32_16x16x32_bf16(wa[nt], hb[mt], o[mt][nt], 0, 0, 0);
        }
#pragma unroll
        for (int mt = 0; mt < 2; ++mt) {
            float rstd = 1.f;
            if (sel == 0) { float s = 0.f;
#pragma unroll
                for (int nt = 0; nt < 4; ++nt) s += (o[mt][nt].x * o[mt][nt].x + o[mt][nt].y * o[mt][nt].y) + (o[mt][nt].z * o[mt][nt].z + o[mt][nt].w * o[mt][nt].w);
                s += __shfl_xor(s, 16); s += __shfl_xor(s, 32);
                rstd = rsqrtf(s * (1.f / 64.f) + RMS_EPS); }
            const int r = rt * 256 + wid * 32 + mt * 16 + fr;
            if (r < 4088) { const int b = r / 1022, rem = r % 1022, i = rem >> 1, g = rem & 1;
                bf16_t* dst = (bf16_t*)(P.ws + (sel ? WS_VC : WS_KC)) + ((size_t)(b * 2 + g) * 512 + i) * 64;
#pragma unroll
                for (int nt = 0; nt < 4; ++nt) { const int col = nt * 16 + 4 * fq; f32x4 v = o[mt][nt] * rstd;
                    if (sel == 0) { const f32x4 w = *(const f32x4*)(P.k_norm_w + col); v.x *= w.x; v.y *= w.y; v.z *= w.z; v.w *= w.w; }
                    u32x2 pk; pk.x = cvtpk(v.x, v.y); pk.y = cvtpk(v.z, v.w); *(u32x2*)(dst + col) = pk; } }
        }
    }
    __syncthreads();
}

__device__ __forceinline__ int off_row128(int row, int ch) { return row * 128 + ((ch ^ ((row >> 1) & 7)) << 4); }
__device__ __forceinline__ int off_row256(int row, int ch) { return row * 256 + ((ch ^ (row & 15)) << 4); }
__device__ __forceinline__ int fk_(int r) { return (r & 3) | (((r >> 3) & 1) << 2); }
__device__ __forceinline__ int off_tr256(int row, int col) { return row * 256 + ((((col >> 4) ^ fk_(row)) << 5) + ((col & 15) << 1)); }
constexpr int HL_QT = 0, HL_KT = 16384, HL_KH = 32768, HL_V = 49152, HL_SB = 65536, HL_P = 98304  , HL_TOT = 106496  , HL_RED = 110592  , HL_END = 111104;

template <int MODE> __device__ __forceinline__ void hgrn_unit(const Params& P, LAS unsigned char* lds, int u) {
    const int tid = opaque_tid(), lane = tid & 63, wid = tid >> 6, fr = lane & 15, fq = lane >> 4;
    const int b = u >> 7, h = (u >> 5) & 3, sc = u & 31;
    const bf16_t* hq = (const bf16_t*)(P.ws + WS_HQ); const bf16_t* logf = (const bf16_t*)(P.ws + WS_LOGF);
    const bf16_t* hv = (const bf16_t*)(P.ws + WS_HV); const bf16_t* hg = (const bf16_t*)(P.ws + WS_HG);
    float* HLs = (float*)(P.ws + WS_HL); float* HDs = (float*)(P.ws + WS_HD);
    bf16_t* mix = (bf16_t*)(P.ws + WS_MIX);
    LAS float* tot = (LAS float*)(lds + HL_TOT); LAS float* red = (LAS float*)(lds + HL_RED);
    f32x4 st[8];
#pragma unroll
    for (int vt = 0; vt < 8; ++vt) st[vt] = (f32x4){0.f, 0.f, 0.f, 0.f};
    if (MODE == 1) {
        const float* Lj = HLs + (size_t)u * 16384 + (16 * wid + fr) * 128 + 4 * fq;
#pragma unroll
        for (int vt = 0; vt < 8; ++vt) st[vt] = *(const f32x4*)(Lj + vt * 16);
    }
    float dsum = 0.f;
    const int kp = tid & 63, te = tid >> 6;
    for (int c = 0; c < 4; ++c) {
        const size_t tok0 = (size_t)b * SEQ + sc * 256 + c * 64;
        float lf0[8], lf1[8], cs0[8], cs1[8];
        { float a0 = 0.f, a1 = 0.f;
#pragma unroll
          for (int i = 0; i < 8; ++i) { const unsigned vr = *(const unsigned*)(logf + (tok0 + te * 8 + i) * 512 + h * 128 + 2 * kp); const float vx = __uint_as_float(vr << 16), vy = __uint_as_float(vr & 0xffff0000u); lf0[i] = vx; lf1[i] = vy; a0 += vx; a1 += vy; cs0[i] = a0; cs1[i] = a1; }
          tot[te * 128 + 2 * kp] = a0; tot[te * 128 + 2 * kp + 1] = a1; }
        unsigned qpre[8];
        if (MODE == 1) {
#pragma unroll
            for (int i = 0; i < 8; ++i) qpre[i] = *(const unsigned*)(hq + (tok0 + te * 8 + i) * 512 + h * 128 + 2 * kp);
        }
        u32x2 gpre[4];
        if (MODE == 1) {
#pragma unroll
            for (int i = 0; i < 4; ++i) gpre[i] = *(const u32x2*)(hg + (tok0 + (wid >> 1) * 16 + fr) * 512 + h * 128 + (4 * (wid & 1) + i) * 16 + 4 * fq);
        }
#pragma unroll
        for (int i = 0; i < 2; ++i) { const int pc = tid + NTHREADS * i, row = pc >> 4, c8 = (pc & 15) * 8;
            const u32x4 v = *(const u32x4*)(hv + (tok0 + row) * 512 + h * 128 + c8);
            *(LAS u32x4*)(lds + HL_V + off_tr256(row, c8)) = v; }
        if (MODE == 1 ) {
#pragma unroll
            for (int vt = 0; vt < 8; ++vt) { u32x2 pk; pk.x = cvtpk(st[vt].x, st[vt].y); pk.y = cvtpk(st[vt].z, st[vt].w);
                *(LAS u32x2*)(lds + HL_SB + off_tr256(16 * wid + fr, 16 * vt + 4 * fq)) = pk; }
        }
        __syncthreads();
        float pre0 = 0.f, pre1 = 0.f, last0 = 0.f, last1 = 0.f;
#pragma unroll
        for (int e = 0; e < 8; ++e) { const float t0 = tot[e * 128 + 2 * kp], t1 = tot[e * 128 + 2 * kp + 1]; if (e < te) { pre0 += t0; pre1 += t1; } last0 += t0; last1 += t1; }
#pragma unroll
        for (int i = 0; i < 8; ++i) {
            const int t = te * 8 + i;
            const float c0 = cs0[i] + pre0, c1 = cs1[i] + pre1;
            const float k0 = 1.f - __expf(lf0[i]), k1 = 1.f - __expf(lf1[i]);
            const unsigned khat = cvtpk(k0 * __expf(last0 - c0), k1 * __expf(last1 - c1));
            *(LAS unsigned*)(lds + HL_KH + off_tr256(t, 2 * kp)) = khat;
            if (MODE == 1) {
                const unsigned qraw = qpre[i];
                const float q0 = __uint_as_float(qraw << 16), q1 = __uint_as_float(qraw & 0xffff0000u);
                const unsigned qt = cvtpk(q0 * __expf(c0), q1 * __expf(c1));
                const unsigned kt = cvtpk(k0 * __expf(fminf(-c0, 80.f)), k1 * __expf(fminf(-c1, 80.f)));
                const int o = off_row256(t, kp >> 2) + ((kp & 3) << 2);
                *(LAS unsigned*)(lds + HL_QT + o) = qt; *(LAS unsigned*)(lds + HL_KT + o) = kt;
            }
        }
        const float dec = __expf(tot[0 * 128 + 16 * wid + fr] + tot[1 * 128 + 16 * wid + fr] + tot[2 * 128 + 16 * wid + fr] + tot[3 * 128 + 16 * wid + fr]
                                 + tot[4 * 128 + 16 * wid + fr] + tot[5 * 128 + 16 * wid + fr] + tot[6 * 128 + 16 * wid + fr] + tot[7 * 128 + 16 * wid + fr]);
        if (MODE == 0 && tid < 128) { float s = 0.f;
#pragma unroll
            for (int e = 0; e < 8; ++e) s += tot[e * 128 + tid];
            dsum += s; }
        __syncthreads();
        f32x4 oacc[4];
        if (MODE == 1) {
            { const int tt = wid & 3;
#pragma unroll
              for (int si = 0; si < 2; ++si) { const int stl = 2 * (wid >> 2) + si;
                  f32x4 sacc = (f32x4){0.f, 0.f, 0.f, 0.f};
                  if (stl <= tt) {
#pragma unroll
                      for (int ks = 0; ks < 4; ++ks) {
                          const bf16x8 a = *(const LAS bf16x8*)(lds + HL_KT + off_row256(stl * 16 + fr, ks * 4 + fq));
                          const bf16x8 bq = *(const LAS bf16x8*)(lds + HL_QT + off_row256(tt * 16 + fr, ks * 4 + fq));
                          sacc = __builtin_amdgcn_mfma_f32_16x16x32_bf16(a, bq, sacc, 0, 0, 0);
                      }
                  }
                  const int t = tt * 16 + fr, s0 = stl * 16 + 4 * fq;
                  u32x2 pk; pk.x = cvtpk(s0 + 0 <= t ? sacc.x : 0.f, s0 + 1 <= t ? sacc.y : 0.f); pk.y = cvtpk(s0 + 2 <= t ? sacc.z : 0.f, s0 + 3 <= t ? sacc.w : 0.f);
                  *(LAS u32x2*)(lds + HL_P + off_row128(t, s0 >> 3) + ((s0 & 7) << 1)) = pk; }
            }
            __syncthreads();
            { const int tt = wid >> 1;
#pragma unroll
              for (int i = 0; i < 4; ++i) { const int vt = 4 * (wid & 1) + i;
                  f32x4 a = (f32x4){0.f, 0.f, 0.f, 0.f};
#pragma unroll
                  for (int ks = 0; ks < 2; ++ks) {
                      const int kr = ks * 32 + 8 * fq + (fr >> 2);
                      const s16x4 lo = lds_tr(lds + HL_V + off_tr256(kr, vt * 16 + 4 * (fr & 3))), hi = lds_tr(lds + HL_V + off_tr256(kr + 4, vt * 16 + 4 * (fr & 3)));
                      const bf16x8 va = (bf16x8){lo[0], lo[1], lo[2], lo[3], hi[0], hi[1], hi[2], hi[3]};
                      const bf16x8 pb = *(const LAS bf16x8*)(lds + HL_P + off_row128(tt * 16 + fr, ks * 4 + fq));
                      a = __builtin_amdgcn_mfma_f32_16x16x32_bf16(va, pb, a, 0, 0, 0);
                  }
#pragma unroll
                  for (int ks = 0; ks < 4; ++ks) {
                      const int kr = ks * 32 + 8 * fq + (fr >> 2);
                      const s16x4 lo = lds_tr(lds + HL_SB + off_tr256(kr, vt * 16 + 4 * (fr & 3))), hi = lds_tr(lds + HL_SB + off_tr256(kr + 4, vt * 16 + 4 * (fr & 3)));
                      const bf16x8 sa = (bf16x8){lo[0], lo[1], lo[2], lo[3], hi[0], hi[1], hi[2], hi[3]};
                      const bf16x8 qb = *(const LAS bf16x8*)(lds + HL_QT + off_row256(tt * 16 + fr, ks * 4 + fq));
                      a = __builtin_amdgcn_mfma_f32_16x16x32_bf16(sa, qb, a, 0, 0, 0);
                  }
                  const u32x2 gr = gpre[i];
                  a.x *= __uint_as_float(gr.x << 16); a.y *= __uint_as_float(gr.x & 0xffff0000u); a.z *= __uint_as_float(gr.y << 16); a.w *= __uint_as_float(gr.y & 0xffff0000u);
                  oacc[i] = a; }
              float ss = 0.f;
#pragma unroll
              for (int i = 0; i < 4; ++i) ss += (oacc[i].x * oacc[i].x + oacc[i].y * oacc[i].y) + (oacc[i].z * oacc[i].z + oacc[i].w * oacc[i].w);
              ss += __shfl_xor(ss, 16); ss += __shfl_xor(ss, 32);
              if (fq == 0) red[(tt * 2 + (wid & 1)) * 16 + fr] = ss; }
        }
#pragma unroll
        for (int vt = 0; vt < 8; ++vt) {
            f32x4 a = st[vt] * dec;
#pragma unroll
            for (int ks = 0; ks < 2; ++ks) {
                const int kr = ks * 32 + 8 * fq + (fr >> 2);
                const s16x4 lo = lds_tr(lds + HL_V + off_tr256(kr, vt * 16 + 4 * (fr & 3))), hi = lds_tr(lds + HL_V + off_tr256(kr + 4, vt * 16 + 4 * (fr & 3)));
                const bf16x8 va = (bf16x8){lo[0], lo[1], lo[2], lo[3], hi[0], hi[1], hi[2], hi[3]};
                const s16x4 lo2 = lds_tr(lds + HL_KH + off_tr256(kr, wid * 16 + 4 * (fr & 3))), hi2 = lds_tr(lds + HL_KH + off_tr256(kr + 4, wid * 16 + 4 * (fr & 3)));
                const bf16x8 kb = (bf16x8){lo2[0], lo2[1], lo2[2], lo2[3], hi2[0], hi2[1], hi2[2], hi2[3]};
                a = __builtin_amdgcn_mfma_f32_16x16x32_bf16(va, kb, a, 0, 0, 0);
            }
            st[vt] = a;
        }
        __syncthreads();
        if (MODE == 1) {
            const int tt = wid >> 1; const float ssum = red[(tt * 2) * 16 + fr] + red[(tt * 2 + 1) * 16 + fr];
            const float rstd = rsqrtf(ssum * (1.f / 128.f) + RMS_EPS);
#pragma unroll
            for (int i = 0; i < 4; ++i) { const int v = (4 * (wid & 1) + i) * 16 + 4 * fq; const f32x4 w = *(const f32x4*)(P.rec_out_norm_w + h * 128 + v);
                u32x2 pk; pk.x = cvtpk(oacc[i].x * rstd * w.x, oacc[i].y * rstd * w.y); pk.y = cvtpk(oacc[i].z * rstd * w.z, oacc[i].w * rstd * w.w);
                *(u32x2*)(mix + (tok0 + tt * 16 + fr) * 1024 + 512 + h * 128 + v) = pk; }
        }
    }
    if (MODE == 0) {
#pragma unroll
        for (int vt = 0; vt < 8; ++vt) *(f32x4*)(HLs + (size_t)u * 16384 + (16 * wid + fr) * 128 + vt * 16 + 4 * fq) = st[vt];
        if (tid < 128) HDs[(size_t)u * 128 + tid] = __expf(dsum);
    }
    __syncthreads();
}


__device__ __forceinline__ void phase_hgrn_prefix(const Params& P) {
    float* HLs = (float*)(P.ws + WS_HL); const float* HDs = (const float*)(P.ws + WS_HD);
    const int gt = blockIdx.x * NTHREADS + threadIdx.x, NG = gridDim.x * NTHREADS;
    for (int e = gt; e < 16 * 4096; e += NG) {
        const int bh = e >> 12, q = e & 4095, kk = q >> 5;
        float* base = HLs + (size_t)bh * 32 * 16384 + q * 4; const float* db = HDs + (size_t)bh * 32 * 128 + kk;
        f32x4 s = (f32x4){0.f, 0.f, 0.f, 0.f};
#pragma unroll 1
        for (int g8 = 0; g8 < 32; g8 += 8) { f32x4 l[8]; float d[8];
#pragma unroll
            for (int j = 0; j < 8; ++j) { l[j] = *(const f32x4*)(base + (size_t)(g8 + j) * 16384); d[j] = db[(g8 + j) * 128]; }
#pragma unroll
            for (int j = 0; j < 8; ++j) { *(f32x4*)(base + (size_t)(g8 + j) * 16384) = s; s = s * d[j] + l[j]; } }
    }
}

constexpr int NL_K = 0, NL_V = 16384, NL_IMP = 32768, NL_IMP_STRIDE = 132, NL_SELM = NL_IMP + 8 * 8 * NL_IMP_STRIDE * 4, NL_END = NL_SELM + 1024;
__device__ __forceinline__ int off_v128(int row, int ch) { return row * 128 + ((ch ^ ((row & 3) << 1)) << 4); }
#define MFMA32(a, b, c) __builtin_amdgcn_mfma_f32_32x32x16_bf16(a, b, c, 0, 0, 0)

struct NsaLane { int t; float sl2; int qi; unsigned long long mlo, mhi; };
__device__ __forceinline__ float quad_sum(float v) {
    v += __int_as_float(__builtin_amdgcn_update_dpp(0, __float_as_int(v), 0xB1, 0xF, 0xF, true));
    v += __int_as_float(__builtin_amdgcn_update_dpp(0, __float_as_int(v), 0x4E, 0xF, 0xF, true));
    return v; }

template <int MODE> __device__ __forceinline__ void nsa_pass(LAS unsigned char* lds, const bf16_t* Kg, const bf16_t* Vg, int rs, unsigned long long ulo, unsigned long long uhi,
                                                            const bf16x8 (&qf)[4], const NsaLane& L, float inv, float& lsum, f32x16 (&O)[2], LAS float* impw) {
    const int tid = opaque_tid(), lane = tid & 63, hi = lane >> 5, c = lane & 31;
    const int ld_row = tid >> 3, ld_ch = tid & 7;
    const int kw_off = off_row128(ld_row, ld_ch), vw_off = off_v128(ld_row, ld_ch);
    u32x4 k0, v0, k1, v1, k2, v2;
    auto next = [&](int jj) -> int { ++jj; if (jj < 64) { const unsigned long long m = ulo >> jj; if (m) return jj + __builtin_ctzll(m); jj = 64; }
                                     if (jj < 128) { const unsigned long long m = uhi >> (jj - 64); if (m) return jj + __builtin_ctzll(m); } return 128; };
    int jA = next(-1), jB = jA < 128 ? next(jA) : 128, jC = jB < 128 ? next(jB) : 128;
    const int jsafe = jA < 128 ? jA : 0;
    auto ldk = [&](int jj) -> u32x4 { const int q = jj < 128 ? jj : jsafe; return *(const u32x4*)(Kg + (size_t)(q * 64 + ld_row) * rs + ld_ch * 8); };
    auto ldv = [&](int jj) -> u32x4 { const int q = jj < 128 ? jj : jsafe; return *(const u32x4*)(Vg + (size_t)(q * 64 + ld_row) * rs + ld_ch * 8); };
    k0 = ldk(jA); k1 = ldk(jB); k2 = ldk(jC);
    if (MODE != 0) { v0 = ldv(jA); v1 = ldv(jB); v2 = ldv(jC); }
    int it = 0;
    auto step = [&](u32x4& kreg, u32x4& vreg) {
        const int j = jA;
        LAS unsigned char* kb = lds + NL_K + (it & 1) * 8192; LAS unsigned char* vb = lds + NL_V + (it & 1) * 8192;
        *(LAS u32x4*)(kb + kw_off) = kreg; if (MODE != 0) *(LAS u32x4*)(vb + vw_off) = vreg;
        const int jD = jC < 128 ? next(jC) : 128;
        kreg = ldk(jD); if (MODE != 0) vreg = ldv(jD);
        __syncthreads();
        bool need = true; bool selbit = true;
        if (MODE == 2) { selbit = (j < 64 ? (L.mlo >> j) : (L.mhi >> (j - 64))) & 1ull; need = __any(selbit); }
        if (need) {
            f32x16 p0 = {}, p1 = {};
#pragma unroll
            for (int ks = 0; ks < 4; ++ks) {
                const bf16x8 a0 = *(const LAS bf16x8*)(kb + off_row128(c, 2 * ks + hi)), a1 = *(const LAS bf16x8*)(kb + off_row128(32 + c, 2 * ks + hi));
                p0 = MFMA32(a0, qf[ks], p0); p1 = MFMA32(a1, qf[ks], p1);
            }
            const int stride = (MODE <= 1) ? 16 : 1;
            const int dl = (MODE <= 1) ? (L.t - 31 - 16 * (j * 64 + 4 * hi)) : (L.t - (j * 64 + 4 * hi));
            const float nb = -L.sl2 * (float)dl, sls = L.sl2 * (float)stride;
            float rs_ = 0.f;
#pragma unroll
            for (int r = 0; r < 16; ++r) {
                const int ro0 = (r & 3) + 8 * (r >> 2), ro1 = ro0 + 32;
                const int d0 = dl - stride * ro0, d1 = dl - stride * ro1;
                bool v0 = d0 >= 0, v1 = d1 >= 0;
                if (MODE == 3) { v0 = v0 && d0 < 512; v1 = v1 && d1 < 512; }
                if (MODE == 2) { v0 = v0 && selbit; v1 = v1 && selbit; }
                float e0 = __builtin_amdgcn_exp2f(__builtin_fmaf(p0[r], LOG2E, __builtin_fmaf(sls, (float)ro0, nb)));
                float e1 = __builtin_amdgcn_exp2f(__builtin_fmaf(p1[r], LOG2E, __builtin_fmaf(sls, (float)ro1, nb)));
                e0 = v0 ? e0 : 0.f; e1 = v1 ? e1 : 0.f;
                if (MODE == 1) { e0 *= inv; e1 *= inv; }
                p0[r] = e0; p1[r] = e1; rs_ += e0 + e1;
            }
            lsum += rs_;
            if (MODE == 1) {
                float gs[8], ls[8];
#pragma unroll
                for (int kt = 0; kt < 2; ++kt)
#pragma unroll
                    for (int i = 0; i < 4; ++i) {
                        const float g = kt ? (p1[4 * i] + p1[4 * i + 1]) + (p1[4 * i + 2] + p1[4 * i + 3]) : (p0[4 * i] + p0[4 * i + 1]) + (p0[4 * i + 2] + p0[4 * i + 3]);
                        const float l3 = kt ? p1[4 * i + 3] : p0[4 * i + 3];
                        gs[kt * 4 + i] = quad_sum(g); ls[kt * 4 + i] = quad_sum(l3);
                    }
                if ((c & 3) == 0) {
#pragma unroll
                    for (int k8 = 0; k8 < 8; ++k8) { const int jj = j * 16 + (k8 >> 2) * 8 + 2 * (k8 & 3) + hi;
                        __hip_atomic_fetch_add(impw + L.qi * NL_IMP_STRIDE + jj, gs[k8], __ATOMIC_RELAXED, __HIP_MEMORY_SCOPE_WORKGROUP); __hip_atomic_fetch_add(impw + L.qi * NL_IMP_STRIDE + jj + 1, ls[k8], __ATOMIC_RELAXED, __HIP_MEMORY_SCOPE_WORKGROUP); }
                }
            }
            if (MODE != 0) {
                bf16x8 pf[4];
#pragma unroll
                for (int s4 = 0; s4 < 4; ++s4) { u32x4 w;
#pragma unroll
                    for (int e = 0; e < 4; ++e) { const int r = 8 * (s4 & 1) + 2 * e; w[e] = (s4 >> 1) ? cvtpk(p1[r], p1[r + 1]) : cvtpk(p0[r], p0[r + 1]); }
                    pf[s4] = __builtin_bit_cast(bf16x8, w); }
                const int g4 = lane >> 4, sub = g4 & 1, i16 = lane & 15, qq = i16 >> 2, pp = i16 & 3;
#pragma unroll
                for (int dt = 0; dt < 2; ++dt)
#pragma unroll
                    for (int s4 = 0; s4 < 4; ++s4) {
                        const int row = 16 * s4 + 4 * hi + qq, ch = 4 * dt + 2 * sub + (pp >> 1);
                        const s16x4 lo = lds_tr(vb + off_v128(row, ch) + 8 * (pp & 1)), hh = lds_tr(vb + off_v128(row + 8, ch) + 8 * (pp & 1));
                        const bf16x8 vf = (bf16x8){lo[0], lo[1], lo[2], lo[3], hh[0], hh[1], hh[2], hh[3]};
                        O[dt] = MFMA32(vf, pf[s4], O[dt]);
                    }
            }
        }
        jA = jB; jB = jC; jC = jD; ++it;
    };
    while (jA < 128) {
        step(k0, v0); if (jA >= 128) break;
        step(k1, v1); if (jA >= 128) break;
        step(k2, v2);
    }
    __syncthreads();
}

__device__ __forceinline__ void nsa_unit(const Params& P, LAS unsigned char* lds, int u) {
    const int tid = opaque_tid(), lane = tid & 63, wid = tid >> 6, hi = lane >> 5, c = lane & 31;
    const int b = u >> 8, g = (u >> 7) & 1, qb = u & 127;
    const bf16_t* qg = (const bf16_t*)(P.ws + WS_Q); const bf16_t* kv = (const bf16_t*)(P.ws + WS_KV);
    const bf16_t* kcn = (const bf16_t*)(P.ws + WS_KC) + (size_t)(b * 2 + g) * 512 * 64; const bf16_t* vcc = (const bf16_t*)(P.ws + WS_VC) + (size_t)(b * 2 + g) * 512 * 64;
    const float* gates = (const float*)(P.ws + WS_GATES); bf16_t* mix = (bf16_t*)(P.ws + WS_MIX);
    LAS float* impw = (LAS float*)(lds + NL_IMP) + wid * 8 * NL_IMP_STRIDE;
    LAS unsigned long long* selm = (LAS unsigned long long*)(lds + NL_SELM);
    NsaLane L; L.qi = c >> 2; const int hh = c & 3, head = g * 4 + hh;
    L.t = qb * 64 + wid * 8 + L.qi; L.sl2 = exp2f(-(float)(head + 1)) * LOG2E; L.mlo = 0; L.mhi = 0;
    const size_t tok = (size_t)b * SEQ + L.t;
    bf16x8 qf[4];
#pragma unroll
    for (int ks = 0; ks < 4; ++ks) qf[ks] = *(const bf16x8*)(qg + tok * 512 + head * 64 + 16 * ks + 8 * hi);
    for (int i = lane; i < 8 * NL_IMP_STRIDE; i += 64) impw[i] = 0.f;
    const int ncmp = qb * 4 + 3 < 511 ? qb * 4 + 3 : 511;
    const int nblk = (ncmp + 63) >> 6;
    const unsigned long long cm = nblk >= 64 ? ~0ull : ((1ull << nblk) - 1ull);
    f32x16 O[2], Ot[2]; float lsum = 0.f;
    O[0] = f32x16{}; O[1] = f32x16{};
    nsa_pass<0>(lds, kcn, vcc, 64, cm, 0ull, qf, L, 1.f, lsum, O, impw);
    lsum += __shfl_xor(lsum, 32);
    const float invc = 1.0f / fmaxf(lsum, 1e-30f);
    float dummy = 0.f;
    nsa_pass<1>(lds, kcn, vcc, 64, cm, 0ull, qf, L, invc, dummy, O, impw);
    const float* gt = gates + tok * 24 + g * 12 + hh * 3;
    const float g0 = gt[0], g1 = gt[1], g2 = gt[2];
#pragma unroll
    for (int dt = 0; dt < 2; ++dt) Ot[dt] = O[dt] * g0;
    {
        const int ncausal = qb + 1;
        for (int qi = 0; qi < 8; ++qi) {
            unsigned long long lo, hi64;
            if (ncausal <= 16) { lo = (1ull << ncausal) - 1ull; hi64 = 0ull; }
            else {
                const int j0 = lane, j1 = lane + 64;
                const bool f0 = (j0 == 0) || (j0 == qb) || (j0 == qb - 1), f1 = (j1 == qb) || (j1 == qb - 1);
                const unsigned k0 = (j0 <= qb && !f0) ? (0x80000000u | (__float_as_uint(impw[qi * NL_IMP_STRIDE + j0]) & 0x7fffff80u) | (unsigned)j0) : 0u;
                const unsigned k1 = (j1 <= qb && !f1) ? (0x80000000u | (__float_as_uint(impw[qi * NL_IMP_STRIDE + j1]) & 0x7fffff80u) | (unsigned)j1) : 0u;
                const int needn = 13;
                unsigned th = 0u;
                for (int bit = 31; bit >= 0; --bit) { const unsigned cand = th | (1u << bit);
                    const int cnt = __popcll(__ballot(k0 >= cand)) + __popcll(__ballot(k1 >= cand));
                    if (cnt >= needn) th = cand; }
                lo = __ballot(f0 || (k0 >= th && k0 != 0u)); hi64 = __ballot(f1 || (k1 >= th && k1 != 0u));
            }
            if (lane == 0) { selm[(wid * 8 + qi) * 2] = lo; selm[(wid * 8 + qi) * 2 + 1] = hi64; }
        }
    }
    __syncthreads();
    unsigned long long ulo = selm[lane * 2], uhi = selm[lane * 2 + 1];
#pragma unroll
    for (int o = 1; o < 64; o <<= 1) { ulo |= __shfl_xor(ulo, o); uhi |= __shfl_xor(uhi, o); }
    L.mlo = selm[(wid * 8 + L.qi) * 2]; L.mhi = selm[(wid * 8 + L.qi) * 2 + 1];
    const bf16_t* kvb = kv + (size_t)b * SEQ * 768 + g * 64;
    O[0] = f32x16{}; O[1] = f32x16{}; lsum = 0.f;
    nsa_pass<2>(lds, kvb + 256, kvb + 384, 768, ulo, uhi, qf, L, 1.f, lsum, O, impw);
    lsum += __shfl_xor(lsum, 32);
    { const float sc = g1 / fmaxf(lsum, 1e-30f);
#pragma unroll
      for (int dt = 0; dt < 2; ++dt) Ot[dt] += O[dt] * sc; }
    {
        const int jlo = qb >= 8 ? qb - 8 : 0;
        unsigned long long wlo = 0ull, whi = 0ull;
        for (int jj = jlo; jj <= qb; ++jj) { if (jj < 64) wlo |= 1ull << jj; else whi |= 1ull << (jj - 64); }
        O[0] = f32x16{}; O[1] = f32x16{}; lsum = 0.f;
        nsa_pass<3>(lds, kvb + 512, kvb + 640, 768, wlo, whi, qf, L, 1.f, lsum, O, impw);
        lsum += __shfl_xor(lsum, 32);
        const float sc = g2 / fmaxf(lsum, 1e-30f);
#pragma unroll
        for (int dt = 0; dt < 2; ++dt) Ot[dt] += O[dt] * sc;
    }
    float ss = 0.f;
#pragma unroll
    for (int dt = 0; dt < 2; ++dt)
#pragma unroll
        for (int r = 0; r < 16; ++r) ss += Ot[dt][r] * Ot[dt][r];
    ss += __shfl_xor(ss, 32);
    const float rstd = rsqrtf(ss * (1.f / 64.f) + RMS_EPS);
#pragma unroll
    for (int dt = 0; dt < 2; ++dt)
#pragma unroll
        for (int r4 = 0; r4 < 4; ++r4) { const int d = 32 * dt + 8 * r4 + 4 * hi; const f32x4 w = *(const f32x4*)(P.attn_out_norm_w + head * 64 + d);
            u32x2 pk; pk.x = cvtpk(Ot[dt][4 * r4] * rstd * w.x, Ot[dt][4 * r4 + 1] * rstd * w.y); pk.y = cvtpk(Ot[dt][4 * r4 + 2] * rstd * w.z, Ot[dt][4 * r4 + 3] * rstd * w.w);
            *(u32x2*)(mix + tok * 1024 + head * 64 + d) = pk; }
    __syncthreads();
}


__device__ __forceinline__ int gu_hcol(int m0) { const int ni = (m0 >> 4) & 7; return 64 * (m0 >> 7) + 32 * (ni >> 2) + 8 * ((m0 & 15) >> 2) + 4 * ((ni >> 1) & 1); }
__device__ __forceinline__ int p2_col(int m0) { const int ni = (m0 >> 4) & 7; return 128 * (m0 >> 7) + 32 * (ni >> 1) + 8 * ((m0 & 15) >> 2) + 4 * (ni & 1); }
__device__ __forceinline__ void phase_cvt_small(const Params& P) {
    const int tid = threadIdx.x;
    {
        const int gt = blockIdx.x * NTHREADS + tid, NG = gridDim.x * NTHREADS;
        bf16_t* wo = (bf16_t*)(P.ws + WS_WOUT); bf16_t* wrs = (bf16_t*)(P.ws + WS_WRS); bf16_t* wsd = (bf16_t*)(P.ws + WS_WSD);
        for (int i = gt; i < 1024 * 128; i += NG) { const int k = i >> 7, m0 = (i & 127) * 8; const float* s = P.w_out + (size_t)k * 1024 + (m0 & ~255) + p2_col(m0 & 255);
            const f32x4 a = *(const f32x4*)s, b2 = *(const f32x4*)(s + 8);
            *(u32x4*)(wo + (size_t)i * 8) = (u32x4){cvtpk(a.x, a.y), cvtpk(a.z, a.w), cvtpk(b2.x, b2.y), cvtpk(b2.z, b2.w)}; }
        for (int i = gt; i < 256 * 128; i += NG) { const int k = i >> 7, m0 = (i & 127) * 8; const float* s = P.sh_wd + (size_t)k * 1024 + (m0 & ~255) + p2_col(m0 & 255);
            const f32x4 a = *(const f32x4*)s, b2 = *(const f32x4*)(s + 8);
            *(u32x4*)(wsd + (size_t)i * 8) = (u32x4){cvtpk(a.x, a.y), cvtpk(a.z, a.w), cvtpk(b2.x, b2.y), cvtpk(b2.z, b2.w)}; }
        for (int i = gt; i < 1024 * 96; i += NG) { const int k = i / 96, c8 = (i % 96) * 8;
            const float* s; int d2 = 4;
            if (c8 < 256) s = P.router_w + (size_t)k * 256 + c8;
            else { const int cc = c8 - 256, t = cc >> 8; s = ((cc & 16) ? P.sh_wu : P.sh_wg) + (size_t)k * 256 + t * 128 + gu_hcol(cc & 255); d2 = 8; }
            const f32x4 a = *(const f32x4*)s, b2 = *(const f32x4*)(s + d2);
            *(u32x4*)(wrs + (size_t)k * 768 + c8) = (u32x4){cvtpk(a.x, a.y), cvtpk(a.z, a.w), cvtpk(b2.x, b2.y), cvtpk(b2.z, b2.w)}; }
    }
}

__device__ __forceinline__ void route_token(const Params& P, int t, int lane, int& out_idx, float& out_w) {
    const float* scores = (const float*)(P.ws + WS_SCORES) + (size_t)t * 256;
    const f32x4 s4 = *(const f32x4*)(scores + 4 * lane); const f32x4 b4 = *(const f32x4*)(P.router_bias + 4 * lane);
    float sc[4] = {s4.x, s4.y, s4.z, s4.w};
    float bs[4] = {s4.x + b4.x, s4.y + b4.y, s4.z + b4.z, s4.w + b4.w};
    float m1 = fmaxf(bs[0], bs[1]), m2 = fminf(bs[0], bs[1]);
    { const float v = bs[2]; const float n1 = fmaxf(m1, v); m2 = fmaxf(fminf(m1, v), m2); m1 = n1; }
    { const float v = bs[3]; const float n1 = fmaxf(m1, v); m2 = fmaxf(fminf(m1, v), m2); m1 = n1; }
#pragma unroll
    for (int o = 1; o < 8; o <<= 1) { const float o1 = __shfl_xor(m1, o), o2 = __shfl_xor(m2, o); const float n1 = fmaxf(m1, o1); m2 = fmaxf(fminf(m1, o1), fmaxf(m2, o2)); m1 = n1; }
    const float gs = m1 + m2;
    const int grp = lane >> 3;
    int rank = 0;
#pragma unroll
    for (int g2 = 0; g2 < 8; ++g2) { const float og = __shfl(gs, g2 * 8); rank += (og > gs || (og == gs && g2 < grp)) ? 1 : 0; }
    const bool gsel = rank < 4;
    float mv[4];
#pragma unroll
    for (int i = 0; i < 4; ++i) mv[i] = gsel ? bs[i] : -INFINITY;
    int myidx = -1; float myw = 0.f; float wsum = 0.f;
#pragma unroll 1
    for (int k = 0; k < 8; ++k) {
        float bv = mv[0]; int bi = 4 * lane;
#pragma unroll
        for (int i = 1; i < 4; ++i) if (mv[i] > bv) { bv = mv[i]; bi = 4 * lane + i; }
#pragma unroll
        for (int o = 1; o < 64; o <<= 1) { const float ov = __shfl_xor(bv, o); const int oi = __shfl_xor(bi, o); if (ov > bv || (ov == bv && oi < bi)) { bv = ov; bi = oi; } }
        const int wl = bi >> 2, wc = bi & 3;
        const float mine = wc == 0 ? sc[0] : (wc == 1 ? sc[1] : (wc == 2 ? sc[2] : sc[3]));
        const float wv = __shfl(mine, wl);
        wsum += wv;
        if (lane == k) { myidx = bi; myw = wv; }
        if (lane == wl) {
#pragma unroll
            for (int i = 0; i < 4; ++i) if (i == wc) mv[i] = -INFINITY; }
    }
    out_idx = myidx; out_w = myw / wsum * 2.5f;
}


__device__ __forceinline__ void route_token4(const f32x4 (&s4v)[4], const f32x4 (&b4v)[4], int sub, int& out_idx, float& out_w) {
    float sc[16], mv[16];
#pragma unroll
    for (int q = 0; q < 4; ++q) { const f32x4 s4 = s4v[q]; const f32x4 b4 = b4v[q];
        sc[4 * q] = s4.x; sc[4 * q + 1] = s4.y; sc[4 * q + 2] = s4.z; sc[4 * q + 3] = s4.w;
        mv[4 * q] = s4.x + b4.x; mv[4 * q + 1] = s4.y + b4.y; mv[4 * q + 2] = s4.z + b4.z; mv[4 * q + 3] = s4.w + b4.w; }
    float m1 = fmaxf(mv[0], mv[1]), m2 = fminf(mv[0], mv[1]);
#pragma unroll
    for (int i = 2; i < 16; ++i) { const float v = mv[i]; const float n1 = fmaxf(m1, v); m2 = fmaxf(fminf(m1, v), m2); m1 = n1; }
    { const float o1 = __int_as_float(__builtin_amdgcn_update_dpp(0, __float_as_int(m1), 0xB1, 0xF, 0xF, true)), o2 = __int_as_float(__builtin_amdgcn_update_dpp(0, __float_as_int(m2), 0xB1, 0xF, 0xF, true));
      const float n1 = fmaxf(m1, o1); m2 = fmaxf(fminf(m1, o1), fmaxf(m2, o2)); m1 = n1; }
    const float gs = m1 + m2;
    const int grp = sub >> 1;
    int rank = 0;
#pragma unroll
    for (int g2 = 0; g2 < 8; ++g2) { const float og = __shfl(gs, g2 * 2, 16); rank += (og > gs || (og == gs && g2 < grp)) ? 1 : 0; }
    if (rank >= 4) {
#pragma unroll
        for (int i = 0; i < 16; ++i) mv[i] = -INFINITY; }
    int myidx = -1; float myw = 0.f; float wsum = 0.f;
#pragma unroll 1
    for (int k = 0; k < 8; ++k) {
        float bv = mv[0]; int bi = 0;
#pragma unroll
        for (int i = 1; i < 16; ++i) if (mv[i] > bv) { bv = mv[i]; bi = i; }
        int gi = 16 * sub + bi;
#pragma unroll
        for (int st = 0; st < 4; ++st) {
            float ov; int oi;
            if (st == 0) { ov = __int_as_float(__builtin_amdgcn_update_dpp(0, __float_as_int(bv), 0xB1, 0xF, 0xF, true)); oi = __builtin_amdgcn_update_dpp(0, gi, 0xB1, 0xF, 0xF, true); }
            else if (st == 1) { ov = __int_as_float(__builtin_amdgcn_update_dpp(0, __float_as_int(bv), 0x4E, 0xF, 0xF, true)); oi = __builtin_amdgcn_update_dpp(0, gi, 0x4E, 0xF, 0xF, true); }
            else if (st == 2) { ov = __int_as_float(__builtin_amdgcn_update_dpp(0, __float_as_int(bv), 0x141, 0xF, 0xF, true)); oi = __builtin_amdgcn_update_dpp(0, gi, 0x141, 0xF, 0xF, true); }
            else { ov = __int_as_float(__builtin_amdgcn_update_dpp(0, __float_as_int(bv), 0x140, 0xF, 0xF, true)); oi = __builtin_amdgcn_update_dpp(0, gi, 0x140, 0xF, 0xF, true); }
            if (ov > bv || (ov == bv && oi < gi)) { bv = ov; gi = oi; } }
        const int wl = gi >> 4, wc = gi & 15;
        float mine = sc[0];
#pragma unroll
        for (int i = 1; i < 16; ++i) mine = (wc == i) ? sc[i] : mine;
        const float wv = __shfl(mine, wl, 16);
        wsum += wv;
        if (sub == k) { myidx = gi; myw = wv; }
        if (sub == wl) {
#pragma unroll
            for (int i = 0; i < 16; ++i) if (i == wc) mv[i] = -INFINITY; }
    }
    out_idx = myidx; out_w = myw / wsum * 2.5f;
}

__device__ __forceinline__ void phase_p4a(const Params& P, LAS unsigned char* lds) {
    typedef Gemm3 G;
    const int tid = opaque_tid(), lane = tid & 63, wid = tid >> 6, wm = wid >> 1, wn = wid & 1, fr = lane & 15, fq = lane >> 4;
    struct F { const Params& P;
        __device__ __forceinline__ void ptrs(int seg, const bf16_t* (&aptr)[2], const bf16_t* (&bptr)[2]) const {
            const int tid = opaque_tid(), lane = tid & 63, wid = tid >> 6, wm = wid >> 1, wn = wid & 1, fr = lane & 15, fq = lane >> 4, c8 = 8 * (tid & 31); (void)wm; (void)wn; (void)fr; (void)fq; (void)c8;
            const int u = blockIdx.x + seg * gridDim.x, rt = u >> 2, ct = u & 3;
            const bf16_t* mix = (const bf16_t*)(P.ws + WS_MIX); const bf16_t* wo = (const bf16_t*)(P.ws + WS_WOUT);
#pragma unroll
            for (int i = 0; i < 2; ++i) { const int row = G::a_row(i, wid, lane); aptr[i] = mix + (size_t)(rt * 256 + row) * 1024 + G::a_chunk(row, lane) * 8;
                const int k = G::b_k(i, wid, lane); bptr[i] = wo + (size_t)k * 1024 + ct * 256 + G::b_n(k, lane); } }
        __device__ __forceinline__ void epi(int seg, f32x4 (&acc)[4][8]) const {
            const int tid = opaque_tid(), lane = tid & 63, wid = tid >> 6, wm = wid >> 1, wn = wid & 1, fr = lane & 15, fq = lane >> 4, c8 = 8 * (tid & 31); (void)wm; (void)wn; (void)fr; (void)fq; (void)c8;
            const int u = blockIdx.x + seg * gridDim.x, rt = u >> 2, ct = u & 3, b = (rt * 256) / SEQ;
            const float* mod = (const float*)(P.ws + WS_MOD) + b * 6144; float* ssp = (float*)(P.ws + WS_SS); bf16_t* x1 = (bf16_t*)(P.ws + WS_X1);
            f32x4 gv[4], gw[4];
#pragma unroll
            for (int j = 0; j < 4; ++j) { const int col = ct * 256 + wn * 128 + j * 32 + 8 * fq; gv[j] = *(const f32x4*)(mod + 2048 + col); gw[j] = *(const f32x4*)(mod + 2048 + col + 4); }
#pragma unroll
            for (int mi = 0; mi < 4; ++mi) { const size_t m = (size_t)(rt * 256 + wm * 64 + mi * 16 + fr); float ss = 0.f;
                f32x4 xv[4], xw[4];
#pragma unroll
                for (int j = 0; j < 4; ++j) { const int col = ct * 256 + wn * 128 + j * 32 + 8 * fq;
                    xv[j] = __builtin_nontemporal_load((const f32x4*)(P.x + m * 1024 + col)); xw[j] = __builtin_nontemporal_load((const f32x4*)(P.x + m * 1024 + col + 4)); }
#pragma unroll
                for (int j = 0; j < 4; ++j) { const int col = ct * 256 + wn * 128 + j * 32 + 8 * fq;
                    const f32x4 a = acc[mi][2 * j], c = acc[mi][2 * j + 1];
                    f32x4 o, o2; o.x = xv[j].x + gv[j].x * a.x; o.y = xv[j].y + gv[j].y * a.y; o.z = xv[j].z + gv[j].z * a.z; o.w = xv[j].w + gv[j].w * a.w;
                    o2.x = xw[j].x + gw[j].x * c.x; o2.y = xw[j].y + gw[j].y * c.y; o2.z = xw[j].z + gw[j].z * c.z; o2.w = xw[j].w + gw[j].w * c.w;
                    *(u32x4*)(x1 + m * 1024 + col) = (u32x4){cvtpk(o.x, o.y), cvtpk(o.z, o.w), cvtpk(o2.x, o2.y), cvtpk(o2.z, o2.w)};
                    ss += ((o.x * o.x + o.y * o.y) + (o.z * o.z + o.w * o.w)) + ((o2.x * o2.x + o2.y * o2.y) + (o2.z * o2.z + o2.w * o2.w)); }
                asm volatile("" ::: "memory");
                ss += __shfl_xor(ss, 16); ss += __shfl_xor(ss, 32);
                if (fq == 0) ssp[m * 8 + ct * 2 + wn] = ss; } }
    } f{P};
    const int nu = (128 * 4 - (int)blockIdx.x + (int)gridDim.x - 1) / (int)gridDim.x;
    if (nu > 0) G::run_stream(f, nu, 32, 32, (size_t)32 * 1024, lds);
}
__device__ __forceinline__ void phase_p4b(const Params& P) {
    const int lane = threadIdx.x & 63, gw = blockIdx.x * (NTHREADS / 64) + (threadIdx.x >> 6), NGW = gridDim.x * (NTHREADS / 64);
    const float* ssp = (const float*)(P.ws + WS_SS); bf16_t* h2 = (bf16_t*)(P.ws + WS_H);
    for (int b = 0; b < BATCH; ++b) {
        const float* mod = (const float*)(P.ws + WS_MOD) + b * 6144;
        f32x4 ga[4], sh[4];
#pragma unroll
        for (int j = 0; j < 4; ++j) { const int col = (lane + 64 * j) * 4; const f32x4 wv = *(const f32x4*)(P.norm2_w + col), scv = *(const f32x4*)(mod + 4096 + col); sh[j] = *(const f32x4*)(mod + 3072 + col);
            ga[j] = (f32x4){wv.x * (1.f + scv.x), wv.y * (1.f + scv.y), wv.z * (1.f + scv.z), wv.w * (1.f + scv.w)}; }
        for (int m0 = b * SEQ + gw; m0 < (b + 1) * SEQ; m0 += 2 * NGW) {
            const int m1 = m0 + NGW < (b + 1) * SEQ ? m0 + NGW : m0;
            u32x2 xr[2][4]; f32x4 s0[2], s1[2];
#pragma unroll
            for (int r = 0; r < 2; ++r) { const int m = r ? m1 : m0; s0[r] = *(const f32x4*)(ssp + (size_t)m * 8); s1[r] = *(const f32x4*)(ssp + (size_t)m * 8 + 4);
#pragma unroll
                for (int j = 0; j < 4; ++j) xr[r][j] = *(const u32x2*)((const bf16_t*)(P.ws + WS_X1) + (size_t)m * 1024 + (lane + 64 * j) * 4); }
#pragma unroll
            for (int r = 0; r < 2; ++r) { const int m = r ? m1 : m0;
                if (r == 1 && m1 == m0) break;
                const float rstd = rsqrtf(((s0[r].x + s0[r].y) + (s0[r].z + s0[r].w) + (s1[r].x + s1[r].y) + (s1[r].z + s1[r].w)) * (1.f / 1024.f) + RMS_EPS);
#pragma unroll
                for (int j = 0; j < 4; ++j) { const int col = (lane + 64 * j) * 4; const u32x2 x2 = xr[r][j];
                    const f32x4 v = (f32x4){__uint_as_float(x2.x << 16), __uint_as_float(x2.x & 0xffff0000u), __uint_as_float(x2.y << 16), __uint_as_float(x2.y & 0xffff0000u)};
                    const float r0 = v.x * rstd * ga[j].x + sh[j].x, r1 = v.y * rstd * ga[j].y + sh[j].y, r2 = v.z * rstd * ga[j].z + sh[j].z, r3 = v.w * rstd * ga[j].w + sh[j].w;
                    u32x2 pk; pk.x = cvtpk(r0, r1); pk.y = cvtpk(r2, r3);
                    *(u32x2*)(h2 + (size_t)m * 1024 + col) = pk;
                    int q8 = __builtin_amdgcn_cvt_pk_fp8_f32(r0, r1, 0, false); q8 = __builtin_amdgcn_cvt_pk_fp8_f32(r2, r3, q8, true);
                    *(int*)((unsigned char*)(P.ws + WS_H2Q) + (size_t)m * 1024 + col) = q8; } }
        }
    }
}
__device__ __forceinline__ void phase_p4c(const Params& P, LAS unsigned char* lds) {
    typedef Gemm3 G;
    const int tid = opaque_tid(), lane = tid & 63, wid = tid >> 6, wm = wid >> 1, wn = wid & 1, fr = lane & 15, fq = lane >> 4;
    struct F { const Params& P;
        __device__ __forceinline__ void ptrs(int seg, const bf16_t* (&aptr)[2], const bf16_t* (&bptr)[2]) const {
            const int tid = opaque_tid(), lane = tid & 63, wid = tid >> 6, wm = wid >> 1, wn = wid & 1, fr = lane & 15, fq = lane >> 4, c8 = 8 * (tid & 31); (void)wm; (void)wn; (void)fr; (void)fq; (void)c8;
            const int u = blockIdx.x + seg * gridDim.x, rt = u / 3, ct = u % 3;
            const bf16_t* h2 = (const bf16_t*)(P.ws + WS_H); const bf16_t* wrs = (const bf16_t*)(P.ws + WS_WRS);
#pragma unroll
            for (int i = 0; i < 2; ++i) { const int row = G::a_row(i, wid, lane); aptr[i] = h2 + (size_t)(rt * 256 + row) * 1024 + G::a_chunk(row, lane) * 8;
                const int k = G::b_k(i, wid, lane); bptr[i] = wrs + (size_t)k * 768 + ct * 256 + G::b_n(k, lane); } }
        __device__ __forceinline__ void epi(int seg, f32x4 (&acc)[4][8]) const {
            const int tid = opaque_tid(), lane = tid & 63, wid = tid >> 6, wm = wid >> 1, wn = wid & 1, fr = lane & 15, fq = lane >> 4, c8 = 8 * (tid & 31); (void)wm; (void)wn; (void)fr; (void)fq; (void)c8;
            const int u = blockIdx.x + seg * gridDim.x, rt = u / 3, ct = u % 3;
            float* scores = (float*)(P.ws + WS_SCORES); bf16_t* hidS = (bf16_t*)(P.ws + WS_HIDS);
#pragma unroll
            for (int mi = 0; mi < 4; ++mi) { const size_t m = (size_t)(rt * 256 + wm * 64 + mi * 16 + fr);
                if (ct == 0) {
#pragma unroll
                    for (int ni = 0; ni < 8; ++ni) { const f32x4 a = acc[mi][ni];
                        *(f32x4*)(scores + m * 256 + wn * 128 + ni * 16 + 4 * fq) = (f32x4){sigmoidf_(a.x), sigmoidf_(a.y), sigmoidf_(a.z), sigmoidf_(a.w)}; }
                } else {
#pragma unroll
                    for (int j2 = 0; j2 < 2; ++j2) { const f32x4 g = acc[mi][4 * j2], uu = acc[mi][4 * j2 + 1], g2 = acc[mi][4 * j2 + 2], u2 = acc[mi][4 * j2 + 3];
                        u32x4 pk; pk.x = cvtpk(siluf_(g.x) * uu.x, siluf_(g.y) * uu.y); pk.y = cvtpk(siluf_(g.z) * uu.z, siluf_(g.w) * uu.w);
                        pk.z = cvtpk(siluf_(g2.x) * u2.x, siluf_(g2.y) * u2.y); pk.w = cvtpk(siluf_(g2.z) * u2.z, siluf_(g2.w) * u2.w);
                        *(u32x4*)(hidS + m * 256 + (ct - 1) * 128 + wn * 64 + j2 * 32 + 8 * fq) = pk; }
                } } }
    } f{P};
    const int nu = (128 * 3 - (int)blockIdx.x + (int)gridDim.x - 1) / (int)gridDim.x;
    if (nu > 0) G::run_stream(f, nu, 32, 32, (size_t)32 * 768, lds);
}
__device__ __forceinline__ void phase_route(const Params& P, LAS unsigned char* lds) {
    const int tid = opaque_tid(), lane = tid & 63, wid = tid >> 6;
    LAS int* lcnt = (LAS int*)lds; LAS int* lbase = lcnt + 256; LAS int* lrec = lbase + 256; LAS float* lw = (LAS float*)(lrec + 512);
    int* cnt = (int*)(P.ws + WS_CTL + CTL_CNT);
    f32x4 bias4[4];
#pragma unroll
    for (int q = 0; q < 4; ++q) bias4[q] = *(const f32x4*)(P.router_bias + 16 * (lane & 15) + 4 * q);
    for (int t0 = blockIdx.x * 64; t0 < T; t0 += gridDim.x * 64) {
        if (tid < 256) lcnt[tid] = 0;
        __syncthreads();
        f32x4 sv[2][4];
#pragma unroll
        for (int i = 0; i < 2; ++i) { const float* scp = (const float*)(P.ws + WS_SCORES) + (size_t)(t0 + wid * 8 + i * 4 + (lane >> 4)) * 256 + 16 * (lane & 15);
#pragma unroll
            for (int q = 0; q < 4; ++q) sv[i][q] = *(const f32x4*)(scp + 4 * q); }
#pragma unroll
        for (int i = 0; i < 2; ++i) { const int tl = wid * 8 + i * 4 + (lane >> 4), sub = lane & 15; int idx; float w;
            route_token4(sv[i], bias4, sub, idx, w);
            if (sub < 8) { const int rank = __hip_atomic_fetch_add(lcnt + idx, 1, __ATOMIC_RELAXED, __HIP_MEMORY_SCOPE_WORKGROUP); lrec[tl * 8 + sub] = idx | (rank << 8); lw[tl * 8 + sub] = w; } }
        __syncthreads();
        if (tid < 256) { const int c = lcnt[tid]; lbase[tid] = c ? atomicAdd(cnt + tid * CNT_STRIDE, c) : 0; }
        __syncthreads();
        { const int rec = lrec[tid], e = rec & 255, pos = lbase[e] + (rec >> 8); const int slotid = (t0 + (tid >> 3)) * 8 + (tid & 7);
          if (pos < BCAP) ((int*)(P.ws + WS_BUCKET))[(size_t)e * BCAP + pos] = slotid;
          ((float*)(P.ws + WS_RW))[slotid] = lw[tid]; }
        __syncthreads();
    }
}
__device__ __forceinline__ int queue_pull(unsigned* head, volatile LAS unsigned* slot);
__device__ __forceinline__ void p4d_units_from_queue(const Params& P, LAS unsigned char* lds, volatile LAS unsigned* slot) {
    typedef Gemm3 G;
    unsigned* head = (unsigned*)(P.ws + WS_CTL + CTL_Q3 + 512);
    struct F { const Params& P; int ubase;
        __device__ __forceinline__ void ptrs(int seg, const bf16_t* (&aptr)[2], const bf16_t* (&bptr)[2]) const {
            const int tid = opaque_tid(), lane = tid & 63, wid = tid >> 6, wm = wid >> 1, wn = wid & 1, fr = lane & 15, fq = lane >> 4, c8 = 8 * (tid & 31); (void)wm; (void)wn; (void)fr; (void)fq; (void)c8;
            const int u = ubase + seg, rt = u >> 2, ct = u & 3;
            const bf16_t* hidS = (const bf16_t*)(P.ws + WS_HIDS); const bf16_t* wsd = (const bf16_t*)(P.ws + WS_WSD);
#pragma unroll
            for (int i = 0; i < 2; ++i) { const int row = G::a_row(i, wid, lane); aptr[i] = hidS + (size_t)(rt * 256 + row) * 256 + G::a_chunk(row, lane) * 8;
                const int k = G::b_k(i, wid, lane); bptr[i] = wsd + (size_t)k * 1024 + ct * 256 + G::b_n(k, lane); } }
        __device__ __forceinline__ void epi(int seg, f32x4 (&acc)[4][8]) const {
            const int tid = opaque_tid(), lane = tid & 63, wid = tid >> 6, wm = wid >> 1, wn = wid & 1, fr = lane & 15, fq = lane >> 4, c8 = 8 * (tid & 31); (void)wm; (void)wn; (void)fr; (void)fq; (void)c8;
            const int u = ubase + seg, rt = u >> 2, ct = u & 3;
            unsigned char* ysh = (unsigned char*)(P.ws + WS_YSH);
#pragma unroll
            for (int mi = 0; mi < 4; ++mi) { const size_t m = (size_t)(rt * 256 + wm * 64 + mi * 16 + fr);
#pragma unroll
                for (int j = 0; j < 4; ++j) { const int col = ct * 256 + wn * 128 + j * 32 + 8 * fq; const f32x4 a = acc[mi][2 * j] * Y_SCALE, c = acc[mi][2 * j + 1] * Y_SCALE;
                    *(u32x2*)(ysh + m * 1024 + col) = (u32x2){pk4_fp8(a.x, a.y, a.z, a.w), pk4_fp8(c.x, c.y, c.z, c.w)}; } } }
    } f{P, 0};
    for (;;) {
        const int n = queue_pull(head, slot);
        if (n >= 256) break;
        f.ubase = 2 * n;
        G::run_stream(f, 2, 8, 32, (size_t)32 * 1024, lds);
        __syncthreads();
    }
}

__device__ __forceinline__ void phase_expert_cvt(const Params& P) {
    const size_t gt = (size_t)blockIdx.x * NTHREADS + threadIdx.x, NG = (size_t)gridDim.x * NTHREADS;
    bf16_t* wgu = (bf16_t*)(P.ws + WS_WBGU); bf16_t* wd = (bf16_t*)(P.ws + WS_WBD);
    for (size_t i = gt; i < (size_t)256 * 1024 * 64; i += NG) {
        const size_t ek = i >> 6; const int c8 = (int)(i & 63) * 8, t = c8 >> 8;
        const float* s = ((c8 & 16) ? P.exp_wu : P.exp_wg) + ek * 256 + t * 128 + gu_hcol(c8 & 255);
        const f32x4 a = __builtin_nontemporal_load((const f32x4*)s), b2 = __builtin_nontemporal_load((const f32x4*)(s + 8));
        *(u32x4*)(wgu + ek * 512 + c8) = (u32x4){cvtpk(a.x, a.y), cvtpk(a.z, a.w), cvtpk(b2.x, b2.y), cvtpk(b2.z, b2.w)}; }
    for (size_t i = gt; i < (size_t)256 * 256 * 128; i += NG) {
        const size_t ek = i >> 7; const int m0 = (int)(i & 127) * 8, tl = m0 & 255, tile = m0 >> 8;
        const int wnn = tl >> 7, nii = (tl >> 4) & 7, n0 = tl & 15;
        const int ca = tile * 256 + wnn * 128 + 64 * (nii >> 2) + 16 * (n0 >> 2) + 4 * (nii & 3);
        const f32x4 a = __builtin_nontemporal_load((const f32x4*)(P.exp_wd + ek * 1024 + ca)), b2 = __builtin_nontemporal_load((const f32x4*)(P.exp_wd + ek * 1024 + ca + 16));
        *(u32x4*)(wd + ek * 1024 + m0) = (u32x4){cvtpk(a.x, a.y), cvtpk(a.z, a.w), cvtpk(b2.x, b2.y), cvtpk(b2.z, b2.w)}; }
}

constexpr int P6_TILES = 128 * 1024, P6_PRE = P6_TILES + 1024, P6_PAIR = P6_PRE + 1040, P6_W = P6_PAIR + 1024;
__device__ __forceinline__ void phase_experts(const Params& P, LAS unsigned char* lds) {
    typedef Gemm3 G;
    const int tid = opaque_tid(), lane = tid & 63, wid = tid >> 6, wm = wid >> 1, wn = wid & 1, fr = lane & 15, fq = lane >> 4;
    const int* cnt = (const int*)(P.ws + WS_CTL + CTL_CNT); const int* bucket = (const int*)(P.ws + WS_BUCKET); const float* rw = (const float*)(P.ws + WS_RW);
    const bf16_t* h2 = (const bf16_t*)(P.ws + WS_H); bf16_t* hidR = (bf16_t*)(P.ws + WS_HIDR) + (size_t)blockIdx.x * 256 * 256; unsigned char* y = (unsigned char*)(P.ws + WS_Y);
    LAS int* tiles = (LAS int*)(lds + P6_TILES); LAS int* pre = (LAS int*)(lds + P6_PRE); LAS int* pairs = (LAS int*)(lds + P6_PAIR); LAS float* wts = (LAS float*)(lds + P6_W);
    const int nx = (gridDim.x % 8 == 0) ? 8 : 1, xl = blockIdx.x % nx, li = blockIdx.x / nx, nloc = gridDim.x / nx, nek = 256 / nx;
    if (tid < nek) { const int c_ = cnt[(xl + nx * tid) * CNT_STRIDE]; tiles[tid] = ((c_ < BCAP ? c_ : BCAP) + 255) >> 8; }
    __syncthreads();
    if (tid < nek) { int s = 0; for (int i = 0; i < tid; ++i) s += tiles[i]; pre[tid] = s; if (tid == nek - 1) pre[nek] = s + tiles[nek - 1]; }
    __syncthreads();
    const int total = pre[nek];
    const int c8 = 8 * (tid & 31), u16 = c8 >> 4;
    for (int u = li; u < total; u += nloc) {
        int lo = 0, hi = nek - 1;
        while (lo < hi) { const int mid = (lo + hi + 1) >> 1; if (pre[mid] <= u) lo = mid; else hi = mid - 1; }
        const int e = xl + nx * lo, tile = u - pre[lo], n = cnt[e * CNT_STRIDE] < BCAP ? cnt[e * CNT_STRIDE] : BCAP, rows = (n - tile * 256) < 256 ? (n - tile * 256) : 256;
        if (tid < 256) { const int r = tid < rows ? tid : 0; const int pr = bucket[(size_t)e * BCAP + tile * 256 + r]; pairs[tid] = pr; wts[tid] = tid < rows ? rw[pr] : 0.f; }
        __syncthreads();
        {
            struct GU { const bf16_t* h2; LAS int* pairs; const bf16_t* wgu; bf16_t* hidR;
                __device__ __forceinline__ void ptrs(int t, const bf16_t* (&aptr)[2], const bf16_t* (&bptr)[2]) const {
                    const int tid = opaque_tid(), lane = tid & 63, wid = tid >> 6, wm = wid >> 1, wn = wid & 1, fr = lane & 15, fq = lane >> 4, c8 = 8 * (tid & 31); (void)wm; (void)wn; (void)fr; (void)fq; (void)c8;
#pragma unroll
                    for (int i = 0; i < 2; ++i) { const int row = G::a_row(i, wid, lane); aptr[i] = h2 + (size_t)(pairs[row] >> 3) * 1024 + G::a_chunk(row, lane) * 8;
                        const int k = G::b_k(i, wid, lane); bptr[i] = wgu + (size_t)k * 512 + t * 256 + G::b_n(k, lane); } }
                __device__ __forceinline__ void epi(int t, f32x4 (&acc)[4][8]) const {
                    const int tid = opaque_tid(), lane = tid & 63, wid = tid >> 6, wm = wid >> 1, wn = wid & 1, fr = lane & 15, fq = lane >> 4, c8 = 8 * (tid & 31); (void)wm; (void)wn; (void)fr; (void)fq; (void)c8;
#pragma unroll
                    for (int mi = 0; mi < 4; ++mi) { const int rl = wm * 64 + mi * 16 + fr;
#pragma unroll
                        for (int j2 = 0; j2 < 2; ++j2) { const f32x4 g = acc[mi][4 * j2], uu = acc[mi][4 * j2 + 1], g2 = acc[mi][4 * j2 + 2], u2 = acc[mi][4 * j2 + 3];
                            u32x4 pk; pk.x = cvtpk(siluf_(g.x) * uu.x, siluf_(g.y) * uu.y); pk.y = cvtpk(siluf_(g.z) * uu.z, siluf_(g.w) * uu.w);
                            pk.z = cvtpk(siluf_(g2.x) * u2.x, siluf_(g2.y) * u2.y); pk.w = cvtpk(siluf_(g2.z) * u2.z, siluf_(g2.w) * u2.w);
                            *(u32x4*)(hidR + rl * 256 + t * 128 + wn * 64 + j2 * 32 + 8 * fq) = pk; } } }
            } f{h2, pairs, (const bf16_t*)(P.ws + WS_WBGU) + (size_t)e * 1024 * 512, hidR};
            G::run_stream(f, 2, 32, 32, (size_t)32 * 512, lds);
        }
        __syncthreads();
        {
            struct DN { bf16_t* hidR; const bf16_t* wd; unsigned char* y; LAS int* pairs; LAS float* wts; int rows;
                __device__ __forceinline__ void ptrs(int ct, const bf16_t* (&aptr)[2], const bf16_t* (&bptr)[2]) const {
                    const int tid = opaque_tid(), lane = tid & 63, wid = tid >> 6, wm = wid >> 1, wn = wid & 1, fr = lane & 15, fq = lane >> 4, c8 = 8 * (tid & 31); (void)wm; (void)wn; (void)fr; (void)fq; (void)c8;
#pragma unroll
                    for (int i = 0; i < 2; ++i) { const int row = G::a_row(i, wid, lane); aptr[i] = hidR + (size_t)row * 256 + G::a_chunk(row, lane) * 8;
                        const int k = G::b_k(i, wid, lane); bptr[i] = wd + (size_t)k * 1024 + ct * 256 + G::b_n(k, lane); } }
                __device__ __forceinline__ void epi(int ct, f32x4 (&acc)[4][8]) const {
                    const int tid = opaque_tid(), lane = tid & 63, wid = tid >> 6, wm = wid >> 1, wn = wid & 1, fr = lane & 15, fq = lane >> 4, c8 = 8 * (tid & 31); (void)wm; (void)wn; (void)fr; (void)fq; (void)c8;
#pragma unroll
                    for (int mi = 0; mi < 4; ++mi) { const int rl = wm * 64 + mi * 16 + fr; const float wgt = wts[rl]; const size_t pr = (size_t)pairs[rl];
                        if (rl < rows) {
#pragma unroll
                            for (int j2 = 0; j2 < 2; ++j2) { const int col = ct * 256 + wn * 128 + 64 * j2 + 16 * fq; const float sc_ = wgt * Y_SCALE; u32x4 w;
#pragma unroll
                                for (int b2 = 0; b2 < 4; ++b2) { const f32x4 a = acc[mi][4 * j2 + b2] * sc_;
                                    int pk = __builtin_amdgcn_cvt_pk_fp8_f32(a.x, a.y, 0, false); pk = __builtin_amdgcn_cvt_pk_fp8_f32(a.z, a.w, pk, true); w[b2] = (unsigned)pk; }
                                *(u32x4*)(y + pr * 1024 + col) = w; } } } }
            } f{hidR, (const bf16_t*)(P.ws + WS_WBD) + (size_t)e * 256 * 1024, y, pairs, wts, rows};
            G::run_stream(f, 4, 8, 32, (size_t)32 * 1024, lds);
        }
        __syncthreads();
    }
}


__device__ __forceinline__ void cvt8_store_rows(LAS unsigned char* wl, int lane, const u32x4 (&w)[8], unsigned char* obase, size_t row_stride) {
#pragma unroll
    for (int j = 0; j < 8; ++j) *(LAS u32x4*)(wl + lane * 144 + j * 16) = w[j];
    asm volatile("s_waitcnt lgkmcnt(0)" ::: "memory");
#pragma unroll
    for (int i = 0; i < 8; ++i) { const int r = (lane >> 3) + 8 * i; const u32x4 v = *(const LAS u32x4*)(wl + r * 144 + (lane & 7) * 16); *(u32x4*)(obase + (size_t)r * row_stride + (lane & 7) * 16) = v; }
    asm volatile("s_waitcnt lgkmcnt(0)" ::: "memory");
}
__device__ __forceinline__ void cvt8_item(const Params& P, LAS unsigned char* lds, int item) {
    const int tid = opaque_tid(), lane = tid & 63, wv = tid >> 6;
    unsigned char* wgu = (unsigned char*)(P.ws + WS_W8GU); unsigned char* wd = (unsigned char*)(P.ws + WS_W8D);
    LAS unsigned char* wl = lds + wv * 9216;
    const int NGW = 1;
    if (item < 1024)
    for (int u = item * 16 + wv * 2; u < item * 16 + wv * 2 + 2; u += NGW) {
        const int rg = u & 7, kb = (u >> 3) & 7, e = u >> 6;
        const int q = rg * 64 + lane, t = q >> 8, ql = q & 255, wnn = ql >> 7, it = (ql >> 5) & 3, i = ql & 31;
        const int h = t * 128 + wnn * 64 + (it >> 1) * 32 + Gemm8::w_col(i);
        const float* s = ((it & 1) ? P.exp_wu : P.exp_wg) + (size_t)e * 1024 * 256 + (size_t)(kb * 128) * 256 + h;
        unsigned char* o = wgu + ((size_t)e * 512 + rg * 64) * 1024 + kb * 128;
        { float v[128]; u32x4 wq[8];
#pragma unroll
            for (int j = 0; j < 128; ++j) v[j] = __builtin_nontemporal_load(s + (size_t)j * 256);
#pragma unroll
            for (int j = 0; j < 8; ++j) { const float c_ = W8_GU_SCALE; u32x4 w;
                w.x = pk4_fp8(v[16 * j] * c_, v[16 * j + 1] * c_, v[16 * j + 2] * c_, v[16 * j + 3] * c_); w.y = pk4_fp8(v[16 * j + 4] * c_, v[16 * j + 5] * c_, v[16 * j + 6] * c_, v[16 * j + 7] * c_);
                w.z = pk4_fp8(v[16 * j + 8] * c_, v[16 * j + 9] * c_, v[16 * j + 10] * c_, v[16 * j + 11] * c_); w.w = pk4_fp8(v[16 * j + 12] * c_, v[16 * j + 13] * c_, v[16 * j + 14] * c_, v[16 * j + 15] * c_);
                wq[j] = w; }
            cvt8_store_rows(wl, lane, wq, o, 1024); }
    }
    if (item >= 1024)
    for (int u = (item - 1024) * 16 + wv * 2; u < (item - 1024) * 16 + wv * 2 + 2; u += NGW) {
        const int rg = u & 15, kb = (u >> 4) & 1, e = u >> 5;
        const int q = rg * 64 + lane, i = q & 31;
        const int col = (q & ~31) + Gemm8::w_col(i);
        const float* s = P.exp_wd + (size_t)e * 256 * 1024 + (size_t)(kb * 128) * 1024 + col;
        unsigned char* o = wd + ((size_t)e * 1024 + rg * 64) * 256 + kb * 128;
        { float v[128]; u32x4 wq[8];
#pragma unroll
            for (int j = 0; j < 128; ++j) v[j] = __builtin_nontemporal_load(s + (size_t)j * 1024);
#pragma unroll
            for (int j = 0; j < 8; ++j) { const float c_ = W8_D_SCALE; u32x4 w;
                w.x = pk4_fp8(v[16 * j] * c_, v[16 * j + 1] * c_, v[16 * j + 2] * c_, v[16 * j + 3] * c_); w.y = pk4_fp8(v[16 * j + 4] * c_, v[16 * j + 5] * c_, v[16 * j + 6] * c_, v[16 * j + 7] * c_);
                w.z = pk4_fp8(v[16 * j + 8] * c_, v[16 * j + 9] * c_, v[16 * j + 10] * c_, v[16 * j + 11] * c_); w.w = pk4_fp8(v[16 * j + 12] * c_, v[16 * j + 13] * c_, v[16 * j + 14] * c_, v[16 * j + 15] * c_);
                wq[j] = w; }
            cvt8_store_rows(wl, lane, wq, o, 256); }
    }
}

template <int PM> __device__ __forceinline__ void phase_experts8(const Params& P, LAS unsigned char* lds) {
    typedef Gemm8 G;
    const int tid = opaque_tid();
    const int* cnt = (const int*)(P.ws + WS_CTL + CTL_CNT); const int* bucket = (const int*)(P.ws + WS_BUCKET); const float* rw = (const float*)(P.ws + WS_RW);
    const unsigned char* h2q = (const unsigned char*)(P.ws + WS_H2Q); unsigned char* hidR = (unsigned char*)(P.ws + WS_HIDR) + (size_t)blockIdx.x * 256 * 256; unsigned char* y = (unsigned char*)(P.ws + WS_Y);
    LAS int* tiles = (LAS int*)(lds + P6_TILES); LAS int* pre = (LAS int*)(lds + P6_PRE); LAS int* pairs = (LAS int*)(lds + P6_PAIR); LAS float* wts = (LAS float*)(lds + P6_W);
    const int nx = (gridDim.x % 8 == 0) ? 8 : 1, xl = blockIdx.x % nx, li = blockIdx.x / nx, nloc = gridDim.x / nx, nek = 256 / nx;
    if (tid < nek) { const int c_ = cnt[(xl + nx * tid) * CNT_STRIDE]; tiles[tid] = ((c_ < BCAP ? c_ : BCAP) + 255) >> 8; }
    __syncthreads();
    if (tid < nek) { int s = 0; for (int i = 0; i < tid; ++i) s += tiles[i]; pre[tid] = s; if (tid == nek - 1) pre[nek] = s + tiles[nek - 1]; }
    __syncthreads();
    const int total = pre[nek];
    for (int u = li; u < total; u += nloc) {
        int lo = 0, hi_ = nek - 1;
        while (lo < hi_) { const int mid = (lo + hi_ + 1) >> 1; if (pre[mid] <= u) lo = mid; else hi_ = mid - 1; }
        const int e = xl + nx * lo, tile = u - pre[lo], n = cnt[e * CNT_STRIDE] < BCAP ? cnt[e * CNT_STRIDE] : BCAP, rows = (n - tile * 256) < 256 ? (n - tile * 256) : 256;
        if (tid < 256) { const int r = tid < rows ? tid : 0; const int pr = bucket[(size_t)e * BCAP + tile * 256 + r]; pairs[tid] = pr; wts[tid] = tid < rows ? rw[pr] : 0.f; }
        __syncthreads();
        {
            struct GU { const unsigned char* h2q; LAS int* pairs; const unsigned char* wgu; unsigned char* hidR;
                static __device__ __forceinline__ int wscale(int it) { return (it & 1) ? 123 : 121; }
                __device__ __forceinline__ void ptrs(int t, const unsigned char* (&aptr)[2], const unsigned char* (&wptr)[2]) const {
                    const int tid = opaque_tid(), lane = tid & 63, wid = tid >> 6;
#pragma unroll
                    for (int i = 0; i < 2; ++i) { const int row = G::t_row(i, wid, lane); aptr[i] = h2q + (size_t)(pairs[row] >> 3) * 1024 + G::t_chunk(row, lane) * 16;
                        wptr[i] = wgu + (size_t)(t * 256 + row) * 1024 + G::t_chunk(row, lane) * 16; } }
                __device__ __forceinline__ void epi(int t, f32x16 (&acc)[2][4]) const {
                    const int tid = opaque_tid(), lane = tid & 63, wid = tid >> 6, wm = wid >> 1, wn = wid & 1, l31 = lane & 31, hi = lane >> 5;
                    if (PM == 2) return;
#pragma unroll
                    for (int jt = 0; jt < 2; ++jt) { const int rl = wm * 64 + jt * 32 + l31;
#pragma unroll
                        for (int p = 0; p < 2; ++p) {
                            float e[16], hv[16];
#pragma unroll
                            for (int r = 0; r < 16; ++r) e[r] = __builtin_amdgcn_exp2f(acc[jt][2 * p][r] * -LOG2E);
                            __builtin_amdgcn_sched_barrier(0);
#pragma unroll
                            for (int r = 0; r < 16; ++r) { e[r] = __builtin_amdgcn_rcpf(1.0f + e[r]); hv[r] = acc[jt][2 * p][r] * acc[jt][2 * p + 1][r]; }
                            __builtin_amdgcn_sched_barrier(0);
                            u32x4 w;
#pragma unroll
                            for (int q4 = 0; q4 < 4; ++q4) w[q4] = pk4_fp8(hv[4 * q4] * e[4 * q4], hv[4 * q4 + 1] * e[4 * q4 + 1], hv[4 * q4 + 2] * e[4 * q4 + 2], hv[4 * q4 + 3] * e[4 * q4 + 3]);
                            *(u32x4*)(hidR + rl * 256 + t * 128 + wn * 64 + p * 32 + 16 * hi) = w; } } }
            } f{h2q, pairs, (const unsigned char*)(P.ws + WS_W8GU) + (size_t)e * 512 * 1024, hidR};
            if (PM != 3) G::run_stream(f, 2, 16, lds);
        }
        __syncthreads();
        {
            struct DN { const unsigned char* hidR; const unsigned char* wd; unsigned char* y; LAS int* pairs; LAS float* wts; int rows;
                static __device__ __forceinline__ int wscale(int) { return 120; }
                __device__ __forceinline__ void ptrs(int ct, const unsigned char* (&aptr)[2], const unsigned char* (&wptr)[2]) const {
                    const int tid = opaque_tid(), lane = tid & 63, wid = tid >> 6;
#pragma unroll
                    for (int i = 0; i < 2; ++i) { const int row = G::t_row(i, wid, lane); aptr[i] = hidR + (size_t)row * 256 + G::t_chunk(row, lane) * 16;
                        wptr[i] = wd + (size_t)(ct * 256 + row) * 256 + G::t_chunk(row, lane) * 16; } }
                __device__ __forceinline__ void epi(int ct, f32x16 (&acc)[2][4]) const {
                    const int tid = opaque_tid(), lane = tid & 63, wid = tid >> 6, wm = wid >> 1, wn = wid & 1, l31 = lane & 31, hi = lane >> 5;
                    if (PM == 3) return;
#pragma unroll
                    for (int jt = 0; jt < 2; ++jt) { const int rl = wm * 64 + jt * 32 + l31; const float sc_ = wts[rl] * Y_SCALE; const size_t pr = (size_t)pairs[rl];
                        if (rl < rows) {
#pragma unroll
                            for (int it = 0; it < 4; ++it) { u32x4 w;
#pragma unroll
                                for (int q4 = 0; q4 < 4; ++q4) w[q4] = pk4_fp8(acc[jt][it][4 * q4] * sc_, acc[jt][it][4 * q4 + 1] * sc_, acc[jt][it][4 * q4 + 2] * sc_, acc[jt][it][4 * q4 + 3] * sc_);
                                *(u32x4*)(y + pr * 1024 + ct * 256 + wn * 128 + it * 32 + 16 * hi) = w; } } } }
            } f{hidR, (const unsigned char*)(P.ws + WS_W8D) + (size_t)e * 1024 * 256, y, pairs, wts, rows};
            if (PM == 0 || PM == 3) G::run_stream(f, 4, 4, lds);
        }
        __syncthreads();
    }
}

__device__ __forceinline__ void phase_combine(const Params& P) {
    const int lane = threadIdx.x & 63, gw = blockIdx.x * (NTHREADS / 64) + (threadIdx.x >> 6), NGW = gridDim.x * (NTHREADS / 64);
    const unsigned char* y = (const unsigned char*)(P.ws + WS_Y);
    typedef float f32x2_ __attribute__((ext_vector_type(2)));
    for (int m = gw; m < T; m += NGW) {
        const float* mod = (const float*)(P.ws + WS_MOD) + (m / SEQ) * 6144 + 5120;
#pragma unroll
        for (int j = 0; j < 2; ++j) { const int col = (lane + 64 * j) * 8;
            f32x4 s0 = (f32x4){0.f, 0.f, 0.f, 0.f}, s1 = s0;
#pragma unroll
            for (int sl = 0; sl < 9; ++sl) { const u32x2 v = sl < 8 ? __builtin_nontemporal_load((const u32x2*)(y + ((size_t)m * 8 + sl) * 1024 + col)) : __builtin_nontemporal_load((const u32x2*)((const unsigned char*)(P.ws + WS_YSH) + (size_t)m * 1024 + col));
                const f32x2_ a = __builtin_amdgcn_cvt_pk_f32_fp8((int)v.x, false), b = __builtin_amdgcn_cvt_pk_f32_fp8((int)v.x, true);
                const f32x2_ c = __builtin_amdgcn_cvt_pk_f32_fp8((int)v.y, false), d = __builtin_amdgcn_cvt_pk_f32_fp8((int)v.y, true);
                s0.x += a.x; s0.y += a.y; s0.z += b.x; s0.w += b.y; s1.x += c.x; s1.y += c.y; s1.z += d.x; s1.w += d.y; }
            const f32x4 g0 = *(const f32x4*)(mod + col), g1 = *(const f32x4*)(mod + col + 4);
            const u32x4 xr = *(const u32x4*)((const bf16_t*)(P.ws + WS_X1) + (size_t)m * 1024 + col);
            f32x4 o0 = (f32x4){__uint_as_float(xr.x << 16), __uint_as_float(xr.x & 0xffff0000u), __uint_as_float(xr.y << 16), __uint_as_float(xr.y & 0xffff0000u)};
            f32x4 o1 = (f32x4){__uint_as_float(xr.z << 16), __uint_as_float(xr.z & 0xffff0000u), __uint_as_float(xr.w << 16), __uint_as_float(xr.w & 0xffff0000u)};
            o0 += g0 * (s0 * Y_INV); o1 += g1 * (s1 * Y_INV);
            __builtin_nontemporal_store(o0, (f32x4*)(P.out + (size_t)m * 1024 + col)); __builtin_nontemporal_store(o1, (f32x4*)(P.out + (size_t)m * 1024 + col + 4)); }
    }
}


__device__ __forceinline__ int queue_pull(unsigned* head, volatile LAS unsigned* slot) {
    if (threadIdx.x == 0) *slot = atomicAdd(head, 1u);
    __syncthreads();
    const int v = (int)*slot;
    __syncthreads();
    return v;
}
__device__ __forceinline__ void phase_cmp_h1(const Params& P, LAS unsigned char* lds, volatile LAS unsigned* slot) {
    unsigned* head = (unsigned*)(P.ws + WS_CTL + CTL_Q2);
    for (;;) {
        const int u7 = queue_pull(head, slot);
        if (u7 >= 952) break;
        const int g7 = u7 / 7, p7 = u7 % 7;
        if (p7 & 1) { cvt8_item(P, lds, g7 * 3 + (p7 >> 1)); continue; }
        const int u = g7 * 4 + (p7 >> 1);
        if (u < 32) compress_unit(P, lds, u); else hgrn_unit<0>(P, lds, u - 32);
    }
}
__device__ __forceinline__ void phase_h23_nsa(const Params& P, LAS unsigned char* lds, volatile LAS unsigned* slot) {
    unsigned* head = (unsigned*)(P.ws + WS_CTL + CTL_Q3);
    for (;;) {
        const int n2 = queue_pull(head, slot);
        if (n2 >= 2664) break;
        const int g7 = n2 < 2632 ? n2 / 7 : 376, p7 = n2 < 2632 ? n2 % 7 : 2 * (n2 - 2632);
        if (n2 < 2632 && (p7 & 1)) { cvt8_item(P, lds, 408 + g7 * 3 + (p7 >> 1)); continue; }
        const int n = g7 * 4 + (p7 >> 1);
        if (n < 512) nsa_unit(P, lds, (n & 7) * 128 + (127 - (n >> 3)));
        else if (n < 1024) { const int m = n - 512; hgrn_unit<1>(P, lds, (m & 15) * 32 + (31 - (m >> 4))); }
        else { const int m = n - 1024; nsa_unit(P, lds, (m & 7) * 128 + (63 - (m >> 3))); }
    }
}

constexpr int LDS_BYTES = 144 * 1024;
__global__ void __launch_bounds__(NTHREADS) mega(Params P) {
    extern __shared__ __attribute__((aligned(16))) unsigned char smem[];
    LAS unsigned char* lds = (LAS unsigned char*)smem;
    volatile LAS unsigned* xst = (volatile LAS unsigned*)(lds + LDS_BYTES - 16);
    if (threadIdx.x < 4) xst[threadIdx.x] = 0u;
    __syncthreads();
    XcdBarrier xb = xcd_barrier_post((unsigned*)(P.ws + WS_CTL + CTL_BAR), xst);
    phase_mod(P, lds);
    xcd_barrier(xb);
    { const float* mod = (const float*)(P.ws + WS_MOD); norm_mod_rows(P.x, P.norm1_w, mod, mod + 1024, (unsigned char*)(P.ws + WS_H), H1S); }
    xcd_barrier(xb);
    phase_inproj(P, lds);
    xcd_barrier(xb);
    phase_cmp_h1(P, lds, xst + 2);
    xcd_barrier(xb);
    phase_hgrn_prefix(P);
    xcd_barrier(xb);
    phase_h23_nsa(P, lds, xst + 2);
    phase_cvt_small(P);
    xcd_barrier(xb);
    phase_p4a(P, lds);
    xcd_barrier(xb);
    phase_p4b(P);
    xcd_barrier(xb);
    phase_p4c(P, lds);
    xcd_barrier(xb);
    phase_route(P, lds);
    xcd_barrier(xb);
    phase_experts8<0>(P, lds);
    p4d_units_from_queue(P, lds, xst + 2);
    xcd_barrier(xb);
    phase_combine(P);
}

extern "C" void kernel_launch(void* const* d_in, const int* in_sizes, int n_in, void* d_out, int out_size, void* d_ws, size_t ws_size, hipStream_t stream) {
    static int grid = 0;
    if (grid == 0) {
        if (n_in != 25 || ws_size < WS_END) { fprintf(stderr, "kernel_launch: unexpected n_in %d or ws_size %zu (need %zu)\n", n_in, ws_size, (size_t)WS_END); grid = -1; return; }
        int dev = 0, cus = 0, per_cu = 0;
        (void)hipGetDevice(&dev); (void)hipDeviceGetAttribute(&cus, hipDeviceAttributeMultiprocessorCount, dev);
        (void)hipFuncSetAttribute((const void*)mega, hipFuncAttributeMaxDynamicSharedMemorySize, LDS_BYTES);
        (void)hipOccupancyMaxActiveBlocksPerMultiprocessor(&per_cu, (const void*)mega, NTHREADS, LDS_BYTES);
        if (per_cu < 1) { fprintf(stderr, "kernel_launch: occupancy query says %d blocks per CU\n", per_cu); grid = -1; return; }
        grid = cus;
    }
    if (grid < 0) return;
    (void)hipMemsetAsync((char*)d_ws + WS_CTL, 0, 64 * 1024, stream);
    Params p{};
    const float** pf = (const float**)&p;
    for (int i = 0; i < 25; ++i) pf[i] = (const float*)d_in[i];
    p.out = (float*)d_out; p.ws = (unsigned char*)d_ws;
    void* args[] = {&p};
    hipError_t e = hipLaunchCooperativeKernel((const void*)mega, dim3(grid), dim3(NTHREADS), args, LDS_BYTES, stream);
    if (e != hipSuccess) fprintf(stderr, "cooperative launch failed: %s (grid %d)\n", hipGetErrorString(e), grid);
}

#ifdef PHASE_TEST
__global__ void __launch_bounds__(NTHREADS) t_p4a(Params P) { extern __shared__ __attribute__((aligned(16))) unsigned char smem[]; phase_p4a(P, (LAS unsigned char*)smem); }
__global__ void __launch_bounds__(NTHREADS) t_p4d(Params P) { extern __shared__ __attribute__((aligned(16))) unsigned char smem[]; phase_p4d(P, (LAS unsigned char*)smem); }
__global__ void __launch_bounds__(NTHREADS) t_p4(Params P) { extern __shared__ __attribute__((aligned(16))) unsigned char smem[]; phase_p4c(P, (LAS unsigned char*)smem); }
__global__ void __launch_bounds__(NTHREADS) t_p6(Params P) { extern __shared__ __attribute__((aligned(16))) unsigned char smem[]; phase_experts(P, (LAS unsigned char*)smem); }
__global__ void __launch_bounds__(NTHREADS) t_nsa(Params P) { extern __shared__ __attribute__((aligned(16))) unsigned char smem[]; nsa_unit(P, (LAS unsigned char*)smem, blockIdx.x); }
__global__ void __launch_bounds__(NTHREADS) t_mod(Params P) { extern __shared__ __attribute__((aligned(16))) unsigned char smem[]; phase_mod(P, (LAS unsigned char*)smem); }
__global__ void __launch_bounds__(NTHREADS) t_inproj(Params P) { extern __shared__ __attribute__((aligned(16))) unsigned char smem[]; phase_inproj(P, (LAS unsigned char*)smem); }
__global__ void __launch_bounds__(NTHREADS) t_cmp(Params P) { extern __shared__ __attribute__((aligned(16))) unsigned char smem[]; compress_unit(P, (LAS unsigned char*)smem, blockIdx.x); }
__global__ void __launch_bounds__(NTHREADS) t_h0(Params P) { extern __shared__ __attribute__((aligned(16))) unsigned char smem[]; hgrn_unit<0>(P, (LAS unsigned char*)smem, blockIdx.x); }
__global__ void __launch_bounds__(NTHREADS) t_h1(Params P) { extern __shared__ __attribute__((aligned(16))) unsigned char smem[]; hgrn_unit<1>(P, (LAS unsigned char*)smem, blockIdx.x); }
#endif
```
